# Optimizing an MI355X kernel written in HIP

```python
import jax, jax.numpy as jnp
from jax import lax
import numpy as np

D_MODEL = 1024
BATCH = 2
SEQ = 8192
DEPTH = 4

CHUNK = 64
N_META = 16
HEAD_DIM = 64
H_FOX = 8
H_RWKV = 8
W_FOX = H_FOX * HEAD_DIM
W_RWKV = H_RWKV * HEAD_DIM
LORA_W = 64
LORA_A = 64
LORA_G = 128
N_RWKV_IN = 3 * W_RWKV + LORA_W + LORA_A + LORA_G
N_GATES = 2 * D_MODEL
N_IN = 3 * W_FOX + H_FOX + N_RWKV_IN + N_GATES
D_FF = 2816
CONV_W = 3
Q_BLOCK = 128
NORM_EPS = 1e-6
GN_EPS = HEAD_DIM * 1e-5

IN_SPLITS = (W_FOX, 2 * W_FOX, 3 * W_FOX, 3 * W_FOX + H_FOX, 3 * W_FOX + H_FOX + N_RWKV_IN)
RWKV_SPLITS = (W_RWKV, 2 * W_RWKV, 3 * W_RWKV, 3 * W_RWKV + LORA_W, 3 * W_RWKV + LORA_W + LORA_A)

kernel_name = 'hybrid_fox_rwkv7_streaming_block'


def rms_norm(x, g):
    xf = x.astype(jnp.float32)
    y = xf * lax.rsqrt(jnp.mean(xf * xf, axis=-1, keepdims=True) + NORM_EPS)
    return y.astype(x.dtype) * g


def fox_attention(q, k, v, fcum):
    b, h, length, n = q.shape
    nb = length // Q_BLOCK
    q_blocks = jnp.moveaxis(q.reshape(b, h, nb, Q_BLOCK, n), 2, 0)
    f_blocks = jnp.moveaxis(fcum.reshape(b, h, nb, Q_BLOCK), 2, 0)
    starts = jnp.arange(nb, dtype=jnp.int32) * Q_BLOCK
    key_pos = jnp.arange(length, dtype=jnp.int32)
    scale = HEAD_DIM ** -0.5

    def one_block(args):
        q_blk, f_blk, start = args
        s = jnp.einsum('bhqd,bhkd->bhqk', q_blk, k).astype(jnp.float32) * scale
        s = s + f_blk[..., :, None] - fcum[..., None, :]
        q_pos = start + jnp.arange(Q_BLOCK, dtype=jnp.int32)
        mask = key_pos[None, :] <= q_pos[:, None]
        s = jnp.where(mask, s, -jnp.inf)
        p = jax.nn.softmax(s, axis=-1)
        return jnp.einsum('bhqk,bhkd->bhqd', p.astype(v.dtype), v)

    out = lax.map(one_block, (q_blocks, f_blocks, starts))
    return jnp.moveaxis(out, 0, 2).reshape(b, h, length, n)


def rwkv7_scan(r, w, k, v, a, bb):
    b, length, h, n = r.shape

    def step(state, inp):
        r_t, w_t, k_t, v_t, a_t, b_t = inp
        sa = jnp.einsum('bhvk,bhk->bhv', state, a_t)
        state = (state * w_t[:, :, None, :]
                 + sa[..., None] * b_t[:, :, None, :]
                 + v_t[..., None] * k_t[:, :, None, :])
        return state, jnp.einsum('bhvk,bhk->bhv', state, r_t)

    xs = tuple(jnp.moveaxis(t.astype(jnp.float32), 1, 0) for t in (r, w, k, v, a, bb))
    s0 = jnp.zeros((b, h, n, n), jnp.float32)
    _, y = lax.scan(step, s0, xs)
    return jnp.moveaxis(y, 0, 1)


def hybrid_mixer(hn, w_in, q_g, k_g, f_b, mu, w0, w_up, a0, a_up, g_up, k_k, k_a, r_k,
                 gn_w, gn_b, w_bf, w_br, g_b, w_o):
    b, length, _ = hn.shape
    proj = hn @ w_in
    q, k, v, f_logit, rw, gates = jnp.split(proj, IN_SPLITS, axis=-1)

    def to_heads(t, nh):
        return t.reshape(b, length, nh, HEAD_DIM).transpose(0, 2, 1, 3)
    qh = rms_norm(to_heads(q, H_FOX), q_g)
    kh = rms_norm(to_heads(k, H_FOX), k_g)
    vh = to_heads(v, H_FOX)
    log_f = jax.nn.log_sigmoid((f_logit + f_b).astype(jnp.float32))
    fcum = jnp.cumsum(log_f, axis=1).transpose(0, 2, 1)
    o_fox = fox_attention(qh, kh, vh, fcum)
    o_fox = o_fox.transpose(0, 2, 1, 3).reshape(b, length, W_FOX)

    rw_prev = jnp.pad(rw, ((0, 0), (1, 0), (0, 0)))[:, :-1]
    z = rw + mu * (rw_prev - rw)
    r, kr, vr, zw, za, zg = jnp.split(z, RWKV_SPLITS, axis=-1)
    w_log = -jax.nn.softplus(-(w0 + jnp.tanh(zw) @ w_up)) - 0.5
    decay = jnp.exp(-jnp.exp(w_log.astype(jnp.float32)))
    a_rate = jax.nn.sigmoid(a0 + za @ a_up)
    g = jax.nn.sigmoid(zg) @ g_up
    kk = (kr * k_k).reshape(b, length, H_RWKV, HEAD_DIM).astype(jnp.float32)
    kk = kk / jnp.maximum(jnp.sqrt(jnp.sum(kk * kk, axis=-1, keepdims=True)), 1e-12)
    kr = kr * (1.0 + (a_rate - 1.0) * k_a)
    heads4 = lambda t: t.reshape(b, length, H_RWKV, HEAD_DIM)
    r4, k4, v4, a4 = heads4(r), heads4(kr), heads4(vr), heads4(a_rate)
    y = rwkv7_scan(r4, heads4(decay), k4, v4, -kk, kk * a4)
    mean = jnp.mean(y, axis=-1, keepdims=True)
    var = jnp.mean(jnp.square(y - mean), axis=-1, keepdims=True)
    yn = (y - mean) * lax.rsqrt(var + GN_EPS)
    yn = yn * gn_w.reshape(H_RWKV, HEAD_DIM) + gn_b.reshape(H_RWKV, HEAD_DIM)
    bonus = jnp.sum((r4 * k4 * r_k).astype(jnp.float32), axis=-1, keepdims=True) * v4
    o_rwkv = (yn + bonus).astype(hn.dtype).reshape(b, length, W_RWKV) * g

    g_fox, g_rwkv = jnp.split(jax.nn.sigmoid(gates + g_b), 2, axis=-1)
    merged = g_fox * (o_fox @ w_bf) + g_rwkv * (o_rwkv @ w_br)
    return merged @ w_o


def conv_ffn(hn, w_up, w_conv, w_down):
    u = hn @ w_up
    length = u.shape[1]
    u_pad = jnp.pad(u, ((0, 0), (CONV_W - 1, 0), (0, 0)))
    uc = sum(w_conv[j] * u_pad[:, j:j + length] for j in range(CONV_W))
    gate, val = jnp.split(uc, 2, axis=-1)
    return (jax.nn.silu(gate) * val) @ w_down


def setup_inputs(seed: int = 0) -> dict:
    key = jax.random.key(seed)
    ks = jax.random.split(key, 26)
    f32 = jnp.float32

    def nrm(k, shape, s):
        return s * jax.random.normal(k, shape, f32)

    return {
        'x': nrm(ks[0], (BATCH, SEQ, D_MODEL), 1.0),
        'meta_tokens': nrm(ks[1], (N_META, D_MODEL), 1.0),
        'norm_mix': 1.0 + nrm(ks[2], (DEPTH, D_MODEL), 0.02),
        'norm_ffn': 1.0 + nrm(ks[3], (DEPTH, D_MODEL), 0.02),
        'w_in': nrm(ks[4], (DEPTH, D_MODEL, N_IN), D_MODEL ** -0.5),
        'fox_q_norm': 1.0 + nrm(ks[5], (DEPTH, HEAD_DIM), 0.02),
        'fox_k_norm': 1.0 + nrm(ks[6], (DEPTH, HEAD_DIM), 0.02),
        'fox_f_bias': 2.0 + nrm(ks[7], (DEPTH, H_FOX), 1.0),
        'rwkv_shift_mu': jax.random.uniform(ks[8], (DEPTH, N_RWKV_IN), f32),
        'rwkv_w0': -3.0 + nrm(ks[9], (DEPTH, W_RWKV), 1.0),
        'rwkv_w_up': nrm(ks[10], (DEPTH, LORA_W, W_RWKV), 0.1 * LORA_W ** -0.5),
        'rwkv_a0': nrm(ks[11], (DEPTH, W_RWKV), 0.5),
        'rwkv_a_up': nrm(ks[12], (DEPTH, LORA_A, W_RWKV), 0.5 * LORA_A ** -0.5),
        'rwkv_g_up': nrm(ks[13], (DEPTH, LORA_G, W_RWKV), LORA_G ** -0.5),
        'rwkv_k_k': 0.85 + nrm(ks[14], (DEPTH, W_RWKV), 0.1),
        'rwkv_k_a': 1.0 + nrm(ks[15], (DEPTH, W_RWKV), 0.1),
        'rwkv_r_k': nrm(ks[16], (DEPTH, H_RWKV, HEAD_DIM), 0.1),
        'rwkv_gn_w': 1.0 + nrm(ks[17], (DEPTH, W_RWKV), 0.02),
        'rwkv_gn_b': nrm(ks[18], (DEPTH, W_RWKV), 0.02),
        'w_branch_fox': nrm(ks[19], (DEPTH, W_FOX, D_MODEL), W_FOX ** -0.5),
        'w_branch_rwkv': nrm(ks[20], (DEPTH, W_RWKV, D_MODEL), W_RWKV ** -0.5),
        'gate_bias': nrm(ks[21], (DEPTH, N_GATES), 0.1),
        'w_out': nrm(ks[22], (DEPTH, D_MODEL, D_MODEL), 0.5 * D_MODEL ** -0.5),
        'ffn_up': nrm(ks[23], (DEPTH, D_MODEL, 2 * D_FF), D_MODEL ** -0.5),
        'ffn_conv': nrm(ks[24], (DEPTH, CONV_W, 2 * D_FF), CONV_W ** -0.5),
        'ffn_down': nrm(ks[25], (DEPTH, D_FF, D_MODEL), 0.5 * D_FF ** -0.5),
    }


def reference(x, meta_tokens, norm_mix, norm_ffn, w_in, fox_q_norm, fox_k_norm, fox_f_bias,
              rwkv_shift_mu, rwkv_w0, rwkv_w_up, rwkv_a0, rwkv_a_up, rwkv_g_up, rwkv_k_k,
              rwkv_k_a, rwkv_r_k, rwkv_gn_w, rwkv_gn_b, w_branch_fox, w_branch_rwkv,
              gate_bias, w_out, ffn_up, ffn_conv, ffn_down):
    b, s, _ = x.shape
    meta = jnp.broadcast_to(meta_tokens.astype(x.dtype)[None], (b, N_META, D_MODEL))
    h = jnp.concatenate([meta, x], axis=1)
    length = N_META + s
    padded = -(-length // Q_BLOCK) * Q_BLOCK
    h = jnp.pad(h, ((0, 0), (0, padded - length), (0, 0)))
    for i in range(DEPTH):
        h = h + hybrid_mixer(rms_norm(h, norm_mix[i]), w_in[i], fox_q_norm[i], fox_k_norm[i],
                             fox_f_bias[i], rwkv_shift_mu[i], rwkv_w0[i], rwkv_w_up[i],
                             rwkv_a0[i], rwkv_a_up[i], rwkv_g_up[i], rwkv_k_k[i], rwkv_k_a[i],
                             rwkv_r_k[i], rwkv_gn_w[i], rwkv_gn_b[i], w_branch_fox[i],
                             w_branch_rwkv[i], gate_bias[i], w_out[i])
        h = h + conv_ffn(rms_norm(h, norm_ffn[i]), ffn_up[i], ffn_conv[i], ffn_down[i])
    return h[:, N_META:N_META + s]
```

```cpp
#include <hip/hip_runtime.h>
#include <hip/hip_cooperative_groups.h>
#include <cstdio>
#include <cstdint>
#include <cmath>
namespace cg = cooperative_groups;
namespace pg8 {
#define PG8_LAS __attribute__((address_space(3)))
typedef unsigned short bf16_t;
typedef short bf16x8 __attribute__((ext_vector_type(8)));
typedef float f32x4 __attribute__((ext_vector_type(4)));
typedef unsigned u32x4 __attribute__((ext_vector_type(4)));
constexpr int BM = 256, BK = 64, HALF = 128, HTB = HALF * BK * 2  , STAGE_BYTES = 8 * HTB, NXCD = 8, WGM = 8;

__host__ __device__ __forceinline__ int lds_byte(int r, int c) { const int st = (r >> 4) * 2 + (c >> 5), rr = r & 15, cc = c & 31, ob = rr * 64 + cc * 2; return st * 1024 + (ob ^ (((ob >> 9) & 1) << 5)); }
__host__ __device__ __forceinline__ void stage_rc(int b, int& R, int& C) { const int st = b / 1024, sb = b % 1024, swz = sb ^ (((sb >> 9) & 1) << 5); R = (st >> 1) * 16 + swz / 64; C = (st & 1) * 32 + (swz % 64) / 2; }
__host__ __device__ __forceinline__ int perm32(int rho) { const int n = rho >> 4, i = rho & 15; return 8 * (i >> 2) + 4 * n + (i & 3); }

struct Unit { int pm, pn; };
struct Gemm { const bf16_t* A; const bf16_t* Bt; int M, N, K; };

struct StaticOrder {
    int nM, nN, nwg, G, c;
    __host__ __device__ void init(int M, int N, int G_, int c_) { nM = M / BM; nN = N / BM; nwg = nM * nN; G = G_; c = c_; }
    __host__ __device__ bool next(int i, Unit& u) const {
        const long L = (long)i * G + c; if (L >= nwg) return false;
        int wgid = (int)L; { const int q = nwg / NXCD, r = nwg % NXCD, xcd = wgid % NXCD, off = wgid / NXCD; wgid = (xcd < r ? xcd * (q + 1) : r * (q + 1) + (xcd - r) * q) + off; }
        const int nig = WGM * nN, gid = wgid / nig, fm = gid * WGM, gsz = (nM - fm) < WGM ? (nM - fm) : WGM;
        u.pm = fm + ((wgid % nig) % gsz); u.pn = (wgid % nig) / gsz; return true;
    }
    __device__ __forceinline__ void a_ready(const Unit&) const {}
    __device__ __forceinline__ void done(const Unit&) const {}
};

__device__ __forceinline__ unsigned cvt_pk_bf16(float lo, float hi) { unsigned r; asm volatile("v_cvt_pk_bf16_f32 %0, %1, %2" : "=v"(r) : "v"(lo), "v"(hi)); return r; }
typedef float f32x2 __attribute__((ext_vector_type(2)));
template <class Epi, class Sched, bool ALIGN_EPI = false, bool SP2 = false>
__device__ __forceinline__ void gemm_phase(PG8_LAS unsigned char* lds, const Gemm g, const Sched& S, const Epi& E) {
    int tid_ = threadIdx.x; asm volatile("" : "+v"(tid_)); const int tid = tid_, wid = __builtin_amdgcn_readfirstlane(tid >> 6), lane = tid & 63, wr = wid >> 2, wc = wid & 3, fr = lane & 15, fq = lane >> 4;
    const int K = g.K, nt = K / BK;
    unsigned voffA[2], voffB[2];
#pragma unroll
    for (int i = 0; i < 2; ++i) { int R, C; stage_rc(tid * 16 + i * 8192, R, C); const int Rb = Epi::PERM ? ((R & ~31) + perm32(R & 31)) : R;
        voffA[i] = (unsigned)(R * K + C) * 2u; voffB[i] = (unsigned)(Rb * K + C) * 2u; }
    const size_t kstep = (size_t)(BK * 2);
    const size_t hstep = (size_t)HALF * K * 2;
    const size_t tstep = 2 * hstep;
    const unsigned ldsw = (unsigned)wid * 1024u;
    const int aoff = lds_byte(wr * 64 + fr, fq * 8), boff = lds_byte(wc * 32 + fr, fq * 8);
#define PG8_SA(b, h) (((b) * 2 + (h)) * HTB)
#define PG8_SB(b, h) ((4 + (b) * 2 + (h)) * HTB)
#define PG8_STAGE(bufoff, gbase, voff) do { _Pragma("unroll") for (int _i = 0; _i < 2; ++_i) \
        __builtin_amdgcn_global_load_lds((const unsigned*)((const char*)(gbase) + (voff)[_i]), (PG8_LAS unsigned*)(lds + (bufoff) + ldsw + _i * 8192), 16, 0, 0); } while (0)
#define PG8_LDA(dst, b, h) do { _Pragma("unroll") for (int m = 0; m < 4; ++m) _Pragma("unroll") for (int k = 0; k < 2; ++k) dst[m][k] = *(const PG8_LAS bf16x8*)(lds + PG8_SA(b, h) + aoff + m * 2048 + k * 1024); } while (0)
#define PG8_LDB(dst, b, h) do { _Pragma("unroll") for (int n = 0; n < 2; ++n) _Pragma("unroll") for (int k = 0; k < 2; ++k) dst[n][k] = *(const PG8_LAS bf16x8*)(lds + PG8_SB(b, h) + boff + n * 2048 + k * 1024); } while (0)
#define PG8_MMA(ai, bj, At, Bt) do { __builtin_amdgcn_s_setprio(1); _Pragma("unroll") for (int m = 0; m < 4; ++m) _Pragma("unroll") for (int n = 0; n < 2; ++n) _Pragma("unroll") for (int k = 0; k < 2; ++k) \
        acc[ai][bj][m][n] = __builtin_amdgcn_mfma_f32_16x16x32_bf16(Bt[n][k], At[m][k], acc[ai][bj][m][n], 0, 0, 0); __builtin_amdgcn_s_setprio(0); } while (0)
#define PG8_WAIT_V(n) asm volatile("s_waitcnt vmcnt(" #n ")" ::: "memory")
#define PG8_WAIT_L(n) asm volatile("s_waitcnt lgkmcnt(" #n ")" ::: "memory")
#define PG8_BAR __builtin_amdgcn_s_barrier()
#define PG8_SCHED __builtin_amdgcn_sched_barrier(0)
    Unit cur, nxt; int ui = 0;
    if (!S.next(0, cur)) return;
    f32x4 acc[2][2][4][2];
#pragma unroll
    for (int a = 0; a < 2; ++a)
#pragma unroll
        for (int b = 0; b < 2; ++b)
#pragma unroll
            for (int m = 0; m < 4; ++m)
#pragma unroll
                for (int n = 0; n < 2; ++n) acc[a][b][m][n] = (f32x4){0.f, 0.f, 0.f, 0.f};
    bf16x8 At[4][2], B0[2][2], B1[2][2];
    const char* cA = (const char*)g.A + (size_t)cur.pm * tstep; const char* cB = (const char*)g.Bt + (size_t)cur.pn * tstep;
    S.a_ready(cur);
    if constexpr (SP2) {
        PG8_STAGE(PG8_SB(0, 0), cB, voffB); PG8_STAGE(PG8_SB(0, 1), cB + hstep, voffB); PG8_STAGE(PG8_SA(0, 0), cA, voffA); PG8_STAGE(PG8_SA(0, 1), cA + hstep, voffA);
        if (wr == 1) PG8_BAR;
        PG8_WAIT_V(2); PG8_BAR;
        PG8_STAGE(PG8_SB(1, 0), cB + kstep, voffB); PG8_STAGE(PG8_SA(1, 0), cA + kstep, voffA); PG8_STAGE(PG8_SB(1, 1), cB + hstep + kstep, voffB);
        PG8_WAIT_V(6); PG8_BAR;
    } else {
        PG8_STAGE(PG8_SB(0, 0), cB, voffB); PG8_STAGE(PG8_SA(0, 0), cA, voffA); PG8_STAGE(PG8_SB(0, 1), cB + hstep, voffB); PG8_STAGE(PG8_SA(0, 1), cA + hstep, voffA);
        if (wr == 1) PG8_BAR;
        PG8_WAIT_V(4); PG8_BAR;
        PG8_STAGE(PG8_SB(1, 0), cB + kstep, voffB); PG8_STAGE(PG8_SA(1, 0), cA + kstep, voffA); PG8_STAGE(PG8_SB(1, 1), cB + hstep + kstep, voffB);
        PG8_WAIT_V(6); PG8_BAR;
    }
    for (;;) {
        const bool has_next = S.next(ui + 1, nxt);
        const char* nA = has_next ? (const char*)g.A + (size_t)nxt.pm * tstep : cA; const char* nB = has_next ? (const char*)g.Bt + (size_t)nxt.pn * tstep : cB;
        for (int t = 0; t < nt; t += 2) {
            const bool last = (t == nt - 2);
            const char* a1 = cA + (size_t)(t + 1) * kstep;
            const char* a2 = last ? nA : cA + (size_t)(t + 2) * kstep; const char* b2 = last ? nB : cB + (size_t)(t + 2) * kstep;
            const char* a3 = a2 + kstep; const char* b3 = b2 + kstep;
            if (last && has_next) S.a_ready(nxt);
            if constexpr (SP2) {
            PG8_LDB(B0, 0, 0); PG8_LDB(B1, 0, 1); PG8_SCHED; PG8_LDA(At, 0, 0); PG8_STAGE(PG8_SA(1, 1), a1 + hstep, voffA);
            PG8_WAIT_V(8); PG8_WAIT_L(0); PG8_BAR; PG8_MMA(0, 0, At, B0); PG8_MMA(0, 1, At, B1); PG8_BAR; PG8_SCHED;
            PG8_LDA(At, 0, 1); PG8_STAGE(PG8_SB(0, 0), b2, voffB); PG8_STAGE(PG8_SB(0, 1), b2 + hstep, voffB); PG8_STAGE(PG8_SA(0, 0), a2, voffA);
            PG8_WAIT_V(8); PG8_WAIT_L(0); PG8_BAR; PG8_MMA(1, 0, At, B0); PG8_MMA(1, 1, At, B1); PG8_BAR; PG8_SCHED;
            PG8_LDB(B0, 1, 0); PG8_LDB(B1, 1, 1); PG8_SCHED; PG8_LDA(At, 1, 0); PG8_STAGE(PG8_SA(0, 1), a2 + hstep, voffA);
            PG8_WAIT_V(8); PG8_WAIT_L(0); PG8_BAR; PG8_MMA(0, 0, At, B0); PG8_MMA(0, 1, At, B1); PG8_BAR; PG8_SCHED;
            PG8_LDA(At, 1, 1); PG8_STAGE(PG8_SB(1, 0), b3, voffB); PG8_STAGE(PG8_SB(1, 1), b3 + hstep, voffB); PG8_STAGE(PG8_SA(1, 0), a3, voffA);
            PG8_WAIT_V(8); PG8_WAIT_L(0); PG8_BAR; PG8_MMA(1, 0, At, B0); PG8_MMA(1, 1, At, B1); PG8_BAR; PG8_SCHED;
            } else {
            PG8_LDB(B0, 0, 0); PG8_SCHED; PG8_LDA(At, 0, 0); PG8_STAGE(PG8_SA(1, 1), a1 + hstep, voffA);
            PG8_WAIT_L(8); PG8_BAR; PG8_WAIT_L(0); PG8_MMA(0, 0, At, B0); PG8_BAR; PG8_SCHED;
            PG8_LDB(B1, 0, 1); PG8_STAGE(PG8_SB(0, 0), b2, voffB);
            PG8_BAR; PG8_WAIT_L(0); PG8_MMA(0, 1, At, B1); PG8_BAR;
            PG8_LDA(At, 0, 1); PG8_STAGE(PG8_SA(0, 0), a2, voffA);
            PG8_BAR; PG8_WAIT_L(0); PG8_MMA(1, 0, At, B0); PG8_BAR; PG8_SCHED;
            PG8_STAGE(PG8_SB(0, 1), b2 + hstep, voffB);
            PG8_WAIT_V(6); PG8_BAR; PG8_MMA(1, 1, At, B1); PG8_BAR;
            PG8_LDB(B0, 1, 0); PG8_SCHED; PG8_LDA(At, 1, 0); PG8_STAGE(PG8_SA(0, 1), a2 + hstep, voffA);
            PG8_WAIT_L(8); PG8_BAR; PG8_WAIT_L(0); PG8_MMA(0, 0, At, B0); PG8_BAR; PG8_SCHED;
            PG8_LDB(B1, 1, 1); PG8_STAGE(PG8_SB(1, 0), b3, voffB);
            PG8_BAR; PG8_WAIT_L(0); PG8_MMA(0, 1, At, B1); PG8_BAR;
            PG8_LDA(At, 1, 1); PG8_STAGE(PG8_SA(1, 0), a3, voffA);
            PG8_BAR; PG8_WAIT_L(0); PG8_MMA(1, 0, At, B0); PG8_BAR; PG8_SCHED;
            PG8_STAGE(PG8_SB(1, 1), b3 + hstep, voffB);
            PG8_WAIT_V(6); PG8_BAR; PG8_MMA(1, 1, At, B1); PG8_BAR;
            }
        }
        if constexpr (ALIGN_EPI) { if (wr == 0) PG8_BAR; }
        if constexpr (!Epi::AFTER_DRAIN) { E(acc, cur, wr, wc, fr, fq); S.done(cur); }
        if (!has_next) break;
#pragma unroll
        for (int a = 0; a < 2; ++a)
#pragma unroll
            for (int b = 0; b < 2; ++b)
#pragma unroll
                for (int m = 0; m < 4; ++m)
#pragma unroll
                    for (int n = 0; n < 2; ++n) acc[a][b][m][n] = (f32x4){0.f, 0.f, 0.f, 0.f};
        cur = nxt; cA = nA; cB = nB; ++ui;
        if constexpr (ALIGN_EPI) { if (wr == 1) PG8_BAR; }
    }
    PG8_WAIT_V(0);
    if constexpr (!ALIGN_EPI) { if (wr == 0) PG8_BAR; }
    PG8_BAR;
    if constexpr (Epi::AFTER_DRAIN) { E.fused(acc, cur, wr, wc, fr, fq, lds, wid, lane); S.done(cur); }
#undef PG8_SA
#undef PG8_SB
#undef PG8_STAGE
#undef PG8_LDA
#undef PG8_LDB
#undef PG8_MMA
#undef PG8_WAIT_V
#undef PG8_WAIT_L
#undef PG8_BAR
#undef PG8_SCHED
}
}

constexpr int NB = 2, SEQ = 8192, DM = 1024, DEPTH = 4, NMETA = 16, LP = 8320, M = NB * LP;
constexpr int N_IN = 5384, N1 = 5376, NRW = 1792, NGT = 2048, DFF = 2816, NUP = 5632;
constexpr float LOG2E = 1.4426950408889634f;
constexpr float QSCALE = 0.125f * LOG2E;
constexpr float THR2 = 30.0f * LOG2E;
constexpr int NWAVES = 8, NTHR = 512;
constexpr int LDS_BYTES = 147456;

typedef unsigned short bf16;
typedef float f32x4 __attribute__((ext_vector_type(4)));
typedef unsigned u32x4 __attribute__((ext_vector_type(4)));
typedef unsigned u32x2 __attribute__((ext_vector_type(2)));
typedef short bf16x8 __attribute__((ext_vector_type(8)));

constexpr size_t SZ_H = (size_t)M * DM * 4, SZ_X512 = (size_t)M * 512 * 2;
constexpr size_t OFF_CTL = 0, OFF_H = 1u << 20, OFF_WT = OFF_H + SZ_H;
constexpr size_t WT_IN = 0, WT_BF = WT_IN + (size_t)N1 * 1024, WT_BR = WT_BF + 1024 * 512, WT_O = WT_BR + 1024 * 512,
                 WT_UP = WT_O + 1024 * 1024, WT_DN = WT_UP + (size_t)NUP * 1024, WT_END = WT_DN + (size_t)1024 * DFF;
constexpr size_t OFF_HN = OFF_WT + WT_END * 2;
constexpr size_t OFF_Q = OFF_HN + 2 * SZ_X512, OFF_K = OFF_Q + SZ_X512, OFF_V = OFF_K + SZ_X512;
constexpr size_t OFF_RW = OFF_V + SZ_X512, OFF_GT = OFF_RW + (size_t)M * NRW * 2, OFF_MISC = OFF_GT + (size_t)M * NGT * 2;
constexpr size_t OFF_T0 = OFF_MISC + 2 * 16 * LP * 4, WS_NEED = OFF_T0 + 2 * SZ_X512;
static_assert(OFF_HN % 256 == 0 && OFF_RW % 256 == 0 && OFF_T0 % 256 == 0, "alignment");

struct Params { const float* in[26]; float* out; unsigned char* ws; };
struct Ctx { int tid, lane, wave, bid, G; unsigned char* lds; unsigned char* ws; };

__device__ __forceinline__ float bf2f(unsigned b) { return __uint_as_float(b << 16); }
__device__ __forceinline__ float bflo(unsigned w) { return __uint_as_float(w << 16); }
__device__ __forceinline__ float bfhi(unsigned w) { return __uint_as_float(w & 0xffff0000u); }
__device__ __forceinline__ unsigned f2bf(float f) { unsigned u = __float_as_uint(f); return (u + 0x7fffu + ((u >> 16) & 1u)) >> 16; }
__device__ __forceinline__ unsigned pk2(float lo, float hi) { return f2bf(lo) | (f2bf(hi) << 16); }
__device__ __forceinline__ float wave_sum(float v) {
#pragma unroll
    for (int o = 1; o < 64; o <<= 1) v += __shfl_xor(v, o);
    return v;
}
__device__ __forceinline__ float sigmoidf_(float x) { return 1.f / (1.f + __expf(-x)); }
template <int CTRL> __device__ __forceinline__ float dppf(float old, float x) {
    return __int_as_float(__builtin_amdgcn_update_dpp(__float_as_int(old), __float_as_int(x), CTRL, 0xf, 0xf, false));
}
__device__ __forceinline__ float allreduce16(float x) {
    x += dppf<0x121>(0.f, x); x += dppf<0x122>(0.f, x); x += dppf<0x124>(0.f, x); x += dppf<0x128>(0.f, x); return x;
}

namespace pg8 {
struct EpiRoute {
    static constexpr bool PERM = true, AFTER_DRAIN = false;
    unsigned char* ws;
    __device__ __forceinline__ void operator()(const f32x4 (&acc)[2][2][4][2], const Unit& u, int wr, int wc, int fr, int fq) const {
        const int pn = u.pn; size_t off; int ldc, colt;
        if (pn < 6) { off = OFF_Q + (size_t)(pn >> 1) * SZ_X512; ldc = 512; colt = (pn & 1) * 256; }
        else if (pn < 13) { off = OFF_RW; ldc = NRW; colt = (pn - 6) * 256; }
        else { off = OFF_GT; ldc = NGT; colt = (pn - 13) * 256; }
        bf16_t* base = (bf16_t*)(ws + off);
        const int row0 = u.pm * BM + wr * 64 + fr, col0 = colt + wc * 32 + 8 * fq;
#pragma unroll
        for (int ai = 0; ai < 2; ++ai)
#pragma unroll
            for (int m = 0; m < 4; ++m) { bf16_t* rowp = base + (size_t)(row0 + ai * HALF + m * 16) * ldc + col0;
#pragma unroll
                for (int bj = 0; bj < 2; ++bj) { const f32x4 v0 = acc[ai][bj][m][0], v1 = acc[ai][bj][m][1];
                    u32x4 w; w.x = cvt_pk_bf16(v0[0], v0[1]); w.y = cvt_pk_bf16(v0[2], v0[3]); w.z = cvt_pk_bf16(v1[0], v1[1]); w.w = cvt_pk_bf16(v1[2], v1[3]);
                    *(u32x4*)(rowp + bj * HALF) = w; } }
    }
};
template <int MODE> struct EpiGate {
    static constexpr bool PERM = true, AFTER_DRAIN = false;
    bf16_t* O; const bf16_t* GT; const float* gb;
    __device__ __forceinline__ void operator()(const f32x4 (&acc)[2][2][4][2], const Unit& u, int wr, int wc, int fr, int fq) const {
        const int row0 = u.pm * BM + wr * 64 + fr, col0 = u.pn * BM + wc * 32 + 8 * fq;
#pragma unroll
        for (int bj = 0; bj < 2; ++bj) {
            const int c = col0 + bj * HALF;
            const f32x4 b0 = *(const f32x4*)(gb + MODE * 1024 + c), b1 = *(const f32x4*)(gb + MODE * 1024 + c + 4);
#pragma unroll
            for (int ai = 0; ai < 2; ++ai)
#pragma unroll
                for (int m = 0; m < 4; ++m) {
                    const size_t row = (size_t)(row0 + ai * HALF + m * 16);
                    const u32x4 gw = *(const u32x4*)(GT + row * NGT + MODE * 1024 + c);
                    const f32x4 v0 = acc[ai][bj][m][0], v1 = acc[ai][bj][m][1];
                    float r[8];
                    r[0] = sigmoidf_(bflo(gw.x) + b0[0]) * v0[0]; r[1] = sigmoidf_(bfhi(gw.x) + b0[1]) * v0[1];
                    r[2] = sigmoidf_(bflo(gw.y) + b0[2]) * v0[2]; r[3] = sigmoidf_(bfhi(gw.y) + b0[3]) * v0[3];
                    r[4] = sigmoidf_(bflo(gw.z) + b1[0]) * v1[0]; r[5] = sigmoidf_(bfhi(gw.z) + b1[1]) * v1[1];
                    r[6] = sigmoidf_(bflo(gw.w) + b1[2]) * v1[2]; r[7] = sigmoidf_(bfhi(gw.w) + b1[3]) * v1[3];
                    bf16_t* op = O + row * 1024 + c;
                    if (MODE == 1) { const u32x4 ow = *(const u32x4*)op;
                        r[0] += bflo(ow.x); r[1] += bfhi(ow.x); r[2] += bflo(ow.y); r[3] += bfhi(ow.y); r[4] += bflo(ow.z); r[5] += bfhi(ow.z); r[6] += bflo(ow.w); r[7] += bfhi(ow.w); }
                    u32x4 w; w.x = cvt_pk_bf16(r[0], r[1]); w.y = cvt_pk_bf16(r[2], r[3]); w.z = cvt_pk_bf16(r[4], r[5]); w.w = cvt_pk_bf16(r[6], r[7]);
                    *(u32x4*)op = w;
                }
        }
    }
};
struct EpiResid {
    static constexpr bool PERM = false, AFTER_DRAIN = false;
    float* H; float* OUT;
    __device__ __forceinline__ void operator()(const f32x4 (&acc)[2][2][4][2], const Unit& u, int wr, int wc, int fr, int fq) const {
        const int row0 = u.pm * BM + wr * 64 + fr, col0 = u.pn * BM + wc * 32 + 4 * fq;
#pragma unroll
        for (int ai = 0; ai < 2; ++ai)
#pragma unroll
            for (int m = 0; m < 4; ++m) {
                const int row = row0 + ai * HALF + m * 16;
                float* hp = H + (size_t)row * DM + col0;
                const int b = row >= LP ? 1 : 0, t = row - b * LP;
                float* op = (OUT && t >= NMETA && t < NMETA + SEQ) ? OUT + ((size_t)b * SEQ + (t - NMETA)) * DM + col0 : nullptr;
#pragma unroll
                for (int bj = 0; bj < 2; ++bj)
#pragma unroll
                    for (int n = 0; n < 2; ++n) { const int co = bj * HALF + n * 16;
                        const f32x4 v = *(const f32x4*)(hp + co) + acc[ai][bj][m][n];
                        if (OUT) { if (op) *(f32x4*)(op + co) = v; } else *(f32x4*)(hp + co) = v; }
            }
    }
};
struct EpiUp {
    static constexpr bool PERM = true, AFTER_DRAIN = false;
    bf16_t* ACT; bf16_t* HALO; const float* cw;
    __device__ __forceinline__ void operator()(const f32x4 (&acc)[2][2][4][2], const Unit& u, int wr, int wc, int fr, int fq) const {
        const int chan0 = u.pn * 128 + wc * 32 + 8 * fq;
#pragma unroll
        for (int n = 0; n < 2; ++n) {
            const int ch = chan0 + 4 * n;
            f32x4 w[3][2];
#pragma unroll
            for (int j = 0; j < 3; ++j) { w[j][0] = *(const f32x4*)(cw + j * NUP + ch); w[j][1] = *(const f32x4*)(cw + j * NUP + DFF + ch); }
#pragma unroll
            for (int ai = 0; ai < 2; ++ai) {
                const int rowg = u.pm * BM + ai * HALF + wr * 64;
#pragma unroll
                for (int m = 0; m < 4; ++m) {
                    f32x4 uc[2];
#pragma unroll
                    for (int bj = 0; bj < 2; ++bj) {
                        const f32x4 cur = acc[ai][bj][m][n];
                        f32x4 prv; if (m > 0) prv = acc[ai][bj][m - 1][n]; else prv = (f32x4){0.f, 0.f, 0.f, 0.f};
                        f32x4 p1, p2;
#pragma unroll
                        for (int i = 0; i < 4; ++i) {
                            const float r1 = dppf<0x121>(0.f, prv[i]), r2 = dppf<0x122>(0.f, prv[i]);
                            p1[i] = dppf<0x111>(r1, cur[i]); p2[i] = dppf<0x112>(r2, cur[i]);
                        }
                        uc[bj] = w[0][bj] * p2 + w[1][bj] * p1 + w[2][bj] * cur;
                    }
                    float a[4];
#pragma unroll
                    for (int i = 0; i < 4; ++i) a[i] = uc[0][i] * sigmoidf_(uc[0][i]) * uc[1][i];
                    u32x2 o; o.x = cvt_pk_bf16(a[0], a[1]); o.y = cvt_pk_bf16(a[2], a[3]);
                    *(u32x2*)(ACT + (size_t)(rowg + m * 16 + fr) * DFF + ch) = o;
                    if ((m == 3 && fr >= 14) || (m == 0 && fr < 2)) {
                        const int slot = (rowg >> 6) * 4 + (m == 3 ? fr - 14 : 2 + fr);
#pragma unroll
                        for (int bj = 0; bj < 2; ++bj) { const f32x4 cur = acc[ai][bj][m][n]; u32x2 hw; hw.x = cvt_pk_bf16(cur[0], cur[1]); hw.y = cvt_pk_bf16(cur[2], cur[3]);
                            *(u32x2*)(HALO + (size_t)slot * NUP + bj * DFF + ch) = hw; }
                    }
                }
            }
        }
    }
};
}

__device__ __forceinline__ void transpose_item(const float* W, int Nsrc, int K, bf16* WT, int dst_row0, int src_col0, int k0, float* scr, int lane) {
#pragma unroll 8
    for (int i = 0; i < 32; ++i) { const int kk = 2 * i + (lane >> 5); scr[kk * 33 + (lane & 31)] = W[(size_t)(k0 + kk) * Nsrc + src_col0 + (lane & 31)]; }
    asm volatile("s_waitcnt lgkmcnt(0)" ::: "memory");
    const int c = lane & 7;
#pragma unroll
    for (int j = 0; j < 4; ++j) { const int n = (lane >> 3) + 8 * j; const float* s = scr + (8 * c) * 33 + n;
        u32x4 o; o.x = pk2(s[0 * 33], s[1 * 33]); o.y = pk2(s[2 * 33], s[3 * 33]); o.z = pk2(s[4 * 33], s[5 * 33]); o.w = pk2(s[6 * 33], s[7 * 33]);
        *(u32x4*)(WT + (size_t)(dst_row0 + n) * K + k0 + 8 * c) = o; }
    asm volatile("s_waitcnt lgkmcnt(0)" ::: "memory");
}
__device__ __forceinline__ void convert_weights(const Params& P, int l, const Ctx& c) {
    bf16* WT = (bf16*)(c.ws + OFF_WT);
    float* scr = (float*)(c.lds + c.wave * 16384);
    const int gw = c.bid * NWAVES + c.wave, NGW = c.G * NWAVES;
    constexpr int I_IN = 16 * 168, I_BF = 8 * 32, I_O = 16 * 32, I_UP = 16 * 176, I_DN = 44 * 32, I_ALL = I_IN + 2 * I_BF + I_O + I_UP + I_DN;
    for (int it = gw; it < I_ALL; it += NGW) {
        int r = it;
        if (r < I_IN) { const int kb = r / 168, n0 = 32 * (r % 168); transpose_item(P.in[4] + (size_t)l * 1024 * N_IN, N_IN, 1024, WT + WT_IN, n0, n0 + (n0 >= 1536 ? 8 : 0), 64 * kb, scr, c.lane); continue; } r -= I_IN;
        if (r < I_BF) { const int kb = r / 32, n0 = 32 * (r % 32); transpose_item(P.in[19] + (size_t)l * 512 * 1024, 1024, 512, WT + WT_BF, n0, n0, 64 * kb, scr, c.lane); continue; } r -= I_BF;
        if (r < I_BF) { const int kb = r / 32, n0 = 32 * (r % 32); transpose_item(P.in[20] + (size_t)l * 512 * 1024, 1024, 512, WT + WT_BR, n0, n0, 64 * kb, scr, c.lane); continue; } r -= I_BF;
        if (r < I_O) { const int kb = r / 32, n0 = 32 * (r % 32); transpose_item(P.in[22] + (size_t)l * 1024 * 1024, 1024, 1024, WT + WT_O, n0, n0, 64 * kb, scr, c.lane); continue; } r -= I_O;
        if (r < I_UP) { const int kb = r / 176, n0 = 32 * (r % 176); const int pn = n0 >> 8, bj = (n0 >> 7) & 1, x = n0 & 127;
            transpose_item(P.in[23] + (size_t)l * 1024 * NUP, NUP, 1024, WT + WT_UP, n0, bj * DFF + 128 * pn + x, 64 * kb, scr, c.lane); continue; } r -= I_UP;
        { const int kb = r / 32, n0 = 32 * (r % 32); transpose_item(P.in[25] + (size_t)l * DFF * 1024, 1024, DFF, WT + WT_DN, n0, n0, 64 * kb, scr, c.lane); }
    }
}

template <bool FG> __device__ __forceinline__ void phase_norm(const Params& P, int l, const Ctx& c) {
    float* H = (float*)(c.ws + OFF_H); bf16* HN = (bf16*)(c.ws + OFF_HN);
    float* LOGF = (float*)(c.ws + OFF_MISC);
    const float* gain = (FG ? P.in[2] : P.in[3]) + l * DM;
    float* wfs = (float*)c.lds;
    if (FG) {
        __syncthreads();
        const float* win = P.in[4] + (size_t)l * 1024 * N_IN + 1536;
        for (int i = c.tid; i < 8192; i += NTHR) wfs[i] = win[(size_t)(i >> 3) * N_IN + (i & 7)];
        __syncthreads();
    }
    const int gw = c.bid * NWAVES + c.wave, NGW = c.G * NWAVES;
    for (int m = gw; m < M; m += NGW) {
        const int b = m >= LP ? 1 : 0, t = m - b * LP;
        f32x4 v[4];
        if (FG && l == 0) {
            const float* src = (t < NMETA) ? P.in[1] + (size_t)t * DM : P.in[0] + ((size_t)b * SEQ + (t - NMETA)) * DM;
            const bool real = t < NMETA + SEQ;
#pragma unroll
            for (int j = 0; j < 4; ++j) { v[j] = real ? *(const f32x4*)(src + 4 * c.lane + 256 * j) : (f32x4){0.f, 0.f, 0.f, 0.f}; *(f32x4*)(H + (size_t)m * DM + 4 * c.lane + 256 * j) = v[j]; }
        } else {
#pragma unroll
            for (int j = 0; j < 4; ++j) v[j] = *(const f32x4*)(H + (size_t)m * DM + 4 * c.lane + 256 * j);
        }
        float ss = 0.f;
#pragma unroll
        for (int j = 0; j < 4; ++j) ss += (v[j].x * v[j].x + v[j].y * v[j].y) + (v[j].z * v[j].z + v[j].w * v[j].w);
        const float rstd = 1.0f / sqrtf(wave_sum(ss) * (1.f / DM) + 1e-6f);
        float f[8];
#pragma unroll
        for (int q = 0; q < 8; ++q) f[q] = 0.f;
#pragma unroll
        for (int j = 0; j < 4; ++j) {
            const f32x4 g = *(const f32x4*)(gain + 4 * c.lane + 256 * j);
            v[j] = v[j] * rstd * g;
            u32x2 o; o.x = pk2(v[j].x, v[j].y); o.y = pk2(v[j].z, v[j].w);
            *(u32x2*)(HN + (size_t)m * DM + 4 * c.lane + 256 * j) = o;
            if (FG) {
#pragma unroll
                for (int e = 0; e < 4; ++e) { const int k = 4 * c.lane + 256 * j + e; const f32x4 w0 = *(const f32x4*)(wfs + k * 8), w1 = *(const f32x4*)(wfs + k * 8 + 4);
                    const float hv = v[j][e];
                    f[0] += hv * w0.x; f[1] += hv * w0.y; f[2] += hv * w0.z; f[3] += hv * w0.w; f[4] += hv * w1.x; f[5] += hv * w1.y; f[6] += hv * w1.z; f[7] += hv * w1.w; }
            }
        }
        if (FG) {
#pragma unroll
            for (int q = 0; q < 8; ++q) f[q] = wave_sum(f[q]);
            float fv = f[0];
#pragma unroll
            for (int q = 1; q < 8; ++q) fv = (c.lane == q) ? f[q] : fv;
            if (c.lane < 8) { const float x = fv + P.in[7][l * 8 + c.lane]; const float ls = fminf(x, 0.f) - log1pf(expf(-fabsf(x))); LOGF[(size_t)(b * 8 + c.lane) * LP + t] = ls; }
        }
    }
}

__device__ __forceinline__ void phase_fcum(const Params& P, const Ctx& c) {
    if (c.bid < 16 && c.wave == 0) {
        const float* LOGF = (const float*)(c.ws + OFF_MISC) + (size_t)c.bid * LP; float* FC = (float*)(c.ws + OFF_MISC) + 16 * LP + (size_t)c.bid * LP;
        float carry = 0.f;
        for (int ch = 0; ch < LP / 64; ++ch) {
            float v = LOGF[ch * 64 + c.lane];
#pragma unroll
            for (int o = 1; o < 64; o <<= 1) { const float t = __shfl_up(v, o); if (c.lane >= o) v += t; }
            v += carry; FC[ch * 64 + c.lane] = v * LOG2E; carry = __shfl(v, 63);
        }
    }
}

__device__ __forceinline__ void phase_qknorm(const Params& P, int l, const Ctx& c) {
    bf16* Q = (bf16*)(c.ws + OFF_Q); bf16* K = (bf16*)(c.ws + OFF_K);
    const int gw = c.bid * NWAVES + c.wave, NGW = c.G * NWAVES;
    const int d0 = (c.lane & 7) * 8;
    float gq[8], gk[8];
#pragma unroll
    for (int i = 0; i < 8; ++i) { gq[i] = P.in[5][l * 64 + d0 + i] * QSCALE; gk[i] = P.in[6][l * 64 + d0 + i]; }
    for (int m = gw; m < M; m += NGW) {
#pragma unroll
        for (int which = 0; which < 2; ++which) {
            bf16* p = (which ? K : Q) + (size_t)m * 512 + 8 * c.lane;
            const u32x4 w = *(const u32x4*)p;
            float x[8] = {bflo(w.x), bfhi(w.x), bflo(w.y), bfhi(w.y), bflo(w.z), bfhi(w.z), bflo(w.w), bfhi(w.w)};
            float ss = 0.f;
#pragma unroll
            for (int i = 0; i < 8; ++i) ss += x[i] * x[i];
            ss += __shfl_xor(ss, 1); ss += __shfl_xor(ss, 2); ss += __shfl_xor(ss, 4);
            const float rs = 1.0f / sqrtf(ss * (1.f / 64.f) + 1e-6f);
#pragma unroll
            for (int i = 0; i < 8; ++i) x[i] = x[i] * rs * (which ? gk[i] : gq[i]);
            u32x4 o; o.x = pk2(x[0], x[1]); o.y = pk2(x[2], x[3]); o.z = pk2(x[4], x[5]); o.w = pk2(x[6], x[7]);
            *(u32x4*)p = o;
        }
    }
}

struct RwkvBufs { bf16 *R, *K2, *V2, *KK, *AR, *EW, *G; float* Y; bf16* ORW; };
__device__ __forceinline__ RwkvBufs rwkv_bufs(const Params& P, const Ctx& c) {
    RwkvBufs r; r.R = (bf16*)(c.ws + OFF_HN); r.K2 = r.R + (size_t)M * 512;
    r.V2 = (bf16*)P.out; r.KK = r.V2 + (size_t)M * 512; r.G = r.KK + (size_t)M * 512;
    r.AR = (bf16*)(c.ws + OFF_T0); r.EW = r.AR + (size_t)M * 512;
    r.Y = (float*)(c.ws + OFF_RW); r.ORW = (bf16*)(c.ws + OFF_RW + (size_t)M * 512 * 4);
    return r;
}
__device__ __forceinline__ void phase_tokprep(const Params& P, int l, const Ctx& c) {
    const bf16* RW = (const bf16*)(c.ws + OFF_RW);
    const RwkvBufs B = rwkv_bufs(P, c);
    const float* mu = P.in[8] + l * NRW; const float* w0 = P.in[9] + l * 512; const float* wup = P.in[10] + (size_t)l * 64 * 512;
    const float* a0 = P.in[11] + l * 512; const float* aup = P.in[12] + (size_t)l * 64 * 512; const float* gup = P.in[13] + (size_t)l * 128 * 512;
    const float* kkw = P.in[14] + l * 512; const float* kaw = P.in[15] + l * 512;
    float* tz = (float*)c.lds;
    const int j = c.tid;
    const float mur = mu[j], muk = mu[512 + j], muv = mu[1024 + j];
    const float w0j = w0[j], a0j = a0[j], kkj = kkw[j], kaj = kaw[j];
    for (int u = c.bid; u < NB * (LP / 64); u += c.G) {
        const int b = u / (LP / 64), ch = u % (LP / 64);
        const size_t m0 = (size_t)b * LP + ch * 64;
        float pr, pk, pv;
        if (ch == 0) { pr = 0.f; pk = 0.f; pv = 0.f; } else { const bf16* rp = RW + (m0 - 1) * NRW; pr = bf2f(rp[j]); pk = bf2f(rp[512 + j]); pv = bf2f(rp[1024 + j]); }
        for (int sb = 0; sb < 8; ++sb) {
            __syncthreads();
            {
                const int col = c.tid & 255, tq = (c.tid >> 8) * 4;
                const size_t mb = m0 + sb * 8 + tq;
                const float muc = mu[1536 + col];
                float prev = (mb == (size_t)b * LP) ? 0.f : bf2f(RW[(mb - 1) * NRW + 1536 + col]);
#pragma unroll
                for (int i = 0; i < 4; ++i) { const float cur = bf2f(RW[(mb + i) * NRW + 1536 + col]); float z = cur + muc * (prev - cur); prev = cur;
                    if (col < 64) z = tanhf(z); else if (col >= 128) z = sigmoidf_(z);
                    tz[col * 8 + tq + i] = z; }
            }
            __syncthreads();
            float aw[8], aa[8], ag[8];
#pragma unroll
            for (int i = 0; i < 8; ++i) { aw[i] = 0.f; aa[i] = 0.f; ag[i] = 0.f; }
            for (int i = 0; i < 64; ++i) {
                const float wv = wup[i * 512 + j], av = aup[i * 512 + j];
                const f32x4 z0 = *(const f32x4*)(tz + i * 8), z1 = *(const f32x4*)(tz + i * 8 + 4), y0 = *(const f32x4*)(tz + (64 + i) * 8), y1 = *(const f32x4*)(tz + (64 + i) * 8 + 4);
#pragma unroll
                for (int q = 0; q < 4; ++q) { aw[q] += z0[q] * wv; aw[4 + q] += z1[q] * wv; aa[q] += y0[q] * av; aa[4 + q] += y1[q] * av; }
            }
            for (int i = 0; i < 128; ++i) {
                const float gv = gup[i * 512 + j];
                const f32x4 z0 = *(const f32x4*)(tz + (128 + i) * 8), z1 = *(const f32x4*)(tz + (128 + i) * 8 + 4);
#pragma unroll
                for (int q = 0; q < 4; ++q) { ag[q] += z0[q] * gv; ag[4 + q] += z1[q] * gv; }
            }
#pragma unroll
            for (int q = 0; q < 8; ++q) {
                const size_t m = m0 + sb * 8 + q;
                const bf16* rp = RW + m * NRW;
                const float cr = bf2f(rp[j]), ck = bf2f(rp[512 + j]), cv = bf2f(rp[1024 + j]);
                const float zr = cr + mur * (pr - cr), zk = ck + muk * (pk - ck), zv = cv + muv * (pv - cv);
                pr = cr; pk = ck; pv = cv;
                const float xw = -(w0j + aw[q]);
                const float sp = fmaxf(xw, 0.f) + log1pf(expf(-fabsf(xw)));
                const float ew = expf(-sp - 0.5f);
                const float ar = sigmoidf_(a0j + aa[q]);
                const float kkv = zk * kkj;
                const float nn = sqrtf(wave_sum(kkv * kkv));
                const float kkn = kkv / fmaxf(nn, 1e-12f);
                const float k2 = zk * (1.f + (ar - 1.f) * kaj);
                const size_t o = m * 512 + j;
                B.R[o] = (bf16)f2bf(zr); B.K2[o] = (bf16)f2bf(k2); B.V2[o] = (bf16)f2bf(zv); B.KK[o] = (bf16)f2bf(kkn); B.AR[o] = (bf16)f2bf(ar); B.EW[o] = (bf16)f2bf(ew); B.G[o] = (bf16)f2bf(ag[q]);
            }
        }
    }
}

__device__ __forceinline__ void scan_seq(const Params& P, const Ctx& c, int blk) {
    const RwkvBufs B = rwkv_bufs(P, c);
    const int bh = blk >> 1, half = blk & 1, b = bh >> 3, h = bh & 7;
    const int vloc = c.wave * 4 + (c.lane >> 4), kq = c.lane & 15;
    float* sw = (float*)c.lds; float* sa = sw + 2048; float* sb2 = sa + 2048; float* sk = sb2 + 2048; float* sr = sk + 2048; float* sv = sr + 2048; float* sy = sv + 2048;
    const size_t rowb = (size_t)b * LP;
    f32x4 S = (f32x4){0.f, 0.f, 0.f, 0.f};
    for (int t0 = 0; t0 < LP; t0 += 32) {
        __syncthreads();
        for (int e = c.tid; e < 2048; e += NTHR) { const int tok = e >> 6, chn = e & 63; const size_t gi = (rowb + t0 + tok) * 512 + h * 64 + chn;
            const float ew = bf2f(B.EW[gi]), kk = bf2f(B.KK[gi]), ar = bf2f(B.AR[gi]);
            sw[e] = __expf(-ew); sa[e] = -kk; sb2[e] = kk * ar; sk[e] = bf2f(B.K2[gi]); sr[e] = bf2f(B.R[gi]); sv[e] = bf2f(B.V2[gi]); }
        __syncthreads();
#pragma unroll 4
        for (int tok = 0; tok < 32; ++tok) {
            const int o = tok * 64 + 4 * kq;
            const f32x4 w = *(const f32x4*)(sw + o), a = *(const f32x4*)(sa + o), bb = *(const f32x4*)(sb2 + o), kv = *(const f32x4*)(sk + o), r = *(const f32x4*)(sr + o);
            const float vv = sv[tok * 64 + half * 32 + vloc];
            float dot = (S.x * a.x + S.y * a.y) + (S.z * a.z + S.w * a.w);
            dot = allreduce16(dot);
            S = S * w + dot * bb + vv * kv;
            float y = (S.x * r.x + S.y * r.y) + (S.z * r.z + S.w * r.w);
            y = allreduce16(y);
            if (kq == 0) sy[tok * 32 + vloc] = y;
        }
        __syncthreads();
        for (int e = c.tid; e < 1024; e += NTHR) { const int tok = e >> 5, vr = e & 31; B.Y[(rowb + t0 + tok) * 512 + h * 64 + half * 32 + vr] = sy[e]; }
    }
}

__device__ __forceinline__ void phase_gn(const Params& P, int l, const Ctx& c) {
    const RwkvBufs B = rwkv_bufs(P, c);
    const int gw = c.bid * NWAVES + c.wave, NGW = c.G * NWAVES;
    const int c0 = 8 * c.lane;
    float rk[8], gnw[8], gnb[8];
#pragma unroll
    for (int i = 0; i < 8; ++i) { rk[i] = P.in[16][l * 512 + c0 + i]; gnw[i] = P.in[17][l * 512 + c0 + i]; gnb[i] = P.in[18][l * 512 + c0 + i]; }
    for (int m = gw; m < M; m += NGW) {
        const size_t o = (size_t)m * 512 + c0;
        const f32x4 y0 = *(const f32x4*)(B.Y + o), y1 = *(const f32x4*)(B.Y + o + 4);
        float y[8] = {y0.x, y0.y, y0.z, y0.w, y1.x, y1.y, y1.z, y1.w};
        const u32x4 rw = *(const u32x4*)(B.R + o), kw = *(const u32x4*)(B.K2 + o), vw = *(const u32x4*)(B.V2 + o), gw4 = *(const u32x4*)(B.G + o);
        const float r[8] = {bflo(rw.x), bfhi(rw.x), bflo(rw.y), bfhi(rw.y), bflo(rw.z), bfhi(rw.z), bflo(rw.w), bfhi(rw.w)};
        const float k[8] = {bflo(kw.x), bfhi(kw.x), bflo(kw.y), bfhi(kw.y), bflo(kw.z), bfhi(kw.z), bflo(kw.w), bfhi(kw.w)};
        const float v[8] = {bflo(vw.x), bfhi(vw.x), bflo(vw.y), bfhi(vw.y), bflo(vw.z), bfhi(vw.z), bflo(vw.w), bfhi(vw.w)};
        const float g[8] = {bflo(gw4.x), bfhi(gw4.x), bflo(gw4.y), bfhi(gw4.y), bflo(gw4.z), bfhi(gw4.z), bflo(gw4.w), bfhi(gw4.w)};
        float s = 0.f, bs = 0.f;
#pragma unroll
        for (int i = 0; i < 8; ++i) { s += y[i]; bs += r[i] * k[i] * rk[i]; }
        s += __shfl_xor(s, 1); s += __shfl_xor(s, 2); s += __shfl_xor(s, 4);
        bs += __shfl_xor(bs, 1); bs += __shfl_xor(bs, 2); bs += __shfl_xor(bs, 4);
        const float mean = s * (1.f / 64.f);
        float q = 0.f;
#pragma unroll
        for (int i = 0; i < 8; ++i) { y[i] -= mean; q += y[i] * y[i]; }
        q += __shfl_xor(q, 1); q += __shfl_xor(q, 2); q += __shfl_xor(q, 4);
        const float rstd = 1.0f / sqrtf(q * (1.f / 64.f) + 64e-5f);
        float ov[8];
#pragma unroll
        for (int i = 0; i < 8; ++i) ov[i] = (y[i] * rstd * gnw[i] + gnb[i] + bs * v[i]) * g[i];
        u32x4 ow; ow.x = pk2(ov[0], ov[1]); ow.y = pk2(ov[2], ov[3]); ow.z = pk2(ov[4], ov[5]); ow.w = pk2(ov[6], ov[7]);
        *(u32x4*)(B.ORW + o) = ow;
    }
}

__device__ __forceinline__ void attn_unit(const Ctx& c, int bh, int qb, const bf16* Q, const bf16* K, const bf16* V, bf16* O, const float* FC, float qkb2) {
    const int b = bh >> 3, h = bh & 7, lane = c.lane, w = c.wave, lq = lane & 15, g = lane >> 4;
    const int q0 = qb * 128;
    const size_t rowb = (size_t)b * LP;
    const int qrow = q0 + 16 * w + lq;
    bf16* Ks = (bf16*)c.lds; bf16* Vt = Ks + 64 * 72; float* fks = (float*)(Vt + 64 * 72);
    const bf16* qp = Q + (rowb + qrow) * 512 + h * 64 + 8 * g;
    const bf16x8 qf0 = *(const bf16x8*)qp, qf1 = *(const bf16x8*)(qp + 32);
    const float* FCh = FC + (size_t)bh * LP;
    const float fq = FCh[qrow];
    float mrun = -1e30f, lsum = 0.f;
    f32x4 o[4];
#pragma unroll
    for (int i = 0; i < 4; ++i) o[i] = (f32x4){0.f, 0.f, 0.f, 0.f};
    const int kt_max = (q0 + 127) >> 6;
    for (int kt = kt_max; kt >= 0; --kt) {
        const int k0 = kt * 64;
        if (kt < kt_max) { const float fl = FCh[k0 + 63]; const int can = (qkb2 + fq - fl) < (mrun - THR2); if (__syncthreads_and(can)) break; }
        else __syncthreads();
        { const int key = c.tid >> 3, ch = c.tid & 7;
            const size_t goff = (rowb + k0 + key) * 512 + h * 64 + ch * 8;
            const u32x4 kv = *(const u32x4*)(K + goff); const u32x4 vv = *(const u32x4*)(V + goff);
            *(u32x4*)(Ks + key * 72 + ch * 8) = kv;
            bf16* vd = Vt + (ch * 8) * 72 + key;
            vd[0] = (bf16)(vv.x & 0xffff); vd[72] = (bf16)(vv.x >> 16); vd[144] = (bf16)(vv.y & 0xffff); vd[216] = (bf16)(vv.y >> 16);
            vd[288] = (bf16)(vv.z & 0xffff); vd[360] = (bf16)(vv.z >> 16); vd[432] = (bf16)(vv.w & 0xffff); vd[504] = (bf16)(vv.w >> 16);
            if (c.tid < 64) fks[c.tid] = FCh[k0 + c.tid]; }
        __syncthreads();
        if (k0 > q0 + 16 * w + 15) continue;
        f32x4 s[4];
#pragma unroll
        for (int nt = 0; nt < 4; ++nt) { const bf16* kp = Ks + (16 * nt + lq) * 72 + 8 * g; const bf16x8 a0 = *(const bf16x8*)kp, a1 = *(const bf16x8*)(kp + 32);
            s[nt] = __builtin_amdgcn_mfma_f32_16x16x32_bf16(a0, qf0, (f32x4){0.f, 0.f, 0.f, 0.f}, 0, 0, 0);
            s[nt] = __builtin_amdgcn_mfma_f32_16x16x32_bf16(a1, qf1, s[nt], 0, 0, 0); }
        float mx = -INFINITY;
#pragma unroll
        for (int nt = 0; nt < 4; ++nt) { const f32x4 fk = *(const f32x4*)(fks + 16 * nt + 4 * g);
#pragma unroll
            for (int j = 0; j < 4; ++j) { float x = s[nt][j] + fq - fk[j]; const int key = k0 + 16 * nt + 4 * g + j; if (key > qrow) x = -INFINITY; s[nt][j] = x; mx = fmaxf(mx, x); } }
        mx = fmaxf(mx, __shfl_xor(mx, 16)); mx = fmaxf(mx, __shfl_xor(mx, 32));
        const float mnew = fmaxf(mrun, mx), alpha = exp2f(mrun - mnew); mrun = mnew;
        float psum = 0.f;
#pragma unroll
        for (int nt = 0; nt < 4; ++nt)
#pragma unroll
            for (int j = 0; j < 4; ++j) { const float p = exp2f(s[nt][j] - mnew); s[nt][j] = p; psum += p; }
        lsum = lsum * alpha + psum;
#pragma unroll
        for (int dt = 0; dt < 4; ++dt) o[dt] = o[dt] * alpha;
        bf16x8 pb[2];
#pragma unroll
        for (int k2 = 0; k2 < 2; ++k2) { u32x4 pw; pw.x = pk2(s[2 * k2][0], s[2 * k2][1]); pw.y = pk2(s[2 * k2][2], s[2 * k2][3]); pw.z = pk2(s[2 * k2 + 1][0], s[2 * k2 + 1][1]); pw.w = pk2(s[2 * k2 + 1][2], s[2 * k2 + 1][3]);
            pb[k2] = __builtin_bit_cast(bf16x8, pw); }
#pragma unroll
        for (int dt = 0; dt < 4; ++dt)
#pragma unroll
            for (int k2 = 0; k2 < 2; ++k2) { const bf16* vp = Vt + (16 * dt + lq) * 72 + 32 * k2 + 4 * g;
                const u32x2 lo = *(const u32x2*)vp, hi = *(const u32x2*)(vp + 16);
                u32x4 aw; aw.x = lo.x; aw.y = lo.y; aw.z = hi.x; aw.w = hi.y;
                o[dt] = __builtin_amdgcn_mfma_f32_16x16x32_bf16(__builtin_bit_cast(bf16x8, aw), pb[k2], o[dt], 0, 0, 0); }
    }
    lsum += __shfl_xor(lsum, 16); lsum += __shfl_xor(lsum, 32);
    const float inv = 1.0f / lsum;
    bf16* op = O + (rowb + qrow) * 512 + h * 64 + 4 * g;
#pragma unroll
    for (int dt = 0; dt < 4; ++dt) { u32x2 ow; ow.x = pk2(o[dt][0] * inv, o[dt][1] * inv); ow.y = pk2(o[dt][2] * inv, o[dt][3] * inv); *(u32x2*)(op + 16 * dt) = ow; }
    __syncthreads();
}
__device__ __forceinline__ void phase_attn(const Params& P, int l, const Ctx& c, int first_blk) {
    const bf16* Q = (const bf16*)(c.ws + OFF_Q); const bf16* K = (const bf16*)(c.ws + OFF_K); const bf16* V = (const bf16*)(c.ws + OFF_V);
    const float* FC = (const float*)(c.ws + OFF_MISC) + 16 * LP;
    float gqm = fabsf(P.in[5][l * 64 + c.lane]), gkm = fabsf(P.in[6][l * 64 + c.lane]);
#pragma unroll
    for (int o = 1; o < 64; o <<= 1) { gqm = fmaxf(gqm, __shfl_xor(gqm, o)); gkm = fmaxf(gkm, __shfl_xor(gkm, o)); }
    const float qkb2 = 8.0f * gqm * gkm * LOG2E * 1.03f;
    const int nblk = c.G - first_blk, me = c.bid - first_blk;
    constexpr int NQB = LP / 128, NU = 16 * NQB;
    for (int u = me; u < NU; u += nblk) { const int bh = u & 15, qb = NQB - 1 - (u >> 4); attn_unit(c, bh, qb, Q, K, V, (bf16*)(c.ws + OFF_Q), FC, qkb2); }
}

__device__ __forceinline__ void phase_fixup(const Params& P, int l, const Ctx& c) {
    bf16* ACT = (bf16*)(c.ws + OFF_RW); const bf16* HALO = (const bf16*)(c.ws + OFF_Q);
    const float* cw = P.in[24] + (size_t)l * 3 * NUP;
    const int total = (M / 64) * 2 * DFF;
    for (int idx = c.bid * NTHR + c.tid; idx < total; idx += c.G * NTHR) {
        const int rr = idx / DFF, ch = idx - rr * DFF, q64 = rr >> 1, e = rr & 1, row = q64 * 64 + e;
        const int t = row % LP;
        int s0, s1, s2;
        if (e == 0) { s0 = q64 * 4 + 2; s1 = (q64 - 1) * 4 + 1; s2 = (q64 - 1) * 4 + 0; } else { s0 = q64 * 4 + 3; s1 = q64 * 4 + 2; s2 = (q64 - 1) * 4 + 1; }
        float uc[2];
#pragma unroll
        for (int bj = 0; bj < 2; ++bj) { const int col = bj * DFF + ch;
            const float u0 = bf2f(HALO[(size_t)s0 * NUP + col]);
            const float u1 = (t >= 1) ? bf2f(HALO[(size_t)s1 * NUP + col]) : 0.f;
            const float u2 = (t >= 2) ? bf2f(HALO[(size_t)s2 * NUP + col]) : 0.f;
            uc[bj] = cw[col] * u2 + cw[NUP + col] * u1 + cw[2 * NUP + col] * u0; }
        ACT[(size_t)row * DFF + ch] = (bf16)f2bf(uc[0] * sigmoidf_(uc[0]) * uc[1]);
    }
}

#define OPQ_S(x) asm volatile("" : "+s"(x))
#define OPQ_V(x) asm volatile("" : "+v"(x))
#define PHASE_BEGIN() do { int t_ = threadIdx.x; OPQ_V(t_); c.tid = t_; c.lane = t_ & 63; c.wave = __builtin_amdgcn_readfirstlane(t_ >> 6); int b_ = blockIdx.x; OPQ_S(b_); c.bid = b_; \
    unsigned char* w_ = P.ws; OPQ_S(w_); c.ws = w_; ws = w_; l = lc; OPQ_S(l); WT = (pg8::bf16_t*)(ws + OFF_WT); HN = (pg8::bf16_t*)(ws + OFF_HN); } while (0)
__global__ void __launch_bounds__(NTHR, 2) mega(Params P) {
    extern __shared__ __attribute__((aligned(16))) unsigned char lds[];
    cg::grid_group grid = cg::this_grid();
    Ctx c; c.G = gridDim.x; c.lds = lds;
    PG8_LAS unsigned char* ldsl = (PG8_LAS unsigned char*)lds;
    unsigned char* ws; pg8::bf16_t* WT; pg8::bf16_t* HN; int l;
#pragma unroll 1
    for (int lc = 0; lc < DEPTH; ++lc) {
        PHASE_BEGIN();
        convert_weights(P, l, c);
        phase_norm<true>(P, l, c);
        grid.sync();
        PHASE_BEGIN();
        phase_fcum(P, c);
        { pg8::Gemm g{HN, WT + WT_IN, M, N1, 1024}; pg8::StaticOrder S; S.init(M, N1, c.G, c.bid);
          pg8::EpiRoute E{ws};
          pg8::gemm_phase<pg8::EpiRoute, pg8::StaticOrder, true, true>(ldsl, g, S, E); }
        grid.sync();
        PHASE_BEGIN();
        phase_qknorm(P, l, c);
        phase_tokprep(P, l, c);
        grid.sync();
        PHASE_BEGIN();
        if (c.bid < 32) scan_seq(P, c, c.bid); else phase_attn(P, l, c, 32);
        grid.sync();
        PHASE_BEGIN();
        phase_gn(P, l, c);
        grid.sync();
        PHASE_BEGIN();
        { pg8::bf16_t* MG = (pg8::bf16_t*)(ws + OFF_K); const pg8::bf16_t* GT = (const pg8::bf16_t*)(ws + OFF_GT); const float* gb = P.in[21] + l * NGT;
          pg8::StaticOrder S; S.init(M, 1024, c.G, c.bid);
          { pg8::Gemm g{(const pg8::bf16_t*)(ws + OFF_Q), WT + WT_BF, M, 1024, 512}; pg8::EpiGate<0> E{MG, GT, gb};
            pg8::gemm_phase<pg8::EpiGate<0>, pg8::StaticOrder, true, true>(ldsl, g, S, E); }
          __syncthreads();
          PHASE_BEGIN();
          MG = (pg8::bf16_t*)(ws + OFF_K); GT = (const pg8::bf16_t*)(ws + OFF_GT); gb = P.in[21] + l * NGT; S.init(M, 1024, c.G, c.bid);
          { pg8::Gemm g{(const pg8::bf16_t*)(ws + OFF_RW + (size_t)M * 512 * 4), WT + WT_BR, M, 1024, 512}; pg8::EpiGate<1> E{MG, GT, gb};
            pg8::gemm_phase<pg8::EpiGate<1>, pg8::StaticOrder, true, true>(ldsl, g, S, E); } }
        grid.sync();
        PHASE_BEGIN();
        { pg8::Gemm g{(const pg8::bf16_t*)(ws + OFF_K), WT + WT_O, M, 1024, 1024}; pg8::StaticOrder S; S.init(M, 1024, c.G, c.bid);
          pg8::EpiResid E{(float*)(ws + OFF_H), nullptr};
          pg8::gemm_phase<pg8::EpiResid, pg8::StaticOrder, true, true>(ldsl, g, S, E); }
        grid.sync();
        PHASE_BEGIN();
        phase_norm<false>(P, l, c);
        grid.sync();
        PHASE_BEGIN();
        { pg8::Gemm g{HN, WT + WT_UP, M, NUP, 1024}; pg8::StaticOrder S; S.init(M, NUP, c.G, c.bid);
          pg8::EpiUp E{(pg8::bf16_t*)(ws + OFF_RW), (pg8::bf16_t*)(ws + OFF_Q), P.in[24] + (size_t)l * 3 * NUP};
          pg8::gemm_phase<pg8::EpiUp, pg8::StaticOrder, true, true>(ldsl, g, S, E); }
        grid.sync();
        PHASE_BEGIN();
        phase_fixup(P, l, c);
        grid.sync();
        PHASE_BEGIN();
        { pg8::Gemm g{(const pg8::bf16_t*)(ws + OFF_RW), WT + WT_DN, M, 1024, DFF}; pg8::StaticOrder S; S.init(M, 1024, c.G, c.bid);
          pg8::EpiResid E{(float*)(ws + OFF_H), l == DEPTH - 1 ? P.out : nullptr};
          pg8::gemm_phase<pg8::EpiResid, pg8::StaticOrder, true, true>(ldsl, g, S, E); }
        grid.sync();
    }
}

extern "C" void kernel_launch(void* const* d_in, const int* in_sizes, int n_in, void* d_out, int out_size, void* d_ws, size_t ws_size, hipStream_t stream) {
    static int grid = 0;
    if (grid == 0) {
        if (n_in != 26 || out_size != NB * SEQ * DM || ws_size < WS_NEED) { fprintf(stderr, "kernel_launch: unexpected shapes (n_in %d out %d ws %zu need %zu)\n", n_in, out_size, ws_size, (size_t)WS_NEED); grid = -1; return; }
        int dev = 0, cus = 0, per_cu = 0;
        if (hipGetDevice(&dev) != hipSuccess || hipDeviceGetAttribute(&cus, hipDeviceAttributeMultiprocessorCount, dev) != hipSuccess) { grid = -1; return; }
        if (hipFuncSetAttribute((const void*)mega, hipFuncAttributeMaxDynamicSharedMemorySize, LDS_BYTES) != hipSuccess) { fprintf(stderr, "kernel_launch: hipFuncSetAttribute failed\n"); grid = -1; return; }
        if (hipOccupancyMaxActiveBlocksPerMultiprocessor(&per_cu, (const void*)mega, NTHR, LDS_BYTES) != hipSuccess || per_cu < 1) { fprintf(stderr, "kernel_launch: occupancy query says %d\n", per_cu); per_cu = 1; }
        (void)hipGetLastError();
        grid = cus;
    }
    if (grid < 0) return;
    Params p{};
    for (int i = 0; i < 26; ++i) p.in[i] = (const float*)d_in[i];
    p.out = (float*)d_out; p.ws = (unsigned char*)d_ws;
    void* args[] = {&p};
    hipError_t e = hipLaunchCooperativeKernel((const void*)mega, dim3(grid), dim3(NTHR), args, LDS_BYTES, stream);
    if (e != hipSuccess) fprintf(stderr, "kernel_launch: cooperative launch failed: %s (grid %d)\n", hipGetErrorString(e), grid);
}
```

```cpp
#include <hip/hip_runtime.h>
#include <hip/hip_cooperative_groups.h>
#include <cstdio>
#include <cstdint>
#include <cmath>
namespace cg = cooperative_groups;
namespace pg8 {
#define PG8_LAS __attribute__((address_space(3)))
typedef unsigned short bf16_t;
typedef short bf16x8 __attribute__((ext_vector_type(8)));
typedef float f32x4 __attribute__((ext_vector_type(4)));
typedef unsigned u32x4 __attribute__((ext_vector_type(4)));
constexpr int BM = 256, BK = 64, HALF = 128, HTB = HALF * BK * 2  , STAGE_BYTES = 8 * HTB, NXCD = 8, WGM = 8;

__host__ __device__ __forceinline__ int lds_byte(int r, int c) { const int st = (r >> 4) * 2 + (c >> 5), rr = r & 15, cc = c & 31, ob = rr * 64 + cc * 2; return st * 1024 + (ob ^ (((ob >> 9) & 1) << 5)); }
__host__ __device__ __forceinline__ void stage_rc(int b, int& R, int& C) { const int st = b / 1024, sb = b % 1024, swz = sb ^ (((sb >> 9) & 1) << 5); R = (st >> 1) * 16 + swz / 64; C = (st & 1) * 32 + (swz % 64) / 2; }
__host__ __device__ __forceinline__ int perm32(int rho) { const int n = rho >> 4, i = rho & 15; return 8 * (i >> 2) + 4 * n + (i & 3); }

struct Unit { int pm, pn; };
struct Gemm { const bf16_t* A; const bf16_t* Bt; int M, N, K; };

struct StaticOrder {
    int nM, nN, nwg, G, c;
    __host__ __device__ void init(int M, int N, int G_, int c_) { nM = M / BM; nN = N / BM; nwg = nM * nN; G = G_; c = c_; }
    __host__ __device__ bool next(int i, Unit& u) const {
        const long L = (long)i * G + c; if (L >= nwg) return false;
        int wgid = (int)L; { const int q = nwg / NXCD, r = nwg % NXCD, xcd = wgid % NXCD, off = wgid / NXCD; wgid = (xcd < r ? xcd * (q + 1) : r * (q + 1) + (xcd - r) * q) + off; }
        const int nig = WGM * nN, gid = wgid / nig, fm = gid * WGM, gsz = (nM - fm) < WGM ? (nM - fm) : WGM;
        u.pm = fm + ((wgid % nig) % gsz); u.pn = (wgid % nig) / gsz; return true;
    }
    __device__ __forceinline__ void a_ready(const Unit&) const {}
    __device__ __forceinline__ void done(const Unit&) const {}
};

__device__ __forceinline__ unsigned cvt_pk_bf16(float lo, float hi) { unsigned r; asm volatile("v_cvt_pk_bf16_f32 %0, %1, %2" : "=v"(r) : "v"(lo), "v"(hi)); return r; }
typedef float f32x2 __attribute__((ext_vector_type(2)));
template <class Epi, class Sched, bool ALIGN_EPI = false, bool SP2 = false>
__device__ __forceinline__ void gemm_phase(PG8_LAS unsigned char* lds, const Gemm g, const Sched& S, const Epi& E) {
    int tid_ = threadIdx.x; asm volatile("" : "+v"(tid_)); const int tid = tid_, wid = __builtin_amdgcn_readfirstlane(tid >> 6), lane = tid & 63, wr = wid >> 2, wc = wid & 3, fr = lane & 15, fq = lane >> 4;
    const int K = g.K, nt = K / BK;
    unsigned voffA[2], voffB[2];
#pragma unroll
    for (int i = 0; i < 2; ++i) { int R, C; stage_rc(tid * 16 + i * 8192, R, C); const int Rb = Epi::PERM ? ((R & ~31) + perm32(R & 31)) : R;
        voffA[i] = (unsigned)(R * K + C) * 2u; voffB[i] = (unsigned)(Rb * K + C) * 2u; }
    const size_t kstep = (size_t)(BK * 2);
    const size_t hstep = (size_t)HALF * K * 2;
    const size_t tstep = 2 * hstep;
    const unsigned ldsw = (unsigned)wid * 1024u;
    const int aoff = lds_byte(wr * 64 + fr, fq * 8), boff = lds_byte(wc * 32 + fr, fq * 8);
#define PG8_SA(b, h) (((b) * 2 + (h)) * HTB)
#define PG8_SB(b, h) ((4 + (b) * 2 + (h)) * HTB)
#define PG8_STAGE(bufoff, gbase, voff) do { _Pragma("unroll") for (int _i = 0; _i < 2; ++_i) \
        __builtin_amdgcn_global_load_lds((const unsigned*)((const char*)(gbase) + (voff)[_i]), (PG8_LAS unsigned*)(lds + (bufoff) + ldsw + _i * 8192), 16, 0, 0); } while (0)
#define PG8_LDA(dst, b, h) do { _Pragma("unroll") for (int m = 0; m < 4; ++m) _Pragma("unroll") for (int k = 0; k < 2; ++k) dst[m][k] = *(const PG8_LAS bf16x8*)(lds + PG8_SA(b, h) + aoff + m * 2048 + k * 1024); } while (0)
#define PG8_LDB(dst, b, h) do { _Pragma("unroll") for (int n = 0; n < 2; ++n) _Pragma("unroll") for (int k = 0; k < 2; ++k) dst[n][k] = *(const PG8_LAS bf16x8*)(lds + PG8_SB(b, h) + boff + n * 2048 + k * 1024); } while (0)
#define PG8_MMA(ai, bj, At, Bt) do { __builtin_amdgcn_s_setprio(1); _Pragma("unroll") for (int m = 0; m < 4; ++m) _Pragma("unroll") for (int n = 0; n < 2; ++n) _Pragma("unroll") for (int k = 0; k < 2; ++k) \
        acc[ai][bj][m][n] = __builtin_amdgcn_mfma_f32_16x16x32_bf16(Bt[n][k], At[m][k], acc[ai][bj][m][n], 0, 0, 0); __builtin_amdgcn_s_setprio(0); } while (0)
#define PG8_WAIT_V(n) asm volatile("s_waitcnt vmcnt(" #n ")" ::: "memory")
#define PG8_WAIT_L(n) asm volatile("s_waitcnt lgkmcnt(" #n ")" ::: "memory")
#define PG8_BAR __builtin_amdgcn_s_barrier()
#define PG8_SCHED __builtin_amdgcn_sched_barrier(0)
    Unit cur, nxt; int ui = 0;
    if (!S.next(0, cur)) return;
    f32x4 acc[2][2][4][2];
#pragma unroll
    for (int a = 0; a < 2; ++a)
#pragma unroll
        for (int b = 0; b < 2; ++b)
#pragma unroll
            for (int m = 0; m < 4; ++m)
#pragma unroll
                for (int n = 0; n < 2; ++n) acc[a][b][m][n] = (f32x4){0.f, 0.f, 0.f, 0.f};
    bf16x8 At[4][2], B0[2][2], B1[2][2];
    const char* cA = (const char*)g.A + (size_t)cur.pm * tstep; const char* cB = (const char*)g.Bt + (size_t)cur.pn * tstep;
    S.a_ready(cur);
    if constexpr (SP2) {
        PG8_STAGE(PG8_SB(0, 0), cB, voffB); PG8_STAGE(PG8_SB(0, 1), cB + hstep, voffB); PG8_STAGE(PG8_SA(0, 0), cA, voffA); PG8_STAGE(PG8_SA(0, 1), cA + hstep, voffA);
        if (wr == 1) PG8_BAR;
        PG8_WAIT_V(2); PG8_BAR;
        PG8_STAGE(PG8_SB(1, 0), cB + kstep, voffB); PG8_STAGE(PG8_SA(1, 0), cA + kstep, voffA); PG8_STAGE(PG8_SB(1, 1), cB + hstep + kstep, voffB);
        PG8_WAIT_V(6); PG8_BAR;
    } else {
        PG8_STAGE(PG8_SB(0, 0), cB, voffB); PG8_STAGE(PG8_SA(0, 0), cA, voffA); PG8_STAGE(PG8_SB(0, 1), cB + hstep, voffB); PG8_STAGE(PG8_SA(0, 1), cA + hstep, voffA);
        if (wr == 1) PG8_BAR;
        PG8_WAIT_V(4); PG8_BAR;
        PG8_STAGE(PG8_SB(1, 0), cB + kstep, voffB); PG8_STAGE(PG8_SA(1, 0), cA + kstep, voffA); PG8_STAGE(PG8_SB(1, 1), cB + hstep + kstep, voffB);
        PG8_WAIT_V(6); PG8_BAR;
    }
    for (;;) {
        const bool has_next = S.next(ui + 1, nxt);
        const char* nA = has_next ? (const char*)g.A + (size_t)nxt.pm * tstep : cA; const char* nB = has_next ? (const char*)g.Bt + (size_t)nxt.pn * tstep : cB;
        for (int t = 0; t < nt; t += 2) {
            const bool last = (t == nt - 2);
            const char* a1 = cA + (size_t)(t + 1) * kstep;
            const char* a2 = last ? nA : cA + (size_t)(t + 2) * kstep; const char* b2 = last ? nB : cB + (size_t)(t + 2) * kstep;
            const char* a3 = a2 + kstep; const char* b3 = b2 + kstep;
            if (last && has_next) S.a_ready(nxt);
            if constexpr (SP2) {
            PG8_LDB(B0, 0, 0); PG8_LDB(B1, 0, 1); PG8_SCHED; PG8_LDA(At, 0, 0); PG8_STAGE(PG8_SA(1, 1), a1 + hstep, voffA);
            PG8_WAIT_V(8); PG8_WAIT_L(0); PG8_BAR; PG8_MMA(0, 0, At, B0); PG8_MMA(0, 1, At, B1); PG8_BAR; PG8_SCHED;
            PG8_LDA(At, 0, 1); PG8_STAGE(PG8_SB(0, 0), b2, voffB); PG8_STAGE(PG8_SB(0, 1), b2 + hstep, voffB); PG8_STAGE(PG8_SA(0, 0), a2, voffA);
            PG8_WAIT_V(8); PG8_WAIT_L(0); PG8_BAR; PG8_MMA(1, 0, At, B0); PG8_MMA(1, 1, At, B1); PG8_BAR; PG8_SCHED;
            PG8_LDB(B0, 1, 0); PG8_LDB(B1, 1, 1); PG8_SCHED; PG8_LDA(At, 1, 0); PG8_STAGE(PG8_SA(0, 1), a2 + hstep, voffA);
            PG8_WAIT_V(8); PG8_WAIT_L(0); PG8_BAR; PG8_MMA(0, 0, At, B0); PG8_MMA(0, 1, At, B1); PG8_BAR; PG8_SCHED;
            PG8_LDA(At, 1, 1); PG8_STAGE(PG8_SB(1, 0), b3, voffB); PG8_STAGE(PG8_SB(1, 1), b3 + hstep, voffB); PG8_STAGE(PG8_SA(1, 0), a3, voffA);
            PG8_WAIT_V(8); PG8_WAIT_L(0); PG8_BAR; PG8_MMA(1, 0, At, B0); PG8_MMA(1, 1, At, B1); PG8_BAR; PG8_SCHED;
            } else {
            PG8_LDB(B0, 0, 0); PG8_SCHED; PG8_LDA(At, 0, 0); PG8_STAGE(PG8_SA(1, 1), a1 + hstep, voffA);
            PG8_WAIT_L(8); PG8_BAR; PG8_WAIT_L(0); PG8_MMA(0, 0, At, B0); PG8_BAR; PG8_SCHED;
            PG8_LDB(B1, 0, 1); PG8_STAGE(PG8_SB(0, 0), b2, voffB);
            PG8_BAR; PG8_WAIT_L(0); PG8_MMA(0, 1, At, B1); PG8_BAR;
            PG8_LDA(At, 0, 1); PG8_STAGE(PG8_SA(0, 0), a2, voffA);
            PG8_BAR; PG8_WAIT_L(0); PG8_MMA(1, 0, At, B0); PG8_BAR; PG8_SCHED;
            PG8_STAGE(PG8_SB(0, 1), b2 + hstep, voffB);
            PG8_WAIT_V(6); PG8_BAR; PG8_MMA(1, 1, At, B1); PG8_BAR;
            PG8_LDB(B0, 1, 0); PG8_SCHED; PG8_LDA(At, 1, 0); PG8_STAGE(PG8_SA(0, 1), a2 + hstep, voffA);
            PG8_WAIT_L(8); PG8_BAR; PG8_WAIT_L(0); PG8_MMA(0, 0, At, B0); PG8_BAR; PG8_SCHED;
            PG8_LDB(B1, 1, 1); PG8_STAGE(PG8_SB(1, 0), b3, voffB);
            PG8_BAR; PG8_WAIT_L(0); PG8_MMA(0, 1, At, B1); PG8_BAR;
            PG8_LDA(At, 1, 1); PG8_STAGE(PG8_SA(1, 0), a3, voffA);
            PG8_BAR; PG8_WAIT_L(0); PG8_MMA(1, 0, At, B0); PG8_BAR; PG8_SCHED;
            PG8_STAGE(PG8_SB(1, 1), b3 + hstep, voffB);
            PG8_WAIT_V(6); PG8_BAR; PG8_MMA(1, 1, At, B1); PG8_BAR;
            }
        }
        if constexpr (ALIGN_EPI) { if (wr == 0) PG8_BAR; }
        if constexpr (!Epi::AFTER_DRAIN) { E(acc, cur, wr, wc, fr, fq); S.done(cur); }
        if (!has_next) break;
#pragma unroll
        for (int a = 0; a < 2; ++a)
#pragma unroll
            for (int b = 0; b < 2; ++b)
#pragma unroll
                for (int m = 0; m < 4; ++m)
#pragma unroll
                    for (int n = 0; n < 2; ++n) acc[a][b][m][n] = (f32x4){0.f, 0.f, 0.f, 0.f};
        cur = nxt; cA = nA; cB = nB; ++ui;
        if constexpr (ALIGN_EPI) { if (wr == 1) PG8_BAR; }
    }
    PG8_WAIT_V(0);
    if constexpr (!ALIGN_EPI) { if (wr == 0) PG8_BAR; }
    PG8_BAR;
    if constexpr (Epi::AFTER_DRAIN) { E.fused(acc, cur, wr, wc, fr, fq, lds, wid, lane); S.done(cur); }
#undef PG8_SA
#undef PG8_SB
#undef PG8_STAGE
#undef PG8_LDA
#undef PG8_LDB
#undef PG8_MMA
#undef PG8_WAIT_V
#undef PG8_WAIT_L
#undef PG8_BAR
#undef PG8_SCHED
}
}

constexpr int NB = 2, SEQ = 8192, DM = 1024, DEPTH = 4, NMETA = 16, LP = 8320, M = NB * LP;
constexpr int N_IN = 5384, N1 = 5376, NRW = 1792, NGT = 2048, DFF = 2816, NUP = 5632;
constexpr float LOG2E = 1.4426950408889634f;
constexpr float QSCALE = 0.125f * LOG2E;
constexpr float THR2 = 30.0f * LOG2E;
constexpr int NWAVES = 8, NTHR = 512;
constexpr int LDS_BYTES = 147456;

typedef unsigned short bf16;
typedef float f32x4 __attribute__((ext_vector_type(4)));
typedef unsigned u32x4 __attribute__((ext_vector_type(4)));
typedef unsigned u32x2 __attribute__((ext_vector_type(2)));
typedef short bf16x8 __attribute__((ext_vector_type(8)));

constexpr size_t SZ_H = (size_t)M * DM * 4, SZ_X512 = (size_t)M * 512 * 2;
constexpr size_t OFF_CTL = 0, OFF_H = 1u << 20, OFF_WT = OFF_H + SZ_H;
constexpr size_t WT_IN = 0, WT_BF = WT_IN + (size_t)N1 * 1024, WT_BR = WT_BF + 1024 * 512, WT_O = WT_BR + 1024 * 512,
                 WT_UP = WT_O + 1024 * 1024, WT_DN = WT_UP + (size_t)NUP * 1024, WT_LW = WT_DN + (size_t)1024 * DFF, WT_LA = WT_LW + 512 * 64, WT_LG = WT_LA + 512 * 64, WT_END = WT_LG + 512 * 128;
constexpr size_t OFF_HN = OFF_WT + WT_END * 2;
constexpr size_t OFF_Q = OFF_HN + 2 * SZ_X512, OFF_K = OFF_Q + SZ_X512, OFF_V = OFF_K + SZ_X512;
constexpr size_t OFF_RW = OFF_V + SZ_X512, OFF_GT = OFF_RW + (size_t)M * NRW * 2, OFF_MISC = OFF_GT + (size_t)M * NGT * 2;
constexpr size_t OFF_T0 = OFF_MISC + 2 * 16 * LP * 4, WS_NEED = OFF_T0 + 2 * SZ_X512;
static_assert(OFF_HN % 256 == 0 && OFF_RW % 256 == 0 && OFF_T0 % 256 == 0, "alignment");

struct Params { const float* in[26]; float* out; unsigned char* ws; };
struct Ctx { int tid, lane, wave, bid, G; unsigned char* lds; unsigned char* ws; };

__device__ __forceinline__ float bf2f(unsigned b) { return __uint_as_float(b << 16); }
__device__ __forceinline__ float bflo(unsigned w) { return __uint_as_float(w << 16); }
__device__ __forceinline__ float bfhi(unsigned w) { return __uint_as_float(w & 0xffff0000u); }
__device__ __forceinline__ unsigned f2bf(float f) { unsigned u = __float_as_uint(f); return (u + 0x7fffu + ((u >> 16) & 1u)) >> 16; }
__device__ __forceinline__ unsigned pk2(float lo, float hi) { return f2bf(lo) | (f2bf(hi) << 16); }
__device__ __forceinline__ float wave_sum(float v) {
#pragma unroll
    for (int o = 1; o < 64; o <<= 1) v += __shfl_xor(v, o);
    return v;
}
__device__ __forceinline__ float sigmoidf_(float x) { return 1.f / (1.f + __expf(-x)); }
template <int CTRL> __device__ __forceinline__ float dppf(float old, float x) {
    return __int_as_float(__builtin_amdgcn_update_dpp(__float_as_int(old), __float_as_int(x), CTRL, 0xf, 0xf, false));
}
__device__ __forceinline__ float allreduce16(float x) {
    x += dppf<0x121>(0.f, x); x += dppf<0x122>(0.f, x); x += dppf<0x124>(0.f, x); x += dppf<0x128>(0.f, x); return x;
}

namespace pg8 {
struct EpiRoute {
    static constexpr bool PERM = true, AFTER_DRAIN = false;
    unsigned char* ws;
    __device__ __forceinline__ void operator()(const f32x4 (&acc)[2][2][4][2], const Unit& u, int wr, int wc, int fr, int fq) const {
        const int pn = u.pn; size_t off; int ldc, colt;
        if (pn < 6) { off = OFF_Q + (size_t)(pn >> 1) * SZ_X512; ldc = 512; colt = (pn & 1) * 256; }
        else if (pn < 13) { off = OFF_RW; ldc = NRW; colt = (pn - 6) * 256; }
        else { off = OFF_GT; ldc = NGT; colt = (pn - 13) * 256; }
        bf16_t* base = (bf16_t*)(ws + off);
        const int row0 = u.pm * BM + wr * 64 + fr, col0 = colt + wc * 32 + 8 * fq;
#pragma unroll
        for (int ai = 0; ai < 2; ++ai)
#pragma unroll
            for (int m = 0; m < 4; ++m) { bf16_t* rowp = base + (size_t)(row0 + ai * HALF + m * 16) * ldc + col0;
#pragma unroll
                for (int bj = 0; bj < 2; ++bj) { const f32x4 v0 = acc[ai][bj][m][0], v1 = acc[ai][bj][m][1];
                    u32x4 w; w.x = cvt_pk_bf16(v0[0], v0[1]); w.y = cvt_pk_bf16(v0[2], v0[3]); w.z = cvt_pk_bf16(v1[0], v1[1]); w.w = cvt_pk_bf16(v1[2], v1[3]);
                    *(u32x4*)(rowp + bj * HALF) = w; } }
    }
};
template <int MODE> struct EpiGate {
    static constexpr bool PERM = true, AFTER_DRAIN = false;
    bf16_t* O; const bf16_t* GT; const float* gb;
    __device__ __forceinline__ void operator()(const f32x4 (&acc)[2][2][4][2], const Unit& u, int wr, int wc, int fr, int fq) const {
        const int row0 = u.pm * BM + wr * 64 + fr, col0 = u.pn * BM + wc * 32 + 8 * fq;
#pragma unroll
        for (int bj = 0; bj < 2; ++bj) {
            const int c = col0 + bj * HALF;
            const f32x4 b0 = *(const f32x4*)(gb + MODE * 1024 + c), b1 = *(const f32x4*)(gb + MODE * 1024 + c + 4);
#pragma unroll
            for (int ai = 0; ai < 2; ++ai)
#pragma unroll
                for (int m = 0; m < 4; ++m) {
                    const size_t row = (size_t)(row0 + ai * HALF + m * 16);
                    const u32x4 gw = *(const u32x4*)(GT + row * NGT + MODE * 1024 + c);
                    const f32x4 v0 = acc[ai][bj][m][0], v1 = acc[ai][bj][m][1];
                    float r[8];
                    r[0] = sigmoidf_(bflo(gw.x) + b0[0]) * v0[0]; r[1] = sigmoidf_(bfhi(gw.x) + b0[1]) * v0[1];
                    r[2] = sigmoidf_(bflo(gw.y) + b0[2]) * v0[2]; r[3] = sigmoidf_(bfhi(gw.y) + b0[3]) * v0[3];
                    r[4] = sigmoidf_(bflo(gw.z) + b1[0]) * v1[0]; r[5] = sigmoidf_(bfhi(gw.z) + b1[1]) * v1[1];
                    r[6] = sigmoidf_(bflo(gw.w) + b1[2]) * v1[2]; r[7] = sigmoidf_(bfhi(gw.w) + b1[3]) * v1[3];
                    bf16_t* op = O + row * 1024 + c;
                    if (MODE == 1) { const u32x4 ow = *(const u32x4*)op;
                        r[0] += bflo(ow.x); r[1] += bfhi(ow.x); r[2] += bflo(ow.y); r[3] += bfhi(ow.y); r[4] += bflo(ow.z); r[5] += bfhi(ow.z); r[6] += bflo(ow.w); r[7] += bfhi(ow.w); }
                    u32x4 w; w.x = cvt_pk_bf16(r[0], r[1]); w.y = cvt_pk_bf16(r[2], r[3]); w.z = cvt_pk_bf16(r[4], r[5]); w.w = cvt_pk_bf16(r[6], r[7]);
                    *(u32x4*)op = w;
                }
        }
    }
};
struct EpiResid {
    static constexpr bool PERM = false, AFTER_DRAIN = false;
    float* H; float* OUT;
    __device__ __forceinline__ void operator()(const f32x4 (&acc)[2][2][4][2], const Unit& u, int wr, int wc, int fr, int fq) const {
        const int row0 = u.pm * BM + wr * 64 + fr, col0 = u.pn * BM + wc * 32 + 4 * fq;
#pragma unroll
        for (int ai = 0; ai < 2; ++ai)
#pragma unroll
            for (int m = 0; m < 4; ++m) {
                const int row = row0 + ai * HALF + m * 16;
                float* hp = H + (size_t)row * DM + col0;
                const int b = row >= LP ? 1 : 0, t = row - b * LP;
                float* op = (OUT && t >= NMETA && t < NMETA + SEQ) ? OUT + ((size_t)b * SEQ + (t - NMETA)) * DM + col0 : nullptr;
#pragma unroll
                for (int bj = 0; bj < 2; ++bj)
#pragma unroll
                    for (int n = 0; n < 2; ++n) { const int co = bj * HALF + n * 16;
                        const f32x4 v = *(const f32x4*)(hp + co) + acc[ai][bj][m][n];
                        if (OUT) { if (op) *(f32x4*)(op + co) = v; } else *(f32x4*)(hp + co) = v; }
            }
    }
};
struct EpiUp {
    static constexpr bool PERM = true, AFTER_DRAIN = false;
    bf16_t* ACT; bf16_t* HALO; const float* cw;
    __device__ __forceinline__ void operator()(const f32x4 (&acc)[2][2][4][2], const Unit& u, int wr, int wc, int fr, int fq) const {
        const int chan0 = u.pn * 128 + wc * 32 + 8 * fq;
#pragma unroll
        for (int n = 0; n < 2; ++n) {
            const int ch = chan0 + 4 * n;
            f32x4 w[3][2];
#pragma unroll
            for (int j = 0; j < 3; ++j) { w[j][0] = *(const f32x4*)(cw + j * NUP + ch); w[j][1] = *(const f32x4*)(cw + j * NUP + DFF + ch); }
#pragma unroll
            for (int ai = 0; ai < 2; ++ai) {
                const int rowg = u.pm * BM + ai * HALF + wr * 64;
#pragma unroll
                for (int m = 0; m < 4; ++m) {
                    f32x4 uc[2];
#pragma unroll
                    for (int bj = 0; bj < 2; ++bj) {
                        const f32x4 cur = acc[ai][bj][m][n];
                        f32x4 prv; if (m > 0) prv = acc[ai][bj][m - 1][n]; else prv = (f32x4){0.f, 0.f, 0.f, 0.f};
                        f32x4 p1, p2;
#pragma unroll
                        for (int i = 0; i < 4; ++i) {
                            const float r1 = dppf<0x121>(0.f, prv[i]), r2 = dppf<0x122>(0.f, prv[i]);
                            p1[i] = dppf<0x111>(r1, cur[i]); p2[i] = dppf<0x112>(r2, cur[i]);
                        }
                        uc[bj] = w[0][bj] * p2 + w[1][bj] * p1 + w[2][bj] * cur;
                    }
                    float a[4];
#pragma unroll
                    for (int i = 0; i < 4; ++i) a[i] = uc[0][i] * sigmoidf_(uc[0][i]) * uc[1][i];
                    u32x2 o; o.x = cvt_pk_bf16(a[0], a[1]); o.y = cvt_pk_bf16(a[2], a[3]);
                    *(u32x2*)(ACT + (size_t)(rowg + m * 16 + fr) * DFF + ch) = o;
                    if ((m == 3 && fr >= 14) || (m == 0 && fr < 2)) {
                        const int slot = (rowg >> 6) * 4 + (m == 3 ? fr - 14 : 2 + fr);
#pragma unroll
                        for (int bj = 0; bj < 2; ++bj) { const f32x4 cur = acc[ai][bj][m][n]; u32x2 hw; hw.x = cvt_pk_bf16(cur[0], cur[1]); hw.y = cvt_pk_bf16(cur[2], cur[3]);
                            *(u32x2*)(HALO + (size_t)slot * NUP + bj * DFF + ch) = hw; }
                    }
                }
            }
        }
    }
};
}

__device__ __forceinline__ void transpose_item(const float* W, int Nsrc, int K, bf16* WT, int dst_row0, int src_col0, int k0, float* scr, int lane) {
#pragma unroll 8
    for (int i = 0; i < 32; ++i) { const int kk = 2 * i + (lane >> 5); scr[kk * 33 + (lane & 31)] = W[(size_t)(k0 + kk) * Nsrc + src_col0 + (lane & 31)]; }
    asm volatile("s_waitcnt lgkmcnt(0)" ::: "memory");
    const int c = lane & 7;
#pragma unroll
    for (int j = 0; j < 4; ++j) { const int n = (lane >> 3) + 8 * j; const float* s = scr + (8 * c) * 33 + n;
        u32x4 o; o.x = pk2(s[0 * 33], s[1 * 33]); o.y = pk2(s[2 * 33], s[3 * 33]); o.z = pk2(s[4 * 33], s[5 * 33]); o.w = pk2(s[6 * 33], s[7 * 33]);
        *(u32x4*)(WT + (size_t)(dst_row0 + n) * K + k0 + 8 * c) = o; }
    asm volatile("s_waitcnt lgkmcnt(0)" ::: "memory");
}
__device__ __forceinline__ void convert_weights(const Params& P, int l, const Ctx& c) {
    bf16* WT = (bf16*)(c.ws + OFF_WT);
    float* scr = (float*)(c.lds + c.wave * 16384);
    const int gw = c.bid * NWAVES + c.wave, NGW = c.G * NWAVES;
    constexpr int I_IN = 16 * 168, I_BF = 8 * 32, I_O = 16 * 32, I_UP = 16 * 176, I_DN = 44 * 32, I_LR = 16, I_LG = 32, I_ALL = I_IN + 2 * I_BF + I_O + I_UP + I_DN + 2 * I_LR + I_LG;
    for (int it = gw; it < I_ALL; it += NGW) {
        int r = it;
        if (r < I_IN) { const int kb = r / 168, n0 = 32 * (r % 168); transpose_item(P.in[4] + (size_t)l * 1024 * N_IN, N_IN, 1024, WT + WT_IN, n0, n0 + (n0 >= 1536 ? 8 : 0), 64 * kb, scr, c.lane); continue; } r -= I_IN;
        if (r < I_BF) { const int kb = r / 32, n0 = 32 * (r % 32); transpose_item(P.in[19] + (size_t)l * 512 * 1024, 1024, 512, WT + WT_BF, n0, n0, 64 * kb, scr, c.lane); continue; } r -= I_BF;
        if (r < I_BF) { const int kb = r / 32, n0 = 32 * (r % 32); transpose_item(P.in[20] + (size_t)l * 512 * 1024, 1024, 512, WT + WT_BR, n0, n0, 64 * kb, scr, c.lane); continue; } r -= I_BF;
        if (r < I_O) { const int kb = r / 32, n0 = 32 * (r % 32); transpose_item(P.in[22] + (size_t)l * 1024 * 1024, 1024, 1024, WT + WT_O, n0, n0, 64 * kb, scr, c.lane); continue; } r -= I_O;
        if (r < I_UP) { const int kb = r / 176, n0 = 32 * (r % 176); const int pn = n0 >> 8, bj = (n0 >> 7) & 1, x = n0 & 127;
            transpose_item(P.in[23] + (size_t)l * 1024 * NUP, NUP, 1024, WT + WT_UP, n0, bj * DFF + 128 * pn + x, 64 * kb, scr, c.lane); continue; } r -= I_UP;
        if (r < I_DN) { const int kb = r / 32, n0 = 32 * (r % 32); transpose_item(P.in[25] + (size_t)l * DFF * 1024, 1024, DFF, WT + WT_DN, n0, n0, 64 * kb, scr, c.lane); continue; } r -= I_DN;
        if (r < I_LR) { transpose_item(P.in[10] + (size_t)l * 64 * 512, 512, 64, WT + WT_LW, 32 * r, 32 * r, 0, scr, c.lane); continue; } r -= I_LR;
        if (r < I_LR) { transpose_item(P.in[12] + (size_t)l * 64 * 512, 512, 64, WT + WT_LA, 32 * r, 32 * r, 0, scr, c.lane); continue; } r -= I_LR;
        { const int kb = r / 16, n0 = 32 * (r % 16); transpose_item(P.in[13] + (size_t)l * 128 * 512, 512, 128, WT + WT_LG, n0, n0, 64 * kb, scr, c.lane); }
    }
}

template <bool FG> __device__ __forceinline__ void phase_norm(const Params& P, int l, const Ctx& c) {
    float* H = (float*)(c.ws + OFF_H); bf16* HN = (bf16*)(c.ws + OFF_HN);
    float* LOGF = (float*)(c.ws + OFF_MISC);
    const float* gain = (FG ? P.in[2] : P.in[3]) + l * DM;
    float* wfs = (float*)c.lds;
    if (FG) {
        __syncthreads();
        const float* win = P.in[4] + (size_t)l * 1024 * N_IN + 1536;
        for (int i = c.tid; i < 8192; i += NTHR) wfs[i] = win[(size_t)(i >> 3) * N_IN + (i & 7)];
        __syncthreads();
    }
    const int gw = c.bid * NWAVES + c.wave, NGW = c.G * NWAVES;
    for (int m = gw; m < M; m += NGW) {
        const int b = m >= LP ? 1 : 0, t = m - b * LP;
        f32x4 v[4];
        if (FG && l == 0) {
            const float* src = (t < NMETA) ? P.in[1] + (size_t)t * DM : P.in[0] + ((size_t)b * SEQ + (t - NMETA)) * DM;
            const bool real = t < NMETA + SEQ;
#pragma unroll
            for (int j = 0; j < 4; ++j) { v[j] = real ? *(const f32x4*)(src + 4 * c.lane + 256 * j) : (f32x4){0.f, 0.f, 0.f, 0.f}; *(f32x4*)(H + (size_t)m * DM + 4 * c.lane + 256 * j) = v[j]; }
        } else {
#pragma unroll
            for (int j = 0; j < 4; ++j) v[j] = *(const f32x4*)(H + (size_t)m * DM + 4 * c.lane + 256 * j);
        }
        float ss = 0.f;
#pragma unroll
        for (int j = 0; j < 4; ++j) ss += (v[j].x * v[j].x + v[j].y * v[j].y) + (v[j].z * v[j].z + v[j].w * v[j].w);
        const float rstd = 1.0f / sqrtf(wave_sum(ss) * (1.f / DM) + 1e-6f);
        float f[8];
#pragma unroll
        for (int q = 0; q < 8; ++q) f[q] = 0.f;
#pragma unroll
        for (int j = 0; j < 4; ++j) {
            const f32x4 g = *(const f32x4*)(gain + 4 * c.lane + 256 * j);
            v[j] = v[j] * rstd * g;
            u32x2 o; o.x = pk2(v[j].x, v[j].y); o.y = pk2(v[j].z, v[j].w);
            *(u32x2*)(HN + (size_t)m * DM + 4 * c.lane + 256 * j) = o;
            if (FG) {
#pragma unroll
                for (int e = 0; e < 4; ++e) { const int k = 4 * c.lane + 256 * j + e; const f32x4 w0 = *(const f32x4*)(wfs + k * 8), w1 = *(const f32x4*)(wfs + k * 8 + 4);
                    const float hv = v[j][e];
                    f[0] += hv * w0.x; f[1] += hv * w0.y; f[2] += hv * w0.z; f[3] += hv * w0.w; f[4] += hv * w1.x; f[5] += hv * w1.y; f[6] += hv * w1.z; f[7] += hv * w1.w; }
            }
        }
        if (FG) {
#pragma unroll
            for (int q = 0; q < 8; ++q) f[q] = wave_sum(f[q]);
            float fv = f[0];
#pragma unroll
            for (int q = 1; q < 8; ++q) fv = (c.lane == q) ? f[q] : fv;
            if (c.lane < 8) { const float x = fv + P.in[7][l * 8 + c.lane]; const float ls = fminf(x, 0.f) - log1pf(expf(-fabsf(x))); LOGF[(size_t)(b * 8 + c.lane) * LP + t] = ls; }
        }
    }
}

__device__ __forceinline__ void phase_fcum(const Params& P, const Ctx& c) {
    if (c.bid < 16 && c.wave == 0) {
        const float* LOGF = (const float*)(c.ws + OFF_MISC) + (size_t)c.bid * LP; float* FC = (float*)(c.ws + OFF_MISC) + 16 * LP + (size_t)c.bid * LP;
        float carry = 0.f;
        for (int ch = 0; ch < LP / 64; ++ch) {
            float v = LOGF[ch * 64 + c.lane];
#pragma unroll
            for (int o = 1; o < 64; o <<= 1) { const float t = __shfl_up(v, o); if (c.lane >= o) v += t; }
            v += carry; FC[ch * 64 + c.lane] = v * LOG2E; carry = __shfl(v, 63);
        }
    }
}

__device__ __forceinline__ void phase_qknorm(const Params& P, int l, const Ctx& c) {
    bf16* Q = (bf16*)(c.ws + OFF_Q); bf16* K = (bf16*)(c.ws + OFF_K);
    const int gw = c.bid * NWAVES + c.wave, NGW = c.G * NWAVES;
    const int d0 = (c.lane & 7) * 8;
    float gq[8], gk[8];
#pragma unroll
    for (int i = 0; i < 8; ++i) { gq[i] = P.in[5][l * 64 + d0 + i] * QSCALE; gk[i] = P.in[6][l * 64 + d0 + i]; }
    for (int m = gw; m < M; m += NGW) {
#pragma unroll
        for (int which = 0; which < 2; ++which) {
            bf16* p = (which ? K : Q) + (size_t)m * 512 + 8 * c.lane;
            const u32x4 w = *(const u32x4*)p;
            float x[8] = {bflo(w.x), bfhi(w.x), bflo(w.y), bfhi(w.y), bflo(w.z), bfhi(w.z), bflo(w.w), bfhi(w.w)};
            float ss = 0.f;
#pragma unroll
            for (int i = 0; i < 8; ++i) ss += x[i] * x[i];
            ss += __shfl_xor(ss, 1); ss += __shfl_xor(ss, 2); ss += __shfl_xor(ss, 4);
            const float rs = 1.0f / sqrtf(ss * (1.f / 64.f) + 1e-6f);
#pragma unroll
            for (int i = 0; i < 8; ++i) x[i] = x[i] * rs * (which ? gk[i] : gq[i]);
            u32x4 o; o.x = pk2(x[0], x[1]); o.y = pk2(x[2], x[3]); o.z = pk2(x[4], x[5]); o.w = pk2(x[6], x[7]);
            *(u32x4*)p = o;
        }
    }
}

constexpr int NCHK = LP / 64;
constexpr int NUNIT = NB * NCHK * 8;
constexpr int UNIT_A = 16384, UNIT_B = 16640;
constexpr int ST = 72, STG = 136;
constexpr int L_F0 = 92160, L_F1 = 108544;
struct RwkvBufs { bf16 *BON, *G; unsigned char *UA, *UB; float* Y; bf16* ORW; };
__device__ __forceinline__ RwkvBufs rwkv_bufs(const Params& P, const Ctx& c) {
    RwkvBufs r; r.BON = (bf16*)(c.ws + OFF_HN); r.G = r.BON + (size_t)M * 512;
    r.UA = c.ws + OFF_T0; r.UB = (unsigned char*)P.out;
    r.Y = (float*)(c.ws + OFF_RW); r.ORW = (bf16*)(c.ws + OFF_RW + (size_t)M * 512 * 4);
    return r;
}
__device__ __forceinline__ void mm_tile(const bf16* A, int sa, const bf16* Bt, int sb, int nks, f32x4 (&acc)[2], int w, int lq, int g) {
    const int mt = w >> 1, nt0 = 2 * (w & 1);
    for (int ks = 0; ks < nks; ++ks) {
        const bf16x8 a = *(const bf16x8*)(A + (16 * mt + lq) * sa + 32 * ks + 8 * g);
#pragma unroll
        for (int q = 0; q < 2; ++q) { const bf16x8 b = *(const bf16x8*)(Bt + (16 * (nt0 + q) + lq) * sb + 32 * ks + 8 * g); acc[q] = __builtin_amdgcn_mfma_f32_16x16x32_bf16(a, b, acc[q], 0, 0, 0); }
    }
}
#define ZACC(a) do { a[0] = (f32x4){0.f, 0.f, 0.f, 0.f}; a[1] = (f32x4){0.f, 0.f, 0.f, 0.f}; } while (0)
__device__ __forceinline__ int permk(int k) { return 32 * (k >> 5) + 8 * ((k & 15) >> 2) + 4 * ((k >> 4) & 1) + (k & 3); }
__device__ __forceinline__ int swz(int row, int col) { return row * 128 + ((((col >> 3) ^ (row >> 1)) & 7) << 4) + (col & 7) * 2; }

__device__ __forceinline__ void rwkv_prep_unit(const Params& P, int l, const Ctx& c, int u, const RwkvBufs& B) {
    const int h = u & 7, bc = u >> 3, b = bc / NCHK, ch = bc - b * NCHK;
    const size_t m0 = (size_t)b * LP + ch * 64;
    int tid_ = c.tid; asm volatile("" : "+v"(tid_));
    const int tid = tid_, lane = tid & 63, w = c.wave, lq = lane & 15, g = lane >> 4;
    const int t = tid >> 3, cg = tid & 7, c0 = cg * 8, jb = h * 64 + c0;
    unsigned char* L = c.lds;
    bf16* A0 = (bf16*)L; bf16* A1 = A0 + 4608; bf16* A2 = A1 + 4608; bf16* A3 = A2 + 4608; bf16* A4 = A3 + 4608; bf16* A5 = A4 + 4608; bf16* A6 = A5 + 4608;
    bf16* A7 = A6 + 4608; bf16* A8 = A7 + 4608; bf16* A9 = A8 + 4608;
    float* F0 = (float*)(L + L_F0); float* F1 = (float*)(L + L_F1);
    const bf16* RW = (const bf16*)(c.ws + OFF_RW);
    const bf16* WT = (const bf16*)(c.ws + OFF_WT);
    const float* mu = P.in[8] + l * NRW;
    const bool first = (ch == 0 && t == 0);
    const bf16* cur = RW + (m0 + t) * NRW; const bf16* prv = cur - NRW;
    float zr[8], zk[8], zv[8];
#pragma unroll
    for (int s = 0; s < 3; ++s) {
        const u32x4 cw = *(const u32x4*)(cur + s * 512 + jb); u32x4 pw = (u32x4){0u, 0u, 0u, 0u}; if (!first) pw = *(const u32x4*)(prv + s * 512 + jb);
        const float cv[8] = {bflo(cw.x), bfhi(cw.x), bflo(cw.y), bfhi(cw.y), bflo(cw.z), bfhi(cw.z), bflo(cw.w), bfhi(cw.w)};
        const float pv[8] = {bflo(pw.x), bfhi(pw.x), bflo(pw.y), bfhi(pw.y), bflo(pw.z), bfhi(pw.z), bflo(pw.w), bfhi(pw.w)};
#pragma unroll
        for (int i = 0; i < 8; ++i) { const float z = cv[i] + mu[s * 512 + jb + i] * (pv[i] - cv[i]); if (s == 0) zr[i] = z; else if (s == 1) zk[i] = z; else zv[i] = z; }
    }
#pragma unroll
    for (int q4 = 0; q4 < 4; ++q4) {
        const int col = cg * 32 + q4 * 8;
        const u32x4 cw = *(const u32x4*)(cur + 1536 + col); u32x4 pw = (u32x4){0u, 0u, 0u, 0u}; if (!first) pw = *(const u32x4*)(prv + 1536 + col);
        const float cv[8] = {bflo(cw.x), bfhi(cw.x), bflo(cw.y), bfhi(cw.y), bflo(cw.z), bfhi(cw.z), bflo(cw.w), bfhi(cw.w)};
        const float pv[8] = {bflo(pw.x), bfhi(pw.x), bflo(pw.y), bfhi(pw.y), bflo(pw.z), bfhi(pw.z), bflo(pw.w), bfhi(pw.w)};
        float z[8];
#pragma unroll
        for (int i = 0; i < 8; ++i) { z[i] = cv[i] + mu[1536 + col + i] * (pv[i] - cv[i]); if (col < 64) z[i] = tanhf(z[i]); else if (col >= 128) z[i] = sigmoidf_(z[i]); }
        u32x4 o; o.x = pk2(z[0], z[1]); o.y = pk2(z[2], z[3]); o.z = pk2(z[4], z[5]); o.w = pk2(z[6], z[7]);
        bf16* dst = (col < 64) ? A0 + t * ST + col : (col < 128 ? A1 + t * ST + (col - 64) : A2 + t * STG + (col - 128));
        *(u32x4*)dst = o;
    }
    { const int row = tid >> 3, chk = tid & 7;
      *(u32x4*)(A4 + row * ST + chk * 8) = *(const u32x4*)(WT + WT_LW + (size_t)(h * 64 + row) * 64 + chk * 8);
      *(u32x4*)(A5 + row * ST + chk * 8) = *(const u32x4*)(WT + WT_LA + (size_t)(h * 64 + row) * 64 + chk * 8);
#pragma unroll
      for (int i = 0; i < 2; ++i) { const int idx = tid + 512 * i, r2 = idx >> 4, c2 = idx & 15;
          *(u32x4*)((bf16*)F1 + r2 * STG + c2 * 8) = *(const u32x4*)(WT + WT_LG + (size_t)(h * 64 + r2) * 128 + c2 * 8); } }
    __syncthreads();
    { f32x4 aw[2], aa[2], ag[2]; ZACC(aw); ZACC(aa); ZACC(ag);
      mm_tile(A0, ST, A4, ST, 2, aw, w, lq, g); mm_tile(A1, ST, A5, ST, 2, aa, w, lq, g); mm_tile(A2, STG, (const bf16*)F1, STG, 4, ag, w, lq, g);
      const int mt = w >> 1, nt0 = 2 * (w & 1);
#pragma unroll
      for (int q = 0; q < 2; ++q)
#pragma unroll
          for (int j = 0; j < 4; ++j) { const int o = (16 * mt + 4 * g + j) * ST + 16 * (nt0 + q) + lq; A7[o] = (bf16)f2bf(aw[q][j]); A8[o] = (bf16)f2bf(aa[q][j]); A9[o] = (bf16)f2bf(ag[q][j]); } }
    __syncthreads();
    float kk[8], k2[8], ar[8];
    { const u32x4 lw = *(const u32x4*)(A7 + t * ST + c0), la = *(const u32x4*)(A8 + t * ST + c0), lg = *(const u32x4*)(A9 + t * ST + c0);
      const float fw[8] = {bflo(lw.x), bfhi(lw.x), bflo(lw.y), bfhi(lw.y), bflo(lw.z), bfhi(lw.z), bflo(lw.w), bfhi(lw.w)};
      const float fa[8] = {bflo(la.x), bfhi(la.x), bflo(la.y), bfhi(la.y), bflo(la.z), bfhi(la.z), bflo(la.w), bfhi(la.w)};
      float ss = 0.f, bs = 0.f;
#pragma unroll
      for (int i = 0; i < 8; ++i) { const int j = l * 512 + jb + i;
          const float xw = -(P.in[9][j] + fw[i]); const float sp = fmaxf(xw, 0.f) + log1pf(expf(-fabsf(xw)));
          F0[t * 64 + c0 + i] = expf(-sp - 0.5f);
          ar[i] = sigmoidf_(P.in[11][j] + fa[i]);
          kk[i] = zk[i] * P.in[14][j]; ss += kk[i] * kk[i];
          k2[i] = zk[i] * (1.f + (ar[i] - 1.f) * P.in[15][j]);
          bs += zr[i] * k2[i] * P.in[16][j]; }
      ss += __shfl_xor(ss, 1); ss += __shfl_xor(ss, 2); ss += __shfl_xor(ss, 4);
      bs += __shfl_xor(bs, 1); bs += __shfl_xor(bs, 2); bs += __shfl_xor(bs, 4);
      const float inv = 1.0f / fmaxf(sqrtf(ss), 1e-12f);
#pragma unroll
      for (int i = 0; i < 8; ++i) kk[i] *= inv;
      u32x4 bo; bo.x = pk2(bs * zv[0], bs * zv[1]); bo.y = pk2(bs * zv[2], bs * zv[3]); bo.z = pk2(bs * zv[4], bs * zv[5]); bo.w = pk2(bs * zv[6], bs * zv[7]);
      *(u32x4*)(B.BON + (m0 + t) * 512 + jb) = bo; *(u32x4*)(B.G + (m0 + t) * 512 + jb) = lg; }
    __syncthreads();
    {
      const int k = tid & 63, sg = tid >> 6; float e[8], run = 0.f;
#pragma unroll
      for (int s = 0; s < 8; ++s) { run += F0[(8 * sg + s) * 64 + k]; e[s] = run; }
      F1[sg * 64 + k] = run;
      __syncthreads();
      float off = 0.f;
#pragma unroll
      for (int s = 0; s < 8; ++s) off += (s < sg) ? F1[s * 64 + k] : 0.f;
#pragma unroll
      for (int s = 0; s < 8; ++s) F0[(8 * sg + s) * 64 + k] = e[s] + off; }
    __syncthreads();
    { float ct[8], cp[8], cC[8];
#pragma unroll
      for (int i = 0; i < 8; ++i) { ct[i] = F0[t * 64 + c0 + i]; cp[i] = (t > 0) ? F0[(t - 1) * 64 + c0 + i] : 0.f; cC[i] = F0[63 * 64 + c0 + i]; }
      float at[8], bt[8], kt[8], rt[8], bh[8], kh[8];
#pragma unroll
      for (int i = 0; i < 8; ++i) { const float gt = expf(-ct[i]), igt = expf(ct[i]), gp = expf(-cp[i]), gct = expf(ct[i] - cC[i]);
          at[i] = -kk[i] * gp; bt[i] = kk[i] * ar[i] * igt; kt[i] = k2[i] * igt; rt[i] = zr[i] * gt; bh[i] = kk[i] * ar[i] * gct; kh[i] = k2[i] * gct; }
      u32x4 o;
      o.x = pk2(at[0], at[1]); o.y = pk2(at[2], at[3]); o.z = pk2(at[4], at[5]); o.w = pk2(at[6], at[7]); *(u32x4*)(A0 + t * ST + c0) = o;
      o.x = pk2(bt[0], bt[1]); o.y = pk2(bt[2], bt[3]); o.z = pk2(bt[4], bt[5]); o.w = pk2(bt[6], bt[7]); *(u32x4*)(A1 + t * ST + c0) = o;
      o.x = pk2(kt[0], kt[1]); o.y = pk2(kt[2], kt[3]); o.z = pk2(kt[4], kt[5]); o.w = pk2(kt[6], kt[7]); *(u32x4*)(A2 + t * ST + c0) = o;
      o.x = pk2(rt[0], rt[1]); o.y = pk2(rt[2], rt[3]); o.z = pk2(rt[4], rt[5]); o.w = pk2(rt[6], rt[7]); *(u32x4*)(A3 + t * ST + c0) = o;
#pragma unroll
      for (int i = 0; i < 8; ++i) { A4[(c0 + i) * ST + t] = (bf16)f2bf(bh[i]); A5[(c0 + i) * ST + t] = (bf16)f2bf(kh[i]); A6[(c0 + i) * ST + t] = (bf16)f2bf(zv[i]); F1[t * 128 + c0 + i] = at[i]; }
      if (t == 63) { float* gc = (float*)(B.UB + (size_t)u * UNIT_B + 16384) + c0;
#pragma unroll
          for (int i = 0; i < 8; ++i) gc[i] = expf(-cC[i]); } }
    __syncthreads();
    { const int mt = w >> 1, nt0 = 2 * (w & 1);
      f32x4 a1[2], a2[2], a3[2], a4[2]; ZACC(a1); ZACC(a2); ZACC(a3); ZACC(a4);
      mm_tile(A0, ST, A1, ST, 2, a1, w, lq, g); mm_tile(A0, ST, A2, ST, 2, a2, w, lq, g); mm_tile(A3, ST, A1, ST, 2, a3, w, lq, g); mm_tile(A3, ST, A2, ST, 2, a4, w, lq, g);
      __syncthreads();
#pragma unroll
      for (int q = 0; q < 2; ++q) { const int i = 16 * (nt0 + q) + lq; f32x4 lab;
#pragma unroll
          for (int j = 0; j < 4; ++j) { const int tt = 16 * mt + 4 * g + j; lab[j] = (i < tt) ? a1[q][j] : 0.f;
              A7[tt * ST + i] = (bf16)f2bf((i < tt) ? a2[q][j] : 0.f); A8[tt * ST + i] = (bf16)f2bf((i <= tt) ? a3[q][j] : 0.f); A9[tt * ST + i] = (bf16)f2bf((i <= tt) ? a4[q][j] : 0.f); }
          *(f32x4*)(F0 + i * 64 + 16 * mt + 4 * g) = lab; } }
    __syncthreads();
    { const int mt = w >> 1, nt0 = 2 * (w & 1); f32x4 a[2]; ZACC(a);
      mm_tile(A7, ST, A6, ST, 2, a, w, lq, g);
#pragma unroll
      for (int q = 0; q < 2; ++q)
#pragma unroll
          for (int j = 0; j < 4; ++j) F1[(16 * mt + 4 * g + j) * 128 + 64 + 16 * (nt0 + q) + lq] = a[q][j]; }
    __syncthreads();
    { float X[16];
      const int col = 16 * w + lq;
#pragma unroll
      for (int r = 0; r < 16; ++r) X[r] = F1[(4 * r + g) * 128 + col];
      __syncthreads();
#pragma unroll
      for (int i = 0; i < 64; ++i) {
          const float xi = __shfl(X[i >> 2], (i & 3) * 16 + lq);
#pragma unroll
          for (int r = (i >> 2); r < 16; ++r) X[r] += F0[i * 64 + 4 * r + g] * xi;
          asm volatile("" ::: "memory");
      }
      bf16* XT = (bf16*)F1 + (w >> 2) * 4608 + ((col & 63) * ST);
#pragma unroll
      for (int r = 0; r < 16; ++r) XT[4 * r + g] = (bf16)f2bf(X[r]); }
    __syncthreads();
    { const int mt = w >> 1, nt0 = 2 * (w & 1);
      const bf16* AhT = (const bf16*)F1; const bf16* W2T = AhT + 4608;
      unsigned char* ua = B.UA + (size_t)u * UNIT_A; unsigned char* ub = B.UB + (size_t)u * UNIT_B;
      f32x4 a[2];
      ZACC(a); mm_tile(A4, ST, AhT, ST, 2, a, w, lq, g);
#pragma unroll
      for (int q = 0; q < 2; ++q)
#pragma unroll
          for (int j = 0; j < 4; ++j) { const int row = 16 * mt + 4 * g + j, kc = 16 * (nt0 + q) + lq; *(bf16*)(ua + swz(row, permk(kc))) = (bf16)f2bf(a[q][j]); }
      ZACC(a); mm_tile(A8, ST, AhT, ST, 2, a, w, lq, g);
#pragma unroll
      for (int q = 0; q < 2; ++q)
#pragma unroll
          for (int j = 0; j < 4; ++j) { const int row = 16 * mt + 4 * g + j, kc = 16 * (nt0 + q) + lq; *(bf16*)(ua + 8192 + swz(row, permk(kc))) = (bf16)f2bf(a[q][j] + bf2f(A3[row * ST + kc])); }
      ZACC(a); mm_tile(A4, ST, W2T, ST, 2, a, w, lq, g); mm_tile(A5, ST, A6, ST, 2, a, w, lq, g);
#pragma unroll
      for (int q = 0; q < 2; ++q) { const int v = 16 * (nt0 + q) + lq, k0 = 16 * mt + 4 * g; u32x2 o; o.x = pk2(a[q][0], a[q][1]); o.y = pk2(a[q][2], a[q][3]); *(u32x2*)(ub + swz(v, k0)) = o; }
      ZACC(a); mm_tile(A8, ST, W2T, ST, 2, a, w, lq, g); mm_tile(A9, ST, A6, ST, 2, a, w, lq, g);
#pragma unroll
      for (int q = 0; q < 2; ++q) { const int v = 16 * (nt0 + q) + lq, t0 = 16 * mt + 4 * g; u32x2 o; o.x = pk2(a[q][0], a[q][1]); o.y = pk2(a[q][2], a[q][3]); *(u32x2*)(ub + 8192 + swz(v, t0)) = o; } }
    __syncthreads();
}
__device__ __forceinline__ void phase_rwkv_prep(const Params& P, int l, const Ctx& c) {
    const RwkvBufs B = rwkv_bufs(P, c);
    for (int u = c.bid; u < NUNIT; u += c.G) rwkv_prep_unit(P, l, c, u, B);
}

constexpr int SLOTB = 33280;
__device__ __forceinline__ void scan_chunked(const Params& P, const Ctx& c, int bh) {
    const RwkvBufs B = rwkv_bufs(P, c);
    const int b = bh >> 3, h = bh & 7, w = c.wave, lane = c.lane, lq = lane & 15, g = lane >> 4;
    const size_t rowb = (size_t)b * LP;
    const int ll = (w - 4) * 64 + lane;
    unsigned char* L = c.lds;
    f32x4 st[4];
#pragma unroll
    for (int i = 0; i < 4; ++i) st[i] = (f32x4){0.f, 0.f, 0.f, 0.f};
    u32x4 ra[9], rb[9];
#define SC_UNIT(cc) ((size_t)((b * NCHK + (cc)) * 8 + h))
#define SC_LOAD(R, cc) do { const unsigned char* pa_ = B.UA + SC_UNIT(cc) * UNIT_A; const unsigned char* pb_ = B.UB + SC_UNIT(cc) * UNIT_B; \
        _Pragma("unroll") for (int i_ = 0; i_ < 4; ++i_) { R[i_] = *(const u32x4*)(pa_ + (ll + 256 * i_) * 16); R[4 + i_] = *(const u32x4*)(pb_ + (ll + 256 * i_) * 16); } \
        if (ll < 16) R[8] = *(const u32x4*)(pb_ + 16384 + ll * 16); } while (0)
#define SC_WRITE(R, slot) do { unsigned char* s_ = L + (slot) * SLOTB; \
        _Pragma("unroll") for (int i_ = 0; i_ < 4; ++i_) { *(u32x4*)(s_ + (ll + 256 * i_) * 16) = R[i_]; *(u32x4*)(s_ + 16384 + (ll + 256 * i_) * 16) = R[4 + i_]; } \
        if (ll < 16) *(u32x4*)(s_ + 32768 + ll * 16) = R[8]; } while (0)
    if (w >= 4) { SC_LOAD(ra, 0); SC_LOAD(rb, 1); SC_WRITE(ra, 0); SC_WRITE(rb, 1); SC_LOAD(ra, 2); SC_LOAD(rb, 3); }
    __syncthreads();
    for (int cc = 0; cc < NCHK; cc += 2) {
#pragma unroll
        for (int half = 0; half < 2; ++half) {
            const int ci = cc + half;
            if (w >= 4) {
                if (half == 0) { if (ci + 2 < NCHK) SC_WRITE(ra, (ci + 2) % 3); if (ci + 4 < NCHK) SC_LOAD(ra, ci + 4); }
                else { if (ci + 2 < NCHK) SC_WRITE(rb, (ci + 2) % 3); if (ci + 4 < NCHK) SC_LOAD(rb, ci + 4); }
            } else {
                const unsigned char* sl = L + (ci % 3) * SLOTB;
                const int vcol = 16 * w + lq;
                bf16x8 sb[2];
#pragma unroll
                for (int ks = 0; ks < 2; ++ks) { u32x4 pw; pw.x = pk2(st[2 * ks][0], st[2 * ks][1]); pw.y = pk2(st[2 * ks][2], st[2 * ks][3]); pw.z = pk2(st[2 * ks + 1][0], st[2 * ks + 1][1]); pw.w = pk2(st[2 * ks + 1][2], st[2 * ks + 1][3]);
                    sb[ks] = __builtin_bit_cast(bf16x8, pw); }
#pragma unroll
                for (int mt = 0; mt < 4; ++mt) {
                    const f32x4 gc = *(const f32x4*)(sl + 32768 + (16 * mt + 4 * g) * 4);
                    const u32x2 d0 = *(const u32x2*)(sl + 16384 + swz(vcol, 16 * mt + 4 * g));
                    const u32x2 y0 = *(const u32x2*)(sl + 24576 + swz(vcol, 16 * mt + 4 * g));
                    f32x4 ns = (f32x4){bflo(d0.x), bfhi(d0.x), bflo(d0.y), bfhi(d0.y)} + gc * st[mt];
                    f32x4 ya = (f32x4){bflo(y0.x), bfhi(y0.x), bflo(y0.y), bfhi(y0.y)};
#pragma unroll
                    for (int ks = 0; ks < 2; ++ks) {
                        const bf16x8 ga = *(const bf16x8*)(sl + swz(16 * mt + lq, 32 * ks + 8 * g));
                        const bf16x8 rh = *(const bf16x8*)(sl + 8192 + swz(16 * mt + lq, 32 * ks + 8 * g));
                        ns = __builtin_amdgcn_mfma_f32_16x16x32_bf16(ga, sb[ks], ns, 0, 0, 0);
                        ya = __builtin_amdgcn_mfma_f32_16x16x32_bf16(rh, sb[ks], ya, 0, 0, 0);
                    }
                    st[mt] = ns;
                    float* yp = B.Y + (rowb + ci * 64 + 16 * mt + 4 * g) * 512 + h * 64 + vcol;
#pragma unroll
                    for (int j = 0; j < 4; ++j) yp[j * 512] = ya[j];
                }
            }
            __syncthreads();
        }
    }
#undef SC_UNIT
#undef SC_LOAD
#undef SC_WRITE
}

__device__ __forceinline__ void phase_gn(const Params& P, int l, const Ctx& c) {
    const RwkvBufs B = rwkv_bufs(P, c);
    const int gw = c.bid * NWAVES + c.wave, NGW = c.G * NWAVES;
    const int c0 = 8 * c.lane;
    float gnw[8], gnb[8];
#pragma unroll
    for (int i = 0; i < 8; ++i) { gnw[i] = P.in[17][l * 512 + c0 + i]; gnb[i] = P.in[18][l * 512 + c0 + i]; }
    for (int m = gw; m < M; m += NGW) {
        const size_t o = (size_t)m * 512 + c0;
        const f32x4 y0 = *(const f32x4*)(B.Y + o), y1 = *(const f32x4*)(B.Y + o + 4);
        float y[8] = {y0.x, y0.y, y0.z, y0.w, y1.x, y1.y, y1.z, y1.w};
        const u32x4 bw = *(const u32x4*)(B.BON + o), gw4 = *(const u32x4*)(B.G + o);
        const float bo[8] = {bflo(bw.x), bfhi(bw.x), bflo(bw.y), bfhi(bw.y), bflo(bw.z), bfhi(bw.z), bflo(bw.w), bfhi(bw.w)};
        const float gg[8] = {bflo(gw4.x), bfhi(gw4.x), bflo(gw4.y), bfhi(gw4.y), bflo(gw4.z), bfhi(gw4.z), bflo(gw4.w), bfhi(gw4.w)};
        float s = 0.f;
#pragma unroll
        for (int i = 0; i < 8; ++i) s += y[i];
        s += __shfl_xor(s, 1); s += __shfl_xor(s, 2); s += __shfl_xor(s, 4);
        const float mean = s * (1.f / 64.f);
        float q = 0.f;
#pragma unroll
        for (int i = 0; i < 8; ++i) { y[i] -= mean; q += y[i] * y[i]; }
        q += __shfl_xor(q, 1); q += __shfl_xor(q, 2); q += __shfl_xor(q, 4);
        const float rstd = 1.0f / sqrtf(q * (1.f / 64.f) + 64e-5f);
        float ov[8];
#pragma unroll
        for (int i = 0; i < 8; ++i) ov[i] = (y[i] * rstd * gnw[i] + gnb[i] + bo[i]) * gg[i];
        u32x4 ow; ow.x = pk2(ov[0], ov[1]); ow.y = pk2(ov[2], ov[3]); ow.z = pk2(ov[4], ov[5]); ow.w = pk2(ov[6], ov[7]);
        *(u32x4*)(B.ORW + o) = ow;
    }
}

__device__ __forceinline__ void attn_unit(const Ctx& c, int bh, int qb, const bf16* Q, const bf16* K, const bf16* V, bf16* O, const float* FC, float qkb2) {
    const int b = bh >> 3, h = bh & 7, lane = c.lane, w = c.wave, lq = lane & 15, g = lane >> 4;
    const int q0 = qb * 128;
    const size_t rowb = (size_t)b * LP;
    const int qrow = q0 + 16 * w + lq;
    bf16* Ks = (bf16*)c.lds; bf16* Vt = Ks + 64 * 72; float* fks = (float*)(Vt + 64 * 72);
    const bf16* qp = Q + (rowb + qrow) * 512 + h * 64 + 8 * g;
    const bf16x8 qf0 = *(const bf16x8*)qp, qf1 = *(const bf16x8*)(qp + 32);
    const float* FCh = FC + (size_t)bh * LP;
    const float fq = FCh[qrow];
    float mrun = -1e30f, lsum = 0.f;
    f32x4 o[4];
#pragma unroll
    for (int i = 0; i < 4; ++i) o[i] = (f32x4){0.f, 0.f, 0.f, 0.f};
    const int kt_max = (q0 + 127) >> 6;
    for (int kt = kt_max; kt >= 0; --kt) {
        const int k0 = kt * 64;
        if (kt < kt_max) { const float fl = FCh[k0 + 63]; const int can = (qkb2 + fq - fl) < (mrun - THR2); if (__syncthreads_and(can)) break; }
        else __syncthreads();
        { const int key = c.tid >> 3, ch = c.tid & 7;
            const size_t goff = (rowb + k0 + key) * 512 + h * 64 + ch * 8;
            const u32x4 kv = *(const u32x4*)(K + goff); const u32x4 vv = *(const u32x4*)(V + goff);
            *(u32x4*)(Ks + key * 72 + ch * 8) = kv;
            bf16* vd = Vt + (ch * 8) * 72 + key;
            vd[0] = (bf16)(vv.x & 0xffff); vd[72] = (bf16)(vv.x >> 16); vd[144] = (bf16)(vv.y & 0xffff); vd[216] = (bf16)(vv.y >> 16);
            vd[288] = (bf16)(vv.z & 0xffff); vd[360] = (bf16)(vv.z >> 16); vd[432] = (bf16)(vv.w & 0xffff); vd[504] = (bf16)(vv.w >> 16);
            if (c.tid < 64) fks[c.tid] = FCh[k0 + c.tid]; }
        __syncthreads();
        if (k0 > q0 + 16 * w + 15) continue;
        f32x4 s[4];
#pragma unroll
        for (int nt = 0; nt < 4; ++nt) { const bf16* kp = Ks + (16 * nt + lq) * 72 + 8 * g; const bf16x8 a0 = *(const bf16x8*)kp, a1 = *(const bf16x8*)(kp + 32);
            s[nt] = __builtin_amdgcn_mfma_f32_16x16x32_bf16(a0, qf0, (f32x4){0.f, 0.f, 0.f, 0.f}, 0, 0, 0);
            s[nt] = __builtin_amdgcn_mfma_f32_16x16x32_bf16(a1, qf1, s[nt], 0, 0, 0); }
        float mx = -INFINITY;
#pragma unroll
        for (int nt = 0; nt < 4; ++nt) { const f32x4 fk = *(const f32x4*)(fks + 16 * nt + 4 * g);
#pragma unroll
            for (int j = 0; j < 4; ++j) { float x = s[nt][j] + fq - fk[j]; const int key = k0 + 16 * nt + 4 * g + j; if (key > qrow) x = -INFINITY; s[nt][j] = x; mx = fmaxf(mx, x); } }
        mx = fmaxf(mx, __shfl_xor(mx, 16)); mx = fmaxf(mx, __shfl_xor(mx, 32));
        const float mnew = fmaxf(mrun, mx), alpha = exp2f(mrun - mnew); mrun = mnew;
        float psum = 0.f;
#pragma unroll
        for (int nt = 0; nt < 4; ++nt)
#pragma unroll
            for (int j = 0; j < 4; ++j) { const float p = exp2f(s[nt][j] - mnew); s[nt][j] = p; psum += p; }
        lsum = lsum * alpha + psum;
#pragma unroll
        for (int dt = 0; dt < 4; ++dt) o[dt] = o[dt] * alpha;
        bf16x8 pb[2];
#pragma unroll
        for (int k2 = 0; k2 < 2; ++k2) { u32x4 pw; pw.x = pk2(s[2 * k2][0], s[2 * k2][1]); pw.y = pk2(s[2 * k2][2], s[2 * k2][3]); pw.z = pk2(s[2 * k2 + 1][0], s[2 * k2 + 1][1]); pw.w = pk2(s[2 * k2 + 1][2], s[2 * k2 + 1][3]);
            pb[k2] = __builtin_bit_cast(bf16x8, pw); }
#pragma unroll
        for (int dt = 0; dt < 4; ++dt)
#pragma unroll
            for (int k2 = 0; k2 < 2; ++k2) { const bf16* vp = Vt + (16 * dt + lq) * 72 + 32 * k2 + 4 * g;
                const u32x2 lo = *(const u32x2*)vp, hi = *(const u32x2*)(vp + 16);
                u32x4 aw; aw.x = lo.x; aw.y = lo.y; aw.z = hi.x; aw.w = hi.y;
                o[dt] = __builtin_amdgcn_mfma_f32_16x16x32_bf16(__builtin_bit_cast(bf16x8, aw), pb[k2], o[dt], 0, 0, 0); }
    }
    lsum += __shfl_xor(lsum, 16); lsum += __shfl_xor(lsum, 32);
    const float inv = 1.0f / lsum;
    bf16* op = O + (rowb + qrow) * 512 + h * 64 + 4 * g;
#pragma unroll
    for (int dt = 0; dt < 4; ++dt) { u32x2 ow; ow.x = pk2(o[dt][0] * inv, o[dt][1] * inv); ow.y = pk2(o[dt][2] * inv, o[dt][3] * inv); *(u32x2*)(op + 16 * dt) = ow; }
    __syncthreads();
}
__device__ __forceinline__ void phase_attn(const Params& P, int l, const Ctx& c, int first_blk) {
    const bf16* Q = (const bf16*)(c.ws + OFF_Q); const bf16* K = (const bf16*)(c.ws + OFF_K); const bf16* V = (const bf16*)(c.ws + OFF_V);
    const float* FC = (const float*)(c.ws + OFF_MISC) + 16 * LP;
    float gqm = fabsf(P.in[5][l * 64 + c.lane]), gkm = fabsf(P.in[6][l * 64 + c.lane]);
#pragma unroll
    for (int o = 1; o < 64; o <<= 1) { gqm = fmaxf(gqm, __shfl_xor(gqm, o)); gkm = fmaxf(gkm, __shfl_xor(gkm, o)); }
    const float qkb2 = 8.0f * gqm * gkm * LOG2E * 1.03f;
    const int nblk = c.G - first_blk, me = c.bid - first_blk;
    constexpr int NQB = LP / 128, NU = 16 * NQB;
    for (int u = me; u < NU; u += nblk) { const int bh = u & 15, qb = NQB - 1 - (u >> 4); attn_unit(c, bh, qb, Q, K, V, (bf16*)(c.ws + OFF_Q), FC, qkb2); }
}

__device__ __forceinline__ void phase_fixup(const Params& P, int l, const Ctx& c) {
    bf16* ACT = (bf16*)(c.ws + OFF_RW); const bf16* HALO = (const bf16*)(c.ws + OFF_Q);
    const float* cw = P.in[24] + (size_t)l * 3 * NUP;
    const int total = (M / 64) * 2 * DFF;
    for (int idx = c.bid * NTHR + c.tid; idx < total; idx += c.G * NTHR) {
        const int rr = idx / DFF, ch = idx - rr * DFF, q64 = rr >> 1, e = rr & 1, row = q64 * 64 + e;
        const int t = row % LP;
        int s0, s1, s2;
        if (e == 0) { s0 = q64 * 4 + 2; s1 = (q64 - 1) * 4 + 1; s2 = (q64 - 1) * 4 + 0; } else { s0 = q64 * 4 + 3; s1 = q64 * 4 + 2; s2 = (q64 - 1) * 4 + 1; }
        float uc[2];
#pragma unroll
        for (int bj = 0; bj < 2; ++bj) { const int col = bj * DFF + ch;
            const float u0 = bf2f(HALO[(size_t)s0 * NUP + col]);
            const float u1 = (t >= 1) ? bf2f(HALO[(size_t)s1 * NUP + col]) : 0.f;
            const float u2 = (t >= 2) ? bf2f(HALO[(size_t)s2 * NUP + col]) : 0.f;
            uc[bj] = cw[col] * u2 + cw[NUP + col] * u1 + cw[2 * NUP + col] * u0; }
        ACT[(size_t)row * DFF + ch] = (bf16)f2bf(uc[0] * sigmoidf_(uc[0]) * uc[1]);
    }
}

#define OPQ_S(x) asm volatile("" : "+s"(x))
#define OPQ_V(x) asm volatile("" : "+v"(x))
#define PHASE_BEGIN() do { int t_ = threadIdx.x; OPQ_V(t_); c.tid = t_; c.lane = t_ & 63; c.wave = __builtin_amdgcn_readfirstlane(t_ >> 6); int b_ = blockIdx.x; OPQ_S(b_); c.bid = b_; \
    unsigned char* w_ = P.ws; OPQ_S(w_); c.ws = w_; ws = w_; l = lc; OPQ_S(l); WT = (pg8::bf16_t*)(ws + OFF_WT); HN = (pg8::bf16_t*)(ws + OFF_HN); } while (0)
__global__ void __launch_bounds__(NTHR, 2) mega(Params P) {
    extern __shared__ __attribute__((aligned(16))) unsigned char lds[];
    cg::grid_group grid = cg::this_grid();
    Ctx c; c.G = gridDim.x; c.lds = lds;
    PG8_LAS unsigned char* ldsl = (PG8_LAS unsigned char*)lds;
    unsigned char* ws; pg8::bf16_t* WT; pg8::bf16_t* HN; int l;
#pragma unroll 1
    for (int lc = 0; lc < DEPTH; ++lc) {
        PHASE_BEGIN();
        convert_weights(P, l, c);
        phase_norm<true>(P, l, c);
        grid.sync();
        PHASE_BEGIN();
        phase_fcum(P, c);
        { pg8::Gemm g{HN, WT + WT_IN, M, N1, 1024}; pg8::StaticOrder S; S.init(M, N1, c.G, c.bid);
          pg8::EpiRoute E{ws};
          pg8::gemm_phase<pg8::EpiRoute, pg8::StaticOrder, true, true>(ldsl, g, S, E); }
        grid.sync();
        PHASE_BEGIN();
        phase_qknorm(P, l, c);
        phase_rwkv_prep(P, l, c);
        grid.sync();
        PHASE_BEGIN();
        if (c.bid < 16) scan_chunked(P, c, c.bid); else phase_attn(P, l, c, 16);
        grid.sync();
        PHASE_BEGIN();
        phase_gn(P, l, c);
        grid.sync();
        PHASE_BEGIN();
        { pg8::bf16_t* MG = (pg8::bf16_t*)(ws + OFF_K); const pg8::bf16_t* GT = (const pg8::bf16_t*)(ws + OFF_GT); const float* gb = P.in[21] + l * NGT;
          pg8::StaticOrder S; S.init(M, 1024, c.G, c.bid);
          { pg8::Gemm g{(const pg8::bf16_t*)(ws + OFF_Q), WT + WT_BF, M, 1024, 512}; pg8::EpiGate<0> E{MG, GT, gb};
            pg8::gemm_phase<pg8::EpiGate<0>, pg8::StaticOrder, true, true>(ldsl, g, S, E); }
          __syncthreads();
          PHASE_BEGIN();
          MG = (pg8::bf16_t*)(ws + OFF_K); GT = (const pg8::bf16_t*)(ws + OFF_GT); gb = P.in[21] + l * NGT; S.init(M, 1024, c.G, c.bid);
          { pg8::Gemm g{(const pg8::bf16_t*)(ws + OFF_RW + (size_t)M * 512 * 4), WT + WT_BR, M, 1024, 512}; pg8::EpiGate<1> E{MG, GT, gb};
            pg8::gemm_phase<pg8::EpiGate<1>, pg8::StaticOrder, true, true>(ldsl, g, S, E); } }
        grid.sync();
        PHASE_BEGIN();
        { pg8::Gemm g{(const pg8::bf16_t*)(ws + OFF_K), WT + WT_O, M, 1024, 1024}; pg8::StaticOrder S; S.init(M, 1024, c.G, c.bid);
          pg8::EpiResid E{(float*)(ws + OFF_H), nullptr};
          pg8::gemm_phase<pg8::EpiResid, pg8::StaticOrder, true, true>(ldsl, g, S, E); }
        grid.sync();
        PHASE_BEGIN();
        phase_norm<false>(P, l, c);
        grid.sync();
        PHASE_BEGIN();
        { pg8::Gemm g{HN, WT + WT_UP, M, NUP, 1024}; pg8::StaticOrder S; S.init(M, NUP, c.G, c.bid);
          pg8::EpiUp E{(pg8::bf16_t*)(ws + OFF_RW), (pg8::bf16_t*)(ws + OFF_Q), P.in[24] + (size_t)l * 3 * NUP};
          pg8::gemm_phase<pg8::EpiUp, pg8::StaticOrder, true, true>(ldsl, g, S, E); }
        grid.sync();
        PHASE_BEGIN();
        phase_fixup(P, l, c);
        grid.sync();
        PHASE_BEGIN();
        { pg8::Gemm g{(const pg8::bf16_t*)(ws + OFF_RW), WT + WT_DN, M, 1024, DFF}; pg8::StaticOrder S; S.init(M, 1024, c.G, c.bid);
          pg8::EpiResid E{(float*)(ws + OFF_H), l == DEPTH - 1 ? P.out : nullptr};
          pg8::gemm_phase<pg8::EpiResid, pg8::StaticOrder, true, true>(ldsl, g, S, E); }
        grid.sync();
    }
}

extern "C" void kernel_launch(void* const* d_in, const int* in_sizes, int n_in, void* d_out, int out_size, void* d_ws, size_t ws_size, hipStream_t stream) {
    static int grid = 0;
    if (grid == 0) {
        if (n_in != 26 || out_size != NB * SEQ * DM || ws_size < WS_NEED) { fprintf(stderr, "kernel_launch: unexpected shapes (n_in %d out %d ws %zu need %zu)\n", n_in, out_size, ws_size, (size_t)WS_NEED); grid = -1; return; }
        int dev = 0, cus = 0, per_cu = 0;
        if (hipGetDevice(&dev) != hipSuccess || hipDeviceGetAttribute(&cus, hipDeviceAttributeMultiprocessorCount, dev) != hipSuccess) { grid = -1; return; }
        if (hipFuncSetAttribute((const void*)mega, hipFuncAttributeMaxDynamicSharedMemorySize, LDS_BYTES) != hipSuccess) { fprintf(stderr, "kernel_launch: hipFuncSetAttribute failed\n"); grid = -1; return; }
        if (hipOccupancyMaxActiveBlocksPerMultiprocessor(&per_cu, (const void*)mega, NTHR, LDS_BYTES) != hipSuccess || per_cu < 1) { fprintf(stderr, "kernel_launch: occupancy query says %d\n", per_cu); per_cu = 1; }
        (void)hipGetLastError();
        grid = cus;
    }
    if (grid < 0) return;
    Params p{};
    for (int i = 0; i < 26; ++i) p.in[i] = (const float*)d_in[i];
    p.out = (float*)d_out; p.ws = (unsigned char*)d_ws;
    void* args[] = {&p};
    hipError_t e = hipLaunchCooperativeKernel((const void*)mega, dim3(grid), dim3(NTHR), args, LDS_BYTES, stream);
    if (e != hipSuccess) fprintf(stderr, "kernel_launch: cooperative launch failed: %s (grid %d)\n", hipGetErrorString(e), grid);
}
```

```cpp
#include <hip/hip_runtime.h>
#include <hip/hip_cooperative_groups.h>
#include <cstdio>
#include <cstdint>
#include <cmath>
namespace cg = cooperative_groups;
namespace pg8 {
#define PG8_LAS __attribute__((address_space(3)))
typedef unsigned short bf16_t;
typedef short bf16x8 __attribute__((ext_vector_type(8)));
typedef float f32x4 __attribute__((ext_vector_type(4)));
typedef unsigned u32x4 __attribute__((ext_vector_type(4)));
constexpr int BM = 256, BK = 64, HALF = 128, HTB = HALF * BK * 2  , STAGE_BYTES = 8 * HTB, NXCD = 8, WGM = 8;

__host__ __device__ __forceinline__ int lds_byte(int r, int c) { const int st = (r >> 4) * 2 + (c >> 5), rr = r & 15, cc = c & 31, ob = rr * 64 + cc * 2; return st * 1024 + (ob ^ (((ob >> 9) & 1) << 5)); }
__host__ __device__ __forceinline__ void stage_rc(int b, int& R, int& C) { const int st = b / 1024, sb = b % 1024, swz = sb ^ (((sb >> 9) & 1) << 5); R = (st >> 1) * 16 + swz / 64; C = (st & 1) * 32 + (swz % 64) / 2; }
__host__ __device__ __forceinline__ int perm32(int rho) { const int n = rho >> 4, i = rho & 15; return 8 * (i >> 2) + 4 * n + (i & 3); }

struct Unit { int pm, pn; };
struct Gemm { const bf16_t* A; const bf16_t* Bt; int M, N, K; };

struct StaticOrder {
    int nM, nN, nwg, G, c;
    __host__ __device__ void init(int M, int N, int G_, int c_) { nM = M / BM; nN = N / BM; nwg = nM * nN; G = G_; c = c_; }
    __host__ __device__ bool next(int i, Unit& u) const {
        const long L = (long)i * G + c; if (L >= nwg) return false;
        int wgid = (int)L; { const int q = nwg / NXCD, r = nwg % NXCD, xcd = wgid % NXCD, off = wgid / NXCD; wgid = (xcd < r ? xcd * (q + 1) : r * (q + 1) + (xcd - r) * q) + off; }
        const int nig = WGM * nN, gid = wgid / nig, fm = gid * WGM, gsz = (nM - fm) < WGM ? (nM - fm) : WGM;
        u.pm = fm + ((wgid % nig) % gsz); u.pn = (wgid % nig) / gsz; return true;
    }
    __device__ __forceinline__ void a_ready(const Unit&) const {}
    __device__ __forceinline__ void done(const Unit&) const {}
};

__device__ __forceinline__ unsigned cvt_pk_bf16(float lo, float hi) { unsigned r; asm volatile("v_cvt_pk_bf16_f32 %0, %1, %2" : "=v"(r) : "v"(lo), "v"(hi)); return r; }
typedef float f32x2 __attribute__((ext_vector_type(2)));
template <class Epi, class Sched, bool ALIGN_EPI = false, bool SP2 = false>
__device__ __forceinline__ void gemm_phase(PG8_LAS unsigned char* lds, const Gemm g, const Sched& S, const Epi& E) {
    int tid_ = threadIdx.x; asm volatile("" : "+v"(tid_)); const int tid = tid_, wid = __builtin_amdgcn_readfirstlane(tid >> 6), lane = tid & 63, wr = wid >> 2, wc = wid & 3, fr = lane & 15, fq = lane >> 4;
    const int K = g.K, nt = K / BK;
    unsigned voffA[2], voffB[2];
#pragma unroll
    for (int i = 0; i < 2; ++i) { int R, C; stage_rc(tid * 16 + i * 8192, R, C); const int Rb = Epi::PERM ? ((R & ~31) + perm32(R & 31)) : R;
        voffA[i] = (unsigned)(R * K + C) * 2u; voffB[i] = (unsigned)(Rb * K + C) * 2u; }
    const size_t kstep = (size_t)(BK * 2);
    const size_t hstep = (size_t)HALF * K * 2;
    const size_t tstep = 2 * hstep;
    const unsigned ldsw = (unsigned)wid * 1024u;
    const int aoff = lds_byte(wr * 64 + fr, fq * 8), boff = lds_byte(wc * 32 + fr, fq * 8);
#define PG8_SA(b, h) (((b) * 2 + (h)) * HTB)
#define PG8_SB(b, h) ((4 + (b) * 2 + (h)) * HTB)
#define PG8_STAGE(bufoff, gbase, voff) do { _Pragma("unroll") for (int _i = 0; _i < 2; ++_i) \
        __builtin_amdgcn_global_load_lds((const unsigned*)((const char*)(gbase) + (voff)[_i]), (PG8_LAS unsigned*)(lds + (bufoff) + ldsw + _i * 8192), 16, 0, 0); } while (0)
#define PG8_LDA(dst, b, h) do { _Pragma("unroll") for (int m = 0; m < 4; ++m) _Pragma("unroll") for (int k = 0; k < 2; ++k) dst[m][k] = *(const PG8_LAS bf16x8*)(lds + PG8_SA(b, h) + aoff + m * 2048 + k * 1024); } while (0)
#define PG8_LDB(dst, b, h) do { _Pragma("unroll") for (int n = 0; n < 2; ++n) _Pragma("unroll") for (int k = 0; k < 2; ++k) dst[n][k] = *(const PG8_LAS bf16x8*)(lds + PG8_SB(b, h) + boff + n * 2048 + k * 1024); } while (0)
#define PG8_MMA(ai, bj, At, Bt) do { __builtin_amdgcn_s_setprio(1); _Pragma("unroll") for (int m = 0; m < 4; ++m) _Pragma("unroll") for (int n = 0; n < 2; ++n) _Pragma("unroll") for (int k = 0; k < 2; ++k) \
        acc[ai][bj][m][n] = __builtin_amdgcn_mfma_f32_16x16x32_bf16(Bt[n][k], At[m][k], acc[ai][bj][m][n], 0, 0, 0); __builtin_amdgcn_s_setprio(0); } while (0)
#define PG8_WAIT_V(n) asm volatile("s_waitcnt vmcnt(" #n ")" ::: "memory")
#define PG8_WAIT_L(n) asm volatile("s_waitcnt lgkmcnt(" #n ")" ::: "memory")
#define PG8_BAR __builtin_amdgcn_s_barrier()
#define PG8_SCHED __builtin_amdgcn_sched_barrier(0)
    Unit cur, nxt; int ui = 0;
    if (!S.next(0, cur)) return;
    f32x4 acc[2][2][4][2];
#pragma unroll
    for (int a = 0; a < 2; ++a)
#pragma unroll
        for (int b = 0; b < 2; ++b)
#pragma unroll
            for (int m = 0; m < 4; ++m)
#pragma unroll
                for (int n = 0; n < 2; ++n) acc[a][b][m][n] = (f32x4){0.f, 0.f, 0.f, 0.f};
    bf16x8 At[4][2], B0[2][2], B1[2][2];
    const char* cA = (const char*)g.A + (size_t)cur.pm * tstep; const char* cB = (const char*)g.Bt + (size_t)cur.pn * tstep;
    S.a_ready(cur);
    if constexpr (SP2) {
        PG8_STAGE(PG8_SB(0, 0), cB, voffB); PG8_STAGE(PG8_SB(0, 1), cB + hstep, voffB); PG8_STAGE(PG8_SA(0, 0), cA, voffA); PG8_STAGE(PG8_SA(0, 1), cA + hstep, voffA);
        if (wr == 1) PG8_BAR;
        PG8_WAIT_V(2); PG8_BAR;
        PG8_STAGE(PG8_SB(1, 0), cB + kstep, voffB); PG8_STAGE(PG8_SA(1, 0), cA + kstep, voffA); PG8_STAGE(PG8_SB(1, 1), cB + hstep + kstep, voffB);
        PG8_WAIT_V(6); PG8_BAR;
    } else {
        PG8_STAGE(PG8_SB(0, 0), cB, voffB); PG8_STAGE(PG8_SA(0, 0), cA, voffA); PG8_STAGE(PG8_SB(0, 1), cB + hstep, voffB); PG8_STAGE(PG8_SA(0, 1), cA + hstep, voffA);
        if (wr == 1) PG8_BAR;
        PG8_WAIT_V(4); PG8_BAR;
        PG8_STAGE(PG8_SB(1, 0), cB + kstep, voffB); PG8_STAGE(PG8_SA(1, 0), cA + kstep, voffA); PG8_STAGE(PG8_SB(1, 1), cB + hstep + kstep, voffB);
        PG8_WAIT_V(6); PG8_BAR;
    }
    for (;;) {
        const bool has_next = S.next(ui + 1, nxt);
        const char* nA = has_next ? (const char*)g.A + (size_t)nxt.pm * tstep : cA; const char* nB = has_next ? (const char*)g.Bt + (size_t)nxt.pn * tstep : cB;
        for (int t = 0; t < nt; t += 2) {
            const bool last = (t == nt - 2);
            const char* a1 = cA + (size_t)(t + 1) * kstep;
            const char* a2 = last ? nA : cA + (size_t)(t + 2) * kstep; const char* b2 = last ? nB : cB + (size_t)(t + 2) * kstep;
            const char* a3 = a2 + kstep; const char* b3 = b2 + kstep;
            if (last && has_next) S.a_ready(nxt);
            if constexpr (SP2) {
            PG8_LDB(B0, 0, 0); PG8_LDB(B1, 0, 1); PG8_SCHED; PG8_LDA(At, 0, 0); PG8_STAGE(PG8_SA(1, 1), a1 + hstep, voffA);
            PG8_WAIT_V(8); PG8_WAIT_L(0); PG8_BAR; PG8_MMA(0, 0, At, B0); PG8_MMA(0, 1, At, B1); PG8_BAR; PG8_SCHED;
            PG8_LDA(At, 0, 1); PG8_STAGE(PG8_SB(0, 0), b2, voffB); PG8_STAGE(PG8_SB(0, 1), b2 + hstep, voffB); PG8_STAGE(PG8_SA(0, 0), a2, voffA);
            PG8_WAIT_V(8); PG8_WAIT_L(0); PG8_BAR; PG8_MMA(1, 0, At, B0); PG8_MMA(1, 1, At, B1); PG8_BAR; PG8_SCHED;
            PG8_LDB(B0, 1, 0); PG8_LDB(B1, 1, 1); PG8_SCHED; PG8_LDA(At, 1, 0); PG8_STAGE(PG8_SA(0, 1), a2 + hstep, voffA);
            PG8_WAIT_V(8); PG8_WAIT_L(0); PG8_BAR; PG8_MMA(0, 0, At, B0); PG8_MMA(0, 1, At, B1); PG8_BAR; PG8_SCHED;
            PG8_LDA(At, 1, 1); PG8_STAGE(PG8_SB(1, 0), b3, voffB); PG8_STAGE(PG8_SB(1, 1), b3 + hstep, voffB); PG8_STAGE(PG8_SA(1, 0), a3, voffA);
            PG8_WAIT_V(8); PG8_WAIT_L(0); PG8_BAR; PG8_MMA(1, 0, At, B0); PG8_MMA(1, 1, At, B1); PG8_BAR; PG8_SCHED;
            } else {
            PG8_LDB(B0, 0, 0); PG8_SCHED; PG8_LDA(At, 0, 0); PG8_STAGE(PG8_SA(1, 1), a1 + hstep, voffA);
            PG8_WAIT_L(8); PG8_BAR; PG8_WAIT_L(0); PG8_MMA(0, 0, At, B0); PG8_BAR; PG8_SCHED;
            PG8_LDB(B1, 0, 1); PG8_STAGE(PG8_SB(0, 0), b2, voffB);
            PG8_BAR; PG8_WAIT_L(0); PG8_MMA(0, 1, At, B1); PG8_BAR;
            PG8_LDA(At, 0, 1); PG8_STAGE(PG8_SA(0, 0), a2, voffA);
            PG8_BAR; PG8_WAIT_L(0); PG8_MMA(1, 0, At, B0); PG8_BAR; PG8_SCHED;
            PG8_STAGE(PG8_SB(0, 1), b2 + hstep, voffB);
            PG8_WAIT_V(6); PG8_BAR; PG8_MMA(1, 1, At, B1); PG8_BAR;
            PG8_LDB(B0, 1, 0); PG8_SCHED; PG8_LDA(At, 1, 0); PG8_STAGE(PG8_SA(0, 1), a2 + hstep, voffA);
            PG8_WAIT_L(8); PG8_BAR; PG8_WAIT_L(0); PG8_MMA(0, 0, At, B0); PG8_BAR; PG8_SCHED;
            PG8_LDB(B1, 1, 1); PG8_STAGE(PG8_SB(1, 0), b3, voffB);
            PG8_BAR; PG8_WAIT_L(0); PG8_MMA(0, 1, At, B1); PG8_BAR;
            PG8_LDA(At, 1, 1); PG8_STAGE(PG8_SA(1, 0), a3, voffA);
            PG8_BAR; PG8_WAIT_L(0); PG8_MMA(1, 0, At, B0); PG8_BAR; PG8_SCHED;
            PG8_STAGE(PG8_SB(1, 1), b3 + hstep, voffB);
            PG8_WAIT_V(6); PG8_BAR; PG8_MMA(1, 1, At, B1); PG8_BAR;
            }
        }
        if constexpr (ALIGN_EPI) { if (wr == 0) PG8_BAR; }
        if constexpr (!Epi::AFTER_DRAIN) { E(acc, cur, wr, wc, fr, fq); S.done(cur); }
        if (!has_next) break;
#pragma unroll
        for (int a = 0; a < 2; ++a)
#pragma unroll
            for (int b = 0; b < 2; ++b)
#pragma unroll
                for (int m = 0; m < 4; ++m)
#pragma unroll
                    for (int n = 0; n < 2; ++n) acc[a][b][m][n] = (f32x4){0.f, 0.f, 0.f, 0.f};
        cur = nxt; cA = nA; cB = nB; ++ui;
        if constexpr (ALIGN_EPI) { if (wr == 1) PG8_BAR; }
    }
    PG8_WAIT_V(0);
    if constexpr (!ALIGN_EPI) { if (wr == 0) PG8_BAR; }
    PG8_BAR;
    if constexpr (Epi::AFTER_DRAIN) { E.fused(acc, cur, wr, wc, fr, fq, lds, wid, lane); S.done(cur); }
#undef PG8_SA
#undef PG8_SB
#undef PG8_STAGE
#undef PG8_LDA
#undef PG8_LDB
#undef PG8_MMA
#undef PG8_WAIT_V
#undef PG8_WAIT_L
#undef PG8_BAR
#undef PG8_SCHED
}
}
#define GAS __attribute__((address_space(1)))
#define LAS __attribute__((address_space(3)))
typedef GAS unsigned gu32;
typedef GAS unsigned long long gu64;
#define RLX_AGENT __ATOMIC_RELAXED, __HIP_MEMORY_SCOPE_AGENT
#define LDS_WAIT() asm volatile("s_waitcnt lgkmcnt(0)" ::: "memory")
#define VM_WAIT() asm volatile("s_waitcnt vmcnt(0)" ::: "memory")
__device__ __forceinline__ unsigned long long rt() { return __builtin_amdgcn_s_memrealtime(); }
#define XB_TMO      128
#define XB_XCNT(j)  (256  + 64 * (j))
#define XB_XSUB(j)  (1280 + 64 * (j))
#define XB_XGEN(j)  (2304 + 64 * (j))
#define XB_TOP      3328
#define XB_TOPGEN   3392
#define XCD_BAR_WORDS 3456
#define XB_SPIN_CAP (1u << 18)

__device__ __forceinline__ unsigned xb_ld(unsigned* p)              { return __hip_atomic_load(p, __ATOMIC_RELAXED, __HIP_MEMORY_SCOPE_AGENT); }
__device__ __forceinline__ unsigned xb_add(unsigned* p, unsigned v) { return __hip_atomic_fetch_add(p, v, __ATOMIC_RELAXED, __HIP_MEMORY_SCOPE_AGENT); }
__device__ __forceinline__ unsigned xb_xcc_id() { return (unsigned)__builtin_amdgcn_s_getreg((3 << 11) | 20) & 0xFu; }
#define XB_SPIN(cond, bar) do { unsigned _sp = 0; while (cond) { __builtin_amdgcn_s_sleep(1); \
    if ((++_sp & 255u) == 0u) { if (xb_ld(&(bar)[XB_TMO])) break; if (_sp > XB_SPIN_CAP) { atomicAdd(&(bar)[XB_TMO], 1u); break; } } } } while (0)

struct XcdBarrier {
    unsigned* bar; unsigned x;
    volatile LAS unsigned* st;
};

__device__ __forceinline__ XcdBarrier xcd_barrier_post(unsigned* bar, volatile LAS unsigned* st) {
    XcdBarrier b; b.bar = bar; b.x = xb_xcc_id(); b.st = st;
    if (threadIdx.x == 0) (void)xb_add(&bar[XB_XCNT(b.x)], 1u);
    return b;
}
__device__ __forceinline__ void xcd_barrier_complete(unsigned* bar, unsigned x, unsigned& nloc, unsigned& nx) {
    const unsigned G = gridDim.x * gridDim.y * gridDim.z;
    unsigned sum, cnt, mine, sp = 0u;
    for (;;) {
        sum = 0u; cnt = 0u; mine = 0u;
#pragma unroll
        for (unsigned j = 0; j < 16; ++j) { const unsigned c = xb_ld(&bar[XB_XCNT(j)]); sum += c; cnt += (c > 0u) ? 1u : 0u; mine = (j == x) ? c : mine; }
        if (sum == G) break;
        __builtin_amdgcn_s_sleep(1);
        if ((++sp & 255u) == 0u) { if (xb_ld(&bar[XB_TMO])) break; if (sp > XB_SPIN_CAP) { atomicAdd(&bar[XB_TMO], 1u); break; } }
    }
    nloc = mine > 0u ? mine : 1u; nx = cnt > 0u ? cnt : 1u;
}

__device__ __forceinline__ void xcd_barrier(const XcdBarrier& b) {
    asm volatile("s_waitcnt vmcnt(0)" ::: "memory");
    __syncthreads();
    if (threadIdx.x == 0) {
        unsigned* bar = b.bar;
        __builtin_amdgcn_s_waitcnt(0);
        unsigned nloc = b.st[0], nx = b.st[1];
        if (nloc == 0u) { xcd_barrier_complete(bar, b.x, nloc, nx); b.st[0] = nloc; b.st[1] = nx; }
        const unsigned old = xb_add(&bar[XB_XSUB(b.x)], 1u);
        const unsigned gen = old / nloc;
        if (old + 1u == (gen + 1u) * nloc) {
            __builtin_amdgcn_fence(__ATOMIC_RELEASE, "agent");
            asm volatile("s_waitcnt vmcnt(0)" ::: "memory");
            const unsigned og = xb_add(&bar[XB_TOP], 1u);
            const unsigned tg = og / nx;
            if (og + 1u == (tg + 1u) * nx) xb_add(&bar[XB_TOPGEN], 1u);
            else XB_SPIN(xb_ld(&bar[XB_TOPGEN]) == tg, bar);
            __builtin_amdgcn_fence(__ATOMIC_ACQUIRE, "agent");
            xb_add(&bar[XB_XGEN(b.x)], 1u);
            asm volatile("s_waitcnt vmcnt(0)" ::: "memory");
        } else {
            XB_SPIN(xb_ld(&bar[XB_XGEN(b.x)]) == gen, bar);
            __builtin_amdgcn_fence(__ATOMIC_ACQUIRE, "agent");
            asm volatile("s_waitcnt vmcnt(0)" ::: "memory");
        }
    }
    __syncthreads();
}


constexpr int NB = 2, SEQ = 8192, DM = 1024, DEPTH = 4, NMETA = 16, LP = 8320, M = NB * LP;
constexpr int N_IN = 5384, N1 = 5376, NRW = 1792, NGT = 2048, DFF = 2816, NUP = 5632;
constexpr float LOG2E = 1.4426950408889634f;
constexpr float QSCALE = 0.125f * LOG2E;
constexpr float THR2 = 30.0f * LOG2E;
constexpr int NWAVES = 8, NTHR = 512;
constexpr int LDS_BYTES = 147456, MISC_OFF = 147456 - 128;

typedef unsigned short bf16;
typedef float f32x4 __attribute__((ext_vector_type(4)));
typedef unsigned u32x4 __attribute__((ext_vector_type(4)));
typedef unsigned u32x2 __attribute__((ext_vector_type(2)));
typedef short bf16x8 __attribute__((ext_vector_type(8)));

constexpr size_t SZ_H = (size_t)M * DM * 4, SZ_X512 = (size_t)M * 512 * 2;
constexpr size_t OFF_CTL = 0, OFF_H = 1u << 20, OFF_WT = OFF_H + SZ_H;
constexpr size_t WT_IN = 0, WT_BF = WT_IN + (size_t)N1 * 1024, WT_BR = WT_BF + 1024 * 512, WT_O = WT_BR + 1024 * 512,
                 WT_UP = WT_O + 1024 * 1024, WT_DN = WT_UP + (size_t)NUP * 1024, WT_LW = WT_DN + (size_t)1024 * DFF, WT_LA = WT_LW + 512 * 64, WT_LG = WT_LA + 512 * 64, WT_END = WT_LG + 512 * 128;
constexpr size_t OFF_HN = OFF_WT + WT_END * 2;
constexpr size_t OFF_Q = OFF_HN + 2 * SZ_X512, OFF_K = OFF_Q + SZ_X512, OFF_V = OFF_K + SZ_X512;
constexpr size_t OFF_RW = OFF_V + SZ_X512, OFF_GT = OFF_RW + (size_t)M * NRW * 2, OFF_MISC = OFF_GT + (size_t)M * NGT * 2;
constexpr size_t OFF_T0 = OFF_MISC + 2 * 16 * LP * 4, OFF_OF = OFF_T0 + 2 * SZ_X512, WS_NEED = OFF_OF + SZ_X512;
static_assert(OFF_HN % 256 == 0 && OFF_RW % 256 == 0 && OFF_T0 % 256 == 0, "alignment");

struct Params { const float* in[26]; float* out; unsigned char* ws; };
struct Ctx { int tid, lane, wave, bid, G; unsigned char* lds; unsigned char* ws; };

__device__ __forceinline__ float bf2f(unsigned b) { return __uint_as_float(b << 16); }
__device__ __forceinline__ float bflo(unsigned w) { return __uint_as_float(w << 16); }
__device__ __forceinline__ float bfhi(unsigned w) { return __uint_as_float(w & 0xffff0000u); }
__device__ __forceinline__ unsigned f2bf(float f) { unsigned u = __float_as_uint(f); return (u + 0x7fffu + ((u >> 16) & 1u)) >> 16; }
__device__ __forceinline__ unsigned pk2(float lo, float hi) { return f2bf(lo) | (f2bf(hi) << 16); }
__device__ __forceinline__ float wave_sum(float v) {
#pragma unroll
    for (int o = 1; o < 64; o <<= 1) v += __shfl_xor(v, o);
    return v;
}
__device__ __forceinline__ float sigmoidf_(float x) { return 1.f / (1.f + __expf(-x)); }
template <int CTRL> __device__ __forceinline__ float dppf(float old, float x) {
    return __int_as_float(__builtin_amdgcn_update_dpp(__float_as_int(old), __float_as_int(x), CTRL, 0xf, 0xf, false));
}
__device__ __forceinline__ float allreduce16(float x) {
    x += dppf<0x121>(0.f, x); x += dppf<0x122>(0.f, x); x += dppf<0x124>(0.f, x); x += dppf<0x128>(0.f, x); return x;
}

namespace pg8 {
struct EpiRoute {
    static constexpr bool PERM = true, AFTER_DRAIN = false;
    unsigned char* ws;
    __device__ __forceinline__ void operator()(const f32x4 (&acc)[2][2][4][2], const Unit& u, int wr, int wc, int fr, int fq) const {
        const int pn = u.pn; size_t off; int ldc, colt;
        if (pn < 6) { off = OFF_Q + (size_t)(pn >> 1) * SZ_X512; ldc = 512; colt = (pn & 1) * 256; }
        else if (pn < 13) { off = OFF_RW; ldc = NRW; colt = (pn - 6) * 256; }
        else { off = OFF_GT; ldc = NGT; colt = (pn - 13) * 256; }
        bf16_t* base = (bf16_t*)(ws + off);
        const int row0 = u.pm * BM + wr * 64 + fr, col0 = colt + wc * 32 + 8 * fq;
#pragma unroll
        for (int ai = 0; ai < 2; ++ai)
#pragma unroll
            for (int m = 0; m < 4; ++m) { bf16_t* rowp = base + (size_t)(row0 + ai * HALF + m * 16) * ldc + col0;
#pragma unroll
                for (int bj = 0; bj < 2; ++bj) { const f32x4 v0 = acc[ai][bj][m][0], v1 = acc[ai][bj][m][1];
                    u32x4 w; w.x = cvt_pk_bf16(v0[0], v0[1]); w.y = cvt_pk_bf16(v0[2], v0[3]); w.z = cvt_pk_bf16(v1[0], v1[1]); w.w = cvt_pk_bf16(v1[2], v1[3]);
                    *(u32x4*)(rowp + bj * HALF) = w; } }
    }
};
template <int MODE> struct EpiGate {
    static constexpr bool PERM = true, AFTER_DRAIN = false;
    bf16_t* O; const bf16_t* GT; const float* gb;
    __device__ __forceinline__ void operator()(const f32x4 (&acc)[2][2][4][2], const Unit& u, int wr, int wc, int fr, int fq) const {
        const int row0 = u.pm * BM + wr * 64 + fr, col0 = u.pn * BM + wc * 32 + 8 * fq;
#pragma unroll
        for (int bj = 0; bj < 2; ++bj) {
            const int c = col0 + bj * HALF;
            const f32x4 b0 = *(const f32x4*)(gb + MODE * 1024 + c), b1 = *(const f32x4*)(gb + MODE * 1024 + c + 4);
#pragma unroll
            for (int ai = 0; ai < 2; ++ai)
#pragma unroll
                for (int m = 0; m < 4; ++m) {
                    const size_t row = (size_t)(row0 + ai * HALF + m * 16);
                    const u32x4 gw = *(const u32x4*)(GT + row * NGT + MODE * 1024 + c);
                    const f32x4 v0 = acc[ai][bj][m][0], v1 = acc[ai][bj][m][1];
                    float r[8];
                    r[0] = sigmoidf_(bflo(gw.x) + b0[0]) * v0[0]; r[1] = sigmoidf_(bfhi(gw.x) + b0[1]) * v0[1];
                    r[2] = sigmoidf_(bflo(gw.y) + b0[2]) * v0[2]; r[3] = sigmoidf_(bfhi(gw.y) + b0[3]) * v0[3];
                    r[4] = sigmoidf_(bflo(gw.z) + b1[0]) * v1[0]; r[5] = sigmoidf_(bfhi(gw.z) + b1[1]) * v1[1];
                    r[6] = sigmoidf_(bflo(gw.w) + b1[2]) * v1[2]; r[7] = sigmoidf_(bfhi(gw.w) + b1[3]) * v1[3];
                    bf16_t* op = O + row * 1024 + c;
                    if (MODE == 1) { const u32x4 ow = *(const u32x4*)op;
                        r[0] += bflo(ow.x); r[1] += bfhi(ow.x); r[2] += bflo(ow.y); r[3] += bfhi(ow.y); r[4] += bflo(ow.z); r[5] += bfhi(ow.z); r[6] += bflo(ow.w); r[7] += bfhi(ow.w); }
                    u32x4 w; w.x = cvt_pk_bf16(r[0], r[1]); w.y = cvt_pk_bf16(r[2], r[3]); w.z = cvt_pk_bf16(r[4], r[5]); w.w = cvt_pk_bf16(r[6], r[7]);
                    *(u32x4*)op = w;
                }
        }
    }
};
struct EpiResid {
    static constexpr bool PERM = false, AFTER_DRAIN = false;
    float* H; float* OUT;
    __device__ __forceinline__ void operator()(const f32x4 (&acc)[2][2][4][2], const Unit& u, int wr, int wc, int fr, int fq) const {
        const int row0 = u.pm * BM + wr * 64 + fr, col0 = u.pn * BM + wc * 32 + 4 * fq;
#pragma unroll
        for (int ai = 0; ai < 2; ++ai)
#pragma unroll
            for (int m = 0; m < 4; ++m) {
                const int row = row0 + ai * HALF + m * 16;
                float* hp = H + (size_t)row * DM + col0;
                const int b = row >= LP ? 1 : 0, t = row - b * LP;
                float* op = (OUT && t >= NMETA && t < NMETA + SEQ) ? OUT + ((size_t)b * SEQ + (t - NMETA)) * DM + col0 : nullptr;
#pragma unroll
                for (int bj = 0; bj < 2; ++bj)
#pragma unroll
                    for (int n = 0; n < 2; ++n) { const int co = bj * HALF + n * 16;
                        const f32x4 v = *(const f32x4*)(hp + co) + acc[ai][bj][m][n];
                        if (OUT) { if (op) *(f32x4*)(op + co) = v; } else *(f32x4*)(hp + co) = v; }
            }
    }
};
struct EpiUp {
    static constexpr bool PERM = true, AFTER_DRAIN = false;
    bf16_t* ACT; bf16_t* HALO; const float* cw;
    __device__ __forceinline__ void operator()(const f32x4 (&acc)[2][2][4][2], const Unit& u, int wr, int wc, int fr, int fq) const {
        const int chan0 = u.pn * 128 + wc * 32 + 8 * fq;
#pragma unroll
        for (int n = 0; n < 2; ++n) {
            const int ch = chan0 + 4 * n;
            f32x4 w[3][2];
#pragma unroll
            for (int j = 0; j < 3; ++j) { w[j][0] = *(const f32x4*)(cw + j * NUP + ch); w[j][1] = *(const f32x4*)(cw + j * NUP + DFF + ch); }
#pragma unroll
            for (int ai = 0; ai < 2; ++ai) {
                const int rowg = u.pm * BM + ai * HALF + wr * 64;
#pragma unroll
                for (int m = 0; m < 4; ++m) {
                    f32x4 uc[2];
#pragma unroll
                    for (int bj = 0; bj < 2; ++bj) {
                        const f32x4 cur = acc[ai][bj][m][n];
                        f32x4 prv; if (m > 0) prv = acc[ai][bj][m - 1][n]; else prv = (f32x4){0.f, 0.f, 0.f, 0.f};
                        f32x4 p1, p2;
#pragma unroll
                        for (int i = 0; i < 4; ++i) {
                            const float r1 = dppf<0x121>(0.f, prv[i]), r2 = dppf<0x122>(0.f, prv[i]);
                            p1[i] = dppf<0x111>(r1, cur[i]); p2[i] = dppf<0x112>(r2, cur[i]);
                        }
                        uc[bj] = w[0][bj] * p2 + w[1][bj] * p1 + w[2][bj] * cur;
                    }
                    float a[4];
#pragma unroll
                    for (int i = 0; i < 4; ++i) a[i] = uc[0][i] * sigmoidf_(uc[0][i]) * uc[1][i];
                    u32x2 o; o.x = cvt_pk_bf16(a[0], a[1]); o.y = cvt_pk_bf16(a[2], a[3]);
                    *(u32x2*)(ACT + (size_t)(rowg + m * 16 + fr) * DFF + ch) = o;
                    if ((m == 3 && fr >= 14) || (m == 0 && fr < 2)) {
                        const int slot = (rowg >> 6) * 4 + (m == 3 ? fr - 14 : 2 + fr);
#pragma unroll
                        for (int bj = 0; bj < 2; ++bj) { const f32x4 cur = acc[ai][bj][m][n]; u32x2 hw; hw.x = cvt_pk_bf16(cur[0], cur[1]); hw.y = cvt_pk_bf16(cur[2], cur[3]);
                            *(u32x2*)(HALO + (size_t)slot * NUP + bj * DFF + ch) = hw; }
                    }
                }
            }
        }
    }
};
}

#ifndef REP_PREP
#define REP_PREP 1
#endif
#ifndef REP_P3
#define REP_P3 1
#endif
#ifndef REP_SYNC
#define REP_SYNC 0
#endif
__device__ __forceinline__ void transpose_item(const float* W, int Nsrc, int K, bf16* WT, int dst_row0, int src_col0, int k0, float* scr, int lane) {
#pragma unroll 8
    for (int i = 0; i < 32; ++i) { const int kk = 2 * i + (lane >> 5); scr[kk * 33 + (lane & 31)] = W[(size_t)(k0 + kk) * Nsrc + src_col0 + (lane & 31)]; }
    asm volatile("s_waitcnt lgkmcnt(0)" ::: "memory");
    const int c = lane & 7;
#pragma unroll
    for (int j = 0; j < 4; ++j) { const int n = (lane >> 3) + 8 * j; const float* s = scr + (8 * c) * 33 + n;
        u32x4 o; o.x = pk2(s[0 * 33], s[1 * 33]); o.y = pk2(s[2 * 33], s[3 * 33]); o.z = pk2(s[4 * 33], s[5 * 33]); o.w = pk2(s[6 * 33], s[7 * 33]);
        *(u32x4*)(WT + (size_t)(dst_row0 + n) * K + k0 + 8 * c) = o; }
    asm volatile("s_waitcnt lgkmcnt(0)" ::: "memory");
}
__device__ __forceinline__ void convert_weights(const Params& P, int l, const Ctx& c) {
    bf16* WT = (bf16*)(c.ws + OFF_WT);
    float* scr = (float*)(c.lds + c.wave * 16384);
    const int gw = c.bid * NWAVES + c.wave, NGW = c.G * NWAVES;
    constexpr int I_IN = 16 * 168, I_BF = 8 * 32, I_O = 16 * 32, I_UP = 16 * 176, I_DN = 44 * 32, I_LR = 16, I_LG = 32, I_ALL = I_IN + 2 * I_BF + I_O + I_UP + I_DN + 2 * I_LR + I_LG;
    for (int it = gw; it < I_ALL; it += NGW) {
        int r = it;
        if (r < I_IN) { const int kb = r / 168, n0 = 32 * (r % 168); transpose_item(P.in[4] + (size_t)l * 1024 * N_IN, N_IN, 1024, WT + WT_IN, n0, n0 + (n0 >= 1536 ? 8 : 0), 64 * kb, scr, c.lane); continue; } r -= I_IN;
        if (r < I_BF) { const int kb = r / 32, n0 = 32 * (r % 32); transpose_item(P.in[19] + (size_t)l * 512 * 1024, 1024, 512, WT + WT_BF, n0, n0, 64 * kb, scr, c.lane); continue; } r -= I_BF;
        if (r < I_BF) { const int kb = r / 32, n0 = 32 * (r % 32); transpose_item(P.in[20] + (size_t)l * 512 * 1024, 1024, 512, WT + WT_BR, n0, n0, 64 * kb, scr, c.lane); continue; } r -= I_BF;
        if (r < I_O) { const int kb = r / 32, n0 = 32 * (r % 32); transpose_item(P.in[22] + (size_t)l * 1024 * 1024, 1024, 1024, WT + WT_O, n0, n0, 64 * kb, scr, c.lane); continue; } r -= I_O;
        if (r < I_UP) { const int kb = r / 176, n0 = 32 * (r % 176); const int pn = n0 >> 8, bj = (n0 >> 7) & 1, x = n0 & 127;
            transpose_item(P.in[23] + (size_t)l * 1024 * NUP, NUP, 1024, WT + WT_UP, n0, bj * DFF + 128 * pn + x, 64 * kb, scr, c.lane); continue; } r -= I_UP;
        if (r < I_DN) { const int kb = r / 32, n0 = 32 * (r % 32); transpose_item(P.in[25] + (size_t)l * DFF * 1024, 1024, DFF, WT + WT_DN, n0, n0, 64 * kb, scr, c.lane); continue; } r -= I_DN;
        if (r < I_LR) { transpose_item(P.in[10] + (size_t)l * 64 * 512, 512, 64, WT + WT_LW, 32 * r, 32 * r, 0, scr, c.lane); continue; } r -= I_LR;
        if (r < I_LR) { transpose_item(P.in[12] + (size_t)l * 64 * 512, 512, 64, WT + WT_LA, 32 * r, 32 * r, 0, scr, c.lane); continue; } r -= I_LR;
        { const int kb = r / 16, n0 = 32 * (r % 16); transpose_item(P.in[13] + (size_t)l * 128 * 512, 512, 128, WT + WT_LG, n0, n0, 64 * kb, scr, c.lane); }
    }
}

template <bool FG> __device__ __forceinline__ void phase_norm(const Params& P, int l, const Ctx& c) {
    float* H = (float*)(c.ws + OFF_H); bf16* HN = (bf16*)(c.ws + OFF_HN);
    float* LOGF = (float*)(c.ws + OFF_MISC);
    const float* gain = (FG ? P.in[2] : P.in[3]) + l * DM;
    float* wfs = (float*)c.lds;
    if (FG) {
        __syncthreads();
        const float* win = P.in[4] + (size_t)l * 1024 * N_IN + 1536;
        for (int i = c.tid; i < 8192; i += NTHR) wfs[i] = win[(size_t)(i >> 3) * N_IN + (i & 7)];
        __syncthreads();
    }
    const int gw = c.bid * NWAVES + c.wave, NGW = c.G * NWAVES;
    for (int m = gw; m < M; m += NGW) {
        const int b = m >= LP ? 1 : 0, t = m - b * LP;
        f32x4 v[4];
        if (FG && l == 0) {
            const float* src = (t < NMETA) ? P.in[1] + (size_t)t * DM : P.in[0] + ((size_t)b * SEQ + (t - NMETA)) * DM;
            const bool real = t < NMETA + SEQ;
#pragma unroll
            for (int j = 0; j < 4; ++j) { v[j] = real ? *(const f32x4*)(src + 4 * c.lane + 256 * j) : (f32x4){0.f, 0.f, 0.f, 0.f}; *(f32x4*)(H + (size_t)m * DM + 4 * c.lane + 256 * j) = v[j]; }
        } else {
#pragma unroll
            for (int j = 0; j < 4; ++j) v[j] = *(const f32x4*)(H + (size_t)m * DM + 4 * c.lane + 256 * j);
        }
        float ss = 0.f;
#pragma unroll
        for (int j = 0; j < 4; ++j) ss += (v[j].x * v[j].x + v[j].y * v[j].y) + (v[j].z * v[j].z + v[j].w * v[j].w);
        const float rstd = 1.0f / sqrtf(wave_sum(ss) * (1.f / DM) + 1e-6f);
        float f[8];
#pragma unroll
        for (int q = 0; q < 8; ++q) f[q] = 0.f;
#pragma unroll
        for (int j = 0; j < 4; ++j) {
            const f32x4 g = *(const f32x4*)(gain + 4 * c.lane + 256 * j);
            v[j] = v[j] * rstd * g;
            u32x2 o; o.x = pk2(v[j].x, v[j].y); o.y = pk2(v[j].z, v[j].w);
            *(u32x2*)(HN + (size_t)m * DM + 4 * c.lane + 256 * j) = o;
            if (FG) {
#pragma unroll
                for (int e = 0; e < 4; ++e) { const int k = 4 * c.lane + 256 * j + e; const f32x4 w0 = *(const f32x4*)(wfs + k * 8), w1 = *(const f32x4*)(wfs + k * 8 + 4);
                    const float hv = v[j][e];
                    f[0] += hv * w0.x; f[1] += hv * w0.y; f[2] += hv * w0.z; f[3] += hv * w0.w; f[4] += hv * w1.x; f[5] += hv * w1.y; f[6] += hv * w1.z; f[7] += hv * w1.w; }
            }
        }
        if (FG) {
#pragma unroll
            for (int q = 0; q < 8; ++q) f[q] = wave_sum(f[q]);
            float fv = f[0];
#pragma unroll
            for (int q = 1; q < 8; ++q) fv = (c.lane == q) ? f[q] : fv;
            if (c.lane < 8) { const float x = fv + P.in[7][l * 8 + c.lane]; const float ls = fminf(x, 0.f) - log1pf(expf(-fabsf(x))); LOGF[(size_t)(b * 8 + c.lane) * LP + t] = ls; }
        }
    }
}

__device__ __forceinline__ void phase_fcum(const Params& P, const Ctx& c) {
    if (c.bid < 16 && c.wave == 0) {
        const float* LOGF = (const float*)(c.ws + OFF_MISC) + (size_t)c.bid * LP; float* FC = (float*)(c.ws + OFF_MISC) + 16 * LP + (size_t)c.bid * LP;
        float carry = 0.f;
        for (int ch = 0; ch < LP / 64; ++ch) {
            float v = LOGF[ch * 64 + c.lane];
#pragma unroll
            for (int o = 1; o < 64; o <<= 1) { const float t = __shfl_up(v, o); if (c.lane >= o) v += t; }
            v += carry; FC[ch * 64 + c.lane] = v * LOG2E; carry = __shfl(v, 63);
        }
    }
}

__device__ __forceinline__ void phase_qknorm(const Params& P, int l, const Ctx& c) {
    bf16* Q = (bf16*)(c.ws + OFF_Q); bf16* K = (bf16*)(c.ws + OFF_K);
    const int gw = c.bid * NWAVES + c.wave, NGW = c.G * NWAVES;
    const int d0 = (c.lane & 7) * 8;
    float gq[8], gk[8];
#pragma unroll
    for (int i = 0; i < 8; ++i) { gq[i] = P.in[5][l * 64 + d0 + i] * QSCALE; gk[i] = P.in[6][l * 64 + d0 + i]; }
    for (int m = gw; m < M; m += NGW) {
#pragma unroll
        for (int which = 0; which < 2; ++which) {
            bf16* p = (which ? K : Q) + (size_t)m * 512 + 8 * c.lane;
            const u32x4 w = *(const u32x4*)p;
            float x[8] = {bflo(w.x), bfhi(w.x), bflo(w.y), bfhi(w.y), bflo(w.z), bfhi(w.z), bflo(w.w), bfhi(w.w)};
            float ss = 0.f;
#pragma unroll
            for (int i = 0; i < 8; ++i) ss += x[i] * x[i];
            ss += __shfl_xor(ss, 1); ss += __shfl_xor(ss, 2); ss += __shfl_xor(ss, 4);
            const float rs = 1.0f / sqrtf(ss * (1.f / 64.f) + 1e-6f);
#pragma unroll
            for (int i = 0; i < 8; ++i) x[i] = x[i] * rs * (which ? gk[i] : gq[i]);
            u32x4 o; o.x = pk2(x[0], x[1]); o.y = pk2(x[2], x[3]); o.z = pk2(x[4], x[5]); o.w = pk2(x[6], x[7]);
            *(u32x4*)p = o;
        }
    }
}

constexpr int NCHK = LP / 64;
constexpr int NUNIT = NB * NCHK * 8;
constexpr int UNIT_A = 16384, UNIT_B = 16640;
constexpr int ST = 72, STG = 136;
constexpr int L_F0 = 92160, L_F1 = 108544;
struct RwkvBufs { bf16 *BON, *G; unsigned char *UA, *UB; float* Y; bf16* ORW; };
__device__ __forceinline__ RwkvBufs rwkv_bufs(const Params& P, const Ctx& c) {
    RwkvBufs r; r.BON = (bf16*)(c.ws + OFF_HN); r.G = r.BON + (size_t)M * 512;
    r.UA = c.ws + OFF_T0; r.UB = (unsigned char*)P.out;
    r.Y = (float*)(c.ws + OFF_RW); r.ORW = (bf16*)(c.ws + OFF_RW + (size_t)M * 512 * 4);
    return r;
}
__device__ __forceinline__ void mm_tile(const bf16* A, int sa, const bf16* Bt, int sb, int nks, f32x4 (&acc)[2], int w, int lq, int g) {
    const int mt = w >> 1, nt0 = 2 * (w & 1);
    for (int ks = 0; ks < nks; ++ks) {
        const bf16x8 a = *(const bf16x8*)(A + (16 * mt + lq) * sa + 32 * ks + 8 * g);
#pragma unroll
        for (int q = 0; q < 2; ++q) { const bf16x8 b = *(const bf16x8*)(Bt + (16 * (nt0 + q) + lq) * sb + 32 * ks + 8 * g); acc[q] = __builtin_amdgcn_mfma_f32_16x16x32_bf16(a, b, acc[q], 0, 0, 0); }
    }
}
#define ZACC(a) do { a[0] = (f32x4){0.f, 0.f, 0.f, 0.f}; a[1] = (f32x4){0.f, 0.f, 0.f, 0.f}; } while (0)
__device__ __forceinline__ int permk(int k) { return 32 * (k >> 5) + 8 * ((k & 15) >> 2) + 4 * ((k >> 4) & 1) + (k & 3); }
__device__ __forceinline__ int swz(int row, int col) { return row * 128 + ((((col >> 3) ^ (row >> 1)) & 7) << 4) + (col & 7) * 2; }

__device__ __forceinline__ void rwkv_prep_unit(const Params& P, int l, const Ctx& c, int u, const RwkvBufs& B) {
    const int h = u & 7, bc = u >> 3, b = bc / NCHK, ch = bc - b * NCHK;
    const size_t m0 = (size_t)b * LP + ch * 64;
    int tid_ = c.tid; asm volatile("" : "+v"(tid_));
    const int tid = tid_, lane = tid & 63, w = c.wave, lq = lane & 15, g = lane >> 4;
    const int t = tid >> 3, cg = tid & 7, c0 = cg * 8, jb = h * 64 + c0;
    unsigned char* L = c.lds;
    bf16* A0 = (bf16*)L; bf16* A1 = A0 + 4608; bf16* A2 = A1 + 4608; bf16* A3 = A2 + 4608; bf16* A4 = A3 + 4608; bf16* A5 = A4 + 4608; bf16* A6 = A5 + 4608;
    bf16* A7 = A6 + 4608; bf16* A8 = A7 + 4608; bf16* A9 = A8 + 4608;
    float* F0 = (float*)(L + L_F0); float* F1 = (float*)(L + L_F1);
    const bf16* RW = (const bf16*)(c.ws + OFF_RW);
    const bf16* WT = (const bf16*)(c.ws + OFF_WT);
    const float* mu = P.in[8] + l * NRW;
    const bool first = (ch == 0 && t == 0);
    const bf16* cur = RW + (m0 + t) * NRW; const bf16* prv = cur - NRW;
    float zr[8], zk[8], zv[8];
#pragma unroll
    for (int s = 0; s < 3; ++s) {
        const u32x4 cw = *(const u32x4*)(cur + s * 512 + jb); u32x4 pw = (u32x4){0u, 0u, 0u, 0u}; if (!first) pw = *(const u32x4*)(prv + s * 512 + jb);
        const float cv[8] = {bflo(cw.x), bfhi(cw.x), bflo(cw.y), bfhi(cw.y), bflo(cw.z), bfhi(cw.z), bflo(cw.w), bfhi(cw.w)};
        const float pv[8] = {bflo(pw.x), bfhi(pw.x), bflo(pw.y), bfhi(pw.y), bflo(pw.z), bfhi(pw.z), bflo(pw.w), bfhi(pw.w)};
#pragma unroll
        for (int i = 0; i < 8; ++i) { const float z = cv[i] + mu[s * 512 + jb + i] * (pv[i] - cv[i]); if (s == 0) zr[i] = z; else if (s == 1) zk[i] = z; else zv[i] = z; }
    }
#pragma unroll
    for (int q4 = 0; q4 < 4; ++q4) {
        const int col = cg * 32 + q4 * 8;
        const u32x4 cw = *(const u32x4*)(cur + 1536 + col); u32x4 pw = (u32x4){0u, 0u, 0u, 0u}; if (!first) pw = *(const u32x4*)(prv + 1536 + col);
        const float cv[8] = {bflo(cw.x), bfhi(cw.x), bflo(cw.y), bfhi(cw.y), bflo(cw.z), bfhi(cw.z), bflo(cw.w), bfhi(cw.w)};
        const float pv[8] = {bflo(pw.x), bfhi(pw.x), bflo(pw.y), bfhi(pw.y), bflo(pw.z), bfhi(pw.z), bflo(pw.w), bfhi(pw.w)};
        float z[8];
#pragma unroll
        for (int i = 0; i < 8; ++i) { z[i] = cv[i] + mu[1536 + col + i] * (pv[i] - cv[i]); if (col < 64) z[i] = tanhf(z[i]); else if (col >= 128) z[i] = sigmoidf_(z[i]); }
        u32x4 o; o.x = pk2(z[0], z[1]); o.y = pk2(z[2], z[3]); o.z = pk2(z[4], z[5]); o.w = pk2(z[6], z[7]);
        bf16* dst = (col < 64) ? A0 + t * ST + col : (col < 128 ? A1 + t * ST + (col - 64) : A2 + t * STG + (col - 128));
        *(u32x4*)dst = o;
    }
    { const int row = tid >> 3, chk = tid & 7;
      *(u32x4*)(A4 + row * ST + chk * 8) = *(const u32x4*)(WT + WT_LW + (size_t)(h * 64 + row) * 64 + chk * 8);
      *(u32x4*)(A5 + row * ST + chk * 8) = *(const u32x4*)(WT + WT_LA + (size_t)(h * 64 + row) * 64 + chk * 8);
#pragma unroll
      for (int i = 0; i < 2; ++i) { const int idx = tid + 512 * i, r2 = idx >> 4, c2 = idx & 15;
          *(u32x4*)((bf16*)F1 + r2 * STG + c2 * 8) = *(const u32x4*)(WT + WT_LG + (size_t)(h * 64 + r2) * 128 + c2 * 8); } }
    __syncthreads();
    { f32x4 aw[2], aa[2], ag[2]; ZACC(aw); ZACC(aa); ZACC(ag);
      mm_tile(A0, ST, A4, ST, 2, aw, w, lq, g); mm_tile(A1, ST, A5, ST, 2, aa, w, lq, g); mm_tile(A2, STG, (const bf16*)F1, STG, 4, ag, w, lq, g);
      const int mt = w >> 1, nt0 = 2 * (w & 1);
#pragma unroll
      for (int q = 0; q < 2; ++q)
#pragma unroll
          for (int j = 0; j < 4; ++j) { const int o = (16 * mt + 4 * g + j) * ST + 16 * (nt0 + q) + lq; A7[o] = (bf16)f2bf(aw[q][j]); A8[o] = (bf16)f2bf(aa[q][j]); A9[o] = (bf16)f2bf(ag[q][j]); } }
    __syncthreads();
    float kk[8], k2[8], ar[8];
    { const u32x4 lw = *(const u32x4*)(A7 + t * ST + c0), la = *(const u32x4*)(A8 + t * ST + c0), lg = *(const u32x4*)(A9 + t * ST + c0);
      const float fw[8] = {bflo(lw.x), bfhi(lw.x), bflo(lw.y), bfhi(lw.y), bflo(lw.z), bfhi(lw.z), bflo(lw.w), bfhi(lw.w)};
      const float fa[8] = {bflo(la.x), bfhi(la.x), bflo(la.y), bfhi(la.y), bflo(la.z), bfhi(la.z), bflo(la.w), bfhi(la.w)};
      float ss = 0.f, bs = 0.f;
#pragma unroll
      for (int i = 0; i < 8; ++i) { const int j = l * 512 + jb + i;
          const float xw = -(P.in[9][j] + fw[i]); const float sp = fmaxf(xw, 0.f) + log1pf(expf(-fabsf(xw)));
          F0[t * 64 + c0 + i] = expf(-sp - 0.5f);
          ar[i] = sigmoidf_(P.in[11][j] + fa[i]);
          kk[i] = zk[i] * P.in[14][j]; ss += kk[i] * kk[i];
          k2[i] = zk[i] * (1.f + (ar[i] - 1.f) * P.in[15][j]);
          bs += zr[i] * k2[i] * P.in[16][j]; }
      ss += __shfl_xor(ss, 1); ss += __shfl_xor(ss, 2); ss += __shfl_xor(ss, 4);
      bs += __shfl_xor(bs, 1); bs += __shfl_xor(bs, 2); bs += __shfl_xor(bs, 4);
      const float inv = 1.0f / fmaxf(sqrtf(ss), 1e-12f);
#pragma unroll
      for (int i = 0; i < 8; ++i) kk[i] *= inv;
      u32x4 bo; bo.x = pk2(bs * zv[0], bs * zv[1]); bo.y = pk2(bs * zv[2], bs * zv[3]); bo.z = pk2(bs * zv[4], bs * zv[5]); bo.w = pk2(bs * zv[6], bs * zv[7]);
      *(u32x4*)(B.BON + (m0 + t) * 512 + jb) = bo; *(u32x4*)(B.G + (m0 + t) * 512 + jb) = lg; }
    __syncthreads();
    {
      const int k = tid & 63, sg = tid >> 6; float e[8], run = 0.f;
#pragma unroll
      for (int s = 0; s < 8; ++s) { run += F0[(8 * sg + s) * 64 + k]; e[s] = run; }
      F1[sg * 64 + k] = run;
      __syncthreads();
      float off = 0.f;
#pragma unroll
      for (int s = 0; s < 8; ++s) off += (s < sg) ? F1[s * 64 + k] : 0.f;
#pragma unroll
      for (int s = 0; s < 8; ++s) F0[(8 * sg + s) * 64 + k] = e[s] + off; }
    __syncthreads();
    { float ct[8], cp[8], cC[8];
#pragma unroll
      for (int i = 0; i < 8; ++i) { ct[i] = F0[t * 64 + c0 + i]; cp[i] = (t > 0) ? F0[(t - 1) * 64 + c0 + i] : 0.f; cC[i] = F0[63 * 64 + c0 + i]; }
      float at[8], bt[8], kt[8], rt[8], bh[8], kh[8];
#pragma unroll
      for (int i = 0; i < 8; ++i) { const float gt = expf(-ct[i]), igt = expf(ct[i]), gp = expf(-cp[i]), gct = expf(ct[i] - cC[i]);
          at[i] = -kk[i] * gp; bt[i] = kk[i] * ar[i] * igt; kt[i] = k2[i] * igt; rt[i] = zr[i] * gt; bh[i] = kk[i] * ar[i] * gct; kh[i] = k2[i] * gct; }
      u32x4 o;
      o.x = pk2(at[0], at[1]); o.y = pk2(at[2], at[3]); o.z = pk2(at[4], at[5]); o.w = pk2(at[6], at[7]); *(u32x4*)(A0 + t * ST + c0) = o;
      o.x = pk2(bt[0], bt[1]); o.y = pk2(bt[2], bt[3]); o.z = pk2(bt[4], bt[5]); o.w = pk2(bt[6], bt[7]); *(u32x4*)(A1 + t * ST + c0) = o;
      o.x = pk2(kt[0], kt[1]); o.y = pk2(kt[2], kt[3]); o.z = pk2(kt[4], kt[5]); o.w = pk2(kt[6], kt[7]); *(u32x4*)(A2 + t * ST + c0) = o;
      o.x = pk2(rt[0], rt[1]); o.y = pk2(rt[2], rt[3]); o.z = pk2(rt[4], rt[5]); o.w = pk2(rt[6], rt[7]); *(u32x4*)(A3 + t * ST + c0) = o;
#pragma unroll
      for (int i = 0; i < 8; ++i) { A4[(c0 + i) * ST + t] = (bf16)f2bf(bh[i]); A5[(c0 + i) * ST + t] = (bf16)f2bf(kh[i]); A6[(c0 + i) * ST + t] = (bf16)f2bf(zv[i]); F1[t * 128 + c0 + i] = at[i]; }
      if (t == 63) { float* gc = (float*)(B.UB + (size_t)u * UNIT_B + 16384) + c0;
#pragma unroll
          for (int i = 0; i < 8; ++i) gc[i] = expf(-cC[i]); } }
    __syncthreads();
    { const int mt = w >> 1, nt0 = 2 * (w & 1);
      f32x4 a1[2], a2[2], a3[2], a4[2]; ZACC(a1); ZACC(a2); ZACC(a3); ZACC(a4);
      mm_tile(A0, ST, A1, ST, 2, a1, w, lq, g); mm_tile(A0, ST, A2, ST, 2, a2, w, lq, g); mm_tile(A3, ST, A1, ST, 2, a3, w, lq, g); mm_tile(A3, ST, A2, ST, 2, a4, w, lq, g);
      __syncthreads();
#pragma unroll
      for (int q = 0; q < 2; ++q) { const int i = 16 * (nt0 + q) + lq; f32x4 lab;
#pragma unroll
          for (int j = 0; j < 4; ++j) { const int tt = 16 * mt + 4 * g + j; lab[j] = (i < tt) ? a1[q][j] : 0.f;
              A7[tt * ST + i] = (bf16)f2bf((i < tt) ? a2[q][j] : 0.f); A8[tt * ST + i] = (bf16)f2bf((i <= tt) ? a3[q][j] : 0.f); A9[tt * ST + i] = (bf16)f2bf((i <= tt) ? a4[q][j] : 0.f); }
          *(f32x4*)(F0 + i * 64 + 16 * mt + 4 * g) = lab; } }
    __syncthreads();
    { const int mt = w >> 1, nt0 = 2 * (w & 1); f32x4 a[2]; ZACC(a);
      mm_tile(A7, ST, A6, ST, 2, a, w, lq, g);
#pragma unroll
      for (int q = 0; q < 2; ++q)
#pragma unroll
          for (int j = 0; j < 4; ++j) F1[(16 * mt + 4 * g + j) * 128 + 64 + 16 * (nt0 + q) + lq] = a[q][j]; }
    __syncthreads();
    { float X[16];
      const int col = 16 * w + lq;
#pragma unroll
      for (int r = 0; r < 16; ++r) X[r] = F1[(4 * r + g) * 128 + col];
      __syncthreads();
#pragma unroll
      for (int i = 0; i < 64; ++i) {
          const float xi = __shfl(X[i >> 2], (i & 3) * 16 + lq);
#pragma unroll
          for (int r = (i >> 2); r < 16; ++r) X[r] += F0[i * 64 + 4 * r + g] * xi;
          asm volatile("" ::: "memory");
      }
      bf16* XT = (bf16*)F1 + (w >> 2) * 4608 + ((col & 63) * ST);
#pragma unroll
      for (int r = 0; r < 16; ++r) XT[4 * r + g] = (bf16)f2bf(X[r]); }
    __syncthreads();
    { const int mt = w >> 1, nt0 = 2 * (w & 1);
      const bf16* AhT = (const bf16*)F1; const bf16* W2T = AhT + 4608;
      unsigned char* ua = B.UA + (size_t)u * UNIT_A; unsigned char* ub = B.UB + (size_t)u * UNIT_B;
      f32x4 a[2];
      ZACC(a); mm_tile(A4, ST, AhT, ST, 2, a, w, lq, g);
#pragma unroll
      for (int q = 0; q < 2; ++q)
#pragma unroll
          for (int j = 0; j < 4; ++j) { const int row = 16 * mt + 4 * g + j, kc = 16 * (nt0 + q) + lq; *(bf16*)(ua + swz(row, permk(kc))) = (bf16)f2bf(a[q][j]); }
      ZACC(a); mm_tile(A8, ST, AhT, ST, 2, a, w, lq, g);
#pragma unroll
      for (int q = 0; q < 2; ++q)
#pragma unroll
          for (int j = 0; j < 4; ++j) { const int row = 16 * mt + 4 * g + j, kc = 16 * (nt0 + q) + lq; *(bf16*)(ua + 8192 + swz(row, permk(kc))) = (bf16)f2bf(a[q][j] + bf2f(A3[row * ST + kc])); }
      ZACC(a); mm_tile(A4, ST, W2T, ST, 2, a, w, lq, g); mm_tile(A5, ST, A6, ST, 2, a, w, lq, g);
#pragma unroll
      for (int q = 0; q < 2; ++q) { const int v = 16 * (nt0 + q) + lq, k0 = 16 * mt + 4 * g; u32x2 o; o.x = pk2(a[q][0], a[q][1]); o.y = pk2(a[q][2], a[q][3]); *(u32x2*)(ub + swz(v, k0)) = o; }
      ZACC(a); mm_tile(A8, ST, W2T, ST, 2, a, w, lq, g); mm_tile(A9, ST, A6, ST, 2, a, w, lq, g);
#pragma unroll
      for (int q = 0; q < 2; ++q) { const int v = 16 * (nt0 + q) + lq, t0 = 16 * mt + 4 * g; u32x2 o; o.x = pk2(a[q][0], a[q][1]); o.y = pk2(a[q][2], a[q][3]); *(u32x2*)(ub + 8192 + swz(v, t0)) = o; } }
    __syncthreads();
}
__device__ __forceinline__ void phase_rwkv_prep(const Params& P, int l, const Ctx& c) {
    const RwkvBufs B = rwkv_bufs(P, c);
    for (int u = c.bid; u < NUNIT; u += c.G) rwkv_prep_unit(P, l, c, u, B);
}

constexpr int SLOTB = 33280;
__device__ __forceinline__ void scan_chunked(const Params& P, const Ctx& c, int bh) {
    const RwkvBufs B = rwkv_bufs(P, c);
    const int b = bh >> 3, h = bh & 7, w = c.wave, lane = c.lane, lq = lane & 15, g = lane >> 4;
    const size_t rowb = (size_t)b * LP;
    const int ll = (w - 4) * 64 + lane;
    unsigned char* L = c.lds;
    f32x4 st[4];
#pragma unroll
    for (int i = 0; i < 4; ++i) st[i] = (f32x4){0.f, 0.f, 0.f, 0.f};
    u32x4 ra[9], rb[9];
#define SC_UNIT(cc) ((size_t)((b * NCHK + (cc)) * 8 + h))
#define SC_LOAD(R, cc) do { const unsigned char* pa_ = B.UA + SC_UNIT(cc) * UNIT_A; const unsigned char* pb_ = B.UB + SC_UNIT(cc) * UNIT_B; \
        _Pragma("unroll") for (int i_ = 0; i_ < 4; ++i_) { R[i_] = *(const u32x4*)(pa_ + (ll + 256 * i_) * 16); R[4 + i_] = *(const u32x4*)(pb_ + (ll + 256 * i_) * 16); } \
        if (ll < 16) R[8] = *(const u32x4*)(pb_ + 16384 + ll * 16); } while (0)
#define SC_WRITE(R, slot) do { unsigned char* s_ = L + (slot) * SLOTB; \
        _Pragma("unroll") for (int i_ = 0; i_ < 4; ++i_) { *(u32x4*)(s_ + (ll + 256 * i_) * 16) = R[i_]; *(u32x4*)(s_ + 16384 + (ll + 256 * i_) * 16) = R[4 + i_]; } \
        if (ll < 16) *(u32x4*)(s_ + 32768 + ll * 16) = R[8]; } while (0)
    if (w >= 4) { SC_LOAD(ra, 0); SC_LOAD(rb, 1); SC_WRITE(ra, 0); SC_WRITE(rb, 1); SC_LOAD(ra, 2); SC_LOAD(rb, 3); }
    __syncthreads();
    for (int cc = 0; cc < NCHK; cc += 2) {
#pragma unroll
        for (int half = 0; half < 2; ++half) {
            const int ci = cc + half;
            if (w >= 4) {
                if (half == 0) { if (ci + 2 < NCHK) SC_WRITE(ra, (ci + 2) % 3); if (ci + 4 < NCHK) SC_LOAD(ra, ci + 4); }
                else { if (ci + 2 < NCHK) SC_WRITE(rb, (ci + 2) % 3); if (ci + 4 < NCHK) SC_LOAD(rb, ci + 4); }
            } else {
                const unsigned char* sl = L + (ci % 3) * SLOTB;
                const int vcol = 16 * w + lq;
                bf16x8 sb[2];
#pragma unroll
                for (int ks = 0; ks < 2; ++ks) { u32x4 pw; pw.x = pk2(st[2 * ks][0], st[2 * ks][1]); pw.y = pk2(st[2 * ks][2], st[2 * ks][3]); pw.z = pk2(st[2 * ks + 1][0], st[2 * ks + 1][1]); pw.w = pk2(st[2 * ks + 1][2], st[2 * ks + 1][3]);
                    sb[ks] = __builtin_bit_cast(bf16x8, pw); }
#pragma unroll
                for (int mt = 0; mt < 4; ++mt) {
                    const f32x4 gc = *(const f32x4*)(sl + 32768 + (16 * mt + 4 * g) * 4);
                    const u32x2 d0 = *(const u32x2*)(sl + 16384 + swz(vcol, 16 * mt + 4 * g));
                    const u32x2 y0 = *(const u32x2*)(sl + 24576 + swz(vcol, 16 * mt + 4 * g));
                    f32x4 ns = (f32x4){bflo(d0.x), bfhi(d0.x), bflo(d0.y), bfhi(d0.y)} + gc * st[mt];
                    f32x4 ya = (f32x4){bflo(y0.x), bfhi(y0.x), bflo(y0.y), bfhi(y0.y)};
#pragma unroll
                    for (int ks = 0; ks < 2; ++ks) {
                        const bf16x8 ga = *(const bf16x8*)(sl + swz(16 * mt + lq, 32 * ks + 8 * g));
                        const bf16x8 rh = *(const bf16x8*)(sl + 8192 + swz(16 * mt + lq, 32 * ks + 8 * g));
                        ns = __builtin_amdgcn_mfma_f32_16x16x32_bf16(ga, sb[ks], ns, 0, 0, 0);
                        ya = __builtin_amdgcn_mfma_f32_16x16x32_bf16(rh, sb[ks], ya, 0, 0, 0);
                    }
                    st[mt] = ns;
                    float* yp = B.Y + (rowb + ci * 64 + 16 * mt + 4 * g) * 512 + h * 64 + vcol;
#pragma unroll
                    for (int j = 0; j < 4; ++j) yp[j * 512] = ya[j];
                }
            }
            __syncthreads();
        }
    }
#undef SC_UNIT
#undef SC_LOAD
#undef SC_WRITE
}

__device__ __forceinline__ void phase_gn(const Params& P, int l, const Ctx& c) {
    const RwkvBufs B = rwkv_bufs(P, c);
    const int gw = c.bid * NWAVES + c.wave, NGW = c.G * NWAVES;
    const int c0 = 8 * c.lane;
    float gnw[8], gnb[8];
#pragma unroll
    for (int i = 0; i < 8; ++i) { gnw[i] = P.in[17][l * 512 + c0 + i]; gnb[i] = P.in[18][l * 512 + c0 + i]; }
    for (int m = gw; m < M; m += NGW) {
        const size_t o = (size_t)m * 512 + c0;
        const f32x4 y0 = *(const f32x4*)(B.Y + o), y1 = *(const f32x4*)(B.Y + o + 4);
        float y[8] = {y0.x, y0.y, y0.z, y0.w, y1.x, y1.y, y1.z, y1.w};
        const u32x4 bw = *(const u32x4*)(B.BON + o), gw4 = *(const u32x4*)(B.G + o);
        const float bo[8] = {bflo(bw.x), bfhi(bw.x), bflo(bw.y), bfhi(bw.y), bflo(bw.z), bfhi(bw.z), bflo(bw.w), bfhi(bw.w)};
        const float gg[8] = {bflo(gw4.x), bfhi(gw4.x), bflo(gw4.y), bfhi(gw4.y), bflo(gw4.z), bfhi(gw4.z), bflo(gw4.w), bfhi(gw4.w)};
        float s = 0.f;
#pragma unroll
        for (int i = 0; i < 8; ++i) s += y[i];
        s += __shfl_xor(s, 1); s += __shfl_xor(s, 2); s += __shfl_xor(s, 4);
        const float mean = s * (1.f / 64.f);
        float q = 0.f;
#pragma unroll
        for (int i = 0; i < 8; ++i) { y[i] -= mean; q += y[i] * y[i]; }
        q += __shfl_xor(q, 1); q += __shfl_xor(q, 2); q += __shfl_xor(q, 4);
        const float rstd = 1.0f / sqrtf(q * (1.f / 64.f) + 64e-5f);
        float ov[8];
#pragma unroll
        for (int i = 0; i < 8; ++i) ov[i] = (y[i] * rstd * gnw[i] + gnb[i] + bo[i]) * gg[i];
        u32x4 ow; ow.x = pk2(ov[0], ov[1]); ow.y = pk2(ov[2], ov[3]); ow.z = pk2(ov[4], ov[5]); ow.w = pk2(ov[6], ov[7]);
        *(u32x4*)(B.ORW + o) = ow;
    }
}

__device__ __forceinline__ void attn_unit(const Ctx& c, int bh, int qb, const bf16* Q, const bf16* K, const bf16* V, bf16* O, const float* FC, float qkb2) {
    const int b = bh >> 3, h = bh & 7, lane = c.lane, w = c.wave, lq = lane & 15, g = lane >> 4;
    const int q0 = qb * 128;
    const size_t rowb = (size_t)b * LP;
    const int qrow = q0 + 16 * w + lq;
    bf16* Ks = (bf16*)c.lds; bf16* Vt = Ks + 64 * 72; float* fks = (float*)(Vt + 64 * 72);
    const bf16* qp = Q + (rowb + qrow) * 512 + h * 64 + 8 * g;
    const bf16x8 qf0 = *(const bf16x8*)qp, qf1 = *(const bf16x8*)(qp + 32);
    const float* FCh = FC + (size_t)bh * LP;
    const float fq = FCh[qrow];
    float mrun = -1e30f, lsum = 0.f;
    f32x4 o[4];
#pragma unroll
    for (int i = 0; i < 4; ++i) o[i] = (f32x4){0.f, 0.f, 0.f, 0.f};
    const int kt_max = (q0 + 127) >> 6;
    for (int kt = kt_max; kt >= 0; --kt) {
        const int k0 = kt * 64;
        if (kt < kt_max) { const float fl = FCh[k0 + 63]; const int can = (qkb2 + fq - fl) < (mrun - THR2); if (__syncthreads_and(can)) break; }
        else __syncthreads();
        { const int key = c.tid >> 3, ch = c.tid & 7;
            const size_t goff = (rowb + k0 + key) * 512 + h * 64 + ch * 8;
            const u32x4 kv = *(const u32x4*)(K + goff); const u32x4 vv = *(const u32x4*)(V + goff);
            *(u32x4*)(Ks + key * 72 + ch * 8) = kv;
            bf16* vd = Vt + (ch * 8) * 72 + key;
            vd[0] = (bf16)(vv.x & 0xffff); vd[72] = (bf16)(vv.x >> 16); vd[144] = (bf16)(vv.y & 0xffff); vd[216] = (bf16)(vv.y >> 16);
            vd[288] = (bf16)(vv.z & 0xffff); vd[360] = (bf16)(vv.z >> 16); vd[432] = (bf16)(vv.w & 0xffff); vd[504] = (bf16)(vv.w >> 16);
            if (c.tid < 64) fks[c.tid] = FCh[k0 + c.tid]; }
        __syncthreads();
        if (k0 > q0 + 16 * w + 15) continue;
        f32x4 s[4];
#pragma unroll
        for (int nt = 0; nt < 4; ++nt) { const bf16* kp = Ks + (16 * nt + lq) * 72 + 8 * g; const bf16x8 a0 = *(const bf16x8*)kp, a1 = *(const bf16x8*)(kp + 32);
            s[nt] = __builtin_amdgcn_mfma_f32_16x16x32_bf16(a0, qf0, (f32x4){0.f, 0.f, 0.f, 0.f}, 0, 0, 0);
            s[nt] = __builtin_amdgcn_mfma_f32_16x16x32_bf16(a1, qf1, s[nt], 0, 0, 0); }
        float mx = -INFINITY;
#pragma unroll
        for (int nt = 0; nt < 4; ++nt) { const f32x4 fk = *(const f32x4*)(fks + 16 * nt + 4 * g);
#pragma unroll
            for (int j = 0; j < 4; ++j) { float x = s[nt][j] + fq - fk[j]; const int key = k0 + 16 * nt + 4 * g + j; if (key > qrow) x = -INFINITY; s[nt][j] = x; mx = fmaxf(mx, x); } }
        mx = fmaxf(mx, __shfl_xor(mx, 16)); mx = fmaxf(mx, __shfl_xor(mx, 32));
        const float mnew = fmaxf(mrun, mx), alpha = exp2f(mrun - mnew); mrun = mnew;
        float psum = 0.f;
#pragma unroll
        for (int nt = 0; nt < 4; ++nt)
#pragma unroll
            for (int j = 0; j < 4; ++j) { const float p = exp2f(s[nt][j] - mnew); s[nt][j] = p; psum += p; }
        lsum = lsum * alpha + psum;
#pragma unroll
        for (int dt = 0; dt < 4; ++dt) o[dt] = o[dt] * alpha;
        bf16x8 pb[2];
#pragma unroll
        for (int k2 = 0; k2 < 2; ++k2) { u32x4 pw; pw.x = pk2(s[2 * k2][0], s[2 * k2][1]); pw.y = pk2(s[2 * k2][2], s[2 * k2][3]); pw.z = pk2(s[2 * k2 + 1][0], s[2 * k2 + 1][1]); pw.w = pk2(s[2 * k2 + 1][2], s[2 * k2 + 1][3]);
            pb[k2] = __builtin_bit_cast(bf16x8, pw); }
#pragma unroll
        for (int dt = 0; dt < 4; ++dt)
#pragma unroll
            for (int k2 = 0; k2 < 2; ++k2) { const bf16* vp = Vt + (16 * dt + lq) * 72 + 32 * k2 + 4 * g;
                const u32x2 lo = *(const u32x2*)vp, hi = *(const u32x2*)(vp + 16);
                u32x4 aw; aw.x = lo.x; aw.y = lo.y; aw.z = hi.x; aw.w = hi.y;
                o[dt] = __builtin_amdgcn_mfma_f32_16x16x32_bf16(__builtin_bit_cast(bf16x8, aw), pb[k2], o[dt], 0, 0, 0); }
    }
    lsum += __shfl_xor(lsum, 16); lsum += __shfl_xor(lsum, 32);
    const float inv = 1.0f / lsum;
    bf16* op = O + (rowb + qrow) * 512 + h * 64 + 4 * g;
#pragma unroll
    for (int dt = 0; dt < 4; ++dt) { u32x2 ow; ow.x = pk2(o[dt][0] * inv, o[dt][1] * inv); ow.y = pk2(o[dt][2] * inv, o[dt][3] * inv); *(u32x2*)(op + 16 * dt) = ow; }
    __syncthreads();
}
__device__ __forceinline__ void phase_attn(const Params& P, int l, const Ctx& c, int first_blk) {
    const bf16* Q = (const bf16*)(c.ws + OFF_Q); const bf16* K = (const bf16*)(c.ws + OFF_K); const bf16* V = (const bf16*)(c.ws + OFF_V);
    const float* FC = (const float*)(c.ws + OFF_MISC) + 16 * LP;
    float gqm = fabsf(P.in[5][l * 64 + c.lane]), gkm = fabsf(P.in[6][l * 64 + c.lane]);
#pragma unroll
    for (int o = 1; o < 64; o <<= 1) { gqm = fmaxf(gqm, __shfl_xor(gqm, o)); gkm = fmaxf(gkm, __shfl_xor(gkm, o)); }
    const float qkb2 = 8.0f * gqm * gkm * LOG2E * 1.03f;
    const int nblk = c.G - first_blk, me = c.bid - first_blk;
    constexpr int NQB = LP / 128, NU = 16 * NQB;
    for (int u = me; u < NU; u += nblk) { const int bh = u & 15, qb = NQB - 1 - (u >> 4); attn_unit(c, bh, qb, Q, K, V, (bf16*)(c.ws + OFF_OF), FC, qkb2); }
}

__device__ __forceinline__ void phase_fixup(const Params& P, int l, const Ctx& c) {
    bf16* ACT = (bf16*)(c.ws + OFF_RW); const bf16* HALO = (const bf16*)(c.ws + OFF_Q);
    const float* cw = P.in[24] + (size_t)l * 3 * NUP;
    const int total = (M / 64) * 2 * DFF;
    for (int idx = c.bid * NTHR + c.tid; idx < total; idx += c.G * NTHR) {
        const int rr = idx / DFF, ch = idx - rr * DFF, q64 = rr >> 1, e = rr & 1, row = q64 * 64 + e;
        const int t = row % LP;
        int s0, s1, s2;
        if (e == 0) { s0 = q64 * 4 + 2; s1 = (q64 - 1) * 4 + 1; s2 = (q64 - 1) * 4 + 0; } else { s0 = q64 * 4 + 3; s1 = q64 * 4 + 2; s2 = (q64 - 1) * 4 + 1; }
        float uc[2];
#pragma unroll
        for (int bj = 0; bj < 2; ++bj) { const int col = bj * DFF + ch;
            const float u0 = bf2f(HALO[(size_t)s0 * NUP + col]);
            const float u1 = (t >= 1) ? bf2f(HALO[(size_t)s1 * NUP + col]) : 0.f;
            const float u2 = (t >= 2) ? bf2f(HALO[(size_t)s2 * NUP + col]) : 0.f;
            uc[bj] = cw[col] * u2 + cw[NUP + col] * u1 + cw[2 * NUP + col] * u0; }
        ACT[(size_t)row * DFF + ch] = (bf16)f2bf(uc[0] * sigmoidf_(uc[0]) * uc[1]);
    }
}

#define OPQ_S(x) asm volatile("" : "+s"(x))
#define OPQ_V(x) asm volatile("" : "+v"(x))
#define PHASE_BEGIN() do { int t_ = threadIdx.x; OPQ_V(t_); c.tid = t_; c.lane = t_ & 63; c.wave = __builtin_amdgcn_readfirstlane(t_ >> 6); int b_ = blockIdx.x; OPQ_S(b_); c.bid = b_; \
    unsigned char* w_ = P.ws; OPQ_S(w_); c.ws = w_; ws = w_; l = lc; OPQ_S(l); WT = (pg8::bf16_t*)(ws + OFF_WT); HN = (pg8::bf16_t*)(ws + OFF_HN); } while (0)
__global__ void __launch_bounds__(NTHR, 2) mega(Params P) {
    extern __shared__ __attribute__((aligned(16))) unsigned char lds[];
    cg::grid_group grid = cg::this_grid();
    Ctx c; c.G = gridDim.x; c.lds = lds;
    volatile LAS unsigned* MISC = (volatile LAS unsigned*)((LAS unsigned char*)lds + MISC_OFF);
    if (threadIdx.x < 16) MISC[threadIdx.x] = 0u;
    __syncthreads();
    XcdBarrier xbar = xcd_barrier_post((unsigned*)(P.ws + OFF_CTL) + 1024, MISC + 8);
#define SEAM() xcd_barrier(xbar)
    PG8_LAS unsigned char* ldsl = (PG8_LAS unsigned char*)lds;
    unsigned char* ws; pg8::bf16_t* WT; pg8::bf16_t* HN; int l;
#pragma unroll 1
    for (int lc = 0; lc < DEPTH; ++lc) {
        PHASE_BEGIN();
        convert_weights(P, l, c);
        phase_norm<true>(P, l, c);
        grid.sync();
        PHASE_BEGIN();
        phase_fcum(P, c);
        { pg8::Gemm g{HN, WT + WT_IN, M, N1, 1024}; pg8::StaticOrder S; S.init(M, N1, c.G, c.bid);
          pg8::EpiRoute E{ws};
          pg8::gemm_phase<pg8::EpiRoute, pg8::StaticOrder, true, true>(ldsl, g, S, E); }
        SEAM();
        PHASE_BEGIN();
        phase_qknorm(P, l, c);
        for (int rep_ = 0; rep_ < REP_PREP; ++rep_) phase_rwkv_prep(P, l, c);
        SEAM();
        PHASE_BEGIN();
        if (c.bid < 16) scan_chunked(P, c, c.bid); else phase_attn(P, l, c, 16);
#if REP_P3 > 1
        __syncthreads(); PHASE_BEGIN();
        if (c.bid < 16) scan_chunked(P, c, c.bid); else phase_attn(P, l, c, 16);
#endif
        SEAM();
        PHASE_BEGIN();
        phase_gn(P, l, c);
        for (int rep_ = 0; rep_ < REP_SYNC; ++rep_) SEAM();
        SEAM();
        PHASE_BEGIN();
        { pg8::bf16_t* MG = (pg8::bf16_t*)(ws + OFF_K); const pg8::bf16_t* GT = (const pg8::bf16_t*)(ws + OFF_GT); const float* gb = P.in[21] + l * NGT;
          pg8::StaticOrder S; S.init(M, 1024, c.G, c.bid);
          { pg8::Gemm g{(const pg8::bf16_t*)(ws + OFF_OF), WT + WT_BF, M, 1024, 512}; pg8::EpiGate<0> E{MG, GT, gb};
            pg8::gemm_phase<pg8::EpiGate<0>, pg8::StaticOrder, true, true>(ldsl, g, S, E); }
          __syncthreads();
          PHASE_BEGIN();
          MG = (pg8::bf16_t*)(ws + OFF_K); GT = (const pg8::bf16_t*)(ws + OFF_GT); gb = P.in[21] + l * NGT; S.init(M, 1024, c.G, c.bid);
          { pg8::Gemm g{(const pg8::bf16_t*)(ws + OFF_RW + (size_t)M * 512 * 4), WT + WT_BR, M, 1024, 512}; pg8::EpiGate<1> E{MG, GT, gb};
            pg8::gemm_phase<pg8::EpiGate<1>, pg8::StaticOrder, true, true>(ldsl, g, S, E); } }
        SEAM();
        PHASE_BEGIN();
        { pg8::Gemm g{(const pg8::bf16_t*)(ws + OFF_K), WT + WT_O, M, 1024, 1024}; pg8::StaticOrder S; S.init(M, 1024, c.G, c.bid);
          pg8::EpiResid E{(float*)(ws + OFF_H), nullptr};
          pg8::gemm_phase<pg8::EpiResid, pg8::StaticOrder, true, true>(ldsl, g, S, E); }
        SEAM();
        PHASE_BEGIN();
        phase_norm<false>(P, l, c);
        SEAM();
        PHASE_BEGIN();
        { pg8::Gemm g{HN, WT + WT_UP, M, NUP, 1024}; pg8::StaticOrder S; S.init(M, NUP, c.G, c.bid);
          pg8::EpiUp E{(pg8::bf16_t*)(ws + OFF_RW), (pg8::bf16_t*)(ws + OFF_Q), P.in[24] + (size_t)l * 3 * NUP};
          pg8::gemm_phase<pg8::EpiUp, pg8::StaticOrder, true, true>(ldsl, g, S, E); }
        SEAM();
        PHASE_BEGIN();
        phase_fixup(P, l, c);
        SEAM();
        PHASE_BEGIN();
        { pg8::Gemm g{(const pg8::bf16_t*)(ws + OFF_RW), WT + WT_DN, M, 1024, DFF}; pg8::StaticOrder S; S.init(M, 1024, c.G, c.bid);
          pg8::EpiResid E{(float*)(ws + OFF_H), l == DEPTH - 1 ? P.out : nullptr};
          pg8::gemm_phase<pg8::EpiResid, pg8::StaticOrder, true, true>(ldsl, g, S, E); }
        SEAM();
    }
}

extern "C" void kernel_launch(void* const* d_in, const int* in_sizes, int n_in, void* d_out, int out_size, void* d_ws, size_t ws_size, hipStream_t stream) {
    static int grid = 0;
    if (grid == 0) {
        if (n_in != 26 || out_size != NB * SEQ * DM || ws_size < WS_NEED) { fprintf(stderr, "kernel_launch: unexpected shapes (n_in %d out %d ws %zu need %zu)\n", n_in, out_size, ws_size, (size_t)WS_NEED); grid = -1; return; }
        int dev = 0, cus = 0, per_cu = 0;
        if (hipGetDevice(&dev) != hipSuccess || hipDeviceGetAttribute(&cus, hipDeviceAttributeMultiprocessorCount, dev) != hipSuccess) { grid = -1; return; }
        if (hipFuncSetAttribute((const void*)mega, hipFuncAttributeMaxDynamicSharedMemorySize, LDS_BYTES) != hipSuccess) { fprintf(stderr, "kernel_launch: hipFuncSetAttribute failed\n"); grid = -1; return; }
        if (hipOccupancyMaxActiveBlocksPerMultiprocessor(&per_cu, (const void*)mega, NTHR, LDS_BYTES) != hipSuccess || per_cu < 1) { fprintf(stderr, "kernel_launch: occupancy query says %d\n", per_cu); per_cu = 1; }
        (void)hipGetLastError();
        grid = cus;
    }
    if (grid < 0) return;
    if (hipMemsetAsync((char*)d_ws + OFF_CTL, 0, 65536, stream) != hipSuccess) { fprintf(stderr, "kernel_launch: memset failed\n"); return; }
    Params p{};
    for (int i = 0; i < 26; ++i) p.in[i] = (const float*)d_in[i];
    p.out = (float*)d_out; p.ws = (unsigned char*)d_ws;
    void* args[] = {&p};
    hipError_t e = hipLaunchCooperativeKernel((const void*)mega, dim3(grid), dim3(NTHR), args, LDS_BYTES, stream);
    if (e != hipSuccess) fprintf(stderr, "kernel_launch: cooperative launch failed: %s (grid %d)\n", hipGetErrorString(e), grid);
}
```

```cpp
#include <hip/hip_runtime.h>
#include <hip/hip_cooperative_groups.h>
#include <cstdio>
#include <cstdint>
#include <cmath>
namespace cg = cooperative_groups;
namespace pg8 {
#define PG8_LAS __attribute__((address_space(3)))
typedef unsigned short bf16_t;
typedef short bf16x8 __attribute__((ext_vector_type(8)));
typedef float f32x4 __attribute__((ext_vector_type(4)));
typedef unsigned u32x4 __attribute__((ext_vector_type(4)));
constexpr int BM = 256, BK = 64, HALF = 128, HTB = HALF * BK * 2  , STAGE_BYTES = 8 * HTB, NXCD = 8, WGM = 8;

__host__ __device__ __forceinline__ int lds_byte(int r, int c) { const int st = (r >> 4) * 2 + (c >> 5), rr = r & 15, cc = c & 31, ob = rr * 64 + cc * 2; return st * 1024 + (ob ^ (((ob >> 9) & 1) << 5)); }
__host__ __device__ __forceinline__ void stage_rc(int b, int& R, int& C) { const int st = b / 1024, sb = b % 1024, swz = sb ^ (((sb >> 9) & 1) << 5); R = (st >> 1) * 16 + swz / 64; C = (st & 1) * 32 + (swz % 64) / 2; }
__host__ __device__ __forceinline__ int perm32(int rho) { const int n = rho >> 4, i = rho & 15; return 8 * (i >> 2) + 4 * n + (i & 3); }

struct Unit { int pm, pn; };
struct Gemm { const bf16_t* A; const bf16_t* Bt; int M, N, K, ld; };

struct StaticOrder {
    int nM, nN, nwg, G, c;
    __host__ __device__ void init(int M, int N, int G_, int c_) { nM = M / BM; nN = N / BM; nwg = nM * nN; G = G_; c = c_; }
    __host__ __device__ bool next(int i, Unit& u) const {
        const long L = (long)i * G + c; if (L >= nwg) return false;
        int wgid = (int)L; { const int q = nwg / NXCD, r = nwg % NXCD, xcd = wgid % NXCD, off = wgid / NXCD; wgid = (xcd < r ? xcd * (q + 1) : r * (q + 1) + (xcd - r) * q) + off; }
        const int nig = WGM * nN, gid = wgid / nig, fm = gid * WGM, gsz = (nM - fm) < WGM ? (nM - fm) : WGM;
        u.pm = fm + ((wgid % nig) % gsz); u.pn = (wgid % nig) / gsz; return true;
    }
    __device__ __forceinline__ void a_ready(const Unit&) const {}
    __device__ __forceinline__ void done(const Unit&) const {}
};

__device__ __forceinline__ unsigned cvt_pk_bf16(float lo, float hi) { unsigned r; asm volatile("v_cvt_pk_bf16_f32 %0, %1, %2" : "=v"(r) : "v"(lo), "v"(hi)); return r; }
typedef float f32x2 __attribute__((ext_vector_type(2)));
template <class Epi, class Sched, bool ALIGN_EPI = false, bool SP2 = false>
__device__ __forceinline__ void gemm_phase(PG8_LAS unsigned char* lds, const Gemm g, const Sched& S, const Epi& E) {
    int tid_ = threadIdx.x; asm volatile("" : "+v"(tid_)); const int tid = tid_, wid = __builtin_amdgcn_readfirstlane(tid >> 6), lane = tid & 63, wr = wid >> 2, wc = wid & 3, fr = lane & 15, fq = lane >> 4;
    const int K = g.K, nt = K / BK, LD = g.ld;
    unsigned voffA[2], voffB[2];
#pragma unroll
    for (int i = 0; i < 2; ++i) { int R, C; stage_rc(tid * 16 + i * 8192, R, C); const int Rb = Epi::PERM ? ((R & ~31) + perm32(R & 31)) : R;
        voffA[i] = (unsigned)(R * LD + C) * 2u; voffB[i] = (unsigned)(Rb * LD + C) * 2u; }
    const size_t kstep = (size_t)(BK * 2);
    const size_t hstep = (size_t)HALF * LD * 2;
    const size_t tstep = 2 * hstep;
    const unsigned ldsw = (unsigned)wid * 1024u;
    const int aoff = lds_byte(wr * 64 + fr, fq * 8), boff = lds_byte(wc * 32 + fr, fq * 8);
#define PG8_SA(b, h) (((b) * 2 + (h)) * HTB)
#define PG8_SB(b, h) ((4 + (b) * 2 + (h)) * HTB)
#define PG8_STAGE(bufoff, gbase, voff) do { _Pragma("unroll") for (int _i = 0; _i < 2; ++_i) \
        __builtin_amdgcn_global_load_lds((const unsigned*)((const char*)(gbase) + (voff)[_i]), (PG8_LAS unsigned*)(lds + (bufoff) + ldsw + _i * 8192), 16, 0, 0); } while (0)
#define PG8_LDA(dst, b, h) do { _Pragma("unroll") for (int m = 0; m < 4; ++m) _Pragma("unroll") for (int k = 0; k < 2; ++k) dst[m][k] = *(const PG8_LAS bf16x8*)(lds + PG8_SA(b, h) + aoff + m * 2048 + k * 1024); } while (0)
#define PG8_LDB(dst, b, h) do { _Pragma("unroll") for (int n = 0; n < 2; ++n) _Pragma("unroll") for (int k = 0; k < 2; ++k) dst[n][k] = *(const PG8_LAS bf16x8*)(lds + PG8_SB(b, h) + boff + n * 2048 + k * 1024); } while (0)
#define PG8_MMA(ai, bj, At, Bt) do { __builtin_amdgcn_s_setprio(1); _Pragma("unroll") for (int m = 0; m < 4; ++m) _Pragma("unroll") for (int n = 0; n < 2; ++n) _Pragma("unroll") for (int k = 0; k < 2; ++k) \
        acc[ai][bj][m][n] = __builtin_amdgcn_mfma_f32_16x16x32_bf16(Bt[n][k], At[m][k], acc[ai][bj][m][n], 0, 0, 0); __builtin_amdgcn_s_setprio(0); } while (0)
#define PG8_WAIT_V(n) asm volatile("s_waitcnt vmcnt(" #n ")" ::: "memory")
#define PG8_WAIT_L(n) asm volatile("s_waitcnt lgkmcnt(" #n ")" ::: "memory")
#define PG8_BAR __builtin_amdgcn_s_barrier()
#define PG8_SCHED __builtin_amdgcn_sched_barrier(0)
    Unit cur, nxt; int ui = 0;
    if (!S.next(0, cur)) return;
    f32x4 acc[2][2][4][2];
#pragma unroll
    for (int a = 0; a < 2; ++a)
#pragma unroll
        for (int b = 0; b < 2; ++b)
#pragma unroll
            for (int m = 0; m < 4; ++m)
#pragma unroll
                for (int n = 0; n < 2; ++n) acc[a][b][m][n] = (f32x4){0.f, 0.f, 0.f, 0.f};
    bf16x8 At[4][2], B0[2][2], B1[2][2];
    const char* cA = (const char*)g.A + (size_t)cur.pm * tstep; const char* cB = (const char*)g.Bt + (size_t)cur.pn * tstep;
    S.a_ready(cur);
    if constexpr (SP2) {
        PG8_STAGE(PG8_SB(0, 0), cB, voffB); PG8_STAGE(PG8_SB(0, 1), cB + hstep, voffB); PG8_STAGE(PG8_SA(0, 0), cA, voffA); PG8_STAGE(PG8_SA(0, 1), cA + hstep, voffA);
        if (wr == 1) PG8_BAR;
        PG8_WAIT_V(2); PG8_BAR;
        PG8_STAGE(PG8_SB(1, 0), cB + kstep, voffB); PG8_STAGE(PG8_SA(1, 0), cA + kstep, voffA); PG8_STAGE(PG8_SB(1, 1), cB + hstep + kstep, voffB);
        PG8_WAIT_V(6); PG8_BAR;
    } else {
        PG8_STAGE(PG8_SB(0, 0), cB, voffB); PG8_STAGE(PG8_SA(0, 0), cA, voffA); PG8_STAGE(PG8_SB(0, 1), cB + hstep, voffB); PG8_STAGE(PG8_SA(0, 1), cA + hstep, voffA);
        if (wr == 1) PG8_BAR;
        PG8_WAIT_V(4); PG8_BAR;
        PG8_STAGE(PG8_SB(1, 0), cB + kstep, voffB); PG8_STAGE(PG8_SA(1, 0), cA + kstep, voffA); PG8_STAGE(PG8_SB(1, 1), cB + hstep + kstep, voffB);
        PG8_WAIT_V(6); PG8_BAR;
    }
    for (;;) {
        const bool has_next = S.next(ui + 1, nxt);
        const char* nA = has_next ? (const char*)g.A + (size_t)nxt.pm * tstep : cA; const char* nB = has_next ? (const char*)g.Bt + (size_t)nxt.pn * tstep : cB;
        for (int t = 0; t < nt; t += 2) {
            const bool last = (t == nt - 2);
            const char* a1 = cA + (size_t)(t + 1) * kstep;
            const char* a2 = last ? nA : cA + (size_t)(t + 2) * kstep; const char* b2 = last ? nB : cB + (size_t)(t + 2) * kstep;
            const char* a3 = a2 + kstep; const char* b3 = b2 + kstep;
            if (last && has_next) S.a_ready(nxt);
            if constexpr (SP2) {
            PG8_LDB(B0, 0, 0); PG8_LDB(B1, 0, 1); PG8_SCHED; PG8_LDA(At, 0, 0); PG8_STAGE(PG8_SA(1, 1), a1 + hstep, voffA);
            PG8_WAIT_V(8); PG8_WAIT_L(0); PG8_BAR; PG8_MMA(0, 0, At, B0); PG8_MMA(0, 1, At, B1); PG8_BAR; PG8_SCHED;
            PG8_LDA(At, 0, 1); PG8_STAGE(PG8_SB(0, 0), b2, voffB); PG8_STAGE(PG8_SB(0, 1), b2 + hstep, voffB); PG8_STAGE(PG8_SA(0, 0), a2, voffA);
            PG8_WAIT_V(8); PG8_WAIT_L(0); PG8_BAR; PG8_MMA(1, 0, At, B0); PG8_MMA(1, 1, At, B1); PG8_BAR; PG8_SCHED;
            PG8_LDB(B0, 1, 0); PG8_LDB(B1, 1, 1); PG8_SCHED; PG8_LDA(At, 1, 0); PG8_STAGE(PG8_SA(0, 1), a2 + hstep, voffA);
            PG8_WAIT_V(8); PG8_WAIT_L(0); PG8_BAR; PG8_MMA(0, 0, At, B0); PG8_MMA(0, 1, At, B1); PG8_BAR; PG8_SCHED;
            PG8_LDA(At, 1, 1); PG8_STAGE(PG8_SB(1, 0), b3, voffB); PG8_STAGE(PG8_SB(1, 1), b3 + hstep, voffB); PG8_STAGE(PG8_SA(1, 0), a3, voffA);
            PG8_WAIT_V(8); PG8_WAIT_L(0); PG8_BAR; PG8_MMA(1, 0, At, B0); PG8_MMA(1, 1, At, B1); PG8_BAR; PG8_SCHED;
            } else {
            PG8_LDB(B0, 0, 0); PG8_SCHED; PG8_LDA(At, 0, 0); PG8_STAGE(PG8_SA(1, 1), a1 + hstep, voffA);
            PG8_WAIT_L(8); PG8_BAR; PG8_WAIT_L(0); PG8_MMA(0, 0, At, B0); PG8_BAR; PG8_SCHED;
            PG8_LDB(B1, 0, 1); PG8_STAGE(PG8_SB(0, 0), b2, voffB);
            PG8_BAR; PG8_WAIT_L(0); PG8_MMA(0, 1, At, B1); PG8_BAR;
            PG8_LDA(At, 0, 1); PG8_STAGE(PG8_SA(0, 0), a2, voffA);
            PG8_BAR; PG8_WAIT_L(0); PG8_MMA(1, 0, At, B0); PG8_BAR; PG8_SCHED;
            PG8_STAGE(PG8_SB(0, 1), b2 + hstep, voffB);
            PG8_WAIT_V(6); PG8_BAR; PG8_MMA(1, 1, At, B1); PG8_BAR;
            PG8_LDB(B0, 1, 0); PG8_SCHED; PG8_LDA(At, 1, 0); PG8_STAGE(PG8_SA(0, 1), a2 + hstep, voffA);
            PG8_WAIT_L(8); PG8_BAR; PG8_WAIT_L(0); PG8_MMA(0, 0, At, B0); PG8_BAR; PG8_SCHED;
            PG8_LDB(B1, 1, 1); PG8_STAGE(PG8_SB(1, 0), b3, voffB);
            PG8_BAR; PG8_WAIT_L(0); PG8_MMA(0, 1, At, B1); PG8_BAR;
            PG8_LDA(At, 1, 1); PG8_STAGE(PG8_SA(1, 0), a3, voffA);
            PG8_BAR; PG8_WAIT_L(0); PG8_MMA(1, 0, At, B0); PG8_BAR; PG8_SCHED;
            PG8_STAGE(PG8_SB(1, 1), b3 + hstep, voffB);
            PG8_WAIT_V(6); PG8_BAR; PG8_MMA(1, 1, At, B1); PG8_BAR;
            }
        }
        if constexpr (ALIGN_EPI) { if (wr == 0) PG8_BAR; }
        if constexpr (!Epi::AFTER_DRAIN) { E(acc, cur, wr, wc, fr, fq); S.done(cur); }
        if (!has_next) break;
#pragma unroll
        for (int a = 0; a < 2; ++a)
#pragma unroll
            for (int b = 0; b < 2; ++b)
#pragma unroll
                for (int m = 0; m < 4; ++m)
#pragma unroll
                    for (int n = 0; n < 2; ++n) acc[a][b][m][n] = (f32x4){0.f, 0.f, 0.f, 0.f};
        cur = nxt; cA = nA; cB = nB; ++ui;
        if constexpr (ALIGN_EPI) { if (wr == 1) PG8_BAR; }
    }
    PG8_WAIT_V(0);
    if constexpr (!ALIGN_EPI) { if (wr == 0) PG8_BAR; }
    PG8_BAR;
    if constexpr (Epi::AFTER_DRAIN) { E.fused(acc, cur, wr, wc, fr, fq, lds, wid, lane); S.done(cur); }
#undef PG8_SA
#undef PG8_SB
#undef PG8_STAGE
#undef PG8_LDA
#undef PG8_LDB
#undef PG8_MMA
#undef PG8_WAIT_V
#undef PG8_WAIT_L
#undef PG8_BAR
#undef PG8_SCHED
}
}
#define GAS __attribute__((address_space(1)))
#define LAS __attribute__((address_space(3)))
typedef GAS unsigned gu32;
typedef GAS unsigned long long gu64;
#define RLX_AGENT __ATOMIC_RELAXED, __HIP_MEMORY_SCOPE_AGENT
#define LDS_WAIT() asm volatile("s_waitcnt lgkmcnt(0)" ::: "memory")
#define VM_WAIT() asm volatile("s_waitcnt vmcnt(0)" ::: "memory")
__device__ __forceinline__ unsigned long long rt() { return __builtin_amdgcn_s_memrealtime(); }
#define XB_TMO      128
#define XB_XCNT(j)  (256  + 64 * (j))
#define XB_XSUB(j)  (1280 + 64 * (j))
#define XB_XGEN(j)  (2304 + 64 * (j))
#define XB_TOP      3328
#define XB_TOPGEN   3392
#define XCD_BAR_WORDS 3456
#define XB_SPIN_CAP (1u << 18)

__device__ __forceinline__ unsigned xb_ld(unsigned* p)              { return __hip_atomic_load(p, __ATOMIC_RELAXED, __HIP_MEMORY_SCOPE_AGENT); }
__device__ __forceinline__ unsigned xb_add(unsigned* p, unsigned v) { return __hip_atomic_fetch_add(p, v, __ATOMIC_RELAXED, __HIP_MEMORY_SCOPE_AGENT); }
__device__ __forceinline__ unsigned xb_xcc_id() { return (unsigned)__builtin_amdgcn_s_getreg((3 << 11) | 20) & 0xFu; }
#define XB_SPIN(cond, bar) do { unsigned _sp = 0; while (cond) { __builtin_amdgcn_s_sleep(1); \
    if ((++_sp & 255u) == 0u) { if (xb_ld(&(bar)[XB_TMO])) break; if (_sp > XB_SPIN_CAP) { atomicAdd(&(bar)[XB_TMO], 1u); break; } } } } while (0)

struct XcdBarrier {
    unsigned* bar; unsigned x;
    volatile LAS unsigned* st;
};

__device__ __forceinline__ XcdBarrier xcd_barrier_post(unsigned* bar, volatile LAS unsigned* st) {
    XcdBarrier b; b.bar = bar; b.x = xb_xcc_id(); b.st = st;
    if (threadIdx.x == 0) (void)xb_add(&bar[XB_XCNT(b.x)], 1u);
    return b;
}
__device__ __forceinline__ void xcd_barrier_complete(unsigned* bar, unsigned x, unsigned& nloc, unsigned& nx) {
    const unsigned G = gridDim.x * gridDim.y * gridDim.z;
    unsigned sum, cnt, mine, sp = 0u;
    for (;;) {
        sum = 0u; cnt = 0u; mine = 0u;
#pragma unroll
        for (unsigned j = 0; j < 16; ++j) { const unsigned c = xb_ld(&bar[XB_XCNT(j)]); sum += c; cnt += (c > 0u) ? 1u : 0u; mine = (j == x) ? c : mine; }
        if (sum == G) break;
        __builtin_amdgcn_s_sleep(1);
        if ((++sp & 255u) == 0u) { if (xb_ld(&bar[XB_TMO])) break; if (sp > XB_SPIN_CAP) { atomicAdd(&bar[XB_TMO], 1u); break; } }
    }
    nloc = mine > 0u ? mine : 1u; nx = cnt > 0u ? cnt : 1u;
}

__device__ __forceinline__ void xcd_barrier(const XcdBarrier& b) {
    asm volatile("s_waitcnt vmcnt(0)" ::: "memory");
    __syncthreads();
    if (threadIdx.x == 0) {
        unsigned* bar = b.bar;
        __builtin_amdgcn_s_waitcnt(0);
        unsigned nloc = b.st[0], nx = b.st[1];
        if (nloc == 0u) { xcd_barrier_complete(bar, b.x, nloc, nx); b.st[0] = nloc; b.st[1] = nx; }
        const unsigned old = xb_add(&bar[XB_XSUB(b.x)], 1u);
        const unsigned gen = old / nloc;
        if (old + 1u == (gen + 1u) * nloc) {
            __builtin_amdgcn_fence(__ATOMIC_RELEASE, "agent");
            asm volatile("s_waitcnt vmcnt(0)" ::: "memory");
            const unsigned og = xb_add(&bar[XB_TOP], 1u);
            const unsigned tg = og / nx;
            if (og + 1u == (tg + 1u) * nx) xb_add(&bar[XB_TOPGEN], 1u);
            else XB_SPIN(xb_ld(&bar[XB_TOPGEN]) == tg, bar);
            __builtin_amdgcn_fence(__ATOMIC_ACQUIRE, "agent");
            xb_add(&bar[XB_XGEN(b.x)], 1u);
            asm volatile("s_waitcnt vmcnt(0)" ::: "memory");
        } else {
            XB_SPIN(xb_ld(&bar[XB_XGEN(b.x)]) == gen, bar);
            __builtin_amdgcn_fence(__ATOMIC_ACQUIRE, "agent");
            asm volatile("s_waitcnt vmcnt(0)" ::: "memory");
        }
    }
    __syncthreads();
}


constexpr int NB = 2, SEQ = 8192, DM = 1024, DEPTH = 4, NMETA = 16, LP = 8320, M = NB * LP;
constexpr int N_IN = 5384, N1 = 5376, NRW = 1792, NGT = 2048, DFF = 2816, NUP = 5632;
constexpr float LOG2E = 1.4426950408889634f;
constexpr float QSCALE = 0.125f * LOG2E;
constexpr float THR2 = 30.0f * LOG2E;
constexpr int NWAVES = 8, NTHR = 512, MMAIN = 16384;
constexpr int LDS_BYTES = 147456, MISC_OFF = 147456 - 128;

typedef unsigned short bf16;
typedef float f32x4 __attribute__((ext_vector_type(4)));
typedef unsigned u32x4 __attribute__((ext_vector_type(4)));
typedef unsigned u32x2 __attribute__((ext_vector_type(2)));
typedef short bf16x8 __attribute__((ext_vector_type(8)));

constexpr size_t SZ_H = (size_t)M * DM * 4, SZ_X512 = (size_t)M * 512 * 2;
constexpr size_t OFF_CTL = 0, OFF_H = 1u << 20, OFF_WT = OFF_H + SZ_H;
constexpr size_t WT_IN = 0, WT_BF = WT_IN + (size_t)N1 * 1024, WT_BR = WT_BF + 1024 * 512, WT_O = WT_BR + 1024 * 512,
                 WT_UP = WT_O + 1024 * 1024, WT_DN = WT_UP + (size_t)NUP * 1024, WT_LW = WT_DN + (size_t)1024 * DFF, WT_LA = WT_LW + 512 * 64, WT_LG = WT_LA + 512 * 64, WT_END = WT_LG + 512 * 128;
constexpr size_t OFF_HN = OFF_WT + WT_END * 2;
constexpr size_t OFF_Q = OFF_HN + 2 * SZ_X512, OFF_K = OFF_Q + SZ_X512, OFF_V = OFF_K + SZ_X512;
constexpr size_t OFF_RW = OFF_V + SZ_X512, OFF_GT = OFF_RW + (size_t)M * NRW * 2, OFF_MISC = OFF_GT + (size_t)M * NGT * 2;
constexpr size_t OFF_T0 = OFF_MISC + 2 * 16 * LP * 4, OFF_OF = OFF_T0 + 2 * SZ_X512, WS_NEED = OFF_OF + SZ_X512;
static_assert(OFF_HN % 256 == 0 && OFF_RW % 256 == 0 && OFF_T0 % 256 == 0, "alignment");

struct Params { const float* in[26]; float* out; unsigned char* ws; };
struct Ctx { int tid, lane, wave, bid, G; unsigned char* lds; unsigned char* ws; };

__device__ __forceinline__ float bf2f(unsigned b) { return __uint_as_float(b << 16); }
__device__ __forceinline__ float bflo(unsigned w) { return __uint_as_float(w << 16); }
__device__ __forceinline__ float bfhi(unsigned w) { return __uint_as_float(w & 0xffff0000u); }
__device__ __forceinline__ unsigned f2bf(float f) { unsigned u = __float_as_uint(f); return (u + 0x7fffu + ((u >> 16) & 1u)) >> 16; }
__device__ __forceinline__ unsigned pk2(float lo, float hi) { return f2bf(lo) | (f2bf(hi) << 16); }
__device__ __forceinline__ float wave_sum(float v) {
#pragma unroll
    for (int o = 1; o < 64; o <<= 1) v += __shfl_xor(v, o);
    return v;
}
__device__ __forceinline__ float sigmoidf_(float x) { return 1.f / (1.f + __expf(-x)); }
template <int CTRL> __device__ __forceinline__ float dppf(float old, float x) {
    return __int_as_float(__builtin_amdgcn_update_dpp(__float_as_int(old), __float_as_int(x), CTRL, 0xf, 0xf, false));
}
__device__ __forceinline__ float allreduce16(float x) {
    x += dppf<0x121>(0.f, x); x += dppf<0x122>(0.f, x); x += dppf<0x124>(0.f, x); x += dppf<0x128>(0.f, x); return x;
}

namespace pg8 {
struct EpiRoute {
    static constexpr bool PERM = true, AFTER_DRAIN = false;
    unsigned char* ws;
    __device__ __forceinline__ void operator()(const f32x4 (&acc)[2][2][4][2], const Unit& u, int wr, int wc, int fr, int fq) const {
        const int pn = u.pn; size_t off; int ldc, colt;
        if (pn < 6) { off = OFF_Q + (size_t)(pn >> 1) * SZ_X512; ldc = 512; colt = (pn & 1) * 256; }
        else if (pn < 13) { off = OFF_RW; ldc = NRW; colt = (pn - 6) * 256; }
        else { off = OFF_GT; ldc = NGT; colt = (pn - 13) * 256; }
        bf16_t* base = (bf16_t*)(ws + off);
        const int row0 = u.pm * BM + wr * 64 + fr, col0 = colt + wc * 32 + 8 * fq;
#pragma unroll
        for (int ai = 0; ai < 2; ++ai)
#pragma unroll
            for (int m = 0; m < 4; ++m) { bf16_t* rowp = base + (size_t)(row0 + ai * HALF + m * 16) * ldc + col0;
#pragma unroll
                for (int bj = 0; bj < 2; ++bj) { const f32x4 v0 = acc[ai][bj][m][0], v1 = acc[ai][bj][m][1];
                    u32x4 w; w.x = cvt_pk_bf16(v0[0], v0[1]); w.y = cvt_pk_bf16(v0[2], v0[3]); w.z = cvt_pk_bf16(v1[0], v1[1]); w.w = cvt_pk_bf16(v1[2], v1[3]);
                    *(u32x4*)(rowp + bj * HALF) = w; } }
    }
};
template <int MODE> struct EpiGate {
    static constexpr bool PERM = true, AFTER_DRAIN = false;
    bf16_t* O; const bf16_t* GT; const float* gb;
    __device__ __forceinline__ void operator()(const f32x4 (&acc)[2][2][4][2], const Unit& u, int wr, int wc, int fr, int fq) const {
        const int row0 = u.pm * BM + wr * 64 + fr, col0 = u.pn * BM + wc * 32 + 8 * fq;
#pragma unroll
        for (int bj = 0; bj < 2; ++bj) {
            const int c = col0 + bj * HALF;
            const f32x4 b0 = *(const f32x4*)(gb + MODE * 1024 + c), b1 = *(const f32x4*)(gb + MODE * 1024 + c + 4);
#pragma unroll
            for (int ai = 0; ai < 2; ++ai)
#pragma unroll
                for (int m = 0; m < 4; ++m) {
                    const size_t row = (size_t)(row0 + ai * HALF + m * 16);
                    const u32x4 gw = *(const u32x4*)(GT + row * NGT + MODE * 1024 + c);
                    const f32x4 v0 = acc[ai][bj][m][0], v1 = acc[ai][bj][m][1];
                    float r[8];
                    r[0] = sigmoidf_(bflo(gw.x) + b0[0]) * v0[0]; r[1] = sigmoidf_(bfhi(gw.x) + b0[1]) * v0[1];
                    r[2] = sigmoidf_(bflo(gw.y) + b0[2]) * v0[2]; r[3] = sigmoidf_(bfhi(gw.y) + b0[3]) * v0[3];
                    r[4] = sigmoidf_(bflo(gw.z) + b1[0]) * v1[0]; r[5] = sigmoidf_(bfhi(gw.z) + b1[1]) * v1[1];
                    r[6] = sigmoidf_(bflo(gw.w) + b1[2]) * v1[2]; r[7] = sigmoidf_(bfhi(gw.w) + b1[3]) * v1[3];
                    bf16_t* op = O + row * 1024 + c;
                    if (MODE == 1) { const u32x4 ow = *(const u32x4*)op;
                        r[0] += bflo(ow.x); r[1] += bfhi(ow.x); r[2] += bflo(ow.y); r[3] += bfhi(ow.y); r[4] += bflo(ow.z); r[5] += bfhi(ow.z); r[6] += bflo(ow.w); r[7] += bfhi(ow.w); }
                    u32x4 w; w.x = cvt_pk_bf16(r[0], r[1]); w.y = cvt_pk_bf16(r[2], r[3]); w.z = cvt_pk_bf16(r[4], r[5]); w.w = cvt_pk_bf16(r[6], r[7]);
                    *(u32x4*)op = w;
                }
        }
    }
};
struct EpiResid {
    static constexpr bool PERM = false, AFTER_DRAIN = false;
    float* H; float* OUT; int atomic;
    __device__ __forceinline__ void operator()(const f32x4 (&acc)[2][2][4][2], const Unit& u, int wr, int wc, int fr, int fq) const {
        const int row0 = u.pm * BM + wr * 64 + fr, col0 = u.pn * BM + wc * 32 + 4 * fq;
#pragma unroll
        for (int ai = 0; ai < 2; ++ai)
#pragma unroll
            for (int m = 0; m < 4; ++m) {
                const int row = row0 + ai * HALF + m * 16;
                float* hp = H + (size_t)row * DM + col0;
                const int b = row >= LP ? 1 : 0, t = row - b * LP;
                float* op = (OUT && t >= NMETA && t < NMETA + SEQ) ? OUT + ((size_t)b * SEQ + (t - NMETA)) * DM + col0 : nullptr;
#pragma unroll
                for (int bj = 0; bj < 2; ++bj)
#pragma unroll
                    for (int n = 0; n < 2; ++n) { const int co = bj * HALF + n * 16;
                        if (atomic) {
#pragma unroll
                            for (int e = 0; e < 4; ++e) unsafeAtomicAdd(hp + co + e, acc[ai][bj][m][n][e]);
                        } else {
                            const f32x4 v = *(const f32x4*)(hp + co) + acc[ai][bj][m][n];
                            if (OUT) { if (op) *(f32x4*)(op + co) = v; } else *(f32x4*)(hp + co) = v; } }
            }
    }
};
struct EpiResidAtomic {
    static constexpr bool PERM = false, AFTER_DRAIN = false;
    float* H;
    __device__ __forceinline__ void operator()(const f32x4 (&acc)[2][2][4][2], const Unit& u, int wr, int wc, int fr, int fq) const {
        const int row0 = u.pm * BM + wr * 64 + fr, col0 = u.pn * BM + wc * 32 + 4 * fq;
#pragma unroll
        for (int ai = 0; ai < 2; ++ai)
#pragma unroll
            for (int m = 0; m < 4; ++m) { float* hp = H + (size_t)(row0 + ai * HALF + m * 16) * DM + col0;
#pragma unroll
                for (int bj = 0; bj < 2; ++bj)
#pragma unroll
                    for (int n = 0; n < 2; ++n)
#pragma unroll
                        for (int e = 0; e < 4; ++e) unsafeAtomicAdd(hp + bj * HALF + n * 16 + e, acc[ai][bj][m][n][e]); }
    }
};
struct OneUnit {
    StaticOrder so; int mode, pm, pn; bool active;
    __device__ bool next(int i, Unit& u) const { if (mode == 0) return so.next(i, u); if (i != 0 || !active) return false; u.pm = pm; u.pn = pn; return true; }
    __device__ __forceinline__ void a_ready(const Unit&) const {}
    __device__ __forceinline__ void done(const Unit&) const {}
};
struct EpiUp {
    static constexpr bool PERM = true, AFTER_DRAIN = false;
    bf16_t* ACT; bf16_t* HALO; const float* cw;
    __device__ __forceinline__ void operator()(const f32x4 (&acc)[2][2][4][2], const Unit& u, int wr, int wc, int fr, int fq) const {
        const int chan0 = u.pn * 128 + wc * 32 + 8 * fq;
#pragma unroll
        for (int n = 0; n < 2; ++n) {
            const int ch = chan0 + 4 * n;
            f32x4 w[3][2];
#pragma unroll
            for (int j = 0; j < 3; ++j) { w[j][0] = *(const f32x4*)(cw + j * NUP + ch); w[j][1] = *(const f32x4*)(cw + j * NUP + DFF + ch); }
#pragma unroll
            for (int ai = 0; ai < 2; ++ai) {
                const int rowg = u.pm * BM + ai * HALF + wr * 64;
#pragma unroll
                for (int m = 0; m < 4; ++m) {
                    f32x4 uc[2];
#pragma unroll
                    for (int bj = 0; bj < 2; ++bj) {
                        const f32x4 cur = acc[ai][bj][m][n];
                        f32x4 prv; if (m > 0) prv = acc[ai][bj][m - 1][n]; else prv = (f32x4){0.f, 0.f, 0.f, 0.f};
                        f32x4 p1, p2;
#pragma unroll
                        for (int i = 0; i < 4; ++i) {
                            const float r1 = dppf<0x121>(0.f, prv[i]), r2 = dppf<0x122>(0.f, prv[i]);
                            p1[i] = dppf<0x111>(r1, cur[i]); p2[i] = dppf<0x112>(r2, cur[i]);
                        }
                        uc[bj] = w[0][bj] * p2 + w[1][bj] * p1 + w[2][bj] * cur;
                    }
                    float a[4];
#pragma unroll
                    for (int i = 0; i < 4; ++i) a[i] = uc[0][i] * sigmoidf_(uc[0][i]) * uc[1][i];
                    u32x2 o; o.x = cvt_pk_bf16(a[0], a[1]); o.y = cvt_pk_bf16(a[2], a[3]);
                    *(u32x2*)(ACT + (size_t)(rowg + m * 16 + fr) * DFF + ch) = o;
                    if ((m == 3 && fr >= 14) || (m == 0 && fr < 2)) {
                        const int slot = (rowg >> 6) * 4 + (m == 3 ? fr - 14 : 2 + fr);
#pragma unroll
                        for (int bj = 0; bj < 2; ++bj) { const f32x4 cur = acc[ai][bj][m][n]; u32x2 hw; hw.x = cvt_pk_bf16(cur[0], cur[1]); hw.y = cvt_pk_bf16(cur[2], cur[3]);
                            *(u32x2*)(HALO + (size_t)slot * NUP + bj * DFF + ch) = hw; }
                    }
                }
            }
        }
    }
};
}

#ifndef REP_PREP
#define REP_PREP 1
#endif
#ifndef REP_P3
#define REP_P3 1
#endif
#ifndef REP_SYNC
#define REP_SYNC 0
#endif
__device__ __forceinline__ void transpose_item(const float* W, int Nsrc, int K, bf16* WT, int dst_row0, int src_col0, int k0, float* scr, int lane) {
#pragma unroll 8
    for (int i = 0; i < 32; ++i) { const int kk = 2 * i + (lane >> 5); scr[kk * 33 + (lane & 31)] = W[(size_t)(k0 + kk) * Nsrc + src_col0 + (lane & 31)]; }
    asm volatile("s_waitcnt lgkmcnt(0)" ::: "memory");
    const int c = lane & 7;
#pragma unroll
    for (int j = 0; j < 4; ++j) { const int n = (lane >> 3) + 8 * j; const float* s = scr + (8 * c) * 33 + n;
        u32x4 o; o.x = pk2(s[0 * 33], s[1 * 33]); o.y = pk2(s[2 * 33], s[3 * 33]); o.z = pk2(s[4 * 33], s[5 * 33]); o.w = pk2(s[6 * 33], s[7 * 33]);
        *(u32x4*)(WT + (size_t)(dst_row0 + n) * K + k0 + 8 * c) = o; }
    asm volatile("s_waitcnt lgkmcnt(0)" ::: "memory");
}
__device__ __forceinline__ void convert_weights(const Params& P, int l, const Ctx& c) {
    bf16* WT = (bf16*)(c.ws + OFF_WT);
    float* scr = (float*)(c.lds + c.wave * 16384);
    const int gw = c.bid * NWAVES + c.wave, NGW = c.G * NWAVES;
    constexpr int I_IN = 16 * 168, I_BF = 8 * 32, I_O = 16 * 32, I_UP = 16 * 176, I_DN = 44 * 32, I_LR = 16, I_LG = 32, I_ALL = I_IN + 2 * I_BF + I_O + I_UP + I_DN + 2 * I_LR + I_LG;
    for (int it = gw; it < I_ALL; it += NGW) {
        int r = it;
        if (r < I_IN) { const int kb = r / 168, n0 = 32 * (r % 168); transpose_item(P.in[4] + (size_t)l * 1024 * N_IN, N_IN, 1024, WT + WT_IN, n0, n0 + (n0 >= 1536 ? 8 : 0), 64 * kb, scr, c.lane); continue; } r -= I_IN;
        if (r < I_BF) { const int kb = r / 32, n0 = 32 * (r % 32); transpose_item(P.in[19] + (size_t)l * 512 * 1024, 1024, 512, WT + WT_BF, n0, n0, 64 * kb, scr, c.lane); continue; } r -= I_BF;
        if (r < I_BF) { const int kb = r / 32, n0 = 32 * (r % 32); transpose_item(P.in[20] + (size_t)l * 512 * 1024, 1024, 512, WT + WT_BR, n0, n0, 64 * kb, scr, c.lane); continue; } r -= I_BF;
        if (r < I_O) { const int kb = r / 32, n0 = 32 * (r % 32); transpose_item(P.in[22] + (size_t)l * 1024 * 1024, 1024, 1024, WT + WT_O, n0, n0, 64 * kb, scr, c.lane); continue; } r -= I_O;
        if (r < I_UP) { const int kb = r / 176, n0 = 32 * (r % 176); const int pn = n0 >> 8, bj = (n0 >> 7) & 1, x = n0 & 127;
            transpose_item(P.in[23] + (size_t)l * 1024 * NUP, NUP, 1024, WT + WT_UP, n0, bj * DFF + 128 * pn + x, 64 * kb, scr, c.lane); continue; } r -= I_UP;
        if (r < I_DN) { const int kb = r / 32, n0 = 32 * (r % 32); transpose_item(P.in[25] + (size_t)l * DFF * 1024, 1024, DFF, WT + WT_DN, n0, n0, 64 * kb, scr, c.lane); continue; } r -= I_DN;
        if (r < I_LR) { transpose_item(P.in[10] + (size_t)l * 64 * 512, 512, 64, WT + WT_LW, 32 * r, 32 * r, 0, scr, c.lane); continue; } r -= I_LR;
        if (r < I_LR) { transpose_item(P.in[12] + (size_t)l * 64 * 512, 512, 64, WT + WT_LA, 32 * r, 32 * r, 0, scr, c.lane); continue; } r -= I_LR;
        { const int kb = r / 16, n0 = 32 * (r % 16); transpose_item(P.in[13] + (size_t)l * 128 * 512, 512, 128, WT + WT_LG, n0, n0, 64 * kb, scr, c.lane); }
    }
}

template <bool FG> __device__ __forceinline__ void phase_norm(const Params& P, int l, const Ctx& c) {
    float* H = (float*)(c.ws + OFF_H); bf16* HN = (bf16*)(c.ws + OFF_HN);
    float* LOGF = (float*)(c.ws + OFF_MISC);
    const float* gain = (FG ? P.in[2] : P.in[3]) + l * DM;
    float* wfs = (float*)c.lds;
    if (FG) {
        __syncthreads();
        const float* win = P.in[4] + (size_t)l * 1024 * N_IN + 1536;
        for (int i = c.tid; i < 8192; i += NTHR) wfs[i] = win[(size_t)(i >> 3) * N_IN + (i & 7)];
        __syncthreads();
    }
    const int gw = c.bid * NWAVES + c.wave, NGW = c.G * NWAVES;
    for (int m = gw; m < M; m += NGW) {
        const int b = m >= LP ? 1 : 0, t = m - b * LP;
        f32x4 v[4];
        if (FG && l == 0) {
            const float* src = (t < NMETA) ? P.in[1] + (size_t)t * DM : P.in[0] + ((size_t)b * SEQ + (t - NMETA)) * DM;
            const bool real = t < NMETA + SEQ;
#pragma unroll
            for (int j = 0; j < 4; ++j) { v[j] = real ? *(const f32x4*)(src + 4 * c.lane + 256 * j) : (f32x4){0.f, 0.f, 0.f, 0.f}; *(f32x4*)(H + (size_t)m * DM + 4 * c.lane + 256 * j) = v[j]; }
        } else {
#pragma unroll
            for (int j = 0; j < 4; ++j) v[j] = *(const f32x4*)(H + (size_t)m * DM + 4 * c.lane + 256 * j);
        }
        float ss = 0.f;
#pragma unroll
        for (int j = 0; j < 4; ++j) ss += (v[j].x * v[j].x + v[j].y * v[j].y) + (v[j].z * v[j].z + v[j].w * v[j].w);
        const float rstd = 1.0f / sqrtf(wave_sum(ss) * (1.f / DM) + 1e-6f);
        float f[8];
#pragma unroll
        for (int q = 0; q < 8; ++q) f[q] = 0.f;
#pragma unroll
        for (int j = 0; j < 4; ++j) {
            const f32x4 g = *(const f32x4*)(gain + 4 * c.lane + 256 * j);
            v[j] = v[j] * rstd * g;
            u32x2 o; o.x = pk2(v[j].x, v[j].y); o.y = pk2(v[j].z, v[j].w);
            *(u32x2*)(HN + (size_t)m * DM + 4 * c.lane + 256 * j) = o;
            if (FG) {
#pragma unroll
                for (int e = 0; e < 4; ++e) { const int k = 4 * c.lane + 256 * j + e; const f32x4 w0 = *(const f32x4*)(wfs + k * 8), w1 = *(const f32x4*)(wfs + k * 8 + 4);
                    const float hv = v[j][e];
                    f[0] += hv * w0.x; f[1] += hv * w0.y; f[2] += hv * w0.z; f[3] += hv * w0.w; f[4] += hv * w1.x; f[5] += hv * w1.y; f[6] += hv * w1.z; f[7] += hv * w1.w; }
            }
        }
        if (FG) {
#pragma unroll
            for (int q = 0; q < 8; ++q) f[q] = wave_sum(f[q]);
            float fv = f[0];
#pragma unroll
            for (int q = 1; q < 8; ++q) fv = (c.lane == q) ? f[q] : fv;
            if (c.lane < 8) { const float x = fv + P.in[7][l * 8 + c.lane]; const float ls = fminf(x, 0.f) - __logf(1.f + __expf(-fabsf(x))); LOGF[(size_t)(b * 8 + c.lane) * LP + t] = ls; }
        }
    }
}

__device__ __forceinline__ void phase_fcum(const Params& P, const Ctx& c) {
    if (c.bid < 16 && c.wave == 0) {
        const float* LOGF = (const float*)(c.ws + OFF_MISC) + (size_t)c.bid * LP; float* FC = (float*)(c.ws + OFF_MISC) + 16 * LP + (size_t)c.bid * LP;
        float carry = 0.f;
        for (int ch = 0; ch < LP / 64; ++ch) {
            float v = LOGF[ch * 64 + c.lane];
#pragma unroll
            for (int o = 1; o < 64; o <<= 1) { const float t = __shfl_up(v, o); if (c.lane >= o) v += t; }
            v += carry; FC[ch * 64 + c.lane] = v * LOG2E; carry = __shfl(v, 63);
        }
    }
}

__device__ __forceinline__ void phase_qknorm(const Params& P, int l, const Ctx& c) {
    bf16* Q = (bf16*)(c.ws + OFF_Q); bf16* K = (bf16*)(c.ws + OFF_K);
    const int gw = c.bid * NWAVES + c.wave, NGW = c.G * NWAVES;
    const int d0 = (c.lane & 7) * 8;
    float gq[8], gk[8];
#pragma unroll
    for (int i = 0; i < 8; ++i) { gq[i] = P.in[5][l * 64 + d0 + i] * QSCALE; gk[i] = P.in[6][l * 64 + d0 + i]; }
    for (int m = gw; m < M; m += NGW) {
#pragma unroll
        for (int which = 0; which < 2; ++which) {
            bf16* p = (which ? K : Q) + (size_t)m * 512 + 8 * c.lane;
            const u32x4 w = *(const u32x4*)p;
            float x[8] = {bflo(w.x), bfhi(w.x), bflo(w.y), bfhi(w.y), bflo(w.z), bfhi(w.z), bflo(w.w), bfhi(w.w)};
            float ss = 0.f;
#pragma unroll
            for (int i = 0; i < 8; ++i) ss += x[i] * x[i];
            ss += __shfl_xor(ss, 1); ss += __shfl_xor(ss, 2); ss += __shfl_xor(ss, 4);
            const float rs = 1.0f / sqrtf(ss * (1.f / 64.f) + 1e-6f);
#pragma unroll
            for (int i = 0; i < 8; ++i) x[i] = x[i] * rs * (which ? gk[i] : gq[i]);
            u32x4 o; o.x = pk2(x[0], x[1]); o.y = pk2(x[2], x[3]); o.z = pk2(x[4], x[5]); o.w = pk2(x[6], x[7]);
            *(u32x4*)p = o;
        }
    }
}

constexpr int NCHK = LP / 64;
constexpr int NUNIT = NB * NCHK * 8;
constexpr int UNIT_A = 16384, UNIT_B = 16640;
constexpr int ST = 72, STG = 136;
constexpr int L_F0 = 92160, L_F1 = 108544;
struct RwkvBufs { bf16 *BON, *G; unsigned char *UA, *UB; float* Y; bf16* ORW; };
__device__ __forceinline__ RwkvBufs rwkv_bufs(const Params& P, const Ctx& c) {
    RwkvBufs r; r.BON = (bf16*)(c.ws + OFF_HN); r.G = r.BON + (size_t)M * 512;
    r.UA = c.ws + OFF_T0; r.UB = (unsigned char*)P.out;
    r.Y = (float*)(c.ws + OFF_RW); r.ORW = (bf16*)(c.ws + OFF_RW + (size_t)M * 512 * 4);
    return r;
}
__device__ __forceinline__ void mm_tile(const bf16* A, int sa, const bf16* Bt, int sb, int nks, f32x4 (&acc)[2], int w, int lq, int g) {
    const int mt = w >> 1, nt0 = 2 * (w & 1);
    for (int ks = 0; ks < nks; ++ks) {
        const bf16x8 a = *(const bf16x8*)(A + (16 * mt + lq) * sa + 32 * ks + 8 * g);
#pragma unroll
        for (int q = 0; q < 2; ++q) { const bf16x8 b = *(const bf16x8*)(Bt + (16 * (nt0 + q) + lq) * sb + 32 * ks + 8 * g); acc[q] = __builtin_amdgcn_mfma_f32_16x16x32_bf16(a, b, acc[q], 0, 0, 0); }
    }
}
#define ZACC(a) do { a[0] = (f32x4){0.f, 0.f, 0.f, 0.f}; a[1] = (f32x4){0.f, 0.f, 0.f, 0.f}; } while (0)
__device__ __forceinline__ int permk(int k) { return 32 * (k >> 5) + 8 * ((k & 15) >> 2) + 4 * ((k >> 4) & 1) + (k & 3); }
__device__ __forceinline__ int swz(int row, int col) { return row * 128 + ((((col >> 3) ^ (row >> 1)) & 7) << 4) + (col & 7) * 2; }

__device__ __forceinline__ void rwkv_prep_unit(const Params& P, int l, const Ctx& c, int u, const RwkvBufs& B) {
    const int h = u & 7, bc = u >> 3, b = bc / NCHK, ch = bc - b * NCHK;
    const size_t m0 = (size_t)b * LP + ch * 64;
    int tid_ = c.tid; asm volatile("" : "+v"(tid_));
    const int tid = tid_, lane = tid & 63, w = c.wave, lq = lane & 15, g = lane >> 4;
    const int t = tid >> 3, cg = tid & 7, c0 = cg * 8, jb = h * 64 + c0;
    unsigned char* L = c.lds;
    bf16* A0 = (bf16*)L; bf16* A1 = A0 + 4608; bf16* A2 = A1 + 4608; bf16* A3 = A2 + 4608; bf16* A4 = A3 + 4608; bf16* A5 = A4 + 4608; bf16* A6 = A5 + 4608;
    bf16* A7 = A6 + 4608; bf16* A8 = A7 + 4608; bf16* A9 = A8 + 4608;
    float* F0 = (float*)(L + L_F0); float* F1 = (float*)(L + L_F1);
    const bf16* RW = (const bf16*)(c.ws + OFF_RW);
    const bf16* WT = (const bf16*)(c.ws + OFF_WT);
    const float* mu = P.in[8] + l * NRW;
    const bool first = (ch == 0 && t == 0);
    const bf16* cur = RW + (m0 + t) * NRW; const bf16* prv = cur - NRW;
    float zr[8], zk[8], zv[8];
#pragma unroll
    for (int s = 0; s < 3; ++s) {
        const u32x4 cw = *(const u32x4*)(cur + s * 512 + jb); u32x4 pw = (u32x4){0u, 0u, 0u, 0u}; if (!first) pw = *(const u32x4*)(prv + s * 512 + jb);
        const float cv[8] = {bflo(cw.x), bfhi(cw.x), bflo(cw.y), bfhi(cw.y), bflo(cw.z), bfhi(cw.z), bflo(cw.w), bfhi(cw.w)};
        const float pv[8] = {bflo(pw.x), bfhi(pw.x), bflo(pw.y), bfhi(pw.y), bflo(pw.z), bfhi(pw.z), bflo(pw.w), bfhi(pw.w)};
#pragma unroll
        for (int i = 0; i < 8; ++i) { const float z = cv[i] + mu[s * 512 + jb + i] * (pv[i] - cv[i]); if (s == 0) zr[i] = z; else if (s == 1) zk[i] = z; else zv[i] = z; }
    }
#pragma unroll
    for (int q4 = 0; q4 < 4; ++q4) {
        const int col = cg * 32 + q4 * 8;
        const u32x4 cw = *(const u32x4*)(cur + 1536 + col); u32x4 pw = (u32x4){0u, 0u, 0u, 0u}; if (!first) pw = *(const u32x4*)(prv + 1536 + col);
        const float cv[8] = {bflo(cw.x), bfhi(cw.x), bflo(cw.y), bfhi(cw.y), bflo(cw.z), bfhi(cw.z), bflo(cw.w), bfhi(cw.w)};
        const float pv[8] = {bflo(pw.x), bfhi(pw.x), bflo(pw.y), bfhi(pw.y), bflo(pw.z), bfhi(pw.z), bflo(pw.w), bfhi(pw.w)};
        float z[8];
#pragma unroll
        for (int i = 0; i < 8; ++i) { z[i] = cv[i] + mu[1536 + col + i] * (pv[i] - cv[i]); if (col < 64) z[i] = 1.f - 2.f / (1.f + __expf(2.f * z[i])); else if (col >= 128) z[i] = sigmoidf_(z[i]); }
        u32x4 o; o.x = pk2(z[0], z[1]); o.y = pk2(z[2], z[3]); o.z = pk2(z[4], z[5]); o.w = pk2(z[6], z[7]);
        bf16* dst = (col < 64) ? A0 + t * ST + col : (col < 128 ? A1 + t * ST + (col - 64) : A2 + t * STG + (col - 128));
        *(u32x4*)dst = o;
    }
    { const int row = tid >> 3, chk = tid & 7;
      *(u32x4*)(A4 + row * ST + chk * 8) = *(const u32x4*)(WT + WT_LW + (size_t)(h * 64 + row) * 64 + chk * 8);
      *(u32x4*)(A5 + row * ST + chk * 8) = *(const u32x4*)(WT + WT_LA + (size_t)(h * 64 + row) * 64 + chk * 8);
#pragma unroll
      for (int i = 0; i < 2; ++i) { const int idx = tid + 512 * i, r2 = idx >> 4, c2 = idx & 15;
          *(u32x4*)((bf16*)F1 + r2 * STG + c2 * 8) = *(const u32x4*)(WT + WT_LG + (size_t)(h * 64 + r2) * 128 + c2 * 8); } }
    __syncthreads();
    { f32x4 aw[2], aa[2], ag[2]; ZACC(aw); ZACC(aa); ZACC(ag);
      mm_tile(A0, ST, A4, ST, 2, aw, w, lq, g); mm_tile(A1, ST, A5, ST, 2, aa, w, lq, g); mm_tile(A2, STG, (const bf16*)F1, STG, 4, ag, w, lq, g);
      const int mt = w >> 1, nt0 = 2 * (w & 1);
#pragma unroll
      for (int q = 0; q < 2; ++q)
#pragma unroll
          for (int j = 0; j < 4; ++j) { const int o = (16 * mt + 4 * g + j) * ST + 16 * (nt0 + q) + lq; A7[o] = (bf16)f2bf(aw[q][j]); A8[o] = (bf16)f2bf(aa[q][j]); A9[o] = (bf16)f2bf(ag[q][j]); } }
    __syncthreads();
    float kk[8], k2[8], ar[8];
    { const u32x4 lw = *(const u32x4*)(A7 + t * ST + c0), la = *(const u32x4*)(A8 + t * ST + c0), lg = *(const u32x4*)(A9 + t * ST + c0);
      const float fw[8] = {bflo(lw.x), bfhi(lw.x), bflo(lw.y), bfhi(lw.y), bflo(lw.z), bfhi(lw.z), bflo(lw.w), bfhi(lw.w)};
      const float fa[8] = {bflo(la.x), bfhi(la.x), bflo(la.y), bfhi(la.y), bflo(la.z), bfhi(la.z), bflo(la.w), bfhi(la.w)};
      float ss = 0.f, bs = 0.f;
#pragma unroll
      for (int i = 0; i < 8; ++i) { const int j = l * 512 + jb + i;
          const float xw = -(P.in[9][j] + fw[i]); const float sp = fmaxf(xw, 0.f) + __logf(1.f + __expf(-fabsf(xw)));
          F0[t * 64 + c0 + i] = __expf(-sp - 0.5f);
          ar[i] = sigmoidf_(P.in[11][j] + fa[i]);
          kk[i] = zk[i] * P.in[14][j]; ss += kk[i] * kk[i];
          k2[i] = zk[i] * (1.f + (ar[i] - 1.f) * P.in[15][j]);
          bs += zr[i] * k2[i] * P.in[16][j]; }
      ss += __shfl_xor(ss, 1); ss += __shfl_xor(ss, 2); ss += __shfl_xor(ss, 4);
      bs += __shfl_xor(bs, 1); bs += __shfl_xor(bs, 2); bs += __shfl_xor(bs, 4);
      const float inv = 1.0f / fmaxf(sqrtf(ss), 1e-12f);
#pragma unroll
      for (int i = 0; i < 8; ++i) kk[i] *= inv;
      u32x4 bo; bo.x = pk2(bs * zv[0], bs * zv[1]); bo.y = pk2(bs * zv[2], bs * zv[3]); bo.z = pk2(bs * zv[4], bs * zv[5]); bo.w = pk2(bs * zv[6], bs * zv[7]);
      *(u32x4*)(B.BON + (m0 + t) * 512 + jb) = bo; *(u32x4*)(B.G + (m0 + t) * 512 + jb) = lg; }
    __syncthreads();
    {
      const int k = tid & 63, sg = tid >> 6; float e[8], run = 0.f;
#pragma unroll
      for (int s = 0; s < 8; ++s) { run += F0[(8 * sg + s) * 64 + k]; e[s] = run; }
      F1[sg * 64 + k] = run;
      __syncthreads();
      float off = 0.f;
#pragma unroll
      for (int s = 0; s < 8; ++s) off += (s < sg) ? F1[s * 64 + k] : 0.f;
#pragma unroll
      for (int s = 0; s < 8; ++s) F0[(8 * sg + s) * 64 + k] = e[s] + off; }
    __syncthreads();
    { float ct[8], cp[8], cC[8];
#pragma unroll
      for (int i = 0; i < 8; ++i) { ct[i] = F0[t * 64 + c0 + i]; cp[i] = (t > 0) ? F0[(t - 1) * 64 + c0 + i] : 0.f; cC[i] = F0[63 * 64 + c0 + i]; }
      float at[8], bt[8], kt[8], rt[8], bh[8], kh[8];
#pragma unroll
      for (int i = 0; i < 8; ++i) { const float gt = __expf(-ct[i]), igt = __expf(ct[i]), gp = __expf(-cp[i]), gct = __expf(ct[i] - cC[i]);
          at[i] = -kk[i] * gp; bt[i] = kk[i] * ar[i] * igt; kt[i] = k2[i] * igt; rt[i] = zr[i] * gt; bh[i] = kk[i] * ar[i] * gct; kh[i] = k2[i] * gct; }
      u32x4 o;
      o.x = pk2(at[0], at[1]); o.y = pk2(at[2], at[3]); o.z = pk2(at[4], at[5]); o.w = pk2(at[6], at[7]); *(u32x4*)(A0 + t * ST + c0) = o;
      o.x = pk2(bt[0], bt[1]); o.y = pk2(bt[2], bt[3]); o.z = pk2(bt[4], bt[5]); o.w = pk2(bt[6], bt[7]); *(u32x4*)(A1 + t * ST + c0) = o;
      o.x = pk2(kt[0], kt[1]); o.y = pk2(kt[2], kt[3]); o.z = pk2(kt[4], kt[5]); o.w = pk2(kt[6], kt[7]); *(u32x4*)(A2 + t * ST + c0) = o;
      o.x = pk2(rt[0], rt[1]); o.y = pk2(rt[2], rt[3]); o.z = pk2(rt[4], rt[5]); o.w = pk2(rt[6], rt[7]); *(u32x4*)(A3 + t * ST + c0) = o;
#pragma unroll
      for (int i = 0; i < 8; ++i) { A4[(c0 + i) * ST + t] = (bf16)f2bf(bh[i]); A5[(c0 + i) * ST + t] = (bf16)f2bf(kh[i]); A6[(c0 + i) * ST + t] = (bf16)f2bf(zv[i]); F1[t * 128 + c0 + i] = at[i]; }
      if (t == 63) { float* gc = (float*)(B.UB + (size_t)u * UNIT_B + 16384) + c0;
#pragma unroll
          for (int i = 0; i < 8; ++i) gc[i] = __expf(-cC[i]); } }
    __syncthreads();
    { const int mt = w >> 1, nt0 = 2 * (w & 1);
      f32x4 a1[2], a2[2], a3[2], a4[2]; ZACC(a1); ZACC(a2); ZACC(a3); ZACC(a4);
      mm_tile(A0, ST, A1, ST, 2, a1, w, lq, g); mm_tile(A0, ST, A2, ST, 2, a2, w, lq, g); mm_tile(A3, ST, A1, ST, 2, a3, w, lq, g); mm_tile(A3, ST, A2, ST, 2, a4, w, lq, g);
      __syncthreads();
#pragma unroll
      for (int q = 0; q < 2; ++q) { const int i = 16 * (nt0 + q) + lq; f32x4 lab;
#pragma unroll
          for (int j = 0; j < 4; ++j) { const int tt = 16 * mt + 4 * g + j; lab[j] = (i < tt) ? a1[q][j] : 0.f;
              A7[tt * ST + i] = (bf16)f2bf((i < tt) ? a2[q][j] : 0.f); A8[tt * ST + i] = (bf16)f2bf((i <= tt) ? a3[q][j] : 0.f); A9[tt * ST + i] = (bf16)f2bf((i <= tt) ? a4[q][j] : 0.f); }
          *(f32x4*)(F0 + i * 64 + 16 * mt + 4 * g) = lab; } }
    __syncthreads();
    { const int mt = w >> 1, nt0 = 2 * (w & 1); f32x4 a[2]; ZACC(a);
      mm_tile(A7, ST, A6, ST, 2, a, w, lq, g);
#pragma unroll
      for (int q = 0; q < 2; ++q)
#pragma unroll
          for (int j = 0; j < 4; ++j) F1[(16 * mt + 4 * g + j) * 128 + 64 + 16 * (nt0 + q) + lq] = a[q][j]; }
    __syncthreads();
    { float X[16];
      const int col = 16 * w + lq;
#pragma unroll
      for (int r = 0; r < 16; ++r) X[r] = F1[(4 * r + g) * 128 + col];
      __syncthreads();
#pragma unroll
      for (int i = 0; i < 64; ++i) {
          const float xi = __shfl(X[i >> 2], (i & 3) * 16 + lq);
#pragma unroll
          for (int r = (i >> 2); r < 16; ++r) X[r] += F0[i * 64 + 4 * r + g] * xi;
          asm volatile("" ::: "memory");
      }
      bf16* XT = (bf16*)F1 + (w >> 2) * 4608 + ((col & 63) * ST);
#pragma unroll
      for (int r = 0; r < 16; ++r) XT[4 * r + g] = (bf16)f2bf(X[r]); }
    __syncthreads();
    { const int mt = w >> 1, nt0 = 2 * (w & 1);
      const bf16* AhT = (const bf16*)F1; const bf16* W2T = AhT + 4608;
      unsigned char* ua = B.UA + (size_t)u * UNIT_A; unsigned char* ub = B.UB + (size_t)u * UNIT_B;
      f32x4 a[2];
      ZACC(a); mm_tile(A4, ST, AhT, ST, 2, a, w, lq, g);
#pragma unroll
      for (int q = 0; q < 2; ++q)
#pragma unroll
          for (int j = 0; j < 4; ++j) { const int row = 16 * mt + 4 * g + j, kc = 16 * (nt0 + q) + lq; *(bf16*)(ua + swz(row, permk(kc))) = (bf16)f2bf(a[q][j]); }
      ZACC(a); mm_tile(A8, ST, AhT, ST, 2, a, w, lq, g);
#pragma unroll
      for (int q = 0; q < 2; ++q)
#pragma unroll
          for (int j = 0; j < 4; ++j) { const int row = 16 * mt + 4 * g + j, kc = 16 * (nt0 + q) + lq; *(bf16*)(ua + 8192 + swz(row, permk(kc))) = (bf16)f2bf(a[q][j] + bf2f(A3[row * ST + kc])); }
      ZACC(a); mm_tile(A4, ST, W2T, ST, 2, a, w, lq, g); mm_tile(A5, ST, A6, ST, 2, a, w, lq, g);
#pragma unroll
      for (int q = 0; q < 2; ++q) { const int v = 16 * (nt0 + q) + lq, k0 = 16 * mt + 4 * g; u32x2 o; o.x = pk2(a[q][0], a[q][1]); o.y = pk2(a[q][2], a[q][3]); *(u32x2*)(ub + swz(v, k0)) = o; }
      ZACC(a); mm_tile(A8, ST, W2T, ST, 2, a, w, lq, g); mm_tile(A9, ST, A6, ST, 2, a, w, lq, g);
#pragma unroll
      for (int q = 0; q < 2; ++q) { const int v = 16 * (nt0 + q) + lq, t0 = 16 * mt + 4 * g; u32x2 o; o.x = pk2(a[q][0], a[q][1]); o.y = pk2(a[q][2], a[q][3]); *(u32x2*)(ub + 8192 + swz(v, t0)) = o; } }
    __syncthreads();
}
__device__ __forceinline__ void phase_rwkv_prep(const Params& P, int l, const Ctx& c) {
    const RwkvBufs B = rwkv_bufs(P, c);
    for (int u = c.bid; u < NUNIT; u += c.G) rwkv_prep_unit(P, l, c, u, B);
}

constexpr int SLOTB = 33280;
__device__ __forceinline__ void scan_chunked(const Params& P, const Ctx& c, int bh) {
    const RwkvBufs B = rwkv_bufs(P, c);
    const int b = bh >> 3, h = bh & 7, w = c.wave, lane = c.lane, lq = lane & 15, g = lane >> 4;
    const size_t rowb = (size_t)b * LP;
    const int ll = (w - 4) * 64 + lane;
    unsigned char* L = c.lds;
    f32x4 st[4];
#pragma unroll
    for (int i = 0; i < 4; ++i) st[i] = (f32x4){0.f, 0.f, 0.f, 0.f};
    u32x4 ra[9], rb[9];
#define SC_UNIT(cc) ((size_t)((b * NCHK + (cc)) * 8 + h))
#define SC_LOAD(R, cc) do { const unsigned char* pa_ = B.UA + SC_UNIT(cc) * UNIT_A; const unsigned char* pb_ = B.UB + SC_UNIT(cc) * UNIT_B; \
        _Pragma("unroll") for (int i_ = 0; i_ < 4; ++i_) { R[i_] = *(const u32x4*)(pa_ + (ll + 256 * i_) * 16); R[4 + i_] = *(const u32x4*)(pb_ + (ll + 256 * i_) * 16); } \
        if (ll < 16) R[8] = *(const u32x4*)(pb_ + 16384 + ll * 16); } while (0)
#define SC_WRITE(R, slot) do { unsigned char* s_ = L + (slot) * SLOTB; \
        _Pragma("unroll") for (int i_ = 0; i_ < 4; ++i_) { *(u32x4*)(s_ + (ll + 256 * i_) * 16) = R[i_]; *(u32x4*)(s_ + 16384 + (ll + 256 * i_) * 16) = R[4 + i_]; } \
        if (ll < 16) *(u32x4*)(s_ + 32768 + ll * 16) = R[8]; } while (0)
    if (w >= 4) { SC_LOAD(ra, 0); SC_LOAD(rb, 1); SC_WRITE(ra, 0); SC_WRITE(rb, 1); SC_LOAD(ra, 2); SC_LOAD(rb, 3); }
    __syncthreads();
    for (int cc = 0; cc < NCHK; cc += 2) {
#pragma unroll
        for (int half = 0; half < 2; ++half) {
            const int ci = cc + half;
            if (w >= 4) {
                if (half == 0) { if (ci + 2 < NCHK) SC_WRITE(ra, (ci + 2) % 3); if (ci + 4 < NCHK) SC_LOAD(ra, ci + 4); }
                else { if (ci + 2 < NCHK) SC_WRITE(rb, (ci + 2) % 3); if (ci + 4 < NCHK) SC_LOAD(rb, ci + 4); }
            } else {
                const unsigned char* sl = L + (ci % 3) * SLOTB;
                const int vcol = 16 * w + lq;
                bf16x8 sb[2];
#pragma unroll
                for (int ks = 0; ks < 2; ++ks) { u32x4 pw; pw.x = pk2(st[2 * ks][0], st[2 * ks][1]); pw.y = pk2(st[2 * ks][2], st[2 * ks][3]); pw.z = pk2(st[2 * ks + 1][0], st[2 * ks + 1][1]); pw.w = pk2(st[2 * ks + 1][2], st[2 * ks + 1][3]);
                    sb[ks] = __builtin_bit_cast(bf16x8, pw); }
#pragma unroll
                for (int mt = 0; mt < 4; ++mt) {
                    const f32x4 gc = *(const f32x4*)(sl + 32768 + (16 * mt + 4 * g) * 4);
                    const u32x2 d0 = *(const u32x2*)(sl + 16384 + swz(vcol, 16 * mt + 4 * g));
                    const u32x2 y0 = *(const u32x2*)(sl + 24576 + swz(vcol, 16 * mt + 4 * g));
                    f32x4 ns = (f32x4){bflo(d0.x), bfhi(d0.x), bflo(d0.y), bfhi(d0.y)} + gc * st[mt];
                    f32x4 ya = (f32x4){bflo(y0.x), bfhi(y0.x), bflo(y0.y), bfhi(y0.y)};
#pragma unroll
                    for (int ks = 0; ks < 2; ++ks) {
                        const bf16x8 ga = *(const bf16x8*)(sl + swz(16 * mt + lq, 32 * ks + 8 * g));
                        const bf16x8 rh = *(const bf16x8*)(sl + 8192 + swz(16 * mt + lq, 32 * ks + 8 * g));
                        ns = __builtin_amdgcn_mfma_f32_16x16x32_bf16(ga, sb[ks], ns, 0, 0, 0);
                        ya = __builtin_amdgcn_mfma_f32_16x16x32_bf16(rh, sb[ks], ya, 0, 0, 0);
                    }
                    st[mt] = ns;
                    float* yp = B.Y + (rowb + ci * 64 + 16 * mt + 4 * g) * 512 + h * 64 + vcol;
#pragma unroll
                    for (int j = 0; j < 4; ++j) yp[j * 512] = ya[j];
                }
            }
            __syncthreads();
        }
    }
#undef SC_UNIT
#undef SC_LOAD
#undef SC_WRITE
}

__device__ __forceinline__ void phase_gn(const Params& P, int l, const Ctx& c) {
    const RwkvBufs B = rwkv_bufs(P, c);
    const int gw = c.bid * NWAVES + c.wave, NGW = c.G * NWAVES;
    const int c0 = 8 * c.lane;
    float gnw[8], gnb[8];
#pragma unroll
    for (int i = 0; i < 8; ++i) { gnw[i] = P.in[17][l * 512 + c0 + i]; gnb[i] = P.in[18][l * 512 + c0 + i]; }
    for (int m = gw; m < M; m += NGW) {
        const size_t o = (size_t)m * 512 + c0;
        const f32x4 y0 = *(const f32x4*)(B.Y + o), y1 = *(const f32x4*)(B.Y + o + 4);
        float y[8] = {y0.x, y0.y, y0.z, y0.w, y1.x, y1.y, y1.z, y1.w};
        const u32x4 bw = *(const u32x4*)(B.BON + o), gw4 = *(const u32x4*)(B.G + o);
        const float bo[8] = {bflo(bw.x), bfhi(bw.x), bflo(bw.y), bfhi(bw.y), bflo(bw.z), bfhi(bw.z), bflo(bw.w), bfhi(bw.w)};
        const float gg[8] = {bflo(gw4.x), bfhi(gw4.x), bflo(gw4.y), bfhi(gw4.y), bflo(gw4.z), bfhi(gw4.z), bflo(gw4.w), bfhi(gw4.w)};
        float s = 0.f;
#pragma unroll
        for (int i = 0; i < 8; ++i) s += y[i];
        s += __shfl_xor(s, 1); s += __shfl_xor(s, 2); s += __shfl_xor(s, 4);
        const float mean = s * (1.f / 64.f);
        float q = 0.f;
#pragma unroll
        for (int i = 0; i < 8; ++i) { y[i] -= mean; q += y[i] * y[i]; }
        q += __shfl_xor(q, 1); q += __shfl_xor(q, 2); q += __shfl_xor(q, 4);
        const float rstd = 1.0f / sqrtf(q * (1.f / 64.f) + 64e-5f);
        float ov[8];
#pragma unroll
        for (int i = 0; i < 8; ++i) ov[i] = (y[i] * rstd * gnw[i] + gnb[i] + bo[i]) * gg[i];
        u32x4 ow; ow.x = pk2(ov[0], ov[1]); ow.y = pk2(ov[2], ov[3]); ow.z = pk2(ov[4], ov[5]); ow.w = pk2(ov[6], ov[7]);
        *(u32x4*)(B.ORW + o) = ow;
    }
}

__device__ __forceinline__ void attn_unit(const Ctx& c, int bh, int qb, const bf16* Q, const bf16* K, const bf16* V, bf16* O, const float* FC, float qkb2) {
    const int b = bh >> 3, h = bh & 7, lane = c.lane, w = c.wave, lq = lane & 15, g = lane >> 4;
    const int q0 = qb * 128;
    const size_t rowb = (size_t)b * LP;
    const int qrow = q0 + 16 * w + lq;
    bf16* Ks = (bf16*)c.lds; bf16* Vt = Ks + 64 * 72; float* fks = (float*)(Vt + 64 * 72);
    const bf16* qp = Q + (rowb + qrow) * 512 + h * 64 + 8 * g;
    const bf16x8 qf0 = *(const bf16x8*)qp, qf1 = *(const bf16x8*)(qp + 32);
    const float* FCh = FC + (size_t)bh * LP;
    const float fq = FCh[qrow];
    float mrun = -1e30f, lsum = 0.f;
    f32x4 o[4];
#pragma unroll
    for (int i = 0; i < 4; ++i) o[i] = (f32x4){0.f, 0.f, 0.f, 0.f};
    const int kt_max = (q0 + 127) >> 6;
    for (int kt = kt_max; kt >= 0; --kt) {
        const int k0 = kt * 64;
        if (kt < kt_max) { const float fl = FCh[k0 + 63]; const int can = (qkb2 + fq - fl) < (mrun - THR2); if (__syncthreads_and(can)) break; }
        else __syncthreads();
        { const int key = c.tid >> 3, ch = c.tid & 7;
            const size_t goff = (rowb + k0 + key) * 512 + h * 64 + ch * 8;
            const u32x4 kv = *(const u32x4*)(K + goff); const u32x4 vv = *(const u32x4*)(V + goff);
            *(u32x4*)(Ks + key * 72 + ch * 8) = kv;
            bf16* vd = Vt + (ch * 8) * 72 + key;
            vd[0] = (bf16)(vv.x & 0xffff); vd[72] = (bf16)(vv.x >> 16); vd[144] = (bf16)(vv.y & 0xffff); vd[216] = (bf16)(vv.y >> 16);
            vd[288] = (bf16)(vv.z & 0xffff); vd[360] = (bf16)(vv.z >> 16); vd[432] = (bf16)(vv.w & 0xffff); vd[504] = (bf16)(vv.w >> 16);
            if (c.tid < 64) fks[c.tid] = FCh[k0 + c.tid]; }
        __syncthreads();
        if (k0 > q0 + 16 * w + 15) continue;
        f32x4 s[4];
#pragma unroll
        for (int nt = 0; nt < 4; ++nt) { const bf16* kp = Ks + (16 * nt + lq) * 72 + 8 * g; const bf16x8 a0 = *(const bf16x8*)kp, a1 = *(const bf16x8*)(kp + 32);
            s[nt] = __builtin_amdgcn_mfma_f32_16x16x32_bf16(a0, qf0, (f32x4){0.f, 0.f, 0.f, 0.f}, 0, 0, 0);
            s[nt] = __builtin_amdgcn_mfma_f32_16x16x32_bf16(a1, qf1, s[nt], 0, 0, 0); }
        float mx = -INFINITY;
#pragma unroll
        for (int nt = 0; nt < 4; ++nt) { const f32x4 fk = *(const f32x4*)(fks + 16 * nt + 4 * g);
#pragma unroll
            for (int j = 0; j < 4; ++j) { float x = s[nt][j] + fq - fk[j]; const int key = k0 + 16 * nt + 4 * g + j; if (key > qrow) x = -INFINITY; s[nt][j] = x; mx = fmaxf(mx, x); } }
        mx = fmaxf(mx, __shfl_xor(mx, 16)); mx = fmaxf(mx, __shfl_xor(mx, 32));
        const float mnew = fmaxf(mrun, mx), alpha = exp2f(mrun - mnew); mrun = mnew;
        float psum = 0.f;
#pragma unroll
        for (int nt = 0; nt < 4; ++nt)
#pragma unroll
            for (int j = 0; j < 4; ++j) { const float p = exp2f(s[nt][j] - mnew); s[nt][j] = p; psum += p; }
        lsum = lsum * alpha + psum;
#pragma unroll
        for (int dt = 0; dt < 4; ++dt) o[dt] = o[dt] * alpha;
        bf16x8 pb[2];
#pragma unroll
        for (int k2 = 0; k2 < 2; ++k2) { u32x4 pw; pw.x = pk2(s[2 * k2][0], s[2 * k2][1]); pw.y = pk2(s[2 * k2][2], s[2 * k2][3]); pw.z = pk2(s[2 * k2 + 1][0], s[2 * k2 + 1][1]); pw.w = pk2(s[2 * k2 + 1][2], s[2 * k2 + 1][3]);
            pb[k2] = __builtin_bit_cast(bf16x8, pw); }
#pragma unroll
        for (int dt = 0; dt < 4; ++dt)
#pragma unroll
            for (int k2 = 0; k2 < 2; ++k2) { const bf16* vp = Vt + (16 * dt + lq) * 72 + 32 * k2 + 4 * g;
                const u32x2 lo = *(const u32x2*)vp, hi = *(const u32x2*)(vp + 16);
                u32x4 aw; aw.x = lo.x; aw.y = lo.y; aw.z = hi.x; aw.w = hi.y;
                o[dt] = __builtin_amdgcn_mfma_f32_16x16x32_bf16(__builtin_bit_cast(bf16x8, aw), pb[k2], o[dt], 0, 0, 0); }
    }
    lsum += __shfl_xor(lsum, 16); lsum += __shfl_xor(lsum, 32);
    const float inv = 1.0f / lsum;
    bf16* op = O + (rowb + qrow) * 512 + h * 64 + 4 * g;
#pragma unroll
    for (int dt = 0; dt < 4; ++dt) { u32x2 ow; ow.x = pk2(o[dt][0] * inv, o[dt][1] * inv); ow.y = pk2(o[dt][2] * inv, o[dt][3] * inv); *(u32x2*)(op + 16 * dt) = ow; }
    __syncthreads();
}
__device__ __forceinline__ void phase_attn(const Params& P, int l, const Ctx& c, int first_blk) {
    const bf16* Q = (const bf16*)(c.ws + OFF_Q); const bf16* K = (const bf16*)(c.ws + OFF_K); const bf16* V = (const bf16*)(c.ws + OFF_V);
    const float* FC = (const float*)(c.ws + OFF_MISC) + 16 * LP;
    float gqm = fabsf(P.in[5][l * 64 + c.lane]), gkm = fabsf(P.in[6][l * 64 + c.lane]);
#pragma unroll
    for (int o = 1; o < 64; o <<= 1) { gqm = fmaxf(gqm, __shfl_xor(gqm, o)); gkm = fmaxf(gkm, __shfl_xor(gkm, o)); }
    const float qkb2 = 8.0f * gqm * gkm * LOG2E * 1.03f;
    const int nblk = c.G - first_blk, me = c.bid - first_blk;
    constexpr int NQB = LP / 128, NU = 16 * NQB;
    for (int u = me; u < NU; u += nblk) { const int bh = u & 15, qb = NQB - 1 - (u >> 4); attn_unit(c, bh, qb, Q, K, V, (bf16*)(c.ws + OFF_OF), FC, qkb2); }
}

__device__ __forceinline__ void phase_fixup(const Params& P, int l, const Ctx& c) {
    bf16* ACT = (bf16*)(c.ws + OFF_RW); const bf16* HALO = (const bf16*)(c.ws + OFF_Q);
    const float* cw = P.in[24] + (size_t)l * 3 * NUP;
    const int total = (M / 64) * 2 * DFF;
    for (int idx = c.bid * NTHR + c.tid; idx < total; idx += c.G * NTHR) {
        const int rr = idx / DFF, ch = idx - rr * DFF, q64 = rr >> 1, e = rr & 1, row = q64 * 64 + e;
        const int t = row % LP;
        int s0, s1, s2;
        if (e == 0) { s0 = q64 * 4 + 2; s1 = (q64 - 1) * 4 + 1; s2 = (q64 - 1) * 4 + 0; } else { s0 = q64 * 4 + 3; s1 = q64 * 4 + 2; s2 = (q64 - 1) * 4 + 1; }
        float uc[2];
#pragma unroll
        for (int bj = 0; bj < 2; ++bj) { const int col = bj * DFF + ch;
            const float u0 = bf2f(HALO[(size_t)s0 * NUP + col]);
            const float u1 = (t >= 1) ? bf2f(HALO[(size_t)s1 * NUP + col]) : 0.f;
            const float u2 = (t >= 2) ? bf2f(HALO[(size_t)s2 * NUP + col]) : 0.f;
            uc[bj] = cw[col] * u2 + cw[NUP + col] * u1 + cw[2 * NUP + col] * u0; }
        ACT[(size_t)row * DFF + ch] = (bf16)f2bf(uc[0] * sigmoidf_(uc[0]) * uc[1]);
    }
}

#define OPQ_S(x) asm volatile("" : "+s"(x))
#define OPQ_V(x) asm volatile("" : "+v"(x))
#define PHASE_BEGIN() do { int t_ = threadIdx.x; OPQ_V(t_); c.tid = t_; c.lane = t_ & 63; c.wave = __builtin_amdgcn_readfirstlane(t_ >> 6); int b_ = blockIdx.x; OPQ_S(b_); c.bid = b_; \
    unsigned char* w_ = P.ws; OPQ_S(w_); c.ws = w_; ws = w_; l = lc; OPQ_S(l); WT = (pg8::bf16_t*)(ws + OFF_WT); HN = (pg8::bf16_t*)(ws + OFF_HN); } while (0)
__global__ void __launch_bounds__(NTHR, 2) mega(Params P) {
    extern __shared__ __attribute__((aligned(16))) unsigned char lds[];
    Ctx c; c.G = gridDim.x; c.lds = lds;
    volatile LAS unsigned* MISC = (volatile LAS unsigned*)((LAS unsigned char*)lds + MISC_OFF);
    if (threadIdx.x < 16) MISC[threadIdx.x] = 0u;
    __syncthreads();
    (void)xcd_barrier_post((unsigned*)(P.ws + OFF_CTL) + 1024, MISC + 8);
#define SEAM() do { XcdBarrier xb_; xb_.bar = (unsigned*)(P.ws + OFF_CTL) + 1024; xb_.x = xb_xcc_id(); xb_.st = (volatile LAS unsigned*)((LAS unsigned char*)lds + MISC_OFF) + 8; xcd_barrier(xb_); } while (0)
    PG8_LAS unsigned char* ldsl = (PG8_LAS unsigned char*)lds;
    unsigned char* ws; pg8::bf16_t* WT; pg8::bf16_t* HN; int l;
#pragma unroll 1
    for (int lc = 0; lc < DEPTH; ++lc) {
        PHASE_BEGIN();
        convert_weights(P, l, c);
        phase_norm<true>(P, l, c);
        cg::this_grid().sync();
        PHASE_BEGIN();
        phase_fcum(P, c);
        { pg8::Gemm g{HN, WT + WT_IN, M, N1, 1024, 1024}; pg8::StaticOrder S; S.init(M, N1, c.G, c.bid);
          pg8::EpiRoute E{ws};
          pg8::gemm_phase<pg8::EpiRoute, pg8::StaticOrder, true, true>(ldsl, g, S, E); }
        SEAM();
        PHASE_BEGIN();
        phase_qknorm(P, l, c);
        for (int rep_ = 0; rep_ < REP_PREP; ++rep_) phase_rwkv_prep(P, l, c);
        SEAM();
        PHASE_BEGIN();
        if (c.bid < 16) scan_chunked(P, c, c.bid); else phase_attn(P, l, c, 16);
#if REP_P3 > 1
        __syncthreads(); PHASE_BEGIN();
        if (c.bid < 16) scan_chunked(P, c, c.bid); else phase_attn(P, l, c, 16);
#endif
        SEAM();
        PHASE_BEGIN();
        phase_gn(P, l, c);
        for (int rep_ = 0; rep_ < REP_SYNC; ++rep_) SEAM();
        SEAM();
        PHASE_BEGIN();
        { pg8::bf16_t* MG = (pg8::bf16_t*)(ws + OFF_K); const pg8::bf16_t* GT = (const pg8::bf16_t*)(ws + OFF_GT); const float* gb = P.in[21] + l * NGT;
          pg8::StaticOrder S; S.init(M, 1024, c.G, c.bid);
          { pg8::Gemm g{(const pg8::bf16_t*)(ws + OFF_OF), WT + WT_BF, M, 1024, 512, 512}; pg8::EpiGate<0> E{MG, GT, gb};
            pg8::gemm_phase<pg8::EpiGate<0>, pg8::StaticOrder, true, true>(ldsl, g, S, E); }
          __syncthreads();
          PHASE_BEGIN();
          MG = (pg8::bf16_t*)(ws + OFF_K); GT = (const pg8::bf16_t*)(ws + OFF_GT); gb = P.in[21] + l * NGT; S.init(M, 1024, c.G, c.bid);
          { pg8::Gemm g{(const pg8::bf16_t*)(ws + OFF_RW + (size_t)M * 512 * 4), WT + WT_BR, M, 1024, 512, 512}; pg8::EpiGate<1> E{MG, GT, gb};
            pg8::gemm_phase<pg8::EpiGate<1>, pg8::StaticOrder, true, true>(ldsl, g, S, E); } }
        SEAM();
        PHASE_BEGIN();
#pragma unroll 1
        for (int pass = 0; pass < 2; ++pass) {
            if (pass) { __syncthreads(); PHASE_BEGIN(); }
            const int sl = pass ? (c.bid >> 2) : 0;
            pg8::Gemm g{(const pg8::bf16_t*)(ws + OFF_K) + sl * 256, WT + WT_O + sl * 256, M, 1024, pass ? 256 : 1024, 1024};
            pg8::OneUnit S; S.so.init(MMAIN, 1024, c.G, c.bid); S.mode = pass; S.pm = MMAIN / 256; S.pn = c.bid & 3; S.active = sl < 4;
            pg8::EpiResid E{(float*)(ws + OFF_H), nullptr, pass};
            pg8::gemm_phase<pg8::EpiResid, pg8::OneUnit, true, true>(ldsl, g, S, E);
        }
        SEAM();
        PHASE_BEGIN();
        phase_norm<false>(P, l, c);
        SEAM();
        PHASE_BEGIN();
        { pg8::Gemm g{HN, WT + WT_UP, M, NUP, 1024, 1024}; pg8::StaticOrder S; S.init(M, NUP, c.G, c.bid);
          pg8::EpiUp E{(pg8::bf16_t*)(ws + OFF_RW), (pg8::bf16_t*)(ws + OFF_Q), P.in[24] + (size_t)l * 3 * NUP};
          pg8::gemm_phase<pg8::EpiUp, pg8::StaticOrder, true, true>(ldsl, g, S, E); }
        SEAM();
        PHASE_BEGIN();
        phase_fixup(P, l, c);
        SEAM();
        PHASE_BEGIN();
#pragma unroll 1
        for (int pass = 0; pass < 2; ++pass) {
            if (pass) { __syncthreads(); PHASE_BEGIN(); }
            const int sl = pass ? (c.bid >> 2) : 0;
            const int ko = (sl < 2) ? sl * 768 : 1536 + (sl - 2) * 640, kl = (sl < 2) ? 768 : 640;
            pg8::Gemm g{(const pg8::bf16_t*)(ws + OFF_RW) + (pass ? ko : 0), WT + WT_DN + (pass ? ko : 0), M, 1024, pass ? kl : DFF, DFF};
            pg8::OneUnit S; S.so.init(MMAIN, 1024, c.G, c.bid); S.mode = pass; S.pm = MMAIN / 256; S.pn = c.bid & 3; S.active = sl < 4;
            pg8::EpiResid E{(float*)(ws + OFF_H), (l == DEPTH - 1 && !pass) ? P.out : nullptr, pass};
            pg8::gemm_phase<pg8::EpiResid, pg8::OneUnit, true, true>(ldsl, g, S, E);
        }
        SEAM();
        if (l == DEPTH - 1) {
            PHASE_BEGIN();
            const float* H = (const float*)(ws + OFF_H);
            for (int idx = c.bid * NTHR + c.tid; idx < (NMETA + SEQ - (MMAIN - LP)) * (DM / 4); idx += c.G * NTHR) {
                const int r = idx / (DM / 4), q4 = idx - r * (DM / 4), t = (MMAIN - LP) + r;
                *(f32x4*)(P.out + ((size_t)SEQ + (t - NMETA)) * DM + 4 * q4) = *(const f32x4*)(H + (size_t)(LP + t) * DM + 4 * q4);
            }
        }
    }
}

extern "C" void kernel_launch(void* const* d_in, const int* in_sizes, int n_in, void* d_out, int out_size, void* d_ws, size_t ws_size, hipStream_t stream) {
    static int grid = 0;
    if (grid == 0) {
        if (n_in != 26 || out_size != NB * SEQ * DM || ws_size < WS_NEED) { fprintf(stderr, "kernel_launch: unexpected shapes (n_in %d out %d ws %zu need %zu)\n", n_in, out_size, ws_size, (size_t)WS_NEED); grid = -1; return; }
        int dev = 0, cus = 0, per_cu = 0;
        if (hipGetDevice(&dev) != hipSuccess || hipDeviceGetAttribute(&cus, hipDeviceAttributeMultiprocessorCount, dev) != hipSuccess) { grid = -1; return; }
        if (hipFuncSetAttribute((const void*)mega, hipFuncAttributeMaxDynamicSharedMemorySize, LDS_BYTES) != hipSuccess) { fprintf(stderr, "kernel_launch: hipFuncSetAttribute failed\n"); grid = -1; return; }
        if (hipOccupancyMaxActiveBlocksPerMultiprocessor(&per_cu, (const void*)mega, NTHR, LDS_BYTES) != hipSuccess || per_cu < 1) { fprintf(stderr, "kernel_launch: occupancy query says %d\n", per_cu); per_cu = 1; }
        (void)hipGetLastError();
        grid = cus;
    }
    if (grid < 0) return;
    if (hipMemsetAsync((char*)d_ws + OFF_CTL, 0, 65536, stream) != hipSuccess) { fprintf(stderr, "kernel_launch: memset failed\n"); return; }
    Params p{};
    for (int i = 0; i < 26; ++i) p.in[i] = (const float*)d_in[i];
    p.out = (float*)d_out; p.ws = (unsigned char*)d_ws;
    void* args[] = {&p};
    hipError_t e = hipLaunchCooperativeKernel((const void*)mega, dim3(grid), dim3(NTHR), args, LDS_BYTES, stream);
    if (e != hipSuccess) fprintf(stderr, "kernel_launch: cooperative launch failed: %s (grid %d)\n", hipGetErrorString(e), grid);
}
```

```cpp
#include <hip/hip_runtime.h>
#include <hip/hip_cooperative_groups.h>
#include <cstdio>
#include <cstdint>
#include <cmath>
namespace cg = cooperative_groups;
namespace pg8 {
#define PG8_LAS __attribute__((address_space(3)))
typedef unsigned short bf16_t;
typedef short bf16x8 __attribute__((ext_vector_type(8)));
typedef float f32x4 __attribute__((ext_vector_type(4)));
typedef unsigned u32x4 __attribute__((ext_vector_type(4)));
constexpr int BM = 256, BK = 64, HALF = 128, HTB = HALF * BK * 2  , STAGE_BYTES = 8 * HTB, NXCD = 8, WGM = 8;

__host__ __device__ __forceinline__ int lds_byte(int r, int c) { const int st = (r >> 4) * 2 + (c >> 5), rr = r & 15, cc = c & 31, ob = rr * 64 + cc * 2; return st * 1024 + (ob ^ (((ob >> 9) & 1) << 5)); }
__host__ __device__ __forceinline__ void stage_rc(int b, int& R, int& C) { const int st = b / 1024, sb = b % 1024, swz = sb ^ (((sb >> 9) & 1) << 5); R = (st >> 1) * 16 + swz / 64; C = (st & 1) * 32 + (swz % 64) / 2; }
__host__ __device__ __forceinline__ int perm32(int rho) { const int n = rho >> 4, i = rho & 15; return 8 * (i >> 2) + 4 * n + (i & 3); }

struct Unit { int pm, pn; };
struct Gemm { const bf16_t* A; const bf16_t* Bt; int M, N, K, ld; };

struct StaticOrder {
    int nM, nN, nwg, G, c;
    __host__ __device__ void init(int M, int N, int G_, int c_) { nM = M / BM; nN = N / BM; nwg = nM * nN; G = G_; c = c_; }
    __host__ __device__ bool next(int i, Unit& u) const {
        const long L = (long)i * G + c; if (L >= nwg) return false;
        int wgid = (int)L; { const int q = nwg / NXCD, r = nwg % NXCD, xcd = wgid % NXCD, off = wgid / NXCD; wgid = (xcd < r ? xcd * (q + 1) : r * (q + 1) + (xcd - r) * q) + off; }
        const int nig = WGM * nN, gid = wgid / nig, fm = gid * WGM, gsz = (nM - fm) < WGM ? (nM - fm) : WGM;
        u.pm = fm + ((wgid % nig) % gsz); u.pn = (wgid % nig) / gsz; return true;
    }
    __device__ __forceinline__ void a_ready(const Unit&) const {}
    __device__ __forceinline__ void done(const Unit&) const {}
};

__device__ __forceinline__ unsigned cvt_pk_bf16(float lo, float hi) { unsigned r; asm volatile("v_cvt_pk_bf16_f32 %0, %1, %2" : "=v"(r) : "v"(lo), "v"(hi)); return r; }
typedef float f32x2 __attribute__((ext_vector_type(2)));
template <class Epi, class Sched, bool ALIGN_EPI = false, bool SP2 = false>
__device__ __forceinline__ void gemm_phase(PG8_LAS unsigned char* lds, const Gemm g, const Sched& S, const Epi& E) {
    int tid_ = threadIdx.x; asm volatile("" : "+v"(tid_)); const int tid = tid_, wid = __builtin_amdgcn_readfirstlane(tid >> 6), lane = tid & 63, wr = wid >> 2, wc = wid & 3, fr = lane & 15, fq = lane >> 4;
    const int K = g.K, nt = K / BK, LD = g.ld;
    unsigned voffA[2], voffB[2];
#pragma unroll
    for (int i = 0; i < 2; ++i) { int R, C; stage_rc(tid * 16 + i * 8192, R, C); const int Rb = Epi::PERM ? ((R & ~31) + perm32(R & 31)) : R;
        voffA[i] = (unsigned)(R * LD + C) * 2u; voffB[i] = (unsigned)(Rb * LD + C) * 2u; }
    const size_t kstep = (size_t)(BK * 2);
    const size_t hstep = (size_t)HALF * LD * 2;
    const size_t tstep = 2 * hstep;
    const unsigned ldsw = (unsigned)wid * 1024u;
    const int aoff = lds_byte(wr * 64 + fr, fq * 8), boff = lds_byte(wc * 32 + fr, fq * 8);
#define PG8_SA(b, h) (((b) * 2 + (h)) * HTB)
#define PG8_SB(b, h) ((4 + (b) * 2 + (h)) * HTB)
#define PG8_STAGE(bufoff, gbase, voff) do { _Pragma("unroll") for (int _i = 0; _i < 2; ++_i) \
        __builtin_amdgcn_global_load_lds((const unsigned*)((const char*)(gbase) + (voff)[_i]), (PG8_LAS unsigned*)(lds + (bufoff) + ldsw + _i * 8192), 16, 0, 0); } while (0)
#define PG8_LDA(dst, b, h) do { _Pragma("unroll") for (int m = 0; m < 4; ++m) _Pragma("unroll") for (int k = 0; k < 2; ++k) dst[m][k] = *(const PG8_LAS bf16x8*)(lds + PG8_SA(b, h) + aoff + m * 2048 + k * 1024); } while (0)
#define PG8_LDB(dst, b, h) do { _Pragma("unroll") for (int n = 0; n < 2; ++n) _Pragma("unroll") for (int k = 0; k < 2; ++k) dst[n][k] = *(const PG8_LAS bf16x8*)(lds + PG8_SB(b, h) + boff + n * 2048 + k * 1024); } while (0)
#define PG8_MMA(ai, bj, At, Bt) do { __builtin_amdgcn_s_setprio(1); _Pragma("unroll") for (int m = 0; m < 4; ++m) _Pragma("unroll") for (int n = 0; n < 2; ++n) _Pragma("unroll") for (int k = 0; k < 2; ++k) \
        acc[ai][bj][m][n] = __builtin_amdgcn_mfma_f32_16x16x32_bf16(Bt[n][k], At[m][k], acc[ai][bj][m][n], 0, 0, 0); __builtin_amdgcn_s_setprio(0); } while (0)
#define PG8_WAIT_V(n) asm volatile("s_waitcnt vmcnt(" #n ")" ::: "memory")
#define PG8_WAIT_L(n) asm volatile("s_waitcnt lgkmcnt(" #n ")" ::: "memory")
#define PG8_BAR __builtin_amdgcn_s_barrier()
#define PG8_SCHED __builtin_amdgcn_sched_barrier(0)
    Unit cur, nxt; int ui = 0;
    if (!S.next(0, cur)) return;
    f32x4 acc[2][2][4][2];
#pragma unroll
    for (int a = 0; a < 2; ++a)
#pragma unroll
        for (int b = 0; b < 2; ++b)
#pragma unroll
            for (int m = 0; m < 4; ++m)
#pragma unroll
                for (int n = 0; n < 2; ++n) acc[a][b][m][n] = (f32x4){0.f, 0.f, 0.f, 0.f};
    bf16x8 At[4][2], B0[2][2], B1[2][2];
    const char* cA = (const char*)g.A + (size_t)cur.pm * tstep; const char* cB = (const char*)g.Bt + (size_t)cur.pn * tstep;
    S.a_ready(cur);
    if constexpr (SP2) {
        PG8_STAGE(PG8_SB(0, 0), cB, voffB); PG8_STAGE(PG8_SB(0, 1), cB + hstep, voffB); PG8_STAGE(PG8_SA(0, 0), cA, voffA); PG8_STAGE(PG8_SA(0, 1), cA + hstep, voffA);
        if (wr == 1) PG8_BAR;
        PG8_WAIT_V(2); PG8_BAR;
        PG8_STAGE(PG8_SB(1, 0), cB + kstep, voffB); PG8_STAGE(PG8_SA(1, 0), cA + kstep, voffA); PG8_STAGE(PG8_SB(1, 1), cB + hstep + kstep, voffB);
        PG8_WAIT_V(6); PG8_BAR;
    } else {
        PG8_STAGE(PG8_SB(0, 0), cB, voffB); PG8_STAGE(PG8_SA(0, 0), cA, voffA); PG8_STAGE(PG8_SB(0, 1), cB + hstep, voffB); PG8_STAGE(PG8_SA(0, 1), cA + hstep, voffA);
        if (wr == 1) PG8_BAR;
        PG8_WAIT_V(4); PG8_BAR;
        PG8_STAGE(PG8_SB(1, 0), cB + kstep, voffB); PG8_STAGE(PG8_SA(1, 0), cA + kstep, voffA); PG8_STAGE(PG8_SB(1, 1), cB + hstep + kstep, voffB);
        PG8_WAIT_V(6); PG8_BAR;
    }
    for (;;) {
        const bool has_next = S.next(ui + 1, nxt);
        const char* nA = has_next ? (const char*)g.A + (size_t)nxt.pm * tstep : cA; const char* nB = has_next ? (const char*)g.Bt + (size_t)nxt.pn * tstep : cB;
        for (int t = 0; t < nt; t += 2) {
            const bool last = (t == nt - 2);
            const char* a1 = cA + (size_t)(t + 1) * kstep;
            const char* a2 = last ? nA : cA + (size_t)(t + 2) * kstep; const char* b2 = last ? nB : cB + (size_t)(t + 2) * kstep;
            const char* a3 = a2 + kstep; const char* b3 = b2 + kstep;
            if (last && has_next) S.a_ready(nxt);
            if constexpr (SP2) {
            PG8_LDB(B0, 0, 0); PG8_LDB(B1, 0, 1); PG8_SCHED; PG8_LDA(At, 0, 0); PG8_STAGE(PG8_SA(1, 1), a1 + hstep, voffA);
            PG8_WAIT_V(8); PG8_WAIT_L(0); PG8_BAR; PG8_MMA(0, 0, At, B0); PG8_MMA(0, 1, At, B1); PG8_BAR; PG8_SCHED;
            PG8_LDA(At, 0, 1); PG8_STAGE(PG8_SB(0, 0), b2, voffB); PG8_STAGE(PG8_SB(0, 1), b2 + hstep, voffB); PG8_STAGE(PG8_SA(0, 0), a2, voffA);
            PG8_WAIT_V(8); PG8_WAIT_L(0); PG8_BAR; PG8_MMA(1, 0, At, B0); PG8_MMA(1, 1, At, B1); PG8_BAR; PG8_SCHED;
            PG8_LDB(B0, 1, 0); PG8_LDB(B1, 1, 1); PG8_SCHED; PG8_LDA(At, 1, 0); PG8_STAGE(PG8_SA(0, 1), a2 + hstep, voffA);
            PG8_WAIT_V(8); PG8_WAIT_L(0); PG8_BAR; PG8_MMA(0, 0, At, B0); PG8_MMA(0, 1, At, B1); PG8_BAR; PG8_SCHED;
            PG8_LDA(At, 1, 1); PG8_STAGE(PG8_SB(1, 0), b3, voffB); PG8_STAGE(PG8_SB(1, 1), b3 + hstep, voffB); PG8_STAGE(PG8_SA(1, 0), a3, voffA);
            PG8_WAIT_V(8); PG8_WAIT_L(0); PG8_BAR; PG8_MMA(1, 0, At, B0); PG8_MMA(1, 1, At, B1); PG8_BAR; PG8_SCHED;
            } else {
            PG8_LDB(B0, 0, 0); PG8_SCHED; PG8_LDA(At, 0, 0); PG8_STAGE(PG8_SA(1, 1), a1 + hstep, voffA);
            PG8_WAIT_L(8); PG8_BAR; PG8_WAIT_L(0); PG8_MMA(0, 0, At, B0); PG8_BAR; PG8_SCHED;
            PG8_LDB(B1, 0, 1); PG8_STAGE(PG8_SB(0, 0), b2, voffB);
            PG8_BAR; PG8_WAIT_L(0); PG8_MMA(0, 1, At, B1); PG8_BAR;
            PG8_LDA(At, 0, 1); PG8_STAGE(PG8_SA(0, 0), a2, voffA);
            PG8_BAR; PG8_WAIT_L(0); PG8_MMA(1, 0, At, B0); PG8_BAR; PG8_SCHED;
            PG8_STAGE(PG8_SB(0, 1), b2 + hstep, voffB);
            PG8_WAIT_V(6); PG8_BAR; PG8_MMA(1, 1, At, B1); PG8_BAR;
            PG8_LDB(B0, 1, 0); PG8_SCHED; PG8_LDA(At, 1, 0); PG8_STAGE(PG8_SA(0, 1), a2 + hstep, voffA);
            PG8_WAIT_L(8); PG8_BAR; PG8_WAIT_L(0); PG8_MMA(0, 0, At, B0); PG8_BAR; PG8_SCHED;
            PG8_LDB(B1, 1, 1); PG8_STAGE(PG8_SB(1, 0), b3, voffB);
            PG8_BAR; PG8_WAIT_L(0); PG8_MMA(0, 1, At, B1); PG8_BAR;
            PG8_LDA(At, 1, 1); PG8_STAGE(PG8_SA(1, 0), a3, voffA);
            PG8_BAR; PG8_WAIT_L(0); PG8_MMA(1, 0, At, B0); PG8_BAR; PG8_SCHED;
            PG8_STAGE(PG8_SB(1, 1), b3 + hstep, voffB);
            PG8_WAIT_V(6); PG8_BAR; PG8_MMA(1, 1, At, B1); PG8_BAR;
            }
        }
        if constexpr (ALIGN_EPI) { if (wr == 0) PG8_BAR; }
        if constexpr (!Epi::AFTER_DRAIN) { E(acc, cur, wr, wc, fr, fq); S.done(cur); }
        if (!has_next) break;
#pragma unroll
        for (int a = 0; a < 2; ++a)
#pragma unroll
            for (int b = 0; b < 2; ++b)
#pragma unroll
                for (int m = 0; m < 4; ++m)
#pragma unroll
                    for (int n = 0; n < 2; ++n) acc[a][b][m][n] = (f32x4){0.f, 0.f, 0.f, 0.f};
        cur = nxt; cA = nA; cB = nB; ++ui;
        if constexpr (ALIGN_EPI) { if (wr == 1) PG8_BAR; }
    }
    PG8_WAIT_V(0);
    if constexpr (!ALIGN_EPI) { if (wr == 0) PG8_BAR; }
    PG8_BAR;
    if constexpr (Epi::AFTER_DRAIN) { E.fused(acc, cur, wr, wc, fr, fq, lds, wid, lane); S.done(cur); }
#undef PG8_SA
#undef PG8_SB
#undef PG8_STAGE
#undef PG8_LDA
#undef PG8_LDB
#undef PG8_MMA
#undef PG8_WAIT_V
#undef PG8_WAIT_L
#undef PG8_BAR
#undef PG8_SCHED
}
}
#define GAS __attribute__((address_space(1)))
#define LAS __attribute__((address_space(3)))
typedef GAS unsigned gu32;
typedef GAS unsigned long long gu64;
#define RLX_AGENT __ATOMIC_RELAXED, __HIP_MEMORY_SCOPE_AGENT
#define LDS_WAIT() asm volatile("s_waitcnt lgkmcnt(0)" ::: "memory")
#define VM_WAIT() asm volatile("s_waitcnt vmcnt(0)" ::: "memory")
__device__ __forceinline__ unsigned long long rt() { return __builtin_amdgcn_s_memrealtime(); }
#define XB_TMO      128
#define XB_XCNT(j)  (256  + 64 * (j))
#define XB_XSUB(j)  (1280 + 64 * (j))
#define XB_XGEN(j)  (2304 + 64 * (j))
#define XB_TOP      3328
#define XB_TOPGEN   3392
#define XCD_BAR_WORDS 3456
#define XB_SPIN_CAP (1u << 18)

__device__ __forceinline__ unsigned xb_ld(unsigned* p)              { return __hip_atomic_load(p, __ATOMIC_RELAXED, __HIP_MEMORY_SCOPE_AGENT); }
__device__ __forceinline__ unsigned xb_add(unsigned* p, unsigned v) { return __hip_atomic_fetch_add(p, v, __ATOMIC_RELAXED, __HIP_MEMORY_SCOPE_AGENT); }
__device__ __forceinline__ unsigned xb_xcc_id() { return (unsigned)__builtin_amdgcn_s_getreg((3 << 11) | 20) & 0xFu; }
#define XB_SPIN(cond, bar) do { unsigned _sp = 0; while (cond) { __builtin_amdgcn_s_sleep(1); \
    if ((++_sp & 255u) == 0u) { if (xb_ld(&(bar)[XB_TMO])) break; if (_sp > XB_SPIN_CAP) { atomicAdd(&(bar)[XB_TMO], 1u); break; } } } } while (0)

struct XcdBarrier {
    unsigned* bar; unsigned x;
    volatile LAS unsigned* st;
};

__device__ __forceinline__ XcdBarrier xcd_barrier_post(unsigned* bar, volatile LAS unsigned* st) {
    XcdBarrier b; b.bar = bar; b.x = xb_xcc_id(); b.st = st;
    if (threadIdx.x == 0) (void)xb_add(&bar[XB_XCNT(b.x)], 1u);
    return b;
}
__device__ __forceinline__ void xcd_barrier_complete(unsigned* bar, unsigned x, unsigned& nloc, unsigned& nx) {
    const unsigned G = gridDim.x * gridDim.y * gridDim.z;
    unsigned sum, cnt, mine, sp = 0u;
    for (;;) {
        sum = 0u; cnt = 0u; mine = 0u;
#pragma unroll
        for (unsigned j = 0; j < 16; ++j) { const unsigned c = xb_ld(&bar[XB_XCNT(j)]); sum += c; cnt += (c > 0u) ? 1u : 0u; mine = (j == x) ? c : mine; }
        if (sum == G) break;
        __builtin_amdgcn_s_sleep(1);
        if ((++sp & 255u) == 0u) { if (xb_ld(&bar[XB_TMO])) break; if (sp > XB_SPIN_CAP) { atomicAdd(&bar[XB_TMO], 1u); break; } }
    }
    nloc = mine > 0u ? mine : 1u; nx = cnt > 0u ? cnt : 1u;
}

__device__ __forceinline__ void xcd_barrier(const XcdBarrier& b) {
    asm volatile("s_waitcnt vmcnt(0)" ::: "memory");
    __syncthreads();
    if (threadIdx.x == 0) {
        unsigned* bar = b.bar;
        __builtin_amdgcn_s_waitcnt(0);
        unsigned nloc = b.st[0], nx = b.st[1];
        if (nloc == 0u) { xcd_barrier_complete(bar, b.x, nloc, nx); b.st[0] = nloc; b.st[1] = nx; }
        const unsigned old = xb_add(&bar[XB_XSUB(b.x)], 1u);
        const unsigned gen = old / nloc;
        if (old + 1u == (gen + 1u) * nloc) {
            __builtin_amdgcn_fence(__ATOMIC_RELEASE, "agent");
            asm volatile("s_waitcnt vmcnt(0)" ::: "memory");
            const unsigned og = xb_add(&bar[XB_TOP], 1u);
            const unsigned tg = og / nx;
            if (og + 1u == (tg + 1u) * nx) xb_add(&bar[XB_TOPGEN], 1u);
            else XB_SPIN(xb_ld(&bar[XB_TOPGEN]) == tg, bar);
            __builtin_amdgcn_fence(__ATOMIC_ACQUIRE, "agent");
            xb_add(&bar[XB_XGEN(b.x)], 1u);
            asm volatile("s_waitcnt vmcnt(0)" ::: "memory");
        } else {
            XB_SPIN(xb_ld(&bar[XB_XGEN(b.x)]) == gen, bar);
            __builtin_amdgcn_fence(__ATOMIC_ACQUIRE, "agent");
            asm volatile("s_waitcnt vmcnt(0)" ::: "memory");
        }
    }
    __syncthreads();
}


constexpr int NB = 2, SEQ = 8192, DM = 1024, DEPTH = 4, NMETA = 16, LP = 8320, M = NB * LP;
constexpr int N_IN = 5384, N1 = 5376, NRW = 1792, NGT = 2048, DFF = 2816, NUP = 5632;
constexpr float LOG2E = 1.4426950408889634f;
constexpr float QSCALE = 0.125f * LOG2E;
constexpr float THR2 = 30.0f * LOG2E;
constexpr int NWAVES = 8, NTHR = 512, MMAIN = 16384;
constexpr int LDS_BYTES = 147456, MISC_OFF = 147456 - 128;

typedef unsigned short bf16;
typedef float f32x4 __attribute__((ext_vector_type(4)));
typedef unsigned u32x4 __attribute__((ext_vector_type(4)));
typedef unsigned u32x2 __attribute__((ext_vector_type(2)));
typedef short bf16x8 __attribute__((ext_vector_type(8)));

constexpr size_t SZ_H = (size_t)M * DM * 4, SZ_X512 = (size_t)M * 512 * 2;
constexpr size_t OFF_CTL = 0, OFF_H = 1u << 20, OFF_WT = OFF_H + SZ_H;
constexpr size_t WT_IN = 0, WT_BF = WT_IN + (size_t)N1 * 1024, WT_BR = WT_BF + 1024 * 512, WT_O = WT_BR + 1024 * 512,
                 WT_UP = WT_O + 1024 * 1024, WT_DN = WT_UP + (size_t)NUP * 1024, WT_LW = WT_DN + (size_t)1024 * DFF, WT_LA = WT_LW + 512 * 64, WT_LG = WT_LA + 512 * 64, WT_END = WT_LG + 512 * 128;
constexpr size_t OFF_HN = OFF_WT + WT_END * 2;
constexpr size_t OFF_Q = OFF_HN + 2 * SZ_X512, OFF_K = OFF_Q + SZ_X512, OFF_V = OFF_K + SZ_X512;
constexpr size_t OFF_RW = OFF_V + SZ_X512, OFF_GT = OFF_RW + (size_t)M * NRW * 2, OFF_MISC = OFF_GT + (size_t)M * NGT * 2;
constexpr size_t OFF_T0 = OFF_MISC + 2 * 16 * LP * 4, OFF_OF = OFF_T0 + 2 * SZ_X512, WS_NEED = OFF_OF + SZ_X512;
static_assert(OFF_HN % 256 == 0 && OFF_RW % 256 == 0 && OFF_T0 % 256 == 0, "alignment");

struct Params { const float* in[26]; float* out; unsigned char* ws; };
struct Ctx { int tid, lane, wave, bid, G; unsigned char* lds; unsigned char* ws; };

__device__ __forceinline__ float bf2f(unsigned b) { return __uint_as_float(b << 16); }
__device__ __forceinline__ float bflo(unsigned w) { return __uint_as_float(w << 16); }
__device__ __forceinline__ float bfhi(unsigned w) { return __uint_as_float(w & 0xffff0000u); }
__device__ __forceinline__ unsigned f2bf(float f) { unsigned u = __float_as_uint(f); return (u + 0x7fffu + ((u >> 16) & 1u)) >> 16; }
__device__ __forceinline__ unsigned pk2(float lo, float hi) { return f2bf(lo) | (f2bf(hi) << 16); }
__device__ __forceinline__ float wave_sum(float v) {
#pragma unroll
    for (int o = 1; o < 64; o <<= 1) v += __shfl_xor(v, o);
    return v;
}
__device__ __forceinline__ float sigmoidf_(float x) { return 1.f / (1.f + __expf(-x)); }
template <int CTRL> __device__ __forceinline__ float dppf(float old, float x) {
    return __int_as_float(__builtin_amdgcn_update_dpp(__float_as_int(old), __float_as_int(x), CTRL, 0xf, 0xf, false));
}
__device__ __forceinline__ float allreduce16(float x) {
    x += dppf<0x121>(0.f, x); x += dppf<0x122>(0.f, x); x += dppf<0x124>(0.f, x); x += dppf<0x128>(0.f, x); return x;
}

namespace pg8 {
struct EpiRoute {
    static constexpr bool PERM = true, AFTER_DRAIN = false;
    unsigned char* ws;
    __device__ __forceinline__ void operator()(const f32x4 (&acc)[2][2][4][2], const Unit& u, int wr, int wc, int fr, int fq) const {
        const int pn = u.pn; size_t off; int ldc, colt;
        if (pn < 6) { off = OFF_Q + (size_t)(pn >> 1) * SZ_X512; ldc = 512; colt = (pn & 1) * 256; }
        else if (pn < 13) { off = OFF_RW; ldc = NRW; colt = (pn - 6) * 256; }
        else { off = OFF_GT; ldc = NGT; colt = (pn - 13) * 256; }
        bf16_t* base = (bf16_t*)(ws + off);
        const int row0 = u.pm * BM + wr * 64 + fr, col0 = colt + wc * 32 + 8 * fq;
#pragma unroll
        for (int ai = 0; ai < 2; ++ai)
#pragma unroll
            for (int m = 0; m < 4; ++m) { bf16_t* rowp = base + (size_t)(row0 + ai * HALF + m * 16) * ldc + col0;
#pragma unroll
                for (int bj = 0; bj < 2; ++bj) { const f32x4 v0 = acc[ai][bj][m][0], v1 = acc[ai][bj][m][1];
                    u32x4 w; w.x = cvt_pk_bf16(v0[0], v0[1]); w.y = cvt_pk_bf16(v0[2], v0[3]); w.z = cvt_pk_bf16(v1[0], v1[1]); w.w = cvt_pk_bf16(v1[2], v1[3]);
                    *(u32x4*)(rowp + bj * HALF) = w; } }
    }
};
template <int MODE> struct EpiGate {
    static constexpr bool PERM = true, AFTER_DRAIN = false;
    bf16_t* O; const bf16_t* GT; const float* gb;
    __device__ __forceinline__ void operator()(const f32x4 (&acc)[2][2][4][2], const Unit& u, int wr, int wc, int fr, int fq) const {
        const int row0 = u.pm * BM + wr * 64 + fr, col0 = u.pn * BM + wc * 32 + 8 * fq;
#pragma unroll
        for (int bj = 0; bj < 2; ++bj) {
            const int c = col0 + bj * HALF;
            const f32x4 b0 = *(const f32x4*)(gb + MODE * 1024 + c), b1 = *(const f32x4*)(gb + MODE * 1024 + c + 4);
#pragma unroll
            for (int ai = 0; ai < 2; ++ai)
#pragma unroll
                for (int m = 0; m < 4; ++m) {
                    const size_t row = (size_t)(row0 + ai * HALF + m * 16);
                    const u32x4 gw = *(const u32x4*)(GT + row * NGT + MODE * 1024 + c);
                    const f32x4 v0 = acc[ai][bj][m][0], v1 = acc[ai][bj][m][1];
                    float r[8];
                    r[0] = sigmoidf_(bflo(gw.x) + b0[0]) * v0[0]; r[1] = sigmoidf_(bfhi(gw.x) + b0[1]) * v0[1];
                    r[2] = sigmoidf_(bflo(gw.y) + b0[2]) * v0[2]; r[3] = sigmoidf_(bfhi(gw.y) + b0[3]) * v0[3];
                    r[4] = sigmoidf_(bflo(gw.z) + b1[0]) * v1[0]; r[5] = sigmoidf_(bfhi(gw.z) + b1[1]) * v1[1];
                    r[6] = sigmoidf_(bflo(gw.w) + b1[2]) * v1[2]; r[7] = sigmoidf_(bfhi(gw.w) + b1[3]) * v1[3];
                    bf16_t* op = O + row * 1024 + c;
                    if (MODE == 1) { const u32x4 ow = *(const u32x4*)op;
                        r[0] += bflo(ow.x); r[1] += bfhi(ow.x); r[2] += bflo(ow.y); r[3] += bfhi(ow.y); r[4] += bflo(ow.z); r[5] += bfhi(ow.z); r[6] += bflo(ow.w); r[7] += bfhi(ow.w); }
                    u32x4 w; w.x = cvt_pk_bf16(r[0], r[1]); w.y = cvt_pk_bf16(r[2], r[3]); w.z = cvt_pk_bf16(r[4], r[5]); w.w = cvt_pk_bf16(r[6], r[7]);
                    *(u32x4*)op = w;
                }
        }
    }
};
struct EpiResid {
    static constexpr bool PERM = false, AFTER_DRAIN = false;
    float* H; float* OUT; int atomic;
    __device__ __forceinline__ void operator()(const f32x4 (&acc)[2][2][4][2], const Unit& u, int wr, int wc, int fr, int fq) const {
        const int row0 = u.pm * BM + wr * 64 + fr, col0 = u.pn * BM + wc * 32 + 4 * fq;
#pragma unroll
        for (int ai = 0; ai < 2; ++ai)
#pragma unroll
            for (int m = 0; m < 4; ++m) {
                const int row = row0 + ai * HALF + m * 16;
                float* hp = H + (size_t)row * DM + col0;
                const int b = row >= LP ? 1 : 0, t = row - b * LP;
                float* op = (OUT && t >= NMETA && t < NMETA + SEQ) ? OUT + ((size_t)b * SEQ + (t - NMETA)) * DM + col0 : nullptr;
#pragma unroll
                for (int bj = 0; bj < 2; ++bj)
#pragma unroll
                    for (int n = 0; n < 2; ++n) { const int co = bj * HALF + n * 16;
                        if (atomic) {
#pragma unroll
                            for (int e = 0; e < 4; ++e) unsafeAtomicAdd(hp + co + e, acc[ai][bj][m][n][e]);
                        } else {
                            const f32x4 v = *(const f32x4*)(hp + co) + acc[ai][bj][m][n];
                            if (OUT) { if (op) *(f32x4*)(op + co) = v; } else *(f32x4*)(hp + co) = v; } }
            }
    }
};
struct EpiResidAtomic {
    static constexpr bool PERM = false, AFTER_DRAIN = false;
    float* H;
    __device__ __forceinline__ void operator()(const f32x4 (&acc)[2][2][4][2], const Unit& u, int wr, int wc, int fr, int fq) const {
        const int row0 = u.pm * BM + wr * 64 + fr, col0 = u.pn * BM + wc * 32 + 4 * fq;
#pragma unroll
        for (int ai = 0; ai < 2; ++ai)
#pragma unroll
            for (int m = 0; m < 4; ++m) { float* hp = H + (size_t)(row0 + ai * HALF + m * 16) * DM + col0;
#pragma unroll
                for (int bj = 0; bj < 2; ++bj)
#pragma unroll
                    for (int n = 0; n < 2; ++n)
#pragma unroll
                        for (int e = 0; e < 4; ++e) unsafeAtomicAdd(hp + bj * HALF + n * 16 + e, acc[ai][bj][m][n][e]); }
    }
};
struct OneUnit {
    StaticOrder so; int mode, pm, pn; bool active;
    __device__ bool next(int i, Unit& u) const { if (mode == 0) return so.next(i, u); if (i != 0 || !active) return false; u.pm = pm; u.pn = pn; return true; }
    __device__ __forceinline__ void a_ready(const Unit&) const {}
    __device__ __forceinline__ void done(const Unit&) const {}
};
struct EpiUp {
    static constexpr bool PERM = true, AFTER_DRAIN = false;
    bf16_t* ACT; bf16_t* HALO; const float* cw;
    __device__ __forceinline__ void operator()(const f32x4 (&acc)[2][2][4][2], const Unit& u, int wr, int wc, int fr, int fq) const {
        const int chan0 = u.pn * 128 + wc * 32 + 8 * fq;
#pragma unroll
        for (int n = 0; n < 2; ++n) {
            const int ch = chan0 + 4 * n;
            f32x4 w[3][2];
#pragma unroll
            for (int j = 0; j < 3; ++j) { w[j][0] = *(const f32x4*)(cw + j * NUP + ch); w[j][1] = *(const f32x4*)(cw + j * NUP + DFF + ch); }
#pragma unroll
            for (int ai = 0; ai < 2; ++ai) {
                const int rowg = u.pm * BM + ai * HALF + wr * 64;
#pragma unroll
                for (int m = 0; m < 4; ++m) {
                    f32x4 uc[2];
#pragma unroll
                    for (int bj = 0; bj < 2; ++bj) {
                        const f32x4 cur = acc[ai][bj][m][n];
                        f32x4 prv; if (m > 0) prv = acc[ai][bj][m - 1][n]; else prv = (f32x4){0.f, 0.f, 0.f, 0.f};
                        f32x4 p1, p2;
#pragma unroll
                        for (int i = 0; i < 4; ++i) {
                            const float r1 = dppf<0x121>(0.f, prv[i]), r2 = dppf<0x122>(0.f, prv[i]);
                            p1[i] = dppf<0x111>(r1, cur[i]); p2[i] = dppf<0x112>(r2, cur[i]);
                        }
                        uc[bj] = w[0][bj] * p2 + w[1][bj] * p1 + w[2][bj] * cur;
                    }
                    float a[4];
#pragma unroll
                    for (int i = 0; i < 4; ++i) a[i] = uc[0][i] * sigmoidf_(uc[0][i]) * uc[1][i];
                    u32x2 o; o.x = cvt_pk_bf16(a[0], a[1]); o.y = cvt_pk_bf16(a[2], a[3]);
                    *(u32x2*)(ACT + (size_t)(rowg + m * 16 + fr) * DFF + ch) = o;
                    if ((m == 3 && fr >= 14) || (m == 0 && fr < 2)) {
                        const int slot = (rowg >> 6) * 4 + (m == 3 ? fr - 14 : 2 + fr);
#pragma unroll
                        for (int bj = 0; bj < 2; ++bj) { const f32x4 cur = acc[ai][bj][m][n]; u32x2 hw; hw.x = cvt_pk_bf16(cur[0], cur[1]); hw.y = cvt_pk_bf16(cur[2], cur[3]);
                            *(u32x2*)(HALO + (size_t)slot * NUP + bj * DFF + ch) = hw; }
                    }
                }
            }
        }
    }
};
}

#ifndef REP_PREP
#define REP_PREP 1
#endif
#ifndef REP_P3
#define REP_P3 1
#endif
#ifndef REP_SYNC
#define REP_SYNC 0
#endif
#define GLD(T, p) (*(const __attribute__((address_space(1))) T*)(p))
#define GST(T, p) (*(__attribute__((address_space(1))) T*)(p))
#define LDS_BARRIER() do { asm volatile("s_waitcnt lgkmcnt(0)" ::: "memory"); __builtin_amdgcn_s_barrier(); asm volatile("" ::: "memory"); } while (0)
__device__ __forceinline__ void transpose_item(const float* W, int Nsrc, int K, bf16* WT, int dst_row0, int src_col0, int k0, float* scr, int lane) {
#pragma unroll 8
    for (int i = 0; i < 32; ++i) { const int kk = 2 * i + (lane >> 5); scr[kk * 33 + (lane & 31)] = W[(size_t)(k0 + kk) * Nsrc + src_col0 + (lane & 31)]; }
    asm volatile("s_waitcnt lgkmcnt(0)" ::: "memory");
    const int c = lane & 7;
#pragma unroll
    for (int j = 0; j < 4; ++j) { const int n = (lane >> 3) + 8 * j; const float* s = scr + (8 * c) * 33 + n;
        u32x4 o; o.x = pk2(s[0 * 33], s[1 * 33]); o.y = pk2(s[2 * 33], s[3 * 33]); o.z = pk2(s[4 * 33], s[5 * 33]); o.w = pk2(s[6 * 33], s[7 * 33]);
        *(u32x4*)(WT + (size_t)(dst_row0 + n) * K + k0 + 8 * c) = o; }
    asm volatile("s_waitcnt lgkmcnt(0)" ::: "memory");
}
__device__ __forceinline__ void convert_weights(const Params& P, int l, const Ctx& c) {
    bf16* WT = (bf16*)(c.ws + OFF_WT);
    float* scr = (float*)(c.lds + c.wave * 16384);
    const int gw = c.bid * NWAVES + c.wave, NGW = c.G * NWAVES;
    constexpr int I_IN = 16 * 168, I_BF = 8 * 32, I_O = 16 * 32, I_UP = 16 * 176, I_DN = 44 * 32, I_LR = 16, I_LG = 32, I_ALL = I_IN + 2 * I_BF + I_O + I_UP + I_DN + 2 * I_LR + I_LG;
    for (int it = gw; it < I_ALL; it += NGW) {
        int r = it;
        if (r < I_IN) { const int kb = r / 168, n0 = 32 * (r % 168); transpose_item(P.in[4] + (size_t)l * 1024 * N_IN, N_IN, 1024, WT + WT_IN, n0, n0 + (n0 >= 1536 ? 8 : 0), 64 * kb, scr, c.lane); continue; } r -= I_IN;
        if (r < I_BF) { const int kb = r / 32, n0 = 32 * (r % 32); transpose_item(P.in[19] + (size_t)l * 512 * 1024, 1024, 512, WT + WT_BF, n0, n0, 64 * kb, scr, c.lane); continue; } r -= I_BF;
        if (r < I_BF) { const int kb = r / 32, n0 = 32 * (r % 32); transpose_item(P.in[20] + (size_t)l * 512 * 1024, 1024, 512, WT + WT_BR, n0, n0, 64 * kb, scr, c.lane); continue; } r -= I_BF;
        if (r < I_O) { const int kb = r / 32, n0 = 32 * (r % 32); transpose_item(P.in[22] + (size_t)l * 1024 * 1024, 1024, 1024, WT + WT_O, n0, n0, 64 * kb, scr, c.lane); continue; } r -= I_O;
        if (r < I_UP) { const int kb = r / 176, n0 = 32 * (r % 176); const int pn = n0 >> 8, bj = (n0 >> 7) & 1, x = n0 & 127;
            transpose_item(P.in[23] + (size_t)l * 1024 * NUP, NUP, 1024, WT + WT_UP, n0, bj * DFF + 128 * pn + x, 64 * kb, scr, c.lane); continue; } r -= I_UP;
        if (r < I_DN) { const int kb = r / 32, n0 = 32 * (r % 32); transpose_item(P.in[25] + (size_t)l * DFF * 1024, 1024, DFF, WT + WT_DN, n0, n0, 64 * kb, scr, c.lane); continue; } r -= I_DN;
        if (r < I_LR) { transpose_item(P.in[10] + (size_t)l * 64 * 512, 512, 64, WT + WT_LW, 32 * r, 32 * r, 0, scr, c.lane); continue; } r -= I_LR;
        if (r < I_LR) { transpose_item(P.in[12] + (size_t)l * 64 * 512, 512, 64, WT + WT_LA, 32 * r, 32 * r, 0, scr, c.lane); continue; } r -= I_LR;
        { const int kb = r / 16, n0 = 32 * (r % 16); transpose_item(P.in[13] + (size_t)l * 128 * 512, 512, 128, WT + WT_LG, n0, n0, 64 * kb, scr, c.lane); }
    }
}

template <bool FG> __device__ __forceinline__ void phase_norm(const Params& P, int l, const Ctx& c) {
    float* H = (float*)(c.ws + OFF_H); bf16* HN = (bf16*)(c.ws + OFF_HN);
    float* LOGF = (float*)(c.ws + OFF_MISC);
    const float* gain = (FG ? P.in[2] : P.in[3]) + l * DM;
    float* wfs = (float*)c.lds;
    if (FG) {
        __syncthreads();
        const float* win = P.in[4] + (size_t)l * 1024 * N_IN + 1536;
        for (int i = c.tid; i < 8192; i += NTHR) wfs[i] = win[(size_t)(i >> 3) * N_IN + (i & 7)];
        __syncthreads();
    }
    const int gw = c.bid * NWAVES + c.wave, NGW = c.G * NWAVES;
    for (int m = gw; m < M; m += NGW) {
        const int b = m >= LP ? 1 : 0, t = m - b * LP;
        f32x4 v[4];
        if (FG && l == 0) {
            const float* src = (t < NMETA) ? P.in[1] + (size_t)t * DM : P.in[0] + ((size_t)b * SEQ + (t - NMETA)) * DM;
            const bool real = t < NMETA + SEQ;
#pragma unroll
            for (int j = 0; j < 4; ++j) { v[j] = real ? *(const f32x4*)(src + 4 * c.lane + 256 * j) : (f32x4){0.f, 0.f, 0.f, 0.f}; *(f32x4*)(H + (size_t)m * DM + 4 * c.lane + 256 * j) = v[j]; }
        } else {
#pragma unroll
            for (int j = 0; j < 4; ++j) v[j] = *(const f32x4*)(H + (size_t)m * DM + 4 * c.lane + 256 * j);
        }
        float ss = 0.f;
#pragma unroll
        for (int j = 0; j < 4; ++j) ss += (v[j].x * v[j].x + v[j].y * v[j].y) + (v[j].z * v[j].z + v[j].w * v[j].w);
        const float rstd = 1.0f / sqrtf(wave_sum(ss) * (1.f / DM) + 1e-6f);
        float f[8];
#pragma unroll
        for (int q = 0; q < 8; ++q) f[q] = 0.f;
#pragma unroll
        for (int j = 0; j < 4; ++j) {
            const f32x4 g = *(const f32x4*)(gain + 4 * c.lane + 256 * j);
            v[j] = v[j] * rstd * g;
            u32x2 o; o.x = pk2(v[j].x, v[j].y); o.y = pk2(v[j].z, v[j].w);
            *(u32x2*)(HN + (size_t)m * DM + 4 * c.lane + 256 * j) = o;
            if (FG) {
#pragma unroll
                for (int e = 0; e < 4; ++e) { const int k = 4 * c.lane + 256 * j + e; const f32x4 w0 = *(const f32x4*)(wfs + k * 8), w1 = *(const f32x4*)(wfs + k * 8 + 4);
                    const float hv = v[j][e];
                    f[0] += hv * w0.x; f[1] += hv * w0.y; f[2] += hv * w0.z; f[3] += hv * w0.w; f[4] += hv * w1.x; f[5] += hv * w1.y; f[6] += hv * w1.z; f[7] += hv * w1.w; }
            }
        }
        if (FG) {
#pragma unroll
            for (int q = 0; q < 8; ++q) f[q] = wave_sum(f[q]);
            float fv = f[0];
#pragma unroll
            for (int q = 1; q < 8; ++q) fv = (c.lane == q) ? f[q] : fv;
            if (c.lane < 8) { const float x = fv + P.in[7][l * 8 + c.lane]; const float ls = fminf(x, 0.f) - __logf(1.f + __expf(-fabsf(x))); LOGF[(size_t)(b * 8 + c.lane) * LP + t] = ls; }
        }
    }
}

__device__ __forceinline__ void phase_fcum(const Params& P, const Ctx& c) {
    if (c.bid < 16 && c.wave == 0) {
        const float* LOGF = (const float*)(c.ws + OFF_MISC) + (size_t)c.bid * LP; float* FC = (float*)(c.ws + OFF_MISC) + 16 * LP + (size_t)c.bid * LP;
        float carry = 0.f;
        for (int ch = 0; ch < LP / 64; ++ch) {
            float v = LOGF[ch * 64 + c.lane];
#pragma unroll
            for (int o = 1; o < 64; o <<= 1) { const float t = __shfl_up(v, o); if (c.lane >= o) v += t; }
            v += carry; FC[ch * 64 + c.lane] = v * LOG2E; carry = __shfl(v, 63);
        }
    }
}

__device__ __forceinline__ void phase_qknorm(const Params& P, int l, const Ctx& c) {
    bf16* Q = (bf16*)(c.ws + OFF_Q); bf16* K = (bf16*)(c.ws + OFF_K);
    const int gw = c.bid * NWAVES + c.wave, NGW = c.G * NWAVES;
    const int d0 = (c.lane & 7) * 8;
    float gq[8], gk[8];
#pragma unroll
    for (int i = 0; i < 8; ++i) { gq[i] = P.in[5][l * 64 + d0 + i] * QSCALE; gk[i] = P.in[6][l * 64 + d0 + i]; }
    for (int m = gw; m < M; m += NGW) {
#pragma unroll
        for (int which = 0; which < 2; ++which) {
            bf16* p = (which ? K : Q) + (size_t)m * 512 + 8 * c.lane;
            const u32x4 w = *(const u32x4*)p;
            float x[8] = {bflo(w.x), bfhi(w.x), bflo(w.y), bfhi(w.y), bflo(w.z), bfhi(w.z), bflo(w.w), bfhi(w.w)};
            float ss = 0.f;
#pragma unroll
            for (int i = 0; i < 8; ++i) ss += x[i] * x[i];
            ss += __shfl_xor(ss, 1); ss += __shfl_xor(ss, 2); ss += __shfl_xor(ss, 4);
            const float rs = 1.0f / sqrtf(ss * (1.f / 64.f) + 1e-6f);
#pragma unroll
            for (int i = 0; i < 8; ++i) x[i] = x[i] * rs * (which ? gk[i] : gq[i]);
            u32x4 o; o.x = pk2(x[0], x[1]); o.y = pk2(x[2], x[3]); o.z = pk2(x[4], x[5]); o.w = pk2(x[6], x[7]);
            *(u32x4*)p = o;
        }
    }
}

constexpr int NCHK = LP / 64;
constexpr int NUNIT = NB * NCHK * 8;
constexpr int UNIT_A = 16384, UNIT_B = 16640;
constexpr int ST = 72, STG = 136;
constexpr int L_F0 = 92160, L_F1 = 108544;
struct RwkvBufs { bf16 *BON, *G; unsigned char *UA, *UB; float* Y; bf16* ORW; };
__device__ __forceinline__ RwkvBufs rwkv_bufs(const Params& P, const Ctx& c) {
    RwkvBufs r; r.BON = (bf16*)(c.ws + OFF_HN); r.G = r.BON + (size_t)M * 512;
    r.UA = c.ws + OFF_T0; r.UB = (unsigned char*)P.out;
    r.Y = (float*)(c.ws + OFF_RW); r.ORW = (bf16*)(c.ws + OFF_RW + (size_t)M * 512 * 4);
    return r;
}
__device__ __forceinline__ void mm_tile(const bf16* A, int sa, const bf16* Bt, int sb, int nks, f32x4 (&acc)[2], int w, int lq, int g) {
    const int mt = w >> 1, nt0 = 2 * (w & 1);
    for (int ks = 0; ks < nks; ++ks) {
        const bf16x8 a = *(const bf16x8*)(A + (16 * mt + lq) * sa + 32 * ks + 8 * g);
#pragma unroll
        for (int q = 0; q < 2; ++q) { const bf16x8 b = *(const bf16x8*)(Bt + (16 * (nt0 + q) + lq) * sb + 32 * ks + 8 * g); acc[q] = __builtin_amdgcn_mfma_f32_16x16x32_bf16(a, b, acc[q], 0, 0, 0); }
    }
}
#define ZACC(a) do { a[0] = (f32x4){0.f, 0.f, 0.f, 0.f}; a[1] = (f32x4){0.f, 0.f, 0.f, 0.f}; } while (0)
__device__ __forceinline__ int permk(int k) { return 32 * (k >> 5) + 8 * ((k & 15) >> 2) + 4 * ((k >> 4) & 1) + (k & 3); }
__device__ __forceinline__ int swz(int row, int col) { return row * 128 + ((((col >> 3) ^ (row >> 1)) & 7) << 4) + (col & 7) * 2; }

__device__ __forceinline__ void rwkv_prep_unit(const Params& P, int l, const Ctx& c, int u, const RwkvBufs& B) {
    const int h = u & 7, bc = u >> 3, b = bc / NCHK, ch = bc - b * NCHK;
    const size_t m0 = (size_t)b * LP + ch * 64;
    int tid_ = c.tid; asm volatile("" : "+v"(tid_));
    const int tid = tid_, lane = tid & 63, w = c.wave, lq = lane & 15, g = lane >> 4;
    const int t = tid >> 3, cg = tid & 7, c0 = cg * 8, jb = h * 64 + c0;
    unsigned char* L = c.lds;
    bf16* A0 = (bf16*)L; bf16* A1 = A0 + 4608; bf16* A2 = A1 + 4608; bf16* A3 = A2 + 4608; bf16* A4 = A3 + 4608; bf16* A5 = A4 + 4608; bf16* A6 = A5 + 4608;
    bf16* A7 = A6 + 4608; bf16* A8 = A7 + 4608; bf16* A9 = A8 + 4608;
    float* F0 = (float*)(L + L_F0); float* F1 = (float*)(L + L_F1);
    const bf16* RW = (const bf16*)(c.ws + OFF_RW);
    const bf16* WT = (const bf16*)(c.ws + OFF_WT);
    const float* mu = P.in[8] + l * NRW;
    const bool first = (ch == 0 && t == 0);
    const bf16* cur = RW + (m0 + t) * NRW; const bf16* prv = cur - NRW;
    float zr[8], zk[8], zv[8];
#pragma unroll
    for (int s = 0; s < 3; ++s) {
        const u32x4 cw = *(const u32x4*)(cur + s * 512 + jb); u32x4 pw = (u32x4){0u, 0u, 0u, 0u}; if (!first) pw = *(const u32x4*)(prv + s * 512 + jb);
        const float cv[8] = {bflo(cw.x), bfhi(cw.x), bflo(cw.y), bfhi(cw.y), bflo(cw.z), bfhi(cw.z), bflo(cw.w), bfhi(cw.w)};
        const float pv[8] = {bflo(pw.x), bfhi(pw.x), bflo(pw.y), bfhi(pw.y), bflo(pw.z), bfhi(pw.z), bflo(pw.w), bfhi(pw.w)};
#pragma unroll
        for (int i = 0; i < 8; ++i) { const float z = cv[i] + mu[s * 512 + jb + i] * (pv[i] - cv[i]); if (s == 0) zr[i] = z; else if (s == 1) zk[i] = z; else zv[i] = z; }
    }
#pragma unroll
    for (int q4 = 0; q4 < 4; ++q4) {
        const int col = cg * 32 + q4 * 8;
        const u32x4 cw = *(const u32x4*)(cur + 1536 + col); u32x4 pw = (u32x4){0u, 0u, 0u, 0u}; if (!first) pw = *(const u32x4*)(prv + 1536 + col);
        const float cv[8] = {bflo(cw.x), bfhi(cw.x), bflo(cw.y), bfhi(cw.y), bflo(cw.z), bfhi(cw.z), bflo(cw.w), bfhi(cw.w)};
        const float pv[8] = {bflo(pw.x), bfhi(pw.x), bflo(pw.y), bfhi(pw.y), bflo(pw.z), bfhi(pw.z), bflo(pw.w), bfhi(pw.w)};
        float z[8];
#pragma unroll
        for (int i = 0; i < 8; ++i) { z[i] = cv[i] + mu[1536 + col + i] * (pv[i] - cv[i]); if (col < 64) z[i] = 1.f - 2.f / (1.f + __expf(2.f * z[i])); else if (col >= 128) z[i] = sigmoidf_(z[i]); }
        u32x4 o; o.x = pk2(z[0], z[1]); o.y = pk2(z[2], z[3]); o.z = pk2(z[4], z[5]); o.w = pk2(z[6], z[7]);
        bf16* dst = (col < 64) ? A0 + t * ST + col : (col < 128 ? A1 + t * ST + (col - 64) : A2 + t * STG + (col - 128));
        *(u32x4*)dst = o;
    }
    { const int row = tid >> 3, chk = tid & 7;
      *(u32x4*)(A4 + row * ST + chk * 8) = *(const u32x4*)(WT + WT_LW + (size_t)(h * 64 + row) * 64 + chk * 8);
      *(u32x4*)(A5 + row * ST + chk * 8) = *(const u32x4*)(WT + WT_LA + (size_t)(h * 64 + row) * 64 + chk * 8);
#pragma unroll
      for (int i = 0; i < 2; ++i) { const int idx = tid + 512 * i, r2 = idx >> 4, c2 = idx & 15;
          *(u32x4*)((bf16*)F1 + r2 * STG + c2 * 8) = *(const u32x4*)(WT + WT_LG + (size_t)(h * 64 + r2) * 128 + c2 * 8); } }
    __syncthreads();
    { f32x4 aw[2], aa[2], ag[2]; ZACC(aw); ZACC(aa); ZACC(ag);
      mm_tile(A0, ST, A4, ST, 2, aw, w, lq, g); mm_tile(A1, ST, A5, ST, 2, aa, w, lq, g); mm_tile(A2, STG, (const bf16*)F1, STG, 4, ag, w, lq, g);
      const int mt = w >> 1, nt0 = 2 * (w & 1);
#pragma unroll
      for (int q = 0; q < 2; ++q)
#pragma unroll
          for (int j = 0; j < 4; ++j) { const int o = (16 * mt + 4 * g + j) * ST + 16 * (nt0 + q) + lq; A7[o] = (bf16)f2bf(aw[q][j]); A8[o] = (bf16)f2bf(aa[q][j]); A9[o] = (bf16)f2bf(ag[q][j]); } }
    __syncthreads();
    float kk[8], k2[8], ar[8];
    { const u32x4 lw = *(const u32x4*)(A7 + t * ST + c0), la = *(const u32x4*)(A8 + t * ST + c0), lg = *(const u32x4*)(A9 + t * ST + c0);
      const float fw[8] = {bflo(lw.x), bfhi(lw.x), bflo(lw.y), bfhi(lw.y), bflo(lw.z), bfhi(lw.z), bflo(lw.w), bfhi(lw.w)};
      const float fa[8] = {bflo(la.x), bfhi(la.x), bflo(la.y), bfhi(la.y), bflo(la.z), bfhi(la.z), bflo(la.w), bfhi(la.w)};
      float ss = 0.f, bs = 0.f;
#pragma unroll
      for (int i = 0; i < 8; ++i) { const int j = l * 512 + jb + i;
          const float xw = -(P.in[9][j] + fw[i]); const float sp = fmaxf(xw, 0.f) + __logf(1.f + __expf(-fabsf(xw)));
          F0[t * 64 + c0 + i] = __expf(-sp - 0.5f);
          ar[i] = sigmoidf_(P.in[11][j] + fa[i]);
          kk[i] = zk[i] * P.in[14][j]; ss += kk[i] * kk[i];
          k2[i] = zk[i] * (1.f + (ar[i] - 1.f) * P.in[15][j]);
          bs += zr[i] * k2[i] * P.in[16][j]; }
      ss += __shfl_xor(ss, 1); ss += __shfl_xor(ss, 2); ss += __shfl_xor(ss, 4);
      bs += __shfl_xor(bs, 1); bs += __shfl_xor(bs, 2); bs += __shfl_xor(bs, 4);
      const float inv = 1.0f / fmaxf(sqrtf(ss), 1e-12f);
#pragma unroll
      for (int i = 0; i < 8; ++i) kk[i] *= inv;
      u32x4 bo; bo.x = pk2(bs * zv[0], bs * zv[1]); bo.y = pk2(bs * zv[2], bs * zv[3]); bo.z = pk2(bs * zv[4], bs * zv[5]); bo.w = pk2(bs * zv[6], bs * zv[7]);
      *(u32x4*)(B.BON + (m0 + t) * 512 + jb) = bo; *(u32x4*)(B.G + (m0 + t) * 512 + jb) = lg; }
    __syncthreads();
    {
      const int k = tid & 63, sg = tid >> 6; float e[8], run = 0.f;
#pragma unroll
      for (int s = 0; s < 8; ++s) { run += F0[(8 * sg + s) * 64 + k]; e[s] = run; }
      F1[sg * 64 + k] = run;
      __syncthreads();
      float off = 0.f;
#pragma unroll
      for (int s = 0; s < 8; ++s) off += (s < sg) ? F1[s * 64 + k] : 0.f;
#pragma unroll
      for (int s = 0; s < 8; ++s) F0[(8 * sg + s) * 64 + k] = e[s] + off; }
    __syncthreads();
    { float ct[8], cp[8], cC[8];
#pragma unroll
      for (int i = 0; i < 8; ++i) { ct[i] = F0[t * 64 + c0 + i]; cp[i] = (t > 0) ? F0[(t - 1) * 64 + c0 + i] : 0.f; cC[i] = F0[63 * 64 + c0 + i]; }
      float at[8], bt[8], kt[8], rt[8], bh[8], kh[8];
#pragma unroll
      for (int i = 0; i < 8; ++i) { const float gt = __expf(-ct[i]), igt = __expf(ct[i]), gp = __expf(-cp[i]), gct = __expf(ct[i] - cC[i]);
          at[i] = -kk[i] * gp; bt[i] = kk[i] * ar[i] * igt; kt[i] = k2[i] * igt; rt[i] = zr[i] * gt; bh[i] = kk[i] * ar[i] * gct; kh[i] = k2[i] * gct; }
      u32x4 o;
      o.x = pk2(at[0], at[1]); o.y = pk2(at[2], at[3]); o.z = pk2(at[4], at[5]); o.w = pk2(at[6], at[7]); *(u32x4*)(A0 + t * ST + c0) = o;
      o.x = pk2(bt[0], bt[1]); o.y = pk2(bt[2], bt[3]); o.z = pk2(bt[4], bt[5]); o.w = pk2(bt[6], bt[7]); *(u32x4*)(A1 + t * ST + c0) = o;
      o.x = pk2(kt[0], kt[1]); o.y = pk2(kt[2], kt[3]); o.z = pk2(kt[4], kt[5]); o.w = pk2(kt[6], kt[7]); *(u32x4*)(A2 + t * ST + c0) = o;
      o.x = pk2(rt[0], rt[1]); o.y = pk2(rt[2], rt[3]); o.z = pk2(rt[4], rt[5]); o.w = pk2(rt[6], rt[7]); *(u32x4*)(A3 + t * ST + c0) = o;
#pragma unroll
      for (int i = 0; i < 8; ++i) { A4[(c0 + i) * ST + t] = (bf16)f2bf(bh[i]); A5[(c0 + i) * ST + t] = (bf16)f2bf(kh[i]); A6[(c0 + i) * ST + t] = (bf16)f2bf(zv[i]); F1[t * 128 + c0 + i] = at[i]; }
      if (t == 63) { float* gc = (float*)(B.UB + (size_t)u * UNIT_B + 16384) + c0;
#pragma unroll
          for (int i = 0; i < 8; ++i) gc[i] = __expf(-cC[i]); } }
    __syncthreads();
    { const int mt = w >> 1, nt0 = 2 * (w & 1);
      f32x4 a1[2], a2[2], a3[2], a4[2]; ZACC(a1); ZACC(a2); ZACC(a3); ZACC(a4);
      mm_tile(A0, ST, A1, ST, 2, a1, w, lq, g); mm_tile(A0, ST, A2, ST, 2, a2, w, lq, g); mm_tile(A3, ST, A1, ST, 2, a3, w, lq, g); mm_tile(A3, ST, A2, ST, 2, a4, w, lq, g);
      __syncthreads();
#pragma unroll
      for (int q = 0; q < 2; ++q) { const int i = 16 * (nt0 + q) + lq; f32x4 lab;
#pragma unroll
          for (int j = 0; j < 4; ++j) { const int tt = 16 * mt + 4 * g + j; lab[j] = (i < tt) ? a1[q][j] : 0.f;
              A7[tt * ST + i] = (bf16)f2bf((i < tt) ? a2[q][j] : 0.f); A8[tt * ST + i] = (bf16)f2bf((i <= tt) ? a3[q][j] : 0.f); A9[tt * ST + i] = (bf16)f2bf((i <= tt) ? a4[q][j] : 0.f); }
          *(f32x4*)(F0 + i * 64 + 16 * mt + 4 * g) = lab; } }
    __syncthreads();
    { const int mt = w >> 1, nt0 = 2 * (w & 1); f32x4 a[2]; ZACC(a);
      mm_tile(A7, ST, A6, ST, 2, a, w, lq, g);
#pragma unroll
      for (int q = 0; q < 2; ++q)
#pragma unroll
          for (int j = 0; j < 4; ++j) F1[(16 * mt + 4 * g + j) * 128 + 64 + 16 * (nt0 + q) + lq] = a[q][j]; }
    __syncthreads();
    { float X[16];
      const int col = 16 * w + lq;
#pragma unroll
      for (int r = 0; r < 16; ++r) X[r] = F1[(4 * r + g) * 128 + col];
      __syncthreads();
#pragma unroll
      for (int i = 0; i < 64; ++i) {
          const float xi = __shfl(X[i >> 2], (i & 3) * 16 + lq);
#pragma unroll
          for (int r = (i >> 2); r < 16; ++r) X[r] += F0[i * 64 + 4 * r + g] * xi;
          asm volatile("" ::: "memory");
      }
      bf16* XT = (bf16*)F1 + (w >> 2) * 4608 + ((col & 63) * ST);
#pragma unroll
      for (int r = 0; r < 16; ++r) XT[4 * r + g] = (bf16)f2bf(X[r]); }
    __syncthreads();
    { const int mt = w >> 1, nt0 = 2 * (w & 1);
      const bf16* AhT = (const bf16*)F1; const bf16* W2T = AhT + 4608;
      unsigned char* ua = B.UA + (size_t)u * UNIT_A; unsigned char* ub = B.UB + (size_t)u * UNIT_B;
      f32x4 a[2];
      ZACC(a); mm_tile(A4, ST, AhT, ST, 2, a, w, lq, g);
#pragma unroll
      for (int q = 0; q < 2; ++q)
#pragma unroll
          for (int j = 0; j < 4; ++j) { const int row = 16 * mt + 4 * g + j, kc = 16 * (nt0 + q) + lq; *(bf16*)(ua + swz(row, permk(kc))) = (bf16)f2bf(a[q][j]); }
      ZACC(a); mm_tile(A8, ST, AhT, ST, 2, a, w, lq, g);
#pragma unroll
      for (int q = 0; q < 2; ++q)
#pragma unroll
          for (int j = 0; j < 4; ++j) { const int row = 16 * mt + 4 * g + j, kc = 16 * (nt0 + q) + lq; *(bf16*)(ua + 8192 + swz(row, permk(kc))) = (bf16)f2bf(a[q][j] + bf2f(A3[row * ST + kc])); }
      ZACC(a); mm_tile(A4, ST, W2T, ST, 2, a, w, lq, g); mm_tile(A5, ST, A6, ST, 2, a, w, lq, g);
#pragma unroll
      for (int q = 0; q < 2; ++q) { const int v = 16 * (nt0 + q) + lq, k0 = 16 * mt + 4 * g; u32x2 o; o.x = pk2(a[q][0], a[q][1]); o.y = pk2(a[q][2], a[q][3]); *(u32x2*)(ub + swz(v, k0)) = o; }
      ZACC(a); mm_tile(A8, ST, W2T, ST, 2, a, w, lq, g); mm_tile(A9, ST, A6, ST, 2, a, w, lq, g);
#pragma unroll
      for (int q = 0; q < 2; ++q) { const int v = 16 * (nt0 + q) + lq, t0 = 16 * mt + 4 * g; u32x2 o; o.x = pk2(a[q][0], a[q][1]); o.y = pk2(a[q][2], a[q][3]); *(u32x2*)(ub + 8192 + swz(v, t0)) = o; } }
    __syncthreads();
}
__device__ __forceinline__ void phase_rwkv_prep(const Params& P, int l, const Ctx& c) {
    const RwkvBufs B = rwkv_bufs(P, c);
    for (int u = c.bid; u < NUNIT; u += c.G) rwkv_prep_unit(P, l, c, u, B);
}

constexpr int SLOTB = 33280, YST = 68;
__device__ __forceinline__ void scan_chunked(const Params& P, const Ctx& c, int bh) {
    const RwkvBufs B = rwkv_bufs(P, c);
    const int b = bh >> 3, h = bh & 7, w = c.wave, lane = c.lane, lq = lane & 15, g = lane >> 4;
    const size_t rowb = (size_t)b * LP;
    const int ll = c.tid;
    unsigned char* L = c.lds;
    f32x4 st[4];
#pragma unroll
    for (int i = 0; i < 4; ++i) st[i] = (f32x4){0.f, 0.f, 0.f, 0.f};
    u32x4 r0[5], r1[5], r2[5], r3[5], r4[5];
#define SC_UNIT(cc) ((size_t)((b * NCHK + (cc)) * 8 + h))
#define SC_LOAD(R, cc) do { const unsigned char* pa_ = B.UA + SC_UNIT(cc) * UNIT_A; const unsigned char* pb_ = B.UB + SC_UNIT(cc) * UNIT_B; \
        _Pragma("unroll") for (int i_ = 0; i_ < 2; ++i_) { R[i_] = GLD(u32x4, pa_ + (ll + 512 * i_) * 16); R[2 + i_] = GLD(u32x4, pb_ + (ll + 512 * i_) * 16); } \
        if (ll < 16) R[4] = GLD(u32x4, pb_ + 16384 + ll * 16); } while (0)
#define SC_WRITE(R, slot) do { unsigned char* s_ = L + (slot) * SLOTB; \
        _Pragma("unroll") for (int i_ = 0; i_ < 2; ++i_) { *(u32x4*)(s_ + (ll + 512 * i_) * 16) = R[i_]; *(u32x4*)(s_ + 16384 + (ll + 512 * i_) * 16) = R[2 + i_]; } \
        if (ll < 16) *(u32x4*)(s_ + 32768 + ll * 16) = R[4]; } while (0)
#define SC_COMPUTE(ci) do { \
        const unsigned char* sl = L + ((ci) % 3) * SLOTB; \
        const int vcol = 16 * w + lq; \
        bf16x8 gaf[4][2]; f32x4 gcf[4]; u32x2 d0f[4]; \
        _Pragma("unroll") for (int mt = 0; mt < 4; ++mt) { \
            gcf[mt] = *(const f32x4*)(sl + 32768 + (16 * mt + 4 * g) * 4); \
            d0f[mt] = *(const u32x2*)(sl + 16384 + swz(vcol, 16 * mt + 4 * g)); \
            _Pragma("unroll") for (int ks = 0; ks < 2; ++ks) gaf[mt][ks] = *(const bf16x8*)(sl + swz(16 * mt + lq, 32 * ks + 8 * g)); } \
        __builtin_amdgcn_sched_barrier(0);        \
        bf16x8 sb[2]; \
        _Pragma("unroll") for (int ks = 0; ks < 2; ++ks) { u32x4 pw; pw.x = pk2(st[2 * ks][0], st[2 * ks][1]); pw.y = pk2(st[2 * ks][2], st[2 * ks][3]); pw.z = pk2(st[2 * ks + 1][0], st[2 * ks + 1][1]); pw.w = pk2(st[2 * ks + 1][2], st[2 * ks + 1][3]); \
            sb[ks] = __builtin_bit_cast(bf16x8, pw); } \
        _Pragma("unroll") for (int mt = 0; mt < 4; ++mt) { \
            f32x4 ns = (f32x4){bflo(d0f[mt].x), bfhi(d0f[mt].x), bflo(d0f[mt].y), bfhi(d0f[mt].y)} + gcf[mt] * st[mt]; \
            _Pragma("unroll") for (int ks = 0; ks < 2; ++ks) ns = __builtin_amdgcn_mfma_f32_16x16x32_bf16(gaf[mt][ks], sb[ks], ns, 0, 0, 0); \
            st[mt] = ns; } \
        _Pragma("unroll") for (int mt = 0; mt < 4; ++mt) { \
            const u32x2 y0 = *(const u32x2*)(sl + 24576 + swz(vcol, 16 * mt + 4 * g)); \
            f32x4 ya = (f32x4){bflo(y0.x), bfhi(y0.x), bflo(y0.y), bfhi(y0.y)}; \
            _Pragma("unroll") for (int ks = 0; ks < 2; ++ks) { const bf16x8 rh = *(const bf16x8*)(sl + 8192 + swz(16 * mt + lq, 32 * ks + 8 * g)); ya = __builtin_amdgcn_mfma_f32_16x16x32_bf16(rh, sb[ks], ya, 0, 0, 0); } \
            float* yl = (float*)(L + 3 * SLOTB) + ((ci) & 1) * (64 * YST) + (16 * mt + 4 * g) * YST + vcol; \
            _Pragma("unroll") for (int j = 0; j < 4; ++j) yl[j * YST] = ya[j]; } } while (0)
#define SC_YSTORE(ci) do { const float* ys_ = (const float*)(L + 3 * SLOTB) + ((ci) & 1) * (64 * YST) + (c.tid >> 3) * YST + (c.tid & 7) * 8; \
        float* yg_ = B.Y + (rowb + (ci) * 64 + (c.tid >> 3)) * 512 + h * 64 + (c.tid & 7) * 8; \
        GST(f32x4, yg_) = *(const f32x4*)ys_; GST(f32x4, yg_ + 4) = *(const f32x4*)(ys_ + 4); } while (0)
#define SC_ITER(ci, R) do { if ((ci) + 2 < NCHK) SC_WRITE(R, ((ci) + 2) % 3); if ((ci) + 7 < NCHK) SC_LOAD(R, (ci) + 7); if ((ci) > 0) SC_YSTORE((ci) - 1); if (w < 4) { SC_COMPUTE(ci); } LDS_BARRIER(); } while (0)
    { SC_LOAD(r0, 0); SC_LOAD(r1, 1); SC_WRITE(r0, 0); SC_WRITE(r1, 1); SC_LOAD(r2, 2); SC_LOAD(r3, 3); SC_LOAD(r4, 4); SC_LOAD(r0, 5); SC_LOAD(r1, 6); }
    __syncthreads();
#pragma unroll 1
    for (int cc = 0; cc < NCHK; cc += 5) { SC_ITER(cc, r2); SC_ITER(cc + 1, r3); SC_ITER(cc + 2, r4); SC_ITER(cc + 3, r0); SC_ITER(cc + 4, r1); }
    SC_YSTORE(NCHK - 1);
#undef SC_YSTORE
#undef SC_COMPUTE
#undef SC_ITER
#undef SC_UNIT
#undef SC_LOAD
#undef SC_WRITE
}

__device__ __forceinline__ void phase_gn(const Params& P, int l, const Ctx& c) {
    const RwkvBufs B = rwkv_bufs(P, c);
    const int gw = c.bid * NWAVES + c.wave, NGW = c.G * NWAVES;
    const int c0 = 8 * c.lane;
    float gnw[8], gnb[8];
#pragma unroll
    for (int i = 0; i < 8; ++i) { gnw[i] = P.in[17][l * 512 + c0 + i]; gnb[i] = P.in[18][l * 512 + c0 + i]; }
    for (int m = gw; m < M; m += NGW) {
        const size_t o = (size_t)m * 512 + c0;
        const f32x4 y0 = *(const f32x4*)(B.Y + o), y1 = *(const f32x4*)(B.Y + o + 4);
        float y[8] = {y0.x, y0.y, y0.z, y0.w, y1.x, y1.y, y1.z, y1.w};
        const u32x4 bw = *(const u32x4*)(B.BON + o), gw4 = *(const u32x4*)(B.G + o);
        const float bo[8] = {bflo(bw.x), bfhi(bw.x), bflo(bw.y), bfhi(bw.y), bflo(bw.z), bfhi(bw.z), bflo(bw.w), bfhi(bw.w)};
        const float gg[8] = {bflo(gw4.x), bfhi(gw4.x), bflo(gw4.y), bfhi(gw4.y), bflo(gw4.z), bfhi(gw4.z), bflo(gw4.w), bfhi(gw4.w)};
        float s = 0.f;
#pragma unroll
        for (int i = 0; i < 8; ++i) s += y[i];
        s += __shfl_xor(s, 1); s += __shfl_xor(s, 2); s += __shfl_xor(s, 4);
        const float mean = s * (1.f / 64.f);
        float q = 0.f;
#pragma unroll
        for (int i = 0; i < 8; ++i) { y[i] -= mean; q += y[i] * y[i]; }
        q += __shfl_xor(q, 1); q += __shfl_xor(q, 2); q += __shfl_xor(q, 4);
        const float rstd = 1.0f / sqrtf(q * (1.f / 64.f) + 64e-5f);
        float ov[8];
#pragma unroll
        for (int i = 0; i < 8; ++i) ov[i] = (y[i] * rstd * gnw[i] + gnb[i] + bo[i]) * gg[i];
        u32x4 ow; ow.x = pk2(ov[0], ov[1]); ow.y = pk2(ov[2], ov[3]); ow.z = pk2(ov[4], ov[5]); ow.w = pk2(ov[6], ov[7]);
        *(u32x4*)(B.ORW + o) = ow;
    }
}

__device__ __forceinline__ void attn_unit(const Ctx& c, int bh, int qb, const bf16* Q, const bf16* K, const bf16* V, bf16* O, const float* FC, float qkb2) {
    const int b = bh >> 3, h = bh & 7, lane = c.lane, w = c.wave, lq = lane & 15, g = lane >> 4;
    const int q0 = qb * 128;
    const size_t rowb = (size_t)b * LP;
    const int qrow = q0 + 16 * w + lq;
    bf16* Ks = (bf16*)c.lds; bf16* Vt = Ks + 64 * 72; float* fks = (float*)(Vt + 64 * 72);
    const bf16* qp = Q + (rowb + qrow) * 512 + h * 64 + 8 * g;
    const bf16x8 qf0 = GLD(bf16x8, qp), qf1 = GLD(bf16x8, qp + 32);
    const float* FCh = FC + (size_t)bh * LP;
    const float fq = GLD(float, FCh + qrow);
    float mrun = -1e30f, lsum = 0.f;
    f32x4 o[4];
#pragma unroll
    for (int i = 0; i < 4; ++i) o[i] = (f32x4){0.f, 0.f, 0.f, 0.f};
    const int kt_max = (q0 + 127) >> 6;
    const int lkey = c.tid >> 3, lch = c.tid & 7;
    const size_t gbase = (rowb + lkey) * 512 + h * 64 + lch * 8;
    u32x4 kv = GLD(u32x4, K + gbase + (size_t)kt_max * 64 * 512), vv = GLD(u32x4, V + gbase + (size_t)kt_max * 64 * 512);
    float fkv = GLD(float, FCh + kt_max * 64 + (c.tid & 63));
    volatile unsigned* vote = (volatile unsigned*)(fks + 64);
    for (int kt = kt_max; kt >= 0; --kt) {
        const int k0 = kt * 64;
        LDS_BARRIER();
        { int can = 0; if (kt < kt_max) { const float fl = __shfl(fkv, 63); can = (qkb2 + fq - fl) < (mrun - THR2); }
          const int wall = __all(can); if (lane == 0) vote[w] = (unsigned)wall; }
        { *(u32x4*)(Ks + lkey * 72 + lch * 8) = kv;
            bf16* vd = Vt + (lch * 8) * 72 + lkey;
            vd[0] = (bf16)(vv.x & 0xffff); vd[72] = (bf16)(vv.x >> 16); vd[144] = (bf16)(vv.y & 0xffff); vd[216] = (bf16)(vv.y >> 16);
            vd[288] = (bf16)(vv.z & 0xffff); vd[360] = (bf16)(vv.z >> 16); vd[432] = (bf16)(vv.w & 0xffff); vd[504] = (bf16)(vv.w >> 16);
            if (c.tid < 64) fks[c.tid] = fkv;
            if (kt > 0) { kv = GLD(u32x4, K + gbase + (size_t)(k0 - 64) * 512); vv = GLD(u32x4, V + gbase + (size_t)(k0 - 64) * 512); fkv = GLD(float, FCh + k0 - 64 + (c.tid & 63)); } }
        LDS_BARRIER();
        { unsigned all = vote[0] & vote[1] & vote[2] & vote[3] & vote[4] & vote[5] & vote[6] & vote[7]; if (all) break; }
        if (k0 > q0 + 16 * w + 15) continue;
        f32x4 s[4];
#pragma unroll
        for (int nt = 0; nt < 4; ++nt) { const bf16* kp = Ks + (16 * nt + lq) * 72 + 8 * g; const bf16x8 a0 = *(const bf16x8*)kp, a1 = *(const bf16x8*)(kp + 32);
            s[nt] = __builtin_amdgcn_mfma_f32_16x16x32_bf16(a0, qf0, (f32x4){0.f, 0.f, 0.f, 0.f}, 0, 0, 0);
            s[nt] = __builtin_amdgcn_mfma_f32_16x16x32_bf16(a1, qf1, s[nt], 0, 0, 0); }
        float mx = -INFINITY;
#pragma unroll
        for (int nt = 0; nt < 4; ++nt) { const f32x4 fk = *(const f32x4*)(fks + 16 * nt + 4 * g);
#pragma unroll
            for (int j = 0; j < 4; ++j) { float x = s[nt][j] + fq - fk[j]; const int key = k0 + 16 * nt + 4 * g + j; if (key > qrow) x = -INFINITY; s[nt][j] = x; mx = fmaxf(mx, x); } }
        mx = fmaxf(mx, __shfl_xor(mx, 16)); mx = fmaxf(mx, __shfl_xor(mx, 32));
        const float mnew = fmaxf(mrun, mx), alpha = exp2f(mrun - mnew); mrun = mnew;
        float psum = 0.f;
#pragma unroll
        for (int nt = 0; nt < 4; ++nt)
#pragma unroll
            for (int j = 0; j < 4; ++j) { const float p = exp2f(s[nt][j] - mnew); s[nt][j] = p; psum += p; }
        lsum = lsum * alpha + psum;
#pragma unroll
        for (int dt = 0; dt < 4; ++dt) o[dt] = o[dt] * alpha;
        bf16x8 pb[2];
#pragma unroll
        for (int k2 = 0; k2 < 2; ++k2) { u32x4 pw; pw.x = pk2(s[2 * k2][0], s[2 * k2][1]); pw.y = pk2(s[2 * k2][2], s[2 * k2][3]); pw.z = pk2(s[2 * k2 + 1][0], s[2 * k2 + 1][1]); pw.w = pk2(s[2 * k2 + 1][2], s[2 * k2 + 1][3]);
            pb[k2] = __builtin_bit_cast(bf16x8, pw); }
#pragma unroll
        for (int dt = 0; dt < 4; ++dt)
#pragma unroll
            for (int k2 = 0; k2 < 2; ++k2) { const bf16* vp = Vt + (16 * dt + lq) * 72 + 32 * k2 + 4 * g;
                const u32x2 lo = *(const u32x2*)vp, hi = *(const u32x2*)(vp + 16);
                u32x4 aw; aw.x = lo.x; aw.y = lo.y; aw.z = hi.x; aw.w = hi.y;
                o[dt] = __builtin_amdgcn_mfma_f32_16x16x32_bf16(__builtin_bit_cast(bf16x8, aw), pb[k2], o[dt], 0, 0, 0); }
    }
    lsum += __shfl_xor(lsum, 16); lsum += __shfl_xor(lsum, 32);
    const float inv = 1.0f / lsum;
    bf16* op = O + (rowb + qrow) * 512 + h * 64 + 4 * g;
#pragma unroll
    for (int dt = 0; dt < 4; ++dt) { u32x2 ow; ow.x = pk2(o[dt][0] * inv, o[dt][1] * inv); ow.y = pk2(o[dt][2] * inv, o[dt][3] * inv); GST(u32x2, op + 16 * dt) = ow; }
    __syncthreads();
}
__device__ __forceinline__ void phase_attn(const Params& P, int l, const Ctx& c, int first_blk) {
    const bf16* Q = (const bf16*)(c.ws + OFF_Q); const bf16* K = (const bf16*)(c.ws + OFF_K); const bf16* V = (const bf16*)(c.ws + OFF_V);
    const float* FC = (const float*)(c.ws + OFF_MISC) + 16 * LP;
    float gqm = fabsf(P.in[5][l * 64 + c.lane]), gkm = fabsf(P.in[6][l * 64 + c.lane]);
#pragma unroll
    for (int o = 1; o < 64; o <<= 1) { gqm = fmaxf(gqm, __shfl_xor(gqm, o)); gkm = fmaxf(gkm, __shfl_xor(gkm, o)); }
    const float qkb2 = 8.0f * gqm * gkm * LOG2E * 1.03f;
    constexpr int NQB = LP / 128, NU = 16 * NQB;
    unsigned* ctr = (unsigned*)(c.ws + OFF_CTL) + 8192 + 64 * l;
    volatile unsigned* slot = (volatile unsigned*)(c.lds + MISC_OFF) + 4;
    for (;;) {
        __syncthreads();
        if (c.tid == 0) *slot = atomicAdd(ctr, 1u);
        __syncthreads();
        const int u = (int)*slot;
        if (u >= NU) break;
        const int bh = u & 15, qb = NQB - 1 - (u >> 4); attn_unit(c, bh, qb, Q, K, V, (bf16*)(c.ws + OFF_OF), FC, qkb2);
    }
}

__device__ __forceinline__ void phase_fixup(const Params& P, int l, const Ctx& c) {
    bf16* ACT = (bf16*)(c.ws + OFF_RW); const bf16* HALO = (const bf16*)(c.ws + OFF_Q);
    const float* cw = P.in[24] + (size_t)l * 3 * NUP;
    const int total = (M / 64) * 2 * DFF;
    for (int idx = c.bid * NTHR + c.tid; idx < total; idx += c.G * NTHR) {
        const int rr = idx / DFF, ch = idx - rr * DFF, q64 = rr >> 1, e = rr & 1, row = q64 * 64 + e;
        const int t = row % LP;
        int s0, s1, s2;
        if (e == 0) { s0 = q64 * 4 + 2; s1 = (q64 - 1) * 4 + 1; s2 = (q64 - 1) * 4 + 0; } else { s0 = q64 * 4 + 3; s1 = q64 * 4 + 2; s2 = (q64 - 1) * 4 + 1; }
        float uc[2];
#pragma unroll
        for (int bj = 0; bj < 2; ++bj) { const int col = bj * DFF + ch;
            const float u0 = bf2f(HALO[(size_t)s0 * NUP + col]);
            const float u1 = (t >= 1) ? bf2f(HALO[(size_t)s1 * NUP + col]) : 0.f;
            const float u2 = (t >= 2) ? bf2f(HALO[(size_t)s2 * NUP + col]) : 0.f;
            uc[bj] = cw[col] * u2 + cw[NUP + col] * u1 + cw[2 * NUP + col] * u0; }
        ACT[(size_t)row * DFF + ch] = (bf16)f2bf(uc[0] * sigmoidf_(uc[0]) * uc[1]);
    }
}

#define OPQ_S(x) asm volatile("" : "+s"(x))
#define OPQ_V(x) asm volatile("" : "+v"(x))
#define PHASE_BEGIN() do { int t_ = threadIdx.x; OPQ_V(t_); c.tid = t_; c.lane = t_ & 63; c.wave = __builtin_amdgcn_readfirstlane(t_ >> 6); int b_ = blockIdx.x; OPQ_S(b_); c.bid = b_; \
    unsigned char* w0_ = P.ws; OPQ_S(w0_); unsigned char* w_ = (unsigned char*)(__attribute__((address_space(1))) unsigned char*)w0_;   c.ws = w_; ws = w_; l = lc; OPQ_S(l); WT = (pg8::bf16_t*)(ws + OFF_WT); HN = (pg8::bf16_t*)(ws + OFF_HN); } while (0)
__global__ void __launch_bounds__(NTHR, 2) mega(Params P) {
    extern __shared__ __attribute__((aligned(16))) unsigned char lds[];
    Ctx c; c.G = gridDim.x; c.lds = lds;
    volatile LAS unsigned* MISC = (volatile LAS unsigned*)((LAS unsigned char*)lds + MISC_OFF);
    if (threadIdx.x < 16) MISC[threadIdx.x] = 0u;
    __syncthreads();
    (void)xcd_barrier_post((unsigned*)(P.ws + OFF_CTL) + 1024, MISC + 8);
#define SEAM() do { XcdBarrier xb_; xb_.bar = (unsigned*)(P.ws + OFF_CTL) + 1024; xb_.x = xb_xcc_id(); xb_.st = (volatile LAS unsigned*)((LAS unsigned char*)lds + MISC_OFF) + 8; xcd_barrier(xb_); } while (0)
    PG8_LAS unsigned char* ldsl = (PG8_LAS unsigned char*)lds;
    unsigned char* ws; pg8::bf16_t* WT; pg8::bf16_t* HN; int l;
#pragma unroll 1
    for (int lc = 0; lc < DEPTH; ++lc) {
        PHASE_BEGIN();
        convert_weights(P, l, c);
        phase_norm<true>(P, l, c);
        cg::this_grid().sync();
        PHASE_BEGIN();
        phase_fcum(P, c);
        { pg8::Gemm g{HN, WT + WT_IN, M, N1, 1024, 1024}; pg8::StaticOrder S; S.init(M, N1, c.G, c.bid);
          pg8::EpiRoute E{ws};
          pg8::gemm_phase<pg8::EpiRoute, pg8::StaticOrder, true, true>(ldsl, g, S, E); }
        SEAM();
        PHASE_BEGIN();
        phase_qknorm(P, l, c);
        for (int rep_ = 0; rep_ < REP_PREP; ++rep_) phase_rwkv_prep(P, l, c);
        SEAM();
        PHASE_BEGIN();
        if (c.bid < 16) { scan_chunked(P, c, c.bid); __syncthreads(); PHASE_BEGIN(); }
        phase_attn(P, l, c, 16);
#if REP_P3 > 1
        __syncthreads(); PHASE_BEGIN();
        if (c.bid < 16) scan_chunked(P, c, c.bid); else phase_attn(P, l, c, 16);
#endif
        SEAM();
        PHASE_BEGIN();
        phase_gn(P, l, c);
        for (int rep_ = 0; rep_ < REP_SYNC; ++rep_) SEAM();
        SEAM();
        PHASE_BEGIN();
        { pg8::bf16_t* MG = (pg8::bf16_t*)(ws + OFF_K); const pg8::bf16_t* GT = (const pg8::bf16_t*)(ws + OFF_GT); const float* gb = P.in[21] + l * NGT;
          pg8::StaticOrder S; S.init(M, 1024, c.G, c.bid);
          { pg8::Gemm g{(const pg8::bf16_t*)(ws + OFF_OF), WT + WT_BF, M, 1024, 512, 512}; pg8::EpiGate<0> E{MG, GT, gb};
            pg8::gemm_phase<pg8::EpiGate<0>, pg8::StaticOrder, true, true>(ldsl, g, S, E); }
          __syncthreads();
          PHASE_BEGIN();
          MG = (pg8::bf16_t*)(ws + OFF_K); GT = (const pg8::bf16_t*)(ws + OFF_GT); gb = P.in[21] + l * NGT; S.init(M, 1024, c.G, c.bid);
          { pg8::Gemm g{(const pg8::bf16_t*)(ws + OFF_RW + (size_t)M * 512 * 4), WT + WT_BR, M, 1024, 512, 512}; pg8::EpiGate<1> E{MG, GT, gb};
            pg8::gemm_phase<pg8::EpiGate<1>, pg8::StaticOrder, true, true>(ldsl, g, S, E); } }
        SEAM();
        PHASE_BEGIN();
#pragma unroll 1
        for (int pass = 0; pass < 2; ++pass) {
            if (pass) { __syncthreads(); PHASE_BEGIN(); }
            const int sl = pass ? (c.bid >> 2) : 0;
            pg8::Gemm g{(const pg8::bf16_t*)(ws + OFF_K) + sl * 256, WT + WT_O + sl * 256, M, 1024, pass ? 256 : 1024, 1024};
            pg8::OneUnit S; S.so.init(MMAIN, 1024, c.G, c.bid); S.mode = pass; S.pm = MMAIN / 256; S.pn = c.bid & 3; S.active = sl < 4;
            pg8::EpiResid E{(float*)(ws + OFF_H), nullptr, pass};
            pg8::gemm_phase<pg8::EpiResid, pg8::OneUnit, true, true>(ldsl, g, S, E);
        }
        SEAM();
        PHASE_BEGIN();
        phase_norm<false>(P, l, c);
        SEAM();
        PHASE_BEGIN();
        { pg8::Gemm g{HN, WT + WT_UP, M, NUP, 1024, 1024}; pg8::StaticOrder S; S.init(M, NUP, c.G, c.bid);
          pg8::EpiUp E{(pg8::bf16_t*)(ws + OFF_RW), (pg8::bf16_t*)(ws + OFF_Q), P.in[24] + (size_t)l * 3 * NUP};
          pg8::gemm_phase<pg8::EpiUp, pg8::StaticOrder, true, true>(ldsl, g, S, E); }
        SEAM();
        PHASE_BEGIN();
        phase_fixup(P, l, c);
        SEAM();
        PHASE_BEGIN();
#pragma unroll 1
        for (int pass = 0; pass < 2; ++pass) {
            if (pass) { __syncthreads(); PHASE_BEGIN(); }
            const int sl = pass ? (c.bid >> 2) : 0;
            const int ko = (sl < 2) ? sl * 768 : 1536 + (sl - 2) * 640, kl = (sl < 2) ? 768 : 640;
            pg8::Gemm g{(const pg8::bf16_t*)(ws + OFF_RW) + (pass ? ko : 0), WT + WT_DN + (pass ? ko : 0), M, 1024, pass ? kl : DFF, DFF};
            pg8::OneUnit S; S.so.init(MMAIN, 1024, c.G, c.bid); S.mode = pass; S.pm = MMAIN / 256; S.pn = c.bid & 3; S.active = sl < 4;
            pg8::EpiResid E{(float*)(ws + OFF_H), (l == DEPTH - 1 && !pass) ? P.out : nullptr, pass};
            pg8::gemm_phase<pg8::EpiResid, pg8::OneUnit, true, true>(ldsl, g, S, E);
        }
        SEAM();
        if (l == DEPTH - 1) {
            PHASE_BEGIN();
            const float* H = (const float*)(ws + OFF_H);
            for (int idx = c.bid * NTHR + c.tid; idx < (NMETA + SEQ - (MMAIN - LP)) * (DM / 4); idx += c.G * NTHR) {
                const int r = idx / (DM / 4), q4 = idx - r * (DM / 4), t = (MMAIN - LP) + r;
                *(f32x4*)(P.out + ((size_t)SEQ + (t - NMETA)) * DM + 4 * q4) = *(const f32x4*)(H + (size_t)(LP + t) * DM + 4 * q4);
            }
        }
    }
}

extern "C" void kernel_launch(void* const* d_in, const int* in_sizes, int n_in, void* d_out, int out_size, void* d_ws, size_t ws_size, hipStream_t stream) {
    static int grid = 0;
    if (grid == 0) {
        if (n_in != 26 || out_size != NB * SEQ * DM || ws_size < WS_NEED) { fprintf(stderr, "kernel_launch: unexpected shapes (n_in %d out %d ws %zu need %zu)\n", n_in, out_size, ws_size, (size_t)WS_NEED); grid = -1; return; }
        int dev = 0, cus = 0, per_cu = 0;
        if (hipGetDevice(&dev) != hipSuccess || hipDeviceGetAttribute(&cus, hipDeviceAttributeMultiprocessorCount, dev) != hipSuccess) { grid = -1; return; }
        if (hipFuncSetAttribute((const void*)mega, hipFuncAttributeMaxDynamicSharedMemorySize, LDS_BYTES) != hipSuccess) { fprintf(stderr, "kernel_launch: hipFuncSetAttribute failed\n"); grid = -1; return; }
        if (hipOccupancyMaxActiveBlocksPerMultiprocessor(&per_cu, (const void*)mega, NTHR, LDS_BYTES) != hipSuccess || per_cu < 1) { fprintf(stderr, "kernel_launch: occupancy query says %d\n", per_cu); per_cu = 1; }
        (void)hipGetLastError();
        grid = cus;
    }
    if (grid < 0) return;
    if (hipMemsetAsync((char*)d_ws + OFF_CTL, 0, 65536, stream) != hipSuccess) { fprintf(stderr, "kernel_launch: memset failed\n"); return; }
    Params p{};
    for (int i = 0; i < 26; ++i) p.in[i] = (const float*)d_in[i];
    p.out = (float*)d_out; p.ws = (unsigned char*)d_ws;
    void* args[] = {&p};
    hipError_t e = hipLaunchCooperativeKernel((const void*)mega, dim3(grid), dim3(NTHR), args, LDS_BYTES, stream);
    if (e != hipSuccess) fprintf(stderr, "kernel_launch: cooperative launch failed: %s (grid %d)\n", hipGetErrorString(e), grid);
}
```

```cpp
#include <hip/hip_runtime.h>
#include <hip/hip_cooperative_groups.h>
#include <cstdio>
#include <cstdint>
#include <cmath>
namespace cg = cooperative_groups;
namespace pg8 {
#define PG8_LAS __attribute__((address_space(3)))
typedef unsigned short bf16_t;
typedef short bf16x8 __attribute__((ext_vector_type(8)));
typedef float f32x4 __attribute__((ext_vector_type(4)));
typedef unsigned u32x4 __attribute__((ext_vector_type(4)));
constexpr int BM = 256, BK = 64, HALF = 128, HTB = HALF * BK * 2  , STAGE_BYTES = 8 * HTB, NXCD = 8, WGM = 8;

__host__ __device__ __forceinline__ int lds_byte(int r, int c) { const int st = (r >> 4) * 2 + (c >> 5), rr = r & 15, cc = c & 31, ob = rr * 64 + cc * 2; return st * 1024 + (ob ^ (((ob >> 9) & 1) << 5)); }
__host__ __device__ __forceinline__ void stage_rc(int b, int& R, int& C) { const int st = b / 1024, sb = b % 1024, swz = sb ^ (((sb >> 9) & 1) << 5); R = (st >> 1) * 16 + swz / 64; C = (st & 1) * 32 + (swz % 64) / 2; }
__host__ __device__ __forceinline__ int perm32(int rho) { const int n = rho >> 4, i = rho & 15; return 8 * (i >> 2) + 4 * n + (i & 3); }

struct Unit { int pm, pn; };
struct Gemm { const bf16_t* A; const bf16_t* Bt; int M, N, K, ld; };

struct StaticOrder {
    int nM, nN, nwg, G, c;
    __host__ __device__ void init(int M, int N, int G_, int c_) { nM = M / BM; nN = N / BM; nwg = nM * nN; G = G_; c = c_; }
    __host__ __device__ bool next(int i, Unit& u) const {
        const long L = (long)i * G + c; if (L >= nwg) return false;
        int wgid = (int)L; { const int q = nwg / NXCD, r = nwg % NXCD, xcd = wgid % NXCD, off = wgid / NXCD; wgid = (xcd < r ? xcd * (q + 1) : r * (q + 1) + (xcd - r) * q) + off; }
        const int nig = WGM * nN, gid = wgid / nig, fm = gid * WGM, gsz = (nM - fm) < WGM ? (nM - fm) : WGM;
        u.pm = fm + ((wgid % nig) % gsz); u.pn = (wgid % nig) / gsz; return true;
    }
    __device__ __forceinline__ void a_ready(const Unit&) const {}
    __device__ __forceinline__ void done(const Unit&) const {}
};

__device__ __forceinline__ unsigned cvt_pk_bf16(float lo, float hi) { unsigned r; asm volatile("v_cvt_pk_bf16_f32 %0, %1, %2" : "=v"(r) : "v"(lo), "v"(hi)); return r; }
typedef float f32x2 __attribute__((ext_vector_type(2)));
template <class Epi, class Sched, bool ALIGN_EPI = false, bool SP2 = false>
__device__ __forceinline__ void gemm_phase(PG8_LAS unsigned char* lds, const Gemm g, const Sched& S, const Epi& E) {
    int tid_ = threadIdx.x; asm volatile("" : "+v"(tid_)); const int tid = tid_, wid = __builtin_amdgcn_readfirstlane(tid >> 6), lane = tid & 63, wr = wid >> 2, wc = wid & 3, fr = lane & 15, fq = lane >> 4;
    const int K = g.K, nt = K / BK, LD = g.ld;
    unsigned voffA[2], voffB[2];
#pragma unroll
    for (int i = 0; i < 2; ++i) { int R, C; stage_rc(tid * 16 + i * 8192, R, C); const int Rb = Epi::PERM ? ((R & ~31) + perm32(R & 31)) : R;
        voffA[i] = (unsigned)(R * LD + C) * 2u; voffB[i] = (unsigned)(Rb * LD + C) * 2u; }
    const size_t kstep = (size_t)(BK * 2);
    const size_t hstep = (size_t)HALF * LD * 2;
    const size_t tstep = 2 * hstep;
    const unsigned ldsw = (unsigned)wid * 1024u;
    const int aoff = lds_byte(wr * 64 + fr, fq * 8), boff = lds_byte(wc * 32 + fr, fq * 8);
#define PG8_SA(b, h) (((b) * 2 + (h)) * HTB)
#define PG8_SB(b, h) ((4 + (b) * 2 + (h)) * HTB)
#define PG8_STAGE(bufoff, gbase, voff) do { _Pragma("unroll") for (int _i = 0; _i < 2; ++_i) \
        __builtin_amdgcn_global_load_lds((const unsigned*)((const char*)(gbase) + (voff)[_i]), (PG8_LAS unsigned*)(lds + (bufoff) + ldsw + _i * 8192), 16, 0, 0); } while (0)
#define PG8_LDA(dst, b, h) do { _Pragma("unroll") for (int m = 0; m < 4; ++m) _Pragma("unroll") for (int k = 0; k < 2; ++k) dst[m][k] = *(const PG8_LAS bf16x8*)(lds + PG8_SA(b, h) + aoff + m * 2048 + k * 1024); } while (0)
#define PG8_LDB(dst, b, h) do { _Pragma("unroll") for (int n = 0; n < 2; ++n) _Pragma("unroll") for (int k = 0; k < 2; ++k) dst[n][k] = *(const PG8_LAS bf16x8*)(lds + PG8_SB(b, h) + boff + n * 2048 + k * 1024); } while (0)
#define PG8_MMA(ai, bj, At, Bt) do { __builtin_amdgcn_s_setprio(1); _Pragma("unroll") for (int m = 0; m < 4; ++m) _Pragma("unroll") for (int n = 0; n < 2; ++n) _Pragma("unroll") for (int k = 0; k < 2; ++k) \
        acc[ai][bj][m][n] = __builtin_amdgcn_mfma_f32_16x16x32_bf16(Bt[n][k], At[m][k], acc[ai][bj][m][n], 0, 0, 0); __builtin_amdgcn_s_setprio(0); } while (0)
#define PG8_WAIT_V(n) asm volatile("s_waitcnt vmcnt(" #n ")" ::: "memory")
#define PG8_WAIT_L(n) asm volatile("s_waitcnt lgkmcnt(" #n ")" ::: "memory")
#define PG8_BAR __builtin_amdgcn_s_barrier()
#define PG8_SCHED __builtin_amdgcn_sched_barrier(0)
    Unit cur, nxt; int ui = 0;
    if (!S.next(0, cur)) return;
    f32x4 acc[2][2][4][2];
#pragma unroll
    for (int a = 0; a < 2; ++a)
#pragma unroll
        for (int b = 0; b < 2; ++b)
#pragma unroll
            for (int m = 0; m < 4; ++m)
#pragma unroll
                for (int n = 0; n < 2; ++n) acc[a][b][m][n] = (f32x4){0.f, 0.f, 0.f, 0.f};
    bf16x8 At[4][2], B0[2][2], B1[2][2];
    const char* cA = (const char*)g.A + (size_t)cur.pm * tstep; const char* cB = (const char*)g.Bt + (size_t)cur.pn * tstep;
    S.a_ready(cur);
    if constexpr (SP2) {
        PG8_STAGE(PG8_SB(0, 0), cB, voffB); PG8_STAGE(PG8_SB(0, 1), cB + hstep, voffB); PG8_STAGE(PG8_SA(0, 0), cA, voffA); PG8_STAGE(PG8_SA(0, 1), cA + hstep, voffA);
        if (wr == 1) PG8_BAR;
        PG8_WAIT_V(2); PG8_BAR;
        PG8_STAGE(PG8_SB(1, 0), cB + kstep, voffB); PG8_STAGE(PG8_SA(1, 0), cA + kstep, voffA); PG8_STAGE(PG8_SB(1, 1), cB + hstep + kstep, voffB);
        PG8_WAIT_V(6); PG8_BAR;
    } else {
        PG8_STAGE(PG8_SB(0, 0), cB, voffB); PG8_STAGE(PG8_SA(0, 0), cA, voffA); PG8_STAGE(PG8_SB(0, 1), cB + hstep, voffB); PG8_STAGE(PG8_SA(0, 1), cA + hstep, voffA);
        if (wr == 1) PG8_BAR;
        PG8_WAIT_V(4); PG8_BAR;
        PG8_STAGE(PG8_SB(1, 0), cB + kstep, voffB); PG8_STAGE(PG8_SA(1, 0), cA + kstep, voffA); PG8_STAGE(PG8_SB(1, 1), cB + hstep + kstep, voffB);
        PG8_WAIT_V(6); PG8_BAR;
    }
    for (;;) {
        const bool has_next = S.next(ui + 1, nxt);
        const char* nA = has_next ? (const char*)g.A + (size_t)nxt.pm * tstep : cA; const char* nB = has_next ? (const char*)g.Bt + (size_t)nxt.pn * tstep : cB;
        for (int t = 0; t < nt; t += 2) {
            const bool last = (t == nt - 2);
            const char* a1 = cA + (size_t)(t + 1) * kstep;
            const char* a2 = last ? nA : cA + (size_t)(t + 2) * kstep; const char* b2 = last ? nB : cB + (size_t)(t + 2) * kstep;
            const char* a3 = a2 + kstep; const char* b3 = b2 + kstep;
            if (last && has_next) S.a_ready(nxt);
            if constexpr (SP2) {
            PG8_LDB(B0, 0, 0); PG8_LDB(B1, 0, 1); PG8_SCHED; PG8_LDA(At, 0, 0); PG8_STAGE(PG8_SA(1, 1), a1 + hstep, voffA);
            PG8_WAIT_V(8); PG8_WAIT_L(0); PG8_BAR; PG8_MMA(0, 0, At, B0); PG8_MMA(0, 1, At, B1); PG8_BAR; PG8_SCHED;
            PG8_LDA(At, 0, 1); PG8_STAGE(PG8_SB(0, 0), b2, voffB); PG8_STAGE(PG8_SB(0, 1), b2 + hstep, voffB); PG8_STAGE(PG8_SA(0, 0), a2, voffA);
            PG8_WAIT_V(8); PG8_WAIT_L(0); PG8_BAR; PG8_MMA(1, 0, At, B0); PG8_MMA(1, 1, At, B1); PG8_BAR; PG8_SCHED;
            PG8_LDB(B0, 1, 0); PG8_LDB(B1, 1, 1); PG8_SCHED; PG8_LDA(At, 1, 0); PG8_STAGE(PG8_SA(0, 1), a2 + hstep, voffA);
            PG8_WAIT_V(8); PG8_WAIT_L(0); PG8_BAR; PG8_MMA(0, 0, At, B0); PG8_MMA(0, 1, At, B1); PG8_BAR; PG8_SCHED;
            PG8_LDA(At, 1, 1); PG8_STAGE(PG8_SB(1, 0), b3, voffB); PG8_STAGE(PG8_SB(1, 1), b3 + hstep, voffB); PG8_STAGE(PG8_SA(1, 0), a3, voffA);
            PG8_WAIT_V(8); PG8_WAIT_L(0); PG8_BAR; PG8_MMA(1, 0, At, B0); PG8_MMA(1, 1, At, B1); PG8_BAR; PG8_SCHED;
            } else {
            PG8_LDB(B0, 0, 0); PG8_SCHED; PG8_LDA(At, 0, 0); PG8_STAGE(PG8_SA(1, 1), a1 + hstep, voffA);
            PG8_WAIT_L(8); PG8_BAR; PG8_WAIT_L(0); PG8_MMA(0, 0, At, B0); PG8_BAR; PG8_SCHED;
            PG8_LDB(B1, 0, 1); PG8_STAGE(PG8_SB(0, 0), b2, voffB);
            PG8_BAR; PG8_WAIT_L(0); PG8_MMA(0, 1, At, B1); PG8_BAR;
            PG8_LDA(At, 0, 1); PG8_STAGE(PG8_SA(0, 0), a2, voffA);
            PG8_BAR; PG8_WAIT_L(0); PG8_MMA(1, 0, At, B0); PG8_BAR; PG8_SCHED;
            PG8_STAGE(PG8_SB(0, 1), b2 + hstep, voffB);
            PG8_WAIT_V(6); PG8_BAR; PG8_MMA(1, 1, At, B1); PG8_BAR;
            PG8_LDB(B0, 1, 0); PG8_SCHED; PG8_LDA(At, 1, 0); PG8_STAGE(PG8_SA(0, 1), a2 + hstep, voffA);
            PG8_WAIT_L(8); PG8_BAR; PG8_WAIT_L(0); PG8_MMA(0, 0, At, B0); PG8_BAR; PG8_SCHED;
            PG8_LDB(B1, 1, 1); PG8_STAGE(PG8_SB(1, 0), b3, voffB);
            PG8_BAR; PG8_WAIT_L(0); PG8_MMA(0, 1, At, B1); PG8_BAR;
            PG8_LDA(At, 1, 1); PG8_STAGE(PG8_SA(1, 0), a3, voffA);
            PG8_BAR; PG8_WAIT_L(0); PG8_MMA(1, 0, At, B0); PG8_BAR; PG8_SCHED;
            PG8_STAGE(PG8_SB(1, 1), b3 + hstep, voffB);
            PG8_WAIT_V(6); PG8_BAR; PG8_MMA(1, 1, At, B1); PG8_BAR;
            }
        }
        if constexpr (ALIGN_EPI) { if (wr == 0) PG8_BAR; }
        if constexpr (!Epi::AFTER_DRAIN) { E(acc, cur, wr, wc, fr, fq); S.done(cur); }
        if (!has_next) break;
#pragma unroll
        for (int a = 0; a < 2; ++a)
#pragma unroll
            for (int b = 0; b < 2; ++b)
#pragma unroll
                for (int m = 0; m < 4; ++m)
#pragma unroll
                    for (int n = 0; n < 2; ++n) acc[a][b][m][n] = (f32x4){0.f, 0.f, 0.f, 0.f};
        cur = nxt; cA = nA; cB = nB; ++ui;
        if constexpr (ALIGN_EPI) { if (wr == 1) PG8_BAR; }
    }
    PG8_WAIT_V(0);
    if constexpr (!ALIGN_EPI) { if (wr == 0) PG8_BAR; }
    PG8_BAR;
    if constexpr (Epi::AFTER_DRAIN) { E.fused(acc, cur, wr, wc, fr, fq, lds, wid, lane); S.done(cur); }
#undef PG8_SA
#undef PG8_SB
#undef PG8_STAGE
#undef PG8_LDA
#undef PG8_LDB
#undef PG8_MMA
#undef PG8_WAIT_V
#undef PG8_WAIT_L
#undef PG8_BAR
#undef PG8_SCHED
}
}
#define GAS __attribute__((address_space(1)))
#define LAS __attribute__((address_space(3)))
typedef GAS unsigned gu32;
typedef GAS unsigned long long gu64;
#define RLX_AGENT __ATOMIC_RELAXED, __HIP_MEMORY_SCOPE_AGENT
#define LDS_WAIT() asm volatile("s_waitcnt lgkmcnt(0)" ::: "memory")
#define VM_WAIT() asm volatile("s_waitcnt vmcnt(0)" ::: "memory")
__device__ __forceinline__ unsigned long long rt() { return __builtin_amdgcn_s_memrealtime(); }
#define XB_TMO      128
#define XB_XCNT(j)  (256  + 64 * (j))
#define XB_XSUB(j)  (1280 + 64 * (j))
#define XB_XGEN(j)  (2304 + 64 * (j))
#define XB_TOP      3328
#define XB_TOPGEN   3392
#define XCD_BAR_WORDS 3456
#define XB_SPIN_CAP (1u << 18)

__device__ __forceinline__ unsigned xb_ld(unsigned* p)              { return __hip_atomic_load(p, __ATOMIC_RELAXED, __HIP_MEMORY_SCOPE_AGENT); }
__device__ __forceinline__ unsigned xb_add(unsigned* p, unsigned v) { return __hip_atomic_fetch_add(p, v, __ATOMIC_RELAXED, __HIP_MEMORY_SCOPE_AGENT); }
__device__ __forceinline__ unsigned xb_xcc_id() { return (unsigned)__builtin_amdgcn_s_getreg((3 << 11) | 20) & 0xFu; }
#define XB_SPIN(cond, bar) do { unsigned _sp = 0; while (cond) { __builtin_amdgcn_s_sleep(1); \
    if ((++_sp & 255u) == 0u) { if (xb_ld(&(bar)[XB_TMO])) break; if (_sp > XB_SPIN_CAP) { atomicAdd(&(bar)[XB_TMO], 1u); break; } } } } while (0)

struct XcdBarrier {
    unsigned* bar; unsigned x;
    volatile LAS unsigned* st;
};

__device__ __forceinline__ XcdBarrier xcd_barrier_post(unsigned* bar, volatile LAS unsigned* st) {
    XcdBarrier b; b.bar = bar; b.x = xb_xcc_id(); b.st = st;
    if (threadIdx.x == 0) (void)xb_add(&bar[XB_XCNT(b.x)], 1u);
    return b;
}
__device__ __forceinline__ void xcd_barrier_complete(unsigned* bar, unsigned x, unsigned& nloc, unsigned& nx) {
    const unsigned G = gridDim.x * gridDim.y * gridDim.z;
    unsigned sum, cnt, mine, sp = 0u;
    for (;;) {
        sum = 0u; cnt = 0u; mine = 0u;
#pragma unroll
        for (unsigned j = 0; j < 16; ++j) { const unsigned c = xb_ld(&bar[XB_XCNT(j)]); sum += c; cnt += (c > 0u) ? 1u : 0u; mine = (j == x) ? c : mine; }
        if (sum == G) break;
        __builtin_amdgcn_s_sleep(1);
        if ((++sp & 255u) == 0u) { if (xb_ld(&bar[XB_TMO])) break; if (sp > XB_SPIN_CAP) { atomicAdd(&bar[XB_TMO], 1u); break; } }
    }
    nloc = mine > 0u ? mine : 1u; nx = cnt > 0u ? cnt : 1u;
}

__device__ __forceinline__ void xcd_barrier(const XcdBarrier& b) {
    asm volatile("s_waitcnt vmcnt(0)" ::: "memory");
    __syncthreads();
    if (threadIdx.x == 0) {
        unsigned* bar = b.bar;
        __builtin_amdgcn_s_waitcnt(0);
        unsigned nloc = b.st[0], nx = b.st[1];
        if (nloc == 0u) { xcd_barrier_complete(bar, b.x, nloc, nx); b.st[0] = nloc; b.st[1] = nx; }
        const unsigned old = xb_add(&bar[XB_XSUB(b.x)], 1u);
        const unsigned gen = old / nloc;
        if (old + 1u == (gen + 1u) * nloc) {
            __builtin_amdgcn_fence(__ATOMIC_RELEASE, "agent");
            asm volatile("s_waitcnt vmcnt(0)" ::: "memory");
            const unsigned og = xb_add(&bar[XB_TOP], 1u);
            const unsigned tg = og / nx;
            if (og + 1u == (tg + 1u) * nx) xb_add(&bar[XB_TOPGEN], 1u);
            else XB_SPIN(xb_ld(&bar[XB_TOPGEN]) == tg, bar);
            __builtin_amdgcn_fence(__ATOMIC_ACQUIRE, "agent");
            xb_add(&bar[XB_XGEN(b.x)], 1u);
            asm volatile("s_waitcnt vmcnt(0)" ::: "memory");
        } else {
            XB_SPIN(xb_ld(&bar[XB_XGEN(b.x)]) == gen, bar);
            __builtin_amdgcn_fence(__ATOMIC_ACQUIRE, "agent");
            asm volatile("s_waitcnt vmcnt(0)" ::: "memory");
        }
    }
    __syncthreads();
}


constexpr int NB = 2, SEQ = 8192, DM = 1024, DEPTH = 4, NMETA = 16, LP = 8320, M = NB * LP;
constexpr int N_IN = 5384, N1 = 5376, NRW = 1792, NGT = 2048, DFF = 2816, NUP = 5632;
constexpr float LOG2E = 1.4426950408889634f;
constexpr float QSCALE = 0.125f * LOG2E;
constexpr float THR2 = 30.0f * LOG2E;
constexpr int NWAVES = 8, NTHR = 512, MMAIN = 16384;
constexpr int LDS_BYTES = 147456, MISC_OFF = 147456 - 128;

typedef unsigned short bf16;
typedef float f32x4 __attribute__((ext_vector_type(4)));
typedef unsigned u32x4 __attribute__((ext_vector_type(4)));
typedef unsigned u32x2 __attribute__((ext_vector_type(2)));
typedef short bf16x8 __attribute__((ext_vector_type(8)));

constexpr size_t SZ_H = (size_t)M * DM * 4, SZ_X512 = (size_t)M * 512 * 2;
constexpr size_t OFF_CTL = 0, OFF_H = 1u << 20, OFF_WT = OFF_H + SZ_H;
constexpr size_t WT_IN = 0, WT_BF = WT_IN + (size_t)N1 * 1024, WT_BR = WT_BF + 1024 * 512, WT_O = WT_BR + 1024 * 512,
                 WT_UP = WT_O + 1024 * 1024, WT_DN = WT_UP + (size_t)NUP * 1024, WT_LW = WT_DN + (size_t)1024 * DFF, WT_LA = WT_LW + 512 * 64, WT_LG = WT_LA + 512 * 64, WT_END = WT_LG + 512 * 128;
constexpr size_t OFF_HN = OFF_WT + WT_END * 2;
constexpr size_t OFF_Q = OFF_HN + 2 * SZ_X512, OFF_K = OFF_Q + SZ_X512, OFF_V = OFF_K + SZ_X512;
constexpr size_t OFF_RW = OFF_V + SZ_X512, OFF_GT = OFF_RW + (size_t)M * NRW * 2, OFF_MISC = OFF_GT + (size_t)M * NGT * 2;
constexpr size_t OFF_T0 = OFF_MISC + 2 * 16 * LP * 4, OFF_OF = OFF_T0 + 2 * SZ_X512, WS_NEED = OFF_OF + SZ_X512;
static_assert(OFF_HN % 256 == 0 && OFF_RW % 256 == 0 && OFF_T0 % 256 == 0, "alignment");

struct Params { const float* in[26]; float* out; unsigned char* ws; };
struct Ctx { int tid, lane, wave, bid, G; unsigned char* lds; unsigned char* ws; };

__device__ __forceinline__ float bf2f(unsigned b) { return __uint_as_float(b << 16); }
__device__ __forceinline__ float bflo(unsigned w) { return __uint_as_float(w << 16); }
__device__ __forceinline__ float bfhi(unsigned w) { return __uint_as_float(w & 0xffff0000u); }
__device__ __forceinline__ unsigned f2bf(float f) { unsigned u = __float_as_uint(f); return (u + 0x7fffu + ((u >> 16) & 1u)) >> 16; }
__device__ __forceinline__ unsigned pk2(float lo, float hi) { return f2bf(lo) | (f2bf(hi) << 16); }
__device__ __forceinline__ float wave_sum(float v) {
#pragma unroll
    for (int o = 1; o < 64; o <<= 1) v += __shfl_xor(v, o);
    return v;
}
__device__ __forceinline__ float sigmoidf_(float x) { return 1.f / (1.f + __expf(-x)); }
template <int CTRL> __device__ __forceinline__ float dppf(float old, float x) {
    return __int_as_float(__builtin_amdgcn_update_dpp(__float_as_int(old), __float_as_int(x), CTRL, 0xf, 0xf, false));
}
__device__ __forceinline__ float allreduce16(float x) {
    x += dppf<0x121>(0.f, x); x += dppf<0x122>(0.f, x); x += dppf<0x124>(0.f, x); x += dppf<0x128>(0.f, x); return x;
}

namespace pg8 {
struct EpiRoute {
    static constexpr bool PERM = true, AFTER_DRAIN = false;
    unsigned char* ws;
    __device__ __forceinline__ void operator()(const f32x4 (&acc)[2][2][4][2], const Unit& u, int wr, int wc, int fr, int fq) const {
        const int pn = u.pn; size_t off; int ldc, colt;
        if (pn < 6) { off = OFF_Q + (size_t)(pn >> 1) * SZ_X512; ldc = 512; colt = (pn & 1) * 256; }
        else if (pn < 13) { off = OFF_RW; ldc = NRW; colt = (pn - 6) * 256; }
        else { off = OFF_GT; ldc = NGT; colt = (pn - 13) * 256; }
        bf16_t* base = (bf16_t*)(ws + off);
        const int row0 = u.pm * BM + wr * 64 + fr, col0 = colt + wc * 32 + 8 * fq;
#pragma unroll
        for (int ai = 0; ai < 2; ++ai)
#pragma unroll
            for (int m = 0; m < 4; ++m) { bf16_t* rowp = base + (size_t)(row0 + ai * HALF + m * 16) * ldc + col0;
#pragma unroll
                for (int bj = 0; bj < 2; ++bj) { const f32x4 v0 = acc[ai][bj][m][0], v1 = acc[ai][bj][m][1];
                    u32x4 w; w.x = cvt_pk_bf16(v0[0], v0[1]); w.y = cvt_pk_bf16(v0[2], v0[3]); w.z = cvt_pk_bf16(v1[0], v1[1]); w.w = cvt_pk_bf16(v1[2], v1[3]);
                    *(u32x4*)(rowp + bj * HALF) = w; } }
    }
};
template <int MODE> struct EpiGate {
    static constexpr bool PERM = true, AFTER_DRAIN = false;
    bf16_t* O; const bf16_t* GT; const float* gb;
    __device__ __forceinline__ void operator()(const f32x4 (&acc)[2][2][4][2], const Unit& u, int wr, int wc, int fr, int fq) const {
        const int row0 = u.pm * BM + wr * 64 + fr, col0 = u.pn * BM + wc * 32 + 8 * fq;
#pragma unroll
        for (int bj = 0; bj < 2; ++bj) {
            const int c = col0 + bj * HALF;
            const f32x4 b0 = *(const f32x4*)(gb + MODE * 1024 + c), b1 = *(const f32x4*)(gb + MODE * 1024 + c + 4);
#pragma unroll
            for (int ai = 0; ai < 2; ++ai)
#pragma unroll
                for (int m = 0; m < 4; ++m) {
                    const size_t row = (size_t)(row0 + ai * HALF + m * 16);
                    const u32x4 gw = *(const u32x4*)(GT + row * NGT + MODE * 1024 + c);
                    const f32x4 v0 = acc[ai][bj][m][0], v1 = acc[ai][bj][m][1];
                    float r[8];
                    r[0] = sigmoidf_(bflo(gw.x) + b0[0]) * v0[0]; r[1] = sigmoidf_(bfhi(gw.x) + b0[1]) * v0[1];
                    r[2] = sigmoidf_(bflo(gw.y) + b0[2]) * v0[2]; r[3] = sigmoidf_(bfhi(gw.y) + b0[3]) * v0[3];
                    r[4] = sigmoidf_(bflo(gw.z) + b1[0]) * v1[0]; r[5] = sigmoidf_(bfhi(gw.z) + b1[1]) * v1[1];
                    r[6] = sigmoidf_(bflo(gw.w) + b1[2]) * v1[2]; r[7] = sigmoidf_(bfhi(gw.w) + b1[3]) * v1[3];
                    bf16_t* op = O + row * 1024 + c;
                    if (MODE == 1) { const u32x4 ow = *(const u32x4*)op;
                        r[0] += bflo(ow.x); r[1] += bfhi(ow.x); r[2] += bflo(ow.y); r[3] += bfhi(ow.y); r[4] += bflo(ow.z); r[5] += bfhi(ow.z); r[6] += bflo(ow.w); r[7] += bfhi(ow.w); }
                    u32x4 w; w.x = cvt_pk_bf16(r[0], r[1]); w.y = cvt_pk_bf16(r[2], r[3]); w.z = cvt_pk_bf16(r[4], r[5]); w.w = cvt_pk_bf16(r[6], r[7]);
                    *(u32x4*)op = w;
                }
        }
    }
};
struct EpiResid {
    static constexpr bool PERM = false, AFTER_DRAIN = false;
    float* H; float* OUT; int atomic;
    __device__ __forceinline__ void operator()(const f32x4 (&acc)[2][2][4][2], const Unit& u, int wr, int wc, int fr, int fq) const {
        const int row0 = u.pm * BM + wr * 64 + fr, col0 = u.pn * BM + wc * 32 + 4 * fq;
#pragma unroll
        for (int ai = 0; ai < 2; ++ai)
#pragma unroll
            for (int m = 0; m < 4; ++m) {
                const int row = row0 + ai * HALF + m * 16;
                float* hp = H + (size_t)row * DM + col0;
                const int b = row >= LP ? 1 : 0, t = row - b * LP;
                float* op = (OUT && t >= NMETA && t < NMETA + SEQ) ? OUT + ((size_t)b * SEQ + (t - NMETA)) * DM + col0 : nullptr;
#pragma unroll
                for (int bj = 0; bj < 2; ++bj)
#pragma unroll
                    for (int n = 0; n < 2; ++n) { const int co = bj * HALF + n * 16;
                        if (atomic) {
#pragma unroll
                            for (int e = 0; e < 4; ++e) unsafeAtomicAdd(hp + co + e, acc[ai][bj][m][n][e]);
                        } else {
                            const f32x4 v = *(const f32x4*)(hp + co) + acc[ai][bj][m][n];
                            if (OUT) { if (op) *(f32x4*)(op + co) = v; } else *(f32x4*)(hp + co) = v; } }
            }
    }
};
struct EpiResidAtomic {
    static constexpr bool PERM = false, AFTER_DRAIN = false;
    float* H;
    __device__ __forceinline__ void operator()(const f32x4 (&acc)[2][2][4][2], const Unit& u, int wr, int wc, int fr, int fq) const {
        const int row0 = u.pm * BM + wr * 64 + fr, col0 = u.pn * BM + wc * 32 + 4 * fq;
#pragma unroll
        for (int ai = 0; ai < 2; ++ai)
#pragma unroll
            for (int m = 0; m < 4; ++m) { float* hp = H + (size_t)(row0 + ai * HALF + m * 16) * DM + col0;
#pragma unroll
                for (int bj = 0; bj < 2; ++bj)
#pragma unroll
                    for (int n = 0; n < 2; ++n)
#pragma unroll
                        for (int e = 0; e < 4; ++e) unsafeAtomicAdd(hp + bj * HALF + n * 16 + e, acc[ai][bj][m][n][e]); }
    }
};
struct OneUnit {
    StaticOrder so; int mode, pm, pn; bool active;
    __device__ bool next(int i, Unit& u) const { if (mode == 0) return so.next(i, u); if (i != 0 || !active) return false; u.pm = pm; u.pn = pn; return true; }
    __device__ __forceinline__ void a_ready(const Unit&) const {}
    __device__ __forceinline__ void done(const Unit&) const {}
};
struct EpiUp {
    static constexpr bool PERM = true, AFTER_DRAIN = false;
    bf16_t* ACT; bf16_t* HALO; const float* cw;
    __device__ __forceinline__ void operator()(const f32x4 (&acc)[2][2][4][2], const Unit& u, int wr, int wc, int fr, int fq) const {
        const int chan0 = u.pn * 128 + wc * 32 + 8 * fq;
#pragma unroll
        for (int n = 0; n < 2; ++n) {
            const int ch = chan0 + 4 * n;
            f32x4 w[3][2];
#pragma unroll
            for (int j = 0; j < 3; ++j) { w[j][0] = *(const f32x4*)(cw + j * NUP + ch); w[j][1] = *(const f32x4*)(cw + j * NUP + DFF + ch); }
#pragma unroll
            for (int ai = 0; ai < 2; ++ai) {
                const int rowg = u.pm * BM + ai * HALF + wr * 64;
#pragma unroll
                for (int m = 0; m < 4; ++m) {
                    f32x4 uc[2];
#pragma unroll
                    for (int bj = 0; bj < 2; ++bj) {
                        const f32x4 cur = acc[ai][bj][m][n];
                        f32x4 prv; if (m > 0) prv = acc[ai][bj][m - 1][n]; else prv = (f32x4){0.f, 0.f, 0.f, 0.f};
                        f32x4 p1, p2;
#pragma unroll
                        for (int i = 0; i < 4; ++i) {
                            const float r1 = dppf<0x121>(0.f, prv[i]), r2 = dppf<0x122>(0.f, prv[i]);
                            p1[i] = dppf<0x111>(r1, cur[i]); p2[i] = dppf<0x112>(r2, cur[i]);
                        }
                        uc[bj] = w[0][bj] * p2 + w[1][bj] * p1 + w[2][bj] * cur;
                    }
                    float a[4];
#pragma unroll
                    for (int i = 0; i < 4; ++i) a[i] = uc[0][i] * sigmoidf_(uc[0][i]) * uc[1][i];
                    u32x2 o; o.x = cvt_pk_bf16(a[0], a[1]); o.y = cvt_pk_bf16(a[2], a[3]);
                    *(u32x2*)(ACT + (size_t)(rowg + m * 16 + fr) * DFF + ch) = o;
                    if ((m == 3 && fr >= 14) || (m == 0 && fr < 2)) {
                        const int slot = (rowg >> 6) * 4 + (m == 3 ? fr - 14 : 2 + fr);
#pragma unroll
                        for (int bj = 0; bj < 2; ++bj) { const f32x4 cur = acc[ai][bj][m][n]; u32x2 hw; hw.x = cvt_pk_bf16(cur[0], cur[1]); hw.y = cvt_pk_bf16(cur[2], cur[3]);
                            *(u32x2*)(HALO + (size_t)slot * NUP + bj * DFF + ch) = hw; }
                    }
                }
            }
        }
    }
};
}

#ifndef REP_PREP
#define REP_PREP 1
#endif
#ifndef REP_P3
#define REP_P3 1
#endif
#ifndef REP_SYNC
#define REP_SYNC 0
#endif
#define GLD(T, p) (*(const __attribute__((address_space(1))) T*)(p))
#define GST(T, p) (*(__attribute__((address_space(1))) T*)(p))
#define LDS_BARRIER() do { asm volatile("s_waitcnt lgkmcnt(0)" ::: "memory"); __builtin_amdgcn_s_barrier(); asm volatile("" ::: "memory"); } while (0)
__device__ __forceinline__ void transpose_item(const float* W, int Nsrc, int K, bf16* WT, int dst_row0, int src_col0, int k0, float* scr, int lane) {
#pragma unroll 8
    for (int i = 0; i < 32; ++i) { const int kk = 2 * i + (lane >> 5); scr[kk * 33 + (lane & 31)] = W[(size_t)(k0 + kk) * Nsrc + src_col0 + (lane & 31)]; }
    asm volatile("s_waitcnt lgkmcnt(0)" ::: "memory");
    const int c = lane & 7;
#pragma unroll
    for (int j = 0; j < 4; ++j) { const int n = (lane >> 3) + 8 * j; const float* s = scr + (8 * c) * 33 + n;
        u32x4 o; o.x = pk2(s[0 * 33], s[1 * 33]); o.y = pk2(s[2 * 33], s[3 * 33]); o.z = pk2(s[4 * 33], s[5 * 33]); o.w = pk2(s[6 * 33], s[7 * 33]);
        *(u32x4*)(WT + (size_t)(dst_row0 + n) * K + k0 + 8 * c) = o; }
    asm volatile("s_waitcnt lgkmcnt(0)" ::: "memory");
}
__device__ __forceinline__ void convert_weights(const Params& P, int l, const Ctx& c) {
    bf16* WT = (bf16*)(c.ws + OFF_WT);
    float* scr = (float*)(c.lds + c.wave * 16384);
    const int gw = c.bid * NWAVES + c.wave, NGW = c.G * NWAVES;
    constexpr int I_IN = 16 * 168, I_BF = 8 * 32, I_O = 16 * 32, I_UP = 16 * 176, I_DN = 44 * 32, I_LR = 16, I_LG = 32, I_ALL = I_IN + 2 * I_BF + I_O + I_UP + I_DN + 2 * I_LR + I_LG;
    for (int it = gw; it < I_ALL; it += NGW) {
        int r = it;
        if (r < I_IN) { const int kb = r / 168, n0 = 32 * (r % 168); transpose_item(P.in[4] + (size_t)l * 1024 * N_IN, N_IN, 1024, WT + WT_IN, n0, n0 + (n0 >= 1536 ? 8 : 0), 64 * kb, scr, c.lane); continue; } r -= I_IN;
        if (r < I_BF) { const int kb = r / 32, n0 = 32 * (r % 32); transpose_item(P.in[19] + (size_t)l * 512 * 1024, 1024, 512, WT + WT_BF, n0, n0, 64 * kb, scr, c.lane); continue; } r -= I_BF;
        if (r < I_BF) { const int kb = r / 32, n0 = 32 * (r % 32); transpose_item(P.in[20] + (size_t)l * 512 * 1024, 1024, 512, WT + WT_BR, n0, n0, 64 * kb, scr, c.lane); continue; } r -= I_BF;
        if (r < I_O) { const int kb = r / 32, n0 = 32 * (r % 32); transpose_item(P.in[22] + (size_t)l * 1024 * 1024, 1024, 1024, WT + WT_O, n0, n0, 64 * kb, scr, c.lane); continue; } r -= I_O;
        if (r < I_UP) { const int kb = r / 176, n0 = 32 * (r % 176); const int pn = n0 >> 8, bj = (n0 >> 7) & 1, x = n0 & 127;
            transpose_item(P.in[23] + (size_t)l * 1024 * NUP, NUP, 1024, WT + WT_UP, n0, bj * DFF + 128 * pn + x, 64 * kb, scr, c.lane); continue; } r -= I_UP;
        if (r < I_DN) { const int kb = r / 32, n0 = 32 * (r % 32); transpose_item(P.in[25] + (size_t)l * DFF * 1024, 1024, DFF, WT + WT_DN, n0, n0, 64 * kb, scr, c.lane); continue; } r -= I_DN;
        if (r < I_LR) { transpose_item(P.in[10] + (size_t)l * 64 * 512, 512, 64, WT + WT_LW, 32 * r, 32 * r, 0, scr, c.lane); continue; } r -= I_LR;
        if (r < I_LR) { transpose_item(P.in[12] + (size_t)l * 64 * 512, 512, 64, WT + WT_LA, 32 * r, 32 * r, 0, scr, c.lane); continue; } r -= I_LR;
        { const int kb = r / 16, n0 = 32 * (r % 16); transpose_item(P.in[13] + (size_t)l * 128 * 512, 512, 128, WT + WT_LG, n0, n0, 64 * kb, scr, c.lane); }
    }
}

template <bool FG> __device__ __forceinline__ void phase_norm(const Params& P, int l, const Ctx& c) {
    float* H = (float*)(c.ws + OFF_H); bf16* HN = (bf16*)(c.ws + OFF_HN);
    float* LOGF = (float*)(c.ws + OFF_MISC);
    const float* gain = (FG ? P.in[2] : P.in[3]) + l * DM;
    float* wfs = (float*)c.lds;
    if (FG) {
        __syncthreads();
        const float* win = P.in[4] + (size_t)l * 1024 * N_IN + 1536;
        for (int i = c.tid; i < 8192; i += NTHR) wfs[i] = win[(size_t)(i >> 3) * N_IN + (i & 7)];
        __syncthreads();
    }
    const int gw = c.bid * NWAVES + c.wave, NGW = c.G * NWAVES;
    for (int m = gw; m < M; m += NGW) {
        const int b = m >= LP ? 1 : 0, t = m - b * LP;
        f32x4 v[4];
        if (FG && l == 0) {
            const float* src = (t < NMETA) ? P.in[1] + (size_t)t * DM : P.in[0] + ((size_t)b * SEQ + (t - NMETA)) * DM;
            const bool real = t < NMETA + SEQ;
#pragma unroll
            for (int j = 0; j < 4; ++j) { v[j] = real ? *(const f32x4*)(src + 4 * c.lane + 256 * j) : (f32x4){0.f, 0.f, 0.f, 0.f}; *(f32x4*)(H + (size_t)m * DM + 4 * c.lane + 256 * j) = v[j]; }
        } else {
#pragma unroll
            for (int j = 0; j < 4; ++j) v[j] = *(const f32x4*)(H + (size_t)m * DM + 4 * c.lane + 256 * j);
        }
        float ss = 0.f;
#pragma unroll
        for (int j = 0; j < 4; ++j) ss += (v[j].x * v[j].x + v[j].y * v[j].y) + (v[j].z * v[j].z + v[j].w * v[j].w);
        const float rstd = 1.0f / sqrtf(wave_sum(ss) * (1.f / DM) + 1e-6f);
        float f[8];
#pragma unroll
        for (int q = 0; q < 8; ++q) f[q] = 0.f;
#pragma unroll
        for (int j = 0; j < 4; ++j) {
            const f32x4 g = *(const f32x4*)(gain + 4 * c.lane + 256 * j);
            v[j] = v[j] * rstd * g;
            u32x2 o; o.x = pk2(v[j].x, v[j].y); o.y = pk2(v[j].z, v[j].w);
            *(u32x2*)(HN + (size_t)m * DM + 4 * c.lane + 256 * j) = o;
            if (FG) {
#pragma unroll
                for (int e = 0; e < 4; ++e) { const int k = 4 * c.lane + 256 * j + e; const f32x4 w0 = *(const f32x4*)(wfs + k * 8), w1 = *(const f32x4*)(wfs + k * 8 + 4);
                    const float hv = v[j][e];
                    f[0] += hv * w0.x; f[1] += hv * w0.y; f[2] += hv * w0.z; f[3] += hv * w0.w; f[4] += hv * w1.x; f[5] += hv * w1.y; f[6] += hv * w1.z; f[7] += hv * w1.w; }
            }
        }
        if (FG) {
#pragma unroll
            for (int q = 0; q < 8; ++q) f[q] = wave_sum(f[q]);
            float fv = f[0];
#pragma unroll
            for (int q = 1; q < 8; ++q) fv = (c.lane == q) ? f[q] : fv;
            if (c.lane < 8) { const float x = fv + P.in[7][l * 8 + c.lane]; const float ls = fminf(x, 0.f) - __logf(1.f + __expf(-fabsf(x))); LOGF[(size_t)(b * 8 + c.lane) * LP + t] = ls; }
        }
    }
}

__device__ __forceinline__ void phase_fcum(const Params& P, const Ctx& c) {
    if (c.bid < 16 && c.wave == 0) {
        const float* LOGF = (const float*)(c.ws + OFF_MISC) + (size_t)c.bid * LP; float* FC = (float*)(c.ws + OFF_MISC) + 16 * LP + (size_t)c.bid * LP;
        float carry = 0.f;
        for (int ch = 0; ch < LP / 64; ++ch) {
            float v = LOGF[ch * 64 + c.lane];
#pragma unroll
            for (int o = 1; o < 64; o <<= 1) { const float t = __shfl_up(v, o); if (c.lane >= o) v += t; }
            v += carry; FC[ch * 64 + c.lane] = v * LOG2E; carry = __shfl(v, 63);
        }
    }
}

__device__ __forceinline__ void phase_qknorm(const Params& P, int l, const Ctx& c) {
    bf16* Q = (bf16*)(c.ws + OFF_Q); bf16* K = (bf16*)(c.ws + OFF_K);
    const int gw = c.bid * NWAVES + c.wave, NGW = c.G * NWAVES;
    const int d0 = (c.lane & 7) * 8;
    float gq[8], gk[8];
#pragma unroll
    for (int i = 0; i < 8; ++i) { gq[i] = P.in[5][l * 64 + d0 + i] * QSCALE; gk[i] = P.in[6][l * 64 + d0 + i]; }
    for (int m = gw; m < M; m += NGW) {
#pragma unroll
        for (int which = 0; which < 2; ++which) {
            bf16* p = (which ? K : Q) + (size_t)m * 512 + 8 * c.lane;
            const u32x4 w = *(const u32x4*)p;
            float x[8] = {bflo(w.x), bfhi(w.x), bflo(w.y), bfhi(w.y), bflo(w.z), bfhi(w.z), bflo(w.w), bfhi(w.w)};
            float ss = 0.f;
#pragma unroll
            for (int i = 0; i < 8; ++i) ss += x[i] * x[i];
            ss += __shfl_xor(ss, 1); ss += __shfl_xor(ss, 2); ss += __shfl_xor(ss, 4);
            const float rs = 1.0f / sqrtf(ss * (1.f / 64.f) + 1e-6f);
#pragma unroll
            for (int i = 0; i < 8; ++i) x[i] = x[i] * rs * (which ? gk[i] : gq[i]);
            u32x4 o; o.x = pk2(x[0], x[1]); o.y = pk2(x[2], x[3]); o.z = pk2(x[4], x[5]); o.w = pk2(x[6], x[7]);
            *(u32x4*)p = o;
        }
    }
}

constexpr int NCHK = LP / 64;
constexpr int NUNIT = NB * NCHK * 8;
constexpr int UNIT_A = 16384, UNIT_B = 16640;
constexpr int ST = 72, STG = 136;
constexpr int L_F0 = 92160, L_F1 = 108544;
struct RwkvBufs { bf16 *BON, *G; unsigned char *UA, *UB; float* Y; bf16* ORW; };
__device__ __forceinline__ RwkvBufs rwkv_bufs(const Params& P, const Ctx& c) {
    RwkvBufs r; r.BON = (bf16*)(c.ws + OFF_HN); r.G = r.BON + (size_t)M * 512;
    r.UA = c.ws + OFF_T0; r.UB = (unsigned char*)P.out;
    r.Y = (float*)(c.ws + OFF_RW); r.ORW = (bf16*)(c.ws + OFF_RW + (size_t)M * 512 * 4);
    return r;
}
__device__ __forceinline__ void mm_tile(const bf16* A, int sa, const bf16* Bt, int sb, int nks, f32x4 (&acc)[2], int w, int lq, int g) {
    const int mt = w >> 1, nt0 = 2 * (w & 1);
    for (int ks = 0; ks < nks; ++ks) {
        const bf16x8 a = *(const bf16x8*)(A + (16 * mt + lq) * sa + 32 * ks + 8 * g);
#pragma unroll
        for (int q = 0; q < 2; ++q) { const bf16x8 b = *(const bf16x8*)(Bt + (16 * (nt0 + q) + lq) * sb + 32 * ks + 8 * g); acc[q] = __builtin_amdgcn_mfma_f32_16x16x32_bf16(a, b, acc[q], 0, 0, 0); }
    }
}
#define ZACC(a) do { a[0] = (f32x4){0.f, 0.f, 0.f, 0.f}; a[1] = (f32x4){0.f, 0.f, 0.f, 0.f}; } while (0)
__device__ __forceinline__ int permk(int k) { return 32 * (k >> 5) + 8 * ((k & 15) >> 2) + 4 * ((k >> 4) & 1) + (k & 3); }
__device__ __forceinline__ int swz(int row, int col) { return row * 128 + ((((col >> 3) ^ (row >> 1)) & 7) << 4) + (col & 7) * 2; }

__device__ __forceinline__ void rwkv_prep_unit(const Params& P, int l, const Ctx& c, int u, const RwkvBufs& B) {
    const int h = u & 7, bc = u >> 3, b = bc / NCHK, ch = bc - b * NCHK;
    const size_t m0 = (size_t)b * LP + ch * 64;
    int tid_ = c.tid; asm volatile("" : "+v"(tid_));
    const int tid = tid_, lane = tid & 63, w = c.wave, lq = lane & 15, g = lane >> 4;
    const int t = tid >> 3, cg = tid & 7, c0 = cg * 8, jb = h * 64 + c0;
    unsigned char* L = c.lds;
    bf16* A0 = (bf16*)L; bf16* A1 = A0 + 4608; bf16* A2 = A1 + 4608; bf16* A3 = A2 + 4608; bf16* A4 = A3 + 4608; bf16* A5 = A4 + 4608; bf16* A6 = A5 + 4608;
    bf16* A7 = A6 + 4608; bf16* A8 = A7 + 4608; bf16* A9 = A8 + 4608;
    float* F0 = (float*)(L + L_F0); float* F1 = (float*)(L + L_F1);
    const bf16* RW = (const bf16*)(c.ws + OFF_RW);
    const bf16* WT = (const bf16*)(c.ws + OFF_WT);
    const float* mu = P.in[8] + l * NRW;
    const bool first = (ch == 0 && t == 0);
    const bf16* cur = RW + (m0 + t) * NRW; const bf16* prv = cur - NRW;
    float zr[8], zk[8], zv[8];
#pragma unroll
    for (int s = 0; s < 3; ++s) {
        const u32x4 cw = *(const u32x4*)(cur + s * 512 + jb); u32x4 pw = (u32x4){0u, 0u, 0u, 0u}; if (!first) pw = *(const u32x4*)(prv + s * 512 + jb);
        const float cv[8] = {bflo(cw.x), bfhi(cw.x), bflo(cw.y), bfhi(cw.y), bflo(cw.z), bfhi(cw.z), bflo(cw.w), bfhi(cw.w)};
        const float pv[8] = {bflo(pw.x), bfhi(pw.x), bflo(pw.y), bfhi(pw.y), bflo(pw.z), bfhi(pw.z), bflo(pw.w), bfhi(pw.w)};
#pragma unroll
        for (int i = 0; i < 8; ++i) { const float z = cv[i] + mu[s * 512 + jb + i] * (pv[i] - cv[i]); if (s == 0) zr[i] = z; else if (s == 1) zk[i] = z; else zv[i] = z; }
    }
#pragma unroll
    for (int q4 = 0; q4 < 4; ++q4) {
        const int col = cg * 32 + q4 * 8;
        const u32x4 cw = *(const u32x4*)(cur + 1536 + col); u32x4 pw = (u32x4){0u, 0u, 0u, 0u}; if (!first) pw = *(const u32x4*)(prv + 1536 + col);
        const float cv[8] = {bflo(cw.x), bfhi(cw.x), bflo(cw.y), bfhi(cw.y), bflo(cw.z), bfhi(cw.z), bflo(cw.w), bfhi(cw.w)};
        const float pv[8] = {bflo(pw.x), bfhi(pw.x), bflo(pw.y), bfhi(pw.y), bflo(pw.z), bfhi(pw.z), bflo(pw.w), bfhi(pw.w)};
        float z[8];
#pragma unroll
        for (int i = 0; i < 8; ++i) { z[i] = cv[i] + mu[1536 + col + i] * (pv[i] - cv[i]); if (col < 64) z[i] = 1.f - 2.f / (1.f + __expf(2.f * z[i])); else if (col >= 128) z[i] = sigmoidf_(z[i]); }
        u32x4 o; o.x = pk2(z[0], z[1]); o.y = pk2(z[2], z[3]); o.z = pk2(z[4], z[5]); o.w = pk2(z[6], z[7]);
        bf16* dst = (col < 64) ? A0 + t * ST + col : (col < 128 ? A1 + t * ST + (col - 64) : A2 + t * STG + (col - 128));
        *(u32x4*)dst = o;
    }
    { const int row = tid >> 3, chk = tid & 7;
      *(u32x4*)(A4 + row * ST + chk * 8) = *(const u32x4*)(WT + WT_LW + (size_t)(h * 64 + row) * 64 + chk * 8);
      *(u32x4*)(A5 + row * ST + chk * 8) = *(const u32x4*)(WT + WT_LA + (size_t)(h * 64 + row) * 64 + chk * 8);
#pragma unroll
      for (int i = 0; i < 2; ++i) { const int idx = tid + 512 * i, r2 = idx >> 4, c2 = idx & 15;
          *(u32x4*)((bf16*)F1 + r2 * STG + c2 * 8) = *(const u32x4*)(WT + WT_LG + (size_t)(h * 64 + r2) * 128 + c2 * 8); } }
    LDS_BARRIER();
    { f32x4 aw[2], aa[2], ag[2]; ZACC(aw); ZACC(aa); ZACC(ag);
      mm_tile(A0, ST, A4, ST, 2, aw, w, lq, g); mm_tile(A1, ST, A5, ST, 2, aa, w, lq, g); mm_tile(A2, STG, (const bf16*)F1, STG, 4, ag, w, lq, g);
      const int mt = w >> 1, nt0 = 2 * (w & 1);
#pragma unroll
      for (int q = 0; q < 2; ++q)
#pragma unroll
          for (int j = 0; j < 4; ++j) { const int o = (16 * mt + 4 * g + j) * ST + 16 * (nt0 + q) + lq; A7[o] = (bf16)f2bf(aw[q][j]); A8[o] = (bf16)f2bf(aa[q][j]); A9[o] = (bf16)f2bf(ag[q][j]); } }
    LDS_BARRIER();
    float kk[8], k2[8], ar[8];
    { const u32x4 lw = *(const u32x4*)(A7 + t * ST + c0), la = *(const u32x4*)(A8 + t * ST + c0), lg = *(const u32x4*)(A9 + t * ST + c0);
      const float fw[8] = {bflo(lw.x), bfhi(lw.x), bflo(lw.y), bfhi(lw.y), bflo(lw.z), bfhi(lw.z), bflo(lw.w), bfhi(lw.w)};
      const float fa[8] = {bflo(la.x), bfhi(la.x), bflo(la.y), bfhi(la.y), bflo(la.z), bfhi(la.z), bflo(la.w), bfhi(la.w)};
      float ss = 0.f, bs = 0.f;
#pragma unroll
      for (int i = 0; i < 8; ++i) { const int j = l * 512 + jb + i;
          const float xw = -(P.in[9][j] + fw[i]); const float sp = fmaxf(xw, 0.f) + __logf(1.f + __expf(-fabsf(xw)));
          F0[t * 64 + c0 + i] = __expf(-sp - 0.5f);
          ar[i] = sigmoidf_(P.in[11][j] + fa[i]);
          kk[i] = zk[i] * P.in[14][j]; ss += kk[i] * kk[i];
          k2[i] = zk[i] * (1.f + (ar[i] - 1.f) * P.in[15][j]);
          bs += zr[i] * k2[i] * P.in[16][j]; }
      ss += __shfl_xor(ss, 1); ss += __shfl_xor(ss, 2); ss += __shfl_xor(ss, 4);
      bs += __shfl_xor(bs, 1); bs += __shfl_xor(bs, 2); bs += __shfl_xor(bs, 4);
      const float inv = 1.0f / fmaxf(sqrtf(ss), 1e-12f);
#pragma unroll
      for (int i = 0; i < 8; ++i) kk[i] *= inv;
      u32x4 bo; bo.x = pk2(bs * zv[0], bs * zv[1]); bo.y = pk2(bs * zv[2], bs * zv[3]); bo.z = pk2(bs * zv[4], bs * zv[5]); bo.w = pk2(bs * zv[6], bs * zv[7]);
      *(u32x4*)(B.BON + (m0 + t) * 512 + jb) = bo; *(u32x4*)(B.G + (m0 + t) * 512 + jb) = lg; }
    LDS_BARRIER();
    {
      const int k = tid & 63, sg = tid >> 6; float e[8], run = 0.f;
#pragma unroll
      for (int s = 0; s < 8; ++s) { run += F0[(8 * sg + s) * 64 + k]; e[s] = run; }
      F1[sg * 64 + k] = run;
      LDS_BARRIER();
      float off = 0.f;
#pragma unroll
      for (int s = 0; s < 8; ++s) off += (s < sg) ? F1[s * 64 + k] : 0.f;
#pragma unroll
      for (int s = 0; s < 8; ++s) F0[(8 * sg + s) * 64 + k] = e[s] + off; }
    LDS_BARRIER();
    { float ct[8], cp[8], cC[8];
#pragma unroll
      for (int i = 0; i < 8; ++i) { ct[i] = F0[t * 64 + c0 + i]; cp[i] = (t > 0) ? F0[(t - 1) * 64 + c0 + i] : 0.f; cC[i] = F0[63 * 64 + c0 + i]; }
      float at[8], bt[8], kt[8], rt[8], bh[8], kh[8];
#pragma unroll
      for (int i = 0; i < 8; ++i) { const float gt = __expf(-ct[i]), igt = __expf(ct[i]), gp = __expf(-cp[i]), gct = __expf(ct[i] - cC[i]);
          at[i] = -kk[i] * gp; bt[i] = kk[i] * ar[i] * igt; kt[i] = k2[i] * igt; rt[i] = zr[i] * gt; bh[i] = kk[i] * ar[i] * gct; kh[i] = k2[i] * gct; }
      u32x4 o;
      o.x = pk2(at[0], at[1]); o.y = pk2(at[2], at[3]); o.z = pk2(at[4], at[5]); o.w = pk2(at[6], at[7]); *(u32x4*)(A0 + t * ST + c0) = o;
      o.x = pk2(bt[0], bt[1]); o.y = pk2(bt[2], bt[3]); o.z = pk2(bt[4], bt[5]); o.w = pk2(bt[6], bt[7]); *(u32x4*)(A1 + t * ST + c0) = o;
      o.x = pk2(kt[0], kt[1]); o.y = pk2(kt[2], kt[3]); o.z = pk2(kt[4], kt[5]); o.w = pk2(kt[6], kt[7]); *(u32x4*)(A2 + t * ST + c0) = o;
      o.x = pk2(rt[0], rt[1]); o.y = pk2(rt[2], rt[3]); o.z = pk2(rt[4], rt[5]); o.w = pk2(rt[6], rt[7]); *(u32x4*)(A3 + t * ST + c0) = o;
#pragma unroll
      for (int i = 0; i < 8; ++i) { A4[(c0 + i) * ST + t] = (bf16)f2bf(bh[i]); A5[(c0 + i) * ST + t] = (bf16)f2bf(kh[i]); A6[(c0 + i) * ST + t] = (bf16)f2bf(zv[i]); F1[t * 128 + c0 + i] = at[i]; }
      if (t == 63) { float* gc = (float*)(B.UB + (size_t)u * UNIT_B + 16384) + c0;
#pragma unroll
          for (int i = 0; i < 8; ++i) gc[i] = __expf(-cC[i]); } }
    LDS_BARRIER();
    { const int mt = w >> 1, nt0 = 2 * (w & 1);
      f32x4 a1[2], a2[2], a3[2], a4[2]; ZACC(a1); ZACC(a2); ZACC(a3); ZACC(a4);
      mm_tile(A0, ST, A1, ST, 2, a1, w, lq, g); mm_tile(A0, ST, A2, ST, 2, a2, w, lq, g); mm_tile(A3, ST, A1, ST, 2, a3, w, lq, g); mm_tile(A3, ST, A2, ST, 2, a4, w, lq, g);
      LDS_BARRIER();
#pragma unroll
      for (int q = 0; q < 2; ++q) { const int i = 16 * (nt0 + q) + lq; f32x4 lab;
#pragma unroll
          for (int j = 0; j < 4; ++j) { const int tt = 16 * mt + 4 * g + j; lab[j] = (i < tt) ? a1[q][j] : 0.f;
              A7[tt * ST + i] = (bf16)f2bf((i < tt) ? a2[q][j] : 0.f); A8[tt * ST + i] = (bf16)f2bf((i <= tt) ? a3[q][j] : 0.f); A9[tt * ST + i] = (bf16)f2bf((i <= tt) ? a4[q][j] : 0.f); }
          *(f32x4*)(F0 + i * 64 + 16 * mt + 4 * g) = lab; } }
    LDS_BARRIER();
    { const int mt = w >> 1, nt0 = 2 * (w & 1); f32x4 a[2]; ZACC(a);
      mm_tile(A7, ST, A6, ST, 2, a, w, lq, g);
#pragma unroll
      for (int q = 0; q < 2; ++q)
#pragma unroll
          for (int j = 0; j < 4; ++j) F1[(16 * mt + 4 * g + j) * 128 + 64 + 16 * (nt0 + q) + lq] = a[q][j]; }
    LDS_BARRIER();
    { float X[16];
      const int col = 16 * w + lq;
#pragma unroll
      for (int r = 0; r < 16; ++r) X[r] = F1[(4 * r + g) * 128 + col];
      LDS_BARRIER();
#pragma unroll
      for (int i = 0; i < 64; ++i) {
          const float xi = __shfl(X[i >> 2], (i & 3) * 16 + lq);
#pragma unroll
          for (int r = (i >> 2); r < 16; ++r) X[r] += F0[i * 64 + 4 * r + g] * xi;
          asm volatile("" ::: "memory");
      }
      bf16* XT = (bf16*)F1 + (w >> 2) * 4608 + ((col & 63) * ST);
#pragma unroll
      for (int r = 0; r < 16; ++r) XT[4 * r + g] = (bf16)f2bf(X[r]); }
    LDS_BARRIER();
    { const int mt = w >> 1, nt0 = 2 * (w & 1);
      const bf16* AhT = (const bf16*)F1; const bf16* W2T = AhT + 4608;
      unsigned char* ua = B.UA + (size_t)u * UNIT_A; unsigned char* ub = B.UB + (size_t)u * UNIT_B;
      f32x4 a[2];
      ZACC(a); mm_tile(A4, ST, AhT, ST, 2, a, w, lq, g);
#pragma unroll
      for (int q = 0; q < 2; ++q)
#pragma unroll
          for (int j = 0; j < 4; ++j) { const int row = 16 * mt + 4 * g + j, kc = 16 * (nt0 + q) + lq; *(bf16*)(ua + swz(row, permk(kc))) = (bf16)f2bf(a[q][j]); }
      ZACC(a); mm_tile(A8, ST, AhT, ST, 2, a, w, lq, g);
#pragma unroll
      for (int q = 0; q < 2; ++q)
#pragma unroll
          for (int j = 0; j < 4; ++j) { const int row = 16 * mt + 4 * g + j, kc = 16 * (nt0 + q) + lq; *(bf16*)(ua + 8192 + swz(row, permk(kc))) = (bf16)f2bf(a[q][j] + bf2f(A3[row * ST + kc])); }
      ZACC(a); mm_tile(A4, ST, W2T, ST, 2, a, w, lq, g); mm_tile(A5, ST, A6, ST, 2, a, w, lq, g);
#pragma unroll
      for (int q = 0; q < 2; ++q) { const int v = 16 * (nt0 + q) + lq, k0 = 16 * mt + 4 * g; u32x2 o; o.x = pk2(a[q][0], a[q][1]); o.y = pk2(a[q][2], a[q][3]); *(u32x2*)(ub + swz(v, k0)) = o; }
      ZACC(a); mm_tile(A8, ST, W2T, ST, 2, a, w, lq, g); mm_tile(A9, ST, A6, ST, 2, a, w, lq, g);
#pragma unroll
      for (int q = 0; q < 2; ++q) { const int v = 16 * (nt0 + q) + lq, t0 = 16 * mt + 4 * g; u32x2 o; o.x = pk2(a[q][0], a[q][1]); o.y = pk2(a[q][2], a[q][3]); *(u32x2*)(ub + 8192 + swz(v, t0)) = o; } }
    LDS_BARRIER();
}
__device__ __forceinline__ void phase_rwkv_prep(const Params& P, int l, const Ctx& c) {
    const RwkvBufs B = rwkv_bufs(P, c);
    for (int u = c.bid; u < NUNIT; u += c.G) rwkv_prep_unit(P, l, c, u, B);
}

constexpr int SLOTB = 33280, YST = 68;
__device__ __forceinline__ void scan_chunked(const Params& P, const Ctx& c, int bh) {
    const RwkvBufs B = rwkv_bufs(P, c);
    const int b = bh >> 3, h = bh & 7, w = c.wave, lane = c.lane, lq = lane & 15, g = lane >> 4;
    const size_t rowb = (size_t)b * LP;
    const int ll = c.tid;
    unsigned char* L = c.lds;
    f32x4 st[4];
#pragma unroll
    for (int i = 0; i < 4; ++i) st[i] = (f32x4){0.f, 0.f, 0.f, 0.f};
    u32x4 r0[5], r1[5], r2[5], r3[5], r4[5];
#define SC_UNIT(cc) ((size_t)((b * NCHK + (cc)) * 8 + h))
#define SC_LOAD(R, cc) do { const unsigned char* pa_ = B.UA + SC_UNIT(cc) * UNIT_A; const unsigned char* pb_ = B.UB + SC_UNIT(cc) * UNIT_B; \
        _Pragma("unroll") for (int i_ = 0; i_ < 2; ++i_) { R[i_] = GLD(u32x4, pa_ + (ll + 512 * i_) * 16); R[2 + i_] = GLD(u32x4, pb_ + (ll + 512 * i_) * 16); } \
        if (ll < 16) R[4] = GLD(u32x4, pb_ + 16384 + ll * 16); } while (0)
#define SC_WRITE(R, slot) do { unsigned char* s_ = L + (slot) * SLOTB; \
        _Pragma("unroll") for (int i_ = 0; i_ < 2; ++i_) { *(u32x4*)(s_ + (ll + 512 * i_) * 16) = R[i_]; *(u32x4*)(s_ + 16384 + (ll + 512 * i_) * 16) = R[2 + i_]; } \
        if (ll < 16) *(u32x4*)(s_ + 32768 + ll * 16) = R[4]; } while (0)
#define SC_COMPUTE(ci) do { \
        const unsigned char* sl = L + ((ci) % 3) * SLOTB; \
        const int vcol = 16 * w + lq; \
        bf16x8 gaf[4][2]; f32x4 gcf[4]; u32x2 d0f[4]; \
        _Pragma("unroll") for (int mt = 0; mt < 4; ++mt) { \
            gcf[mt] = *(const f32x4*)(sl + 32768 + (16 * mt + 4 * g) * 4); \
            d0f[mt] = *(const u32x2*)(sl + 16384 + swz(vcol, 16 * mt + 4 * g)); \
            _Pragma("unroll") for (int ks = 0; ks < 2; ++ks) gaf[mt][ks] = *(const bf16x8*)(sl + swz(16 * mt + lq, 32 * ks + 8 * g)); } \
        __builtin_amdgcn_sched_barrier(0);        \
        bf16x8 sb[2]; \
        _Pragma("unroll") for (int ks = 0; ks < 2; ++ks) { u32x4 pw; pw.x = pk2(st[2 * ks][0], st[2 * ks][1]); pw.y = pk2(st[2 * ks][2], st[2 * ks][3]); pw.z = pk2(st[2 * ks + 1][0], st[2 * ks + 1][1]); pw.w = pk2(st[2 * ks + 1][2], st[2 * ks + 1][3]); \
            sb[ks] = __builtin_bit_cast(bf16x8, pw); } \
        _Pragma("unroll") for (int mt = 0; mt < 4; ++mt) { \
            f32x4 ns = (f32x4){bflo(d0f[mt].x), bfhi(d0f[mt].x), bflo(d0f[mt].y), bfhi(d0f[mt].y)} + gcf[mt] * st[mt]; \
            _Pragma("unroll") for (int ks = 0; ks < 2; ++ks) ns = __builtin_amdgcn_mfma_f32_16x16x32_bf16(gaf[mt][ks], sb[ks], ns, 0, 0, 0); \
            st[mt] = ns; } \
        _Pragma("unroll") for (int mt = 0; mt < 4; ++mt) { \
            const u32x2 y0 = *(const u32x2*)(sl + 24576 + swz(vcol, 16 * mt + 4 * g)); \
            f32x4 ya = (f32x4){bflo(y0.x), bfhi(y0.x), bflo(y0.y), bfhi(y0.y)}; \
            _Pragma("unroll") for (int ks = 0; ks < 2; ++ks) { const bf16x8 rh = *(const bf16x8*)(sl + 8192 + swz(16 * mt + lq, 32 * ks + 8 * g)); ya = __builtin_amdgcn_mfma_f32_16x16x32_bf16(rh, sb[ks], ya, 0, 0, 0); } \
            float* yl = (float*)(L + 3 * SLOTB) + ((ci) & 1) * (64 * YST) + (16 * mt + 4 * g) * YST + vcol; \
            _Pragma("unroll") for (int j = 0; j < 4; ++j) yl[j * YST] = ya[j]; } } while (0)
#define SC_YSTORE(ci) do { const float* ys_ = (const float*)(L + 3 * SLOTB) + ((ci) & 1) * (64 * YST) + (c.tid >> 3) * YST + (c.tid & 7) * 8; \
        float* yg_ = B.Y + (rowb + (ci) * 64 + (c.tid >> 3)) * 512 + h * 64 + (c.tid & 7) * 8; \
        GST(f32x4, yg_) = *(const f32x4*)ys_; GST(f32x4, yg_ + 4) = *(const f32x4*)(ys_ + 4); } while (0)
#define SC_ITER(ci, R) do { if ((ci) + 2 < NCHK) SC_WRITE(R, ((ci) + 2) % 3); if ((ci) + 7 < NCHK) SC_LOAD(R, (ci) + 7); if ((ci) > 0) SC_YSTORE((ci) - 1); if (w < 4) { SC_COMPUTE(ci); } LDS_BARRIER(); } while (0)
    { SC_LOAD(r0, 0); SC_LOAD(r1, 1); SC_WRITE(r0, 0); SC_WRITE(r1, 1); SC_LOAD(r2, 2); SC_LOAD(r3, 3); SC_LOAD(r4, 4); SC_LOAD(r0, 5); SC_LOAD(r1, 6); }
    __syncthreads();
#pragma unroll 1
    for (int cc = 0; cc < NCHK; cc += 5) { SC_ITER(cc, r2); SC_ITER(cc + 1, r3); SC_ITER(cc + 2, r4); SC_ITER(cc + 3, r0); SC_ITER(cc + 4, r1); }
    SC_YSTORE(NCHK - 1);
#undef SC_YSTORE
#undef SC_COMPUTE
#undef SC_ITER
#undef SC_UNIT
#undef SC_LOAD
#undef SC_WRITE
}

__device__ __forceinline__ void phase_gn(const Params& P, int l, const Ctx& c) {
    const RwkvBufs B = rwkv_bufs(P, c);
    const int gw = c.bid * NWAVES + c.wave, NGW = c.G * NWAVES;
    const int c0 = 8 * c.lane;
    float gnw[8], gnb[8];
#pragma unroll
    for (int i = 0; i < 8; ++i) { gnw[i] = P.in[17][l * 512 + c0 + i]; gnb[i] = P.in[18][l * 512 + c0 + i]; }
    for (int m = gw; m < M; m += NGW) {
        const size_t o = (size_t)m * 512 + c0;
        const f32x4 y0 = *(const f32x4*)(B.Y + o), y1 = *(const f32x4*)(B.Y + o + 4);
        float y[8] = {y0.x, y0.y, y0.z, y0.w, y1.x, y1.y, y1.z, y1.w};
        const u32x4 bw = *(const u32x4*)(B.BON + o), gw4 = *(const u32x4*)(B.G + o);
        const float bo[8] = {bflo(bw.x), bfhi(bw.x), bflo(bw.y), bfhi(bw.y), bflo(bw.z), bfhi(bw.z), bflo(bw.w), bfhi(bw.w)};
        const float gg[8] = {bflo(gw4.x), bfhi(gw4.x), bflo(gw4.y), bfhi(gw4.y), bflo(gw4.z), bfhi(gw4.z), bflo(gw4.w), bfhi(gw4.w)};
        float s = 0.f;
#pragma unroll
        for (int i = 0; i < 8; ++i) s += y[i];
        s += __shfl_xor(s, 1); s += __shfl_xor(s, 2); s += __shfl_xor(s, 4);
        const float mean = s * (1.f / 64.f);
        float q = 0.f;
#pragma unroll
        for (int i = 0; i < 8; ++i) { y[i] -= mean; q += y[i] * y[i]; }
        q += __shfl_xor(q, 1); q += __shfl_xor(q, 2); q += __shfl_xor(q, 4);
        const float rstd = 1.0f / sqrtf(q * (1.f / 64.f) + 64e-5f);
        float ov[8];
#pragma unroll
        for (int i = 0; i < 8; ++i) ov[i] = (y[i] * rstd * gnw[i] + gnb[i] + bo[i]) * gg[i];
        u32x4 ow; ow.x = pk2(ov[0], ov[1]); ow.y = pk2(ov[2], ov[3]); ow.z = pk2(ov[4], ov[5]); ow.w = pk2(ov[6], ov[7]);
        *(u32x4*)(B.ORW + o) = ow;
    }
}

__device__ __forceinline__ void attn_unit(const Ctx& c, int bh, int qb, const bf16* Q, const bf16* K, const bf16* V, bf16* O, const float* FC, float qkb2) {
    const int b = bh >> 3, h = bh & 7, lane = c.lane, w = c.wave, lq = lane & 15, g = lane >> 4;
    const int q0 = qb * 128;
    const size_t rowb = (size_t)b * LP;
    const int qrow = q0 + 16 * w + lq;
    bf16* Ks = (bf16*)c.lds; bf16* Vt = Ks + 64 * 72; float* fks = (float*)(Vt + 64 * 72);
    const bf16* qp = Q + (rowb + qrow) * 512 + h * 64 + 8 * g;
    const bf16x8 qf0 = GLD(bf16x8, qp), qf1 = GLD(bf16x8, qp + 32);
    const float* FCh = FC + (size_t)bh * LP;
    const float fq = GLD(float, FCh + qrow);
    float mrun = -1e30f, lsum = 0.f;
    f32x4 o[4];
#pragma unroll
    for (int i = 0; i < 4; ++i) o[i] = (f32x4){0.f, 0.f, 0.f, 0.f};
    const int kt_max = (q0 + 127) >> 6;
    const int lkey = c.tid >> 3, lch = c.tid & 7;
    const size_t gbase = (rowb + lkey) * 512 + h * 64 + lch * 8;
    u32x4 kv = GLD(u32x4, K + gbase + (size_t)kt_max * 64 * 512), vv = GLD(u32x4, V + gbase + (size_t)kt_max * 64 * 512);
    float fkv = GLD(float, FCh + kt_max * 64 + (c.tid & 63));
    volatile unsigned* vote = (volatile unsigned*)(fks + 64);
    for (int kt = kt_max; kt >= 0; --kt) {
        const int k0 = kt * 64;
        LDS_BARRIER();
        { int can = 0; if (kt < kt_max) { const float fl = __shfl(fkv, 63); can = (qkb2 + fq - fl) < (mrun - THR2); }
          const int wall = __all(can); if (lane == 0) vote[w] = (unsigned)wall; }
        { *(u32x4*)(Ks + lkey * 72 + lch * 8) = kv;
            bf16* vd = Vt + (lch * 8) * 72 + lkey;
            vd[0] = (bf16)(vv.x & 0xffff); vd[72] = (bf16)(vv.x >> 16); vd[144] = (bf16)(vv.y & 0xffff); vd[216] = (bf16)(vv.y >> 16);
            vd[288] = (bf16)(vv.z & 0xffff); vd[360] = (bf16)(vv.z >> 16); vd[432] = (bf16)(vv.w & 0xffff); vd[504] = (bf16)(vv.w >> 16);
            if (c.tid < 64) fks[c.tid] = fkv;
            if (kt > 0) { kv = GLD(u32x4, K + gbase + (size_t)(k0 - 64) * 512); vv = GLD(u32x4, V + gbase + (size_t)(k0 - 64) * 512); fkv = GLD(float, FCh + k0 - 64 + (c.tid & 63)); } }
        LDS_BARRIER();
        { unsigned all = vote[0] & vote[1] & vote[2] & vote[3] & vote[4] & vote[5] & vote[6] & vote[7]; if (all) break; }
        if (k0 > q0 + 16 * w + 15) continue;
        f32x4 s[4];
#pragma unroll
        for (int nt = 0; nt < 4; ++nt) { const bf16* kp = Ks + (16 * nt + lq) * 72 + 8 * g; const bf16x8 a0 = *(const bf16x8*)kp, a1 = *(const bf16x8*)(kp + 32);
            s[nt] = __builtin_amdgcn_mfma_f32_16x16x32_bf16(a0, qf0, (f32x4){0.f, 0.f, 0.f, 0.f}, 0, 0, 0);
            s[nt] = __builtin_amdgcn_mfma_f32_16x16x32_bf16(a1, qf1, s[nt], 0, 0, 0); }
        float mx = -INFINITY;
#pragma unroll
        for (int nt = 0; nt < 4; ++nt) { const f32x4 fk = *(const f32x4*)(fks + 16 * nt + 4 * g);
#pragma unroll
            for (int j = 0; j < 4; ++j) { float x = s[nt][j] + fq - fk[j]; const int key = k0 + 16 * nt + 4 * g + j; if (key > qrow) x = -INFINITY; s[nt][j] = x; mx = fmaxf(mx, x); } }
        mx = fmaxf(mx, __shfl_xor(mx, 16)); mx = fmaxf(mx, __shfl_xor(mx, 32));
        const float mnew = fmaxf(mrun, mx), alpha = exp2f(mrun - mnew); mrun = mnew;
        float psum = 0.f;
#pragma unroll
        for (int nt = 0; nt < 4; ++nt)
#pragma unroll
            for (int j = 0; j < 4; ++j) { const float p = exp2f(s[nt][j] - mnew); s[nt][j] = p; psum += p; }
        lsum = lsum * alpha + psum;
#pragma unroll
        for (int dt = 0; dt < 4; ++dt) o[dt] = o[dt] * alpha;
        bf16x8 pb[2];
#pragma unroll
        for (int k2 = 0; k2 < 2; ++k2) { u32x4 pw; pw.x = pk2(s[2 * k2][0], s[2 * k2][1]); pw.y = pk2(s[2 * k2][2], s[2 * k2][3]); pw.z = pk2(s[2 * k2 + 1][0], s[2 * k2 + 1][1]); pw.w = pk2(s[2 * k2 + 1][2], s[2 * k2 + 1][3]);
            pb[k2] = __builtin_bit_cast(bf16x8, pw); }
#pragma unroll
        for (int dt = 0; dt < 4; ++dt)
#pragma unroll
            for (int k2 = 0; k2 < 2; ++k2) { const bf16* vp = Vt + (16 * dt + lq) * 72 + 32 * k2 + 4 * g;
                const u32x2 lo = *(const u32x2*)vp, hi = *(const u32x2*)(vp + 16);
                u32x4 aw; aw.x = lo.x; aw.y = lo.y; aw.z = hi.x; aw.w = hi.y;
                o[dt] = __builtin_amdgcn_mfma_f32_16x16x32_bf16(__builtin_bit_cast(bf16x8, aw), pb[k2], o[dt], 0, 0, 0); }
    }
    lsum += __shfl_xor(lsum, 16); lsum += __shfl_xor(lsum, 32);
    const float inv = 1.0f / lsum;
    bf16* op = O + (rowb + qrow) * 512 + h * 64 + 4 * g;
#pragma unroll
    for (int dt = 0; dt < 4; ++dt) { u32x2 ow; ow.x = pk2(o[dt][0] * inv, o[dt][1] * inv); ow.y = pk2(o[dt][2] * inv, o[dt][3] * inv); GST(u32x2, op + 16 * dt) = ow; }
    __syncthreads();
}
__device__ __forceinline__ void phase_attn(const Params& P, int l, const Ctx& c, int first_blk) {
    const bf16* Q = (const bf16*)(c.ws + OFF_Q); const bf16* K = (const bf16*)(c.ws + OFF_K); const bf16* V = (const bf16*)(c.ws + OFF_V);
    const float* FC = (const float*)(c.ws + OFF_MISC) + 16 * LP;
    float gqm = fabsf(P.in[5][l * 64 + c.lane]), gkm = fabsf(P.in[6][l * 64 + c.lane]);
#pragma unroll
    for (int o = 1; o < 64; o <<= 1) { gqm = fmaxf(gqm, __shfl_xor(gqm, o)); gkm = fmaxf(gkm, __shfl_xor(gkm, o)); }
    const float qkb2 = 8.0f * gqm * gkm * LOG2E * 1.03f;
    constexpr int NQB = LP / 128, NU = 16 * NQB;
    unsigned* ctr = (unsigned*)(c.ws + OFF_CTL) + 8192 + 64 * l;
    volatile unsigned* slot = (volatile unsigned*)(c.lds + MISC_OFF) + 4;
    for (;;) {
        __syncthreads();
        if (c.tid == 0) *slot = atomicAdd(ctr, 1u);
        __syncthreads();
        const int u = (int)*slot;
        if (u >= NU) break;
        const int bh = u & 15, qb = NQB - 1 - (u >> 4); attn_unit(c, bh, qb, Q, K, V, (bf16*)(c.ws + OFF_OF), FC, qkb2);
    }
}

__device__ __forceinline__ void phase_fixup(const Params& P, int l, const Ctx& c) {
    bf16* ACT = (bf16*)(c.ws + OFF_RW); const bf16* HALO = (const bf16*)(c.ws + OFF_Q);
    const float* cw = P.in[24] + (size_t)l * 3 * NUP;
    const int total = (M / 64) * 2 * DFF;
    for (int idx = c.bid * NTHR + c.tid; idx < total; idx += c.G * NTHR) {
        const int rr = idx / DFF, ch = idx - rr * DFF, q64 = rr >> 1, e = rr & 1, row = q64 * 64 + e;
        const int t = row % LP;
        int s0, s1, s2;
        if (e == 0) { s0 = q64 * 4 + 2; s1 = (q64 - 1) * 4 + 1; s2 = (q64 - 1) * 4 + 0; } else { s0 = q64 * 4 + 3; s1 = q64 * 4 + 2; s2 = (q64 - 1) * 4 + 1; }
        float uc[2];
#pragma unroll
        for (int bj = 0; bj < 2; ++bj) { const int col = bj * DFF + ch;
            const float u0 = bf2f(HALO[(size_t)s0 * NUP + col]);
            const float u1 = (t >= 1) ? bf2f(HALO[(size_t)s1 * NUP + col]) : 0.f;
            const float u2 = (t >= 2) ? bf2f(HALO[(size_t)s2 * NUP + col]) : 0.f;
            uc[bj] = cw[col] * u2 + cw[NUP + col] * u1 + cw[2 * NUP + col] * u0; }
        ACT[(size_t)row * DFF + ch] = (bf16)f2bf(uc[0] * sigmoidf_(uc[0]) * uc[1]);
    }
}

#define OPQ_S(x) asm volatile("" : "+s"(x))
#define OPQ_V(x) asm volatile("" : "+v"(x))
#define PHASE_BEGIN() do { int t_ = threadIdx.x; OPQ_V(t_); c.tid = t_; c.lane = t_ & 63; c.wave = __builtin_amdgcn_readfirstlane(t_ >> 6); int b_ = blockIdx.x; OPQ_S(b_); c.bid = b_; \
    size_t z_ = 0; OPQ_S(z_); unsigned char* w_ = P.ws + z_;   c.ws = w_; ws = w_; l = lc; OPQ_S(l); WT = (pg8::bf16_t*)(ws + OFF_WT); HN = (pg8::bf16_t*)(ws + OFF_HN); } while (0)
__global__ void __launch_bounds__(NTHR, 2) mega(Params P) {
    extern __shared__ __attribute__((aligned(16))) unsigned char lds[];
    Ctx c; c.G = gridDim.x; c.lds = lds;
    volatile LAS unsigned* MISC = (volatile LAS unsigned*)((LAS unsigned char*)lds + MISC_OFF);
    if (threadIdx.x < 16) MISC[threadIdx.x] = 0u;
    __syncthreads();
    (void)xcd_barrier_post((unsigned*)(P.ws + OFF_CTL) + 1024, MISC + 8);
#define SEAM() do { XcdBarrier xb_; xb_.bar = (unsigned*)(P.ws + OFF_CTL) + 1024; xb_.x = xb_xcc_id(); xb_.st = (volatile LAS unsigned*)((LAS unsigned char*)lds + MISC_OFF) + 8; xcd_barrier(xb_); } while (0)
    PG8_LAS unsigned char* ldsl = (PG8_LAS unsigned char*)lds;
    unsigned char* ws; pg8::bf16_t* WT; pg8::bf16_t* HN; int l;
#pragma unroll 1
    for (int lc = 0; lc < DEPTH; ++lc) {
        PHASE_BEGIN();
        convert_weights(P, l, c);
        phase_norm<true>(P, l, c);
        if (lc == 0) cg::this_grid().sync(); else SEAM();
        PHASE_BEGIN();
        phase_fcum(P, c);
        { pg8::Gemm g{HN, WT + WT_IN, M, N1, 1024, 1024}; pg8::StaticOrder S; S.init(M, N1, c.G, c.bid);
          pg8::EpiRoute E{ws};
          pg8::gemm_phase<pg8::EpiRoute, pg8::StaticOrder, true, true>(ldsl, g, S, E); }
        SEAM();
        PHASE_BEGIN();
        phase_qknorm(P, l, c);
        for (int rep_ = 0; rep_ < REP_PREP; ++rep_) phase_rwkv_prep(P, l, c);
        SEAM();
        PHASE_BEGIN();
        if (c.bid < 16) { scan_chunked(P, c, c.bid); __syncthreads(); PHASE_BEGIN(); }
        phase_attn(P, l, c, 16);
#if REP_P3 > 1
        __syncthreads(); PHASE_BEGIN();
        if (c.bid < 16) scan_chunked(P, c, c.bid); else phase_attn(P, l, c, 16);
#endif
        SEAM();
        PHASE_BEGIN();
        phase_gn(P, l, c);
        for (int rep_ = 0; rep_ < REP_SYNC; ++rep_) SEAM();
        SEAM();
        PHASE_BEGIN();
        { pg8::bf16_t* MG = (pg8::bf16_t*)(ws + OFF_K); const pg8::bf16_t* GT = (const pg8::bf16_t*)(ws + OFF_GT); const float* gb = P.in[21] + l * NGT;
          pg8::StaticOrder S; S.init(M, 1024, c.G, c.bid);
          { pg8::Gemm g{(const pg8::bf16_t*)(ws + OFF_OF), WT + WT_BF, M, 1024, 512, 512}; pg8::EpiGate<0> E{MG, GT, gb};
            pg8::gemm_phase<pg8::EpiGate<0>, pg8::StaticOrder, true, true>(ldsl, g, S, E); }
          __syncthreads();
          PHASE_BEGIN();
          MG = (pg8::bf16_t*)(ws + OFF_K); GT = (const pg8::bf16_t*)(ws + OFF_GT); gb = P.in[21] + l * NGT; S.init(M, 1024, c.G, c.bid);
          { pg8::Gemm g{(const pg8::bf16_t*)(ws + OFF_RW + (size_t)M * 512 * 4), WT + WT_BR, M, 1024, 512, 512}; pg8::EpiGate<1> E{MG, GT, gb};
            pg8::gemm_phase<pg8::EpiGate<1>, pg8::StaticOrder, true, true>(ldsl, g, S, E); } }
        SEAM();
        PHASE_BEGIN();
#pragma unroll 1
        for (int pass = 0; pass < 2; ++pass) {
            if (pass) { __syncthreads(); PHASE_BEGIN(); }
            const int sl = pass ? (c.bid >> 2) : 0;
            pg8::Gemm g{(const pg8::bf16_t*)(ws + OFF_K) + sl * 256, WT + WT_O + sl * 256, M, 1024, pass ? 256 : 1024, 1024};
            pg8::OneUnit S; S.so.init(MMAIN, 1024, c.G, c.bid); S.mode = pass; S.pm = MMAIN / 256; S.pn = c.bid & 3; S.active = sl < 4;
            pg8::EpiResid E{(float*)(ws + OFF_H), nullptr, pass};
            pg8::gemm_phase<pg8::EpiResid, pg8::OneUnit, true, true>(ldsl, g, S, E);
        }
        SEAM();
        PHASE_BEGIN();
        phase_norm<false>(P, l, c);
        SEAM();
        PHASE_BEGIN();
        { pg8::Gemm g{HN, WT + WT_UP, M, NUP, 1024, 1024}; pg8::StaticOrder S; S.init(M, NUP, c.G, c.bid);
          pg8::EpiUp E{(pg8::bf16_t*)(ws + OFF_RW), (pg8::bf16_t*)(ws + OFF_Q), P.in[24] + (size_t)l * 3 * NUP};
          pg8::gemm_phase<pg8::EpiUp, pg8::StaticOrder, true, true>(ldsl, g, S, E); }
        SEAM();
        PHASE_BEGIN();
        phase_fixup(P, l, c);
        SEAM();
        PHASE_BEGIN();
#pragma unroll 1
        for (int pass = 0; pass < 2; ++pass) {
            if (pass) { __syncthreads(); PHASE_BEGIN(); }
            const int sl = pass ? (c.bid >> 2) : 0;
            const int ko = (sl < 2) ? sl * 768 : 1536 + (sl - 2) * 640, kl = (sl < 2) ? 768 : 640;
            pg8::Gemm g{(const pg8::bf16_t*)(ws + OFF_RW) + (pass ? ko : 0), WT + WT_DN + (pass ? ko : 0), M, 1024, pass ? kl : DFF, DFF};
            pg8::OneUnit S; S.so.init(MMAIN, 1024, c.G, c.bid); S.mode = pass; S.pm = MMAIN / 256; S.pn = c.bid & 3; S.active = sl < 4;
            pg8::EpiResid E{(float*)(ws + OFF_H), (l == DEPTH - 1 && !pass) ? P.out : nullptr, pass};
            pg8::gemm_phase<pg8::EpiResid, pg8::OneUnit, true, true>(ldsl, g, S, E);
        }
        SEAM();
        if (l == DEPTH - 1) {
            PHASE_BEGIN();
            const float* H = (const float*)(ws + OFF_H);
            for (int idx = c.bid * NTHR + c.tid; idx < (NMETA + SEQ - (MMAIN - LP)) * (DM / 4); idx += c.G * NTHR) {
                const int r = idx / (DM / 4), q4 = idx - r * (DM / 4), t = (MMAIN - LP) + r;
                *(f32x4*)(P.out + ((size_t)SEQ + (t - NMETA)) * DM + 4 * q4) = *(const f32x4*)(H + (size_t)(LP + t) * DM + 4 * q4);
            }
        }
    }
}

extern "C" void kernel_launch(void* const* d_in, const int* in_sizes, int n_in, void* d_out, int out_size, void* d_ws, size_t ws_size, hipStream_t stream) {
    static int grid = 0;
    if (grid == 0) {
        if (n_in != 26 || out_size != NB * SEQ * DM || ws_size < WS_NEED) { fprintf(stderr, "kernel_launch: unexpected shapes (n_in %d out %d ws %zu need %zu)\n", n_in, out_size, ws_size, (size_t)WS_NEED); grid = -1; return; }
        int dev = 0, cus = 0, per_cu = 0;
        if (hipGetDevice(&dev) != hipSuccess || hipDeviceGetAttribute(&cus, hipDeviceAttributeMultiprocessorCount, dev) != hipSuccess) { grid = -1; return; }
        if (hipFuncSetAttribute((const void*)mega, hipFuncAttributeMaxDynamicSharedMemorySize, LDS_BYTES) != hipSuccess) { fprintf(stderr, "kernel_launch: hipFuncSetAttribute failed\n"); grid = -1; return; }
        if (hipOccupancyMaxActiveBlocksPerMultiprocessor(&per_cu, (const void*)mega, NTHR, LDS_BYTES) != hipSuccess || per_cu < 1) { fprintf(stderr, "kernel_launch: occupancy query says %d\n", per_cu); per_cu = 1; }
        (void)hipGetLastError();
        grid = cus;
    }
    if (grid < 0) return;
    if (hipMemsetAsync((char*)d_ws + OFF_CTL, 0, 65536, stream) != hipSuccess) { fprintf(stderr, "kernel_launch: memset failed\n"); return; }
    Params p{};
    for (int i = 0; i < 26; ++i) p.in[i] = (const float*)d_in[i];
    p.out = (float*)d_out; p.ws = (unsigned char*)d_ws;
    void* args[] = {&p};
    hipError_t e = hipLaunchCooperativeKernel((const void*)mega, dim3(grid), dim3(NTHR), args, LDS_BYTES, stream);
    if (e != hipSuccess) fprintf(stderr, "kernel_launch: cooperative launch failed: %s (grid %d)\n", hipGetErrorString(e), grid);
}
```

```cpp
#include <hip/hip_runtime.h>
#include <hip/hip_cooperative_groups.h>
#include <cstdio>
#include <cstdint>
#include <cmath>
namespace cg = cooperative_groups;
namespace pg8 {
#define PG8_LAS __attribute__((address_space(3)))
typedef unsigned short bf16_t;
typedef short bf16x8 __attribute__((ext_vector_type(8)));
typedef float f32x4 __attribute__((ext_vector_type(4)));
typedef unsigned u32x4 __attribute__((ext_vector_type(4)));
constexpr int BM = 256, BK = 64, HALF = 128, HTB = HALF * BK * 2  , STAGE_BYTES = 8 * HTB, NXCD = 8, WGM = 8;

__host__ __device__ __forceinline__ int lds_byte(int r, int c) { const int st = (r >> 4) * 2 + (c >> 5), rr = r & 15, cc = c & 31, ob = rr * 64 + cc * 2; return st * 1024 + (ob ^ (((ob >> 9) & 1) << 5)); }
__host__ __device__ __forceinline__ void stage_rc(int b, int& R, int& C) { const int st = b / 1024, sb = b % 1024, swz = sb ^ (((sb >> 9) & 1) << 5); R = (st >> 1) * 16 + swz / 64; C = (st & 1) * 32 + (swz % 64) / 2; }
__host__ __device__ __forceinline__ int perm32(int rho) { const int n = rho >> 4, i = rho & 15; return 8 * (i >> 2) + 4 * n + (i & 3); }

struct Unit { int pm, pn; };
struct Gemm { const bf16_t* A; const bf16_t* Bt; int M, N, K, ld; };

struct StaticOrder {
    int nM, nN, nwg, G, c;
    __host__ __device__ void init(int M, int N, int G_, int c_) { nM = M / BM; nN = N / BM; nwg = nM * nN; G = G_; c = c_; }
    __host__ __device__ bool next(int i, Unit& u) const {
        const long L = (long)i * G + c; if (L >= nwg) return false;
        int wgid = (int)L; { const int q = nwg / NXCD, r = nwg % NXCD, xcd = wgid % NXCD, off = wgid / NXCD; wgid = (xcd < r ? xcd * (q + 1) : r * (q + 1) + (xcd - r) * q) + off; }
        const int nig = WGM * nN, gid = wgid / nig, fm = gid * WGM, gsz = (nM - fm) < WGM ? (nM - fm) : WGM;
        u.pm = fm + ((wgid % nig) % gsz); u.pn = (wgid % nig) / gsz; return true;
    }
    __device__ __forceinline__ void a_ready(const Unit&) const {}
    __device__ __forceinline__ void done(const Unit&) const {}
};

__device__ __forceinline__ unsigned cvt_pk_bf16(float lo, float hi) { unsigned r; asm volatile("v_cvt_pk_bf16_f32 %0, %1, %2" : "=v"(r) : "v"(lo), "v"(hi)); return r; }
typedef float f32x2 __attribute__((ext_vector_type(2)));
template <class Epi, class Sched, bool ALIGN_EPI = false, bool SP2 = false>
__device__ __forceinline__ void gemm_phase(PG8_LAS unsigned char* lds, const Gemm g, const Sched& S, const Epi& E) {
    int tid_ = threadIdx.x; asm volatile("" : "+v"(tid_)); const int tid = tid_, wid = __builtin_amdgcn_readfirstlane(tid >> 6), lane = tid & 63, wr = wid >> 2, wc = wid & 3, fr = lane & 15, fq = lane >> 4;
    const int K = g.K, nt = K / BK, LD = g.ld;
    unsigned voffA[2], voffB[2];
#pragma unroll
    for (int i = 0; i < 2; ++i) { int R, C; stage_rc(tid * 16 + i * 8192, R, C); const int Rb = Epi::PERM ? ((R & ~31) + perm32(R & 31)) : R;
        voffA[i] = (unsigned)(R * LD + C) * 2u; voffB[i] = (unsigned)(Rb * LD + C) * 2u; }
    const size_t kstep = (size_t)(BK * 2);
    const size_t hstep = (size_t)HALF * LD * 2;
    const size_t tstep = 2 * hstep;
    const unsigned ldsw = (unsigned)wid * 1024u;
    const int aoff = lds_byte(wr * 64 + fr, fq * 8), boff = lds_byte(wc * 32 + fr, fq * 8);
#define PG8_SA(b, h) (((b) * 2 + (h)) * HTB)
#define PG8_SB(b, h) ((4 + (b) * 2 + (h)) * HTB)
#define PG8_STAGE(bufoff, gbase, voff) do { _Pragma("unroll") for (int _i = 0; _i < 2; ++_i) \
        __builtin_amdgcn_global_load_lds((const unsigned*)((const char*)(gbase) + (voff)[_i]), (PG8_LAS unsigned*)(lds + (bufoff) + ldsw + _i * 8192), 16, 0, 0); } while (0)
#define PG8_LDA(dst, b, h) do { _Pragma("unroll") for (int m = 0; m < 4; ++m) _Pragma("unroll") for (int k = 0; k < 2; ++k) dst[m][k] = *(const PG8_LAS bf16x8*)(lds + PG8_SA(b, h) + aoff + m * 2048 + k * 1024); } while (0)
#define PG8_LDB(dst, b, h) do { _Pragma("unroll") for (int n = 0; n < 2; ++n) _Pragma("unroll") for (int k = 0; k < 2; ++k) dst[n][k] = *(const PG8_LAS bf16x8*)(lds + PG8_SB(b, h) + boff + n * 2048 + k * 1024); } while (0)
#define PG8_MMA(ai, bj, At, Bt) do { __builtin_amdgcn_s_setprio(1); _Pragma("unroll") for (int m = 0; m < 4; ++m) _Pragma("unroll") for (int n = 0; n < 2; ++n) _Pragma("unroll") for (int k = 0; k < 2; ++k) \
        acc[ai][bj][m][n] = __builtin_amdgcn_mfma_f32_16x16x32_bf16(Bt[n][k], At[m][k], acc[ai][bj][m][n], 0, 0, 0); __builtin_amdgcn_s_setprio(0); } while (0)
#define PG8_WAIT_V(n) asm volatile("s_waitcnt vmcnt(" #n ")" ::: "memory")
#define PG8_WAIT_L(n) asm volatile("s_waitcnt lgkmcnt(" #n ")" ::: "memory")
#define PG8_BAR __builtin_amdgcn_s_barrier()
#define PG8_SCHED __builtin_amdgcn_sched_barrier(0)
    Unit cur, nxt; int ui = 0;
    if (!S.next(0, cur)) return;
    f32x4 acc[2][2][4][2];
#pragma unroll
    for (int a = 0; a < 2; ++a)
#pragma unroll
        for (int b = 0; b < 2; ++b)
#pragma unroll
            for (int m = 0; m < 4; ++m)
#pragma unroll
                for (int n = 0; n < 2; ++n) acc[a][b][m][n] = (f32x4){0.f, 0.f, 0.f, 0.f};
    bf16x8 At[4][2], B0[2][2], B1[2][2];
    const char* cA = (const char*)g.A + (size_t)cur.pm * tstep; const char* cB = (const char*)g.Bt + (size_t)cur.pn * tstep;
    S.a_ready(cur);
    if constexpr (SP2) {
        PG8_STAGE(PG8_SB(0, 0), cB, voffB); PG8_STAGE(PG8_SB(0, 1), cB + hstep, voffB); PG8_STAGE(PG8_SA(0, 0), cA, voffA); PG8_STAGE(PG8_SA(0, 1), cA + hstep, voffA);
        if (wr == 1) PG8_BAR;
        PG8_WAIT_V(2); PG8_BAR;
        PG8_STAGE(PG8_SB(1, 0), cB + kstep, voffB); PG8_STAGE(PG8_SA(1, 0), cA + kstep, voffA); PG8_STAGE(PG8_SB(1, 1), cB + hstep + kstep, voffB);
        PG8_WAIT_V(6); PG8_BAR;
    } else {
        PG8_STAGE(PG8_SB(0, 0), cB, voffB); PG8_STAGE(PG8_SA(0, 0), cA, voffA); PG8_STAGE(PG8_SB(0, 1), cB + hstep, voffB); PG8_STAGE(PG8_SA(0, 1), cA + hstep, voffA);
        if (wr == 1) PG8_BAR;
        PG8_WAIT_V(4); PG8_BAR;
        PG8_STAGE(PG8_SB(1, 0), cB + kstep, voffB); PG8_STAGE(PG8_SA(1, 0), cA + kstep, voffA); PG8_STAGE(PG8_SB(1, 1), cB + hstep + kstep, voffB);
        PG8_WAIT_V(6); PG8_BAR;
    }
    for (;;) {
        const bool has_next = S.next(ui + 1, nxt);
        const char* nA = has_next ? (const char*)g.A + (size_t)nxt.pm * tstep : cA; const char* nB = has_next ? (const char*)g.Bt + (size_t)nxt.pn * tstep : cB;
        for (int t = 0; t < nt; t += 2) {
            const bool last = (t == nt - 2);
            const char* a1 = cA + (size_t)(t + 1) * kstep;
            const char* a2 = last ? nA : cA + (size_t)(t + 2) * kstep; const char* b2 = last ? nB : cB + (size_t)(t + 2) * kstep;
            const char* a3 = a2 + kstep; const char* b3 = b2 + kstep;
            if (last && has_next) S.a_ready(nxt);
            if constexpr (SP2) {
            PG8_LDB(B0, 0, 0); PG8_LDB(B1, 0, 1); PG8_SCHED; PG8_LDA(At, 0, 0); PG8_STAGE(PG8_SA(1, 1), a1 + hstep, voffA);
            PG8_WAIT_V(8); PG8_WAIT_L(0); PG8_BAR; PG8_MMA(0, 0, At, B0); PG8_MMA(0, 1, At, B1); PG8_BAR; PG8_SCHED;
            PG8_LDA(At, 0, 1); PG8_STAGE(PG8_SB(0, 0), b2, voffB); PG8_STAGE(PG8_SB(0, 1), b2 + hstep, voffB); PG8_STAGE(PG8_SA(0, 0), a2, voffA);
            PG8_WAIT_V(8); PG8_WAIT_L(0); PG8_BAR; PG8_MMA(1, 0, At, B0); PG8_MMA(1, 1, At, B1); PG8_BAR; PG8_SCHED;
            PG8_LDB(B0, 1, 0); PG8_LDB(B1, 1, 1); PG8_SCHED; PG8_LDA(At, 1, 0); PG8_STAGE(PG8_SA(0, 1), a2 + hstep, voffA);
            PG8_WAIT_V(8); PG8_WAIT_L(0); PG8_BAR; PG8_MMA(0, 0, At, B0); PG8_MMA(0, 1, At, B1); PG8_BAR; PG8_SCHED;
            PG8_LDA(At, 1, 1); PG8_STAGE(PG8_SB(1, 0), b3, voffB); PG8_STAGE(PG8_SB(1, 1), b3 + hstep, voffB); PG8_STAGE(PG8_SA(1, 0), a3, voffA);
            PG8_WAIT_V(8); PG8_WAIT_L(0); PG8_BAR; PG8_MMA(1, 0, At, B0); PG8_MMA(1, 1, At, B1); PG8_BAR; PG8_SCHED;
            } else {
            PG8_LDB(B0, 0, 0); PG8_SCHED; PG8_LDA(At, 0, 0); PG8_STAGE(PG8_SA(1, 1), a1 + hstep, voffA);
            PG8_WAIT_L(8); PG8_BAR; PG8_WAIT_L(0); PG8_MMA(0, 0, At, B0); PG8_BAR; PG8_SCHED;
            PG8_LDB(B1, 0, 1); PG8_STAGE(PG8_SB(0, 0), b2, voffB);
            PG8_BAR; PG8_WAIT_L(0); PG8_MMA(0, 1, At, B1); PG8_BAR;
            PG8_LDA(At, 0, 1); PG8_STAGE(PG8_SA(0, 0), a2, voffA);
            PG8_BAR; PG8_WAIT_L(0); PG8_MMA(1, 0, At, B0); PG8_BAR; PG8_SCHED;
            PG8_STAGE(PG8_SB(0, 1), b2 + hstep, voffB);
            PG8_WAIT_V(6); PG8_BAR; PG8_MMA(1, 1, At, B1); PG8_BAR;
            PG8_LDB(B0, 1, 0); PG8_SCHED; PG8_LDA(At, 1, 0); PG8_STAGE(PG8_SA(0, 1), a2 + hstep, voffA);
            PG8_WAIT_L(8); PG8_BAR; PG8_WAIT_L(0); PG8_MMA(0, 0, At, B0); PG8_BAR; PG8_SCHED;
            PG8_LDB(B1, 1, 1); PG8_STAGE(PG8_SB(1, 0), b3, voffB);
            PG8_BAR; PG8_WAIT_L(0); PG8_MMA(0, 1, At, B1); PG8_BAR;
            PG8_LDA(At, 1, 1); PG8_STAGE(PG8_SA(1, 0), a3, voffA);
            PG8_BAR; PG8_WAIT_L(0); PG8_MMA(1, 0, At, B0); PG8_BAR; PG8_SCHED;
            PG8_STAGE(PG8_SB(1, 1), b3 + hstep, voffB);
            PG8_WAIT_V(6); PG8_BAR; PG8_MMA(1, 1, At, B1); PG8_BAR;
            }
        }
        if constexpr (ALIGN_EPI) { if (wr == 0) PG8_BAR; }
        if constexpr (!Epi::AFTER_DRAIN) { E(acc, cur, wr, wc, fr, fq); S.done(cur); }
        if (!has_next) break;
#pragma unroll
        for (int a = 0; a < 2; ++a)
#pragma unroll
            for (int b = 0; b < 2; ++b)
#pragma unroll
                for (int m = 0; m < 4; ++m)
#pragma unroll
                    for (int n = 0; n < 2; ++n) acc[a][b][m][n] = (f32x4){0.f, 0.f, 0.f, 0.f};
        cur = nxt; cA = nA; cB = nB; ++ui;
        if constexpr (ALIGN_EPI) { if (wr == 1) PG8_BAR; }
    }
    PG8_WAIT_V(0);
    if constexpr (!ALIGN_EPI) { if (wr == 0) PG8_BAR; }
    PG8_BAR;
    if constexpr (Epi::AFTER_DRAIN) { E.fused(acc, cur, wr, wc, fr, fq, lds, wid, lane); S.done(cur); }
#undef PG8_SA
#undef PG8_SB
#undef PG8_STAGE
#undef PG8_LDA
#undef PG8_LDB
#undef PG8_MMA
#undef PG8_WAIT_V
#undef PG8_WAIT_L
#undef PG8_BAR
#undef PG8_SCHED
}
}
#define GAS __attribute__((address_space(1)))
#define LAS __attribute__((address_space(3)))
typedef GAS unsigned gu32;
typedef GAS unsigned long long gu64;
#define RLX_AGENT __ATOMIC_RELAXED, __HIP_MEMORY_SCOPE_AGENT
#define LDS_WAIT() asm volatile("s_waitcnt lgkmcnt(0)" ::: "memory")
#define VM_WAIT() asm volatile("s_waitcnt vmcnt(0)" ::: "memory")
__device__ __forceinline__ unsigned long long rt() { return __builtin_amdgcn_s_memrealtime(); }
#define XB_TMO      128
#define XB_XCNT(j)  (256  + 64 * (j))
#define XB_XSUB(j)  (1280 + 64 * (j))
#define XB_XGEN(j)  (2304 + 64 * (j))
#define XB_TOP      3328
#define XB_TOPGEN   3392
#define XCD_BAR_WORDS 3456
#define XB_SPIN_CAP (1u << 18)

__device__ __forceinline__ unsigned xb_ld(unsigned* p)              { return __hip_atomic_load(p, __ATOMIC_RELAXED, __HIP_MEMORY_SCOPE_AGENT); }
__device__ __forceinline__ unsigned xb_add(unsigned* p, unsigned v) { return __hip_atomic_fetch_add(p, v, __ATOMIC_RELAXED, __HIP_MEMORY_SCOPE_AGENT); }
__device__ __forceinline__ unsigned xb_xcc_id() { return (unsigned)__builtin_amdgcn_s_getreg((3 << 11) | 20) & 0xFu; }
#define XB_SPIN(cond, bar) do { unsigned _sp = 0; while (cond) { __builtin_amdgcn_s_sleep(1); \
    if ((++_sp & 255u) == 0u) { if (xb_ld(&(bar)[XB_TMO])) break; if (_sp > XB_SPIN_CAP) { atomicAdd(&(bar)[XB_TMO], 1u); break; } } } } while (0)

struct XcdBarrier {
    unsigned* bar; unsigned x;
    volatile LAS unsigned* st;
};

__device__ __forceinline__ XcdBarrier xcd_barrier_post(unsigned* bar, volatile LAS unsigned* st) {
    XcdBarrier b; b.bar = bar; b.x = xb_xcc_id(); b.st = st;
    if (threadIdx.x == 0) (void)xb_add(&bar[XB_XCNT(b.x)], 1u);
    return b;
}
__device__ __forceinline__ void xcd_barrier_complete(unsigned* bar, unsigned x, unsigned& nloc, unsigned& nx) {
    const unsigned G = gridDim.x * gridDim.y * gridDim.z;
    unsigned sum, cnt, mine, sp = 0u;
    for (;;) {
        sum = 0u; cnt = 0u; mine = 0u;
#pragma unroll
        for (unsigned j = 0; j < 16; ++j) { const unsigned c = xb_ld(&bar[XB_XCNT(j)]); sum += c; cnt += (c > 0u) ? 1u : 0u; mine = (j == x) ? c : mine; }
        if (sum == G) break;
        __builtin_amdgcn_s_sleep(1);
        if ((++sp & 255u) == 0u) { if (xb_ld(&bar[XB_TMO])) break; if (sp > XB_SPIN_CAP) { atomicAdd(&bar[XB_TMO], 1u); break; } }
    }
    nloc = mine > 0u ? mine : 1u; nx = cnt > 0u ? cnt : 1u;
}

__device__ __forceinline__ void xcd_barrier(const XcdBarrier& b) {
    asm volatile("s_waitcnt vmcnt(0)" ::: "memory");
    __syncthreads();
    if (threadIdx.x == 0) {
        unsigned* bar = b.bar;
        __builtin_amdgcn_s_waitcnt(0);
        unsigned nloc = b.st[0], nx = b.st[1];
        if (nloc == 0u) { xcd_barrier_complete(bar, b.x, nloc, nx); b.st[0] = nloc; b.st[1] = nx; }
        const unsigned old = xb_add(&bar[XB_XSUB(b.x)], 1u);
        const unsigned gen = old / nloc;
        if (old + 1u == (gen + 1u) * nloc) {
            __builtin_amdgcn_fence(__ATOMIC_RELEASE, "agent");
            asm volatile("s_waitcnt vmcnt(0)" ::: "memory");
            const unsigned og = xb_add(&bar[XB_TOP], 1u);
            const unsigned tg = og / nx;
            if (og + 1u == (tg + 1u) * nx) xb_add(&bar[XB_TOPGEN], 1u);
            else XB_SPIN(xb_ld(&bar[XB_TOPGEN]) == tg, bar);
            __builtin_amdgcn_fence(__ATOMIC_ACQUIRE, "agent");
            xb_add(&bar[XB_XGEN(b.x)], 1u);
            asm volatile("s_waitcnt vmcnt(0)" ::: "memory");
        } else {
            XB_SPIN(xb_ld(&bar[XB_XGEN(b.x)]) == gen, bar);
            __builtin_amdgcn_fence(__ATOMIC_ACQUIRE, "agent");
            asm volatile("s_waitcnt vmcnt(0)" ::: "memory");
        }
    }
    __syncthreads();
}


constexpr int NB = 2, SEQ = 8192, DM = 1024, DEPTH = 4, NMETA = 16, LP = 8320, M = NB * LP;
constexpr int N_IN = 5384, N1 = 5376, NRW = 1792, NGT = 2048, DFF = 2816, NUP = 5632;
constexpr float LOG2E = 1.4426950408889634f;
constexpr float QSCALE = 0.125f * LOG2E;
constexpr float THR2 = 30.0f * LOG2E;
constexpr int NWAVES = 8, NTHR = 512, MMAIN = 16384;
constexpr int LDS_BYTES = 147456, MISC_OFF = 147456 - 128;

typedef unsigned short bf16;
typedef float f32x4 __attribute__((ext_vector_type(4)));
typedef unsigned u32x4 __attribute__((ext_vector_type(4)));
typedef unsigned u32x2 __attribute__((ext_vector_type(2)));
typedef short bf16x8 __attribute__((ext_vector_type(8)));

constexpr size_t SZ_H = (size_t)M * DM * 4, SZ_X512 = (size_t)M * 512 * 2;
constexpr size_t OFF_CTL = 0, OFF_H = 1u << 20, OFF_WT = OFF_H + SZ_H;
constexpr size_t WT_IN = 0, WT_BF = WT_IN + (size_t)N1 * 1024, WT_BR = WT_BF + 1024 * 512, WT_O = WT_BR + 1024 * 512,
                 WT_UP = WT_O + 1024 * 1024, WT_DN = WT_UP + (size_t)NUP * 1024, WT_LW = WT_DN + (size_t)1024 * DFF, WT_LA = WT_LW + 512 * 64, WT_LG = WT_LA + 512 * 64, WT_END = WT_LG + 512 * 128;
constexpr size_t OFF_HN = OFF_WT + WT_END * 2;
constexpr size_t OFF_Q = OFF_HN + 2 * SZ_X512, OFF_K = OFF_Q + SZ_X512, OFF_V = OFF_K + SZ_X512;
constexpr size_t OFF_RW = OFF_V + SZ_X512, OFF_GT = OFF_RW + (size_t)M * NRW * 2, OFF_MISC = OFF_GT + (size_t)M * NGT * 2;
constexpr size_t OFF_T0 = OFF_MISC + 2 * 16 * LP * 4, OFF_OF = OFF_T0 + 2 * SZ_X512, WS_NEED = OFF_OF + SZ_X512;
static_assert(OFF_HN % 256 == 0 && OFF_RW % 256 == 0 && OFF_T0 % 256 == 0, "alignment");

struct Params { const float* in[26]; float* out; unsigned char* ws; };
struct Ctx { int tid, lane, wave, bid, G; unsigned char* lds; unsigned char* ws; };

__device__ __forceinline__ float bf2f(unsigned b) { return __uint_as_float(b << 16); }
__device__ __forceinline__ float bflo(unsigned w) { return __uint_as_float(w << 16); }
__device__ __forceinline__ float bfhi(unsigned w) { return __uint_as_float(w & 0xffff0000u); }
typedef float f32x2_t_ __attribute__((ext_vector_type(2))); typedef __bf16 bf16x2_t_ __attribute__((ext_vector_type(2)));
__device__ __forceinline__ unsigned pk2(float lo, float hi) { const f32x2_t_ v = {lo, hi}; const bf16x2_t_ r = __builtin_convertvector(v, bf16x2_t_); return __builtin_bit_cast(unsigned, r); }
__device__ __forceinline__ unsigned f2bf(float f) { return pk2(f, 0.f) & 0xffffu; }
__device__ __forceinline__ float wave_sum(float v) {
#pragma unroll
    for (int o = 1; o < 64; o <<= 1) v += __shfl_xor(v, o);
    return v;
}
__device__ __forceinline__ float sigmoidf_(float x) { return __builtin_amdgcn_rcpf(1.f + __expf(-x)); }
template <int CTRL> __device__ __forceinline__ float dppf(float old, float x) {
    return __int_as_float(__builtin_amdgcn_update_dpp(__float_as_int(old), __float_as_int(x), CTRL, 0xf, 0xf, false));
}
__device__ __forceinline__ float allreduce16(float x) {
    x += dppf<0x121>(0.f, x); x += dppf<0x122>(0.f, x); x += dppf<0x124>(0.f, x); x += dppf<0x128>(0.f, x); return x;
}

namespace pg8 {
struct EpiRoute {
    static constexpr bool PERM = true, AFTER_DRAIN = false;
    unsigned char* ws;
    __device__ __forceinline__ void operator()(const f32x4 (&acc)[2][2][4][2], const Unit& u, int wr, int wc, int fr, int fq) const {
        const int pn = u.pn; size_t off; int ldc, colt;
        if (pn < 6) { off = OFF_Q + (size_t)(pn >> 1) * SZ_X512; ldc = 512; colt = (pn & 1) * 256; }
        else if (pn < 13) { off = OFF_RW; ldc = NRW; colt = (pn - 6) * 256; }
        else { off = OFF_GT; ldc = NGT; colt = (pn - 13) * 256; }
        bf16_t* base = (bf16_t*)(ws + off);
        const int row0 = u.pm * BM + wr * 64 + fr, col0 = colt + wc * 32 + 8 * fq;
#pragma unroll
        for (int ai = 0; ai < 2; ++ai)
#pragma unroll
            for (int m = 0; m < 4; ++m) { bf16_t* rowp = base + (size_t)(row0 + ai * HALF + m * 16) * ldc + col0;
#pragma unroll
                for (int bj = 0; bj < 2; ++bj) { const f32x4 v0 = acc[ai][bj][m][0], v1 = acc[ai][bj][m][1];
                    u32x4 w; w.x = cvt_pk_bf16(v0[0], v0[1]); w.y = cvt_pk_bf16(v0[2], v0[3]); w.z = cvt_pk_bf16(v1[0], v1[1]); w.w = cvt_pk_bf16(v1[2], v1[3]);
                    *(u32x4*)(rowp + bj * HALF) = w; } }
    }
};
template <int MODE> struct EpiGate {
    static constexpr bool PERM = true, AFTER_DRAIN = false;
    bf16_t* O; const bf16_t* GT; const float* gb;
    __device__ __forceinline__ void operator()(const f32x4 (&acc)[2][2][4][2], const Unit& u, int wr, int wc, int fr, int fq) const {
        const int row0 = u.pm * BM + wr * 64 + fr, col0 = u.pn * BM + wc * 32 + 8 * fq;
#pragma unroll
        for (int bj = 0; bj < 2; ++bj) {
            const int c = col0 + bj * HALF;
            const f32x4 b0 = *(const f32x4*)(gb + MODE * 1024 + c), b1 = *(const f32x4*)(gb + MODE * 1024 + c + 4);
#pragma unroll
            for (int ai = 0; ai < 2; ++ai)
#pragma unroll
                for (int m = 0; m < 4; ++m) {
                    const size_t row = (size_t)(row0 + ai * HALF + m * 16);
                    const u32x4 gw = *(const u32x4*)(GT + row * NGT + MODE * 1024 + c);
                    const f32x4 v0 = acc[ai][bj][m][0], v1 = acc[ai][bj][m][1];
                    float r[8];
                    r[0] = sigmoidf_(bflo(gw.x) + b0[0]) * v0[0]; r[1] = sigmoidf_(bfhi(gw.x) + b0[1]) * v0[1];
                    r[2] = sigmoidf_(bflo(gw.y) + b0[2]) * v0[2]; r[3] = sigmoidf_(bfhi(gw.y) + b0[3]) * v0[3];
                    r[4] = sigmoidf_(bflo(gw.z) + b1[0]) * v1[0]; r[5] = sigmoidf_(bfhi(gw.z) + b1[1]) * v1[1];
                    r[6] = sigmoidf_(bflo(gw.w) + b1[2]) * v1[2]; r[7] = sigmoidf_(bfhi(gw.w) + b1[3]) * v1[3];
                    bf16_t* op = O + row * 1024 + c;
                    if (MODE == 1) { const u32x4 ow = *(const u32x4*)op;
                        r[0] += bflo(ow.x); r[1] += bfhi(ow.x); r[2] += bflo(ow.y); r[3] += bfhi(ow.y); r[4] += bflo(ow.z); r[5] += bfhi(ow.z); r[6] += bflo(ow.w); r[7] += bfhi(ow.w); }
                    u32x4 w; w.x = cvt_pk_bf16(r[0], r[1]); w.y = cvt_pk_bf16(r[2], r[3]); w.z = cvt_pk_bf16(r[4], r[5]); w.w = cvt_pk_bf16(r[6], r[7]);
                    *(u32x4*)op = w;
                }
        }
    }
};
struct EpiResid {
    static constexpr bool PERM = false, AFTER_DRAIN = false;
    float* H; float* OUT; int atomic;
    __device__ __forceinline__ void operator()(const f32x4 (&acc)[2][2][4][2], const Unit& u, int wr, int wc, int fr, int fq) const {
        const int row0 = u.pm * BM + wr * 64 + fr, col0 = u.pn * BM + wc * 32 + 4 * fq;
#pragma unroll
        for (int ai = 0; ai < 2; ++ai)
#pragma unroll
            for (int m = 0; m < 4; ++m) {
                const int row = row0 + ai * HALF + m * 16;
                float* hp = H + (size_t)row * DM + col0;
                const int b = row >= LP ? 1 : 0, t = row - b * LP;
                float* op = (OUT && t >= NMETA && t < NMETA + SEQ) ? OUT + ((size_t)b * SEQ + (t - NMETA)) * DM + col0 : nullptr;
#pragma unroll
                for (int bj = 0; bj < 2; ++bj)
#pragma unroll
                    for (int n = 0; n < 2; ++n) { const int co = bj * HALF + n * 16;
                        if (atomic) {
#pragma unroll
                            for (int e = 0; e < 4; ++e) unsafeAtomicAdd(hp + co + e, acc[ai][bj][m][n][e]);
                        } else {
                            const f32x4 v = *(const f32x4*)(hp + co) + acc[ai][bj][m][n];
                            if (OUT) { if (op) *(f32x4*)(op + co) = v; } else *(f32x4*)(hp + co) = v; } }
            }
    }
};
struct EpiResidAtomic {
    static constexpr bool PERM = false, AFTER_DRAIN = false;
    float* H;
    __device__ __forceinline__ void operator()(const f32x4 (&acc)[2][2][4][2], const Unit& u, int wr, int wc, int fr, int fq) const {
        const int row0 = u.pm * BM + wr * 64 + fr, col0 = u.pn * BM + wc * 32 + 4 * fq;
#pragma unroll
        for (int ai = 0; ai < 2; ++ai)
#pragma unroll
            for (int m = 0; m < 4; ++m) { float* hp = H + (size_t)(row0 + ai * HALF + m * 16) * DM + col0;
#pragma unroll
                for (int bj = 0; bj < 2; ++bj)
#pragma unroll
                    for (int n = 0; n < 2; ++n)
#pragma unroll
                        for (int e = 0; e < 4; ++e) unsafeAtomicAdd(hp + bj * HALF + n * 16 + e, acc[ai][bj][m][n][e]); }
    }
};
struct OneUnit {
    StaticOrder so; int mode, pm, pn; bool active;
    __device__ bool next(int i, Unit& u) const { if (mode == 0) return so.next(i, u); if (i != 0 || !active) return false; u.pm = pm; u.pn = pn; return true; }
    __device__ __forceinline__ void a_ready(const Unit&) const {}
    __device__ __forceinline__ void done(const Unit&) const {}
};
struct EpiUp {
    static constexpr bool PERM = true, AFTER_DRAIN = false;
    bf16_t* ACT; bf16_t* HALO; const float* cw;
    __device__ __forceinline__ void operator()(const f32x4 (&acc)[2][2][4][2], const Unit& u, int wr, int wc, int fr, int fq) const {
        const int chan0 = u.pn * 128 + wc * 32 + 8 * fq;
#pragma unroll
        for (int n = 0; n < 2; ++n) {
            const int ch = chan0 + 4 * n;
            f32x4 w[3][2];
#pragma unroll
            for (int j = 0; j < 3; ++j) { w[j][0] = *(const f32x4*)(cw + j * NUP + ch); w[j][1] = *(const f32x4*)(cw + j * NUP + DFF + ch); }
#pragma unroll
            for (int ai = 0; ai < 2; ++ai) {
                const int rowg = u.pm * BM + ai * HALF + wr * 64;
#pragma unroll
                for (int m = 0; m < 4; ++m) {
                    f32x4 uc[2];
#pragma unroll
                    for (int bj = 0; bj < 2; ++bj) {
                        const f32x4 cur = acc[ai][bj][m][n];
                        f32x4 prv; if (m > 0) prv = acc[ai][bj][m - 1][n]; else prv = (f32x4){0.f, 0.f, 0.f, 0.f};
                        f32x4 p1, p2;
#pragma unroll
                        for (int i = 0; i < 4; ++i) {
                            const float r1 = dppf<0x121>(0.f, prv[i]), r2 = dppf<0x122>(0.f, prv[i]);
                            p1[i] = dppf<0x111>(r1, cur[i]); p2[i] = dppf<0x112>(r2, cur[i]);
                        }
                        uc[bj] = w[0][bj] * p2 + w[1][bj] * p1 + w[2][bj] * cur;
                    }
                    float a[4];
#pragma unroll
                    for (int i = 0; i < 4; ++i) a[i] = uc[0][i] * sigmoidf_(uc[0][i]) * uc[1][i];
                    u32x2 o; o.x = cvt_pk_bf16(a[0], a[1]); o.y = cvt_pk_bf16(a[2], a[3]);
                    *(u32x2*)(ACT + (size_t)(rowg + m * 16 + fr) * DFF + ch) = o;
                    if ((m == 3 && fr >= 14) || (m == 0 && fr < 2)) {
                        const int slot = (rowg >> 6) * 4 + (m == 3 ? fr - 14 : 2 + fr);
#pragma unroll
                        for (int bj = 0; bj < 2; ++bj) { const f32x4 cur = acc[ai][bj][m][n]; u32x2 hw; hw.x = cvt_pk_bf16(cur[0], cur[1]); hw.y = cvt_pk_bf16(cur[2], cur[3]);
                            *(u32x2*)(HALO + (size_t)slot * NUP + bj * DFF + ch) = hw; }
                    }
                }
            }
        }
    }
};
}

#ifndef REP_PREP
#define REP_PREP 1
#endif
#ifndef REP_P3
#define REP_P3 1
#endif
#ifndef REP_SYNC
#define REP_SYNC 0
#endif
#define GLD(T, p) (*(const __attribute__((address_space(1))) T*)(p))
#define GST(T, p) (*(__attribute__((address_space(1))) T*)(p))
#define LDS_BARRIER() do { asm volatile("s_waitcnt lgkmcnt(0)" ::: "memory"); __builtin_amdgcn_s_barrier(); asm volatile("" ::: "memory"); } while (0)
__device__ __forceinline__ void transpose_item(const float* W, int Nsrc, int K, bf16* WT, int dst_row0, int src_col0, int k0, float* scr, int lane) {
#pragma unroll 8
    for (int i = 0; i < 32; ++i) { const int kk = 2 * i + (lane >> 5); scr[kk * 33 + (lane & 31)] = W[(size_t)(k0 + kk) * Nsrc + src_col0 + (lane & 31)]; }
    asm volatile("s_waitcnt lgkmcnt(0)" ::: "memory");
    const int c = lane & 7;
#pragma unroll
    for (int j = 0; j < 4; ++j) { const int n = (lane >> 3) + 8 * j; const float* s = scr + (8 * c) * 33 + n;
        u32x4 o; o.x = pk2(s[0 * 33], s[1 * 33]); o.y = pk2(s[2 * 33], s[3 * 33]); o.z = pk2(s[4 * 33], s[5 * 33]); o.w = pk2(s[6 * 33], s[7 * 33]);
        *(u32x4*)(WT + (size_t)(dst_row0 + n) * K + k0 + 8 * c) = o; }
    asm volatile("s_waitcnt lgkmcnt(0)" ::: "memory");
}
__device__ __forceinline__ void convert_weights(const Params& P, int l, const Ctx& c) {
    bf16* WT = (bf16*)(c.ws + OFF_WT);
    float* scr = (float*)(c.lds + c.wave * 16384);
    const int gw = c.bid * NWAVES + c.wave, NGW = c.G * NWAVES;
    constexpr int I_IN = 16 * 168, I_BF = 8 * 32, I_O = 16 * 32, I_UP = 16 * 176, I_DN = 44 * 32, I_LR = 16, I_LG = 32, I_ALL = I_IN + 2 * I_BF + I_O + I_UP + I_DN + 2 * I_LR + I_LG;
    for (int it = gw; it < I_ALL; it += NGW) {
        int r = it;
        if (r < I_IN) { const int kb = r / 168, n0 = 32 * (r % 168); transpose_item(P.in[4] + (size_t)l * 1024 * N_IN, N_IN, 1024, WT + WT_IN, n0, n0 + (n0 >= 1536 ? 8 : 0), 64 * kb, scr, c.lane); continue; } r -= I_IN;
        if (r < I_BF) { const int kb = r / 32, n0 = 32 * (r % 32); transpose_item(P.in[19] + (size_t)l * 512 * 1024, 1024, 512, WT + WT_BF, n0, n0, 64 * kb, scr, c.lane); continue; } r -= I_BF;
        if (r < I_BF) { const int kb = r / 32, n0 = 32 * (r % 32); transpose_item(P.in[20] + (size_t)l * 512 * 1024, 1024, 512, WT + WT_BR, n0, n0, 64 * kb, scr, c.lane); continue; } r -= I_BF;
        if (r < I_O) { const int kb = r / 32, n0 = 32 * (r % 32); transpose_item(P.in[22] + (size_t)l * 1024 * 1024, 1024, 1024, WT + WT_O, n0, n0, 64 * kb, scr, c.lane); continue; } r -= I_O;
        if (r < I_UP) { const int kb = r / 176, n0 = 32 * (r % 176); const int pn = n0 >> 8, bj = (n0 >> 7) & 1, x = n0 & 127;
            transpose_item(P.in[23] + (size_t)l * 1024 * NUP, NUP, 1024, WT + WT_UP, n0, bj * DFF + 128 * pn + x, 64 * kb, scr, c.lane); continue; } r -= I_UP;
        if (r < I_DN) { const int kb = r / 32, n0 = 32 * (r % 32); transpose_item(P.in[25] + (size_t)l * DFF * 1024, 1024, DFF, WT + WT_DN, n0, n0, 64 * kb, scr, c.lane); continue; } r -= I_DN;
        if (r < I_LR) { transpose_item(P.in[10] + (size_t)l * 64 * 512, 512, 64, WT + WT_LW, 32 * r, 32 * r, 0, scr, c.lane); continue; } r -= I_LR;
        if (r < I_LR) { transpose_item(P.in[12] + (size_t)l * 64 * 512, 512, 64, WT + WT_LA, 32 * r, 32 * r, 0, scr, c.lane); continue; } r -= I_LR;
        { const int kb = r / 16, n0 = 32 * (r % 16); transpose_item(P.in[13] + (size_t)l * 128 * 512, 512, 128, WT + WT_LG, n0, n0, 64 * kb, scr, c.lane); }
    }
}

template <bool FG> __device__ __forceinline__ void phase_norm(const Params& P, int l, const Ctx& c) {
    float* H = (float*)(c.ws + OFF_H); bf16* HN = (bf16*)(c.ws + OFF_HN);
    float* LOGF = (float*)(c.ws + OFF_MISC);
    const float* gain = (FG ? P.in[2] : P.in[3]) + l * DM;
    float* wfs = (float*)c.lds;
    if (FG) {
        __syncthreads();
        const float* win = P.in[4] + (size_t)l * 1024 * N_IN + 1536;
        for (int i = c.tid; i < 8192; i += NTHR) wfs[i] = win[(size_t)(i >> 3) * N_IN + (i & 7)];
        __syncthreads();
    }
    const int gw = c.bid * NWAVES + c.wave, NGW = c.G * NWAVES;
    for (int m = gw; m < M; m += NGW) {
        const int b = m >= LP ? 1 : 0, t = m - b * LP;
        f32x4 v[4];
        if (FG && l == 0) {
            const float* src = (t < NMETA) ? P.in[1] + (size_t)t * DM : P.in[0] + ((size_t)b * SEQ + (t - NMETA)) * DM;
            const bool real = t < NMETA + SEQ;
#pragma unroll
            for (int j = 0; j < 4; ++j) { v[j] = real ? *(const f32x4*)(src + 4 * c.lane + 256 * j) : (f32x4){0.f, 0.f, 0.f, 0.f}; *(f32x4*)(H + (size_t)m * DM + 4 * c.lane + 256 * j) = v[j]; }
        } else {
#pragma unroll
            for (int j = 0; j < 4; ++j) v[j] = *(const f32x4*)(H + (size_t)m * DM + 4 * c.lane + 256 * j);
        }
        float ss = 0.f;
#pragma unroll
        for (int j = 0; j < 4; ++j) ss += (v[j].x * v[j].x + v[j].y * v[j].y) + (v[j].z * v[j].z + v[j].w * v[j].w);
        const float rstd = 1.0f / sqrtf(wave_sum(ss) * (1.f / DM) + 1e-6f);
        float f[8];
#pragma unroll
        for (int q = 0; q < 8; ++q) f[q] = 0.f;
#pragma unroll
        for (int j = 0; j < 4; ++j) {
            const f32x4 g = *(const f32x4*)(gain + 4 * c.lane + 256 * j);
            v[j] = v[j] * rstd * g;
            u32x2 o; o.x = pk2(v[j].x, v[j].y); o.y = pk2(v[j].z, v[j].w);
            *(u32x2*)(HN + (size_t)m * DM + 4 * c.lane + 256 * j) = o;
            if (FG) {
#pragma unroll
                for (int e = 0; e < 4; ++e) { const int k = 4 * c.lane + 256 * j + e; const f32x4 w0 = *(const f32x4*)(wfs + k * 8), w1 = *(const f32x4*)(wfs + k * 8 + 4);
                    const float hv = v[j][e];
                    f[0] += hv * w0.x; f[1] += hv * w0.y; f[2] += hv * w0.z; f[3] += hv * w0.w; f[4] += hv * w1.x; f[5] += hv * w1.y; f[6] += hv * w1.z; f[7] += hv * w1.w; }
            }
        }
        if (FG) {
#pragma unroll
            for (int q = 0; q < 8; ++q) f[q] = wave_sum(f[q]);
            float fv = f[0];
#pragma unroll
            for (int q = 1; q < 8; ++q) fv = (c.lane == q) ? f[q] : fv;
            if (c.lane < 8) { const float x = fv + P.in[7][l * 8 + c.lane]; const float ls = fminf(x, 0.f) - __logf(1.f + __expf(-fabsf(x))); LOGF[(size_t)(b * 8 + c.lane) * LP + t] = ls; }
        }
    }
}

__device__ __forceinline__ void phase_fcum(const Params& P, const Ctx& c) {
    if (c.bid < 16 && c.wave == 0) {
        const float* LOGF = (const float*)(c.ws + OFF_MISC) + (size_t)c.bid * LP; float* FC = (float*)(c.ws + OFF_MISC) + 16 * LP + (size_t)c.bid * LP;
        float carry = 0.f;
        for (int ch = 0; ch < LP / 64; ++ch) {
            float v = LOGF[ch * 64 + c.lane];
#pragma unroll
            for (int o = 1; o < 64; o <<= 1) { const float t = __shfl_up(v, o); if (c.lane >= o) v += t; }
            v += carry; FC[ch * 64 + c.lane] = v * LOG2E; carry = __shfl(v, 63);
        }
    }
}

__device__ __forceinline__ void phase_qknorm(const Params& P, int l, const Ctx& c) {
    bf16* Q = (bf16*)(c.ws + OFF_Q); bf16* K = (bf16*)(c.ws + OFF_K);
    const int gw = c.bid * NWAVES + c.wave, NGW = c.G * NWAVES;
    const int d0 = (c.lane & 7) * 8;
    float gq[8], gk[8];
#pragma unroll
    for (int i = 0; i < 8; ++i) { gq[i] = P.in[5][l * 64 + d0 + i] * QSCALE; gk[i] = P.in[6][l * 64 + d0 + i]; }
    for (int m = gw; m < M; m += NGW) {
#pragma unroll
        for (int which = 0; which < 2; ++which) {
            bf16* p = (which ? K : Q) + (size_t)m * 512 + 8 * c.lane;
            const u32x4 w = *(const u32x4*)p;
            float x[8] = {bflo(w.x), bfhi(w.x), bflo(w.y), bfhi(w.y), bflo(w.z), bfhi(w.z), bflo(w.w), bfhi(w.w)};
            float ss = 0.f;
#pragma unroll
            for (int i = 0; i < 8; ++i) ss += x[i] * x[i];
            ss += __shfl_xor(ss, 1); ss += __shfl_xor(ss, 2); ss += __shfl_xor(ss, 4);
            const float rs = 1.0f / sqrtf(ss * (1.f / 64.f) + 1e-6f);
#pragma unroll
            for (int i = 0; i < 8; ++i) x[i] = x[i] * rs * (which ? gk[i] : gq[i]);
            u32x4 o; o.x = pk2(x[0], x[1]); o.y = pk2(x[2], x[3]); o.z = pk2(x[4], x[5]); o.w = pk2(x[6], x[7]);
            *(u32x4*)p = o;
        }
    }
}

constexpr int NCHK = LP / 64;
constexpr int NUNIT = NB * NCHK * 8;
constexpr int UNIT_A = 16384, UNIT_B = 16640;
constexpr int ST = 72, STG = 136;
constexpr int L_F0 = 92160, L_F1 = 108544;
struct RwkvBufs { bf16 *BON, *G; unsigned char *UA, *UB; float* Y; bf16* ORW; };
__device__ __forceinline__ RwkvBufs rwkv_bufs(const Params& P, const Ctx& c) {
    RwkvBufs r; r.BON = (bf16*)(c.ws + OFF_HN); r.G = r.BON + (size_t)M * 512;
    r.UA = c.ws + OFF_T0; r.UB = (unsigned char*)P.out;
    r.Y = (float*)(c.ws + OFF_RW); r.ORW = (bf16*)(c.ws + OFF_RW + (size_t)M * 512 * 4);
    return r;
}
__device__ __forceinline__ void mm_tile(const bf16* A, int sa, const bf16* Bt, int sb, int nks, f32x4 (&acc)[2], int w, int lq, int g) {
    const int mt = w >> 1, nt0 = 2 * (w & 1);
    for (int ks = 0; ks < nks; ++ks) {
        const bf16x8 a = *(const bf16x8*)(A + (16 * mt + lq) * sa + 32 * ks + 8 * g);
#pragma unroll
        for (int q = 0; q < 2; ++q) { const bf16x8 b = *(const bf16x8*)(Bt + (16 * (nt0 + q) + lq) * sb + 32 * ks + 8 * g); acc[q] = __builtin_amdgcn_mfma_f32_16x16x32_bf16(a, b, acc[q], 0, 0, 0); }
    }
}
#define ZACC(a) do { a[0] = (f32x4){0.f, 0.f, 0.f, 0.f}; a[1] = (f32x4){0.f, 0.f, 0.f, 0.f}; } while (0)
__device__ __forceinline__ int permk(int k) { return 32 * (k >> 5) + 8 * ((k & 15) >> 2) + 4 * ((k >> 4) & 1) + (k & 3); }
__device__ __forceinline__ int swz(int row, int col) { return row * 128 + ((((col >> 3) ^ (row >> 1)) & 7) << 4) + (col & 7) * 2; }

__device__ __forceinline__ void rwkv_prep_unit(const Params& P, int l, const Ctx& c, int u, const RwkvBufs& B) {
    const int h = u & 7, bc = u >> 3, b = bc / NCHK, ch = bc - b * NCHK;
    const size_t m0 = (size_t)b * LP + ch * 64;
    int tid_ = c.tid; asm volatile("" : "+v"(tid_));
    const int tid = tid_, lane = tid & 63, w = c.wave, lq = lane & 15, g = lane >> 4;
    const int t = tid >> 3, cg = tid & 7, c0 = cg * 8, jb = h * 64 + c0;
    unsigned char* L = c.lds;
    bf16* A0 = (bf16*)L; bf16* A1 = A0 + 4608; bf16* A2 = A1 + 4608; bf16* A3 = A2 + 4608; bf16* A4 = A3 + 4608; bf16* A5 = A4 + 4608; bf16* A6 = A5 + 4608;
    bf16* A7 = A6 + 4608; bf16* A8 = A7 + 4608; bf16* A9 = A8 + 4608;
    float* F0 = (float*)(L + L_F0); float* F1 = (float*)(L + L_F1);
    const bf16* RW = (const bf16*)(c.ws + OFF_RW);
    const bf16* WT = (const bf16*)(c.ws + OFF_WT);
    const float* mu = P.in[8] + l * NRW;
    const bool first = (ch == 0 && t == 0);
    const bf16* cur = RW + (m0 + t) * NRW; const bf16* prv = cur - NRW;
    float zr[8], zk[8], zv[8];
#pragma unroll
    for (int s = 0; s < 3; ++s) {
        const u32x4 cw = *(const u32x4*)(cur + s * 512 + jb); u32x4 pw = (u32x4){0u, 0u, 0u, 0u}; if (!first) pw = *(const u32x4*)(prv + s * 512 + jb);
        const float cv[8] = {bflo(cw.x), bfhi(cw.x), bflo(cw.y), bfhi(cw.y), bflo(cw.z), bfhi(cw.z), bflo(cw.w), bfhi(cw.w)};
        const float pv[8] = {bflo(pw.x), bfhi(pw.x), bflo(pw.y), bfhi(pw.y), bflo(pw.z), bfhi(pw.z), bflo(pw.w), bfhi(pw.w)};
#pragma unroll
        for (int i = 0; i < 8; ++i) { const float z = cv[i] + mu[s * 512 + jb + i] * (pv[i] - cv[i]); if (s == 0) zr[i] = z; else if (s == 1) zk[i] = z; else zv[i] = z; }
    }
#pragma unroll
    for (int q4 = 0; q4 < 4; ++q4) {
        const int col = cg * 32 + q4 * 8;
        const u32x4 cw = *(const u32x4*)(cur + 1536 + col); u32x4 pw = (u32x4){0u, 0u, 0u, 0u}; if (!first) pw = *(const u32x4*)(prv + 1536 + col);
        const float cv[8] = {bflo(cw.x), bfhi(cw.x), bflo(cw.y), bfhi(cw.y), bflo(cw.z), bfhi(cw.z), bflo(cw.w), bfhi(cw.w)};
        const float pv[8] = {bflo(pw.x), bfhi(pw.x), bflo(pw.y), bfhi(pw.y), bflo(pw.z), bfhi(pw.z), bflo(pw.w), bfhi(pw.w)};
        float z[8];
#pragma unroll
        for (int i = 0; i < 8; ++i) { z[i] = cv[i] + mu[1536 + col + i] * (pv[i] - cv[i]); if (col < 64) z[i] = 1.f - 2.f / (1.f + __expf(2.f * z[i])); else if (col >= 128) z[i] = sigmoidf_(z[i]); }
        u32x4 o; o.x = pk2(z[0], z[1]); o.y = pk2(z[2], z[3]); o.z = pk2(z[4], z[5]); o.w = pk2(z[6], z[7]);
        bf16* dst = (col < 64) ? A0 + t * ST + col : (col < 128 ? A1 + t * ST + (col - 64) : A2 + t * STG + (col - 128));
        *(u32x4*)dst = o;
    }
    { const int row = tid >> 3, chk = tid & 7;
      *(u32x4*)(A4 + row * ST + chk * 8) = *(const u32x4*)(WT + WT_LW + (size_t)(h * 64 + row) * 64 + chk * 8);
      *(u32x4*)(A5 + row * ST + chk * 8) = *(const u32x4*)(WT + WT_LA + (size_t)(h * 64 + row) * 64 + chk * 8);
#pragma unroll
      for (int i = 0; i < 2; ++i) { const int idx = tid + 512 * i, r2 = idx >> 4, c2 = idx & 15;
          *(u32x4*)((bf16*)F1 + r2 * STG + c2 * 8) = *(const u32x4*)(WT + WT_LG + (size_t)(h * 64 + r2) * 128 + c2 * 8); } }
    LDS_BARRIER();
    { f32x4 aw[2], aa[2], ag[2]; ZACC(aw); ZACC(aa); ZACC(ag);
      mm_tile(A0, ST, A4, ST, 2, aw, w, lq, g); mm_tile(A1, ST, A5, ST, 2, aa, w, lq, g); mm_tile(A2, STG, (const bf16*)F1, STG, 4, ag, w, lq, g);
      const int mt = w >> 1, nt0 = 2 * (w & 1);
#pragma unroll
      for (int q = 0; q < 2; ++q)
#pragma unroll
          for (int j = 0; j < 4; ++j) { const int o = (16 * mt + 4 * g + j) * ST + 16 * (nt0 + q) + lq; A7[o] = (bf16)f2bf(aw[q][j]); A8[o] = (bf16)f2bf(aa[q][j]); A9[o] = (bf16)f2bf(ag[q][j]); } }
    LDS_BARRIER();
    float kk[8], k2[8], ar[8];
    { const u32x4 lw = *(const u32x4*)(A7 + t * ST + c0), la = *(const u32x4*)(A8 + t * ST + c0), lg = *(const u32x4*)(A9 + t * ST + c0);
      const float fw[8] = {bflo(lw.x), bfhi(lw.x), bflo(lw.y), bfhi(lw.y), bflo(lw.z), bfhi(lw.z), bflo(lw.w), bfhi(lw.w)};
      const float fa[8] = {bflo(la.x), bfhi(la.x), bflo(la.y), bfhi(la.y), bflo(la.z), bfhi(la.z), bflo(la.w), bfhi(la.w)};
      float ss = 0.f, bs = 0.f;
#pragma unroll
      for (int i = 0; i < 8; ++i) { const int j = l * 512 + jb + i;
          const float xw = -(P.in[9][j] + fw[i]); const float sp = fmaxf(xw, 0.f) + __logf(1.f + __expf(-fabsf(xw)));
          F0[t * 64 + c0 + i] = __expf(-sp - 0.5f);
          ar[i] = sigmoidf_(P.in[11][j] + fa[i]);
          kk[i] = zk[i] * P.in[14][j]; ss += kk[i] * kk[i];
          k2[i] = zk[i] * (1.f + (ar[i] - 1.f) * P.in[15][j]);
          bs += zr[i] * k2[i] * P.in[16][j]; }
      ss += __shfl_xor(ss, 1); ss += __shfl_xor(ss, 2); ss += __shfl_xor(ss, 4);
      bs += __shfl_xor(bs, 1); bs += __shfl_xor(bs, 2); bs += __shfl_xor(bs, 4);
      const float inv = 1.0f / fmaxf(sqrtf(ss), 1e-12f);
#pragma unroll
      for (int i = 0; i < 8; ++i) kk[i] *= inv;
      u32x4 bo; bo.x = pk2(bs * zv[0], bs * zv[1]); bo.y = pk2(bs * zv[2], bs * zv[3]); bo.z = pk2(bs * zv[4], bs * zv[5]); bo.w = pk2(bs * zv[6], bs * zv[7]);
      *(u32x4*)(B.BON + (m0 + t) * 512 + jb) = bo; *(u32x4*)(B.G + (m0 + t) * 512 + jb) = lg; }
    LDS_BARRIER();
    {
      const int k = tid & 63, sg = tid >> 6; float e[8], run = 0.f;
#pragma unroll
      for (int s = 0; s < 8; ++s) { run += F0[(8 * sg + s) * 64 + k]; e[s] = run; }
      F1[sg * 64 + k] = run;
      LDS_BARRIER();
      float off = 0.f;
#pragma unroll
      for (int s = 0; s < 8; ++s) off += (s < sg) ? F1[s * 64 + k] : 0.f;
#pragma unroll
      for (int s = 0; s < 8; ++s) F0[(8 * sg + s) * 64 + k] = e[s] + off; }
    LDS_BARRIER();
    { float ct[8], cp[8], cC[8];
#pragma unroll
      for (int i = 0; i < 8; ++i) { ct[i] = F0[t * 64 + c0 + i]; cp[i] = (t > 0) ? F0[(t - 1) * 64 + c0 + i] : 0.f; cC[i] = F0[63 * 64 + c0 + i]; }
      float at[8], bt[8], kt[8], rt[8], bh[8], kh[8];
#pragma unroll
      for (int i = 0; i < 8; ++i) { const float gt = __expf(-ct[i]), igt = __expf(ct[i]), gp = __expf(-cp[i]), gct = __expf(ct[i] - cC[i]);
          at[i] = -kk[i] * gp; bt[i] = kk[i] * ar[i] * igt; kt[i] = k2[i] * igt; rt[i] = zr[i] * gt; bh[i] = kk[i] * ar[i] * gct; kh[i] = k2[i] * gct; }
      u32x4 o;
      o.x = pk2(at[0], at[1]); o.y = pk2(at[2], at[3]); o.z = pk2(at[4], at[5]); o.w = pk2(at[6], at[7]); *(u32x4*)(A0 + t * ST + c0) = o;
      o.x = pk2(bt[0], bt[1]); o.y = pk2(bt[2], bt[3]); o.z = pk2(bt[4], bt[5]); o.w = pk2(bt[6], bt[7]); *(u32x4*)(A1 + t * ST + c0) = o;
      o.x = pk2(kt[0], kt[1]); o.y = pk2(kt[2], kt[3]); o.z = pk2(kt[4], kt[5]); o.w = pk2(kt[6], kt[7]); *(u32x4*)(A2 + t * ST + c0) = o;
      o.x = pk2(rt[0], rt[1]); o.y = pk2(rt[2], rt[3]); o.z = pk2(rt[4], rt[5]); o.w = pk2(rt[6], rt[7]); *(u32x4*)(A3 + t * ST + c0) = o;
#pragma unroll
      for (int i = 0; i < 8; ++i) { A4[(c0 + i) * ST + t] = (bf16)f2bf(bh[i]); A5[(c0 + i) * ST + t] = (bf16)f2bf(kh[i]); A6[(c0 + i) * ST + t] = (bf16)f2bf(zv[i]); F1[t * 128 + c0 + i] = at[i]; }
      if (t == 63) { float* gc = (float*)(B.UB + (size_t)u * UNIT_B + 16384) + c0;
#pragma unroll
          for (int i = 0; i < 8; ++i) gc[i] = __expf(-cC[i]); } }
    LDS_BARRIER();
    { const int mt = w >> 1, nt0 = 2 * (w & 1);
      f32x4 a1[2], a2[2], a3[2], a4[2]; ZACC(a1); ZACC(a2); ZACC(a3); ZACC(a4);
      mm_tile(A0, ST, A1, ST, 2, a1, w, lq, g); mm_tile(A0, ST, A2, ST, 2, a2, w, lq, g); mm_tile(A3, ST, A1, ST, 2, a3, w, lq, g); mm_tile(A3, ST, A2, ST, 2, a4, w, lq, g);
      LDS_BARRIER();
#pragma unroll
      for (int q = 0; q < 2; ++q) { const int i = 16 * (nt0 + q) + lq; f32x4 lab;
#pragma unroll
          for (int j = 0; j < 4; ++j) { const int tt = 16 * mt + 4 * g + j; lab[j] = (i < tt) ? a1[q][j] : 0.f;
              A7[tt * ST + i] = (bf16)f2bf((i < tt) ? a2[q][j] : 0.f); A8[tt * ST + i] = (bf16)f2bf((i <= tt) ? a3[q][j] : 0.f); A9[tt * ST + i] = (bf16)f2bf((i <= tt) ? a4[q][j] : 0.f); }
#pragma unroll
          for (int j = 0; j < 4; ++j) F0[i * 64 + j * 16 + 4 * mt + g] = lab[j]; } }
    LDS_BARRIER();
    { const int mt = w >> 1, nt0 = 2 * (w & 1); f32x4 a[2]; ZACC(a);
      mm_tile(A7, ST, A6, ST, 2, a, w, lq, g);
#pragma unroll
      for (int q = 0; q < 2; ++q)
#pragma unroll
          for (int j = 0; j < 4; ++j) F1[(16 * mt + 4 * g + j) * 128 + 64 + 16 * (nt0 + q) + lq] = a[q][j]; }
    LDS_BARRIER();
    { float X[16];
      const int col = 16 * w + lq;
#pragma unroll
      for (int r = 0; r < 16; ++r) X[r] = F1[(4 * r + g) * 128 + col];
      LDS_BARRIER();
      f32x4 Lc[4];
#pragma unroll
      for (int q = 0; q < 4; ++q) Lc[q] = *(const f32x4*)(F0 + g * 16 + 4 * q);
#pragma unroll
      for (int i = 0; i < 64; ++i) {
          const float xi = __shfl(X[i >> 2], (i & 3) * 16 + lq);
          f32x4 Ln[4];
#pragma unroll
          for (int q = 0; q < 4; ++q) Ln[q] = Lc[q];
          if (i + 1 < 64) {
#pragma unroll
              for (int q = ((i + 1) >> 4); q < 4; ++q) Ln[q] = *(const f32x4*)(F0 + (i + 1) * 64 + g * 16 + 4 * q);
          }
#pragma unroll
          for (int r = (i >> 2); r < 16; ++r) X[r] += Lc[r >> 2][r & 3] * xi;
#pragma unroll
          for (int q = 0; q < 4; ++q) Lc[q] = Ln[q];
          __builtin_amdgcn_sched_barrier(0);
      }
      bf16* XT = (bf16*)F1 + (w >> 2) * 4608 + ((col & 63) * ST);
#pragma unroll
      for (int r = 0; r < 16; ++r) XT[4 * r + g] = (bf16)f2bf(X[r]); }
    LDS_BARRIER();
    { const int mt = w >> 1, nt0 = 2 * (w & 1);
      const bf16* AhT = (const bf16*)F1; const bf16* W2T = AhT + 4608;
      unsigned char* ua = B.UA + (size_t)u * UNIT_A; unsigned char* ub = B.UB + (size_t)u * UNIT_B;
      f32x4 a[2];
      ZACC(a); mm_tile(A4, ST, AhT, ST, 2, a, w, lq, g);
#pragma unroll
      for (int q = 0; q < 2; ++q)
#pragma unroll
          for (int j = 0; j < 4; ++j) { const int row = 16 * mt + 4 * g + j, kc = 16 * (nt0 + q) + lq; *(bf16*)(ua + swz(row, permk(kc))) = (bf16)f2bf(a[q][j]); }
      ZACC(a); mm_tile(A8, ST, AhT, ST, 2, a, w, lq, g);
#pragma unroll
      for (int q = 0; q < 2; ++q)
#pragma unroll
          for (int j = 0; j < 4; ++j) { const int row = 16 * mt + 4 * g + j, kc = 16 * (nt0 + q) + lq; *(bf16*)(ua + 8192 + swz(row, permk(kc))) = (bf16)f2bf(a[q][j] + bf2f(A3[row * ST + kc])); }
      ZACC(a); mm_tile(A4, ST, W2T, ST, 2, a, w, lq, g); mm_tile(A5, ST, A6, ST, 2, a, w, lq, g);
#pragma unroll
      for (int q = 0; q < 2; ++q) { const int v = 16 * (nt0 + q) + lq, k0 = 16 * mt + 4 * g; u32x2 o; o.x = pk2(a[q][0], a[q][1]); o.y = pk2(a[q][2], a[q][3]); *(u32x2*)(ub + swz(v, k0)) = o; }
      ZACC(a); mm_tile(A8, ST, W2T, ST, 2, a, w, lq, g); mm_tile(A9, ST, A6, ST, 2, a, w, lq, g);
#pragma unroll
      for (int q = 0; q < 2; ++q) { const int v = 16 * (nt0 + q) + lq, t0 = 16 * mt + 4 * g; u32x2 o; o.x = pk2(a[q][0], a[q][1]); o.y = pk2(a[q][2], a[q][3]); *(u32x2*)(ub + 8192 + swz(v, t0)) = o; } }
    LDS_BARRIER();
}
__device__ __forceinline__ void phase_rwkv_prep(const Params& P, int l, const Ctx& c) {
    const RwkvBufs B = rwkv_bufs(P, c);
    for (int u = c.bid; u < NUNIT; u += c.G) rwkv_prep_unit(P, l, c, u, B);
}

constexpr int SLOTB = 33280, YST = 68;
__device__ __forceinline__ void scan_chunked(const Params& P, const Ctx& c, int bh) {
    const RwkvBufs B = rwkv_bufs(P, c);
    const int b = bh >> 3, h = bh & 7, w = c.wave, lane = c.lane, lq = lane & 15, g = lane >> 4;
    const size_t rowb = (size_t)b * LP;
    const int ll = c.tid;
    unsigned char* L = c.lds;
    f32x4 st[4];
#pragma unroll
    for (int i = 0; i < 4; ++i) st[i] = (f32x4){0.f, 0.f, 0.f, 0.f};
    u32x4 r0[5], r1[5], r2[5], r3[5], r4[5];
#define SC_UNIT(cc) ((size_t)((b * NCHK + (cc)) * 8 + h))
#define SC_LOAD(R, cc) do { const unsigned char* pa_ = B.UA + SC_UNIT(cc) * UNIT_A; const unsigned char* pb_ = B.UB + SC_UNIT(cc) * UNIT_B; \
        _Pragma("unroll") for (int i_ = 0; i_ < 2; ++i_) { R[i_] = GLD(u32x4, pa_ + (ll + 512 * i_) * 16); R[2 + i_] = GLD(u32x4, pb_ + (ll + 512 * i_) * 16); } \
        if (ll < 16) R[4] = GLD(u32x4, pb_ + 16384 + ll * 16); } while (0)
#define SC_WRITE(R, slot) do { unsigned char* s_ = L + (slot) * SLOTB; \
        _Pragma("unroll") for (int i_ = 0; i_ < 2; ++i_) { *(u32x4*)(s_ + (ll + 512 * i_) * 16) = R[i_]; *(u32x4*)(s_ + 16384 + (ll + 512 * i_) * 16) = R[2 + i_]; } \
        if (ll < 16) *(u32x4*)(s_ + 32768 + ll * 16) = R[4]; } while (0)
#define SC_COMPUTE(ci) do { \
        const unsigned char* sl = L + ((ci) % 3) * SLOTB; \
        const int vcol = 16 * w + lq; \
        bf16x8 gaf[4][2]; f32x4 gcf[4]; u32x2 d0f[4]; \
        _Pragma("unroll") for (int mt = 0; mt < 4; ++mt) { \
            gcf[mt] = *(const f32x4*)(sl + 32768 + (16 * mt + 4 * g) * 4); \
            d0f[mt] = *(const u32x2*)(sl + 16384 + swz(vcol, 16 * mt + 4 * g)); \
            _Pragma("unroll") for (int ks = 0; ks < 2; ++ks) gaf[mt][ks] = *(const bf16x8*)(sl + swz(16 * mt + lq, 32 * ks + 8 * g)); } \
        __builtin_amdgcn_sched_barrier(0);        \
        bf16x8 sb[2]; \
        _Pragma("unroll") for (int ks = 0; ks < 2; ++ks) { u32x4 pw; pw.x = pk2(st[2 * ks][0], st[2 * ks][1]); pw.y = pk2(st[2 * ks][2], st[2 * ks][3]); pw.z = pk2(st[2 * ks + 1][0], st[2 * ks + 1][1]); pw.w = pk2(st[2 * ks + 1][2], st[2 * ks + 1][3]); \
            sb[ks] = __builtin_bit_cast(bf16x8, pw); } \
        _Pragma("unroll") for (int mt = 0; mt < 4; ++mt) { \
            f32x4 ns = (f32x4){bflo(d0f[mt].x), bfhi(d0f[mt].x), bflo(d0f[mt].y), bfhi(d0f[mt].y)} + gcf[mt] * st[mt]; \
            _Pragma("unroll") for (int ks = 0; ks < 2; ++ks) ns = __builtin_amdgcn_mfma_f32_16x16x32_bf16(gaf[mt][ks], sb[ks], ns, 0, 0, 0); \
            st[mt] = ns; } \
        _Pragma("unroll") for (int mt = 0; mt < 4; ++mt) { \
            const u32x2 y0 = *(const u32x2*)(sl + 24576 + swz(vcol, 16 * mt + 4 * g)); \
            f32x4 ya = (f32x4){bflo(y0.x), bfhi(y0.x), bflo(y0.y), bfhi(y0.y)}; \
            _Pragma("unroll") for (int ks = 0; ks < 2; ++ks) { const bf16x8 rh = *(const bf16x8*)(sl + 8192 + swz(16 * mt + lq, 32 * ks + 8 * g)); ya = __builtin_amdgcn_mfma_f32_16x16x32_bf16(rh, sb[ks], ya, 0, 0, 0); } \
            float* yl = (float*)(L + 3 * SLOTB) + ((ci) & 1) * (64 * YST) + (16 * mt + 4 * g) * YST + vcol; \
            _Pragma("unroll") for (int j = 0; j < 4; ++j) yl[j * YST] = ya[j]; } } while (0)
#define SC_YSTORE(ci) do { const float* ys_ = (const float*)(L + 3 * SLOTB) + ((ci) & 1) * (64 * YST) + (c.tid >> 3) * YST + (c.tid & 7) * 8; \
        float* yg_ = B.Y + (rowb + (ci) * 64 + (c.tid >> 3)) * 512 + h * 64 + (c.tid & 7) * 8; \
        GST(f32x4, yg_) = *(const f32x4*)ys_; GST(f32x4, yg_ + 4) = *(const f32x4*)(ys_ + 4); } while (0)
#define SC_ITER(ci, R) do { if ((ci) + 2 < NCHK) SC_WRITE(R, ((ci) + 2) % 3); if ((ci) + 7 < NCHK) SC_LOAD(R, (ci) + 7); if ((ci) > 0) SC_YSTORE((ci) - 1); if (w < 4) { SC_COMPUTE(ci); } LDS_BARRIER(); } while (0)
    { SC_LOAD(r0, 0); SC_LOAD(r1, 1); SC_WRITE(r0, 0); SC_WRITE(r1, 1); SC_LOAD(r2, 2); SC_LOAD(r3, 3); SC_LOAD(r4, 4); SC_LOAD(r0, 5); SC_LOAD(r1, 6); }
    __syncthreads();
#pragma unroll 1
    for (int cc = 0; cc < NCHK; cc += 5) { SC_ITER(cc, r2); SC_ITER(cc + 1, r3); SC_ITER(cc + 2, r4); SC_ITER(cc + 3, r0); SC_ITER(cc + 4, r1); }
    SC_YSTORE(NCHK - 1);
#undef SC_YSTORE
#undef SC_COMPUTE
#undef SC_ITER
#undef SC_UNIT
#undef SC_LOAD
#undef SC_WRITE
}

__device__ __forceinline__ void phase_gn(const Params& P, int l, const Ctx& c) {
    const RwkvBufs B = rwkv_bufs(P, c);
    const int gw = c.bid * NWAVES + c.wave, NGW = c.G * NWAVES;
    const int c0 = 8 * c.lane;
    float gnw[8], gnb[8];
#pragma unroll
    for (int i = 0; i < 8; ++i) { gnw[i] = P.in[17][l * 512 + c0 + i]; gnb[i] = P.in[18][l * 512 + c0 + i]; }
    for (int m = gw; m < M; m += NGW) {
        const size_t o = (size_t)m * 512 + c0;
        const f32x4 y0 = *(const f32x4*)(B.Y + o), y1 = *(const f32x4*)(B.Y + o + 4);
        float y[8] = {y0.x, y0.y, y0.z, y0.w, y1.x, y1.y, y1.z, y1.w};
        const u32x4 bw = *(const u32x4*)(B.BON + o), gw4 = *(const u32x4*)(B.G + o);
        const float bo[8] = {bflo(bw.x), bfhi(bw.x), bflo(bw.y), bfhi(bw.y), bflo(bw.z), bfhi(bw.z), bflo(bw.w), bfhi(bw.w)};
        const float gg[8] = {bflo(gw4.x), bfhi(gw4.x), bflo(gw4.y), bfhi(gw4.y), bflo(gw4.z), bfhi(gw4.z), bflo(gw4.w), bfhi(gw4.w)};
        float s = 0.f;
#pragma unroll
        for (int i = 0; i < 8; ++i) s += y[i];
        s += __shfl_xor(s, 1); s += __shfl_xor(s, 2); s += __shfl_xor(s, 4);
        const float mean = s * (1.f / 64.f);
        float q = 0.f;
#pragma unroll
        for (int i = 0; i < 8; ++i) { y[i] -= mean; q += y[i] * y[i]; }
        q += __shfl_xor(q, 1); q += __shfl_xor(q, 2); q += __shfl_xor(q, 4);
        const float rstd = 1.0f / sqrtf(q * (1.f / 64.f) + 64e-5f);
        float ov[8];
#pragma unroll
        for (int i = 0; i < 8; ++i) ov[i] = (y[i] * rstd * gnw[i] + gnb[i] + bo[i]) * gg[i];
        u32x4 ow; ow.x = pk2(ov[0], ov[1]); ow.y = pk2(ov[2], ov[3]); ow.z = pk2(ov[4], ov[5]); ow.w = pk2(ov[6], ov[7]);
        *(u32x4*)(B.ORW + o) = ow;
    }
}

__device__ __forceinline__ void attn_unit(const Ctx& c, int bh, int qb, const bf16* Q, const bf16* K, const bf16* V, bf16* O, const float* FC, float qkb2) {
    const int b = bh >> 3, h = bh & 7, lane = c.lane, w = c.wave, lq = lane & 15, g = lane >> 4;
    const int q0 = qb * 128;
    const size_t rowb = (size_t)b * LP;
    const int qrow = q0 + 16 * w + lq;
    bf16* Ks = (bf16*)c.lds; bf16* Vt = Ks + 64 * 72; float* fks = (float*)(Vt + 64 * 72);
    const bf16* qp = Q + (rowb + qrow) * 512 + h * 64 + 8 * g;
    const bf16x8 qf0 = GLD(bf16x8, qp), qf1 = GLD(bf16x8, qp + 32);
    const float* FCh = FC + (size_t)bh * LP;
    const float fq = GLD(float, FCh + qrow);
    float mrun = -1e30f, lsum = 0.f;
    f32x4 o[4];
#pragma unroll
    for (int i = 0; i < 4; ++i) o[i] = (f32x4){0.f, 0.f, 0.f, 0.f};
    const int kt_max = (q0 + 127) >> 6;
    const int lkey = c.tid >> 3, lch = c.tid & 7;
    const size_t gbase = (rowb + lkey) * 512 + h * 64 + lch * 8;
    u32x4 kv = GLD(u32x4, K + gbase + (size_t)kt_max * 64 * 512), vv = GLD(u32x4, V + gbase + (size_t)kt_max * 64 * 512);
    float fkv = GLD(float, FCh + kt_max * 64 + (c.tid & 63));
    volatile unsigned* vote = (volatile unsigned*)(fks + 64);
    for (int kt = kt_max; kt >= 0; --kt) {
        const int k0 = kt * 64;
        LDS_BARRIER();
        { int can = 0; if (kt < kt_max) { const float fl = __shfl(fkv, 63); can = (qkb2 + fq - fl) < (mrun - THR2); }
          const int wall = __all(can); if (lane == 0) vote[w] = (unsigned)wall; }
        { *(u32x4*)(Ks + lkey * 72 + lch * 8) = kv;
            bf16* vd = Vt + (lch * 8) * 72 + lkey;
            vd[0] = (bf16)(vv.x & 0xffff); vd[72] = (bf16)(vv.x >> 16); vd[144] = (bf16)(vv.y & 0xffff); vd[216] = (bf16)(vv.y >> 16);
            vd[288] = (bf16)(vv.z & 0xffff); vd[360] = (bf16)(vv.z >> 16); vd[432] = (bf16)(vv.w & 0xffff); vd[504] = (bf16)(vv.w >> 16);
            if (c.tid < 64) fks[c.tid] = fkv;
            if (kt > 0) { kv = GLD(u32x4, K + gbase + (size_t)(k0 - 64) * 512); vv = GLD(u32x4, V + gbase + (size_t)(k0 - 64) * 512); fkv = GLD(float, FCh + k0 - 64 + (c.tid & 63)); } }
        LDS_BARRIER();
        { unsigned all = vote[0] & vote[1] & vote[2] & vote[3] & vote[4] & vote[5] & vote[6] & vote[7]; if (all) break; }
        if (k0 > q0 + 16 * w + 15) continue;
        f32x4 s[4];
#pragma unroll
        for (int nt = 0; nt < 4; ++nt) { const bf16* kp = Ks + (16 * nt + lq) * 72 + 8 * g; const bf16x8 a0 = *(const bf16x8*)kp, a1 = *(const bf16x8*)(kp + 32);
            s[nt] = __builtin_amdgcn_mfma_f32_16x16x32_bf16(a0, qf0, (f32x4){0.f, 0.f, 0.f, 0.f}, 0, 0, 0);
            s[nt] = __builtin_amdgcn_mfma_f32_16x16x32_bf16(a1, qf1, s[nt], 0, 0, 0); }
        float mx = -INFINITY;
#pragma unroll
        for (int nt = 0; nt < 4; ++nt) { const f32x4 fk = *(const f32x4*)(fks + 16 * nt + 4 * g);
#pragma unroll
            for (int j = 0; j < 4; ++j) { float x = s[nt][j] + fq - fk[j]; const int key = k0 + 16 * nt + 4 * g + j; if (key > qrow) x = -INFINITY; s[nt][j] = x; mx = fmaxf(mx, x); } }
        mx = fmaxf(mx, __shfl_xor(mx, 16)); mx = fmaxf(mx, __shfl_xor(mx, 32));
        const float mnew = fmaxf(mrun, mx), alpha = exp2f(mrun - mnew); mrun = mnew;
        float psum = 0.f;
#pragma unroll
        for (int nt = 0; nt < 4; ++nt)
#pragma unroll
            for (int j = 0; j < 4; ++j) { const float p = exp2f(s[nt][j] - mnew); s[nt][j] = p; psum += p; }
        lsum = lsum * alpha + psum;
#pragma unroll
        for (int dt = 0; dt < 4; ++dt) o[dt] = o[dt] * alpha;
        bf16x8 pb[2];
#pragma unroll
        for (int k2 = 0; k2 < 2; ++k2) { u32x4 pw; pw.x = pk2(s[2 * k2][0], s[2 * k2][1]); pw.y = pk2(s[2 * k2][2], s[2 * k2][3]); pw.z = pk2(s[2 * k2 + 1][0], s[2 * k2 + 1][1]); pw.w = pk2(s[2 * k2 + 1][2], s[2 * k2 + 1][3]);
            pb[k2] = __builtin_bit_cast(bf16x8, pw); }
#pragma unroll
        for (int dt = 0; dt < 4; ++dt)
#pragma unroll
            for (int k2 = 0; k2 < 2; ++k2) { const bf16* vp = Vt + (16 * dt + lq) * 72 + 32 * k2 + 4 * g;
                const u32x2 lo = *(const u32x2*)vp, hi = *(const u32x2*)(vp + 16);
                u32x4 aw; aw.x = lo.x; aw.y = lo.y; aw.z = hi.x; aw.w = hi.y;
                o[dt] = __builtin_amdgcn_mfma_f32_16x16x32_bf16(__builtin_bit_cast(bf16x8, aw), pb[k2], o[dt], 0, 0, 0); }
    }
    lsum += __shfl_xor(lsum, 16); lsum += __shfl_xor(lsum, 32);
    const float inv = 1.0f / lsum;
    bf16* op = O + (rowb + qrow) * 512 + h * 64 + 4 * g;
#pragma unroll
    for (int dt = 0; dt < 4; ++dt) { u32x2 ow; ow.x = pk2(o[dt][0] * inv, o[dt][1] * inv); ow.y = pk2(o[dt][2] * inv, o[dt][3] * inv); GST(u32x2, op + 16 * dt) = ow; }
    __syncthreads();
}
__device__ __forceinline__ void phase_attn(const Params& P, int l, const Ctx& c, int first_blk) {
    const bf16* Q = (const bf16*)(c.ws + OFF_Q); const bf16* K = (const bf16*)(c.ws + OFF_K); const bf16* V = (const bf16*)(c.ws + OFF_V);
    const float* FC = (const float*)(c.ws + OFF_MISC) + 16 * LP;
    float gqm = fabsf(P.in[5][l * 64 + c.lane]), gkm = fabsf(P.in[6][l * 64 + c.lane]);
#pragma unroll
    for (int o = 1; o < 64; o <<= 1) { gqm = fmaxf(gqm, __shfl_xor(gqm, o)); gkm = fmaxf(gkm, __shfl_xor(gkm, o)); }
    const float qkb2 = 8.0f * gqm * gkm * LOG2E * 1.03f;
    constexpr int NQB = LP / 128, NU = 16 * NQB;
    unsigned* ctr = (unsigned*)(c.ws + OFF_CTL) + 8192 + 64 * l;
    volatile unsigned* slot = (volatile unsigned*)(c.lds + MISC_OFF) + 4;
    for (;;) {
        __syncthreads();
        if (c.tid == 0) *slot = atomicAdd(ctr, 1u);
        __syncthreads();
        const int u = (int)*slot;
        if (u >= NU) break;
        const int bh = u & 15, qb = NQB - 1 - (u >> 4); attn_unit(c, bh, qb, Q, K, V, (bf16*)(c.ws + OFF_OF), FC, qkb2);
    }
}

__device__ __forceinline__ void phase_fixup(const Params& P, int l, const Ctx& c) {
    bf16* ACT = (bf16*)(c.ws + OFF_RW); const bf16* HALO = (const bf16*)(c.ws + OFF_Q);
    const float* cw = P.in[24] + (size_t)l * 3 * NUP;
    const int total = (M / 64) * 2 * DFF;
    for (int idx = c.bid * NTHR + c.tid; idx < total; idx += c.G * NTHR) {
        const int rr = idx / DFF, ch = idx - rr * DFF, q64 = rr >> 1, e = rr & 1, row = q64 * 64 + e;
        const int t = row % LP;
        int s0, s1, s2;
        if (e == 0) { s0 = q64 * 4 + 2; s1 = (q64 - 1) * 4 + 1; s2 = (q64 - 1) * 4 + 0; } else { s0 = q64 * 4 + 3; s1 = q64 * 4 + 2; s2 = (q64 - 1) * 4 + 1; }
        float uc[2];
#pragma unroll
        for (int bj = 0; bj < 2; ++bj) { const int col = bj * DFF + ch;
            const float u0 = bf2f(HALO[(size_t)s0 * NUP + col]);
            const float u1 = (t >= 1) ? bf2f(HALO[(size_t)s1 * NUP + col]) : 0.f;
            const float u2 = (t >= 2) ? bf2f(HALO[(size_t)s2 * NUP + col]) : 0.f;
            uc[bj] = cw[col] * u2 + cw[NUP + col] * u1 + cw[2 * NUP + col] * u0; }
        ACT[(size_t)row * DFF + ch] = (bf16)f2bf(uc[0] * sigmoidf_(uc[0]) * uc[1]);
    }
}

#define OPQ_S(x) asm volatile("" : "+s"(x))
#define OPQ_V(x) asm volatile("" : "+v"(x))
#define PHASE_BEGIN() do { int t_ = threadIdx.x; OPQ_V(t_); c.tid = t_; c.lane = t_ & 63; c.wave = __builtin_amdgcn_readfirstlane(t_ >> 6); int b_ = blockIdx.x; OPQ_S(b_); c.bid = b_; \
    size_t z_ = 0; OPQ_S(z_); unsigned char* w_ = P.ws + z_;   c.ws = w_; ws = w_; l = lc; OPQ_S(l); WT = (pg8::bf16_t*)(ws + OFF_WT); HN = (pg8::bf16_t*)(ws + OFF_HN); } while (0)
__global__ void __launch_bounds__(NTHR, 2) mega(Params P) {
    extern __shared__ __attribute__((aligned(16))) unsigned char lds[];
    Ctx c; c.G = gridDim.x; c.lds = lds;
    volatile LAS unsigned* MISC = (volatile LAS unsigned*)((LAS unsigned char*)lds + MISC_OFF);
    if (threadIdx.x < 16) MISC[threadIdx.x] = 0u;
    __syncthreads();
    (void)xcd_barrier_post((unsigned*)(P.ws + OFF_CTL) + 1024, MISC + 8);
#define SEAM() do { XcdBarrier xb_; xb_.bar = (unsigned*)(P.ws + OFF_CTL) + 1024; xb_.x = xb_xcc_id(); xb_.st = (volatile LAS unsigned*)((LAS unsigned char*)lds + MISC_OFF) + 8; xcd_barrier(xb_); } while (0)
    PG8_LAS unsigned char* ldsl = (PG8_LAS unsigned char*)lds;
    unsigned char* ws; pg8::bf16_t* WT; pg8::bf16_t* HN; int l;
#pragma unroll 1
    for (int lc = 0; lc < DEPTH; ++lc) {
        PHASE_BEGIN();
        convert_weights(P, l, c);
        phase_norm<true>(P, l, c);
        if (lc == 0) cg::this_grid().sync(); else SEAM();
        PHASE_BEGIN();
        phase_fcum(P, c);
        { pg8::Gemm g{HN, WT + WT_IN, M, N1, 1024, 1024}; pg8::StaticOrder S; S.init(M, N1, c.G, c.bid);
          pg8::EpiRoute E{ws};
          pg8::gemm_phase<pg8::EpiRoute, pg8::StaticOrder, true, true>(ldsl, g, S, E); }
        SEAM();
        PHASE_BEGIN();
        phase_qknorm(P, l, c);
        for (int rep_ = 0; rep_ < REP_PREP; ++rep_) phase_rwkv_prep(P, l, c);
        SEAM();
        PHASE_BEGIN();
        if (c.bid < 16) { scan_chunked(P, c, c.bid); __syncthreads(); PHASE_BEGIN(); }
        phase_attn(P, l, c, 16);
#if REP_P3 > 1
        __syncthreads(); PHASE_BEGIN();
        if (c.bid < 16) scan_chunked(P, c, c.bid); else phase_attn(P, l, c, 16);
#endif
        SEAM();
        PHASE_BEGIN();
        phase_gn(P, l, c);
        for (int rep_ = 0; rep_ < REP_SYNC; ++rep_) SEAM();
        SEAM();
        PHASE_BEGIN();
        { pg8::bf16_t* MG = (pg8::bf16_t*)(ws + OFF_K); const pg8::bf16_t* GT = (const pg8::bf16_t*)(ws + OFF_GT); const float* gb = P.in[21] + l * NGT;
          pg8::StaticOrder S; S.init(M, 1024, c.G, c.bid);
          { pg8::Gemm g{(const pg8::bf16_t*)(ws + OFF_OF), WT + WT_BF, M, 1024, 512, 512}; pg8::EpiGate<0> E{MG, GT, gb};
            pg8::gemm_phase<pg8::EpiGate<0>, pg8::StaticOrder, true, true>(ldsl, g, S, E); }
          __syncthreads();
          PHASE_BEGIN();
          MG = (pg8::bf16_t*)(ws + OFF_K); GT = (const pg8::bf16_t*)(ws + OFF_GT); gb = P.in[21] + l * NGT; S.init(M, 1024, c.G, c.bid);
          { pg8::Gemm g{(const pg8::bf16_t*)(ws + OFF_RW + (size_t)M * 512 * 4), WT + WT_BR, M, 1024, 512, 512}; pg8::EpiGate<1> E{MG, GT, gb};
            pg8::gemm_phase<pg8::EpiGate<1>, pg8::StaticOrder, true, true>(ldsl, g, S, E); } }
        SEAM();
        PHASE_BEGIN();
#pragma unroll 1
        for (int pass = 0; pass < 2; ++pass) {
            if (pass) { __syncthreads(); PHASE_BEGIN(); }
            const int sl = pass ? (c.bid >> 2) : 0;
            pg8::Gemm g{(const pg8::bf16_t*)(ws + OFF_K) + sl * 256, WT + WT_O + sl * 256, M, 1024, pass ? 256 : 1024, 1024};
            pg8::OneUnit S; S.so.init(MMAIN, 1024, c.G, c.bid); S.mode = pass; S.pm = MMAIN / 256; S.pn = c.bid & 3; S.active = sl < 4;
            pg8::EpiResid E{(float*)(ws + OFF_H), nullptr, pass};
            pg8::gemm_phase<pg8::EpiResid, pg8::OneUnit, true, true>(ldsl, g, S, E);
        }
        SEAM();
        PHASE_BEGIN();
        phase_norm<false>(P, l, c);
        SEAM();
        PHASE_BEGIN();
        { pg8::Gemm g{HN, WT + WT_UP, M, NUP, 1024, 1024}; pg8::StaticOrder S; S.init(M, NUP, c.G, c.bid);
          pg8::EpiUp E{(pg8::bf16_t*)(ws + OFF_RW), (pg8::bf16_t*)(ws + OFF_Q), P.in[24] + (size_t)l * 3 * NUP};
          pg8::gemm_phase<pg8::EpiUp, pg8::StaticOrder, true, true>(ldsl, g, S, E); }
        SEAM();
        PHASE_BEGIN();
        phase_fixup(P, l, c);
        SEAM();
        PHASE_BEGIN();
#pragma unroll 1
        for (int pass = 0; pass < 2; ++pass) {
            if (pass) { __syncthreads(); PHASE_BEGIN(); }
            const int sl = pass ? (c.bid >> 2) : 0;
            const int ko = (sl < 2) ? sl * 768 : 1536 + (sl - 2) * 640, kl = (sl < 2) ? 768 : 640;
            pg8::Gemm g{(const pg8::bf16_t*)(ws + OFF_RW) + (pass ? ko : 0), WT + WT_DN + (pass ? ko : 0), M, 1024, pass ? kl : DFF, DFF};
            pg8::OneUnit S; S.so.init(MMAIN, 1024, c.G, c.bid); S.mode = pass; S.pm = MMAIN / 256; S.pn = c.bid & 3; S.active = sl < 4;
            pg8::EpiResid E{(float*)(ws + OFF_H), (l == DEPTH - 1 && !pass) ? P.out : nullptr, pass};
            pg8::gemm_phase<pg8::EpiResid, pg8::OneUnit, true, true>(ldsl, g, S, E);
        }
        SEAM();
        if (l == DEPTH - 1) {
            PHASE_BEGIN();
            const float* H = (const float*)(ws + OFF_H);
            for (int idx = c.bid * NTHR + c.tid; idx < (NMETA + SEQ - (MMAIN - LP)) * (DM / 4); idx += c.G * NTHR) {
                const int r = idx / (DM / 4), q4 = idx - r * (DM / 4), t = (MMAIN - LP) + r;
                *(f32x4*)(P.out + ((size_t)SEQ + (t - NMETA)) * DM + 4 * q4) = *(const f32x4*)(H + (size_t)(LP + t) * DM + 4 * q4);
            }
        }
    }
}

extern "C" void kernel_launch(void* const* d_in, const int* in_sizes, int n_in, void* d_out, int out_size, void* d_ws, size_t ws_size, hipStream_t stream) {
    static int grid = 0;
    if (grid == 0) {
        if (n_in != 26 || out_size != NB * SEQ * DM || ws_size < WS_NEED) { fprintf(stderr, "kernel_launch: unexpected shapes (n_in %d out %d ws %zu need %zu)\n", n_in, out_size, ws_size, (size_t)WS_NEED); grid = -1; return; }
        int dev = 0, cus = 0, per_cu = 0;
        if (hipGetDevice(&dev) != hipSuccess || hipDeviceGetAttribute(&cus, hipDeviceAttributeMultiprocessorCount, dev) != hipSuccess) { grid = -1; return; }
        if (hipFuncSetAttribute((const void*)mega, hipFuncAttributeMaxDynamicSharedMemorySize, LDS_BYTES) != hipSuccess) { fprintf(stderr, "kernel_launch: hipFuncSetAttribute failed\n"); grid = -1; return; }
        if (hipOccupancyMaxActiveBlocksPerMultiprocessor(&per_cu, (const void*)mega, NTHR, LDS_BYTES) != hipSuccess || per_cu < 1) { fprintf(stderr, "kernel_launch: occupancy query says %d\n", per_cu); per_cu = 1; }
        (void)hipGetLastError();
        grid = cus;
    }
    if (grid < 0) return;
    if (hipMemsetAsync((char*)d_ws + OFF_CTL, 0, 65536, stream) != hipSuccess) { fprintf(stderr, "kernel_launch: memset failed\n"); return; }
    Params p{};
    for (int i = 0; i < 26; ++i) p.in[i] = (const float*)d_in[i];
    p.out = (float*)d_out; p.ws = (unsigned char*)d_ws;
    void* args[] = {&p};
    hipError_t e = hipLaunchCooperativeKernel((const void*)mega, dim3(grid), dim3(NTHR), args, LDS_BYTES, stream);
    if (e != hipSuccess) fprintf(stderr, "kernel_launch: cooperative launch failed: %s (grid %d)\n", hipGetErrorString(e), grid);
}
```

```cpp
#include <hip/hip_runtime.h>
#include <hip/hip_cooperative_groups.h>
#include <cstdio>
#include <cstdint>
#include <cmath>
namespace cg = cooperative_groups;
namespace pg8 {
#define PG8_LAS __attribute__((address_space(3)))
typedef unsigned short bf16_t;
typedef short bf16x8 __attribute__((ext_vector_type(8)));
typedef float f32x4 __attribute__((ext_vector_type(4)));
typedef unsigned u32x4 __attribute__((ext_vector_type(4)));
constexpr int BM = 256, BK = 64, HALF = 128, HTB = HALF * BK * 2  , STAGE_BYTES = 8 * HTB, NXCD = 8, WGM = 8;

__host__ __device__ __forceinline__ int lds_byte(int r, int c) { const int st = (r >> 4) * 2 + (c >> 5), rr = r & 15, cc = c & 31, ob = rr * 64 + cc * 2; return st * 1024 + (ob ^ (((ob >> 9) & 1) << 5)); }
__host__ __device__ __forceinline__ void stage_rc(int b, int& R, int& C) { const int st = b / 1024, sb = b % 1024, swz = sb ^ (((sb >> 9) & 1) << 5); R = (st >> 1) * 16 + swz / 64; C = (st & 1) * 32 + (swz % 64) / 2; }
__host__ __device__ __forceinline__ int perm32(int rho) { const int n = rho >> 4, i = rho & 15; return 8 * (i >> 2) + 4 * n + (i & 3); }

struct Unit { int pm, pn; };
struct Gemm { const bf16_t* A; const bf16_t* Bt; int M, N, K, ld; };

struct StaticOrder {
    int nM, nN, nwg, G, c;
    __host__ __device__ void init(int M, int N, int G_, int c_) { nM = M / BM; nN = N / BM; nwg = nM * nN; G = G_; c = c_; }
    __host__ __device__ bool next(int i, Unit& u) const {
        const long L = (long)i * G + c; if (L >= nwg) return false;
        int wgid = (int)L; { const int q = nwg / NXCD, r = nwg % NXCD, xcd = wgid % NXCD, off = wgid / NXCD; wgid = (xcd < r ? xcd * (q + 1) : r * (q + 1) + (xcd - r) * q) + off; }
        const int nig = WGM * nN, gid = wgid / nig, fm = gid * WGM, gsz = (nM - fm) < WGM ? (nM - fm) : WGM;
        u.pm = fm + ((wgid % nig) % gsz); u.pn = (wgid % nig) / gsz; return true;
    }
    __device__ __forceinline__ void a_ready(const Unit&) const {}
    __device__ __forceinline__ void done(const Unit&) const {}
};

__device__ __forceinline__ unsigned cvt_pk_bf16(float lo, float hi) { unsigned r; asm volatile("v_cvt_pk_bf16_f32 %0, %1, %2" : "=v"(r) : "v"(lo), "v"(hi)); return r; }
typedef float f32x2 __attribute__((ext_vector_type(2)));
template <class Epi, class Sched, bool ALIGN_EPI = false, bool SP2 = false>
__device__ __forceinline__ void gemm_phase(PG8_LAS unsigned char* lds, const Gemm g, const Sched& S, const Epi& E) {
    int tid_ = threadIdx.x; asm volatile("" : "+v"(tid_)); const int tid = tid_, wid = __builtin_amdgcn_readfirstlane(tid >> 6), lane = tid & 63, wr = wid >> 2, wc = wid & 3, fr = lane & 15, fq = lane >> 4;
    const int K = g.K, nt = K / BK, LD = g.ld;
    unsigned voffA[2], voffB[2];
#pragma unroll
    for (int i = 0; i < 2; ++i) { int R, C; stage_rc(tid * 16 + i * 8192, R, C); const int Rb = Epi::PERM ? ((R & ~31) + perm32(R & 31)) : R;
        voffA[i] = (unsigned)(R * LD + C) * 2u; voffB[i] = (unsigned)(Rb * LD + C) * 2u; }
    const size_t kstep = (size_t)(BK * 2);
    const size_t hstep = (size_t)HALF * LD * 2;
    const size_t tstep = 2 * hstep;
    const unsigned ldsw = (unsigned)wid * 1024u;
    const int aoff = lds_byte(wr * 64 + fr, fq * 8), boff = lds_byte(wc * 32 + fr, fq * 8);
#define PG8_SA(b, h) (((b) * 2 + (h)) * HTB)
#define PG8_SB(b, h) ((4 + (b) * 2 + (h)) * HTB)
#define PG8_STAGE(bufoff, gbase, voff) do { _Pragma("unroll") for (int _i = 0; _i < 2; ++_i) \
        __builtin_amdgcn_global_load_lds((const unsigned*)((const char*)(gbase) + (voff)[_i]), (PG8_LAS unsigned*)(lds + (bufoff) + ldsw + _i * 8192), 16, 0, 0); } while (0)
#define PG8_LDA(dst, b, h) do { _Pragma("unroll") for (int m = 0; m < 4; ++m) _Pragma("unroll") for (int k = 0; k < 2; ++k) dst[m][k] = *(const PG8_LAS bf16x8*)(lds + PG8_SA(b, h) + aoff + m * 2048 + k * 1024); } while (0)
#define PG8_LDB(dst, b, h) do { _Pragma("unroll") for (int n = 0; n < 2; ++n) _Pragma("unroll") for (int k = 0; k < 2; ++k) dst[n][k] = *(const PG8_LAS bf16x8*)(lds + PG8_SB(b, h) + boff + n * 2048 + k * 1024); } while (0)
#define PG8_MMA(ai, bj, At, Bt) do { __builtin_amdgcn_s_setprio(1); _Pragma("unroll") for (int m = 0; m < 4; ++m) _Pragma("unroll") for (int n = 0; n < 2; ++n) _Pragma("unroll") for (int k = 0; k < 2; ++k) \
        acc[ai][bj][m][n] = __builtin_amdgcn_mfma_f32_16x16x32_bf16(Bt[n][k], At[m][k], acc[ai][bj][m][n], 0, 0, 0); __builtin_amdgcn_s_setprio(0); } while (0)
#define PG8_WAIT_V(n) asm volatile("s_waitcnt vmcnt(" #n ")" ::: "memory")
#define PG8_WAIT_L(n) asm volatile("s_waitcnt lgkmcnt(" #n ")" ::: "memory")
#define PG8_BAR __builtin_amdgcn_s_barrier()
#define PG8_SCHED __builtin_amdgcn_sched_barrier(0)
    Unit cur, nxt; int ui = 0;
    if (!S.next(0, cur)) return;
    f32x4 acc[2][2][4][2];
#pragma unroll
    for (int a = 0; a < 2; ++a)
#pragma unroll
        for (int b = 0; b < 2; ++b)
#pragma unroll
            for (int m = 0; m < 4; ++m)
#pragma unroll
                for (int n = 0; n < 2; ++n) acc[a][b][m][n] = (f32x4){0.f, 0.f, 0.f, 0.f};
    bf16x8 At[4][2], B0[2][2], B1[2][2];
    const char* cA = (const char*)g.A + (size_t)cur.pm * tstep; const char* cB = (const char*)g.Bt + (size_t)cur.pn * tstep;
    S.a_ready(cur);
    if constexpr (SP2) {
        PG8_STAGE(PG8_SB(0, 0), cB, voffB); PG8_STAGE(PG8_SB(0, 1), cB + hstep, voffB); PG8_STAGE(PG8_SA(0, 0), cA, voffA); PG8_STAGE(PG8_SA(0, 1), cA + hstep, voffA);
        if (wr == 1) PG8_BAR;
        PG8_WAIT_V(2); PG8_BAR;
        PG8_STAGE(PG8_SB(1, 0), cB + kstep, voffB); PG8_STAGE(PG8_SA(1, 0), cA + kstep, voffA); PG8_STAGE(PG8_SB(1, 1), cB + hstep + kstep, voffB);
        PG8_WAIT_V(6); PG8_BAR;
    } else {
        PG8_STAGE(PG8_SB(0, 0), cB, voffB); PG8_STAGE(PG8_SA(0, 0), cA, voffA); PG8_STAGE(PG8_SB(0, 1), cB + hstep, voffB); PG8_STAGE(PG8_SA(0, 1), cA + hstep, voffA);
        if (wr == 1) PG8_BAR;
        PG8_WAIT_V(4); PG8_BAR;
        PG8_STAGE(PG8_SB(1, 0), cB + kstep, voffB); PG8_STAGE(PG8_SA(1, 0), cA + kstep, voffA); PG8_STAGE(PG8_SB(1, 1), cB + hstep + kstep, voffB);
        PG8_WAIT_V(6); PG8_BAR;
    }
    for (;;) {
        const bool has_next = S.next(ui + 1, nxt);
        const char* nA = has_next ? (const char*)g.A + (size_t)nxt.pm * tstep : cA; const char* nB = has_next ? (const char*)g.Bt + (size_t)nxt.pn * tstep : cB;
        for (int t = 0; t < nt; t += 2) {
            const bool last = (t == nt - 2);
            const char* a1 = cA + (size_t)(t + 1) * kstep;
            const char* a2 = last ? nA : cA + (size_t)(t + 2) * kstep; const char* b2 = last ? nB : cB + (size_t)(t + 2) * kstep;
            const char* a3 = a2 + kstep; const char* b3 = b2 + kstep;
            if (last && has_next) S.a_ready(nxt);
            if constexpr (SP2) {
            PG8_LDB(B0, 0, 0); PG8_LDB(B1, 0, 1); PG8_SCHED; PG8_LDA(At, 0, 0); PG8_STAGE(PG8_SA(1, 1), a1 + hstep, voffA);
            PG8_WAIT_V(8); PG8_WAIT_L(0); PG8_BAR; PG8_MMA(0, 0, At, B0); PG8_MMA(0, 1, At, B1); PG8_BAR; PG8_SCHED;
            PG8_LDA(At, 0, 1); PG8_STAGE(PG8_SB(0, 0), b2, voffB); PG8_STAGE(PG8_SB(0, 1), b2 + hstep, voffB); PG8_STAGE(PG8_SA(0, 0), a2, voffA);
            PG8_WAIT_V(8); PG8_WAIT_L(0); PG8_BAR; PG8_MMA(1, 0, At, B0); PG8_MMA(1, 1, At, B1); PG8_BAR; PG8_SCHED;
            PG8_LDB(B0, 1, 0); PG8_LDB(B1, 1, 1); PG8_SCHED; PG8_LDA(At, 1, 0); PG8_STAGE(PG8_SA(0, 1), a2 + hstep, voffA);
            PG8_WAIT_V(8); PG8_WAIT_L(0); PG8_BAR; PG8_MMA(0, 0, At, B0); PG8_MMA(0, 1, At, B1); PG8_BAR; PG8_SCHED;
            PG8_LDA(At, 1, 1); PG8_STAGE(PG8_SB(1, 0), b3, voffB); PG8_STAGE(PG8_SB(1, 1), b3 + hstep, voffB); PG8_STAGE(PG8_SA(1, 0), a3, voffA);
            PG8_WAIT_V(8); PG8_WAIT_L(0); PG8_BAR; PG8_MMA(1, 0, At, B0); PG8_MMA(1, 1, At, B1); PG8_BAR; PG8_SCHED;
            } else {
            PG8_LDB(B0, 0, 0); PG8_SCHED; PG8_LDA(At, 0, 0); PG8_STAGE(PG8_SA(1, 1), a1 + hstep, voffA);
            PG8_WAIT_L(8); PG8_BAR; PG8_WAIT_L(0); PG8_MMA(0, 0, At, B0); PG8_BAR; PG8_SCHED;
            PG8_LDB(B1, 0, 1); PG8_STAGE(PG8_SB(0, 0), b2, voffB);
            PG8_BAR; PG8_WAIT_L(0); PG8_MMA(0, 1, At, B1); PG8_BAR;
            PG8_LDA(At, 0, 1); PG8_STAGE(PG8_SA(0, 0), a2, voffA);
            PG8_BAR; PG8_WAIT_L(0); PG8_MMA(1, 0, At, B0); PG8_BAR; PG8_SCHED;
            PG8_STAGE(PG8_SB(0, 1), b2 + hstep, voffB);
            PG8_WAIT_V(6); PG8_BAR; PG8_MMA(1, 1, At, B1); PG8_BAR;
            PG8_LDB(B0, 1, 0); PG8_SCHED; PG8_LDA(At, 1, 0); PG8_STAGE(PG8_SA(0, 1), a2 + hstep, voffA);
            PG8_WAIT_L(8); PG8_BAR; PG8_WAIT_L(0); PG8_MMA(0, 0, At, B0); PG8_BAR; PG8_SCHED;
            PG8_LDB(B1, 1, 1); PG8_STAGE(PG8_SB(1, 0), b3, voffB);
            PG8_BAR; PG8_WAIT_L(0); PG8_MMA(0, 1, At, B1); PG8_BAR;
            PG8_LDA(At, 1, 1); PG8_STAGE(PG8_SA(1, 0), a3, voffA);
            PG8_BAR; PG8_WAIT_L(0); PG8_MMA(1, 0, At, B0); PG8_BAR; PG8_SCHED;
            PG8_STAGE(PG8_SB(1, 1), b3 + hstep, voffB);
            PG8_WAIT_V(6); PG8_BAR; PG8_MMA(1, 1, At, B1); PG8_BAR;
            }
        }
        if constexpr (ALIGN_EPI) { if (wr == 0) PG8_BAR; }
        if constexpr (!Epi::AFTER_DRAIN) { E(acc, cur, wr, wc, fr, fq); S.done(cur); }
        if (!has_next) break;
#pragma unroll
        for (int a = 0; a < 2; ++a)
#pragma unroll
            for (int b = 0; b < 2; ++b)
#pragma unroll
                for (int m = 0; m < 4; ++m)
#pragma unroll
                    for (int n = 0; n < 2; ++n) acc[a][b][m][n] = (f32x4){0.f, 0.f, 0.f, 0.f};
        cur = nxt; cA = nA; cB = nB; ++ui;
        if constexpr (ALIGN_EPI) { if (wr == 1) PG8_BAR; }
    }
    PG8_WAIT_V(0);
    if constexpr (!ALIGN_EPI) { if (wr == 0) PG8_BAR; }
    PG8_BAR;
    if constexpr (Epi::AFTER_DRAIN) { E.fused(acc, cur, wr, wc, fr, fq, lds, wid, lane); S.done(cur); }
#undef PG8_SA
#undef PG8_SB
#undef PG8_STAGE
#undef PG8_LDA
#undef PG8_LDB
#undef PG8_MMA
#undef PG8_WAIT_V
#undef PG8_WAIT_L
#undef PG8_BAR
#undef PG8_SCHED
}
}
#define GAS __attribute__((address_space(1)))
#define LAS __attribute__((address_space(3)))
typedef GAS unsigned gu32;
typedef GAS unsigned long long gu64;
#define RLX_AGENT __ATOMIC_RELAXED, __HIP_MEMORY_SCOPE_AGENT
#define LDS_WAIT() asm volatile("s_waitcnt lgkmcnt(0)" ::: "memory")
#define VM_WAIT() asm volatile("s_waitcnt vmcnt(0)" ::: "memory")
__device__ __forceinline__ unsigned long long rt() { return __builtin_amdgcn_s_memrealtime(); }
#define XB_TMO      128
#define XB_XCNT(j)  (256  + 64 * (j))
#define XB_XSUB(j)  (1280 + 64 * (j))
#define XB_XGEN(j)  (2304 + 64 * (j))
#define XB_TOP      3328
#define XB_TOPGEN   3392
#define XCD_BAR_WORDS 3456
#define XB_SPIN_CAP (1u << 18)

__device__ __forceinline__ unsigned xb_ld(unsigned* p)              { return __hip_atomic_load(p, __ATOMIC_RELAXED, __HIP_MEMORY_SCOPE_AGENT); }
__device__ __forceinline__ unsigned xb_add(unsigned* p, unsigned v) { return __hip_atomic_fetch_add(p, v, __ATOMIC_RELAXED, __HIP_MEMORY_SCOPE_AGENT); }
__device__ __forceinline__ unsigned xb_xcc_id() { return (unsigned)__builtin_amdgcn_s_getreg((3 << 11) | 20) & 0xFu; }
#define XB_SPIN(cond, bar) do { unsigned _sp = 0; while (cond) { __builtin_amdgcn_s_sleep(1); \
    if ((++_sp & 255u) == 0u) { if (xb_ld(&(bar)[XB_TMO])) break; if (_sp > XB_SPIN_CAP) { atomicAdd(&(bar)[XB_TMO], 1u); break; } } } } while (0)

struct XcdBarrier {
    unsigned* bar; unsigned x;
    volatile LAS unsigned* st;
};

__device__ __forceinline__ XcdBarrier xcd_barrier_post(unsigned* bar, volatile LAS unsigned* st) {
    XcdBarrier b; b.bar = bar; b.x = xb_xcc_id(); b.st = st;
    if (threadIdx.x == 0) (void)xb_add(&bar[XB_XCNT(b.x)], 1u);
    return b;
}
__device__ __forceinline__ void xcd_barrier_complete(unsigned* bar, unsigned x, unsigned& nloc, unsigned& nx) {
    const unsigned G = gridDim.x * gridDim.y * gridDim.z;
    unsigned sum, cnt, mine, sp = 0u;
    for (;;) {
        sum = 0u; cnt = 0u; mine = 0u;
#pragma unroll
        for (unsigned j = 0; j < 16; ++j) { const unsigned c = xb_ld(&bar[XB_XCNT(j)]); sum += c; cnt += (c > 0u) ? 1u : 0u; mine = (j == x) ? c : mine; }
        if (sum == G) break;
        __builtin_amdgcn_s_sleep(1);
        if ((++sp & 255u) == 0u) { if (xb_ld(&bar[XB_TMO])) break; if (sp > XB_SPIN_CAP) { atomicAdd(&bar[XB_TMO], 1u); break; } }
    }
    nloc = mine > 0u ? mine : 1u; nx = cnt > 0u ? cnt : 1u;
}

__device__ __forceinline__ void xcd_barrier(const XcdBarrier& b) {
    asm volatile("s_waitcnt vmcnt(0)" ::: "memory");
    __syncthreads();
    if (threadIdx.x == 0) {
        unsigned* bar = b.bar;
        __builtin_amdgcn_s_waitcnt(0);
        unsigned nloc = b.st[0], nx = b.st[1];
        if (nloc == 0u) { xcd_barrier_complete(bar, b.x, nloc, nx); b.st[0] = nloc; b.st[1] = nx; }
        const unsigned old = xb_add(&bar[XB_XSUB(b.x)], 1u);
        const unsigned gen = old / nloc;
        if (old + 1u == (gen + 1u) * nloc) {
            __builtin_amdgcn_fence(__ATOMIC_RELEASE, "agent");
            asm volatile("s_waitcnt vmcnt(0)" ::: "memory");
            const unsigned og = xb_add(&bar[XB_TOP], 1u);
            const unsigned tg = og / nx;
            if (og + 1u == (tg + 1u) * nx) xb_add(&bar[XB_TOPGEN], 1u);
            else XB_SPIN(xb_ld(&bar[XB_TOPGEN]) == tg, bar);
            __builtin_amdgcn_fence(__ATOMIC_ACQUIRE, "agent");
            xb_add(&bar[XB_XGEN(b.x)], 1u);
            asm volatile("s_waitcnt vmcnt(0)" ::: "memory");
        } else {
            XB_SPIN(xb_ld(&bar[XB_XGEN(b.x)]) == gen, bar);
            __builtin_amdgcn_fence(__ATOMIC_ACQUIRE, "agent");
            asm volatile("s_waitcnt vmcnt(0)" ::: "memory");
        }
    }
    __syncthreads();
}


constexpr int NB = 2, SEQ = 8192, DM = 1024, DEPTH = 4, NMETA = 16, LP = 8320, M = NB * LP;
constexpr int N_IN = 5384, N1 = 5376, NRW = 1792, NGT = 2048, DFF = 2816, NUP = 5632;
constexpr float LOG2E = 1.4426950408889634f;
constexpr float QSCALE = 0.125f * LOG2E;
constexpr float THR2 = 30.0f * LOG2E;
constexpr int NWAVES = 8, NTHR = 512, MMAIN = 16384;
constexpr int LDS_BYTES = 147456, MISC_OFF = 147456 - 128;

typedef unsigned short bf16;
typedef float f32x4 __attribute__((ext_vector_type(4)));
typedef unsigned u32x4 __attribute__((ext_vector_type(4)));
typedef unsigned u32x2 __attribute__((ext_vector_type(2)));
typedef short bf16x8 __attribute__((ext_vector_type(8)));

constexpr size_t SZ_H = (size_t)M * DM * 4, SZ_X512 = (size_t)M * 512 * 2;
constexpr size_t OFF_CTL = 0, OFF_H = 1u << 20, OFF_WT = OFF_H + SZ_H;
constexpr size_t WT_IN = 0, WT_BF = WT_IN + (size_t)N1 * 1024, WT_BR = WT_BF + 1024 * 512, WT_O = WT_BR + 1024 * 512,
                 WT_UP = WT_O + 1024 * 1024, WT_DN = WT_UP + (size_t)NUP * 1024, WT_LW = WT_DN + (size_t)1024 * DFF, WT_LA = WT_LW + 512 * 64, WT_LG = WT_LA + 512 * 64, WT_END = WT_LG + 512 * 128;
constexpr size_t OFF_HN = OFF_WT + WT_END * 2;
constexpr size_t OFF_Q = OFF_HN + 2 * SZ_X512, OFF_K = OFF_Q + SZ_X512, OFF_V = OFF_K + SZ_X512;
constexpr size_t OFF_RW = OFF_V + SZ_X512, OFF_GT = OFF_RW + (size_t)M * NRW * 2, OFF_MISC = OFF_GT + (size_t)M * NGT * 2;
constexpr size_t OFF_T0 = OFF_MISC + 2 * 16 * LP * 4, OFF_OF = OFF_T0 + 2 * SZ_X512, WS_NEED = OFF_OF + SZ_X512;
static_assert(OFF_HN % 256 == 0 && OFF_RW % 256 == 0 && OFF_T0 % 256 == 0, "alignment");

struct Params { const float* in[26]; float* out; unsigned char* ws; };
struct Ctx { int tid, lane, wave, bid, G; unsigned char* lds; unsigned char* ws; };

__device__ __forceinline__ float bf2f(unsigned b) { return __uint_as_float(b << 16); }
__device__ __forceinline__ float bflo(unsigned w) { return __uint_as_float(w << 16); }
__device__ __forceinline__ float bfhi(unsigned w) { return __uint_as_float(w & 0xffff0000u); }
typedef float f32x2_t_ __attribute__((ext_vector_type(2))); typedef __bf16 bf16x2_t_ __attribute__((ext_vector_type(2)));
__device__ __forceinline__ unsigned pk2(float lo, float hi) { const f32x2_t_ v = {lo, hi}; const bf16x2_t_ r = __builtin_convertvector(v, bf16x2_t_); return __builtin_bit_cast(unsigned, r); }
__device__ __forceinline__ unsigned f2bf(float f) { return pk2(f, 0.f) & 0xffffu; }
__device__ __forceinline__ float wave_sum(float v) {
#pragma unroll
    for (int o = 1; o < 64; o <<= 1) v += __shfl_xor(v, o);
    return v;
}
__device__ __forceinline__ float sigmoidf_(float x) { return __builtin_amdgcn_rcpf(1.f + __expf(-x)); }
template <int CTRL> __device__ __forceinline__ float dppf(float old, float x) {
    return __int_as_float(__builtin_amdgcn_update_dpp(__float_as_int(old), __float_as_int(x), CTRL, 0xf, 0xf, false));
}
__device__ __forceinline__ float allreduce16(float x) {
    x += dppf<0x121>(0.f, x); x += dppf<0x122>(0.f, x); x += dppf<0x124>(0.f, x); x += dppf<0x128>(0.f, x); return x;
}

namespace pg8 {
struct EpiRoute {
    static constexpr bool PERM = true, AFTER_DRAIN = false;
    unsigned char* ws;
    __device__ __forceinline__ void operator()(const f32x4 (&acc)[2][2][4][2], const Unit& u, int wr, int wc, int fr, int fq) const {
        const int pn = u.pn; size_t off; int ldc, colt;
        if (pn < 6) { off = OFF_Q + (size_t)(pn >> 1) * SZ_X512; ldc = 512; colt = (pn & 1) * 256; }
        else if (pn < 13) { off = OFF_RW; ldc = NRW; colt = (pn - 6) * 256; }
        else { off = OFF_GT; ldc = NGT; colt = (pn - 13) * 256; }
        bf16_t* base = (bf16_t*)(ws + off);
        const int row0 = u.pm * BM + wr * 64 + fr, col0 = colt + wc * 32 + 8 * fq;
#pragma unroll
        for (int ai = 0; ai < 2; ++ai)
#pragma unroll
            for (int m = 0; m < 4; ++m) { bf16_t* rowp = base + (size_t)(row0 + ai * HALF + m * 16) * ldc + col0;
#pragma unroll
                for (int bj = 0; bj < 2; ++bj) { const f32x4 v0 = acc[ai][bj][m][0], v1 = acc[ai][bj][m][1];
                    u32x4 w; w.x = cvt_pk_bf16(v0[0], v0[1]); w.y = cvt_pk_bf16(v0[2], v0[3]); w.z = cvt_pk_bf16(v1[0], v1[1]); w.w = cvt_pk_bf16(v1[2], v1[3]);
                    *(u32x4*)(rowp + bj * HALF) = w; } }
    }
};
template <int MODE> struct EpiGate {
    static constexpr bool PERM = true, AFTER_DRAIN = false;
    bf16_t* O; const bf16_t* GT; const float* gb;
    __device__ __forceinline__ void operator()(const f32x4 (&acc)[2][2][4][2], const Unit& u, int wr, int wc, int fr, int fq) const {
        const int row0 = u.pm * BM + wr * 64 + fr, col0 = u.pn * BM + wc * 32 + 8 * fq;
#pragma unroll
        for (int bj = 0; bj < 2; ++bj) {
            const int c = col0 + bj * HALF;
            const f32x4 b0 = *(const f32x4*)(gb + MODE * 1024 + c), b1 = *(const f32x4*)(gb + MODE * 1024 + c + 4);
#pragma unroll
            for (int ai = 0; ai < 2; ++ai)
#pragma unroll
                for (int m = 0; m < 4; ++m) {
                    const size_t row = (size_t)(row0 + ai * HALF + m * 16);
                    const u32x4 gw = *(const u32x4*)(GT + row * NGT + MODE * 1024 + c);
                    const f32x4 v0 = acc[ai][bj][m][0], v1 = acc[ai][bj][m][1];
                    float r[8];
                    r[0] = sigmoidf_(bflo(gw.x) + b0[0]) * v0[0]; r[1] = sigmoidf_(bfhi(gw.x) + b0[1]) * v0[1];
                    r[2] = sigmoidf_(bflo(gw.y) + b0[2]) * v0[2]; r[3] = sigmoidf_(bfhi(gw.y) + b0[3]) * v0[3];
                    r[4] = sigmoidf_(bflo(gw.z) + b1[0]) * v1[0]; r[5] = sigmoidf_(bfhi(gw.z) + b1[1]) * v1[1];
                    r[6] = sigmoidf_(bflo(gw.w) + b1[2]) * v1[2]; r[7] = sigmoidf_(bfhi(gw.w) + b1[3]) * v1[3];
                    bf16_t* op = O + row * 1024 + c;
                    if (MODE == 1) { const u32x4 ow = *(const u32x4*)op;
                        r[0] += bflo(ow.x); r[1] += bfhi(ow.x); r[2] += bflo(ow.y); r[3] += bfhi(ow.y); r[4] += bflo(ow.z); r[5] += bfhi(ow.z); r[6] += bflo(ow.w); r[7] += bfhi(ow.w); }
                    u32x4 w; w.x = cvt_pk_bf16(r[0], r[1]); w.y = cvt_pk_bf16(r[2], r[3]); w.z = cvt_pk_bf16(r[4], r[5]); w.w = cvt_pk_bf16(r[6], r[7]);
                    *(u32x4*)op = w;
                }
        }
    }
};
struct EpiResid {
    static constexpr bool PERM = false, AFTER_DRAIN = false;
    float* H; float* OUT; int atomic;
    __device__ __forceinline__ void operator()(const f32x4 (&acc)[2][2][4][2], const Unit& u, int wr, int wc, int fr, int fq) const {
        const int row0 = u.pm * BM + wr * 64 + fr, col0 = u.pn * BM + wc * 32 + 4 * fq;
#pragma unroll
        for (int ai = 0; ai < 2; ++ai)
#pragma unroll
            for (int m = 0; m < 4; ++m) {
                const int row = row0 + ai * HALF + m * 16;
                float* hp = H + (size_t)row * DM + col0;
                const int b = row >= LP ? 1 : 0, t = row - b * LP;
                float* op = (OUT && t >= NMETA && t < NMETA + SEQ) ? OUT + ((size_t)b * SEQ + (t - NMETA)) * DM + col0 : nullptr;
#pragma unroll
                for (int bj = 0; bj < 2; ++bj)
#pragma unroll
                    for (int n = 0; n < 2; ++n) { const int co = bj * HALF + n * 16;
                        if (atomic) {
#pragma unroll
                            for (int e = 0; e < 4; ++e) unsafeAtomicAdd(hp + co + e, acc[ai][bj][m][n][e]);
                        } else {
                            const f32x4 v = *(const f32x4*)(hp + co) + acc[ai][bj][m][n];
                            if (OUT) { if (op) *(f32x4*)(op + co) = v; } else *(f32x4*)(hp + co) = v; } }
            }
    }
};
struct EpiResidAtomic {
    static constexpr bool PERM = false, AFTER_DRAIN = false;
    float* H;
    __device__ __forceinline__ void operator()(const f32x4 (&acc)[2][2][4][2], const Unit& u, int wr, int wc, int fr, int fq) const {
        const int row0 = u.pm * BM + wr * 64 + fr, col0 = u.pn * BM + wc * 32 + 4 * fq;
#pragma unroll
        for (int ai = 0; ai < 2; ++ai)
#pragma unroll
            for (int m = 0; m < 4; ++m) { float* hp = H + (size_t)(row0 + ai * HALF + m * 16) * DM + col0;
#pragma unroll
                for (int bj = 0; bj < 2; ++bj)
#pragma unroll
                    for (int n = 0; n < 2; ++n)
#pragma unroll
                        for (int e = 0; e < 4; ++e) unsafeAtomicAdd(hp + bj * HALF + n * 16 + e, acc[ai][bj][m][n][e]); }
    }
};
struct OneUnit {
    StaticOrder so; int mode, pm, pn; bool active;
    __device__ bool next(int i, Unit& u) const { if (mode == 0) return so.next(i, u); if (i != 0 || !active) return false; u.pm = pm; u.pn = pn; return true; }
    __device__ __forceinline__ void a_ready(const Unit&) const {}
    __device__ __forceinline__ void done(const Unit&) const {}
};
struct EpiUp {
    static constexpr bool PERM = true, AFTER_DRAIN = false;
    bf16_t* ACT; bf16_t* HALO; const float* cw;
    __device__ __forceinline__ void operator()(const f32x4 (&acc)[2][2][4][2], const Unit& u, int wr, int wc, int fr, int fq) const {
        const int chan0 = u.pn * 128 + wc * 32 + 8 * fq;
#pragma unroll
        for (int n = 0; n < 2; ++n) {
            const int ch = chan0 + 4 * n;
            f32x4 w[3][2];
#pragma unroll
            for (int j = 0; j < 3; ++j) { w[j][0] = *(const f32x4*)(cw + j * NUP + ch); w[j][1] = *(const f32x4*)(cw + j * NUP + DFF + ch); }
#pragma unroll
            for (int ai = 0; ai < 2; ++ai) {
                const int rowg = u.pm * BM + ai * HALF + wr * 64;
#pragma unroll
                for (int m = 0; m < 4; ++m) {
                    f32x4 uc[2];
#pragma unroll
                    for (int bj = 0; bj < 2; ++bj) {
                        const f32x4 cur = acc[ai][bj][m][n];
                        f32x4 prv; if (m > 0) prv = acc[ai][bj][m - 1][n]; else prv = (f32x4){0.f, 0.f, 0.f, 0.f};
                        f32x4 p1, p2;
#pragma unroll
                        for (int i = 0; i < 4; ++i) {
                            const float r1 = dppf<0x121>(0.f, prv[i]), r2 = dppf<0x122>(0.f, prv[i]);
                            p1[i] = dppf<0x111>(r1, cur[i]); p2[i] = dppf<0x112>(r2, cur[i]);
                        }
                        uc[bj] = w[0][bj] * p2 + w[1][bj] * p1 + w[2][bj] * cur;
                    }
                    float a[4];
#pragma unroll
                    for (int i = 0; i < 4; ++i) a[i] = uc[0][i] * sigmoidf_(uc[0][i]) * uc[1][i];
                    u32x2 o; o.x = cvt_pk_bf16(a[0], a[1]); o.y = cvt_pk_bf16(a[2], a[3]);
                    *(u32x2*)(ACT + (size_t)(rowg + m * 16 + fr) * DFF + ch) = o;
                    if ((m == 3 && fr >= 14) || (m == 0 && fr < 2)) {
                        const int slot = (rowg >> 6) * 4 + (m == 3 ? fr - 14 : 2 + fr);
#pragma unroll
                        for (int bj = 0; bj < 2; ++bj) { const f32x4 cur = acc[ai][bj][m][n]; u32x2 hw; hw.x = cvt_pk_bf16(cur[0], cur[1]); hw.y = cvt_pk_bf16(cur[2], cur[3]);
                            *(u32x2*)(HALO + (size_t)slot * NUP + bj * DFF + ch) = hw; }
                    }
                }
            }
        }
    }
};
}

#ifndef REP_PREP
#define REP_PREP 1
#endif
#ifndef REP_P3
#define REP_P3 1
#endif
#ifndef REP_SYNC
#define REP_SYNC 0
#endif
#define GLD(T, p) (*(const __attribute__((address_space(1))) T*)(p))
#define GST(T, p) (*(__attribute__((address_space(1))) T*)(p))
#define LDS_BARRIER() do { asm volatile("s_waitcnt lgkmcnt(0)" ::: "memory"); __builtin_amdgcn_s_barrier(); asm volatile("" ::: "memory"); } while (0)
__device__ __forceinline__ void transpose_item(const float* W, int Nsrc, int K, bf16* WT, int dst_row0, int src_col0, int k0, float* scr, int lane) {
#pragma unroll 8
    for (int i = 0; i < 32; ++i) { const int kk = 2 * i + (lane >> 5); scr[kk * 33 + (lane & 31)] = W[(size_t)(k0 + kk) * Nsrc + src_col0 + (lane & 31)]; }
    asm volatile("s_waitcnt lgkmcnt(0)" ::: "memory");
    const int c = lane & 7;
#pragma unroll
    for (int j = 0; j < 4; ++j) { const int n = (lane >> 3) + 8 * j; const float* s = scr + (8 * c) * 33 + n;
        u32x4 o; o.x = pk2(s[0 * 33], s[1 * 33]); o.y = pk2(s[2 * 33], s[3 * 33]); o.z = pk2(s[4 * 33], s[5 * 33]); o.w = pk2(s[6 * 33], s[7 * 33]);
        *(u32x4*)(WT + (size_t)(dst_row0 + n) * K + k0 + 8 * c) = o; }
    asm volatile("s_waitcnt lgkmcnt(0)" ::: "memory");
}
__device__ __forceinline__ void convert_weights(const Params& P, int l, const Ctx& c) {
    bf16* WT = (bf16*)(c.ws + OFF_WT);
    float* scr = (float*)(c.lds + c.wave * 16384);
    const int gw = c.bid * NWAVES + c.wave, NGW = c.G * NWAVES;
    constexpr int I_IN = 16 * 168, I_BF = 8 * 32, I_O = 16 * 32, I_UP = 16 * 176, I_DN = 44 * 32, I_LR = 16, I_LG = 32, I_ALL = I_IN + 2 * I_BF + I_O + I_UP + I_DN + 2 * I_LR + I_LG;
    for (int it = gw; it < I_ALL; it += NGW) {
        int r = it;
        if (r < I_IN) { const int kb = r / 168, n0 = 32 * (r % 168); transpose_item(P.in[4] + (size_t)l * 1024 * N_IN, N_IN, 1024, WT + WT_IN, n0, n0 + (n0 >= 1536 ? 8 : 0), 64 * kb, scr, c.lane); continue; } r -= I_IN;
        if (r < I_BF) { const int kb = r / 32, n0 = 32 * (r % 32); transpose_item(P.in[19] + (size_t)l * 512 * 1024, 1024, 512, WT + WT_BF, n0, n0, 64 * kb, scr, c.lane); continue; } r -= I_BF;
        if (r < I_BF) { const int kb = r / 32, n0 = 32 * (r % 32); transpose_item(P.in[20] + (size_t)l * 512 * 1024, 1024, 512, WT + WT_BR, n0, n0, 64 * kb, scr, c.lane); continue; } r -= I_BF;
        if (r < I_O) { const int kb = r / 32, n0 = 32 * (r % 32); transpose_item(P.in[22] + (size_t)l * 1024 * 1024, 1024, 1024, WT + WT_O, n0, n0, 64 * kb, scr, c.lane); continue; } r -= I_O;
        if (r < I_UP) { const int kb = r / 176, n0 = 32 * (r % 176); const int pn = n0 >> 8, bj = (n0 >> 7) & 1, x = n0 & 127;
            transpose_item(P.in[23] + (size_t)l * 1024 * NUP, NUP, 1024, WT + WT_UP, n0, bj * DFF + 128 * pn + x, 64 * kb, scr, c.lane); continue; } r -= I_UP;
        if (r < I_DN) { const int kb = r / 32, n0 = 32 * (r % 32); transpose_item(P.in[25] + (size_t)l * DFF * 1024, 1024, DFF, WT + WT_DN, n0, n0, 64 * kb, scr, c.lane); continue; } r -= I_DN;
        if (r < I_LR) { transpose_item(P.in[10] + (size_t)l * 64 * 512, 512, 64, WT + WT_LW, 32 * r, 32 * r, 0, scr, c.lane); continue; } r -= I_LR;
        if (r < I_LR) { transpose_item(P.in[12] + (size_t)l * 64 * 512, 512, 64, WT + WT_LA, 32 * r, 32 * r, 0, scr, c.lane); continue; } r -= I_LR;
        { const int kb = r / 16, n0 = 32 * (r % 16); transpose_item(P.in[13] + (size_t)l * 128 * 512, 512, 128, WT + WT_LG, n0, n0, 64 * kb, scr, c.lane); }
    }
}

template <bool FG> __device__ __forceinline__ void phase_norm(const Params& P, int l, const Ctx& c) {
    float* H = (float*)(c.ws + OFF_H); bf16* HN = (bf16*)(c.ws + OFF_HN);
    float* LOGF = (float*)(c.ws + OFF_MISC);
    const float* gain = (FG ? P.in[2] : P.in[3]) + l * DM;
    float* wfs = (float*)c.lds;
    if (FG) {
        __syncthreads();
        const float* win = P.in[4] + (size_t)l * 1024 * N_IN + 1536;
        for (int i = c.tid; i < 8192; i += NTHR) wfs[i] = win[(size_t)(i >> 3) * N_IN + (i & 7)];
        __syncthreads();
    }
    const int gw = c.bid * NWAVES + c.wave, NGW = c.G * NWAVES;
    for (int m = gw; m < M; m += NGW) {
        const int b = m >= LP ? 1 : 0, t = m - b * LP;
        f32x4 v[4];
        if (FG && l == 0) {
            const float* src = (t < NMETA) ? P.in[1] + (size_t)t * DM : P.in[0] + ((size_t)b * SEQ + (t - NMETA)) * DM;
            const bool real = t < NMETA + SEQ;
#pragma unroll
            for (int j = 0; j < 4; ++j) { v[j] = real ? *(const f32x4*)(src + 4 * c.lane + 256 * j) : (f32x4){0.f, 0.f, 0.f, 0.f}; *(f32x4*)(H + (size_t)m * DM + 4 * c.lane + 256 * j) = v[j]; }
        } else {
#pragma unroll
            for (int j = 0; j < 4; ++j) v[j] = *(const f32x4*)(H + (size_t)m * DM + 4 * c.lane + 256 * j);
        }
        float ss = 0.f;
#pragma unroll
        for (int j = 0; j < 4; ++j) ss += (v[j].x * v[j].x + v[j].y * v[j].y) + (v[j].z * v[j].z + v[j].w * v[j].w);
        const float rstd = 1.0f / sqrtf(wave_sum(ss) * (1.f / DM) + 1e-6f);
        float f[8];
#pragma unroll
        for (int q = 0; q < 8; ++q) f[q] = 0.f;
#pragma unroll
        for (int j = 0; j < 4; ++j) {
            const f32x4 g = *(const f32x4*)(gain + 4 * c.lane + 256 * j);
            v[j] = v[j] * rstd * g;
            u32x2 o; o.x = pk2(v[j].x, v[j].y); o.y = pk2(v[j].z, v[j].w);
            *(u32x2*)(HN + (size_t)m * DM + 4 * c.lane + 256 * j) = o;
            if (FG) {
#pragma unroll
                for (int e = 0; e < 4; ++e) { const int k = 4 * c.lane + 256 * j + e; const f32x4 w0 = *(const f32x4*)(wfs + k * 8), w1 = *(const f32x4*)(wfs + k * 8 + 4);
                    const float hv = v[j][e];
                    f[0] += hv * w0.x; f[1] += hv * w0.y; f[2] += hv * w0.z; f[3] += hv * w0.w; f[4] += hv * w1.x; f[5] += hv * w1.y; f[6] += hv * w1.z; f[7] += hv * w1.w; }
            }
        }
        if (FG) {
#pragma unroll
            for (int q = 0; q < 8; ++q) f[q] = wave_sum(f[q]);
            float fv = f[0];
#pragma unroll
            for (int q = 1; q < 8; ++q) fv = (c.lane == q) ? f[q] : fv;
            if (c.lane < 8) { const float x = fv + P.in[7][l * 8 + c.lane]; const float ls = fminf(x, 0.f) - __logf(1.f + __expf(-fabsf(x))); LOGF[(size_t)(b * 8 + c.lane) * LP + t] = ls; }
        }
    }
}

__device__ __forceinline__ void phase_fcum(const Params& P, const Ctx& c) {
    if (c.bid < 16 && c.wave == 0) {
        const float* LOGF = (const float*)(c.ws + OFF_MISC) + (size_t)c.bid * LP; float* FC = (float*)(c.ws + OFF_MISC) + 16 * LP + (size_t)c.bid * LP;
        float carry = 0.f;
        for (int ch = 0; ch < LP / 64; ++ch) {
            float v = LOGF[ch * 64 + c.lane];
#pragma unroll
            for (int o = 1; o < 64; o <<= 1) { const float t = __shfl_up(v, o); if (c.lane >= o) v += t; }
            v += carry; FC[ch * 64 + c.lane] = v * LOG2E; carry = __shfl(v, 63);
        }
    }
}

__device__ __forceinline__ void phase_qknorm(const Params& P, int l, const Ctx& c) {
    bf16* Q = (bf16*)(c.ws + OFF_Q); bf16* K = (bf16*)(c.ws + OFF_K);
    const int gw = c.bid * NWAVES + c.wave, NGW = c.G * NWAVES;
    const int d0 = (c.lane & 7) * 8;
    float gq[8], gk[8];
#pragma unroll
    for (int i = 0; i < 8; ++i) { gq[i] = P.in[5][l * 64 + d0 + i] * QSCALE; gk[i] = P.in[6][l * 64 + d0 + i]; }
    for (int m = gw; m < M; m += NGW) {
#pragma unroll
        for (int which = 0; which < 2; ++which) {
            bf16* p = (which ? K : Q) + (size_t)m * 512 + 8 * c.lane;
            const u32x4 w = *(const u32x4*)p;
            float x[8] = {bflo(w.x), bfhi(w.x), bflo(w.y), bfhi(w.y), bflo(w.z), bfhi(w.z), bflo(w.w), bfhi(w.w)};
            float ss = 0.f;
#pragma unroll
            for (int i = 0; i < 8; ++i) ss += x[i] * x[i];
            ss += __shfl_xor(ss, 1); ss += __shfl_xor(ss, 2); ss += __shfl_xor(ss, 4);
            const float rs = 1.0f / sqrtf(ss * (1.f / 64.f) + 1e-6f);
#pragma unroll
            for (int i = 0; i < 8; ++i) x[i] = x[i] * rs * (which ? gk[i] : gq[i]);
            u32x4 o; o.x = pk2(x[0], x[1]); o.y = pk2(x[2], x[3]); o.z = pk2(x[4], x[5]); o.w = pk2(x[6], x[7]);
            *(u32x4*)p = o;
        }
    }
}

constexpr int NCHK = LP / 64;
constexpr int NUNIT = NB * NCHK * 8;
constexpr int UNIT_A = 16384, UNIT_B = 16640;
constexpr int ST = 72, STG = 136;
constexpr int L_F0 = 92160, L_F1 = 108544;
struct RwkvBufs { bf16 *BON, *G; unsigned char *UA, *UB; float* Y; bf16* ORW; };
__device__ __forceinline__ RwkvBufs rwkv_bufs(const Params& P, const Ctx& c) {
    RwkvBufs r; r.BON = (bf16*)(c.ws + OFF_HN); r.G = r.BON + (size_t)M * 512;
    r.UA = c.ws + OFF_T0; r.UB = (unsigned char*)P.out;
    r.Y = (float*)(c.ws + OFF_RW); r.ORW = (bf16*)(c.ws + OFF_RW + (size_t)M * 512 * 4);
    return r;
}
__device__ __forceinline__ void mm_tile(const bf16* A, int sa, const bf16* Bt, int sb, int nks, f32x4 (&acc)[2], int w, int lq, int g) {
    const int mt = w >> 1, nt0 = 2 * (w & 1);
    for (int ks = 0; ks < nks; ++ks) {
        const bf16x8 a = *(const bf16x8*)(A + (16 * mt + lq) * sa + 32 * ks + 8 * g);
#pragma unroll
        for (int q = 0; q < 2; ++q) { const bf16x8 b = *(const bf16x8*)(Bt + (16 * (nt0 + q) + lq) * sb + 32 * ks + 8 * g); acc[q] = __builtin_amdgcn_mfma_f32_16x16x32_bf16(a, b, acc[q], 0, 0, 0); }
    }
}
template <bool SA, bool SB> __device__ __forceinline__ void mm_tile2(const bf16* A, int sa, const bf16* Bt, int sb, int nks, f32x4 (&acc)[2], int w, int lq, int g) {
    const int mt = w >> 1, nt0 = 2 * (w & 1);
    const int ra = 16 * mt + lq, xa = SA ? 8 * ((ra >> 3) & 7) : 0;
    for (int ks = 0; ks < nks; ++ks) {
        const bf16x8 a = *(const bf16x8*)(A + ra * sa + ((32 * ks + 8 * g) ^ xa));
#pragma unroll
        for (int q = 0; q < 2; ++q) { const int rb = 16 * (nt0 + q) + lq, xb = SB ? 8 * ((rb >> 3) & 7) : 0;
            const bf16x8 bb = *(const bf16x8*)(Bt + rb * sb + ((32 * ks + 8 * g) ^ xb)); acc[q] = __builtin_amdgcn_mfma_f32_16x16x32_bf16(a, bb, acc[q], 0, 0, 0); }
    }
}
#define ZACC(a) do { a[0] = (f32x4){0.f, 0.f, 0.f, 0.f}; a[1] = (f32x4){0.f, 0.f, 0.f, 0.f}; } while (0)
__device__ __forceinline__ int permk(int k) { return 32 * (k >> 5) + 8 * ((k & 15) >> 2) + 4 * ((k >> 4) & 1) + (k & 3); }
__device__ __forceinline__ int swz(int row, int col) { return row * 128 + ((((col >> 3) ^ (row >> 1)) & 7) << 4) + (col & 7) * 2; }

__device__ __forceinline__ void rwkv_prep_unit(const Params& P, int l, const Ctx& c, int u, const RwkvBufs& B) {
    const int h = u & 7, bc = u >> 3, b = bc / NCHK, ch = bc - b * NCHK;
    const size_t m0 = (size_t)b * LP + ch * 64;
    int tid_ = c.tid; asm volatile("" : "+v"(tid_));
    const int tid = tid_, lane = tid & 63, w = c.wave, lq = lane & 15, g = lane >> 4;
    const int t = tid >> 3, cg = tid & 7, c0 = cg * 8, jb = h * 64 + c0;
    unsigned char* L = c.lds;
    bf16* A0 = (bf16*)L; bf16* A1 = A0 + 4608; bf16* A2 = A1 + 4608; bf16* A3 = A2 + 4608; bf16* A4 = A3 + 4608; bf16* A5 = A4 + 4608; bf16* A6 = A5 + 4608;
    bf16* A7 = A6 + 4608; bf16* A8 = A7 + 4608; bf16* A9 = A8 + 4608;
    float* F0 = (float*)(L + L_F0); float* F1 = (float*)(L + L_F1);
    const bf16* RW = (const bf16*)(c.ws + OFF_RW);
    const bf16* WT = (const bf16*)(c.ws + OFF_WT);
    const float* mu = P.in[8] + l * NRW;
    const bool first = (ch == 0 && t == 0);
    const bf16* cur = RW + (m0 + t) * NRW; const bf16* prv = cur - NRW;
    float zr[8], zk[8], zv[8];
#pragma unroll
    for (int s = 0; s < 3; ++s) {
        const u32x4 cw = *(const u32x4*)(cur + s * 512 + jb); u32x4 pw = (u32x4){0u, 0u, 0u, 0u}; if (!first) pw = *(const u32x4*)(prv + s * 512 + jb);
        const float cv[8] = {bflo(cw.x), bfhi(cw.x), bflo(cw.y), bfhi(cw.y), bflo(cw.z), bfhi(cw.z), bflo(cw.w), bfhi(cw.w)};
        const float pv[8] = {bflo(pw.x), bfhi(pw.x), bflo(pw.y), bfhi(pw.y), bflo(pw.z), bfhi(pw.z), bflo(pw.w), bfhi(pw.w)};
#pragma unroll
        for (int i = 0; i < 8; ++i) { const float z = cv[i] + mu[s * 512 + jb + i] * (pv[i] - cv[i]); if (s == 0) zr[i] = z; else if (s == 1) zk[i] = z; else zv[i] = z; }
    }
#pragma unroll
    for (int q4 = 0; q4 < 4; ++q4) {
        const int col = cg * 32 + q4 * 8;
        const u32x4 cw = *(const u32x4*)(cur + 1536 + col); u32x4 pw = (u32x4){0u, 0u, 0u, 0u}; if (!first) pw = *(const u32x4*)(prv + 1536 + col);
        const float cv[8] = {bflo(cw.x), bfhi(cw.x), bflo(cw.y), bfhi(cw.y), bflo(cw.z), bfhi(cw.z), bflo(cw.w), bfhi(cw.w)};
        const float pv[8] = {bflo(pw.x), bfhi(pw.x), bflo(pw.y), bfhi(pw.y), bflo(pw.z), bfhi(pw.z), bflo(pw.w), bfhi(pw.w)};
        float z[8];
#pragma unroll
        for (int i = 0; i < 8; ++i) { z[i] = cv[i] + mu[1536 + col + i] * (pv[i] - cv[i]); if (col < 64) z[i] = 1.f - 2.f / (1.f + __expf(2.f * z[i])); else if (col >= 128) z[i] = sigmoidf_(z[i]); }
        u32x4 o; o.x = pk2(z[0], z[1]); o.y = pk2(z[2], z[3]); o.z = pk2(z[4], z[5]); o.w = pk2(z[6], z[7]);
        bf16* dst = (col < 64) ? A0 + t * ST + col : (col < 128 ? A1 + t * ST + (col - 64) : A2 + t * STG + (col - 128));
        *(u32x4*)dst = o;
    }
    { const int row = tid >> 3, chk = tid & 7;
      *(u32x4*)(A4 + row * ST + chk * 8) = *(const u32x4*)(WT + WT_LW + (size_t)(h * 64 + row) * 64 + chk * 8);
      *(u32x4*)(A5 + row * ST + chk * 8) = *(const u32x4*)(WT + WT_LA + (size_t)(h * 64 + row) * 64 + chk * 8);
#pragma unroll
      for (int i = 0; i < 2; ++i) { const int idx = tid + 512 * i, r2 = idx >> 4, c2 = idx & 15;
          *(u32x4*)((bf16*)F1 + r2 * STG + c2 * 8) = *(const u32x4*)(WT + WT_LG + (size_t)(h * 64 + r2) * 128 + c2 * 8); } }
    LDS_BARRIER();
    { f32x4 aw[2], aa[2], ag[2]; ZACC(aw); ZACC(aa); ZACC(ag);
      mm_tile(A4, ST, A0, ST, 2, aw, w, lq, g); mm_tile(A5, ST, A1, ST, 2, aa, w, lq, g); mm_tile((const bf16*)F1, STG, A2, STG, 4, ag, w, lq, g);
      const int mt = w >> 1, nt0 = 2 * (w & 1);
#pragma unroll
      for (int q = 0; q < 2; ++q) { const int o = (16 * (nt0 + q) + lq) * ST + 16 * mt + 4 * g; u32x2 p;
          p.x = pk2(aw[q][0], aw[q][1]); p.y = pk2(aw[q][2], aw[q][3]); *(u32x2*)(A7 + o) = p;
          p.x = pk2(aa[q][0], aa[q][1]); p.y = pk2(aa[q][2], aa[q][3]); *(u32x2*)(A8 + o) = p;
          p.x = pk2(ag[q][0], ag[q][1]); p.y = pk2(ag[q][2], ag[q][3]); *(u32x2*)(A9 + o) = p; } }
    LDS_BARRIER();
    float kk[8], k2[8], ar[8];
    { const u32x4 lw = *(const u32x4*)(A7 + t * ST + c0), la = *(const u32x4*)(A8 + t * ST + c0), lg = *(const u32x4*)(A9 + t * ST + c0);
      const float fw[8] = {bflo(lw.x), bfhi(lw.x), bflo(lw.y), bfhi(lw.y), bflo(lw.z), bfhi(lw.z), bflo(lw.w), bfhi(lw.w)};
      const float fa[8] = {bflo(la.x), bfhi(la.x), bflo(la.y), bfhi(la.y), bflo(la.z), bfhi(la.z), bflo(la.w), bfhi(la.w)};
      float ss = 0.f, bs = 0.f;
#pragma unroll
      for (int i = 0; i < 8; ++i) { const int j = l * 512 + jb + i;
          const float xw = -(P.in[9][j] + fw[i]); const float sp = fmaxf(xw, 0.f) + __logf(1.f + __expf(-fabsf(xw)));
          F0[t * 64 + c0 + i] = __expf(-sp - 0.5f);
          ar[i] = sigmoidf_(P.in[11][j] + fa[i]);
          kk[i] = zk[i] * P.in[14][j]; ss += kk[i] * kk[i];
          k2[i] = zk[i] * (1.f + (ar[i] - 1.f) * P.in[15][j]);
          bs += zr[i] * k2[i] * P.in[16][j]; }
      ss += __shfl_xor(ss, 1); ss += __shfl_xor(ss, 2); ss += __shfl_xor(ss, 4);
      bs += __shfl_xor(bs, 1); bs += __shfl_xor(bs, 2); bs += __shfl_xor(bs, 4);
      const float inv = 1.0f / fmaxf(sqrtf(ss), 1e-12f);
#pragma unroll
      for (int i = 0; i < 8; ++i) kk[i] *= inv;
      u32x4 bo; bo.x = pk2(bs * zv[0], bs * zv[1]); bo.y = pk2(bs * zv[2], bs * zv[3]); bo.z = pk2(bs * zv[4], bs * zv[5]); bo.w = pk2(bs * zv[6], bs * zv[7]);
      *(u32x4*)(B.BON + (m0 + t) * 512 + jb) = bo; *(u32x4*)(B.G + (m0 + t) * 512 + jb) = lg; }
    LDS_BARRIER();
    {
      const int k = tid & 63, sg = tid >> 6; float e[8], run = 0.f;
#pragma unroll
      for (int s = 0; s < 8; ++s) { run += F0[(8 * sg + s) * 64 + k]; e[s] = run; }
      F1[sg * 64 + k] = run;
      LDS_BARRIER();
      float off = 0.f;
#pragma unroll
      for (int s = 0; s < 8; ++s) off += (s < sg) ? F1[s * 64 + k] : 0.f;
#pragma unroll
      for (int s = 0; s < 8; ++s) F0[(8 * sg + s) * 64 + k] = e[s] + off; }
    LDS_BARRIER();
    { float ct[8], cp[8], cC[8];
#pragma unroll
      for (int i = 0; i < 8; ++i) { ct[i] = F0[t * 64 + c0 + i]; cp[i] = (t > 0) ? F0[(t - 1) * 64 + c0 + i] : 0.f; cC[i] = F0[63 * 64 + c0 + i]; }
      float at[8], bt[8], kt[8], rt[8], bh[8], kh[8];
#pragma unroll
      for (int i = 0; i < 8; ++i) { const float gt = __expf(-ct[i]), igt = __expf(ct[i]), gp = __expf(-cp[i]), gct = __expf(ct[i] - cC[i]);
          at[i] = -kk[i] * gp; bt[i] = kk[i] * ar[i] * igt; kt[i] = k2[i] * igt; rt[i] = zr[i] * gt; bh[i] = kk[i] * ar[i] * gct; kh[i] = k2[i] * gct; }
      u32x4 o;
      o.x = pk2(at[0], at[1]); o.y = pk2(at[2], at[3]); o.z = pk2(at[4], at[5]); o.w = pk2(at[6], at[7]); *(u32x4*)(A0 + t * ST + c0) = o;
      o.x = pk2(bt[0], bt[1]); o.y = pk2(bt[2], bt[3]); o.z = pk2(bt[4], bt[5]); o.w = pk2(bt[6], bt[7]); *(u32x4*)(A1 + t * ST + c0) = o;
      o.x = pk2(kt[0], kt[1]); o.y = pk2(kt[2], kt[3]); o.z = pk2(kt[4], kt[5]); o.w = pk2(kt[6], kt[7]); *(u32x4*)(A2 + t * ST + c0) = o;
      o.x = pk2(rt[0], rt[1]); o.y = pk2(rt[2], rt[3]); o.z = pk2(rt[4], rt[5]); o.w = pk2(rt[6], rt[7]); *(u32x4*)(A3 + t * ST + c0) = o;
#pragma unroll
      for (int i = 0; i < 8; ++i) { const int o = (c0 + i) * ST + (t ^ c0);
          A4[o] = (bf16)f2bf(bh[i]); A5[o] = (bf16)f2bf(kh[i]); A6[o] = (bf16)f2bf(zv[i]); F1[t * 128 + c0 + i] = at[i]; }
      if (t == 63) { float* gc = (float*)(B.UB + (size_t)u * UNIT_B + 16384) + c0;
#pragma unroll
          for (int i = 0; i < 8; ++i) gc[i] = __expf(-cC[i]); } }
    LDS_BARRIER();
    { const int mt = w >> 1, nt0 = 2 * (w & 1);
      f32x4 a[2];
      ZACC(a); mm_tile(A0, ST, A1, ST, 2, a, w, lq, g);
#pragma unroll
      for (int q = 0; q < 2; ++q) { const int i = 16 * (nt0 + q) + lq; f32x4 lab;
#pragma unroll
          for (int j = 0; j < 4; ++j) lab[j] = (i < 16 * mt + 4 * g + j) ? a[q][j] : 0.f;
#pragma unroll
          for (int j = 0; j < 4; ++j) F0[i * 64 + j * 16 + 4 * mt + g] = lab[j]; }
      asm volatile("" ::: "memory");
#define ST1_STORE(DST, INCL) do { _Pragma("unroll") for (int q = 0; q < 2; ++q) { const int tt = 16 * (nt0 + q) + lq, i0 = 16 * mt + 4 * g; float v_[4]; \
          _Pragma("unroll") for (int j = 0; j < 4; ++j) v_[j] = (i0 + j < tt + (INCL)) ? a[q][j] : 0.f; \
          u32x2 p_; p_.x = pk2(v_[0], v_[1]); p_.y = pk2(v_[2], v_[3]); *(u32x2*)((DST) + tt * ST + i0) = p_; } } while (0)
      ZACC(a); mm_tile(A2, ST, A0, ST, 2, a, w, lq, g); ST1_STORE(A7, 0); asm volatile("" ::: "memory");
      ZACC(a); mm_tile(A1, ST, A3, ST, 2, a, w, lq, g); ST1_STORE(A8, 1); asm volatile("" ::: "memory");
      ZACC(a); mm_tile(A2, ST, A3, ST, 2, a, w, lq, g); ST1_STORE(A9, 1);
#undef ST1_STORE
    }
    LDS_BARRIER();
    { const int mt = w >> 1, nt0 = 2 * (w & 1); f32x4 a[2]; ZACC(a);
      mm_tile2<true, false>(A6, ST, A7, ST, 2, a, w, lq, g);
#pragma unroll
      for (int q = 0; q < 2; ++q) *(f32x4*)(F1 + (16 * (nt0 + q) + lq) * 128 + 64 + 16 * mt + 4 * g) = a[q]; }
    LDS_BARRIER();
    { float X[16];
      const int col = 16 * w + lq;
#pragma unroll
      for (int r = 0; r < 16; ++r) X[r] = F1[(4 * r + g) * 128 + col];
      LDS_BARRIER();
      f32x4 Lc[4];
#pragma unroll
      for (int q = 0; q < 4; ++q) Lc[q] = *(const f32x4*)(F0 + g * 16 + 4 * q);
#pragma unroll
      for (int i = 0; i < 64; ++i) {
          const float xi = __shfl(X[i >> 2], (i & 3) * 16 + lq);
          f32x4 Ln[4];
#pragma unroll
          for (int q = 0; q < 4; ++q) Ln[q] = Lc[q];
          if (i + 1 < 64) {
#pragma unroll
              for (int q = ((i + 1) >> 4); q < 4; ++q) Ln[q] = *(const f32x4*)(F0 + (i + 1) * 64 + g * 16 + 4 * q);
          }
#pragma unroll
          for (int r = (i >> 2); r < 16; ++r) X[r] += Lc[r >> 2][r & 3] * xi;
#pragma unroll
          for (int q = 0; q < 4; ++q) Lc[q] = Ln[q];
          __builtin_amdgcn_sched_barrier(0);
      }
      bf16* XT = (bf16*)F1 + (w >> 2) * 4608 + ((col & 63) * ST);
#pragma unroll
      for (int r = 0; r < 16; ++r) XT[4 * r + g] = (bf16)f2bf(X[r]); }
    LDS_BARRIER();
    { const int mt = w >> 1, nt0 = 2 * (w & 1);
      const bf16* AhT = (const bf16*)F1; const bf16* W2T = AhT + 4608;
      unsigned char* ua = B.UA + (size_t)u * UNIT_A; unsigned char* ub = B.UB + (size_t)u * UNIT_B;
      const int p0 = 32 * (mt >> 1) + 8 * g + 4 * (mt & 1);
      f32x4 a[2];
      ZACC(a); mm_tile2<false, true>(AhT, ST, A4, ST, 2, a, w, lq, g);
#pragma unroll
      for (int q = 0; q < 2; ++q) { const int k = 16 * (nt0 + q) + lq; u32x2 o; o.x = pk2(a[q][0], a[q][1]); o.y = pk2(a[q][2], a[q][3]); *(u32x2*)(ua + swz(k, p0)) = o; }
      ZACC(a); mm_tile(AhT, ST, A8, ST, 2, a, w, lq, g);
#pragma unroll
      for (int q = 0; q < 2; ++q) { const int tt = 16 * (nt0 + q) + lq; const u32x2 rr = *(const u32x2*)(A3 + tt * ST + 16 * mt + 4 * g);
          u32x2 o; o.x = pk2(a[q][0] + bflo(rr.x), a[q][1] + bfhi(rr.x)); o.y = pk2(a[q][2] + bflo(rr.y), a[q][3] + bfhi(rr.y)); *(u32x2*)(ua + 8192 + swz(tt, p0)) = o; }
      ZACC(a); mm_tile2<true, false>(A4, ST, W2T, ST, 2, a, w, lq, g); mm_tile2<true, true>(A5, ST, A6, ST, 2, a, w, lq, g);
#pragma unroll
      for (int q = 0; q < 2; ++q) { const int v = 16 * (nt0 + q) + lq, k0 = 16 * mt + 4 * g; u32x2 o; o.x = pk2(a[q][0], a[q][1]); o.y = pk2(a[q][2], a[q][3]); *(u32x2*)(ub + swz(v, k0)) = o; }
      ZACC(a); mm_tile(A8, ST, W2T, ST, 2, a, w, lq, g); mm_tile2<false, true>(A9, ST, A6, ST, 2, a, w, lq, g);
#pragma unroll
      for (int q = 0; q < 2; ++q) { const int v = 16 * (nt0 + q) + lq, t0 = 16 * mt + 4 * g; u32x2 o; o.x = pk2(a[q][0], a[q][1]); o.y = pk2(a[q][2], a[q][3]); *(u32x2*)(ub + 8192 + swz(v, t0)) = o; } }
    LDS_BARRIER();
}
__device__ __forceinline__ void phase_rwkv_prep(const Params& P, int l, const Ctx& c) {
    const RwkvBufs B = rwkv_bufs(P, c);
    for (int u = c.bid; u < NUNIT; u += c.G) rwkv_prep_unit(P, l, c, u, B);
}

constexpr int SLOTB = 33280, YST = 68;
__device__ __forceinline__ void scan_chunked(const Params& P, const Ctx& c, int bh) {
    const RwkvBufs B = rwkv_bufs(P, c);
    const int b = bh >> 3, h = bh & 7, w = c.wave, lane = c.lane, lq = lane & 15, g = lane >> 4;
    const size_t rowb = (size_t)b * LP;
    const int ll = c.tid;
    unsigned char* L = c.lds;
    f32x4 st[4];
#pragma unroll
    for (int i = 0; i < 4; ++i) st[i] = (f32x4){0.f, 0.f, 0.f, 0.f};
    u32x4 r0[5], r1[5], r2[5], r3[5], r4[5];
#define SC_UNIT(cc) ((size_t)((b * NCHK + (cc)) * 8 + h))
#define SC_LOAD(R, cc) do { const unsigned char* pa_ = B.UA + SC_UNIT(cc) * UNIT_A; const unsigned char* pb_ = B.UB + SC_UNIT(cc) * UNIT_B; \
        _Pragma("unroll") for (int i_ = 0; i_ < 2; ++i_) { R[i_] = GLD(u32x4, pa_ + (ll + 512 * i_) * 16); R[2 + i_] = GLD(u32x4, pb_ + (ll + 512 * i_) * 16); } \
        if (ll < 16) R[4] = GLD(u32x4, pb_ + 16384 + ll * 16); } while (0)
#define SC_WRITE(R, slot) do { unsigned char* s_ = L + (slot) * SLOTB; \
        _Pragma("unroll") for (int i_ = 0; i_ < 2; ++i_) { *(u32x4*)(s_ + (ll + 512 * i_) * 16) = R[i_]; *(u32x4*)(s_ + 16384 + (ll + 512 * i_) * 16) = R[2 + i_]; } \
        if (ll < 16) *(u32x4*)(s_ + 32768 + ll * 16) = R[4]; } while (0)
#define SC_COMPUTE(ci) do { \
        const unsigned char* sl = L + ((ci) % 3) * SLOTB; \
        const int vcol = 16 * w + lq; \
        bf16x8 gaf[4][2]; f32x4 gcf[4]; u32x2 d0f[4]; \
        _Pragma("unroll") for (int mt = 0; mt < 4; ++mt) { \
            gcf[mt] = *(const f32x4*)(sl + 32768 + (16 * mt + 4 * g) * 4); \
            d0f[mt] = *(const u32x2*)(sl + 16384 + swz(vcol, 16 * mt + 4 * g)); \
            _Pragma("unroll") for (int ks = 0; ks < 2; ++ks) gaf[mt][ks] = *(const bf16x8*)(sl + swz(16 * mt + lq, 32 * ks + 8 * g)); } \
        __builtin_amdgcn_sched_barrier(0);        \
        bf16x8 sb[2]; \
        _Pragma("unroll") for (int ks = 0; ks < 2; ++ks) { u32x4 pw; pw.x = pk2(st[2 * ks][0], st[2 * ks][1]); pw.y = pk2(st[2 * ks][2], st[2 * ks][3]); pw.z = pk2(st[2 * ks + 1][0], st[2 * ks + 1][1]); pw.w = pk2(st[2 * ks + 1][2], st[2 * ks + 1][3]); \
            sb[ks] = __builtin_bit_cast(bf16x8, pw); } \
        _Pragma("unroll") for (int mt = 0; mt < 4; ++mt) { \
            f32x4 ns = (f32x4){bflo(d0f[mt].x), bfhi(d0f[mt].x), bflo(d0f[mt].y), bfhi(d0f[mt].y)} + gcf[mt] * st[mt]; \
            _Pragma("unroll") for (int ks = 0; ks < 2; ++ks) ns = __builtin_amdgcn_mfma_f32_16x16x32_bf16(gaf[mt][ks], sb[ks], ns, 0, 0, 0); \
            st[mt] = ns; } \
        _Pragma("unroll") for (int mt = 0; mt < 4; ++mt) { \
            const u32x2 y0 = *(const u32x2*)(sl + 24576 + swz(vcol, 16 * mt + 4 * g)); \
            f32x4 ya = (f32x4){bflo(y0.x), bfhi(y0.x), bflo(y0.y), bfhi(y0.y)}; \
            _Pragma("unroll") for (int ks = 0; ks < 2; ++ks) { const bf16x8 rh = *(const bf16x8*)(sl + 8192 + swz(16 * mt + lq, 32 * ks + 8 * g)); ya = __builtin_amdgcn_mfma_f32_16x16x32_bf16(rh, sb[ks], ya, 0, 0, 0); } \
            float* yl = (float*)(L + 3 * SLOTB) + ((ci) & 1) * (64 * YST) + (16 * mt + 4 * g) * YST + vcol; \
            _Pragma("unroll") for (int j = 0; j < 4; ++j) yl[j * YST] = ya[j]; } } while (0)
#define SC_YSTORE(ci) do { const float* ys_ = (const float*)(L + 3 * SLOTB) + ((ci) & 1) * (64 * YST) + (c.tid >> 3) * YST + (c.tid & 7) * 8; \
        float* yg_ = B.Y + (rowb + (ci) * 64 + (c.tid >> 3)) * 512 + h * 64 + (c.tid & 7) * 8; \
        GST(f32x4, yg_) = *(const f32x4*)ys_; GST(f32x4, yg_ + 4) = *(const f32x4*)(ys_ + 4); } while (0)
#define SC_ITER(ci, R) do { if ((ci) + 2 < NCHK) SC_WRITE(R, ((ci) + 2) % 3); if ((ci) + 7 < NCHK) SC_LOAD(R, (ci) + 7); if ((ci) > 0) SC_YSTORE((ci) - 1); if (w < 4) { SC_COMPUTE(ci); } LDS_BARRIER(); } while (0)
    { SC_LOAD(r0, 0); SC_LOAD(r1, 1); SC_WRITE(r0, 0); SC_WRITE(r1, 1); SC_LOAD(r2, 2); SC_LOAD(r3, 3); SC_LOAD(r4, 4); SC_LOAD(r0, 5); SC_LOAD(r1, 6); }
    __syncthreads();
#pragma unroll 1
    for (int cc = 0; cc < NCHK; cc += 5) { SC_ITER(cc, r2); SC_ITER(cc + 1, r3); SC_ITER(cc + 2, r4); SC_ITER(cc + 3, r0); SC_ITER(cc + 4, r1); }
    SC_YSTORE(NCHK - 1);
#undef SC_YSTORE
#undef SC_COMPUTE
#undef SC_ITER
#undef SC_UNIT
#undef SC_LOAD
#undef SC_WRITE
}

__device__ __forceinline__ void phase_gn(const Params& P, int l, const Ctx& c) {
    const RwkvBufs B = rwkv_bufs(P, c);
    const int gw = c.bid * NWAVES + c.wave, NGW = c.G * NWAVES;
    const int c0 = 8 * c.lane;
    float gnw[8], gnb[8];
#pragma unroll
    for (int i = 0; i < 8; ++i) { gnw[i] = P.in[17][l * 512 + c0 + i]; gnb[i] = P.in[18][l * 512 + c0 + i]; }
    for (int m = gw; m < M; m += NGW) {
        const size_t o = (size_t)m * 512 + c0;
        const f32x4 y0 = *(const f32x4*)(B.Y + o), y1 = *(const f32x4*)(B.Y + o + 4);
        float y[8] = {y0.x, y0.y, y0.z, y0.w, y1.x, y1.y, y1.z, y1.w};
        const u32x4 bw = *(const u32x4*)(B.BON + o), gw4 = *(const u32x4*)(B.G + o);
        const float bo[8] = {bflo(bw.x), bfhi(bw.x), bflo(bw.y), bfhi(bw.y), bflo(bw.z), bfhi(bw.z), bflo(bw.w), bfhi(bw.w)};
        const float gg[8] = {bflo(gw4.x), bfhi(gw4.x), bflo(gw4.y), bfhi(gw4.y), bflo(gw4.z), bfhi(gw4.z), bflo(gw4.w), bfhi(gw4.w)};
        float s = 0.f;
#pragma unroll
        for (int i = 0; i < 8; ++i) s += y[i];
        s += __shfl_xor(s, 1); s += __shfl_xor(s, 2); s += __shfl_xor(s, 4);
        const float mean = s * (1.f / 64.f);
        float q = 0.f;
#pragma unroll
        for (int i = 0; i < 8; ++i) { y[i] -= mean; q += y[i] * y[i]; }
        q += __shfl_xor(q, 1); q += __shfl_xor(q, 2); q += __shfl_xor(q, 4);
        const float rstd = 1.0f / sqrtf(q * (1.f / 64.f) + 64e-5f);
        float ov[8];
#pragma unroll
        for (int i = 0; i < 8; ++i) ov[i] = (y[i] * rstd * gnw[i] + gnb[i] + bo[i]) * gg[i];
        u32x4 ow; ow.x = pk2(ov[0], ov[1]); ow.y = pk2(ov[2], ov[3]); ow.z = pk2(ov[4], ov[5]); ow.w = pk2(ov[6], ov[7]);
        *(u32x4*)(B.ORW + o) = ow;
    }
}

__device__ __forceinline__ void attn_unit(const Ctx& c, int bh, int qb, const bf16* Q, const bf16* K, const bf16* V, bf16* O, const float* FC, float qkb2, const float* gq, const float* gk) {
    const int b = bh >> 3, h = bh & 7, lane = c.lane, w = c.wave, lq = lane & 15, g = lane >> 4;
    const int q0 = qb * 128;
    const size_t rowb = (size_t)b * LP;
    const int qrow = q0 + 16 * w + lq;
    bf16* Ks = (bf16*)c.lds; bf16* Vt = Ks + 64 * 72; float* fks = (float*)(Vt + 64 * 72);
    const bf16* qp = Q + (rowb + qrow) * 512 + h * 64 + 8 * g;
    bf16x8 qf0, qf1;
    { const u32x4 r0 = GLD(u32x4, qp), r1 = GLD(u32x4, qp + 32);
      float x[16] = {bflo(r0.x), bfhi(r0.x), bflo(r0.y), bfhi(r0.y), bflo(r0.z), bfhi(r0.z), bflo(r0.w), bfhi(r0.w), bflo(r1.x), bfhi(r1.x), bflo(r1.y), bfhi(r1.y), bflo(r1.z), bfhi(r1.z), bflo(r1.w), bfhi(r1.w)};
      float ss = 0.f;
#pragma unroll
      for (int i = 0; i < 16; ++i) ss += x[i] * x[i];
      ss += __shfl_xor(ss, 16); ss += __shfl_xor(ss, 32);
      const float rs = QSCALE / sqrtf(ss * (1.f / 64.f) + 1e-6f);
#pragma unroll
      for (int i = 0; i < 8; ++i) { x[i] *= rs * gq[8 * g + i]; x[8 + i] *= rs * gq[32 + 8 * g + i]; }
      u32x4 p0, p1; p0.x = pk2(x[0], x[1]); p0.y = pk2(x[2], x[3]); p0.z = pk2(x[4], x[5]); p0.w = pk2(x[6], x[7]); p1.x = pk2(x[8], x[9]); p1.y = pk2(x[10], x[11]); p1.z = pk2(x[12], x[13]); p1.w = pk2(x[14], x[15]);
      qf0 = __builtin_bit_cast(bf16x8, p0); qf1 = __builtin_bit_cast(bf16x8, p1); }
    const float* FCh = FC + (size_t)bh * LP;
    const float fq = GLD(float, FCh + qrow);
    float mrun = -1e30f, lsum = 0.f;
    f32x4 o[4];
#pragma unroll
    for (int i = 0; i < 4; ++i) o[i] = (f32x4){0.f, 0.f, 0.f, 0.f};
    const int kt_max = (q0 + 127) >> 6;
    const int lkey = c.tid >> 3, lch = c.tid & 7;
    float gkr[8];
#pragma unroll
    for (int i = 0; i < 8; ++i) gkr[i] = gk[lch * 8 + i];
    const size_t gbase = (rowb + lkey) * 512 + h * 64 + lch * 8;
    u32x4 kv = GLD(u32x4, K + gbase + (size_t)kt_max * 64 * 512), vv = GLD(u32x4, V + gbase + (size_t)kt_max * 64 * 512);
    float fkv = GLD(float, FCh + kt_max * 64 + (c.tid & 63));
    volatile unsigned* vote = (volatile unsigned*)(fks + 64);
    for (int kt = kt_max; kt >= 0; --kt) {
        const int k0 = kt * 64;
        LDS_BARRIER();
        { int can = 0; if (kt < kt_max) { const float fl = __shfl(fkv, 63); can = (qkb2 + fq - fl) < (mrun - THR2); }
          const int wall = __all(can); if (lane == 0) vote[w] = (unsigned)wall; }
        { { float x[8] = {bflo(kv.x), bfhi(kv.x), bflo(kv.y), bfhi(kv.y), bflo(kv.z), bfhi(kv.z), bflo(kv.w), bfhi(kv.w)}; float ss = 0.f;
#pragma unroll
              for (int i = 0; i < 8; ++i) ss += x[i] * x[i];
              ss += __shfl_xor(ss, 1); ss += __shfl_xor(ss, 2); ss += __shfl_xor(ss, 4);
              const float rs = 1.0f / sqrtf(ss * (1.f / 64.f) + 1e-6f);
              u32x4 kn; kn.x = pk2(x[0] * rs * gkr[0], x[1] * rs * gkr[1]); kn.y = pk2(x[2] * rs * gkr[2], x[3] * rs * gkr[3]); kn.z = pk2(x[4] * rs * gkr[4], x[5] * rs * gkr[5]); kn.w = pk2(x[6] * rs * gkr[6], x[7] * rs * gkr[7]);
              *(u32x4*)(Ks + lkey * 72 + lch * 8) = kn; }
            bf16* vd = Vt + (lch * 8) * 72 + lkey;
            vd[0] = (bf16)(vv.x & 0xffff); vd[72] = (bf16)(vv.x >> 16); vd[144] = (bf16)(vv.y & 0xffff); vd[216] = (bf16)(vv.y >> 16);
            vd[288] = (bf16)(vv.z & 0xffff); vd[360] = (bf16)(vv.z >> 16); vd[432] = (bf16)(vv.w & 0xffff); vd[504] = (bf16)(vv.w >> 16);
            if (c.tid < 64) fks[c.tid] = fkv;
            if (kt > 0) { kv = GLD(u32x4, K + gbase + (size_t)(k0 - 64) * 512); vv = GLD(u32x4, V + gbase + (size_t)(k0 - 64) * 512); fkv = GLD(float, FCh + k0 - 64 + (c.tid & 63)); } }
        LDS_BARRIER();
        { unsigned all = vote[0] & vote[1] & vote[2] & vote[3] & vote[4] & vote[5] & vote[6] & vote[7]; if (all) break; }
        if (k0 > q0 + 16 * w + 15) continue;
        f32x4 s[4];
#pragma unroll
        for (int nt = 0; nt < 4; ++nt) { const bf16* kp = Ks + (16 * nt + lq) * 72 + 8 * g; const bf16x8 a0 = *(const bf16x8*)kp, a1 = *(const bf16x8*)(kp + 32);
            s[nt] = __builtin_amdgcn_mfma_f32_16x16x32_bf16(a0, qf0, (f32x4){0.f, 0.f, 0.f, 0.f}, 0, 0, 0);
            s[nt] = __builtin_amdgcn_mfma_f32_16x16x32_bf16(a1, qf1, s[nt], 0, 0, 0); }
        float mx = -INFINITY;
#pragma unroll
        for (int nt = 0; nt < 4; ++nt) { const f32x4 fk = *(const f32x4*)(fks + 16 * nt + 4 * g);
#pragma unroll
            for (int j = 0; j < 4; ++j) { float x = s[nt][j] + fq - fk[j]; const int key = k0 + 16 * nt + 4 * g + j; if (key > qrow) x = -INFINITY; s[nt][j] = x; mx = fmaxf(mx, x); } }
        mx = fmaxf(mx, __shfl_xor(mx, 16)); mx = fmaxf(mx, __shfl_xor(mx, 32));
        const float mnew = fmaxf(mrun, mx), alpha = __builtin_amdgcn_exp2f(mrun - mnew); mrun = mnew;
        float psum = 0.f;
#pragma unroll
        for (int nt = 0; nt < 4; ++nt)
#pragma unroll
            for (int j = 0; j < 4; ++j) { const float p = __builtin_amdgcn_exp2f(s[nt][j] - mnew); s[nt][j] = p; psum += p; }
        lsum = lsum * alpha + psum;
#pragma unroll
        for (int dt = 0; dt < 4; ++dt) o[dt] = o[dt] * alpha;
        bf16x8 pb[2];
#pragma unroll
        for (int k2 = 0; k2 < 2; ++k2) { u32x4 pw; pw.x = pk2(s[2 * k2][0], s[2 * k2][1]); pw.y = pk2(s[2 * k2][2], s[2 * k2][3]); pw.z = pk2(s[2 * k2 + 1][0], s[2 * k2 + 1][1]); pw.w = pk2(s[2 * k2 + 1][2], s[2 * k2 + 1][3]);
            pb[k2] = __builtin_bit_cast(bf16x8, pw); }
#pragma unroll
        for (int dt = 0; dt < 4; ++dt)
#pragma unroll
            for (int k2 = 0; k2 < 2; ++k2) { const bf16* vp = Vt + (16 * dt + lq) * 72 + 32 * k2 + 4 * g;
                const u32x2 lo = *(const u32x2*)vp, hi = *(const u32x2*)(vp + 16);
                u32x4 aw; aw.x = lo.x; aw.y = lo.y; aw.z = hi.x; aw.w = hi.y;
                o[dt] = __builtin_amdgcn_mfma_f32_16x16x32_bf16(__builtin_bit_cast(bf16x8, aw), pb[k2], o[dt], 0, 0, 0); }
    }
    lsum += __shfl_xor(lsum, 16); lsum += __shfl_xor(lsum, 32);
    const float inv = 1.0f / lsum;
    bf16* op = O + (rowb + qrow) * 512 + h * 64 + 4 * g;
#pragma unroll
    for (int dt = 0; dt < 4; ++dt) { u32x2 ow; ow.x = pk2(o[dt][0] * inv, o[dt][1] * inv); ow.y = pk2(o[dt][2] * inv, o[dt][3] * inv); GST(u32x2, op + 16 * dt) = ow; }
    __syncthreads();
}
__device__ __forceinline__ void phase_attn(const Params& P, int l, const Ctx& c, int first_blk) {
    const bf16* Q = (const bf16*)(c.ws + OFF_Q); const bf16* K = (const bf16*)(c.ws + OFF_K); const bf16* V = (const bf16*)(c.ws + OFF_V);
    const float* FC = (const float*)(c.ws + OFF_MISC) + 16 * LP;
    float gqm = fabsf(P.in[5][l * 64 + c.lane]), gkm = fabsf(P.in[6][l * 64 + c.lane]);
#pragma unroll
    for (int o = 1; o < 64; o <<= 1) { gqm = fmaxf(gqm, __shfl_xor(gqm, o)); gkm = fmaxf(gkm, __shfl_xor(gkm, o)); }
    const float qkb2 = 8.0f * gqm * gkm * LOG2E * 1.03f;
    constexpr int NQB = LP / 128, NU = 16 * NQB;
    unsigned* ctr = (unsigned*)(c.ws + OFF_CTL) + 8192 + 64 * l;
    volatile unsigned* slot = (volatile unsigned*)(c.lds + MISC_OFF) + 4;
    for (;;) {
        __syncthreads();
        if (c.tid == 0) *slot = atomicAdd(ctr, 1u);
        __syncthreads();
        const int u = (int)*slot;
        if (u >= NU) break;
        const int bh = u & 15, qb = NQB - 1 - (u >> 4); attn_unit(c, bh, qb, Q, K, V, (bf16*)(c.ws + OFF_OF), FC, qkb2, P.in[5] + l * 64, P.in[6] + l * 64);
    }
}

__device__ __forceinline__ void phase_fixup(const Params& P, int l, const Ctx& c) {
    bf16* ACT = (bf16*)(c.ws + OFF_RW); const bf16* HALO = (const bf16*)(c.ws + OFF_Q);
    const float* cw = P.in[24] + (size_t)l * 3 * NUP;
    const int total = (M / 64) * 2 * DFF;
    for (int idx = c.bid * NTHR + c.tid; idx < total; idx += c.G * NTHR) {
        const int rr = idx / DFF, ch = idx - rr * DFF, q64 = rr >> 1, e = rr & 1, row = q64 * 64 + e;
        const int t = row % LP;
        int s0, s1, s2;
        if (e == 0) { s0 = q64 * 4 + 2; s1 = (q64 - 1) * 4 + 1; s2 = (q64 - 1) * 4 + 0; } else { s0 = q64 * 4 + 3; s1 = q64 * 4 + 2; s2 = (q64 - 1) * 4 + 1; }
        float uc[2];
#pragma unroll
        for (int bj = 0; bj < 2; ++bj) { const int col = bj * DFF + ch;
            const float u0 = bf2f(HALO[(size_t)s0 * NUP + col]);
            const float u1 = (t >= 1) ? bf2f(HALO[(size_t)s1 * NUP + col]) : 0.f;
            const float u2 = (t >= 2) ? bf2f(HALO[(size_t)s2 * NUP + col]) : 0.f;
            uc[bj] = cw[col] * u2 + cw[NUP + col] * u1 + cw[2 * NUP + col] * u0; }
        ACT[(size_t)row * DFF + ch] = (bf16)f2bf(uc[0] * sigmoidf_(uc[0]) * uc[1]);
    }
}

#define OPQ_S(x) asm volatile("" : "+s"(x))
#define OPQ_V(x) asm volatile("" : "+v"(x))
#define PHASE_BEGIN() do { int t_ = threadIdx.x; OPQ_V(t_); c.tid = t_; c.lane = t_ & 63; c.wave = __builtin_amdgcn_readfirstlane(t_ >> 6); int b_ = blockIdx.x; OPQ_S(b_); c.bid = b_; \
    size_t z_ = 0; OPQ_S(z_); unsigned char* w_ = P.ws + z_;   c.ws = w_; ws = w_; l = lc; OPQ_S(l); WT = (pg8::bf16_t*)(ws + OFF_WT); HN = (pg8::bf16_t*)(ws + OFF_HN); } while (0)
__global__ void __launch_bounds__(NTHR, 2) mega(Params P) {
    extern __shared__ __attribute__((aligned(16))) unsigned char lds[];
    Ctx c; c.G = gridDim.x; c.lds = lds;
    volatile LAS unsigned* MISC = (volatile LAS unsigned*)((LAS unsigned char*)lds + MISC_OFF);
    if (threadIdx.x < 16) MISC[threadIdx.x] = 0u;
    __syncthreads();
    (void)xcd_barrier_post((unsigned*)(P.ws + OFF_CTL) + 1024, MISC + 8);
#define SEAM() do { XcdBarrier xb_; xb_.bar = (unsigned*)(P.ws + OFF_CTL) + 1024; xb_.x = xb_xcc_id(); xb_.st = (volatile LAS unsigned*)((LAS unsigned char*)lds + MISC_OFF) + 8; xcd_barrier(xb_); } while (0)
    PG8_LAS unsigned char* ldsl = (PG8_LAS unsigned char*)lds;
    unsigned char* ws; pg8::bf16_t* WT; pg8::bf16_t* HN; int l;
#pragma unroll 1
    for (int lc = 0; lc < DEPTH; ++lc) {
        PHASE_BEGIN();
        convert_weights(P, l, c);
        phase_norm<true>(P, l, c);
        if (lc == 0) cg::this_grid().sync(); else SEAM();
        PHASE_BEGIN();
        phase_fcum(P, c);
        { pg8::Gemm g{HN, WT + WT_IN, M, N1, 1024, 1024}; pg8::StaticOrder S; S.init(M, N1, c.G, c.bid);
          pg8::EpiRoute E{ws};
          pg8::gemm_phase<pg8::EpiRoute, pg8::StaticOrder, true, true>(ldsl, g, S, E); }
        SEAM();
        PHASE_BEGIN();
        for (int rep_ = 0; rep_ < REP_PREP; ++rep_) phase_rwkv_prep(P, l, c);
        SEAM();
        PHASE_BEGIN();
        if (c.bid < 16) { scan_chunked(P, c, c.bid); __syncthreads(); PHASE_BEGIN(); }
        phase_attn(P, l, c, 16);
#if REP_P3 > 1
        __syncthreads(); PHASE_BEGIN();
        if (c.bid < 16) scan_chunked(P, c, c.bid); else phase_attn(P, l, c, 16);
#endif
        SEAM();
        PHASE_BEGIN();
        phase_gn(P, l, c);
        for (int rep_ = 0; rep_ < REP_SYNC; ++rep_) SEAM();
        SEAM();
        PHASE_BEGIN();
        { pg8::bf16_t* MG = (pg8::bf16_t*)(ws + OFF_K); const pg8::bf16_t* GT = (const pg8::bf16_t*)(ws + OFF_GT); const float* gb = P.in[21] + l * NGT;
          pg8::StaticOrder S; S.init(M, 1024, c.G, c.bid);
          { pg8::Gemm g{(const pg8::bf16_t*)(ws + OFF_OF), WT + WT_BF, M, 1024, 512, 512}; pg8::EpiGate<0> E{MG, GT, gb};
            pg8::gemm_phase<pg8::EpiGate<0>, pg8::StaticOrder, true, true>(ldsl, g, S, E); }
          __syncthreads();
          PHASE_BEGIN();
          MG = (pg8::bf16_t*)(ws + OFF_K); GT = (const pg8::bf16_t*)(ws + OFF_GT); gb = P.in[21] + l * NGT; S.init(M, 1024, c.G, c.bid);
          { pg8::Gemm g{(const pg8::bf16_t*)(ws + OFF_RW + (size_t)M * 512 * 4), WT + WT_BR, M, 1024, 512, 512}; pg8::EpiGate<1> E{MG, GT, gb};
            pg8::gemm_phase<pg8::EpiGate<1>, pg8::StaticOrder, true, true>(ldsl, g, S, E); } }
        SEAM();
        PHASE_BEGIN();
#pragma unroll 1
        for (int pass = 0; pass < 2; ++pass) {
            if (pass) { __syncthreads(); PHASE_BEGIN(); }
            const int sl = pass ? (c.bid >> 2) : 0;
            pg8::Gemm g{(const pg8::bf16_t*)(ws + OFF_K) + sl * 256, WT + WT_O + sl * 256, M, 1024, pass ? 256 : 1024, 1024};
            pg8::OneUnit S; S.so.init(MMAIN, 1024, c.G, c.bid); S.mode = pass; S.pm = MMAIN / 256; S.pn = c.bid & 3; S.active = sl < 4;
            pg8::EpiResid E{(float*)(ws + OFF_H), nullptr, pass};
            pg8::gemm_phase<pg8::EpiResid, pg8::OneUnit, true, true>(ldsl, g, S, E);
        }
        SEAM();
        PHASE_BEGIN();
        phase_norm<false>(P, l, c);
        SEAM();
        PHASE_BEGIN();
        { pg8::Gemm g{HN, WT + WT_UP, M, NUP, 1024, 1024}; pg8::StaticOrder S; S.init(M, NUP, c.G, c.bid);
          pg8::EpiUp E{(pg8::bf16_t*)(ws + OFF_RW), (pg8::bf16_t*)(ws + OFF_Q), P.in[24] + (size_t)l * 3 * NUP};
          pg8::gemm_phase<pg8::EpiUp, pg8::StaticOrder, true, true>(ldsl, g, S, E); }
        SEAM();
        PHASE_BEGIN();
        phase_fixup(P, l, c);
        SEAM();
        PHASE_BEGIN();
#pragma unroll 1
        for (int pass = 0; pass < 2; ++pass) {
            if (pass) { __syncthreads(); PHASE_BEGIN(); }
            const int sl = pass ? (c.bid >> 2) : 0;
            const int ko = (sl < 2) ? sl * 768 : 1536 + (sl - 2) * 640, kl = (sl < 2) ? 768 : 640;
            pg8::Gemm g{(const pg8::bf16_t*)(ws + OFF_RW) + (pass ? ko : 0), WT + WT_DN + (pass ? ko : 0), M, 1024, pass ? kl : DFF, DFF};
            pg8::OneUnit S; S.so.init(MMAIN, 1024, c.G, c.bid); S.mode = pass; S.pm = MMAIN / 256; S.pn = c.bid & 3; S.active = sl < 4;
            pg8::EpiResid E{(float*)(ws + OFF_H), (l == DEPTH - 1 && !pass) ? P.out : nullptr, pass};
            pg8::gemm_phase<pg8::EpiResid, pg8::OneUnit, true, true>(ldsl, g, S, E);
        }
        SEAM();
        if (l == DEPTH - 1) {
            PHASE_BEGIN();
            const float* H = (const float*)(ws + OFF_H);
            for (int idx = c.bid * NTHR + c.tid; idx < (NMETA + SEQ - (MMAIN - LP)) * (DM / 4); idx += c.G * NTHR) {
                const int r = idx / (DM / 4), q4 = idx - r * (DM / 4), t = (MMAIN - LP) + r;
                *(f32x4*)(P.out + ((size_t)SEQ + (t - NMETA)) * DM + 4 * q4) = *(const f32x4*)(H + (size_t)(LP + t) * DM + 4 * q4);
            }
        }
    }
}

extern "C" void kernel_launch(void* const* d_in, const int* in_sizes, int n_in, void* d_out, int out_size, void* d_ws, size_t ws_size, hipStream_t stream) {
    static int grid = 0;
    if (grid == 0) {
        if (n_in != 26 || out_size != NB * SEQ * DM || ws_size < WS_NEED) { fprintf(stderr, "kernel_launch: unexpected shapes (n_in %d out %d ws %zu need %zu)\n", n_in, out_size, ws_size, (size_t)WS_NEED); grid = -1; return; }
        int dev = 0, cus = 0, per_cu = 0;
        if (hipGetDevice(&dev) != hipSuccess || hipDeviceGetAttribute(&cus, hipDeviceAttributeMultiprocessorCount, dev) != hipSuccess) { grid = -1; return; }
        if (hipFuncSetAttribute((const void*)mega, hipFuncAttributeMaxDynamicSharedMemorySize, LDS_BYTES) != hipSuccess) { fprintf(stderr, "kernel_launch: hipFuncSetAttribute failed\n"); grid = -1; return; }
        if (hipOccupancyMaxActiveBlocksPerMultiprocessor(&per_cu, (const void*)mega, NTHR, LDS_BYTES) != hipSuccess || per_cu < 1) { fprintf(stderr, "kernel_launch: occupancy query says %d\n", per_cu); per_cu = 1; }
        (void)hipGetLastError();
        grid = cus;
    }
    if (grid < 0) return;
    if (hipMemsetAsync((char*)d_ws + OFF_CTL, 0, 65536, stream) != hipSuccess) { fprintf(stderr, "kernel_launch: memset failed\n"); return; }
    Params p{};
    for (int i = 0; i < 26; ++i) p.in[i] = (const float*)d_in[i];
    p.out = (float*)d_out; p.ws = (unsigned char*)d_ws;
    void* args[] = {&p};
    hipError_t e = hipLaunchCooperativeKernel((const void*)mega, dim3(grid), dim3(NTHR), args, LDS_BYTES, stream);
    if (e != hipSuccess) fprintf(stderr, "kernel_launch: cooperative launch failed: %s (grid %d)\n", hipGetErrorString(e), grid);
}
```

```cpp
#include <hip/hip_runtime.h>
#include <hip/hip_cooperative_groups.h>
#include <cstdio>
#include <cstdint>
#include <cmath>
namespace cg = cooperative_groups;
namespace pg8 {
#define PG8_LAS __attribute__((address_space(3)))
typedef unsigned short bf16_t;
typedef short bf16x8 __attribute__((ext_vector_type(8)));
typedef float f32x4 __attribute__((ext_vector_type(4)));
typedef unsigned u32x4 __attribute__((ext_vector_type(4)));
constexpr int BM = 256, BK = 64, HALF = 128, HTB = HALF * BK * 2  , STAGE_BYTES = 8 * HTB, NXCD = 8, WGM = 8;

__host__ __device__ __forceinline__ int lds_byte(int r, int c) { const int st = (r >> 4) * 2 + (c >> 5), rr = r & 15, cc = c & 31, ob = rr * 64 + cc * 2; return st * 1024 + (ob ^ (((ob >> 9) & 1) << 5)); }
__host__ __device__ __forceinline__ void stage_rc(int b, int& R, int& C) { const int st = b / 1024, sb = b % 1024, swz = sb ^ (((sb >> 9) & 1) << 5); R = (st >> 1) * 16 + swz / 64; C = (st & 1) * 32 + (swz % 64) / 2; }
__host__ __device__ __forceinline__ int perm32(int rho) { const int n = rho >> 4, i = rho & 15; return 8 * (i >> 2) + 4 * n + (i & 3); }

struct Unit { int pm, pn; };
struct Gemm { const bf16_t* A; const bf16_t* Bt; int M, N, K, ld; };

struct StaticOrder {
    int nM, nN, nwg, G, c;
    __host__ __device__ void init(int M, int N, int G_, int c_) { nM = M / BM; nN = N / BM; nwg = nM * nN; G = G_; c = c_; }
    __host__ __device__ bool next(int i, Unit& u) const {
        const long L = (long)i * G + c; if (L >= nwg) return false;
        int wgid = (int)L; { const int q = nwg / NXCD, r = nwg % NXCD, xcd = wgid % NXCD, off = wgid / NXCD; wgid = (xcd < r ? xcd * (q + 1) : r * (q + 1) + (xcd - r) * q) + off; }
        const int nig = WGM * nN, gid = wgid / nig, fm = gid * WGM, gsz = (nM - fm) < WGM ? (nM - fm) : WGM;
        u.pm = fm + ((wgid % nig) % gsz); u.pn = (wgid % nig) / gsz; return true;
    }
    __device__ __forceinline__ void a_ready(const Unit&) const {}
    __device__ __forceinline__ void done(const Unit&) const {}
};

__device__ __forceinline__ unsigned cvt_pk_bf16(float lo, float hi) { unsigned r; asm volatile("v_cvt_pk_bf16_f32 %0, %1, %2" : "=v"(r) : "v"(lo), "v"(hi)); return r; }
typedef float f32x2 __attribute__((ext_vector_type(2)));
template <class Epi, class Sched, bool ALIGN_EPI = false, bool SP2 = false>
__device__ __forceinline__ void gemm_phase(PG8_LAS unsigned char* lds, const Gemm g, const Sched& S, const Epi& E) {
    int tid_ = threadIdx.x; asm volatile("" : "+v"(tid_)); const int tid = tid_, wid = __builtin_amdgcn_readfirstlane(tid >> 6), lane = tid & 63, wr = wid >> 2, wc = wid & 3, fr = lane & 15, fq = lane >> 4;
    const int K = g.K, nt = K / BK, LD = g.ld;
    unsigned voffA[2], voffB[2];
#pragma unroll
    for (int i = 0; i < 2; ++i) { int R, C; stage_rc(tid * 16 + i * 8192, R, C); const int Rb = Epi::PERM ? ((R & ~31) + perm32(R & 31)) : R;
        voffA[i] = (unsigned)(R * LD + C) * 2u; voffB[i] = (unsigned)(Rb * LD + C) * 2u; }
    const size_t kstep = (size_t)(BK * 2);
    const size_t hstep = (size_t)HALF * LD * 2;
    const size_t tstep = 2 * hstep;
    const unsigned ldsw = (unsigned)wid * 1024u;
    const int aoff = lds_byte(wr * 64 + fr, fq * 8), boff = lds_byte(wc * 32 + fr, fq * 8);
#define PG8_SA(b, h) (((b) * 2 + (h)) * HTB)
#define PG8_SB(b, h) ((4 + (b) * 2 + (h)) * HTB)
#define PG8_STAGE(bufoff, gbase, voff) do { _Pragma("unroll") for (int _i = 0; _i < 2; ++_i) \
        __builtin_amdgcn_global_load_lds((const unsigned*)((const char*)(gbase) + (voff)[_i]), (PG8_LAS unsigned*)(lds + (bufoff) + ldsw + _i * 8192), 16, 0, 0); } while (0)
#define PG8_LDA(dst, b, h) do { _Pragma("unroll") for (int m = 0; m < 4; ++m) _Pragma("unroll") for (int k = 0; k < 2; ++k) dst[m][k] = *(const PG8_LAS bf16x8*)(lds + PG8_SA(b, h) + aoff + m * 2048 + k * 1024); } while (0)
#define PG8_LDB(dst, b, h) do { _Pragma("unroll") for (int n = 0; n < 2; ++n) _Pragma("unroll") for (int k = 0; k < 2; ++k) dst[n][k] = *(const PG8_LAS bf16x8*)(lds + PG8_SB(b, h) + boff + n * 2048 + k * 1024); } while (0)
#define PG8_MMA(ai, bj, At, Bt) do { __builtin_amdgcn_s_setprio(1); _Pragma("unroll") for (int m = 0; m < 4; ++m) _Pragma("unroll") for (int n = 0; n < 2; ++n) _Pragma("unroll") for (int k = 0; k < 2; ++k) \
        acc[ai][bj][m][n] = __builtin_amdgcn_mfma_f32_16x16x32_bf16(Bt[n][k], At[m][k], acc[ai][bj][m][n], 0, 0, 0); __builtin_amdgcn_s_setprio(0); } while (0)
#define PG8_WAIT_V(n) asm volatile("s_waitcnt vmcnt(" #n ")" ::: "memory")
#define PG8_WAIT_L(n) asm volatile("s_waitcnt lgkmcnt(" #n ")" ::: "memory")
#define PG8_BAR __builtin_amdgcn_s_barrier()
#define PG8_SCHED __builtin_amdgcn_sched_barrier(0)
    Unit cur, nxt; int ui = 0;
    if (!S.next(0, cur)) return;
    f32x4 acc[2][2][4][2];
#pragma unroll
    for (int a = 0; a < 2; ++a)
#pragma unroll
        for (int b = 0; b < 2; ++b)
#pragma unroll
            for (int m = 0; m < 4; ++m)
#pragma unroll
                for (int n = 0; n < 2; ++n) acc[a][b][m][n] = (f32x4){0.f, 0.f, 0.f, 0.f};
    bf16x8 At[4][2], B0[2][2], B1[2][2];
    const char* cA = (const char*)g.A + (size_t)cur.pm * tstep; const char* cB = (const char*)g.Bt + (size_t)cur.pn * tstep;
    S.a_ready(cur);
    if constexpr (SP2) {
        PG8_STAGE(PG8_SB(0, 0), cB, voffB); PG8_STAGE(PG8_SB(0, 1), cB + hstep, voffB); PG8_STAGE(PG8_SA(0, 0), cA, voffA); PG8_STAGE(PG8_SA(0, 1), cA + hstep, voffA);
        if (wr == 1) PG8_BAR;
        PG8_WAIT_V(2); PG8_BAR;
        PG8_STAGE(PG8_SB(1, 0), cB + kstep, voffB); PG8_STAGE(PG8_SA(1, 0), cA + kstep, voffA); PG8_STAGE(PG8_SB(1, 1), cB + hstep + kstep, voffB);
        PG8_WAIT_V(6); PG8_BAR;
    } else {
        PG8_STAGE(PG8_SB(0, 0), cB, voffB); PG8_STAGE(PG8_SA(0, 0), cA, voffA); PG8_STAGE(PG8_SB(0, 1), cB + hstep, voffB); PG8_STAGE(PG8_SA(0, 1), cA + hstep, voffA);
        if (wr == 1) PG8_BAR;
        PG8_WAIT_V(4); PG8_BAR;
        PG8_STAGE(PG8_SB(1, 0), cB + kstep, voffB); PG8_STAGE(PG8_SA(1, 0), cA + kstep, voffA); PG8_STAGE(PG8_SB(1, 1), cB + hstep + kstep, voffB);
        PG8_WAIT_V(6); PG8_BAR;
    }
    for (;;) {
        const bool has_next = S.next(ui + 1, nxt);
        const char* nA = has_next ? (const char*)g.A + (size_t)nxt.pm * tstep : cA; const char* nB = has_next ? (const char*)g.Bt + (size_t)nxt.pn * tstep : cB;
        for (int t = 0; t < nt; t += 2) {
            const bool last = (t == nt - 2);
            const char* a1 = cA + (size_t)(t + 1) * kstep;
            const char* a2 = last ? nA : cA + (size_t)(t + 2) * kstep; const char* b2 = last ? nB : cB + (size_t)(t + 2) * kstep;
            const char* a3 = a2 + kstep; const char* b3 = b2 + kstep;
            if (last && has_next) S.a_ready(nxt);
            if constexpr (SP2) {
            PG8_LDB(B0, 0, 0); PG8_LDB(B1, 0, 1); PG8_SCHED; PG8_LDA(At, 0, 0); PG8_STAGE(PG8_SA(1, 1), a1 + hstep, voffA);
            PG8_WAIT_V(8); PG8_WAIT_L(0); PG8_BAR; PG8_MMA(0, 0, At, B0); PG8_MMA(0, 1, At, B1); PG8_BAR; PG8_SCHED;
            PG8_LDA(At, 0, 1); PG8_STAGE(PG8_SB(0, 0), b2, voffB); PG8_STAGE(PG8_SB(0, 1), b2 + hstep, voffB); PG8_STAGE(PG8_SA(0, 0), a2, voffA);
            PG8_WAIT_V(8); PG8_WAIT_L(0); PG8_BAR; PG8_MMA(1, 0, At, B0); PG8_MMA(1, 1, At, B1); PG8_BAR; PG8_SCHED;
            PG8_LDB(B0, 1, 0); PG8_LDB(B1, 1, 1); PG8_SCHED; PG8_LDA(At, 1, 0); PG8_STAGE(PG8_SA(0, 1), a2 + hstep, voffA);
            PG8_WAIT_V(8); PG8_WAIT_L(0); PG8_BAR; PG8_MMA(0, 0, At, B0); PG8_MMA(0, 1, At, B1); PG8_BAR; PG8_SCHED;
            PG8_LDA(At, 1, 1); PG8_STAGE(PG8_SB(1, 0), b3, voffB); PG8_STAGE(PG8_SB(1, 1), b3 + hstep, voffB); PG8_STAGE(PG8_SA(1, 0), a3, voffA);
            PG8_WAIT_V(8); PG8_WAIT_L(0); PG8_BAR; PG8_MMA(1, 0, At, B0); PG8_MMA(1, 1, At, B1); PG8_BAR; PG8_SCHED;
            } else {
            PG8_LDB(B0, 0, 0); PG8_SCHED; PG8_LDA(At, 0, 0); PG8_STAGE(PG8_SA(1, 1), a1 + hstep, voffA);
            PG8_WAIT_L(8); PG8_BAR; PG8_WAIT_L(0); PG8_MMA(0, 0, At, B0); PG8_BAR; PG8_SCHED;
            PG8_LDB(B1, 0, 1); PG8_STAGE(PG8_SB(0, 0), b2, voffB);
            PG8_BAR; PG8_WAIT_L(0); PG8_MMA(0, 1, At, B1); PG8_BAR;
            PG8_LDA(At, 0, 1); PG8_STAGE(PG8_SA(0, 0), a2, voffA);
            PG8_BAR; PG8_WAIT_L(0); PG8_MMA(1, 0, At, B0); PG8_BAR; PG8_SCHED;
            PG8_STAGE(PG8_SB(0, 1), b2 + hstep, voffB);
            PG8_WAIT_V(6); PG8_BAR; PG8_MMA(1, 1, At, B1); PG8_BAR;
            PG8_LDB(B0, 1, 0); PG8_SCHED; PG8_LDA(At, 1, 0); PG8_STAGE(PG8_SA(0, 1), a2 + hstep, voffA);
            PG8_WAIT_L(8); PG8_BAR; PG8_WAIT_L(0); PG8_MMA(0, 0, At, B0); PG8_BAR; PG8_SCHED;
            PG8_LDB(B1, 1, 1); PG8_STAGE(PG8_SB(1, 0), b3, voffB);
            PG8_BAR; PG8_WAIT_L(0); PG8_MMA(0, 1, At, B1); PG8_BAR;
            PG8_LDA(At, 1, 1); PG8_STAGE(PG8_SA(1, 0), a3, voffA);
            PG8_BAR; PG8_WAIT_L(0); PG8_MMA(1, 0, At, B0); PG8_BAR; PG8_SCHED;
            PG8_STAGE(PG8_SB(1, 1), b3 + hstep, voffB);
            PG8_WAIT_V(6); PG8_BAR; PG8_MMA(1, 1, At, B1); PG8_BAR;
            }
        }
        if constexpr (ALIGN_EPI) { if (wr == 0) PG8_BAR; }
        if constexpr (!Epi::AFTER_DRAIN) { E(acc, cur, wr, wc, fr, fq); S.done(cur); }
        if (!has_next) break;
#pragma unroll
        for (int a = 0; a < 2; ++a)
#pragma unroll
            for (int b = 0; b < 2; ++b)
#pragma unroll
                for (int m = 0; m < 4; ++m)
#pragma unroll
                    for (int n = 0; n < 2; ++n) acc[a][b][m][n] = (f32x4){0.f, 0.f, 0.f, 0.f};
        cur = nxt; cA = nA; cB = nB; ++ui;
        if constexpr (ALIGN_EPI) { if (wr == 1) PG8_BAR; }
    }
    PG8_WAIT_V(0);
    if constexpr (!ALIGN_EPI) { if (wr == 0) PG8_BAR; }
    PG8_BAR;
    if constexpr (Epi::AFTER_DRAIN) { E.fused(acc, cur, wr, wc, fr, fq, lds, wid, lane); S.done(cur); }
#undef PG8_SA
#undef PG8_SB
#undef PG8_STAGE
#undef PG8_LDA
#undef PG8_LDB
#undef PG8_MMA
#undef PG8_WAIT_V
#undef PG8_WAIT_L
#undef PG8_BAR
#undef PG8_SCHED
}
}
#define GAS __attribute__((address_space(1)))
#define LAS __attribute__((address_space(3)))
typedef GAS unsigned gu32;
typedef GAS unsigned long long gu64;
#define RLX_AGENT __ATOMIC_RELAXED, __HIP_MEMORY_SCOPE_AGENT
#define LDS_WAIT() asm volatile("s_waitcnt lgkmcnt(0)" ::: "memory")
#define VM_WAIT() asm volatile("s_waitcnt vmcnt(0)" ::: "memory")
__device__ __forceinline__ unsigned long long rt() { return __builtin_amdgcn_s_memrealtime(); }
#define XB_TMO      128
#define XB_XCNT(j)  (256  + 64 * (j))
#define XB_XSUB(j)  (1280 + 64 * (j))
#define XB_XGEN(j)  (2304 + 64 * (j))
#define XB_TOP      3328
#define XB_TOPGEN   3392
#define XCD_BAR_WORDS 3456
#define XB_SPIN_CAP (1u << 18)

__device__ __forceinline__ unsigned xb_ld(unsigned* p)              { return __hip_atomic_load(p, __ATOMIC_RELAXED, __HIP_MEMORY_SCOPE_AGENT); }
__device__ __forceinline__ unsigned xb_add(unsigned* p, unsigned v) { return __hip_atomic_fetch_add(p, v, __ATOMIC_RELAXED, __HIP_MEMORY_SCOPE_AGENT); }
__device__ __forceinline__ unsigned xb_xcc_id() { return (unsigned)__builtin_amdgcn_s_getreg((3 << 11) | 20) & 0xFu; }
#define XB_SPIN(cond, bar) do { unsigned _sp = 0; while (cond) { __builtin_amdgcn_s_sleep(1); \
    if ((++_sp & 255u) == 0u) { if (xb_ld(&(bar)[XB_TMO])) break; if (_sp > XB_SPIN_CAP) { atomicAdd(&(bar)[XB_TMO], 1u); break; } } } } while (0)

struct XcdBarrier {
    unsigned* bar; unsigned x;
    volatile LAS unsigned* st;
};

__device__ __forceinline__ XcdBarrier xcd_barrier_post(unsigned* bar, volatile LAS unsigned* st) {
    XcdBarrier b; b.bar = bar; b.x = xb_xcc_id(); b.st = st;
    if (threadIdx.x == 0) (void)xb_add(&bar[XB_XCNT(b.x)], 1u);
    return b;
}
__device__ __forceinline__ void xcd_barrier_complete(unsigned* bar, unsigned x, unsigned& nloc, unsigned& nx) {
    const unsigned G = gridDim.x * gridDim.y * gridDim.z;
    unsigned sum, cnt, mine, sp = 0u;
    for (;;) {
        sum = 0u; cnt = 0u; mine = 0u;
#pragma unroll
        for (unsigned j = 0; j < 16; ++j) { const unsigned c = xb_ld(&bar[XB_XCNT(j)]); sum += c; cnt += (c > 0u) ? 1u : 0u; mine = (j == x) ? c : mine; }
        if (sum == G) break;
        __builtin_amdgcn_s_sleep(1);
        if ((++sp & 255u) == 0u) { if (xb_ld(&bar[XB_TMO])) break; if (sp > XB_SPIN_CAP) { atomicAdd(&bar[XB_TMO], 1u); break; } }
    }
    nloc = mine > 0u ? mine : 1u; nx = cnt > 0u ? cnt : 1u;
}

__device__ __forceinline__ void xcd_barrier(const XcdBarrier& b) {
    asm volatile("s_waitcnt vmcnt(0)" ::: "memory");
    __syncthreads();
    if (threadIdx.x == 0) {
        unsigned* bar = b.bar;
        __builtin_amdgcn_s_waitcnt(0);
        unsigned nloc = b.st[0], nx = b.st[1];
        if (nloc == 0u) { xcd_barrier_complete(bar, b.x, nloc, nx); b.st[0] = nloc; b.st[1] = nx; }
        const unsigned old = xb_add(&bar[XB_XSUB(b.x)], 1u);
        const unsigned gen = old / nloc;
        if (old + 1u == (gen + 1u) * nloc) {
            __builtin_amdgcn_fence(__ATOMIC_RELEASE, "agent");
            asm volatile("s_waitcnt vmcnt(0)" ::: "memory");
            const unsigned og = xb_add(&bar[XB_TOP], 1u);
            const unsigned tg = og / nx;
            if (og + 1u == (tg + 1u) * nx) xb_add(&bar[XB_TOPGEN], 1u);
            else XB_SPIN(xb_ld(&bar[XB_TOPGEN]) == tg, bar);
            __builtin_amdgcn_fence(__ATOMIC_ACQUIRE, "agent");
            xb_add(&bar[XB_XGEN(b.x)], 1u);
            asm volatile("s_waitcnt vmcnt(0)" ::: "memory");
        } else {
            XB_SPIN(xb_ld(&bar[XB_XGEN(b.x)]) == gen, bar);
            __builtin_amdgcn_fence(__ATOMIC_ACQUIRE, "agent");
            asm volatile("s_waitcnt vmcnt(0)" ::: "memory");
        }
    }
    __syncthreads();
}


constexpr int NB = 2, SEQ = 8192, DM = 1024, DEPTH = 4, NMETA = 16, LP = 8320, M = NB * LP;
constexpr int N_IN = 5384, N1 = 5376, NRW = 1792, NGT = 2048, DFF = 2816, NUP = 5632;
constexpr float LOG2E = 1.4426950408889634f;
constexpr float QSCALE = 0.125f * LOG2E;
constexpr float THR2 = 30.0f * LOG2E;
constexpr int NWAVES = 8, NTHR = 512, MMAIN = 16384;
constexpr int LDS_BYTES = 147456, MISC_OFF = 147456 - 128;

typedef unsigned short bf16;
typedef float f32x4 __attribute__((ext_vector_type(4)));
typedef unsigned u32x4 __attribute__((ext_vector_type(4)));
typedef unsigned u32x2 __attribute__((ext_vector_type(2)));
typedef short bf16x8 __attribute__((ext_vector_type(8)));

constexpr size_t SZ_H = (size_t)M * DM * 4, SZ_X512 = (size_t)M * 512 * 2;
constexpr size_t OFF_CTL = 0, OFF_H = 1u << 20, OFF_WT = OFF_H + SZ_H;
constexpr size_t WT_IN = 0, WT_BF = WT_IN + (size_t)N1 * 1024, WT_BR = WT_BF + 1024 * 512, WT_O = WT_BR + 1024 * 512,
                 WT_UP = WT_O + 1024 * 1024, WT_DN = WT_UP + (size_t)NUP * 1024, WT_LW = WT_DN + (size_t)1024 * DFF, WT_LA = WT_LW + 512 * 64, WT_LG = WT_LA + 512 * 64, WT_END = WT_LG + 512 * 128;
constexpr size_t OFF_HN = OFF_WT + WT_END * 2;
constexpr size_t OFF_Q = OFF_HN + 2 * SZ_X512, OFF_K = OFF_Q + SZ_X512, OFF_V = OFF_K + SZ_X512;
constexpr size_t OFF_RW = OFF_V + SZ_X512, OFF_GT = OFF_RW + (size_t)M * NRW * 2, OFF_MISC = OFF_GT + (size_t)M * NGT * 2;
constexpr size_t OFF_T0 = OFF_MISC + 2 * 16 * LP * 4, OFF_OF = OFF_T0 + 2 * SZ_X512, WS_NEED = OFF_OF + SZ_X512;
static_assert(OFF_HN % 256 == 0 && OFF_RW % 256 == 0 && OFF_T0 % 256 == 0, "alignment");

struct Params { const float* in[26]; float* out; unsigned char* ws; };
struct Ctx { int tid, lane, wave, bid, G; unsigned char* lds; unsigned char* ws; };

__device__ __forceinline__ float bf2f(unsigned b) { return __uint_as_float(b << 16); }
__device__ __forceinline__ float bflo(unsigned w) { return __uint_as_float(w << 16); }
__device__ __forceinline__ float bfhi(unsigned w) { return __uint_as_float(w & 0xffff0000u); }
typedef float f32x2_t_ __attribute__((ext_vector_type(2))); typedef __bf16 bf16x2_t_ __attribute__((ext_vector_type(2)));
__device__ __forceinline__ unsigned pk2(float lo, float hi) { const f32x2_t_ v = {lo, hi}; const bf16x2_t_ r = __builtin_convertvector(v, bf16x2_t_); return __builtin_bit_cast(unsigned, r); }
__device__ __forceinline__ unsigned f2bf(float f) { return pk2(f, 0.f) & 0xffffu; }
__device__ __forceinline__ float wave_sum(float v) {
#pragma unroll
    for (int o = 1; o < 64; o <<= 1) v += __shfl_xor(v, o);
    return v;
}
__device__ __forceinline__ float sigmoidf_(float x) { return __builtin_amdgcn_rcpf(1.f + __expf(-x)); }
template <int CTRL> __device__ __forceinline__ float dppf(float old, float x) {
    return __int_as_float(__builtin_amdgcn_update_dpp(__float_as_int(old), __float_as_int(x), CTRL, 0xf, 0xf, false));
}
__device__ __forceinline__ float allreduce16(float x) {
    x += dppf<0x121>(0.f, x); x += dppf<0x122>(0.f, x); x += dppf<0x124>(0.f, x); x += dppf<0x128>(0.f, x); return x;
}

namespace pg8 {
struct EpiRoute {
    static constexpr bool PERM = true, AFTER_DRAIN = false;
    unsigned char* ws;
    __device__ __forceinline__ void operator()(const f32x4 (&acc)[2][2][4][2], const Unit& u, int wr, int wc, int fr, int fq) const {
        const int pn = u.pn; size_t off; int ldc, colt;
        if (pn < 6) { off = OFF_Q + (size_t)(pn >> 1) * SZ_X512; ldc = 512; colt = (pn & 1) * 256; }
        else if (pn < 13) { off = OFF_RW; ldc = NRW; colt = (pn - 6) * 256; }
        else { off = OFF_GT; ldc = NGT; colt = (pn - 13) * 256; }
        bf16_t* base = (bf16_t*)(ws + off);
        const int row0 = u.pm * BM + wr * 64 + fr, col0 = colt + wc * 32 + 8 * fq;
#pragma unroll
        for (int ai = 0; ai < 2; ++ai)
#pragma unroll
            for (int m = 0; m < 4; ++m) { bf16_t* rowp = base + (size_t)(row0 + ai * HALF + m * 16) * ldc + col0;
#pragma unroll
                for (int bj = 0; bj < 2; ++bj) { const f32x4 v0 = acc[ai][bj][m][0], v1 = acc[ai][bj][m][1];
                    u32x4 w; w.x = cvt_pk_bf16(v0[0], v0[1]); w.y = cvt_pk_bf16(v0[2], v0[3]); w.z = cvt_pk_bf16(v1[0], v1[1]); w.w = cvt_pk_bf16(v1[2], v1[3]);
                    *(u32x4*)(rowp + bj * HALF) = w; } }
    }
};
template <int MODE> struct EpiGate {
    static constexpr bool PERM = true, AFTER_DRAIN = false;
    bf16_t* O; const bf16_t* GT; const float* gb;
    __device__ __forceinline__ void operator()(const f32x4 (&acc)[2][2][4][2], const Unit& u, int wr, int wc, int fr, int fq) const {
        const int row0 = u.pm * BM + wr * 64 + fr, col0 = u.pn * BM + wc * 32 + 8 * fq;
#pragma unroll
        for (int bj = 0; bj < 2; ++bj) {
            const int c = col0 + bj * HALF;
            const f32x4 b0 = *(const f32x4*)(gb + MODE * 1024 + c), b1 = *(const f32x4*)(gb + MODE * 1024 + c + 4);
#pragma unroll
            for (int ai = 0; ai < 2; ++ai)
#pragma unroll
                for (int m = 0; m < 4; ++m) {
                    const size_t row = (size_t)(row0 + ai * HALF + m * 16);
                    const u32x4 gw = *(const u32x4*)(GT + row * NGT + MODE * 1024 + c);
                    const f32x4 v0 = acc[ai][bj][m][0], v1 = acc[ai][bj][m][1];
                    float r[8];
                    r[0] = sigmoidf_(bflo(gw.x) + b0[0]) * v0[0]; r[1] = sigmoidf_(bfhi(gw.x) + b0[1]) * v0[1];
                    r[2] = sigmoidf_(bflo(gw.y) + b0[2]) * v0[2]; r[3] = sigmoidf_(bfhi(gw.y) + b0[3]) * v0[3];
                    r[4] = sigmoidf_(bflo(gw.z) + b1[0]) * v1[0]; r[5] = sigmoidf_(bfhi(gw.z) + b1[1]) * v1[1];
                    r[6] = sigmoidf_(bflo(gw.w) + b1[2]) * v1[2]; r[7] = sigmoidf_(bfhi(gw.w) + b1[3]) * v1[3];
                    bf16_t* op = O + row * 1024 + c;
                    if (MODE == 1) { const u32x4 ow = *(const u32x4*)op;
                        r[0] += bflo(ow.x); r[1] += bfhi(ow.x); r[2] += bflo(ow.y); r[3] += bfhi(ow.y); r[4] += bflo(ow.z); r[5] += bfhi(ow.z); r[6] += bflo(ow.w); r[7] += bfhi(ow.w); }
                    u32x4 w; w.x = cvt_pk_bf16(r[0], r[1]); w.y = cvt_pk_bf16(r[2], r[3]); w.z = cvt_pk_bf16(r[4], r[5]); w.w = cvt_pk_bf16(r[6], r[7]);
                    *(u32x4*)op = w;
                }
        }
    }
};
struct EpiResid {
    static constexpr bool PERM = false, AFTER_DRAIN = false;
    float* H; float* OUT; int atomic;
    __device__ __forceinline__ void operator()(const f32x4 (&acc)[2][2][4][2], const Unit& u, int wr, int wc, int fr, int fq) const {
        const int row0 = u.pm * BM + wr * 64 + fr, col0 = u.pn * BM + wc * 32 + 4 * fq;
#pragma unroll
        for (int ai = 0; ai < 2; ++ai)
#pragma unroll
            for (int m = 0; m < 4; ++m) {
                const int row = row0 + ai * HALF + m * 16;
                float* hp = H + (size_t)row * DM + col0;
                const int b = row >= LP ? 1 : 0, t = row - b * LP;
                float* op = (OUT && t >= NMETA && t < NMETA + SEQ) ? OUT + ((size_t)b * SEQ + (t - NMETA)) * DM + col0 : nullptr;
#pragma unroll
                for (int bj = 0; bj < 2; ++bj)
#pragma unroll
                    for (int n = 0; n < 2; ++n) { const int co = bj * HALF + n * 16;
                        if (atomic) {
#pragma unroll
                            for (int e = 0; e < 4; ++e) unsafeAtomicAdd(hp + co + e, acc[ai][bj][m][n][e]);
                        } else {
                            const f32x4 v = *(const f32x4*)(hp + co) + acc[ai][bj][m][n];
                            if (OUT) { if (op) *(f32x4*)(op + co) = v; } else *(f32x4*)(hp + co) = v; } }
            }
    }
};
struct EpiResidAtomic {
    static constexpr bool PERM = false, AFTER_DRAIN = false;
    float* H;
    __device__ __forceinline__ void operator()(const f32x4 (&acc)[2][2][4][2], const Unit& u, int wr, int wc, int fr, int fq) const {
        const int row0 = u.pm * BM + wr * 64 + fr, col0 = u.pn * BM + wc * 32 + 4 * fq;
#pragma unroll
        for (int ai = 0; ai < 2; ++ai)
#pragma unroll
            for (int m = 0; m < 4; ++m) { float* hp = H + (size_t)(row0 + ai * HALF + m * 16) * DM + col0;
#pragma unroll
                for (int bj = 0; bj < 2; ++bj)
#pragma unroll
                    for (int n = 0; n < 2; ++n)
#pragma unroll
                        for (int e = 0; e < 4; ++e) unsafeAtomicAdd(hp + bj * HALF + n * 16 + e, acc[ai][bj][m][n][e]); }
    }
};
struct OneUnit {
    StaticOrder so; int mode, pm, pn; bool active;
    __device__ bool next(int i, Unit& u) const { if (mode == 0) return so.next(i, u); if (i != 0 || !active) return false; u.pm = pm; u.pn = pn; return true; }
    __device__ __forceinline__ void a_ready(const Unit&) const {}
    __device__ __forceinline__ void done(const Unit&) const {}
};
struct EpiUp {
    static constexpr bool PERM = true, AFTER_DRAIN = false;
    bf16_t* ACT; bf16_t* HALO; const float* cw;
    __device__ __forceinline__ void operator()(const f32x4 (&acc)[2][2][4][2], const Unit& u, int wr, int wc, int fr, int fq) const {
        const int chan0 = u.pn * 128 + wc * 32 + 8 * fq;
#pragma unroll
        for (int n = 0; n < 2; ++n) {
            const int ch = chan0 + 4 * n;
            f32x4 w[3][2];
#pragma unroll
            for (int j = 0; j < 3; ++j) { w[j][0] = *(const f32x4*)(cw + j * NUP + ch); w[j][1] = *(const f32x4*)(cw + j * NUP + DFF + ch); }
#pragma unroll
            for (int ai = 0; ai < 2; ++ai) {
                const int rowg = u.pm * BM + ai * HALF + wr * 64;
#pragma unroll
                for (int m = 0; m < 4; ++m) {
                    f32x4 uc[2];
#pragma unroll
                    for (int bj = 0; bj < 2; ++bj) {
                        const f32x4 cur = acc[ai][bj][m][n];
                        f32x4 prv; if (m > 0) prv = acc[ai][bj][m - 1][n]; else prv = (f32x4){0.f, 0.f, 0.f, 0.f};
                        f32x4 p1, p2;
#pragma unroll
                        for (int i = 0; i < 4; ++i) {
                            const float r1 = dppf<0x121>(0.f, prv[i]), r2 = dppf<0x122>(0.f, prv[i]);
                            p1[i] = dppf<0x111>(r1, cur[i]); p2[i] = dppf<0x112>(r2, cur[i]);
                        }
                        uc[bj] = w[0][bj] * p2 + w[1][bj] * p1 + w[2][bj] * cur;
                    }
                    float a[4];
#pragma unroll
                    for (int i = 0; i < 4; ++i) a[i] = uc[0][i] * sigmoidf_(uc[0][i]) * uc[1][i];
                    u32x2 o; o.x = cvt_pk_bf16(a[0], a[1]); o.y = cvt_pk_bf16(a[2], a[3]);
                    *(u32x2*)(ACT + (size_t)(rowg + m * 16 + fr) * DFF + ch) = o;
                    if ((m == 3 && fr >= 14) || (m == 0 && fr < 2)) {
                        const int slot = (rowg >> 6) * 4 + (m == 3 ? fr - 14 : 2 + fr);
#pragma unroll
                        for (int bj = 0; bj < 2; ++bj) { const f32x4 cur = acc[ai][bj][m][n]; u32x2 hw; hw.x = cvt_pk_bf16(cur[0], cur[1]); hw.y = cvt_pk_bf16(cur[2], cur[3]);
                            *(u32x2*)(HALO + (size_t)slot * NUP + bj * DFF + ch) = hw; }
                    }
                }
            }
        }
    }
};
}

#ifndef REP_PREP
#define REP_PREP 1
#endif
#ifndef REP_P3
#define REP_P3 1
#endif
#ifndef REP_SYNC
#define REP_SYNC 0
#endif
#define GLD(T, p) (*(const __attribute__((address_space(1))) T*)(p))
#define GST(T, p) (*(__attribute__((address_space(1))) T*)(p))
#define LDS_BARRIER() do { asm volatile("s_waitcnt lgkmcnt(0)" ::: "memory"); __builtin_amdgcn_s_barrier(); asm volatile("" ::: "memory"); } while (0)
__device__ __forceinline__ void transpose_item(const float* W, int Nsrc, int K, bf16* WT, int dst_row0, int src_col0, int k0, float* scr, int lane) {
#pragma unroll 8
    for (int i = 0; i < 32; ++i) { const int kk = 2 * i + (lane >> 5); scr[kk * 33 + (lane & 31)] = W[(size_t)(k0 + kk) * Nsrc + src_col0 + (lane & 31)]; }
    asm volatile("s_waitcnt lgkmcnt(0)" ::: "memory");
    const int c = lane & 7;
#pragma unroll
    for (int j = 0; j < 4; ++j) { const int n = (lane >> 3) + 8 * j; const float* s = scr + (8 * c) * 33 + n;
        u32x4 o; o.x = pk2(s[0 * 33], s[1 * 33]); o.y = pk2(s[2 * 33], s[3 * 33]); o.z = pk2(s[4 * 33], s[5 * 33]); o.w = pk2(s[6 * 33], s[7 * 33]);
        *(u32x4*)(WT + (size_t)(dst_row0 + n) * K + k0 + 8 * c) = o; }
    asm volatile("s_waitcnt lgkmcnt(0)" ::: "memory");
}
__device__ __forceinline__ void convert_weights(const Params& P, int l, const Ctx& c) {
    bf16* WT = (bf16*)(c.ws + OFF_WT);
    float* scr = (float*)(c.lds + c.wave * 16384);
    const int gw = c.bid * NWAVES + c.wave, NGW = c.G * NWAVES;
    constexpr int I_IN = 16 * 168, I_BF = 8 * 32, I_O = 16 * 32, I_UP = 16 * 176, I_DN = 44 * 32, I_LR = 16, I_LG = 32, I_ALL = I_IN + 2 * I_BF + I_O + I_UP + I_DN + 2 * I_LR + I_LG;
    for (int it = gw; it < I_ALL; it += NGW) {
        int r = it;
        if (r < I_IN) { const int kb = r / 168, n0 = 32 * (r % 168); transpose_item(P.in[4] + (size_t)l * 1024 * N_IN, N_IN, 1024, WT + WT_IN, n0, n0 + (n0 >= 1536 ? 8 : 0), 64 * kb, scr, c.lane); continue; } r -= I_IN;
        if (r < I_BF) { const int kb = r / 32, n0 = 32 * (r % 32); transpose_item(P.in[19] + (size_t)l * 512 * 1024, 1024, 512, WT + WT_BF, n0, n0, 64 * kb, scr, c.lane); continue; } r -= I_BF;
        if (r < I_BF) { const int kb = r / 32, n0 = 32 * (r % 32); transpose_item(P.in[20] + (size_t)l * 512 * 1024, 1024, 512, WT + WT_BR, n0, n0, 64 * kb, scr, c.lane); continue; } r -= I_BF;
        if (r < I_O) { const int kb = r / 32, n0 = 32 * (r % 32); transpose_item(P.in[22] + (size_t)l * 1024 * 1024, 1024, 1024, WT + WT_O, n0, n0, 64 * kb, scr, c.lane); continue; } r -= I_O;
        if (r < I_UP) { const int kb = r / 176, n0 = 32 * (r % 176); const int pn = n0 >> 8, bj = (n0 >> 7) & 1, x = n0 & 127;
            transpose_item(P.in[23] + (size_t)l * 1024 * NUP, NUP, 1024, WT + WT_UP, n0, bj * DFF + 128 * pn + x, 64 * kb, scr, c.lane); continue; } r -= I_UP;
        if (r < I_DN) { const int kb = r / 32, n0 = 32 * (r % 32); transpose_item(P.in[25] + (size_t)l * DFF * 1024, 1024, DFF, WT + WT_DN, n0, n0, 64 * kb, scr, c.lane); continue; } r -= I_DN;
        if (r < I_LR) { transpose_item(P.in[10] + (size_t)l * 64 * 512, 512, 64, WT + WT_LW, 32 * r, 32 * r, 0, scr, c.lane); continue; } r -= I_LR;
        if (r < I_LR) { transpose_item(P.in[12] + (size_t)l * 64 * 512, 512, 64, WT + WT_LA, 32 * r, 32 * r, 0, scr, c.lane); continue; } r -= I_LR;
        { const int kb = r / 16, n0 = 32 * (r % 16); transpose_item(P.in[13] + (size_t)l * 128 * 512, 512, 128, WT + WT_LG, n0, n0, 64 * kb, scr, c.lane); }
    }
}

template <bool FG> __device__ __forceinline__ void phase_norm(const Params& P, int l, const Ctx& c) {
    float* H = (float*)(c.ws + OFF_H); bf16* HN = (bf16*)(c.ws + OFF_HN);
    float* LOGF = (float*)(c.ws + OFF_MISC);
    const float* gain = (FG ? P.in[2] : P.in[3]) + l * DM;
    float* wfs = (float*)c.lds;
    if (FG) {
        __syncthreads();
        const float* win = P.in[4] + (size_t)l * 1024 * N_IN + 1536;
        for (int i = c.tid; i < 8192; i += NTHR) wfs[i] = win[(size_t)(i >> 3) * N_IN + (i & 7)];
        __syncthreads();
    }
    const int gw = c.bid * NWAVES + c.wave, NGW = c.G * NWAVES;
    for (int m = gw; m < M; m += NGW) {
        const int b = m >= LP ? 1 : 0, t = m - b * LP;
        f32x4 v[4];
        if (FG && l == 0) {
            const float* src = (t < NMETA) ? P.in[1] + (size_t)t * DM : P.in[0] + ((size_t)b * SEQ + (t - NMETA)) * DM;
            const bool real = t < NMETA + SEQ;
#pragma unroll
            for (int j = 0; j < 4; ++j) { v[j] = real ? *(const f32x4*)(src + 4 * c.lane + 256 * j) : (f32x4){0.f, 0.f, 0.f, 0.f}; *(f32x4*)(H + (size_t)m * DM + 4 * c.lane + 256 * j) = v[j]; }
        } else {
#pragma unroll
            for (int j = 0; j < 4; ++j) v[j] = *(const f32x4*)(H + (size_t)m * DM + 4 * c.lane + 256 * j);
        }
        float ss = 0.f;
#pragma unroll
        for (int j = 0; j < 4; ++j) ss += (v[j].x * v[j].x + v[j].y * v[j].y) + (v[j].z * v[j].z + v[j].w * v[j].w);
        const float rstd = 1.0f / sqrtf(wave_sum(ss) * (1.f / DM) + 1e-6f);
        float f[8];
#pragma unroll
        for (int q = 0; q < 8; ++q) f[q] = 0.f;
#pragma unroll
        for (int j = 0; j < 4; ++j) {
            const f32x4 g = *(const f32x4*)(gain + 4 * c.lane + 256 * j);
            v[j] = v[j] * rstd * g;
            u32x2 o; o.x = pk2(v[j].x, v[j].y); o.y = pk2(v[j].z, v[j].w);
            *(u32x2*)(HN + (size_t)m * DM + 4 * c.lane + 256 * j) = o;
            if (FG) {
#pragma unroll
                for (int e = 0; e < 4; ++e) { const int k = 4 * c.lane + 256 * j + e; const f32x4 w0 = *(const f32x4*)(wfs + k * 8), w1 = *(const f32x4*)(wfs + k * 8 + 4);
                    const float hv = v[j][e];
                    f[0] += hv * w0.x; f[1] += hv * w0.y; f[2] += hv * w0.z; f[3] += hv * w0.w; f[4] += hv * w1.x; f[5] += hv * w1.y; f[6] += hv * w1.z; f[7] += hv * w1.w; }
            }
        }
        if (FG) {
#pragma unroll
            for (int q = 0; q < 8; ++q) f[q] = wave_sum(f[q]);
            float fv = f[0];
#pragma unroll
            for (int q = 1; q < 8; ++q) fv = (c.lane == q) ? f[q] : fv;
            if (c.lane < 8) { const float x = fv + P.in[7][l * 8 + c.lane]; const float ls = fminf(x, 0.f) - __logf(1.f + __expf(-fabsf(x))); LOGF[(size_t)(b * 8 + c.lane) * LP + t] = ls; }
        }
    }
}

__device__ __forceinline__ void phase_fcum(const Params& P, const Ctx& c) {
    if (c.bid < 16 && c.wave == 0) {
        const float* LOGF = (const float*)(c.ws + OFF_MISC) + (size_t)c.bid * LP; float* FC = (float*)(c.ws + OFF_MISC) + 16 * LP + (size_t)c.bid * LP;
        float carry = 0.f;
        for (int ch = 0; ch < LP / 64; ++ch) {
            float v = LOGF[ch * 64 + c.lane];
#pragma unroll
            for (int o = 1; o < 64; o <<= 1) { const float t = __shfl_up(v, o); if (c.lane >= o) v += t; }
            v += carry; FC[ch * 64 + c.lane] = v * LOG2E; carry = __shfl(v, 63);
        }
    }
}

__device__ __forceinline__ void phase_qknorm(const Params& P, int l, const Ctx& c) {
    bf16* Q = (bf16*)(c.ws + OFF_Q); bf16* K = (bf16*)(c.ws + OFF_K);
    const int gw = c.bid * NWAVES + c.wave, NGW = c.G * NWAVES;
    const int d0 = (c.lane & 7) * 8;
    float gq[8], gk[8];
#pragma unroll
    for (int i = 0; i < 8; ++i) { gq[i] = P.in[5][l * 64 + d0 + i] * QSCALE; gk[i] = P.in[6][l * 64 + d0 + i]; }
    for (int m = gw; m < M; m += NGW) {
#pragma unroll
        for (int which = 0; which < 2; ++which) {
            bf16* p = (which ? K : Q) + (size_t)m * 512 + 8 * c.lane;
            const u32x4 w = *(const u32x4*)p;
            float x[8] = {bflo(w.x), bfhi(w.x), bflo(w.y), bfhi(w.y), bflo(w.z), bfhi(w.z), bflo(w.w), bfhi(w.w)};
            float ss = 0.f;
#pragma unroll
            for (int i = 0; i < 8; ++i) ss += x[i] * x[i];
            ss += __shfl_xor(ss, 1); ss += __shfl_xor(ss, 2); ss += __shfl_xor(ss, 4);
            const float rs = 1.0f / sqrtf(ss * (1.f / 64.f) + 1e-6f);
#pragma unroll
            for (int i = 0; i < 8; ++i) x[i] = x[i] * rs * (which ? gk[i] : gq[i]);
            u32x4 o; o.x = pk2(x[0], x[1]); o.y = pk2(x[2], x[3]); o.z = pk2(x[4], x[5]); o.w = pk2(x[6], x[7]);
            *(u32x4*)p = o;
        }
    }
}

constexpr int NCHK = LP / 64;
constexpr int NUNIT = NB * NCHK * 8;
constexpr int UNIT_A = 16384, UNIT_B = 16640;
constexpr int ST = 72, STG = 136;
constexpr int L_F0 = 92160, L_F1 = 108544;
struct RwkvBufs { bf16 *BON, *G; unsigned char *UA, *UB; float* Y; bf16* ORW; };
__device__ __forceinline__ RwkvBufs rwkv_bufs(const Params& P, const Ctx& c) {
    RwkvBufs r; r.BON = (bf16*)(c.ws + OFF_HN); r.G = r.BON + (size_t)M * 512;
    r.UA = c.ws + OFF_T0; r.UB = (unsigned char*)P.out;
    r.Y = (float*)(c.ws + OFF_RW); r.ORW = (bf16*)(c.ws + OFF_RW + (size_t)M * 512 * 4);
    return r;
}
__device__ __forceinline__ void mm_tile(const bf16* A, int sa, const bf16* Bt, int sb, int nks, f32x4 (&acc)[2], int w, int lq, int g) {
    const int mt = w >> 1, nt0 = 2 * (w & 1);
    for (int ks = 0; ks < nks; ++ks) {
        const bf16x8 a = *(const bf16x8*)(A + (16 * mt + lq) * sa + 32 * ks + 8 * g);
#pragma unroll
        for (int q = 0; q < 2; ++q) { const bf16x8 b = *(const bf16x8*)(Bt + (16 * (nt0 + q) + lq) * sb + 32 * ks + 8 * g); acc[q] = __builtin_amdgcn_mfma_f32_16x16x32_bf16(a, b, acc[q], 0, 0, 0); }
    }
}
template <bool SA, bool SB> __device__ __forceinline__ void mm_tile2(const bf16* A, int sa, const bf16* Bt, int sb, int nks, f32x4 (&acc)[2], int w, int lq, int g) {
    const int mt = w >> 1, nt0 = 2 * (w & 1);
    const int ra = 16 * mt + lq, xa = SA ? 8 * ((ra >> 3) & 7) : 0;
    for (int ks = 0; ks < nks; ++ks) {
        const bf16x8 a = *(const bf16x8*)(A + ra * sa + ((32 * ks + 8 * g) ^ xa));
#pragma unroll
        for (int q = 0; q < 2; ++q) { const int rb = 16 * (nt0 + q) + lq, xb = SB ? 8 * ((rb >> 3) & 7) : 0;
            const bf16x8 bb = *(const bf16x8*)(Bt + rb * sb + ((32 * ks + 8 * g) ^ xb)); acc[q] = __builtin_amdgcn_mfma_f32_16x16x32_bf16(a, bb, acc[q], 0, 0, 0); }
    }
}
#define ZACC(a) do { a[0] = (f32x4){0.f, 0.f, 0.f, 0.f}; a[1] = (f32x4){0.f, 0.f, 0.f, 0.f}; } while (0)
__device__ __forceinline__ int permk(int k) { return 32 * (k >> 5) + 8 * ((k & 15) >> 2) + 4 * ((k >> 4) & 1) + (k & 3); }
__device__ __forceinline__ int swz(int row, int col) { return row * 128 + ((((col >> 3) ^ (row >> 1)) & 7) << 4) + (col & 7) * 2; }

__device__ __forceinline__ void rwkv_prep_unit(const Params& P, int l, const Ctx& c, int u, const RwkvBufs& B, const float (&pw0)[8], const float (&pa0)[8], const float (&pkk)[8], const float (&pka)[8], const float (&prk)[8]) {
    const int h = u & 7, bc = u >> 3, b = bc / NCHK, ch = bc - b * NCHK;
    const size_t m0 = (size_t)b * LP + ch * 64;
    int tid_ = c.tid; asm volatile("" : "+v"(tid_));
    const int tid = tid_, lane = tid & 63, w = c.wave, lq = lane & 15, g = lane >> 4;
    const int t = tid >> 3, cg = tid & 7, c0 = cg * 8, jb = h * 64 + c0;
    unsigned char* L = c.lds;
    bf16* A0 = (bf16*)L; bf16* A1 = A0 + 4608; bf16* A2 = A1 + 4608; bf16* A3 = A2 + 4608; bf16* A4 = A3 + 4608; bf16* A5 = A4 + 4608; bf16* A6 = A5 + 4608;
    bf16* A7 = A6 + 4608; bf16* A8 = A7 + 4608; bf16* A9 = A8 + 4608;
    float* F0 = (float*)(L + L_F0); float* F1 = (float*)(L + L_F1);
    const bf16* RW = (const bf16*)(c.ws + OFF_RW);
    const bf16* WT = (const bf16*)(c.ws + OFF_WT);
    const float* mu = P.in[8] + l * NRW;
    const bool first = (ch == 0 && t == 0);
    const bf16* cur = RW + (m0 + t) * NRW; const bf16* prv = cur - NRW;
    float zr[8], zk[8], zv[8];
#pragma unroll
    for (int s = 0; s < 3; ++s) {
        const u32x4 cw = *(const u32x4*)(cur + s * 512 + jb); u32x4 pw = (u32x4){0u, 0u, 0u, 0u}; if (!first) pw = *(const u32x4*)(prv + s * 512 + jb);
        const float cv[8] = {bflo(cw.x), bfhi(cw.x), bflo(cw.y), bfhi(cw.y), bflo(cw.z), bfhi(cw.z), bflo(cw.w), bfhi(cw.w)};
        const float pv[8] = {bflo(pw.x), bfhi(pw.x), bflo(pw.y), bfhi(pw.y), bflo(pw.z), bfhi(pw.z), bflo(pw.w), bfhi(pw.w)};
#pragma unroll
        for (int i = 0; i < 8; ++i) { const float z = cv[i] + mu[s * 512 + jb + i] * (pv[i] - cv[i]); if (s == 0) zr[i] = z; else if (s == 1) zk[i] = z; else zv[i] = z; }
    }
#pragma unroll
    for (int q4 = 0; q4 < 4; ++q4) {
        const int col = cg * 32 + q4 * 8;
        const u32x4 cw = *(const u32x4*)(cur + 1536 + col); u32x4 pw = (u32x4){0u, 0u, 0u, 0u}; if (!first) pw = *(const u32x4*)(prv + 1536 + col);
        const float cv[8] = {bflo(cw.x), bfhi(cw.x), bflo(cw.y), bfhi(cw.y), bflo(cw.z), bfhi(cw.z), bflo(cw.w), bfhi(cw.w)};
        const float pv[8] = {bflo(pw.x), bfhi(pw.x), bflo(pw.y), bfhi(pw.y), bflo(pw.z), bfhi(pw.z), bflo(pw.w), bfhi(pw.w)};
        float z[8];
#pragma unroll
        for (int i = 0; i < 8; ++i) { z[i] = cv[i] + mu[1536 + col + i] * (pv[i] - cv[i]); if (col < 64) z[i] = 1.f - 2.f / (1.f + __expf(2.f * z[i])); else if (col >= 128) z[i] = sigmoidf_(z[i]); }
        u32x4 o; o.x = pk2(z[0], z[1]); o.y = pk2(z[2], z[3]); o.z = pk2(z[4], z[5]); o.w = pk2(z[6], z[7]);
        bf16* dst = (col < 64) ? A0 + t * ST + col : (col < 128 ? A1 + t * ST + (col - 64) : A2 + t * STG + (col - 128));
        *(u32x4*)dst = o;
    }
    { const int row = tid >> 3, chk = tid & 7;
      *(u32x4*)(A4 + row * ST + chk * 8) = *(const u32x4*)(WT + WT_LW + (size_t)(h * 64 + row) * 64 + chk * 8);
      *(u32x4*)(A5 + row * ST + chk * 8) = *(const u32x4*)(WT + WT_LA + (size_t)(h * 64 + row) * 64 + chk * 8);
#pragma unroll
      for (int i = 0; i < 2; ++i) { const int idx = tid + 512 * i, r2 = idx >> 4, c2 = idx & 15;
          *(u32x4*)((bf16*)F1 + r2 * STG + c2 * 8) = *(const u32x4*)(WT + WT_LG + (size_t)(h * 64 + r2) * 128 + c2 * 8); } }
    LDS_BARRIER();
    { f32x4 aw[2], aa[2], ag[2]; ZACC(aw); ZACC(aa); ZACC(ag);
      mm_tile(A4, ST, A0, ST, 2, aw, w, lq, g); mm_tile(A5, ST, A1, ST, 2, aa, w, lq, g); mm_tile((const bf16*)F1, STG, A2, STG, 4, ag, w, lq, g);
      const int mt = w >> 1, nt0 = 2 * (w & 1);
#pragma unroll
      for (int q = 0; q < 2; ++q) { const int o = (16 * (nt0 + q) + lq) * ST + 16 * mt + 4 * g; u32x2 p;
          p.x = pk2(aw[q][0], aw[q][1]); p.y = pk2(aw[q][2], aw[q][3]); *(u32x2*)(A7 + o) = p;
          p.x = pk2(aa[q][0], aa[q][1]); p.y = pk2(aa[q][2], aa[q][3]); *(u32x2*)(A8 + o) = p;
          p.x = pk2(ag[q][0], ag[q][1]); p.y = pk2(ag[q][2], ag[q][3]); *(u32x2*)(A9 + o) = p; } }
    LDS_BARRIER();
    float kk[8], k2[8], ar[8];
    { const u32x4 lw = *(const u32x4*)(A7 + t * ST + c0), la = *(const u32x4*)(A8 + t * ST + c0), lg = *(const u32x4*)(A9 + t * ST + c0);
      const float fw[8] = {bflo(lw.x), bfhi(lw.x), bflo(lw.y), bfhi(lw.y), bflo(lw.z), bfhi(lw.z), bflo(lw.w), bfhi(lw.w)};
      const float fa[8] = {bflo(la.x), bfhi(la.x), bflo(la.y), bfhi(la.y), bflo(la.z), bfhi(la.z), bflo(la.w), bfhi(la.w)};
      float ss = 0.f, bs = 0.f;
#pragma unroll
      for (int i = 0; i < 8; ++i) {
          const float xw = -(pw0[i] + fw[i]); const float sp = fmaxf(xw, 0.f) + __logf(1.f + __expf(-fabsf(xw)));
          F0[t * 64 + c0 + i] = __expf(-sp - 0.5f);
          ar[i] = sigmoidf_(pa0[i] + fa[i]);
          kk[i] = zk[i] * pkk[i]; ss += kk[i] * kk[i];
          k2[i] = zk[i] * (1.f + (ar[i] - 1.f) * pka[i]);
          bs += zr[i] * k2[i] * prk[i]; }
      ss += __shfl_xor(ss, 1); ss += __shfl_xor(ss, 2); ss += __shfl_xor(ss, 4);
      bs += __shfl_xor(bs, 1); bs += __shfl_xor(bs, 2); bs += __shfl_xor(bs, 4);
      const float inv = 1.0f / fmaxf(sqrtf(ss), 1e-12f);
#pragma unroll
      for (int i = 0; i < 8; ++i) kk[i] *= inv;
      u32x4 bo; bo.x = pk2(bs * zv[0], bs * zv[1]); bo.y = pk2(bs * zv[2], bs * zv[3]); bo.z = pk2(bs * zv[4], bs * zv[5]); bo.w = pk2(bs * zv[6], bs * zv[7]);
      *(u32x4*)(B.BON + (m0 + t) * 512 + jb) = bo; *(u32x4*)(B.G + (m0 + t) * 512 + jb) = lg; }
    LDS_BARRIER();
    {
      const int k = tid & 63, sg = tid >> 6; float e[8], run = 0.f;
#pragma unroll
      for (int s = 0; s < 8; ++s) { run += F0[(8 * sg + s) * 64 + k]; e[s] = run; }
      F1[sg * 64 + k] = run;
      LDS_BARRIER();
      float off = 0.f;
#pragma unroll
      for (int s = 0; s < 8; ++s) off += (s < sg) ? F1[s * 64 + k] : 0.f;
#pragma unroll
      for (int s = 0; s < 8; ++s) F0[(8 * sg + s) * 64 + k] = e[s] + off; }
    LDS_BARRIER();
    { float ct[8], cp[8], cC[8];
#pragma unroll
      for (int i = 0; i < 8; ++i) { ct[i] = F0[t * 64 + c0 + i]; cp[i] = (t > 0) ? F0[(t - 1) * 64 + c0 + i] : 0.f; cC[i] = F0[63 * 64 + c0 + i]; }
      float at[8], bt[8], kt[8], rt[8], bh[8], kh[8];
#pragma unroll
      for (int i = 0; i < 8; ++i) { const float gt = __expf(-ct[i]), igt = __expf(ct[i]), gp = __expf(-cp[i]), gct = __expf(ct[i] - cC[i]);
          at[i] = -kk[i] * gp; bt[i] = kk[i] * ar[i] * igt; kt[i] = k2[i] * igt; rt[i] = zr[i] * gt; bh[i] = kk[i] * ar[i] * gct; kh[i] = k2[i] * gct; }
      u32x4 o;
      o.x = pk2(at[0], at[1]); o.y = pk2(at[2], at[3]); o.z = pk2(at[4], at[5]); o.w = pk2(at[6], at[7]); *(u32x4*)(A0 + t * ST + c0) = o;
      o.x = pk2(bt[0], bt[1]); o.y = pk2(bt[2], bt[3]); o.z = pk2(bt[4], bt[5]); o.w = pk2(bt[6], bt[7]); *(u32x4*)(A1 + t * ST + c0) = o;
      o.x = pk2(kt[0], kt[1]); o.y = pk2(kt[2], kt[3]); o.z = pk2(kt[4], kt[5]); o.w = pk2(kt[6], kt[7]); *(u32x4*)(A2 + t * ST + c0) = o;
      o.x = pk2(rt[0], rt[1]); o.y = pk2(rt[2], rt[3]); o.z = pk2(rt[4], rt[5]); o.w = pk2(rt[6], rt[7]); *(u32x4*)(A3 + t * ST + c0) = o;
#pragma unroll
      for (int i = 0; i < 8; ++i) { const int o = (c0 + i) * ST + (t ^ c0);
          A4[o] = (bf16)f2bf(bh[i]); A5[o] = (bf16)f2bf(kh[i]); A6[o] = (bf16)f2bf(zv[i]); F1[t * 128 + c0 + i] = at[i]; }
      if (t == 63) { float* gc = (float*)(B.UB + (size_t)u * UNIT_B + 16384) + c0;
#pragma unroll
          for (int i = 0; i < 8; ++i) gc[i] = __expf(-cC[i]); } }
    LDS_BARRIER();
    { const int mt = w >> 1, nt0 = 2 * (w & 1);
      f32x4 a[2];
      ZACC(a); mm_tile(A0, ST, A1, ST, 2, a, w, lq, g);
#pragma unroll
      for (int q = 0; q < 2; ++q) { const int i = 16 * (nt0 + q) + lq; f32x4 lab;
#pragma unroll
          for (int j = 0; j < 4; ++j) lab[j] = (i < 16 * mt + 4 * g + j) ? a[q][j] : 0.f;
#pragma unroll
          for (int j = 0; j < 4; ++j) F0[i * 64 + j * 16 + 4 * mt + g] = lab[j]; }
      asm volatile("" ::: "memory");
#define ST1_STORE(DST, INCL) do { _Pragma("unroll") for (int q = 0; q < 2; ++q) { const int tt = 16 * (nt0 + q) + lq, i0 = 16 * mt + 4 * g; float v_[4]; \
          _Pragma("unroll") for (int j = 0; j < 4; ++j) v_[j] = (i0 + j < tt + (INCL)) ? a[q][j] : 0.f; \
          u32x2 p_; p_.x = pk2(v_[0], v_[1]); p_.y = pk2(v_[2], v_[3]); *(u32x2*)((DST) + tt * ST + i0) = p_; } } while (0)
      ZACC(a); mm_tile(A2, ST, A0, ST, 2, a, w, lq, g); ST1_STORE(A7, 0); asm volatile("" ::: "memory");
      ZACC(a); mm_tile(A1, ST, A3, ST, 2, a, w, lq, g); ST1_STORE(A8, 1); asm volatile("" ::: "memory");
      ZACC(a); mm_tile(A2, ST, A3, ST, 2, a, w, lq, g); ST1_STORE(A9, 1);
#undef ST1_STORE
    }
    LDS_BARRIER();
    { const int mt = w >> 1, nt0 = 2 * (w & 1); f32x4 a[2]; ZACC(a);
      mm_tile2<true, false>(A6, ST, A7, ST, 2, a, w, lq, g);
#pragma unroll
      for (int q = 0; q < 2; ++q) *(f32x4*)(F1 + (16 * (nt0 + q) + lq) * 128 + 64 + 16 * mt + 4 * g) = a[q]; }
    LDS_BARRIER();
    { float X[16];
      const int col = 16 * w + lq;
#pragma unroll
      for (int r = 0; r < 16; ++r) X[r] = F1[(4 * r + g) * 128 + col];
      LDS_BARRIER();
      f32x4 Lc[4];
#pragma unroll
      for (int q = 0; q < 4; ++q) Lc[q] = *(const f32x4*)(F0 + g * 16 + 4 * q);
#pragma unroll
      for (int i = 0; i < 64; ++i) {
          const float xi = __shfl(X[i >> 2], (i & 3) * 16 + lq);
          f32x4 Ln[4];
#pragma unroll
          for (int q = 0; q < 4; ++q) Ln[q] = Lc[q];
          if (i + 1 < 64) {
#pragma unroll
              for (int q = ((i + 1) >> 4); q < 4; ++q) Ln[q] = *(const f32x4*)(F0 + (i + 1) * 64 + g * 16 + 4 * q);
          }
#pragma unroll
          for (int r = (i >> 2); r < 16; ++r) X[r] += Lc[r >> 2][r & 3] * xi;
#pragma unroll
          for (int q = 0; q < 4; ++q) Lc[q] = Ln[q];
          __builtin_amdgcn_sched_barrier(0);
      }
      bf16* XT = (bf16*)F1 + (w >> 2) * 4608 + ((col & 63) * ST);
#pragma unroll
      for (int r = 0; r < 16; ++r) XT[4 * r + g] = (bf16)f2bf(X[r]); }
    LDS_BARRIER();
    { const int mt = w >> 1, nt0 = 2 * (w & 1);
      const bf16* AhT = (const bf16*)F1; const bf16* W2T = AhT + 4608;
      unsigned char* ua = B.UA + (size_t)u * UNIT_A; unsigned char* ub = B.UB + (size_t)u * UNIT_B;
      const int p0 = 32 * (mt >> 1) + 8 * g + 4 * (mt & 1);
      f32x4 a[2];
      ZACC(a); mm_tile2<false, true>(AhT, ST, A4, ST, 2, a, w, lq, g);
#pragma unroll
      for (int q = 0; q < 2; ++q) { const int k = 16 * (nt0 + q) + lq; u32x2 o; o.x = pk2(a[q][0], a[q][1]); o.y = pk2(a[q][2], a[q][3]); *(u32x2*)(ua + swz(k, p0)) = o; }
      ZACC(a); mm_tile(AhT, ST, A8, ST, 2, a, w, lq, g);
#pragma unroll
      for (int q = 0; q < 2; ++q) { const int tt = 16 * (nt0 + q) + lq; const u32x2 rr = *(const u32x2*)(A3 + tt * ST + 16 * mt + 4 * g);
          u32x2 o; o.x = pk2(a[q][0] + bflo(rr.x), a[q][1] + bfhi(rr.x)); o.y = pk2(a[q][2] + bflo(rr.y), a[q][3] + bfhi(rr.y)); *(u32x2*)(ua + 8192 + swz(tt, p0)) = o; }
      ZACC(a); mm_tile2<true, false>(A4, ST, W2T, ST, 2, a, w, lq, g); mm_tile2<true, true>(A5, ST, A6, ST, 2, a, w, lq, g);
#pragma unroll
      for (int q = 0; q < 2; ++q) { const int v = 16 * (nt0 + q) + lq, k0 = 16 * mt + 4 * g; u32x2 o; o.x = pk2(a[q][0], a[q][1]); o.y = pk2(a[q][2], a[q][3]); *(u32x2*)(ub + swz(v, k0)) = o; }
      ZACC(a); mm_tile(A8, ST, W2T, ST, 2, a, w, lq, g); mm_tile2<false, true>(A9, ST, A6, ST, 2, a, w, lq, g);
#pragma unroll
      for (int q = 0; q < 2; ++q) { const int v = 16 * (nt0 + q) + lq, t0 = 16 * mt + 4 * g; u32x2 o; o.x = pk2(a[q][0], a[q][1]); o.y = pk2(a[q][2], a[q][3]); *(u32x2*)(ub + 8192 + swz(v, t0)) = o; } }
    LDS_BARRIER();
}
__device__ __forceinline__ void phase_rwkv_prep(const Params& P, int l, const Ctx& c) {
    const RwkvBufs B = rwkv_bufs(P, c);
    float pw0[8], pa0[8], pkk[8], pka[8], prk[8]; int hprev = -1;
    for (int u = c.bid; u < NUNIT; u += c.G) {
        const int h = u & 7;
        if (h != hprev) { hprev = h; const int j0 = l * 512 + h * 64 + (c.tid & 7) * 8;
#pragma unroll
            for (int i = 0; i < 8; ++i) { pw0[i] = P.in[9][j0 + i]; pa0[i] = P.in[11][j0 + i]; pkk[i] = P.in[14][j0 + i]; pka[i] = P.in[15][j0 + i]; prk[i] = P.in[16][j0 + i]; } }
        rwkv_prep_unit(P, l, c, u, B, pw0, pa0, pkk, pka, prk);
    }
}

constexpr int SLOTB = 33280, YST = 68;
__device__ __forceinline__ void scan_chunked(const Params& P, const Ctx& c, int bh) {
    const RwkvBufs B = rwkv_bufs(P, c);
    const int b = bh >> 3, h = bh & 7, w = c.wave, lane = c.lane, lq = lane & 15, g = lane >> 4;
    const size_t rowb = (size_t)b * LP;
    const int ll = c.tid;
    unsigned char* L = c.lds;
    f32x4 st[4];
#pragma unroll
    for (int i = 0; i < 4; ++i) st[i] = (f32x4){0.f, 0.f, 0.f, 0.f};
    u32x4 r0[5], r1[5], r2[5], r3[5], r4[5];
#define SC_UNIT(cc) ((size_t)((b * NCHK + (cc)) * 8 + h))
#define SC_LOAD(R, cc) do { const unsigned char* pa_ = B.UA + SC_UNIT(cc) * UNIT_A; const unsigned char* pb_ = B.UB + SC_UNIT(cc) * UNIT_B; \
        _Pragma("unroll") for (int i_ = 0; i_ < 2; ++i_) { R[i_] = GLD(u32x4, pa_ + (ll + 512 * i_) * 16); R[2 + i_] = GLD(u32x4, pb_ + (ll + 512 * i_) * 16); } \
        if (ll < 16) R[4] = GLD(u32x4, pb_ + 16384 + ll * 16); } while (0)
#define SC_WRITE(R, slot) do { unsigned char* s_ = L + (slot) * SLOTB; \
        _Pragma("unroll") for (int i_ = 0; i_ < 2; ++i_) { *(u32x4*)(s_ + (ll + 512 * i_) * 16) = R[i_]; *(u32x4*)(s_ + 16384 + (ll + 512 * i_) * 16) = R[2 + i_]; } \
        if (ll < 16) *(u32x4*)(s_ + 32768 + ll * 16) = R[4]; } while (0)
#define SC_COMPUTE(ci) do { \
        const unsigned char* sl = L + ((ci) % 3) * SLOTB; \
        const int vcol = 16 * w + lq; \
        bf16x8 gaf[4][2]; f32x4 gcf[4]; u32x2 d0f[4]; \
        _Pragma("unroll") for (int mt = 0; mt < 4; ++mt) { \
            gcf[mt] = *(const f32x4*)(sl + 32768 + (16 * mt + 4 * g) * 4); \
            d0f[mt] = *(const u32x2*)(sl + 16384 + swz(vcol, 16 * mt + 4 * g)); \
            _Pragma("unroll") for (int ks = 0; ks < 2; ++ks) gaf[mt][ks] = *(const bf16x8*)(sl + swz(16 * mt + lq, 32 * ks + 8 * g)); } \
        __builtin_amdgcn_sched_barrier(0);        \
        bf16x8 sb[2]; \
        _Pragma("unroll") for (int ks = 0; ks < 2; ++ks) { u32x4 pw; pw.x = pk2(st[2 * ks][0], st[2 * ks][1]); pw.y = pk2(st[2 * ks][2], st[2 * ks][3]); pw.z = pk2(st[2 * ks + 1][0], st[2 * ks + 1][1]); pw.w = pk2(st[2 * ks + 1][2], st[2 * ks + 1][3]); \
            sb[ks] = __builtin_bit_cast(bf16x8, pw); } \
        _Pragma("unroll") for (int mt = 0; mt < 4; ++mt) { \
            f32x4 ns = (f32x4){bflo(d0f[mt].x), bfhi(d0f[mt].x), bflo(d0f[mt].y), bfhi(d0f[mt].y)} + gcf[mt] * st[mt]; \
            _Pragma("unroll") for (int ks = 0; ks < 2; ++ks) ns = __builtin_amdgcn_mfma_f32_16x16x32_bf16(gaf[mt][ks], sb[ks], ns, 0, 0, 0); \
            st[mt] = ns; } \
        _Pragma("unroll") for (int mt = 0; mt < 4; ++mt) { \
            const u32x2 y0 = *(const u32x2*)(sl + 24576 + swz(vcol, 16 * mt + 4 * g)); \
            f32x4 ya = (f32x4){bflo(y0.x), bfhi(y0.x), bflo(y0.y), bfhi(y0.y)}; \
            _Pragma("unroll") for (int ks = 0; ks < 2; ++ks) { const bf16x8 rh = *(const bf16x8*)(sl + 8192 + swz(16 * mt + lq, 32 * ks + 8 * g)); ya = __builtin_amdgcn_mfma_f32_16x16x32_bf16(rh, sb[ks], ya, 0, 0, 0); } \
            float* yl = (float*)(L + 3 * SLOTB) + ((ci) & 1) * (64 * YST) + (16 * mt + 4 * g) * YST + vcol; \
            _Pragma("unroll") for (int j = 0; j < 4; ++j) yl[j * YST] = ya[j]; } } while (0)
#define SC_YSTORE(ci) do { const float* ys_ = (const float*)(L + 3 * SLOTB) + ((ci) & 1) * (64 * YST) + (c.tid >> 3) * YST + (c.tid & 7) * 8; \
        float* yg_ = B.Y + (rowb + (ci) * 64 + (c.tid >> 3)) * 512 + h * 64 + (c.tid & 7) * 8; \
        GST(f32x4, yg_) = *(const f32x4*)ys_; GST(f32x4, yg_ + 4) = *(const f32x4*)(ys_ + 4); } while (0)
#define SC_ITER(ci, R) do { if ((ci) + 2 < NCHK) SC_WRITE(R, ((ci) + 2) % 3); if ((ci) + 7 < NCHK) SC_LOAD(R, (ci) + 7); if ((ci) > 0) SC_YSTORE((ci) - 1); if (w < 4) { SC_COMPUTE(ci); } LDS_BARRIER(); } while (0)
    { SC_LOAD(r0, 0); SC_LOAD(r1, 1); SC_WRITE(r0, 0); SC_WRITE(r1, 1); SC_LOAD(r2, 2); SC_LOAD(r3, 3); SC_LOAD(r4, 4); SC_LOAD(r0, 5); SC_LOAD(r1, 6); }
    __syncthreads();
#pragma unroll 1
    for (int cc = 0; cc < NCHK; cc += 5) { SC_ITER(cc, r2); SC_ITER(cc + 1, r3); SC_ITER(cc + 2, r4); SC_ITER(cc + 3, r0); SC_ITER(cc + 4, r1); }
    SC_YSTORE(NCHK - 1);
#undef SC_YSTORE
#undef SC_COMPUTE
#undef SC_ITER
#undef SC_UNIT
#undef SC_LOAD
#undef SC_WRITE
}

__device__ __forceinline__ void phase_gn(const Params& P, int l, const Ctx& c) {
    const RwkvBufs B = rwkv_bufs(P, c);
    const int gw = c.bid * NWAVES + c.wave, NGW = c.G * NWAVES;
    const int c0 = 8 * c.lane;
    float gnw[8], gnb[8];
#pragma unroll
    for (int i = 0; i < 8; ++i) { gnw[i] = P.in[17][l * 512 + c0 + i]; gnb[i] = P.in[18][l * 512 + c0 + i]; }
    for (int m = gw; m < M; m += NGW) {
        const size_t o = (size_t)m * 512 + c0;
        const f32x4 y0 = *(const f32x4*)(B.Y + o), y1 = *(const f32x4*)(B.Y + o + 4);
        float y[8] = {y0.x, y0.y, y0.z, y0.w, y1.x, y1.y, y1.z, y1.w};
        const u32x4 bw = *(const u32x4*)(B.BON + o), gw4 = *(const u32x4*)(B.G + o);
        const float bo[8] = {bflo(bw.x), bfhi(bw.x), bflo(bw.y), bfhi(bw.y), bflo(bw.z), bfhi(bw.z), bflo(bw.w), bfhi(bw.w)};
        const float gg[8] = {bflo(gw4.x), bfhi(gw4.x), bflo(gw4.y), bfhi(gw4.y), bflo(gw4.z), bfhi(gw4.z), bflo(gw4.w), bfhi(gw4.w)};
        float s = 0.f;
#pragma unroll
        for (int i = 0; i < 8; ++i) s += y[i];
        s += __shfl_xor(s, 1); s += __shfl_xor(s, 2); s += __shfl_xor(s, 4);
        const float mean = s * (1.f / 64.f);
        float q = 0.f;
#pragma unroll
        for (int i = 0; i < 8; ++i) { y[i] -= mean; q += y[i] * y[i]; }
        q += __shfl_xor(q, 1); q += __shfl_xor(q, 2); q += __shfl_xor(q, 4);
        const float rstd = 1.0f / sqrtf(q * (1.f / 64.f) + 64e-5f);
        float ov[8];
#pragma unroll
        for (int i = 0; i < 8; ++i) ov[i] = (y[i] * rstd * gnw[i] + gnb[i] + bo[i]) * gg[i];
        u32x4 ow; ow.x = pk2(ov[0], ov[1]); ow.y = pk2(ov[2], ov[3]); ow.z = pk2(ov[4], ov[5]); ow.w = pk2(ov[6], ov[7]);
        *(u32x4*)(B.ORW + o) = ow;
    }
}

__device__ __forceinline__ void attn_unit(const Ctx& c, int bh, int qb, const bf16* Q, const bf16* K, const bf16* V, bf16* O, const float* FC, float qkb2, const float* gq, const float* gk) {
    const int b = bh >> 3, h = bh & 7, lane = c.lane, w = c.wave, lq = lane & 15, g = lane >> 4;
    const int q0 = qb * 128;
    const size_t rowb = (size_t)b * LP;
    const int qrow = q0 + 16 * w + lq;
    bf16* Ks = (bf16*)c.lds; bf16* Vt = Ks + 64 * 72; float* fks = (float*)(Vt + 64 * 72);
    const bf16* qp = Q + (rowb + qrow) * 512 + h * 64 + 8 * g;
    bf16x8 qf0, qf1;
    { const u32x4 r0 = GLD(u32x4, qp), r1 = GLD(u32x4, qp + 32);
      float x[16] = {bflo(r0.x), bfhi(r0.x), bflo(r0.y), bfhi(r0.y), bflo(r0.z), bfhi(r0.z), bflo(r0.w), bfhi(r0.w), bflo(r1.x), bfhi(r1.x), bflo(r1.y), bfhi(r1.y), bflo(r1.z), bfhi(r1.z), bflo(r1.w), bfhi(r1.w)};
      float ss = 0.f;
#pragma unroll
      for (int i = 0; i < 16; ++i) ss += x[i] * x[i];
      ss += __shfl_xor(ss, 16); ss += __shfl_xor(ss, 32);
      const float rs = QSCALE / sqrtf(ss * (1.f / 64.f) + 1e-6f);
#pragma unroll
      for (int i = 0; i < 8; ++i) { x[i] *= rs * gq[8 * g + i]; x[8 + i] *= rs * gq[32 + 8 * g + i]; }
      u32x4 p0, p1; p0.x = pk2(x[0], x[1]); p0.y = pk2(x[2], x[3]); p0.z = pk2(x[4], x[5]); p0.w = pk2(x[6], x[7]); p1.x = pk2(x[8], x[9]); p1.y = pk2(x[10], x[11]); p1.z = pk2(x[12], x[13]); p1.w = pk2(x[14], x[15]);
      qf0 = __builtin_bit_cast(bf16x8, p0); qf1 = __builtin_bit_cast(bf16x8, p1); }
    const float* FCh = FC + (size_t)bh * LP;
    const float fq = GLD(float, FCh + qrow);
    float mrun = -1e30f, lsum = 0.f;
    f32x4 o[4];
#pragma unroll
    for (int i = 0; i < 4; ++i) o[i] = (f32x4){0.f, 0.f, 0.f, 0.f};
    const int kt_max = (q0 + 127) >> 6;
    const int lkey = c.tid >> 3, lch = c.tid & 7;
    float gkr[8];
#pragma unroll
    for (int i = 0; i < 8; ++i) gkr[i] = gk[lch * 8 + i];
    const size_t gbase = (rowb + lkey) * 512 + h * 64 + lch * 8;
    u32x4 kv = GLD(u32x4, K + gbase + (size_t)kt_max * 64 * 512), vv = GLD(u32x4, V + gbase + (size_t)kt_max * 64 * 512);
    float fkv = GLD(float, FCh + kt_max * 64 + (c.tid & 63));
    volatile unsigned* vote = (volatile unsigned*)(fks + 64);
    for (int kt = kt_max; kt >= 0; --kt) {
        const int k0 = kt * 64;
        LDS_BARRIER();
        { int can = 0; if (kt < kt_max) { const float fl = __shfl(fkv, 63); can = (qkb2 + fq - fl) < (mrun - THR2); }
          const int wall = __all(can); if (lane == 0) vote[w] = (unsigned)wall; }
        { { float x[8] = {bflo(kv.x), bfhi(kv.x), bflo(kv.y), bfhi(kv.y), bflo(kv.z), bfhi(kv.z), bflo(kv.w), bfhi(kv.w)}; float ss = 0.f;
#pragma unroll
              for (int i = 0; i < 8; ++i) ss += x[i] * x[i];
              ss += __shfl_xor(ss, 1); ss += __shfl_xor(ss, 2); ss += __shfl_xor(ss, 4);
              const float rs = 1.0f / sqrtf(ss * (1.f / 64.f) + 1e-6f);
              u32x4 kn; kn.x = pk2(x[0] * rs * gkr[0], x[1] * rs * gkr[1]); kn.y = pk2(x[2] * rs * gkr[2], x[3] * rs * gkr[3]); kn.z = pk2(x[4] * rs * gkr[4], x[5] * rs * gkr[5]); kn.w = pk2(x[6] * rs * gkr[6], x[7] * rs * gkr[7]);
              *(u32x4*)(Ks + lkey * 72 + lch * 8) = kn; }
            bf16* vd = Vt + (lch * 8) * 72 + lkey;
            vd[0] = (bf16)(vv.x & 0xffff); vd[72] = (bf16)(vv.x >> 16); vd[144] = (bf16)(vv.y & 0xffff); vd[216] = (bf16)(vv.y >> 16);
            vd[288] = (bf16)(vv.z & 0xffff); vd[360] = (bf16)(vv.z >> 16); vd[432] = (bf16)(vv.w & 0xffff); vd[504] = (bf16)(vv.w >> 16);
            if (c.tid < 64) fks[c.tid] = fkv;
            if (kt > 0) { kv = GLD(u32x4, K + gbase + (size_t)(k0 - 64) * 512); vv = GLD(u32x4, V + gbase + (size_t)(k0 - 64) * 512); fkv = GLD(float, FCh + k0 - 64 + (c.tid & 63)); } }
        LDS_BARRIER();
        { unsigned all = vote[0] & vote[1] & vote[2] & vote[3] & vote[4] & vote[5] & vote[6] & vote[7]; if (all) break; }
        if (k0 > q0 + 16 * w + 15) continue;
        f32x4 s[4];
#pragma unroll
        for (int nt = 0; nt < 4; ++nt) { const bf16* kp = Ks + (16 * nt + lq) * 72 + 8 * g; const bf16x8 a0 = *(const bf16x8*)kp, a1 = *(const bf16x8*)(kp + 32);
            s[nt] = __builtin_amdgcn_mfma_f32_16x16x32_bf16(a0, qf0, (f32x4){0.f, 0.f, 0.f, 0.f}, 0, 0, 0);
            s[nt] = __builtin_amdgcn_mfma_f32_16x16x32_bf16(a1, qf1, s[nt], 0, 0, 0); }
        float mx = -INFINITY;
#pragma unroll
        for (int nt = 0; nt < 4; ++nt) { const f32x4 fk = *(const f32x4*)(fks + 16 * nt + 4 * g);
#pragma unroll
            for (int j = 0; j < 4; ++j) { float x = s[nt][j] + fq - fk[j]; const int key = k0 + 16 * nt + 4 * g + j; if (key > qrow) x = -INFINITY; s[nt][j] = x; mx = fmaxf(mx, x); } }
        mx = fmaxf(mx, __shfl_xor(mx, 16)); mx = fmaxf(mx, __shfl_xor(mx, 32));
        const float mnew = fmaxf(mrun, mx), alpha = __builtin_amdgcn_exp2f(mrun - mnew); mrun = mnew;
        float psum = 0.f;
#pragma unroll
        for (int nt = 0; nt < 4; ++nt)
#pragma unroll
            for (int j = 0; j < 4; ++j) { const float p = __builtin_amdgcn_exp2f(s[nt][j] - mnew); s[nt][j] = p; psum += p; }
        lsum = lsum * alpha + psum;
#pragma unroll
        for (int dt = 0; dt < 4; ++dt) o[dt] = o[dt] * alpha;
        bf16x8 pb[2];
#pragma unroll
        for (int k2 = 0; k2 < 2; ++k2) { u32x4 pw; pw.x = pk2(s[2 * k2][0], s[2 * k2][1]); pw.y = pk2(s[2 * k2][2], s[2 * k2][3]); pw.z = pk2(s[2 * k2 + 1][0], s[2 * k2 + 1][1]); pw.w = pk2(s[2 * k2 + 1][2], s[2 * k2 + 1][3]);
            pb[k2] = __builtin_bit_cast(bf16x8, pw); }
#pragma unroll
        for (int dt = 0; dt < 4; ++dt)
#pragma unroll
            for (int k2 = 0; k2 < 2; ++k2) { const bf16* vp = Vt + (16 * dt + lq) * 72 + 32 * k2 + 4 * g;
                const u32x2 lo = *(const u32x2*)vp, hi = *(const u32x2*)(vp + 16);
                u32x4 aw; aw.x = lo.x; aw.y = lo.y; aw.z = hi.x; aw.w = hi.y;
                o[dt] = __builtin_amdgcn_mfma_f32_16x16x32_bf16(__builtin_bit_cast(bf16x8, aw), pb[k2], o[dt], 0, 0, 0); }
    }
    lsum += __shfl_xor(lsum, 16); lsum += __shfl_xor(lsum, 32);
    const float inv = 1.0f / lsum;
    bf16* op = O + (rowb + qrow) * 512 + h * 64 + 4 * g;
#pragma unroll
    for (int dt = 0; dt < 4; ++dt) { u32x2 ow; ow.x = pk2(o[dt][0] * inv, o[dt][1] * inv); ow.y = pk2(o[dt][2] * inv, o[dt][3] * inv); GST(u32x2, op + 16 * dt) = ow; }
    __syncthreads();
}
__device__ __forceinline__ void phase_attn(const Params& P, int l, const Ctx& c, int first_blk) {
    const bf16* Q = (const bf16*)(c.ws + OFF_Q); const bf16* K = (const bf16*)(c.ws + OFF_K); const bf16* V = (const bf16*)(c.ws + OFF_V);
    const float* FC = (const float*)(c.ws + OFF_MISC) + 16 * LP;
    float gqm = fabsf(P.in[5][l * 64 + c.lane]), gkm = fabsf(P.in[6][l * 64 + c.lane]);
#pragma unroll
    for (int o = 1; o < 64; o <<= 1) { gqm = fmaxf(gqm, __shfl_xor(gqm, o)); gkm = fmaxf(gkm, __shfl_xor(gkm, o)); }
    const float qkb2 = 8.0f * gqm * gkm * LOG2E * 1.03f;
    constexpr int NQB = LP / 128, NU = 16 * NQB;
    unsigned* ctr = (unsigned*)(c.ws + OFF_CTL) + 8192 + 64 * l;
    volatile unsigned* slot = (volatile unsigned*)(c.lds + MISC_OFF) + 4;
    for (;;) {
        __syncthreads();
        if (c.tid == 0) *slot = atomicAdd(ctr, 1u);
        __syncthreads();
        const int u = (int)*slot;
        if (u >= NU) break;
        const int bh = u & 15, qb = NQB - 1 - (u >> 4); attn_unit(c, bh, qb, Q, K, V, (bf16*)(c.ws + OFF_OF), FC, qkb2, P.in[5] + l * 64, P.in[6] + l * 64);
    }
}

__device__ __forceinline__ void phase_fixup(const Params& P, int l, const Ctx& c) {
    bf16* ACT = (bf16*)(c.ws + OFF_RW); const bf16* HALO = (const bf16*)(c.ws + OFF_Q);
    const float* cw = P.in[24] + (size_t)l * 3 * NUP;
    const int total = (M / 64) * 2 * DFF;
    for (int idx = c.bid * NTHR + c.tid; idx < total; idx += c.G * NTHR) {
        const int rr = idx / DFF, ch = idx - rr * DFF, q64 = rr >> 1, e = rr & 1, row = q64 * 64 + e;
        const int t = row % LP;
        int s0, s1, s2;
        if (e == 0) { s0 = q64 * 4 + 2; s1 = (q64 - 1) * 4 + 1; s2 = (q64 - 1) * 4 + 0; } else { s0 = q64 * 4 + 3; s1 = q64 * 4 + 2; s2 = (q64 - 1) * 4 + 1; }
        float uc[2];
#pragma unroll
        for (int bj = 0; bj < 2; ++bj) { const int col = bj * DFF + ch;
            const float u0 = bf2f(HALO[(size_t)s0 * NUP + col]);
            const float u1 = (t >= 1) ? bf2f(HALO[(size_t)s1 * NUP + col]) : 0.f;
            const float u2 = (t >= 2) ? bf2f(HALO[(size_t)s2 * NUP + col]) : 0.f;
            uc[bj] = cw[col] * u2 + cw[NUP + col] * u1 + cw[2 * NUP + col] * u0; }
        ACT[(size_t)row * DFF + ch] = (bf16)f2bf(uc[0] * sigmoidf_(uc[0]) * uc[1]);
    }
}

#define OPQ_S(x) asm volatile("" : "+s"(x))
#define OPQ_V(x) asm volatile("" : "+v"(x))
#define PHASE_BEGIN() do { int t_ = threadIdx.x; OPQ_V(t_); c.tid = t_; c.lane = t_ & 63; c.wave = __builtin_amdgcn_readfirstlane(t_ >> 6); int b_ = blockIdx.x; OPQ_S(b_); c.bid = b_; \
    size_t z_ = 0; OPQ_S(z_); unsigned char* w_ = P.ws + z_;   c.ws = w_; ws = w_; l = lc; OPQ_S(l); WT = (pg8::bf16_t*)(ws + OFF_WT); HN = (pg8::bf16_t*)(ws + OFF_HN); } while (0)
__global__ void __launch_bounds__(NTHR, 2) mega(Params P) {
    extern __shared__ __attribute__((aligned(16))) unsigned char lds[];
    Ctx c; c.G = gridDim.x; c.lds = lds;
    volatile LAS unsigned* MISC = (volatile LAS unsigned*)((LAS unsigned char*)lds + MISC_OFF);
    if (threadIdx.x < 16) MISC[threadIdx.x] = 0u;
    __syncthreads();
    (void)xcd_barrier_post((unsigned*)(P.ws + OFF_CTL) + 1024, MISC + 8);
#define SEAM() do { XcdBarrier xb_; xb_.bar = (unsigned*)(P.ws + OFF_CTL) + 1024; xb_.x = xb_xcc_id(); xb_.st = (volatile LAS unsigned*)((LAS unsigned char*)lds + MISC_OFF) + 8; xcd_barrier(xb_); } while (0)
    PG8_LAS unsigned char* ldsl = (PG8_LAS unsigned char*)lds;
    unsigned char* ws; pg8::bf16_t* WT; pg8::bf16_t* HN; int l;
#pragma unroll 1
    for (int lc = 0; lc < DEPTH; ++lc) {
        PHASE_BEGIN();
        convert_weights(P, l, c);
        phase_norm<true>(P, l, c);
        if (lc == 0) cg::this_grid().sync(); else SEAM();
        PHASE_BEGIN();
        phase_fcum(P, c);
        { pg8::Gemm g{HN, WT + WT_IN, M, N1, 1024, 1024}; pg8::StaticOrder S; S.init(M, N1, c.G, c.bid);
          pg8::EpiRoute E{ws};
          pg8::gemm_phase<pg8::EpiRoute, pg8::StaticOrder, true, true>(ldsl, g, S, E); }
        SEAM();
        PHASE_BEGIN();
        for (int rep_ = 0; rep_ < REP_PREP; ++rep_) phase_rwkv_prep(P, l, c);
        SEAM();
        PHASE_BEGIN();
        if (c.bid < 16) { scan_chunked(P, c, c.bid); __syncthreads(); PHASE_BEGIN(); }
        phase_attn(P, l, c, 16);
#if REP_P3 > 1
        __syncthreads(); PHASE_BEGIN();
        if (c.bid < 16) scan_chunked(P, c, c.bid); else phase_attn(P, l, c, 16);
#endif
        SEAM();
        PHASE_BEGIN();
        phase_gn(P, l, c);
        for (int rep_ = 0; rep_ < REP_SYNC; ++rep_) SEAM();
        SEAM();
        PHASE_BEGIN();
        { pg8::bf16_t* MG = (pg8::bf16_t*)(ws + OFF_K); const pg8::bf16_t* GT = (const pg8::bf16_t*)(ws + OFF_GT); const float* gb = P.in[21] + l * NGT;
          pg8::StaticOrder S; S.init(M, 1024, c.G, c.bid);
          { pg8::Gemm g{(const pg8::bf16_t*)(ws + OFF_OF), WT + WT_BF, M, 1024, 512, 512}; pg8::EpiGate<0> E{MG, GT, gb};
            pg8::gemm_phase<pg8::EpiGate<0>, pg8::StaticOrder, true, true>(ldsl, g, S, E); }
          __syncthreads();
          PHASE_BEGIN();
          MG = (pg8::bf16_t*)(ws + OFF_K); GT = (const pg8::bf16_t*)(ws + OFF_GT); gb = P.in[21] + l * NGT; S.init(M, 1024, c.G, c.bid);
          { pg8::Gemm g{(const pg8::bf16_t*)(ws + OFF_RW + (size_t)M * 512 * 4), WT + WT_BR, M, 1024, 512, 512}; pg8::EpiGate<1> E{MG, GT, gb};
            pg8::gemm_phase<pg8::EpiGate<1>, pg8::StaticOrder, true, true>(ldsl, g, S, E); } }
        SEAM();
        PHASE_BEGIN();
#pragma unroll 1
        for (int pass = 0; pass < 2; ++pass) {
            if (pass) { __syncthreads(); PHASE_BEGIN(); }
            const int sl = pass ? (c.bid >> 2) : 0;
            pg8::Gemm g{(const pg8::bf16_t*)(ws + OFF_K) + sl * 256, WT + WT_O + sl * 256, M, 1024, pass ? 256 : 1024, 1024};
            pg8::OneUnit S; S.so.init(MMAIN, 1024, c.G, c.bid); S.mode = pass; S.pm = MMAIN / 256; S.pn = c.bid & 3; S.active = sl < 4;
            pg8::EpiResid E{(float*)(ws + OFF_H), nullptr, pass};
            pg8::gemm_phase<pg8::EpiResid, pg8::OneUnit, true, true>(ldsl, g, S, E);
        }
        SEAM();
        PHASE_BEGIN();
        phase_norm<false>(P, l, c);
        SEAM();
        PHASE_BEGIN();
        { pg8::Gemm g{HN, WT + WT_UP, M, NUP, 1024, 1024}; pg8::StaticOrder S; S.init(M, NUP, c.G, c.bid);
          pg8::EpiUp E{(pg8::bf16_t*)(ws + OFF_RW), (pg8::bf16_t*)(ws + OFF_Q), P.in[24] + (size_t)l * 3 * NUP};
          pg8::gemm_phase<pg8::EpiUp, pg8::StaticOrder, true, true>(ldsl, g, S, E); }
        SEAM();
        PHASE_BEGIN();
        phase_fixup(P, l, c);
        SEAM();
        PHASE_BEGIN();
#pragma unroll 1
        for (int pass = 0; pass < 2; ++pass) {
            if (pass) { __syncthreads(); PHASE_BEGIN(); }
            const int sl = pass ? (c.bid >> 2) : 0;
            const int ko = (sl < 2) ? sl * 768 : 1536 + (sl - 2) * 640, kl = (sl < 2) ? 768 : 640;
            pg8::Gemm g{(const pg8::bf16_t*)(ws + OFF_RW) + (pass ? ko : 0), WT + WT_DN + (pass ? ko : 0), M, 1024, pass ? kl : DFF, DFF};
            pg8::OneUnit S; S.so.init(MMAIN, 1024, c.G, c.bid); S.mode = pass; S.pm = MMAIN / 256; S.pn = c.bid & 3; S.active = sl < 4;
            pg8::EpiResid E{(float*)(ws + OFF_H), (l == DEPTH - 1 && !pass) ? P.out : nullptr, pass};
            pg8::gemm_phase<pg8::EpiResid, pg8::OneUnit, true, true>(ldsl, g, S, E);
        }
        SEAM();
        if (l == DEPTH - 1) {
            PHASE_BEGIN();
            const float* H = (const float*)(ws + OFF_H);
            for (int idx = c.bid * NTHR + c.tid; idx < (NMETA + SEQ - (MMAIN - LP)) * (DM / 4); idx += c.G * NTHR) {
                const int r = idx / (DM / 4), q4 = idx - r * (DM / 4), t = (MMAIN - LP) + r;
                *(f32x4*)(P.out + ((size_t)SEQ + (t - NMETA)) * DM + 4 * q4) = *(const f32x4*)(H + (size_t)(LP + t) * DM + 4 * q4);
            }
        }
    }
}

extern "C" void kernel_launch(void* const* d_in, const int* in_sizes, int n_in, void* d_out, int out_size, void* d_ws, size_t ws_size, hipStream_t stream) {
    static int grid = 0;
    if (grid == 0) {
        if (n_in != 26 || out_size != NB * SEQ * DM || ws_size < WS_NEED) { fprintf(stderr, "kernel_launch: unexpected shapes (n_in %d out %d ws %zu need %zu)\n", n_in, out_size, ws_size, (size_t)WS_NEED); grid = -1; return; }
        int dev = 0, cus = 0, per_cu = 0;
        if (hipGetDevice(&dev) != hipSuccess || hipDeviceGetAttribute(&cus, hipDeviceAttributeMultiprocessorCount, dev) != hipSuccess) { grid = -1; return; }
        if (hipFuncSetAttribute((const void*)mega, hipFuncAttributeMaxDynamicSharedMemorySize, LDS_BYTES) != hipSuccess) { fprintf(stderr, "kernel_launch: hipFuncSetAttribute failed\n"); grid = -1; return; }
        if (hipOccupancyMaxActiveBlocksPerMultiprocessor(&per_cu, (const void*)mega, NTHR, LDS_BYTES) != hipSuccess || per_cu < 1) { fprintf(stderr, "kernel_launch: occupancy query says %d\n", per_cu); per_cu = 1; }
        (void)hipGetLastError();
        grid = cus;
    }
    if (grid < 0) return;
    if (hipMemsetAsync((char*)d_ws + OFF_CTL, 0, 65536, stream) != hipSuccess) { fprintf(stderr, "kernel_launch: memset failed\n"); return; }
    Params p{};
    for (int i = 0; i < 26; ++i) p.in[i] = (const float*)d_in[i];
    p.out = (float*)d_out; p.ws = (unsigned char*)d_ws;
    void* args[] = {&p};
    hipError_t e = hipLaunchCooperativeKernel((const void*)mega, dim3(grid), dim3(NTHR), args, LDS_BYTES, stream);
    if (e != hipSuccess) fprintf(stderr, "kernel_launch: cooperative launch failed: %s (grid %d)\n", hipGetErrorString(e), grid);
}
```

```cpp
#include <hip/hip_runtime.h>
#include <hip/hip_cooperative_groups.h>
#include <cstdio>
#include <cstdint>
#include <cmath>
namespace cg = cooperative_groups;
namespace pg8 {
#define PG8_LAS __attribute__((address_space(3)))
typedef unsigned short bf16_t;
typedef short bf16x8 __attribute__((ext_vector_type(8)));
typedef float f32x4 __attribute__((ext_vector_type(4)));
typedef unsigned u32x4 __attribute__((ext_vector_type(4)));
constexpr int BM = 256, BK = 64, HALF = 128, HTB = HALF * BK * 2  , STAGE_BYTES = 8 * HTB, NXCD = 8, WGM = 8;

__host__ __device__ __forceinline__ int lds_byte(int r, int c) { const int st = (r >> 4) * 2 + (c >> 5), rr = r & 15, cc = c & 31, ob = rr * 64 + cc * 2; return st * 1024 + (ob ^ (((ob >> 9) & 1) << 5)); }
__host__ __device__ __forceinline__ void stage_rc(int b, int& R, int& C) { const int st = b / 1024, sb = b % 1024, swz = sb ^ (((sb >> 9) & 1) << 5); R = (st >> 1) * 16 + swz / 64; C = (st & 1) * 32 + (swz % 64) / 2; }
__host__ __device__ __forceinline__ int perm32(int rho) { const int n = rho >> 4, i = rho & 15; return 8 * (i >> 2) + 4 * n + (i & 3); }

struct Unit { int pm, pn; };
struct Gemm { const bf16_t* A; const bf16_t* Bt; int M, N, K, ld; };

struct StaticOrder {
    int nM, nN, nwg, G, c;
    __host__ __device__ void init(int M, int N, int G_, int c_) { nM = M / BM; nN = N / BM; nwg = nM * nN; G = G_; c = c_; }
    __host__ __device__ bool next(int i, Unit& u) const {
        const long L = (long)i * G + c; if (L >= nwg) return false;
        int wgid = (int)L; { const int q = nwg / NXCD, r = nwg % NXCD, xcd = wgid % NXCD, off = wgid / NXCD; wgid = (xcd < r ? xcd * (q + 1) : r * (q + 1) + (xcd - r) * q) + off; }
        const int nig = WGM * nN, gid = wgid / nig, fm = gid * WGM, gsz = (nM - fm) < WGM ? (nM - fm) : WGM;
        u.pm = fm + ((wgid % nig) % gsz); u.pn = (wgid % nig) / gsz; return true;
    }
    __device__ __forceinline__ void a_ready(const Unit&) const {}
    __device__ __forceinline__ void done(const Unit&) const {}
};

__device__ __forceinline__ unsigned cvt_pk_bf16(float lo, float hi) { unsigned r; asm volatile("v_cvt_pk_bf16_f32 %0, %1, %2" : "=v"(r) : "v"(lo), "v"(hi)); return r; }
typedef float f32x2 __attribute__((ext_vector_type(2)));
template <class Epi, class Sched, bool ALIGN_EPI = false, bool SP2 = false>
__device__ __forceinline__ void gemm_phase(PG8_LAS unsigned char* lds, const Gemm g, const Sched& S, const Epi& E) {
    int tid_ = threadIdx.x; asm volatile("" : "+v"(tid_)); const int tid = tid_, wid = __builtin_amdgcn_readfirstlane(tid >> 6), lane = tid & 63, wr = wid >> 2, wc = wid & 3, fr = lane & 15, fq = lane >> 4;
    const int K = g.K, nt = K / BK, LD = g.ld;
    unsigned voffA[2], voffB[2];
#pragma unroll
    for (int i = 0; i < 2; ++i) { int R, C; stage_rc(tid * 16 + i * 8192, R, C); const int Rb = Epi::PERM ? ((R & ~31) + perm32(R & 31)) : R;
        voffA[i] = (unsigned)(R * LD + C) * 2u; voffB[i] = (unsigned)(Rb * LD + C) * 2u; }
    const size_t kstep = (size_t)(BK * 2);
    const size_t hstep = (size_t)HALF * LD * 2;
    const size_t tstep = 2 * hstep;
    const unsigned ldsw = (unsigned)wid * 1024u;
    const int aoff = lds_byte(wr * 64 + fr, fq * 8), boff = lds_byte(wc * 32 + fr, fq * 8);
#define PG8_SA(b, h) (((b) * 2 + (h)) * HTB)
#define PG8_SB(b, h) ((4 + (b) * 2 + (h)) * HTB)
#define PG8_STAGE(bufoff, gbase, voff) do { _Pragma("unroll") for (int _i = 0; _i < 2; ++_i) \
        __builtin_amdgcn_global_load_lds((const unsigned*)((const char*)(gbase) + (voff)[_i]), (PG8_LAS unsigned*)(lds + (bufoff) + ldsw + _i * 8192), 16, 0, 0); } while (0)
#define PG8_LDA(dst, b, h) do { _Pragma("unroll") for (int m = 0; m < 4; ++m) _Pragma("unroll") for (int k = 0; k < 2; ++k) dst[m][k] = *(const PG8_LAS bf16x8*)(lds + PG8_SA(b, h) + aoff + m * 2048 + k * 1024); } while (0)
#define PG8_LDB(dst, b, h) do { _Pragma("unroll") for (int n = 0; n < 2; ++n) _Pragma("unroll") for (int k = 0; k < 2; ++k) dst[n][k] = *(const PG8_LAS bf16x8*)(lds + PG8_SB(b, h) + boff + n * 2048 + k * 1024); } while (0)
#define PG8_MMA(ai, bj, At, Bt) do { __builtin_amdgcn_s_setprio(1); _Pragma("unroll") for (int m = 0; m < 4; ++m) _Pragma("unroll") for (int n = 0; n < 2; ++n) _Pragma("unroll") for (int k = 0; k < 2; ++k) \
        acc[ai][bj][m][n] = __builtin_amdgcn_mfma_f32_16x16x32_bf16(Bt[n][k], At[m][k], acc[ai][bj][m][n], 0, 0, 0); __builtin_amdgcn_s_setprio(0); } while (0)
#define PG8_WAIT_V(n) asm volatile("s_waitcnt vmcnt(" #n ")" ::: "memory")
#define PG8_WAIT_L(n) asm volatile("s_waitcnt lgkmcnt(" #n ")" ::: "memory")
#define PG8_BAR __builtin_amdgcn_s_barrier()
#define PG8_SCHED __builtin_amdgcn_sched_barrier(0)
    Unit cur, nxt; int ui = 0;
    if (!S.next(0, cur)) return;
    f32x4 acc[2][2][4][2];
#pragma unroll
    for (int a = 0; a < 2; ++a)
#pragma unroll
        for (int b = 0; b < 2; ++b)
#pragma unroll
            for (int m = 0; m < 4; ++m)
#pragma unroll
                for (int n = 0; n < 2; ++n) acc[a][b][m][n] = (f32x4){0.f, 0.f, 0.f, 0.f};
    bf16x8 At[4][2], B0[2][2], B1[2][2];
    const char* cA = (const char*)g.A + (size_t)cur.pm * tstep; const char* cB = (const char*)g.Bt + (size_t)cur.pn * tstep;
    S.a_ready(cur);
    if constexpr (SP2) {
        PG8_STAGE(PG8_SB(0, 0), cB, voffB); PG8_STAGE(PG8_SB(0, 1), cB + hstep, voffB); PG8_STAGE(PG8_SA(0, 0), cA, voffA); PG8_STAGE(PG8_SA(0, 1), cA + hstep, voffA);
        if (wr == 1) PG8_BAR;
        PG8_WAIT_V(2); PG8_BAR;
        PG8_STAGE(PG8_SB(1, 0), cB + kstep, voffB); PG8_STAGE(PG8_SA(1, 0), cA + kstep, voffA); PG8_STAGE(PG8_SB(1, 1), cB + hstep + kstep, voffB);
        PG8_WAIT_V(6); PG8_BAR;
    } else {
        PG8_STAGE(PG8_SB(0, 0), cB, voffB); PG8_STAGE(PG8_SA(0, 0), cA, voffA); PG8_STAGE(PG8_SB(0, 1), cB + hstep, voffB); PG8_STAGE(PG8_SA(0, 1), cA + hstep, voffA);
        if (wr == 1) PG8_BAR;
        PG8_WAIT_V(4); PG8_BAR;
        PG8_STAGE(PG8_SB(1, 0), cB + kstep, voffB); PG8_STAGE(PG8_SA(1, 0), cA + kstep, voffA); PG8_STAGE(PG8_SB(1, 1), cB + hstep + kstep, voffB);
        PG8_WAIT_V(6); PG8_BAR;
    }
    for (;;) {
        const bool has_next = S.next(ui + 1, nxt);
        const char* nA = has_next ? (const char*)g.A + (size_t)nxt.pm * tstep : cA; const char* nB = has_next ? (const char*)g.Bt + (size_t)nxt.pn * tstep : cB;
        for (int t = 0; t < nt; t += 2) {
            const bool last = (t == nt - 2);
            const char* a1 = cA + (size_t)(t + 1) * kstep;
            const char* a2 = last ? nA : cA + (size_t)(t + 2) * kstep; const char* b2 = last ? nB : cB + (size_t)(t + 2) * kstep;
            const char* a3 = a2 + kstep; const char* b3 = b2 + kstep;
            if (last && has_next) S.a_ready(nxt);
            if constexpr (SP2) {
            PG8_LDB(B0, 0, 0); PG8_LDB(B1, 0, 1); PG8_SCHED; PG8_LDA(At, 0, 0); PG8_STAGE(PG8_SA(1, 1), a1 + hstep, voffA);
            PG8_WAIT_V(8); PG8_WAIT_L(0); PG8_BAR; PG8_MMA(0, 0, At, B0); PG8_MMA(0, 1, At, B1); PG8_BAR; PG8_SCHED;
            PG8_LDA(At, 0, 1); PG8_STAGE(PG8_SB(0, 0), b2, voffB); PG8_STAGE(PG8_SB(0, 1), b2 + hstep, voffB); PG8_STAGE(PG8_SA(0, 0), a2, voffA);
            PG8_WAIT_V(8); PG8_WAIT_L(0); PG8_BAR; PG8_MMA(1, 0, At, B0); PG8_MMA(1, 1, At, B1); PG8_BAR; PG8_SCHED;
            PG8_LDB(B0, 1, 0); PG8_LDB(B1, 1, 1); PG8_SCHED; PG8_LDA(At, 1, 0); PG8_STAGE(PG8_SA(0, 1), a2 + hstep, voffA);
            PG8_WAIT_V(8); PG8_WAIT_L(0); PG8_BAR; PG8_MMA(0, 0, At, B0); PG8_MMA(0, 1, At, B1); PG8_BAR; PG8_SCHED;
            PG8_LDA(At, 1, 1); PG8_STAGE(PG8_SB(1, 0), b3, voffB); PG8_STAGE(PG8_SB(1, 1), b3 + hstep, voffB); PG8_STAGE(PG8_SA(1, 0), a3, voffA);
            PG8_WAIT_V(8); PG8_WAIT_L(0); PG8_BAR; PG8_MMA(1, 0, At, B0); PG8_MMA(1, 1, At, B1); PG8_BAR; PG8_SCHED;
            } else {
            PG8_LDB(B0, 0, 0); PG8_SCHED; PG8_LDA(At, 0, 0); PG8_STAGE(PG8_SA(1, 1), a1 + hstep, voffA);
            PG8_WAIT_L(8); PG8_BAR; PG8_WAIT_L(0); PG8_MMA(0, 0, At, B0); PG8_BAR; PG8_SCHED;
            PG8_LDB(B1, 0, 1); PG8_STAGE(PG8_SB(0, 0), b2, voffB);
            PG8_BAR; PG8_WAIT_L(0); PG8_MMA(0, 1, At, B1); PG8_BAR;
            PG8_LDA(At, 0, 1); PG8_STAGE(PG8_SA(0, 0), a2, voffA);
            PG8_BAR; PG8_WAIT_L(0); PG8_MMA(1, 0, At, B0); PG8_BAR; PG8_SCHED;
            PG8_STAGE(PG8_SB(0, 1), b2 + hstep, voffB);
            PG8_WAIT_V(6); PG8_BAR; PG8_MMA(1, 1, At, B1); PG8_BAR;
            PG8_LDB(B0, 1, 0); PG8_SCHED; PG8_LDA(At, 1, 0); PG8_STAGE(PG8_SA(0, 1), a2 + hstep, voffA);
            PG8_WAIT_L(8); PG8_BAR; PG8_WAIT_L(0); PG8_MMA(0, 0, At, B0); PG8_BAR; PG8_SCHED;
            PG8_LDB(B1, 1, 1); PG8_STAGE(PG8_SB(1, 0), b3, voffB);
            PG8_BAR; PG8_WAIT_L(0); PG8_MMA(0, 1, At, B1); PG8_BAR;
            PG8_LDA(At, 1, 1); PG8_STAGE(PG8_SA(1, 0), a3, voffA);
            PG8_BAR; PG8_WAIT_L(0); PG8_MMA(1, 0, At, B0); PG8_BAR; PG8_SCHED;
            PG8_STAGE(PG8_SB(1, 1), b3 + hstep, voffB);
            PG8_WAIT_V(6); PG8_BAR; PG8_MMA(1, 1, At, B1); PG8_BAR;
            }
        }
        if constexpr (ALIGN_EPI) { if (wr == 0) PG8_BAR; }
        if constexpr (!Epi::AFTER_DRAIN) { E(acc, cur, wr, wc, fr, fq); S.done(cur); }
        if (!has_next) break;
#pragma unroll
        for (int a = 0; a < 2; ++a)
#pragma unroll
            for (int b = 0; b < 2; ++b)
#pragma unroll
                for (int m = 0; m < 4; ++m)
#pragma unroll
                    for (int n = 0; n < 2; ++n) acc[a][b][m][n] = (f32x4){0.f, 0.f, 0.f, 0.f};
        cur = nxt; cA = nA; cB = nB; ++ui;
        if constexpr (ALIGN_EPI) { if (wr == 1) PG8_BAR; }
    }
    PG8_WAIT_V(0);
    if constexpr (!ALIGN_EPI) { if (wr == 0) PG8_BAR; }
    PG8_BAR;
    if constexpr (Epi::AFTER_DRAIN) { E.fused(acc, cur, wr, wc, fr, fq, lds, wid, lane); S.done(cur); }
#undef PG8_SA
#undef PG8_SB
#undef PG8_STAGE
#undef PG8_LDA
#undef PG8_LDB
#undef PG8_MMA
#undef PG8_WAIT_V
#undef PG8_WAIT_L
#undef PG8_BAR
#undef PG8_SCHED
}
}
#define GAS __attribute__((address_space(1)))
#define LAS __attribute__((address_space(3)))
typedef GAS unsigned gu32;
typedef GAS unsigned long long gu64;
#define RLX_AGENT __ATOMIC_RELAXED, __HIP_MEMORY_SCOPE_AGENT
#define LDS_WAIT() asm volatile("s_waitcnt lgkmcnt(0)" ::: "memory")
#define VM_WAIT() asm volatile("s_waitcnt vmcnt(0)" ::: "memory")
__device__ __forceinline__ unsigned long long rt() { return __builtin_amdgcn_s_memrealtime(); }
#define XB_TMO      128
#define XB_XCNT(j)  (256  + 64 * (j))
#define XB_XSUB(j)  (1280 + 64 * (j))
#define XB_XGEN(j)  (2304 + 64 * (j))
#define XB_TOP      3328
#define XB_TOPGEN   3392
#define XCD_BAR_WORDS 3456
#define XB_SPIN_CAP (1u << 18)

__device__ __forceinline__ unsigned xb_ld(unsigned* p)              { return __hip_atomic_load(p, __ATOMIC_RELAXED, __HIP_MEMORY_SCOPE_AGENT); }
__device__ __forceinline__ unsigned xb_add(unsigned* p, unsigned v) { return __hip_atomic_fetch_add(p, v, __ATOMIC_RELAXED, __HIP_MEMORY_SCOPE_AGENT); }
__device__ __forceinline__ unsigned xb_xcc_id() { return (unsigned)__builtin_amdgcn_s_getreg((3 << 11) | 20) & 0xFu; }
#define XB_SPIN(cond, bar) do { unsigned _sp = 0; while (cond) { __builtin_amdgcn_s_sleep(1); \
    if ((++_sp & 255u) == 0u) { if (xb_ld(&(bar)[XB_TMO])) break; if (_sp > XB_SPIN_CAP) { atomicAdd(&(bar)[XB_TMO], 1u); break; } } } } while (0)

struct XcdBarrier {
    unsigned* bar; unsigned x;
    volatile LAS unsigned* st;
};

__device__ __forceinline__ XcdBarrier xcd_barrier_post(unsigned* bar, volatile LAS unsigned* st) {
    XcdBarrier b; b.bar = bar; b.x = xb_xcc_id(); b.st = st;
    if (threadIdx.x == 0) (void)xb_add(&bar[XB_XCNT(b.x)], 1u);
    return b;
}
__device__ __forceinline__ void xcd_barrier_complete(unsigned* bar, unsigned x, unsigned& nloc, unsigned& nx) {
    const unsigned G = gridDim.x * gridDim.y * gridDim.z;
    unsigned sum, cnt, mine, sp = 0u;
    for (;;) {
        sum = 0u; cnt = 0u; mine = 0u;
#pragma unroll
        for (unsigned j = 0; j < 16; ++j) { const unsigned c = xb_ld(&bar[XB_XCNT(j)]); sum += c; cnt += (c > 0u) ? 1u : 0u; mine = (j == x) ? c : mine; }
        if (sum == G) break;
        __builtin_amdgcn_s_sleep(1);
        if ((++sp & 255u) == 0u) { if (xb_ld(&bar[XB_TMO])) break; if (sp > XB_SPIN_CAP) { atomicAdd(&bar[XB_TMO], 1u); break; } }
    }
    nloc = mine > 0u ? mine : 1u; nx = cnt > 0u ? cnt : 1u;
}

__device__ __forceinline__ void xcd_barrier(const XcdBarrier& b) {
    asm volatile("s_waitcnt vmcnt(0)" ::: "memory");
    __syncthreads();
    if (threadIdx.x == 0) {
        unsigned* bar = b.bar;
        __builtin_amdgcn_s_waitcnt(0);
        unsigned nloc = b.st[0], nx = b.st[1];
        if (nloc == 0u) { xcd_barrier_complete(bar, b.x, nloc, nx); b.st[0] = nloc; b.st[1] = nx; }
        const unsigned old = xb_add(&bar[XB_XSUB(b.x)], 1u);
        const unsigned gen = old / nloc;
        if (old + 1u == (gen + 1u) * nloc) {
            __builtin_amdgcn_fence(__ATOMIC_RELEASE, "agent");
            asm volatile("s_waitcnt vmcnt(0)" ::: "memory");
            const unsigned og = xb_add(&bar[XB_TOP], 1u);
            const unsigned tg = og / nx;
            if (og + 1u == (tg + 1u) * nx) xb_add(&bar[XB_TOPGEN], 1u);
            else XB_SPIN(xb_ld(&bar[XB_TOPGEN]) == tg, bar);
            __builtin_amdgcn_fence(__ATOMIC_ACQUIRE, "agent");
            xb_add(&bar[XB_XGEN(b.x)], 1u);
            asm volatile("s_waitcnt vmcnt(0)" ::: "memory");
        } else {
            XB_SPIN(xb_ld(&bar[XB_XGEN(b.x)]) == gen, bar);
            __builtin_amdgcn_fence(__ATOMIC_ACQUIRE, "agent");
            asm volatile("s_waitcnt vmcnt(0)" ::: "memory");
        }
    }
    __syncthreads();
}


constexpr int NB = 2, SEQ = 8192, DM = 1024, DEPTH = 4, NMETA = 16, LP = 8320, M = NB * LP;
constexpr int N_IN = 5384, N1 = 5376, NRW = 1792, NGT = 2048, DFF = 2816, NUP = 5632;
constexpr float LOG2E = 1.4426950408889634f;
constexpr float QSCALE = 0.125f * LOG2E;
constexpr float THR2 = 30.0f * LOG2E;
constexpr int NWAVES = 8, NTHR = 512, MMAIN = 16384;
constexpr int LDS_BYTES = 147456, MISC_OFF = 147456 - 128;

typedef unsigned short bf16;
typedef float f32x4 __attribute__((ext_vector_type(4)));
typedef unsigned u32x4 __attribute__((ext_vector_type(4)));
typedef unsigned u32x2 __attribute__((ext_vector_type(2)));
typedef short bf16x8 __attribute__((ext_vector_type(8)));

constexpr size_t SZ_H = (size_t)M * DM * 4, SZ_X512 = (size_t)M * 512 * 2;
constexpr size_t OFF_CTL = 0, OFF_H = 1u << 20, OFF_WT = OFF_H + SZ_H;
constexpr size_t WT_IN = 0, WT_BF = WT_IN + (size_t)N1 * 1024, WT_BR = WT_BF + 1024 * 512, WT_O = WT_BR + 1024 * 512,
                 WT_UP = WT_O + 1024 * 1024, WT_DN = WT_UP + (size_t)NUP * 1024, WT_LW = WT_DN + (size_t)1024 * DFF, WT_LA = WT_LW + 512 * 64, WT_LG = WT_LA + 512 * 64, WT_END = WT_LG + 512 * 128;
constexpr size_t OFF_HN = OFF_WT + WT_END * 2;
constexpr size_t OFF_Q = OFF_HN + 2 * SZ_X512, OFF_K = OFF_Q + SZ_X512, OFF_V = OFF_K + SZ_X512;
constexpr size_t OFF_RW = OFF_V + SZ_X512, OFF_GT = OFF_RW + (size_t)M * NRW * 2, OFF_MISC = OFF_GT + (size_t)M * NGT * 2;
constexpr size_t OFF_T0 = OFF_MISC + 2 * 16 * LP * 4, OFF_OF = OFF_T0 + 2 * SZ_X512, WS_NEED = OFF_OF + SZ_X512;
static_assert(OFF_HN % 256 == 0 && OFF_RW % 256 == 0 && OFF_T0 % 256 == 0, "alignment");

struct Params { const float* in[26]; float* out; unsigned char* ws; };
struct Ctx { int tid, lane, wave, bid, G; unsigned char* lds; unsigned char* ws; };

__device__ __forceinline__ float bf2f(unsigned b) { return __uint_as_float(b << 16); }
__device__ __forceinline__ float bflo(unsigned w) { return __uint_as_float(w << 16); }
__device__ __forceinline__ float bfhi(unsigned w) { return __uint_as_float(w & 0xffff0000u); }
typedef float f32x2_t_ __attribute__((ext_vector_type(2))); typedef __bf16 bf16x2_t_ __attribute__((ext_vector_type(2)));
__device__ __forceinline__ unsigned pk2(float lo, float hi) { const f32x2_t_ v = {lo, hi}; const bf16x2_t_ r = __builtin_convertvector(v, bf16x2_t_); return __builtin_bit_cast(unsigned, r); }
__device__ __forceinline__ unsigned f2bf(float f) { return pk2(f, 0.f) & 0xffffu; }
__device__ __forceinline__ float wave_sum(float v) {
#pragma unroll
    for (int o = 1; o < 64; o <<= 1) v += __shfl_xor(v, o);
    return v;
}
__device__ __forceinline__ float sigmoidf_(float x) { return __builtin_amdgcn_rcpf(1.f + __expf(-x)); }
template <int CTRL> __device__ __forceinline__ float dppf(float old, float x) {
    return __int_as_float(__builtin_amdgcn_update_dpp(__float_as_int(old), __float_as_int(x), CTRL, 0xf, 0xf, false));
}
__device__ __forceinline__ float allreduce16(float x) {
    x += dppf<0x121>(0.f, x); x += dppf<0x122>(0.f, x); x += dppf<0x124>(0.f, x); x += dppf<0x128>(0.f, x); return x;
}

namespace pg8 {
struct EpiRoute {
    static constexpr bool PERM = true, AFTER_DRAIN = false;
    unsigned char* ws;
    __device__ __forceinline__ void operator()(const f32x4 (&acc)[2][2][4][2], const Unit& u, int wr, int wc, int fr, int fq) const {
        const int pn = u.pn; size_t off; int ldc, colt;
        if (pn < 6) { off = OFF_Q + (size_t)(pn >> 1) * SZ_X512; ldc = 512; colt = (pn & 1) * 256; }
        else if (pn < 13) { off = OFF_RW; ldc = NRW; colt = (pn - 6) * 256; }
        else { off = OFF_GT; ldc = NGT; colt = (pn - 13) * 256; }
        bf16_t* base = (bf16_t*)(ws + off);
        const int row0 = u.pm * BM + wr * 64 + fr, col0 = colt + wc * 32 + 8 * fq;
#pragma unroll
        for (int ai = 0; ai < 2; ++ai)
#pragma unroll
            for (int m = 0; m < 4; ++m) { bf16_t* rowp = base + (size_t)(row0 + ai * HALF + m * 16) * ldc + col0;
#pragma unroll
                for (int bj = 0; bj < 2; ++bj) { const f32x4 v0 = acc[ai][bj][m][0], v1 = acc[ai][bj][m][1];
                    u32x4 w; w.x = cvt_pk_bf16(v0[0], v0[1]); w.y = cvt_pk_bf16(v0[2], v0[3]); w.z = cvt_pk_bf16(v1[0], v1[1]); w.w = cvt_pk_bf16(v1[2], v1[3]);
                    *(u32x4*)(rowp + bj * HALF) = w; } }
    }
};
template <int MODE> struct EpiGate {
    static constexpr bool PERM = true, AFTER_DRAIN = false;
    bf16_t* O; const bf16_t* GT; const float* gb;
    __device__ __forceinline__ void operator()(const f32x4 (&acc)[2][2][4][2], const Unit& u, int wr, int wc, int fr, int fq) const {
        const int row0 = u.pm * BM + wr * 64 + fr, col0 = u.pn * BM + wc * 32 + 8 * fq;
#pragma unroll
        for (int bj = 0; bj < 2; ++bj) {
            const int c = col0 + bj * HALF;
            const f32x4 b0 = *(const f32x4*)(gb + MODE * 1024 + c), b1 = *(const f32x4*)(gb + MODE * 1024 + c + 4);
#pragma unroll
            for (int ai = 0; ai < 2; ++ai)
#pragma unroll
                for (int m = 0; m < 4; ++m) {
                    const size_t row = (size_t)(row0 + ai * HALF + m * 16);
                    const u32x4 gw = *(const u32x4*)(GT + row * NGT + MODE * 1024 + c);
                    const f32x4 v0 = acc[ai][bj][m][0], v1 = acc[ai][bj][m][1];
                    float r[8];
                    r[0] = sigmoidf_(bflo(gw.x) + b0[0]) * v0[0]; r[1] = sigmoidf_(bfhi(gw.x) + b0[1]) * v0[1];
                    r[2] = sigmoidf_(bflo(gw.y) + b0[2]) * v0[2]; r[3] = sigmoidf_(bfhi(gw.y) + b0[3]) * v0[3];
                    r[4] = sigmoidf_(bflo(gw.z) + b1[0]) * v1[0]; r[5] = sigmoidf_(bfhi(gw.z) + b1[1]) * v1[1];
                    r[6] = sigmoidf_(bflo(gw.w) + b1[2]) * v1[2]; r[7] = sigmoidf_(bfhi(gw.w) + b1[3]) * v1[3];
                    bf16_t* op = O + row * 1024 + c;
                    if (MODE == 1) { const u32x4 ow = *(const u32x4*)op;
                        r[0] += bflo(ow.x); r[1] += bfhi(ow.x); r[2] += bflo(ow.y); r[3] += bfhi(ow.y); r[4] += bflo(ow.z); r[5] += bfhi(ow.z); r[6] += bflo(ow.w); r[7] += bfhi(ow.w); }
                    u32x4 w; w.x = cvt_pk_bf16(r[0], r[1]); w.y = cvt_pk_bf16(r[2], r[3]); w.z = cvt_pk_bf16(r[4], r[5]); w.w = cvt_pk_bf16(r[6], r[7]);
                    *(u32x4*)op = w;
                }
        }
    }
};
struct EpiResid {
    static constexpr bool PERM = false, AFTER_DRAIN = false;
    float* H; float* OUT; int atomic;
    __device__ __forceinline__ void operator()(const f32x4 (&acc)[2][2][4][2], const Unit& u, int wr, int wc, int fr, int fq) const {
        const int row0 = u.pm * BM + wr * 64 + fr, col0 = u.pn * BM + wc * 32 + 4 * fq;
#pragma unroll
        for (int ai = 0; ai < 2; ++ai)
#pragma unroll
            for (int m = 0; m < 4; ++m) {
                const int row = row0 + ai * HALF + m * 16;
                float* hp = H + (size_t)row * DM + col0;
                const int b = row >= LP ? 1 : 0, t = row - b * LP;
                float* op = (OUT && t >= NMETA && t < NMETA + SEQ) ? OUT + ((size_t)b * SEQ + (t - NMETA)) * DM + col0 : nullptr;
#pragma unroll
                for (int bj = 0; bj < 2; ++bj)
#pragma unroll
                    for (int n = 0; n < 2; ++n) { const int co = bj * HALF + n * 16;
                        if (atomic) {
#pragma unroll
                            for (int e = 0; e < 4; ++e) unsafeAtomicAdd(hp + co + e, acc[ai][bj][m][n][e]);
                        } else {
                            const f32x4 v = *(const f32x4*)(hp + co) + acc[ai][bj][m][n];
                            if (OUT) { if (op) *(f32x4*)(op + co) = v; } else *(f32x4*)(hp + co) = v; } }
            }
    }
};
struct EpiResidAtomic {
    static constexpr bool PERM = false, AFTER_DRAIN = false;
    float* H;
    __device__ __forceinline__ void operator()(const f32x4 (&acc)[2][2][4][2], const Unit& u, int wr, int wc, int fr, int fq) const {
        const int row0 = u.pm * BM + wr * 64 + fr, col0 = u.pn * BM + wc * 32 + 4 * fq;
#pragma unroll
        for (int ai = 0; ai < 2; ++ai)
#pragma unroll
            for (int m = 0; m < 4; ++m) { float* hp = H + (size_t)(row0 + ai * HALF + m * 16) * DM + col0;
#pragma unroll
                for (int bj = 0; bj < 2; ++bj)
#pragma unroll
                    for (int n = 0; n < 2; ++n)
#pragma unroll
                        for (int e = 0; e < 4; ++e) unsafeAtomicAdd(hp + bj * HALF + n * 16 + e, acc[ai][bj][m][n][e]); }
    }
};
struct OneUnit {
    StaticOrder so; int mode, pm, pn; bool active;
    __device__ bool next(int i, Unit& u) const { if (mode == 0) return so.next(i, u); if (i != 0 || !active) return false; u.pm = pm; u.pn = pn; return true; }
    __device__ __forceinline__ void a_ready(const Unit&) const {}
    __device__ __forceinline__ void done(const Unit&) const {}
};
struct EpiUp {
    static constexpr bool PERM = true, AFTER_DRAIN = false;
    bf16_t* ACT; bf16_t* HALO; const float* cw;
    __device__ __forceinline__ void operator()(const f32x4 (&acc)[2][2][4][2], const Unit& u, int wr, int wc, int fr, int fq) const {
        const int chan0 = u.pn * 128 + wc * 32 + 8 * fq;
#pragma unroll
        for (int n = 0; n < 2; ++n) {
            const int ch = chan0 + 4 * n;
            f32x4 w[3][2];
#pragma unroll
            for (int j = 0; j < 3; ++j) { w[j][0] = *(const f32x4*)(cw + j * NUP + ch); w[j][1] = *(const f32x4*)(cw + j * NUP + DFF + ch); }
#pragma unroll
            for (int ai = 0; ai < 2; ++ai) {
                const int rowg = u.pm * BM + ai * HALF + wr * 64;
#pragma unroll
                for (int m = 0; m < 4; ++m) {
                    f32x4 uc[2];
#pragma unroll
                    for (int bj = 0; bj < 2; ++bj) {
                        const f32x4 cur = acc[ai][bj][m][n];
                        f32x4 prv; if (m > 0) prv = acc[ai][bj][m - 1][n]; else prv = (f32x4){0.f, 0.f, 0.f, 0.f};
                        f32x4 p1, p2;
#pragma unroll
                        for (int i = 0; i < 4; ++i) {
                            const float r1 = dppf<0x121>(0.f, prv[i]), r2 = dppf<0x122>(0.f, prv[i]);
                            p1[i] = dppf<0x111>(r1, cur[i]); p2[i] = dppf<0x112>(r2, cur[i]);
                        }
                        uc[bj] = w[0][bj] * p2 + w[1][bj] * p1 + w[2][bj] * cur;
                    }
                    float a[4];
#pragma unroll
                    for (int i = 0; i < 4; ++i) a[i] = uc[0][i] * sigmoidf_(uc[0][i]) * uc[1][i];
                    u32x2 o; o.x = cvt_pk_bf16(a[0], a[1]); o.y = cvt_pk_bf16(a[2], a[3]);
                    *(u32x2*)(ACT + (size_t)(rowg + m * 16 + fr) * DFF + ch) = o;
                    if ((m == 3 && fr >= 14) || (m == 0 && fr < 2)) {
                        const int slot = (rowg >> 6) * 4 + (m == 3 ? fr - 14 : 2 + fr);
#pragma unroll
                        for (int bj = 0; bj < 2; ++bj) { const f32x4 cur = acc[ai][bj][m][n]; u32x2 hw; hw.x = cvt_pk_bf16(cur[0], cur[1]); hw.y = cvt_pk_bf16(cur[2], cur[3]);
                            *(u32x2*)(HALO + (size_t)slot * NUP + bj * DFF + ch) = hw; }
                    }
                }
            }
        }
    }
};
}

#ifndef REP_PREP
#define REP_PREP 1
#endif
#ifndef REP_P3
#define REP_P3 1
#endif
#ifndef REP_SYNC
#define REP_SYNC 0
#endif
#define GLD(T, p) (*(const __attribute__((address_space(1))) T*)(p))
#define GST(T, p) (*(__attribute__((address_space(1))) T*)(p))
#define LDS_BARRIER() do { asm volatile("s_waitcnt lgkmcnt(0)" ::: "memory"); __builtin_amdgcn_s_barrier(); asm volatile("" ::: "memory"); } while (0)
__device__ __forceinline__ void transpose_item(const float* W, int Nsrc, int K, bf16* WT, int dst_row0, int src_col0, int k0, float* scr, int lane) {
#pragma unroll 8
    for (int i = 0; i < 32; ++i) { const int kk = 2 * i + (lane >> 5); scr[kk * 33 + (lane & 31)] = W[(size_t)(k0 + kk) * Nsrc + src_col0 + (lane & 31)]; }
    asm volatile("s_waitcnt lgkmcnt(0)" ::: "memory");
    const int c = lane & 7;
#pragma unroll
    for (int j = 0; j < 4; ++j) { const int n = (lane >> 3) + 8 * j; const float* s = scr + (8 * c) * 33 + n;
        u32x4 o; o.x = pk2(s[0 * 33], s[1 * 33]); o.y = pk2(s[2 * 33], s[3 * 33]); o.z = pk2(s[4 * 33], s[5 * 33]); o.w = pk2(s[6 * 33], s[7 * 33]);
        *(u32x4*)(WT + (size_t)(dst_row0 + n) * K + k0 + 8 * c) = o; }
    asm volatile("s_waitcnt lgkmcnt(0)" ::: "memory");
}
__device__ __forceinline__ void convert_weights(const Params& P, int l, const Ctx& c) {
    bf16* WT = (bf16*)(c.ws + OFF_WT);
    float* scr = (float*)(c.lds + c.wave * 16384);
    const int gw = c.bid * NWAVES + c.wave, NGW = c.G * NWAVES;
    constexpr int I_IN = 16 * 168, I_BF = 8 * 32, I_O = 16 * 32, I_UP = 16 * 176, I_DN = 44 * 32, I_LR = 16, I_LG = 32, I_ALL = I_IN + 2 * I_BF + I_O + I_UP + I_DN + 2 * I_LR + I_LG;
    for (int it = gw; it < I_ALL; it += NGW) {
        int r = it;
        if (r < I_IN) { const int kb = r / 168, n0 = 32 * (r % 168); transpose_item(P.in[4] + (size_t)l * 1024 * N_IN, N_IN, 1024, WT + WT_IN, n0, n0 + (n0 >= 1536 ? 8 : 0), 64 * kb, scr, c.lane); continue; } r -= I_IN;
        if (r < I_BF) { const int kb = r / 32, n0 = 32 * (r % 32); transpose_item(P.in[19] + (size_t)l * 512 * 1024, 1024, 512, WT + WT_BF, n0, n0, 64 * kb, scr, c.lane); continue; } r -= I_BF;
        if (r < I_BF) { const int kb = r / 32, n0 = 32 * (r % 32); transpose_item(P.in[20] + (size_t)l * 512 * 1024, 1024, 512, WT + WT_BR, n0, n0, 64 * kb, scr, c.lane); continue; } r -= I_BF;
        if (r < I_O) { const int kb = r / 32, n0 = 32 * (r % 32); transpose_item(P.in[22] + (size_t)l * 1024 * 1024, 1024, 1024, WT + WT_O, n0, n0, 64 * kb, scr, c.lane); continue; } r -= I_O;
        if (r < I_UP) { const int kb = r / 176, n0 = 32 * (r % 176); const int pn = n0 >> 8, bj = (n0 >> 7) & 1, x = n0 & 127;
            transpose_item(P.in[23] + (size_t)l * 1024 * NUP, NUP, 1024, WT + WT_UP, n0, bj * DFF + 128 * pn + x, 64 * kb, scr, c.lane); continue; } r -= I_UP;
        if (r < I_DN) { const int kb = r / 32, n0 = 32 * (r % 32); transpose_item(P.in[25] + (size_t)l * DFF * 1024, 1024, DFF, WT + WT_DN, n0, n0, 64 * kb, scr, c.lane); continue; } r -= I_DN;
        if (r < I_LR) { transpose_item(P.in[10] + (size_t)l * 64 * 512, 512, 64, WT + WT_LW, 32 * r, 32 * r, 0, scr, c.lane); continue; } r -= I_LR;
        if (r < I_LR) { transpose_item(P.in[12] + (size_t)l * 64 * 512, 512, 64, WT + WT_LA, 32 * r, 32 * r, 0, scr, c.lane); continue; } r -= I_LR;
        { const int kb = r / 16, n0 = 32 * (r % 16); transpose_item(P.in[13] + (size_t)l * 128 * 512, 512, 128, WT + WT_LG, n0, n0, 64 * kb, scr, c.lane); }
    }
}

template <bool FG> __device__ __forceinline__ void phase_norm(const Params& P, int l, const Ctx& c) {
    float* H = (float*)(c.ws + OFF_H); bf16* HN = (bf16*)(c.ws + OFF_HN);
    float* LOGF = (float*)(c.ws + OFF_MISC);
    const float* gain = (FG ? P.in[2] : P.in[3]) + l * DM;
    float* wfs = (float*)c.lds;
    if (FG) {
        __syncthreads();
        const float* win = P.in[4] + (size_t)l * 1024 * N_IN + 1536;
        for (int i = c.tid; i < 8192; i += NTHR) wfs[i] = win[(size_t)(i >> 3) * N_IN + (i & 7)];
        __syncthreads();
    }
    const int gw = c.bid * NWAVES + c.wave, NGW = c.G * NWAVES;
    for (int m = gw; m < M; m += NGW) {
        const int b = m >= LP ? 1 : 0, t = m - b * LP;
        f32x4 v[4];
        if (FG && l == 0) {
            const float* src = (t < NMETA) ? P.in[1] + (size_t)t * DM : P.in[0] + ((size_t)b * SEQ + (t - NMETA)) * DM;
            const bool real = t < NMETA + SEQ;
#pragma unroll
            for (int j = 0; j < 4; ++j) { v[j] = real ? *(const f32x4*)(src + 4 * c.lane + 256 * j) : (f32x4){0.f, 0.f, 0.f, 0.f}; *(f32x4*)(H + (size_t)m * DM + 4 * c.lane + 256 * j) = v[j]; }
        } else {
#pragma unroll
            for (int j = 0; j < 4; ++j) v[j] = *(const f32x4*)(H + (size_t)m * DM + 4 * c.lane + 256 * j);
        }
        float ss = 0.f;
#pragma unroll
        for (int j = 0; j < 4; ++j) ss += (v[j].x * v[j].x + v[j].y * v[j].y) + (v[j].z * v[j].z + v[j].w * v[j].w);
        const float rstd = 1.0f / sqrtf(wave_sum(ss) * (1.f / DM) + 1e-6f);
        float f[8];
#pragma unroll
        for (int q = 0; q < 8; ++q) f[q] = 0.f;
#pragma unroll
        for (int j = 0; j < 4; ++j) {
            const f32x4 g = *(const f32x4*)(gain + 4 * c.lane + 256 * j);
            v[j] = v[j] * rstd * g;
            u32x2 o; o.x = pk2(v[j].x, v[j].y); o.y = pk2(v[j].z, v[j].w);
            *(u32x2*)(HN + (size_t)m * DM + 4 * c.lane + 256 * j) = o;
            if (FG) {
#pragma unroll
                for (int e = 0; e < 4; ++e) { const int k = 4 * c.lane + 256 * j + e; const f32x4 w0 = *(const f32x4*)(wfs + k * 8), w1 = *(const f32x4*)(wfs + k * 8 + 4);
                    const float hv = v[j][e];
                    f[0] += hv * w0.x; f[1] += hv * w0.y; f[2] += hv * w0.z; f[3] += hv * w0.w; f[4] += hv * w1.x; f[5] += hv * w1.y; f[6] += hv * w1.z; f[7] += hv * w1.w; }
            }
        }
        if (FG) {
#pragma unroll
            for (int q = 0; q < 8; ++q) f[q] = wave_sum(f[q]);
            float fv = f[0];
#pragma unroll
            for (int q = 1; q < 8; ++q) fv = (c.lane == q) ? f[q] : fv;
            if (c.lane < 8) { const float x = fv + P.in[7][l * 8 + c.lane]; const float ls = fminf(x, 0.f) - __logf(1.f + __expf(-fabsf(x))); LOGF[(size_t)(b * 8 + c.lane) * LP + t] = ls; }
        }
    }
}

__device__ __forceinline__ void phase_fcum(const Params& P, const Ctx& c) {
    const int s = c.bid - (c.G - 16);
    if (s < 0) return;
    const float* LOGF = (const float*)(c.ws + OFF_MISC) + (size_t)s * LP; float* FC = (float*)(c.ws + OFF_MISC) + 16 * LP + (size_t)s * LP;
    float* wt = (float*)c.lds;
    const int base = c.tid * 17;
    float v[17]; float run = 0.f;
#pragma unroll
    for (int i = 0; i < 17; ++i) { const int idx = base + i; const float x = (idx < LP) ? LOGF[idx] : 0.f; run += x; v[i] = run; }
    float incl = run;
#pragma unroll
    for (int o = 1; o < 64; o <<= 1) { const float t = __shfl_up(incl, o); if (c.lane >= o) incl += t; }
    if (c.lane == 63) wt[c.wave] = incl;
    __syncthreads();
    float off = incl - run;
#pragma unroll
    for (int w2 = 0; w2 < 8; ++w2) off += (w2 < c.wave) ? wt[w2] : 0.f;
#pragma unroll
    for (int i = 0; i < 17; ++i) { const int idx = base + i; if (idx < LP) FC[idx] = (v[i] + off) * LOG2E; }
    __syncthreads();
}

__device__ __forceinline__ void phase_qknorm(const Params& P, int l, const Ctx& c) {
    bf16* Q = (bf16*)(c.ws + OFF_Q); bf16* K = (bf16*)(c.ws + OFF_K);
    const int gw = c.bid * NWAVES + c.wave, NGW = c.G * NWAVES;
    const int d0 = (c.lane & 7) * 8;
    float gq[8], gk[8];
#pragma unroll
    for (int i = 0; i < 8; ++i) { gq[i] = P.in[5][l * 64 + d0 + i] * QSCALE; gk[i] = P.in[6][l * 64 + d0 + i]; }
    for (int m = gw; m < M; m += NGW) {
#pragma unroll
        for (int which = 0; which < 2; ++which) {
            bf16* p = (which ? K : Q) + (size_t)m * 512 + 8 * c.lane;
            const u32x4 w = *(const u32x4*)p;
            float x[8] = {bflo(w.x), bfhi(w.x), bflo(w.y), bfhi(w.y), bflo(w.z), bfhi(w.z), bflo(w.w), bfhi(w.w)};
            float ss = 0.f;
#pragma unroll
            for (int i = 0; i < 8; ++i) ss += x[i] * x[i];
            ss += __shfl_xor(ss, 1); ss += __shfl_xor(ss, 2); ss += __shfl_xor(ss, 4);
            const float rs = 1.0f / sqrtf(ss * (1.f / 64.f) + 1e-6f);
#pragma unroll
            for (int i = 0; i < 8; ++i) x[i] = x[i] * rs * (which ? gk[i] : gq[i]);
            u32x4 o; o.x = pk2(x[0], x[1]); o.y = pk2(x[2], x[3]); o.z = pk2(x[4], x[5]); o.w = pk2(x[6], x[7]);
            *(u32x4*)p = o;
        }
    }
}

constexpr int NCHK = LP / 64;
constexpr int NUNIT = NB * NCHK * 8;
constexpr int UNIT_A = 16384, UNIT_B = 16640;
constexpr int ST = 72, STG = 136;
constexpr int L_F0 = 92160, L_F1 = 108544;
struct RwkvBufs { bf16 *BON, *G; unsigned char *UA, *UB; float* Y; bf16* ORW; };
__device__ __forceinline__ RwkvBufs rwkv_bufs(const Params& P, const Ctx& c) {
    RwkvBufs r; r.BON = (bf16*)(c.ws + OFF_HN); r.G = r.BON + (size_t)M * 512;
    r.UA = c.ws + OFF_T0; r.UB = (unsigned char*)P.out;
    r.Y = (float*)(c.ws + OFF_RW); r.ORW = (bf16*)(c.ws + OFF_RW + (size_t)M * 512 * 4);
    return r;
}
__device__ __forceinline__ void mm_tile(const bf16* A, int sa, const bf16* Bt, int sb, int nks, f32x4 (&acc)[2], int w, int lq, int g) {
    const int mt = w >> 1, nt0 = 2 * (w & 1);
    for (int ks = 0; ks < nks; ++ks) {
        const bf16x8 a = *(const bf16x8*)(A + (16 * mt + lq) * sa + 32 * ks + 8 * g);
#pragma unroll
        for (int q = 0; q < 2; ++q) { const bf16x8 b = *(const bf16x8*)(Bt + (16 * (nt0 + q) + lq) * sb + 32 * ks + 8 * g); acc[q] = __builtin_amdgcn_mfma_f32_16x16x32_bf16(a, b, acc[q], 0, 0, 0); }
    }
}
template <bool SA, bool SB> __device__ __forceinline__ void mm_tile2(const bf16* A, int sa, const bf16* Bt, int sb, int nks, f32x4 (&acc)[2], int w, int lq, int g) {
    const int mt = w >> 1, nt0 = 2 * (w & 1);
    const int ra = 16 * mt + lq, xa = SA ? 8 * ((ra >> 3) & 7) : 0;
    for (int ks = 0; ks < nks; ++ks) {
        const bf16x8 a = *(const bf16x8*)(A + ra * sa + ((32 * ks + 8 * g) ^ xa));
#pragma unroll
        for (int q = 0; q < 2; ++q) { const int rb = 16 * (nt0 + q) + lq, xb = SB ? 8 * ((rb >> 3) & 7) : 0;
            const bf16x8 bb = *(const bf16x8*)(Bt + rb * sb + ((32 * ks + 8 * g) ^ xb)); acc[q] = __builtin_amdgcn_mfma_f32_16x16x32_bf16(a, bb, acc[q], 0, 0, 0); }
    }
}
#define ZACC(a) do { a[0] = (f32x4){0.f, 0.f, 0.f, 0.f}; a[1] = (f32x4){0.f, 0.f, 0.f, 0.f}; } while (0)
__device__ __forceinline__ int permk(int k) { return 32 * (k >> 5) + 8 * ((k & 15) >> 2) + 4 * ((k >> 4) & 1) + (k & 3); }
__device__ __forceinline__ int swz(int row, int col) { return row * 128 + ((((col >> 3) ^ (row >> 1)) & 7) << 4) + (col & 7) * 2; }

__device__ __forceinline__ void rwkv_prep_unit(const Params& P, int l, const Ctx& c, int u, const RwkvBufs& B, const float (&pw0)[8], const float (&pa0)[8], const float (&pkk)[8], const float (&pka)[8], const float (&prk)[8]) {
    const int h = u & 7, bc = u >> 3, b = bc / NCHK, ch = bc - b * NCHK;
    const size_t m0 = (size_t)b * LP + ch * 64;
    int tid_ = c.tid; asm volatile("" : "+v"(tid_));
    const int tid = tid_, lane = tid & 63, w = c.wave, lq = lane & 15, g = lane >> 4;
    const int t = tid >> 3, cg = tid & 7, c0 = cg * 8, jb = h * 64 + c0;
    unsigned char* L = c.lds;
    bf16* A0 = (bf16*)L; bf16* A1 = A0 + 4608; bf16* A2 = A1 + 4608; bf16* A3 = A2 + 4608; bf16* A4 = A3 + 4608; bf16* A5 = A4 + 4608; bf16* A6 = A5 + 4608;
    bf16* A7 = A6 + 4608; bf16* A8 = A7 + 4608; bf16* A9 = A8 + 4608;
    float* F0 = (float*)(L + L_F0); float* F1 = (float*)(L + L_F1);
    const bf16* RW = (const bf16*)(c.ws + OFF_RW);
    const bf16* WT = (const bf16*)(c.ws + OFF_WT);
    const float* mu = P.in[8] + l * NRW;
    const bool first = (ch == 0 && t == 0);
    const bf16* cur = RW + (m0 + t) * NRW; const bf16* prv = cur - NRW;
    float zr[8], zk[8], zv[8];
#pragma unroll
    for (int s = 0; s < 3; ++s) {
        const u32x4 cw = *(const u32x4*)(cur + s * 512 + jb); u32x4 pw = (u32x4){0u, 0u, 0u, 0u}; if (!first) pw = *(const u32x4*)(prv + s * 512 + jb);
        const float cv[8] = {bflo(cw.x), bfhi(cw.x), bflo(cw.y), bfhi(cw.y), bflo(cw.z), bfhi(cw.z), bflo(cw.w), bfhi(cw.w)};
        const float pv[8] = {bflo(pw.x), bfhi(pw.x), bflo(pw.y), bfhi(pw.y), bflo(pw.z), bfhi(pw.z), bflo(pw.w), bfhi(pw.w)};
#pragma unroll
        for (int i = 0; i < 8; ++i) { const float z = cv[i] + mu[s * 512 + jb + i] * (pv[i] - cv[i]); if (s == 0) zr[i] = z; else if (s == 1) zk[i] = z; else zv[i] = z; }
    }
#pragma unroll
    for (int q4 = 0; q4 < 4; ++q4) {
        const int col = cg * 32 + q4 * 8;
        const u32x4 cw = *(const u32x4*)(cur + 1536 + col); u32x4 pw = (u32x4){0u, 0u, 0u, 0u}; if (!first) pw = *(const u32x4*)(prv + 1536 + col);
        const float cv[8] = {bflo(cw.x), bfhi(cw.x), bflo(cw.y), bfhi(cw.y), bflo(cw.z), bfhi(cw.z), bflo(cw.w), bfhi(cw.w)};
        const float pv[8] = {bflo(pw.x), bfhi(pw.x), bflo(pw.y), bfhi(pw.y), bflo(pw.z), bfhi(pw.z), bflo(pw.w), bfhi(pw.w)};
        float z[8];
#pragma unroll
        for (int i = 0; i < 8; ++i) { z[i] = cv[i] + mu[1536 + col + i] * (pv[i] - cv[i]); if (col < 64) z[i] = 1.f - 2.f / (1.f + __expf(2.f * z[i])); else if (col >= 128) z[i] = sigmoidf_(z[i]); }
        u32x4 o; o.x = pk2(z[0], z[1]); o.y = pk2(z[2], z[3]); o.z = pk2(z[4], z[5]); o.w = pk2(z[6], z[7]);
        bf16* dst = (col < 64) ? A0 + t * ST + col : (col < 128 ? A1 + t * ST + (col - 64) : A2 + t * STG + (col - 128));
        *(u32x4*)dst = o;
    }
    { const int row = tid >> 3, chk = tid & 7;
      *(u32x4*)(A4 + row * ST + chk * 8) = *(const u32x4*)(WT + WT_LW + (size_t)(h * 64 + row) * 64 + chk * 8);
      *(u32x4*)(A5 + row * ST + chk * 8) = *(const u32x4*)(WT + WT_LA + (size_t)(h * 64 + row) * 64 + chk * 8);
#pragma unroll
      for (int i = 0; i < 2; ++i) { const int idx = tid + 512 * i, r2 = idx >> 4, c2 = idx & 15;
          *(u32x4*)((bf16*)F1 + r2 * STG + c2 * 8) = *(const u32x4*)(WT + WT_LG + (size_t)(h * 64 + r2) * 128 + c2 * 8); } }
    LDS_BARRIER();
    { f32x4 aw[2], aa[2], ag[2]; ZACC(aw); ZACC(aa); ZACC(ag);
      mm_tile(A4, ST, A0, ST, 2, aw, w, lq, g); mm_tile(A5, ST, A1, ST, 2, aa, w, lq, g); mm_tile((const bf16*)F1, STG, A2, STG, 4, ag, w, lq, g);
      const int mt = w >> 1, nt0 = 2 * (w & 1);
#pragma unroll
      for (int q = 0; q < 2; ++q) { const int o = (16 * (nt0 + q) + lq) * ST + 16 * mt + 4 * g; u32x2 p;
          p.x = pk2(aw[q][0], aw[q][1]); p.y = pk2(aw[q][2], aw[q][3]); *(u32x2*)(A7 + o) = p;
          p.x = pk2(aa[q][0], aa[q][1]); p.y = pk2(aa[q][2], aa[q][3]); *(u32x2*)(A8 + o) = p;
          p.x = pk2(ag[q][0], ag[q][1]); p.y = pk2(ag[q][2], ag[q][3]); *(u32x2*)(A9 + o) = p; } }
    LDS_BARRIER();
    float kk[8], k2[8], ar[8];
    { const u32x4 lw = *(const u32x4*)(A7 + t * ST + c0), la = *(const u32x4*)(A8 + t * ST + c0), lg = *(const u32x4*)(A9 + t * ST + c0);
      const float fw[8] = {bflo(lw.x), bfhi(lw.x), bflo(lw.y), bfhi(lw.y), bflo(lw.z), bfhi(lw.z), bflo(lw.w), bfhi(lw.w)};
      const float fa[8] = {bflo(la.x), bfhi(la.x), bflo(la.y), bfhi(la.y), bflo(la.z), bfhi(la.z), bflo(la.w), bfhi(la.w)};
      float ss = 0.f, bs = 0.f;
#pragma unroll
      for (int i = 0; i < 8; ++i) {
          const float xw = -(pw0[i] + fw[i]); const float sp = fmaxf(xw, 0.f) + __logf(1.f + __expf(-fabsf(xw)));
          F0[t * 64 + c0 + i] = __expf(-sp - 0.5f);
          ar[i] = sigmoidf_(pa0[i] + fa[i]);
          kk[i] = zk[i] * pkk[i]; ss += kk[i] * kk[i];
          k2[i] = zk[i] * (1.f + (ar[i] - 1.f) * pka[i]);
          bs += zr[i] * k2[i] * prk[i]; }
      ss += __shfl_xor(ss, 1); ss += __shfl_xor(ss, 2); ss += __shfl_xor(ss, 4);
      bs += __shfl_xor(bs, 1); bs += __shfl_xor(bs, 2); bs += __shfl_xor(bs, 4);
      const float inv = 1.0f / fmaxf(sqrtf(ss), 1e-12f);
#pragma unroll
      for (int i = 0; i < 8; ++i) kk[i] *= inv;
      u32x4 bo; bo.x = pk2(bs * zv[0], bs * zv[1]); bo.y = pk2(bs * zv[2], bs * zv[3]); bo.z = pk2(bs * zv[4], bs * zv[5]); bo.w = pk2(bs * zv[6], bs * zv[7]);
      *(u32x4*)(B.BON + (m0 + t) * 512 + jb) = bo; *(u32x4*)(B.G + (m0 + t) * 512 + jb) = lg; }
    LDS_BARRIER();
    {
      const int k = tid & 63, sg = tid >> 6; float e[8], run = 0.f;
#pragma unroll
      for (int s = 0; s < 8; ++s) { run += F0[(8 * sg + s) * 64 + k]; e[s] = run; }
      F1[sg * 64 + k] = run;
      LDS_BARRIER();
      float off = 0.f;
#pragma unroll
      for (int s = 0; s < 8; ++s) off += (s < sg) ? F1[s * 64 + k] : 0.f;
#pragma unroll
      for (int s = 0; s < 8; ++s) F0[(8 * sg + s) * 64 + k] = e[s] + off; }
    LDS_BARRIER();
    { float ct[8], cp[8], cC[8];
#pragma unroll
      for (int i = 0; i < 8; ++i) { ct[i] = F0[t * 64 + c0 + i]; cp[i] = (t > 0) ? F0[(t - 1) * 64 + c0 + i] : 0.f; cC[i] = F0[63 * 64 + c0 + i]; }
      float at[8], bt[8], kt[8], rt[8], bh[8], kh[8];
#pragma unroll
      for (int i = 0; i < 8; ++i) { const float gt = __expf(-ct[i]), igt = __expf(ct[i]), gp = __expf(-cp[i]), gct = __expf(ct[i] - cC[i]);
          at[i] = -kk[i] * gp; bt[i] = kk[i] * ar[i] * igt; kt[i] = k2[i] * igt; rt[i] = zr[i] * gt; bh[i] = kk[i] * ar[i] * gct; kh[i] = k2[i] * gct; }
      u32x4 o;
      o.x = pk2(at[0], at[1]); o.y = pk2(at[2], at[3]); o.z = pk2(at[4], at[5]); o.w = pk2(at[6], at[7]); *(u32x4*)(A0 + t * ST + c0) = o;
      o.x = pk2(bt[0], bt[1]); o.y = pk2(bt[2], bt[3]); o.z = pk2(bt[4], bt[5]); o.w = pk2(bt[6], bt[7]); *(u32x4*)(A1 + t * ST + c0) = o;
      o.x = pk2(kt[0], kt[1]); o.y = pk2(kt[2], kt[3]); o.z = pk2(kt[4], kt[5]); o.w = pk2(kt[6], kt[7]); *(u32x4*)(A2 + t * ST + c0) = o;
      o.x = pk2(rt[0], rt[1]); o.y = pk2(rt[2], rt[3]); o.z = pk2(rt[4], rt[5]); o.w = pk2(rt[6], rt[7]); *(u32x4*)(A3 + t * ST + c0) = o;
#pragma unroll
      for (int i = 0; i < 8; ++i) { const int o = (c0 + i) * ST + (t ^ c0);
          A4[o] = (bf16)f2bf(bh[i]); A5[o] = (bf16)f2bf(kh[i]); A6[o] = (bf16)f2bf(zv[i]); F1[t * 128 + c0 + i] = at[i]; }
      if (t == 63) { float* gc = (float*)(B.UB + (size_t)u * UNIT_B + 16384) + c0;
#pragma unroll
          for (int i = 0; i < 8; ++i) gc[i] = __expf(-cC[i]); } }
    LDS_BARRIER();
    { const int mt = w >> 1, nt0 = 2 * (w & 1);
      f32x4 a[2];
      ZACC(a); mm_tile(A0, ST, A1, ST, 2, a, w, lq, g);
#pragma unroll
      for (int q = 0; q < 2; ++q) { const int i = 16 * (nt0 + q) + lq; f32x4 lab;
#pragma unroll
          for (int j = 0; j < 4; ++j) lab[j] = (i < 16 * mt + 4 * g + j) ? a[q][j] : 0.f;
#pragma unroll
          for (int j = 0; j < 4; ++j) F0[i * 64 + j * 16 + 4 * mt + g] = lab[j]; }
      asm volatile("" ::: "memory");
#define ST1_STORE(DST, INCL) do { _Pragma("unroll") for (int q = 0; q < 2; ++q) { const int tt = 16 * (nt0 + q) + lq, i0 = 16 * mt + 4 * g; float v_[4]; \
          _Pragma("unroll") for (int j = 0; j < 4; ++j) v_[j] = (i0 + j < tt + (INCL)) ? a[q][j] : 0.f; \
          u32x2 p_; p_.x = pk2(v_[0], v_[1]); p_.y = pk2(v_[2], v_[3]); *(u32x2*)((DST) + tt * ST + i0) = p_; } } while (0)
      ZACC(a); mm_tile(A2, ST, A0, ST, 2, a, w, lq, g); ST1_STORE(A7, 0); asm volatile("" ::: "memory");
      ZACC(a); mm_tile(A1, ST, A3, ST, 2, a, w, lq, g); ST1_STORE(A8, 1); asm volatile("" ::: "memory");
      ZACC(a); mm_tile(A2, ST, A3, ST, 2, a, w, lq, g); ST1_STORE(A9, 1);
#undef ST1_STORE
    }
    LDS_BARRIER();
    { const int mt = w >> 1, nt0 = 2 * (w & 1); f32x4 a[2]; ZACC(a);
      mm_tile2<true, false>(A6, ST, A7, ST, 2, a, w, lq, g);
#pragma unroll
      for (int q = 0; q < 2; ++q) *(f32x4*)(F1 + (16 * (nt0 + q) + lq) * 128 + 64 + 16 * mt + 4 * g) = a[q]; }
    LDS_BARRIER();
    { float X[16];
      const int col = 16 * w + lq;
#pragma unroll
      for (int r = 0; r < 16; ++r) X[r] = F1[(4 * r + g) * 128 + col];
      LDS_BARRIER();
      f32x4 Lc[4];
#pragma unroll
      for (int q = 0; q < 4; ++q) Lc[q] = *(const f32x4*)(F0 + g * 16 + 4 * q);
#pragma unroll
      for (int i = 0; i < 64; ++i) {
          const float xi = __shfl(X[i >> 2], (i & 3) * 16 + lq);
          f32x4 Ln[4];
#pragma unroll
          for (int q = 0; q < 4; ++q) Ln[q] = Lc[q];
          if (i + 1 < 64) {
#pragma unroll
              for (int q = ((i + 1) >> 4); q < 4; ++q) Ln[q] = *(const f32x4*)(F0 + (i + 1) * 64 + g * 16 + 4 * q);
          }
#pragma unroll
          for (int r = (i >> 2); r < 16; ++r) X[r] += Lc[r >> 2][r & 3] * xi;
#pragma unroll
          for (int q = 0; q < 4; ++q) Lc[q] = Ln[q];
          __builtin_amdgcn_sched_barrier(0);
      }
      bf16* XT = (bf16*)F1 + (w >> 2) * 4608 + ((col & 63) * ST);
#pragma unroll
      for (int r = 0; r < 16; ++r) XT[4 * r + g] = (bf16)f2bf(X[r]); }
    LDS_BARRIER();
    { const int mt = w >> 1, nt0 = 2 * (w & 1);
      const bf16* AhT = (const bf16*)F1; const bf16* W2T = AhT + 4608;
      unsigned char* ua = B.UA + (size_t)u * UNIT_A; unsigned char* ub = B.UB + (size_t)u * UNIT_B;
      const int p0 = 32 * (mt >> 1) + 8 * g + 4 * (mt & 1);
      f32x4 a[2];
      ZACC(a); mm_tile2<false, true>(AhT, ST, A4, ST, 2, a, w, lq, g);
#pragma unroll
      for (int q = 0; q < 2; ++q) { const int k = 16 * (nt0 + q) + lq; u32x2 o; o.x = pk2(a[q][0], a[q][1]); o.y = pk2(a[q][2], a[q][3]); *(u32x2*)(ua + swz(k, p0)) = o; }
      ZACC(a); mm_tile(AhT, ST, A8, ST, 2, a, w, lq, g);
#pragma unroll
      for (int q = 0; q < 2; ++q) { const int tt = 16 * (nt0 + q) + lq; const u32x2 rr = *(const u32x2*)(A3 + tt * ST + 16 * mt + 4 * g);
          u32x2 o; o.x = pk2(a[q][0] + bflo(rr.x), a[q][1] + bfhi(rr.x)); o.y = pk2(a[q][2] + bflo(rr.y), a[q][3] + bfhi(rr.y)); *(u32x2*)(ua + 8192 + swz(tt, p0)) = o; }
      ZACC(a); mm_tile2<true, false>(A4, ST, W2T, ST, 2, a, w, lq, g); mm_tile2<true, true>(A5, ST, A6, ST, 2, a, w, lq, g);
#pragma unroll
      for (int q = 0; q < 2; ++q) { const int v = 16 * (nt0 + q) + lq, k0 = 16 * mt + 4 * g; u32x2 o; o.x = pk2(a[q][0], a[q][1]); o.y = pk2(a[q][2], a[q][3]); *(u32x2*)(ub + swz(v, k0)) = o; }
      ZACC(a); mm_tile(A8, ST, W2T, ST, 2, a, w, lq, g); mm_tile2<false, true>(A9, ST, A6, ST, 2, a, w, lq, g);
#pragma unroll
      for (int q = 0; q < 2; ++q) { const int v = 16 * (nt0 + q) + lq, t0 = 16 * mt + 4 * g; u32x2 o; o.x = pk2(a[q][0], a[q][1]); o.y = pk2(a[q][2], a[q][3]); *(u32x2*)(ub + 8192 + swz(v, t0)) = o; } }
    LDS_BARRIER();
}
__device__ __forceinline__ void phase_rwkv_prep(const Params& P, int l, const Ctx& c) {
    const RwkvBufs B = rwkv_bufs(P, c);
    float pw0[8], pa0[8], pkk[8], pka[8], prk[8]; int hprev = -1;
    for (int u = c.bid; u < NUNIT; u += c.G) {
        const int h = u & 7;
        if (h != hprev) { hprev = h; const int j0 = l * 512 + h * 64 + (c.tid & 7) * 8;
#pragma unroll
            for (int i = 0; i < 8; ++i) { pw0[i] = P.in[9][j0 + i]; pa0[i] = P.in[11][j0 + i]; pkk[i] = P.in[14][j0 + i]; pka[i] = P.in[15][j0 + i]; prk[i] = P.in[16][j0 + i]; } }
        rwkv_prep_unit(P, l, c, u, B, pw0, pa0, pkk, pka, prk);
    }
}

constexpr int SLOTB = 33280, YST = 68;
__device__ __forceinline__ void scan_chunked(const Params& P, const Ctx& c, int bh) {
    const RwkvBufs B = rwkv_bufs(P, c);
    const int b = bh >> 3, h = bh & 7, w = c.wave, lane = c.lane, lq = lane & 15, g = lane >> 4;
    const size_t rowb = (size_t)b * LP;
    const int ll = c.tid;
    unsigned char* L = c.lds;
    f32x4 st[4];
#pragma unroll
    for (int i = 0; i < 4; ++i) st[i] = (f32x4){0.f, 0.f, 0.f, 0.f};
    u32x4 r0[5], r1[5], r2[5], r3[5], r4[5];
#define SC_UNIT(cc) ((size_t)((b * NCHK + (cc)) * 8 + h))
#define SC_LOAD(R, cc) do { const unsigned char* pa_ = B.UA + SC_UNIT(cc) * UNIT_A; const unsigned char* pb_ = B.UB + SC_UNIT(cc) * UNIT_B; \
        _Pragma("unroll") for (int i_ = 0; i_ < 2; ++i_) { R[i_] = GLD(u32x4, pa_ + (ll + 512 * i_) * 16); R[2 + i_] = GLD(u32x4, pb_ + (ll + 512 * i_) * 16); } \
        if (ll < 16) R[4] = GLD(u32x4, pb_ + 16384 + ll * 16); } while (0)
#define SC_WRITE(R, slot) do { unsigned char* s_ = L + (slot) * SLOTB; \
        _Pragma("unroll") for (int i_ = 0; i_ < 2; ++i_) { *(u32x4*)(s_ + (ll + 512 * i_) * 16) = R[i_]; *(u32x4*)(s_ + 16384 + (ll + 512 * i_) * 16) = R[2 + i_]; } \
        if (ll < 16) *(u32x4*)(s_ + 32768 + ll * 16) = R[4]; } while (0)
#define SC_COMPUTE(ci) do { \
        const unsigned char* sl = L + ((ci) % 3) * SLOTB; \
        const int vcol = 16 * w + lq; \
        bf16x8 gaf[4][2]; f32x4 gcf[4]; u32x2 d0f[4]; \
        _Pragma("unroll") for (int mt = 0; mt < 4; ++mt) { \
            gcf[mt] = *(const f32x4*)(sl + 32768 + (16 * mt + 4 * g) * 4); \
            d0f[mt] = *(const u32x2*)(sl + 16384 + swz(vcol, 16 * mt + 4 * g)); \
            _Pragma("unroll") for (int ks = 0; ks < 2; ++ks) gaf[mt][ks] = *(const bf16x8*)(sl + swz(16 * mt + lq, 32 * ks + 8 * g)); } \
        __builtin_amdgcn_sched_barrier(0);        \
        bf16x8 sb[2]; \
        _Pragma("unroll") for (int ks = 0; ks < 2; ++ks) { u32x4 pw; pw.x = pk2(st[2 * ks][0], st[2 * ks][1]); pw.y = pk2(st[2 * ks][2], st[2 * ks][3]); pw.z = pk2(st[2 * ks + 1][0], st[2 * ks + 1][1]); pw.w = pk2(st[2 * ks + 1][2], st[2 * ks + 1][3]); \
            sb[ks] = __builtin_bit_cast(bf16x8, pw); } \
        _Pragma("unroll") for (int mt = 0; mt < 4; ++mt) { \
            f32x4 ns = (f32x4){bflo(d0f[mt].x), bfhi(d0f[mt].x), bflo(d0f[mt].y), bfhi(d0f[mt].y)} + gcf[mt] * st[mt]; \
            _Pragma("unroll") for (int ks = 0; ks < 2; ++ks) ns = __builtin_amdgcn_mfma_f32_16x16x32_bf16(gaf[mt][ks], sb[ks], ns, 0, 0, 0); \
            st[mt] = ns; } \
        _Pragma("unroll") for (int mt = 0; mt < 4; ++mt) { \
            const u32x2 y0 = *(const u32x2*)(sl + 24576 + swz(vcol, 16 * mt + 4 * g)); \
            f32x4 ya = (f32x4){bflo(y0.x), bfhi(y0.x), bflo(y0.y), bfhi(y0.y)}; \
            _Pragma("unroll") for (int ks = 0; ks < 2; ++ks) { const bf16x8 rh = *(const bf16x8*)(sl + 8192 + swz(16 * mt + lq, 32 * ks + 8 * g)); ya = __builtin_amdgcn_mfma_f32_16x16x32_bf16(rh, sb[ks], ya, 0, 0, 0); } \
            float* yl = (float*)(L + 3 * SLOTB) + ((ci) & 1) * (64 * YST) + (16 * mt + 4 * g) * YST + vcol; \
            _Pragma("unroll") for (int j = 0; j < 4; ++j) yl[j * YST] = ya[j]; } } while (0)
#define SC_YSTORE(ci) do { const float* ys_ = (const float*)(L + 3 * SLOTB) + ((ci) & 1) * (64 * YST) + (c.tid >> 3) * YST + (c.tid & 7) * 8; \
        float* yg_ = B.Y + (rowb + (ci) * 64 + (c.tid >> 3)) * 512 + h * 64 + (c.tid & 7) * 8; \
        GST(f32x4, yg_) = *(const f32x4*)ys_; GST(f32x4, yg_ + 4) = *(const f32x4*)(ys_ + 4); } while (0)
#define SC_ITER(ci, R) do { if ((ci) + 2 < NCHK) SC_WRITE(R, ((ci) + 2) % 3); if ((ci) + 7 < NCHK) SC_LOAD(R, (ci) + 7); if ((ci) > 0) SC_YSTORE((ci) - 1); if (w < 4) { SC_COMPUTE(ci); } LDS_BARRIER(); } while (0)
    { SC_LOAD(r0, 0); SC_LOAD(r1, 1); SC_WRITE(r0, 0); SC_WRITE(r1, 1); SC_LOAD(r2, 2); SC_LOAD(r3, 3); SC_LOAD(r4, 4); SC_LOAD(r0, 5); SC_LOAD(r1, 6); }
    __syncthreads();
#pragma unroll 1
    for (int cc = 0; cc < NCHK; cc += 5) { SC_ITER(cc, r2); SC_ITER(cc + 1, r3); SC_ITER(cc + 2, r4); SC_ITER(cc + 3, r0); SC_ITER(cc + 4, r1); }
    SC_YSTORE(NCHK - 1);
#undef SC_YSTORE
#undef SC_COMPUTE
#undef SC_ITER
#undef SC_UNIT
#undef SC_LOAD
#undef SC_WRITE
}

__device__ __forceinline__ void phase_gn(const Params& P, int l, const Ctx& c) {
    const RwkvBufs B = rwkv_bufs(P, c);
    const int gw = c.bid * NWAVES + c.wave, NGW = c.G * NWAVES;
    const int c0 = 8 * c.lane;
    float gnw[8], gnb[8];
#pragma unroll
    for (int i = 0; i < 8; ++i) { gnw[i] = P.in[17][l * 512 + c0 + i]; gnb[i] = P.in[18][l * 512 + c0 + i]; }
    for (int m = gw; m < M; m += NGW) {
        const size_t o = (size_t)m * 512 + c0;
        const f32x4 y0 = *(const f32x4*)(B.Y + o), y1 = *(const f32x4*)(B.Y + o + 4);
        float y[8] = {y0.x, y0.y, y0.z, y0.w, y1.x, y1.y, y1.z, y1.w};
        const u32x4 bw = *(const u32x4*)(B.BON + o), gw4 = *(const u32x4*)(B.G + o);
        const float bo[8] = {bflo(bw.x), bfhi(bw.x), bflo(bw.y), bfhi(bw.y), bflo(bw.z), bfhi(bw.z), bflo(bw.w), bfhi(bw.w)};
        const float gg[8] = {bflo(gw4.x), bfhi(gw4.x), bflo(gw4.y), bfhi(gw4.y), bflo(gw4.z), bfhi(gw4.z), bflo(gw4.w), bfhi(gw4.w)};
        float s = 0.f;
#pragma unroll
        for (int i = 0; i < 8; ++i) s += y[i];
        s += __shfl_xor(s, 1); s += __shfl_xor(s, 2); s += __shfl_xor(s, 4);
        const float mean = s * (1.f / 64.f);
        float q = 0.f;
#pragma unroll
        for (int i = 0; i < 8; ++i) { y[i] -= mean; q += y[i] * y[i]; }
        q += __shfl_xor(q, 1); q += __shfl_xor(q, 2); q += __shfl_xor(q, 4);
        const float rstd = 1.0f / sqrtf(q * (1.f / 64.f) + 64e-5f);
        float ov[8];
#pragma unroll
        for (int i = 0; i < 8; ++i) ov[i] = (y[i] * rstd * gnw[i] + gnb[i] + bo[i]) * gg[i];
        u32x4 ow; ow.x = pk2(ov[0], ov[1]); ow.y = pk2(ov[2], ov[3]); ow.z = pk2(ov[4], ov[5]); ow.w = pk2(ov[6], ov[7]);
        *(u32x4*)(B.ORW + o) = ow;
    }
}

__device__ __forceinline__ void attn_unit(const Ctx& c, int bh, int qb, const bf16* Q, const bf16* K, const bf16* V, bf16* O, const float* FC, float qkb2, const float* gq, const float* gk) {
    const int b = bh >> 3, h = bh & 7, lane = c.lane, w = c.wave, lq = lane & 15, g = lane >> 4;
    const int q0 = qb * 128;
    const size_t rowb = (size_t)b * LP;
    const int qrow = q0 + 16 * w + lq;
    bf16* Ks = (bf16*)c.lds; bf16* Vt = Ks + 64 * 72; float* fks = (float*)(Vt + 64 * 72);
    const bf16* qp = Q + (rowb + qrow) * 512 + h * 64 + 8 * g;
    bf16x8 qf0, qf1;
    { const u32x4 r0 = GLD(u32x4, qp), r1 = GLD(u32x4, qp + 32);
      float x[16] = {bflo(r0.x), bfhi(r0.x), bflo(r0.y), bfhi(r0.y), bflo(r0.z), bfhi(r0.z), bflo(r0.w), bfhi(r0.w), bflo(r1.x), bfhi(r1.x), bflo(r1.y), bfhi(r1.y), bflo(r1.z), bfhi(r1.z), bflo(r1.w), bfhi(r1.w)};
      float ss = 0.f;
#pragma unroll
      for (int i = 0; i < 16; ++i) ss += x[i] * x[i];
      ss += __shfl_xor(ss, 16); ss += __shfl_xor(ss, 32);
      const float rs = QSCALE / sqrtf(ss * (1.f / 64.f) + 1e-6f);
#pragma unroll
      for (int i = 0; i < 8; ++i) { x[i] *= rs * gq[8 * g + i]; x[8 + i] *= rs * gq[32 + 8 * g + i]; }
      u32x4 p0, p1; p0.x = pk2(x[0], x[1]); p0.y = pk2(x[2], x[3]); p0.z = pk2(x[4], x[5]); p0.w = pk2(x[6], x[7]); p1.x = pk2(x[8], x[9]); p1.y = pk2(x[10], x[11]); p1.z = pk2(x[12], x[13]); p1.w = pk2(x[14], x[15]);
      qf0 = __builtin_bit_cast(bf16x8, p0); qf1 = __builtin_bit_cast(bf16x8, p1); }
    const float* FCh = FC + (size_t)bh * LP;
    const float fq = GLD(float, FCh + qrow);
    float mrun = -1e30f, lsum = 0.f;
    f32x4 o[4];
#pragma unroll
    for (int i = 0; i < 4; ++i) o[i] = (f32x4){0.f, 0.f, 0.f, 0.f};
    const int kt_max = (q0 + 127) >> 6;
    const int lkey = c.tid >> 3, lch = c.tid & 7;
    float gkr[8];
#pragma unroll
    for (int i = 0; i < 8; ++i) gkr[i] = gk[lch * 8 + i];
    const size_t gbase = (rowb + lkey) * 512 + h * 64 + lch * 8;
    u32x4 kv = GLD(u32x4, K + gbase + (size_t)kt_max * 64 * 512), vv = GLD(u32x4, V + gbase + (size_t)kt_max * 64 * 512);
    float fkv = GLD(float, FCh + kt_max * 64 + (c.tid & 63));
    volatile unsigned* vote = (volatile unsigned*)(fks + 64);
    for (int kt = kt_max; kt >= 0; --kt) {
        const int k0 = kt * 64;
        LDS_BARRIER();
        { int can = 0; if (kt < kt_max) { const float fl = __shfl(fkv, 63); can = (qkb2 + fq - fl) < (mrun - THR2); }
          const int wall = __all(can); if (lane == 0) vote[w] = (unsigned)wall; }
        { { float x[8] = {bflo(kv.x), bfhi(kv.x), bflo(kv.y), bfhi(kv.y), bflo(kv.z), bfhi(kv.z), bflo(kv.w), bfhi(kv.w)}; float ss = 0.f;
#pragma unroll
              for (int i = 0; i < 8; ++i) ss += x[i] * x[i];
              ss += __shfl_xor(ss, 1); ss += __shfl_xor(ss, 2); ss += __shfl_xor(ss, 4);
              const float rs = 1.0f / sqrtf(ss * (1.f / 64.f) + 1e-6f);
              u32x4 kn; kn.x = pk2(x[0] * rs * gkr[0], x[1] * rs * gkr[1]); kn.y = pk2(x[2] * rs * gkr[2], x[3] * rs * gkr[3]); kn.z = pk2(x[4] * rs * gkr[4], x[5] * rs * gkr[5]); kn.w = pk2(x[6] * rs * gkr[6], x[7] * rs * gkr[7]);
              *(u32x4*)(Ks + lkey * 72 + lch * 8) = kn; }
            bf16* vd = Vt + (lch * 8) * 72 + lkey;
            vd[0] = (bf16)(vv.x & 0xffff); vd[72] = (bf16)(vv.x >> 16); vd[144] = (bf16)(vv.y & 0xffff); vd[216] = (bf16)(vv.y >> 16);
            vd[288] = (bf16)(vv.z & 0xffff); vd[360] = (bf16)(vv.z >> 16); vd[432] = (bf16)(vv.w & 0xffff); vd[504] = (bf16)(vv.w >> 16);
            if (c.tid < 64) fks[c.tid] = fkv;
            if (kt > 0) { kv = GLD(u32x4, K + gbase + (size_t)(k0 - 64) * 512); vv = GLD(u32x4, V + gbase + (size_t)(k0 - 64) * 512); fkv = GLD(float, FCh + k0 - 64 + (c.tid & 63)); } }
        LDS_BARRIER();
        { unsigned all = vote[0] & vote[1] & vote[2] & vote[3] & vote[4] & vote[5] & vote[6] & vote[7]; if (all) break; }
        if (k0 > q0 + 16 * w + 15) continue;
        f32x4 s[4];
#pragma unroll
        for (int nt = 0; nt < 4; ++nt) { const bf16* kp = Ks + (16 * nt + lq) * 72 + 8 * g; const bf16x8 a0 = *(const bf16x8*)kp, a1 = *(const bf16x8*)(kp + 32);
            s[nt] = __builtin_amdgcn_mfma_f32_16x16x32_bf16(a0, qf0, (f32x4){0.f, 0.f, 0.f, 0.f}, 0, 0, 0);
            s[nt] = __builtin_amdgcn_mfma_f32_16x16x32_bf16(a1, qf1, s[nt], 0, 0, 0); }
        float mx = -INFINITY;
#pragma unroll
        for (int nt = 0; nt < 4; ++nt) { const f32x4 fk = *(const f32x4*)(fks + 16 * nt + 4 * g);
#pragma unroll
            for (int j = 0; j < 4; ++j) { float x = s[nt][j] + fq - fk[j]; const int key = k0 + 16 * nt + 4 * g + j; if (key > qrow) x = -INFINITY; s[nt][j] = x; mx = fmaxf(mx, x); } }
        mx = fmaxf(mx, __shfl_xor(mx, 16)); mx = fmaxf(mx, __shfl_xor(mx, 32));
        const float mnew = fmaxf(mrun, mx), alpha = __builtin_amdgcn_exp2f(mrun - mnew); mrun = mnew;
        float psum = 0.f;
#pragma unroll
        for (int nt = 0; nt < 4; ++nt)
#pragma unroll
            for (int j = 0; j < 4; ++j) { const float p = __builtin_amdgcn_exp2f(s[nt][j] - mnew); s[nt][j] = p; psum += p; }
        lsum = lsum * alpha + psum;
#pragma unroll
        for (int dt = 0; dt < 4; ++dt) o[dt] = o[dt] * alpha;
        bf16x8 pb[2];
#pragma unroll
        for (int k2 = 0; k2 < 2; ++k2) { u32x4 pw; pw.x = pk2(s[2 * k2][0], s[2 * k2][1]); pw.y = pk2(s[2 * k2][2], s[2 * k2][3]); pw.z = pk2(s[2 * k2 + 1][0], s[2 * k2 + 1][1]); pw.w = pk2(s[2 * k2 + 1][2], s[2 * k2 + 1][3]);
            pb[k2] = __builtin_bit_cast(bf16x8, pw); }
#pragma unroll
        for (int dt = 0; dt < 4; ++dt)
#pragma unroll
            for (int k2 = 0; k2 < 2; ++k2) { const bf16* vp = Vt + (16 * dt + lq) * 72 + 32 * k2 + 4 * g;
                const u32x2 lo = *(const u32x2*)vp, hi = *(const u32x2*)(vp + 16);
                u32x4 aw; aw.x = lo.x; aw.y = lo.y; aw.z = hi.x; aw.w = hi.y;
                o[dt] = __builtin_amdgcn_mfma_f32_16x16x32_bf16(__builtin_bit_cast(bf16x8, aw), pb[k2], o[dt], 0, 0, 0); }
    }
    lsum += __shfl_xor(lsum, 16); lsum += __shfl_xor(lsum, 32);
    const float inv = 1.0f / lsum;
    bf16* op = O + (rowb + qrow) * 512 + h * 64 + 4 * g;
#pragma unroll
    for (int dt = 0; dt < 4; ++dt) { u32x2 ow; ow.x = pk2(o[dt][0] * inv, o[dt][1] * inv); ow.y = pk2(o[dt][2] * inv, o[dt][3] * inv); GST(u32x2, op + 16 * dt) = ow; }
    __syncthreads();
}
__device__ __forceinline__ void phase_attn(const Params& P, int l, const Ctx& c, int first_blk) {
    const bf16* Q = (const bf16*)(c.ws + OFF_Q); const bf16* K = (const bf16*)(c.ws + OFF_K); const bf16* V = (const bf16*)(c.ws + OFF_V);
    const float* FC = (const float*)(c.ws + OFF_MISC) + 16 * LP;
    float gqm = fabsf(P.in[5][l * 64 + c.lane]), gkm = fabsf(P.in[6][l * 64 + c.lane]);
#pragma unroll
    for (int o = 1; o < 64; o <<= 1) { gqm = fmaxf(gqm, __shfl_xor(gqm, o)); gkm = fmaxf(gkm, __shfl_xor(gkm, o)); }
    const float qkb2 = 8.0f * gqm * gkm * LOG2E * 1.03f;
    constexpr int NQB = LP / 128, NU = 16 * NQB;
    unsigned* ctr = (unsigned*)(c.ws + OFF_CTL) + 8192 + 64 * l;
    volatile unsigned* slot = (volatile unsigned*)(c.lds + MISC_OFF) + 4;
    for (;;) {
        __syncthreads();
        if (c.tid == 0) *slot = atomicAdd(ctr, 1u);
        __syncthreads();
        const int u = (int)*slot;
        if (u >= NU) break;
        const int bh = u & 15, qb = NQB - 1 - (u >> 4); attn_unit(c, bh, qb, Q, K, V, (bf16*)(c.ws + OFF_OF), FC, qkb2, P.in[5] + l * 64, P.in[6] + l * 64);
    }
}

__device__ __forceinline__ void phase_fixup(const Params& P, int l, const Ctx& c) {
    bf16* ACT = (bf16*)(c.ws + OFF_RW); const bf16* HALO = (const bf16*)(c.ws + OFF_Q);
    const float* cw = P.in[24] + (size_t)l * 3 * NUP;
    const int total = (M / 64) * 2 * DFF;
    for (int idx = c.bid * NTHR + c.tid; idx < total; idx += c.G * NTHR) {
        const int rr = idx / DFF, ch = idx - rr * DFF, q64 = rr >> 1, e = rr & 1, row = q64 * 64 + e;
        const int t = row % LP;
        int s0, s1, s2;
        if (e == 0) { s0 = q64 * 4 + 2; s1 = (q64 - 1) * 4 + 1; s2 = (q64 - 1) * 4 + 0; } else { s0 = q64 * 4 + 3; s1 = q64 * 4 + 2; s2 = (q64 - 1) * 4 + 1; }
        float uc[2];
#pragma unroll
        for (int bj = 0; bj < 2; ++bj) { const int col = bj * DFF + ch;
            const float u0 = bf2f(HALO[(size_t)s0 * NUP + col]);
            const float u1 = (t >= 1) ? bf2f(HALO[(size_t)s1 * NUP + col]) : 0.f;
            const float u2 = (t >= 2) ? bf2f(HALO[(size_t)s2 * NUP + col]) : 0.f;
            uc[bj] = cw[col] * u2 + cw[NUP + col] * u1 + cw[2 * NUP + col] * u0; }
        ACT[(size_t)row * DFF + ch] = (bf16)f2bf(uc[0] * sigmoidf_(uc[0]) * uc[1]);
    }
}

#define OPQ_S(x) asm volatile("" : "+s"(x))
#define OPQ_V(x) asm volatile("" : "+v"(x))
#define PHASE_BEGIN() do { int t_ = threadIdx.x; OPQ_V(t_); c.tid = t_; c.lane = t_ & 63; c.wave = __builtin_amdgcn_readfirstlane(t_ >> 6); int b_ = blockIdx.x; OPQ_S(b_); c.bid = b_; \
    size_t z_ = 0; OPQ_S(z_); unsigned char* w_ = P.ws + z_;   c.ws = w_; ws = w_; l = lc; OPQ_S(l); WT = (pg8::bf16_t*)(ws + OFF_WT); HN = (pg8::bf16_t*)(ws + OFF_HN); } while (0)
__global__ void __launch_bounds__(NTHR, 2) mega(Params P) {
    extern __shared__ __attribute__((aligned(16))) unsigned char lds[];
    Ctx c; c.G = gridDim.x; c.lds = lds;
    volatile LAS unsigned* MISC = (volatile LAS unsigned*)((LAS unsigned char*)lds + MISC_OFF);
    if (threadIdx.x < 16) MISC[threadIdx.x] = 0u;
    __syncthreads();
    (void)xcd_barrier_post((unsigned*)(P.ws + OFF_CTL) + 1024, MISC + 8);
#define SEAM() do { XcdBarrier xb_; xb_.bar = (unsigned*)(P.ws + OFF_CTL) + 1024; xb_.x = xb_xcc_id(); xb_.st = (volatile LAS unsigned*)((LAS unsigned char*)lds + MISC_OFF) + 8; xcd_barrier(xb_); } while (0)
    PG8_LAS unsigned char* ldsl = (PG8_LAS unsigned char*)lds;
    unsigned char* ws; pg8::bf16_t* WT; pg8::bf16_t* HN; int l;
#pragma unroll 1
    for (int lc = 0; lc < DEPTH; ++lc) {
        PHASE_BEGIN();
        convert_weights(P, l, c);
        phase_norm<true>(P, l, c);
        if (lc == 0) cg::this_grid().sync(); else SEAM();
        PHASE_BEGIN();
        phase_fcum(P, c);
        { pg8::Gemm g{HN, WT + WT_IN, M, N1, 1024, 1024}; pg8::StaticOrder S; S.init(M, N1, c.G, c.bid);
          pg8::EpiRoute E{ws};
          pg8::gemm_phase<pg8::EpiRoute, pg8::StaticOrder, true, true>(ldsl, g, S, E); }
        SEAM();
        PHASE_BEGIN();
        for (int rep_ = 0; rep_ < REP_PREP; ++rep_) phase_rwkv_prep(P, l, c);
        SEAM();
        PHASE_BEGIN();
        if (c.bid < 16) { scan_chunked(P, c, c.bid); __syncthreads(); PHASE_BEGIN(); }
        phase_attn(P, l, c, 16);
#if REP_P3 > 1
        __syncthreads(); PHASE_BEGIN();
        if (c.bid < 16) scan_chunked(P, c, c.bid); else phase_attn(P, l, c, 16);
#endif
        SEAM();
        PHASE_BEGIN();
        phase_gn(P, l, c);
        for (int rep_ = 0; rep_ < REP_SYNC; ++rep_) SEAM();
        SEAM();
        PHASE_BEGIN();
        { pg8::bf16_t* MG = (pg8::bf16_t*)(ws + OFF_K); const pg8::bf16_t* GT = (const pg8::bf16_t*)(ws + OFF_GT); const float* gb = P.in[21] + l * NGT;
          pg8::StaticOrder S; S.init(M, 1024, c.G, c.bid);
          { pg8::Gemm g{(const pg8::bf16_t*)(ws + OFF_OF), WT + WT_BF, M, 1024, 512, 512}; pg8::EpiGate<0> E{MG, GT, gb};
            pg8::gemm_phase<pg8::EpiGate<0>, pg8::StaticOrder, true, true>(ldsl, g, S, E); }
          __syncthreads();
          PHASE_BEGIN();
          MG = (pg8::bf16_t*)(ws + OFF_K); GT = (const pg8::bf16_t*)(ws + OFF_GT); gb = P.in[21] + l * NGT; S.init(M, 1024, c.G, c.bid);
          { pg8::Gemm g{(const pg8::bf16_t*)(ws + OFF_RW + (size_t)M * 512 * 4), WT + WT_BR, M, 1024, 512, 512}; pg8::EpiGate<1> E{MG, GT, gb};
            pg8::gemm_phase<pg8::EpiGate<1>, pg8::StaticOrder, true, true>(ldsl, g, S, E); } }
        SEAM();
        PHASE_BEGIN();
#pragma unroll 1
        for (int pass = 0; pass < 2; ++pass) {
            if (pass) { __syncthreads(); PHASE_BEGIN(); }
            const int sl = pass ? (c.bid >> 2) : 0;
            pg8::Gemm g{(const pg8::bf16_t*)(ws + OFF_K) + sl * 256, WT + WT_O + sl * 256, M, 1024, pass ? 256 : 1024, 1024};
            pg8::OneUnit S; S.so.init(MMAIN, 1024, c.G, c.bid); S.mode = pass; S.pm = MMAIN / 256; S.pn = c.bid & 3; S.active = sl < 4;
            pg8::EpiResid E{(float*)(ws + OFF_H), nullptr, pass};
            pg8::gemm_phase<pg8::EpiResid, pg8::OneUnit, true, true>(ldsl, g, S, E);
        }
        SEAM();
        PHASE_BEGIN();
        phase_norm<false>(P, l, c);
        SEAM();
        PHASE_BEGIN();
        { pg8::Gemm g{HN, WT + WT_UP, M, NUP, 1024, 1024}; pg8::StaticOrder S; S.init(M, NUP, c.G, c.bid);
          pg8::EpiUp E{(pg8::bf16_t*)(ws + OFF_RW), (pg8::bf16_t*)(ws + OFF_Q), P.in[24] + (size_t)l * 3 * NUP};
          pg8::gemm_phase<pg8::EpiUp, pg8::StaticOrder, true, true>(ldsl, g, S, E); }
        SEAM();
        PHASE_BEGIN();
        phase_fixup(P, l, c);
        SEAM();
        PHASE_BEGIN();
#pragma unroll 1
        for (int pass = 0; pass < 2; ++pass) {
            if (pass) { __syncthreads(); PHASE_BEGIN(); }
            const int sl = pass ? (c.bid >> 2) : 0;
            const int ko = (sl < 2) ? sl * 768 : 1536 + (sl - 2) * 640, kl = (sl < 2) ? 768 : 640;
            pg8::Gemm g{(const pg8::bf16_t*)(ws + OFF_RW) + (pass ? ko : 0), WT + WT_DN + (pass ? ko : 0), M, 1024, pass ? kl : DFF, DFF};
            pg8::OneUnit S; S.so.init(MMAIN, 1024, c.G, c.bid); S.mode = pass; S.pm = MMAIN / 256; S.pn = c.bid & 3; S.active = sl < 4;
            pg8::EpiResid E{(float*)(ws + OFF_H), (l == DEPTH - 1 && !pass) ? P.out : nullptr, pass};
            pg8::gemm_phase<pg8::EpiResid, pg8::OneUnit, true, true>(ldsl, g, S, E);
        }
        SEAM();
        if (l == DEPTH - 1) {
            PHASE_BEGIN();
            const float* H = (const float*)(ws + OFF_H);
            for (int idx = c.bid * NTHR + c.tid; idx < (NMETA + SEQ - (MMAIN - LP)) * (DM / 4); idx += c.G * NTHR) {
                const int r = idx / (DM / 4), q4 = idx - r * (DM / 4), t = (MMAIN - LP) + r;
                *(f32x4*)(P.out + ((size_t)SEQ + (t - NMETA)) * DM + 4 * q4) = *(const f32x4*)(H + (size_t)(LP + t) * DM + 4 * q4);
            }
        }
    }
}

extern "C" void kernel_launch(void* const* d_in, const int* in_sizes, int n_in, void* d_out, int out_size, void* d_ws, size_t ws_size, hipStream_t stream) {
    static int grid = 0;
    if (grid == 0) {
        if (n_in != 26 || out_size != NB * SEQ * DM || ws_size < WS_NEED) { fprintf(stderr, "kernel_launch: unexpected shapes (n_in %d out %d ws %zu need %zu)\n", n_in, out_size, ws_size, (size_t)WS_NEED); grid = -1; return; }
        int dev = 0, cus = 0, per_cu = 0;
        if (hipGetDevice(&dev) != hipSuccess || hipDeviceGetAttribute(&cus, hipDeviceAttributeMultiprocessorCount, dev) != hipSuccess) { grid = -1; return; }
        if (hipFuncSetAttribute((const void*)mega, hipFuncAttributeMaxDynamicSharedMemorySize, LDS_BYTES) != hipSuccess) { fprintf(stderr, "kernel_launch: hipFuncSetAttribute failed\n"); grid = -1; return; }
        if (hipOccupancyMaxActiveBlocksPerMultiprocessor(&per_cu, (const void*)mega, NTHR, LDS_BYTES) != hipSuccess || per_cu < 1) { fprintf(stderr, "kernel_launch: occupancy query says %d\n", per_cu); per_cu = 1; }
        (void)hipGetLastError();
        grid = cus;
    }
    if (grid < 0) return;
    if (hipMemsetAsync((char*)d_ws + OFF_CTL, 0, 65536, stream) != hipSuccess) { fprintf(stderr, "kernel_launch: memset failed\n"); return; }
    Params p{};
    for (int i = 0; i < 26; ++i) p.in[i] = (const float*)d_in[i];
    p.out = (float*)d_out; p.ws = (unsigned char*)d_ws;
    void* args[] = {&p};
    hipError_t e = hipLaunchCooperativeKernel((const void*)mega, dim3(grid), dim3(NTHR), args, LDS_BYTES, stream);
    if (e != hipSuccess) fprintf(stderr, "kernel_launch: cooperative launch failed: %s (grid %d)\n", hipGetErrorString(e), grid);
}
```

```cpp
#include <hip/hip_runtime.h>
#include <hip/hip_cooperative_groups.h>
#include <cstdio>
#include <cstdint>
#include <cmath>
namespace cg = cooperative_groups;
namespace pg8 {
#define PG8_LAS __attribute__((address_space(3)))
typedef unsigned short bf16_t;
typedef short bf16x8 __attribute__((ext_vector_type(8)));
typedef float f32x4 __attribute__((ext_vector_type(4)));
typedef unsigned u32x4 __attribute__((ext_vector_type(4)));
constexpr int BM = 256, BK = 64, HALF = 128, HTB = HALF * BK * 2  , STAGE_BYTES = 8 * HTB, NXCD = 8, WGM = 8;

__host__ __device__ __forceinline__ int lds_byte(int r, int c) { const int st = (r >> 4) * 2 + (c >> 5), rr = r & 15, cc = c & 31, ob = rr * 64 + cc * 2; return st * 1024 + (ob ^ (((ob >> 9) & 1) << 5)); }
__host__ __device__ __forceinline__ void stage_rc(int b, int& R, int& C) { const int st = b / 1024, sb = b % 1024, swz = sb ^ (((sb >> 9) & 1) << 5); R = (st >> 1) * 16 + swz / 64; C = (st & 1) * 32 + (swz % 64) / 2; }
__host__ __device__ __forceinline__ int perm32(int rho) { const int n = rho >> 4, i = rho & 15; return 8 * (i >> 2) + 4 * n + (i & 3); }

struct Unit { int pm, pn; };
struct Gemm { const bf16_t* A; const bf16_t* Bt; int M, N, K, ld; };

struct StaticOrder {
    int nM, nN, nwg, G, c;
    __host__ __device__ void init(int M, int N, int G_, int c_) { nM = M / BM; nN = N / BM; nwg = nM * nN; G = G_; c = c_; }
    __host__ __device__ bool next(int i, Unit& u) const {
        const long L = (long)i * G + c; if (L >= nwg) return false;
        int wgid = (int)L; { const int q = nwg / NXCD, r = nwg % NXCD, xcd = wgid % NXCD, off = wgid / NXCD; wgid = (xcd < r ? xcd * (q + 1) : r * (q + 1) + (xcd - r) * q) + off; }
        const int nig = WGM * nN, gid = wgid / nig, fm = gid * WGM, gsz = (nM - fm) < WGM ? (nM - fm) : WGM;
        u.pm = fm + ((wgid % nig) % gsz); u.pn = (wgid % nig) / gsz; return true;
    }
    __device__ __forceinline__ void a_ready(const Unit&) const {}
    __device__ __forceinline__ void done(const Unit&) const {}
};

__device__ __forceinline__ unsigned cvt_pk_bf16(float lo, float hi) { unsigned r; asm volatile("v_cvt_pk_bf16_f32 %0, %1, %2" : "=v"(r) : "v"(lo), "v"(hi)); return r; }
typedef float f32x2 __attribute__((ext_vector_type(2)));
template <class Epi, class Sched, bool ALIGN_EPI = false, bool SP2 = false>
__device__ __forceinline__ void gemm_phase(PG8_LAS unsigned char* lds, const Gemm g, const Sched& S, const Epi& E) {
    int tid_ = threadIdx.x; asm volatile("" : "+v"(tid_)); const int tid = tid_, wid = __builtin_amdgcn_readfirstlane(tid >> 6), lane = tid & 63, wr = wid >> 2, wc = wid & 3, fr = lane & 15, fq = lane >> 4;
    const int K = g.K, nt = K / BK, LD = g.ld;
    unsigned voffA[2], voffB[2];
#pragma unroll
    for (int i = 0; i < 2; ++i) { int R, C; stage_rc(tid * 16 + i * 8192, R, C); const int Rb = Epi::PERM ? ((R & ~31) + perm32(R & 31)) : R;
        voffA[i] = (unsigned)(R * LD + C) * 2u; voffB[i] = (unsigned)(Rb * LD + C) * 2u; }
    const size_t kstep = (size_t)(BK * 2);
    const size_t hstep = (size_t)HALF * LD * 2;
    const size_t tstep = 2 * hstep;
    const unsigned ldsw = (unsigned)wid * 1024u;
    const int aoff = lds_byte(wr * 64 + fr, fq * 8), boff = lds_byte(wc * 32 + fr, fq * 8);
#define PG8_SA(b, h) (((b) * 2 + (h)) * HTB)
#define PG8_SB(b, h) ((4 + (b) * 2 + (h)) * HTB)
#define PG8_STAGE(bufoff, gbase, voff) do { _Pragma("unroll") for (int _i = 0; _i < 2; ++_i) \
        __builtin_amdgcn_global_load_lds((const unsigned*)((const char*)(gbase) + (voff)[_i]), (PG8_LAS unsigned*)(lds + (bufoff) + ldsw + _i * 8192), 16, 0, 0); } while (0)
#define PG8_LDA(dst, b, h) do { _Pragma("unroll") for (int m = 0; m < 4; ++m) _Pragma("unroll") for (int k = 0; k < 2; ++k) dst[m][k] = *(const PG8_LAS bf16x8*)(lds + PG8_SA(b, h) + aoff + m * 2048 + k * 1024); } while (0)
#define PG8_LDB(dst, b, h) do { _Pragma("unroll") for (int n = 0; n < 2; ++n) _Pragma("unroll") for (int k = 0; k < 2; ++k) dst[n][k] = *(const PG8_LAS bf16x8*)(lds + PG8_SB(b, h) + boff + n * 2048 + k * 1024); } while (0)
#define PG8_MMA(ai, bj, At, Bt) do { __builtin_amdgcn_s_setprio(1); _Pragma("unroll") for (int m = 0; m < 4; ++m) _Pragma("unroll") for (int n = 0; n < 2; ++n) _Pragma("unroll") for (int k = 0; k < 2; ++k) \
        acc[ai][bj][m][n] = __builtin_amdgcn_mfma_f32_16x16x32_bf16(Bt[n][k], At[m][k], acc[ai][bj][m][n], 0, 0, 0); __builtin_amdgcn_s_setprio(0); } while (0)
#define PG8_WAIT_V(n) asm volatile("s_waitcnt vmcnt(" #n ")" ::: "memory")
#define PG8_WAIT_L(n) asm volatile("s_waitcnt lgkmcnt(" #n ")" ::: "memory")
#define PG8_BAR __builtin_amdgcn_s_barrier()
#define PG8_SCHED __builtin_amdgcn_sched_barrier(0)
    Unit cur, nxt; int ui = 0;
    if (!S.next(0, cur)) return;
    f32x4 acc[2][2][4][2];
#pragma unroll
    for (int a = 0; a < 2; ++a)
#pragma unroll
        for (int b = 0; b < 2; ++b)
#pragma unroll
            for (int m = 0; m < 4; ++m)
#pragma unroll
                for (int n = 0; n < 2; ++n) acc[a][b][m][n] = (f32x4){0.f, 0.f, 0.f, 0.f};
    bf16x8 At[4][2], B0[2][2], B1[2][2];
    const char* cA = (const char*)g.A + (size_t)cur.pm * tstep; const char* cB = (const char*)g.Bt + (size_t)cur.pn * tstep;
    S.a_ready(cur);
    if constexpr (SP2) {
        PG8_STAGE(PG8_SB(0, 0), cB, voffB); PG8_STAGE(PG8_SB(0, 1), cB + hstep, voffB); PG8_STAGE(PG8_SA(0, 0), cA, voffA); PG8_STAGE(PG8_SA(0, 1), cA + hstep, voffA);
        if (wr == 1) PG8_BAR;
        PG8_WAIT_V(2); PG8_BAR;
        PG8_STAGE(PG8_SB(1, 0), cB + kstep, voffB); PG8_STAGE(PG8_SA(1, 0), cA + kstep, voffA); PG8_STAGE(PG8_SB(1, 1), cB + hstep + kstep, voffB);
        PG8_WAIT_V(6); PG8_BAR;
    } else {
        PG8_STAGE(PG8_SB(0, 0), cB, voffB); PG8_STAGE(PG8_SA(0, 0), cA, voffA); PG8_STAGE(PG8_SB(0, 1), cB + hstep, voffB); PG8_STAGE(PG8_SA(0, 1), cA + hstep, voffA);
        if (wr == 1) PG8_BAR;
        PG8_WAIT_V(4); PG8_BAR;
        PG8_STAGE(PG8_SB(1, 0), cB + kstep, voffB); PG8_STAGE(PG8_SA(1, 0), cA + kstep, voffA); PG8_STAGE(PG8_SB(1, 1), cB + hstep + kstep, voffB);
        PG8_WAIT_V(6); PG8_BAR;
    }
    for (;;) {
        const bool has_next = S.next(ui + 1, nxt);
        const char* nA = has_next ? (const char*)g.A + (size_t)nxt.pm * tstep : cA; const char* nB = has_next ? (const char*)g.Bt + (size_t)nxt.pn * tstep : cB;
        for (int t = 0; t < nt; t += 2) {
            const bool last = (t == nt - 2);
            const char* a1 = cA + (size_t)(t + 1) * kstep;
            const char* a2 = last ? nA : cA + (size_t)(t + 2) * kstep; const char* b2 = last ? nB : cB + (size_t)(t + 2) * kstep;
            const char* a3 = a2 + kstep; const char* b3 = b2 + kstep;
            if (last && has_next) S.a_ready(nxt);
            if constexpr (SP2) {
            PG8_LDB(B0, 0, 0); PG8_LDB(B1, 0, 1); PG8_SCHED; PG8_LDA(At, 0, 0); PG8_STAGE(PG8_SA(1, 1), a1 + hstep, voffA);
            PG8_WAIT_V(8); PG8_WAIT_L(0); PG8_BAR; PG8_MMA(0, 0, At, B0); PG8_MMA(0, 1, At, B1); PG8_BAR; PG8_SCHED;
            PG8_LDA(At, 0, 1); PG8_STAGE(PG8_SB(0, 0), b2, voffB); PG8_STAGE(PG8_SB(0, 1), b2 + hstep, voffB); PG8_STAGE(PG8_SA(0, 0), a2, voffA);
            PG8_WAIT_V(8); PG8_WAIT_L(0); PG8_BAR; PG8_MMA(1, 0, At, B0); PG8_MMA(1, 1, At, B1); PG8_BAR; PG8_SCHED;
            PG8_LDB(B0, 1, 0); PG8_LDB(B1, 1, 1); PG8_SCHED; PG8_LDA(At, 1, 0); PG8_STAGE(PG8_SA(0, 1), a2 + hstep, voffA);
            PG8_WAIT_V(8); PG8_WAIT_L(0); PG8_BAR; PG8_MMA(0, 0, At, B0); PG8_MMA(0, 1, At, B1); PG8_BAR; PG8_SCHED;
            PG8_LDA(At, 1, 1); PG8_STAGE(PG8_SB(1, 0), b3, voffB); PG8_STAGE(PG8_SB(1, 1), b3 + hstep, voffB); PG8_STAGE(PG8_SA(1, 0), a3, voffA);
            PG8_WAIT_V(8); PG8_WAIT_L(0); PG8_BAR; PG8_MMA(1, 0, At, B0); PG8_MMA(1, 1, At, B1); PG8_BAR; PG8_SCHED;
            } else {
            PG8_LDB(B0, 0, 0); PG8_SCHED; PG8_LDA(At, 0, 0); PG8_STAGE(PG8_SA(1, 1), a1 + hstep, voffA);
            PG8_WAIT_L(8); PG8_BAR; PG8_WAIT_L(0); PG8_MMA(0, 0, At, B0); PG8_BAR; PG8_SCHED;
            PG8_LDB(B1, 0, 1); PG8_STAGE(PG8_SB(0, 0), b2, voffB);
            PG8_BAR; PG8_WAIT_L(0); PG8_MMA(0, 1, At, B1); PG8_BAR;
            PG8_LDA(At, 0, 1); PG8_STAGE(PG8_SA(0, 0), a2, voffA);
            PG8_BAR; PG8_WAIT_L(0); PG8_MMA(1, 0, At, B0); PG8_BAR; PG8_SCHED;
            PG8_STAGE(PG8_SB(0, 1), b2 + hstep, voffB);
            PG8_WAIT_V(6); PG8_BAR; PG8_MMA(1, 1, At, B1); PG8_BAR;
            PG8_LDB(B0, 1, 0); PG8_SCHED; PG8_LDA(At, 1, 0); PG8_STAGE(PG8_SA(0, 1), a2 + hstep, voffA);
            PG8_WAIT_L(8); PG8_BAR; PG8_WAIT_L(0); PG8_MMA(0, 0, At, B0); PG8_BAR; PG8_SCHED;
            PG8_LDB(B1, 1, 1); PG8_STAGE(PG8_SB(1, 0), b3, voffB);
            PG8_BAR; PG8_WAIT_L(0); PG8_MMA(0, 1, At, B1); PG8_BAR;
            PG8_LDA(At, 1, 1); PG8_STAGE(PG8_SA(1, 0), a3, voffA);
            PG8_BAR; PG8_WAIT_L(0); PG8_MMA(1, 0, At, B0); PG8_BAR; PG8_SCHED;
            PG8_STAGE(PG8_SB(1, 1), b3 + hstep, voffB);
            PG8_WAIT_V(6); PG8_BAR; PG8_MMA(1, 1, At, B1); PG8_BAR;
            }
        }
        if constexpr (ALIGN_EPI) { if (wr == 0) PG8_BAR; }
        if constexpr (!Epi::AFTER_DRAIN) { E(acc, cur, wr, wc, fr, fq); S.done(cur); }
        if (!has_next) break;
#pragma unroll
        for (int a = 0; a < 2; ++a)
#pragma unroll
            for (int b = 0; b < 2; ++b)
#pragma unroll
                for (int m = 0; m < 4; ++m)
#pragma unroll
                    for (int n = 0; n < 2; ++n) acc[a][b][m][n] = (f32x4){0.f, 0.f, 0.f, 0.f};
        cur = nxt; cA = nA; cB = nB; ++ui;
        if constexpr (ALIGN_EPI) { if (wr == 1) PG8_BAR; }
    }
    PG8_WAIT_V(0);
    if constexpr (!ALIGN_EPI) { if (wr == 0) PG8_BAR; }
    PG8_BAR;
    if constexpr (Epi::AFTER_DRAIN) { E.fused(acc, cur, wr, wc, fr, fq, lds, wid, lane); S.done(cur); }
#undef PG8_SA
#undef PG8_SB
#undef PG8_STAGE
#undef PG8_LDA
#undef PG8_LDB
#undef PG8_MMA
#undef PG8_WAIT_V
#undef PG8_WAIT_L
#undef PG8_BAR
#undef PG8_SCHED
}
}
#define GAS __attribute__((address_space(1)))
#define LAS __attribute__((address_space(3)))
typedef GAS unsigned gu32;
typedef GAS unsigned long long gu64;
#define RLX_AGENT __ATOMIC_RELAXED, __HIP_MEMORY_SCOPE_AGENT
#define LDS_WAIT() asm volatile("s_waitcnt lgkmcnt(0)" ::: "memory")
#define VM_WAIT() asm volatile("s_waitcnt vmcnt(0)" ::: "memory")
__device__ __forceinline__ unsigned long long rt() { return __builtin_amdgcn_s_memrealtime(); }
#define XB_TMO      128
#define XB_XCNT(j)  (256  + 64 * (j))
#define XB_XSUB(j)  (1280 + 64 * (j))
#define XB_XGEN(j)  (2304 + 64 * (j))
#define XB_TOP      3328
#define XB_TOPGEN   3392
#define XCD_BAR_WORDS 3456
#define XB_SPIN_CAP (1u << 18)

__device__ __forceinline__ unsigned xb_ld(unsigned* p)              { return __hip_atomic_load(p, __ATOMIC_RELAXED, __HIP_MEMORY_SCOPE_AGENT); }
__device__ __forceinline__ unsigned xb_add(unsigned* p, unsigned v) { return __hip_atomic_fetch_add(p, v, __ATOMIC_RELAXED, __HIP_MEMORY_SCOPE_AGENT); }
__device__ __forceinline__ unsigned xb_xcc_id() { return (unsigned)__builtin_amdgcn_s_getreg((3 << 11) | 20) & 0xFu; }
#define XB_SPIN(cond, bar) do { unsigned _sp = 0; while (cond) { __builtin_amdgcn_s_sleep(1); \
    if ((++_sp & 255u) == 0u) { if (xb_ld(&(bar)[XB_TMO])) break; if (_sp > XB_SPIN_CAP) { atomicAdd(&(bar)[XB_TMO], 1u); break; } } } } while (0)

struct XcdBarrier {
    unsigned* bar; unsigned x;
    volatile LAS unsigned* st;
};

__device__ __forceinline__ XcdBarrier xcd_barrier_post(unsigned* bar, volatile LAS unsigned* st) {
    XcdBarrier b; b.bar = bar; b.x = xb_xcc_id(); b.st = st;
    if (threadIdx.x == 0) (void)xb_add(&bar[XB_XCNT(b.x)], 1u);
    return b;
}
__device__ __forceinline__ void xcd_barrier_complete(unsigned* bar, unsigned x, unsigned& nloc, unsigned& nx) {
    const unsigned G = gridDim.x * gridDim.y * gridDim.z;
    unsigned sum, cnt, mine, sp = 0u;
    for (;;) {
        sum = 0u; cnt = 0u; mine = 0u;
#pragma unroll
        for (unsigned j = 0; j < 16; ++j) { const unsigned c = xb_ld(&bar[XB_XCNT(j)]); sum += c; cnt += (c > 0u) ? 1u : 0u; mine = (j == x) ? c : mine; }
        if (sum == G) break;
        __builtin_amdgcn_s_sleep(1);
        if ((++sp & 255u) == 0u) { if (xb_ld(&bar[XB_TMO])) break; if (sp > XB_SPIN_CAP) { atomicAdd(&bar[XB_TMO], 1u); break; } }
    }
    nloc = mine > 0u ? mine : 1u; nx = cnt > 0u ? cnt : 1u;
}

__device__ __forceinline__ void xcd_barrier(const XcdBarrier& b) {
    asm volatile("s_waitcnt vmcnt(0)" ::: "memory");
    __syncthreads();
    if (threadIdx.x == 0) {
        unsigned* bar = b.bar;
        __builtin_amdgcn_s_waitcnt(0);
        unsigned nloc = b.st[0], nx = b.st[1];
        if (nloc == 0u) { xcd_barrier_complete(bar, b.x, nloc, nx); b.st[0] = nloc; b.st[1] = nx; }
        const unsigned old = xb_add(&bar[XB_XSUB(b.x)], 1u);
        const unsigned gen = old / nloc;
        if (old + 1u == (gen + 1u) * nloc) {
            __builtin_amdgcn_fence(__ATOMIC_RELEASE, "agent");
            asm volatile("s_waitcnt vmcnt(0)" ::: "memory");
            const unsigned og = xb_add(&bar[XB_TOP], 1u);
            const unsigned tg = og / nx;
            if (og + 1u == (tg + 1u) * nx) xb_add(&bar[XB_TOPGEN], 1u);
            else XB_SPIN(xb_ld(&bar[XB_TOPGEN]) == tg, bar);
            __builtin_amdgcn_fence(__ATOMIC_ACQUIRE, "agent");
            xb_add(&bar[XB_XGEN(b.x)], 1u);
            asm volatile("s_waitcnt vmcnt(0)" ::: "memory");
        } else {
            XB_SPIN(xb_ld(&bar[XB_XGEN(b.x)]) == gen, bar);
            __builtin_amdgcn_fence(__ATOMIC_ACQUIRE, "agent");
            asm volatile("s_waitcnt vmcnt(0)" ::: "memory");
        }
    }
    __syncthreads();
}


constexpr int NB = 2, SEQ = 8192, DM = 1024, DEPTH = 4, NMETA = 16, LP = 8320, M = NB * LP;
constexpr int N_IN = 5384, N1 = 5376, NRW = 1792, NGT = 2048, DFF = 2816, NUP = 5632;
constexpr float LOG2E = 1.4426950408889634f;
constexpr float QSCALE = 0.125f * LOG2E;
constexpr float THR2 = 30.0f * LOG2E;
constexpr int NWAVES = 8, NTHR = 512, MMAIN = 16384;
constexpr int LDS_BYTES = 147456, MISC_OFF = 147456 - 128;

typedef unsigned short bf16;
typedef float f32x4 __attribute__((ext_vector_type(4)));
typedef unsigned u32x4 __attribute__((ext_vector_type(4)));
typedef unsigned u32x2 __attribute__((ext_vector_type(2)));
typedef short bf16x8 __attribute__((ext_vector_type(8)));

constexpr size_t SZ_H = (size_t)M * DM * 4, SZ_X512 = (size_t)M * 512 * 2;
constexpr size_t OFF_CTL = 0, OFF_H = 1u << 20, OFF_WT = OFF_H + SZ_H;
constexpr size_t WT_IN = 0, WT_BF = WT_IN + (size_t)N1 * 1024, WT_BR = WT_BF + 1024 * 512, WT_O = WT_BR + 1024 * 512,
                 WT_UP = WT_O + 1024 * 1024, WT_DN = WT_UP + (size_t)NUP * 1024, WT_LW = WT_DN + (size_t)1024 * DFF, WT_LA = WT_LW + 512 * 64, WT_LG = WT_LA + 512 * 64, WT_END = WT_LG + 512 * 128;
constexpr size_t OFF_HN = OFF_WT + WT_END * 2;
constexpr size_t OFF_Q = OFF_HN + 2 * SZ_X512, OFF_K = OFF_Q + SZ_X512, OFF_V = OFF_K + SZ_X512;
constexpr size_t OFF_RW = OFF_V + SZ_X512, OFF_GT = OFF_RW + (size_t)M * NRW * 2, OFF_MISC = OFF_GT + (size_t)M * NGT * 2;
constexpr size_t OFF_T0 = OFF_MISC + 2 * 16 * LP * 4, OFF_OF = OFF_T0 + 2 * SZ_X512, OFF_TAIL = OFF_OF + SZ_X512, WS_NEED = OFF_TAIL + 256 * 1024 * 2;
static_assert(OFF_HN % 256 == 0 && OFF_RW % 256 == 0 && OFF_T0 % 256 == 0, "alignment");

struct Params { const float* in[26]; float* out; unsigned char* ws; };
struct Ctx { int tid, lane, wave, bid, G; unsigned char* lds; unsigned char* ws; };

__device__ __forceinline__ float bf2f(unsigned b) { return __uint_as_float(b << 16); }
__device__ __forceinline__ float bflo(unsigned w) { return __uint_as_float(w << 16); }
__device__ __forceinline__ float bfhi(unsigned w) { return __uint_as_float(w & 0xffff0000u); }
typedef float f32x2_t_ __attribute__((ext_vector_type(2))); typedef __bf16 bf16x2_t_ __attribute__((ext_vector_type(2)));
__device__ __forceinline__ unsigned pk2(float lo, float hi) { const f32x2_t_ v = {lo, hi}; const bf16x2_t_ r = __builtin_convertvector(v, bf16x2_t_); return __builtin_bit_cast(unsigned, r); }
__device__ __forceinline__ unsigned f2bf(float f) { return pk2(f, 0.f) & 0xffffu; }
__device__ __forceinline__ float wave_sum(float v) {
#pragma unroll
    for (int o = 1; o < 64; o <<= 1) v += __shfl_xor(v, o);
    return v;
}
__device__ __forceinline__ float sigmoidf_(float x) { return __builtin_amdgcn_rcpf(1.f + __expf(-x)); }
template <int CTRL> __device__ __forceinline__ float dppf(float old, float x) {
    return __int_as_float(__builtin_amdgcn_update_dpp(__float_as_int(old), __float_as_int(x), CTRL, 0xf, 0xf, false));
}
__device__ __forceinline__ float allreduce16(float x) {
    x += dppf<0x121>(0.f, x); x += dppf<0x122>(0.f, x); x += dppf<0x124>(0.f, x); x += dppf<0x128>(0.f, x); return x;
}

namespace pg8 {
struct EpiRoute {
    static constexpr bool PERM = true, AFTER_DRAIN = false;
    unsigned char* ws;
    __device__ __forceinline__ void operator()(const f32x4 (&acc)[2][2][4][2], const Unit& u, int wr, int wc, int fr, int fq) const {
        const int pn = u.pn; size_t off; int ldc, colt;
        if (pn < 6) { off = OFF_Q + (size_t)(pn >> 1) * SZ_X512; ldc = 512; colt = (pn & 1) * 256; }
        else if (pn < 13) { off = OFF_RW; ldc = NRW; colt = (pn - 6) * 256; }
        else { off = OFF_GT; ldc = NGT; colt = (pn - 13) * 256; }
        bf16_t* base = (bf16_t*)(ws + off);
        const int row0 = u.pm * BM + wr * 64 + fr, col0 = colt + wc * 32 + 8 * fq;
#pragma unroll
        for (int ai = 0; ai < 2; ++ai)
#pragma unroll
            for (int m = 0; m < 4; ++m) { bf16_t* rowp = base + (size_t)(row0 + ai * HALF + m * 16) * ldc + col0;
#pragma unroll
                for (int bj = 0; bj < 2; ++bj) { const f32x4 v0 = acc[ai][bj][m][0], v1 = acc[ai][bj][m][1];
                    u32x4 w; w.x = cvt_pk_bf16(v0[0], v0[1]); w.y = cvt_pk_bf16(v0[2], v0[3]); w.z = cvt_pk_bf16(v1[0], v1[1]); w.w = cvt_pk_bf16(v1[2], v1[3]);
                    *(u32x4*)(rowp + bj * HALF) = w; } }
    }
};
struct EpiGateR {
    static constexpr bool PERM = true, AFTER_DRAIN = false;
    bf16_t* O; const bf16_t* GT; const float* gb; int goff, accum;
    __device__ __forceinline__ void operator()(const f32x4 (&acc)[2][2][4][2], const Unit& u, int wr, int wc, int fr, int fq) const {
        const int row0 = u.pm * BM + wr * 64 + fr, col0 = u.pn * BM + wc * 32 + 8 * fq;
#pragma unroll
        for (int bj = 0; bj < 2; ++bj) {
            const int c = col0 + bj * HALF;
            const f32x4 b0 = *(const f32x4*)(gb + goff + c), b1 = *(const f32x4*)(gb + goff + c + 4);
#pragma unroll
            for (int ai = 0; ai < 2; ++ai)
#pragma unroll
                for (int m = 0; m < 4; ++m) {
                    const size_t row = (size_t)(row0 + ai * HALF + m * 16);
                    const u32x4 gw = *(const u32x4*)(GT + row * NGT + goff + c);
                    const f32x4 v0 = acc[ai][bj][m][0], v1 = acc[ai][bj][m][1];
                    float r[8];
                    r[0] = sigmoidf_(bflo(gw.x) + b0[0]) * v0[0]; r[1] = sigmoidf_(bfhi(gw.x) + b0[1]) * v0[1];
                    r[2] = sigmoidf_(bflo(gw.y) + b0[2]) * v0[2]; r[3] = sigmoidf_(bfhi(gw.y) + b0[3]) * v0[3];
                    r[4] = sigmoidf_(bflo(gw.z) + b1[0]) * v1[0]; r[5] = sigmoidf_(bfhi(gw.z) + b1[1]) * v1[1];
                    r[6] = sigmoidf_(bflo(gw.w) + b1[2]) * v1[2]; r[7] = sigmoidf_(bfhi(gw.w) + b1[3]) * v1[3];
                    bf16_t* op = O + row * 1024 + c;
                    if (accum) { const u32x4 ow = *(const u32x4*)op;
                        r[0] += bflo(ow.x); r[1] += bfhi(ow.x); r[2] += bflo(ow.y); r[3] += bfhi(ow.y); r[4] += bflo(ow.z); r[5] += bfhi(ow.z); r[6] += bflo(ow.w); r[7] += bfhi(ow.w); }
                    u32x4 w; w.x = cvt_pk_bf16(r[0], r[1]); w.y = cvt_pk_bf16(r[2], r[3]); w.z = cvt_pk_bf16(r[4], r[5]); w.w = cvt_pk_bf16(r[6], r[7]);
                    *(u32x4*)op = w;
                }
        }
    }
};
struct EpiResid {
    static constexpr bool PERM = false, AFTER_DRAIN = false;
    float* H; float* OUT; int atomic;
    __device__ __forceinline__ void operator()(const f32x4 (&acc)[2][2][4][2], const Unit& u, int wr, int wc, int fr, int fq) const {
        const int row0 = u.pm * BM + wr * 64 + fr, col0 = u.pn * BM + wc * 32 + 4 * fq;
#pragma unroll
        for (int ai = 0; ai < 2; ++ai)
#pragma unroll
            for (int m = 0; m < 4; ++m) {
                const int row = row0 + ai * HALF + m * 16;
                float* hp = H + (size_t)row * DM + col0;
                const int b = row >= LP ? 1 : 0, t = row - b * LP;
                float* op = (OUT && t >= NMETA && t < NMETA + SEQ) ? OUT + ((size_t)b * SEQ + (t - NMETA)) * DM + col0 : nullptr;
#pragma unroll
                for (int bj = 0; bj < 2; ++bj)
#pragma unroll
                    for (int n = 0; n < 2; ++n) { const int co = bj * HALF + n * 16;
                        if (atomic) {
                            if (row < LP + NMETA + SEQ) {
#pragma unroll
                                for (int e = 0; e < 4; ++e) unsafeAtomicAdd(hp + co + e, acc[ai][bj][m][n][e]); }
                        } else {
                            const f32x4 v = *(const f32x4*)(hp + co) + acc[ai][bj][m][n];
                            if (OUT) { if (op) *(f32x4*)(op + co) = v; } else *(f32x4*)(hp + co) = v; } }
            }
    }
};
struct EpiResidAtomic {
    static constexpr bool PERM = false, AFTER_DRAIN = false;
    float* H;
    __device__ __forceinline__ void operator()(const f32x4 (&acc)[2][2][4][2], const Unit& u, int wr, int wc, int fr, int fq) const {
        const int row0 = u.pm * BM + wr * 64 + fr, col0 = u.pn * BM + wc * 32 + 4 * fq;
#pragma unroll
        for (int ai = 0; ai < 2; ++ai)
#pragma unroll
            for (int m = 0; m < 4; ++m) { float* hp = H + (size_t)(row0 + ai * HALF + m * 16) * DM + col0;
#pragma unroll
                for (int bj = 0; bj < 2; ++bj)
#pragma unroll
                    for (int n = 0; n < 2; ++n)
#pragma unroll
                        for (int e = 0; e < 4; ++e) unsafeAtomicAdd(hp + bj * HALF + n * 16 + e, acc[ai][bj][m][n][e]); }
    }
};
struct OneUnit {
    StaticOrder so; int mode, pm, pn; bool active;
    __device__ bool next(int i, Unit& u) const { if (mode == 0) return so.next(i, u); if (i != 0 || !active) return false; u.pm = pm; u.pn = pn; return true; }
    __device__ __forceinline__ void a_ready(const Unit&) const {}
    __device__ __forceinline__ void done(const Unit&) const {}
};
struct EpiUp {
    static constexpr bool PERM = true, AFTER_DRAIN = false;
    bf16_t* ACT; bf16_t* HALO; const float* cw;
    __device__ __forceinline__ void operator()(const f32x4 (&acc)[2][2][4][2], const Unit& u, int wr, int wc, int fr, int fq) const {
        const int chan0 = u.pn * 128 + wc * 32 + 8 * fq;
#pragma unroll
        for (int n = 0; n < 2; ++n) {
            const int ch = chan0 + 4 * n;
            f32x4 w[3][2];
#pragma unroll
            for (int j = 0; j < 3; ++j) { w[j][0] = *(const f32x4*)(cw + j * NUP + ch); w[j][1] = *(const f32x4*)(cw + j * NUP + DFF + ch); }
#pragma unroll
            for (int ai = 0; ai < 2; ++ai) {
                const int rowg = u.pm * BM + ai * HALF + wr * 64;
#pragma unroll
                for (int m = 0; m < 4; ++m) {
                    f32x4 uc[2];
#pragma unroll
                    for (int bj = 0; bj < 2; ++bj) {
                        const f32x4 cur = acc[ai][bj][m][n];
                        f32x4 prv; if (m > 0) prv = acc[ai][bj][m - 1][n]; else prv = (f32x4){0.f, 0.f, 0.f, 0.f};
                        f32x4 p1, p2;
#pragma unroll
                        for (int i = 0; i < 4; ++i) {
                            const float r1 = dppf<0x121>(0.f, prv[i]), r2 = dppf<0x122>(0.f, prv[i]);
                            p1[i] = dppf<0x111>(r1, cur[i]); p2[i] = dppf<0x112>(r2, cur[i]);
                        }
                        uc[bj] = w[0][bj] * p2 + w[1][bj] * p1 + w[2][bj] * cur;
                    }
                    float a[4];
#pragma unroll
                    for (int i = 0; i < 4; ++i) a[i] = uc[0][i] * sigmoidf_(uc[0][i]) * uc[1][i];
                    u32x2 o; o.x = cvt_pk_bf16(a[0], a[1]); o.y = cvt_pk_bf16(a[2], a[3]);
                    *(u32x2*)(ACT + (size_t)(rowg + m * 16 + fr) * DFF + ch) = o;
                    if ((m == 3 && fr >= 14) || (m == 0 && fr < 2)) {
                        const int slot = (rowg >> 6) * 4 + (m == 3 ? fr - 14 : 2 + fr);
#pragma unroll
                        for (int bj = 0; bj < 2; ++bj) { const f32x4 cur = acc[ai][bj][m][n]; u32x2 hw; hw.x = cvt_pk_bf16(cur[0], cur[1]); hw.y = cvt_pk_bf16(cur[2], cur[3]);
                            *(u32x2*)(HALO + (size_t)slot * NUP + bj * DFF + ch) = hw; }
                    }
                }
            }
        }
    }
};
}

#ifndef REP_PREP
#define REP_PREP 1
#endif
#ifndef REP_P3
#define REP_P3 1
#endif
#ifndef REP_SYNC
#define REP_SYNC 0
#endif
#define GLD(T, p) (*(const __attribute__((address_space(1))) T*)(p))
#define GST(T, p) (*(__attribute__((address_space(1))) T*)(p))
#define LDS_BARRIER() do { asm volatile("s_waitcnt lgkmcnt(0)" ::: "memory"); __builtin_amdgcn_s_barrier(); asm volatile("" ::: "memory"); } while (0)
__device__ __forceinline__ void transpose_item(const float* W, int Nsrc, int K, bf16* WT, int dst_row0, int src_col0, int k0, float* scr, int lane) {
#pragma unroll 8
    for (int i = 0; i < 32; ++i) { const int kk = 2 * i + (lane >> 5); scr[kk * 33 + (lane & 31)] = W[(size_t)(k0 + kk) * Nsrc + src_col0 + (lane & 31)]; }
    asm volatile("s_waitcnt lgkmcnt(0)" ::: "memory");
    const int c = lane & 7;
#pragma unroll
    for (int j = 0; j < 4; ++j) { const int n = (lane >> 3) + 8 * j; const float* s = scr + (8 * c) * 33 + n;
        u32x4 o; o.x = pk2(s[0 * 33], s[1 * 33]); o.y = pk2(s[2 * 33], s[3 * 33]); o.z = pk2(s[4 * 33], s[5 * 33]); o.w = pk2(s[6 * 33], s[7 * 33]);
        *(u32x4*)(WT + (size_t)(dst_row0 + n) * K + k0 + 8 * c) = o; }
    asm volatile("s_waitcnt lgkmcnt(0)" ::: "memory");
}
__device__ __forceinline__ void convert_weights(const Params& P, int l, const Ctx& c) {
    bf16* WT = (bf16*)(c.ws + OFF_WT);
    float* scr = (float*)(c.lds + c.wave * 16384);
    const int gw = c.bid * NWAVES + c.wave, NGW = c.G * NWAVES;
    constexpr int I_IN = 16 * 168, I_BF = 8 * 32, I_O = 16 * 32, I_UP = 16 * 176, I_DN = 44 * 32, I_LR = 16, I_LG = 32, I_ALL = I_IN + 2 * I_BF + I_O + I_UP + I_DN + 2 * I_LR + I_LG;
    for (int it = gw; it < I_ALL; it += NGW) {
        int r = it;
        if (r < I_IN) { const int kb = r / 168, n0 = 32 * (r % 168); transpose_item(P.in[4] + (size_t)l * 1024 * N_IN, N_IN, 1024, WT + WT_IN, n0, n0 + (n0 >= 1536 ? 8 : 0), 64 * kb, scr, c.lane); continue; } r -= I_IN;
        if (r < I_BF) { const int kb = r / 32, n0 = 32 * (r % 32); transpose_item(P.in[19] + (size_t)l * 512 * 1024, 1024, 512, WT + WT_BF, n0, n0, 64 * kb, scr, c.lane); continue; } r -= I_BF;
        if (r < I_BF) { const int kb = r / 32, n0 = 32 * (r % 32); transpose_item(P.in[20] + (size_t)l * 512 * 1024, 1024, 512, WT + WT_BR, n0, n0, 64 * kb, scr, c.lane); continue; } r -= I_BF;
        if (r < I_O) { const int kb = r / 32, n0 = 32 * (r % 32); transpose_item(P.in[22] + (size_t)l * 1024 * 1024, 1024, 1024, WT + WT_O, n0, n0, 64 * kb, scr, c.lane); continue; } r -= I_O;
        if (r < I_UP) { const int kb = r / 176, n0 = 32 * (r % 176); const int pn = n0 >> 8, bj = (n0 >> 7) & 1, x = n0 & 127;
            transpose_item(P.in[23] + (size_t)l * 1024 * NUP, NUP, 1024, WT + WT_UP, n0, bj * DFF + 128 * pn + x, 64 * kb, scr, c.lane); continue; } r -= I_UP;
        if (r < I_DN) { const int kb = r / 32, n0 = 32 * (r % 32); transpose_item(P.in[25] + (size_t)l * DFF * 1024, 1024, DFF, WT + WT_DN, n0, n0, 64 * kb, scr, c.lane); continue; } r -= I_DN;
        if (r < I_LR) { transpose_item(P.in[10] + (size_t)l * 64 * 512, 512, 64, WT + WT_LW, 32 * r, 32 * r, 0, scr, c.lane); continue; } r -= I_LR;
        if (r < I_LR) { transpose_item(P.in[12] + (size_t)l * 64 * 512, 512, 64, WT + WT_LA, 32 * r, 32 * r, 0, scr, c.lane); continue; } r -= I_LR;
        { const int kb = r / 16, n0 = 32 * (r % 16); transpose_item(P.in[13] + (size_t)l * 128 * 512, 512, 128, WT + WT_LG, n0, n0, 64 * kb, scr, c.lane); }
    }
}

template <bool FG> __device__ __forceinline__ void phase_norm(const Params& P, int l, const Ctx& c) {
    float* H = (float*)(c.ws + OFF_H); bf16* HN = (bf16*)(c.ws + OFF_HN);
    float* LOGF = (float*)(c.ws + OFF_MISC);
    const float* gain = (FG ? P.in[2] : P.in[3]) + l * DM;
    float* wfs = (float*)c.lds;
    if (FG) {
        __syncthreads();
        const float* win = P.in[4] + (size_t)l * 1024 * N_IN + 1536;
        for (int i = c.tid; i < 8192; i += NTHR) wfs[i] = win[(size_t)(i >> 3) * N_IN + (i & 7)];
        __syncthreads();
    }
    const int gw = c.bid * NWAVES + c.wave, NGW = c.G * NWAVES;
    for (int m = gw; m < M; m += NGW) {
        const int b = m >= LP ? 1 : 0, t = m - b * LP;
        f32x4 v[4];
        if (FG && l == 0) {
            const float* src = (t < NMETA) ? P.in[1] + (size_t)t * DM : P.in[0] + ((size_t)b * SEQ + (t - NMETA)) * DM;
            const bool real = t < NMETA + SEQ;
#pragma unroll
            for (int j = 0; j < 4; ++j) { v[j] = real ? *(const f32x4*)(src + 4 * c.lane + 256 * j) : (f32x4){0.f, 0.f, 0.f, 0.f}; *(f32x4*)(H + (size_t)m * DM + 4 * c.lane + 256 * j) = v[j]; }
        } else {
#pragma unroll
            for (int j = 0; j < 4; ++j) v[j] = *(const f32x4*)(H + (size_t)m * DM + 4 * c.lane + 256 * j);
        }
        float ss = 0.f;
#pragma unroll
        for (int j = 0; j < 4; ++j) ss += (v[j].x * v[j].x + v[j].y * v[j].y) + (v[j].z * v[j].z + v[j].w * v[j].w);
        const float rstd = 1.0f / sqrtf(wave_sum(ss) * (1.f / DM) + 1e-6f);
        float f[8];
#pragma unroll
        for (int q = 0; q < 8; ++q) f[q] = 0.f;
#pragma unroll
        for (int j = 0; j < 4; ++j) {
            const f32x4 g = *(const f32x4*)(gain + 4 * c.lane + 256 * j);
            v[j] = v[j] * rstd * g;
            u32x2 o; o.x = pk2(v[j].x, v[j].y); o.y = pk2(v[j].z, v[j].w);
            *(u32x2*)(HN + (size_t)m * DM + 4 * c.lane + 256 * j) = o;
            if (FG) {
#pragma unroll
                for (int e = 0; e < 4; ++e) { const int k = 4 * c.lane + 256 * j + e; const f32x4 w0 = *(const f32x4*)(wfs + k * 8), w1 = *(const f32x4*)(wfs + k * 8 + 4);
                    const float hv = v[j][e];
                    f[0] += hv * w0.x; f[1] += hv * w0.y; f[2] += hv * w0.z; f[3] += hv * w0.w; f[4] += hv * w1.x; f[5] += hv * w1.y; f[6] += hv * w1.z; f[7] += hv * w1.w; }
            }
        }
        if (FG) {
#pragma unroll
            for (int q = 0; q < 8; ++q) f[q] = wave_sum(f[q]);
            float fv = f[0];
#pragma unroll
            for (int q = 1; q < 8; ++q) fv = (c.lane == q) ? f[q] : fv;
            if (c.lane < 8) { const float x = fv + P.in[7][l * 8 + c.lane]; const float ls = fminf(x, 0.f) - __logf(1.f + __expf(-fabsf(x))); LOGF[(size_t)(b * 8 + c.lane) * LP + t] = ls; }
        }
    }
}

__device__ __forceinline__ void phase_fcum(const Params& P, const Ctx& c) {
    const int s = c.bid - (c.G - 16);
    if (s < 0) return;
    const float* LOGF = (const float*)(c.ws + OFF_MISC) + (size_t)s * LP; float* FC = (float*)(c.ws + OFF_MISC) + 16 * LP + (size_t)s * LP;
    float* wt = (float*)c.lds;
    const int base = c.tid * 17;
    float v[17]; float run = 0.f;
#pragma unroll
    for (int i = 0; i < 17; ++i) { const int idx = base + i; const float x = (idx < LP) ? LOGF[idx] : 0.f; run += x; v[i] = run; }
    float incl = run;
#pragma unroll
    for (int o = 1; o < 64; o <<= 1) { const float t = __shfl_up(incl, o); if (c.lane >= o) incl += t; }
    if (c.lane == 63) wt[c.wave] = incl;
    __syncthreads();
    float off = incl - run;
#pragma unroll
    for (int w2 = 0; w2 < 8; ++w2) off += (w2 < c.wave) ? wt[w2] : 0.f;
#pragma unroll
    for (int i = 0; i < 17; ++i) { const int idx = base + i; if (idx < LP) FC[idx] = (v[i] + off) * LOG2E; }
    __syncthreads();
}

__device__ __forceinline__ void phase_qknorm(const Params& P, int l, const Ctx& c) {
    bf16* Q = (bf16*)(c.ws + OFF_Q); bf16* K = (bf16*)(c.ws + OFF_K);
    const int gw = c.bid * NWAVES + c.wave, NGW = c.G * NWAVES;
    const int d0 = (c.lane & 7) * 8;
    float gq[8], gk[8];
#pragma unroll
    for (int i = 0; i < 8; ++i) { gq[i] = P.in[5][l * 64 + d0 + i] * QSCALE; gk[i] = P.in[6][l * 64 + d0 + i]; }
    for (int m = gw; m < M; m += NGW) {
#pragma unroll
        for (int which = 0; which < 2; ++which) {
            bf16* p = (which ? K : Q) + (size_t)m * 512 + 8 * c.lane;
            const u32x4 w = *(const u32x4*)p;
            float x[8] = {bflo(w.x), bfhi(w.x), bflo(w.y), bfhi(w.y), bflo(w.z), bfhi(w.z), bflo(w.w), bfhi(w.w)};
            float ss = 0.f;
#pragma unroll
            for (int i = 0; i < 8; ++i) ss += x[i] * x[i];
            ss += __shfl_xor(ss, 1); ss += __shfl_xor(ss, 2); ss += __shfl_xor(ss, 4);
            const float rs = 1.0f / sqrtf(ss * (1.f / 64.f) + 1e-6f);
#pragma unroll
            for (int i = 0; i < 8; ++i) x[i] = x[i] * rs * (which ? gk[i] : gq[i]);
            u32x4 o; o.x = pk2(x[0], x[1]); o.y = pk2(x[2], x[3]); o.z = pk2(x[4], x[5]); o.w = pk2(x[6], x[7]);
            *(u32x4*)p = o;
        }
    }
}

constexpr int NCHK = LP / 64;
constexpr int NUNIT = NB * NCHK * 8;
constexpr int UNIT_A = 16384, UNIT_B = 16640;
constexpr int ST = 72, STG = 136;
constexpr int L_F0 = 92160, L_F1 = 108544;
struct RwkvBufs { bf16 *BON, *G; unsigned char *UA, *UB; float* Y; bf16* ORW; };
__device__ __forceinline__ RwkvBufs rwkv_bufs(const Params& P, const Ctx& c) {
    RwkvBufs r; r.BON = (bf16*)(c.ws + OFF_HN); r.G = r.BON + (size_t)M * 512;
    r.UA = c.ws + OFF_T0; r.UB = (unsigned char*)P.out;
    r.Y = (float*)(c.ws + OFF_RW); r.ORW = (bf16*)(c.ws + OFF_RW + (size_t)M * 512 * 4);
    return r;
}
__device__ __forceinline__ void mm_tile(const bf16* A, int sa, const bf16* Bt, int sb, int nks, f32x4 (&acc)[2], int w, int lq, int g) {
    const int mt = w >> 1, nt0 = 2 * (w & 1);
    for (int ks = 0; ks < nks; ++ks) {
        const bf16x8 a = *(const bf16x8*)(A + (16 * mt + lq) * sa + 32 * ks + 8 * g);
#pragma unroll
        for (int q = 0; q < 2; ++q) { const bf16x8 b = *(const bf16x8*)(Bt + (16 * (nt0 + q) + lq) * sb + 32 * ks + 8 * g); acc[q] = __builtin_amdgcn_mfma_f32_16x16x32_bf16(a, b, acc[q], 0, 0, 0); }
    }
}
template <bool SA, bool SB> __device__ __forceinline__ void mm_tile2(const bf16* A, int sa, const bf16* Bt, int sb, int nks, f32x4 (&acc)[2], int w, int lq, int g) {
    const int mt = w >> 1, nt0 = 2 * (w & 1);
    const int ra = 16 * mt + lq, xa = SA ? 8 * ((ra >> 3) & 7) : 0;
    for (int ks = 0; ks < nks; ++ks) {
        const bf16x8 a = *(const bf16x8*)(A + ra * sa + ((32 * ks + 8 * g) ^ xa));
#pragma unroll
        for (int q = 0; q < 2; ++q) { const int rb = 16 * (nt0 + q) + lq, xb = SB ? 8 * ((rb >> 3) & 7) : 0;
            const bf16x8 bb = *(const bf16x8*)(Bt + rb * sb + ((32 * ks + 8 * g) ^ xb)); acc[q] = __builtin_amdgcn_mfma_f32_16x16x32_bf16(a, bb, acc[q], 0, 0, 0); }
    }
}
#define ZACC(a) do { a[0] = (f32x4){0.f, 0.f, 0.f, 0.f}; a[1] = (f32x4){0.f, 0.f, 0.f, 0.f}; } while (0)
__device__ __forceinline__ int permk(int k) { return 32 * (k >> 5) + 8 * ((k & 15) >> 2) + 4 * ((k >> 4) & 1) + (k & 3); }
__device__ __forceinline__ int swz(int row, int col) { return row * 128 + ((((col >> 3) ^ (row >> 1)) & 7) << 4) + (col & 7) * 2; }

__device__ __forceinline__ void rwkv_prep_unit(const Params& P, int l, const Ctx& c, int u, const RwkvBufs& B, const float (&pw0)[8], const float (&pa0)[8], const float (&pkk)[8], const float (&pka)[8], const float (&prk)[8]) {
    const int h = u & 7, bc = u >> 3, b = bc / NCHK, ch = bc - b * NCHK;
    const size_t m0 = (size_t)b * LP + ch * 64;
    int tid_ = c.tid; asm volatile("" : "+v"(tid_));
    const int tid = tid_, lane = tid & 63, w = c.wave, lq = lane & 15, g = lane >> 4;
    const int t = tid >> 3, cg = tid & 7, c0 = cg * 8, jb = h * 64 + c0;
    unsigned char* L = c.lds;
    bf16* A0 = (bf16*)L; bf16* A1 = A0 + 4608; bf16* A2 = A1 + 4608; bf16* A3 = A2 + 4608; bf16* A4 = A3 + 4608; bf16* A5 = A4 + 4608; bf16* A6 = A5 + 4608;
    bf16* A7 = A6 + 4608; bf16* A8 = A7 + 4608; bf16* A9 = A8 + 4608;
    float* F0 = (float*)(L + L_F0); float* F1 = (float*)(L + L_F1);
    const bf16* RW = (const bf16*)(c.ws + OFF_RW);
    const bf16* WT = (const bf16*)(c.ws + OFF_WT);
    const float* mu = P.in[8] + l * NRW;
    const bool first = (ch == 0 && t == 0);
    const bf16* cur = RW + (m0 + t) * NRW; const bf16* prv = cur - NRW;
    float zr[8], zk[8], zv[8];
#pragma unroll
    for (int s = 0; s < 3; ++s) {
        const u32x4 cw = *(const u32x4*)(cur + s * 512 + jb); u32x4 pw = (u32x4){0u, 0u, 0u, 0u}; if (!first) pw = *(const u32x4*)(prv + s * 512 + jb);
        const float cv[8] = {bflo(cw.x), bfhi(cw.x), bflo(cw.y), bfhi(cw.y), bflo(cw.z), bfhi(cw.z), bflo(cw.w), bfhi(cw.w)};
        const float pv[8] = {bflo(pw.x), bfhi(pw.x), bflo(pw.y), bfhi(pw.y), bflo(pw.z), bfhi(pw.z), bflo(pw.w), bfhi(pw.w)};
#pragma unroll
        for (int i = 0; i < 8; ++i) { const float z = cv[i] + mu[s * 512 + jb + i] * (pv[i] - cv[i]); if (s == 0) zr[i] = z; else if (s == 1) zk[i] = z; else zv[i] = z; }
    }
#pragma unroll
    for (int q4 = 0; q4 < 4; ++q4) {
        const int col = cg * 32 + q4 * 8;
        const u32x4 cw = *(const u32x4*)(cur + 1536 + col); u32x4 pw = (u32x4){0u, 0u, 0u, 0u}; if (!first) pw = *(const u32x4*)(prv + 1536 + col);
        const float cv[8] = {bflo(cw.x), bfhi(cw.x), bflo(cw.y), bfhi(cw.y), bflo(cw.z), bfhi(cw.z), bflo(cw.w), bfhi(cw.w)};
        const float pv[8] = {bflo(pw.x), bfhi(pw.x), bflo(pw.y), bfhi(pw.y), bflo(pw.z), bfhi(pw.z), bflo(pw.w), bfhi(pw.w)};
        float z[8];
#pragma unroll
        for (int i = 0; i < 8; ++i) { z[i] = cv[i] + mu[1536 + col + i] * (pv[i] - cv[i]); if (col < 64) z[i] = 1.f - 2.f / (1.f + __expf(2.f * z[i])); else if (col >= 128) z[i] = sigmoidf_(z[i]); }
        u32x4 o; o.x = pk2(z[0], z[1]); o.y = pk2(z[2], z[3]); o.z = pk2(z[4], z[5]); o.w = pk2(z[6], z[7]);
        bf16* dst = (col < 64) ? A0 + t * ST + col : (col < 128 ? A1 + t * ST + (col - 64) : A2 + t * STG + (col - 128));
        *(u32x4*)dst = o;
    }
    { const int row = tid >> 3, chk = tid & 7;
      *(u32x4*)(A4 + row * ST + chk * 8) = *(const u32x4*)(WT + WT_LW + (size_t)(h * 64 + row) * 64 + chk * 8);
      *(u32x4*)(A5 + row * ST + chk * 8) = *(const u32x4*)(WT + WT_LA + (size_t)(h * 64 + row) * 64 + chk * 8);
#pragma unroll
      for (int i = 0; i < 2; ++i) { const int idx = tid + 512 * i, r2 = idx >> 4, c2 = idx & 15;
          *(u32x4*)((bf16*)F1 + r2 * STG + c2 * 8) = *(const u32x4*)(WT + WT_LG + (size_t)(h * 64 + r2) * 128 + c2 * 8); } }
    LDS_BARRIER();
    { f32x4 aw[2], aa[2], ag[2]; ZACC(aw); ZACC(aa); ZACC(ag);
      mm_tile(A4, ST, A0, ST, 2, aw, w, lq, g); mm_tile(A5, ST, A1, ST, 2, aa, w, lq, g); mm_tile((const bf16*)F1, STG, A2, STG, 4, ag, w, lq, g);
      const int mt = w >> 1, nt0 = 2 * (w & 1);
#pragma unroll
      for (int q = 0; q < 2; ++q) { const int o = (16 * (nt0 + q) + lq) * ST + 16 * mt + 4 * g; u32x2 p;
          p.x = pk2(aw[q][0], aw[q][1]); p.y = pk2(aw[q][2], aw[q][3]); *(u32x2*)(A7 + o) = p;
          p.x = pk2(aa[q][0], aa[q][1]); p.y = pk2(aa[q][2], aa[q][3]); *(u32x2*)(A8 + o) = p;
          p.x = pk2(ag[q][0], ag[q][1]); p.y = pk2(ag[q][2], ag[q][3]); *(u32x2*)(A9 + o) = p; } }
    LDS_BARRIER();
    float kk[8], k2[8], ar[8];
    { const u32x4 lw = *(const u32x4*)(A7 + t * ST + c0), la = *(const u32x4*)(A8 + t * ST + c0), lg = *(const u32x4*)(A9 + t * ST + c0);
      const float fw[8] = {bflo(lw.x), bfhi(lw.x), bflo(lw.y), bfhi(lw.y), bflo(lw.z), bfhi(lw.z), bflo(lw.w), bfhi(lw.w)};
      const float fa[8] = {bflo(la.x), bfhi(la.x), bflo(la.y), bfhi(la.y), bflo(la.z), bfhi(la.z), bflo(la.w), bfhi(la.w)};
      float ss = 0.f, bs = 0.f;
#pragma unroll
      for (int i = 0; i < 8; ++i) {
          const float xw = -(pw0[i] + fw[i]); const float sp = fmaxf(xw, 0.f) + __logf(1.f + __expf(-fabsf(xw)));
          F0[t * 64 + c0 + i] = __expf(-sp - 0.5f);
          ar[i] = sigmoidf_(pa0[i] + fa[i]);
          kk[i] = zk[i] * pkk[i]; ss += kk[i] * kk[i];
          k2[i] = zk[i] * (1.f + (ar[i] - 1.f) * pka[i]);
          bs += zr[i] * k2[i] * prk[i]; }
      ss += __shfl_xor(ss, 1); ss += __shfl_xor(ss, 2); ss += __shfl_xor(ss, 4);
      bs += __shfl_xor(bs, 1); bs += __shfl_xor(bs, 2); bs += __shfl_xor(bs, 4);
      const float inv = 1.0f / fmaxf(sqrtf(ss), 1e-12f);
#pragma unroll
      for (int i = 0; i < 8; ++i) kk[i] *= inv;
      u32x4 bo; bo.x = pk2(bs * zv[0], bs * zv[1]); bo.y = pk2(bs * zv[2], bs * zv[3]); bo.z = pk2(bs * zv[4], bs * zv[5]); bo.w = pk2(bs * zv[6], bs * zv[7]);
      *(u32x4*)(B.BON + (m0 + t) * 512 + jb) = bo; *(u32x4*)(B.G + (m0 + t) * 512 + jb) = lg; }
    LDS_BARRIER();
    {
      const int k = tid & 63, sg = tid >> 6; float e[8], run = 0.f;
#pragma unroll
      for (int s = 0; s < 8; ++s) { run += F0[(8 * sg + s) * 64 + k]; e[s] = run; }
      F1[sg * 64 + k] = run;
      LDS_BARRIER();
      float off = 0.f;
#pragma unroll
      for (int s = 0; s < 8; ++s) off += (s < sg) ? F1[s * 64 + k] : 0.f;
#pragma unroll
      for (int s = 0; s < 8; ++s) F0[(8 * sg + s) * 64 + k] = e[s] + off; }
    LDS_BARRIER();
    { float ct[8], cp[8], cC[8];
#pragma unroll
      for (int i = 0; i < 8; ++i) { ct[i] = F0[t * 64 + c0 + i]; cp[i] = (t > 0) ? F0[(t - 1) * 64 + c0 + i] : 0.f; cC[i] = F0[63 * 64 + c0 + i]; }
      float at[8], bt[8], kt[8], rt[8], bh[8], kh[8];
#pragma unroll
      for (int i = 0; i < 8; ++i) { const float gt = __expf(-ct[i]), igt = __expf(ct[i]), gp = __expf(-cp[i]), gct = __expf(ct[i] - cC[i]);
          at[i] = -kk[i] * gp; bt[i] = kk[i] * ar[i] * igt; kt[i] = k2[i] * igt; rt[i] = zr[i] * gt; bh[i] = kk[i] * ar[i] * gct; kh[i] = k2[i] * gct; }
      u32x4 o;
      o.x = pk2(at[0], at[1]); o.y = pk2(at[2], at[3]); o.z = pk2(at[4], at[5]); o.w = pk2(at[6], at[7]); *(u32x4*)(A0 + t * ST + c0) = o;
      o.x = pk2(bt[0], bt[1]); o.y = pk2(bt[2], bt[3]); o.z = pk2(bt[4], bt[5]); o.w = pk2(bt[6], bt[7]); *(u32x4*)(A1 + t * ST + c0) = o;
      o.x = pk2(kt[0], kt[1]); o.y = pk2(kt[2], kt[3]); o.z = pk2(kt[4], kt[5]); o.w = pk2(kt[6], kt[7]); *(u32x4*)(A2 + t * ST + c0) = o;
      o.x = pk2(rt[0], rt[1]); o.y = pk2(rt[2], rt[3]); o.z = pk2(rt[4], rt[5]); o.w = pk2(rt[6], rt[7]); *(u32x4*)(A3 + t * ST + c0) = o;
#pragma unroll
      for (int i = 0; i < 8; ++i) { const int o = (c0 + i) * ST + (t ^ c0);
          A4[o] = (bf16)f2bf(bh[i]); A5[o] = (bf16)f2bf(kh[i]); A6[o] = (bf16)f2bf(zv[i]); F1[t * 128 + c0 + i] = at[i]; }
      if (t == 63) { float* gc = (float*)(B.UB + (size_t)u * UNIT_B + 16384) + c0;
#pragma unroll
          for (int i = 0; i < 8; ++i) gc[i] = __expf(-cC[i]); } }
    LDS_BARRIER();
    { const int mt = w >> 1, nt0 = 2 * (w & 1);
      f32x4 a[2];
      ZACC(a); mm_tile(A0, ST, A1, ST, 2, a, w, lq, g);
#pragma unroll
      for (int q = 0; q < 2; ++q) { const int i = 16 * (nt0 + q) + lq; f32x4 lab;
#pragma unroll
          for (int j = 0; j < 4; ++j) lab[j] = (i < 16 * mt + 4 * g + j) ? a[q][j] : 0.f;
#pragma unroll
          for (int j = 0; j < 4; ++j) F0[i * 64 + j * 16 + 4 * mt + g] = lab[j]; }
      asm volatile("" ::: "memory");
#define ST1_STORE(DST, INCL) do { _Pragma("unroll") for (int q = 0; q < 2; ++q) { const int tt = 16 * (nt0 + q) + lq, i0 = 16 * mt + 4 * g; float v_[4]; \
          _Pragma("unroll") for (int j = 0; j < 4; ++j) v_[j] = (i0 + j < tt + (INCL)) ? a[q][j] : 0.f; \
          u32x2 p_; p_.x = pk2(v_[0], v_[1]); p_.y = pk2(v_[2], v_[3]); *(u32x2*)((DST) + tt * ST + i0) = p_; } } while (0)
      ZACC(a); mm_tile(A2, ST, A0, ST, 2, a, w, lq, g); ST1_STORE(A7, 0); asm volatile("" ::: "memory");
      ZACC(a); mm_tile(A1, ST, A3, ST, 2, a, w, lq, g); ST1_STORE(A8, 1); asm volatile("" ::: "memory");
      ZACC(a); mm_tile(A2, ST, A3, ST, 2, a, w, lq, g); ST1_STORE(A9, 1);
#undef ST1_STORE
    }
    LDS_BARRIER();
    { const int mt = w >> 1, nt0 = 2 * (w & 1); f32x4 a[2]; ZACC(a);
      mm_tile2<true, false>(A6, ST, A7, ST, 2, a, w, lq, g);
#pragma unroll
      for (int q = 0; q < 2; ++q) *(f32x4*)(F1 + (16 * (nt0 + q) + lq) * 128 + 64 + 16 * mt + 4 * g) = a[q]; }
    LDS_BARRIER();
    { float X[16];
      const int col = 16 * w + lq;
#pragma unroll
      for (int r = 0; r < 16; ++r) X[r] = F1[(4 * r + g) * 128 + col];
      LDS_BARRIER();
      f32x4 Lc[4];
#pragma unroll
      for (int q = 0; q < 4; ++q) Lc[q] = *(const f32x4*)(F0 + g * 16 + 4 * q);
#pragma unroll
      for (int i = 0; i < 64; ++i) {
          const float xi = __shfl(X[i >> 2], (i & 3) * 16 + lq);
          f32x4 Ln[4];
#pragma unroll
          for (int q = 0; q < 4; ++q) Ln[q] = Lc[q];
          if (i + 1 < 64) {
#pragma unroll
              for (int q = ((i + 1) >> 4); q < 4; ++q) Ln[q] = *(const f32x4*)(F0 + (i + 1) * 64 + g * 16 + 4 * q);
          }
#pragma unroll
          for (int r = (i >> 2); r < 16; ++r) X[r] += Lc[r >> 2][r & 3] * xi;
#pragma unroll
          for (int q = 0; q < 4; ++q) Lc[q] = Ln[q];
          __builtin_amdgcn_sched_barrier(0);
      }
      bf16* XT = (bf16*)F1 + (w >> 2) * 4608 + ((col & 63) * ST);
#pragma unroll
      for (int r = 0; r < 16; ++r) XT[4 * r + g] = (bf16)f2bf(X[r]); }
    LDS_BARRIER();
    { const int mt = w >> 1, nt0 = 2 * (w & 1);
      const bf16* AhT = (const bf16*)F1; const bf16* W2T = AhT + 4608;
      unsigned char* ua = B.UA + (size_t)u * UNIT_A; unsigned char* ub = B.UB + (size_t)u * UNIT_B;
      const int p0 = 32 * (mt >> 1) + 8 * g + 4 * (mt & 1);
      f32x4 a[2];
      ZACC(a); mm_tile2<false, true>(AhT, ST, A4, ST, 2, a, w, lq, g);
#pragma unroll
      for (int q = 0; q < 2; ++q) { const int k = 16 * (nt0 + q) + lq; u32x2 o; o.x = pk2(a[q][0], a[q][1]); o.y = pk2(a[q][2], a[q][3]); *(u32x2*)(ua + swz(k, p0)) = o; }
      ZACC(a); mm_tile(AhT, ST, A8, ST, 2, a, w, lq, g);
#pragma unroll
      for (int q = 0; q < 2; ++q) { const int tt = 16 * (nt0 + q) + lq; const u32x2 rr = *(const u32x2*)(A3 + tt * ST + 16 * mt + 4 * g);
          u32x2 o; o.x = pk2(a[q][0] + bflo(rr.x), a[q][1] + bfhi(rr.x)); o.y = pk2(a[q][2] + bflo(rr.y), a[q][3] + bfhi(rr.y)); *(u32x2*)(ua + 8192 + swz(tt, p0)) = o; }
      ZACC(a); mm_tile2<true, false>(A4, ST, W2T, ST, 2, a, w, lq, g); mm_tile2<true, true>(A5, ST, A6, ST, 2, a, w, lq, g);
#pragma unroll
      for (int q = 0; q < 2; ++q) { const int v = 16 * (nt0 + q) + lq, k0 = 16 * mt + 4 * g; u32x2 o; o.x = pk2(a[q][0], a[q][1]); o.y = pk2(a[q][2], a[q][3]); *(u32x2*)(ub + swz(v, k0)) = o; }
      ZACC(a); mm_tile(A8, ST, W2T, ST, 2, a, w, lq, g); mm_tile2<false, true>(A9, ST, A6, ST, 2, a, w, lq, g);
#pragma unroll
      for (int q = 0; q < 2; ++q) { const int v = 16 * (nt0 + q) + lq, t0 = 16 * mt + 4 * g; u32x2 o; o.x = pk2(a[q][0], a[q][1]); o.y = pk2(a[q][2], a[q][3]); *(u32x2*)(ub + 8192 + swz(v, t0)) = o; } }
    LDS_BARRIER();
}
__device__ __forceinline__ void phase_rwkv_prep(const Params& P, int l, const Ctx& c) {
    const RwkvBufs B = rwkv_bufs(P, c);
    float pw0[8], pa0[8], pkk[8], pka[8], prk[8]; int hprev = -1;
    for (int u = c.bid; u < NUNIT; u += c.G) {
        const int h = u & 7;
        if (h != hprev) { hprev = h; const int j0 = l * 512 + h * 64 + (c.tid & 7) * 8;
#pragma unroll
            for (int i = 0; i < 8; ++i) { pw0[i] = P.in[9][j0 + i]; pa0[i] = P.in[11][j0 + i]; pkk[i] = P.in[14][j0 + i]; pka[i] = P.in[15][j0 + i]; prk[i] = P.in[16][j0 + i]; } }
        rwkv_prep_unit(P, l, c, u, B, pw0, pa0, pkk, pka, prk);
    }
}

constexpr int SLOTB = 33280, YST = 68;
__device__ __forceinline__ void scan_chunked(const Params& P, const Ctx& c, int bh) {
    const RwkvBufs B = rwkv_bufs(P, c);
    const int b = bh >> 3, h = bh & 7, w = c.wave, lane = c.lane, lq = lane & 15, g = lane >> 4;
    const size_t rowb = (size_t)b * LP;
    const int ll = c.tid;
    unsigned char* L = c.lds;
    f32x4 st[4];
#pragma unroll
    for (int i = 0; i < 4; ++i) st[i] = (f32x4){0.f, 0.f, 0.f, 0.f};
    u32x4 r0[5], r1[5], r2[5], r3[5], r4[5];
#define SC_UNIT(cc) ((size_t)((b * NCHK + (cc)) * 8 + h))
#define SC_LOAD(R, cc) do { const unsigned char* pa_ = B.UA + SC_UNIT(cc) * UNIT_A; const unsigned char* pb_ = B.UB + SC_UNIT(cc) * UNIT_B; \
        _Pragma("unroll") for (int i_ = 0; i_ < 2; ++i_) { R[i_] = GLD(u32x4, pa_ + (ll + 512 * i_) * 16); R[2 + i_] = GLD(u32x4, pb_ + (ll + 512 * i_) * 16); } \
        if (ll < 16) R[4] = GLD(u32x4, pb_ + 16384 + ll * 16); } while (0)
#define SC_WRITE(R, slot) do { unsigned char* s_ = L + (slot) * SLOTB; \
        _Pragma("unroll") for (int i_ = 0; i_ < 2; ++i_) { *(u32x4*)(s_ + (ll + 512 * i_) * 16) = R[i_]; *(u32x4*)(s_ + 16384 + (ll + 512 * i_) * 16) = R[2 + i_]; } \
        if (ll < 16) *(u32x4*)(s_ + 32768 + ll * 16) = R[4]; } while (0)
#define SC_COMPUTE(ci) do { \
        const unsigned char* sl = L + ((ci) % 3) * SLOTB; \
        const int vcol = 16 * w + lq; \
        bf16x8 gaf[4][2]; f32x4 gcf[4]; u32x2 d0f[4]; \
        _Pragma("unroll") for (int mt = 0; mt < 4; ++mt) { \
            gcf[mt] = *(const f32x4*)(sl + 32768 + (16 * mt + 4 * g) * 4); \
            d0f[mt] = *(const u32x2*)(sl + 16384 + swz(vcol, 16 * mt + 4 * g)); \
            _Pragma("unroll") for (int ks = 0; ks < 2; ++ks) gaf[mt][ks] = *(const bf16x8*)(sl + swz(16 * mt + lq, 32 * ks + 8 * g)); } \
        __builtin_amdgcn_sched_barrier(0);        \
        bf16x8 sb[2]; \
        _Pragma("unroll") for (int ks = 0; ks < 2; ++ks) { u32x4 pw; pw.x = pk2(st[2 * ks][0], st[2 * ks][1]); pw.y = pk2(st[2 * ks][2], st[2 * ks][3]); pw.z = pk2(st[2 * ks + 1][0], st[2 * ks + 1][1]); pw.w = pk2(st[2 * ks + 1][2], st[2 * ks + 1][3]); \
            sb[ks] = __builtin_bit_cast(bf16x8, pw); } \
        _Pragma("unroll") for (int mt = 0; mt < 4; ++mt) { \
            f32x4 ns = (f32x4){bflo(d0f[mt].x), bfhi(d0f[mt].x), bflo(d0f[mt].y), bfhi(d0f[mt].y)} + gcf[mt] * st[mt]; \
            _Pragma("unroll") for (int ks = 0; ks < 2; ++ks) ns = __builtin_amdgcn_mfma_f32_16x16x32_bf16(gaf[mt][ks], sb[ks], ns, 0, 0, 0); \
            st[mt] = ns; } \
        _Pragma("unroll") for (int mt = 0; mt < 4; ++mt) { \
            const u32x2 y0 = *(const u32x2*)(sl + 24576 + swz(vcol, 16 * mt + 4 * g)); \
            f32x4 ya = (f32x4){bflo(y0.x), bfhi(y0.x), bflo(y0.y), bfhi(y0.y)}; \
            _Pragma("unroll") for (int ks = 0; ks < 2; ++ks) { const bf16x8 rh = *(const bf16x8*)(sl + 8192 + swz(16 * mt + lq, 32 * ks + 8 * g)); ya = __builtin_amdgcn_mfma_f32_16x16x32_bf16(rh, sb[ks], ya, 0, 0, 0); } \
            float* yl = (float*)(L + 3 * SLOTB) + ((ci) & 1) * (64 * YST) + (16 * mt + 4 * g) * YST + vcol; \
            _Pragma("unroll") for (int j = 0; j < 4; ++j) yl[j * YST] = ya[j]; } } while (0)
#define SC_YSTORE(ci) do { const float* ys_ = (const float*)(L + 3 * SLOTB) + ((ci) & 1) * (64 * YST) + (c.tid >> 3) * YST + (c.tid & 7) * 8; \
        float* yg_ = B.Y + (rowb + (ci) * 64 + (c.tid >> 3)) * 512 + h * 64 + (c.tid & 7) * 8; \
        GST(f32x4, yg_) = *(const f32x4*)ys_; GST(f32x4, yg_ + 4) = *(const f32x4*)(ys_ + 4); } while (0)
#define SC_ITER(ci, R) do { if ((ci) + 2 < NCHK) SC_WRITE(R, ((ci) + 2) % 3); if ((ci) + 7 < NCHK) SC_LOAD(R, (ci) + 7); if ((ci) > 0) SC_YSTORE((ci) - 1); if (w < 4) { SC_COMPUTE(ci); } LDS_BARRIER(); } while (0)
    { SC_LOAD(r0, 0); SC_LOAD(r1, 1); SC_WRITE(r0, 0); SC_WRITE(r1, 1); SC_LOAD(r2, 2); SC_LOAD(r3, 3); SC_LOAD(r4, 4); SC_LOAD(r0, 5); SC_LOAD(r1, 6); }
    __syncthreads();
#pragma unroll 1
    for (int cc = 0; cc < NCHK; cc += 5) { SC_ITER(cc, r2); SC_ITER(cc + 1, r3); SC_ITER(cc + 2, r4); SC_ITER(cc + 3, r0); SC_ITER(cc + 4, r1); }
    SC_YSTORE(NCHK - 1);
#undef SC_YSTORE
#undef SC_COMPUTE
#undef SC_ITER
#undef SC_UNIT
#undef SC_LOAD
#undef SC_WRITE
}

__device__ __forceinline__ void phase_gn(const Params& P, int l, const Ctx& c) {
    const RwkvBufs B = rwkv_bufs(P, c);
    const int gw = c.bid * NWAVES + c.wave, NGW = c.G * NWAVES;
    const int c0 = 8 * c.lane;
    float gnw[8], gnb[8];
#pragma unroll
    for (int i = 0; i < 8; ++i) { gnw[i] = P.in[17][l * 512 + c0 + i]; gnb[i] = P.in[18][l * 512 + c0 + i]; }
    for (int m = gw; m < M; m += NGW) {
        const size_t o = (size_t)m * 512 + c0;
        const f32x4 y0 = *(const f32x4*)(B.Y + o), y1 = *(const f32x4*)(B.Y + o + 4);
        float y[8] = {y0.x, y0.y, y0.z, y0.w, y1.x, y1.y, y1.z, y1.w};
        const u32x4 bw = *(const u32x4*)(B.BON + o), gw4 = *(const u32x4*)(B.G + o);
        const float bo[8] = {bflo(bw.x), bfhi(bw.x), bflo(bw.y), bfhi(bw.y), bflo(bw.z), bfhi(bw.z), bflo(bw.w), bfhi(bw.w)};
        const float gg[8] = {bflo(gw4.x), bfhi(gw4.x), bflo(gw4.y), bfhi(gw4.y), bflo(gw4.z), bfhi(gw4.z), bflo(gw4.w), bfhi(gw4.w)};
        float s = 0.f;
#pragma unroll
        for (int i = 0; i < 8; ++i) s += y[i];
        s += __shfl_xor(s, 1); s += __shfl_xor(s, 2); s += __shfl_xor(s, 4);
        const float mean = s * (1.f / 64.f);
        float q = 0.f;
#pragma unroll
        for (int i = 0; i < 8; ++i) { y[i] -= mean; q += y[i] * y[i]; }
        q += __shfl_xor(q, 1); q += __shfl_xor(q, 2); q += __shfl_xor(q, 4);
        const float rstd = 1.0f / sqrtf(q * (1.f / 64.f) + 64e-5f);
        float ov[8];
#pragma unroll
        for (int i = 0; i < 8; ++i) ov[i] = (y[i] * rstd * gnw[i] + gnb[i] + bo[i]) * gg[i];
        u32x4 ow; ow.x = pk2(ov[0], ov[1]); ow.y = pk2(ov[2], ov[3]); ow.z = pk2(ov[4], ov[5]); ow.w = pk2(ov[6], ov[7]);
        *(u32x4*)(B.ORW + o) = ow;
    }
}

__device__ __forceinline__ void attn_unit(const Ctx& c, int bh, int qb, const bf16* Q, const bf16* K, const bf16* V, bf16* O, const float* FC, float qkb2, const float* gq, const float* gk) {
    const int b = bh >> 3, h = bh & 7, lane = c.lane, w = c.wave, lq = lane & 15, g = lane >> 4;
    const int q0 = qb * 128;
    const size_t rowb = (size_t)b * LP;
    const int qrow = q0 + 16 * w + lq;
    bf16* Ks = (bf16*)c.lds; bf16* Vt = Ks + 64 * 72; float* fks = (float*)(Vt + 64 * 72);
    const bf16* qp = Q + (rowb + qrow) * 512 + h * 64 + 8 * g;
    bf16x8 qf0, qf1;
    { const u32x4 r0 = GLD(u32x4, qp), r1 = GLD(u32x4, qp + 32);
      float x[16] = {bflo(r0.x), bfhi(r0.x), bflo(r0.y), bfhi(r0.y), bflo(r0.z), bfhi(r0.z), bflo(r0.w), bfhi(r0.w), bflo(r1.x), bfhi(r1.x), bflo(r1.y), bfhi(r1.y), bflo(r1.z), bfhi(r1.z), bflo(r1.w), bfhi(r1.w)};
      float ss = 0.f;
#pragma unroll
      for (int i = 0; i < 16; ++i) ss += x[i] * x[i];
      ss += __shfl_xor(ss, 16); ss += __shfl_xor(ss, 32);
      const float rs = QSCALE / sqrtf(ss * (1.f / 64.f) + 1e-6f);
#pragma unroll
      for (int i = 0; i < 8; ++i) { x[i] *= rs * gq[8 * g + i]; x[8 + i] *= rs * gq[32 + 8 * g + i]; }
      u32x4 p0, p1; p0.x = pk2(x[0], x[1]); p0.y = pk2(x[2], x[3]); p0.z = pk2(x[4], x[5]); p0.w = pk2(x[6], x[7]); p1.x = pk2(x[8], x[9]); p1.y = pk2(x[10], x[11]); p1.z = pk2(x[12], x[13]); p1.w = pk2(x[14], x[15]);
      qf0 = __builtin_bit_cast(bf16x8, p0); qf1 = __builtin_bit_cast(bf16x8, p1); }
    const float* FCh = FC + (size_t)bh * LP;
    const float fq = GLD(float, FCh + qrow);
    float mrun = -1e30f, lsum = 0.f;
    f32x4 o[4];
#pragma unroll
    for (int i = 0; i < 4; ++i) o[i] = (f32x4){0.f, 0.f, 0.f, 0.f};
    const int kt_max = (q0 + 127) >> 6;
    const int lkey = c.tid >> 3, lch = c.tid & 7;
    float gkr[8];
#pragma unroll
    for (int i = 0; i < 8; ++i) gkr[i] = gk[lch * 8 + i];
    const size_t gbase = (rowb + lkey) * 512 + h * 64 + lch * 8;
    u32x4 kv = GLD(u32x4, K + gbase + (size_t)kt_max * 64 * 512), vv = GLD(u32x4, V + gbase + (size_t)kt_max * 64 * 512);
    float fkv = GLD(float, FCh + kt_max * 64 + (c.tid & 63));
    volatile unsigned* vote = (volatile unsigned*)(fks + 64);
    for (int kt = kt_max; kt >= 0; --kt) {
        const int k0 = kt * 64;
        LDS_BARRIER();
        { int can = 0; if (kt < kt_max) { const float fl = __shfl(fkv, 63); can = (qkb2 + fq - fl) < (mrun - THR2); }
          const int wall = __all(can); if (lane == 0) vote[w] = (unsigned)wall; }
        { { float x[8] = {bflo(kv.x), bfhi(kv.x), bflo(kv.y), bfhi(kv.y), bflo(kv.z), bfhi(kv.z), bflo(kv.w), bfhi(kv.w)}; float ss = 0.f;
#pragma unroll
              for (int i = 0; i < 8; ++i) ss += x[i] * x[i];
              ss += __shfl_xor(ss, 1); ss += __shfl_xor(ss, 2); ss += __shfl_xor(ss, 4);
              const float rs = 1.0f / sqrtf(ss * (1.f / 64.f) + 1e-6f);
              u32x4 kn; kn.x = pk2(x[0] * rs * gkr[0], x[1] * rs * gkr[1]); kn.y = pk2(x[2] * rs * gkr[2], x[3] * rs * gkr[3]); kn.z = pk2(x[4] * rs * gkr[4], x[5] * rs * gkr[5]); kn.w = pk2(x[6] * rs * gkr[6], x[7] * rs * gkr[7]);
              *(u32x4*)(Ks + lkey * 72 + lch * 8) = kn; }
            bf16* vd = Vt + (lch * 8) * 72 + lkey;
            vd[0] = (bf16)(vv.x & 0xffff); vd[72] = (bf16)(vv.x >> 16); vd[144] = (bf16)(vv.y & 0xffff); vd[216] = (bf16)(vv.y >> 16);
            vd[288] = (bf16)(vv.z & 0xffff); vd[360] = (bf16)(vv.z >> 16); vd[432] = (bf16)(vv.w & 0xffff); vd[504] = (bf16)(vv.w >> 16);
            if (c.tid < 64) fks[c.tid] = fkv;
            if (kt > 0) { kv = GLD(u32x4, K + gbase + (size_t)(k0 - 64) * 512); vv = GLD(u32x4, V + gbase + (size_t)(k0 - 64) * 512); fkv = GLD(float, FCh + k0 - 64 + (c.tid & 63)); } }
        LDS_BARRIER();
        { unsigned all = vote[0] & vote[1] & vote[2] & vote[3] & vote[4] & vote[5] & vote[6] & vote[7]; if (all) break; }
        if (k0 > q0 + 16 * w + 15) continue;
        f32x4 s[4];
#pragma unroll
        for (int nt = 0; nt < 4; ++nt) { const bf16* kp = Ks + (16 * nt + lq) * 72 + 8 * g; const bf16x8 a0 = *(const bf16x8*)kp, a1 = *(const bf16x8*)(kp + 32);
            s[nt] = __builtin_amdgcn_mfma_f32_16x16x32_bf16(a0, qf0, (f32x4){0.f, 0.f, 0.f, 0.f}, 0, 0, 0);
            s[nt] = __builtin_amdgcn_mfma_f32_16x16x32_bf16(a1, qf1, s[nt], 0, 0, 0); }
        float mx = -INFINITY;
#pragma unroll
        for (int nt = 0; nt < 4; ++nt) { const f32x4 fk = *(const f32x4*)(fks + 16 * nt + 4 * g);
#pragma unroll
            for (int j = 0; j < 4; ++j) { float x = s[nt][j] + fq - fk[j]; const int key = k0 + 16 * nt + 4 * g + j; if (key > qrow) x = -INFINITY; s[nt][j] = x; mx = fmaxf(mx, x); } }
        mx = fmaxf(mx, __shfl_xor(mx, 16)); mx = fmaxf(mx, __shfl_xor(mx, 32));
        const float mnew = fmaxf(mrun, mx), alpha = __builtin_amdgcn_exp2f(mrun - mnew); mrun = mnew;
        float psum = 0.f;
#pragma unroll
        for (int nt = 0; nt < 4; ++nt)
#pragma unroll
            for (int j = 0; j < 4; ++j) { const float p = __builtin_amdgcn_exp2f(s[nt][j] - mnew); s[nt][j] = p; psum += p; }
        lsum = lsum * alpha + psum;
#pragma unroll
        for (int dt = 0; dt < 4; ++dt) o[dt] = o[dt] * alpha;
        bf16x8 pb[2];
#pragma unroll
        for (int k2 = 0; k2 < 2; ++k2) { u32x4 pw; pw.x = pk2(s[2 * k2][0], s[2 * k2][1]); pw.y = pk2(s[2 * k2][2], s[2 * k2][3]); pw.z = pk2(s[2 * k2 + 1][0], s[2 * k2 + 1][1]); pw.w = pk2(s[2 * k2 + 1][2], s[2 * k2 + 1][3]);
            pb[k2] = __builtin_bit_cast(bf16x8, pw); }
#pragma unroll
        for (int dt = 0; dt < 4; ++dt)
#pragma unroll
            for (int k2 = 0; k2 < 2; ++k2) { const bf16* vp = Vt + (16 * dt + lq) * 72 + 32 * k2 + 4 * g;
                const u32x2 lo = *(const u32x2*)vp, hi = *(const u32x2*)(vp + 16);
                u32x4 aw; aw.x = lo.x; aw.y = lo.y; aw.z = hi.x; aw.w = hi.y;
                o[dt] = __builtin_amdgcn_mfma_f32_16x16x32_bf16(__builtin_bit_cast(bf16x8, aw), pb[k2], o[dt], 0, 0, 0); }
    }
    lsum += __shfl_xor(lsum, 16); lsum += __shfl_xor(lsum, 32);
    const float inv = 1.0f / lsum;
    bf16* op = O + (rowb + qrow) * 512 + h * 64 + 4 * g;
#pragma unroll
    for (int dt = 0; dt < 4; ++dt) { u32x2 ow; ow.x = pk2(o[dt][0] * inv, o[dt][1] * inv); ow.y = pk2(o[dt][2] * inv, o[dt][3] * inv); GST(u32x2, op + 16 * dt) = ow; }
    __syncthreads();
}
__device__ __forceinline__ void phase_attn(const Params& P, int l, const Ctx& c, int first_blk) {
    const bf16* Q = (const bf16*)(c.ws + OFF_Q); const bf16* K = (const bf16*)(c.ws + OFF_K); const bf16* V = (const bf16*)(c.ws + OFF_V);
    const float* FC = (const float*)(c.ws + OFF_MISC) + 16 * LP;
    float gqm = fabsf(P.in[5][l * 64 + c.lane]), gkm = fabsf(P.in[6][l * 64 + c.lane]);
#pragma unroll
    for (int o = 1; o < 64; o <<= 1) { gqm = fmaxf(gqm, __shfl_xor(gqm, o)); gkm = fmaxf(gkm, __shfl_xor(gkm, o)); }
    const float qkb2 = 8.0f * gqm * gkm * LOG2E * 1.03f;
    constexpr int NQB = LP / 128, NU = 16 * NQB;
    unsigned* ctr = (unsigned*)(c.ws + OFF_CTL) + 8192 + 64 * l;
    volatile unsigned* slot = (volatile unsigned*)(c.lds + MISC_OFF) + 4;
    for (;;) {
        __syncthreads();
        if (c.tid == 0) *slot = atomicAdd(ctr, 1u);
        __syncthreads();
        const int u = (int)*slot;
        if (u >= NU) break;
        const int bh = u & 15, qb = NQB - 1 - (u >> 4); attn_unit(c, bh, qb, Q, K, V, (bf16*)(c.ws + OFF_OF), FC, qkb2, P.in[5] + l * 64, P.in[6] + l * 64);
    }
}

__device__ __forceinline__ void phase_fixup(const Params& P, int l, const Ctx& c) {
    bf16* ACT = (bf16*)(c.ws + OFF_RW); const bf16* HALO = (const bf16*)(c.ws + OFF_Q);
    const float* cw = P.in[24] + (size_t)l * 3 * NUP;
    const int total = (M / 64) * 2 * DFF;
    for (int idx = c.bid * NTHR + c.tid; idx < total; idx += c.G * NTHR) {
        const int rr = idx / DFF, ch = idx - rr * DFF, q64 = rr >> 1, e = rr & 1, row = q64 * 64 + e;
        const int t = row % LP;
        int s0, s1, s2;
        if (e == 0) { s0 = q64 * 4 + 2; s1 = (q64 - 1) * 4 + 1; s2 = (q64 - 1) * 4 + 0; } else { s0 = q64 * 4 + 3; s1 = q64 * 4 + 2; s2 = (q64 - 1) * 4 + 1; }
        float uc[2];
#pragma unroll
        for (int bj = 0; bj < 2; ++bj) { const int col = bj * DFF + ch;
            const float u0 = bf2f(HALO[(size_t)s0 * NUP + col]);
            const float u1 = (t >= 1) ? bf2f(HALO[(size_t)s1 * NUP + col]) : 0.f;
            const float u2 = (t >= 2) ? bf2f(HALO[(size_t)s2 * NUP + col]) : 0.f;
            uc[bj] = cw[col] * u2 + cw[NUP + col] * u1 + cw[2 * NUP + col] * u0; }
        ACT[(size_t)row * DFF + ch] = (bf16)f2bf(uc[0] * sigmoidf_(uc[0]) * uc[1]);
    }
}

#define OPQ_S(x) asm volatile("" : "+s"(x))
#define OPQ_V(x) asm volatile("" : "+v"(x))
#define PHASE_BEGIN() do { int t_ = threadIdx.x; OPQ_V(t_); c.tid = t_; c.lane = t_ & 63; c.wave = __builtin_amdgcn_readfirstlane(t_ >> 6); int b_ = blockIdx.x; OPQ_S(b_); c.bid = b_; \
    size_t z_ = 0; OPQ_S(z_); unsigned char* w_ = P.ws + z_;   c.ws = w_; ws = w_; l = lc; OPQ_S(l); WT = (pg8::bf16_t*)(ws + OFF_WT); HN = (pg8::bf16_t*)(ws + OFF_HN); } while (0)
__global__ void __launch_bounds__(NTHR, 2) mega(Params P) {
    extern __shared__ __attribute__((aligned(16))) unsigned char lds[];
    Ctx c; c.G = gridDim.x; c.lds = lds;
    volatile LAS unsigned* MISC = (volatile LAS unsigned*)((LAS unsigned char*)lds + MISC_OFF);
    if (threadIdx.x < 16) MISC[threadIdx.x] = 0u;
    __syncthreads();
    (void)xcd_barrier_post((unsigned*)(P.ws + OFF_CTL) + 1024, MISC + 8);
#define SEAM() do { XcdBarrier xb_; xb_.bar = (unsigned*)(P.ws + OFF_CTL) + 1024; xb_.x = xb_xcc_id(); xb_.st = (volatile LAS unsigned*)((LAS unsigned char*)lds + MISC_OFF) + 8; xcd_barrier(xb_); } while (0)
    PG8_LAS unsigned char* ldsl = (PG8_LAS unsigned char*)lds;
    unsigned char* ws; pg8::bf16_t* WT; pg8::bf16_t* HN; int l;
#pragma unroll 1
    for (int lc = 0; lc < DEPTH; ++lc) {
        PHASE_BEGIN();
        convert_weights(P, l, c);
        phase_norm<true>(P, l, c);
        if (lc == 0) cg::this_grid().sync(); else SEAM();
        PHASE_BEGIN();
        phase_fcum(P, c);
        { pg8::Gemm g{HN, WT + WT_IN, M, N1, 1024, 1024}; pg8::StaticOrder S; S.init(M, N1, c.G, c.bid);
          pg8::EpiRoute E{ws};
          pg8::gemm_phase<pg8::EpiRoute, pg8::StaticOrder, true, true>(ldsl, g, S, E); }
        SEAM();
        PHASE_BEGIN();
        for (int rep_ = 0; rep_ < REP_PREP; ++rep_) phase_rwkv_prep(P, l, c);
        SEAM();
        PHASE_BEGIN();
        if (c.bid < 16) { scan_chunked(P, c, c.bid); __syncthreads(); PHASE_BEGIN(); }
        phase_attn(P, l, c, 16);
#if REP_P3 > 1
        __syncthreads(); PHASE_BEGIN();
        if (c.bid < 16) scan_chunked(P, c, c.bid); else phase_attn(P, l, c, 16);
#endif
        SEAM();
        PHASE_BEGIN();
        phase_gn(P, l, c);
        for (int rep_ = 0; rep_ < REP_SYNC; ++rep_) SEAM();
        SEAM();
        PHASE_BEGIN();
#pragma unroll 1
        for (int pass = 0; pass < 3; ++pass) {
            if (pass) { __syncthreads(); PHASE_BEGIN(); }
            const int rw_side = pass == 2 ? ((c.bid >> 2) & 1) : pass;
            const pg8::bf16_t* A = rw_side ? (const pg8::bf16_t*)(ws + OFF_RW + (size_t)M * 512 * 4) : (const pg8::bf16_t*)(ws + OFF_OF);
            pg8::Gemm g{A, WT + (rw_side ? WT_BR : WT_BF), M, 1024, 512, 512};
            pg8::OneUnit S; S.so.init(MMAIN, 1024, c.G, c.bid); S.mode = pass == 2; S.pm = MMAIN / 256; S.pn = c.bid & 3; S.active = c.bid < 8;
            pg8::bf16_t* O = (pass == 2 && rw_side) ? (pg8::bf16_t*)(ws + OFF_TAIL) - (size_t)MMAIN * 1024 : (pg8::bf16_t*)(ws + OFF_K);
            pg8::EpiGateR E{O, (const pg8::bf16_t*)(ws + OFF_GT), P.in[21] + l * NGT, rw_side * 1024, pass == 1};
            pg8::gemm_phase<pg8::EpiGateR, pg8::OneUnit, true, true>(ldsl, g, S, E);
        }
        SEAM();
        PHASE_BEGIN();
#pragma unroll 1
        for (int pass = 0; pass < 2; ++pass) {
            if (pass) { __syncthreads(); PHASE_BEGIN(); }
            const int sl = pass ? (c.bid >> 2) : 0, ks = sl & 3;
            const pg8::bf16_t* A = (pass && sl >= 4) ? (const pg8::bf16_t*)(ws + OFF_TAIL) - (size_t)MMAIN * 1024 : (const pg8::bf16_t*)(ws + OFF_K);
            pg8::Gemm g{A + ks * 256, WT + WT_O + ks * 256, M, 1024, pass ? 256 : 1024, 1024};
            pg8::OneUnit S; S.so.init(MMAIN, 1024, c.G, c.bid); S.mode = pass; S.pm = MMAIN / 256; S.pn = c.bid & 3; S.active = sl < 8;
            pg8::EpiResid E{(float*)(ws + OFF_H), nullptr, pass};
            pg8::gemm_phase<pg8::EpiResid, pg8::OneUnit, true, true>(ldsl, g, S, E);
        }
        SEAM();
        PHASE_BEGIN();
        phase_norm<false>(P, l, c);
        SEAM();
        PHASE_BEGIN();
        { pg8::Gemm g{HN, WT + WT_UP, M, NUP, 1024, 1024}; pg8::StaticOrder S; S.init(M, NUP, c.G, c.bid);
          pg8::EpiUp E{(pg8::bf16_t*)(ws + OFF_RW), (pg8::bf16_t*)(ws + OFF_Q), P.in[24] + (size_t)l * 3 * NUP};
          pg8::gemm_phase<pg8::EpiUp, pg8::StaticOrder, true, true>(ldsl, g, S, E); }
        SEAM();
        PHASE_BEGIN();
        phase_fixup(P, l, c);
        SEAM();
        PHASE_BEGIN();
#pragma unroll 1
        for (int pass = 0; pass < 2; ++pass) {
            if (pass) { __syncthreads(); PHASE_BEGIN(); }
            const int sl = pass ? (c.bid >> 2) : 0;
            const int ko = (sl < 2) ? sl * 768 : 1536 + (sl - 2) * 640, kl = (sl < 2) ? 768 : 640;
            pg8::Gemm g{(const pg8::bf16_t*)(ws + OFF_RW) + (pass ? ko : 0), WT + WT_DN + (pass ? ko : 0), M, 1024, pass ? kl : DFF, DFF};
            pg8::OneUnit S; S.so.init(MMAIN, 1024, c.G, c.bid); S.mode = pass; S.pm = MMAIN / 256; S.pn = c.bid & 3; S.active = sl < 4;
            pg8::EpiResid E{(float*)(ws + OFF_H), (l == DEPTH - 1 && !pass) ? P.out : nullptr, pass};
            pg8::gemm_phase<pg8::EpiResid, pg8::OneUnit, true, true>(ldsl, g, S, E);
        }
        SEAM();
        if (l == DEPTH - 1) {
            PHASE_BEGIN();
            const float* H = (const float*)(ws + OFF_H);
            for (int idx = c.bid * NTHR + c.tid; idx < (NMETA + SEQ - (MMAIN - LP)) * (DM / 4); idx += c.G * NTHR) {
                const int r = idx / (DM / 4), q4 = idx - r * (DM / 4), t = (MMAIN - LP) + r;
                *(f32x4*)(P.out + ((size_t)SEQ + (t - NMETA)) * DM + 4 * q4) = *(const f32x4*)(H + (size_t)(LP + t) * DM + 4 * q4);
            }
        }
    }
}

extern "C" void kernel_launch(void* const* d_in, const int* in_sizes, int n_in, void* d_out, int out_size, void* d_ws, size_t ws_size, hipStream_t stream) {
    static int grid = 0;
    if (grid == 0) {
        if (n_in != 26 || out_size != NB * SEQ * DM || ws_size < WS_NEED) { fprintf(stderr, "kernel_launch: unexpected shapes (n_in %d out %d ws %zu need %zu)\n", n_in, out_size, ws_size, (size_t)WS_NEED); grid = -1; return; }
        int dev = 0, cus = 0, per_cu = 0;
        if (hipGetDevice(&dev) != hipSuccess || hipDeviceGetAttribute(&cus, hipDeviceAttributeMultiprocessorCount, dev) != hipSuccess) { grid = -1; return; }
        if (hipFuncSetAttribute((const void*)mega, hipFuncAttributeMaxDynamicSharedMemorySize, LDS_BYTES) != hipSuccess) { fprintf(stderr, "kernel_launch: hipFuncSetAttribute failed\n"); grid = -1; return; }
        if (hipOccupancyMaxActiveBlocksPerMultiprocessor(&per_cu, (const void*)mega, NTHR, LDS_BYTES) != hipSuccess || per_cu < 1) { fprintf(stderr, "kernel_launch: occupancy query says %d\n", per_cu); per_cu = 1; }
        (void)hipGetLastError();
        grid = cus;
    }
    if (grid < 0) return;
    if (hipMemsetAsync((char*)d_ws + OFF_CTL, 0, 65536, stream) != hipSuccess) { fprintf(stderr, "kernel_launch: memset failed\n"); return; }
    Params p{};
    for (int i = 0; i < 26; ++i) p.in[i] = (const float*)d_in[i];
    p.out = (float*)d_out; p.ws = (unsigned char*)d_ws;
    void* args[] = {&p};
    hipError_t e = hipLaunchCooperativeKernel((const void*)mega, dim3(grid), dim3(NTHR), args, LDS_BYTES, stream);
    if (e != hipSuccess) fprintf(stderr, "kernel_launch: cooperative launch failed: %s (grid %d)\n", hipGetErrorString(e), grid);
}
```

```cpp
#include <hip/hip_runtime.h>
#include <hip/hip_cooperative_groups.h>
#include <cstdio>
#include <cstdint>
#include <cmath>
namespace cg = cooperative_groups;
namespace pg8 {
#define PG8_LAS __attribute__((address_space(3)))
typedef unsigned short bf16_t;
typedef short bf16x8 __attribute__((ext_vector_type(8)));
typedef float f32x4 __attribute__((ext_vector_type(4)));
typedef unsigned u32x4 __attribute__((ext_vector_type(4)));
constexpr int BM = 256, BK = 64, HALF = 128, HTB = HALF * BK * 2  , STAGE_BYTES = 8 * HTB, NXCD = 8, WGM = 8;

__host__ __device__ __forceinline__ int lds_byte(int r, int c) { const int st = (r >> 4) * 2 + (c >> 5), rr = r & 15, cc = c & 31, ob = rr * 64 + cc * 2; return st * 1024 + (ob ^ (((ob >> 9) & 1) << 5)); }
__host__ __device__ __forceinline__ void stage_rc(int b, int& R, int& C) { const int st = b / 1024, sb = b % 1024, swz = sb ^ (((sb >> 9) & 1) << 5); R = (st >> 1) * 16 + swz / 64; C = (st & 1) * 32 + (swz % 64) / 2; }
__host__ __device__ __forceinline__ int perm32(int rho) { const int n = rho >> 4, i = rho & 15; return 8 * (i >> 2) + 4 * n + (i & 3); }

struct Unit { int pm, pn; };
struct Gemm { const bf16_t* A; const bf16_t* Bt; int M, N, K, ld; };

struct StaticOrder {
    int nM, nN, nwg, G, c;
    __host__ __device__ void init(int M, int N, int G_, int c_) { nM = M / BM; nN = N / BM; nwg = nM * nN; G = G_; c = c_; }
    __host__ __device__ bool next(int i, Unit& u) const {
        const long L = (long)i * G + c; if (L >= nwg) return false;
        int wgid = (int)L; { const int q = nwg / NXCD, r = nwg % NXCD, xcd = wgid % NXCD, off = wgid / NXCD; wgid = (xcd < r ? xcd * (q + 1) : r * (q + 1) + (xcd - r) * q) + off; }
        const int nig = WGM * nN, gid = wgid / nig, fm = gid * WGM, gsz = (nM - fm) < WGM ? (nM - fm) : WGM;
        u.pm = fm + ((wgid % nig) % gsz); u.pn = (wgid % nig) / gsz; return true;
    }
    __device__ __forceinline__ void a_ready(const Unit&) const {}
    __device__ __forceinline__ void done(const Unit&) const {}
};

__device__ __forceinline__ unsigned cvt_pk_bf16(float lo, float hi) { unsigned r; asm volatile("v_cvt_pk_bf16_f32 %0, %1, %2" : "=v"(r) : "v"(lo), "v"(hi)); return r; }
typedef float f32x2 __attribute__((ext_vector_type(2)));
template <class Epi, class Sched, bool ALIGN_EPI = false, bool SP2 = false>
__device__ __forceinline__ void gemm_phase(PG8_LAS unsigned char* lds, const Gemm g, const Sched& S, const Epi& E) {
    int tid_ = threadIdx.x; asm volatile("" : "+v"(tid_)); const int tid = tid_, wid = __builtin_amdgcn_readfirstlane(tid >> 6), lane = tid & 63, wr = wid >> 2, wc = wid & 3, fr = lane & 15, fq = lane >> 4;
    const int K = g.K, nt = K / BK, LD = g.ld;
    unsigned voffA[2], voffB[2];
#pragma unroll
    for (int i = 0; i < 2; ++i) { int R, C; stage_rc(tid * 16 + i * 8192, R, C); const int Rb = Epi::PERM ? ((R & ~31) + perm32(R & 31)) : R;
        voffA[i] = (unsigned)(R * LD + C) * 2u; voffB[i] = (unsigned)(Rb * LD + C) * 2u; }
    const size_t kstep = (size_t)(BK * 2);
    const size_t hstep = (size_t)HALF * LD * 2;
    const size_t tstep = 2 * hstep;
    const unsigned ldsw = (unsigned)wid * 1024u;
    const int aoff = lds_byte(wr * 64 + fr, fq * 8), boff = lds_byte(wc * 32 + fr, fq * 8);
#define PG8_SA(b, h) (((b) * 2 + (h)) * HTB)
#define PG8_SB(b, h) ((4 + (b) * 2 + (h)) * HTB)
#define PG8_STAGE(bufoff, gbase, voff) do { _Pragma("unroll") for (int _i = 0; _i < 2; ++_i) \
        __builtin_amdgcn_global_load_lds((const unsigned*)((const char*)(gbase) + (voff)[_i]), (PG8_LAS unsigned*)(lds + (bufoff) + ldsw + _i * 8192), 16, 0, 0); } while (0)
#define PG8_LDA(dst, b, h) do { _Pragma("unroll") for (int m = 0; m < 4; ++m) _Pragma("unroll") for (int k = 0; k < 2; ++k) dst[m][k] = *(const PG8_LAS bf16x8*)(lds + PG8_SA(b, h) + aoff + m * 2048 + k * 1024); } while (0)
#define PG8_LDB(dst, b, h) do { _Pragma("unroll") for (int n = 0; n < 2; ++n) _Pragma("unroll") for (int k = 0; k < 2; ++k) dst[n][k] = *(const PG8_LAS bf16x8*)(lds + PG8_SB(b, h) + boff + n * 2048 + k * 1024); } while (0)
#define PG8_MMA(ai, bj, At, Bt) do { __builtin_amdgcn_s_setprio(1); _Pragma("unroll") for (int m = 0; m < 4; ++m) _Pragma("unroll") for (int n = 0; n < 2; ++n) _Pragma("unroll") for (int k = 0; k < 2; ++k) \
        acc[ai][bj][m][n] = __builtin_amdgcn_mfma_f32_16x16x32_bf16(Bt[n][k], At[m][k], acc[ai][bj][m][n], 0, 0, 0); __builtin_amdgcn_s_setprio(0); } while (0)
#define PG8_WAIT_V(n) asm volatile("s_waitcnt vmcnt(" #n ")" ::: "memory")
#define PG8_WAIT_L(n) asm volatile("s_waitcnt lgkmcnt(" #n ")" ::: "memory")
#define PG8_BAR __builtin_amdgcn_s_barrier()
#define PG8_SCHED __builtin_amdgcn_sched_barrier(0)
    Unit cur, nxt; int ui = 0;
    if (!S.next(0, cur)) return;
    f32x4 acc[2][2][4][2];
#pragma unroll
    for (int a = 0; a < 2; ++a)
#pragma unroll
        for (int b = 0; b < 2; ++b)
#pragma unroll
            for (int m = 0; m < 4; ++m)
#pragma unroll
                for (int n = 0; n < 2; ++n) acc[a][b][m][n] = (f32x4){0.f, 0.f, 0.f, 0.f};
    bf16x8 At[4][2], B0[2][2], B1[2][2];
    const char* cA = (const char*)g.A + (size_t)cur.pm * tstep; const char* cB = (const char*)g.Bt + (size_t)cur.pn * tstep;
    S.a_ready(cur);
    if constexpr (SP2) {
        PG8_STAGE(PG8_SB(0, 0), cB, voffB); PG8_STAGE(PG8_SB(0, 1), cB + hstep, voffB); PG8_STAGE(PG8_SA(0, 0), cA, voffA); PG8_STAGE(PG8_SA(0, 1), cA + hstep, voffA);
        if (wr == 1) PG8_BAR;
        PG8_WAIT_V(2); PG8_BAR;
        PG8_STAGE(PG8_SB(1, 0), cB + kstep, voffB); PG8_STAGE(PG8_SA(1, 0), cA + kstep, voffA); PG8_STAGE(PG8_SB(1, 1), cB + hstep + kstep, voffB);
        PG8_WAIT_V(6); PG8_BAR;
    } else {
        PG8_STAGE(PG8_SB(0, 0), cB, voffB); PG8_STAGE(PG8_SA(0, 0), cA, voffA); PG8_STAGE(PG8_SB(0, 1), cB + hstep, voffB); PG8_STAGE(PG8_SA(0, 1), cA + hstep, voffA);
        if (wr == 1) PG8_BAR;
        PG8_WAIT_V(4); PG8_BAR;
        PG8_STAGE(PG8_SB(1, 0), cB + kstep, voffB); PG8_STAGE(PG8_SA(1, 0), cA + kstep, voffA); PG8_STAGE(PG8_SB(1, 1), cB + hstep + kstep, voffB);
        PG8_WAIT_V(6); PG8_BAR;
    }
    for (;;) {
        const bool has_next = S.next(ui + 1, nxt);
        const char* nA = has_next ? (const char*)g.A + (size_t)nxt.pm * tstep : cA; const char* nB = has_next ? (const char*)g.Bt + (size_t)nxt.pn * tstep : cB;
        for (int t = 0; t < nt; t += 2) {
            const bool last = (t == nt - 2);
            const char* a1 = cA + (size_t)(t + 1) * kstep;
            const char* a2 = last ? nA : cA + (size_t)(t + 2) * kstep; const char* b2 = last ? nB : cB + (size_t)(t + 2) * kstep;
            const char* a3 = a2 + kstep; const char* b3 = b2 + kstep;
            if (last && has_next) S.a_ready(nxt);
            if constexpr (SP2) {
            PG8_LDB(B0, 0, 0); PG8_LDB(B1, 0, 1); PG8_SCHED; PG8_LDA(At, 0, 0); PG8_STAGE(PG8_SA(1, 1), a1 + hstep, voffA);
            PG8_WAIT_V(8); PG8_WAIT_L(0); PG8_BAR; PG8_MMA(0, 0, At, B0); PG8_MMA(0, 1, At, B1); PG8_BAR; PG8_SCHED;
            PG8_LDA(At, 0, 1); PG8_STAGE(PG8_SB(0, 0), b2, voffB); PG8_STAGE(PG8_SB(0, 1), b2 + hstep, voffB); PG8_STAGE(PG8_SA(0, 0), a2, voffA);
            PG8_WAIT_V(8); PG8_WAIT_L(0); PG8_BAR; PG8_MMA(1, 0, At, B0); PG8_MMA(1, 1, At, B1); PG8_BAR; PG8_SCHED;
            PG8_LDB(B0, 1, 0); PG8_LDB(B1, 1, 1); PG8_SCHED; PG8_LDA(At, 1, 0); PG8_STAGE(PG8_SA(0, 1), a2 + hstep, voffA);
            PG8_WAIT_V(8); PG8_WAIT_L(0); PG8_BAR; PG8_MMA(0, 0, At, B0); PG8_MMA(0, 1, At, B1); PG8_BAR; PG8_SCHED;
            PG8_LDA(At, 1, 1); PG8_STAGE(PG8_SB(1, 0), b3, voffB); PG8_STAGE(PG8_SB(1, 1), b3 + hstep, voffB); PG8_STAGE(PG8_SA(1, 0), a3, voffA);
            PG8_WAIT_V(8); PG8_WAIT_L(0); PG8_BAR; PG8_MMA(1, 0, At, B0); PG8_MMA(1, 1, At, B1); PG8_BAR; PG8_SCHED;
            } else {
            PG8_LDB(B0, 0, 0); PG8_SCHED; PG8_LDA(At, 0, 0); PG8_STAGE(PG8_SA(1, 1), a1 + hstep, voffA);
            PG8_WAIT_L(8); PG8_BAR; PG8_WAIT_L(0); PG8_MMA(0, 0, At, B0); PG8_BAR; PG8_SCHED;
            PG8_LDB(B1, 0, 1); PG8_STAGE(PG8_SB(0, 0), b2, voffB);
            PG8_BAR; PG8_WAIT_L(0); PG8_MMA(0, 1, At, B1); PG8_BAR;
            PG8_LDA(At, 0, 1); PG8_STAGE(PG8_SA(0, 0), a2, voffA);
            PG8_BAR; PG8_WAIT_L(0); PG8_MMA(1, 0, At, B0); PG8_BAR; PG8_SCHED;
            PG8_STAGE(PG8_SB(0, 1), b2 + hstep, voffB);
            PG8_WAIT_V(6); PG8_BAR; PG8_MMA(1, 1, At, B1); PG8_BAR;
            PG8_LDB(B0, 1, 0); PG8_SCHED; PG8_LDA(At, 1, 0); PG8_STAGE(PG8_SA(0, 1), a2 + hstep, voffA);
            PG8_WAIT_L(8); PG8_BAR; PG8_WAIT_L(0); PG8_MMA(0, 0, At, B0); PG8_BAR; PG8_SCHED;
            PG8_LDB(B1, 1, 1); PG8_STAGE(PG8_SB(1, 0), b3, voffB);
            PG8_BAR; PG8_WAIT_L(0); PG8_MMA(0, 1, At, B1); PG8_BAR;
            PG8_LDA(At, 1, 1); PG8_STAGE(PG8_SA(1, 0), a3, voffA);
            PG8_BAR; PG8_WAIT_L(0); PG8_MMA(1, 0, At, B0); PG8_BAR; PG8_SCHED;
            PG8_STAGE(PG8_SB(1, 1), b3 + hstep, voffB);
            PG8_WAIT_V(6); PG8_BAR; PG8_MMA(1, 1, At, B1); PG8_BAR;
            }
        }
        if constexpr (ALIGN_EPI) { if (wr == 0) PG8_BAR; }
        if constexpr (!Epi::AFTER_DRAIN) { E(acc, cur, wr, wc, fr, fq); S.done(cur); }
        if (!has_next) break;
#pragma unroll
        for (int a = 0; a < 2; ++a)
#pragma unroll
            for (int b = 0; b < 2; ++b)
#pragma unroll
                for (int m = 0; m < 4; ++m)
#pragma unroll
                    for (int n = 0; n < 2; ++n) acc[a][b][m][n] = (f32x4){0.f, 0.f, 0.f, 0.f};
        cur = nxt; cA = nA; cB = nB; ++ui;
        if constexpr (ALIGN_EPI) { if (wr == 1) PG8_BAR; }
    }
    PG8_WAIT_V(0);
    if constexpr (!ALIGN_EPI) { if (wr == 0) PG8_BAR; }
    PG8_BAR;
    if constexpr (Epi::AFTER_DRAIN) { E.fused(acc, cur, wr, wc, fr, fq, lds, wid, lane); S.done(cur); }
#undef PG8_SA
#undef PG8_SB
#undef PG8_STAGE
#undef PG8_LDA
#undef PG8_LDB
#undef PG8_MMA
#undef PG8_WAIT_V
#undef PG8_WAIT_L
#undef PG8_BAR
#undef PG8_SCHED
}
}
#define GAS __attribute__((address_space(1)))
#define LAS __attribute__((address_space(3)))
typedef GAS unsigned gu32;
typedef GAS unsigned long long gu64;
#define RLX_AGENT __ATOMIC_RELAXED, __HIP_MEMORY_SCOPE_AGENT
#define LDS_WAIT() asm volatile("s_waitcnt lgkmcnt(0)" ::: "memory")
#define VM_WAIT() asm volatile("s_waitcnt vmcnt(0)" ::: "memory")
__device__ __forceinline__ unsigned long long rt() { return __builtin_amdgcn_s_memrealtime(); }
#define XB_TMO      128
#define XB_XCNT(j)  (256  + 64 * (j))
#define XB_XSUB(j)  (1280 + 64 * (j))
#define XB_XGEN(j)  (2304 + 64 * (j))
#define XB_TOP      3328
#define XB_TOPGEN   3392
#define XCD_BAR_WORDS 3456
#define XB_SPIN_CAP (1u << 18)

__device__ __forceinline__ unsigned xb_ld(unsigned* p)              { return __hip_atomic_load(p, __ATOMIC_RELAXED, __HIP_MEMORY_SCOPE_AGENT); }
__device__ __forceinline__ unsigned xb_add(unsigned* p, unsigned v) { return __hip_atomic_fetch_add(p, v, __ATOMIC_RELAXED, __HIP_MEMORY_SCOPE_AGENT); }
__device__ __forceinline__ unsigned xb_xcc_id() { return (unsigned)__builtin_amdgcn_s_getreg((3 << 11) | 20) & 0xFu; }
#define XB_SPIN(cond, bar) do { unsigned _sp = 0; while (cond) { __builtin_amdgcn_s_sleep(1); \
    if ((++_sp & 255u) == 0u) { if (xb_ld(&(bar)[XB_TMO])) break; if (_sp > XB_SPIN_CAP) { atomicAdd(&(bar)[XB_TMO], 1u); break; } } } } while (0)

struct XcdBarrier {
    unsigned* bar; unsigned x;
    volatile LAS unsigned* st;
};

__device__ __forceinline__ XcdBarrier xcd_barrier_post(unsigned* bar, volatile LAS unsigned* st) {
    XcdBarrier b; b.bar = bar; b.x = xb_xcc_id(); b.st = st;
    if (threadIdx.x == 0) (void)xb_add(&bar[XB_XCNT(b.x)], 1u);
    return b;
}
__device__ __forceinline__ void xcd_barrier_complete(unsigned* bar, unsigned x, unsigned& nloc, unsigned& nx) {
    const unsigned G = gridDim.x * gridDim.y * gridDim.z;
    unsigned sum, cnt, mine, sp = 0u;
    for (;;) {
        sum = 0u; cnt = 0u; mine = 0u;
#pragma unroll
        for (unsigned j = 0; j < 16; ++j) { const unsigned c = xb_ld(&bar[XB_XCNT(j)]); sum += c; cnt += (c > 0u) ? 1u : 0u; mine = (j == x) ? c : mine; }
        if (sum == G) break;
        __builtin_amdgcn_s_sleep(1);
        if ((++sp & 255u) == 0u) { if (xb_ld(&bar[XB_TMO])) break; if (sp > XB_SPIN_CAP) { atomicAdd(&bar[XB_TMO], 1u); break; } }
    }
    nloc = mine > 0u ? mine : 1u; nx = cnt > 0u ? cnt : 1u;
}

__device__ __forceinline__ void xcd_barrier(const XcdBarrier& b) {
    asm volatile("s_waitcnt vmcnt(0)" ::: "memory");
    __syncthreads();
    if (threadIdx.x == 0) {
        unsigned* bar = b.bar;
        __builtin_amdgcn_s_waitcnt(0);
        unsigned nloc = b.st[0], nx = b.st[1];
        if (nloc == 0u) { xcd_barrier_complete(bar, b.x, nloc, nx); b.st[0] = nloc; b.st[1] = nx; }
        const unsigned old = xb_add(&bar[XB_XSUB(b.x)], 1u);
        const unsigned gen = old / nloc;
        if (old + 1u == (gen + 1u) * nloc) {
            __builtin_amdgcn_fence(__ATOMIC_RELEASE, "agent");
            asm volatile("s_waitcnt vmcnt(0)" ::: "memory");
            const unsigned og = xb_add(&bar[XB_TOP], 1u);
            const unsigned tg = og / nx;
            if (og + 1u == (tg + 1u) * nx) xb_add(&bar[XB_TOPGEN], 1u);
            else XB_SPIN(xb_ld(&bar[XB_TOPGEN]) == tg, bar);
            __builtin_amdgcn_fence(__ATOMIC_ACQUIRE, "agent");
            xb_add(&bar[XB_XGEN(b.x)], 1u);
            asm volatile("s_waitcnt vmcnt(0)" ::: "memory");
        } else {
            XB_SPIN(xb_ld(&bar[XB_XGEN(b.x)]) == gen, bar);
            __builtin_amdgcn_fence(__ATOMIC_ACQUIRE, "agent");
            asm volatile("s_waitcnt vmcnt(0)" ::: "memory");
        }
    }
    __syncthreads();
}


constexpr int NB = 2, SEQ = 8192, DM = 1024, DEPTH = 4, NMETA = 16, LP = 8320, M = NB * LP;
constexpr int N_IN = 5384, N1 = 5376, NRW = 1792, NGT = 2048, DFF = 2816, NUP = 5632;
constexpr float LOG2E = 1.4426950408889634f;
constexpr float QSCALE = 0.125f * LOG2E;
constexpr float THR2 = 30.0f * LOG2E;
constexpr int NWAVES = 8, NTHR = 512, MMAIN = 16384;
constexpr int LDS_BYTES = 147456, MISC_OFF = 147456 - 128;

typedef unsigned short bf16;
typedef float f32x4 __attribute__((ext_vector_type(4)));
typedef unsigned u32x4 __attribute__((ext_vector_type(4)));
typedef unsigned u32x2 __attribute__((ext_vector_type(2)));
typedef short bf16x8 __attribute__((ext_vector_type(8)));

constexpr size_t SZ_H = (size_t)M * DM * 4, SZ_X512 = (size_t)M * 512 * 2;
constexpr size_t OFF_CTL = 0, OFF_H = 1u << 20, OFF_WT = OFF_H + SZ_H;
constexpr size_t WT_IN = 0, WT_BF = WT_IN + (size_t)N1 * 1024, WT_BR = WT_BF + 1024 * 512, WT_O = WT_BR + 1024 * 512,
                 WT_UP = WT_O + 1024 * 1024, WT_DN = WT_UP + (size_t)NUP * 1024, WT_LW = WT_DN + (size_t)1024 * DFF, WT_LA = WT_LW + 512 * 64, WT_LG = WT_LA + 512 * 64, WT_END = WT_LG + 512 * 128;
constexpr size_t OFF_HN = OFF_WT + WT_END * 2;
constexpr size_t OFF_Q = OFF_HN + 2 * SZ_X512, OFF_K = OFF_Q + SZ_X512, OFF_V = OFF_K + SZ_X512;
constexpr size_t OFF_RW = OFF_V + SZ_X512, OFF_GT = OFF_RW + (size_t)M * NRW * 2, OFF_MISC = OFF_GT + (size_t)M * NGT * 2;
constexpr size_t OFF_T0 = OFF_MISC + 2 * 16 * LP * 4, OFF_OF = OFF_T0 + 2 * SZ_X512, OFF_TAIL = OFF_OF + SZ_X512, WS_NEED = OFF_TAIL + 256 * 1024 * 2;
static_assert(OFF_HN % 256 == 0 && OFF_RW % 256 == 0 && OFF_T0 % 256 == 0, "alignment");

struct Params { const float* in[26]; float* out; unsigned char* ws; };
struct Ctx { int tid, lane, wave, bid, G; unsigned char* lds; unsigned char* ws; };

__device__ __forceinline__ float bf2f(unsigned b) { return __uint_as_float(b << 16); }
__device__ __forceinline__ float bflo(unsigned w) { return __uint_as_float(w << 16); }
__device__ __forceinline__ float bfhi(unsigned w) { return __uint_as_float(w & 0xffff0000u); }
typedef float f32x2_t_ __attribute__((ext_vector_type(2))); typedef __bf16 bf16x2_t_ __attribute__((ext_vector_type(2)));
__device__ __forceinline__ unsigned pk2(float lo, float hi) { const f32x2_t_ v = {lo, hi}; const bf16x2_t_ r = __builtin_convertvector(v, bf16x2_t_); return __builtin_bit_cast(unsigned, r); }
__device__ __forceinline__ unsigned f2bf(float f) { return pk2(f, 0.f) & 0xffffu; }
__device__ __forceinline__ float wave_sum(float v) {
#pragma unroll
    for (int o = 1; o < 64; o <<= 1) v += __shfl_xor(v, o);
    return v;
}
__device__ __forceinline__ float sigmoidf_(float x) { return __builtin_amdgcn_rcpf(1.f + __expf(-x)); }
template <int CTRL> __device__ __forceinline__ float dppf(float old, float x) {
    return __int_as_float(__builtin_amdgcn_update_dpp(__float_as_int(old), __float_as_int(x), CTRL, 0xf, 0xf, false));
}
__device__ __forceinline__ float allreduce16(float x) {
    x += dppf<0x121>(0.f, x); x += dppf<0x122>(0.f, x); x += dppf<0x124>(0.f, x); x += dppf<0x128>(0.f, x); return x;
}

namespace pg8 {
struct EpiRoute {
    static constexpr bool PERM = true, AFTER_DRAIN = false;
    unsigned char* ws;
    __device__ __forceinline__ void operator()(const f32x4 (&acc)[2][2][4][2], const Unit& u, int wr, int wc, int fr, int fq) const {
        const int pn = u.pn; size_t off; int ldc, colt;
        if (pn < 6) { off = OFF_Q + (size_t)(pn >> 1) * SZ_X512; ldc = 512; colt = (pn & 1) * 256; }
        else if (pn < 13) { off = OFF_RW; ldc = NRW; colt = (pn - 6) * 256; }
        else { off = OFF_GT; ldc = NGT; colt = (pn - 13) * 256; }
        bf16_t* base = (bf16_t*)(ws + off);
        const int row0 = u.pm * BM + wr * 64 + fr, col0 = colt + wc * 32 + 8 * fq;
#pragma unroll
        for (int ai = 0; ai < 2; ++ai)
#pragma unroll
            for (int m = 0; m < 4; ++m) { bf16_t* rowp = base + (size_t)(row0 + ai * HALF + m * 16) * ldc + col0;
#pragma unroll
                for (int bj = 0; bj < 2; ++bj) { const f32x4 v0 = acc[ai][bj][m][0], v1 = acc[ai][bj][m][1];
                    u32x4 w; w.x = cvt_pk_bf16(v0[0], v0[1]); w.y = cvt_pk_bf16(v0[2], v0[3]); w.z = cvt_pk_bf16(v1[0], v1[1]); w.w = cvt_pk_bf16(v1[2], v1[3]);
                    *(u32x4*)(rowp + bj * HALF) = w; } }
    }
};
struct EpiGateR {
    static constexpr bool PERM = true, AFTER_DRAIN = false;
    bf16_t* O; const bf16_t* GT; const float* gb; int goff, accum;
    __device__ __forceinline__ void operator()(const f32x4 (&acc)[2][2][4][2], const Unit& u, int wr, int wc, int fr, int fq) const {
        const int row0 = u.pm * BM + wr * 64 + fr, col0 = u.pn * BM + wc * 32 + 8 * fq;
#pragma unroll
        for (int bj = 0; bj < 2; ++bj) {
            const int c = col0 + bj * HALF;
            const f32x4 b0 = *(const f32x4*)(gb + goff + c), b1 = *(const f32x4*)(gb + goff + c + 4);
#pragma unroll
            for (int ai = 0; ai < 2; ++ai)
#pragma unroll
                for (int m = 0; m < 4; ++m) {
                    const size_t row = (size_t)(row0 + ai * HALF + m * 16);
                    const u32x4 gw = *(const u32x4*)(GT + row * NGT + goff + c);
                    const f32x4 v0 = acc[ai][bj][m][0], v1 = acc[ai][bj][m][1];
                    float r[8];
                    r[0] = sigmoidf_(bflo(gw.x) + b0[0]) * v0[0]; r[1] = sigmoidf_(bfhi(gw.x) + b0[1]) * v0[1];
                    r[2] = sigmoidf_(bflo(gw.y) + b0[2]) * v0[2]; r[3] = sigmoidf_(bfhi(gw.y) + b0[3]) * v0[3];
                    r[4] = sigmoidf_(bflo(gw.z) + b1[0]) * v1[0]; r[5] = sigmoidf_(bfhi(gw.z) + b1[1]) * v1[1];
                    r[6] = sigmoidf_(bflo(gw.w) + b1[2]) * v1[2]; r[7] = sigmoidf_(bfhi(gw.w) + b1[3]) * v1[3];
                    bf16_t* op = O + row * 1024 + c;
                    if (accum) { const u32x4 ow = *(const u32x4*)op;
                        r[0] += bflo(ow.x); r[1] += bfhi(ow.x); r[2] += bflo(ow.y); r[3] += bfhi(ow.y); r[4] += bflo(ow.z); r[5] += bfhi(ow.z); r[6] += bflo(ow.w); r[7] += bfhi(ow.w); }
                    u32x4 w; w.x = cvt_pk_bf16(r[0], r[1]); w.y = cvt_pk_bf16(r[2], r[3]); w.z = cvt_pk_bf16(r[4], r[5]); w.w = cvt_pk_bf16(r[6], r[7]);
                    *(u32x4*)op = w;
                }
        }
    }
};
struct EpiResid {
    static constexpr bool PERM = false, AFTER_DRAIN = false;
    float* H; float* OUT; int atomic;
    __device__ __forceinline__ void operator()(const f32x4 (&acc)[2][2][4][2], const Unit& u, int wr, int wc, int fr, int fq) const {
        const int row0 = u.pm * BM + wr * 64 + fr, col0 = u.pn * BM + wc * 32 + 4 * fq;
#pragma unroll
        for (int ai = 0; ai < 2; ++ai)
#pragma unroll
            for (int m = 0; m < 4; ++m) {
                const int row = row0 + ai * HALF + m * 16;
                float* hp = H + (size_t)row * DM + col0;
                const int b = row >= LP ? 1 : 0, t = row - b * LP;
                float* op = (OUT && t >= NMETA && t < NMETA + SEQ) ? OUT + ((size_t)b * SEQ + (t - NMETA)) * DM + col0 : nullptr;
#pragma unroll
                for (int bj = 0; bj < 2; ++bj)
#pragma unroll
                    for (int n = 0; n < 2; ++n) { const int co = bj * HALF + n * 16;
                        if (atomic) {
                            if (row < LP + NMETA + SEQ) {
#pragma unroll
                                for (int e = 0; e < 4; ++e) unsafeAtomicAdd(hp + co + e, acc[ai][bj][m][n][e]); }
                        } else {
                            const f32x4 v = *(const f32x4*)(hp + co) + acc[ai][bj][m][n];
                            if (OUT) { if (op) *(f32x4*)(op + co) = v; } else *(f32x4*)(hp + co) = v; } }
            }
    }
};
struct EpiResidAtomic {
    static constexpr bool PERM = false, AFTER_DRAIN = false;
    float* H;
    __device__ __forceinline__ void operator()(const f32x4 (&acc)[2][2][4][2], const Unit& u, int wr, int wc, int fr, int fq) const {
        const int row0 = u.pm * BM + wr * 64 + fr, col0 = u.pn * BM + wc * 32 + 4 * fq;
#pragma unroll
        for (int ai = 0; ai < 2; ++ai)
#pragma unroll
            for (int m = 0; m < 4; ++m) { float* hp = H + (size_t)(row0 + ai * HALF + m * 16) * DM + col0;
#pragma unroll
                for (int bj = 0; bj < 2; ++bj)
#pragma unroll
                    for (int n = 0; n < 2; ++n)
#pragma unroll
                        for (int e = 0; e < 4; ++e) unsafeAtomicAdd(hp + bj * HALF + n * 16 + e, acc[ai][bj][m][n][e]); }
    }
};
struct OneUnit {
    StaticOrder so; int mode, pm, pn; bool active;
    __device__ bool next(int i, Unit& u) const { if (mode == 0) return so.next(i, u); if (i != 0 || !active) return false; u.pm = pm; u.pn = pn; return true; }
    __device__ __forceinline__ void a_ready(const Unit&) const {}
    __device__ __forceinline__ void done(const Unit&) const {}
};
struct EpiUp {
    static constexpr bool PERM = true, AFTER_DRAIN = false;
    bf16_t* ACT; bf16_t* HALO; const float* cw;
    __device__ __forceinline__ void operator()(const f32x4 (&acc)[2][2][4][2], const Unit& u, int wr, int wc, int fr, int fq) const {
        const int chan0 = u.pn * 128 + wc * 32 + 8 * fq;
#pragma unroll
        for (int n = 0; n < 2; ++n) {
            const int ch = chan0 + 4 * n;
            f32x4 w[3][2];
#pragma unroll
            for (int j = 0; j < 3; ++j) { w[j][0] = *(const f32x4*)(cw + j * NUP + ch); w[j][1] = *(const f32x4*)(cw + j * NUP + DFF + ch); }
#pragma unroll
            for (int ai = 0; ai < 2; ++ai) {
                const int rowg = u.pm * BM + ai * HALF + wr * 64;
#pragma unroll
                for (int m = 0; m < 4; ++m) {
                    f32x4 uc[2];
#pragma unroll
                    for (int bj = 0; bj < 2; ++bj) {
                        const f32x4 cur = acc[ai][bj][m][n];
                        f32x4 prv; if (m > 0) prv = acc[ai][bj][m - 1][n]; else prv = (f32x4){0.f, 0.f, 0.f, 0.f};
                        f32x4 p1, p2;
#pragma unroll
                        for (int i = 0; i < 4; ++i) {
                            const float r1 = dppf<0x121>(0.f, prv[i]), r2 = dppf<0x122>(0.f, prv[i]);
                            p1[i] = dppf<0x111>(r1, cur[i]); p2[i] = dppf<0x112>(r2, cur[i]);
                        }
                        uc[bj] = w[0][bj] * p2 + w[1][bj] * p1 + w[2][bj] * cur;
                    }
                    float a[4];
#pragma unroll
                    for (int i = 0; i < 4; ++i) a[i] = uc[0][i] * sigmoidf_(uc[0][i]) * uc[1][i];
                    u32x2 o; o.x = cvt_pk_bf16(a[0], a[1]); o.y = cvt_pk_bf16(a[2], a[3]);
                    *(u32x2*)(ACT + (size_t)(rowg + m * 16 + fr) * DFF + ch) = o;
                    if ((m == 3 && fr >= 14) || (m == 0 && fr < 2)) {
                        const int slot = (rowg >> 6) * 4 + (m == 3 ? fr - 14 : 2 + fr);
#pragma unroll
                        for (int bj = 0; bj < 2; ++bj) { const f32x4 cur = acc[ai][bj][m][n]; u32x2 hw; hw.x = cvt_pk_bf16(cur[0], cur[1]); hw.y = cvt_pk_bf16(cur[2], cur[3]);
                            *(u32x2*)(HALO + (size_t)slot * NUP + bj * DFF + ch) = hw; }
                    }
                }
            }
        }
    }
};
}

#ifndef REP_PREP
#define REP_PREP 1
#endif
#ifndef REP_P3
#define REP_P3 1
#endif
#ifndef REP_SYNC
#define REP_SYNC 0
#endif
#define GLD(T, p) (*(const __attribute__((address_space(1))) T*)(p))
#define GST(T, p) (*(__attribute__((address_space(1))) T*)(p))
#define LDS_BARRIER() do { asm volatile("s_waitcnt lgkmcnt(0)" ::: "memory"); __builtin_amdgcn_s_barrier(); asm volatile("" ::: "memory"); } while (0)
__device__ __forceinline__ void transpose_item(const float* W, int Nsrc, int K, bf16* WT, int dst_row0, int src_col0, int k0, float* scr, int lane) {
#pragma unroll 8
    for (int i = 0; i < 32; ++i) { const int kk = 2 * i + (lane >> 5); scr[kk * 33 + (lane & 31)] = W[(size_t)(k0 + kk) * Nsrc + src_col0 + (lane & 31)]; }
    asm volatile("s_waitcnt lgkmcnt(0)" ::: "memory");
    const int c = lane & 7;
#pragma unroll
    for (int j = 0; j < 4; ++j) { const int n = (lane >> 3) + 8 * j; const float* s = scr + (8 * c) * 33 + n;
        u32x4 o; o.x = pk2(s[0 * 33], s[1 * 33]); o.y = pk2(s[2 * 33], s[3 * 33]); o.z = pk2(s[4 * 33], s[5 * 33]); o.w = pk2(s[6 * 33], s[7 * 33]);
        *(u32x4*)(WT + (size_t)(dst_row0 + n) * K + k0 + 8 * c) = o; }
    asm volatile("s_waitcnt lgkmcnt(0)" ::: "memory");
}
__device__ __forceinline__ void convert_weights(const Params& P, int l, const Ctx& c) {
    bf16* WT = (bf16*)(c.ws + OFF_WT);
    float* scr = (float*)(c.lds + c.wave * 16384);
    const int gw = c.bid * NWAVES + c.wave, NGW = c.G * NWAVES;
    constexpr int I_IN = 16 * 168, I_BF = 8 * 32, I_O = 16 * 32, I_UP = 16 * 176, I_DN = 44 * 32, I_LR = 16, I_LG = 32, I_ALL = I_IN + 2 * I_BF + I_O + I_UP + I_DN + 2 * I_LR + I_LG;
    for (int it = gw; it < I_ALL; it += NGW) {
        int r = it;
        if (r < I_IN) { const int kb = r / 168, n0 = 32 * (r % 168); transpose_item(P.in[4] + (size_t)l * 1024 * N_IN, N_IN, 1024, WT + WT_IN, n0, n0 + (n0 >= 1536 ? 8 : 0), 64 * kb, scr, c.lane); continue; } r -= I_IN;
        if (r < I_BF) { const int kb = r / 32, n0 = 32 * (r % 32); transpose_item(P.in[19] + (size_t)l * 512 * 1024, 1024, 512, WT + WT_BF, n0, n0, 64 * kb, scr, c.lane); continue; } r -= I_BF;
        if (r < I_BF) { const int kb = r / 32, n0 = 32 * (r % 32); transpose_item(P.in[20] + (size_t)l * 512 * 1024, 1024, 512, WT + WT_BR, n0, n0, 64 * kb, scr, c.lane); continue; } r -= I_BF;
        if (r < I_O) { const int kb = r / 32, n0 = 32 * (r % 32); transpose_item(P.in[22] + (size_t)l * 1024 * 1024, 1024, 1024, WT + WT_O, n0, n0, 64 * kb, scr, c.lane); continue; } r -= I_O;
        if (r < I_UP) { const int kb = r / 176, n0 = 32 * (r % 176); const int pn = n0 >> 8, bj = (n0 >> 7) & 1, x = n0 & 127;
            transpose_item(P.in[23] + (size_t)l * 1024 * NUP, NUP, 1024, WT + WT_UP, n0, bj * DFF + 128 * pn + x, 64 * kb, scr, c.lane); continue; } r -= I_UP;
        if (r < I_DN) { const int kb = r / 32, n0 = 32 * (r % 32); transpose_item(P.in[25] + (size_t)l * DFF * 1024, 1024, DFF, WT + WT_DN, n0, n0, 64 * kb, scr, c.lane); continue; } r -= I_DN;
        if (r < I_LR) { transpose_item(P.in[10] + (size_t)l * 64 * 512, 512, 64, WT + WT_LW, 32 * r, 32 * r, 0, scr, c.lane); continue; } r -= I_LR;
        if (r < I_LR) { transpose_item(P.in[12] + (size_t)l * 64 * 512, 512, 64, WT + WT_LA, 32 * r, 32 * r, 0, scr, c.lane); continue; } r -= I_LR;
        { const int kb = r / 16, n0 = 32 * (r % 16); transpose_item(P.in[13] + (size_t)l * 128 * 512, 512, 128, WT + WT_LG, n0, n0, 64 * kb, scr, c.lane); }
    }
}

template <bool FG> __device__ __forceinline__ void phase_norm(const Params& P, int l, const Ctx& c) {
    float* H = (float*)(c.ws + OFF_H); bf16* HN = (bf16*)(c.ws + OFF_HN);
    float* LOGF = (float*)(c.ws + OFF_MISC);
    const float* gain = (FG ? P.in[2] : P.in[3]) + l * DM;
    float* wfs = (float*)c.lds;
    if (FG) {
        __syncthreads();
        const float* win = P.in[4] + (size_t)l * 1024 * N_IN + 1536;
        for (int i = c.tid; i < 8192; i += NTHR) wfs[i] = win[(size_t)(i >> 3) * N_IN + (i & 7)];
        __syncthreads();
    }
    const int gw = c.bid * NWAVES + c.wave, NGW = c.G * NWAVES;
    for (int m = gw; m < M; m += NGW) {
        const int b = m >= LP ? 1 : 0, t = m - b * LP;
        f32x4 v[4];
        if (FG && l == 0) {
            const float* src = (t < NMETA) ? P.in[1] + (size_t)t * DM : P.in[0] + ((size_t)b * SEQ + (t - NMETA)) * DM;
            const bool real = t < NMETA + SEQ;
#pragma unroll
            for (int j = 0; j < 4; ++j) { v[j] = real ? *(const f32x4*)(src + 4 * c.lane + 256 * j) : (f32x4){0.f, 0.f, 0.f, 0.f}; *(f32x4*)(H + (size_t)m * DM + 4 * c.lane + 256 * j) = v[j]; }
        } else {
#pragma unroll
            for (int j = 0; j < 4; ++j) v[j] = *(const f32x4*)(H + (size_t)m * DM + 4 * c.lane + 256 * j);
        }
        float ss = 0.f;
#pragma unroll
        for (int j = 0; j < 4; ++j) ss += (v[j].x * v[j].x + v[j].y * v[j].y) + (v[j].z * v[j].z + v[j].w * v[j].w);
        const float rstd = 1.0f / sqrtf(wave_sum(ss) * (1.f / DM) + 1e-6f);
        float f[8];
#pragma unroll
        for (int q = 0; q < 8; ++q) f[q] = 0.f;
#pragma unroll
        for (int j = 0; j < 4; ++j) {
            const f32x4 g = *(const f32x4*)(gain + 4 * c.lane + 256 * j);
            v[j] = v[j] * rstd * g;
            u32x2 o; o.x = pk2(v[j].x, v[j].y); o.y = pk2(v[j].z, v[j].w);
            *(u32x2*)(HN + (size_t)m * DM + 4 * c.lane + 256 * j) = o;
            if (FG) {
#pragma unroll
                for (int e = 0; e < 4; ++e) { const int k = 4 * c.lane + 256 * j + e; const f32x4 w0 = *(const f32x4*)(wfs + k * 8), w1 = *(const f32x4*)(wfs + k * 8 + 4);
                    const float hv = v[j][e];
                    f[0] += hv * w0.x; f[1] += hv * w0.y; f[2] += hv * w0.z; f[3] += hv * w0.w; f[4] += hv * w1.x; f[5] += hv * w1.y; f[6] += hv * w1.z; f[7] += hv * w1.w; }
            }
        }
        if (FG) {
#pragma unroll
            for (int q = 0; q < 8; ++q) f[q] = wave_sum(f[q]);
            float fv = f[0];
#pragma unroll
            for (int q = 1; q < 8; ++q) fv = (c.lane == q) ? f[q] : fv;
            if (c.lane < 8) { const float x = fv + P.in[7][l * 8 + c.lane]; const float ls = fminf(x, 0.f) - __logf(1.f + __expf(-fabsf(x))); LOGF[(size_t)(b * 8 + c.lane) * LP + t] = ls; }
        }
    }
}

__device__ __forceinline__ void phase_fcum(const Params& P, const Ctx& c) {
    const int s = c.bid - (c.G - 16);
    if (s < 0) return;
    const float* LOGF = (const float*)(c.ws + OFF_MISC) + (size_t)s * LP; float* FC = (float*)(c.ws + OFF_MISC) + 16 * LP + (size_t)s * LP;
    float* wt = (float*)c.lds;
    const int base = c.tid * 17;
    float v[17]; float run = 0.f;
#pragma unroll
    for (int i = 0; i < 17; ++i) { const int idx = base + i; const float x = (idx < LP) ? LOGF[idx] : 0.f; run += x; v[i] = run; }
    float incl = run;
#pragma unroll
    for (int o = 1; o < 64; o <<= 1) { const float t = __shfl_up(incl, o); if (c.lane >= o) incl += t; }
    if (c.lane == 63) wt[c.wave] = incl;
    __syncthreads();
    float off = incl - run;
#pragma unroll
    for (int w2 = 0; w2 < 8; ++w2) off += (w2 < c.wave) ? wt[w2] : 0.f;
#pragma unroll
    for (int i = 0; i < 17; ++i) { const int idx = base + i; if (idx < LP) FC[idx] = (v[i] + off) * LOG2E; }
    __syncthreads();
}

__device__ __forceinline__ void phase_qknorm(const Params& P, int l, const Ctx& c) {
    bf16* Q = (bf16*)(c.ws + OFF_Q); bf16* K = (bf16*)(c.ws + OFF_K);
    const int gw = c.bid * NWAVES + c.wave, NGW = c.G * NWAVES;
    const int d0 = (c.lane & 7) * 8;
    float gq[8], gk[8];
#pragma unroll
    for (int i = 0; i < 8; ++i) { gq[i] = P.in[5][l * 64 + d0 + i] * QSCALE; gk[i] = P.in[6][l * 64 + d0 + i]; }
    for (int m = gw; m < M; m += NGW) {
#pragma unroll
        for (int which = 0; which < 2; ++which) {
            bf16* p = (which ? K : Q) + (size_t)m * 512 + 8 * c.lane;
            const u32x4 w = *(const u32x4*)p;
            float x[8] = {bflo(w.x), bfhi(w.x), bflo(w.y), bfhi(w.y), bflo(w.z), bfhi(w.z), bflo(w.w), bfhi(w.w)};
            float ss = 0.f;
#pragma unroll
            for (int i = 0; i < 8; ++i) ss += x[i] * x[i];
            ss += __shfl_xor(ss, 1); ss += __shfl_xor(ss, 2); ss += __shfl_xor(ss, 4);
            const float rs = 1.0f / sqrtf(ss * (1.f / 64.f) + 1e-6f);
#pragma unroll
            for (int i = 0; i < 8; ++i) x[i] = x[i] * rs * (which ? gk[i] : gq[i]);
            u32x4 o; o.x = pk2(x[0], x[1]); o.y = pk2(x[2], x[3]); o.z = pk2(x[4], x[5]); o.w = pk2(x[6], x[7]);
            *(u32x4*)p = o;
        }
    }
}

constexpr int NCHK = LP / 64;
constexpr int NUNIT = NB * NCHK * 8;
constexpr int UNIT_A = 16384, UNIT_B = 16640;
constexpr int ST = 72, STG = 136;
constexpr int L_F0 = 92160, L_F1 = 108544;
struct RwkvBufs { bf16 *BON, *G; unsigned char *UA, *UB; float* Y; bf16* ORW; };
__device__ __forceinline__ RwkvBufs rwkv_bufs(const Params& P, const Ctx& c) {
    RwkvBufs r; r.BON = (bf16*)(c.ws + OFF_HN); r.G = r.BON + (size_t)M * 512;
    r.UA = c.ws + OFF_T0; r.UB = (unsigned char*)P.out;
    r.Y = (float*)(c.ws + OFF_RW); r.ORW = (bf16*)(c.ws + OFF_RW + (size_t)M * 512 * 4);
    return r;
}
__device__ __forceinline__ void mm_tile(const bf16* A, int sa, const bf16* Bt, int sb, int nks, f32x4 (&acc)[2], int w, int lq, int g) {
    const int mt = w >> 1, nt0 = 2 * (w & 1);
    for (int ks = 0; ks < nks; ++ks) {
        const bf16x8 a = *(const bf16x8*)(A + (16 * mt + lq) * sa + 32 * ks + 8 * g);
#pragma unroll
        for (int q = 0; q < 2; ++q) { const bf16x8 b = *(const bf16x8*)(Bt + (16 * (nt0 + q) + lq) * sb + 32 * ks + 8 * g); acc[q] = __builtin_amdgcn_mfma_f32_16x16x32_bf16(a, b, acc[q], 0, 0, 0); }
    }
}
template <bool SA, bool SB> __device__ __forceinline__ void mm_tile2(const bf16* A, int sa, const bf16* Bt, int sb, int nks, f32x4 (&acc)[2], int w, int lq, int g) {
    const int mt = w >> 1, nt0 = 2 * (w & 1);
    const int ra = 16 * mt + lq, xa = SA ? 8 * ((ra >> 3) & 7) : 0;
    for (int ks = 0; ks < nks; ++ks) {
        const bf16x8 a = *(const bf16x8*)(A + ra * sa + ((32 * ks + 8 * g) ^ xa));
#pragma unroll
        for (int q = 0; q < 2; ++q) { const int rb = 16 * (nt0 + q) + lq, xb = SB ? 8 * ((rb >> 3) & 7) : 0;
            const bf16x8 bb = *(const bf16x8*)(Bt + rb * sb + ((32 * ks + 8 * g) ^ xb)); acc[q] = __builtin_amdgcn_mfma_f32_16x16x32_bf16(a, bb, acc[q], 0, 0, 0); }
    }
}
#define ZACC(a) do { a[0] = (f32x4){0.f, 0.f, 0.f, 0.f}; a[1] = (f32x4){0.f, 0.f, 0.f, 0.f}; } while (0)
__device__ __forceinline__ int permk(int k) { return 32 * (k >> 5) + 8 * ((k & 15) >> 2) + 4 * ((k >> 4) & 1) + (k & 3); }
__device__ __forceinline__ int swz(int row, int col) { return row * 128 + ((((col >> 3) ^ (row >> 1)) & 7) << 4) + (col & 7) * 2; }

__device__ __forceinline__ void rwkv_prep_unit(const Params& P, int l, const Ctx& c, int u, const RwkvBufs& B, const float (&pw0)[8], const float (&pa0)[8], const float (&pkk)[8], const float (&pka)[8], const float (&prk)[8]) {
    const int h = u & 7, bc = u >> 3, b = bc / NCHK, ch = bc - b * NCHK;
    const size_t m0 = (size_t)b * LP + ch * 64;
    int tid_ = c.tid; asm volatile("" : "+v"(tid_));
    const int tid = tid_, lane = tid & 63, w = c.wave, lq = lane & 15, g = lane >> 4;
    const int t = tid >> 3, cg = tid & 7, c0 = cg * 8, jb = h * 64 + c0;
    unsigned char* L = c.lds;
    bf16* A0 = (bf16*)L; bf16* A1 = A0 + 4608; bf16* A2 = A1 + 4608; bf16* A3 = A2 + 4608; bf16* A4 = A3 + 4608; bf16* A5 = A4 + 4608; bf16* A6 = A5 + 4608;
    bf16* A7 = A6 + 4608; bf16* A8 = A7 + 4608; bf16* A9 = A8 + 4608;
    float* F0 = (float*)(L + L_F0); float* F1 = (float*)(L + L_F1);
    const bf16* RW = (const bf16*)(c.ws + OFF_RW);
    const bf16* WT = (const bf16*)(c.ws + OFF_WT);
    const float* mu = P.in[8] + l * NRW;
    const bool first = (ch == 0 && t == 0);
    const bf16* cur = RW + (m0 + t) * NRW; const bf16* prv = cur - NRW;
    float zr[8], zk[8], zv[8];
#pragma unroll
    for (int s = 0; s < 3; ++s) {
        const u32x4 cw = *(const u32x4*)(cur + s * 512 + jb); u32x4 pw = (u32x4){0u, 0u, 0u, 0u}; if (!first) pw = *(const u32x4*)(prv + s * 512 + jb);
        const float cv[8] = {bflo(cw.x), bfhi(cw.x), bflo(cw.y), bfhi(cw.y), bflo(cw.z), bfhi(cw.z), bflo(cw.w), bfhi(cw.w)};
        const float pv[8] = {bflo(pw.x), bfhi(pw.x), bflo(pw.y), bfhi(pw.y), bflo(pw.z), bfhi(pw.z), bflo(pw.w), bfhi(pw.w)};
#pragma unroll
        for (int i = 0; i < 8; ++i) { const float z = cv[i] + mu[s * 512 + jb + i] * (pv[i] - cv[i]); if (s == 0) zr[i] = z; else if (s == 1) zk[i] = z; else zv[i] = z; }
    }
#pragma unroll
    for (int q4 = 0; q4 < 4; ++q4) {
        const int col = cg * 32 + q4 * 8;
        const u32x4 cw = *(const u32x4*)(cur + 1536 + col); u32x4 pw = (u32x4){0u, 0u, 0u, 0u}; if (!first) pw = *(const u32x4*)(prv + 1536 + col);
        const float cv[8] = {bflo(cw.x), bfhi(cw.x), bflo(cw.y), bfhi(cw.y), bflo(cw.z), bfhi(cw.z), bflo(cw.w), bfhi(cw.w)};
        const float pv[8] = {bflo(pw.x), bfhi(pw.x), bflo(pw.y), bfhi(pw.y), bflo(pw.z), bfhi(pw.z), bflo(pw.w), bfhi(pw.w)};
        float z[8];
#pragma unroll
        for (int i = 0; i < 8; ++i) { z[i] = cv[i] + mu[1536 + col + i] * (pv[i] - cv[i]); if (col < 64) z[i] = 1.f - 2.f / (1.f + __expf(2.f * z[i])); else if (col >= 128) z[i] = sigmoidf_(z[i]); }
        u32x4 o; o.x = pk2(z[0], z[1]); o.y = pk2(z[2], z[3]); o.z = pk2(z[4], z[5]); o.w = pk2(z[6], z[7]);
        bf16* dst = (col < 64) ? A0 + t * ST + col : (col < 128 ? A1 + t * ST + (col - 64) : A2 + t * STG + (col - 128));
        *(u32x4*)dst = o;
    }
    { const int row = tid >> 3, chk = tid & 7;
      *(u32x4*)(A4 + row * ST + chk * 8) = *(const u32x4*)(WT + WT_LW + (size_t)(h * 64 + row) * 64 + chk * 8);
      *(u32x4*)(A5 + row * ST + chk * 8) = *(const u32x4*)(WT + WT_LA + (size_t)(h * 64 + row) * 64 + chk * 8);
#pragma unroll
      for (int i = 0; i < 2; ++i) { const int idx = tid + 512 * i, r2 = idx >> 4, c2 = idx & 15;
          *(u32x4*)((bf16*)F1 + r2 * STG + c2 * 8) = *(const u32x4*)(WT + WT_LG + (size_t)(h * 64 + r2) * 128 + c2 * 8); } }
    LDS_BARRIER();
    { f32x4 aw[2], aa[2], ag[2]; ZACC(aw); ZACC(aa); ZACC(ag);
      mm_tile(A4, ST, A0, ST, 2, aw, w, lq, g); mm_tile(A5, ST, A1, ST, 2, aa, w, lq, g); mm_tile((const bf16*)F1, STG, A2, STG, 4, ag, w, lq, g);
      const int mt = w >> 1, nt0 = 2 * (w & 1);
#pragma unroll
      for (int q = 0; q < 2; ++q) { const int o = (16 * (nt0 + q) + lq) * ST + 16 * mt + 4 * g; u32x2 p;
          p.x = pk2(aw[q][0], aw[q][1]); p.y = pk2(aw[q][2], aw[q][3]); *(u32x2*)(A7 + o) = p;
          p.x = pk2(aa[q][0], aa[q][1]); p.y = pk2(aa[q][2], aa[q][3]); *(u32x2*)(A8 + o) = p;
          p.x = pk2(ag[q][0], ag[q][1]); p.y = pk2(ag[q][2], ag[q][3]); *(u32x2*)(A9 + o) = p; } }
    LDS_BARRIER();
    float kk[8], k2[8], ar[8];
    { const u32x4 lw = *(const u32x4*)(A7 + t * ST + c0), la = *(const u32x4*)(A8 + t * ST + c0), lg = *(const u32x4*)(A9 + t * ST + c0);
      const float fw[8] = {bflo(lw.x), bfhi(lw.x), bflo(lw.y), bfhi(lw.y), bflo(lw.z), bfhi(lw.z), bflo(lw.w), bfhi(lw.w)};
      const float fa[8] = {bflo(la.x), bfhi(la.x), bflo(la.y), bfhi(la.y), bflo(la.z), bfhi(la.z), bflo(la.w), bfhi(la.w)};
      float ss = 0.f, bs = 0.f;
#pragma unroll
      for (int i = 0; i < 8; ++i) {
          const float xw = -(pw0[i] + fw[i]); const float sp = fmaxf(xw, 0.f) + __logf(1.f + __expf(-fabsf(xw)));
          F0[t * 64 + c0 + i] = __expf(-sp - 0.5f);
          ar[i] = sigmoidf_(pa0[i] + fa[i]);
          kk[i] = zk[i] * pkk[i]; ss += kk[i] * kk[i];
          k2[i] = zk[i] * (1.f + (ar[i] - 1.f) * pka[i]);
          bs += zr[i] * k2[i] * prk[i]; }
      ss += __shfl_xor(ss, 1); ss += __shfl_xor(ss, 2); ss += __shfl_xor(ss, 4);
      bs += __shfl_xor(bs, 1); bs += __shfl_xor(bs, 2); bs += __shfl_xor(bs, 4);
      const float inv = 1.0f / fmaxf(sqrtf(ss), 1e-12f);
#pragma unroll
      for (int i = 0; i < 8; ++i) kk[i] *= inv;
      u32x4 bo; bo.x = pk2(bs * zv[0], bs * zv[1]); bo.y = pk2(bs * zv[2], bs * zv[3]); bo.z = pk2(bs * zv[4], bs * zv[5]); bo.w = pk2(bs * zv[6], bs * zv[7]);
      *(u32x4*)(B.BON + (m0 + t) * 512 + jb) = bo; *(u32x4*)(B.G + (m0 + t) * 512 + jb) = lg; }
    LDS_BARRIER();
    {
      const int k = tid & 63, sg = tid >> 6; float e[8], run = 0.f;
#pragma unroll
      for (int s = 0; s < 8; ++s) { run += F0[(8 * sg + s) * 64 + k]; e[s] = run; }
      F1[sg * 64 + k] = run;
      LDS_BARRIER();
      float off = 0.f;
#pragma unroll
      for (int s = 0; s < 8; ++s) off += (s < sg) ? F1[s * 64 + k] : 0.f;
#pragma unroll
      for (int s = 0; s < 8; ++s) F0[(8 * sg + s) * 64 + k] = e[s] + off; }
    LDS_BARRIER();
    { float ct[8], cp[8], cC[8];
#pragma unroll
      for (int i = 0; i < 8; ++i) { ct[i] = F0[t * 64 + c0 + i]; cp[i] = (t > 0) ? F0[(t - 1) * 64 + c0 + i] : 0.f; cC[i] = F0[63 * 64 + c0 + i]; }
      float at[8], bt[8], kt[8], rt[8], bh[8], kh[8];
#pragma unroll
      for (int i = 0; i < 8; ++i) { const float gt = __expf(-ct[i]), igt = __expf(ct[i]), gp = __expf(-cp[i]), gct = __expf(ct[i] - cC[i]);
          at[i] = -kk[i] * gp; bt[i] = kk[i] * ar[i] * igt; kt[i] = k2[i] * igt; rt[i] = zr[i] * gt; bh[i] = kk[i] * ar[i] * gct; kh[i] = k2[i] * gct; }
      u32x4 o;
      o.x = pk2(at[0], at[1]); o.y = pk2(at[2], at[3]); o.z = pk2(at[4], at[5]); o.w = pk2(at[6], at[7]); *(u32x4*)(A0 + t * ST + c0) = o;
      o.x = pk2(bt[0], bt[1]); o.y = pk2(bt[2], bt[3]); o.z = pk2(bt[4], bt[5]); o.w = pk2(bt[6], bt[7]); *(u32x4*)(A1 + t * ST + c0) = o;
      o.x = pk2(kt[0], kt[1]); o.y = pk2(kt[2], kt[3]); o.z = pk2(kt[4], kt[5]); o.w = pk2(kt[6], kt[7]); *(u32x4*)(A2 + t * ST + c0) = o;
      o.x = pk2(rt[0], rt[1]); o.y = pk2(rt[2], rt[3]); o.z = pk2(rt[4], rt[5]); o.w = pk2(rt[6], rt[7]); *(u32x4*)(A3 + t * ST + c0) = o;
#pragma unroll
      for (int i = 0; i < 8; ++i) { const int o = (c0 + i) * ST + (t ^ c0);
          A4[o] = (bf16)f2bf(bh[i]); A5[o] = (bf16)f2bf(kh[i]); A6[o] = (bf16)f2bf(zv[i]); F1[t * 128 + c0 + i] = at[i]; }
      if (t == 63) { float* gc = (float*)(B.UB + (size_t)u * UNIT_B + 16384) + c0;
#pragma unroll
          for (int i = 0; i < 8; ++i) gc[i] = __expf(-cC[i]); } }
    LDS_BARRIER();
    { const int mt = w >> 1, nt0 = 2 * (w & 1);
      f32x4 a[2];
      ZACC(a); mm_tile(A0, ST, A1, ST, 2, a, w, lq, g);
#pragma unroll
      for (int q = 0; q < 2; ++q) { const int i = 16 * (nt0 + q) + lq; f32x4 lab;
#pragma unroll
          for (int j = 0; j < 4; ++j) lab[j] = (i < 16 * mt + 4 * g + j) ? a[q][j] : 0.f;
#pragma unroll
          for (int j = 0; j < 4; ++j) F0[i * 64 + j * 16 + 4 * mt + g] = lab[j]; }
      asm volatile("" ::: "memory");
#define ST1_STORE(DST, INCL) do { _Pragma("unroll") for (int q = 0; q < 2; ++q) { const int tt = 16 * (nt0 + q) + lq, i0 = 16 * mt + 4 * g; float v_[4]; \
          _Pragma("unroll") for (int j = 0; j < 4; ++j) v_[j] = (i0 + j < tt + (INCL)) ? a[q][j] : 0.f; \
          u32x2 p_; p_.x = pk2(v_[0], v_[1]); p_.y = pk2(v_[2], v_[3]); *(u32x2*)((DST) + tt * ST + i0) = p_; } } while (0)
      ZACC(a); mm_tile(A2, ST, A0, ST, 2, a, w, lq, g); ST1_STORE(A7, 0); asm volatile("" ::: "memory");
      ZACC(a); mm_tile(A1, ST, A3, ST, 2, a, w, lq, g); ST1_STORE(A8, 1); asm volatile("" ::: "memory");
      ZACC(a); mm_tile(A2, ST, A3, ST, 2, a, w, lq, g); ST1_STORE(A9, 1);
#undef ST1_STORE
    }
    LDS_BARRIER();
    { const int mt = w >> 1, nt0 = 2 * (w & 1); f32x4 a[2]; ZACC(a);
      mm_tile2<true, false>(A6, ST, A7, ST, 2, a, w, lq, g);
#pragma unroll
      for (int q = 0; q < 2; ++q) *(f32x4*)(F1 + (16 * (nt0 + q) + lq) * 128 + 64 + 16 * mt + 4 * g) = a[q]; }
    LDS_BARRIER();
    { float X[16];
      const int col = 16 * w + lq;
#pragma unroll
      for (int r = 0; r < 16; ++r) X[r] = F1[(4 * r + g) * 128 + col];
      LDS_BARRIER();
      f32x4 Lc[4];
#pragma unroll
      for (int q = 0; q < 4; ++q) Lc[q] = *(const f32x4*)(F0 + g * 16 + 4 * q);
#pragma unroll
      for (int i = 0; i < 64; ++i) {
          const float xi = __shfl(X[i >> 2], (i & 3) * 16 + lq);
          f32x4 Ln[4];
#pragma unroll
          for (int q = 0; q < 4; ++q) Ln[q] = Lc[q];
          if (i + 1 < 64) {
#pragma unroll
              for (int q = ((i + 1) >> 4); q < 4; ++q) Ln[q] = *(const f32x4*)(F0 + (i + 1) * 64 + g * 16 + 4 * q);
          }
#pragma unroll
          for (int r = (i >> 2); r < 16; ++r) X[r] += Lc[r >> 2][r & 3] * xi;
#pragma unroll
          for (int q = 0; q < 4; ++q) Lc[q] = Ln[q];
          __builtin_amdgcn_sched_barrier(0);
      }
      bf16* XT = (bf16*)F1 + (w >> 2) * 4608 + ((col & 63) * ST);
#pragma unroll
      for (int r = 0; r < 16; ++r) XT[4 * r + g] = (bf16)f2bf(X[r]); }
    LDS_BARRIER();
    { const int mt = w >> 1, nt0 = 2 * (w & 1);
      const bf16* AhT = (const bf16*)F1; const bf16* W2T = AhT + 4608;
      unsigned char* ua = B.UA + (size_t)u * UNIT_A; unsigned char* ub = B.UB + (size_t)u * UNIT_B;
      const int p0 = 32 * (mt >> 1) + 8 * g + 4 * (mt & 1);
      f32x4 a[2];
      ZACC(a); mm_tile2<false, true>(AhT, ST, A4, ST, 2, a, w, lq, g);
#pragma unroll
      for (int q = 0; q < 2; ++q) { const int k = 16 * (nt0 + q) + lq; u32x2 o; o.x = pk2(a[q][0], a[q][1]); o.y = pk2(a[q][2], a[q][3]); *(u32x2*)(ua + swz(k, p0)) = o; }
      ZACC(a); mm_tile(AhT, ST, A8, ST, 2, a, w, lq, g);
#pragma unroll
      for (int q = 0; q < 2; ++q) { const int tt = 16 * (nt0 + q) + lq; const u32x2 rr = *(const u32x2*)(A3 + tt * ST + 16 * mt + 4 * g);
          u32x2 o; o.x = pk2(a[q][0] + bflo(rr.x), a[q][1] + bfhi(rr.x)); o.y = pk2(a[q][2] + bflo(rr.y), a[q][3] + bfhi(rr.y)); *(u32x2*)(ua + 8192 + swz(tt, p0)) = o; }
      ZACC(a); mm_tile2<true, false>(A4, ST, W2T, ST, 2, a, w, lq, g); mm_tile2<true, true>(A5, ST, A6, ST, 2, a, w, lq, g);
#pragma unroll
      for (int q = 0; q < 2; ++q) { const int v = 16 * (nt0 + q) + lq, k0 = 16 * mt + 4 * g; u32x2 o; o.x = pk2(a[q][0], a[q][1]); o.y = pk2(a[q][2], a[q][3]); *(u32x2*)(ub + swz(v, k0)) = o; }
      ZACC(a); mm_tile(A8, ST, W2T, ST, 2, a, w, lq, g); mm_tile2<false, true>(A9, ST, A6, ST, 2, a, w, lq, g);
#pragma unroll
      for (int q = 0; q < 2; ++q) { const int v = 16 * (nt0 + q) + lq, t0 = 16 * mt + 4 * g; u32x2 o; o.x = pk2(a[q][0], a[q][1]); o.y = pk2(a[q][2], a[q][3]); *(u32x2*)(ub + 8192 + swz(v, t0)) = o; } }
    LDS_BARRIER();
}
__device__ __forceinline__ void phase_rwkv_prep(const Params& P, int l, const Ctx& c) {
    const RwkvBufs B = rwkv_bufs(P, c);
    float pw0[8], pa0[8], pkk[8], pka[8], prk[8]; int hprev = -1;
    for (int u = c.bid; u < NUNIT; u += c.G) {
        const int h = u & 7;
        if (h != hprev) { hprev = h; const int j0 = l * 512 + h * 64 + (c.tid & 7) * 8;
#pragma unroll
            for (int i = 0; i < 8; ++i) { pw0[i] = P.in[9][j0 + i]; pa0[i] = P.in[11][j0 + i]; pkk[i] = P.in[14][j0 + i]; pka[i] = P.in[15][j0 + i]; prk[i] = P.in[16][j0 + i]; } }
        rwkv_prep_unit(P, l, c, u, B, pw0, pa0, pkk, pka, prk);
    }
}

constexpr int SLOTB = 33280, YST = 68;
__device__ __forceinline__ void scan_chunked(const Params& P, const Ctx& c, int bh) {
    const RwkvBufs B = rwkv_bufs(P, c);
    const int b = bh >> 3, h = bh & 7, w = c.wave, lane = c.lane, lq = lane & 15, g = lane >> 4;
    const size_t rowb = (size_t)b * LP;
    const int ll = c.tid;
    unsigned char* L = c.lds;
    f32x4 st[4];
#pragma unroll
    for (int i = 0; i < 4; ++i) st[i] = (f32x4){0.f, 0.f, 0.f, 0.f};
    u32x4 r0[5], r1[5], r2[5], r3[5], r4[5];
#define SC_UNIT(cc) ((size_t)((b * NCHK + (cc)) * 8 + h))
#define SC_LOAD(R, cc) do { const unsigned char* pa_ = B.UA + SC_UNIT(cc) * UNIT_A; const unsigned char* pb_ = B.UB + SC_UNIT(cc) * UNIT_B; \
        _Pragma("unroll") for (int i_ = 0; i_ < 2; ++i_) { R[i_] = GLD(u32x4, pa_ + (ll + 512 * i_) * 16); R[2 + i_] = GLD(u32x4, pb_ + (ll + 512 * i_) * 16); } \
        if (ll < 16) R[4] = GLD(u32x4, pb_ + 16384 + ll * 16); } while (0)
#define SC_WRITE(R, slot) do { unsigned char* s_ = L + (slot) * SLOTB; \
        _Pragma("unroll") for (int i_ = 0; i_ < 2; ++i_) { *(u32x4*)(s_ + (ll + 512 * i_) * 16) = R[i_]; *(u32x4*)(s_ + 16384 + (ll + 512 * i_) * 16) = R[2 + i_]; } \
        if (ll < 16) *(u32x4*)(s_ + 32768 + ll * 16) = R[4]; } while (0)
#define SC_COMPUTE(ci) do { \
        const unsigned char* sl = L + ((ci) % 3) * SLOTB; \
        const int vcol = 16 * w + lq; \
        bf16x8 gaf[4][2]; f32x4 gcf[4]; u32x2 d0f[4]; \
        _Pragma("unroll") for (int mt = 0; mt < 4; ++mt) { \
            gcf[mt] = *(const f32x4*)(sl + 32768 + (16 * mt + 4 * g) * 4); \
            d0f[mt] = *(const u32x2*)(sl + 16384 + swz(vcol, 16 * mt + 4 * g)); \
            _Pragma("unroll") for (int ks = 0; ks < 2; ++ks) gaf[mt][ks] = *(const bf16x8*)(sl + swz(16 * mt + lq, 32 * ks + 8 * g)); } \
        __builtin_amdgcn_sched_barrier(0);        \
        bf16x8 sb[2]; \
        _Pragma("unroll") for (int ks = 0; ks < 2; ++ks) { u32x4 pw; pw.x = pk2(st[2 * ks][0], st[2 * ks][1]); pw.y = pk2(st[2 * ks][2], st[2 * ks][3]); pw.z = pk2(st[2 * ks + 1][0], st[2 * ks + 1][1]); pw.w = pk2(st[2 * ks + 1][2], st[2 * ks + 1][3]); \
            sb[ks] = __builtin_bit_cast(bf16x8, pw); } \
        _Pragma("unroll") for (int mt = 0; mt < 4; ++mt) { \
            f32x4 ns = (f32x4){bflo(d0f[mt].x), bfhi(d0f[mt].x), bflo(d0f[mt].y), bfhi(d0f[mt].y)} + gcf[mt] * st[mt]; \
            _Pragma("unroll") for (int ks = 0; ks < 2; ++ks) ns = __builtin_amdgcn_mfma_f32_16x16x32_bf16(gaf[mt][ks], sb[ks], ns, 0, 0, 0); \
            st[mt] = ns; } \
        _Pragma("unroll") for (int mt = 0; mt < 4; ++mt) { \
            const u32x2 y0 = *(const u32x2*)(sl + 24576 + swz(vcol, 16 * mt + 4 * g)); \
            f32x4 ya = (f32x4){bflo(y0.x), bfhi(y0.x), bflo(y0.y), bfhi(y0.y)}; \
            _Pragma("unroll") for (int ks = 0; ks < 2; ++ks) { const bf16x8 rh = *(const bf16x8*)(sl + 8192 + swz(16 * mt + lq, 32 * ks + 8 * g)); ya = __builtin_amdgcn_mfma_f32_16x16x32_bf16(rh, sb[ks], ya, 0, 0, 0); } \
            float* yl = (float*)(L + 3 * SLOTB) + ((ci) & 1) * (64 * YST) + (16 * mt + 4 * g) * YST + vcol; \
            _Pragma("unroll") for (int j = 0; j < 4; ++j) yl[j * YST] = ya[j]; } } while (0)
#define SC_YSTORE(ci) do { const float* ys_ = (const float*)(L + 3 * SLOTB) + ((ci) & 1) * (64 * YST) + (c.tid >> 3) * YST + (c.tid & 7) * 8; \
        float* yg_ = B.Y + (rowb + (ci) * 64 + (c.tid >> 3)) * 512 + h * 64 + (c.tid & 7) * 8; \
        GST(f32x4, yg_) = *(const f32x4*)ys_; GST(f32x4, yg_ + 4) = *(const f32x4*)(ys_ + 4); } while (0)
#define SC_ITER(ci, R) do { if ((ci) + 2 < NCHK) SC_WRITE(R, ((ci) + 2) % 3); if ((ci) + 7 < NCHK) SC_LOAD(R, (ci) + 7); if ((ci) > 0) SC_YSTORE((ci) - 1); if (w < 4) { SC_COMPUTE(ci); } LDS_BARRIER(); } while (0)
    { SC_LOAD(r0, 0); SC_LOAD(r1, 1); SC_WRITE(r0, 0); SC_WRITE(r1, 1); SC_LOAD(r2, 2); SC_LOAD(r3, 3); SC_LOAD(r4, 4); SC_LOAD(r0, 5); SC_LOAD(r1, 6); }
    __syncthreads();
#pragma unroll 1
    for (int cc = 0; cc < NCHK; cc += 5) { SC_ITER(cc, r2); SC_ITER(cc + 1, r3); SC_ITER(cc + 2, r4); SC_ITER(cc + 3, r0); SC_ITER(cc + 4, r1); }
    SC_YSTORE(NCHK - 1);
#undef SC_YSTORE
#undef SC_COMPUTE
#undef SC_ITER
#undef SC_UNIT
#undef SC_LOAD
#undef SC_WRITE
}

__device__ __forceinline__ void phase_gn(const Params& P, int l, const Ctx& c) {
    const RwkvBufs B = rwkv_bufs(P, c);
    const int gw = c.bid * NWAVES + c.wave, NGW = c.G * NWAVES;
    const int c0 = 8 * c.lane;
    float gnw[8], gnb[8];
#pragma unroll
    for (int i = 0; i < 8; ++i) { gnw[i] = P.in[17][l * 512 + c0 + i]; gnb[i] = P.in[18][l * 512 + c0 + i]; }
    for (int m = gw; m < M; m += NGW) {
        const size_t o = (size_t)m * 512 + c0;
        const f32x4 y0 = *(const f32x4*)(B.Y + o), y1 = *(const f32x4*)(B.Y + o + 4);
        float y[8] = {y0.x, y0.y, y0.z, y0.w, y1.x, y1.y, y1.z, y1.w};
        const u32x4 bw = *(const u32x4*)(B.BON + o), gw4 = *(const u32x4*)(B.G + o);
        const float bo[8] = {bflo(bw.x), bfhi(bw.x), bflo(bw.y), bfhi(bw.y), bflo(bw.z), bfhi(bw.z), bflo(bw.w), bfhi(bw.w)};
        const float gg[8] = {bflo(gw4.x), bfhi(gw4.x), bflo(gw4.y), bfhi(gw4.y), bflo(gw4.z), bfhi(gw4.z), bflo(gw4.w), bfhi(gw4.w)};
        float s = 0.f;
#pragma unroll
        for (int i = 0; i < 8; ++i) s += y[i];
        s += __shfl_xor(s, 1); s += __shfl_xor(s, 2); s += __shfl_xor(s, 4);
        const float mean = s * (1.f / 64.f);
        float q = 0.f;
#pragma unroll
        for (int i = 0; i < 8; ++i) { y[i] -= mean; q += y[i] * y[i]; }
        q += __shfl_xor(q, 1); q += __shfl_xor(q, 2); q += __shfl_xor(q, 4);
        const float rstd = 1.0f / sqrtf(q * (1.f / 64.f) + 64e-5f);
        float ov[8];
#pragma unroll
        for (int i = 0; i < 8; ++i) ov[i] = (y[i] * rstd * gnw[i] + gnb[i] + bo[i]) * gg[i];
        u32x4 ow; ow.x = pk2(ov[0], ov[1]); ow.y = pk2(ov[2], ov[3]); ow.z = pk2(ov[4], ov[5]); ow.w = pk2(ov[6], ov[7]);
        *(u32x4*)(B.ORW + o) = ow;
    }
}

__device__ __forceinline__ void attn_unit(const Ctx& c, int bh, int qb, const bf16* Q, const bf16* K, const bf16* V, bf16* O, const float* FC, float qkb2, const float* gq, const float* gk) {
    const int b = bh >> 3, h = bh & 7, lane = c.lane, w = c.wave, lq = lane & 15, g = lane >> 4;
    const int q0 = qb * 128;
    const size_t rowb = (size_t)b * LP;
    const int qrow = q0 + 16 * w + lq;
    bf16* Ks = (bf16*)c.lds; bf16* Vt = Ks + 64 * 72; float* fks = (float*)(Vt + 64 * 72);
    const bf16* qp = Q + (rowb + qrow) * 512 + h * 64 + 8 * g;
    bf16x8 qf0, qf1;
    { const u32x4 r0 = GLD(u32x4, qp), r1 = GLD(u32x4, qp + 32);
      float x[16] = {bflo(r0.x), bfhi(r0.x), bflo(r0.y), bfhi(r0.y), bflo(r0.z), bfhi(r0.z), bflo(r0.w), bfhi(r0.w), bflo(r1.x), bfhi(r1.x), bflo(r1.y), bfhi(r1.y), bflo(r1.z), bfhi(r1.z), bflo(r1.w), bfhi(r1.w)};
      float ss = 0.f;
#pragma unroll
      for (int i = 0; i < 16; ++i) ss += x[i] * x[i];
      ss += __shfl_xor(ss, 16); ss += __shfl_xor(ss, 32);
      const float rs = QSCALE / sqrtf(ss * (1.f / 64.f) + 1e-6f);
#pragma unroll
      for (int i = 0; i < 8; ++i) { x[i] *= rs * gq[8 * g + i]; x[8 + i] *= rs * gq[32 + 8 * g + i]; }
      u32x4 p0, p1; p0.x = pk2(x[0], x[1]); p0.y = pk2(x[2], x[3]); p0.z = pk2(x[4], x[5]); p0.w = pk2(x[6], x[7]); p1.x = pk2(x[8], x[9]); p1.y = pk2(x[10], x[11]); p1.z = pk2(x[12], x[13]); p1.w = pk2(x[14], x[15]);
      qf0 = __builtin_bit_cast(bf16x8, p0); qf1 = __builtin_bit_cast(bf16x8, p1); }
    const float* FCh = FC + (size_t)bh * LP;
    const float fq = GLD(float, FCh + qrow);
    float mrun = -1e30f, lsum = 0.f;
    f32x4 o[4];
#pragma unroll
    for (int i = 0; i < 4; ++i) o[i] = (f32x4){0.f, 0.f, 0.f, 0.f};
    const int kt_max = (q0 + 127) >> 6;
    const int lkey = c.tid >> 3, lch = c.tid & 7;
    float gkr[8];
#pragma unroll
    for (int i = 0; i < 8; ++i) gkr[i] = gk[lch * 8 + i];
    const size_t gbase = (rowb + lkey) * 512 + h * 64 + lch * 8;
    u32x4 kv = GLD(u32x4, K + gbase + (size_t)kt_max * 64 * 512), vv = GLD(u32x4, V + gbase + (size_t)kt_max * 64 * 512);
    float fkv = GLD(float, FCh + kt_max * 64 + (c.tid & 63));
    volatile unsigned* vote = (volatile unsigned*)(fks + 64);
    for (int kt = kt_max; kt >= 0; --kt) {
        const int k0 = kt * 64;
        LDS_BARRIER();
        { int can = 0; if (kt < kt_max) { const float fl = __shfl(fkv, 63); can = (qkb2 + fq - fl) < (mrun - THR2); }
          const int wall = __all(can); if (lane == 0) vote[w] = (unsigned)wall; }
        { { float x[8] = {bflo(kv.x), bfhi(kv.x), bflo(kv.y), bfhi(kv.y), bflo(kv.z), bfhi(kv.z), bflo(kv.w), bfhi(kv.w)}; float ss = 0.f;
#pragma unroll
              for (int i = 0; i < 8; ++i) ss += x[i] * x[i];
              ss += __shfl_xor(ss, 1); ss += __shfl_xor(ss, 2); ss += __shfl_xor(ss, 4);
              const float rs = 1.0f / sqrtf(ss * (1.f / 64.f) + 1e-6f);
              u32x4 kn; kn.x = pk2(x[0] * rs * gkr[0], x[1] * rs * gkr[1]); kn.y = pk2(x[2] * rs * gkr[2], x[3] * rs * gkr[3]); kn.z = pk2(x[4] * rs * gkr[4], x[5] * rs * gkr[5]); kn.w = pk2(x[6] * rs * gkr[6], x[7] * rs * gkr[7]);
              *(u32x4*)(Ks + lkey * 72 + lch * 8) = kn; }
            bf16* vd = Vt + (lch * 8) * 72 + lkey;
            vd[0] = (bf16)(vv.x & 0xffff); vd[72] = (bf16)(vv.x >> 16); vd[144] = (bf16)(vv.y & 0xffff); vd[216] = (bf16)(vv.y >> 16);
            vd[288] = (bf16)(vv.z & 0xffff); vd[360] = (bf16)(vv.z >> 16); vd[432] = (bf16)(vv.w & 0xffff); vd[504] = (bf16)(vv.w >> 16);
            if (c.tid < 64) fks[c.tid] = fkv;
            if (kt > 0) { kv = GLD(u32x4, K + gbase + (size_t)(k0 - 64) * 512); vv = GLD(u32x4, V + gbase + (size_t)(k0 - 64) * 512); fkv = GLD(float, FCh + k0 - 64 + (c.tid & 63)); } }
        LDS_BARRIER();
        { unsigned all = vote[0] & vote[1] & vote[2] & vote[3] & vote[4] & vote[5] & vote[6] & vote[7]; if (all) break; }
        if (k0 > q0 + 16 * w + 15) continue;
        f32x4 s[4];
#pragma unroll
        for (int nt = 0; nt < 4; ++nt) { const bf16* kp = Ks + (16 * nt + lq) * 72 + 8 * g; const bf16x8 a0 = *(const bf16x8*)kp, a1 = *(const bf16x8*)(kp + 32);
            s[nt] = __builtin_amdgcn_mfma_f32_16x16x32_bf16(a0, qf0, (f32x4){0.f, 0.f, 0.f, 0.f}, 0, 0, 0);
            s[nt] = __builtin_amdgcn_mfma_f32_16x16x32_bf16(a1, qf1, s[nt], 0, 0, 0); }
        float mx = -INFINITY;
#pragma unroll
        for (int nt = 0; nt < 4; ++nt) { const f32x4 fk = *(const f32x4*)(fks + 16 * nt + 4 * g);
#pragma unroll
            for (int j = 0; j < 4; ++j) { float x = s[nt][j] + fq - fk[j]; const int key = k0 + 16 * nt + 4 * g + j; if (key > qrow) x = -INFINITY; s[nt][j] = x; mx = fmaxf(mx, x); } }
        mx = fmaxf(mx, __shfl_xor(mx, 16)); mx = fmaxf(mx, __shfl_xor(mx, 32));
        const float mnew = fmaxf(mrun, mx), alpha = __builtin_amdgcn_exp2f(mrun - mnew); mrun = mnew;
        float psum = 0.f;
#pragma unroll
        for (int nt = 0; nt < 4; ++nt)
#pragma unroll
            for (int j = 0; j < 4; ++j) { const float p = __builtin_amdgcn_exp2f(s[nt][j] - mnew); s[nt][j] = p; psum += p; }
        lsum = lsum * alpha + psum;
#pragma unroll
        for (int dt = 0; dt < 4; ++dt) o[dt] = o[dt] * alpha;
        bf16x8 pb[2];
#pragma unroll
        for (int k2 = 0; k2 < 2; ++k2) { u32x4 pw; pw.x = pk2(s[2 * k2][0], s[2 * k2][1]); pw.y = pk2(s[2 * k2][2], s[2 * k2][3]); pw.z = pk2(s[2 * k2 + 1][0], s[2 * k2 + 1][1]); pw.w = pk2(s[2 * k2 + 1][2], s[2 * k2 + 1][3]);
            pb[k2] = __builtin_bit_cast(bf16x8, pw); }
#pragma unroll
        for (int dt = 0; dt < 4; ++dt)
#pragma unroll
            for (int k2 = 0; k2 < 2; ++k2) { const bf16* vp = Vt + (16 * dt + lq) * 72 + 32 * k2 + 4 * g;
                const u32x2 lo = *(const u32x2*)vp, hi = *(const u32x2*)(vp + 16);
                u32x4 aw; aw.x = lo.x; aw.y = lo.y; aw.z = hi.x; aw.w = hi.y;
                o[dt] = __builtin_amdgcn_mfma_f32_16x16x32_bf16(__builtin_bit_cast(bf16x8, aw), pb[k2], o[dt], 0, 0, 0); }
    }
    lsum += __shfl_xor(lsum, 16); lsum += __shfl_xor(lsum, 32);
    const float inv = 1.0f / lsum;
    bf16* op = O + (rowb + qrow) * 512 + h * 64 + 4 * g;
#pragma unroll
    for (int dt = 0; dt < 4; ++dt) { u32x2 ow; ow.x = pk2(o[dt][0] * inv, o[dt][1] * inv); ow.y = pk2(o[dt][2] * inv, o[dt][3] * inv); GST(u32x2, op + 16 * dt) = ow; }
    __syncthreads();
}
__device__ __forceinline__ void phase_attn(const Params& P, int l, const Ctx& c, int first_blk) {
    const bf16* Q = (const bf16*)(c.ws + OFF_Q); const bf16* K = (const bf16*)(c.ws + OFF_K); const bf16* V = (const bf16*)(c.ws + OFF_V);
    const float* FC = (const float*)(c.ws + OFF_MISC) + 16 * LP;
    float gqm = fabsf(P.in[5][l * 64 + c.lane]), gkm = fabsf(P.in[6][l * 64 + c.lane]);
#pragma unroll
    for (int o = 1; o < 64; o <<= 1) { gqm = fmaxf(gqm, __shfl_xor(gqm, o)); gkm = fmaxf(gkm, __shfl_xor(gkm, o)); }
    const float qkb2 = 8.0f * gqm * gkm * LOG2E * 1.03f;
    constexpr int NQB = LP / 128, NU = 16 * NQB;
    unsigned* ctr = (unsigned*)(c.ws + OFF_CTL) + 8192 + 64 * l;
    volatile unsigned* slot = (volatile unsigned*)(c.lds + MISC_OFF) + 4;
    for (;;) {
        __syncthreads();
        if (c.tid == 0) *slot = atomicAdd(ctr, 1u);
        __syncthreads();
        const int u = (int)*slot;
        if (u >= NU) break;
        const int bh = u & 15, qb = NQB - 1 - (u >> 4); attn_unit(c, bh, qb, Q, K, V, (bf16*)(c.ws + OFF_OF), FC, qkb2, P.in[5] + l * 64, P.in[6] + l * 64);
    }
}

__device__ __forceinline__ void phase_fixup(const Params& P, int l, const Ctx& c) {
    bf16* ACT = (bf16*)(c.ws + OFF_RW); const bf16* HALO = (const bf16*)(c.ws + OFF_Q);
    const float* cw = P.in[24] + (size_t)l * 3 * NUP;
    const int total = (M / 64) * 2 * DFF;
    for (int idx = c.bid * NTHR + c.tid; idx < total; idx += c.G * NTHR) {
        const int rr = idx / DFF, ch = idx - rr * DFF, q64 = rr >> 1, e = rr & 1, row = q64 * 64 + e;
        const int t = row % LP;
        int s0, s1, s2;
        if (e == 0) { s0 = q64 * 4 + 2; s1 = (q64 - 1) * 4 + 1; s2 = (q64 - 1) * 4 + 0; } else { s0 = q64 * 4 + 3; s1 = q64 * 4 + 2; s2 = (q64 - 1) * 4 + 1; }
        float uc[2];
#pragma unroll
        for (int bj = 0; bj < 2; ++bj) { const int col = bj * DFF + ch;
            const float u0 = bf2f(HALO[(size_t)s0 * NUP + col]);
            const float u1 = (t >= 1) ? bf2f(HALO[(size_t)s1 * NUP + col]) : 0.f;
            const float u2 = (t >= 2) ? bf2f(HALO[(size_t)s2 * NUP + col]) : 0.f;
            uc[bj] = cw[col] * u2 + cw[NUP + col] * u1 + cw[2 * NUP + col] * u0; }
        ACT[(size_t)row * DFF + ch] = (bf16)f2bf(uc[0] * sigmoidf_(uc[0]) * uc[1]);
    }
}

#define OPQ_S(x) asm volatile("" : "+s"(x))
#define OPQ_V(x) asm volatile("" : "+v"(x))
#define PHASE_BEGIN() do { int t_ = threadIdx.x; OPQ_V(t_); c.tid = t_; c.lane = t_ & 63; c.wave = __builtin_amdgcn_readfirstlane(t_ >> 6); int b_ = blockIdx.x; OPQ_S(b_); c.bid = b_; \
    size_t z_ = 0; OPQ_S(z_); unsigned char* w_ = P.ws + z_;   c.ws = w_; ws = w_; l = lc; OPQ_S(l); WT = (pg8::bf16_t*)(ws + OFF_WT); HN = (pg8::bf16_t*)(ws + OFF_HN); } while (0)
__global__ void __launch_bounds__(NTHR, 2) mega(Params P) {
    extern __shared__ __attribute__((aligned(16))) unsigned char lds[];
    Ctx c; c.G = gridDim.x; c.lds = lds;
    volatile LAS unsigned* MISC = (volatile LAS unsigned*)((LAS unsigned char*)lds + MISC_OFF);
    if (threadIdx.x < 16) MISC[threadIdx.x] = 0u;
    __syncthreads();
    (void)xcd_barrier_post((unsigned*)(P.ws + OFF_CTL) + 1024, MISC + 8);
#define SEAM() do { XcdBarrier xb_; xb_.bar = (unsigned*)(P.ws + OFF_CTL) + 1024; xb_.x = xb_xcc_id(); xb_.st = (volatile LAS unsigned*)((LAS unsigned char*)lds + MISC_OFF) + 8; xcd_barrier(xb_); } while (0)
    PG8_LAS unsigned char* ldsl = (PG8_LAS unsigned char*)lds;
    unsigned char* ws; pg8::bf16_t* WT; pg8::bf16_t* HN; int l;
#pragma unroll 1
    for (int lc = 0; lc < DEPTH; ++lc) {
        PHASE_BEGIN();
        convert_weights(P, l, c);
        phase_norm<true>(P, l, c);
        if (lc == 0) cg::this_grid().sync(); else SEAM();
        PHASE_BEGIN();
        phase_fcum(P, c);
        { pg8::Gemm g{HN, WT + WT_IN, M, N1, 1024, 1024}; pg8::StaticOrder S; S.init(M, N1, c.G, c.bid);
          pg8::EpiRoute E{ws};
          pg8::gemm_phase<pg8::EpiRoute, pg8::StaticOrder, true, true>(ldsl, g, S, E); }
        SEAM();
        PHASE_BEGIN();
        for (int rep_ = 0; rep_ < REP_PREP; ++rep_) phase_rwkv_prep(P, l, c);
        SEAM();
        PHASE_BEGIN();
        if (c.bid < 16) { scan_chunked(P, c, c.bid); __syncthreads(); PHASE_BEGIN(); }
        phase_attn(P, l, c, 16);
#if REP_P3 > 1
        __syncthreads(); PHASE_BEGIN();
        if (c.bid < 16) scan_chunked(P, c, c.bid); else phase_attn(P, l, c, 16);
#endif
        SEAM();
        PHASE_BEGIN();
        phase_gn(P, l, c);
        for (int rep_ = 0; rep_ < REP_SYNC; ++rep_) SEAM();
        SEAM();
        PHASE_BEGIN();
#pragma unroll 1
        for (int pass = 0; pass < 3; ++pass) {
            if (pass) { __syncthreads(); PHASE_BEGIN(); }
            const int rw_side = pass == 2 ? ((c.bid >> 2) & 1) : pass;
            const pg8::bf16_t* A = rw_side ? (const pg8::bf16_t*)(ws + OFF_RW + (size_t)M * 512 * 4) : (const pg8::bf16_t*)(ws + OFF_OF);
            pg8::Gemm g{A, WT + (rw_side ? WT_BR : WT_BF), M, 1024, 512, 512};
            pg8::OneUnit S; S.so.init(MMAIN, 1024, c.G, c.bid); S.mode = pass == 2; S.pm = MMAIN / 256; S.pn = c.bid & 3; S.active = c.bid < 8;
            pg8::bf16_t* O = (pass == 2 && rw_side) ? (pg8::bf16_t*)(ws + OFF_TAIL) - (size_t)MMAIN * 1024 : (pg8::bf16_t*)(ws + OFF_K);
            pg8::EpiGateR E{O, (const pg8::bf16_t*)(ws + OFF_GT), P.in[21] + l * NGT, rw_side * 1024, pass == 1};
            pg8::gemm_phase<pg8::EpiGateR, pg8::OneUnit, true, true>(ldsl, g, S, E);
        }
        SEAM();
        PHASE_BEGIN();
#pragma unroll 1
        for (int pass = 0; pass < 2; ++pass) {
            if (pass) { __syncthreads(); PHASE_BEGIN(); }
            const int sl = pass ? (c.bid >> 2) : 0, ks = sl & 3;
            const pg8::bf16_t* A = (pass && sl >= 4) ? (const pg8::bf16_t*)(ws + OFF_TAIL) - (size_t)MMAIN * 1024 : (const pg8::bf16_t*)(ws + OFF_K);
            pg8::Gemm g{A + ks * 256, WT + WT_O + ks * 256, M, 1024, pass ? 256 : 1024, 1024};
            pg8::OneUnit S; S.so.init(MMAIN, 1024, c.G, c.bid); S.mode = pass; S.pm = MMAIN / 256; S.pn = c.bid & 3; S.active = sl < 8;
            pg8::EpiResid E{(float*)(ws + OFF_H), nullptr, pass};
            pg8::gemm_phase<pg8::EpiResid, pg8::OneUnit, true, true>(ldsl, g, S, E);
        }
        SEAM();
        PHASE_BEGIN();
        phase_norm<false>(P, l, c);
        SEAM();
        PHASE_BEGIN();
        { pg8::Gemm g{HN, WT + WT_UP, M, NUP, 1024, 1024}; pg8::StaticOrder S; S.init(M, NUP, c.G, c.bid);
          pg8::EpiUp E{(pg8::bf16_t*)(ws + OFF_RW), (pg8::bf16_t*)(ws + OFF_Q), P.in[24] + (size_t)l * 3 * NUP};
          pg8::gemm_phase<pg8::EpiUp, pg8::StaticOrder, true, true>(ldsl, g, S, E); }
        SEAM();
        PHASE_BEGIN();
        phase_fixup(P, l, c);
        SEAM();
        PHASE_BEGIN();
#pragma unroll 1
        for (int pass = 0; pass < 2; ++pass) {
            if (pass) { __syncthreads(); PHASE_BEGIN(); }
            const int sl = pass ? (c.bid >> 2) : 0;
            const int ko = (sl < 6) ? sl * 384 : 2304 + (sl - 6) * 256, kl = (sl < 6) ? 384 : 256;
            pg8::Gemm g{(const pg8::bf16_t*)(ws + OFF_RW) + (pass ? ko : 0), WT + WT_DN + (pass ? ko : 0), M, 1024, pass ? kl : DFF, DFF};
            pg8::OneUnit S; S.so.init(MMAIN, 1024, c.G, c.bid); S.mode = pass; S.pm = MMAIN / 256; S.pn = c.bid & 3; S.active = sl < 8;
            pg8::EpiResid E{(float*)(ws + OFF_H), (l == DEPTH - 1 && !pass) ? P.out : nullptr, pass};
            pg8::gemm_phase<pg8::EpiResid, pg8::OneUnit, true, true>(ldsl, g, S, E);
        }
        SEAM();
        if (l == DEPTH - 1) {
            PHASE_BEGIN();
            const float* H = (const float*)(ws + OFF_H);
            for (int idx = c.bid * NTHR + c.tid; idx < (NMETA + SEQ - (MMAIN - LP)) * (DM / 4); idx += c.G * NTHR) {
                const int r = idx / (DM / 4), q4 = idx - r * (DM / 4), t = (MMAIN - LP) + r;
                *(f32x4*)(P.out + ((size_t)SEQ + (t - NMETA)) * DM + 4 * q4) = *(const f32x4*)(H + (size_t)(LP + t) * DM + 4 * q4);
            }
        }
    }
}

extern "C" void kernel_launch(void* const* d_in, const int* in_sizes, int n_in, void* d_out, int out_size, void* d_ws, size_t ws_size, hipStream_t stream) {
    static int grid = 0;
    if (grid == 0) {
        if (n_in != 26 || out_size != NB * SEQ * DM || ws_size < WS_NEED) { fprintf(stderr, "kernel_launch: unexpected shapes (n_in %d out %d ws %zu need %zu)\n", n_in, out_size, ws_size, (size_t)WS_NEED); grid = -1; return; }
        int dev = 0, cus = 0, per_cu = 0;
        if (hipGetDevice(&dev) != hipSuccess || hipDeviceGetAttribute(&cus, hipDeviceAttributeMultiprocessorCount, dev) != hipSuccess) { grid = -1; return; }
        if (hipFuncSetAttribute((const void*)mega, hipFuncAttributeMaxDynamicSharedMemorySize, LDS_BYTES) != hipSuccess) { fprintf(stderr, "kernel_launch: hipFuncSetAttribute failed\n"); grid = -1; return; }
        if (hipOccupancyMaxActiveBlocksPerMultiprocessor(&per_cu, (const void*)mega, NTHR, LDS_BYTES) != hipSuccess || per_cu < 1) { fprintf(stderr, "kernel_launch: occupancy query says %d\n", per_cu); per_cu = 1; }
        (void)hipGetLastError();
        grid = cus;
    }
    if (grid < 0) return;
    if (hipMemsetAsync((char*)d_ws + OFF_CTL, 0, 65536, stream) != hipSuccess) { fprintf(stderr, "kernel_launch: memset failed\n"); return; }
    Params p{};
    for (int i = 0; i < 26; ++i) p.in[i] = (const float*)d_in[i];
    p.out = (float*)d_out; p.ws = (unsigned char*)d_ws;
    void* args[] = {&p};
    hipError_t e = hipLaunchCooperativeKernel((const void*)mega, dim3(grid), dim3(NTHR), args, LDS_BYTES, stream);
    if (e != hipSuccess) fprintf(stderr, "kernel_launch: cooperative launch failed: %s (grid %d)\n", hipGetErrorString(e), grid);
}
```

```cpp
#include <hip/hip_runtime.h>
#include <hip/hip_cooperative_groups.h>
#include <cstdio>
#include <cstdint>
#include <cmath>
namespace cg = cooperative_groups;
namespace pg8 {
#define PG8_LAS __attribute__((address_space(3)))
typedef unsigned short bf16_t;
typedef short bf16x8 __attribute__((ext_vector_type(8)));
typedef float f32x4 __attribute__((ext_vector_type(4)));
typedef unsigned u32x4 __attribute__((ext_vector_type(4)));
constexpr int BM = 256, BK = 64, HALF = 128, HTB = HALF * BK * 2  , STAGE_BYTES = 8 * HTB, NXCD = 8, WGM = 8;

__host__ __device__ __forceinline__ int lds_byte(int r, int c) { const int st = (r >> 4) * 2 + (c >> 5), rr = r & 15, cc = c & 31, ob = rr * 64 + cc * 2; return st * 1024 + (ob ^ (((ob >> 9) & 1) << 5)); }
__host__ __device__ __forceinline__ void stage_rc(int b, int& R, int& C) { const int st = b / 1024, sb = b % 1024, swz = sb ^ (((sb >> 9) & 1) << 5); R = (st >> 1) * 16 + swz / 64; C = (st & 1) * 32 + (swz % 64) / 2; }
__host__ __device__ __forceinline__ int perm32(int rho) { const int n = rho >> 4, i = rho & 15; return 8 * (i >> 2) + 4 * n + (i & 3); }

struct Unit { int pm, pn; };
struct Gemm { const bf16_t* A; const bf16_t* Bt; int M, N, K, ld; };

struct StaticOrder {
    int nM, nN, nwg, G, c;
    __host__ __device__ void init(int M, int N, int G_, int c_) { nM = M / BM; nN = N / BM; nwg = nM * nN; G = G_; c = c_; }
    __host__ __device__ bool next(int i, Unit& u) const {
        const long L = (long)i * G + c; if (L >= nwg) return false;
        int wgid = (int)L; { const int q = nwg / NXCD, r = nwg % NXCD, xcd = wgid % NXCD, off = wgid / NXCD; wgid = (xcd < r ? xcd * (q + 1) : r * (q + 1) + (xcd - r) * q) + off; }
        const int nig = WGM * nN, gid = wgid / nig, fm = gid * WGM, gsz = (nM - fm) < WGM ? (nM - fm) : WGM;
        u.pm = fm + ((wgid % nig) % gsz); u.pn = (wgid % nig) / gsz; return true;
    }
    __device__ __forceinline__ void a_ready(const Unit&) const {}
    __device__ __forceinline__ void done(const Unit&) const {}
};

__device__ __forceinline__ unsigned cvt_pk_bf16(float lo, float hi) { unsigned r; asm volatile("v_cvt_pk_bf16_f32 %0, %1, %2" : "=v"(r) : "v"(lo), "v"(hi)); return r; }
typedef float f32x2 __attribute__((ext_vector_type(2)));
template <class Epi, class Sched, bool ALIGN_EPI = false, bool SP2 = false>
__device__ __forceinline__ void gemm_phase(PG8_LAS unsigned char* lds, const Gemm g, const Sched& S, const Epi& E) {
    int tid_ = threadIdx.x; asm volatile("" : "+v"(tid_)); const int tid = tid_, wid = __builtin_amdgcn_readfirstlane(tid >> 6), lane = tid & 63, wr = wid >> 2, wc = wid & 3, fr = lane & 15, fq = lane >> 4;
    const int K = g.K, nt = K / BK, LD = g.ld;
    unsigned voffA[2], voffB[2];
#pragma unroll
    for (int i = 0; i < 2; ++i) { int R, C; stage_rc(tid * 16 + i * 8192, R, C); const int Rb = Epi::PERM ? ((R & ~31) + perm32(R & 31)) : R;
        voffA[i] = (unsigned)(R * LD + C) * 2u; voffB[i] = (unsigned)(Rb * LD + C) * 2u; }
    const size_t kstep = (size_t)(BK * 2);
    const size_t hstep = (size_t)HALF * LD * 2;
    const size_t tstep = 2 * hstep;
    const unsigned ldsw = (unsigned)wid * 1024u;
    const int aoff = lds_byte(wr * 64 + fr, fq * 8), boff = lds_byte(wc * 32 + fr, fq * 8);
#define PG8_SA(b, h) (((b) * 2 + (h)) * HTB)
#define PG8_SB(b, h) ((4 + (b) * 2 + (h)) * HTB)
#define PG8_STAGE(bufoff, gbase, voff) do { _Pragma("unroll") for (int _i = 0; _i < 2; ++_i) \
        __builtin_amdgcn_global_load_lds((const unsigned*)((const char*)(gbase) + (voff)[_i]), (PG8_LAS unsigned*)(lds + (bufoff) + ldsw + _i * 8192), 16, 0, 0); } while (0)
#define PG8_LDA(dst, b, h) do { _Pragma("unroll") for (int m = 0; m < 4; ++m) _Pragma("unroll") for (int k = 0; k < 2; ++k) dst[m][k] = *(const PG8_LAS bf16x8*)(lds + PG8_SA(b, h) + aoff + m * 2048 + k * 1024); } while (0)
#define PG8_LDB(dst, b, h) do { _Pragma("unroll") for (int n = 0; n < 2; ++n) _Pragma("unroll") for (int k = 0; k < 2; ++k) dst[n][k] = *(const PG8_LAS bf16x8*)(lds + PG8_SB(b, h) + boff + n * 2048 + k * 1024); } while (0)
#define PG8_MMA(ai, bj, At, Bt) do { __builtin_amdgcn_s_setprio(1); _Pragma("unroll") for (int m = 0; m < 4; ++m) _Pragma("unroll") for (int n = 0; n < 2; ++n) _Pragma("unroll") for (int k = 0; k < 2; ++k) \
        acc[ai][bj][m][n] = __builtin_amdgcn_mfma_f32_16x16x32_bf16(Bt[n][k], At[m][k], acc[ai][bj][m][n], 0, 0, 0); __builtin_amdgcn_s_setprio(0); } while (0)
#define PG8_WAIT_V(n) asm volatile("s_waitcnt vmcnt(" #n ")" ::: "memory")
#define PG8_WAIT_L(n) asm volatile("s_waitcnt lgkmcnt(" #n ")" ::: "memory")
#define PG8_BAR __builtin_amdgcn_s_barrier()
#define PG8_SCHED __builtin_amdgcn_sched_barrier(0)
    Unit cur, nxt; int ui = 0;
    if (!S.next(0, cur)) return;
    f32x4 acc[2][2][4][2];
#pragma unroll
    for (int a = 0; a < 2; ++a)
#pragma unroll
        for (int b = 0; b < 2; ++b)
#pragma unroll
            for (int m = 0; m < 4; ++m)
#pragma unroll
                for (int n = 0; n < 2; ++n) acc[a][b][m][n] = (f32x4){0.f, 0.f, 0.f, 0.f};
    bf16x8 At[4][2], B0[2][2], B1[2][2];
    const char* cA = (const char*)g.A + (size_t)cur.pm * tstep; const char* cB = (const char*)g.Bt + (size_t)cur.pn * tstep;
    S.a_ready(cur);
    if constexpr (SP2) {
        PG8_STAGE(PG8_SB(0, 0), cB, voffB); PG8_STAGE(PG8_SB(0, 1), cB + hstep, voffB); PG8_STAGE(PG8_SA(0, 0), cA, voffA); PG8_STAGE(PG8_SA(0, 1), cA + hstep, voffA);
        if (wr == 1) PG8_BAR;
        PG8_WAIT_V(2); PG8_BAR;
        PG8_STAGE(PG8_SB(1, 0), cB + kstep, voffB); PG8_STAGE(PG8_SA(1, 0), cA + kstep, voffA); PG8_STAGE(PG8_SB(1, 1), cB + hstep + kstep, voffB);
        PG8_WAIT_V(6); PG8_BAR;
    } else {
        PG8_STAGE(PG8_SB(0, 0), cB, voffB); PG8_STAGE(PG8_SA(0, 0), cA, voffA); PG8_STAGE(PG8_SB(0, 1), cB + hstep, voffB); PG8_STAGE(PG8_SA(0, 1), cA + hstep, voffA);
        if (wr == 1) PG8_BAR;
        PG8_WAIT_V(4); PG8_BAR;
        PG8_STAGE(PG8_SB(1, 0), cB + kstep, voffB); PG8_STAGE(PG8_SA(1, 0), cA + kstep, voffA); PG8_STAGE(PG8_SB(1, 1), cB + hstep + kstep, voffB);
        PG8_WAIT_V(6); PG8_BAR;
    }
    for (;;) {
        const bool has_next = S.next(ui + 1, nxt);
        const char* nA = has_next ? (const char*)g.A + (size_t)nxt.pm * tstep : cA; const char* nB = has_next ? (const char*)g.Bt + (size_t)nxt.pn * tstep : cB;
        for (int t = 0; t < nt; t += 2) {
            const bool last = (t == nt - 2);
            const char* a1 = cA + (size_t)(t + 1) * kstep;
            const char* a2 = last ? nA : cA + (size_t)(t + 2) * kstep; const char* b2 = last ? nB : cB + (size_t)(t + 2) * kstep;
            const char* a3 = a2 + kstep; const char* b3 = b2 + kstep;
            if (last && has_next) S.a_ready(nxt);
            if constexpr (SP2) {
            PG8_LDB(B0, 0, 0); PG8_LDB(B1, 0, 1); PG8_SCHED; PG8_LDA(At, 0, 0); PG8_STAGE(PG8_SA(1, 1), a1 + hstep, voffA);
            PG8_WAIT_V(8); PG8_WAIT_L(0); PG8_BAR; PG8_MMA(0, 0, At, B0); PG8_MMA(0, 1, At, B1); PG8_BAR; PG8_SCHED;
            PG8_LDA(At, 0, 1); PG8_STAGE(PG8_SB(0, 0), b2, voffB); PG8_STAGE(PG8_SB(0, 1), b2 + hstep, voffB); PG8_STAGE(PG8_SA(0, 0), a2, voffA);
            PG8_WAIT_V(8); PG8_WAIT_L(0); PG8_BAR; PG8_MMA(1, 0, At, B0); PG8_MMA(1, 1, At, B1); PG8_BAR; PG8_SCHED;
            PG8_LDB(B0, 1, 0); PG8_LDB(B1, 1, 1); PG8_SCHED; PG8_LDA(At, 1, 0); PG8_STAGE(PG8_SA(0, 1), a2 + hstep, voffA);
            PG8_WAIT_V(8); PG8_WAIT_L(0); PG8_BAR; PG8_MMA(0, 0, At, B0); PG8_MMA(0, 1, At, B1); PG8_BAR; PG8_SCHED;
            PG8_LDA(At, 1, 1); PG8_STAGE(PG8_SB(1, 0), b3, voffB); PG8_STAGE(PG8_SB(1, 1), b3 + hstep, voffB); PG8_STAGE(PG8_SA(1, 0), a3, voffA);
            PG8_WAIT_V(8); PG8_WAIT_L(0); PG8_BAR; PG8_MMA(1, 0, At, B0); PG8_MMA(1, 1, At, B1); PG8_BAR; PG8_SCHED;
            } else {
            PG8_LDB(B0, 0, 0); PG8_SCHED; PG8_LDA(At, 0, 0); PG8_STAGE(PG8_SA(1, 1), a1 + hstep, voffA);
            PG8_WAIT_L(8); PG8_BAR; PG8_WAIT_L(0); PG8_MMA(0, 0, At, B0); PG8_BAR; PG8_SCHED;
            PG8_LDB(B1, 0, 1); PG8_STAGE(PG8_SB(0, 0), b2, voffB);
            PG8_BAR; PG8_WAIT_L(0); PG8_MMA(0, 1, At, B1); PG8_BAR;
            PG8_LDA(At, 0, 1); PG8_STAGE(PG8_SA(0, 0), a2, voffA);
            PG8_BAR; PG8_WAIT_L(0); PG8_MMA(1, 0, At, B0); PG8_BAR; PG8_SCHED;
            PG8_STAGE(PG8_SB(0, 1), b2 + hstep, voffB);
            PG8_WAIT_V(6); PG8_BAR; PG8_MMA(1, 1, At, B1); PG8_BAR;
            PG8_LDB(B0, 1, 0); PG8_SCHED; PG8_LDA(At, 1, 0); PG8_STAGE(PG8_SA(0, 1), a2 + hstep, voffA);
            PG8_WAIT_L(8); PG8_BAR; PG8_WAIT_L(0); PG8_MMA(0, 0, At, B0); PG8_BAR; PG8_SCHED;
            PG8_LDB(B1, 1, 1); PG8_STAGE(PG8_SB(1, 0), b3, voffB);
            PG8_BAR; PG8_WAIT_L(0); PG8_MMA(0, 1, At, B1); PG8_BAR;
            PG8_LDA(At, 1, 1); PG8_STAGE(PG8_SA(1, 0), a3, voffA);
            PG8_BAR; PG8_WAIT_L(0); PG8_MMA(1, 0, At, B0); PG8_BAR; PG8_SCHED;
            PG8_STAGE(PG8_SB(1, 1), b3 + hstep, voffB);
            PG8_WAIT_V(6); PG8_BAR; PG8_MMA(1, 1, At, B1); PG8_BAR;
            }
        }
        if constexpr (ALIGN_EPI) { if (wr == 0) PG8_BAR; }
        if constexpr (!Epi::AFTER_DRAIN) { E(acc, cur, wr, wc, fr, fq); S.done(cur); }
        if (!has_next) break;
#pragma unroll
        for (int a = 0; a < 2; ++a)
#pragma unroll
            for (int b = 0; b < 2; ++b)
#pragma unroll
                for (int m = 0; m < 4; ++m)
#pragma unroll
                    for (int n = 0; n < 2; ++n) acc[a][b][m][n] = (f32x4){0.f, 0.f, 0.f, 0.f};
        cur = nxt; cA = nA; cB = nB; ++ui;
        if constexpr (ALIGN_EPI) { if (wr == 1) PG8_BAR; }
    }
    PG8_WAIT_V(0);
    if constexpr (!ALIGN_EPI) { if (wr == 0) PG8_BAR; }
    PG8_BAR;
    if constexpr (Epi::AFTER_DRAIN) { E.fused(acc, cur, wr, wc, fr, fq, lds, wid, lane); S.done(cur); }
#undef PG8_SA
#undef PG8_SB
#undef PG8_STAGE
#undef PG8_LDA
#undef PG8_LDB
#undef PG8_MMA
#undef PG8_WAIT_V
#undef PG8_WAIT_L
#undef PG8_BAR
#undef PG8_SCHED
}
}
#define GAS __attribute__((address_space(1)))
#define LAS __attribute__((address_space(3)))
typedef GAS unsigned gu32;
typedef GAS unsigned long long gu64;
#define RLX_AGENT __ATOMIC_RELAXED, __HIP_MEMORY_SCOPE_AGENT
#define LDS_WAIT() asm volatile("s_waitcnt lgkmcnt(0)" ::: "memory")
#define VM_WAIT() asm volatile("s_waitcnt vmcnt(0)" ::: "memory")
__device__ __forceinline__ unsigned long long rt() { return __builtin_amdgcn_s_memrealtime(); }
#define XB_TMO      128
#define XB_XCNT(j)  (256  + 64 * (j))
#define XB_XSUB(j)  (1280 + 64 * (j))
#define XB_XGEN(j)  (2304 + 64 * (j))
#define XB_TOP      3328
#define XB_TOPGEN   3392
#define XCD_BAR_WORDS 3456
#define XB_SPIN_CAP (1u << 18)

__device__ __forceinline__ unsigned xb_ld(unsigned* p)              { return __hip_atomic_load(p, __ATOMIC_RELAXED, __HIP_MEMORY_SCOPE_AGENT); }
__device__ __forceinline__ unsigned xb_add(unsigned* p, unsigned v) { return __hip_atomic_fetch_add(p, v, __ATOMIC_RELAXED, __HIP_MEMORY_SCOPE_AGENT); }
__device__ __forceinline__ unsigned xb_xcc_id() { return (unsigned)__builtin_amdgcn_s_getreg((3 << 11) | 20) & 0xFu; }
#define XB_SPIN(cond, bar) do { unsigned _sp = 0; while (cond) { __builtin_amdgcn_s_sleep(1); \
    if ((++_sp & 255u) == 0u) { if (xb_ld(&(bar)[XB_TMO])) break; if (_sp > XB_SPIN_CAP) { atomicAdd(&(bar)[XB_TMO], 1u); break; } } } } while (0)

struct XcdBarrier {
    unsigned* bar; unsigned x;
    volatile LAS unsigned* st;
};

__device__ __forceinline__ XcdBarrier xcd_barrier_post(unsigned* bar, volatile LAS unsigned* st) {
    XcdBarrier b; b.bar = bar; b.x = xb_xcc_id(); b.st = st;
    if (threadIdx.x == 0) (void)xb_add(&bar[XB_XCNT(b.x)], 1u);
    return b;
}
__device__ __forceinline__ void xcd_barrier_complete(unsigned* bar, unsigned x, unsigned& nloc, unsigned& nx) {
    const unsigned G = gridDim.x * gridDim.y * gridDim.z;
    unsigned sum, cnt, mine, sp = 0u;
    for (;;) {
        sum = 0u; cnt = 0u; mine = 0u;
#pragma unroll
        for (unsigned j = 0; j < 16; ++j) { const unsigned c = xb_ld(&bar[XB_XCNT(j)]); sum += c; cnt += (c > 0u) ? 1u : 0u; mine = (j == x) ? c : mine; }
        if (sum == G) break;
        __builtin_amdgcn_s_sleep(1);
        if ((++sp & 255u) == 0u) { if (xb_ld(&bar[XB_TMO])) break; if (sp > XB_SPIN_CAP) { atomicAdd(&bar[XB_TMO], 1u); break; } }
    }
    nloc = mine > 0u ? mine : 1u; nx = cnt > 0u ? cnt : 1u;
}

__device__ __forceinline__ void xcd_barrier(const XcdBarrier& b) {
    asm volatile("s_waitcnt vmcnt(0)" ::: "memory");
    __syncthreads();
    if (threadIdx.x == 0) {
        unsigned* bar = b.bar;
        __builtin_amdgcn_s_waitcnt(0);
        unsigned nloc = b.st[0], nx = b.st[1];
        if (nloc == 0u) { xcd_barrier_complete(bar, b.x, nloc, nx); b.st[0] = nloc; b.st[1] = nx; }
        const unsigned old = xb_add(&bar[XB_XSUB(b.x)], 1u);
        const unsigned gen = old / nloc;
        if (old + 1u == (gen + 1u) * nloc) {
            __builtin_amdgcn_fence(__ATOMIC_RELEASE, "agent");
            asm volatile("s_waitcnt vmcnt(0)" ::: "memory");
            const unsigned og = xb_add(&bar[XB_TOP], 1u);
            const unsigned tg = og / nx;
            if (og + 1u == (tg + 1u) * nx) xb_add(&bar[XB_TOPGEN], 1u);
            else XB_SPIN(xb_ld(&bar[XB_TOPGEN]) == tg, bar);
            __builtin_amdgcn_fence(__ATOMIC_ACQUIRE, "agent");
            xb_add(&bar[XB_XGEN(b.x)], 1u);
            asm volatile("s_waitcnt vmcnt(0)" ::: "memory");
        } else {
            XB_SPIN(xb_ld(&bar[XB_XGEN(b.x)]) == gen, bar);
            __builtin_amdgcn_fence(__ATOMIC_ACQUIRE, "agent");
            asm volatile("s_waitcnt vmcnt(0)" ::: "memory");
        }
    }
    __syncthreads();
}


constexpr int NB = 2, SEQ = 8192, DM = 1024, DEPTH = 4, NMETA = 16, LP = 8320, M = NB * LP;
constexpr int N_IN = 5384, N1 = 5376, NRW = 1792, NGT = 2048, DFF = 2816, NUP = 5632;
constexpr float LOG2E = 1.4426950408889634f;
constexpr float QSCALE = 0.125f * LOG2E;
constexpr float THR2 = 24.0f * LOG2E;
constexpr int NWAVES = 8, NTHR = 512, MMAIN = 16384;
constexpr int LDS_BYTES = 147456, MISC_OFF = 147456 - 128;

typedef unsigned short bf16;
typedef float f32x4 __attribute__((ext_vector_type(4)));
typedef unsigned u32x4 __attribute__((ext_vector_type(4)));
typedef unsigned u32x2 __attribute__((ext_vector_type(2)));
typedef short bf16x8 __attribute__((ext_vector_type(8)));

constexpr size_t SZ_H = (size_t)M * DM * 4, SZ_X512 = (size_t)M * 512 * 2;
constexpr size_t OFF_CTL = 0, OFF_H = 1u << 20, OFF_WT = OFF_H + SZ_H;
constexpr size_t WT_IN = 0, WT_BF = WT_IN + (size_t)N1 * 1024, WT_BR = WT_BF + 1024 * 512, WT_O = WT_BR + 1024 * 512,
                 WT_UP = WT_O + 1024 * 1024, WT_DN = WT_UP + (size_t)NUP * 1024, WT_LW = WT_DN + (size_t)1024 * DFF, WT_LA = WT_LW + 512 * 64, WT_LG = WT_LA + 512 * 64, WT_END = WT_LG + 512 * 128;
constexpr size_t OFF_HN = OFF_WT + WT_END * 2;
constexpr size_t OFF_Q = OFF_HN + 2 * SZ_X512, OFF_K = OFF_Q + SZ_X512, OFF_V = OFF_K + SZ_X512;
constexpr size_t OFF_RW = OFF_V + SZ_X512, OFF_GT = OFF_RW + (size_t)M * NRW * 2, OFF_MISC = OFF_GT + (size_t)M * NGT * 2;
constexpr size_t OFF_T0 = OFF_MISC + 2 * 16 * LP * 4, OFF_OF = OFF_T0 + 2 * SZ_X512, OFF_TAIL = OFF_OF + SZ_X512, WS_NEED = OFF_TAIL + 256 * 1024 * 2;
static_assert(OFF_HN % 256 == 0 && OFF_RW % 256 == 0 && OFF_T0 % 256 == 0, "alignment");

struct Params { const float* in[26]; float* out; unsigned char* ws; };
struct Ctx { int tid, lane, wave, bid, G; unsigned char* lds; unsigned char* ws; };

__device__ __forceinline__ float bf2f(unsigned b) { return __uint_as_float(b << 16); }
__device__ __forceinline__ float bflo(unsigned w) { return __uint_as_float(w << 16); }
__device__ __forceinline__ float bfhi(unsigned w) { return __uint_as_float(w & 0xffff0000u); }
typedef float f32x2_t_ __attribute__((ext_vector_type(2))); typedef __bf16 bf16x2_t_ __attribute__((ext_vector_type(2)));
__device__ __forceinline__ unsigned pk2(float lo, float hi) { const f32x2_t_ v = {lo, hi}; const bf16x2_t_ r = __builtin_convertvector(v, bf16x2_t_); return __builtin_bit_cast(unsigned, r); }
__device__ __forceinline__ unsigned f2bf(float f) { return pk2(f, 0.f) & 0xffffu; }
__device__ __forceinline__ float wave_sum(float v) {
#pragma unroll
    for (int o = 1; o < 64; o <<= 1) v += __shfl_xor(v, o);
    return v;
}
__device__ __forceinline__ float sigmoidf_(float x) { return __builtin_amdgcn_rcpf(1.f + __expf(-x)); }
template <int CTRL> __device__ __forceinline__ float dppf(float old, float x) {
    return __int_as_float(__builtin_amdgcn_update_dpp(__float_as_int(old), __float_as_int(x), CTRL, 0xf, 0xf, false));
}
__device__ __forceinline__ float allreduce16(float x) {
    x += dppf<0x121>(0.f, x); x += dppf<0x122>(0.f, x); x += dppf<0x124>(0.f, x); x += dppf<0x128>(0.f, x); return x;
}

namespace pg8 {
struct EpiRoute {
    static constexpr bool PERM = true, AFTER_DRAIN = false;
    unsigned char* ws;
    __device__ __forceinline__ void operator()(const f32x4 (&acc)[2][2][4][2], const Unit& u, int wr, int wc, int fr, int fq) const {
        const int pn = u.pn; size_t off; int ldc, colt;
        if (pn < 6) { off = OFF_Q + (size_t)(pn >> 1) * SZ_X512; ldc = 512; colt = (pn & 1) * 256; }
        else if (pn < 13) { off = OFF_RW; ldc = NRW; colt = (pn - 6) * 256; }
        else { off = OFF_GT; ldc = NGT; colt = (pn - 13) * 256; }
        bf16_t* base = (bf16_t*)(ws + off);
        const int row0 = u.pm * BM + wr * 64 + fr, col0 = colt + wc * 32 + 8 * fq;
#pragma unroll
        for (int ai = 0; ai < 2; ++ai)
#pragma unroll
            for (int m = 0; m < 4; ++m) { bf16_t* rowp = base + (size_t)(row0 + ai * HALF + m * 16) * ldc + col0;
#pragma unroll
                for (int bj = 0; bj < 2; ++bj) { const f32x4 v0 = acc[ai][bj][m][0], v1 = acc[ai][bj][m][1];
                    u32x4 w; w.x = cvt_pk_bf16(v0[0], v0[1]); w.y = cvt_pk_bf16(v0[2], v0[3]); w.z = cvt_pk_bf16(v1[0], v1[1]); w.w = cvt_pk_bf16(v1[2], v1[3]);
                    *(u32x4*)(rowp + bj * HALF) = w; } }
    }
};
struct EpiGateR {
    static constexpr bool PERM = true, AFTER_DRAIN = false;
    bf16_t* O; const bf16_t* GT; const float* gb; int goff, accum;
    __device__ __forceinline__ void operator()(const f32x4 (&acc)[2][2][4][2], const Unit& u, int wr, int wc, int fr, int fq) const {
        const int row0 = u.pm * BM + wr * 64 + fr, col0 = u.pn * BM + wc * 32 + 8 * fq;
#pragma unroll
        for (int bj = 0; bj < 2; ++bj) {
            const int c = col0 + bj * HALF;
            const f32x4 b0 = *(const f32x4*)(gb + goff + c), b1 = *(const f32x4*)(gb + goff + c + 4);
#pragma unroll
            for (int ai = 0; ai < 2; ++ai)
#pragma unroll
                for (int m = 0; m < 4; ++m) {
                    const size_t row = (size_t)(row0 + ai * HALF + m * 16);
                    const u32x4 gw = *(const u32x4*)(GT + row * NGT + goff + c);
                    const f32x4 v0 = acc[ai][bj][m][0], v1 = acc[ai][bj][m][1];
                    float r[8];
                    r[0] = sigmoidf_(bflo(gw.x) + b0[0]) * v0[0]; r[1] = sigmoidf_(bfhi(gw.x) + b0[1]) * v0[1];
                    r[2] = sigmoidf_(bflo(gw.y) + b0[2]) * v0[2]; r[3] = sigmoidf_(bfhi(gw.y) + b0[3]) * v0[3];
                    r[4] = sigmoidf_(bflo(gw.z) + b1[0]) * v1[0]; r[5] = sigmoidf_(bfhi(gw.z) + b1[1]) * v1[1];
                    r[6] = sigmoidf_(bflo(gw.w) + b1[2]) * v1[2]; r[7] = sigmoidf_(bfhi(gw.w) + b1[3]) * v1[3];
                    bf16_t* op = O + row * 1024 + c;
                    if (accum) { const u32x4 ow = *(const u32x4*)op;
                        r[0] += bflo(ow.x); r[1] += bfhi(ow.x); r[2] += bflo(ow.y); r[3] += bfhi(ow.y); r[4] += bflo(ow.z); r[5] += bfhi(ow.z); r[6] += bflo(ow.w); r[7] += bfhi(ow.w); }
                    u32x4 w; w.x = cvt_pk_bf16(r[0], r[1]); w.y = cvt_pk_bf16(r[2], r[3]); w.z = cvt_pk_bf16(r[4], r[5]); w.w = cvt_pk_bf16(r[6], r[7]);
                    *(u32x4*)op = w;
                }
        }
    }
};
struct EpiResid {
    static constexpr bool PERM = false, AFTER_DRAIN = false;
    float* H; float* OUT; int atomic;
    __device__ __forceinline__ void operator()(const f32x4 (&acc)[2][2][4][2], const Unit& u, int wr, int wc, int fr, int fq) const {
        const int row0 = u.pm * BM + wr * 64 + fr, col0 = u.pn * BM + wc * 32 + 4 * fq;
#pragma unroll
        for (int ai = 0; ai < 2; ++ai)
#pragma unroll
            for (int m = 0; m < 4; ++m) {
                const int row = row0 + ai * HALF + m * 16;
                float* hp = H + (size_t)row * DM + col0;
                const int b = row >= LP ? 1 : 0, t = row - b * LP;
                float* op = (OUT && t >= NMETA && t < NMETA + SEQ) ? OUT + ((size_t)b * SEQ + (t - NMETA)) * DM + col0 : nullptr;
#pragma unroll
                for (int bj = 0; bj < 2; ++bj)
#pragma unroll
                    for (int n = 0; n < 2; ++n) { const int co = bj * HALF + n * 16;
                        if (atomic) {
                            if (row < LP + NMETA + SEQ) {
#pragma unroll
                                for (int e = 0; e < 4; ++e) unsafeAtomicAdd(hp + co + e, acc[ai][bj][m][n][e]); }
                        } else {
                            const f32x4 v = *(const f32x4*)(hp + co) + acc[ai][bj][m][n];
                            if (OUT) { if (op) *(f32x4*)(op + co) = v; } else *(f32x4*)(hp + co) = v; } }
            }
    }
};
struct EpiResidAtomic {
    static constexpr bool PERM = false, AFTER_DRAIN = false;
    float* H;
    __device__ __forceinline__ void operator()(const f32x4 (&acc)[2][2][4][2], const Unit& u, int wr, int wc, int fr, int fq) const {
        const int row0 = u.pm * BM + wr * 64 + fr, col0 = u.pn * BM + wc * 32 + 4 * fq;
#pragma unroll
        for (int ai = 0; ai < 2; ++ai)
#pragma unroll
            for (int m = 0; m < 4; ++m) { float* hp = H + (size_t)(row0 + ai * HALF + m * 16) * DM + col0;
#pragma unroll
                for (int bj = 0; bj < 2; ++bj)
#pragma unroll
                    for (int n = 0; n < 2; ++n)
#pragma unroll
                        for (int e = 0; e < 4; ++e) unsafeAtomicAdd(hp + bj * HALF + n * 16 + e, acc[ai][bj][m][n][e]); }
    }
};
struct OneUnit {
    StaticOrder so; int mode, pm, pn; bool active;
    __device__ bool next(int i, Unit& u) const { if (mode == 0) return so.next(i, u); if (i != 0 || !active) return false; u.pm = pm; u.pn = pn; return true; }
    __device__ __forceinline__ void a_ready(const Unit&) const {}
    __device__ __forceinline__ void done(const Unit&) const {}
};
struct EpiUp {
    static constexpr bool PERM = true, AFTER_DRAIN = false;
    bf16_t* ACT; bf16_t* HALO; const float* cw;
    __device__ __forceinline__ void operator()(const f32x4 (&acc)[2][2][4][2], const Unit& u, int wr, int wc, int fr, int fq) const {
        const int chan0 = u.pn * 128 + wc * 32 + 8 * fq;
#pragma unroll
        for (int n = 0; n < 2; ++n) {
            const int ch = chan0 + 4 * n;
            f32x4 w[3][2];
#pragma unroll
            for (int j = 0; j < 3; ++j) { w[j][0] = *(const f32x4*)(cw + j * NUP + ch); w[j][1] = *(const f32x4*)(cw + j * NUP + DFF + ch); }
#pragma unroll
            for (int ai = 0; ai < 2; ++ai) {
                const int rowg = u.pm * BM + ai * HALF + wr * 64;
#pragma unroll
                for (int m = 0; m < 4; ++m) {
                    f32x4 uc[2];
#pragma unroll
                    for (int bj = 0; bj < 2; ++bj) {
                        const f32x4 cur = acc[ai][bj][m][n];
                        f32x4 prv; if (m > 0) prv = acc[ai][bj][m - 1][n]; else prv = (f32x4){0.f, 0.f, 0.f, 0.f};
                        f32x4 p1, p2;
#pragma unroll
                        for (int i = 0; i < 4; ++i) {
                            const float r1 = dppf<0x121>(0.f, prv[i]), r2 = dppf<0x122>(0.f, prv[i]);
                            p1[i] = dppf<0x111>(r1, cur[i]); p2[i] = dppf<0x112>(r2, cur[i]);
                        }
                        uc[bj] = w[0][bj] * p2 + w[1][bj] * p1 + w[2][bj] * cur;
                    }
                    float a[4];
#pragma unroll
                    for (int i = 0; i < 4; ++i) a[i] = uc[0][i] * sigmoidf_(uc[0][i]) * uc[1][i];
                    u32x2 o; o.x = cvt_pk_bf16(a[0], a[1]); o.y = cvt_pk_bf16(a[2], a[3]);
                    *(u32x2*)(ACT + (size_t)(rowg + m * 16 + fr) * DFF + ch) = o;
                    if ((m == 3 && fr >= 14) || (m == 0 && fr < 2)) {
                        const int slot = (rowg >> 6) * 4 + (m == 3 ? fr - 14 : 2 + fr);
#pragma unroll
                        for (int bj = 0; bj < 2; ++bj) { const f32x4 cur = acc[ai][bj][m][n]; u32x2 hw; hw.x = cvt_pk_bf16(cur[0], cur[1]); hw.y = cvt_pk_bf16(cur[2], cur[3]);
                            *(u32x2*)(HALO + (size_t)slot * NUP + bj * DFF + ch) = hw; }
                    }
                }
            }
        }
    }
};
}

#ifndef REP_PREP
#define REP_PREP 1
#endif
#ifndef REP_P3
#define REP_P3 1
#endif
#ifndef REP_SYNC
#define REP_SYNC 0
#endif
#define GLD(T, p) (*(const __attribute__((address_space(1))) T*)(p))
#define GST(T, p) (*(__attribute__((address_space(1))) T*)(p))
#define LDS_BARRIER() do { asm volatile("s_waitcnt lgkmcnt(0)" ::: "memory"); __builtin_amdgcn_s_barrier(); asm volatile("" ::: "memory"); } while (0)
__device__ __forceinline__ void transpose_item(const float* W, int Nsrc, int K, bf16* WT, int dst_row0, int src_col0, int k0, float* scr, int lane) {
#pragma unroll 8
    for (int i = 0; i < 32; ++i) { const int kk = 2 * i + (lane >> 5); scr[kk * 33 + (lane & 31)] = W[(size_t)(k0 + kk) * Nsrc + src_col0 + (lane & 31)]; }
    asm volatile("s_waitcnt lgkmcnt(0)" ::: "memory");
    const int c = lane & 7;
#pragma unroll
    for (int j = 0; j < 4; ++j) { const int n = (lane >> 3) + 8 * j; const float* s = scr + (8 * c) * 33 + n;
        u32x4 o; o.x = pk2(s[0 * 33], s[1 * 33]); o.y = pk2(s[2 * 33], s[3 * 33]); o.z = pk2(s[4 * 33], s[5 * 33]); o.w = pk2(s[6 * 33], s[7 * 33]);
        *(u32x4*)(WT + (size_t)(dst_row0 + n) * K + k0 + 8 * c) = o; }
    asm volatile("s_waitcnt lgkmcnt(0)" ::: "memory");
}
__device__ __forceinline__ void convert_weights(const Params& P, int l, const Ctx& c) {
    bf16* WT = (bf16*)(c.ws + OFF_WT);
    float* scr = (float*)(c.lds + c.wave * 16384);
    const int gw = c.bid * NWAVES + c.wave, NGW = c.G * NWAVES;
    constexpr int I_IN = 16 * 168, I_BF = 8 * 32, I_O = 16 * 32, I_UP = 16 * 176, I_DN = 44 * 32, I_LR = 16, I_LG = 32, I_ALL = I_IN + 2 * I_BF + I_O + I_UP + I_DN + 2 * I_LR + I_LG;
    for (int it = gw; it < I_ALL; it += NGW) {
        int r = it;
        if (r < I_IN) { const int kb = r / 168, n0 = 32 * (r % 168); transpose_item(P.in[4] + (size_t)l * 1024 * N_IN, N_IN, 1024, WT + WT_IN, n0, n0 + (n0 >= 1536 ? 8 : 0), 64 * kb, scr, c.lane); continue; } r -= I_IN;
        if (r < I_BF) { const int kb = r / 32, n0 = 32 * (r % 32); transpose_item(P.in[19] + (size_t)l * 512 * 1024, 1024, 512, WT + WT_BF, n0, n0, 64 * kb, scr, c.lane); continue; } r -= I_BF;
        if (r < I_BF) { const int kb = r / 32, n0 = 32 * (r % 32); transpose_item(P.in[20] + (size_t)l * 512 * 1024, 1024, 512, WT + WT_BR, n0, n0, 64 * kb, scr, c.lane); continue; } r -= I_BF;
        if (r < I_O) { const int kb = r / 32, n0 = 32 * (r % 32); transpose_item(P.in[22] + (size_t)l * 1024 * 1024, 1024, 1024, WT + WT_O, n0, n0, 64 * kb, scr, c.lane); continue; } r -= I_O;
        if (r < I_UP) { const int kb = r / 176, n0 = 32 * (r % 176); const int pn = n0 >> 8, bj = (n0 >> 7) & 1, x = n0 & 127;
            transpose_item(P.in[23] + (size_t)l * 1024 * NUP, NUP, 1024, WT + WT_UP, n0, bj * DFF + 128 * pn + x, 64 * kb, scr, c.lane); continue; } r -= I_UP;
        if (r < I_DN) { const int kb = r / 32, n0 = 32 * (r % 32); transpose_item(P.in[25] + (size_t)l * DFF * 1024, 1024, DFF, WT + WT_DN, n0, n0, 64 * kb, scr, c.lane); continue; } r -= I_DN;
        if (r < I_LR) { transpose_item(P.in[10] + (size_t)l * 64 * 512, 512, 64, WT + WT_LW, 32 * r, 32 * r, 0, scr, c.lane); continue; } r -= I_LR;
        if (r < I_LR) { transpose_item(P.in[12] + (size_t)l * 64 * 512, 512, 64, WT + WT_LA, 32 * r, 32 * r, 0, scr, c.lane); continue; } r -= I_LR;
        { const int kb = r / 16, n0 = 32 * (r % 16); transpose_item(P.in[13] + (size_t)l * 128 * 512, 512, 128, WT + WT_LG, n0, n0, 64 * kb, scr, c.lane); }
    }
}

template <bool FG> __device__ __forceinline__ void phase_norm(const Params& P, int l, const Ctx& c) {
    float* H = (float*)(c.ws + OFF_H); bf16* HN = (bf16*)(c.ws + OFF_HN);
    float* LOGF = (float*)(c.ws + OFF_MISC);
    const float* gain = (FG ? P.in[2] : P.in[3]) + l * DM;
    float* wfs = (float*)c.lds;
    if (FG) {
        __syncthreads();
        const float* win = P.in[4] + (size_t)l * 1024 * N_IN + 1536;
        for (int i = c.tid; i < 8192; i += NTHR) wfs[i] = win[(size_t)(i >> 3) * N_IN + (i & 7)];
        __syncthreads();
    }
    const int gw = c.bid * NWAVES + c.wave, NGW = c.G * NWAVES;
    for (int m = gw; m < M; m += NGW) {
        const int b = m >= LP ? 1 : 0, t = m - b * LP;
        f32x4 v[4];
        if (FG && l == 0) {
            const float* src = (t < NMETA) ? P.in[1] + (size_t)t * DM : P.in[0] + ((size_t)b * SEQ + (t - NMETA)) * DM;
            const bool real = t < NMETA + SEQ;
#pragma unroll
            for (int j = 0; j < 4; ++j) { v[j] = real ? *(const f32x4*)(src + 4 * c.lane + 256 * j) : (f32x4){0.f, 0.f, 0.f, 0.f}; *(f32x4*)(H + (size_t)m * DM + 4 * c.lane + 256 * j) = v[j]; }
        } else {
#pragma unroll
            for (int j = 0; j < 4; ++j) v[j] = *(const f32x4*)(H + (size_t)m * DM + 4 * c.lane + 256 * j);
        }
        float ss = 0.f;
#pragma unroll
        for (int j = 0; j < 4; ++j) ss += (v[j].x * v[j].x + v[j].y * v[j].y) + (v[j].z * v[j].z + v[j].w * v[j].w);
        const float rstd = 1.0f / sqrtf(wave_sum(ss) * (1.f / DM) + 1e-6f);
        float f[8];
#pragma unroll
        for (int q = 0; q < 8; ++q) f[q] = 0.f;
#pragma unroll
        for (int j = 0; j < 4; ++j) {
            const f32x4 g = *(const f32x4*)(gain + 4 * c.lane + 256 * j);
            v[j] = v[j] * rstd * g;
            u32x2 o; o.x = pk2(v[j].x, v[j].y); o.y = pk2(v[j].z, v[j].w);
            *(u32x2*)(HN + (size_t)m * DM + 4 * c.lane + 256 * j) = o;
            if (FG) {
#pragma unroll
                for (int e = 0; e < 4; ++e) { const int k = 4 * c.lane + 256 * j + e; const f32x4 w0 = *(const f32x4*)(wfs + k * 8), w1 = *(const f32x4*)(wfs + k * 8 + 4);
                    const float hv = v[j][e];
                    f[0] += hv * w0.x; f[1] += hv * w0.y; f[2] += hv * w0.z; f[3] += hv * w0.w; f[4] += hv * w1.x; f[5] += hv * w1.y; f[6] += hv * w1.z; f[7] += hv * w1.w; }
            }
        }
        if (FG) {
#pragma unroll
            for (int q = 0; q < 8; ++q) f[q] = wave_sum(f[q]);
            float fv = f[0];
#pragma unroll
            for (int q = 1; q < 8; ++q) fv = (c.lane == q) ? f[q] : fv;
            if (c.lane < 8) { const float x = fv + P.in[7][l * 8 + c.lane]; const float ls = fminf(x, 0.f) - __logf(1.f + __expf(-fabsf(x))); LOGF[(size_t)(b * 8 + c.lane) * LP + t] = ls; }
        }
    }
}

__device__ __forceinline__ void phase_fcum(const Params& P, const Ctx& c) {
    const int s = c.bid - (c.G - 16);
    if (s < 0) return;
    const float* LOGF = (const float*)(c.ws + OFF_MISC) + (size_t)s * LP; float* FC = (float*)(c.ws + OFF_MISC) + 16 * LP + (size_t)s * LP;
    float* wt = (float*)c.lds;
    const int base = c.tid * 17;
    float v[17]; float run = 0.f;
#pragma unroll
    for (int i = 0; i < 17; ++i) { const int idx = base + i; const float x = (idx < LP) ? LOGF[idx] : 0.f; run += x; v[i] = run; }
    float incl = run;
#pragma unroll
    for (int o = 1; o < 64; o <<= 1) { const float t = __shfl_up(incl, o); if (c.lane >= o) incl += t; }
    if (c.lane == 63) wt[c.wave] = incl;
    __syncthreads();
    float off = incl - run;
#pragma unroll
    for (int w2 = 0; w2 < 8; ++w2) off += (w2 < c.wave) ? wt[w2] : 0.f;
#pragma unroll
    for (int i = 0; i < 17; ++i) { const int idx = base + i; if (idx < LP) FC[idx] = (v[i] + off) * LOG2E; }
    __syncthreads();
}

__device__ __forceinline__ void phase_qknorm(const Params& P, int l, const Ctx& c) {
    bf16* Q = (bf16*)(c.ws + OFF_Q); bf16* K = (bf16*)(c.ws + OFF_K);
    const int gw = c.bid * NWAVES + c.wave, NGW = c.G * NWAVES;
    const int d0 = (c.lane & 7) * 8;
    float gq[8], gk[8];
#pragma unroll
    for (int i = 0; i < 8; ++i) { gq[i] = P.in[5][l * 64 + d0 + i] * QSCALE; gk[i] = P.in[6][l * 64 + d0 + i]; }
    for (int m = gw; m < M; m += NGW) {
#pragma unroll
        for (int which = 0; which < 2; ++which) {
            bf16* p = (which ? K : Q) + (size_t)m * 512 + 8 * c.lane;
            const u32x4 w = *(const u32x4*)p;
            float x[8] = {bflo(w.x), bfhi(w.x), bflo(w.y), bfhi(w.y), bflo(w.z), bfhi(w.z), bflo(w.w), bfhi(w.w)};
            float ss = 0.f;
#pragma unroll
            for (int i = 0; i < 8; ++i) ss += x[i] * x[i];
            ss += __shfl_xor(ss, 1); ss += __shfl_xor(ss, 2); ss += __shfl_xor(ss, 4);
            const float rs = 1.0f / sqrtf(ss * (1.f / 64.f) + 1e-6f);
#pragma unroll
            for (int i = 0; i < 8; ++i) x[i] = x[i] * rs * (which ? gk[i] : gq[i]);
            u32x4 o; o.x = pk2(x[0], x[1]); o.y = pk2(x[2], x[3]); o.z = pk2(x[4], x[5]); o.w = pk2(x[6], x[7]);
            *(u32x4*)p = o;
        }
    }
}

constexpr int NCHK = LP / 64;
constexpr int NUNIT = NB * NCHK * 8;
constexpr int UNIT_A = 16384, UNIT_B = 16640;
constexpr int ST = 72, STG = 136;
constexpr int L_F0 = 92160, L_F1 = 108544;
struct RwkvBufs { bf16 *BON, *G; unsigned char *UA, *UB; float* Y; bf16* ORW; };
__device__ __forceinline__ RwkvBufs rwkv_bufs(const Params& P, const Ctx& c) {
    RwkvBufs r; r.BON = (bf16*)(c.ws + OFF_HN); r.G = r.BON + (size_t)M * 512;
    r.UA = c.ws + OFF_T0; r.UB = (unsigned char*)P.out;
    r.Y = (float*)(c.ws + OFF_RW); r.ORW = (bf16*)(c.ws + OFF_RW + (size_t)M * 512 * 4);
    return r;
}
__device__ __forceinline__ void mm_tile(const bf16* A, int sa, const bf16* Bt, int sb, int nks, f32x4 (&acc)[2], int w, int lq, int g) {
    const int mt = w >> 1, nt0 = 2 * (w & 1);
    for (int ks = 0; ks < nks; ++ks) {
        const bf16x8 a = *(const bf16x8*)(A + (16 * mt + lq) * sa + 32 * ks + 8 * g);
#pragma unroll
        for (int q = 0; q < 2; ++q) { const bf16x8 b = *(const bf16x8*)(Bt + (16 * (nt0 + q) + lq) * sb + 32 * ks + 8 * g); acc[q] = __builtin_amdgcn_mfma_f32_16x16x32_bf16(a, b, acc[q], 0, 0, 0); }
    }
}
template <bool SA, bool SB> __device__ __forceinline__ void mm_tile2(const bf16* A, int sa, const bf16* Bt, int sb, int nks, f32x4 (&acc)[2], int w, int lq, int g) {
    const int mt = w >> 1, nt0 = 2 * (w & 1);
    const int ra = 16 * mt + lq, xa = SA ? 8 * ((ra >> 3) & 7) : 0;
    for (int ks = 0; ks < nks; ++ks) {
        const bf16x8 a = *(const bf16x8*)(A + ra * sa + ((32 * ks + 8 * g) ^ xa));
#pragma unroll
        for (int q = 0; q < 2; ++q) { const int rb = 16 * (nt0 + q) + lq, xb = SB ? 8 * ((rb >> 3) & 7) : 0;
            const bf16x8 bb = *(const bf16x8*)(Bt + rb * sb + ((32 * ks + 8 * g) ^ xb)); acc[q] = __builtin_amdgcn_mfma_f32_16x16x32_bf16(a, bb, acc[q], 0, 0, 0); }
    }
}
#define ZACC(a) do { a[0] = (f32x4){0.f, 0.f, 0.f, 0.f}; a[1] = (f32x4){0.f, 0.f, 0.f, 0.f}; } while (0)
__device__ __forceinline__ int permk(int k) { return 32 * (k >> 5) + 8 * ((k & 15) >> 2) + 4 * ((k >> 4) & 1) + (k & 3); }
__device__ __forceinline__ int swz(int row, int col) { return row * 128 + ((((col >> 3) ^ (row >> 1)) & 7) << 4) + (col & 7) * 2; }

__device__ __forceinline__ void rwkv_prep_unit(const Params& P, int l, const Ctx& c, int u, const RwkvBufs& B, const float (&pw0)[8], const float (&pa0)[8], const float (&pkk)[8], const float (&pka)[8], const float (&prk)[8]) {
    const int h = u & 7, bc = u >> 3, b = bc / NCHK, ch = bc - b * NCHK;
    const size_t m0 = (size_t)b * LP + ch * 64;
    int tid_ = c.tid; asm volatile("" : "+v"(tid_));
    const int tid = tid_, lane = tid & 63, w = c.wave, lq = lane & 15, g = lane >> 4;
    const int t = tid >> 3, cg = tid & 7, c0 = cg * 8, jb = h * 64 + c0;
    unsigned char* L = c.lds;
    bf16* A0 = (bf16*)L; bf16* A1 = A0 + 4608; bf16* A2 = A1 + 4608; bf16* A3 = A2 + 4608; bf16* A4 = A3 + 4608; bf16* A5 = A4 + 4608; bf16* A6 = A5 + 4608;
    bf16* A7 = A6 + 4608; bf16* A8 = A7 + 4608; bf16* A9 = A8 + 4608;
    float* F0 = (float*)(L + L_F0); float* F1 = (float*)(L + L_F1);
    const bf16* RW = (const bf16*)(c.ws + OFF_RW);
    const bf16* WT = (const bf16*)(c.ws + OFF_WT);
    const float* mu = P.in[8] + l * NRW;
    const bool first = (ch == 0 && t == 0);
    const bf16* cur = RW + (m0 + t) * NRW; const bf16* prv = cur - NRW;
    float zr[8], zk[8], zv[8];
#pragma unroll
    for (int s = 0; s < 3; ++s) {
        const u32x4 cw = *(const u32x4*)(cur + s * 512 + jb); u32x4 pw = (u32x4){0u, 0u, 0u, 0u}; if (!first) pw = *(const u32x4*)(prv + s * 512 + jb);
        const float cv[8] = {bflo(cw.x), bfhi(cw.x), bflo(cw.y), bfhi(cw.y), bflo(cw.z), bfhi(cw.z), bflo(cw.w), bfhi(cw.w)};
        const float pv[8] = {bflo(pw.x), bfhi(pw.x), bflo(pw.y), bfhi(pw.y), bflo(pw.z), bfhi(pw.z), bflo(pw.w), bfhi(pw.w)};
#pragma unroll
        for (int i = 0; i < 8; ++i) { const float z = cv[i] + mu[s * 512 + jb + i] * (pv[i] - cv[i]); if (s == 0) zr[i] = z; else if (s == 1) zk[i] = z; else zv[i] = z; }
    }
#pragma unroll
    for (int q4 = 0; q4 < 4; ++q4) {
        const int col = cg * 32 + q4 * 8;
        const u32x4 cw = *(const u32x4*)(cur + 1536 + col); u32x4 pw = (u32x4){0u, 0u, 0u, 0u}; if (!first) pw = *(const u32x4*)(prv + 1536 + col);
        const float cv[8] = {bflo(cw.x), bfhi(cw.x), bflo(cw.y), bfhi(cw.y), bflo(cw.z), bfhi(cw.z), bflo(cw.w), bfhi(cw.w)};
        const float pv[8] = {bflo(pw.x), bfhi(pw.x), bflo(pw.y), bfhi(pw.y), bflo(pw.z), bfhi(pw.z), bflo(pw.w), bfhi(pw.w)};
        float z[8];
#pragma unroll
        for (int i = 0; i < 8; ++i) { z[i] = cv[i] + mu[1536 + col + i] * (pv[i] - cv[i]); if (col < 64) z[i] = 1.f - 2.f / (1.f + __expf(2.f * z[i])); else if (col >= 128) z[i] = sigmoidf_(z[i]); }
        u32x4 o; o.x = pk2(z[0], z[1]); o.y = pk2(z[2], z[3]); o.z = pk2(z[4], z[5]); o.w = pk2(z[6], z[7]);
        bf16* dst = (col < 64) ? A0 + t * ST + col : (col < 128 ? A1 + t * ST + (col - 64) : A2 + t * STG + (col - 128));
        *(u32x4*)dst = o;
    }
    { const int row = tid >> 3, chk = tid & 7;
      *(u32x4*)(A4 + row * ST + chk * 8) = *(const u32x4*)(WT + WT_LW + (size_t)(h * 64 + row) * 64 + chk * 8);
      *(u32x4*)(A5 + row * ST + chk * 8) = *(const u32x4*)(WT + WT_LA + (size_t)(h * 64 + row) * 64 + chk * 8);
#pragma unroll
      for (int i = 0; i < 2; ++i) { const int idx = tid + 512 * i, r2 = idx >> 4, c2 = idx & 15;
          *(u32x4*)((bf16*)F1 + r2 * STG + c2 * 8) = *(const u32x4*)(WT + WT_LG + (size_t)(h * 64 + r2) * 128 + c2 * 8); } }
    LDS_BARRIER();
    { f32x4 aw[2], aa[2], ag[2]; ZACC(aw); ZACC(aa); ZACC(ag);
      mm_tile(A4, ST, A0, ST, 2, aw, w, lq, g); mm_tile(A5, ST, A1, ST, 2, aa, w, lq, g); mm_tile((const bf16*)F1, STG, A2, STG, 4, ag, w, lq, g);
      const int mt = w >> 1, nt0 = 2 * (w & 1);
#pragma unroll
      for (int q = 0; q < 2; ++q) { const int o = (16 * (nt0 + q) + lq) * ST + 16 * mt + 4 * g; u32x2 p;
          p.x = pk2(aw[q][0], aw[q][1]); p.y = pk2(aw[q][2], aw[q][3]); *(u32x2*)(A7 + o) = p;
          p.x = pk2(aa[q][0], aa[q][1]); p.y = pk2(aa[q][2], aa[q][3]); *(u32x2*)(A8 + o) = p;
          p.x = pk2(ag[q][0], ag[q][1]); p.y = pk2(ag[q][2], ag[q][3]); *(u32x2*)(A9 + o) = p; } }
    LDS_BARRIER();
    float kk[8], k2[8], ar[8];
    { const u32x4 lw = *(const u32x4*)(A7 + t * ST + c0), la = *(const u32x4*)(A8 + t * ST + c0), lg = *(const u32x4*)(A9 + t * ST + c0);
      const float fw[8] = {bflo(lw.x), bfhi(lw.x), bflo(lw.y), bfhi(lw.y), bflo(lw.z), bfhi(lw.z), bflo(lw.w), bfhi(lw.w)};
      const float fa[8] = {bflo(la.x), bfhi(la.x), bflo(la.y), bfhi(la.y), bflo(la.z), bfhi(la.z), bflo(la.w), bfhi(la.w)};
      float ss = 0.f, bs = 0.f;
#pragma unroll
      for (int i = 0; i < 8; ++i) {
          const float xw = -(pw0[i] + fw[i]); const float sp = fmaxf(xw, 0.f) + __logf(1.f + __expf(-fabsf(xw)));
          F0[t * 64 + c0 + i] = __expf(-sp - 0.5f);
          ar[i] = sigmoidf_(pa0[i] + fa[i]);
          kk[i] = zk[i] * pkk[i]; ss += kk[i] * kk[i];
          k2[i] = zk[i] * (1.f + (ar[i] - 1.f) * pka[i]);
          bs += zr[i] * k2[i] * prk[i]; }
      ss += __shfl_xor(ss, 1); ss += __shfl_xor(ss, 2); ss += __shfl_xor(ss, 4);
      bs += __shfl_xor(bs, 1); bs += __shfl_xor(bs, 2); bs += __shfl_xor(bs, 4);
      const float inv = 1.0f / fmaxf(sqrtf(ss), 1e-12f);
#pragma unroll
      for (int i = 0; i < 8; ++i) kk[i] *= inv;
      u32x4 bo; bo.x = pk2(bs * zv[0], bs * zv[1]); bo.y = pk2(bs * zv[2], bs * zv[3]); bo.z = pk2(bs * zv[4], bs * zv[5]); bo.w = pk2(bs * zv[6], bs * zv[7]);
      *(u32x4*)(B.BON + (m0 + t) * 512 + jb) = bo; *(u32x4*)(B.G + (m0 + t) * 512 + jb) = lg; }
    LDS_BARRIER();
    {
      const int k = tid & 63, sg = tid >> 6; float e[8], run = 0.f;
#pragma unroll
      for (int s = 0; s < 8; ++s) { run += F0[(8 * sg + s) * 64 + k]; e[s] = run; }
      F1[sg * 64 + k] = run;
      LDS_BARRIER();
      float off = 0.f;
#pragma unroll
      for (int s = 0; s < 8; ++s) off += (s < sg) ? F1[s * 64 + k] : 0.f;
#pragma unroll
      for (int s = 0; s < 8; ++s) F0[(8 * sg + s) * 64 + k] = e[s] + off; }
    LDS_BARRIER();
    { float ct[8], cp[8], cC[8];
#pragma unroll
      for (int i = 0; i < 8; ++i) { ct[i] = F0[t * 64 + c0 + i]; cp[i] = (t > 0) ? F0[(t - 1) * 64 + c0 + i] : 0.f; cC[i] = F0[63 * 64 + c0 + i]; }
      float at[8], bt[8], kt[8], rt[8], bh[8], kh[8];
#pragma unroll
      for (int i = 0; i < 8; ++i) { const float gt = __expf(-ct[i]), igt = __expf(ct[i]), gp = __expf(-cp[i]), gct = __expf(ct[i] - cC[i]);
          at[i] = -kk[i] * gp; bt[i] = kk[i] * ar[i] * igt; kt[i] = k2[i] * igt; rt[i] = zr[i] * gt; bh[i] = kk[i] * ar[i] * gct; kh[i] = k2[i] * gct; }
      u32x4 o;
      o.x = pk2(at[0], at[1]); o.y = pk2(at[2], at[3]); o.z = pk2(at[4], at[5]); o.w = pk2(at[6], at[7]); *(u32x4*)(A0 + t * ST + c0) = o;
      o.x = pk2(bt[0], bt[1]); o.y = pk2(bt[2], bt[3]); o.z = pk2(bt[4], bt[5]); o.w = pk2(bt[6], bt[7]); *(u32x4*)(A1 + t * ST + c0) = o;
      o.x = pk2(kt[0], kt[1]); o.y = pk2(kt[2], kt[3]); o.z = pk2(kt[4], kt[5]); o.w = pk2(kt[6], kt[7]); *(u32x4*)(A2 + t * ST + c0) = o;
      o.x = pk2(rt[0], rt[1]); o.y = pk2(rt[2], rt[3]); o.z = pk2(rt[4], rt[5]); o.w = pk2(rt[6], rt[7]); *(u32x4*)(A3 + t * ST + c0) = o;
#pragma unroll
      for (int i = 0; i < 8; ++i) { const int o = (c0 + i) * ST + (t ^ c0);
          A4[o] = (bf16)f2bf(bh[i]); A5[o] = (bf16)f2bf(kh[i]); A6[o] = (bf16)f2bf(zv[i]); F1[t * 128 + c0 + i] = at[i]; }
      if (t == 63) { float* gc = (float*)(B.UB + (size_t)u * UNIT_B + 16384) + c0;
#pragma unroll
          for (int i = 0; i < 8; ++i) gc[i] = __expf(-cC[i]); } }
    LDS_BARRIER();
    { const int mt = w >> 1, nt0 = 2 * (w & 1);
      f32x4 a[2];
      ZACC(a); mm_tile(A0, ST, A1, ST, 2, a, w, lq, g);
#pragma unroll
      for (int q = 0; q < 2; ++q) { const int i = 16 * (nt0 + q) + lq; f32x4 lab;
#pragma unroll
          for (int j = 0; j < 4; ++j) lab[j] = (i < 16 * mt + 4 * g + j) ? a[q][j] : 0.f;
#pragma unroll
          for (int j = 0; j < 4; ++j) F0[i * 64 + j * 16 + 4 * mt + g] = lab[j]; }
      asm volatile("" ::: "memory");
#define ST1_STORE(DST, INCL) do { _Pragma("unroll") for (int q = 0; q < 2; ++q) { const int tt = 16 * (nt0 + q) + lq, i0 = 16 * mt + 4 * g; float v_[4]; \
          _Pragma("unroll") for (int j = 0; j < 4; ++j) v_[j] = (i0 + j < tt + (INCL)) ? a[q][j] : 0.f; \
          u32x2 p_; p_.x = pk2(v_[0], v_[1]); p_.y = pk2(v_[2], v_[3]); *(u32x2*)((DST) + tt * ST + i0) = p_; } } while (0)
      ZACC(a); mm_tile(A2, ST, A0, ST, 2, a, w, lq, g); ST1_STORE(A7, 0); asm volatile("" ::: "memory");
      ZACC(a); mm_tile(A1, ST, A3, ST, 2, a, w, lq, g); ST1_STORE(A8, 1); asm volatile("" ::: "memory");
      ZACC(a); mm_tile(A2, ST, A3, ST, 2, a, w, lq, g); ST1_STORE(A9, 1);
#undef ST1_STORE
    }
    LDS_BARRIER();
    { const int mt = w >> 1, nt0 = 2 * (w & 1); f32x4 a[2]; ZACC(a);
      mm_tile2<true, false>(A6, ST, A7, ST, 2, a, w, lq, g);
#pragma unroll
      for (int q = 0; q < 2; ++q) *(f32x4*)(F1 + (16 * (nt0 + q) + lq) * 128 + 64 + 16 * mt + 4 * g) = a[q]; }
    LDS_BARRIER();
    { float X[16];
      const int col = 16 * w + lq;
#pragma unroll
      for (int r = 0; r < 16; ++r) X[r] = F1[(4 * r + g) * 128 + col];
      LDS_BARRIER();
      f32x4 Lc[4];
#pragma unroll
      for (int q = 0; q < 4; ++q) Lc[q] = *(const f32x4*)(F0 + g * 16 + 4 * q);
#pragma unroll
      for (int i = 0; i < 64; ++i) {
          const float xi = __shfl(X[i >> 2], (i & 3) * 16 + lq);
          f32x4 Ln[4];
#pragma unroll
          for (int q = 0; q < 4; ++q) Ln[q] = Lc[q];
          if (i + 1 < 64) {
#pragma unroll
              for (int q = ((i + 1) >> 4); q < 4; ++q) Ln[q] = *(const f32x4*)(F0 + (i + 1) * 64 + g * 16 + 4 * q);
          }
#pragma unroll
          for (int r = (i >> 2); r < 16; ++r) X[r] += Lc[r >> 2][r & 3] * xi;
#pragma unroll
          for (int q = 0; q < 4; ++q) Lc[q] = Ln[q];
          __builtin_amdgcn_sched_barrier(0);
      }
      bf16* XT = (bf16*)F1 + (w >> 2) * 4608 + ((col & 63) * ST);
#pragma unroll
      for (int r = 0; r < 16; ++r) XT[4 * r + g] = (bf16)f2bf(X[r]); }
    LDS_BARRIER();
    { const int mt = w >> 1, nt0 = 2 * (w & 1);
      const bf16* AhT = (const bf16*)F1; const bf16* W2T = AhT + 4608;
      unsigned char* ua = B.UA + (size_t)u * UNIT_A; unsigned char* ub = B.UB + (size_t)u * UNIT_B;
      const int p0 = 32 * (mt >> 1) + 8 * g + 4 * (mt & 1);
      f32x4 a[2];
      ZACC(a); mm_tile2<false, true>(AhT, ST, A4, ST, 2, a, w, lq, g);
#pragma unroll
      for (int q = 0; q < 2; ++q) { const int k = 16 * (nt0 + q) + lq; u32x2 o; o.x = pk2(a[q][0], a[q][1]); o.y = pk2(a[q][2], a[q][3]); *(u32x2*)(ua + swz(k, p0)) = o; }
      ZACC(a); mm_tile(AhT, ST, A8, ST, 2, a, w, lq, g);
#pragma unroll
      for (int q = 0; q < 2; ++q) { const int tt = 16 * (nt0 + q) + lq; const u32x2 rr = *(const u32x2*)(A3 + tt * ST + 16 * mt + 4 * g);
          u32x2 o; o.x = pk2(a[q][0] + bflo(rr.x), a[q][1] + bfhi(rr.x)); o.y = pk2(a[q][2] + bflo(rr.y), a[q][3] + bfhi(rr.y)); *(u32x2*)(ua + 8192 + swz(tt, p0)) = o; }
      ZACC(a); mm_tile2<true, false>(A4, ST, W2T, ST, 2, a, w, lq, g); mm_tile2<true, true>(A5, ST, A6, ST, 2, a, w, lq, g);
#pragma unroll
      for (int q = 0; q < 2; ++q) { const int v = 16 * (nt0 + q) + lq, k0 = 16 * mt + 4 * g; u32x2 o; o.x = pk2(a[q][0], a[q][1]); o.y = pk2(a[q][2], a[q][3]); *(u32x2*)(ub + swz(v, k0)) = o; }
      ZACC(a); mm_tile(A8, ST, W2T, ST, 2, a, w, lq, g); mm_tile2<false, true>(A9, ST, A6, ST, 2, a, w, lq, g);
#pragma unroll
      for (int q = 0; q < 2; ++q) { const int v = 16 * (nt0 + q) + lq, t0 = 16 * mt + 4 * g; u32x2 o; o.x = pk2(a[q][0], a[q][1]); o.y = pk2(a[q][2], a[q][3]); *(u32x2*)(ub + 8192 + swz(v, t0)) = o; } }
    LDS_BARRIER();
}
__device__ __forceinline__ void phase_rwkv_prep(const Params& P, int l, const Ctx& c) {
    const RwkvBufs B = rwkv_bufs(P, c);
    float pw0[8], pa0[8], pkk[8], pka[8], prk[8]; int hprev = -1;
    for (int u = c.bid; u < NUNIT; u += c.G) {
        const int h = u & 7;
        if (h != hprev) { hprev = h; const int j0 = l * 512 + h * 64 + (c.tid & 7) * 8;
#pragma unroll
            for (int i = 0; i < 8; ++i) { pw0[i] = P.in[9][j0 + i]; pa0[i] = P.in[11][j0 + i]; pkk[i] = P.in[14][j0 + i]; pka[i] = P.in[15][j0 + i]; prk[i] = P.in[16][j0 + i]; } }
        rwkv_prep_unit(P, l, c, u, B, pw0, pa0, pkk, pka, prk);
    }
}

constexpr int SLOTB = 33280, YST = 68;
__device__ __forceinline__ void scan_chunked(const Params& P, const Ctx& c, int bh) {
    const RwkvBufs B = rwkv_bufs(P, c);
    const int b = bh >> 3, h = bh & 7, w = c.wave, lane = c.lane, lq = lane & 15, g = lane >> 4;
    const size_t rowb = (size_t)b * LP;
    const int ll = c.tid;
    unsigned char* L = c.lds;
    f32x4 st[4];
#pragma unroll
    for (int i = 0; i < 4; ++i) st[i] = (f32x4){0.f, 0.f, 0.f, 0.f};
    u32x4 r0[5], r1[5], r2[5], r3[5], r4[5];
#define SC_UNIT(cc) ((size_t)((b * NCHK + (cc)) * 8 + h))
#define SC_LOAD(R, cc) do { const unsigned char* pa_ = B.UA + SC_UNIT(cc) * UNIT_A; const unsigned char* pb_ = B.UB + SC_UNIT(cc) * UNIT_B; \
        _Pragma("unroll") for (int i_ = 0; i_ < 2; ++i_) { R[i_] = GLD(u32x4, pa_ + (ll + 512 * i_) * 16); R[2 + i_] = GLD(u32x4, pb_ + (ll + 512 * i_) * 16); } \
        if (ll < 16) R[4] = GLD(u32x4, pb_ + 16384 + ll * 16); } while (0)
#define SC_WRITE(R, slot) do { unsigned char* s_ = L + (slot) * SLOTB; \
        _Pragma("unroll") for (int i_ = 0; i_ < 2; ++i_) { *(u32x4*)(s_ + (ll + 512 * i_) * 16) = R[i_]; *(u32x4*)(s_ + 16384 + (ll + 512 * i_) * 16) = R[2 + i_]; } \
        if (ll < 16) *(u32x4*)(s_ + 32768 + ll * 16) = R[4]; } while (0)
#define SC_COMPUTE(ci) do { \
        const unsigned char* sl = L + ((ci) % 3) * SLOTB; \
        const int vcol = 16 * w + lq; \
        bf16x8 gaf[4][2]; f32x4 gcf[4]; u32x2 d0f[4]; \
        _Pragma("unroll") for (int mt = 0; mt < 4; ++mt) { \
            gcf[mt] = *(const f32x4*)(sl + 32768 + (16 * mt + 4 * g) * 4); \
            d0f[mt] = *(const u32x2*)(sl + 16384 + swz(vcol, 16 * mt + 4 * g)); \
            _Pragma("unroll") for (int ks = 0; ks < 2; ++ks) gaf[mt][ks] = *(const bf16x8*)(sl + swz(16 * mt + lq, 32 * ks + 8 * g)); } \
        __builtin_amdgcn_sched_barrier(0);        \
        bf16x8 sb[2]; \
        _Pragma("unroll") for (int ks = 0; ks < 2; ++ks) { u32x4 pw; pw.x = pk2(st[2 * ks][0], st[2 * ks][1]); pw.y = pk2(st[2 * ks][2], st[2 * ks][3]); pw.z = pk2(st[2 * ks + 1][0], st[2 * ks + 1][1]); pw.w = pk2(st[2 * ks + 1][2], st[2 * ks + 1][3]); \
            sb[ks] = __builtin_bit_cast(bf16x8, pw); } \
        _Pragma("unroll") for (int mt = 0; mt < 4; ++mt) { \
            f32x4 ns = (f32x4){bflo(d0f[mt].x), bfhi(d0f[mt].x), bflo(d0f[mt].y), bfhi(d0f[mt].y)} + gcf[mt] * st[mt]; \
            _Pragma("unroll") for (int ks = 0; ks < 2; ++ks) ns = __builtin_amdgcn_mfma_f32_16x16x32_bf16(gaf[mt][ks], sb[ks], ns, 0, 0, 0); \
            st[mt] = ns; } \
        bf16x8 rhf[4][2]; u32x2 y0f[4];        \
        _Pragma("unroll") for (int mt = 0; mt < 4; ++mt) { y0f[mt] = *(const u32x2*)(sl + 24576 + swz(vcol, 16 * mt + 4 * g)); \
            _Pragma("unroll") for (int ks = 0; ks < 2; ++ks) rhf[mt][ks] = *(const bf16x8*)(sl + 8192 + swz(16 * mt + lq, 32 * ks + 8 * g)); } \
        __builtin_amdgcn_sched_barrier(0); \
        f32x4 yav[4]; \
        _Pragma("unroll") for (int mt = 0; mt < 4; ++mt) { yav[mt] = (f32x4){bflo(y0f[mt].x), bfhi(y0f[mt].x), bflo(y0f[mt].y), bfhi(y0f[mt].y)}; \
            _Pragma("unroll") for (int ks = 0; ks < 2; ++ks) yav[mt] = __builtin_amdgcn_mfma_f32_16x16x32_bf16(rhf[mt][ks], sb[ks], yav[mt], 0, 0, 0); } \
        _Pragma("unroll") for (int mt = 0; mt < 4; ++mt) { \
            float* yl = (float*)(L + 3 * SLOTB) + ((ci) & 1) * (64 * YST) + (16 * mt + 4 * g) * YST + vcol; \
            _Pragma("unroll") for (int j = 0; j < 4; ++j) yl[j * YST] = yav[mt][j]; } } while (0)
#define SC_YSTORE(ci) do { const float* ys_ = (const float*)(L + 3 * SLOTB) + ((ci) & 1) * (64 * YST) + (c.tid >> 3) * YST + (c.tid & 7) * 8; \
        float* yg_ = B.Y + (rowb + (ci) * 64 + (c.tid >> 3)) * 512 + h * 64 + (c.tid & 7) * 8; \
        GST(f32x4, yg_) = *(const f32x4*)ys_; GST(f32x4, yg_ + 4) = *(const f32x4*)(ys_ + 4); } while (0)
#define SC_ITER(ci, R) do { if ((ci) + 2 < NCHK) SC_WRITE(R, ((ci) + 2) % 3); if ((ci) + 7 < NCHK) SC_LOAD(R, (ci) + 7); if ((ci) > 0) SC_YSTORE((ci) - 1); if (w < 4) { SC_COMPUTE(ci); } LDS_BARRIER(); } while (0)
    { SC_LOAD(r0, 0); SC_LOAD(r1, 1); SC_WRITE(r0, 0); SC_WRITE(r1, 1); SC_LOAD(r2, 2); SC_LOAD(r3, 3); SC_LOAD(r4, 4); SC_LOAD(r0, 5); SC_LOAD(r1, 6); }
    __syncthreads();
#pragma unroll 1
    for (int cc = 0; cc < NCHK; cc += 5) { SC_ITER(cc, r2); SC_ITER(cc + 1, r3); SC_ITER(cc + 2, r4); SC_ITER(cc + 3, r0); SC_ITER(cc + 4, r1); }
    SC_YSTORE(NCHK - 1);
#undef SC_YSTORE
#undef SC_COMPUTE
#undef SC_ITER
#undef SC_UNIT
#undef SC_LOAD
#undef SC_WRITE
}

__device__ __forceinline__ void phase_gn(const Params& P, int l, const Ctx& c) {
    const RwkvBufs B = rwkv_bufs(P, c);
    const int gw = c.bid * NWAVES + c.wave, NGW = c.G * NWAVES;
    const int c0 = 8 * c.lane;
    float gnw[8], gnb[8];
#pragma unroll
    for (int i = 0; i < 8; ++i) { gnw[i] = P.in[17][l * 512 + c0 + i]; gnb[i] = P.in[18][l * 512 + c0 + i]; }
    for (int m = gw; m < M; m += NGW) {
        const size_t o = (size_t)m * 512 + c0;
        const f32x4 y0 = *(const f32x4*)(B.Y + o), y1 = *(const f32x4*)(B.Y + o + 4);
        float y[8] = {y0.x, y0.y, y0.z, y0.w, y1.x, y1.y, y1.z, y1.w};
        const u32x4 bw = *(const u32x4*)(B.BON + o), gw4 = *(const u32x4*)(B.G + o);
        const float bo[8] = {bflo(bw.x), bfhi(bw.x), bflo(bw.y), bfhi(bw.y), bflo(bw.z), bfhi(bw.z), bflo(bw.w), bfhi(bw.w)};
        const float gg[8] = {bflo(gw4.x), bfhi(gw4.x), bflo(gw4.y), bfhi(gw4.y), bflo(gw4.z), bfhi(gw4.z), bflo(gw4.w), bfhi(gw4.w)};
        float s = 0.f;
#pragma unroll
        for (int i = 0; i < 8; ++i) s += y[i];
        s += __shfl_xor(s, 1); s += __shfl_xor(s, 2); s += __shfl_xor(s, 4);
        const float mean = s * (1.f / 64.f);
        float q = 0.f;
#pragma unroll
        for (int i = 0; i < 8; ++i) { y[i] -= mean; q += y[i] * y[i]; }
        q += __shfl_xor(q, 1); q += __shfl_xor(q, 2); q += __shfl_xor(q, 4);
        const float rstd = 1.0f / sqrtf(q * (1.f / 64.f) + 64e-5f);
        float ov[8];
#pragma unroll
        for (int i = 0; i < 8; ++i) ov[i] = (y[i] * rstd * gnw[i] + gnb[i] + bo[i]) * gg[i];
        u32x4 ow; ow.x = pk2(ov[0], ov[1]); ow.y = pk2(ov[2], ov[3]); ow.z = pk2(ov[4], ov[5]); ow.w = pk2(ov[6], ov[7]);
        *(u32x4*)(B.ORW + o) = ow;
    }
}

__device__ __forceinline__ void attn_unit(const Ctx& c, int bh, int qb, const bf16* Q, const bf16* K, const bf16* V, bf16* O, const float* FC, float qkb2, const float* gq, const float* gk) {
    const int b = bh >> 3, h = bh & 7, lane = c.lane, w = c.wave, lq = lane & 15, g = lane >> 4;
    const int q0 = qb * 128;
    const size_t rowb = (size_t)b * LP;
    const int qrow = q0 + 16 * w + lq;
    bf16* Ks = (bf16*)c.lds; bf16* Vt = Ks + 64 * 72; float* fks = (float*)(Vt + 64 * 72);
    const bf16* qp = Q + (rowb + qrow) * 512 + h * 64 + 8 * g;
    bf16x8 qf0, qf1;
    { const u32x4 r0 = GLD(u32x4, qp), r1 = GLD(u32x4, qp + 32);
      float x[16] = {bflo(r0.x), bfhi(r0.x), bflo(r0.y), bfhi(r0.y), bflo(r0.z), bfhi(r0.z), bflo(r0.w), bfhi(r0.w), bflo(r1.x), bfhi(r1.x), bflo(r1.y), bfhi(r1.y), bflo(r1.z), bfhi(r1.z), bflo(r1.w), bfhi(r1.w)};
      float ss = 0.f;
#pragma unroll
      for (int i = 0; i < 16; ++i) ss += x[i] * x[i];
      ss += __shfl_xor(ss, 16); ss += __shfl_xor(ss, 32);
      const float rs = QSCALE / sqrtf(ss * (1.f / 64.f) + 1e-6f);
#pragma unroll
      for (int i = 0; i < 8; ++i) { x[i] *= rs * gq[8 * g + i]; x[8 + i] *= rs * gq[32 + 8 * g + i]; }
      u32x4 p0, p1; p0.x = pk2(x[0], x[1]); p0.y = pk2(x[2], x[3]); p0.z = pk2(x[4], x[5]); p0.w = pk2(x[6], x[7]); p1.x = pk2(x[8], x[9]); p1.y = pk2(x[10], x[11]); p1.z = pk2(x[12], x[13]); p1.w = pk2(x[14], x[15]);
      qf0 = __builtin_bit_cast(bf16x8, p0); qf1 = __builtin_bit_cast(bf16x8, p1); }
    const float* FCh = FC + (size_t)bh * LP;
    const float fq = GLD(float, FCh + qrow);
    float mrun = -1e30f, lsum = 0.f;
    f32x4 o[4];
#pragma unroll
    for (int i = 0; i < 4; ++i) o[i] = (f32x4){0.f, 0.f, 0.f, 0.f};
    const int kt_max = (q0 + 127) >> 6;
    const int lkey = c.tid >> 3, lch = c.tid & 7;
    float gkr[8];
#pragma unroll
    for (int i = 0; i < 8; ++i) gkr[i] = gk[lch * 8 + i];
    const size_t gbase = (rowb + lkey) * 512 + h * 64 + lch * 8;
    u32x4 kv = GLD(u32x4, K + gbase + (size_t)kt_max * 64 * 512), vv = GLD(u32x4, V + gbase + (size_t)kt_max * 64 * 512);
    float fkv = GLD(float, FCh + kt_max * 64 + (c.tid & 63));
    volatile unsigned* vote = (volatile unsigned*)(fks + 64);
    for (int kt = kt_max; kt >= 0; --kt) {
        const int k0 = kt * 64;
        LDS_BARRIER();
        { int can = 0; if (kt < kt_max) { const float fl = __shfl(fkv, 63); can = (qkb2 + fq - fl) < (mrun - THR2); }
          const int wall = __all(can); if (lane == 0) vote[w] = (unsigned)wall; }
        { { float x[8] = {bflo(kv.x), bfhi(kv.x), bflo(kv.y), bfhi(kv.y), bflo(kv.z), bfhi(kv.z), bflo(kv.w), bfhi(kv.w)}; float ss = 0.f;
#pragma unroll
              for (int i = 0; i < 8; ++i) ss += x[i] * x[i];
              ss += __shfl_xor(ss, 1); ss += __shfl_xor(ss, 2); ss += __shfl_xor(ss, 4);
              const float rs = 1.0f / sqrtf(ss * (1.f / 64.f) + 1e-6f);
              u32x4 kn; kn.x = pk2(x[0] * rs * gkr[0], x[1] * rs * gkr[1]); kn.y = pk2(x[2] * rs * gkr[2], x[3] * rs * gkr[3]); kn.z = pk2(x[4] * rs * gkr[4], x[5] * rs * gkr[5]); kn.w = pk2(x[6] * rs * gkr[6], x[7] * rs * gkr[7]);
              *(u32x4*)(Ks + lkey * 72 + lch * 8) = kn; }
            bf16* vd = Vt + (lch * 8) * 72 + lkey;
            vd[0] = (bf16)(vv.x & 0xffff); vd[72] = (bf16)(vv.x >> 16); vd[144] = (bf16)(vv.y & 0xffff); vd[216] = (bf16)(vv.y >> 16);
            vd[288] = (bf16)(vv.z & 0xffff); vd[360] = (bf16)(vv.z >> 16); vd[432] = (bf16)(vv.w & 0xffff); vd[504] = (bf16)(vv.w >> 16);
            if (c.tid < 64) fks[c.tid] = fkv;
            if (kt > 0) { kv = GLD(u32x4, K + gbase + (size_t)(k0 - 64) * 512); vv = GLD(u32x4, V + gbase + (size_t)(k0 - 64) * 512); fkv = GLD(float, FCh + k0 - 64 + (c.tid & 63)); } }
        LDS_BARRIER();
        { unsigned all = vote[0] & vote[1] & vote[2] & vote[3] & vote[4] & vote[5] & vote[6] & vote[7]; if (all) break; }
        if (k0 > q0 + 16 * w + 15) continue;
        f32x4 s[4];
#pragma unroll
        for (int nt = 0; nt < 4; ++nt) { const bf16* kp = Ks + (16 * nt + lq) * 72 + 8 * g; const bf16x8 a0 = *(const bf16x8*)kp, a1 = *(const bf16x8*)(kp + 32);
            s[nt] = __builtin_amdgcn_mfma_f32_16x16x32_bf16(a0, qf0, (f32x4){0.f, 0.f, 0.f, 0.f}, 0, 0, 0);
            s[nt] = __builtin_amdgcn_mfma_f32_16x16x32_bf16(a1, qf1, s[nt], 0, 0, 0); }
        float mx = -INFINITY;
#pragma unroll
        for (int nt = 0; nt < 4; ++nt) { const f32x4 fk = *(const f32x4*)(fks + 16 * nt + 4 * g);
#pragma unroll
            for (int j = 0; j < 4; ++j) { float x = s[nt][j] + fq - fk[j]; const int key = k0 + 16 * nt + 4 * g + j; if (key > qrow) x = -INFINITY; s[nt][j] = x; mx = fmaxf(mx, x); } }
        mx = fmaxf(mx, __shfl_xor(mx, 16)); mx = fmaxf(mx, __shfl_xor(mx, 32));
        const float mnew = fmaxf(mrun, mx), alpha = __builtin_amdgcn_exp2f(mrun - mnew); mrun = mnew;
        float psum = 0.f;
#pragma unroll
        for (int nt = 0; nt < 4; ++nt)
#pragma unroll
            for (int j = 0; j < 4; ++j) { const float p = __builtin_amdgcn_exp2f(s[nt][j] - mnew); s[nt][j] = p; psum += p; }
        lsum = lsum * alpha + psum;
#pragma unroll
        for (int dt = 0; dt < 4; ++dt) o[dt] = o[dt] * alpha;
        bf16x8 pb[2];
#pragma unroll
        for (int k2 = 0; k2 < 2; ++k2) { u32x4 pw; pw.x = pk2(s[2 * k2][0], s[2 * k2][1]); pw.y = pk2(s[2 * k2][2], s[2 * k2][3]); pw.z = pk2(s[2 * k2 + 1][0], s[2 * k2 + 1][1]); pw.w = pk2(s[2 * k2 + 1][2], s[2 * k2 + 1][3]);
            pb[k2] = __builtin_bit_cast(bf16x8, pw); }
#pragma unroll
        for (int dt = 0; dt < 4; ++dt)
#pragma unroll
            for (int k2 = 0; k2 < 2; ++k2) { const bf16* vp = Vt + (16 * dt + lq) * 72 + 32 * k2 + 4 * g;
                const u32x2 lo = *(const u32x2*)vp, hi = *(const u32x2*)(vp + 16);
                u32x4 aw; aw.x = lo.x; aw.y = lo.y; aw.z = hi.x; aw.w = hi.y;
                o[dt] = __builtin_amdgcn_mfma_f32_16x16x32_bf16(__builtin_bit_cast(bf16x8, aw), pb[k2], o[dt], 0, 0, 0); }
    }
    lsum += __shfl_xor(lsum, 16); lsum += __shfl_xor(lsum, 32);
    const float inv = 1.0f / lsum;
    bf16* op = O + (rowb + qrow) * 512 + h * 64 + 4 * g;
#pragma unroll
    for (int dt = 0; dt < 4; ++dt) { u32x2 ow; ow.x = pk2(o[dt][0] * inv, o[dt][1] * inv); ow.y = pk2(o[dt][2] * inv, o[dt][3] * inv); GST(u32x2, op + 16 * dt) = ow; }
    __syncthreads();
}
__device__ __forceinline__ void phase_attn(const Params& P, int l, const Ctx& c, int first_blk) {
    const bf16* Q = (const bf16*)(c.ws + OFF_Q); const bf16* K = (const bf16*)(c.ws + OFF_K); const bf16* V = (const bf16*)(c.ws + OFF_V);
    const float* FC = (const float*)(c.ws + OFF_MISC) + 16 * LP;
    float gqm = fabsf(P.in[5][l * 64 + c.lane]), gkm = fabsf(P.in[6][l * 64 + c.lane]);
#pragma unroll
    for (int o = 1; o < 64; o <<= 1) { gqm = fmaxf(gqm, __shfl_xor(gqm, o)); gkm = fmaxf(gkm, __shfl_xor(gkm, o)); }
    const float qkb2 = 8.0f * gqm * gkm * LOG2E * 1.03f;
    constexpr int NQB = LP / 128, NU = 16 * NQB;
    unsigned* ctr = (unsigned*)(c.ws + OFF_CTL) + 8192 + 64 * l;
    volatile unsigned* slot = (volatile unsigned*)(c.lds + MISC_OFF) + 4;
    for (;;) {
        __syncthreads();
        if (c.tid == 0) *slot = atomicAdd(ctr, 1u);
        __syncthreads();
        const int u = (int)*slot;
        if (u >= NU) break;
        const int bh = u & 15, qb = NQB - 1 - (u >> 4); attn_unit(c, bh, qb, Q, K, V, (bf16*)(c.ws + OFF_OF), FC, qkb2, P.in[5] + l * 64, P.in[6] + l * 64);
    }
}

__device__ __forceinline__ void phase_fixup(const Params& P, int l, const Ctx& c) {
    bf16* ACT = (bf16*)(c.ws + OFF_RW); const bf16* HALO = (const bf16*)(c.ws + OFF_Q);
    const float* cw = P.in[24] + (size_t)l * 3 * NUP;
    const int total = (M / 64) * 2 * DFF;
    for (int idx = c.bid * NTHR + c.tid; idx < total; idx += c.G * NTHR) {
        const int rr = idx / DFF, ch = idx - rr * DFF, q64 = rr >> 1, e = rr & 1, row = q64 * 64 + e;
        const int t = row % LP;
        int s0, s1, s2;
        if (e == 0) { s0 = q64 * 4 + 2; s1 = (q64 - 1) * 4 + 1; s2 = (q64 - 1) * 4 + 0; } else { s0 = q64 * 4 + 3; s1 = q64 * 4 + 2; s2 = (q64 - 1) * 4 + 1; }
        float uc[2];
#pragma unroll
        for (int bj = 0; bj < 2; ++bj) { const int col = bj * DFF + ch;
            const float u0 = bf2f(HALO[(size_t)s0 * NUP + col]);
            const float u1 = (t >= 1) ? bf2f(HALO[(size_t)s1 * NUP + col]) : 0.f;
            const float u2 = (t >= 2) ? bf2f(HALO[(size_t)s2 * NUP + col]) : 0.f;
            uc[bj] = cw[col] * u2 + cw[NUP + col] * u1 + cw[2 * NUP + col] * u0; }
        ACT[(size_t)row * DFF + ch] = (bf16)f2bf(uc[0] * sigmoidf_(uc[0]) * uc[1]);
    }
}

#define OPQ_S(x) asm volatile("" : "+s"(x))
#define OPQ_V(x) asm volatile("" : "+v"(x))
#define PHASE_BEGIN() do { int t_ = threadIdx.x; OPQ_V(t_); c.tid = t_; c.lane = t_ & 63; c.wave = __builtin_amdgcn_readfirstlane(t_ >> 6); int b_ = blockIdx.x; OPQ_S(b_); c.bid = b_; \
    size_t z_ = 0; OPQ_S(z_); unsigned char* w_ = P.ws + z_;   c.ws = w_; ws = w_; l = lc; OPQ_S(l); WT = (pg8::bf16_t*)(ws + OFF_WT); HN = (pg8::bf16_t*)(ws + OFF_HN); } while (0)
__global__ void __launch_bounds__(NTHR, 2) mega(Params P) {
    extern __shared__ __attribute__((aligned(16))) unsigned char lds[];
    Ctx c; c.G = gridDim.x; c.lds = lds;
    volatile LAS unsigned* MISC = (volatile LAS unsigned*)((LAS unsigned char*)lds + MISC_OFF);
    if (threadIdx.x < 16) MISC[threadIdx.x] = 0u;
    __syncthreads();
    (void)xcd_barrier_post((unsigned*)(P.ws + OFF_CTL) + 1024, MISC + 8);
#define SEAM() do { XcdBarrier xb_; xb_.bar = (unsigned*)(P.ws + OFF_CTL) + 1024; xb_.x = xb_xcc_id(); xb_.st = (volatile LAS unsigned*)((LAS unsigned char*)lds + MISC_OFF) + 8; xcd_barrier(xb_); } while (0)
    PG8_LAS unsigned char* ldsl = (PG8_LAS unsigned char*)lds;
    unsigned char* ws; pg8::bf16_t* WT; pg8::bf16_t* HN; int l;
#pragma unroll 1
    for (int lc = 0; lc < DEPTH; ++lc) {
        PHASE_BEGIN();
        convert_weights(P, l, c);
        phase_norm<true>(P, l, c);
        if (lc == 0) cg::this_grid().sync(); else SEAM();
        PHASE_BEGIN();
        phase_fcum(P, c);
        { pg8::Gemm g{HN, WT + WT_IN, M, N1, 1024, 1024}; pg8::StaticOrder S; S.init(M, N1, c.G, c.bid);
          pg8::EpiRoute E{ws};
          pg8::gemm_phase<pg8::EpiRoute, pg8::StaticOrder, true, true>(ldsl, g, S, E); }
        SEAM();
        PHASE_BEGIN();
        for (int rep_ = 0; rep_ < REP_PREP; ++rep_) phase_rwkv_prep(P, l, c);
        SEAM();
        PHASE_BEGIN();
        if (c.bid < 16) { scan_chunked(P, c, c.bid); __syncthreads(); PHASE_BEGIN(); }
        phase_attn(P, l, c, 16);
#if REP_P3 > 1
        __syncthreads(); PHASE_BEGIN();
        if (c.bid < 16) scan_chunked(P, c, c.bid); else phase_attn(P, l, c, 16);
#endif
        SEAM();
        PHASE_BEGIN();
        phase_gn(P, l, c);
        for (int rep_ = 0; rep_ < REP_SYNC; ++rep_) SEAM();
        SEAM();
        PHASE_BEGIN();
#pragma unroll 1
        for (int pass = 0; pass < 3; ++pass) {
            if (pass) { __syncthreads(); PHASE_BEGIN(); }
            const int rw_side = pass == 2 ? ((c.bid >> 2) & 1) : pass;
            const pg8::bf16_t* A = rw_side ? (const pg8::bf16_t*)(ws + OFF_RW + (size_t)M * 512 * 4) : (const pg8::bf16_t*)(ws + OFF_OF);
            pg8::Gemm g{A, WT + (rw_side ? WT_BR : WT_BF), M, 1024, 512, 512};
            pg8::OneUnit S; S.so.init(MMAIN, 1024, c.G, c.bid); S.mode = pass == 2; S.pm = MMAIN / 256; S.pn = c.bid & 3; S.active = c.bid < 8;
            pg8::bf16_t* O = (pass == 2 && rw_side) ? (pg8::bf16_t*)(ws + OFF_TAIL) - (size_t)MMAIN * 1024 : (pg8::bf16_t*)(ws + OFF_K);
            pg8::EpiGateR E{O, (const pg8::bf16_t*)(ws + OFF_GT), P.in[21] + l * NGT, rw_side * 1024, pass == 1};
            pg8::gemm_phase<pg8::EpiGateR, pg8::OneUnit, true, true>(ldsl, g, S, E);
        }
        SEAM();
        PHASE_BEGIN();
#pragma unroll 1
        for (int pass = 0; pass < 2; ++pass) {
            if (pass) { __syncthreads(); PHASE_BEGIN(); }
            const int sl = pass ? (c.bid >> 2) : 0, ks = sl & 3;
            const pg8::bf16_t* A = (pass && sl >= 4) ? (const pg8::bf16_t*)(ws + OFF_TAIL) - (size_t)MMAIN * 1024 : (const pg8::bf16_t*)(ws + OFF_K);
            pg8::Gemm g{A + ks * 256, WT + WT_O + ks * 256, M, 1024, pass ? 256 : 1024, 1024};
            pg8::OneUnit S; S.so.init(MMAIN, 1024, c.G, c.bid); S.mode = pass; S.pm = MMAIN / 256; S.pn = c.bid & 3; S.active = sl < 8;
            pg8::EpiResid E{(float*)(ws + OFF_H), nullptr, pass};
            pg8::gemm_phase<pg8::EpiResid, pg8::OneUnit, true, true>(ldsl, g, S, E);
        }
        SEAM();
        PHASE_BEGIN();
        phase_norm<false>(P, l, c);
        SEAM();
        PHASE_BEGIN();
        { pg8::Gemm g{HN, WT + WT_UP, M, NUP, 1024, 1024}; pg8::StaticOrder S; S.init(M, NUP, c.G, c.bid);
          pg8::EpiUp E{(pg8::bf16_t*)(ws + OFF_RW), (pg8::bf16_t*)(ws + OFF_Q), P.in[24] + (size_t)l * 3 * NUP};
          pg8::gemm_phase<pg8::EpiUp, pg8::StaticOrder, true, true>(ldsl, g, S, E); }
        SEAM();
        PHASE_BEGIN();
        phase_fixup(P, l, c);
        SEAM();
        PHASE_BEGIN();
#pragma unroll 1
        for (int pass = 0; pass < 2; ++pass) {
            if (pass) { __syncthreads(); PHASE_BEGIN(); }
            const int sl = pass ? (c.bid >> 2) : 0;
            const int ko = (sl < 6) ? sl * 384 : 2304 + (sl - 6) * 256, kl = (sl < 6) ? 384 : 256;
            pg8::Gemm g{(const pg8::bf16_t*)(ws + OFF_RW) + (pass ? ko : 0), WT + WT_DN + (pass ? ko : 0), M, 1024, pass ? kl : DFF, DFF};
            pg8::OneUnit S; S.so.init(MMAIN, 1024, c.G, c.bid); S.mode = pass; S.pm = MMAIN / 256; S.pn = c.bid & 3; S.active = sl < 8;
            pg8::EpiResid E{(float*)(ws + OFF_H), (l == DEPTH - 1 && !pass) ? P.out : nullptr, pass};
            pg8::gemm_phase<pg8::EpiResid, pg8::OneUnit, true, true>(ldsl, g, S, E);
        }
        SEAM();
        if (l == DEPTH - 1) {
            PHASE_BEGIN();
            const float* H = (const float*)(ws + OFF_H);
            for (int idx = c.bid * NTHR + c.tid; idx < (NMETA + SEQ - (MMAIN - LP)) * (DM / 4); idx += c.G * NTHR) {
                const int r = idx / (DM / 4), q4 = idx - r * (DM / 4), t = (MMAIN - LP) + r;
                *(f32x4*)(P.out + ((size_t)SEQ + (t - NMETA)) * DM + 4 * q4) = *(const f32x4*)(H + (size_t)(LP + t) * DM + 4 * q4);
            }
        }
    }
}

extern "C" void kernel_launch(void* const* d_in, const int* in_sizes, int n_in, void* d_out, int out_size, void* d_ws, size_t ws_size, hipStream_t stream) {
    static int grid = 0;
    if (grid == 0) {
        if (n_in != 26 || out_size != NB * SEQ * DM || ws_size < WS_NEED) { fprintf(stderr, "kernel_launch: unexpected shapes (n_in %d out %d ws %zu need %zu)\n", n_in, out_size, ws_size, (size_t)WS_NEED); grid = -1; return; }
        int dev = 0, cus = 0, per_cu = 0;
        if (hipGetDevice(&dev) != hipSuccess || hipDeviceGetAttribute(&cus, hipDeviceAttributeMultiprocessorCount, dev) != hipSuccess) { grid = -1; return; }
        if (hipFuncSetAttribute((const void*)mega, hipFuncAttributeMaxDynamicSharedMemorySize, LDS_BYTES) != hipSuccess) { fprintf(stderr, "kernel_launch: hipFuncSetAttribute failed\n"); grid = -1; return; }
        if (hipOccupancyMaxActiveBlocksPerMultiprocessor(&per_cu, (const void*)mega, NTHR, LDS_BYTES) != hipSuccess || per_cu < 1) { fprintf(stderr, "kernel_launch: occupancy query says %d\n", per_cu); per_cu = 1; }
        (void)hipGetLastError();
        grid = cus;
    }
    if (grid < 0) return;
    if (hipMemsetAsync((char*)d_ws + OFF_CTL, 0, 65536, stream) != hipSuccess) { fprintf(stderr, "kernel_launch: memset failed\n"); return; }
    Params p{};
    for (int i = 0; i < 26; ++i) p.in[i] = (const float*)d_in[i];
    p.out = (float*)d_out; p.ws = (unsigned char*)d_ws;
    void* args[] = {&p};
    hipError_t e = hipLaunchCooperativeKernel((const void*)mega, dim3(grid), dim3(NTHR), args, LDS_BYTES, stream);
    if (e != hipSuccess) fprintf(stderr, "kernel_launch: cooperative launch failed: %s (grid %d)\n", hipGetErrorString(e), grid);
}
```

```cpp
#include <hip/hip_runtime.h>
#include <hip/hip_cooperative_groups.h>
#include <cstdio>
#include <cstdint>
#include <cmath>
namespace cg = cooperative_groups;
namespace pg8 {
#define PG8_LAS __attribute__((address_space(3)))
typedef unsigned short bf16_t;
typedef short bf16x8 __attribute__((ext_vector_type(8)));
typedef float f32x4 __attribute__((ext_vector_type(4)));
typedef unsigned u32x4 __attribute__((ext_vector_type(4)));
constexpr int BM = 256, BK = 64, HALF = 128, HTB = HALF * BK * 2  , STAGE_BYTES = 8 * HTB, NXCD = 8, WGM = 8;

__host__ __device__ __forceinline__ int lds_byte(int r, int c) { const int st = (r >> 4) * 2 + (c >> 5), rr = r & 15, cc = c & 31, ob = rr * 64 + cc * 2; return st * 1024 + (ob ^ (((ob >> 9) & 1) << 5)); }
__host__ __device__ __forceinline__ void stage_rc(int b, int& R, int& C) { const int st = b / 1024, sb = b % 1024, swz = sb ^ (((sb >> 9) & 1) << 5); R = (st >> 1) * 16 + swz / 64; C = (st & 1) * 32 + (swz % 64) / 2; }
__host__ __device__ __forceinline__ int perm32(int rho) { const int n = rho >> 4, i = rho & 15; return 8 * (i >> 2) + 4 * n + (i & 3); }

struct Unit { int pm, pn; };
struct Gemm { const bf16_t* A; const bf16_t* Bt; int M, N, K, ld; };

struct StaticOrder {
    int nM, nN, nwg, G, c;
    __host__ __device__ void init(int M, int N, int G_, int c_) { nM = M / BM; nN = N / BM; nwg = nM * nN; G = G_; c = c_; }
    __host__ __device__ bool next(int i, Unit& u) const {
        const long L = (long)i * G + c; if (L >= nwg) return false;
        int wgid = (int)L; { const int q = nwg / NXCD, r = nwg % NXCD, xcd = wgid % NXCD, off = wgid / NXCD; wgid = (xcd < r ? xcd * (q + 1) : r * (q + 1) + (xcd - r) * q) + off; }
        const int nig = WGM * nN, gid = wgid / nig, fm = gid * WGM, gsz = (nM - fm) < WGM ? (nM - fm) : WGM;
        u.pm = fm + ((wgid % nig) % gsz); u.pn = (wgid % nig) / gsz; return true;
    }
    __device__ __forceinline__ void a_ready(const Unit&) const {}
    __device__ __forceinline__ void done(const Unit&) const {}
};

__device__ __forceinline__ unsigned cvt_pk_bf16(float lo, float hi) { unsigned r; asm volatile("v_cvt_pk_bf16_f32 %0, %1, %2" : "=v"(r) : "v"(lo), "v"(hi)); return r; }
typedef float f32x2 __attribute__((ext_vector_type(2)));
template <class Epi, class Sched, bool ALIGN_EPI = false, bool SP2 = false>
__device__ __forceinline__ void gemm_phase(PG8_LAS unsigned char* lds, const Gemm g, const Sched& S, const Epi& E) {
    int tid_ = threadIdx.x; asm volatile("" : "+v"(tid_)); const int tid = tid_, wid = __builtin_amdgcn_readfirstlane(tid >> 6), lane = tid & 63, wr = wid >> 2, wc = wid & 3, fr = lane & 15, fq = lane >> 4;
    const int K = g.K, nt = K / BK, LD = g.ld;
    unsigned voffA[2], voffB[2];
#pragma unroll
    for (int i = 0; i < 2; ++i) { int R, C; stage_rc(tid * 16 + i * 8192, R, C); const int Rb = Epi::PERM ? ((R & ~31) + perm32(R & 31)) : R;
        voffA[i] = (unsigned)(R * LD + C) * 2u; voffB[i] = (unsigned)(Rb * LD + C) * 2u; }
    const size_t kstep = (size_t)(BK * 2);
    const size_t hstep = (size_t)HALF * LD * 2;
    const size_t tstep = 2 * hstep;
    const unsigned ldsw = (unsigned)wid * 1024u;
    const int aoff = lds_byte(wr * 64 + fr, fq * 8), boff = lds_byte(wc * 32 + fr, fq * 8);
#define PG8_SA(b, h) (((b) * 2 + (h)) * HTB)
#define PG8_SB(b, h) ((4 + (b) * 2 + (h)) * HTB)
#define PG8_STAGE(bufoff, gbase, voff) do { _Pragma("unroll") for (int _i = 0; _i < 2; ++_i) \
        __builtin_amdgcn_global_load_lds((const unsigned*)((const char*)(gbase) + (voff)[_i]), (PG8_LAS unsigned*)(lds + (bufoff) + ldsw + _i * 8192), 16, 0, 0); } while (0)
#define PG8_LDA(dst, b, h) do { _Pragma("unroll") for (int m = 0; m < 4; ++m) _Pragma("unroll") for (int k = 0; k < 2; ++k) dst[m][k] = *(const PG8_LAS bf16x8*)(lds + PG8_SA(b, h) + aoff + m * 2048 + k * 1024); } while (0)
#define PG8_LDB(dst, b, h) do { _Pragma("unroll") for (int n = 0; n < 2; ++n) _Pragma("unroll") for (int k = 0; k < 2; ++k) dst[n][k] = *(const PG8_LAS bf16x8*)(lds + PG8_SB(b, h) + boff + n * 2048 + k * 1024); } while (0)
#define PG8_MMA(ai, bj, At, Bt) do { __builtin_amdgcn_s_setprio(1); _Pragma("unroll") for (int m = 0; m < 4; ++m) _Pragma("unroll") for (int n = 0; n < 2; ++n) _Pragma("unroll") for (int k = 0; k < 2; ++k) \
        acc[ai][bj][m][n] = __builtin_amdgcn_mfma_f32_16x16x32_bf16(Bt[n][k], At[m][k], acc[ai][bj][m][n], 0, 0, 0); __builtin_amdgcn_s_setprio(0); } while (0)
#define PG8_WAIT_V(n) asm volatile("s_waitcnt vmcnt(" #n ")" ::: "memory")
#define PG8_WAIT_L(n) asm volatile("s_waitcnt lgkmcnt(" #n ")" ::: "memory")
#define PG8_BAR __builtin_amdgcn_s_barrier()
#define PG8_SCHED __builtin_amdgcn_sched_barrier(0)
    Unit cur, nxt; int ui = 0;
    if (!S.next(0, cur)) return;
    f32x4 acc[2][2][4][2];
#pragma unroll
    for (int a = 0; a < 2; ++a)
#pragma unroll
        for (int b = 0; b < 2; ++b)
#pragma unroll
            for (int m = 0; m < 4; ++m)
#pragma unroll
                for (int n = 0; n < 2; ++n) acc[a][b][m][n] = (f32x4){0.f, 0.f, 0.f, 0.f};
    bf16x8 At[4][2], B0[2][2], B1[2][2];
    const char* cA = (const char*)g.A + (size_t)cur.pm * tstep; const char* cB = (const char*)g.Bt + (size_t)cur.pn * tstep;
    S.a_ready(cur);
    if constexpr (SP2) {
        PG8_STAGE(PG8_SB(0, 0), cB, voffB); PG8_STAGE(PG8_SB(0, 1), cB + hstep, voffB); PG8_STAGE(PG8_SA(0, 0), cA, voffA); PG8_STAGE(PG8_SA(0, 1), cA + hstep, voffA);
        if (wr == 1) PG8_BAR;
        PG8_WAIT_V(2); PG8_BAR;
        PG8_STAGE(PG8_SB(1, 0), cB + kstep, voffB); PG8_STAGE(PG8_SA(1, 0), cA + kstep, voffA); PG8_STAGE(PG8_SB(1, 1), cB + hstep + kstep, voffB);
        PG8_WAIT_V(6); PG8_BAR;
    } else {
        PG8_STAGE(PG8_SB(0, 0), cB, voffB); PG8_STAGE(PG8_SA(0, 0), cA, voffA); PG8_STAGE(PG8_SB(0, 1), cB + hstep, voffB); PG8_STAGE(PG8_SA(0, 1), cA + hstep, voffA);
        if (wr == 1) PG8_BAR;
        PG8_WAIT_V(4); PG8_BAR;
        PG8_STAGE(PG8_SB(1, 0), cB + kstep, voffB); PG8_STAGE(PG8_SA(1, 0), cA + kstep, voffA); PG8_STAGE(PG8_SB(1, 1), cB + hstep + kstep, voffB);
        PG8_WAIT_V(6); PG8_BAR;
    }
    for (;;) {
        const bool has_next = S.next(ui + 1, nxt);
        const char* nA = has_next ? (const char*)g.A + (size_t)nxt.pm * tstep : cA; const char* nB = has_next ? (const char*)g.Bt + (size_t)nxt.pn * tstep : cB;
        for (int t = 0; t < nt; t += 2) {
            const bool last = (t == nt - 2);
            const char* a1 = cA + (size_t)(t + 1) * kstep;
            const char* a2 = last ? nA : cA + (size_t)(t + 2) * kstep; const char* b2 = last ? nB : cB + (size_t)(t + 2) * kstep;
            const char* a3 = a2 + kstep; const char* b3 = b2 + kstep;
            if (last && has_next) S.a_ready(nxt);
            if constexpr (SP2) {
            PG8_LDB(B0, 0, 0); PG8_LDB(B1, 0, 1); PG8_SCHED; PG8_LDA(At, 0, 0); PG8_STAGE(PG8_SA(1, 1), a1 + hstep, voffA);
            PG8_WAIT_V(8); PG8_WAIT_L(0); PG8_BAR; PG8_MMA(0, 0, At, B0); PG8_MMA(0, 1, At, B1); PG8_BAR; PG8_SCHED;
            PG8_LDA(At, 0, 1); PG8_STAGE(PG8_SB(0, 0), b2, voffB); PG8_STAGE(PG8_SB(0, 1), b2 + hstep, voffB); PG8_STAGE(PG8_SA(0, 0), a2, voffA);
            PG8_WAIT_V(8); PG8_WAIT_L(0); PG8_BAR; PG8_MMA(1, 0, At, B0); PG8_MMA(1, 1, At, B1); PG8_BAR; PG8_SCHED;
            PG8_LDB(B0, 1, 0); PG8_LDB(B1, 1, 1); PG8_SCHED; PG8_LDA(At, 1, 0); PG8_STAGE(PG8_SA(0, 1), a2 + hstep, voffA);
            PG8_WAIT_V(8); PG8_WAIT_L(0); PG8_BAR; PG8_MMA(0, 0, At, B0); PG8_MMA(0, 1, At, B1); PG8_BAR; PG8_SCHED;
            PG8_LDA(At, 1, 1); PG8_STAGE(PG8_SB(1, 0), b3, voffB); PG8_STAGE(PG8_SB(1, 1), b3 + hstep, voffB); PG8_STAGE(PG8_SA(1, 0), a3, voffA);
            PG8_WAIT_V(8); PG8_WAIT_L(0); PG8_BAR; PG8_MMA(1, 0, At, B0); PG8_MMA(1, 1, At, B1); PG8_BAR; PG8_SCHED;
            } else {
            PG8_LDB(B0, 0, 0); PG8_SCHED; PG8_LDA(At, 0, 0); PG8_STAGE(PG8_SA(1, 1), a1 + hstep, voffA);
            PG8_WAIT_L(8); PG8_BAR; PG8_WAIT_L(0); PG8_MMA(0, 0, At, B0); PG8_BAR; PG8_SCHED;
            PG8_LDB(B1, 0, 1); PG8_STAGE(PG8_SB(0, 0), b2, voffB);
            PG8_BAR; PG8_WAIT_L(0); PG8_MMA(0, 1, At, B1); PG8_BAR;
            PG8_LDA(At, 0, 1); PG8_STAGE(PG8_SA(0, 0), a2, voffA);
            PG8_BAR; PG8_WAIT_L(0); PG8_MMA(1, 0, At, B0); PG8_BAR; PG8_SCHED;
            PG8_STAGE(PG8_SB(0, 1), b2 + hstep, voffB);
            PG8_WAIT_V(6); PG8_BAR; PG8_MMA(1, 1, At, B1); PG8_BAR;
            PG8_LDB(B0, 1, 0); PG8_SCHED; PG8_LDA(At, 1, 0); PG8_STAGE(PG8_SA(0, 1), a2 + hstep, voffA);
            PG8_WAIT_L(8); PG8_BAR; PG8_WAIT_L(0); PG8_MMA(0, 0, At, B0); PG8_BAR; PG8_SCHED;
            PG8_LDB(B1, 1, 1); PG8_STAGE(PG8_SB(1, 0), b3, voffB);
            PG8_BAR; PG8_WAIT_L(0); PG8_MMA(0, 1, At, B1); PG8_BAR;
            PG8_LDA(At, 1, 1); PG8_STAGE(PG8_SA(1, 0), a3, voffA);
            PG8_BAR; PG8_WAIT_L(0); PG8_MMA(1, 0, At, B0); PG8_BAR; PG8_SCHED;
            PG8_STAGE(PG8_SB(1, 1), b3 + hstep, voffB);
            PG8_WAIT_V(6); PG8_BAR; PG8_MMA(1, 1, At, B1); PG8_BAR;
            }
        }
        if constexpr (ALIGN_EPI) { if (wr == 0) PG8_BAR; }
        if constexpr (!Epi::AFTER_DRAIN) { E(acc, cur, wr, wc, fr, fq); S.done(cur); }
        if (!has_next) break;
#pragma unroll
        for (int a = 0; a < 2; ++a)
#pragma unroll
            for (int b = 0; b < 2; ++b)
#pragma unroll
                for (int m = 0; m < 4; ++m)
#pragma unroll
                    for (int n = 0; n < 2; ++n) acc[a][b][m][n] = (f32x4){0.f, 0.f, 0.f, 0.f};
        cur = nxt; cA = nA; cB = nB; ++ui;
        if constexpr (ALIGN_EPI) { if (wr == 1) PG8_BAR; }
    }
    PG8_WAIT_V(0);
    if constexpr (!ALIGN_EPI) { if (wr == 0) PG8_BAR; }
    PG8_BAR;
    if constexpr (Epi::AFTER_DRAIN) { E.fused(acc, cur, wr, wc, fr, fq, lds, wid, lane); S.done(cur); }
#undef PG8_SA
#undef PG8_SB
#undef PG8_STAGE
#undef PG8_LDA
#undef PG8_LDB
#undef PG8_MMA
#undef PG8_WAIT_V
#undef PG8_WAIT_L
#undef PG8_BAR
#undef PG8_SCHED
}
}
#define GAS __attribute__((address_space(1)))
#define LAS __attribute__((address_space(3)))
typedef GAS unsigned gu32;
typedef GAS unsigned long long gu64;
#define RLX_AGENT __ATOMIC_RELAXED, __HIP_MEMORY_SCOPE_AGENT
#define LDS_WAIT() asm volatile("s_waitcnt lgkmcnt(0)" ::: "memory")
#define VM_WAIT() asm volatile("s_waitcnt vmcnt(0)" ::: "memory")
__device__ __forceinline__ unsigned long long rt() { return __builtin_amdgcn_s_memrealtime(); }
#define XB_TMO      128
#define XB_XCNT(j)  (256  + 64 * (j))
#define XB_XSUB(j)  (1280 + 64 * (j))
#define XB_XGEN(j)  (2304 + 64 * (j))
#define XB_TOP      3328
#define XB_TOPGEN   3392
#define XCD_BAR_WORDS 3456
#define XB_SPIN_CAP (1u << 18)

__device__ __forceinline__ unsigned xb_ld(unsigned* p)              { return __hip_atomic_load(p, __ATOMIC_RELAXED, __HIP_MEMORY_SCOPE_AGENT); }
__device__ __forceinline__ unsigned xb_add(unsigned* p, unsigned v) { return __hip_atomic_fetch_add(p, v, __ATOMIC_RELAXED, __HIP_MEMORY_SCOPE_AGENT); }
__device__ __forceinline__ unsigned xb_xcc_id() { return (unsigned)__builtin_amdgcn_s_getreg((3 << 11) | 20) & 0xFu; }
#define XB_SPIN(cond, bar) do { unsigned _sp = 0; while (cond) { __builtin_amdgcn_s_sleep(1); \
    if ((++_sp & 255u) == 0u) { if (xb_ld(&(bar)[XB_TMO])) break; if (_sp > XB_SPIN_CAP) { atomicAdd(&(bar)[XB_TMO], 1u); break; } } } } while (0)

struct XcdBarrier {
    unsigned* bar; unsigned x;
    volatile LAS unsigned* st;
};

__device__ __forceinline__ XcdBarrier xcd_barrier_post(unsigned* bar, volatile LAS unsigned* st) {
    XcdBarrier b; b.bar = bar; b.x = xb_xcc_id(); b.st = st;
    if (threadIdx.x == 0) (void)xb_add(&bar[XB_XCNT(b.x)], 1u);
    return b;
}
__device__ __forceinline__ void xcd_barrier_complete(unsigned* bar, unsigned x, unsigned& nloc, unsigned& nx) {
    const unsigned G = gridDim.x * gridDim.y * gridDim.z;
    unsigned sum, cnt, mine, sp = 0u;
    for (;;) {
        sum = 0u; cnt = 0u; mine = 0u;
#pragma unroll
        for (unsigned j = 0; j < 16; ++j) { const unsigned c = xb_ld(&bar[XB_XCNT(j)]); sum += c; cnt += (c > 0u) ? 1u : 0u; mine = (j == x) ? c : mine; }
        if (sum == G) break;
        __builtin_amdgcn_s_sleep(1);
        if ((++sp & 255u) == 0u) { if (xb_ld(&bar[XB_TMO])) break; if (sp > XB_SPIN_CAP) { atomicAdd(&bar[XB_TMO], 1u); break; } }
    }
    nloc = mine > 0u ? mine : 1u; nx = cnt > 0u ? cnt : 1u;
}

__device__ __forceinline__ void xcd_barrier(const XcdBarrier& b) {
    asm volatile("s_waitcnt vmcnt(0)" ::: "memory");
    __syncthreads();
    if (threadIdx.x == 0) {
        unsigned* bar = b.bar;
        __builtin_amdgcn_s_waitcnt(0);
        unsigned nloc = b.st[0], nx = b.st[1];
        if (nloc == 0u) { xcd_barrier_complete(bar, b.x, nloc, nx); b.st[0] = nloc; b.st[1] = nx; }
        const unsigned old = xb_add(&bar[XB_XSUB(b.x)], 1u);
        const unsigned gen = old / nloc;
        if (old + 1u == (gen + 1u) * nloc) {
            __builtin_amdgcn_fence(__ATOMIC_RELEASE, "agent");
            asm volatile("s_waitcnt vmcnt(0)" ::: "memory");
            const unsigned og = xb_add(&bar[XB_TOP], 1u);
            const unsigned tg = og / nx;
            if (og + 1u == (tg + 1u) * nx) xb_add(&bar[XB_TOPGEN], 1u);
            else XB_SPIN(xb_ld(&bar[XB_TOPGEN]) == tg, bar);
            __builtin_amdgcn_fence(__ATOMIC_ACQUIRE, "agent");
            xb_add(&bar[XB_XGEN(b.x)], 1u);
            asm volatile("s_waitcnt vmcnt(0)" ::: "memory");
        } else {
            XB_SPIN(xb_ld(&bar[XB_XGEN(b.x)]) == gen, bar);
            __builtin_amdgcn_fence(__ATOMIC_ACQUIRE, "agent");
            asm volatile("s_waitcnt vmcnt(0)" ::: "memory");
        }
    }
    __syncthreads();
}


constexpr int NB = 2, SEQ = 8192, DM = 1024, DEPTH = 4, NMETA = 16, LP = 8320, M = NB * LP;
constexpr int N_IN = 5384, N1 = 5376, NRW = 1792, NGT = 2048, DFF = 2816, NUP = 5632;
constexpr float LOG2E = 1.4426950408889634f;
constexpr float QSCALE = 0.125f * LOG2E;
constexpr float THR2 = 24.0f * LOG2E;
constexpr int NWAVES = 8, NTHR = 512, MMAIN = 16384;
constexpr int LDS_BYTES = 147456, MISC_OFF = 147456 - 128;

typedef unsigned short bf16;
typedef float f32x4 __attribute__((ext_vector_type(4)));
typedef unsigned u32x4 __attribute__((ext_vector_type(4)));
typedef unsigned u32x2 __attribute__((ext_vector_type(2)));
typedef short bf16x8 __attribute__((ext_vector_type(8)));

constexpr size_t SZ_H = (size_t)M * DM * 4, SZ_X512 = (size_t)M * 512 * 2;
constexpr size_t OFF_CTL = 0, OFF_H = 1u << 20, OFF_WT = OFF_H + SZ_H;
constexpr size_t WT_IN = 0, WT_BF = WT_IN + (size_t)N1 * 1024, WT_BR = WT_BF + 1024 * 512, WT_O = WT_BR + 1024 * 512,
                 WT_UP = WT_O + 1024 * 1024, WT_DN = WT_UP + (size_t)NUP * 1024, WT_LW = WT_DN + (size_t)1024 * DFF, WT_LA = WT_LW + 512 * 64, WT_LG = WT_LA + 512 * 64, WT_END = WT_LG + 512 * 128;
constexpr size_t OFF_HN = OFF_WT + WT_END * 2;
constexpr size_t OFF_Q = OFF_HN + 2 * SZ_X512, OFF_K = OFF_Q + SZ_X512, OFF_V = OFF_K + SZ_X512;
constexpr size_t OFF_RW = OFF_V + SZ_X512, OFF_GT = OFF_RW + (size_t)M * NRW * 2, OFF_MISC = OFF_GT + (size_t)M * NGT * 2;
constexpr size_t OFF_T0 = OFF_MISC + 2 * 16 * LP * 4, OFF_OF = OFF_T0 + 2 * SZ_X512, OFF_TAIL = OFF_OF + SZ_X512, WS_NEED = OFF_TAIL + 256 * 1024 * 2;
static_assert(OFF_HN % 256 == 0 && OFF_RW % 256 == 0 && OFF_T0 % 256 == 0, "alignment");

struct Params { const float* in[26]; float* out; unsigned char* ws; };
struct Ctx { int tid, lane, wave, bid, G; unsigned char* lds; unsigned char* ws; };

__device__ __forceinline__ float bf2f(unsigned b) { return __uint_as_float(b << 16); }
__device__ __forceinline__ float bflo(unsigned w) { return __uint_as_float(w << 16); }
__device__ __forceinline__ float bfhi(unsigned w) { return __uint_as_float(w & 0xffff0000u); }
typedef float f32x2_t_ __attribute__((ext_vector_type(2))); typedef __bf16 bf16x2_t_ __attribute__((ext_vector_type(2)));
__device__ __forceinline__ unsigned pk2(float lo, float hi) { const f32x2_t_ v = {lo, hi}; const bf16x2_t_ r = __builtin_convertvector(v, bf16x2_t_); return __builtin_bit_cast(unsigned, r); }
__device__ __forceinline__ unsigned f2bf(float f) { return pk2(f, 0.f) & 0xffffu; }
__device__ __forceinline__ float wave_sum(float v) {
#pragma unroll
    for (int o = 1; o < 64; o <<= 1) v += __shfl_xor(v, o);
    return v;
}
__device__ __forceinline__ float sigmoidf_(float x) { return __builtin_amdgcn_rcpf(1.f + __expf(-x)); }
template <int CTRL> __device__ __forceinline__ float dppf(float old, float x) {
    return __int_as_float(__builtin_amdgcn_update_dpp(__float_as_int(old), __float_as_int(x), CTRL, 0xf, 0xf, false));
}
__device__ __forceinline__ float allreduce16(float x) {
    x += dppf<0x121>(0.f, x); x += dppf<0x122>(0.f, x); x += dppf<0x124>(0.f, x); x += dppf<0x128>(0.f, x); return x;
}

namespace pg8 {
struct EpiRoute {
    static constexpr bool PERM = true, AFTER_DRAIN = false;
    unsigned char* ws;
    __device__ __forceinline__ void operator()(const f32x4 (&acc)[2][2][4][2], const Unit& u, int wr, int wc, int fr, int fq) const {
        const int pn = u.pn; size_t off; int ldc, colt;
        if (pn < 6) { off = OFF_Q + (size_t)(pn >> 1) * SZ_X512; ldc = 512; colt = (pn & 1) * 256; }
        else if (pn < 13) { off = OFF_RW; ldc = NRW; colt = (pn - 6) * 256; }
        else { off = OFF_GT; ldc = NGT; colt = (pn - 13) * 256; }
        bf16_t* base = (bf16_t*)(ws + off);
        const int row0 = u.pm * BM + wr * 64 + fr, col0 = colt + wc * 32 + 8 * fq;
#pragma unroll
        for (int ai = 0; ai < 2; ++ai)
#pragma unroll
            for (int m = 0; m < 4; ++m) { bf16_t* rowp = base + (size_t)(row0 + ai * HALF + m * 16) * ldc + col0;
#pragma unroll
                for (int bj = 0; bj < 2; ++bj) { const f32x4 v0 = acc[ai][bj][m][0], v1 = acc[ai][bj][m][1];
                    u32x4 w; w.x = cvt_pk_bf16(v0[0], v0[1]); w.y = cvt_pk_bf16(v0[2], v0[3]); w.z = cvt_pk_bf16(v1[0], v1[1]); w.w = cvt_pk_bf16(v1[2], v1[3]);
                    *(u32x4*)(rowp + bj * HALF) = w; } }
    }
};
struct EpiGateR {
    static constexpr bool PERM = true, AFTER_DRAIN = false;
    bf16_t* O; const bf16_t* GT; const float* gb; int goff, accum;
    __device__ __forceinline__ void operator()(const f32x4 (&acc)[2][2][4][2], const Unit& u, int wr, int wc, int fr, int fq) const {
        const int row0 = u.pm * BM + wr * 64 + fr, col0 = u.pn * BM + wc * 32 + 8 * fq;
#pragma unroll
        for (int bj = 0; bj < 2; ++bj) {
            const int c = col0 + bj * HALF;
            const f32x4 b0 = *(const f32x4*)(gb + goff + c), b1 = *(const f32x4*)(gb + goff + c + 4);
#pragma unroll
            for (int ai = 0; ai < 2; ++ai)
#pragma unroll
                for (int m = 0; m < 4; ++m) {
                    const size_t row = (size_t)(row0 + ai * HALF + m * 16);
                    const u32x4 gw = *(const u32x4*)(GT + row * NGT + goff + c);
                    const f32x4 v0 = acc[ai][bj][m][0], v1 = acc[ai][bj][m][1];
                    float r[8];
                    r[0] = sigmoidf_(bflo(gw.x) + b0[0]) * v0[0]; r[1] = sigmoidf_(bfhi(gw.x) + b0[1]) * v0[1];
                    r[2] = sigmoidf_(bflo(gw.y) + b0[2]) * v0[2]; r[3] = sigmoidf_(bfhi(gw.y) + b0[3]) * v0[3];
                    r[4] = sigmoidf_(bflo(gw.z) + b1[0]) * v1[0]; r[5] = sigmoidf_(bfhi(gw.z) + b1[1]) * v1[1];
                    r[6] = sigmoidf_(bflo(gw.w) + b1[2]) * v1[2]; r[7] = sigmoidf_(bfhi(gw.w) + b1[3]) * v1[3];
                    bf16_t* op = O + row * 1024 + c;
                    if (accum) { const u32x4 ow = *(const u32x4*)op;
                        r[0] += bflo(ow.x); r[1] += bfhi(ow.x); r[2] += bflo(ow.y); r[3] += bfhi(ow.y); r[4] += bflo(ow.z); r[5] += bfhi(ow.z); r[6] += bflo(ow.w); r[7] += bfhi(ow.w); }
                    u32x4 w; w.x = cvt_pk_bf16(r[0], r[1]); w.y = cvt_pk_bf16(r[2], r[3]); w.z = cvt_pk_bf16(r[4], r[5]); w.w = cvt_pk_bf16(r[6], r[7]);
                    *(u32x4*)op = w;
                }
        }
    }
};
struct EpiResid {
    static constexpr bool PERM = false, AFTER_DRAIN = false;
    float* H; float* OUT; int atomic;
    __device__ __forceinline__ void operator()(const f32x4 (&acc)[2][2][4][2], const Unit& u, int wr, int wc, int fr, int fq) const {
        const int row0 = u.pm * BM + wr * 64 + fr, col0 = u.pn * BM + wc * 32 + 4 * fq;
#pragma unroll
        for (int ai = 0; ai < 2; ++ai)
#pragma unroll
            for (int m = 0; m < 4; ++m) {
                const int row = row0 + ai * HALF + m * 16;
                float* hp = H + (size_t)row * DM + col0;
                const int b = row >= LP ? 1 : 0, t = row - b * LP;
                float* op = (OUT && t >= NMETA && t < NMETA + SEQ) ? OUT + ((size_t)b * SEQ + (t - NMETA)) * DM + col0 : nullptr;
#pragma unroll
                for (int bj = 0; bj < 2; ++bj)
#pragma unroll
                    for (int n = 0; n < 2; ++n) { const int co = bj * HALF + n * 16;
                        if (atomic) {
                            if (row < LP + NMETA + SEQ) {
#pragma unroll
                                for (int e = 0; e < 4; ++e) unsafeAtomicAdd(hp + co + e, acc[ai][bj][m][n][e]); }
                        } else {
                            const f32x4 v = *(const f32x4*)(hp + co) + acc[ai][bj][m][n];
                            if (OUT) { if (op) *(f32x4*)(op + co) = v; } else *(f32x4*)(hp + co) = v; } }
            }
    }
};
struct EpiResidAtomic {
    static constexpr bool PERM = false, AFTER_DRAIN = false;
    float* H;
    __device__ __forceinline__ void operator()(const f32x4 (&acc)[2][2][4][2], const Unit& u, int wr, int wc, int fr, int fq) const {
        const int row0 = u.pm * BM + wr * 64 + fr, col0 = u.pn * BM + wc * 32 + 4 * fq;
#pragma unroll
        for (int ai = 0; ai < 2; ++ai)
#pragma unroll
            for (int m = 0; m < 4; ++m) { float* hp = H + (size_t)(row0 + ai * HALF + m * 16) * DM + col0;
#pragma unroll
                for (int bj = 0; bj < 2; ++bj)
#pragma unroll
                    for (int n = 0; n < 2; ++n)
#pragma unroll
                        for (int e = 0; e < 4; ++e) unsafeAtomicAdd(hp + bj * HALF + n * 16 + e, acc[ai][bj][m][n][e]); }
    }
};
struct OneUnit {
    StaticOrder so; int mode, pm, pn; bool active;
    __device__ bool next(int i, Unit& u) const { if (mode == 0) return so.next(i, u); if (i != 0 || !active) return false; u.pm = pm; u.pn = pn; return true; }
    __device__ __forceinline__ void a_ready(const Unit&) const {}
    __device__ __forceinline__ void done(const Unit&) const {}
};
struct EpiUp {
    static constexpr bool PERM = true, AFTER_DRAIN = false;
    bf16_t* ACT; bf16_t* HALO; const float* cw;
    __device__ __forceinline__ void operator()(const f32x4 (&acc)[2][2][4][2], const Unit& u, int wr, int wc, int fr, int fq) const {
        const int chan0 = u.pn * 128 + wc * 32 + 8 * fq;
#pragma unroll
        for (int n = 0; n < 2; ++n) {
            const int ch = chan0 + 4 * n;
            f32x4 w[3][2];
#pragma unroll
            for (int j = 0; j < 3; ++j) { w[j][0] = *(const f32x4*)(cw + j * NUP + ch); w[j][1] = *(const f32x4*)(cw + j * NUP + DFF + ch); }
#pragma unroll
            for (int ai = 0; ai < 2; ++ai) {
                const int rowg = u.pm * BM + ai * HALF + wr * 64;
#pragma unroll
                for (int m = 0; m < 4; ++m) {
                    f32x4 uc[2];
#pragma unroll
                    for (int bj = 0; bj < 2; ++bj) {
                        const f32x4 cur = acc[ai][bj][m][n];
                        f32x4 prv; if (m > 0) prv = acc[ai][bj][m - 1][n]; else prv = (f32x4){0.f, 0.f, 0.f, 0.f};
                        f32x4 p1, p2;
#pragma unroll
                        for (int i = 0; i < 4; ++i) {
                            const float r1 = dppf<0x121>(0.f, prv[i]), r2 = dppf<0x122>(0.f, prv[i]);
                            p1[i] = dppf<0x111>(r1, cur[i]); p2[i] = dppf<0x112>(r2, cur[i]);
                        }
                        uc[bj] = w[0][bj] * p2 + w[1][bj] * p1 + w[2][bj] * cur;
                    }
                    float a[4];
#pragma unroll
                    for (int i = 0; i < 4; ++i) a[i] = uc[0][i] * sigmoidf_(uc[0][i]) * uc[1][i];
                    u32x2 o; o.x = cvt_pk_bf16(a[0], a[1]); o.y = cvt_pk_bf16(a[2], a[3]);
                    *(u32x2*)(ACT + (size_t)(rowg + m * 16 + fr) * DFF + ch) = o;
                    if ((m == 3 && fr >= 14) || (m == 0 && fr < 2)) {
                        const int slot = (rowg >> 6) * 4 + (m == 3 ? fr - 14 : 2 + fr);
#pragma unroll
                        for (int bj = 0; bj < 2; ++bj) { const f32x4 cur = acc[ai][bj][m][n]; u32x2 hw; hw.x = cvt_pk_bf16(cur[0], cur[1]); hw.y = cvt_pk_bf16(cur[2], cur[3]);
                            *(u32x2*)(HALO + (size_t)slot * NUP + bj * DFF + ch) = hw; }
                    }
                }
            }
        }
    }
};
}

#ifndef REP_PREP
#define REP_PREP 1
#endif
#ifndef REP_P3
#define REP_P3 1
#endif
#ifndef REP_SYNC
#define REP_SYNC 0
#endif
#define GLD(T, p) (*(const __attribute__((address_space(1))) T*)(p))
#define GST(T, p) (*(__attribute__((address_space(1))) T*)(p))
#define LDS_BARRIER() do { asm volatile("s_waitcnt lgkmcnt(0)" ::: "memory"); __builtin_amdgcn_s_barrier(); asm volatile("" ::: "memory"); } while (0)
__device__ __forceinline__ void transpose_item(const float* W, int Nsrc, int K, bf16* WT, int dst_row0, int src_col0, int k0, float* scr, int lane) {
#pragma unroll 8
    for (int i = 0; i < 32; ++i) { const int kk = 2 * i + (lane >> 5); scr[kk * 33 + (lane & 31)] = W[(size_t)(k0 + kk) * Nsrc + src_col0 + (lane & 31)]; }
    asm volatile("s_waitcnt lgkmcnt(0)" ::: "memory");
    const int c = lane & 7;
#pragma unroll
    for (int j = 0; j < 4; ++j) { const int n = (lane >> 3) + 8 * j; const float* s = scr + (8 * c) * 33 + n;
        u32x4 o; o.x = pk2(s[0 * 33], s[1 * 33]); o.y = pk2(s[2 * 33], s[3 * 33]); o.z = pk2(s[4 * 33], s[5 * 33]); o.w = pk2(s[6 * 33], s[7 * 33]);
        *(u32x4*)(WT + (size_t)(dst_row0 + n) * K + k0 + 8 * c) = o; }
    asm volatile("s_waitcnt lgkmcnt(0)" ::: "memory");
}
__device__ __forceinline__ void convert_weights(const Params& P, int l, const Ctx& c) {
    bf16* WT = (bf16*)(c.ws + OFF_WT);
    float* scr = (float*)(c.lds + c.wave * 16384);
    const int gw = c.bid * NWAVES + c.wave, NGW = c.G * NWAVES;
    constexpr int I_IN = 16 * 168, I_BF = 8 * 32, I_O = 16 * 32, I_UP = 16 * 176, I_DN = 44 * 32, I_LR = 16, I_LG = 32, I_ALL = I_IN + 2 * I_BF + I_O + I_UP + I_DN + 2 * I_LR + I_LG;
    for (int it = gw; it < I_ALL; it += NGW) {
        int r = it;
        if (r < I_IN) { const int kb = r / 168, n0 = 32 * (r % 168); transpose_item(P.in[4] + (size_t)l * 1024 * N_IN, N_IN, 1024, WT + WT_IN, n0, n0 + (n0 >= 1536 ? 8 : 0), 64 * kb, scr, c.lane); continue; } r -= I_IN;
        if (r < I_BF) { const int kb = r / 32, n0 = 32 * (r % 32); transpose_item(P.in[19] + (size_t)l * 512 * 1024, 1024, 512, WT + WT_BF, n0, n0, 64 * kb, scr, c.lane); continue; } r -= I_BF;
        if (r < I_BF) { const int kb = r / 32, n0 = 32 * (r % 32); transpose_item(P.in[20] + (size_t)l * 512 * 1024, 1024, 512, WT + WT_BR, n0, n0, 64 * kb, scr, c.lane); continue; } r -= I_BF;
        if (r < I_O) { const int kb = r / 32, n0 = 32 * (r % 32); transpose_item(P.in[22] + (size_t)l * 1024 * 1024, 1024, 1024, WT + WT_O, n0, n0, 64 * kb, scr, c.lane); continue; } r -= I_O;
        if (r < I_UP) { const int kb = r / 176, n0 = 32 * (r % 176); const int pn = n0 >> 8, bj = (n0 >> 7) & 1, x = n0 & 127;
            transpose_item(P.in[23] + (size_t)l * 1024 * NUP, NUP, 1024, WT + WT_UP, n0, bj * DFF + 128 * pn + x, 64 * kb, scr, c.lane); continue; } r -= I_UP;
        if (r < I_DN) { const int kb = r / 32, n0 = 32 * (r % 32); transpose_item(P.in[25] + (size_t)l * DFF * 1024, 1024, DFF, WT + WT_DN, n0, n0, 64 * kb, scr, c.lane); continue; } r -= I_DN;
        if (r < I_LR) { transpose_item(P.in[10] + (size_t)l * 64 * 512, 512, 64, WT + WT_LW, 32 * r, 32 * r, 0, scr, c.lane); continue; } r -= I_LR;
        if (r < I_LR) { transpose_item(P.in[12] + (size_t)l * 64 * 512, 512, 64, WT + WT_LA, 32 * r, 32 * r, 0, scr, c.lane); continue; } r -= I_LR;
        { const int kb = r / 16, n0 = 32 * (r % 16); transpose_item(P.in[13] + (size_t)l * 128 * 512, 512, 128, WT + WT_LG, n0, n0, 64 * kb, scr, c.lane); }
    }
}

template <bool FG> __device__ __forceinline__ void phase_norm(const Params& P, int l, const Ctx& c) {
    float* H = (float*)(c.ws + OFF_H); bf16* HN = (bf16*)(c.ws + OFF_HN);
    float* LOGF = (float*)(c.ws + OFF_MISC);
    const float* gain = (FG ? P.in[2] : P.in[3]) + l * DM;
    float* wfs = (float*)c.lds;
    if (FG) {
        __syncthreads();
        const float* win = P.in[4] + (size_t)l * 1024 * N_IN + 1536;
        for (int i = c.tid; i < 8192; i += NTHR) wfs[i] = win[(size_t)(i >> 3) * N_IN + (i & 7)];
        __syncthreads();
    }
    const int gw = c.bid * NWAVES + c.wave, NGW = c.G * NWAVES;
    for (int m = gw; m < M; m += NGW) {
        const int b = m >= LP ? 1 : 0, t = m - b * LP;
        f32x4 v[4];
        if (FG && l == 0) {
            const float* src = (t < NMETA) ? P.in[1] + (size_t)t * DM : P.in[0] + ((size_t)b * SEQ + (t - NMETA)) * DM;
            const bool real = t < NMETA + SEQ;
#pragma unroll
            for (int j = 0; j < 4; ++j) { v[j] = real ? *(const f32x4*)(src + 4 * c.lane + 256 * j) : (f32x4){0.f, 0.f, 0.f, 0.f}; *(f32x4*)(H + (size_t)m * DM + 4 * c.lane + 256 * j) = v[j]; }
        } else {
#pragma unroll
            for (int j = 0; j < 4; ++j) v[j] = *(const f32x4*)(H + (size_t)m * DM + 4 * c.lane + 256 * j);
        }
        float ss = 0.f;
#pragma unroll
        for (int j = 0; j < 4; ++j) ss += (v[j].x * v[j].x + v[j].y * v[j].y) + (v[j].z * v[j].z + v[j].w * v[j].w);
        const float rstd = 1.0f / sqrtf(wave_sum(ss) * (1.f / DM) + 1e-6f);
        float f[8];
#pragma unroll
        for (int q = 0; q < 8; ++q) f[q] = 0.f;
#pragma unroll
        for (int j = 0; j < 4; ++j) {
            const f32x4 g = *(const f32x4*)(gain + 4 * c.lane + 256 * j);
            v[j] = v[j] * rstd * g;
            u32x2 o; o.x = pk2(v[j].x, v[j].y); o.y = pk2(v[j].z, v[j].w);
            *(u32x2*)(HN + (size_t)m * DM + 4 * c.lane + 256 * j) = o;
            if (FG) {
#pragma unroll
                for (int e = 0; e < 4; ++e) { const int k = 4 * c.lane + 256 * j + e; const f32x4 w0 = *(const f32x4*)(wfs + k * 8), w1 = *(const f32x4*)(wfs + k * 8 + 4);
                    const float hv = v[j][e];
                    f[0] += hv * w0.x; f[1] += hv * w0.y; f[2] += hv * w0.z; f[3] += hv * w0.w; f[4] += hv * w1.x; f[5] += hv * w1.y; f[6] += hv * w1.z; f[7] += hv * w1.w; }
            }
        }
        if (FG) {
#pragma unroll
            for (int q = 0; q < 8; ++q) f[q] = wave_sum(f[q]);
            float fv = f[0];
#pragma unroll
            for (int q = 1; q < 8; ++q) fv = (c.lane == q) ? f[q] : fv;
            if (c.lane < 8) { const float x = fv + P.in[7][l * 8 + c.lane]; const float ls = fminf(x, 0.f) - __logf(1.f + __expf(-fabsf(x))); LOGF[(size_t)(b * 8 + c.lane) * LP + t] = ls; }
        }
    }
}

__device__ __forceinline__ void phase_fcum(const Params& P, const Ctx& c) {
    const int s = c.bid - (c.G - 16);
    if (s < 0) return;
    const float* LOGF = (const float*)(c.ws + OFF_MISC) + (size_t)s * LP; float* FC = (float*)(c.ws + OFF_MISC) + 16 * LP + (size_t)s * LP;
    float* wt = (float*)c.lds;
    const int base = c.tid * 17;
    float v[17]; float run = 0.f;
#pragma unroll
    for (int i = 0; i < 17; ++i) { const int idx = base + i; const float x = (idx < LP) ? LOGF[idx] : 0.f; run += x; v[i] = run; }
    float incl = run;
#pragma unroll
    for (int o = 1; o < 64; o <<= 1) { const float t = __shfl_up(incl, o); if (c.lane >= o) incl += t; }
    if (c.lane == 63) wt[c.wave] = incl;
    __syncthreads();
    float off = incl - run;
#pragma unroll
    for (int w2 = 0; w2 < 8; ++w2) off += (w2 < c.wave) ? wt[w2] : 0.f;
#pragma unroll
    for (int i = 0; i < 17; ++i) { const int idx = base + i; if (idx < LP) FC[idx] = (v[i] + off) * LOG2E; }
    __syncthreads();
}

__device__ __forceinline__ void phase_qknorm(const Params& P, int l, const Ctx& c) {
    bf16* Q = (bf16*)(c.ws + OFF_Q); bf16* K = (bf16*)(c.ws + OFF_K);
    const int gw = c.bid * NWAVES + c.wave, NGW = c.G * NWAVES;
    const int d0 = (c.lane & 7) * 8;
    float gq[8], gk[8];
#pragma unroll
    for (int i = 0; i < 8; ++i) { gq[i] = P.in[5][l * 64 + d0 + i] * QSCALE; gk[i] = P.in[6][l * 64 + d0 + i]; }
    for (int m = gw; m < M; m += NGW) {
#pragma unroll
        for (int which = 0; which < 2; ++which) {
            bf16* p = (which ? K : Q) + (size_t)m * 512 + 8 * c.lane;
            const u32x4 w = *(const u32x4*)p;
            float x[8] = {bflo(w.x), bfhi(w.x), bflo(w.y), bfhi(w.y), bflo(w.z), bfhi(w.z), bflo(w.w), bfhi(w.w)};
            float ss = 0.f;
#pragma unroll
            for (int i = 0; i < 8; ++i) ss += x[i] * x[i];
            ss += __shfl_xor(ss, 1); ss += __shfl_xor(ss, 2); ss += __shfl_xor(ss, 4);
            const float rs = 1.0f / sqrtf(ss * (1.f / 64.f) + 1e-6f);
#pragma unroll
            for (int i = 0; i < 8; ++i) x[i] = x[i] * rs * (which ? gk[i] : gq[i]);
            u32x4 o; o.x = pk2(x[0], x[1]); o.y = pk2(x[2], x[3]); o.z = pk2(x[4], x[5]); o.w = pk2(x[6], x[7]);
            *(u32x4*)p = o;
        }
    }
}

constexpr int NCHK = LP / 64;
constexpr int NUNIT = NB * NCHK * 8;
constexpr int UNIT_A = 16384, UNIT_B = 16640;
constexpr int ST = 72, STG = 136;
constexpr int L_F0 = 92160, L_F1 = 108544;
struct RwkvBufs { bf16 *BON, *G; unsigned char *UA, *UB; float* Y; bf16* ORW; };
__device__ __forceinline__ RwkvBufs rwkv_bufs(const Params& P, const Ctx& c) {
    RwkvBufs r; r.BON = (bf16*)(c.ws + OFF_HN); r.G = r.BON + (size_t)M * 512;
    r.UA = c.ws + OFF_T0; r.UB = (unsigned char*)P.out;
    r.Y = (float*)(c.ws + OFF_RW); r.ORW = (bf16*)(c.ws + OFF_RW + (size_t)M * 512 * 4);
    return r;
}
__device__ __forceinline__ void mm_tile(const bf16* A, int sa, const bf16* Bt, int sb, int nks, f32x4 (&acc)[2], int w, int lq, int g) {
    const int mt = w >> 1, nt0 = 2 * (w & 1);
    for (int ks = 0; ks < nks; ++ks) {
        const bf16x8 a = *(const bf16x8*)(A + (16 * mt + lq) * sa + 32 * ks + 8 * g);
#pragma unroll
        for (int q = 0; q < 2; ++q) { const bf16x8 b = *(const bf16x8*)(Bt + (16 * (nt0 + q) + lq) * sb + 32 * ks + 8 * g); acc[q] = __builtin_amdgcn_mfma_f32_16x16x32_bf16(a, b, acc[q], 0, 0, 0); }
    }
}
template <bool SA, bool SB> __device__ __forceinline__ void mm_tile2(const bf16* A, int sa, const bf16* Bt, int sb, int nks, f32x4 (&acc)[2], int w, int lq, int g) {
    const int mt = w >> 1, nt0 = 2 * (w & 1);
    const int ra = 16 * mt + lq, xa = SA ? 8 * ((ra >> 3) & 7) : 0;
    for (int ks = 0; ks < nks; ++ks) {
        const bf16x8 a = *(const bf16x8*)(A + ra * sa + ((32 * ks + 8 * g) ^ xa));
#pragma unroll
        for (int q = 0; q < 2; ++q) { const int rb = 16 * (nt0 + q) + lq, xb = SB ? 8 * ((rb >> 3) & 7) : 0;
            const bf16x8 bb = *(const bf16x8*)(Bt + rb * sb + ((32 * ks + 8 * g) ^ xb)); acc[q] = __builtin_amdgcn_mfma_f32_16x16x32_bf16(a, bb, acc[q], 0, 0, 0); }
    }
}
#define ZACC(a) do { a[0] = (f32x4){0.f, 0.f, 0.f, 0.f}; a[1] = (f32x4){0.f, 0.f, 0.f, 0.f}; } while (0)
__device__ __forceinline__ int permk(int k) { return 32 * (k >> 5) + 8 * ((k & 15) >> 2) + 4 * ((k >> 4) & 1) + (k & 3); }
__device__ __forceinline__ int swz(int row, int col) { return row * 128 + ((((col >> 3) ^ (row >> 1)) & 7) << 4) + (col & 7) * 2; }

__device__ __forceinline__ void rwkv_prep_unit(const Params& P, int l, const Ctx& c, int u, const RwkvBufs& B, const float (&pw0)[8], const float (&pa0)[8], const float (&pkk)[8], const float (&pka)[8], const float (&prk)[8]) {
    const int h = u & 7, bc = u >> 3, b = bc / NCHK, ch = bc - b * NCHK;
    const size_t m0 = (size_t)b * LP + ch * 64;
    int tid_ = c.tid; asm volatile("" : "+v"(tid_));
    const int tid = tid_, lane = tid & 63, w = c.wave, lq = lane & 15, g = lane >> 4;
    const int t = tid >> 3, cg = tid & 7, c0 = cg * 8, jb = h * 64 + c0;
    unsigned char* L = c.lds;
    bf16* A0 = (bf16*)L; bf16* A1 = A0 + 4608; bf16* A2 = A1 + 4608; bf16* A3 = A2 + 4608; bf16* A4 = A3 + 4608; bf16* A5 = A4 + 4608; bf16* A6 = A5 + 4608;
    bf16* A7 = A6 + 4608; bf16* A8 = A7 + 4608; bf16* A9 = A8 + 4608;
    float* F0 = (float*)(L + L_F0); float* F1 = (float*)(L + L_F1);
    const bf16* RW = (const bf16*)(c.ws + OFF_RW);
    const bf16* WT = (const bf16*)(c.ws + OFF_WT);
    const float* mu = P.in[8] + l * NRW;
    const bool first = (ch == 0 && t == 0);
    const bf16* cur = RW + (m0 + t) * NRW; const bf16* prv = cur - NRW;
    float zr[8], zk[8], zv[8];
#pragma unroll
    for (int s = 0; s < 3; ++s) {
        const u32x4 cw = *(const u32x4*)(cur + s * 512 + jb); u32x4 pw = (u32x4){0u, 0u, 0u, 0u}; if (!first) pw = *(const u32x4*)(prv + s * 512 + jb);
        const float cv[8] = {bflo(cw.x), bfhi(cw.x), bflo(cw.y), bfhi(cw.y), bflo(cw.z), bfhi(cw.z), bflo(cw.w), bfhi(cw.w)};
        const float pv[8] = {bflo(pw.x), bfhi(pw.x), bflo(pw.y), bfhi(pw.y), bflo(pw.z), bfhi(pw.z), bflo(pw.w), bfhi(pw.w)};
#pragma unroll
        for (int i = 0; i < 8; ++i) { const float z = cv[i] + mu[s * 512 + jb + i] * (pv[i] - cv[i]); if (s == 0) zr[i] = z; else if (s == 1) zk[i] = z; else zv[i] = z; }
    }
#pragma unroll
    for (int q4 = 0; q4 < 4; ++q4) {
        const int col = cg * 32 + q4 * 8;
        const u32x4 cw = *(const u32x4*)(cur + 1536 + col); u32x4 pw = (u32x4){0u, 0u, 0u, 0u}; if (!first) pw = *(const u32x4*)(prv + 1536 + col);
        const float cv[8] = {bflo(cw.x), bfhi(cw.x), bflo(cw.y), bfhi(cw.y), bflo(cw.z), bfhi(cw.z), bflo(cw.w), bfhi(cw.w)};
        const float pv[8] = {bflo(pw.x), bfhi(pw.x), bflo(pw.y), bfhi(pw.y), bflo(pw.z), bfhi(pw.z), bflo(pw.w), bfhi(pw.w)};
        float z[8];
#pragma unroll
        for (int i = 0; i < 8; ++i) { z[i] = cv[i] + mu[1536 + col + i] * (pv[i] - cv[i]); if (col < 64) z[i] = 1.f - 2.f / (1.f + __expf(2.f * z[i])); else if (col >= 128) z[i] = sigmoidf_(z[i]); }
        u32x4 o; o.x = pk2(z[0], z[1]); o.y = pk2(z[2], z[3]); o.z = pk2(z[4], z[5]); o.w = pk2(z[6], z[7]);
        bf16* dst = (col < 64) ? A0 + t * ST + col : (col < 128 ? A1 + t * ST + (col - 64) : A2 + t * STG + (col - 128));
        *(u32x4*)dst = o;
    }
    { const int row = tid >> 3, chk = tid & 7;
      *(u32x4*)(A4 + row * ST + chk * 8) = *(const u32x4*)(WT + WT_LW + (size_t)(h * 64 + row) * 64 + chk * 8);
      *(u32x4*)(A5 + row * ST + chk * 8) = *(const u32x4*)(WT + WT_LA + (size_t)(h * 64 + row) * 64 + chk * 8);
#pragma unroll
      for (int i = 0; i < 2; ++i) { const int idx = tid + 512 * i, r2 = idx >> 4, c2 = idx & 15;
          *(u32x4*)((bf16*)F1 + r2 * STG + c2 * 8) = *(const u32x4*)(WT + WT_LG + (size_t)(h * 64 + r2) * 128 + c2 * 8); } }
    LDS_BARRIER();
    { f32x4 aw[2], aa[2], ag[2]; ZACC(aw); ZACC(aa); ZACC(ag);
      mm_tile(A4, ST, A0, ST, 2, aw, w, lq, g); mm_tile(A5, ST, A1, ST, 2, aa, w, lq, g); mm_tile((const bf16*)F1, STG, A2, STG, 4, ag, w, lq, g);
      const int mt = w >> 1, nt0 = 2 * (w & 1);
#pragma unroll
      for (int q = 0; q < 2; ++q) { const int o = (16 * (nt0 + q) + lq) * ST + 16 * mt + 4 * g; u32x2 p;
          p.x = pk2(aw[q][0], aw[q][1]); p.y = pk2(aw[q][2], aw[q][3]); *(u32x2*)(A7 + o) = p;
          p.x = pk2(aa[q][0], aa[q][1]); p.y = pk2(aa[q][2], aa[q][3]); *(u32x2*)(A8 + o) = p;
          p.x = pk2(ag[q][0], ag[q][1]); p.y = pk2(ag[q][2], ag[q][3]); *(u32x2*)(A9 + o) = p; } }
    LDS_BARRIER();
    float kk[8], k2[8], ar[8];
    { const u32x4 lw = *(const u32x4*)(A7 + t * ST + c0), la = *(const u32x4*)(A8 + t * ST + c0), lg = *(const u32x4*)(A9 + t * ST + c0);
      const float fw[8] = {bflo(lw.x), bfhi(lw.x), bflo(lw.y), bfhi(lw.y), bflo(lw.z), bfhi(lw.z), bflo(lw.w), bfhi(lw.w)};
      const float fa[8] = {bflo(la.x), bfhi(la.x), bflo(la.y), bfhi(la.y), bflo(la.z), bfhi(la.z), bflo(la.w), bfhi(la.w)};
      float ss = 0.f, bs = 0.f;
#pragma unroll
      for (int i = 0; i < 8; ++i) {
          const float xw = -(pw0[i] + fw[i]); const float sp = fmaxf(xw, 0.f) + __logf(1.f + __expf(-fabsf(xw)));
          F0[t * 64 + c0 + i] = __expf(-sp - 0.5f);
          ar[i] = sigmoidf_(pa0[i] + fa[i]);
          kk[i] = zk[i] * pkk[i]; ss += kk[i] * kk[i];
          k2[i] = zk[i] * (1.f + (ar[i] - 1.f) * pka[i]);
          bs += zr[i] * k2[i] * prk[i]; }
      ss += __shfl_xor(ss, 1); ss += __shfl_xor(ss, 2); ss += __shfl_xor(ss, 4);
      bs += __shfl_xor(bs, 1); bs += __shfl_xor(bs, 2); bs += __shfl_xor(bs, 4);
      const float inv = 1.0f / fmaxf(sqrtf(ss), 1e-12f);
#pragma unroll
      for (int i = 0; i < 8; ++i) kk[i] *= inv;
      u32x4 bo; bo.x = pk2(bs * zv[0], bs * zv[1]); bo.y = pk2(bs * zv[2], bs * zv[3]); bo.z = pk2(bs * zv[4], bs * zv[5]); bo.w = pk2(bs * zv[6], bs * zv[7]);
      *(u32x4*)(B.BON + (m0 + t) * 512 + jb) = bo; *(u32x4*)(B.G + (m0 + t) * 512 + jb) = lg; }
    LDS_BARRIER();
    {
      const int k = tid & 63, sg = tid >> 6; float e[8], run = 0.f;
#pragma unroll
      for (int s = 0; s < 8; ++s) { run += F0[(8 * sg + s) * 64 + k]; e[s] = run; }
      F1[sg * 64 + k] = run;
      LDS_BARRIER();
      float off = 0.f;
#pragma unroll
      for (int s = 0; s < 8; ++s) off += (s < sg) ? F1[s * 64 + k] : 0.f;
#pragma unroll
      for (int s = 0; s < 8; ++s) F0[(8 * sg + s) * 64 + k] = e[s] + off; }
    LDS_BARRIER();
    { float ct[8], cp[8], cC[8];
#pragma unroll
      for (int i = 0; i < 8; ++i) { ct[i] = F0[t * 64 + c0 + i]; cp[i] = (t > 0) ? F0[(t - 1) * 64 + c0 + i] : 0.f; cC[i] = F0[63 * 64 + c0 + i]; }
      float at[8], bt[8], kt[8], rt[8], bh[8], kh[8];
#pragma unroll
      for (int i = 0; i < 8; ++i) { const float gt = __expf(-ct[i]), igt = __expf(ct[i]), gp = __expf(-cp[i]), gct = __expf(ct[i] - cC[i]);
          at[i] = -kk[i] * gp; bt[i] = kk[i] * ar[i] * igt; kt[i] = k2[i] * igt; rt[i] = zr[i] * gt; bh[i] = kk[i] * ar[i] * gct; kh[i] = k2[i] * gct; }
      u32x4 o;
      o.x = pk2(at[0], at[1]); o.y = pk2(at[2], at[3]); o.z = pk2(at[4], at[5]); o.w = pk2(at[6], at[7]); *(u32x4*)(A0 + t * ST + c0) = o;
      o.x = pk2(bt[0], bt[1]); o.y = pk2(bt[2], bt[3]); o.z = pk2(bt[4], bt[5]); o.w = pk2(bt[6], bt[7]); *(u32x4*)(A1 + t * ST + c0) = o;
      o.x = pk2(kt[0], kt[1]); o.y = pk2(kt[2], kt[3]); o.z = pk2(kt[4], kt[5]); o.w = pk2(kt[6], kt[7]); *(u32x4*)(A2 + t * ST + c0) = o;
      o.x = pk2(rt[0], rt[1]); o.y = pk2(rt[2], rt[3]); o.z = pk2(rt[4], rt[5]); o.w = pk2(rt[6], rt[7]); *(u32x4*)(A3 + t * ST + c0) = o;
#pragma unroll
      for (int i = 0; i < 8; ++i) { const int o = (c0 + i) * ST + (t ^ c0);
          A4[o] = (bf16)f2bf(bh[i]); A5[o] = (bf16)f2bf(kh[i]); A6[o] = (bf16)f2bf(zv[i]); F1[t * 128 + c0 + i] = at[i]; }
      if (t == 63) { float* gc = (float*)(B.UB + (size_t)u * UNIT_B + 16384) + c0;
#pragma unroll
          for (int i = 0; i < 8; ++i) gc[i] = __expf(-cC[i]); } }
    LDS_BARRIER();
    { const int mt = w >> 1, nt0 = 2 * (w & 1);
      f32x4 a[2];
      ZACC(a); mm_tile(A0, ST, A1, ST, 2, a, w, lq, g);
#pragma unroll
      for (int q = 0; q < 2; ++q) { const int i = 16 * (nt0 + q) + lq; f32x4 lab;
#pragma unroll
          for (int j = 0; j < 4; ++j) lab[j] = (i < 16 * mt + 4 * g + j) ? a[q][j] : 0.f;
#pragma unroll
          for (int j = 0; j < 4; ++j) F0[i * 64 + j * 16 + 4 * mt + g] = lab[j]; }
      asm volatile("" ::: "memory");
#define ST1_STORE(DST, INCL) do { _Pragma("unroll") for (int q = 0; q < 2; ++q) { const int tt = 16 * (nt0 + q) + lq, i0 = 16 * mt + 4 * g; float v_[4]; \
          _Pragma("unroll") for (int j = 0; j < 4; ++j) v_[j] = (i0 + j < tt + (INCL)) ? a[q][j] : 0.f; \
          u32x2 p_; p_.x = pk2(v_[0], v_[1]); p_.y = pk2(v_[2], v_[3]); *(u32x2*)((DST) + tt * ST + i0) = p_; } } while (0)
      ZACC(a); mm_tile(A2, ST, A0, ST, 2, a, w, lq, g); ST1_STORE(A7, 0); asm volatile("" ::: "memory");
      ZACC(a); mm_tile(A1, ST, A3, ST, 2, a, w, lq, g); ST1_STORE(A8, 1); asm volatile("" ::: "memory");
      ZACC(a); mm_tile(A2, ST, A3, ST, 2, a, w, lq, g); ST1_STORE(A9, 1);
#undef ST1_STORE
    }
    LDS_BARRIER();
    { const int mt = w >> 1, nt0 = 2 * (w & 1); f32x4 a[2]; ZACC(a);
      mm_tile2<true, false>(A6, ST, A7, ST, 2, a, w, lq, g);
#pragma unroll
      for (int q = 0; q < 2; ++q) *(f32x4*)(F1 + (16 * (nt0 + q) + lq) * 128 + 64 + 16 * mt + 4 * g) = a[q]; }
    LDS_BARRIER();
    { float X[16];
      const int col = 16 * w + lq;
#pragma unroll
      for (int r = 0; r < 16; ++r) X[r] = F1[(4 * r + g) * 128 + col];
      LDS_BARRIER();
      f32x4 Lc[4];
#pragma unroll
      for (int q = 0; q < 4; ++q) Lc[q] = *(const f32x4*)(F0 + g * 16 + 4 * q);
#pragma unroll
      for (int i = 0; i < 64; ++i) {
          const float xi = __shfl(X[i >> 2], (i & 3) * 16 + lq);
          f32x4 Ln[4];
#pragma unroll
          for (int q = 0; q < 4; ++q) Ln[q] = Lc[q];
          if (i + 1 < 64) {
#pragma unroll
              for (int q = ((i + 1) >> 4); q < 4; ++q) Ln[q] = *(const f32x4*)(F0 + (i + 1) * 64 + g * 16 + 4 * q);
          }
#pragma unroll
          for (int r = (i >> 2); r < 16; ++r) X[r] += Lc[r >> 2][r & 3] * xi;
#pragma unroll
          for (int q = 0; q < 4; ++q) Lc[q] = Ln[q];
          __builtin_amdgcn_sched_barrier(0);
      }
      bf16* XT = (bf16*)F1 + (w >> 2) * 4608 + ((col & 63) * ST);
#pragma unroll
      for (int r = 0; r < 16; ++r) XT[4 * r + g] = (bf16)f2bf(X[r]); }
    LDS_BARRIER();
    { const int mt = w >> 1, nt0 = 2 * (w & 1);
      const bf16* AhT = (const bf16*)F1; const bf16* W2T = AhT + 4608;
      unsigned char* ua = B.UA + (size_t)u * UNIT_A; unsigned char* ub = B.UB + (size_t)u * UNIT_B;
      const int p0 = 32 * (mt >> 1) + 8 * g + 4 * (mt & 1);
      f32x4 a[2];
      ZACC(a); mm_tile2<false, true>(AhT, ST, A4, ST, 2, a, w, lq, g);
#pragma unroll
      for (int q = 0; q < 2; ++q) { const int k = 16 * (nt0 + q) + lq; u32x2 o; o.x = pk2(a[q][0], a[q][1]); o.y = pk2(a[q][2], a[q][3]); *(u32x2*)(ua + swz(k, p0)) = o; }
      ZACC(a); mm_tile(AhT, ST, A8, ST, 2, a, w, lq, g);
#pragma unroll
      for (int q = 0; q < 2; ++q) { const int tt = 16 * (nt0 + q) + lq; const u32x2 rr = *(const u32x2*)(A3 + tt * ST + 16 * mt + 4 * g);
          u32x2 o; o.x = pk2(a[q][0] + bflo(rr.x), a[q][1] + bfhi(rr.x)); o.y = pk2(a[q][2] + bflo(rr.y), a[q][3] + bfhi(rr.y)); *(u32x2*)(ua + 8192 + swz(tt, p0)) = o; }
      ZACC(a); mm_tile2<true, false>(A4, ST, W2T, ST, 2, a, w, lq, g); mm_tile2<true, true>(A5, ST, A6, ST, 2, a, w, lq, g);
#pragma unroll
      for (int q = 0; q < 2; ++q) { const int v = 16 * (nt0 + q) + lq, k0 = 16 * mt + 4 * g; u32x2 o; o.x = pk2(a[q][0], a[q][1]); o.y = pk2(a[q][2], a[q][3]); *(u32x2*)(ub + swz(v, k0)) = o; }
      ZACC(a); mm_tile(A8, ST, W2T, ST, 2, a, w, lq, g); mm_tile2<false, true>(A9, ST, A6, ST, 2, a, w, lq, g);
#pragma unroll
      for (int q = 0; q < 2; ++q) { const int v = 16 * (nt0 + q) + lq, t0 = 16 * mt + 4 * g; u32x2 o; o.x = pk2(a[q][0], a[q][1]); o.y = pk2(a[q][2], a[q][3]); *(u32x2*)(ub + 8192 + swz(v, t0)) = o; } }
    LDS_BARRIER();
}
__device__ __forceinline__ void phase_rwkv_prep(const Params& P, int l, const Ctx& c) {
    const RwkvBufs B = rwkv_bufs(P, c);
    float pw0[8], pa0[8], pkk[8], pka[8], prk[8]; int hprev = -1;
    for (int u = c.bid; u < NUNIT; u += c.G) {
        const int h = u & 7;
        if (h != hprev) { hprev = h; const int j0 = l * 512 + h * 64 + (c.tid & 7) * 8;
#pragma unroll
            for (int i = 0; i < 8; ++i) { pw0[i] = P.in[9][j0 + i]; pa0[i] = P.in[11][j0 + i]; pkk[i] = P.in[14][j0 + i]; pka[i] = P.in[15][j0 + i]; prk[i] = P.in[16][j0 + i]; } }
        rwkv_prep_unit(P, l, c, u, B, pw0, pa0, pkk, pka, prk);
    }
}

constexpr int SLOTB = 33280, YST = 68;
__device__ __forceinline__ void scan_chunked(const Params& P, const Ctx& c, int bh) {
    const RwkvBufs B = rwkv_bufs(P, c);
    const int b = bh >> 3, h = bh & 7, w = c.wave, lane = c.lane, lq = lane & 15, g = lane >> 4;
    const size_t rowb = (size_t)b * LP;
    const int ll = c.tid;
    unsigned char* L = c.lds;
    f32x4 st[4];
#pragma unroll
    for (int i = 0; i < 4; ++i) st[i] = (f32x4){0.f, 0.f, 0.f, 0.f};
    u32x4 r0[5], r1[5], r2[5], r3[5], r4[5];
#define SC_UNIT(cc) ((size_t)((b * NCHK + (cc)) * 8 + h))
#define SC_LOAD(R, cc) do { const unsigned char* pa_ = B.UA + SC_UNIT(cc) * UNIT_A; const unsigned char* pb_ = B.UB + SC_UNIT(cc) * UNIT_B; \
        _Pragma("unroll") for (int i_ = 0; i_ < 2; ++i_) { R[i_] = GLD(u32x4, pa_ + (ll + 512 * i_) * 16); R[2 + i_] = GLD(u32x4, pb_ + (ll + 512 * i_) * 16); } \
        if (ll < 16) R[4] = GLD(u32x4, pb_ + 16384 + ll * 16); } while (0)
#define SC_WRITE(R, slot) do { unsigned char* s_ = L + (slot) * SLOTB; \
        _Pragma("unroll") for (int i_ = 0; i_ < 2; ++i_) { *(u32x4*)(s_ + (ll + 512 * i_) * 16) = R[i_]; *(u32x4*)(s_ + 16384 + (ll + 512 * i_) * 16) = R[2 + i_]; } \
        if (ll < 16) *(u32x4*)(s_ + 32768 + ll * 16) = R[4]; } while (0)
#define SC_COMPUTE(ci) do { \
        const unsigned char* sl = L + ((ci) % 3) * SLOTB; \
        const int vcol = 16 * w + lq; \
        bf16x8 gaf[4][2]; f32x4 gcf[4]; u32x2 d0f[4]; \
        _Pragma("unroll") for (int mt = 0; mt < 4; ++mt) { \
            gcf[mt] = *(const f32x4*)(sl + 32768 + (16 * mt + 4 * g) * 4); \
            d0f[mt] = *(const u32x2*)(sl + 16384 + swz(vcol, 16 * mt + 4 * g)); \
            _Pragma("unroll") for (int ks = 0; ks < 2; ++ks) gaf[mt][ks] = *(const bf16x8*)(sl + swz(16 * mt + lq, 32 * ks + 8 * g)); } \
        __builtin_amdgcn_sched_barrier(0);        \
        bf16x8 sb[2]; \
        _Pragma("unroll") for (int ks = 0; ks < 2; ++ks) { u32x4 pw; pw.x = pk2(st[2 * ks][0], st[2 * ks][1]); pw.y = pk2(st[2 * ks][2], st[2 * ks][3]); pw.z = pk2(st[2 * ks + 1][0], st[2 * ks + 1][1]); pw.w = pk2(st[2 * ks + 1][2], st[2 * ks + 1][3]); \
            sb[ks] = __builtin_bit_cast(bf16x8, pw); } \
        _Pragma("unroll") for (int mt = 0; mt < 4; ++mt) { \
            f32x4 ns = (f32x4){bflo(d0f[mt].x), bfhi(d0f[mt].x), bflo(d0f[mt].y), bfhi(d0f[mt].y)} + gcf[mt] * st[mt]; \
            _Pragma("unroll") for (int ks = 0; ks < 2; ++ks) ns = __builtin_amdgcn_mfma_f32_16x16x32_bf16(gaf[mt][ks], sb[ks], ns, 0, 0, 0); \
            st[mt] = ns; } \
        bf16x8 rhf[4][2]; u32x2 y0f[4];        \
        _Pragma("unroll") for (int mt = 0; mt < 4; ++mt) { y0f[mt] = *(const u32x2*)(sl + 24576 + swz(vcol, 16 * mt + 4 * g)); \
            _Pragma("unroll") for (int ks = 0; ks < 2; ++ks) rhf[mt][ks] = *(const bf16x8*)(sl + 8192 + swz(16 * mt + lq, 32 * ks + 8 * g)); } \
        __builtin_amdgcn_sched_barrier(0); \
        f32x4 yav[4]; \
        _Pragma("unroll") for (int mt = 0; mt < 4; ++mt) { yav[mt] = (f32x4){bflo(y0f[mt].x), bfhi(y0f[mt].x), bflo(y0f[mt].y), bfhi(y0f[mt].y)}; \
            _Pragma("unroll") for (int ks = 0; ks < 2; ++ks) yav[mt] = __builtin_amdgcn_mfma_f32_16x16x32_bf16(rhf[mt][ks], sb[ks], yav[mt], 0, 0, 0); } \
        _Pragma("unroll") for (int mt = 0; mt < 4; ++mt) { \
            float* yl = (float*)(L + 3 * SLOTB) + ((ci) & 1) * (64 * YST) + (16 * mt + 4 * g) * YST + vcol; \
            _Pragma("unroll") for (int j = 0; j < 4; ++j) yl[j * YST] = yav[mt][j]; } } while (0)
#define SC_YSTORE(ci) do { const float* ys_ = (const float*)(L + 3 * SLOTB) + ((ci) & 1) * (64 * YST) + (c.tid >> 3) * YST + (c.tid & 7) * 8; \
        float* yg_ = B.Y + (rowb + (ci) * 64 + (c.tid >> 3)) * 512 + h * 64 + (c.tid & 7) * 8; \
        GST(f32x4, yg_) = *(const f32x4*)ys_; GST(f32x4, yg_ + 4) = *(const f32x4*)(ys_ + 4); } while (0)
#define SC_ITER(ci, R) do { if ((ci) + 2 < NCHK) SC_WRITE(R, ((ci) + 2) % 3); if ((ci) + 7 < NCHK) SC_LOAD(R, (ci) + 7); if ((ci) > 0) SC_YSTORE((ci) - 1); if (w < 4) { SC_COMPUTE(ci); } LDS_BARRIER(); } while (0)
    { SC_LOAD(r0, 0); SC_LOAD(r1, 1); SC_WRITE(r0, 0); SC_WRITE(r1, 1); SC_LOAD(r2, 2); SC_LOAD(r3, 3); SC_LOAD(r4, 4); SC_LOAD(r0, 5); SC_LOAD(r1, 6); }
    __syncthreads();
#pragma unroll 1
    for (int cc = 0; cc < NCHK; cc += 5) { SC_ITER(cc, r2); SC_ITER(cc + 1, r3); SC_ITER(cc + 2, r4); SC_ITER(cc + 3, r0); SC_ITER(cc + 4, r1); }
    SC_YSTORE(NCHK - 1);
#undef SC_YSTORE
#undef SC_COMPUTE
#undef SC_ITER
#undef SC_UNIT
#undef SC_LOAD
#undef SC_WRITE
}

__device__ __forceinline__ void phase_gn(const Params& P, int l, const Ctx& c) {
    const RwkvBufs B = rwkv_bufs(P, c);
    const int gw = c.bid * NWAVES + c.wave, NGW = c.G * NWAVES;
    const int c0 = 8 * c.lane;
    float gnw[8], gnb[8];
#pragma unroll
    for (int i = 0; i < 8; ++i) { gnw[i] = P.in[17][l * 512 + c0 + i]; gnb[i] = P.in[18][l * 512 + c0 + i]; }
    for (int m = gw; m < M; m += NGW) {
        const size_t o = (size_t)m * 512 + c0;
        const f32x4 y0 = *(const f32x4*)(B.Y + o), y1 = *(const f32x4*)(B.Y + o + 4);
        float y[8] = {y0.x, y0.y, y0.z, y0.w, y1.x, y1.y, y1.z, y1.w};
        const u32x4 bw = *(const u32x4*)(B.BON + o), gw4 = *(const u32x4*)(B.G + o);
        const float bo[8] = {bflo(bw.x), bfhi(bw.x), bflo(bw.y), bfhi(bw.y), bflo(bw.z), bfhi(bw.z), bflo(bw.w), bfhi(bw.w)};
        const float gg[8] = {bflo(gw4.x), bfhi(gw4.x), bflo(gw4.y), bfhi(gw4.y), bflo(gw4.z), bfhi(gw4.z), bflo(gw4.w), bfhi(gw4.w)};
        float s = 0.f;
#pragma unroll
        for (int i = 0; i < 8; ++i) s += y[i];
        s += __shfl_xor(s, 1); s += __shfl_xor(s, 2); s += __shfl_xor(s, 4);
        const float mean = s * (1.f / 64.f);
        float q = 0.f;
#pragma unroll
        for (int i = 0; i < 8; ++i) { y[i] -= mean; q += y[i] * y[i]; }
        q += __shfl_xor(q, 1); q += __shfl_xor(q, 2); q += __shfl_xor(q, 4);
        const float rstd = 1.0f / sqrtf(q * (1.f / 64.f) + 64e-5f);
        float ov[8];
#pragma unroll
        for (int i = 0; i < 8; ++i) ov[i] = (y[i] * rstd * gnw[i] + gnb[i] + bo[i]) * gg[i];
        u32x4 ow; ow.x = pk2(ov[0], ov[1]); ow.y = pk2(ov[2], ov[3]); ow.z = pk2(ov[4], ov[5]); ow.w = pk2(ov[6], ov[7]);
        *(u32x4*)(B.ORW + o) = ow;
    }
}

__device__ __forceinline__ void attn_unit(const Ctx& c, int bh, int qb, const bf16* Q, const bf16* K, const bf16* V, bf16* O, const float* FC, float qkb2, const float* gq, const float* gk) {
    const int b = bh >> 3, h = bh & 7, lane = c.lane, w = c.wave, lq = lane & 15, g = lane >> 4;
    const int q0 = qb * 128;
    const size_t rowb = (size_t)b * LP;
    const int qrow = q0 + 16 * w + lq;
    bf16* Ks = (bf16*)c.lds; bf16* Vt = Ks + 64 * 72; float* fks = (float*)(Vt + 64 * 72);
    const bf16* qp = Q + (rowb + qrow) * 512 + h * 64 + 8 * g;
    bf16x8 qf0, qf1;
    { const u32x4 r0 = GLD(u32x4, qp), r1 = GLD(u32x4, qp + 32);
      float x[16] = {bflo(r0.x), bfhi(r0.x), bflo(r0.y), bfhi(r0.y), bflo(r0.z), bfhi(r0.z), bflo(r0.w), bfhi(r0.w), bflo(r1.x), bfhi(r1.x), bflo(r1.y), bfhi(r1.y), bflo(r1.z), bfhi(r1.z), bflo(r1.w), bfhi(r1.w)};
      float ss = 0.f;
#pragma unroll
      for (int i = 0; i < 16; ++i) ss += x[i] * x[i];
      ss += __shfl_xor(ss, 16); ss += __shfl_xor(ss, 32);
      const float rs = QSCALE / sqrtf(ss * (1.f / 64.f) + 1e-6f);
#pragma unroll
      for (int i = 0; i < 8; ++i) { x[i] *= rs * gq[8 * g + i]; x[8 + i] *= rs * gq[32 + 8 * g + i]; }
      u32x4 p0, p1; p0.x = pk2(x[0], x[1]); p0.y = pk2(x[2], x[3]); p0.z = pk2(x[4], x[5]); p0.w = pk2(x[6], x[7]); p1.x = pk2(x[8], x[9]); p1.y = pk2(x[10], x[11]); p1.z = pk2(x[12], x[13]); p1.w = pk2(x[14], x[15]);
      qf0 = __builtin_bit_cast(bf16x8, p0); qf1 = __builtin_bit_cast(bf16x8, p1); }
    const float* FCh = FC + (size_t)bh * LP;
    const float fq = GLD(float, FCh + qrow);
    float mrun = -1e30f, lsum = 0.f;
    f32x4 o[4];
#pragma unroll
    for (int i = 0; i < 4; ++i) o[i] = (f32x4){0.f, 0.f, 0.f, 0.f};
    const int kt_max = (q0 + 127) >> 6;
    const int lkey = c.tid >> 3, lch = c.tid & 7;
    float gkr[8];
#pragma unroll
    for (int i = 0; i < 8; ++i) gkr[i] = gk[lch * 8 + i];
    const size_t gbase = (rowb + lkey) * 512 + h * 64 + lch * 8;
    u32x4 kv = GLD(u32x4, K + gbase + (size_t)kt_max * 64 * 512), vv = GLD(u32x4, V + gbase + (size_t)kt_max * 64 * 512);
    float fkv = GLD(float, FCh + kt_max * 64 + (c.tid & 63));
    volatile unsigned* vote = (volatile unsigned*)(fks + 64);
    for (int kt = kt_max; kt >= 0; --kt) {
        const int k0 = kt * 64;
        LDS_BARRIER();
        { int can = 0; if (kt < kt_max) { const float fl = __shfl(fkv, 63); can = (qkb2 + fq - fl) < (mrun - THR2); }
          const int wall = __all(can); if (lane == 0) vote[w] = (unsigned)wall; }
        { { float x[8] = {bflo(kv.x), bfhi(kv.x), bflo(kv.y), bfhi(kv.y), bflo(kv.z), bfhi(kv.z), bflo(kv.w), bfhi(kv.w)}; float ss = 0.f;
#pragma unroll
              for (int i = 0; i < 8; ++i) ss += x[i] * x[i];
              ss += __shfl_xor(ss, 1); ss += __shfl_xor(ss, 2); ss += __shfl_xor(ss, 4);
              const float rs = 1.0f / sqrtf(ss * (1.f / 64.f) + 1e-6f);
              u32x4 kn; kn.x = pk2(x[0] * rs * gkr[0], x[1] * rs * gkr[1]); kn.y = pk2(x[2] * rs * gkr[2], x[3] * rs * gkr[3]); kn.z = pk2(x[4] * rs * gkr[4], x[5] * rs * gkr[5]); kn.w = pk2(x[6] * rs * gkr[6], x[7] * rs * gkr[7]);
              *(u32x4*)(Ks + lkey * 72 + lch * 8) = kn; }
            bf16* vd = Vt + (lch * 8) * 72 + (lkey ^ (8 * lch));
            vd[0] = (bf16)(vv.x & 0xffff); vd[72] = (bf16)(vv.x >> 16); vd[144] = (bf16)(vv.y & 0xffff); vd[216] = (bf16)(vv.y >> 16);
            vd[288] = (bf16)(vv.z & 0xffff); vd[360] = (bf16)(vv.z >> 16); vd[432] = (bf16)(vv.w & 0xffff); vd[504] = (bf16)(vv.w >> 16);
            if (c.tid < 64) fks[c.tid] = fkv;
            if (kt > 0) { kv = GLD(u32x4, K + gbase + (size_t)(k0 - 64) * 512); vv = GLD(u32x4, V + gbase + (size_t)(k0 - 64) * 512); fkv = GLD(float, FCh + k0 - 64 + (c.tid & 63)); } }
        LDS_BARRIER();
        { unsigned all = vote[0] & vote[1] & vote[2] & vote[3] & vote[4] & vote[5] & vote[6] & vote[7]; if (all) break; }
        if (k0 > q0 + 16 * w + 15) continue;
        f32x4 s[4];
#pragma unroll
        for (int nt = 0; nt < 4; ++nt) { const bf16* kp = Ks + (16 * nt + lq) * 72 + 8 * g; const bf16x8 a0 = *(const bf16x8*)kp, a1 = *(const bf16x8*)(kp + 32);
            s[nt] = __builtin_amdgcn_mfma_f32_16x16x32_bf16(a0, qf0, (f32x4){0.f, 0.f, 0.f, 0.f}, 0, 0, 0);
            s[nt] = __builtin_amdgcn_mfma_f32_16x16x32_bf16(a1, qf1, s[nt], 0, 0, 0); }
        float mx = -INFINITY;
#pragma unroll
        for (int nt = 0; nt < 4; ++nt) { const f32x4 fk = *(const f32x4*)(fks + 16 * nt + 4 * g);
#pragma unroll
            for (int j = 0; j < 4; ++j) { float x = s[nt][j] + fq - fk[j]; const int key = k0 + 16 * nt + 4 * g + j; if (key > qrow) x = -INFINITY; s[nt][j] = x; mx = fmaxf(mx, x); } }
        mx = fmaxf(mx, __shfl_xor(mx, 16)); mx = fmaxf(mx, __shfl_xor(mx, 32));
        const float mnew = fmaxf(mrun, mx), alpha = __builtin_amdgcn_exp2f(mrun - mnew); mrun = mnew;
        float psum = 0.f;
#pragma unroll
        for (int nt = 0; nt < 4; ++nt)
#pragma unroll
            for (int j = 0; j < 4; ++j) { const float p = __builtin_amdgcn_exp2f(s[nt][j] - mnew); s[nt][j] = p; psum += p; }
        lsum = lsum * alpha + psum;
#pragma unroll
        for (int dt = 0; dt < 4; ++dt) o[dt] = o[dt] * alpha;
        bf16x8 pb[2];
#pragma unroll
        for (int k2 = 0; k2 < 2; ++k2) { u32x4 pw; pw.x = pk2(s[2 * k2][0], s[2 * k2][1]); pw.y = pk2(s[2 * k2][2], s[2 * k2][3]); pw.z = pk2(s[2 * k2 + 1][0], s[2 * k2 + 1][1]); pw.w = pk2(s[2 * k2 + 1][2], s[2 * k2 + 1][3]);
            pb[k2] = __builtin_bit_cast(bf16x8, pw); }
#pragma unroll
        for (int dt = 0; dt < 4; ++dt)
#pragma unroll
            for (int k2 = 0; k2 < 2; ++k2) { const int vrow = 16 * dt + lq, vx = 8 * ((vrow >> 3) & 7); const bf16* vp = Vt + vrow * 72;
                const u32x2 lo = *(const u32x2*)(vp + ((32 * k2 + 4 * g) ^ vx)), hi = *(const u32x2*)(vp + ((32 * k2 + 16 + 4 * g) ^ vx));
                u32x4 aw; aw.x = lo.x; aw.y = lo.y; aw.z = hi.x; aw.w = hi.y;
                o[dt] = __builtin_amdgcn_mfma_f32_16x16x32_bf16(__builtin_bit_cast(bf16x8, aw), pb[k2], o[dt], 0, 0, 0); }
    }
    lsum += __shfl_xor(lsum, 16); lsum += __shfl_xor(lsum, 32);
    const float inv = 1.0f / lsum;
    bf16* op = O + (rowb + qrow) * 512 + h * 64 + 4 * g;
#pragma unroll
    for (int dt = 0; dt < 4; ++dt) { u32x2 ow; ow.x = pk2(o[dt][0] * inv, o[dt][1] * inv); ow.y = pk2(o[dt][2] * inv, o[dt][3] * inv); GST(u32x2, op + 16 * dt) = ow; }
    __syncthreads();
}
__device__ __forceinline__ void phase_attn(const Params& P, int l, const Ctx& c, int first_blk) {
    const bf16* Q = (const bf16*)(c.ws + OFF_Q); const bf16* K = (const bf16*)(c.ws + OFF_K); const bf16* V = (const bf16*)(c.ws + OFF_V);
    const float* FC = (const float*)(c.ws + OFF_MISC) + 16 * LP;
    float gqm = fabsf(P.in[5][l * 64 + c.lane]), gkm = fabsf(P.in[6][l * 64 + c.lane]);
#pragma unroll
    for (int o = 1; o < 64; o <<= 1) { gqm = fmaxf(gqm, __shfl_xor(gqm, o)); gkm = fmaxf(gkm, __shfl_xor(gkm, o)); }
    const float qkb2 = 8.0f * gqm * gkm * LOG2E * 1.03f;
    constexpr int NQB = LP / 128, NU = 16 * NQB;
    unsigned* ctr = (unsigned*)(c.ws + OFF_CTL) + 8192 + 64 * l;
    volatile unsigned* slot = (volatile unsigned*)(c.lds + MISC_OFF) + 4;
    for (;;) {
        __syncthreads();
        if (c.tid == 0) *slot = atomicAdd(ctr, 1u);
        __syncthreads();
        const int u = (int)*slot;
        if (u >= NU) break;
        const int bh = u & 15, qb = NQB - 1 - (u >> 4); attn_unit(c, bh, qb, Q, K, V, (bf16*)(c.ws + OFF_OF), FC, qkb2, P.in[5] + l * 64, P.in[6] + l * 64);
    }
}

__device__ __forceinline__ void phase_fixup(const Params& P, int l, const Ctx& c) {
    bf16* ACT = (bf16*)(c.ws + OFF_RW); const bf16* HALO = (const bf16*)(c.ws + OFF_Q);
    const float* cw = P.in[24] + (size_t)l * 3 * NUP;
    const int total = (M / 64) * 2 * DFF;
    for (int idx = c.bid * NTHR + c.tid; idx < total; idx += c.G * NTHR) {
        const int rr = idx / DFF, ch = idx - rr * DFF, q64 = rr >> 1, e = rr & 1, row = q64 * 64 + e;
        const int t = row % LP;
        int s0, s1, s2;
        if (e == 0) { s0 = q64 * 4 + 2; s1 = (q64 - 1) * 4 + 1; s2 = (q64 - 1) * 4 + 0; } else { s0 = q64 * 4 + 3; s1 = q64 * 4 + 2; s2 = (q64 - 1) * 4 + 1; }
        float uc[2];
#pragma unroll
        for (int bj = 0; bj < 2; ++bj) { const int col = bj * DFF + ch;
            const float u0 = bf2f(HALO[(size_t)s0 * NUP + col]);
            const float u1 = (t >= 1) ? bf2f(HALO[(size_t)s1 * NUP + col]) : 0.f;
            const float u2 = (t >= 2) ? bf2f(HALO[(size_t)s2 * NUP + col]) : 0.f;
            uc[bj] = cw[col] * u2 + cw[NUP + col] * u1 + cw[2 * NUP + col] * u0; }
        ACT[(size_t)row * DFF + ch] = (bf16)f2bf(uc[0] * sigmoidf_(uc[0]) * uc[1]);
    }
}

#define OPQ_S(x) asm volatile("" : "+s"(x))
#define OPQ_V(x) asm volatile("" : "+v"(x))
#define PHASE_BEGIN() do { int t_ = threadIdx.x; OPQ_V(t_); c.tid = t_; c.lane = t_ & 63; c.wave = __builtin_amdgcn_readfirstlane(t_ >> 6); int b_ = blockIdx.x; OPQ_S(b_); c.bid = b_; \
    size_t z_ = 0; OPQ_S(z_); unsigned char* w_ = P.ws + z_;   c.ws = w_; ws = w_; l = lc; OPQ_S(l); WT = (pg8::bf16_t*)(ws + OFF_WT); HN = (pg8::bf16_t*)(ws + OFF_HN); } while (0)
__global__ void __launch_bounds__(NTHR, 2) mega(Params P) {
    extern __shared__ __attribute__((aligned(16))) unsigned char lds[];
    Ctx c; c.G = gridDim.x; c.lds = lds;
    volatile LAS unsigned* MISC = (volatile LAS unsigned*)((LAS unsigned char*)lds + MISC_OFF);
    if (threadIdx.x < 16) MISC[threadIdx.x] = 0u;
    __syncthreads();
    (void)xcd_barrier_post((unsigned*)(P.ws + OFF_CTL) + 1024, MISC + 8);
#define SEAM() do { XcdBarrier xb_; xb_.bar = (unsigned*)(P.ws + OFF_CTL) + 1024; xb_.x = xb_xcc_id(); xb_.st = (volatile LAS unsigned*)((LAS unsigned char*)lds + MISC_OFF) + 8; xcd_barrier(xb_); } while (0)
    PG8_LAS unsigned char* ldsl = (PG8_LAS unsigned char*)lds;
    unsigned char* ws; pg8::bf16_t* WT; pg8::bf16_t* HN; int l;
#pragma unroll 1
    for (int lc = 0; lc < DEPTH; ++lc) {
        PHASE_BEGIN();
        convert_weights(P, l, c);
        phase_norm<true>(P, l, c);
        if (lc == 0) cg::this_grid().sync(); else SEAM();
        PHASE_BEGIN();
        phase_fcum(P, c);
        { pg8::Gemm g{HN, WT + WT_IN, M, N1, 1024, 1024}; pg8::StaticOrder S; S.init(M, N1, c.G, c.bid);
          pg8::EpiRoute E{ws};
          pg8::gemm_phase<pg8::EpiRoute, pg8::StaticOrder, true, true>(ldsl, g, S, E); }
        SEAM();
        PHASE_BEGIN();
        for (int rep_ = 0; rep_ < REP_PREP; ++rep_) phase_rwkv_prep(P, l, c);
        SEAM();
        PHASE_BEGIN();
        if (c.bid < 16) { scan_chunked(P, c, c.bid); __syncthreads(); PHASE_BEGIN(); }
        phase_attn(P, l, c, 16);
#if REP_P3 > 1
        __syncthreads(); PHASE_BEGIN();
        if (c.bid < 16) scan_chunked(P, c, c.bid); else phase_attn(P, l, c, 16);
#endif
        SEAM();
        PHASE_BEGIN();
        phase_gn(P, l, c);
        for (int rep_ = 0; rep_ < REP_SYNC; ++rep_) SEAM();
        SEAM();
        PHASE_BEGIN();
#pragma unroll 1
        for (int pass = 0; pass < 3; ++pass) {
            if (pass) { __syncthreads(); PHASE_BEGIN(); }
            const int rw_side = pass == 2 ? ((c.bid >> 2) & 1) : pass;
            const pg8::bf16_t* A = rw_side ? (const pg8::bf16_t*)(ws + OFF_RW + (size_t)M * 512 * 4) : (const pg8::bf16_t*)(ws + OFF_OF);
            pg8::Gemm g{A, WT + (rw_side ? WT_BR : WT_BF), M, 1024, 512, 512};
            pg8::OneUnit S; S.so.init(MMAIN, 1024, c.G, c.bid); S.mode = pass == 2; S.pm = MMAIN / 256; S.pn = c.bid & 3; S.active = c.bid < 8;
            pg8::bf16_t* O = (pass == 2 && rw_side) ? (pg8::bf16_t*)(ws + OFF_TAIL) - (size_t)MMAIN * 1024 : (pg8::bf16_t*)(ws + OFF_K);
            pg8::EpiGateR E{O, (const pg8::bf16_t*)(ws + OFF_GT), P.in[21] + l * NGT, rw_side * 1024, pass == 1};
            pg8::gemm_phase<pg8::EpiGateR, pg8::OneUnit, true, true>(ldsl, g, S, E);
        }
        SEAM();
        PHASE_BEGIN();
#pragma unroll 1
        for (int pass = 0; pass < 2; ++pass) {
            if (pass) { __syncthreads(); PHASE_BEGIN(); }
            const int sl = pass ? (c.bid >> 2) : 0, ks = sl & 3;
            const pg8::bf16_t* A = (pass && sl >= 4) ? (const pg8::bf16_t*)(ws + OFF_TAIL) - (size_t)MMAIN * 1024 : (const pg8::bf16_t*)(ws + OFF_K);
            pg8::Gemm g{A + ks * 256, WT + WT_O + ks * 256, M, 1024, pass ? 256 : 1024, 1024};
            pg8::OneUnit S; S.so.init(MMAIN, 1024, c.G, c.bid); S.mode = pass; S.pm = MMAIN / 256; S.pn = c.bid & 3; S.active = sl < 8;
            pg8::EpiResid E{(float*)(ws + OFF_H), nullptr, pass};
            pg8::gemm_phase<pg8::EpiResid, pg8::OneUnit, true, true>(ldsl, g, S, E);
        }
        SEAM();
        PHASE_BEGIN();
        phase_norm<false>(P, l, c);
        SEAM();
        PHASE_BEGIN();
        { pg8::Gemm g{HN, WT + WT_UP, M, NUP, 1024, 1024}; pg8::StaticOrder S; S.init(M, NUP, c.G, c.bid);
          pg8::EpiUp E{(pg8::bf16_t*)(ws + OFF_RW), (pg8::bf16_t*)(ws + OFF_Q), P.in[24] + (size_t)l * 3 * NUP};
          pg8::gemm_phase<pg8::EpiUp, pg8::StaticOrder, true, true>(ldsl, g, S, E); }
        SEAM();
        PHASE_BEGIN();
        phase_fixup(P, l, c);
        SEAM();
        PHASE_BEGIN();
#pragma unroll 1
        for (int pass = 0; pass < 2; ++pass) {
            if (pass) { __syncthreads(); PHASE_BEGIN(); }
            const int sl = pass ? (c.bid >> 2) : 0;
            const int ko = (sl < 6) ? sl * 384 : 2304 + (sl - 6) * 256, kl = (sl < 6) ? 384 : 256;
            pg8::Gemm g{(const pg8::bf16_t*)(ws + OFF_RW) + (pass ? ko : 0), WT + WT_DN + (pass ? ko : 0), M, 1024, pass ? kl : DFF, DFF};
            pg8::OneUnit S; S.so.init(MMAIN, 1024, c.G, c.bid); S.mode = pass; S.pm = MMAIN / 256; S.pn = c.bid & 3; S.active = sl < 8;
            pg8::EpiResid E{(float*)(ws + OFF_H), (l == DEPTH - 1 && !pass) ? P.out : nullptr, pass};
            pg8::gemm_phase<pg8::EpiResid, pg8::OneUnit, true, true>(ldsl, g, S, E);
        }
        SEAM();
        if (l == DEPTH - 1) {
            PHASE_BEGIN();
            const float* H = (const float*)(ws + OFF_H);
            for (int idx = c.bid * NTHR + c.tid; idx < (NMETA + SEQ - (MMAIN - LP)) * (DM / 4); idx += c.G * NTHR) {
                const int r = idx / (DM / 4), q4 = idx - r * (DM / 4), t = (MMAIN - LP) + r;
                *(f32x4*)(P.out + ((size_t)SEQ + (t - NMETA)) * DM + 4 * q4) = *(const f32x4*)(H + (size_t)(LP + t) * DM + 4 * q4);
            }
        }
    }
}

extern "C" void kernel_launch(void* const* d_in, const int* in_sizes, int n_in, void* d_out, int out_size, void* d_ws, size_t ws_size, hipStream_t stream) {
    static int grid = 0;
    if (grid == 0) {
        if (n_in != 26 || out_size != NB * SEQ * DM || ws_size < WS_NEED) { fprintf(stderr, "kernel_launch: unexpected shapes (n_in %d out %d ws %zu need %zu)\n", n_in, out_size, ws_size, (size_t)WS_NEED); grid = -1; return; }
        int dev = 0, cus = 0, per_cu = 0;
        if (hipGetDevice(&dev) != hipSuccess || hipDeviceGetAttribute(&cus, hipDeviceAttributeMultiprocessorCount, dev) != hipSuccess) { grid = -1; return; }
        if (hipFuncSetAttribute((const void*)mega, hipFuncAttributeMaxDynamicSharedMemorySize, LDS_BYTES) != hipSuccess) { fprintf(stderr, "kernel_launch: hipFuncSetAttribute failed\n"); grid = -1; return; }
        if (hipOccupancyMaxActiveBlocksPerMultiprocessor(&per_cu, (const void*)mega, NTHR, LDS_BYTES) != hipSuccess || per_cu < 1) { fprintf(stderr, "kernel_launch: occupancy query says %d\n", per_cu); per_cu = 1; }
        (void)hipGetLastError();
        grid = cus;
    }
    if (grid < 0) return;
    if (hipMemsetAsync((char*)d_ws + OFF_CTL, 0, 65536, stream) != hipSuccess) { fprintf(stderr, "kernel_launch: memset failed\n"); return; }
    Params p{};
    for (int i = 0; i < 26; ++i) p.in[i] = (const float*)d_in[i];
    p.out = (float*)d_out; p.ws = (unsigned char*)d_ws;
    void* args[] = {&p};
    hipError_t e = hipLaunchCooperativeKernel((const void*)mega, dim3(grid), dim3(NTHR), args, LDS_BYTES, stream);
    if (e != hipSuccess) fprintf(stderr, "kernel_launch: cooperative launch failed: %s (grid %d)\n", hipGetErrorString(e), grid);
}
```

```cpp
#include <hip/hip_runtime.h>
#include <hip/hip_cooperative_groups.h>
#include <cstdio>
#include <cstdint>
#include <cmath>
namespace cg = cooperative_groups;
namespace pg8 {
#define PG8_LAS __attribute__((address_space(3)))
typedef unsigned short bf16_t;
typedef short bf16x8 __attribute__((ext_vector_type(8)));
typedef float f32x4 __attribute__((ext_vector_type(4)));
typedef unsigned u32x4 __attribute__((ext_vector_type(4)));
constexpr int BM = 256, BK = 64, HALF = 128, HTB = HALF * BK * 2  , STAGE_BYTES = 8 * HTB, NXCD = 8, WGM = 8;

__host__ __device__ __forceinline__ int lds_byte(int r, int c) { const int st = (r >> 4) * 2 + (c >> 5), rr = r & 15, cc = c & 31, ob = rr * 64 + cc * 2; return st * 1024 + (ob ^ (((ob >> 9) & 1) << 5)); }
__host__ __device__ __forceinline__ void stage_rc(int b, int& R, int& C) { const int st = b / 1024, sb = b % 1024, swz = sb ^ (((sb >> 9) & 1) << 5); R = (st >> 1) * 16 + swz / 64; C = (st & 1) * 32 + (swz % 64) / 2; }
__host__ __device__ __forceinline__ int perm32(int rho) { const int n = rho >> 4, i = rho & 15; return 8 * (i >> 2) + 4 * n + (i & 3); }

struct Unit { int pm, pn; };
struct Gemm { const bf16_t* A; const bf16_t* Bt; int M, N, K, ld; };

struct StaticOrder {
    int nM, nN, nwg, G, c;
    __host__ __device__ void init(int M, int N, int G_, int c_) { nM = M / BM; nN = N / BM; nwg = nM * nN; G = G_; c = c_; }
    __host__ __device__ bool next(int i, Unit& u) const {
        const long L = (long)i * G + c; if (L >= nwg) return false;
        int wgid = (int)L; { const int q = nwg / NXCD, r = nwg % NXCD, xcd = wgid % NXCD, off = wgid / NXCD; wgid = (xcd < r ? xcd * (q + 1) : r * (q + 1) + (xcd - r) * q) + off; }
        const int nig = WGM * nN, gid = wgid / nig, fm = gid * WGM, gsz = (nM - fm) < WGM ? (nM - fm) : WGM;
        u.pm = fm + ((wgid % nig) % gsz); u.pn = (wgid % nig) / gsz; return true;
    }
    __device__ __forceinline__ void a_ready(const Unit&) const {}
    __device__ __forceinline__ void done(const Unit&) const {}
};

__device__ __forceinline__ unsigned cvt_pk_bf16(float lo, float hi) { unsigned r; asm volatile("v_cvt_pk_bf16_f32 %0, %1, %2" : "=v"(r) : "v"(lo), "v"(hi)); return r; }
typedef float f32x2 __attribute__((ext_vector_type(2)));
template <class Epi, class Sched, bool ALIGN_EPI = false, bool SP2 = false>
__device__ __forceinline__ void gemm_phase(PG8_LAS unsigned char* lds, const Gemm g, const Sched& S, const Epi& E) {
    int tid_ = threadIdx.x; asm volatile("" : "+v"(tid_)); const int tid = tid_, wid = __builtin_amdgcn_readfirstlane(tid >> 6), lane = tid & 63, wr = wid >> 2, wc = wid & 3, fr = lane & 15, fq = lane >> 4;
    const int K = g.K, nt = K / BK, LD = g.ld;
    unsigned voffA[2], voffB[2];
#pragma unroll
    for (int i = 0; i < 2; ++i) { int R, C; stage_rc(tid * 16 + i * 8192, R, C); const int Rb = Epi::PERM ? ((R & ~31) + perm32(R & 31)) : R;
        voffA[i] = (unsigned)(R * LD + C) * 2u; voffB[i] = (unsigned)(Rb * LD + C) * 2u; }
    const size_t kstep = (size_t)(BK * 2);
    const size_t hstep = (size_t)HALF * LD * 2;
    const size_t tstep = 2 * hstep;
    const unsigned ldsw = (unsigned)wid * 1024u;
    const int aoff = lds_byte(wr * 64 + fr, fq * 8), boff = lds_byte(wc * 32 + fr, fq * 8);
#define PG8_SA(b, h) (((b) * 2 + (h)) * HTB)
#define PG8_SB(b, h) ((4 + (b) * 2 + (h)) * HTB)
#define PG8_STAGE(bufoff, gbase, voff) do { _Pragma("unroll") for (int _i = 0; _i < 2; ++_i) \
        __builtin_amdgcn_global_load_lds((const unsigned*)((const char*)(gbase) + (voff)[_i]), (PG8_LAS unsigned*)(lds + (bufoff) + ldsw + _i * 8192), 16, 0, 0); } while (0)
#define PG8_LDA(dst, b, h) do { _Pragma("unroll") for (int m = 0; m < 4; ++m) _Pragma("unroll") for (int k = 0; k < 2; ++k) dst[m][k] = *(const PG8_LAS bf16x8*)(lds + PG8_SA(b, h) + aoff + m * 2048 + k * 1024); } while (0)
#define PG8_LDB(dst, b, h) do { _Pragma("unroll") for (int n = 0; n < 2; ++n) _Pragma("unroll") for (int k = 0; k < 2; ++k) dst[n][k] = *(const PG8_LAS bf16x8*)(lds + PG8_SB(b, h) + boff + n * 2048 + k * 1024); } while (0)
#define PG8_MMA(ai, bj, At, Bt) do { __builtin_amdgcn_s_setprio(1); _Pragma("unroll") for (int m = 0; m < 4; ++m) _Pragma("unroll") for (int n = 0; n < 2; ++n) _Pragma("unroll") for (int k = 0; k < 2; ++k) \
        acc[ai][bj][m][n] = __builtin_amdgcn_mfma_f32_16x16x32_bf16(Bt[n][k], At[m][k], acc[ai][bj][m][n], 0, 0, 0); __builtin_amdgcn_s_setprio(0); } while (0)
#define PG8_WAIT_V(n) asm volatile("s_waitcnt vmcnt(" #n ")" ::: "memory")
#define PG8_WAIT_L(n) asm volatile("s_waitcnt lgkmcnt(" #n ")" ::: "memory")
#define PG8_BAR __builtin_amdgcn_s_barrier()
#define PG8_SCHED __builtin_amdgcn_sched_barrier(0)
    Unit cur, nxt; int ui = 0;
    if (!S.next(0, cur)) return;
    f32x4 acc[2][2][4][2];
#pragma unroll
    for (int a = 0; a < 2; ++a)
#pragma unroll
        for (int b = 0; b < 2; ++b)
#pragma unroll
            for (int m = 0; m < 4; ++m)
#pragma unroll
                for (int n = 0; n < 2; ++n) acc[a][b][m][n] = (f32x4){0.f, 0.f, 0.f, 0.f};
    bf16x8 At[4][2], B0[2][2], B1[2][2];
    const char* cA = (const char*)g.A + (size_t)cur.pm * tstep; const char* cB = (const char*)g.Bt + (size_t)cur.pn * tstep;
    S.a_ready(cur);
    if constexpr (SP2) {
        PG8_STAGE(PG8_SB(0, 0), cB, voffB); PG8_STAGE(PG8_SB(0, 1), cB + hstep, voffB); PG8_STAGE(PG8_SA(0, 0), cA, voffA); PG8_STAGE(PG8_SA(0, 1), cA + hstep, voffA);
        if (wr == 1) PG8_BAR;
        PG8_WAIT_V(2); PG8_BAR;
        PG8_STAGE(PG8_SB(1, 0), cB + kstep, voffB); PG8_STAGE(PG8_SA(1, 0), cA + kstep, voffA); PG8_STAGE(PG8_SB(1, 1), cB + hstep + kstep, voffB);
        PG8_WAIT_V(6); PG8_BAR;
    } else {
        PG8_STAGE(PG8_SB(0, 0), cB, voffB); PG8_STAGE(PG8_SA(0, 0), cA, voffA); PG8_STAGE(PG8_SB(0, 1), cB + hstep, voffB); PG8_STAGE(PG8_SA(0, 1), cA + hstep, voffA);
        if (wr == 1) PG8_BAR;
        PG8_WAIT_V(4); PG8_BAR;
        PG8_STAGE(PG8_SB(1, 0), cB + kstep, voffB); PG8_STAGE(PG8_SA(1, 0), cA + kstep, voffA); PG8_STAGE(PG8_SB(1, 1), cB + hstep + kstep, voffB);
        PG8_WAIT_V(6); PG8_BAR;
    }
    for (;;) {
        const bool has_next = S.next(ui + 1, nxt);
        const char* nA = has_next ? (const char*)g.A + (size_t)nxt.pm * tstep : cA; const char* nB = has_next ? (const char*)g.Bt + (size_t)nxt.pn * tstep : cB;
        for (int t = 0; t < nt; t += 2) {
            const bool last = (t == nt - 2);
            const char* a1 = cA + (size_t)(t + 1) * kstep;
            const char* a2 = last ? nA : cA + (size_t)(t + 2) * kstep; const char* b2 = last ? nB : cB + (size_t)(t + 2) * kstep;
            const char* a3 = a2 + kstep; const char* b3 = b2 + kstep;
            if (last && has_next) S.a_ready(nxt);
            if constexpr (SP2) {
            PG8_LDB(B0, 0, 0); PG8_LDB(B1, 0, 1); PG8_SCHED; PG8_LDA(At, 0, 0); PG8_STAGE(PG8_SA(1, 1), a1 + hstep, voffA);
            PG8_WAIT_V(8); PG8_WAIT_L(0); PG8_BAR; PG8_MMA(0, 0, At, B0); PG8_MMA(0, 1, At, B1); PG8_BAR; PG8_SCHED;
            PG8_LDA(At, 0, 1); PG8_STAGE(PG8_SB(0, 0), b2, voffB); PG8_STAGE(PG8_SB(0, 1), b2 + hstep, voffB); PG8_STAGE(PG8_SA(0, 0), a2, voffA);
            PG8_WAIT_V(8); PG8_WAIT_L(0); PG8_BAR; PG8_MMA(1, 0, At, B0); PG8_MMA(1, 1, At, B1); PG8_BAR; PG8_SCHED;
            PG8_LDB(B0, 1, 0); PG8_LDB(B1, 1, 1); PG8_SCHED; PG8_LDA(At, 1, 0); PG8_STAGE(PG8_SA(0, 1), a2 + hstep, voffA);
            PG8_WAIT_V(8); PG8_WAIT_L(0); PG8_BAR; PG8_MMA(0, 0, At, B0); PG8_MMA(0, 1, At, B1); PG8_BAR; PG8_SCHED;
            PG8_LDA(At, 1, 1); PG8_STAGE(PG8_SB(1, 0), b3, voffB); PG8_STAGE(PG8_SB(1, 1), b3 + hstep, voffB); PG8_STAGE(PG8_SA(1, 0), a3, voffA);
            PG8_WAIT_V(8); PG8_WAIT_L(0); PG8_BAR; PG8_MMA(1, 0, At, B0); PG8_MMA(1, 1, At, B1); PG8_BAR; PG8_SCHED;
            } else {
            PG8_LDB(B0, 0, 0); PG8_SCHED; PG8_LDA(At, 0, 0); PG8_STAGE(PG8_SA(1, 1), a1 + hstep, voffA);
            PG8_WAIT_L(8); PG8_BAR; PG8_WAIT_L(0); PG8_MMA(0, 0, At, B0); PG8_BAR; PG8_SCHED;
            PG8_LDB(B1, 0, 1); PG8_STAGE(PG8_SB(0, 0), b2, voffB);
            PG8_BAR; PG8_WAIT_L(0); PG8_MMA(0, 1, At, B1); PG8_BAR;
            PG8_LDA(At, 0, 1); PG8_STAGE(PG8_SA(0, 0), a2, voffA);
            PG8_BAR; PG8_WAIT_L(0); PG8_MMA(1, 0, At, B0); PG8_BAR; PG8_SCHED;
            PG8_STAGE(PG8_SB(0, 1), b2 + hstep, voffB);
            PG8_WAIT_V(6); PG8_BAR; PG8_MMA(1, 1, At, B1); PG8_BAR;
            PG8_LDB(B0, 1, 0); PG8_SCHED; PG8_LDA(At, 1, 0); PG8_STAGE(PG8_SA(0, 1), a2 + hstep, voffA);
            PG8_WAIT_L(8); PG8_BAR; PG8_WAIT_L(0); PG8_MMA(0, 0, At, B0); PG8_BAR; PG8_SCHED;
            PG8_LDB(B1, 1, 1); PG8_STAGE(PG8_SB(1, 0), b3, voffB);
            PG8_BAR; PG8_WAIT_L(0); PG8_MMA(0, 1, At, B1); PG8_BAR;
            PG8_LDA(At, 1, 1); PG8_STAGE(PG8_SA(1, 0), a3, voffA);
            PG8_BAR; PG8_WAIT_L(0); PG8_MMA(1, 0, At, B0); PG8_BAR; PG8_SCHED;
            PG8_STAGE(PG8_SB(1, 1), b3 + hstep, voffB);
            PG8_WAIT_V(6); PG8_BAR; PG8_MMA(1, 1, At, B1); PG8_BAR;
            }
        }
        if constexpr (ALIGN_EPI) { if (wr == 0) PG8_BAR; }
        if constexpr (!Epi::AFTER_DRAIN) { E(acc, cur, wr, wc, fr, fq); S.done(cur); }
        if (!has_next) break;
#pragma unroll
        for (int a = 0; a < 2; ++a)
#pragma unroll
            for (int b = 0; b < 2; ++b)
#pragma unroll
                for (int m = 0; m < 4; ++m)
#pragma unroll
                    for (int n = 0; n < 2; ++n) acc[a][b][m][n] = (f32x4){0.f, 0.f, 0.f, 0.f};
        cur = nxt; cA = nA; cB = nB; ++ui;
        if constexpr (ALIGN_EPI) { if (wr == 1) PG8_BAR; }
    }
    PG8_WAIT_V(0);
    if constexpr (!ALIGN_EPI) { if (wr == 0) PG8_BAR; }
    PG8_BAR;
    if constexpr (Epi::AFTER_DRAIN) { E.fused(acc, cur, wr, wc, fr, fq, lds, wid, lane); S.done(cur); }
#undef PG8_SA
#undef PG8_SB
#undef PG8_STAGE
#undef PG8_LDA
#undef PG8_LDB
#undef PG8_MMA
#undef PG8_WAIT_V
#undef PG8_WAIT_L
#undef PG8_BAR
#undef PG8_SCHED
}
}
#define GAS __attribute__((address_space(1)))
#define LAS __attribute__((address_space(3)))
typedef GAS unsigned gu32;
typedef GAS unsigned long long gu64;
#define RLX_AGENT __ATOMIC_RELAXED, __HIP_MEMORY_SCOPE_AGENT
#define LDS_WAIT() asm volatile("s_waitcnt lgkmcnt(0)" ::: "memory")
#define VM_WAIT() asm volatile("s_waitcnt vmcnt(0)" ::: "memory")
__device__ __forceinline__ unsigned long long rt() { return __builtin_amdgcn_s_memrealtime(); }
#define XB_TMO      128
#define XB_XCNT(j)  (256  + 64 * (j))
#define XB_XSUB(j)  (1280 + 64 * (j))
#define XB_XGEN(j)  (2304 + 64 * (j))
#define XB_TOP      3328
#define XB_TOPGEN   3392
#define XCD_BAR_WORDS 3456
#define XB_SPIN_CAP (1u << 18)

__device__ __forceinline__ unsigned xb_ld(unsigned* p)              { return __hip_atomic_load(p, __ATOMIC_RELAXED, __HIP_MEMORY_SCOPE_AGENT); }
__device__ __forceinline__ unsigned xb_add(unsigned* p, unsigned v) { return __hip_atomic_fetch_add(p, v, __ATOMIC_RELAXED, __HIP_MEMORY_SCOPE_AGENT); }
__device__ __forceinline__ unsigned xb_xcc_id() { return (unsigned)__builtin_amdgcn_s_getreg((3 << 11) | 20) & 0xFu; }
#define XB_SPIN(cond, bar) do { unsigned _sp = 0; while (cond) { __builtin_amdgcn_s_sleep(1); \
    if ((++_sp & 255u) == 0u) { if (xb_ld(&(bar)[XB_TMO])) break; if (_sp > XB_SPIN_CAP) { atomicAdd(&(bar)[XB_TMO], 1u); break; } } } } while (0)

struct XcdBarrier {
    unsigned* bar; unsigned x;
    volatile LAS unsigned* st;
};

__device__ __forceinline__ XcdBarrier xcd_barrier_post(unsigned* bar, volatile LAS unsigned* st) {
    XcdBarrier b; b.bar = bar; b.x = xb_xcc_id(); b.st = st;
    if (threadIdx.x == 0) (void)xb_add(&bar[XB_XCNT(b.x)], 1u);
    return b;
}
__device__ __forceinline__ void xcd_barrier_complete(unsigned* bar, unsigned x, unsigned& nloc, unsigned& nx) {
    const unsigned G = gridDim.x * gridDim.y * gridDim.z;
    unsigned sum, cnt, mine, sp = 0u;
    for (;;) {
        sum = 0u; cnt = 0u; mine = 0u;
#pragma unroll
        for (unsigned j = 0; j < 16; ++j) { const unsigned c = xb_ld(&bar[XB_XCNT(j)]); sum += c; cnt += (c > 0u) ? 1u : 0u; mine = (j == x) ? c : mine; }
        if (sum == G) break;
        __builtin_amdgcn_s_sleep(1);
        if ((++sp & 255u) == 0u) { if (xb_ld(&bar[XB_TMO])) break; if (sp > XB_SPIN_CAP) { atomicAdd(&bar[XB_TMO], 1u); break; } }
    }
    nloc = mine > 0u ? mine : 1u; nx = cnt > 0u ? cnt : 1u;
}

__device__ __forceinline__ void xcd_barrier(const XcdBarrier& b) {
    asm volatile("s_waitcnt vmcnt(0)" ::: "memory");
    __syncthreads();
    if (threadIdx.x == 0) {
        unsigned* bar = b.bar;
        __builtin_amdgcn_s_waitcnt(0);
        unsigned nloc = b.st[0], nx = b.st[1];
        if (nloc == 0u) { xcd_barrier_complete(bar, b.x, nloc, nx); b.st[0] = nloc; b.st[1] = nx; }
        const unsigned old = xb_add(&bar[XB_XSUB(b.x)], 1u);
        const unsigned gen = old / nloc;
        if (old + 1u == (gen + 1u) * nloc) {
            __builtin_amdgcn_fence(__ATOMIC_RELEASE, "agent");
            asm volatile("s_waitcnt vmcnt(0)" ::: "memory");
            const unsigned og = xb_add(&bar[XB_TOP], 1u);
            const unsigned tg = og / nx;
            if (og + 1u == (tg + 1u) * nx) xb_add(&bar[XB_TOPGEN], 1u);
            else XB_SPIN(xb_ld(&bar[XB_TOPGEN]) == tg, bar);
            __builtin_amdgcn_fence(__ATOMIC_ACQUIRE, "agent");
            xb_add(&bar[XB_XGEN(b.x)], 1u);
            asm volatile("s_waitcnt vmcnt(0)" ::: "memory");
        } else {
            XB_SPIN(xb_ld(&bar[XB_XGEN(b.x)]) == gen, bar);
            __builtin_amdgcn_fence(__ATOMIC_ACQUIRE, "agent");
            asm volatile("s_waitcnt vmcnt(0)" ::: "memory");
        }
    }
    __syncthreads();
}


constexpr int NB = 2, SEQ = 8192, DM = 1024, DEPTH = 4, NMETA = 16, LP = 8320, M = NB * LP;
constexpr int N_IN = 5384, N1 = 5376, NRW = 1792, NGT = 2048, DFF = 2816, NUP = 5632;
constexpr float LOG2E = 1.4426950408889634f;
constexpr float QSCALE = 0.125f * LOG2E;
constexpr float THR2 = 24.0f * LOG2E;
constexpr int NWAVES = 8, NTHR = 512, MMAIN = 16384;
constexpr int LDS_BYTES = 147456, MISC_OFF = 147456 - 128;

typedef unsigned short bf16;
typedef float f32x4 __attribute__((ext_vector_type(4)));
typedef unsigned u32x4 __attribute__((ext_vector_type(4)));
typedef unsigned u32x2 __attribute__((ext_vector_type(2)));
typedef short bf16x8 __attribute__((ext_vector_type(8)));

constexpr size_t SZ_H = (size_t)M * DM * 4, SZ_X512 = (size_t)M * 512 * 2;
constexpr size_t OFF_CTL = 0, OFF_H = 1u << 20, OFF_WT = OFF_H + SZ_H;
constexpr size_t WT_IN = 0, WT_BF = WT_IN + (size_t)N1 * 1024, WT_BR = WT_BF + 1024 * 512, WT_O = WT_BR + 1024 * 512,
                 WT_UP = WT_O + 1024 * 1024, WT_DN = WT_UP + (size_t)NUP * 1024, WT_LW = WT_DN + (size_t)1024 * DFF, WT_LA = WT_LW + 512 * 64, WT_LG = WT_LA + 512 * 64, WT_END = WT_LG + 512 * 128;
constexpr size_t OFF_HN = OFF_WT + WT_END * 2;
constexpr size_t OFF_Q = OFF_HN + 2 * SZ_X512, OFF_K = OFF_Q + SZ_X512, OFF_V = OFF_K + SZ_X512;
constexpr size_t OFF_RW = OFF_V + SZ_X512, OFF_GT = OFF_RW + (size_t)M * NRW * 2, OFF_MISC = OFF_GT + (size_t)M * NGT * 2;
constexpr size_t OFF_T0 = OFF_MISC + 2 * 16 * LP * 4, OFF_OF = OFF_T0 + 2 * SZ_X512, OFF_TAIL = OFF_OF + SZ_X512, WS_NEED = OFF_TAIL + 256 * 1024 * 2;
static_assert(OFF_HN % 256 == 0 && OFF_RW % 256 == 0 && OFF_T0 % 256 == 0, "alignment");

struct Params { const float* in[26]; float* out; unsigned char* ws; };
struct Ctx { int tid, lane, wave, bid, G; unsigned char* lds; unsigned char* ws; };

__device__ __forceinline__ float bf2f(unsigned b) { return __uint_as_float(b << 16); }
__device__ __forceinline__ float bflo(unsigned w) { return __uint_as_float(w << 16); }
__device__ __forceinline__ float bfhi(unsigned w) { return __uint_as_float(w & 0xffff0000u); }
typedef float f32x2_t_ __attribute__((ext_vector_type(2))); typedef __bf16 bf16x2_t_ __attribute__((ext_vector_type(2)));
__device__ __forceinline__ unsigned pk2(float lo, float hi) { const f32x2_t_ v = {lo, hi}; const bf16x2_t_ r = __builtin_convertvector(v, bf16x2_t_); return __builtin_bit_cast(unsigned, r); }
__device__ __forceinline__ unsigned f2bf(float f) { return pk2(f, 0.f) & 0xffffu; }
__device__ __forceinline__ float wave_sum(float v) {
#pragma unroll
    for (int o = 1; o < 64; o <<= 1) v += __shfl_xor(v, o);
    return v;
}
__device__ __forceinline__ float sigmoidf_(float x) { return __builtin_amdgcn_rcpf(1.f + __expf(-x)); }
template <int CTRL> __device__ __forceinline__ float dppf(float old, float x) {
    return __int_as_float(__builtin_amdgcn_update_dpp(__float_as_int(old), __float_as_int(x), CTRL, 0xf, 0xf, false));
}
__device__ __forceinline__ float allreduce16(float x) {
    x += dppf<0x121>(0.f, x); x += dppf<0x122>(0.f, x); x += dppf<0x124>(0.f, x); x += dppf<0x128>(0.f, x); return x;
}

namespace pg8 {
struct EpiRoute {
    static constexpr bool PERM = true, AFTER_DRAIN = false;
    unsigned char* ws;
    __device__ __forceinline__ void operator()(const f32x4 (&acc)[2][2][4][2], const Unit& u, int wr, int wc, int fr, int fq) const {
        const int pn = u.pn; size_t off; int ldc, colt;
        if (pn < 6) { off = OFF_Q + (size_t)(pn >> 1) * SZ_X512; ldc = 512; colt = (pn & 1) * 256; }
        else if (pn < 13) { off = OFF_RW; ldc = NRW; colt = (pn - 6) * 256; }
        else { off = OFF_GT; ldc = NGT; colt = (pn - 13) * 256; }
        bf16_t* base = (bf16_t*)(ws + off);
        const int row0 = u.pm * BM + wr * 64 + fr, col0 = colt + wc * 32 + 8 * fq;
#pragma unroll
        for (int ai = 0; ai < 2; ++ai)
#pragma unroll
            for (int m = 0; m < 4; ++m) { bf16_t* rowp = base + (size_t)(row0 + ai * HALF + m * 16) * ldc + col0;
#pragma unroll
                for (int bj = 0; bj < 2; ++bj) { const f32x4 v0 = acc[ai][bj][m][0], v1 = acc[ai][bj][m][1];
                    u32x4 w; w.x = cvt_pk_bf16(v0[0], v0[1]); w.y = cvt_pk_bf16(v0[2], v0[3]); w.z = cvt_pk_bf16(v1[0], v1[1]); w.w = cvt_pk_bf16(v1[2], v1[3]);
                    *(u32x4*)(rowp + bj * HALF) = w; } }
    }
};
struct EpiGateR {
    static constexpr bool PERM = true, AFTER_DRAIN = false;
    bf16_t* O; const bf16_t* GT; const float* gb; int goff, accum;
    __device__ __forceinline__ void operator()(const f32x4 (&acc)[2][2][4][2], const Unit& u, int wr, int wc, int fr, int fq) const {
        const int row0 = u.pm * BM + wr * 64 + fr, col0 = u.pn * BM + wc * 32 + 8 * fq;
#pragma unroll
        for (int bj = 0; bj < 2; ++bj) {
            const int c = col0 + bj * HALF;
            const f32x4 b0 = *(const f32x4*)(gb + goff + c), b1 = *(const f32x4*)(gb + goff + c + 4);
#pragma unroll
            for (int ai = 0; ai < 2; ++ai)
#pragma unroll
                for (int m = 0; m < 4; ++m) {
                    const size_t row = (size_t)(row0 + ai * HALF + m * 16);
                    const u32x4 gw = *(const u32x4*)(GT + row * NGT + goff + c);
                    const f32x4 v0 = acc[ai][bj][m][0], v1 = acc[ai][bj][m][1];
                    float r[8];
                    r[0] = sigmoidf_(bflo(gw.x) + b0[0]) * v0[0]; r[1] = sigmoidf_(bfhi(gw.x) + b0[1]) * v0[1];
                    r[2] = sigmoidf_(bflo(gw.y) + b0[2]) * v0[2]; r[3] = sigmoidf_(bfhi(gw.y) + b0[3]) * v0[3];
                    r[4] = sigmoidf_(bflo(gw.z) + b1[0]) * v1[0]; r[5] = sigmoidf_(bfhi(gw.z) + b1[1]) * v1[1];
                    r[6] = sigmoidf_(bflo(gw.w) + b1[2]) * v1[2]; r[7] = sigmoidf_(bfhi(gw.w) + b1[3]) * v1[3];
                    bf16_t* op = O + row * 1024 + c;
                    if (accum) { const u32x4 ow = *(const u32x4*)op;
                        r[0] += bflo(ow.x); r[1] += bfhi(ow.x); r[2] += bflo(ow.y); r[3] += bfhi(ow.y); r[4] += bflo(ow.z); r[5] += bfhi(ow.z); r[6] += bflo(ow.w); r[7] += bfhi(ow.w); }
                    u32x4 w; w.x = cvt_pk_bf16(r[0], r[1]); w.y = cvt_pk_bf16(r[2], r[3]); w.z = cvt_pk_bf16(r[4], r[5]); w.w = cvt_pk_bf16(r[6], r[7]);
                    *(u32x4*)op = w;
                }
        }
    }
};
struct EpiResid {
    static constexpr bool PERM = false, AFTER_DRAIN = false;
    float* H; float* OUT; int atomic;
    __device__ __forceinline__ void operator()(const f32x4 (&acc)[2][2][4][2], const Unit& u, int wr, int wc, int fr, int fq) const {
        const int row0 = u.pm * BM + wr * 64 + fr, col0 = u.pn * BM + wc * 32 + 4 * fq;
#pragma unroll
        for (int ai = 0; ai < 2; ++ai)
#pragma unroll
            for (int m = 0; m < 4; ++m) {
                const int row = row0 + ai * HALF + m * 16;
                float* hp = H + (size_t)row * DM + col0;
                const int b = row >= LP ? 1 : 0, t = row - b * LP;
                float* op = (OUT && t >= NMETA && t < NMETA + SEQ) ? OUT + ((size_t)b * SEQ + (t - NMETA)) * DM + col0 : nullptr;
#pragma unroll
                for (int bj = 0; bj < 2; ++bj)
#pragma unroll
                    for (int n = 0; n < 2; ++n) { const int co = bj * HALF + n * 16;
                        if (atomic) {
                            if (row < LP + NMETA + SEQ) {
#pragma unroll
                                for (int e = 0; e < 4; ++e) unsafeAtomicAdd(hp + co + e, acc[ai][bj][m][n][e]); }
                        } else {
                            const f32x4 v = *(const f32x4*)(hp + co) + acc[ai][bj][m][n];
                            if (OUT) { if (op) *(f32x4*)(op + co) = v; } else *(f32x4*)(hp + co) = v; } }
            }
    }
};
struct EpiResidAtomic {
    static constexpr bool PERM = false, AFTER_DRAIN = false;
    float* H;
    __device__ __forceinline__ void operator()(const f32x4 (&acc)[2][2][4][2], const Unit& u, int wr, int wc, int fr, int fq) const {
        const int row0 = u.pm * BM + wr * 64 + fr, col0 = u.pn * BM + wc * 32 + 4 * fq;
#pragma unroll
        for (int ai = 0; ai < 2; ++ai)
#pragma unroll
            for (int m = 0; m < 4; ++m) { float* hp = H + (size_t)(row0 + ai * HALF + m * 16) * DM + col0;
#pragma unroll
                for (int bj = 0; bj < 2; ++bj)
#pragma unroll
                    for (int n = 0; n < 2; ++n)
#pragma unroll
                        for (int e = 0; e < 4; ++e) unsafeAtomicAdd(hp + bj * HALF + n * 16 + e, acc[ai][bj][m][n][e]); }
    }
};
struct OneUnit {
    StaticOrder so; int mode, pm, pn; bool active;
    __device__ bool next(int i, Unit& u) const { if (mode == 0) return so.next(i, u); if (i != 0 || !active) return false; u.pm = pm; u.pn = pn; return true; }
    __device__ __forceinline__ void a_ready(const Unit&) const {}
    __device__ __forceinline__ void done(const Unit&) const {}
};
struct EpiUp {
    static constexpr bool PERM = true, AFTER_DRAIN = false;
    bf16_t* ACT; bf16_t* HALO; const float* cw;
    __device__ __forceinline__ void operator()(const f32x4 (&acc)[2][2][4][2], const Unit& u, int wr, int wc, int fr, int fq) const {
        const int chan0 = u.pn * 128 + wc * 32 + 8 * fq;
#pragma unroll
        for (int n = 0; n < 2; ++n) {
            const int ch = chan0 + 4 * n;
            f32x4 w[3][2];
#pragma unroll
            for (int j = 0; j < 3; ++j) { w[j][0] = *(const f32x4*)(cw + j * NUP + ch); w[j][1] = *(const f32x4*)(cw + j * NUP + DFF + ch); }
#pragma unroll
            for (int ai = 0; ai < 2; ++ai) {
                const int rowg = u.pm * BM + ai * HALF + wr * 64;
#pragma unroll
                for (int m = 0; m < 4; ++m) {
                    f32x4 uc[2];
#pragma unroll
                    for (int bj = 0; bj < 2; ++bj) {
                        const f32x4 cur = acc[ai][bj][m][n];
                        f32x4 prv; if (m > 0) prv = acc[ai][bj][m - 1][n]; else prv = (f32x4){0.f, 0.f, 0.f, 0.f};
                        f32x4 p1, p2;
#pragma unroll
                        for (int i = 0; i < 4; ++i) {
                            const float r1 = dppf<0x121>(0.f, prv[i]), r2 = dppf<0x122>(0.f, prv[i]);
                            p1[i] = dppf<0x111>(r1, cur[i]); p2[i] = dppf<0x112>(r2, cur[i]);
                        }
                        uc[bj] = w[0][bj] * p2 + w[1][bj] * p1 + w[2][bj] * cur;
                    }
                    float a[4];
#pragma unroll
                    for (int i = 0; i < 4; ++i) a[i] = uc[0][i] * sigmoidf_(uc[0][i]) * uc[1][i];
                    u32x2 o; o.x = cvt_pk_bf16(a[0], a[1]); o.y = cvt_pk_bf16(a[2], a[3]);
                    *(u32x2*)(ACT + (size_t)(rowg + m * 16 + fr) * DFF + ch) = o;
                    if ((m == 3 && fr >= 14) || (m == 0 && fr < 2)) {
                        const int slot = (rowg >> 6) * 4 + (m == 3 ? fr - 14 : 2 + fr);
#pragma unroll
                        for (int bj = 0; bj < 2; ++bj) { const f32x4 cur = acc[ai][bj][m][n]; u32x2 hw; hw.x = cvt_pk_bf16(cur[0], cur[1]); hw.y = cvt_pk_bf16(cur[2], cur[3]);
                            *(u32x2*)(HALO + (size_t)slot * NUP + bj * DFF + ch) = hw; }
                    }
                }
            }
        }
    }
};
}

#ifndef REP_PREP
#define REP_PREP 1
#endif
#ifndef REP_P3
#define REP_P3 1
#endif
#ifndef REP_SYNC
#define REP_SYNC 0
#endif
#define GLD(T, p) (*(const __attribute__((address_space(1))) T*)(p))
#define GST(T, p) (*(__attribute__((address_space(1))) T*)(p))
#define LDS_BARRIER() do { asm volatile("s_waitcnt lgkmcnt(0)" ::: "memory"); __builtin_amdgcn_s_barrier(); asm volatile("" ::: "memory"); } while (0)
__device__ __forceinline__ void transpose_item(const float* W, int Nsrc, int K, bf16* WT, int dst_row0, int src_col0, int k0, float* scr, int lane) {
#pragma unroll 8
    for (int i = 0; i < 32; ++i) { const int kk = 2 * i + (lane >> 5); scr[kk * 33 + (lane & 31)] = W[(size_t)(k0 + kk) * Nsrc + src_col0 + (lane & 31)]; }
    asm volatile("s_waitcnt lgkmcnt(0)" ::: "memory");
    const int c = lane & 7;
#pragma unroll
    for (int j = 0; j < 4; ++j) { const int n = (lane >> 3) + 8 * j; const float* s = scr + (8 * c) * 33 + n;
        u32x4 o; o.x = pk2(s[0 * 33], s[1 * 33]); o.y = pk2(s[2 * 33], s[3 * 33]); o.z = pk2(s[4 * 33], s[5 * 33]); o.w = pk2(s[6 * 33], s[7 * 33]);
        *(u32x4*)(WT + (size_t)(dst_row0 + n) * K + k0 + 8 * c) = o; }
    asm volatile("s_waitcnt lgkmcnt(0)" ::: "memory");
}
__device__ __forceinline__ void convert_weights(const Params& P, int l, const Ctx& c) {
    bf16* WT = (bf16*)(c.ws + OFF_WT);
    float* scr = (float*)(c.lds + c.wave * 16384);
    const int gw = c.bid * NWAVES + c.wave, NGW = c.G * NWAVES;
    constexpr int I_IN = 16 * 168, I_BF = 8 * 32, I_O = 16 * 32, I_UP = 16 * 176, I_DN = 44 * 32, I_LR = 16, I_LG = 32, I_ALL = I_IN + 2 * I_BF + I_O + I_UP + I_DN + 2 * I_LR + I_LG;
    for (int it = gw; it < I_ALL; it += NGW) {
        int r = it;
        if (r < I_IN) { const int kb = r / 168, n0 = 32 * (r % 168); transpose_item(P.in[4] + (size_t)l * 1024 * N_IN, N_IN, 1024, WT + WT_IN, n0, n0 + (n0 >= 1536 ? 8 : 0), 64 * kb, scr, c.lane); continue; } r -= I_IN;
        if (r < I_BF) { const int kb = r / 32, n0 = 32 * (r % 32); transpose_item(P.in[19] + (size_t)l * 512 * 1024, 1024, 512, WT + WT_BF, n0, n0, 64 * kb, scr, c.lane); continue; } r -= I_BF;
        if (r < I_BF) { const int kb = r / 32, n0 = 32 * (r % 32); transpose_item(P.in[20] + (size_t)l * 512 * 1024, 1024, 512, WT + WT_BR, n0, n0, 64 * kb, scr, c.lane); continue; } r -= I_BF;
        if (r < I_O) { const int kb = r / 32, n0 = 32 * (r % 32); transpose_item(P.in[22] + (size_t)l * 1024 * 1024, 1024, 1024, WT + WT_O, n0, n0, 64 * kb, scr, c.lane); continue; } r -= I_O;
        if (r < I_UP) { const int kb = r / 176, n0 = 32 * (r % 176); const int pn = n0 >> 8, bj = (n0 >> 7) & 1, x = n0 & 127;
            transpose_item(P.in[23] + (size_t)l * 1024 * NUP, NUP, 1024, WT + WT_UP, n0, bj * DFF + 128 * pn + x, 64 * kb, scr, c.lane); continue; } r -= I_UP;
        if (r < I_DN) { const int kb = r / 32, n0 = 32 * (r % 32); transpose_item(P.in[25] + (size_t)l * DFF * 1024, 1024, DFF, WT + WT_DN, n0, n0, 64 * kb, scr, c.lane); continue; } r -= I_DN;
        if (r < I_LR) { transpose_item(P.in[10] + (size_t)l * 64 * 512, 512, 64, WT + WT_LW, 32 * r, 32 * r, 0, scr, c.lane); continue; } r -= I_LR;
        if (r < I_LR) { transpose_item(P.in[12] + (size_t)l * 64 * 512, 512, 64, WT + WT_LA, 32 * r, 32 * r, 0, scr, c.lane); continue; } r -= I_LR;
        { const int kb = r / 16, n0 = 32 * (r % 16); transpose_item(P.in[13] + (size_t)l * 128 * 512, 512, 128, WT + WT_LG, n0, n0, 64 * kb, scr, c.lane); }
    }
}

template <bool FG> __device__ __forceinline__ void phase_norm(const Params& P, int l, const Ctx& c) {
    float* H = (float*)(c.ws + OFF_H); bf16* HN = (bf16*)(c.ws + OFF_HN);
    float* LOGF = (float*)(c.ws + OFF_MISC);
    const float* gain = (FG ? P.in[2] : P.in[3]) + l * DM;
    float* wfs = (float*)c.lds;
    if (FG) {
        __syncthreads();
        const float* win = P.in[4] + (size_t)l * 1024 * N_IN + 1536;
        for (int i = c.tid; i < 8192; i += NTHR) wfs[i] = win[(size_t)(i >> 3) * N_IN + (i & 7)];
        __syncthreads();
    }
    const int gw = c.bid * NWAVES + c.wave, NGW = c.G * NWAVES;
    for (int m = gw; m < M; m += NGW) {
        const int b = m >= LP ? 1 : 0, t = m - b * LP;
        f32x4 v[4];
        if (FG && l == 0) {
            const float* src = (t < NMETA) ? P.in[1] + (size_t)t * DM : P.in[0] + ((size_t)b * SEQ + (t - NMETA)) * DM;
            const bool real = t < NMETA + SEQ;
#pragma unroll
            for (int j = 0; j < 4; ++j) { v[j] = real ? *(const f32x4*)(src + 4 * c.lane + 256 * j) : (f32x4){0.f, 0.f, 0.f, 0.f}; *(f32x4*)(H + (size_t)m * DM + 4 * c.lane + 256 * j) = v[j]; }
        } else {
#pragma unroll
            for (int j = 0; j < 4; ++j) v[j] = *(const f32x4*)(H + (size_t)m * DM + 4 * c.lane + 256 * j);
        }
        float ss = 0.f;
#pragma unroll
        for (int j = 0; j < 4; ++j) ss += (v[j].x * v[j].x + v[j].y * v[j].y) + (v[j].z * v[j].z + v[j].w * v[j].w);
        const float rstd = 1.0f / sqrtf(wave_sum(ss) * (1.f / DM) + 1e-6f);
        float f[8];
#pragma unroll
        for (int q = 0; q < 8; ++q) f[q] = 0.f;
#pragma unroll
        for (int j = 0; j < 4; ++j) {
            const f32x4 g = *(const f32x4*)(gain + 4 * c.lane + 256 * j);
            v[j] = v[j] * rstd * g;
            u32x2 o; o.x = pk2(v[j].x, v[j].y); o.y = pk2(v[j].z, v[j].w);
            *(u32x2*)(HN + (size_t)m * DM + 4 * c.lane + 256 * j) = o;
            if (FG) {
#pragma unroll
                for (int e = 0; e < 4; ++e) { const int k = 4 * c.lane + 256 * j + e; const f32x4 w0 = *(const f32x4*)(wfs + k * 8), w1 = *(const f32x4*)(wfs + k * 8 + 4);
                    const float hv = v[j][e];
                    f[0] += hv * w0.x; f[1] += hv * w0.y; f[2] += hv * w0.z; f[3] += hv * w0.w; f[4] += hv * w1.x; f[5] += hv * w1.y; f[6] += hv * w1.z; f[7] += hv * w1.w; }
            }
        }
        if (FG) {
#pragma unroll
            for (int q = 0; q < 8; ++q) f[q] = wave_sum(f[q]);
            float fv = f[0];
#pragma unroll
            for (int q = 1; q < 8; ++q) fv = (c.lane == q) ? f[q] : fv;
            if (c.lane < 8) { const float x = fv + P.in[7][l * 8 + c.lane]; const float ls = fminf(x, 0.f) - __logf(1.f + __expf(-fabsf(x))); LOGF[(size_t)(b * 8 + c.lane) * LP + t] = ls; }
        }
    }
}

__device__ __forceinline__ void phase_fcum(const Params& P, const Ctx& c) {
    const int s = c.bid - (c.G - 16);
    if (s < 0) return;
    const float* LOGF = (const float*)(c.ws + OFF_MISC) + (size_t)s * LP; float* FC = (float*)(c.ws + OFF_MISC) + 16 * LP + (size_t)s * LP;
    float* wt = (float*)c.lds;
    const int base = c.tid * 17;
    float v[17]; float run = 0.f;
#pragma unroll
    for (int i = 0; i < 17; ++i) { const int idx = base + i; const float x = (idx < LP) ? LOGF[idx] : 0.f; run += x; v[i] = run; }
    float incl = run;
#pragma unroll
    for (int o = 1; o < 64; o <<= 1) { const float t = __shfl_up(incl, o); if (c.lane >= o) incl += t; }
    if (c.lane == 63) wt[c.wave] = incl;
    __syncthreads();
    float off = incl - run;
#pragma unroll
    for (int w2 = 0; w2 < 8; ++w2) off += (w2 < c.wave) ? wt[w2] : 0.f;
#pragma unroll
    for (int i = 0; i < 17; ++i) { const int idx = base + i; if (idx < LP) FC[idx] = (v[i] + off) * LOG2E; }
    __syncthreads();
}

__device__ __forceinline__ void phase_qknorm(const Params& P, int l, const Ctx& c) {
    bf16* Q = (bf16*)(c.ws + OFF_Q); bf16* K = (bf16*)(c.ws + OFF_K);
    const int gw = c.bid * NWAVES + c.wave, NGW = c.G * NWAVES;
    const int d0 = (c.lane & 7) * 8;
    float gq[8], gk[8];
#pragma unroll
    for (int i = 0; i < 8; ++i) { gq[i] = P.in[5][l * 64 + d0 + i] * QSCALE; gk[i] = P.in[6][l * 64 + d0 + i]; }
    for (int m = gw; m < M; m += NGW) {
#pragma unroll
        for (int which = 0; which < 2; ++which) {
            bf16* p = (which ? K : Q) + (size_t)m * 512 + 8 * c.lane;
            const u32x4 w = *(const u32x4*)p;
            float x[8] = {bflo(w.x), bfhi(w.x), bflo(w.y), bfhi(w.y), bflo(w.z), bfhi(w.z), bflo(w.w), bfhi(w.w)};
            float ss = 0.f;
#pragma unroll
            for (int i = 0; i < 8; ++i) ss += x[i] * x[i];
            ss += __shfl_xor(ss, 1); ss += __shfl_xor(ss, 2); ss += __shfl_xor(ss, 4);
            const float rs = 1.0f / sqrtf(ss * (1.f / 64.f) + 1e-6f);
#pragma unroll
            for (int i = 0; i < 8; ++i) x[i] = x[i] * rs * (which ? gk[i] : gq[i]);
            u32x4 o; o.x = pk2(x[0], x[1]); o.y = pk2(x[2], x[3]); o.z = pk2(x[4], x[5]); o.w = pk2(x[6], x[7]);
            *(u32x4*)p = o;
        }
    }
}

constexpr int NCHK = LP / 64;
constexpr int NUNIT = NB * NCHK * 8;
constexpr int UNIT_A = 16384, UNIT_B = 16640;
constexpr int ST = 72, STG = 136;
constexpr int L_F0 = 92160, L_F1 = 108544;
struct RwkvBufs { bf16 *BON, *G; unsigned char *UA, *UB; float* Y; bf16* ORW; };
__device__ __forceinline__ RwkvBufs rwkv_bufs(const Params& P, const Ctx& c) {
    RwkvBufs r; r.BON = (bf16*)(c.ws + OFF_HN); r.G = r.BON + (size_t)M * 512;
    r.UA = c.ws + OFF_T0; r.UB = (unsigned char*)P.out;
    r.Y = (float*)(c.ws + OFF_RW); r.ORW = (bf16*)(c.ws + OFF_RW + (size_t)M * 512 * 4);
    return r;
}
__device__ __forceinline__ void mm_tile(const bf16* A, int sa, const bf16* Bt, int sb, int nks, f32x4 (&acc)[2], int w, int lq, int g) {
    const int mt = w >> 1, nt0 = 2 * (w & 1);
    for (int ks = 0; ks < nks; ++ks) {
        const bf16x8 a = *(const bf16x8*)(A + (16 * mt + lq) * sa + 32 * ks + 8 * g);
#pragma unroll
        for (int q = 0; q < 2; ++q) { const bf16x8 b = *(const bf16x8*)(Bt + (16 * (nt0 + q) + lq) * sb + 32 * ks + 8 * g); acc[q] = __builtin_amdgcn_mfma_f32_16x16x32_bf16(a, b, acc[q], 0, 0, 0); }
    }
}
template <bool SA, bool SB> __device__ __forceinline__ void mm_tile2(const bf16* A, int sa, const bf16* Bt, int sb, int nks, f32x4 (&acc)[2], int w, int lq, int g) {
    const int mt = w >> 1, nt0 = 2 * (w & 1);
    const int ra = 16 * mt + lq, xa = SA ? 8 * ((ra >> 3) & 7) : 0;
    for (int ks = 0; ks < nks; ++ks) {
        const bf16x8 a = *(const bf16x8*)(A + ra * sa + ((32 * ks + 8 * g) ^ xa));
#pragma unroll
        for (int q = 0; q < 2; ++q) { const int rb = 16 * (nt0 + q) + lq, xb = SB ? 8 * ((rb >> 3) & 7) : 0;
            const bf16x8 bb = *(const bf16x8*)(Bt + rb * sb + ((32 * ks + 8 * g) ^ xb)); acc[q] = __builtin_amdgcn_mfma_f32_16x16x32_bf16(a, bb, acc[q], 0, 0, 0); }
    }
}
#define ZACC(a) do { a[0] = (f32x4){0.f, 0.f, 0.f, 0.f}; a[1] = (f32x4){0.f, 0.f, 0.f, 0.f}; } while (0)
__device__ __forceinline__ int permk(int k) { return 32 * (k >> 5) + 8 * ((k & 15) >> 2) + 4 * ((k >> 4) & 1) + (k & 3); }
__device__ __forceinline__ int swz(int row, int col) { return row * 128 + ((((col >> 3) ^ (row >> 1)) & 7) << 4) + (col & 7) * 2; }

__device__ __forceinline__ void rwkv_prep_unit(const Params& P, int l, const Ctx& c, int u, const RwkvBufs& B, const float (&pw0)[8], const float (&pa0)[8], const float (&pkk)[8], const float (&pka)[8], const float (&prk)[8]) {
    const int h = u & 7, bc = u >> 3, b = bc / NCHK, ch = bc - b * NCHK;
    const size_t m0 = (size_t)b * LP + ch * 64;
    int tid_ = c.tid; asm volatile("" : "+v"(tid_));
    const int tid = tid_, lane = tid & 63, w = c.wave, lq = lane & 15, g = lane >> 4;
    const int t = tid >> 3, cg = tid & 7, c0 = cg * 8, jb = h * 64 + c0;
    unsigned char* L = c.lds;
    bf16* A0 = (bf16*)L; bf16* A1 = A0 + 4608; bf16* A2 = A1 + 4608; bf16* A3 = A2 + 4608; bf16* A4 = A3 + 4608; bf16* A5 = A4 + 4608; bf16* A6 = A5 + 4608;
    bf16* A7 = A6 + 4608; bf16* A8 = A7 + 4608; bf16* A9 = A8 + 4608;
    float* F0 = (float*)(L + L_F0); float* F1 = (float*)(L + L_F1);
    const bf16* RW = (const bf16*)(c.ws + OFF_RW);
    const bf16* WT = (const bf16*)(c.ws + OFF_WT);
    const float* mu = P.in[8] + l * NRW;
    const bool first = (ch == 0 && t == 0);
    const bf16* cur = RW + (m0 + t) * NRW; const bf16* prv = cur - NRW;
    float zr[8], zk[8], zv[8];
#pragma unroll
    for (int s = 0; s < 3; ++s) {
        const u32x4 cw = *(const u32x4*)(cur + s * 512 + jb); u32x4 pw = (u32x4){0u, 0u, 0u, 0u}; if (!first) pw = *(const u32x4*)(prv + s * 512 + jb);
        const float cv[8] = {bflo(cw.x), bfhi(cw.x), bflo(cw.y), bfhi(cw.y), bflo(cw.z), bfhi(cw.z), bflo(cw.w), bfhi(cw.w)};
        const float pv[8] = {bflo(pw.x), bfhi(pw.x), bflo(pw.y), bfhi(pw.y), bflo(pw.z), bfhi(pw.z), bflo(pw.w), bfhi(pw.w)};
#pragma unroll
        for (int i = 0; i < 8; ++i) { const float z = cv[i] + mu[s * 512 + jb + i] * (pv[i] - cv[i]); if (s == 0) zr[i] = z; else if (s == 1) zk[i] = z; else zv[i] = z; }
    }
#pragma unroll
    for (int q4 = 0; q4 < 4; ++q4) {
        const int col = cg * 32 + q4 * 8;
        const u32x4 cw = *(const u32x4*)(cur + 1536 + col); u32x4 pw = (u32x4){0u, 0u, 0u, 0u}; if (!first) pw = *(const u32x4*)(prv + 1536 + col);
        const float cv[8] = {bflo(cw.x), bfhi(cw.x), bflo(cw.y), bfhi(cw.y), bflo(cw.z), bfhi(cw.z), bflo(cw.w), bfhi(cw.w)};
        const float pv[8] = {bflo(pw.x), bfhi(pw.x), bflo(pw.y), bfhi(pw.y), bflo(pw.z), bfhi(pw.z), bflo(pw.w), bfhi(pw.w)};
        float z[8];
#pragma unroll
        for (int i = 0; i < 8; ++i) { z[i] = cv[i] + mu[1536 + col + i] * (pv[i] - cv[i]); if (col < 64) z[i] = 1.f - 2.f / (1.f + __expf(2.f * z[i])); else if (col >= 128) z[i] = sigmoidf_(z[i]); }
        u32x4 o; o.x = pk2(z[0], z[1]); o.y = pk2(z[2], z[3]); o.z = pk2(z[4], z[5]); o.w = pk2(z[6], z[7]);
        bf16* dst = (col < 64) ? A0 + t * ST + col : (col < 128 ? A1 + t * ST + (col - 64) : A2 + t * STG + (col - 128));
        *(u32x4*)dst = o;
    }
    { const int row = tid >> 3, chk = tid & 7;
      *(u32x4*)(A4 + row * ST + chk * 8) = *(const u32x4*)(WT + WT_LW + (size_t)(h * 64 + row) * 64 + chk * 8);
      *(u32x4*)(A5 + row * ST + chk * 8) = *(const u32x4*)(WT + WT_LA + (size_t)(h * 64 + row) * 64 + chk * 8);
#pragma unroll
      for (int i = 0; i < 2; ++i) { const int idx = tid + 512 * i, r2 = idx >> 4, c2 = idx & 15;
          *(u32x4*)((bf16*)F1 + r2 * STG + c2 * 8) = *(const u32x4*)(WT + WT_LG + (size_t)(h * 64 + r2) * 128 + c2 * 8); } }
    LDS_BARRIER();
    { f32x4 aw[2], aa[2], ag[2]; ZACC(aw); ZACC(aa); ZACC(ag);
      mm_tile(A4, ST, A0, ST, 2, aw, w, lq, g); mm_tile(A5, ST, A1, ST, 2, aa, w, lq, g); mm_tile((const bf16*)F1, STG, A2, STG, 4, ag, w, lq, g);
      const int mt = w >> 1, nt0 = 2 * (w & 1);
#pragma unroll
      for (int q = 0; q < 2; ++q) { const int o = (16 * (nt0 + q) + lq) * ST + 16 * mt + 4 * g; u32x2 p;
          p.x = pk2(aw[q][0], aw[q][1]); p.y = pk2(aw[q][2], aw[q][3]); *(u32x2*)(A7 + o) = p;
          p.x = pk2(aa[q][0], aa[q][1]); p.y = pk2(aa[q][2], aa[q][3]); *(u32x2*)(A8 + o) = p;
          p.x = pk2(ag[q][0], ag[q][1]); p.y = pk2(ag[q][2], ag[q][3]); *(u32x2*)(A9 + o) = p; } }
    LDS_BARRIER();
    float kk[8], k2[8], ar[8];
    { const u32x4 lw = *(const u32x4*)(A7 + t * ST + c0), la = *(const u32x4*)(A8 + t * ST + c0), lg = *(const u32x4*)(A9 + t * ST + c0);
      const float fw[8] = {bflo(lw.x), bfhi(lw.x), bflo(lw.y), bfhi(lw.y), bflo(lw.z), bfhi(lw.z), bflo(lw.w), bfhi(lw.w)};
      const float fa[8] = {bflo(la.x), bfhi(la.x), bflo(la.y), bfhi(la.y), bflo(la.z), bfhi(la.z), bflo(la.w), bfhi(la.w)};
      float ss = 0.f, bs = 0.f;
#pragma unroll
      for (int i = 0; i < 8; ++i) {
          const float xw = -(pw0[i] + fw[i]); const float sp = fmaxf(xw, 0.f) + __logf(1.f + __expf(-fabsf(xw)));
          F0[t * 64 + c0 + i] = __expf(-sp - 0.5f);
          ar[i] = sigmoidf_(pa0[i] + fa[i]);
          kk[i] = zk[i] * pkk[i]; ss += kk[i] * kk[i];
          k2[i] = zk[i] * (1.f + (ar[i] - 1.f) * pka[i]);
          bs += zr[i] * k2[i] * prk[i]; }
      ss += __shfl_xor(ss, 1); ss += __shfl_xor(ss, 2); ss += __shfl_xor(ss, 4);
      bs += __shfl_xor(bs, 1); bs += __shfl_xor(bs, 2); bs += __shfl_xor(bs, 4);
      const float inv = 1.0f / fmaxf(sqrtf(ss), 1e-12f);
#pragma unroll
      for (int i = 0; i < 8; ++i) kk[i] *= inv;
      u32x4 bo; bo.x = pk2(bs * zv[0], bs * zv[1]); bo.y = pk2(bs * zv[2], bs * zv[3]); bo.z = pk2(bs * zv[4], bs * zv[5]); bo.w = pk2(bs * zv[6], bs * zv[7]);
      *(u32x4*)(B.BON + (m0 + t) * 512 + jb) = bo; *(u32x4*)(B.G + (m0 + t) * 512 + jb) = lg; }
    LDS_BARRIER();
    {
      const int k = tid & 63, sg = tid >> 6; float e[8], run = 0.f;
#pragma unroll
      for (int s = 0; s < 8; ++s) { run += F0[(8 * sg + s) * 64 + k]; e[s] = run; }
      F1[sg * 64 + k] = run;
      LDS_BARRIER();
      float off = 0.f;
#pragma unroll
      for (int s = 0; s < 8; ++s) off += (s < sg) ? F1[s * 64 + k] : 0.f;
#pragma unroll
      for (int s = 0; s < 8; ++s) F0[(8 * sg + s) * 64 + k] = e[s] + off; }
    LDS_BARRIER();
    { float ct[8], cp[8], cC[8];
#pragma unroll
      for (int i = 0; i < 8; ++i) { ct[i] = F0[t * 64 + c0 + i]; cp[i] = (t > 0) ? F0[(t - 1) * 64 + c0 + i] : 0.f; cC[i] = F0[63 * 64 + c0 + i]; }
      float at[8], bt[8], kt[8], rt[8], bh[8], kh[8];
#pragma unroll
      for (int i = 0; i < 8; ++i) { const float gt = __expf(-ct[i]), igt = __expf(ct[i]), gp = __expf(-cp[i]), gct = __expf(ct[i] - cC[i]);
          at[i] = -kk[i] * gp; bt[i] = kk[i] * ar[i] * igt; kt[i] = k2[i] * igt; rt[i] = zr[i] * gt; bh[i] = kk[i] * ar[i] * gct; kh[i] = k2[i] * gct; }
      u32x4 o;
      o.x = pk2(at[0], at[1]); o.y = pk2(at[2], at[3]); o.z = pk2(at[4], at[5]); o.w = pk2(at[6], at[7]); *(u32x4*)(A0 + t * ST + c0) = o;
      o.x = pk2(bt[0], bt[1]); o.y = pk2(bt[2], bt[3]); o.z = pk2(bt[4], bt[5]); o.w = pk2(bt[6], bt[7]); *(u32x4*)(A1 + t * ST + c0) = o;
      o.x = pk2(kt[0], kt[1]); o.y = pk2(kt[2], kt[3]); o.z = pk2(kt[4], kt[5]); o.w = pk2(kt[6], kt[7]); *(u32x4*)(A2 + t * ST + c0) = o;
      o.x = pk2(rt[0], rt[1]); o.y = pk2(rt[2], rt[3]); o.z = pk2(rt[4], rt[5]); o.w = pk2(rt[6], rt[7]); *(u32x4*)(A3 + t * ST + c0) = o;
#pragma unroll
      for (int i = 0; i < 8; ++i) { const int o = (c0 + i) * ST + (t ^ c0);
          A4[o] = (bf16)f2bf(bh[i]); A5[o] = (bf16)f2bf(kh[i]); A6[o] = (bf16)f2bf(zv[i]); F1[t * 128 + c0 + i] = at[i]; }
      if (t == 63) { float* gc = (float*)(B.UB + (size_t)u * UNIT_B + 16384) + c0;
#pragma unroll
          for (int i = 0; i < 8; ++i) gc[i] = __expf(-cC[i]); } }
    LDS_BARRIER();
    { const int mt = w >> 1, nt0 = 2 * (w & 1);
      f32x4 a[2];
      ZACC(a); mm_tile(A0, ST, A1, ST, 2, a, w, lq, g);
#pragma unroll
      for (int q = 0; q < 2; ++q) { const int i = 16 * (nt0 + q) + lq; f32x4 lab;
#pragma unroll
          for (int j = 0; j < 4; ++j) lab[j] = (i < 16 * mt + 4 * g + j) ? a[q][j] : 0.f;
#pragma unroll
          for (int j = 0; j < 4; ++j) F0[i * 64 + j * 16 + 4 * mt + g] = lab[j]; }
      asm volatile("" ::: "memory");
#define ST1_STORE(DST, INCL) do { _Pragma("unroll") for (int q = 0; q < 2; ++q) { const int tt = 16 * (nt0 + q) + lq, i0 = 16 * mt + 4 * g; float v_[4]; \
          _Pragma("unroll") for (int j = 0; j < 4; ++j) v_[j] = (i0 + j < tt + (INCL)) ? a[q][j] : 0.f; \
          u32x2 p_; p_.x = pk2(v_[0], v_[1]); p_.y = pk2(v_[2], v_[3]); *(u32x2*)((DST) + tt * ST + i0) = p_; } } while (0)
      ZACC(a); mm_tile(A2, ST, A0, ST, 2, a, w, lq, g); ST1_STORE(A7, 0); asm volatile("" ::: "memory");
      ZACC(a); mm_tile(A1, ST, A3, ST, 2, a, w, lq, g); ST1_STORE(A8, 1); asm volatile("" ::: "memory");
      ZACC(a); mm_tile(A2, ST, A3, ST, 2, a, w, lq, g); ST1_STORE(A9, 1);
#undef ST1_STORE
    }
    LDS_BARRIER();
    { const int mt = w >> 1, nt0 = 2 * (w & 1); f32x4 a[2]; ZACC(a);
      mm_tile2<true, false>(A6, ST, A7, ST, 2, a, w, lq, g);
#pragma unroll
      for (int q = 0; q < 2; ++q) *(f32x4*)(F1 + (16 * (nt0 + q) + lq) * 128 + 64 + 16 * mt + 4 * g) = a[q]; }
    LDS_BARRIER();
    { float X[16];
      const int col = 16 * w + lq;
#pragma unroll
      for (int r = 0; r < 16; ++r) X[r] = F1[(4 * r + g) * 128 + col];
      LDS_BARRIER();
      f32x4 Lc[4];
#pragma unroll
      for (int q = 0; q < 4; ++q) Lc[q] = *(const f32x4*)(F0 + g * 16 + 4 * q);
#pragma unroll
      for (int i = 0; i < 64; ++i) {
          const float xi = __shfl(X[i >> 2], (i & 3) * 16 + lq);
          f32x4 Ln[4];
#pragma unroll
          for (int q = 0; q < 4; ++q) Ln[q] = Lc[q];
          if (i + 1 < 64) {
#pragma unroll
              for (int q = ((i + 1) >> 4); q < 4; ++q) Ln[q] = *(const f32x4*)(F0 + (i + 1) * 64 + g * 16 + 4 * q);
          }
#pragma unroll
          for (int r = (i >> 2); r < 16; ++r) X[r] += Lc[r >> 2][r & 3] * xi;
#pragma unroll
          for (int q = 0; q < 4; ++q) Lc[q] = Ln[q];
          __builtin_amdgcn_sched_barrier(0);
      }
      bf16* XT = (bf16*)F1 + (w >> 2) * 4608 + ((col & 63) * ST);
#pragma unroll
      for (int r = 0; r < 16; ++r) XT[4 * r + g] = (bf16)f2bf(X[r]); }
    LDS_BARRIER();
    { const int mt = w >> 1, nt0 = 2 * (w & 1);
      const bf16* AhT = (const bf16*)F1; const bf16* W2T = AhT + 4608;
      unsigned char* ua = B.UA + (size_t)u * UNIT_A; unsigned char* ub = B.UB + (size_t)u * UNIT_B;
      const int p0 = 32 * (mt >> 1) + 8 * g + 4 * (mt & 1);
      f32x4 a[2];
      ZACC(a); mm_tile2<false, true>(AhT, ST, A4, ST, 2, a, w, lq, g);
#pragma unroll
      for (int q = 0; q < 2; ++q) { const int k = 16 * (nt0 + q) + lq; u32x2 o; o.x = pk2(a[q][0], a[q][1]); o.y = pk2(a[q][2], a[q][3]); *(u32x2*)(ua + swz(k, p0)) = o; }
      ZACC(a); mm_tile(AhT, ST, A8, ST, 2, a, w, lq, g);
#pragma unroll
      for (int q = 0; q < 2; ++q) { const int tt = 16 * (nt0 + q) + lq; const u32x2 rr = *(const u32x2*)(A3 + tt * ST + 16 * mt + 4 * g);
          u32x2 o; o.x = pk2(a[q][0] + bflo(rr.x), a[q][1] + bfhi(rr.x)); o.y = pk2(a[q][2] + bflo(rr.y), a[q][3] + bfhi(rr.y)); *(u32x2*)(ua + 8192 + swz(tt, p0)) = o; }
      ZACC(a); mm_tile2<true, false>(A4, ST, W2T, ST, 2, a, w, lq, g); mm_tile2<true, true>(A5, ST, A6, ST, 2, a, w, lq, g);
#pragma unroll
      for (int q = 0; q < 2; ++q) { const int v = 16 * (nt0 + q) + lq, k0 = 16 * mt + 4 * g; u32x2 o; o.x = pk2(a[q][0], a[q][1]); o.y = pk2(a[q][2], a[q][3]); *(u32x2*)(ub + swz(v, k0)) = o; }
      ZACC(a); mm_tile(A8, ST, W2T, ST, 2, a, w, lq, g); mm_tile2<false, true>(A9, ST, A6, ST, 2, a, w, lq, g);
#pragma unroll
      for (int q = 0; q < 2; ++q) { const int v = 16 * (nt0 + q) + lq, t0 = 16 * mt + 4 * g; u32x2 o; o.x = pk2(a[q][0], a[q][1]); o.y = pk2(a[q][2], a[q][3]); *(u32x2*)(ub + 8192 + swz(v, t0)) = o; } }
    LDS_BARRIER();
}
__device__ __forceinline__ void phase_rwkv_prep(const Params& P, int l, const Ctx& c) {
    const RwkvBufs B = rwkv_bufs(P, c);
    float pw0[8], pa0[8], pkk[8], pka[8], prk[8]; int hprev = -1;
    for (int u = c.bid; u < NUNIT; u += c.G) {
        const int h = u & 7;
        if (h != hprev) { hprev = h; const int j0 = l * 512 + h * 64 + (c.tid & 7) * 8;
#pragma unroll
            for (int i = 0; i < 8; ++i) { pw0[i] = P.in[9][j0 + i]; pa0[i] = P.in[11][j0 + i]; pkk[i] = P.in[14][j0 + i]; pka[i] = P.in[15][j0 + i]; prk[i] = P.in[16][j0 + i]; } }
        rwkv_prep_unit(P, l, c, u, B, pw0, pa0, pkk, pka, prk);
    }
}

constexpr int SLOTB = 33280, YST = 68;
__device__ __forceinline__ void scan_chunked(const Params& P, const Ctx& c, int bh) {
    const RwkvBufs B = rwkv_bufs(P, c);
    const int b = bh >> 3, h = bh & 7, w = c.wave, lane = c.lane, lq = lane & 15, g = lane >> 4;
    const size_t rowb = (size_t)b * LP;
    const int ll = c.tid;
    unsigned char* L = c.lds;
    f32x4 st[4];
#pragma unroll
    for (int i = 0; i < 4; ++i) st[i] = (f32x4){0.f, 0.f, 0.f, 0.f};
    u32x4 r0[5], r1[5], r2[5], r3[5], r4[5];
#define SC_UNIT(cc) ((size_t)((b * NCHK + (cc)) * 8 + h))
#define SC_LOAD(R, cc) do { const unsigned char* pa_ = B.UA + SC_UNIT(cc) * UNIT_A; const unsigned char* pb_ = B.UB + SC_UNIT(cc) * UNIT_B; \
        _Pragma("unroll") for (int i_ = 0; i_ < 2; ++i_) { R[i_] = GLD(u32x4, pa_ + (ll + 512 * i_) * 16); R[2 + i_] = GLD(u32x4, pb_ + (ll + 512 * i_) * 16); } \
        if (ll < 16) R[4] = GLD(u32x4, pb_ + 16384 + ll * 16); } while (0)
#define SC_WRITE(R, slot) do { unsigned char* s_ = L + (slot) * SLOTB; \
        _Pragma("unroll") for (int i_ = 0; i_ < 2; ++i_) { *(u32x4*)(s_ + (ll + 512 * i_) * 16) = R[i_]; *(u32x4*)(s_ + 16384 + (ll + 512 * i_) * 16) = R[2 + i_]; } \
        if (ll < 16) *(u32x4*)(s_ + 32768 + ll * 16) = R[4]; } while (0)
#define SC_COMPUTE(ci) do { \
        const unsigned char* sl = L + ((ci) % 3) * SLOTB; \
        const int vcol = 16 * w + lq; \
        bf16x8 gaf[4][2]; f32x4 gcf[4]; u32x2 d0f[4]; \
        _Pragma("unroll") for (int mt = 0; mt < 4; ++mt) { \
            gcf[mt] = *(const f32x4*)(sl + 32768 + (16 * mt + 4 * g) * 4); \
            d0f[mt] = *(const u32x2*)(sl + 16384 + swz(vcol, 16 * mt + 4 * g)); \
            _Pragma("unroll") for (int ks = 0; ks < 2; ++ks) gaf[mt][ks] = *(const bf16x8*)(sl + swz(16 * mt + lq, 32 * ks + 8 * g)); } \
        __builtin_amdgcn_sched_barrier(0);        \
        bf16x8 sb[2]; \
        _Pragma("unroll") for (int ks = 0; ks < 2; ++ks) { u32x4 pw; pw.x = pk2(st[2 * ks][0], st[2 * ks][1]); pw.y = pk2(st[2 * ks][2], st[2 * ks][3]); pw.z = pk2(st[2 * ks + 1][0], st[2 * ks + 1][1]); pw.w = pk2(st[2 * ks + 1][2], st[2 * ks + 1][3]); \
            sb[ks] = __builtin_bit_cast(bf16x8, pw); } \
        _Pragma("unroll") for (int mt = 0; mt < 4; ++mt) { \
            f32x4 ns = (f32x4){bflo(d0f[mt].x), bfhi(d0f[mt].x), bflo(d0f[mt].y), bfhi(d0f[mt].y)} + gcf[mt] * st[mt]; \
            _Pragma("unroll") for (int ks = 0; ks < 2; ++ks) ns = __builtin_amdgcn_mfma_f32_16x16x32_bf16(gaf[mt][ks], sb[ks], ns, 0, 0, 0); \
            st[mt] = ns; } \
        bf16x8 rhf[4][2]; u32x2 y0f[4];        \
        _Pragma("unroll") for (int mt = 0; mt < 4; ++mt) { y0f[mt] = *(const u32x2*)(sl + 24576 + swz(vcol, 16 * mt + 4 * g)); \
            _Pragma("unroll") for (int ks = 0; ks < 2; ++ks) rhf[mt][ks] = *(const bf16x8*)(sl + 8192 + swz(16 * mt + lq, 32 * ks + 8 * g)); } \
        __builtin_amdgcn_sched_barrier(0); \
        f32x4 yav[4]; \
        _Pragma("unroll") for (int mt = 0; mt < 4; ++mt) { yav[mt] = (f32x4){bflo(y0f[mt].x), bfhi(y0f[mt].x), bflo(y0f[mt].y), bfhi(y0f[mt].y)}; \
            _Pragma("unroll") for (int ks = 0; ks < 2; ++ks) yav[mt] = __builtin_amdgcn_mfma_f32_16x16x32_bf16(rhf[mt][ks], sb[ks], yav[mt], 0, 0, 0); } \
        _Pragma("unroll") for (int mt = 0; mt < 4; ++mt) { \
            float* yl = (float*)(L + 3 * SLOTB) + ((ci) & 1) * (64 * YST) + (16 * mt + 4 * g) * YST + vcol; \
            _Pragma("unroll") for (int j = 0; j < 4; ++j) yl[j * YST] = yav[mt][j]; } } while (0)
#define SC_YSTORE(ci) do { const float* ys_ = (const float*)(L + 3 * SLOTB) + ((ci) & 1) * (64 * YST) + (c.tid >> 3) * YST + (c.tid & 7) * 8; \
        float* yg_ = B.Y + (rowb + (ci) * 64 + (c.tid >> 3)) * 512 + h * 64 + (c.tid & 7) * 8; \
        GST(f32x4, yg_) = *(const f32x4*)ys_; GST(f32x4, yg_ + 4) = *(const f32x4*)(ys_ + 4); } while (0)
#define SC_ITER(ci, R) do { if ((ci) + 2 < NCHK) SC_WRITE(R, ((ci) + 2) % 3); if ((ci) + 7 < NCHK) SC_LOAD(R, (ci) + 7); if ((ci) > 0) SC_YSTORE((ci) - 1); if (w < 4) { SC_COMPUTE(ci); } LDS_BARRIER(); } while (0)
    { SC_LOAD(r0, 0); SC_LOAD(r1, 1); SC_WRITE(r0, 0); SC_WRITE(r1, 1); SC_LOAD(r2, 2); SC_LOAD(r3, 3); SC_LOAD(r4, 4); SC_LOAD(r0, 5); SC_LOAD(r1, 6); }
    __syncthreads();
#pragma unroll 1
    for (int cc = 0; cc < NCHK; cc += 5) { SC_ITER(cc, r2); SC_ITER(cc + 1, r3); SC_ITER(cc + 2, r4); SC_ITER(cc + 3, r0); SC_ITER(cc + 4, r1); }
    SC_YSTORE(NCHK - 1);
#undef SC_YSTORE
#undef SC_COMPUTE
#undef SC_ITER
#undef SC_UNIT
#undef SC_LOAD
#undef SC_WRITE
}

__device__ __forceinline__ void phase_gn(const Params& P, int l, const Ctx& c) {
    const RwkvBufs B = rwkv_bufs(P, c);
    const int gw = c.bid * NWAVES + c.wave, NGW = c.G * NWAVES;
    const int c0 = 8 * c.lane;
    float gnw[8], gnb[8];
#pragma unroll
    for (int i = 0; i < 8; ++i) { gnw[i] = P.in[17][l * 512 + c0 + i]; gnb[i] = P.in[18][l * 512 + c0 + i]; }
    for (int m = gw; m < M; m += NGW) {
        const size_t o = (size_t)m * 512 + c0;
        const f32x4 y0 = *(const f32x4*)(B.Y + o), y1 = *(const f32x4*)(B.Y + o + 4);
        float y[8] = {y0.x, y0.y, y0.z, y0.w, y1.x, y1.y, y1.z, y1.w};
        const u32x4 bw = *(const u32x4*)(B.BON + o), gw4 = *(const u32x4*)(B.G + o);
        const float bo[8] = {bflo(bw.x), bfhi(bw.x), bflo(bw.y), bfhi(bw.y), bflo(bw.z), bfhi(bw.z), bflo(bw.w), bfhi(bw.w)};
        const float gg[8] = {bflo(gw4.x), bfhi(gw4.x), bflo(gw4.y), bfhi(gw4.y), bflo(gw4.z), bfhi(gw4.z), bflo(gw4.w), bfhi(gw4.w)};
        float s = 0.f;
#pragma unroll
        for (int i = 0; i < 8; ++i) s += y[i];
        s += __shfl_xor(s, 1); s += __shfl_xor(s, 2); s += __shfl_xor(s, 4);
        const float mean = s * (1.f / 64.f);
        float q = 0.f;
#pragma unroll
        for (int i = 0; i < 8; ++i) { y[i] -= mean; q += y[i] * y[i]; }
        q += __shfl_xor(q, 1); q += __shfl_xor(q, 2); q += __shfl_xor(q, 4);
        const float rstd = 1.0f / sqrtf(q * (1.f / 64.f) + 64e-5f);
        float ov[8];
#pragma unroll
        for (int i = 0; i < 8; ++i) ov[i] = (y[i] * rstd * gnw[i] + gnb[i] + bo[i]) * gg[i];
        u32x4 ow; ow.x = pk2(ov[0], ov[1]); ow.y = pk2(ov[2], ov[3]); ow.z = pk2(ov[4], ov[5]); ow.w = pk2(ov[6], ov[7]);
        *(u32x4*)(B.ORW + o) = ow;
    }
}

__device__ __forceinline__ void attn_unit(const Ctx& c, int bh, int qb, const bf16* Q, const bf16* K, const bf16* V, bf16* O, const float* FC, float qkb2, const float* gq, const float* gk) {
    const int b = bh >> 3, h = bh & 7, lane = c.lane, w = c.wave, lq = lane & 15, g = lane >> 4;
    const int q0 = qb * 128;
    const size_t rowb = (size_t)b * LP;
    const int qrow = q0 + 16 * w + lq;
    bf16* Ks = (bf16*)c.lds; bf16* Vt = Ks + 64 * 72; float* fks = (float*)(Vt + 64 * 72);
    const bf16* qp = Q + (rowb + qrow) * 512 + h * 64 + 8 * g;
    bf16x8 qf0, qf1;
    { const u32x4 r0 = GLD(u32x4, qp), r1 = GLD(u32x4, qp + 32);
      float x[16] = {bflo(r0.x), bfhi(r0.x), bflo(r0.y), bfhi(r0.y), bflo(r0.z), bfhi(r0.z), bflo(r0.w), bfhi(r0.w), bflo(r1.x), bfhi(r1.x), bflo(r1.y), bfhi(r1.y), bflo(r1.z), bfhi(r1.z), bflo(r1.w), bfhi(r1.w)};
      float ss = 0.f;
#pragma unroll
      for (int i = 0; i < 16; ++i) ss += x[i] * x[i];
      ss += __shfl_xor(ss, 16); ss += __shfl_xor(ss, 32);
      const float rs = QSCALE / sqrtf(ss * (1.f / 64.f) + 1e-6f);
#pragma unroll
      for (int i = 0; i < 8; ++i) { x[i] *= rs * gq[8 * g + i]; x[8 + i] *= rs * gq[32 + 8 * g + i]; }
      u32x4 p0, p1; p0.x = pk2(x[0], x[1]); p0.y = pk2(x[2], x[3]); p0.z = pk2(x[4], x[5]); p0.w = pk2(x[6], x[7]); p1.x = pk2(x[8], x[9]); p1.y = pk2(x[10], x[11]); p1.z = pk2(x[12], x[13]); p1.w = pk2(x[14], x[15]);
      qf0 = __builtin_bit_cast(bf16x8, p0); qf1 = __builtin_bit_cast(bf16x8, p1); }
    const float* FCh = FC + (size_t)bh * LP;
    const float fq = GLD(float, FCh + qrow);
    float mrun = -1e30f, lsum = 0.f;
    f32x4 o[4];
#pragma unroll
    for (int i = 0; i < 4; ++i) o[i] = (f32x4){0.f, 0.f, 0.f, 0.f};
    const int kt_max = (q0 + 127) >> 6;
    const int lkey = c.tid >> 3, lch = c.tid & 7;
    float gkr[8];
#pragma unroll
    for (int i = 0; i < 8; ++i) gkr[i] = gk[lch * 8 + i];
    const size_t gbase = (rowb + lkey) * 512 + h * 64 + lch * 8;
    u32x4 kv = GLD(u32x4, K + gbase + (size_t)kt_max * 64 * 512), vv = GLD(u32x4, V + gbase + (size_t)kt_max * 64 * 512);
    float fkv = GLD(float, FCh + kt_max * 64 + (c.tid & 63));
    volatile unsigned* vote = (volatile unsigned*)(fks + 64);
    for (int kt = kt_max; kt >= 0; --kt) {
        const int k0 = kt * 64;
        LDS_BARRIER();
        { int can = 0; if (kt < kt_max) { const float fl = __shfl(fkv, 63); can = (qkb2 + fq - fl) < (mrun - THR2); }
          const int wall = __all(can); if (lane == 0) vote[w] = (unsigned)wall; }
        { { float x[8] = {bflo(kv.x), bfhi(kv.x), bflo(kv.y), bfhi(kv.y), bflo(kv.z), bfhi(kv.z), bflo(kv.w), bfhi(kv.w)}; float ss = 0.f;
#pragma unroll
              for (int i = 0; i < 8; ++i) ss += x[i] * x[i];
              ss += __shfl_xor(ss, 1); ss += __shfl_xor(ss, 2); ss += __shfl_xor(ss, 4);
              const float rs = 1.0f / sqrtf(ss * (1.f / 64.f) + 1e-6f);
              u32x4 kn; kn.x = pk2(x[0] * rs * gkr[0], x[1] * rs * gkr[1]); kn.y = pk2(x[2] * rs * gkr[2], x[3] * rs * gkr[3]); kn.z = pk2(x[4] * rs * gkr[4], x[5] * rs * gkr[5]); kn.w = pk2(x[6] * rs * gkr[6], x[7] * rs * gkr[7]);
              *(u32x4*)(Ks + lkey * 72 + lch * 8) = kn; }
            bf16* vd = Vt + (lch * 8) * 72 + (lkey ^ (8 * lch));
            vd[0] = (bf16)(vv.x & 0xffff); vd[72] = (bf16)(vv.x >> 16); vd[144] = (bf16)(vv.y & 0xffff); vd[216] = (bf16)(vv.y >> 16);
            vd[288] = (bf16)(vv.z & 0xffff); vd[360] = (bf16)(vv.z >> 16); vd[432] = (bf16)(vv.w & 0xffff); vd[504] = (bf16)(vv.w >> 16);
            if (c.tid < 64) fks[c.tid] = fkv;
            if (kt > 0) { kv = GLD(u32x4, K + gbase + (size_t)(k0 - 64) * 512); vv = GLD(u32x4, V + gbase + (size_t)(k0 - 64) * 512); fkv = GLD(float, FCh + k0 - 64 + (c.tid & 63)); } }
        LDS_BARRIER();
        { unsigned all = vote[0] & vote[1] & vote[2] & vote[3] & vote[4] & vote[5] & vote[6] & vote[7]; if (all) break; }
        if (k0 > q0 + 16 * w + 15) continue;
        f32x4 s[4];
#pragma unroll
        for (int nt = 0; nt < 4; ++nt) { const bf16* kp = Ks + (16 * nt + lq) * 72 + 8 * g; const bf16x8 a0 = *(const bf16x8*)kp, a1 = *(const bf16x8*)(kp + 32);
            s[nt] = __builtin_amdgcn_mfma_f32_16x16x32_bf16(a0, qf0, (f32x4){0.f, 0.f, 0.f, 0.f}, 0, 0, 0);
            s[nt] = __builtin_amdgcn_mfma_f32_16x16x32_bf16(a1, qf1, s[nt], 0, 0, 0); }
        float mx = -INFINITY;
#pragma unroll
        for (int nt = 0; nt < 4; ++nt) { const f32x4 fk = *(const f32x4*)(fks + 16 * nt + 4 * g);
#pragma unroll
            for (int j = 0; j < 4; ++j) { float x = s[nt][j] + fq - fk[j]; const int key = k0 + 16 * nt + 4 * g + j; if (key > qrow) x = -INFINITY; s[nt][j] = x; mx = fmaxf(mx, x); } }
        mx = fmaxf(mx, __shfl_xor(mx, 16)); mx = fmaxf(mx, __shfl_xor(mx, 32));
        const float mnew = fmaxf(mrun, mx), alpha = __builtin_amdgcn_exp2f(mrun - mnew); mrun = mnew;
        float psum = 0.f;
#pragma unroll
        for (int nt = 0; nt < 4; ++nt)
#pragma unroll
            for (int j = 0; j < 4; ++j) { const float p = __builtin_amdgcn_exp2f(s[nt][j] - mnew); s[nt][j] = p; psum += p; }
        lsum = lsum * alpha + psum;
#pragma unroll
        for (int dt = 0; dt < 4; ++dt) o[dt] = o[dt] * alpha;
        bf16x8 pb[2];
#pragma unroll
        for (int k2 = 0; k2 < 2; ++k2) { u32x4 pw; pw.x = pk2(s[2 * k2][0], s[2 * k2][1]); pw.y = pk2(s[2 * k2][2], s[2 * k2][3]); pw.z = pk2(s[2 * k2 + 1][0], s[2 * k2 + 1][1]); pw.w = pk2(s[2 * k2 + 1][2], s[2 * k2 + 1][3]);
            pb[k2] = __builtin_bit_cast(bf16x8, pw); }
#pragma unroll
        for (int dt = 0; dt < 4; ++dt)
#pragma unroll
            for (int k2 = 0; k2 < 2; ++k2) { const int vrow = 16 * dt + lq, vx = 8 * ((vrow >> 3) & 7); const bf16* vp = Vt + vrow * 72;
                const u32x2 lo = *(const u32x2*)(vp + ((32 * k2 + 4 * g) ^ vx)), hi = *(const u32x2*)(vp + ((32 * k2 + 16 + 4 * g) ^ vx));
                u32x4 aw; aw.x = lo.x; aw.y = lo.y; aw.z = hi.x; aw.w = hi.y;
                o[dt] = __builtin_amdgcn_mfma_f32_16x16x32_bf16(__builtin_bit_cast(bf16x8, aw), pb[k2], o[dt], 0, 0, 0); }
    }
    lsum += __shfl_xor(lsum, 16); lsum += __shfl_xor(lsum, 32);
    const float inv = 1.0f / lsum;
    bf16* op = O + (rowb + qrow) * 512 + h * 64 + 4 * g;
#pragma unroll
    for (int dt = 0; dt < 4; ++dt) { u32x2 ow; ow.x = pk2(o[dt][0] * inv, o[dt][1] * inv); ow.y = pk2(o[dt][2] * inv, o[dt][3] * inv); GST(u32x2, op + 16 * dt) = ow; }
    __syncthreads();
}
__device__ __forceinline__ void phase_attn(const Params& P, int l, const Ctx& c, int first_blk) {
    const bf16* Q = (const bf16*)(c.ws + OFF_Q); const bf16* K = (const bf16*)(c.ws + OFF_K); const bf16* V = (const bf16*)(c.ws + OFF_V);
    const float* FC = (const float*)(c.ws + OFF_MISC) + 16 * LP;
    float gqm = fabsf(P.in[5][l * 64 + c.lane]), gkm = fabsf(P.in[6][l * 64 + c.lane]);
#pragma unroll
    for (int o = 1; o < 64; o <<= 1) { gqm = fmaxf(gqm, __shfl_xor(gqm, o)); gkm = fmaxf(gkm, __shfl_xor(gkm, o)); }
    const float qkb2 = 8.0f * gqm * gkm * LOG2E * 1.03f;
    constexpr int NQB = LP / 128, NU = 16 * NQB;
    unsigned* ctr = (unsigned*)(c.ws + OFF_CTL) + 8192 + 64 * l;
    volatile unsigned* slot = (volatile unsigned*)(c.lds + MISC_OFF) + 4;
    for (;;) {
        __syncthreads();
        if (c.tid == 0) *slot = atomicAdd(ctr, 1u);
        __syncthreads();
        const int u = (int)*slot;
        if (u >= NU) break;
        const int bh = u & 15, qb = NQB - 1 - (u >> 4); attn_unit(c, bh, qb, Q, K, V, (bf16*)(c.ws + OFF_OF), FC, qkb2, P.in[5] + l * 64, P.in[6] + l * 64);
    }
}

__device__ __forceinline__ void phase_fixup(const Params& P, int l, const Ctx& c) {
    bf16* ACT = (bf16*)(c.ws + OFF_RW); const bf16* HALO = (const bf16*)(c.ws + OFF_Q);
    const float* cw = P.in[24] + (size_t)l * 3 * NUP;
    const int total = (M / 64) * 2 * DFF;
    for (int idx = c.bid * NTHR + c.tid; idx < total; idx += c.G * NTHR) {
        const int rr = idx / DFF, ch = idx - rr * DFF, q64 = rr >> 1, e = rr & 1, row = q64 * 64 + e;
        const int t = row % LP;
        int s0, s1, s2;
        if (e == 0) { s0 = q64 * 4 + 2; s1 = (q64 - 1) * 4 + 1; s2 = (q64 - 1) * 4 + 0; } else { s0 = q64 * 4 + 3; s1 = q64 * 4 + 2; s2 = (q64 - 1) * 4 + 1; }
        float uc[2];
#pragma unroll
        for (int bj = 0; bj < 2; ++bj) { const int col = bj * DFF + ch;
            const float u0 = bf2f(HALO[(size_t)s0 * NUP + col]);
            const float u1 = (t >= 1) ? bf2f(HALO[(size_t)s1 * NUP + col]) : 0.f;
            const float u2 = (t >= 2) ? bf2f(HALO[(size_t)s2 * NUP + col]) : 0.f;
            uc[bj] = cw[col] * u2 + cw[NUP + col] * u1 + cw[2 * NUP + col] * u0; }
        ACT[(size_t)row * DFF + ch] = (bf16)f2bf(uc[0] * sigmoidf_(uc[0]) * uc[1]);
    }
}

#define OPQ_S(x) asm volatile("" : "+s"(x))
#define OPQ_V(x) asm volatile("" : "+v"(x))
#define PHASE_BEGIN() do { int t_ = threadIdx.x; OPQ_V(t_); c.tid = t_; c.lane = t_ & 63; c.wave = __builtin_amdgcn_readfirstlane(t_ >> 6); int b_ = blockIdx.x; OPQ_S(b_); c.bid = b_; \
    size_t z_ = 0; OPQ_S(z_); unsigned char* w_ = P.ws + z_;   c.ws = w_; ws = w_; l = lc; OPQ_S(l); WT = (pg8::bf16_t*)(ws + OFF_WT); HN = (pg8::bf16_t*)(ws + OFF_HN); } while (0)
__global__ void __launch_bounds__(NTHR, 2) mega(Params P) {
    extern __shared__ __attribute__((aligned(16))) unsigned char lds[];
    Ctx c; c.G = gridDim.x; c.lds = lds;
    volatile LAS unsigned* MISC = (volatile LAS unsigned*)((LAS unsigned char*)lds + MISC_OFF);
    if (threadIdx.x < 16) MISC[threadIdx.x] = 0u;
    __syncthreads();
    (void)xcd_barrier_post((unsigned*)(P.ws + OFF_CTL) + 1024, MISC + 8);
#define SEAM() do { XcdBarrier xb_; xb_.bar = (unsigned*)(P.ws + OFF_CTL) + 1024; xb_.x = xb_xcc_id(); xb_.st = (volatile LAS unsigned*)((LAS unsigned char*)lds + MISC_OFF) + 8; xcd_barrier(xb_); } while (0)
    PG8_LAS unsigned char* ldsl = (PG8_LAS unsigned char*)lds;
    unsigned char* ws; pg8::bf16_t* WT; pg8::bf16_t* HN; int l;
#pragma unroll 1
    for (int lc = 0; lc < DEPTH; ++lc) {
        PHASE_BEGIN();
        convert_weights(P, l, c);
        phase_norm<true>(P, l, c);
        SEAM();
        if (P.out == nullptr) cg::this_grid().sync();
        PHASE_BEGIN();
        phase_fcum(P, c);
        { pg8::Gemm g{HN, WT + WT_IN, M, N1, 1024, 1024}; pg8::StaticOrder S; S.init(M, N1, c.G, c.bid);
          pg8::EpiRoute E{ws};
          pg8::gemm_phase<pg8::EpiRoute, pg8::StaticOrder, true, true>(ldsl, g, S, E); }
        SEAM();
        PHASE_BEGIN();
        for (int rep_ = 0; rep_ < REP_PREP; ++rep_) phase_rwkv_prep(P, l, c);
        SEAM();
        PHASE_BEGIN();
        if (c.bid < 16) { scan_chunked(P, c, c.bid); __syncthreads(); PHASE_BEGIN(); }
        phase_attn(P, l, c, 16);
#if REP_P3 > 1
        __syncthreads(); PHASE_BEGIN();
        if (c.bid < 16) scan_chunked(P, c, c.bid); else phase_attn(P, l, c, 16);
#endif
        SEAM();
        PHASE_BEGIN();
        phase_gn(P, l, c);
        for (int rep_ = 0; rep_ < REP_SYNC; ++rep_) SEAM();
        SEAM();
        PHASE_BEGIN();
#pragma unroll 1
        for (int pass = 0; pass < 3; ++pass) {
            if (pass) { __syncthreads(); PHASE_BEGIN(); }
            const int rw_side = pass == 2 ? ((c.bid >> 2) & 1) : pass;
            const pg8::bf16_t* A = rw_side ? (const pg8::bf16_t*)(ws + OFF_RW + (size_t)M * 512 * 4) : (const pg8::bf16_t*)(ws + OFF_OF);
            pg8::Gemm g{A, WT + (rw_side ? WT_BR : WT_BF), M, 1024, 512, 512};
            pg8::OneUnit S; S.so.init(MMAIN, 1024, c.G, c.bid); S.mode = pass == 2; S.pm = MMAIN / 256; S.pn = c.bid & 3; S.active = c.bid < 8;
            pg8::bf16_t* O = (pass == 2 && rw_side) ? (pg8::bf16_t*)(ws + OFF_TAIL) - (size_t)MMAIN * 1024 : (pg8::bf16_t*)(ws + OFF_K);
            pg8::EpiGateR E{O, (const pg8::bf16_t*)(ws + OFF_GT), P.in[21] + l * NGT, rw_side * 1024, pass == 1};
            pg8::gemm_phase<pg8::EpiGateR, pg8::OneUnit, true, true>(ldsl, g, S, E);
        }
        SEAM();
        PHASE_BEGIN();
#pragma unroll 1
        for (int pass = 0; pass < 2; ++pass) {
            if (pass) { __syncthreads(); PHASE_BEGIN(); }
            const int sl = pass ? (c.bid >> 2) : 0, ks = sl & 3;
            const pg8::bf16_t* A = (pass && sl >= 4) ? (const pg8::bf16_t*)(ws + OFF_TAIL) - (size_t)MMAIN * 1024 : (const pg8::bf16_t*)(ws + OFF_K);
            pg8::Gemm g{A + ks * 256, WT + WT_O + ks * 256, M, 1024, pass ? 256 : 1024, 1024};
            pg8::OneUnit S; S.so.init(MMAIN, 1024, c.G, c.bid); S.mode = pass; S.pm = MMAIN / 256; S.pn = c.bid & 3; S.active = sl < 8;
            pg8::EpiResid E{(float*)(ws + OFF_H), nullptr, pass};
            pg8::gemm_phase<pg8::EpiResid, pg8::OneUnit, true, true>(ldsl, g, S, E);
        }
        SEAM();
        PHASE_BEGIN();
        phase_norm<false>(P, l, c);
        SEAM();
        PHASE_BEGIN();
        { pg8::Gemm g{HN, WT + WT_UP, M, NUP, 1024, 1024}; pg8::StaticOrder S; S.init(M, NUP, c.G, c.bid);
          pg8::EpiUp E{(pg8::bf16_t*)(ws + OFF_RW), (pg8::bf16_t*)(ws + OFF_Q), P.in[24] + (size_t)l * 3 * NUP};
          pg8::gemm_phase<pg8::EpiUp, pg8::StaticOrder, true, true>(ldsl, g, S, E); }
        SEAM();
        PHASE_BEGIN();
        phase_fixup(P, l, c);
        SEAM();
        PHASE_BEGIN();
#pragma unroll 1
        for (int pass = 0; pass < 2; ++pass) {
            if (pass) { __syncthreads(); PHASE_BEGIN(); }
            const int sl = pass ? (c.bid >> 2) : 0;
            const int ko = (sl < 6) ? sl * 384 : 2304 + (sl - 6) * 256, kl = (sl < 6) ? 384 : 256;
            pg8::Gemm g{(const pg8::bf16_t*)(ws + OFF_RW) + (pass ? ko : 0), WT + WT_DN + (pass ? ko : 0), M, 1024, pass ? kl : DFF, DFF};
            pg8::OneUnit S; S.so.init(MMAIN, 1024, c.G, c.bid); S.mode = pass; S.pm = MMAIN / 256; S.pn = c.bid & 3; S.active = sl < 8;
            pg8::EpiResid E{(float*)(ws + OFF_H), (l == DEPTH - 1 && !pass) ? P.out : nullptr, pass};
            pg8::gemm_phase<pg8::EpiResid, pg8::OneUnit, true, true>(ldsl, g, S, E);
        }
        SEAM();
        if (l == DEPTH - 1) {
            PHASE_BEGIN();
            const float* H = (const float*)(ws + OFF_H);
            for (int idx = c.bid * NTHR + c.tid; idx < (NMETA + SEQ - (MMAIN - LP)) * (DM / 4); idx += c.G * NTHR) {
                const int r = idx / (DM / 4), q4 = idx - r * (DM / 4), t = (MMAIN - LP) + r;
                *(f32x4*)(P.out + ((size_t)SEQ + (t - NMETA)) * DM + 4 * q4) = *(const f32x4*)(H + (size_t)(LP + t) * DM + 4 * q4);
            }
        }
    }
}

extern "C" void kernel_launch(void* const* d_in, const int* in_sizes, int n_in, void* d_out, int out_size, void* d_ws, size_t ws_size, hipStream_t stream) {
    static int grid = 0;
    if (grid == 0) {
        if (n_in != 26 || out_size != NB * SEQ * DM || ws_size < WS_NEED) { fprintf(stderr, "kernel_launch: unexpected shapes (n_in %d out %d ws %zu need %zu)\n", n_in, out_size, ws_size, (size_t)WS_NEED); grid = -1; return; }
        int dev = 0, cus = 0, per_cu = 0;
        if (hipGetDevice(&dev) != hipSuccess || hipDeviceGetAttribute(&cus, hipDeviceAttributeMultiprocessorCount, dev) != hipSuccess) { grid = -1; return; }
        if (hipFuncSetAttribute((const void*)mega, hipFuncAttributeMaxDynamicSharedMemorySize, LDS_BYTES) != hipSuccess) { fprintf(stderr, "kernel_launch: hipFuncSetAttribute failed\n"); grid = -1; return; }
        if (hipOccupancyMaxActiveBlocksPerMultiprocessor(&per_cu, (const void*)mega, NTHR, LDS_BYTES) != hipSuccess || per_cu < 1) { fprintf(stderr, "kernel_launch: occupancy query says %d\n", per_cu); per_cu = 1; }
        (void)hipGetLastError();
        grid = cus;
    }
    if (grid < 0) return;
    if (hipMemsetAsync((char*)d_ws + OFF_CTL, 0, 65536, stream) != hipSuccess) { fprintf(stderr, "kernel_launch: memset failed\n"); return; }
    Params p{};
    for (int i = 0; i < 26; ++i) p.in[i] = (const float*)d_in[i];
    p.out = (float*)d_out; p.ws = (unsigned char*)d_ws;
    void* args[] = {&p};
    hipError_t e = hipLaunchCooperativeKernel((const void*)mega, dim3(grid), dim3(NTHR), args, LDS_BYTES, stream);
    if (e != hipSuccess) fprintf(stderr, "kernel_launch: cooperative launch failed: %s (grid %d)\n", hipGetErrorString(e), grid);
}
```

```cpp
#include <hip/hip_runtime.h>
#include <hip/hip_cooperative_groups.h>
#include <cstdio>
#include <cstdint>
#include <cmath>
namespace cg = cooperative_groups;
namespace pg8 {
#define PG8_LAS __attribute__((address_space(3)))
typedef unsigned short bf16_t;
typedef short bf16x8 __attribute__((ext_vector_type(8)));
typedef float f32x4 __attribute__((ext_vector_type(4)));
typedef unsigned u32x4 __attribute__((ext_vector_type(4)));
constexpr int BM = 256, BK = 64, HALF = 128, HTB = HALF * BK * 2  , STAGE_BYTES = 8 * HTB, NXCD = 8, WGM = 8;

__host__ __device__ __forceinline__ int lds_byte(int r, int c) { const int st = (r >> 4) * 2 + (c >> 5), rr = r & 15, cc = c & 31, ob = rr * 64 + cc * 2; return st * 1024 + (ob ^ (((ob >> 9) & 1) << 5)); }
__host__ __device__ __forceinline__ void stage_rc(int b, int& R, int& C) { const int st = b / 1024, sb = b % 1024, swz = sb ^ (((sb >> 9) & 1) << 5); R = (st >> 1) * 16 + swz / 64; C = (st & 1) * 32 + (swz % 64) / 2; }
__host__ __device__ __forceinline__ int perm32(int rho) { const int n = rho >> 4, i = rho & 15; return 8 * (i >> 2) + 4 * n + (i & 3); }

struct Unit { int pm, pn; };
struct Gemm { const bf16_t* A; const bf16_t* Bt; int M, N, K, ld; };

struct StaticOrder {
    int nM, nN, nwg, G, c;
    __host__ __device__ void init(int M, int N, int G_, int c_) { nM = M / BM; nN = N / BM; nwg = nM * nN; G = G_; c = c_; }
    __host__ __device__ bool next(int i, Unit& u) const {
        const long L = (long)i * G + c; if (L >= nwg) return false;
        int wgid = (int)L; { const int q = nwg / NXCD, r = nwg % NXCD, xcd = wgid % NXCD, off = wgid / NXCD; wgid = (xcd < r ? xcd * (q + 1) : r * (q + 1) + (xcd - r) * q) + off; }
        const int nig = WGM * nN, gid = wgid / nig, fm = gid * WGM, gsz = (nM - fm) < WGM ? (nM - fm) : WGM;
        u.pm = fm + ((wgid % nig) % gsz); u.pn = (wgid % nig) / gsz; return true;
    }
    __device__ __forceinline__ void a_ready(const Unit&) const {}
    __device__ __forceinline__ void done(const Unit&) const {}
};

__device__ __forceinline__ unsigned cvt_pk_bf16(float lo, float hi) { unsigned r; asm volatile("v_cvt_pk_bf16_f32 %0, %1, %2" : "=v"(r) : "v"(lo), "v"(hi)); return r; }
typedef float f32x2 __attribute__((ext_vector_type(2)));
template <class Epi, class Sched, bool ALIGN_EPI = false, bool SP2 = false>
__device__ __forceinline__ void gemm_phase(PG8_LAS unsigned char* lds, const Gemm g, const Sched& S, const Epi& E) {
    int tid_ = threadIdx.x; asm volatile("" : "+v"(tid_)); const int tid = tid_, wid = __builtin_amdgcn_readfirstlane(tid >> 6), lane = tid & 63, wr = wid >> 2, wc = wid & 3, fr = lane & 15, fq = lane >> 4;
    const int K = g.K, nt = K / BK, LD = g.ld;
    unsigned voffA[2], voffB[2];
#pragma unroll
    for (int i = 0; i < 2; ++i) { int R, C; stage_rc(tid * 16 + i * 8192, R, C); const int Rb = Epi::PERM ? ((R & ~31) + perm32(R & 31)) : R;
        voffA[i] = (unsigned)(R * LD + C) * 2u; voffB[i] = (unsigned)(Rb * LD + C) * 2u; }
    const size_t kstep = (size_t)(BK * 2);
    const size_t hstep = (size_t)HALF * LD * 2;
    const size_t tstep = 2 * hstep;
    const unsigned ldsw = (unsigned)wid * 1024u;
    const int aoff = lds_byte(wr * 64 + fr, fq * 8), boff = lds_byte(wc * 32 + fr, fq * 8);
#define PG8_SA(b, h) (((b) * 2 + (h)) * HTB)
#define PG8_SB(b, h) ((4 + (b) * 2 + (h)) * HTB)
#define PG8_STAGE(bufoff, gbase, voff) do { _Pragma("unroll") for (int _i = 0; _i < 2; ++_i) \
        __builtin_amdgcn_global_load_lds((const unsigned*)((const char*)(gbase) + (voff)[_i]), (PG8_LAS unsigned*)(lds + (bufoff) + ldsw + _i * 8192), 16, 0, 0); } while (0)
#define PG8_LDA(dst, b, h) do { _Pragma("unroll") for (int m = 0; m < 4; ++m) _Pragma("unroll") for (int k = 0; k < 2; ++k) dst[m][k] = *(const PG8_LAS bf16x8*)(lds + PG8_SA(b, h) + aoff + m * 2048 + k * 1024); } while (0)
#define PG8_LDB(dst, b, h) do { _Pragma("unroll") for (int n = 0; n < 2; ++n) _Pragma("unroll") for (int k = 0; k < 2; ++k) dst[n][k] = *(const PG8_LAS bf16x8*)(lds + PG8_SB(b, h) + boff + n * 2048 + k * 1024); } while (0)
#define PG8_MMA(ai, bj, At, Bt) do { __builtin_amdgcn_s_setprio(1); _Pragma("unroll") for (int m = 0; m < 4; ++m) _Pragma("unroll") for (int n = 0; n < 2; ++n) _Pragma("unroll") for (int k = 0; k < 2; ++k) \
        acc[ai][bj][m][n] = __builtin_amdgcn_mfma_f32_16x16x32_bf16(Bt[n][k], At[m][k], acc[ai][bj][m][n], 0, 0, 0); __builtin_amdgcn_s_setprio(0); } while (0)
#define PG8_WAIT_V(n) asm volatile("s_waitcnt vmcnt(" #n ")" ::: "memory")
#define PG8_WAIT_L(n) asm volatile("s_waitcnt lgkmcnt(" #n ")" ::: "memory")
#define PG8_BAR __builtin_amdgcn_s_barrier()
#define PG8_SCHED __builtin_amdgcn_sched_barrier(0)
    Unit cur, nxt; int ui = 0;
    if (!S.next(0, cur)) return;
    f32x4 acc[2][2][4][2];
#pragma unroll
    for (int a = 0; a < 2; ++a)
#pragma unroll
        for (int b = 0; b < 2; ++b)
#pragma unroll
            for (int m = 0; m < 4; ++m)
#pragma unroll
                for (int n = 0; n < 2; ++n) acc[a][b][m][n] = (f32x4){0.f, 0.f, 0.f, 0.f};
    bf16x8 At[4][2], B0[2][2], B1[2][2];
    const char* cA = (const char*)g.A + (size_t)cur.pm * tstep; const char* cB = (const char*)g.Bt + (size_t)cur.pn * tstep;
    S.a_ready(cur);
    if constexpr (SP2) {
        PG8_STAGE(PG8_SB(0, 0), cB, voffB); PG8_STAGE(PG8_SB(0, 1), cB + hstep, voffB); PG8_STAGE(PG8_SA(0, 0), cA, voffA); PG8_STAGE(PG8_SA(0, 1), cA + hstep, voffA);
        if (wr == 1) PG8_BAR;
        PG8_WAIT_V(2); PG8_BAR;
        PG8_STAGE(PG8_SB(1, 0), cB + kstep, voffB); PG8_STAGE(PG8_SA(1, 0), cA + kstep, voffA); PG8_STAGE(PG8_SB(1, 1), cB + hstep + kstep, voffB);
        PG8_WAIT_V(6); PG8_BAR;
    } else {
        PG8_STAGE(PG8_SB(0, 0), cB, voffB); PG8_STAGE(PG8_SA(0, 0), cA, voffA); PG8_STAGE(PG8_SB(0, 1), cB + hstep, voffB); PG8_STAGE(PG8_SA(0, 1), cA + hstep, voffA);
        if (wr == 1) PG8_BAR;
        PG8_WAIT_V(4); PG8_BAR;
        PG8_STAGE(PG8_SB(1, 0), cB + kstep, voffB); PG8_STAGE(PG8_SA(1, 0), cA + kstep, voffA); PG8_STAGE(PG8_SB(1, 1), cB + hstep + kstep, voffB);
        PG8_WAIT_V(6); PG8_BAR;
    }
    for (;;) {
        const bool has_next = S.next(ui + 1, nxt);
        const char* nA = has_next ? (const char*)g.A + (size_t)nxt.pm * tstep : cA; const char* nB = has_next ? (const char*)g.Bt + (size_t)nxt.pn * tstep : cB;
        for (int t = 0; t < nt; t += 2) {
            const bool last = (t == nt - 2);
            const char* a1 = cA + (size_t)(t + 1) * kstep;
            const char* a2 = last ? nA : cA + (size_t)(t + 2) * kstep; const char* b2 = last ? nB : cB + (size_t)(t + 2) * kstep;
            const char* a3 = a2 + kstep; const char* b3 = b2 + kstep;
            if (last && has_next) S.a_ready(nxt);
            if constexpr (SP2) {
            PG8_LDB(B0, 0, 0); PG8_LDB(B1, 0, 1); PG8_SCHED; PG8_LDA(At, 0, 0); PG8_STAGE(PG8_SA(1, 1), a1 + hstep, voffA);
            PG8_WAIT_V(8); PG8_WAIT_L(0); PG8_BAR; PG8_MMA(0, 0, At, B0); PG8_MMA(0, 1, At, B1); PG8_BAR; PG8_SCHED;
            PG8_LDA(At, 0, 1); PG8_STAGE(PG8_SB(0, 0), b2, voffB); PG8_STAGE(PG8_SB(0, 1), b2 + hstep, voffB); PG8_STAGE(PG8_SA(0, 0), a2, voffA);
            PG8_WAIT_V(8); PG8_WAIT_L(0); PG8_BAR; PG8_MMA(1, 0, At, B0); PG8_MMA(1, 1, At, B1); PG8_BAR; PG8_SCHED;
            PG8_LDB(B0, 1, 0); PG8_LDB(B1, 1, 1); PG8_SCHED; PG8_LDA(At, 1, 0); PG8_STAGE(PG8_SA(0, 1), a2 + hstep, voffA);
            PG8_WAIT_V(8); PG8_WAIT_L(0); PG8_BAR; PG8_MMA(0, 0, At, B0); PG8_MMA(0, 1, At, B1); PG8_BAR; PG8_SCHED;
            PG8_LDA(At, 1, 1); PG8_STAGE(PG8_SB(1, 0), b3, voffB); PG8_STAGE(PG8_SB(1, 1), b3 + hstep, voffB); PG8_STAGE(PG8_SA(1, 0), a3, voffA);
            PG8_WAIT_V(8); PG8_WAIT_L(0); PG8_BAR; PG8_MMA(1, 0, At, B0); PG8_MMA(1, 1, At, B1); PG8_BAR; PG8_SCHED;
            } else {
            PG8_LDB(B0, 0, 0); PG8_SCHED; PG8_LDA(At, 0, 0); PG8_STAGE(PG8_SA(1, 1), a1 + hstep, voffA);
            PG8_WAIT_L(8); PG8_BAR; PG8_WAIT_L(0); PG8_MMA(0, 0, At, B0); PG8_BAR; PG8_SCHED;
            PG8_LDB(B1, 0, 1); PG8_STAGE(PG8_SB(0, 0), b2, voffB);
            PG8_BAR; PG8_WAIT_L(0); PG8_MMA(0, 1, At, B1); PG8_BAR;
            PG8_LDA(At, 0, 1); PG8_STAGE(PG8_SA(0, 0), a2, voffA);
            PG8_BAR; PG8_WAIT_L(0); PG8_MMA(1, 0, At, B0); PG8_BAR; PG8_SCHED;
            PG8_STAGE(PG8_SB(0, 1), b2 + hstep, voffB);
            PG8_WAIT_V(6); PG8_BAR; PG8_MMA(1, 1, At, B1); PG8_BAR;
            PG8_LDB(B0, 1, 0); PG8_SCHED; PG8_LDA(At, 1, 0); PG8_STAGE(PG8_SA(0, 1), a2 + hstep, voffA);
            PG8_WAIT_L(8); PG8_BAR; PG8_WAIT_L(0); PG8_MMA(0, 0, At, B0); PG8_BAR; PG8_SCHED;
            PG8_LDB(B1, 1, 1); PG8_STAGE(PG8_SB(1, 0), b3, voffB);
            PG8_BAR; PG8_WAIT_L(0); PG8_MMA(0, 1, At, B1); PG8_BAR;
            PG8_LDA(At, 1, 1); PG8_STAGE(PG8_SA(1, 0), a3, voffA);
            PG8_BAR; PG8_WAIT_L(0); PG8_MMA(1, 0, At, B0); PG8_BAR; PG8_SCHED;
            PG8_STAGE(PG8_SB(1, 1), b3 + hstep, voffB);
            PG8_WAIT_V(6); PG8_BAR; PG8_MMA(1, 1, At, B1); PG8_BAR;
            }
        }
        if constexpr (ALIGN_EPI) { if (wr == 0) PG8_BAR; }
        if constexpr (!Epi::AFTER_DRAIN) { E(acc, cur, wr, wc, fr, fq); S.done(cur); }
        if (!has_next) break;
#pragma unroll
        for (int a = 0; a < 2; ++a)
#pragma unroll
            for (int b = 0; b < 2; ++b)
#pragma unroll
                for (int m = 0; m < 4; ++m)
#pragma unroll
                    for (int n = 0; n < 2; ++n) acc[a][b][m][n] = (f32x4){0.f, 0.f, 0.f, 0.f};
        cur = nxt; cA = nA; cB = nB; ++ui;
        if constexpr (ALIGN_EPI) { if (wr == 1) PG8_BAR; }
    }
    PG8_WAIT_V(0);
    if constexpr (!ALIGN_EPI) { if (wr == 0) PG8_BAR; }
    PG8_BAR;
    if constexpr (Epi::AFTER_DRAIN) { E.fused(acc, cur, wr, wc, fr, fq, lds, wid, lane); S.done(cur); }
#undef PG8_SA
#undef PG8_SB
#undef PG8_STAGE
#undef PG8_LDA
#undef PG8_LDB
#undef PG8_MMA
#undef PG8_WAIT_V
#undef PG8_WAIT_L
#undef PG8_BAR
#undef PG8_SCHED
}
}
#define GAS __attribute__((address_space(1)))
#define LAS __attribute__((address_space(3)))
typedef GAS unsigned gu32;
typedef GAS unsigned long long gu64;
#define RLX_AGENT __ATOMIC_RELAXED, __HIP_MEMORY_SCOPE_AGENT
#define LDS_WAIT() asm volatile("s_waitcnt lgkmcnt(0)" ::: "memory")
#define VM_WAIT() asm volatile("s_waitcnt vmcnt(0)" ::: "memory")
__device__ __forceinline__ unsigned long long rt() { return __builtin_amdgcn_s_memrealtime(); }
#define XB_TMO      128
#define XB_XCNT(j)  (256  + 64 * (j))
#define XB_XSUB(j)  (1280 + 64 * (j))
#define XB_XGEN(j)  (2304 + 64 * (j))
#define XB_TOP      3328
#define XB_TOPGEN   3392
#define XCD_BAR_WORDS 3456
#define XB_SPIN_CAP (1u << 18)

__device__ __forceinline__ unsigned xb_ld(unsigned* p)              { return __hip_atomic_load(p, __ATOMIC_RELAXED, __HIP_MEMORY_SCOPE_AGENT); }
__device__ __forceinline__ unsigned xb_add(unsigned* p, unsigned v) { return __hip_atomic_fetch_add(p, v, __ATOMIC_RELAXED, __HIP_MEMORY_SCOPE_AGENT); }
__device__ __forceinline__ unsigned xb_xcc_id() { return (unsigned)__builtin_amdgcn_s_getreg((3 << 11) | 20) & 0xFu; }
#define XB_SPIN(cond, bar) do { unsigned _sp = 0; while (cond) { __builtin_amdgcn_s_sleep(1); \
    if ((++_sp & 255u) == 0u) { if (xb_ld(&(bar)[XB_TMO])) break; if (_sp > XB_SPIN_CAP) { atomicAdd(&(bar)[XB_TMO], 1u); break; } } } } while (0)

struct XcdBarrier {
    unsigned* bar; unsigned x;
    volatile LAS unsigned* st;
};

__device__ __forceinline__ XcdBarrier xcd_barrier_post(unsigned* bar, volatile LAS unsigned* st) {
    XcdBarrier b; b.bar = bar; b.x = xb_xcc_id(); b.st = st;
    if (threadIdx.x == 0) (void)xb_add(&bar[XB_XCNT(b.x)], 1u);
    return b;
}
__device__ __forceinline__ void xcd_barrier_complete(unsigned* bar, unsigned x, unsigned& nloc, unsigned& nx) {
    const unsigned G = gridDim.x * gridDim.y * gridDim.z;
    unsigned sum, cnt, mine, sp = 0u;
    for (;;) {
        sum = 0u; cnt = 0u; mine = 0u;
#pragma unroll
        for (unsigned j = 0; j < 16; ++j) { const unsigned c = xb_ld(&bar[XB_XCNT(j)]); sum += c; cnt += (c > 0u) ? 1u : 0u; mine = (j == x) ? c : mine; }
        if (sum == G) break;
        __builtin_amdgcn_s_sleep(1);
        if ((++sp & 255u) == 0u) { if (xb_ld(&bar[XB_TMO])) break; if (sp > XB_SPIN_CAP) { atomicAdd(&bar[XB_TMO], 1u); break; } }
    }
    nloc = mine > 0u ? mine : 1u; nx = cnt > 0u ? cnt : 1u;
}

__device__ __forceinline__ void xcd_barrier(const XcdBarrier& b) {
    asm volatile("s_waitcnt vmcnt(0)" ::: "memory");
    __syncthreads();
    if (threadIdx.x == 0) {
        unsigned* bar = b.bar;
        __builtin_amdgcn_s_waitcnt(0);
        unsigned nloc = b.st[0], nx = b.st[1];
        if (nloc == 0u) { xcd_barrier_complete(bar, b.x, nloc, nx); b.st[0] = nloc; b.st[1] = nx; }
        const unsigned old = xb_add(&bar[XB_XSUB(b.x)], 1u);
        const unsigned gen = old / nloc;
        if (old + 1u == (gen + 1u) * nloc) {
            __builtin_amdgcn_fence(__ATOMIC_RELEASE, "agent");
            asm volatile("s_waitcnt vmcnt(0)" ::: "memory");
            const unsigned og = xb_add(&bar[XB_TOP], 1u);
            const unsigned tg = og / nx;
            if (og + 1u == (tg + 1u) * nx) xb_add(&bar[XB_TOPGEN], 1u);
            else XB_SPIN(xb_ld(&bar[XB_TOPGEN]) == tg, bar);
            __builtin_amdgcn_fence(__ATOMIC_ACQUIRE, "agent");
            xb_add(&bar[XB_XGEN(b.x)], 1u);
            asm volatile("s_waitcnt vmcnt(0)" ::: "memory");
        } else {
            XB_SPIN(xb_ld(&bar[XB_XGEN(b.x)]) == gen, bar);
            __builtin_amdgcn_fence(__ATOMIC_ACQUIRE, "agent");
            asm volatile("s_waitcnt vmcnt(0)" ::: "memory");
        }
    }
    __syncthreads();
}


constexpr int NB = 2, SEQ = 8192, DM = 1024, DEPTH = 4, NMETA = 16, LP = 8320, M = NB * LP;
constexpr int N_IN = 5384, N1 = 5376, NRW = 1792, NGT = 2048, DFF = 2816, NUP = 5632;
constexpr float LOG2E = 1.4426950408889634f;
constexpr float QSCALE = 0.125f * LOG2E;
constexpr float THR2 = 24.0f * LOG2E;
constexpr int NWAVES = 8, NTHR = 512, MMAIN = 16384;
constexpr int LDS_BYTES = 147456, MISC_OFF = 147456 - 128;

typedef unsigned short bf16;
typedef float f32x4 __attribute__((ext_vector_type(4)));
typedef unsigned u32x4 __attribute__((ext_vector_type(4)));
typedef unsigned u32x2 __attribute__((ext_vector_type(2)));
typedef short bf16x8 __attribute__((ext_vector_type(8)));

constexpr size_t SZ_H = (size_t)M * DM * 4, SZ_X512 = (size_t)M * 512 * 2;
constexpr size_t OFF_CTL = 0, OFF_H = 1u << 20, OFF_WT = OFF_H + SZ_H;
constexpr size_t WT_IN = 0, WT_BF = WT_IN + (size_t)N1 * 1024, WT_BR = WT_BF + 1024 * 512, WT_O = WT_BR + 1024 * 512,
                 WT_UP = WT_O + 1024 * 1024, WT_DN = WT_UP + (size_t)NUP * 1024, WT_LW = WT_DN + (size_t)1024 * DFF, WT_LA = WT_LW + 512 * 64, WT_LG = WT_LA + 512 * 64, WT_END = WT_LG + 512 * 128;
constexpr size_t OFF_HN = OFF_WT + WT_END * 2;
constexpr size_t OFF_Q = OFF_HN + 2 * SZ_X512, OFF_K = OFF_Q + SZ_X512, OFF_V = OFF_K + SZ_X512;
constexpr size_t OFF_RW = OFF_V + SZ_X512, OFF_GT = OFF_RW + (size_t)M * NRW * 2, OFF_MISC = OFF_GT + (size_t)M * NGT * 2;
constexpr size_t OFF_T0 = OFF_MISC + 2 * 16 * LP * 4, OFF_OF = OFF_T0 + 2 * SZ_X512, OFF_TAIL = OFF_OF + SZ_X512, WS_NEED = OFF_TAIL + 256 * 1024 * 2;
static_assert(OFF_HN % 256 == 0 && OFF_RW % 256 == 0 && OFF_T0 % 256 == 0, "alignment");

struct Params { const float* in[26]; float* out; unsigned char* ws; };
struct Ctx { int tid, lane, wave, bid, G; unsigned char* lds; unsigned char* ws; };

__device__ __forceinline__ float bf2f(unsigned b) { return __uint_as_float(b << 16); }
__device__ __forceinline__ float bflo(unsigned w) { return __uint_as_float(w << 16); }
__device__ __forceinline__ float bfhi(unsigned w) { return __uint_as_float(w & 0xffff0000u); }
typedef float f32x2_t_ __attribute__((ext_vector_type(2))); typedef __bf16 bf16x2_t_ __attribute__((ext_vector_type(2)));
__device__ __forceinline__ unsigned pk2(float lo, float hi) { const f32x2_t_ v = {lo, hi}; const bf16x2_t_ r = __builtin_convertvector(v, bf16x2_t_); return __builtin_bit_cast(unsigned, r); }
__device__ __forceinline__ unsigned f2bf(float f) { return pk2(f, 0.f) & 0xffffu; }
__device__ __forceinline__ float wave_sum(float v) {
#pragma unroll
    for (int o = 1; o < 64; o <<= 1) v += __shfl_xor(v, o);
    return v;
}
__device__ __forceinline__ float sigmoidf_(float x) { return __builtin_amdgcn_rcpf(1.f + __expf(-x)); }
template <int CTRL> __device__ __forceinline__ float dppf(float old, float x) {
    return __int_as_float(__builtin_amdgcn_update_dpp(__float_as_int(old), __float_as_int(x), CTRL, 0xf, 0xf, false));
}
__device__ __forceinline__ float allreduce16(float x) {
    x += dppf<0x121>(0.f, x); x += dppf<0x122>(0.f, x); x += dppf<0x124>(0.f, x); x += dppf<0x128>(0.f, x); return x;
}

namespace pg8 {
struct EpiRoute {
    static constexpr bool PERM = true, AFTER_DRAIN = false;
    unsigned char* ws;
    __device__ __forceinline__ void operator()(const f32x4 (&acc)[2][2][4][2], const Unit& u, int wr, int wc, int fr, int fq) const {
        const int pn = u.pn; size_t off; int ldc, colt;
        if (pn < 6) { off = OFF_Q + (size_t)(pn >> 1) * SZ_X512; ldc = 512; colt = (pn & 1) * 256; }
        else if (pn < 13) { off = OFF_RW; ldc = NRW; colt = (pn - 6) * 256; }
        else { off = OFF_GT; ldc = NGT; colt = (pn - 13) * 256; }
        bf16_t* base = (bf16_t*)(ws + off);
        const int row0 = u.pm * BM + wr * 64 + fr, col0 = colt + wc * 32 + 8 * fq;
#pragma unroll
        for (int ai = 0; ai < 2; ++ai)
#pragma unroll
            for (int m = 0; m < 4; ++m) { bf16_t* rowp = base + (size_t)(row0 + ai * HALF + m * 16) * ldc + col0;
#pragma unroll
                for (int bj = 0; bj < 2; ++bj) { const f32x4 v0 = acc[ai][bj][m][0], v1 = acc[ai][bj][m][1];
                    u32x4 w; w.x = cvt_pk_bf16(v0[0], v0[1]); w.y = cvt_pk_bf16(v0[2], v0[3]); w.z = cvt_pk_bf16(v1[0], v1[1]); w.w = cvt_pk_bf16(v1[2], v1[3]);
                    *(u32x4*)(rowp + bj * HALF) = w; } }
    }
};
struct EpiGateR {
    static constexpr bool PERM = true, AFTER_DRAIN = false;
    bf16_t* O; const bf16_t* GT; const float* gb; int goff, accum;
    __device__ __forceinline__ void operator()(const f32x4 (&acc)[2][2][4][2], const Unit& u, int wr, int wc, int fr, int fq) const {
        const int row0 = u.pm * BM + wr * 64 + fr, col0 = u.pn * BM + wc * 32 + 8 * fq;
#pragma unroll
        for (int bj = 0; bj < 2; ++bj) {
            const int c = col0 + bj * HALF;
            const f32x4 b0 = *(const f32x4*)(gb + goff + c), b1 = *(const f32x4*)(gb + goff + c + 4);
#pragma unroll
            for (int ai = 0; ai < 2; ++ai)
#pragma unroll
                for (int m = 0; m < 4; ++m) {
                    const size_t row = (size_t)(row0 + ai * HALF + m * 16);
                    const u32x4 gw = *(const u32x4*)(GT + row * NGT + goff + c);
                    const f32x4 v0 = acc[ai][bj][m][0], v1 = acc[ai][bj][m][1];
                    float r[8];
                    r[0] = sigmoidf_(bflo(gw.x) + b0[0]) * v0[0]; r[1] = sigmoidf_(bfhi(gw.x) + b0[1]) * v0[1];
                    r[2] = sigmoidf_(bflo(gw.y) + b0[2]) * v0[2]; r[3] = sigmoidf_(bfhi(gw.y) + b0[3]) * v0[3];
                    r[4] = sigmoidf_(bflo(gw.z) + b1[0]) * v1[0]; r[5] = sigmoidf_(bfhi(gw.z) + b1[1]) * v1[1];
                    r[6] = sigmoidf_(bflo(gw.w) + b1[2]) * v1[2]; r[7] = sigmoidf_(bfhi(gw.w) + b1[3]) * v1[3];
                    bf16_t* op = O + row * 1024 + c;
                    if (accum) { const u32x4 ow = *(const u32x4*)op;
                        r[0] += bflo(ow.x); r[1] += bfhi(ow.x); r[2] += bflo(ow.y); r[3] += bfhi(ow.y); r[4] += bflo(ow.z); r[5] += bfhi(ow.z); r[6] += bflo(ow.w); r[7] += bfhi(ow.w); }
                    u32x4 w; w.x = cvt_pk_bf16(r[0], r[1]); w.y = cvt_pk_bf16(r[2], r[3]); w.z = cvt_pk_bf16(r[4], r[5]); w.w = cvt_pk_bf16(r[6], r[7]);
                    *(u32x4*)op = w;
                }
        }
    }
};
struct EpiResid {
    static constexpr bool PERM = false, AFTER_DRAIN = false;
    float* H; float* OUT; int atomic;
    __device__ __forceinline__ void operator()(const f32x4 (&acc)[2][2][4][2], const Unit& u, int wr, int wc, int fr, int fq) const {
        const int row0 = u.pm * BM + wr * 64 + fr, col0 = u.pn * BM + wc * 32 + 4 * fq;
#pragma unroll
        for (int ai = 0; ai < 2; ++ai)
#pragma unroll
            for (int m = 0; m < 4; ++m) {
                const int row = row0 + ai * HALF + m * 16;
                float* hp = H + (size_t)row * DM + col0;
                const int b = row >= LP ? 1 : 0, t = row - b * LP;
                float* op = (OUT && t >= NMETA && t < NMETA + SEQ) ? OUT + ((size_t)b * SEQ + (t - NMETA)) * DM + col0 : nullptr;
#pragma unroll
                for (int bj = 0; bj < 2; ++bj)
#pragma unroll
                    for (int n = 0; n < 2; ++n) { const int co = bj * HALF + n * 16;
                        if (atomic) {
                            if (row < LP + NMETA + SEQ) {
#pragma unroll
                                for (int e = 0; e < 4; ++e) unsafeAtomicAdd(hp + co + e, acc[ai][bj][m][n][e]); }
                        } else {
                            const f32x4 v = *(const f32x4*)(hp + co) + acc[ai][bj][m][n];
                            if (OUT) { if (op) *(f32x4*)(op + co) = v; } else *(f32x4*)(hp + co) = v; } }
            }
    }
};
struct EpiResidAtomic {
    static constexpr bool PERM = false, AFTER_DRAIN = false;
    float* H;
    __device__ __forceinline__ void operator()(const f32x4 (&acc)[2][2][4][2], const Unit& u, int wr, int wc, int fr, int fq) const {
        const int row0 = u.pm * BM + wr * 64 + fr, col0 = u.pn * BM + wc * 32 + 4 * fq;
#pragma unroll
        for (int ai = 0; ai < 2; ++ai)
#pragma unroll
            for (int m = 0; m < 4; ++m) { float* hp = H + (size_t)(row0 + ai * HALF + m * 16) * DM + col0;
#pragma unroll
                for (int bj = 0; bj < 2; ++bj)
#pragma unroll
                    for (int n = 0; n < 2; ++n)
#pragma unroll
                        for (int e = 0; e < 4; ++e) unsafeAtomicAdd(hp + bj * HALF + n * 16 + e, acc[ai][bj][m][n][e]); }
    }
};
struct OneUnit {
    StaticOrder so; int mode, pm, pn; bool active;
    __device__ bool next(int i, Unit& u) const { if (mode == 0) return so.next(i, u); if (i != 0 || !active) return false; u.pm = pm; u.pn = pn; return true; }
    __device__ __forceinline__ void a_ready(const Unit&) const {}
    __device__ __forceinline__ void done(const Unit&) const {}
};
struct EpiUp {
    static constexpr bool PERM = true, AFTER_DRAIN = false;
    bf16_t* ACT; bf16_t* HALO; const float* cw;
    __device__ __forceinline__ void operator()(const f32x4 (&acc)[2][2][4][2], const Unit& u, int wr, int wc, int fr, int fq) const {
        const int chan0 = u.pn * 128 + wc * 32 + 8 * fq;
#pragma unroll
        for (int n = 0; n < 2; ++n) {
            const int ch = chan0 + 4 * n;
            f32x4 w[3][2];
#pragma unroll
            for (int j = 0; j < 3; ++j) { w[j][0] = *(const f32x4*)(cw + j * NUP + ch); w[j][1] = *(const f32x4*)(cw + j * NUP + DFF + ch); }
#pragma unroll
            for (int ai = 0; ai < 2; ++ai) {
                const int rowg = u.pm * BM + ai * HALF + wr * 64;
#pragma unroll
                for (int m = 0; m < 4; ++m) {
                    f32x4 uc[2];
#pragma unroll
                    for (int bj = 0; bj < 2; ++bj) {
                        const f32x4 cur = acc[ai][bj][m][n];
                        f32x4 prv; if (m > 0) prv = acc[ai][bj][m - 1][n]; else prv = (f32x4){0.f, 0.f, 0.f, 0.f};
                        f32x4 p1, p2;
#pragma unroll
                        for (int i = 0; i < 4; ++i) {
                            const float r1 = dppf<0x121>(0.f, prv[i]), r2 = dppf<0x122>(0.f, prv[i]);
                            p1[i] = dppf<0x111>(r1, cur[i]); p2[i] = dppf<0x112>(r2, cur[i]);
                        }
                        uc[bj] = w[0][bj] * p2 + w[1][bj] * p1 + w[2][bj] * cur;
                    }
                    float a[4];
#pragma unroll
                    for (int i = 0; i < 4; ++i) a[i] = uc[0][i] * sigmoidf_(uc[0][i]) * uc[1][i];
                    u32x2 o; o.x = cvt_pk_bf16(a[0], a[1]); o.y = cvt_pk_bf16(a[2], a[3]);
                    *(u32x2*)(ACT + (size_t)(rowg + m * 16 + fr) * DFF + ch) = o;
                    if ((m == 3 && fr >= 14) || (m == 0 && fr < 2)) {
                        const int slot = (rowg >> 6) * 4 + (m == 3 ? fr - 14 : 2 + fr);
#pragma unroll
                        for (int bj = 0; bj < 2; ++bj) { const f32x4 cur = acc[ai][bj][m][n]; u32x2 hw; hw.x = cvt_pk_bf16(cur[0], cur[1]); hw.y = cvt_pk_bf16(cur[2], cur[3]);
                            *(u32x2*)(HALO + (size_t)slot * NUP + bj * DFF + ch) = hw; }
                    }
                }
            }
        }
    }
};
}

#ifndef REP_PREP
#define REP_PREP 1
#endif
#ifndef REP_P3
#define REP_P3 1
#endif
#ifndef REP_SYNC
#define REP_SYNC 0
#endif
#define GLD(T, p) (*(const __attribute__((address_space(1))) T*)(p))
#define GST(T, p) (*(__attribute__((address_space(1))) T*)(p))
#define LDS_BARRIER() do { asm volatile("s_waitcnt lgkmcnt(0)" ::: "memory"); __builtin_amdgcn_s_barrier(); asm volatile("" ::: "memory"); } while (0)
__device__ __forceinline__ void transpose_item(const float* W, int Nsrc, int K, bf16* WT, int dst_row0, int src_col0, int k0, float* scr, int lane) {
#pragma unroll 8
    for (int i = 0; i < 32; ++i) { const int kk = 2 * i + (lane >> 5); scr[kk * 33 + (lane & 31)] = W[(size_t)(k0 + kk) * Nsrc + src_col0 + (lane & 31)]; }
    asm volatile("s_waitcnt lgkmcnt(0)" ::: "memory");
    const int c = lane & 7;
#pragma unroll
    for (int j = 0; j < 4; ++j) { const int n = (lane >> 3) + 8 * j; const float* s = scr + (8 * c) * 33 + n;
        u32x4 o; o.x = pk2(s[0 * 33], s[1 * 33]); o.y = pk2(s[2 * 33], s[3 * 33]); o.z = pk2(s[4 * 33], s[5 * 33]); o.w = pk2(s[6 * 33], s[7 * 33]);
        *(u32x4*)(WT + (size_t)(dst_row0 + n) * K + k0 + 8 * c) = o; }
    asm volatile("s_waitcnt lgkmcnt(0)" ::: "memory");
}
__device__ __forceinline__ void convert_weights(const Params& P, int l, const Ctx& c) {
    bf16* WT = (bf16*)(c.ws + OFF_WT);
    float* scr = (float*)(c.lds + c.wave * 16384);
    const int gw = c.bid * NWAVES + c.wave, NGW = c.G * NWAVES;
    constexpr int I_IN = 16 * 168, I_BF = 8 * 32, I_O = 16 * 32, I_UP = 16 * 176, I_DN = 44 * 32, I_LR = 16, I_LG = 32, I_ALL = I_IN + 2 * I_BF + I_O + I_UP + I_DN + 2 * I_LR + I_LG;
    for (int it = gw; it < I_ALL; it += NGW) {
        int r = it;
        if (r < I_IN) { const int kb = r / 168, n0 = 32 * (r % 168); transpose_item(P.in[4] + (size_t)l * 1024 * N_IN, N_IN, 1024, WT + WT_IN, n0, n0 + (n0 >= 1536 ? 8 : 0), 64 * kb, scr, c.lane); continue; } r -= I_IN;
        if (r < I_BF) { const int kb = r / 32, n0 = 32 * (r % 32); transpose_item(P.in[19] + (size_t)l * 512 * 1024, 1024, 512, WT + WT_BF, n0, n0, 64 * kb, scr, c.lane); continue; } r -= I_BF;
        if (r < I_BF) { const int kb = r / 32, n0 = 32 * (r % 32); transpose_item(P.in[20] + (size_t)l * 512 * 1024, 1024, 512, WT + WT_BR, n0, n0, 64 * kb, scr, c.lane); continue; } r -= I_BF;
        if (r < I_O) { const int kb = r / 32, n0 = 32 * (r % 32); transpose_item(P.in[22] + (size_t)l * 1024 * 1024, 1024, 1024, WT + WT_O, n0, n0, 64 * kb, scr, c.lane); continue; } r -= I_O;
        if (r < I_UP) { const int kb = r / 176, n0 = 32 * (r % 176); const int pn = n0 >> 8, bj = (n0 >> 7) & 1, x = n0 & 127;
            transpose_item(P.in[23] + (size_t)l * 1024 * NUP, NUP, 1024, WT + WT_UP, n0, bj * DFF + 128 * pn + x, 64 * kb, scr, c.lane); continue; } r -= I_UP;
        if (r < I_DN) { const int kb = r / 32, n0 = 32 * (r % 32); transpose_item(P.in[25] + (size_t)l * DFF * 1024, 1024, DFF, WT + WT_DN, n0, n0, 64 * kb, scr, c.lane); continue; } r -= I_DN;
        if (r < I_LR) { transpose_item(P.in[10] + (size_t)l * 64 * 512, 512, 64, WT + WT_LW, 32 * r, 32 * r, 0, scr, c.lane); continue; } r -= I_LR;
        if (r < I_LR) { transpose_item(P.in[12] + (size_t)l * 64 * 512, 512, 64, WT + WT_LA, 32 * r, 32 * r, 0, scr, c.lane); continue; } r -= I_LR;
        { const int kb = r / 16, n0 = 32 * (r % 16); transpose_item(P.in[13] + (size_t)l * 128 * 512, 512, 128, WT + WT_LG, n0, n0, 64 * kb, scr, c.lane); }
    }
}

template <bool FG> __device__ __forceinline__ void phase_norm(const Params& P, int l, const Ctx& c) {
    float* H = (float*)(c.ws + OFF_H); bf16* HN = (bf16*)(c.ws + OFF_HN);
    float* LOGF = (float*)(c.ws + OFF_MISC);
    const float* gain = (FG ? P.in[2] : P.in[3]) + l * DM;
    float* wfs = (float*)c.lds;
    if (FG) {
        __syncthreads();
        const float* win = P.in[4] + (size_t)l * 1024 * N_IN + 1536;
        for (int i = c.tid; i < 8192; i += NTHR) wfs[i] = win[(size_t)(i >> 3) * N_IN + (i & 7)];
        __syncthreads();
    }
    const int gw = c.bid * NWAVES + c.wave, NGW = c.G * NWAVES;
#define NORM_LOAD(mm, dst) do { const int b_ = (mm) >= LP ? 1 : 0, t_ = (mm) - b_ * LP; \
        if (FG && l == 0) { const float* src_ = (t_ < NMETA) ? P.in[1] + (size_t)t_ * DM : P.in[0] + ((size_t)b_ * SEQ + (t_ - NMETA)) * DM; const bool real_ = t_ < NMETA + SEQ; \
            _Pragma("unroll") for (int j_ = 0; j_ < 4; ++j_) dst[j_] = real_ ? *(const f32x4*)(src_ + 4 * c.lane + 256 * j_) : (f32x4){0.f, 0.f, 0.f, 0.f}; } \
        else { _Pragma("unroll") for (int j_ = 0; j_ < 4; ++j_) dst[j_] = *(const f32x4*)(H + (size_t)(mm) * DM + 4 * c.lane + 256 * j_); } } while (0)
    f32x4 nv[4];
    if (gw < M) NORM_LOAD(gw, nv);
    for (int m = gw; m < M; m += NGW) {
        const int b = m >= LP ? 1 : 0, t = m - b * LP;
        f32x4 v[4];
#pragma unroll
        for (int j = 0; j < 4; ++j) v[j] = nv[j];
        if (m + NGW < M) NORM_LOAD(m + NGW, nv);
        if (FG && l == 0) {
#pragma unroll
            for (int j = 0; j < 4; ++j) *(f32x4*)(H + (size_t)m * DM + 4 * c.lane + 256 * j) = v[j];
        }
        float ss = 0.f;
#pragma unroll
        for (int j = 0; j < 4; ++j) ss += (v[j].x * v[j].x + v[j].y * v[j].y) + (v[j].z * v[j].z + v[j].w * v[j].w);
        const float rstd = 1.0f / sqrtf(wave_sum(ss) * (1.f / DM) + 1e-6f);
        float f[8];
#pragma unroll
        for (int q = 0; q < 8; ++q) f[q] = 0.f;
#pragma unroll
        for (int j = 0; j < 4; ++j) {
            const f32x4 g = *(const f32x4*)(gain + 4 * c.lane + 256 * j);
            v[j] = v[j] * rstd * g;
            u32x2 o; o.x = pk2(v[j].x, v[j].y); o.y = pk2(v[j].z, v[j].w);
            *(u32x2*)(HN + (size_t)m * DM + 4 * c.lane + 256 * j) = o;
            if (FG) {
#pragma unroll
                for (int e = 0; e < 4; ++e) { const int k = 4 * c.lane + 256 * j + e; const f32x4 w0 = *(const f32x4*)(wfs + k * 8), w1 = *(const f32x4*)(wfs + k * 8 + 4);
                    const float hv = v[j][e];
                    f[0] += hv * w0.x; f[1] += hv * w0.y; f[2] += hv * w0.z; f[3] += hv * w0.w; f[4] += hv * w1.x; f[5] += hv * w1.y; f[6] += hv * w1.z; f[7] += hv * w1.w; }
            }
        }
        if (FG) {
#pragma unroll
            for (int q = 0; q < 8; ++q) f[q] = wave_sum(f[q]);
            float fv = f[0];
#pragma unroll
            for (int q = 1; q < 8; ++q) fv = (c.lane == q) ? f[q] : fv;
            if (c.lane < 8) { const float x = fv + P.in[7][l * 8 + c.lane]; const float ls = fminf(x, 0.f) - __logf(1.f + __expf(-fabsf(x))); LOGF[(size_t)(b * 8 + c.lane) * LP + t] = ls; }
        }
    }
}

__device__ __forceinline__ void phase_fcum(const Params& P, const Ctx& c) {
    const int s = c.bid - (c.G - 16);
    if (s < 0) return;
    const float* LOGF = (const float*)(c.ws + OFF_MISC) + (size_t)s * LP; float* FC = (float*)(c.ws + OFF_MISC) + 16 * LP + (size_t)s * LP;
    float* wt = (float*)c.lds;
    const int base = c.tid * 17;
    float v[17]; float run = 0.f;
#pragma unroll
    for (int i = 0; i < 17; ++i) { const int idx = base + i; const float x = (idx < LP) ? LOGF[idx] : 0.f; run += x; v[i] = run; }
    float incl = run;
#pragma unroll
    for (int o = 1; o < 64; o <<= 1) { const float t = __shfl_up(incl, o); if (c.lane >= o) incl += t; }
    if (c.lane == 63) wt[c.wave] = incl;
    __syncthreads();
    float off = incl - run;
#pragma unroll
    for (int w2 = 0; w2 < 8; ++w2) off += (w2 < c.wave) ? wt[w2] : 0.f;
#pragma unroll
    for (int i = 0; i < 17; ++i) { const int idx = base + i; if (idx < LP) FC[idx] = (v[i] + off) * LOG2E; }
    __syncthreads();
}

__device__ __forceinline__ void phase_qknorm(const Params& P, int l, const Ctx& c) {
    bf16* Q = (bf16*)(c.ws + OFF_Q); bf16* K = (bf16*)(c.ws + OFF_K);
    const int gw = c.bid * NWAVES + c.wave, NGW = c.G * NWAVES;
    const int d0 = (c.lane & 7) * 8;
    float gq[8], gk[8];
#pragma unroll
    for (int i = 0; i < 8; ++i) { gq[i] = P.in[5][l * 64 + d0 + i] * QSCALE; gk[i] = P.in[6][l * 64 + d0 + i]; }
    for (int m = gw; m < M; m += NGW) {
#pragma unroll
        for (int which = 0; which < 2; ++which) {
            bf16* p = (which ? K : Q) + (size_t)m * 512 + 8 * c.lane;
            const u32x4 w = *(const u32x4*)p;
            float x[8] = {bflo(w.x), bfhi(w.x), bflo(w.y), bfhi(w.y), bflo(w.z), bfhi(w.z), bflo(w.w), bfhi(w.w)};
            float ss = 0.f;
#pragma unroll
            for (int i = 0; i < 8; ++i) ss += x[i] * x[i];
            ss += __shfl_xor(ss, 1); ss += __shfl_xor(ss, 2); ss += __shfl_xor(ss, 4);
            const float rs = 1.0f / sqrtf(ss * (1.f / 64.f) + 1e-6f);
#pragma unroll
            for (int i = 0; i < 8; ++i) x[i] = x[i] * rs * (which ? gk[i] : gq[i]);
            u32x4 o; o.x = pk2(x[0], x[1]); o.y = pk2(x[2], x[3]); o.z = pk2(x[4], x[5]); o.w = pk2(x[6], x[7]);
            *(u32x4*)p = o;
        }
    }
}

constexpr int NCHK = LP / 64;
constexpr int NUNIT = NB * NCHK * 8;
constexpr int UNIT_A = 16384, UNIT_B = 16640;
constexpr int ST = 72, STG = 136;
constexpr int L_F0 = 92160, L_F1 = 108544;
struct RwkvBufs { bf16 *BON, *G; unsigned char *UA, *UB; float* Y; bf16* ORW; };
__device__ __forceinline__ RwkvBufs rwkv_bufs(const Params& P, const Ctx& c) {
    RwkvBufs r; r.BON = (bf16*)(c.ws + OFF_HN); r.G = r.BON + (size_t)M * 512;
    r.UA = c.ws + OFF_T0; r.UB = (unsigned char*)P.out;
    r.Y = (float*)(c.ws + OFF_RW); r.ORW = (bf16*)(c.ws + OFF_RW + (size_t)M * 512 * 4);
    return r;
}
__device__ __forceinline__ void mm_tile(const bf16* A, int sa, const bf16* Bt, int sb, int nks, f32x4 (&acc)[2], int w, int lq, int g) {
    const int mt = w >> 1, nt0 = 2 * (w & 1);
    for (int ks = 0; ks < nks; ++ks) {
        const bf16x8 a = *(const bf16x8*)(A + (16 * mt + lq) * sa + 32 * ks + 8 * g);
#pragma unroll
        for (int q = 0; q < 2; ++q) { const bf16x8 b = *(const bf16x8*)(Bt + (16 * (nt0 + q) + lq) * sb + 32 * ks + 8 * g); acc[q] = __builtin_amdgcn_mfma_f32_16x16x32_bf16(a, b, acc[q], 0, 0, 0); }
    }
}
template <bool SA, bool SB> __device__ __forceinline__ void mm_tile2(const bf16* A, int sa, const bf16* Bt, int sb, int nks, f32x4 (&acc)[2], int w, int lq, int g) {
    const int mt = w >> 1, nt0 = 2 * (w & 1);
    const int ra = 16 * mt + lq, xa = SA ? 8 * ((ra >> 3) & 7) : 0;
    for (int ks = 0; ks < nks; ++ks) {
        const bf16x8 a = *(const bf16x8*)(A + ra * sa + ((32 * ks + 8 * g) ^ xa));
#pragma unroll
        for (int q = 0; q < 2; ++q) { const int rb = 16 * (nt0 + q) + lq, xb = SB ? 8 * ((rb >> 3) & 7) : 0;
            const bf16x8 bb = *(const bf16x8*)(Bt + rb * sb + ((32 * ks + 8 * g) ^ xb)); acc[q] = __builtin_amdgcn_mfma_f32_16x16x32_bf16(a, bb, acc[q], 0, 0, 0); }
    }
}
#define ZACC(a) do { a[0] = (f32x4){0.f, 0.f, 0.f, 0.f}; a[1] = (f32x4){0.f, 0.f, 0.f, 0.f}; } while (0)
__device__ __forceinline__ int permk(int k) { return 32 * (k >> 5) + 8 * ((k & 15) >> 2) + 4 * ((k >> 4) & 1) + (k & 3); }
__device__ __forceinline__ int swz(int row, int col) { return row * 128 + ((((col >> 3) ^ (row >> 1)) & 7) << 4) + (col & 7) * 2; }

__device__ __forceinline__ void rwkv_prep_unit(const Params& P, int l, const Ctx& c, int u, const RwkvBufs& B, const float (&pw0)[8], const float (&pa0)[8], const float (&pkk)[8], const float (&pka)[8], const float (&prk)[8]) {
    const int h = u & 7, bc = u >> 3, b = bc / NCHK, ch = bc - b * NCHK;
    const size_t m0 = (size_t)b * LP + ch * 64;
    int tid_ = c.tid; asm volatile("" : "+v"(tid_));
    const int tid = tid_, lane = tid & 63, w = c.wave, lq = lane & 15, g = lane >> 4;
    const int t = tid >> 3, cg = tid & 7, c0 = cg * 8, jb = h * 64 + c0;
    unsigned char* L = c.lds;
    bf16* A0 = (bf16*)L; bf16* A1 = A0 + 4608; bf16* A2 = A1 + 4608; bf16* A3 = A2 + 4608; bf16* A4 = A3 + 4608; bf16* A5 = A4 + 4608; bf16* A6 = A5 + 4608;
    bf16* A7 = A6 + 4608; bf16* A8 = A7 + 4608; bf16* A9 = A8 + 4608;
    float* F0 = (float*)(L + L_F0); float* F1 = (float*)(L + L_F1);
    const bf16* RW = (const bf16*)(c.ws + OFF_RW);
    const bf16* WT = (const bf16*)(c.ws + OFF_WT);
    const float* mu = P.in[8] + l * NRW;
    const bool first = (ch == 0 && t == 0);
    const bf16* cur = RW + (m0 + t) * NRW; const bf16* prv = cur - NRW;
    float zr[8], zk[8], zv[8];
#pragma unroll
    for (int s = 0; s < 3; ++s) {
        const u32x4 cw = *(const u32x4*)(cur + s * 512 + jb); u32x4 pw = (u32x4){0u, 0u, 0u, 0u}; if (!first) pw = *(const u32x4*)(prv + s * 512 + jb);
        const float cv[8] = {bflo(cw.x), bfhi(cw.x), bflo(cw.y), bfhi(cw.y), bflo(cw.z), bfhi(cw.z), bflo(cw.w), bfhi(cw.w)};
        const float pv[8] = {bflo(pw.x), bfhi(pw.x), bflo(pw.y), bfhi(pw.y), bflo(pw.z), bfhi(pw.z), bflo(pw.w), bfhi(pw.w)};
#pragma unroll
        for (int i = 0; i < 8; ++i) { const float z = cv[i] + mu[s * 512 + jb + i] * (pv[i] - cv[i]); if (s == 0) zr[i] = z; else if (s == 1) zk[i] = z; else zv[i] = z; }
    }
#pragma unroll
    for (int q4 = 0; q4 < 4; ++q4) {
        const int col = cg * 32 + q4 * 8;
        const u32x4 cw = *(const u32x4*)(cur + 1536 + col); u32x4 pw = (u32x4){0u, 0u, 0u, 0u}; if (!first) pw = *(const u32x4*)(prv + 1536 + col);
        const float cv[8] = {bflo(cw.x), bfhi(cw.x), bflo(cw.y), bfhi(cw.y), bflo(cw.z), bfhi(cw.z), bflo(cw.w), bfhi(cw.w)};
        const float pv[8] = {bflo(pw.x), bfhi(pw.x), bflo(pw.y), bfhi(pw.y), bflo(pw.z), bfhi(pw.z), bflo(pw.w), bfhi(pw.w)};
        float z[8];
#pragma unroll
        for (int i = 0; i < 8; ++i) { z[i] = cv[i] + mu[1536 + col + i] * (pv[i] - cv[i]); if (col < 64) z[i] = 1.f - 2.f / (1.f + __expf(2.f * z[i])); else if (col >= 128) z[i] = sigmoidf_(z[i]); }
        u32x4 o; o.x = pk2(z[0], z[1]); o.y = pk2(z[2], z[3]); o.z = pk2(z[4], z[5]); o.w = pk2(z[6], z[7]);
        bf16* dst = (col < 64) ? A0 + t * ST + col : (col < 128 ? A1 + t * ST + (col - 64) : A2 + t * STG + (col - 128));
        *(u32x4*)dst = o;
    }
    { const int row = tid >> 3, chk = tid & 7;
      *(u32x4*)(A4 + row * ST + chk * 8) = *(const u32x4*)(WT + WT_LW + (size_t)(h * 64 + row) * 64 + chk * 8);
      *(u32x4*)(A5 + row * ST + chk * 8) = *(const u32x4*)(WT + WT_LA + (size_t)(h * 64 + row) * 64 + chk * 8);
#pragma unroll
      for (int i = 0; i < 2; ++i) { const int idx = tid + 512 * i, r2 = idx >> 4, c2 = idx & 15;
          *(u32x4*)((bf16*)F1 + r2 * STG + c2 * 8) = *(const u32x4*)(WT + WT_LG + (size_t)(h * 64 + r2) * 128 + c2 * 8); } }
    LDS_BARRIER();
    { f32x4 aw[2], aa[2], ag[2]; ZACC(aw); ZACC(aa); ZACC(ag);
      mm_tile(A4, ST, A0, ST, 2, aw, w, lq, g); mm_tile(A5, ST, A1, ST, 2, aa, w, lq, g); mm_tile((const bf16*)F1, STG, A2, STG, 4, ag, w, lq, g);
      const int mt = w >> 1, nt0 = 2 * (w & 1);
#pragma unroll
      for (int q = 0; q < 2; ++q) { const int o = (16 * (nt0 + q) + lq) * ST + 16 * mt + 4 * g; u32x2 p;
          p.x = pk2(aw[q][0], aw[q][1]); p.y = pk2(aw[q][2], aw[q][3]); *(u32x2*)(A7 + o) = p;
          p.x = pk2(aa[q][0], aa[q][1]); p.y = pk2(aa[q][2], aa[q][3]); *(u32x2*)(A8 + o) = p;
          p.x = pk2(ag[q][0], ag[q][1]); p.y = pk2(ag[q][2], ag[q][3]); *(u32x2*)(A9 + o) = p; } }
    LDS_BARRIER();
    float kk[8], k2[8], ar[8];
    { const u32x4 lw = *(const u32x4*)(A7 + t * ST + c0), la = *(const u32x4*)(A8 + t * ST + c0), lg = *(const u32x4*)(A9 + t * ST + c0);
      const float fw[8] = {bflo(lw.x), bfhi(lw.x), bflo(lw.y), bfhi(lw.y), bflo(lw.z), bfhi(lw.z), bflo(lw.w), bfhi(lw.w)};
      const float fa[8] = {bflo(la.x), bfhi(la.x), bflo(la.y), bfhi(la.y), bflo(la.z), bfhi(la.z), bflo(la.w), bfhi(la.w)};
      float ss = 0.f, bs = 0.f;
#pragma unroll
      for (int i = 0; i < 8; ++i) {
          const float xw = -(pw0[i] + fw[i]); const float sp = fmaxf(xw, 0.f) + __logf(1.f + __expf(-fabsf(xw)));
          F0[t * 64 + c0 + i] = __expf(-sp - 0.5f);
          ar[i] = sigmoidf_(pa0[i] + fa[i]);
          kk[i] = zk[i] * pkk[i]; ss += kk[i] * kk[i];
          k2[i] = zk[i] * (1.f + (ar[i] - 1.f) * pka[i]);
          bs += zr[i] * k2[i] * prk[i]; }
      ss += __shfl_xor(ss, 1); ss += __shfl_xor(ss, 2); ss += __shfl_xor(ss, 4);
      bs += __shfl_xor(bs, 1); bs += __shfl_xor(bs, 2); bs += __shfl_xor(bs, 4);
      const float inv = 1.0f / fmaxf(sqrtf(ss), 1e-12f);
#pragma unroll
      for (int i = 0; i < 8; ++i) kk[i] *= inv;
      u32x4 bo; bo.x = pk2(bs * zv[0], bs * zv[1]); bo.y = pk2(bs * zv[2], bs * zv[3]); bo.z = pk2(bs * zv[4], bs * zv[5]); bo.w = pk2(bs * zv[6], bs * zv[7]);
      *(u32x4*)(B.BON + (m0 + t) * 512 + jb) = bo; *(u32x4*)(B.G + (m0 + t) * 512 + jb) = lg; }
    LDS_BARRIER();
    {
      const int k = tid & 63, sg = tid >> 6; float e[8], run = 0.f;
#pragma unroll
      for (int s = 0; s < 8; ++s) { run += F0[(8 * sg + s) * 64 + k]; e[s] = run; }
      F1[sg * 64 + k] = run;
      LDS_BARRIER();
      float off = 0.f;
#pragma unroll
      for (int s = 0; s < 8; ++s) off += (s < sg) ? F1[s * 64 + k] : 0.f;
#pragma unroll
      for (int s = 0; s < 8; ++s) F0[(8 * sg + s) * 64 + k] = e[s] + off; }
    LDS_BARRIER();
    { float ct[8], cp[8], cC[8];
#pragma unroll
      for (int i = 0; i < 8; ++i) { ct[i] = F0[t * 64 + c0 + i]; cp[i] = (t > 0) ? F0[(t - 1) * 64 + c0 + i] : 0.f; cC[i] = F0[63 * 64 + c0 + i]; }
      float at[8], bt[8], kt[8], rt[8], bh[8], kh[8];
#pragma unroll
      for (int i = 0; i < 8; ++i) { const float gt = __expf(-ct[i]), igt = __expf(ct[i]), gp = __expf(-cp[i]), gct = __expf(ct[i] - cC[i]);
          at[i] = -kk[i] * gp; bt[i] = kk[i] * ar[i] * igt; kt[i] = k2[i] * igt; rt[i] = zr[i] * gt; bh[i] = kk[i] * ar[i] * gct; kh[i] = k2[i] * gct; }
      u32x4 o;
      o.x = pk2(at[0], at[1]); o.y = pk2(at[2], at[3]); o.z = pk2(at[4], at[5]); o.w = pk2(at[6], at[7]); *(u32x4*)(A0 + t * ST + c0) = o;
      o.x = pk2(bt[0], bt[1]); o.y = pk2(bt[2], bt[3]); o.z = pk2(bt[4], bt[5]); o.w = pk2(bt[6], bt[7]); *(u32x4*)(A1 + t * ST + c0) = o;
      o.x = pk2(kt[0], kt[1]); o.y = pk2(kt[2], kt[3]); o.z = pk2(kt[4], kt[5]); o.w = pk2(kt[6], kt[7]); *(u32x4*)(A2 + t * ST + c0) = o;
      o.x = pk2(rt[0], rt[1]); o.y = pk2(rt[2], rt[3]); o.z = pk2(rt[4], rt[5]); o.w = pk2(rt[6], rt[7]); *(u32x4*)(A3 + t * ST + c0) = o;
#pragma unroll
      for (int i = 0; i < 8; ++i) { const int o = (c0 + i) * ST + (t ^ c0);
          A4[o] = (bf16)f2bf(bh[i]); A5[o] = (bf16)f2bf(kh[i]); A6[o] = (bf16)f2bf(zv[i]); F1[t * 128 + c0 + i] = at[i]; }
      if (t == 63) { float* gc = (float*)(B.UB + (size_t)u * UNIT_B + 16384) + c0;
#pragma unroll
          for (int i = 0; i < 8; ++i) gc[i] = __expf(-cC[i]); } }
    LDS_BARRIER();
    { const int mt = w >> 1, nt0 = 2 * (w & 1);
      f32x4 a[2];
      ZACC(a); mm_tile(A0, ST, A1, ST, 2, a, w, lq, g);
#pragma unroll
      for (int q = 0; q < 2; ++q) { const int i = 16 * (nt0 + q) + lq; f32x4 lab;
#pragma unroll
          for (int j = 0; j < 4; ++j) lab[j] = (i < 16 * mt + 4 * g + j) ? a[q][j] : 0.f;
#pragma unroll
          for (int j = 0; j < 4; ++j) F0[i * 64 + j * 16 + 4 * mt + g] = lab[j]; }
      asm volatile("" ::: "memory");
#define ST1_STORE(DST, INCL) do { _Pragma("unroll") for (int q = 0; q < 2; ++q) { const int tt = 16 * (nt0 + q) + lq, i0 = 16 * mt + 4 * g; float v_[4]; \
          _Pragma("unroll") for (int j = 0; j < 4; ++j) v_[j] = (i0 + j < tt + (INCL)) ? a[q][j] : 0.f; \
          u32x2 p_; p_.x = pk2(v_[0], v_[1]); p_.y = pk2(v_[2], v_[3]); *(u32x2*)((DST) + tt * ST + i0) = p_; } } while (0)
      ZACC(a); mm_tile(A2, ST, A0, ST, 2, a, w, lq, g); ST1_STORE(A7, 0); asm volatile("" ::: "memory");
      ZACC(a); mm_tile(A1, ST, A3, ST, 2, a, w, lq, g); ST1_STORE(A8, 1); asm volatile("" ::: "memory");
      ZACC(a); mm_tile(A2, ST, A3, ST, 2, a, w, lq, g); ST1_STORE(A9, 1);
#undef ST1_STORE
    }
    LDS_BARRIER();
    { const int mt = w >> 1, nt0 = 2 * (w & 1); f32x4 a[2]; ZACC(a);
      mm_tile2<true, false>(A6, ST, A7, ST, 2, a, w, lq, g);
#pragma unroll
      for (int q = 0; q < 2; ++q) *(f32x4*)(F1 + (16 * (nt0 + q) + lq) * 128 + 64 + 16 * mt + 4 * g) = a[q]; }
    LDS_BARRIER();
    { float X[16];
      const int col = 16 * w + lq;
#pragma unroll
      for (int r = 0; r < 16; ++r) X[r] = F1[(4 * r + g) * 128 + col];
      LDS_BARRIER();
      f32x4 Lc[4];
#pragma unroll
      for (int q = 0; q < 4; ++q) Lc[q] = *(const f32x4*)(F0 + g * 16 + 4 * q);
#pragma unroll
      for (int i = 0; i < 64; ++i) {
          const float xi = __shfl(X[i >> 2], (i & 3) * 16 + lq);
          f32x4 Ln[4];
#pragma unroll
          for (int q = 0; q < 4; ++q) Ln[q] = Lc[q];
          if (i + 1 < 64) {
#pragma unroll
              for (int q = ((i + 1) >> 4); q < 4; ++q) Ln[q] = *(const f32x4*)(F0 + (i + 1) * 64 + g * 16 + 4 * q);
          }
#pragma unroll
          for (int r = (i >> 2); r < 16; ++r) X[r] += Lc[r >> 2][r & 3] * xi;
#pragma unroll
          for (int q = 0; q < 4; ++q) Lc[q] = Ln[q];
          __builtin_amdgcn_sched_barrier(0);
      }
      bf16* XT = (bf16*)F1 + (w >> 2) * 4608 + ((col & 63) * ST);
#pragma unroll
      for (int r = 0; r < 16; ++r) XT[4 * r + g] = (bf16)f2bf(X[r]); }
    LDS_BARRIER();
    { const int mt = w >> 1, nt0 = 2 * (w & 1);
      const bf16* AhT = (const bf16*)F1; const bf16* W2T = AhT + 4608;
      unsigned char* ua = B.UA + (size_t)u * UNIT_A; unsigned char* ub = B.UB + (size_t)u * UNIT_B;
      const int p0 = 32 * (mt >> 1) + 8 * g + 4 * (mt & 1);
      f32x4 a[2];
      ZACC(a); mm_tile2<false, true>(AhT, ST, A4, ST, 2, a, w, lq, g);
#pragma unroll
      for (int q = 0; q < 2; ++q) { const int k = 16 * (nt0 + q) + lq; u32x2 o; o.x = pk2(a[q][0], a[q][1]); o.y = pk2(a[q][2], a[q][3]); *(u32x2*)(ua + swz(k, p0)) = o; }
      ZACC(a); mm_tile(AhT, ST, A8, ST, 2, a, w, lq, g);
#pragma unroll
      for (int q = 0; q < 2; ++q) { const int tt = 16 * (nt0 + q) + lq; const u32x2 rr = *(const u32x2*)(A3 + tt * ST + 16 * mt + 4 * g);
          u32x2 o; o.x = pk2(a[q][0] + bflo(rr.x), a[q][1] + bfhi(rr.x)); o.y = pk2(a[q][2] + bflo(rr.y), a[q][3] + bfhi(rr.y)); *(u32x2*)(ua + 8192 + swz(tt, p0)) = o; }
      ZACC(a); mm_tile2<true, false>(A4, ST, W2T, ST, 2, a, w, lq, g); mm_tile2<true, true>(A5, ST, A6, ST, 2, a, w, lq, g);
#pragma unroll
      for (int q = 0; q < 2; ++q) { const int v = 16 * (nt0 + q) + lq, k0 = 16 * mt + 4 * g; u32x2 o; o.x = pk2(a[q][0], a[q][1]); o.y = pk2(a[q][2], a[q][3]); *(u32x2*)(ub + swz(v, k0)) = o; }
      ZACC(a); mm_tile(A8, ST, W2T, ST, 2, a, w, lq, g); mm_tile2<false, true>(A9, ST, A6, ST, 2, a, w, lq, g);
#pragma unroll
      for (int q = 0; q < 2; ++q) { const int v = 16 * (nt0 + q) + lq, t0 = 16 * mt + 4 * g; u32x2 o; o.x = pk2(a[q][0], a[q][1]); o.y = pk2(a[q][2], a[q][3]); *(u32x2*)(ub + 8192 + swz(v, t0)) = o; } }
    LDS_BARRIER();
}
__device__ __forceinline__ void phase_rwkv_prep(const Params& P, int l, const Ctx& c) {
    const RwkvBufs B = rwkv_bufs(P, c);
    float pw0[8], pa0[8], pkk[8], pka[8], prk[8]; int hprev = -1;
    for (int u = c.bid; u < NUNIT; u += c.G) {
        const int h = u & 7;
        if (h != hprev) { hprev = h; const int j0 = l * 512 + h * 64 + (c.tid & 7) * 8;
#pragma unroll
            for (int i = 0; i < 8; ++i) { pw0[i] = P.in[9][j0 + i]; pa0[i] = P.in[11][j0 + i]; pkk[i] = P.in[14][j0 + i]; pka[i] = P.in[15][j0 + i]; prk[i] = P.in[16][j0 + i]; } }
        rwkv_prep_unit(P, l, c, u, B, pw0, pa0, pkk, pka, prk);
    }
}

constexpr int SLOTB = 33280, YST = 68;
__device__ __forceinline__ void scan_chunked(const Params& P, const Ctx& c, int bh) {
    const RwkvBufs B = rwkv_bufs(P, c);
    const int b = bh >> 3, h = bh & 7, w = c.wave, lane = c.lane, lq = lane & 15, g = lane >> 4;
    const size_t rowb = (size_t)b * LP;
    const int ll = c.tid;
    unsigned char* L = c.lds;
    f32x4 st[4];
#pragma unroll
    for (int i = 0; i < 4; ++i) st[i] = (f32x4){0.f, 0.f, 0.f, 0.f};
    u32x4 r0[5], r1[5], r2[5], r3[5], r4[5];
#define SC_UNIT(cc) ((size_t)((b * NCHK + (cc)) * 8 + h))
#define SC_LOAD(R, cc) do { const unsigned char* pa_ = B.UA + SC_UNIT(cc) * UNIT_A; const unsigned char* pb_ = B.UB + SC_UNIT(cc) * UNIT_B; \
        _Pragma("unroll") for (int i_ = 0; i_ < 2; ++i_) { R[i_] = GLD(u32x4, pa_ + (ll + 512 * i_) * 16); R[2 + i_] = GLD(u32x4, pb_ + (ll + 512 * i_) * 16); } \
        if (ll < 16) R[4] = GLD(u32x4, pb_ + 16384 + ll * 16); } while (0)
#define SC_WRITE(R, slot) do { unsigned char* s_ = L + (slot) * SLOTB; \
        _Pragma("unroll") for (int i_ = 0; i_ < 2; ++i_) { *(u32x4*)(s_ + (ll + 512 * i_) * 16) = R[i_]; *(u32x4*)(s_ + 16384 + (ll + 512 * i_) * 16) = R[2 + i_]; } \
        if (ll < 16) *(u32x4*)(s_ + 32768 + ll * 16) = R[4]; } while (0)
#define SC_COMPUTE(ci) do { \
        const unsigned char* sl = L + ((ci) % 3) * SLOTB; \
        const int vcol = 16 * w + lq; \
        bf16x8 gaf[4][2]; f32x4 gcf[4]; u32x2 d0f[4]; \
        _Pragma("unroll") for (int mt = 0; mt < 4; ++mt) { \
            gcf[mt] = *(const f32x4*)(sl + 32768 + (16 * mt + 4 * g) * 4); \
            d0f[mt] = *(const u32x2*)(sl + 16384 + swz(vcol, 16 * mt + 4 * g)); \
            _Pragma("unroll") for (int ks = 0; ks < 2; ++ks) gaf[mt][ks] = *(const bf16x8*)(sl + swz(16 * mt + lq, 32 * ks + 8 * g)); } \
        __builtin_amdgcn_sched_barrier(0);        \
        bf16x8 sb[2]; \
        _Pragma("unroll") for (int ks = 0; ks < 2; ++ks) { u32x4 pw; pw.x = pk2(st[2 * ks][0], st[2 * ks][1]); pw.y = pk2(st[2 * ks][2], st[2 * ks][3]); pw.z = pk2(st[2 * ks + 1][0], st[2 * ks + 1][1]); pw.w = pk2(st[2 * ks + 1][2], st[2 * ks + 1][3]); \
            sb[ks] = __builtin_bit_cast(bf16x8, pw); } \
        _Pragma("unroll") for (int mt = 0; mt < 4; ++mt) { \
            f32x4 ns = (f32x4){bflo(d0f[mt].x), bfhi(d0f[mt].x), bflo(d0f[mt].y), bfhi(d0f[mt].y)} + gcf[mt] * st[mt]; \
            _Pragma("unroll") for (int ks = 0; ks < 2; ++ks) ns = __builtin_amdgcn_mfma_f32_16x16x32_bf16(gaf[mt][ks], sb[ks], ns, 0, 0, 0); \
            st[mt] = ns; } \
        bf16x8 rhf[4][2]; u32x2 y0f[4];        \
        _Pragma("unroll") for (int mt = 0; mt < 4; ++mt) { y0f[mt] = *(const u32x2*)(sl + 24576 + swz(vcol, 16 * mt + 4 * g)); \
            _Pragma("unroll") for (int ks = 0; ks < 2; ++ks) rhf[mt][ks] = *(const bf16x8*)(sl + 8192 + swz(16 * mt + lq, 32 * ks + 8 * g)); } \
        __builtin_amdgcn_sched_barrier(0); \
        f32x4 yav[4]; \
        _Pragma("unroll") for (int mt = 0; mt < 4; ++mt) { yav[mt] = (f32x4){bflo(y0f[mt].x), bfhi(y0f[mt].x), bflo(y0f[mt].y), bfhi(y0f[mt].y)}; \
            _Pragma("unroll") for (int ks = 0; ks < 2; ++ks) yav[mt] = __builtin_amdgcn_mfma_f32_16x16x32_bf16(rhf[mt][ks], sb[ks], yav[mt], 0, 0, 0); } \
        _Pragma("unroll") for (int mt = 0; mt < 4; ++mt) { \
            float* yl = (float*)(L + 3 * SLOTB) + ((ci) & 1) * (64 * YST) + (16 * mt + 4 * g) * YST + vcol; \
            _Pragma("unroll") for (int j = 0; j < 4; ++j) yl[j * YST] = yav[mt][j]; } } while (0)
#define SC_YSTORE(ci) do { const float* ys_ = (const float*)(L + 3 * SLOTB) + ((ci) & 1) * (64 * YST) + (c.tid >> 3) * YST + (c.tid & 7) * 8; \
        float* yg_ = B.Y + (rowb + (ci) * 64 + (c.tid >> 3)) * 512 + h * 64 + (c.tid & 7) * 8; \
        GST(f32x4, yg_) = *(const f32x4*)ys_; GST(f32x4, yg_ + 4) = *(const f32x4*)(ys_ + 4); } while (0)
#define SC_ITER(ci, R) do { if ((ci) + 2 < NCHK) SC_WRITE(R, ((ci) + 2) % 3); if ((ci) + 7 < NCHK) SC_LOAD(R, (ci) + 7); if ((ci) > 0) SC_YSTORE((ci) - 1); if (w < 4) { SC_COMPUTE(ci); } LDS_BARRIER(); } while (0)
    { SC_LOAD(r0, 0); SC_LOAD(r1, 1); SC_WRITE(r0, 0); SC_WRITE(r1, 1); SC_LOAD(r2, 2); SC_LOAD(r3, 3); SC_LOAD(r4, 4); SC_LOAD(r0, 5); SC_LOAD(r1, 6); }
    __syncthreads();
#pragma unroll 1
    for (int cc = 0; cc < NCHK; cc += 5) { SC_ITER(cc, r2); SC_ITER(cc + 1, r3); SC_ITER(cc + 2, r4); SC_ITER(cc + 3, r0); SC_ITER(cc + 4, r1); }
    SC_YSTORE(NCHK - 1);
#undef SC_YSTORE
#undef SC_COMPUTE
#undef SC_ITER
#undef SC_UNIT
#undef SC_LOAD
#undef SC_WRITE
}

__device__ __forceinline__ void phase_gn(const Params& P, int l, const Ctx& c) {
    const RwkvBufs B = rwkv_bufs(P, c);
    const int gw = c.bid * NWAVES + c.wave, NGW = c.G * NWAVES;
    const int c0 = 8 * c.lane;
    float gnw[8], gnb[8];
#pragma unroll
    for (int i = 0; i < 8; ++i) { gnw[i] = P.in[17][l * 512 + c0 + i]; gnb[i] = P.in[18][l * 512 + c0 + i]; }
    f32x4 ny0, ny1; u32x4 nbw, ngw;
#define GN_LOAD(mm) do { const size_t o_ = (size_t)(mm) * 512 + c0; ny0 = *(const f32x4*)(B.Y + o_); ny1 = *(const f32x4*)(B.Y + o_ + 4); nbw = *(const u32x4*)(B.BON + o_); ngw = *(const u32x4*)(B.G + o_); } while (0)
    if (gw < M) GN_LOAD(gw);
    for (int m = gw; m < M; m += NGW) {
        const size_t o = (size_t)m * 512 + c0;
        const f32x4 y0 = ny0, y1 = ny1; const u32x4 bw = nbw, gw4 = ngw;
        if (m + NGW < M) GN_LOAD(m + NGW);
        float y[8] = {y0.x, y0.y, y0.z, y0.w, y1.x, y1.y, y1.z, y1.w};
        const float bo[8] = {bflo(bw.x), bfhi(bw.x), bflo(bw.y), bfhi(bw.y), bflo(bw.z), bfhi(bw.z), bflo(bw.w), bfhi(bw.w)};
        const float gg[8] = {bflo(gw4.x), bfhi(gw4.x), bflo(gw4.y), bfhi(gw4.y), bflo(gw4.z), bfhi(gw4.z), bflo(gw4.w), bfhi(gw4.w)};
        float s = 0.f;
#pragma unroll
        for (int i = 0; i < 8; ++i) s += y[i];
        s += __shfl_xor(s, 1); s += __shfl_xor(s, 2); s += __shfl_xor(s, 4);
        const float mean = s * (1.f / 64.f);
        float q = 0.f;
#pragma unroll
        for (int i = 0; i < 8; ++i) { y[i] -= mean; q += y[i] * y[i]; }
        q += __shfl_xor(q, 1); q += __shfl_xor(q, 2); q += __shfl_xor(q, 4);
        const float rstd = 1.0f / sqrtf(q * (1.f / 64.f) + 64e-5f);
        float ov[8];
#pragma unroll
        for (int i = 0; i < 8; ++i) ov[i] = (y[i] * rstd * gnw[i] + gnb[i] + bo[i]) * gg[i];
        u32x4 ow; ow.x = pk2(ov[0], ov[1]); ow.y = pk2(ov[2], ov[3]); ow.z = pk2(ov[4], ov[5]); ow.w = pk2(ov[6], ov[7]);
        *(u32x4*)(B.ORW + o) = ow;
    }
}

__device__ __forceinline__ void attn_unit(const Ctx& c, int bh, int qb, const bf16* Q, const bf16* K, const bf16* V, bf16* O, const float* FC, float qkb2, const float* gq, const float* gk) {
    const int b = bh >> 3, h = bh & 7, lane = c.lane, w = c.wave, lq = lane & 15, g = lane >> 4;
    const int q0 = qb * 128;
    const size_t rowb = (size_t)b * LP;
    const int qrow = q0 + 16 * w + lq;
    bf16* Ks = (bf16*)c.lds; bf16* Vt = Ks + 64 * 72; float* fks = (float*)(Vt + 64 * 72);
    const bf16* qp = Q + (rowb + qrow) * 512 + h * 64 + 8 * g;
    bf16x8 qf0, qf1;
    { const u32x4 r0 = GLD(u32x4, qp), r1 = GLD(u32x4, qp + 32);
      float x[16] = {bflo(r0.x), bfhi(r0.x), bflo(r0.y), bfhi(r0.y), bflo(r0.z), bfhi(r0.z), bflo(r0.w), bfhi(r0.w), bflo(r1.x), bfhi(r1.x), bflo(r1.y), bfhi(r1.y), bflo(r1.z), bfhi(r1.z), bflo(r1.w), bfhi(r1.w)};
      float ss = 0.f;
#pragma unroll
      for (int i = 0; i < 16; ++i) ss += x[i] * x[i];
      ss += __shfl_xor(ss, 16); ss += __shfl_xor(ss, 32);
      const float rs = QSCALE / sqrtf(ss * (1.f / 64.f) + 1e-6f);
#pragma unroll
      for (int i = 0; i < 8; ++i) { x[i] *= rs * gq[8 * g + i]; x[8 + i] *= rs * gq[32 + 8 * g + i]; }
      u32x4 p0, p1; p0.x = pk2(x[0], x[1]); p0.y = pk2(x[2], x[3]); p0.z = pk2(x[4], x[5]); p0.w = pk2(x[6], x[7]); p1.x = pk2(x[8], x[9]); p1.y = pk2(x[10], x[11]); p1.z = pk2(x[12], x[13]); p1.w = pk2(x[14], x[15]);
      qf0 = __builtin_bit_cast(bf16x8, p0); qf1 = __builtin_bit_cast(bf16x8, p1); }
    const float* FCh = FC + (size_t)bh * LP;
    const float fq = GLD(float, FCh + qrow);
    float mrun = -1e30f, lsum = 0.f;
    f32x4 o[4];
#pragma unroll
    for (int i = 0; i < 4; ++i) o[i] = (f32x4){0.f, 0.f, 0.f, 0.f};
    const int kt_max = (q0 + 127) >> 6;
    const int lkey = c.tid >> 3, lch = c.tid & 7;
    float gkr[8];
#pragma unroll
    for (int i = 0; i < 8; ++i) gkr[i] = gk[lch * 8 + i];
    const size_t gbase = (rowb + lkey) * 512 + h * 64 + lch * 8;
    u32x4 kv = GLD(u32x4, K + gbase + (size_t)kt_max * 64 * 512), vv = GLD(u32x4, V + gbase + (size_t)kt_max * 64 * 512);
    float fkv = GLD(float, FCh + kt_max * 64 + (c.tid & 63));
    volatile unsigned* vote = (volatile unsigned*)(fks + 64);
    for (int kt = kt_max; kt >= 0; --kt) {
        const int k0 = kt * 64;
        LDS_BARRIER();
        { int can = 0; if (kt < kt_max) { const float fl = __shfl(fkv, 63); can = (qkb2 + fq - fl) < (mrun - THR2); }
          const int wall = __all(can); if (lane == 0) vote[w] = (unsigned)wall; }
        { { float x[8] = {bflo(kv.x), bfhi(kv.x), bflo(kv.y), bfhi(kv.y), bflo(kv.z), bfhi(kv.z), bflo(kv.w), bfhi(kv.w)}; float ss = 0.f;
#pragma unroll
              for (int i = 0; i < 8; ++i) ss += x[i] * x[i];
              ss += __shfl_xor(ss, 1); ss += __shfl_xor(ss, 2); ss += __shfl_xor(ss, 4);
              const float rs = 1.0f / sqrtf(ss * (1.f / 64.f) + 1e-6f);
              u32x4 kn; kn.x = pk2(x[0] * rs * gkr[0], x[1] * rs * gkr[1]); kn.y = pk2(x[2] * rs * gkr[2], x[3] * rs * gkr[3]); kn.z = pk2(x[4] * rs * gkr[4], x[5] * rs * gkr[5]); kn.w = pk2(x[6] * rs * gkr[6], x[7] * rs * gkr[7]);
              *(u32x4*)(Ks + lkey * 72 + lch * 8) = kn; }
            bf16* vd = Vt + (lch * 8) * 72 + (lkey ^ (8 * lch));
            vd[0] = (bf16)(vv.x & 0xffff); vd[72] = (bf16)(vv.x >> 16); vd[144] = (bf16)(vv.y & 0xffff); vd[216] = (bf16)(vv.y >> 16);
            vd[288] = (bf16)(vv.z & 0xffff); vd[360] = (bf16)(vv.z >> 16); vd[432] = (bf16)(vv.w & 0xffff); vd[504] = (bf16)(vv.w >> 16);
            if (c.tid < 64) fks[c.tid] = fkv;
            if (kt > 0) { kv = GLD(u32x4, K + gbase + (size_t)(k0 - 64) * 512); vv = GLD(u32x4, V + gbase + (size_t)(k0 - 64) * 512); fkv = GLD(float, FCh + k0 - 64 + (c.tid & 63)); } }
        LDS_BARRIER();
        { unsigned all = vote[0] & vote[1] & vote[2] & vote[3] & vote[4] & vote[5] & vote[6] & vote[7]; if (all) break; }
        if (k0 > q0 + 16 * w + 15) continue;
        f32x4 s[4];
#pragma unroll
        for (int nt = 0; nt < 4; ++nt) { const bf16* kp = Ks + (16 * nt + lq) * 72 + 8 * g; const bf16x8 a0 = *(const bf16x8*)kp, a1 = *(const bf16x8*)(kp + 32);
            s[nt] = __builtin_amdgcn_mfma_f32_16x16x32_bf16(a0, qf0, (f32x4){0.f, 0.f, 0.f, 0.f}, 0, 0, 0);
            s[nt] = __builtin_amdgcn_mfma_f32_16x16x32_bf16(a1, qf1, s[nt], 0, 0, 0); }
        float mx = -INFINITY;
#pragma unroll
        for (int nt = 0; nt < 4; ++nt) { const f32x4 fk = *(const f32x4*)(fks + 16 * nt + 4 * g);
#pragma unroll
            for (int j = 0; j < 4; ++j) { float x = s[nt][j] + fq - fk[j]; const int key = k0 + 16 * nt + 4 * g + j; if (key > qrow) x = -INFINITY; s[nt][j] = x; mx = fmaxf(mx, x); } }
        mx = fmaxf(mx, __shfl_xor(mx, 16)); mx = fmaxf(mx, __shfl_xor(mx, 32));
        const float mnew = fmaxf(mrun, mx), alpha = __builtin_amdgcn_exp2f(mrun - mnew); mrun = mnew;
        float psum = 0.f;
#pragma unroll
        for (int nt = 0; nt < 4; ++nt)
#pragma unroll
            for (int j = 0; j < 4; ++j) { const float p = __builtin_amdgcn_exp2f(s[nt][j] - mnew); s[nt][j] = p; psum += p; }
        lsum = lsum * alpha + psum;
#pragma unroll
        for (int dt = 0; dt < 4; ++dt) o[dt] = o[dt] * alpha;
        bf16x8 pb[2];
#pragma unroll
        for (int k2 = 0; k2 < 2; ++k2) { u32x4 pw; pw.x = pk2(s[2 * k2][0], s[2 * k2][1]); pw.y = pk2(s[2 * k2][2], s[2 * k2][3]); pw.z = pk2(s[2 * k2 + 1][0], s[2 * k2 + 1][1]); pw.w = pk2(s[2 * k2 + 1][2], s[2 * k2 + 1][3]);
            pb[k2] = __builtin_bit_cast(bf16x8, pw); }
#pragma unroll
        for (int dt = 0; dt < 4; ++dt)
#pragma unroll
            for (int k2 = 0; k2 < 2; ++k2) { const int vrow = 16 * dt + lq, vx = 8 * ((vrow >> 3) & 7); const bf16* vp = Vt + vrow * 72;
                const u32x2 lo = *(const u32x2*)(vp + ((32 * k2 + 4 * g) ^ vx)), hi = *(const u32x2*)(vp + ((32 * k2 + 16 + 4 * g) ^ vx));
                u32x4 aw; aw.x = lo.x; aw.y = lo.y; aw.z = hi.x; aw.w = hi.y;
                o[dt] = __builtin_amdgcn_mfma_f32_16x16x32_bf16(__builtin_bit_cast(bf16x8, aw), pb[k2], o[dt], 0, 0, 0); }
    }
    lsum += __shfl_xor(lsum, 16); lsum += __shfl_xor(lsum, 32);
    const float inv = 1.0f / lsum;
    bf16* op = O + (rowb + qrow) * 512 + h * 64 + 4 * g;
#pragma unroll
    for (int dt = 0; dt < 4; ++dt) { u32x2 ow; ow.x = pk2(o[dt][0] * inv, o[dt][1] * inv); ow.y = pk2(o[dt][2] * inv, o[dt][3] * inv); GST(u32x2, op + 16 * dt) = ow; }
    __syncthreads();
}
__device__ __forceinline__ void phase_attn(const Params& P, int l, const Ctx& c, int first_blk) {
    const bf16* Q = (const bf16*)(c.ws + OFF_Q); const bf16* K = (const bf16*)(c.ws + OFF_K); const bf16* V = (const bf16*)(c.ws + OFF_V);
    const float* FC = (const float*)(c.ws + OFF_MISC) + 16 * LP;
    float gqm = fabsf(P.in[5][l * 64 + c.lane]), gkm = fabsf(P.in[6][l * 64 + c.lane]);
#pragma unroll
    for (int o = 1; o < 64; o <<= 1) { gqm = fmaxf(gqm, __shfl_xor(gqm, o)); gkm = fmaxf(gkm, __shfl_xor(gkm, o)); }
    const float qkb2 = 8.0f * gqm * gkm * LOG2E * 1.03f;
    constexpr int NQB = LP / 128, NU = 16 * NQB;
    unsigned* ctr = (unsigned*)(c.ws + OFF_CTL) + 8192 + 64 * l;
    volatile unsigned* slot = (volatile unsigned*)(c.lds + MISC_OFF) + 4;
    for (;;) {
        __syncthreads();
        if (c.tid == 0) *slot = atomicAdd(ctr, 1u);
        __syncthreads();
        const int u = (int)*slot;
        if (u >= NU) break;
        const int bh = u & 15, qb = NQB - 1 - (u >> 4); attn_unit(c, bh, qb, Q, K, V, (bf16*)(c.ws + OFF_OF), FC, qkb2, P.in[5] + l * 64, P.in[6] + l * 64);
    }
}

__device__ __forceinline__ void phase_fixup(const Params& P, int l, const Ctx& c) {
    bf16* ACT = (bf16*)(c.ws + OFF_RW); const bf16* HALO = (const bf16*)(c.ws + OFF_Q);
    const float* cw = P.in[24] + (size_t)l * 3 * NUP;
    const int total = (M / 64) * 2 * DFF;
    for (int idx = c.bid * NTHR + c.tid; idx < total; idx += c.G * NTHR) {
        const int rr = idx / DFF, ch = idx - rr * DFF, q64 = rr >> 1, e = rr & 1, row = q64 * 64 + e;
        const int t = row % LP;
        int s0, s1, s2;
        if (e == 0) { s0 = q64 * 4 + 2; s1 = (q64 - 1) * 4 + 1; s2 = (q64 - 1) * 4 + 0; } else { s0 = q64 * 4 + 3; s1 = q64 * 4 + 2; s2 = (q64 - 1) * 4 + 1; }
        float uc[2];
#pragma unroll
        for (int bj = 0; bj < 2; ++bj) { const int col = bj * DFF + ch;
            const float u0 = bf2f(HALO[(size_t)s0 * NUP + col]);
            const float u1 = (t >= 1) ? bf2f(HALO[(size_t)s1 * NUP + col]) : 0.f;
            const float u2 = (t >= 2) ? bf2f(HALO[(size_t)s2 * NUP + col]) : 0.f;
            uc[bj] = cw[col] * u2 + cw[NUP + col] * u1 + cw[2 * NUP + col] * u0; }
        ACT[(size_t)row * DFF + ch] = (bf16)f2bf(uc[0] * sigmoidf_(uc[0]) * uc[1]);
    }
}

#define OPQ_S(x) asm volatile("" : "+s"(x))
#define OPQ_V(x) asm volatile("" : "+v"(x))
#define PHASE_BEGIN() do { int t_ = threadIdx.x; OPQ_V(t_); c.tid = t_; c.lane = t_ & 63; c.wave = __builtin_amdgcn_readfirstlane(t_ >> 6); int b_ = blockIdx.x; OPQ_S(b_); c.bid = b_; \
    size_t z_ = 0; OPQ_S(z_); unsigned char* w_ = P.ws + z_;   c.ws = w_; ws = w_; l = lc; OPQ_S(l); WT = (pg8::bf16_t*)(ws + OFF_WT); HN = (pg8::bf16_t*)(ws + OFF_HN); } while (0)
__global__ void __launch_bounds__(NTHR, 2) mega(Params P) {
    extern __shared__ __attribute__((aligned(16))) unsigned char lds[];
    Ctx c; c.G = gridDim.x; c.lds = lds;
    volatile LAS unsigned* MISC = (volatile LAS unsigned*)((LAS unsigned char*)lds + MISC_OFF);
    if (threadIdx.x < 16) MISC[threadIdx.x] = 0u;
    __syncthreads();
    (void)xcd_barrier_post((unsigned*)(P.ws + OFF_CTL) + 1024, MISC + 8);
#define SEAM() do { XcdBarrier xb_; xb_.bar = (unsigned*)(P.ws + OFF_CTL) + 1024; xb_.x = xb_xcc_id(); xb_.st = (volatile LAS unsigned*)((LAS unsigned char*)lds + MISC_OFF) + 8; xcd_barrier(xb_); } while (0)
    PG8_LAS unsigned char* ldsl = (PG8_LAS unsigned char*)lds;
    unsigned char* ws; pg8::bf16_t* WT; pg8::bf16_t* HN; int l;
#pragma unroll 1
    for (int lc = 0; lc < DEPTH; ++lc) {
        PHASE_BEGIN();
        convert_weights(P, l, c);
        phase_norm<true>(P, l, c);
        SEAM();
        if (P.out == nullptr) cg::this_grid().sync();
        PHASE_BEGIN();
        phase_fcum(P, c);
        { pg8::Gemm g{HN, WT + WT_IN, M, N1, 1024, 1024}; pg8::StaticOrder S; S.init(M, N1, c.G, c.bid);
          pg8::EpiRoute E{ws};
          pg8::gemm_phase<pg8::EpiRoute, pg8::StaticOrder, true, true>(ldsl, g, S, E); }
        SEAM();
        PHASE_BEGIN();
        for (int rep_ = 0; rep_ < REP_PREP; ++rep_) phase_rwkv_prep(P, l, c);
        SEAM();
        PHASE_BEGIN();
        if (c.bid < 16) { scan_chunked(P, c, c.bid); __syncthreads(); PHASE_BEGIN(); }
        phase_attn(P, l, c, 16);
#if REP_P3 > 1
        __syncthreads(); PHASE_BEGIN();
        if (c.bid < 16) scan_chunked(P, c, c.bid); else phase_attn(P, l, c, 16);
#endif
        SEAM();
        PHASE_BEGIN();
        phase_gn(P, l, c);
        for (int rep_ = 0; rep_ < REP_SYNC; ++rep_) SEAM();
        SEAM();
        PHASE_BEGIN();
#pragma unroll 1
        for (int pass = 0; pass < 3; ++pass) {
            if (pass) { __syncthreads(); PHASE_BEGIN(); }
            const int rw_side = pass == 2 ? ((c.bid >> 2) & 1) : pass;
            const pg8::bf16_t* A = rw_side ? (const pg8::bf16_t*)(ws + OFF_RW + (size_t)M * 512 * 4) : (const pg8::bf16_t*)(ws + OFF_OF);
            pg8::Gemm g{A, WT + (rw_side ? WT_BR : WT_BF), M, 1024, 512, 512};
            pg8::OneUnit S; S.so.init(MMAIN, 1024, c.G, c.bid); S.mode = pass == 2; S.pm = MMAIN / 256; S.pn = c.bid & 3; S.active = c.bid < 8;
            pg8::bf16_t* O = (pass == 2 && rw_side) ? (pg8::bf16_t*)(ws + OFF_TAIL) - (size_t)MMAIN * 1024 : (pg8::bf16_t*)(ws + OFF_K);
            pg8::EpiGateR E{O, (const pg8::bf16_t*)(ws + OFF_GT), P.in[21] + l * NGT, rw_side * 1024, pass == 1};
            pg8::gemm_phase<pg8::EpiGateR, pg8::OneUnit, true, true>(ldsl, g, S, E);
        }
        SEAM();
        PHASE_BEGIN();
#pragma unroll 1
        for (int pass = 0; pass < 2; ++pass) {
            if (pass) { __syncthreads(); PHASE_BEGIN(); }
            const int sl = pass ? (c.bid >> 2) : 0, ks = sl & 3;
            const pg8::bf16_t* A = (pass && sl >= 4) ? (const pg8::bf16_t*)(ws + OFF_TAIL) - (size_t)MMAIN * 1024 : (const pg8::bf16_t*)(ws + OFF_K);
            pg8::Gemm g{A + ks * 256, WT + WT_O + ks * 256, M, 1024, pass ? 256 : 1024, 1024};
            pg8::OneUnit S; S.so.init(MMAIN, 1024, c.G, c.bid); S.mode = pass; S.pm = MMAIN / 256; S.pn = c.bid & 3; S.active = sl < 8;
            pg8::EpiResid E{(float*)(ws + OFF_H), nullptr, pass};
            pg8::gemm_phase<pg8::EpiResid, pg8::OneUnit, true, true>(ldsl, g, S, E);
        }
        SEAM();
        PHASE_BEGIN();
        phase_norm<false>(P, l, c);
        SEAM();
        PHASE_BEGIN();
        { pg8::Gemm g{HN, WT + WT_UP, M, NUP, 1024, 1024}; pg8::StaticOrder S; S.init(M, NUP, c.G, c.bid);
          pg8::EpiUp E{(pg8::bf16_t*)(ws + OFF_RW), (pg8::bf16_t*)(ws + OFF_Q), P.in[24] + (size_t)l * 3 * NUP};
          pg8::gemm_phase<pg8::EpiUp, pg8::StaticOrder, true, true>(ldsl, g, S, E); }
        SEAM();
        PHASE_BEGIN();
        phase_fixup(P, l, c);
        SEAM();
        PHASE_BEGIN();
#pragma unroll 1
        for (int pass = 0; pass < 2; ++pass) {
            if (pass) { __syncthreads(); PHASE_BEGIN(); }
            const int sl = pass ? (c.bid >> 2) : 0;
            const int ko = (sl < 6) ? sl * 384 : 2304 + (sl - 6) * 256, kl = (sl < 6) ? 384 : 256;
            pg8::Gemm g{(const pg8::bf16_t*)(ws + OFF_RW) + (pass ? ko : 0), WT + WT_DN + (pass ? ko : 0), M, 1024, pass ? kl : DFF, DFF};
            pg8::OneUnit S; S.so.init(MMAIN, 1024, c.G, c.bid); S.mode = pass; S.pm = MMAIN / 256; S.pn = c.bid & 3; S.active = sl < 8;
            pg8::EpiResid E{(float*)(ws + OFF_H), (l == DEPTH - 1 && !pass) ? P.out : nullptr, pass};
            pg8::gemm_phase<pg8::EpiResid, pg8::OneUnit, true, true>(ldsl, g, S, E);
        }
        SEAM();
        if (l == DEPTH - 1) {
            PHASE_BEGIN();
            const float* H = (const float*)(ws + OFF_H);
            for (int idx = c.bid * NTHR + c.tid; idx < (NMETA + SEQ - (MMAIN - LP)) * (DM / 4); idx += c.G * NTHR) {
                const int r = idx / (DM / 4), q4 = idx - r * (DM / 4), t = (MMAIN - LP) + r;
                *(f32x4*)(P.out + ((size_t)SEQ + (t - NMETA)) * DM + 4 * q4) = *(const f32x4*)(H + (size_t)(LP + t) * DM + 4 * q4);
            }
        }
    }
}

extern "C" void kernel_launch(void* const* d_in, const int* in_sizes, int n_in, void* d_out, int out_size, void* d_ws, size_t ws_size, hipStream_t stream) {
    static int grid = 0;
    if (grid == 0) {
        if (n_in != 26 || out_size != NB * SEQ * DM || ws_size < WS_NEED) { fprintf(stderr, "kernel_launch: unexpected shapes (n_in %d out %d ws %zu need %zu)\n", n_in, out_size, ws_size, (size_t)WS_NEED); grid = -1; return; }
        int dev = 0, cus = 0, per_cu = 0;
        if (hipGetDevice(&dev) != hipSuccess || hipDeviceGetAttribute(&cus, hipDeviceAttributeMultiprocessorCount, dev) != hipSuccess) { grid = -1; return; }
        if (hipFuncSetAttribute((const void*)mega, hipFuncAttributeMaxDynamicSharedMemorySize, LDS_BYTES) != hipSuccess) { fprintf(stderr, "kernel_launch: hipFuncSetAttribute failed\n"); grid = -1; return; }
        if (hipOccupancyMaxActiveBlocksPerMultiprocessor(&per_cu, (const void*)mega, NTHR, LDS_BYTES) != hipSuccess || per_cu < 1) { fprintf(stderr, "kernel_launch: occupancy query says %d\n", per_cu); per_cu = 1; }
        (void)hipGetLastError();
        grid = cus;
    }
    if (grid < 0) return;
    if (hipMemsetAsync((char*)d_ws + OFF_CTL, 0, 65536, stream) != hipSuccess) { fprintf(stderr, "kernel_launch: memset failed\n"); return; }
    Params p{};
    for (int i = 0; i < 26; ++i) p.in[i] = (const float*)d_in[i];
    p.out = (float*)d_out; p.ws = (unsigned char*)d_ws;
    void* args[] = {&p};
    hipError_t e = hipLaunchCooperativeKernel((const void*)mega, dim3(grid), dim3(NTHR), args, LDS_BYTES, stream);
    if (e != hipSuccess) fprintf(stderr, "kernel_launch: cooperative launch failed: %s (grid %d)\n", hipGetErrorString(e), grid);
}
```

```cpp
#include <hip/hip_runtime.h>
#include <hip/hip_cooperative_groups.h>
#include <cstdio>
#include <cstdint>
#include <cmath>
namespace cg = cooperative_groups;
namespace pg8 {
#define PG8_LAS __attribute__((address_space(3)))
typedef unsigned short bf16_t;
typedef short bf16x8 __attribute__((ext_vector_type(8)));
typedef float f32x4 __attribute__((ext_vector_type(4)));
typedef unsigned u32x4 __attribute__((ext_vector_type(4)));
constexpr int BM = 256, BK = 64, HALF = 128, HTB = HALF * BK * 2  , STAGE_BYTES = 8 * HTB, NXCD = 8, WGM = 8;

__host__ __device__ __forceinline__ int lds_byte(int r, int c) { const int st = (r >> 4) * 2 + (c >> 5), rr = r & 15, cc = c & 31, ob = rr * 64 + cc * 2; return st * 1024 + (ob ^ (((ob >> 9) & 1) << 5)); }
__host__ __device__ __forceinline__ void stage_rc(int b, int& R, int& C) { const int st = b / 1024, sb = b % 1024, swz = sb ^ (((sb >> 9) & 1) << 5); R = (st >> 1) * 16 + swz / 64; C = (st & 1) * 32 + (swz % 64) / 2; }
__host__ __device__ __forceinline__ int perm32(int rho) { const int n = rho >> 4, i = rho & 15; return 8 * (i >> 2) + 4 * n + (i & 3); }

struct Unit { int pm, pn; };
struct Gemm { const bf16_t* A; const bf16_t* Bt; int M, N, K, ld; };

struct StaticOrder {
    int nM, nN, nwg, G, c;
    __host__ __device__ void init(int M, int N, int G_, int c_) { nM = M / BM; nN = N / BM; nwg = nM * nN; G = G_; c = c_; }
    __host__ __device__ bool next(int i, Unit& u) const {
        const long L = (long)i * G + c; if (L >= nwg) return false;
        int wgid = (int)L; { const int q = nwg / NXCD, r = nwg % NXCD, xcd = wgid % NXCD, off = wgid / NXCD; wgid = (xcd < r ? xcd * (q + 1) : r * (q + 1) + (xcd - r) * q) + off; }
        const int nig = WGM * nN, gid = wgid / nig, fm = gid * WGM, gsz = (nM - fm) < WGM ? (nM - fm) : WGM;
        u.pm = fm + ((wgid % nig) % gsz); u.pn = (wgid % nig) / gsz; return true;
    }
    __device__ __forceinline__ void a_ready(const Unit&) const {}
    __device__ __forceinline__ void done(const Unit&) const {}
};

__device__ __forceinline__ unsigned cvt_pk_bf16(float lo, float hi) { unsigned r; asm volatile("v_cvt_pk_bf16_f32 %0, %1, %2" : "=v"(r) : "v"(lo), "v"(hi)); return r; }
typedef float f32x2 __attribute__((ext_vector_type(2)));
template <class Epi, class Sched, bool ALIGN_EPI = false, bool SP2 = false>
__device__ __forceinline__ void gemm_phase(PG8_LAS unsigned char* lds, const Gemm g, const Sched& S, const Epi& E) {
    int tid_ = threadIdx.x; asm volatile("" : "+v"(tid_)); const int tid = tid_, wid = __builtin_amdgcn_readfirstlane(tid >> 6), lane = tid & 63, wr = wid >> 2, wc = wid & 3, fr = lane & 15, fq = lane >> 4;
    const int K = g.K, nt = K / BK, LD = g.ld;
    unsigned voffA[2], voffB[2];
#pragma unroll
    for (int i = 0; i < 2; ++i) { int R, C; stage_rc(tid * 16 + i * 8192, R, C); const int Rb = Epi::PERM ? ((R & ~31) + perm32(R & 31)) : R;
        voffA[i] = (unsigned)(R * LD + C) * 2u; voffB[i] = (unsigned)(Rb * LD + C) * 2u; }
    const size_t kstep = (size_t)(BK * 2);
    const size_t hstep = (size_t)HALF * LD * 2;
    const size_t tstep = 2 * hstep;
    const unsigned ldsw = (unsigned)wid * 1024u;
    const int aoff = lds_byte(wr * 64 + fr, fq * 8), boff = lds_byte(wc * 32 + fr, fq * 8);
#define PG8_SA(b, h) (((b) * 2 + (h)) * HTB)
#define PG8_SB(b, h) ((4 + (b) * 2 + (h)) * HTB)
#define PG8_STAGE(bufoff, gbase, voff) do { _Pragma("unroll") for (int _i = 0; _i < 2; ++_i) \
        __builtin_amdgcn_global_load_lds((const unsigned*)((const char*)(gbase) + (voff)[_i]), (PG8_LAS unsigned*)(lds + (bufoff) + ldsw + _i * 8192), 16, 0, 0); } while (0)
#define PG8_LDA(dst, b, h) do { _Pragma("unroll") for (int m = 0; m < 4; ++m) _Pragma("unroll") for (int k = 0; k < 2; ++k) dst[m][k] = *(const PG8_LAS bf16x8*)(lds + PG8_SA(b, h) + aoff + m * 2048 + k * 1024); } while (0)
#define PG8_LDB(dst, b, h) do { _Pragma("unroll") for (int n = 0; n < 2; ++n) _Pragma("unroll") for (int k = 0; k < 2; ++k) dst[n][k] = *(const PG8_LAS bf16x8*)(lds + PG8_SB(b, h) + boff + n * 2048 + k * 1024); } while (0)
#define PG8_MMA(ai, bj, At, Bt) do { __builtin_amdgcn_s_setprio(1); _Pragma("unroll") for (int m = 0; m < 4; ++m) _Pragma("unroll") for (int n = 0; n < 2; ++n) _Pragma("unroll") for (int k = 0; k < 2; ++k) \
        acc[ai][bj][m][n] = __builtin_amdgcn_mfma_f32_16x16x32_bf16(Bt[n][k], At[m][k], acc[ai][bj][m][n], 0, 0, 0); __builtin_amdgcn_s_setprio(0); } while (0)
#define PG8_WAIT_V(n) asm volatile("s_waitcnt vmcnt(" #n ")" ::: "memory")
#define PG8_WAIT_L(n) asm volatile("s_waitcnt lgkmcnt(" #n ")" ::: "memory")
#define PG8_BAR __builtin_amdgcn_s_barrier()
#define PG8_SCHED __builtin_amdgcn_sched_barrier(0)
    Unit cur, nxt; int ui = 0;
    if (!S.next(0, cur)) return;
    f32x4 acc[2][2][4][2];
#pragma unroll
    for (int a = 0; a < 2; ++a)
#pragma unroll
        for (int b = 0; b < 2; ++b)
#pragma unroll
            for (int m = 0; m < 4; ++m)
#pragma unroll
                for (int n = 0; n < 2; ++n) acc[a][b][m][n] = (f32x4){0.f, 0.f, 0.f, 0.f};
    bf16x8 At[4][2], B0[2][2], B1[2][2];
    const char* cA = (const char*)g.A + (size_t)cur.pm * tstep; const char* cB = (const char*)g.Bt + (size_t)cur.pn * tstep;
    S.a_ready(cur);
    if constexpr (SP2) {
        PG8_STAGE(PG8_SB(0, 0), cB, voffB); PG8_STAGE(PG8_SB(0, 1), cB + hstep, voffB); PG8_STAGE(PG8_SA(0, 0), cA, voffA); PG8_STAGE(PG8_SA(0, 1), cA + hstep, voffA);
        if (wr == 1) PG8_BAR;
        PG8_WAIT_V(2); PG8_BAR;
        PG8_STAGE(PG8_SB(1, 0), cB + kstep, voffB); PG8_STAGE(PG8_SA(1, 0), cA + kstep, voffA); PG8_STAGE(PG8_SB(1, 1), cB + hstep + kstep, voffB);
        PG8_WAIT_V(6); PG8_BAR;
    } else {
        PG8_STAGE(PG8_SB(0, 0), cB, voffB); PG8_STAGE(PG8_SA(0, 0), cA, voffA); PG8_STAGE(PG8_SB(0, 1), cB + hstep, voffB); PG8_STAGE(PG8_SA(0, 1), cA + hstep, voffA);
        if (wr == 1) PG8_BAR;
        PG8_WAIT_V(4); PG8_BAR;
        PG8_STAGE(PG8_SB(1, 0), cB + kstep, voffB); PG8_STAGE(PG8_SA(1, 0), cA + kstep, voffA); PG8_STAGE(PG8_SB(1, 1), cB + hstep + kstep, voffB);
        PG8_WAIT_V(6); PG8_BAR;
    }
    for (;;) {
        const bool has_next = S.next(ui + 1, nxt);
        const char* nA = has_next ? (const char*)g.A + (size_t)nxt.pm * tstep : cA; const char* nB = has_next ? (const char*)g.Bt + (size_t)nxt.pn * tstep : cB;
        for (int t = 0; t < nt; t += 2) {
            const bool last = (t == nt - 2);
            const char* a1 = cA + (size_t)(t + 1) * kstep;
            const char* a2 = last ? nA : cA + (size_t)(t + 2) * kstep; const char* b2 = last ? nB : cB + (size_t)(t + 2) * kstep;
            const char* a3 = a2 + kstep; const char* b3 = b2 + kstep;
            if (last && has_next) S.a_ready(nxt);
            if constexpr (SP2) {
            PG8_LDB(B0, 0, 0); PG8_LDB(B1, 0, 1); PG8_SCHED; PG8_LDA(At, 0, 0); PG8_STAGE(PG8_SA(1, 1), a1 + hstep, voffA);
            PG8_WAIT_V(8); PG8_WAIT_L(0); PG8_BAR; PG8_MMA(0, 0, At, B0); PG8_MMA(0, 1, At, B1); PG8_BAR; PG8_SCHED;
            PG8_LDA(At, 0, 1); PG8_STAGE(PG8_SB(0, 0), b2, voffB); PG8_STAGE(PG8_SB(0, 1), b2 + hstep, voffB); PG8_STAGE(PG8_SA(0, 0), a2, voffA);
            PG8_WAIT_V(8); PG8_WAIT_L(0); PG8_BAR; PG8_MMA(1, 0, At, B0); PG8_MMA(1, 1, At, B1); PG8_BAR; PG8_SCHED;
            PG8_LDB(B0, 1, 0); PG8_LDB(B1, 1, 1); PG8_SCHED; PG8_LDA(At, 1, 0); PG8_STAGE(PG8_SA(0, 1), a2 + hstep, voffA);
            PG8_WAIT_V(8); PG8_WAIT_L(0); PG8_BAR; PG8_MMA(0, 0, At, B0); PG8_MMA(0, 1, At, B1); PG8_BAR; PG8_SCHED;
            PG8_LDA(At, 1, 1); PG8_STAGE(PG8_SB(1, 0), b3, voffB); PG8_STAGE(PG8_SB(1, 1), b3 + hstep, voffB); PG8_STAGE(PG8_SA(1, 0), a3, voffA);
            PG8_WAIT_V(8); PG8_WAIT_L(0); PG8_BAR; PG8_MMA(1, 0, At, B0); PG8_MMA(1, 1, At, B1); PG8_BAR; PG8_SCHED;
            } else {
            PG8_LDB(B0, 0, 0); PG8_SCHED; PG8_LDA(At, 0, 0); PG8_STAGE(PG8_SA(1, 1), a1 + hstep, voffA);
            PG8_WAIT_L(8); PG8_BAR; PG8_WAIT_L(0); PG8_MMA(0, 0, At, B0); PG8_BAR; PG8_SCHED;
            PG8_LDB(B1, 0, 1); PG8_STAGE(PG8_SB(0, 0), b2, voffB);
            PG8_BAR; PG8_WAIT_L(0); PG8_MMA(0, 1, At, B1); PG8_BAR;
            PG8_LDA(At, 0, 1); PG8_STAGE(PG8_SA(0, 0), a2, voffA);
            PG8_BAR; PG8_WAIT_L(0); PG8_MMA(1, 0, At, B0); PG8_BAR; PG8_SCHED;
            PG8_STAGE(PG8_SB(0, 1), b2 + hstep, voffB);
            PG8_WAIT_V(6); PG8_BAR; PG8_MMA(1, 1, At, B1); PG8_BAR;
            PG8_LDB(B0, 1, 0); PG8_SCHED; PG8_LDA(At, 1, 0); PG8_STAGE(PG8_SA(0, 1), a2 + hstep, voffA);
            PG8_WAIT_L(8); PG8_BAR; PG8_WAIT_L(0); PG8_MMA(0, 0, At, B0); PG8_BAR; PG8_SCHED;
            PG8_LDB(B1, 1, 1); PG8_STAGE(PG8_SB(1, 0), b3, voffB);
            PG8_BAR; PG8_WAIT_L(0); PG8_MMA(0, 1, At, B1); PG8_BAR;
            PG8_LDA(At, 1, 1); PG8_STAGE(PG8_SA(1, 0), a3, voffA);
            PG8_BAR; PG8_WAIT_L(0); PG8_MMA(1, 0, At, B0); PG8_BAR; PG8_SCHED;
            PG8_STAGE(PG8_SB(1, 1), b3 + hstep, voffB);
            PG8_WAIT_V(6); PG8_BAR; PG8_MMA(1, 1, At, B1); PG8_BAR;
            }
        }
        if constexpr (ALIGN_EPI) { if (wr == 0) PG8_BAR; }
        if constexpr (!Epi::AFTER_DRAIN) { E(acc, cur, wr, wc, fr, fq); S.done(cur); }
        if (!has_next) break;
#pragma unroll
        for (int a = 0; a < 2; ++a)
#pragma unroll
            for (int b = 0; b < 2; ++b)
#pragma unroll
                for (int m = 0; m < 4; ++m)
#pragma unroll
                    for (int n = 0; n < 2; ++n) acc[a][b][m][n] = (f32x4){0.f, 0.f, 0.f, 0.f};
        cur = nxt; cA = nA; cB = nB; ++ui;
        if constexpr (ALIGN_EPI) { if (wr == 1) PG8_BAR; }
    }
    PG8_WAIT_V(0);
    if constexpr (!ALIGN_EPI) { if (wr == 0) PG8_BAR; }
    PG8_BAR;
    if constexpr (Epi::AFTER_DRAIN) { E.fused(acc, cur, wr, wc, fr, fq, lds, wid, lane); S.done(cur); }
#undef PG8_SA
#undef PG8_SB
#undef PG8_STAGE
#undef PG8_LDA
#undef PG8_LDB
#undef PG8_MMA
#undef PG8_WAIT_V
#undef PG8_WAIT_L
#undef PG8_BAR
#undef PG8_SCHED
}
}
#define GAS __attribute__((address_space(1)))
#define LAS __attribute__((address_space(3)))
typedef GAS unsigned gu32;
typedef GAS unsigned long long gu64;
#define RLX_AGENT __ATOMIC_RELAXED, __HIP_MEMORY_SCOPE_AGENT
#define LDS_WAIT() asm volatile("s_waitcnt lgkmcnt(0)" ::: "memory")
#define VM_WAIT() asm volatile("s_waitcnt vmcnt(0)" ::: "memory")
__device__ __forceinline__ unsigned long long rt() { return __builtin_amdgcn_s_memrealtime(); }
#define XB_TMO      128
#define XB_XCNT(j)  (256  + 64 * (j))
#define XB_XSUB(j)  (1280 + 64 * (j))
#define XB_XGEN(j)  (2304 + 64 * (j))
#define XB_TOP      3328
#define XB_TOPGEN   3392
#define XCD_BAR_WORDS 3456
#define XB_SPIN_CAP (1u << 18)

__device__ __forceinline__ unsigned xb_ld(unsigned* p)              { return __hip_atomic_load(p, __ATOMIC_RELAXED, __HIP_MEMORY_SCOPE_AGENT); }
__device__ __forceinline__ unsigned xb_add(unsigned* p, unsigned v) { return __hip_atomic_fetch_add(p, v, __ATOMIC_RELAXED, __HIP_MEMORY_SCOPE_AGENT); }
__device__ __forceinline__ unsigned xb_xcc_id() { return (unsigned)__builtin_amdgcn_s_getreg((3 << 11) | 20) & 0xFu; }
#define XB_SPIN(cond, bar) do { unsigned _sp = 0; while (cond) { __builtin_amdgcn_s_sleep(1); \
    if ((++_sp & 255u) == 0u) { if (xb_ld(&(bar)[XB_TMO])) break; if (_sp > XB_SPIN_CAP) { atomicAdd(&(bar)[XB_TMO], 1u); break; } } } } while (0)

struct XcdBarrier {
    unsigned* bar; unsigned x;
    volatile LAS unsigned* st;
};

__device__ __forceinline__ XcdBarrier xcd_barrier_post(unsigned* bar, volatile LAS unsigned* st) {
    XcdBarrier b; b.bar = bar; b.x = xb_xcc_id(); b.st = st;
    if (threadIdx.x == 0) (void)xb_add(&bar[XB_XCNT(b.x)], 1u);
    return b;
}
__device__ __forceinline__ void xcd_barrier_complete(unsigned* bar, unsigned x, unsigned& nloc, unsigned& nx) {
    const unsigned G = gridDim.x * gridDim.y * gridDim.z;
    unsigned sum, cnt, mine, sp = 0u;
    for (;;) {
        sum = 0u; cnt = 0u; mine = 0u;
#pragma unroll
        for (unsigned j = 0; j < 16; ++j) { const unsigned c = xb_ld(&bar[XB_XCNT(j)]); sum += c; cnt += (c > 0u) ? 1u : 0u; mine = (j == x) ? c : mine; }
        if (sum == G) break;
        __builtin_amdgcn_s_sleep(1);
        if ((++sp & 255u) == 0u) { if (xb_ld(&bar[XB_TMO])) break; if (sp > XB_SPIN_CAP) { atomicAdd(&bar[XB_TMO], 1u); break; } }
    }
    nloc = mine > 0u ? mine : 1u; nx = cnt > 0u ? cnt : 1u;
}

__device__ __forceinline__ void xcd_barrier(const XcdBarrier& b) {
    asm volatile("s_waitcnt vmcnt(0)" ::: "memory");
    __syncthreads();
    if (threadIdx.x == 0) {
        unsigned* bar = b.bar;
        __builtin_amdgcn_s_waitcnt(0);
        unsigned nloc = b.st[0], nx = b.st[1];
        if (nloc == 0u) { xcd_barrier_complete(bar, b.x, nloc, nx); b.st[0] = nloc; b.st[1] = nx; }
        const unsigned old = xb_add(&bar[XB_XSUB(b.x)], 1u);
        const unsigned gen = old / nloc;
        if (old + 1u == (gen + 1u) * nloc) {
            __builtin_amdgcn_fence(__ATOMIC_RELEASE, "agent");
            asm volatile("s_waitcnt vmcnt(0)" ::: "memory");
            const unsigned og = xb_add(&bar[XB_TOP], 1u);
            const unsigned tg = og / nx;
            if (og + 1u == (tg + 1u) * nx) xb_add(&bar[XB_TOPGEN], 1u);
            else XB_SPIN(xb_ld(&bar[XB_TOPGEN]) == tg, bar);
            __builtin_amdgcn_fence(__ATOMIC_ACQUIRE, "agent");
            xb_add(&bar[XB_XGEN(b.x)], 1u);
            asm volatile("s_waitcnt vmcnt(0)" ::: "memory");
        } else {
            XB_SPIN(xb_ld(&bar[XB_XGEN(b.x)]) == gen, bar);
            __builtin_amdgcn_fence(__ATOMIC_ACQUIRE, "agent");
            asm volatile("s_waitcnt vmcnt(0)" ::: "memory");
        }
    }
    __syncthreads();
}


constexpr int NB = 2, SEQ = 8192, DM = 1024, DEPTH = 4, NMETA = 16, LP = 8320, M = NB * LP;
constexpr int N_IN = 5384, N1 = 5376, NRW = 1792, NGT = 2048, DFF = 2816, NUP = 5632;
constexpr float LOG2E = 1.4426950408889634f;
constexpr float QSCALE = 0.125f * LOG2E;
constexpr float THR2 = 24.0f * LOG2E;
constexpr int NWAVES = 8, NTHR = 512, MMAIN = 16384;
constexpr int LDS_BYTES = 147456, MISC_OFF = 147456 - 128;

typedef unsigned short bf16;
typedef float f32x4 __attribute__((ext_vector_type(4)));
typedef unsigned u32x4 __attribute__((ext_vector_type(4)));
typedef unsigned u32x2 __attribute__((ext_vector_type(2)));
typedef short bf16x8 __attribute__((ext_vector_type(8)));

constexpr size_t SZ_H = (size_t)M * DM * 4, SZ_X512 = (size_t)M * 512 * 2;
constexpr size_t OFF_CTL = 0, OFF_H = 1u << 20, OFF_WT = OFF_H + SZ_H;
constexpr size_t WT_IN = 0, WT_BF = WT_IN + (size_t)N1 * 1024, WT_BR = WT_BF + 1024 * 512, WT_O = WT_BR + 1024 * 512,
                 WT_UP = WT_O + 1024 * 1024, WT_DN = WT_UP + (size_t)NUP * 1024, WT_LW = WT_DN + (size_t)1024 * DFF, WT_LA = WT_LW + 512 * 64, WT_LG = WT_LA + 512 * 64, WT_END = WT_LG + 512 * 128;
constexpr size_t OFF_HN = OFF_WT + WT_END * 2;
constexpr size_t OFF_Q = OFF_HN + 2 * SZ_X512, OFF_K = OFF_Q + SZ_X512, OFF_V = OFF_K + SZ_X512;
constexpr size_t OFF_RW = OFF_V + SZ_X512, OFF_GT = OFF_RW + (size_t)M * NRW * 2, OFF_MISC = OFF_GT + (size_t)M * NGT * 2;
constexpr size_t OFF_T0 = OFF_MISC + 2 * 16 * LP * 4, OFF_OF = OFF_T0 + 2 * SZ_X512, OFF_TAIL = OFF_OF + SZ_X512, WS_NEED = OFF_TAIL + 256 * 1024 * 2;
static_assert(OFF_HN % 256 == 0 && OFF_RW % 256 == 0 && OFF_T0 % 256 == 0, "alignment");

struct Params { const float* in[26]; float* out; unsigned char* ws; };
struct Ctx { int tid, lane, wave, bid, G; unsigned char* lds; unsigned char* ws; };

__device__ __forceinline__ float bf2f(unsigned b) { return __uint_as_float(b << 16); }
__device__ __forceinline__ float bflo(unsigned w) { return __uint_as_float(w << 16); }
__device__ __forceinline__ float bfhi(unsigned w) { return __uint_as_float(w & 0xffff0000u); }
typedef float f32x2_t_ __attribute__((ext_vector_type(2))); typedef __bf16 bf16x2_t_ __attribute__((ext_vector_type(2)));
__device__ __forceinline__ unsigned pk2(float lo, float hi) { const f32x2_t_ v = {lo, hi}; const bf16x2_t_ r = __builtin_convertvector(v, bf16x2_t_); return __builtin_bit_cast(unsigned, r); }
__device__ __forceinline__ unsigned f2bf(float f) { return pk2(f, 0.f) & 0xffffu; }
__device__ __forceinline__ float wave_sum(float v) {
#pragma unroll
    for (int o = 1; o < 64; o <<= 1) v += __shfl_xor(v, o);
    return v;
}
__device__ __forceinline__ float sigmoidf_(float x) { return __builtin_amdgcn_rcpf(1.f + __expf(-x)); }
template <int CTRL> __device__ __forceinline__ float dppf(float old, float x) {
    return __int_as_float(__builtin_amdgcn_update_dpp(__float_as_int(old), __float_as_int(x), CTRL, 0xf, 0xf, false));
}
__device__ __forceinline__ float allreduce16(float x) {
    x += dppf<0x121>(0.f, x); x += dppf<0x122>(0.f, x); x += dppf<0x124>(0.f, x); x += dppf<0x128>(0.f, x); return x;
}

namespace pg8 {
struct EpiRoute {
    static constexpr bool PERM = true, AFTER_DRAIN = false;
    unsigned char* ws;
    __device__ __forceinline__ void operator()(const f32x4 (&acc)[2][2][4][2], const Unit& u, int wr, int wc, int fr, int fq) const {
        const int pn = u.pn; size_t off; int ldc, colt;
        if (pn < 6) { off = OFF_Q + (size_t)(pn >> 1) * SZ_X512; ldc = 512; colt = (pn & 1) * 256; }
        else if (pn < 13) { off = OFF_RW; ldc = NRW; colt = (pn - 6) * 256; }
        else { off = OFF_GT; ldc = NGT; colt = (pn - 13) * 256; }
        bf16_t* base = (bf16_t*)(ws + off);
        const int row0 = u.pm * BM + wr * 64 + fr, col0 = colt + wc * 32 + 8 * fq;
#pragma unroll
        for (int ai = 0; ai < 2; ++ai)
#pragma unroll
            for (int m = 0; m < 4; ++m) { bf16_t* rowp = base + (size_t)(row0 + ai * HALF + m * 16) * ldc + col0;
#pragma unroll
                for (int bj = 0; bj < 2; ++bj) { const f32x4 v0 = acc[ai][bj][m][0], v1 = acc[ai][bj][m][1];
                    u32x4 w; w.x = cvt_pk_bf16(v0[0], v0[1]); w.y = cvt_pk_bf16(v0[2], v0[3]); w.z = cvt_pk_bf16(v1[0], v1[1]); w.w = cvt_pk_bf16(v1[2], v1[3]);
                    *(u32x4*)(rowp + bj * HALF) = w; } }
    }
};
struct EpiGateR {
    static constexpr bool PERM = true, AFTER_DRAIN = false;
    bf16_t* O; const bf16_t* GT; const float* gb; int goff, accum;
    __device__ __forceinline__ void operator()(const f32x4 (&acc)[2][2][4][2], const Unit& u, int wr, int wc, int fr, int fq) const {
        const int row0 = u.pm * BM + wr * 64 + fr, col0 = u.pn * BM + wc * 32 + 8 * fq;
#pragma unroll
        for (int bj = 0; bj < 2; ++bj) {
            const int c = col0 + bj * HALF;
            const f32x4 b0 = *(const f32x4*)(gb + goff + c), b1 = *(const f32x4*)(gb + goff + c + 4);
#pragma unroll
            for (int ai = 0; ai < 2; ++ai)
#pragma unroll
                for (int m = 0; m < 4; ++m) {
                    const size_t row = (size_t)(row0 + ai * HALF + m * 16);
                    const u32x4 gw = *(const u32x4*)(GT + row * NGT + goff + c);
                    const f32x4 v0 = acc[ai][bj][m][0], v1 = acc[ai][bj][m][1];
                    float r[8];
                    r[0] = sigmoidf_(bflo(gw.x) + b0[0]) * v0[0]; r[1] = sigmoidf_(bfhi(gw.x) + b0[1]) * v0[1];
                    r[2] = sigmoidf_(bflo(gw.y) + b0[2]) * v0[2]; r[3] = sigmoidf_(bfhi(gw.y) + b0[3]) * v0[3];
                    r[4] = sigmoidf_(bflo(gw.z) + b1[0]) * v1[0]; r[5] = sigmoidf_(bfhi(gw.z) + b1[1]) * v1[1];
                    r[6] = sigmoidf_(bflo(gw.w) + b1[2]) * v1[2]; r[7] = sigmoidf_(bfhi(gw.w) + b1[3]) * v1[3];
                    bf16_t* op = O + row * 1024 + c;
                    if (accum) { const u32x4 ow = *(const u32x4*)op;
                        r[0] += bflo(ow.x); r[1] += bfhi(ow.x); r[2] += bflo(ow.y); r[3] += bfhi(ow.y); r[4] += bflo(ow.z); r[5] += bfhi(ow.z); r[6] += bflo(ow.w); r[7] += bfhi(ow.w); }
                    u32x4 w; w.x = cvt_pk_bf16(r[0], r[1]); w.y = cvt_pk_bf16(r[2], r[3]); w.z = cvt_pk_bf16(r[4], r[5]); w.w = cvt_pk_bf16(r[6], r[7]);
                    *(u32x4*)op = w;
                }
        }
    }
};
struct EpiResid {
    static constexpr bool PERM = false, AFTER_DRAIN = false;
    float* H; float* OUT; int atomic;
    __device__ __forceinline__ void operator()(const f32x4 (&acc)[2][2][4][2], const Unit& u, int wr, int wc, int fr, int fq) const {
        const int row0 = u.pm * BM + wr * 64 + fr, col0 = u.pn * BM + wc * 32 + 4 * fq;
#pragma unroll
        for (int ai = 0; ai < 2; ++ai)
#pragma unroll
            for (int m = 0; m < 4; ++m) {
                const int row = row0 + ai * HALF + m * 16;
                float* hp = H + (size_t)row * DM + col0;
                const int b = row >= LP ? 1 : 0, t = row - b * LP;
                float* op = (OUT && t >= NMETA && t < NMETA + SEQ) ? OUT + ((size_t)b * SEQ + (t - NMETA)) * DM + col0 : nullptr;
#pragma unroll
                for (int bj = 0; bj < 2; ++bj)
#pragma unroll
                    for (int n = 0; n < 2; ++n) { const int co = bj * HALF + n * 16;
                        if (atomic) {
                            if (row < LP + NMETA + SEQ) {
#pragma unroll
                                for (int e = 0; e < 4; ++e) unsafeAtomicAdd(hp + co + e, acc[ai][bj][m][n][e]); }
                        } else {
                            const f32x4 v = *(const f32x4*)(hp + co) + acc[ai][bj][m][n];
                            if (OUT) { if (op) *(f32x4*)(op + co) = v; } else *(f32x4*)(hp + co) = v; } }
            }
    }
};
struct EpiResidAtomic {
    static constexpr bool PERM = false, AFTER_DRAIN = false;
    float* H;
    __device__ __forceinline__ void operator()(const f32x4 (&acc)[2][2][4][2], const Unit& u, int wr, int wc, int fr, int fq) const {
        const int row0 = u.pm * BM + wr * 64 + fr, col0 = u.pn * BM + wc * 32 + 4 * fq;
#pragma unroll
        for (int ai = 0; ai < 2; ++ai)
#pragma unroll
            for (int m = 0; m < 4; ++m) { float* hp = H + (size_t)(row0 + ai * HALF + m * 16) * DM + col0;
#pragma unroll
                for (int bj = 0; bj < 2; ++bj)
#pragma unroll
                    for (int n = 0; n < 2; ++n)
#pragma unroll
                        for (int e = 0; e < 4; ++e) unsafeAtomicAdd(hp + bj * HALF + n * 16 + e, acc[ai][bj][m][n][e]); }
    }
};
struct OneUnit {
    StaticOrder so; int mode, pm, pn; bool active;
    __device__ bool next(int i, Unit& u) const { if (mode == 0) return so.next(i, u); if (i != 0 || !active) return false; u.pm = pm; u.pn = pn; return true; }
    __device__ __forceinline__ void a_ready(const Unit&) const {}
    __device__ __forceinline__ void done(const Unit&) const {}
};
struct EpiUp {
    static constexpr bool PERM = true, AFTER_DRAIN = false;
    bf16_t* ACT; bf16_t* HALO; const float* cw;
    __device__ __forceinline__ void operator()(const f32x4 (&acc)[2][2][4][2], const Unit& u, int wr, int wc, int fr, int fq) const {
        const int chan0 = u.pn * 128 + wc * 32 + 8 * fq;
#pragma unroll
        for (int n = 0; n < 2; ++n) {
            const int ch = chan0 + 4 * n;
            f32x4 w[3][2];
#pragma unroll
            for (int j = 0; j < 3; ++j) { w[j][0] = *(const f32x4*)(cw + j * NUP + ch); w[j][1] = *(const f32x4*)(cw + j * NUP + DFF + ch); }
#pragma unroll
            for (int ai = 0; ai < 2; ++ai) {
                const int rowg = u.pm * BM + ai * HALF + wr * 64;
#pragma unroll
                for (int m = 0; m < 4; ++m) {
                    f32x4 uc[2];
#pragma unroll
                    for (int bj = 0; bj < 2; ++bj) {
                        const f32x4 cur = acc[ai][bj][m][n];
                        f32x4 prv; if (m > 0) prv = acc[ai][bj][m - 1][n]; else prv = (f32x4){0.f, 0.f, 0.f, 0.f};
                        f32x4 p1, p2;
#pragma unroll
                        for (int i = 0; i < 4; ++i) {
                            const float r1 = dppf<0x121>(0.f, prv[i]), r2 = dppf<0x122>(0.f, prv[i]);
                            p1[i] = dppf<0x111>(r1, cur[i]); p2[i] = dppf<0x112>(r2, cur[i]);
                        }
                        uc[bj] = w[0][bj] * p2 + w[1][bj] * p1 + w[2][bj] * cur;
                    }
                    float a[4];
#pragma unroll
                    for (int i = 0; i < 4; ++i) a[i] = uc[0][i] * sigmoidf_(uc[0][i]) * uc[1][i];
                    u32x2 o; o.x = cvt_pk_bf16(a[0], a[1]); o.y = cvt_pk_bf16(a[2], a[3]);
                    *(u32x2*)(ACT + (size_t)(rowg + m * 16 + fr) * DFF + ch) = o;
                    if ((m == 3 && fr >= 14) || (m == 0 && fr < 2)) {
                        const int slot = (rowg >> 6) * 4 + (m == 3 ? fr - 14 : 2 + fr);
#pragma unroll
                        for (int bj = 0; bj < 2; ++bj) { const f32x4 cur = acc[ai][bj][m][n]; u32x2 hw; hw.x = cvt_pk_bf16(cur[0], cur[1]); hw.y = cvt_pk_bf16(cur[2], cur[3]);
                            *(u32x2*)(HALO + (size_t)slot * NUP + bj * DFF + ch) = hw; }
                    }
                }
            }
        }
    }
};
}

#ifndef REP_PREP
#define REP_PREP 1
#endif
#ifndef REP_P3
#define REP_P3 1
#endif
#ifndef REP_SYNC
#define REP_SYNC 0
#endif
#define GLD(T, p) (*(const __attribute__((address_space(1))) T*)(p))
#define GST(T, p) (*(__attribute__((address_space(1))) T*)(p))
#define LDS_BARRIER() do { asm volatile("s_waitcnt lgkmcnt(0)" ::: "memory"); __builtin_amdgcn_s_barrier(); asm volatile("" ::: "memory"); } while (0)
__device__ __forceinline__ void transpose_item(const float* W, int Nsrc, int K, bf16* WT, int dst_row0, int src_col0, int k0, float* scr, int lane) {
#pragma unroll 8
    for (int i = 0; i < 32; ++i) { const int kk = 2 * i + (lane >> 5); scr[kk * 33 + (lane & 31)] = W[(size_t)(k0 + kk) * Nsrc + src_col0 + (lane & 31)]; }
    asm volatile("s_waitcnt lgkmcnt(0)" ::: "memory");
    const int c = lane & 7;
#pragma unroll
    for (int j = 0; j < 4; ++j) { const int n = (lane >> 3) + 8 * j; const float* s = scr + (8 * c) * 33 + n;
        u32x4 o; o.x = pk2(s[0 * 33], s[1 * 33]); o.y = pk2(s[2 * 33], s[3 * 33]); o.z = pk2(s[4 * 33], s[5 * 33]); o.w = pk2(s[6 * 33], s[7 * 33]);
        *(u32x4*)(WT + (size_t)(dst_row0 + n) * K + k0 + 8 * c) = o; }
    asm volatile("s_waitcnt lgkmcnt(0)" ::: "memory");
}
__device__ __forceinline__ void convert_weights(const Params& P, int l, const Ctx& c) {
    bf16* WT = (bf16*)(c.ws + OFF_WT);
    float* scr = (float*)(c.lds + c.wave * 16384);
    const int gw = c.bid * NWAVES + c.wave, NGW = c.G * NWAVES;
    constexpr int I_IN = 16 * 168, I_BF = 8 * 32, I_O = 16 * 32, I_UP = 16 * 176, I_DN = 44 * 32, I_LR = 16, I_LG = 32, I_ALL = I_IN + 2 * I_BF + I_O + I_UP + I_DN + 2 * I_LR + I_LG;
    for (int it = gw; it < I_ALL; it += NGW) {
        int r = it;
        if (r < I_IN) { const int kb = r / 168, n0 = 32 * (r % 168); transpose_item(P.in[4] + (size_t)l * 1024 * N_IN, N_IN, 1024, WT + WT_IN, n0, n0 + (n0 >= 1536 ? 8 : 0), 64 * kb, scr, c.lane); continue; } r -= I_IN;
        if (r < I_BF) { const int kb = r / 32, n0 = 32 * (r % 32); transpose_item(P.in[19] + (size_t)l * 512 * 1024, 1024, 512, WT + WT_BF, n0, n0, 64 * kb, scr, c.lane); continue; } r -= I_BF;
        if (r < I_BF) { const int kb = r / 32, n0 = 32 * (r % 32); transpose_item(P.in[20] + (size_t)l * 512 * 1024, 1024, 512, WT + WT_BR, n0, n0, 64 * kb, scr, c.lane); continue; } r -= I_BF;
        if (r < I_O) { const int kb = r / 32, n0 = 32 * (r % 32); transpose_item(P.in[22] + (size_t)l * 1024 * 1024, 1024, 1024, WT + WT_O, n0, n0, 64 * kb, scr, c.lane); continue; } r -= I_O;
        if (r < I_UP) { const int kb = r / 176, n0 = 32 * (r % 176); const int pn = n0 >> 8, bj = (n0 >> 7) & 1, x = n0 & 127;
            transpose_item(P.in[23] + (size_t)l * 1024 * NUP, NUP, 1024, WT + WT_UP, n0, bj * DFF + 128 * pn + x, 64 * kb, scr, c.lane); continue; } r -= I_UP;
        if (r < I_DN) { const int kb = r / 32, n0 = 32 * (r % 32); transpose_item(P.in[25] + (size_t)l * DFF * 1024, 1024, DFF, WT + WT_DN, n0, n0, 64 * kb, scr, c.lane); continue; } r -= I_DN;
        if (r < I_LR) { transpose_item(P.in[10] + (size_t)l * 64 * 512, 512, 64, WT + WT_LW, 32 * r, 32 * r, 0, scr, c.lane); continue; } r -= I_LR;
        if (r < I_LR) { transpose_item(P.in[12] + (size_t)l * 64 * 512, 512, 64, WT + WT_LA, 32 * r, 32 * r, 0, scr, c.lane); continue; } r -= I_LR;
        { const int kb = r / 16, n0 = 32 * (r % 16); transpose_item(P.in[13] + (size_t)l * 128 * 512, 512, 128, WT + WT_LG, n0, n0, 64 * kb, scr, c.lane); }
    }
}

template <bool FG> __device__ __forceinline__ void phase_norm(const Params& P, int l, const Ctx& c) {
    float* H = (float*)(c.ws + OFF_H); bf16* HN = (bf16*)(c.ws + OFF_HN);
    float* LOGF = (float*)(c.ws + OFF_MISC);
    const float* gain = (FG ? P.in[2] : P.in[3]) + l * DM;
    float* wfs = (float*)c.lds;
    if (FG) {
        __syncthreads();
        const float* win = P.in[4] + (size_t)l * 1024 * N_IN + 1536;
        for (int i = c.tid; i < 8192; i += NTHR) wfs[i] = win[(size_t)(i >> 3) * N_IN + (i & 7)];
        __syncthreads();
    }
    const int gw = c.bid * NWAVES + c.wave, NGW = c.G * NWAVES;
#define NORM_LOAD(mm, dst) do { const int b_ = (mm) >= LP ? 1 : 0, t_ = (mm) - b_ * LP; \
        if (FG && l == 0) { const float* src_ = (t_ < NMETA) ? P.in[1] + (size_t)t_ * DM : P.in[0] + ((size_t)b_ * SEQ + (t_ - NMETA)) * DM; const bool real_ = t_ < NMETA + SEQ; \
            _Pragma("unroll") for (int j_ = 0; j_ < 4; ++j_) dst[j_] = real_ ? *(const f32x4*)(src_ + 4 * c.lane + 256 * j_) : (f32x4){0.f, 0.f, 0.f, 0.f}; } \
        else { _Pragma("unroll") for (int j_ = 0; j_ < 4; ++j_) dst[j_] = *(const f32x4*)(H + (size_t)(mm) * DM + 4 * c.lane + 256 * j_); } } while (0)
    f32x4 nv[4];
    if (gw < M) NORM_LOAD(gw, nv);
    for (int m = gw; m < M; m += NGW) {
        const int b = m >= LP ? 1 : 0, t = m - b * LP;
        f32x4 v[4];
#pragma unroll
        for (int j = 0; j < 4; ++j) v[j] = nv[j];
        if (m + NGW < M) NORM_LOAD(m + NGW, nv);
        if (FG && l == 0) {
#pragma unroll
            for (int j = 0; j < 4; ++j) *(f32x4*)(H + (size_t)m * DM + 4 * c.lane + 256 * j) = v[j];
        }
        float ss = 0.f;
#pragma unroll
        for (int j = 0; j < 4; ++j) ss += (v[j].x * v[j].x + v[j].y * v[j].y) + (v[j].z * v[j].z + v[j].w * v[j].w);
        const float rstd = 1.0f / sqrtf(wave_sum(ss) * (1.f / DM) + 1e-6f);
        float f[8];
#pragma unroll
        for (int q = 0; q < 8; ++q) f[q] = 0.f;
#pragma unroll
        for (int j = 0; j < 4; ++j) {
            const f32x4 g = *(const f32x4*)(gain + 4 * c.lane + 256 * j);
            v[j] = v[j] * rstd * g;
            u32x2 o; o.x = pk2(v[j].x, v[j].y); o.y = pk2(v[j].z, v[j].w);
            *(u32x2*)(HN + (size_t)m * DM + 4 * c.lane + 256 * j) = o;
            if (FG) {
#pragma unroll
                for (int e = 0; e < 4; ++e) { const int k = 4 * c.lane + 256 * j + e; const f32x4 w0 = *(const f32x4*)(wfs + k * 8), w1 = *(const f32x4*)(wfs + k * 8 + 4);
                    const float hv = v[j][e];
                    f[0] += hv * w0.x; f[1] += hv * w0.y; f[2] += hv * w0.z; f[3] += hv * w0.w; f[4] += hv * w1.x; f[5] += hv * w1.y; f[6] += hv * w1.z; f[7] += hv * w1.w; }
            }
        }
        if (FG) {
#pragma unroll
            for (int q = 0; q < 8; ++q) f[q] = wave_sum(f[q]);
            float fv = f[0];
#pragma unroll
            for (int q = 1; q < 8; ++q) fv = (c.lane == q) ? f[q] : fv;
            if (c.lane < 8) { const float x = fv + P.in[7][l * 8 + c.lane]; const float ls = fminf(x, 0.f) - __logf(1.f + __expf(-fabsf(x))); LOGF[(size_t)(b * 8 + c.lane) * LP + t] = ls; }
        }
    }
}

__device__ __forceinline__ void phase_fcum(const Params& P, const Ctx& c) {
    const int s = c.bid - (c.G - 16);
    if (s < 0) return;
    const float* LOGF = (const float*)(c.ws + OFF_MISC) + (size_t)s * LP; float* FC = (float*)(c.ws + OFF_MISC) + 16 * LP + (size_t)s * LP;
    float* wt = (float*)c.lds;
    const int base = c.tid * 17;
    float v[17]; float run = 0.f;
#pragma unroll
    for (int i = 0; i < 17; ++i) { const int idx = base + i; const float x = (idx < LP) ? LOGF[idx] : 0.f; run += x; v[i] = run; }
    float incl = run;
#pragma unroll
    for (int o = 1; o < 64; o <<= 1) { const float t = __shfl_up(incl, o); if (c.lane >= o) incl += t; }
    if (c.lane == 63) wt[c.wave] = incl;
    __syncthreads();
    float off = incl - run;
#pragma unroll
    for (int w2 = 0; w2 < 8; ++w2) off += (w2 < c.wave) ? wt[w2] : 0.f;
#pragma unroll
    for (int i = 0; i < 17; ++i) { const int idx = base + i; if (idx < LP) FC[idx] = (v[i] + off) * LOG2E; }
    __syncthreads();
}

__device__ __forceinline__ void phase_qknorm(const Params& P, int l, const Ctx& c) {
    bf16* Q = (bf16*)(c.ws + OFF_Q); bf16* K = (bf16*)(c.ws + OFF_K);
    const int gw = c.bid * NWAVES + c.wave, NGW = c.G * NWAVES;
    const int d0 = (c.lane & 7) * 8;
    float gq[8], gk[8];
#pragma unroll
    for (int i = 0; i < 8; ++i) { gq[i] = P.in[5][l * 64 + d0 + i] * QSCALE; gk[i] = P.in[6][l * 64 + d0 + i]; }
    for (int m = gw; m < M; m += NGW) {
#pragma unroll
        for (int which = 0; which < 2; ++which) {
            bf16* p = (which ? K : Q) + (size_t)m * 512 + 8 * c.lane;
            const u32x4 w = *(const u32x4*)p;
            float x[8] = {bflo(w.x), bfhi(w.x), bflo(w.y), bfhi(w.y), bflo(w.z), bfhi(w.z), bflo(w.w), bfhi(w.w)};
            float ss = 0.f;
#pragma unroll
            for (int i = 0; i < 8; ++i) ss += x[i] * x[i];
            ss += __shfl_xor(ss, 1); ss += __shfl_xor(ss, 2); ss += __shfl_xor(ss, 4);
            const float rs = 1.0f / sqrtf(ss * (1.f / 64.f) + 1e-6f);
#pragma unroll
            for (int i = 0; i < 8; ++i) x[i] = x[i] * rs * (which ? gk[i] : gq[i]);
            u32x4 o; o.x = pk2(x[0], x[1]); o.y = pk2(x[2], x[3]); o.z = pk2(x[4], x[5]); o.w = pk2(x[6], x[7]);
            *(u32x4*)p = o;
        }
    }
}

constexpr int NCHK = LP / 64;
constexpr int NUNIT = NB * NCHK * 8;
constexpr int UNIT_A = 16384, UNIT_B = 16640;
constexpr int ST = 72, STG = 136;
constexpr int L_F0 = 92160, L_F1 = 108544;
struct RwkvBufs { bf16 *BON, *G; unsigned char *UA, *UB; float* Y; bf16* ORW; };
__device__ __forceinline__ RwkvBufs rwkv_bufs(const Params& P, const Ctx& c) {
    RwkvBufs r; r.BON = (bf16*)(c.ws + OFF_HN); r.G = r.BON + (size_t)M * 512;
    r.UA = c.ws + OFF_T0; r.UB = (unsigned char*)P.out;
    r.Y = (float*)(c.ws + OFF_RW); r.ORW = (bf16*)(c.ws + OFF_RW + (size_t)M * 512 * 4);
    return r;
}
__device__ __forceinline__ void mm_tile(const bf16* A, int sa, const bf16* Bt, int sb, int nks, f32x4 (&acc)[2], int w, int lq, int g) {
    const int mt = w >> 1, nt0 = 2 * (w & 1);
    for (int ks = 0; ks < nks; ++ks) {
        const bf16x8 a = *(const bf16x8*)(A + (16 * mt + lq) * sa + 32 * ks + 8 * g);
#pragma unroll
        for (int q = 0; q < 2; ++q) { const bf16x8 b = *(const bf16x8*)(Bt + (16 * (nt0 + q) + lq) * sb + 32 * ks + 8 * g); acc[q] = __builtin_amdgcn_mfma_f32_16x16x32_bf16(a, b, acc[q], 0, 0, 0); }
    }
}
template <bool SA, bool SB> __device__ __forceinline__ void mm_tile2(const bf16* A, int sa, const bf16* Bt, int sb, int nks, f32x4 (&acc)[2], int w, int lq, int g) {
    const int mt = w >> 1, nt0 = 2 * (w & 1);
    const int ra = 16 * mt + lq, xa = SA ? 8 * ((ra >> 3) & 7) : 0;
    for (int ks = 0; ks < nks; ++ks) {
        const bf16x8 a = *(const bf16x8*)(A + ra * sa + ((32 * ks + 8 * g) ^ xa));
#pragma unroll
        for (int q = 0; q < 2; ++q) { const int rb = 16 * (nt0 + q) + lq, xb = SB ? 8 * ((rb >> 3) & 7) : 0;
            const bf16x8 bb = *(const bf16x8*)(Bt + rb * sb + ((32 * ks + 8 * g) ^ xb)); acc[q] = __builtin_amdgcn_mfma_f32_16x16x32_bf16(a, bb, acc[q], 0, 0, 0); }
    }
}
#define ZACC(a) do { a[0] = (f32x4){0.f, 0.f, 0.f, 0.f}; a[1] = (f32x4){0.f, 0.f, 0.f, 0.f}; } while (0)
__device__ __forceinline__ int permk(int k) { return 32 * (k >> 5) + 8 * ((k & 15) >> 2) + 4 * ((k >> 4) & 1) + (k & 3); }
__device__ __forceinline__ int swz(int row, int col) { return row * 128 + ((((col >> 3) ^ (row >> 1)) & 7) << 4) + (col & 7) * 2; }

__device__ __forceinline__ void rwkv_prep_unit(const Params& P, int l, const Ctx& c, int u, const RwkvBufs& B, const float (&pw0)[8], const float (&pa0)[8], const float (&pkk)[8], const float (&pka)[8], const float (&prk)[8], const u32x4 (&wlr)[4]) {
    const int h = u & 7, bc = u >> 3, b = bc / NCHK, ch = bc - b * NCHK;
    const size_t m0 = (size_t)b * LP + ch * 64;
    int tid_ = c.tid; asm volatile("" : "+v"(tid_));
    const int tid = tid_, lane = tid & 63, w = c.wave, lq = lane & 15, g = lane >> 4;
    const int t = tid >> 3, cg = tid & 7, c0 = cg * 8, jb = h * 64 + c0;
    unsigned char* L = c.lds;
    bf16* A0 = (bf16*)L; bf16* A1 = A0 + 4608; bf16* A2 = A1 + 4608; bf16* A3 = A2 + 4608; bf16* A4 = A3 + 4608; bf16* A5 = A4 + 4608; bf16* A6 = A5 + 4608;
    bf16* A7 = A6 + 4608; bf16* A8 = A7 + 4608; bf16* A9 = A8 + 4608;
    float* F0 = (float*)(L + L_F0); float* F1 = (float*)(L + L_F1);
    const bf16* RW = (const bf16*)(c.ws + OFF_RW);
    const bf16* WT = (const bf16*)(c.ws + OFF_WT);
    const float* mu = P.in[8] + l * NRW;
    const bool first = (ch == 0 && t == 0);
    const bf16* cur = RW + (m0 + t) * NRW; const bf16* prv = cur - NRW;
    float zr[8], zk[8], zv[8];
#pragma unroll
    for (int s = 0; s < 3; ++s) {
        const u32x4 cw = *(const u32x4*)(cur + s * 512 + jb); u32x4 pw = (u32x4){0u, 0u, 0u, 0u}; if (!first) pw = *(const u32x4*)(prv + s * 512 + jb);
        const float cv[8] = {bflo(cw.x), bfhi(cw.x), bflo(cw.y), bfhi(cw.y), bflo(cw.z), bfhi(cw.z), bflo(cw.w), bfhi(cw.w)};
        const float pv[8] = {bflo(pw.x), bfhi(pw.x), bflo(pw.y), bfhi(pw.y), bflo(pw.z), bfhi(pw.z), bflo(pw.w), bfhi(pw.w)};
#pragma unroll
        for (int i = 0; i < 8; ++i) { const float z = cv[i] + mu[s * 512 + jb + i] * (pv[i] - cv[i]); if (s == 0) zr[i] = z; else if (s == 1) zk[i] = z; else zv[i] = z; }
    }
#pragma unroll
    for (int q4 = 0; q4 < 4; ++q4) {
        const int col = cg * 32 + q4 * 8;
        const u32x4 cw = *(const u32x4*)(cur + 1536 + col); u32x4 pw = (u32x4){0u, 0u, 0u, 0u}; if (!first) pw = *(const u32x4*)(prv + 1536 + col);
        const float cv[8] = {bflo(cw.x), bfhi(cw.x), bflo(cw.y), bfhi(cw.y), bflo(cw.z), bfhi(cw.z), bflo(cw.w), bfhi(cw.w)};
        const float pv[8] = {bflo(pw.x), bfhi(pw.x), bflo(pw.y), bfhi(pw.y), bflo(pw.z), bfhi(pw.z), bflo(pw.w), bfhi(pw.w)};
        float z[8];
#pragma unroll
        for (int i = 0; i < 8; ++i) { z[i] = cv[i] + mu[1536 + col + i] * (pv[i] - cv[i]); if (col < 64) z[i] = 1.f - 2.f / (1.f + __expf(2.f * z[i])); else if (col >= 128) z[i] = sigmoidf_(z[i]); }
        u32x4 o; o.x = pk2(z[0], z[1]); o.y = pk2(z[2], z[3]); o.z = pk2(z[4], z[5]); o.w = pk2(z[6], z[7]);
        bf16* dst = (col < 64) ? A0 + t * ST + col : (col < 128 ? A1 + t * ST + (col - 64) : A2 + t * STG + (col - 128));
        *(u32x4*)dst = o;
    }
    { const int row = tid >> 3, chk = tid & 7;
      *(u32x4*)(A4 + row * ST + chk * 8) = wlr[0];
      *(u32x4*)(A5 + row * ST + chk * 8) = wlr[1];
#pragma unroll
      for (int i = 0; i < 2; ++i) { const int idx = tid + 512 * i, r2 = idx >> 4, c2 = idx & 15;
          *(u32x4*)((bf16*)F1 + r2 * STG + c2 * 8) = wlr[2 + i]; } }
    LDS_BARRIER();
    { f32x4 aw[2], aa[2], ag[2]; ZACC(aw); ZACC(aa); ZACC(ag);
      mm_tile(A4, ST, A0, ST, 2, aw, w, lq, g); mm_tile(A5, ST, A1, ST, 2, aa, w, lq, g); mm_tile((const bf16*)F1, STG, A2, STG, 4, ag, w, lq, g);
      const int mt = w >> 1, nt0 = 2 * (w & 1);
#pragma unroll
      for (int q = 0; q < 2; ++q) { const int o = (16 * (nt0 + q) + lq) * ST + 16 * mt + 4 * g; u32x2 p;
          p.x = pk2(aw[q][0], aw[q][1]); p.y = pk2(aw[q][2], aw[q][3]); *(u32x2*)(A7 + o) = p;
          p.x = pk2(aa[q][0], aa[q][1]); p.y = pk2(aa[q][2], aa[q][3]); *(u32x2*)(A8 + o) = p;
          p.x = pk2(ag[q][0], ag[q][1]); p.y = pk2(ag[q][2], ag[q][3]); *(u32x2*)(A9 + o) = p; } }
    LDS_BARRIER();
    float kk[8], k2[8], ar[8];
    { const u32x4 lw = *(const u32x4*)(A7 + t * ST + c0), la = *(const u32x4*)(A8 + t * ST + c0), lg = *(const u32x4*)(A9 + t * ST + c0);
      const float fw[8] = {bflo(lw.x), bfhi(lw.x), bflo(lw.y), bfhi(lw.y), bflo(lw.z), bfhi(lw.z), bflo(lw.w), bfhi(lw.w)};
      const float fa[8] = {bflo(la.x), bfhi(la.x), bflo(la.y), bfhi(la.y), bflo(la.z), bfhi(la.z), bflo(la.w), bfhi(la.w)};
      float ss = 0.f, bs = 0.f;
#pragma unroll
      for (int i = 0; i < 8; ++i) {
          const float xw = -(pw0[i] + fw[i]); const float sp = fmaxf(xw, 0.f) + __logf(1.f + __expf(-fabsf(xw)));
          F0[t * 64 + c0 + i] = __expf(-sp - 0.5f);
          ar[i] = sigmoidf_(pa0[i] + fa[i]);
          kk[i] = zk[i] * pkk[i]; ss += kk[i] * kk[i];
          k2[i] = zk[i] * (1.f + (ar[i] - 1.f) * pka[i]);
          bs += zr[i] * k2[i] * prk[i]; }
      ss += __shfl_xor(ss, 1); ss += __shfl_xor(ss, 2); ss += __shfl_xor(ss, 4);
      bs += __shfl_xor(bs, 1); bs += __shfl_xor(bs, 2); bs += __shfl_xor(bs, 4);
      const float inv = 1.0f / fmaxf(sqrtf(ss), 1e-12f);
#pragma unroll
      for (int i = 0; i < 8; ++i) kk[i] *= inv;
      u32x4 bo; bo.x = pk2(bs * zv[0], bs * zv[1]); bo.y = pk2(bs * zv[2], bs * zv[3]); bo.z = pk2(bs * zv[4], bs * zv[5]); bo.w = pk2(bs * zv[6], bs * zv[7]);
      *(u32x4*)(B.BON + (m0 + t) * 512 + jb) = bo; *(u32x4*)(B.G + (m0 + t) * 512 + jb) = lg; }
    LDS_BARRIER();
    {
      const int k = tid & 63, sg = tid >> 6; float e[8], run = 0.f;
#pragma unroll
      for (int s = 0; s < 8; ++s) { run += F0[(8 * sg + s) * 64 + k]; e[s] = run; }
      F1[sg * 64 + k] = run;
      LDS_BARRIER();
      float off = 0.f;
#pragma unroll
      for (int s = 0; s < 8; ++s) off += (s < sg) ? F1[s * 64 + k] : 0.f;
#pragma unroll
      for (int s = 0; s < 8; ++s) F0[(8 * sg + s) * 64 + k] = e[s] + off; }
    LDS_BARRIER();
    { float ct[8], cp[8], cC[8];
#pragma unroll
      for (int i = 0; i < 8; ++i) { ct[i] = F0[t * 64 + c0 + i]; cp[i] = (t > 0) ? F0[(t - 1) * 64 + c0 + i] : 0.f; cC[i] = F0[63 * 64 + c0 + i]; }
      float at[8], bt[8], kt[8], rt[8], bh[8], kh[8];
#pragma unroll
      for (int i = 0; i < 8; ++i) { const float gt = __expf(-ct[i]), igt = __expf(ct[i]), gp = __expf(-cp[i]), gct = __expf(ct[i] - cC[i]);
          at[i] = -kk[i] * gp; bt[i] = kk[i] * ar[i] * igt; kt[i] = k2[i] * igt; rt[i] = zr[i] * gt; bh[i] = kk[i] * ar[i] * gct; kh[i] = k2[i] * gct; }
      u32x4 o;
      o.x = pk2(at[0], at[1]); o.y = pk2(at[2], at[3]); o.z = pk2(at[4], at[5]); o.w = pk2(at[6], at[7]); *(u32x4*)(A0 + t * ST + c0) = o;
      o.x = pk2(bt[0], bt[1]); o.y = pk2(bt[2], bt[3]); o.z = pk2(bt[4], bt[5]); o.w = pk2(bt[6], bt[7]); *(u32x4*)(A1 + t * ST + c0) = o;
      o.x = pk2(kt[0], kt[1]); o.y = pk2(kt[2], kt[3]); o.z = pk2(kt[4], kt[5]); o.w = pk2(kt[6], kt[7]); *(u32x4*)(A2 + t * ST + c0) = o;
      o.x = pk2(rt[0], rt[1]); o.y = pk2(rt[2], rt[3]); o.z = pk2(rt[4], rt[5]); o.w = pk2(rt[6], rt[7]); *(u32x4*)(A3 + t * ST + c0) = o;
#pragma unroll
      for (int i = 0; i < 8; ++i) { const int o = (c0 + i) * ST + (t ^ c0);
          A4[o] = (bf16)f2bf(bh[i]); A5[o] = (bf16)f2bf(kh[i]); A6[o] = (bf16)f2bf(zv[i]); F1[t * 128 + c0 + i] = at[i]; }
      if (t == 63) { float* gc = (float*)(B.UB + (size_t)u * UNIT_B + 16384) + c0;
#pragma unroll
          for (int i = 0; i < 8; ++i) gc[i] = __expf(-cC[i]); } }
    LDS_BARRIER();
    { const int mt = w >> 1, nt0 = 2 * (w & 1);
      f32x4 a[2];
      ZACC(a); mm_tile(A0, ST, A1, ST, 2, a, w, lq, g);
#pragma unroll
      for (int q = 0; q < 2; ++q) { const int i = 16 * (nt0 + q) + lq; f32x4 lab;
#pragma unroll
          for (int j = 0; j < 4; ++j) lab[j] = (i < 16 * mt + 4 * g + j) ? a[q][j] : 0.f;
#pragma unroll
          for (int j = 0; j < 4; ++j) F0[i * 64 + j * 16 + 4 * mt + g] = lab[j]; }
      asm volatile("" ::: "memory");
#define ST1_STORE(DST, INCL) do { _Pragma("unroll") for (int q = 0; q < 2; ++q) { const int tt = 16 * (nt0 + q) + lq, i0 = 16 * mt + 4 * g; float v_[4]; \
          _Pragma("unroll") for (int j = 0; j < 4; ++j) v_[j] = (i0 + j < tt + (INCL)) ? a[q][j] : 0.f; \
          u32x2 p_; p_.x = pk2(v_[0], v_[1]); p_.y = pk2(v_[2], v_[3]); *(u32x2*)((DST) + tt * ST + i0) = p_; } } while (0)
      ZACC(a); mm_tile(A2, ST, A0, ST, 2, a, w, lq, g); ST1_STORE(A7, 0); asm volatile("" ::: "memory");
      ZACC(a); mm_tile(A1, ST, A3, ST, 2, a, w, lq, g); ST1_STORE(A8, 1); asm volatile("" ::: "memory");
      ZACC(a); mm_tile(A2, ST, A3, ST, 2, a, w, lq, g); ST1_STORE(A9, 1);
#undef ST1_STORE
    }
    LDS_BARRIER();
    { const int mt = w >> 1, nt0 = 2 * (w & 1); f32x4 a[2]; ZACC(a);
      mm_tile2<true, false>(A6, ST, A7, ST, 2, a, w, lq, g);
#pragma unroll
      for (int q = 0; q < 2; ++q) *(f32x4*)(F1 + (16 * (nt0 + q) + lq) * 128 + 64 + 16 * mt + 4 * g) = a[q]; }
    LDS_BARRIER();
    { float X[16];
      const int col = 16 * w + lq;
#pragma unroll
      for (int r = 0; r < 16; ++r) X[r] = F1[(4 * r + g) * 128 + col];
      LDS_BARRIER();
      f32x4 Lc[4];
#pragma unroll
      for (int q = 0; q < 4; ++q) Lc[q] = *(const f32x4*)(F0 + g * 16 + 4 * q);
#pragma unroll
      for (int i = 0; i < 64; ++i) {
          const float xi = __shfl(X[i >> 2], (i & 3) * 16 + lq);
          f32x4 Ln[4];
#pragma unroll
          for (int q = 0; q < 4; ++q) Ln[q] = Lc[q];
          if (i + 1 < 64) {
#pragma unroll
              for (int q = ((i + 1) >> 4); q < 4; ++q) Ln[q] = *(const f32x4*)(F0 + (i + 1) * 64 + g * 16 + 4 * q);
          }
#pragma unroll
          for (int r = (i >> 2); r < 16; ++r) X[r] += Lc[r >> 2][r & 3] * xi;
#pragma unroll
          for (int q = 0; q < 4; ++q) Lc[q] = Ln[q];
          __builtin_amdgcn_sched_barrier(0);
      }
      bf16* XT = (bf16*)F1 + (w >> 2) * 4608 + ((col & 63) * ST);
#pragma unroll
      for (int r = 0; r < 16; ++r) XT[4 * r + g] = (bf16)f2bf(X[r]); }
    LDS_BARRIER();
    { const int mt = w >> 1, nt0 = 2 * (w & 1);
      const bf16* AhT = (const bf16*)F1; const bf16* W2T = AhT + 4608;
      unsigned char* ua = B.UA + (size_t)u * UNIT_A; unsigned char* ub = B.UB + (size_t)u * UNIT_B;
      const int p0 = 32 * (mt >> 1) + 8 * g + 4 * (mt & 1);
      f32x4 a[2];
      ZACC(a); mm_tile2<false, true>(AhT, ST, A4, ST, 2, a, w, lq, g);
#pragma unroll
      for (int q = 0; q < 2; ++q) { const int k = 16 * (nt0 + q) + lq; u32x2 o; o.x = pk2(a[q][0], a[q][1]); o.y = pk2(a[q][2], a[q][3]); *(u32x2*)(ua + swz(k, p0)) = o; }
      ZACC(a); mm_tile(AhT, ST, A8, ST, 2, a, w, lq, g);
#pragma unroll
      for (int q = 0; q < 2; ++q) { const int tt = 16 * (nt0 + q) + lq; const u32x2 rr = *(const u32x2*)(A3 + tt * ST + 16 * mt + 4 * g);
          u32x2 o; o.x = pk2(a[q][0] + bflo(rr.x), a[q][1] + bfhi(rr.x)); o.y = pk2(a[q][2] + bflo(rr.y), a[q][3] + bfhi(rr.y)); *(u32x2*)(ua + 8192 + swz(tt, p0)) = o; }
      ZACC(a); mm_tile2<true, false>(A4, ST, W2T, ST, 2, a, w, lq, g); mm_tile2<true, true>(A5, ST, A6, ST, 2, a, w, lq, g);
#pragma unroll
      for (int q = 0; q < 2; ++q) { const int v = 16 * (nt0 + q) + lq, k0 = 16 * mt + 4 * g; u32x2 o; o.x = pk2(a[q][0], a[q][1]); o.y = pk2(a[q][2], a[q][3]); *(u32x2*)(ub + swz(v, k0)) = o; }
      ZACC(a); mm_tile(A8, ST, W2T, ST, 2, a, w, lq, g); mm_tile2<false, true>(A9, ST, A6, ST, 2, a, w, lq, g);
#pragma unroll
      for (int q = 0; q < 2; ++q) { const int v = 16 * (nt0 + q) + lq, t0 = 16 * mt + 4 * g; u32x2 o; o.x = pk2(a[q][0], a[q][1]); o.y = pk2(a[q][2], a[q][3]); *(u32x2*)(ub + 8192 + swz(v, t0)) = o; } }
    LDS_BARRIER();
}
__device__ __forceinline__ void phase_rwkv_prep(const Params& P, int l, const Ctx& c) {
    const RwkvBufs B = rwkv_bufs(P, c);
    float pw0[8], pa0[8], pkk[8], pka[8], prk[8]; int hprev = -1;
    u32x4 wlr[4];
    for (int u = c.bid; u < NUNIT; u += c.G) {
        const int h = u & 7;
        if (h != hprev) { hprev = h; const int j0 = l * 512 + h * 64 + (c.tid & 7) * 8;
#pragma unroll
            for (int i = 0; i < 8; ++i) { pw0[i] = P.in[9][j0 + i]; pa0[i] = P.in[11][j0 + i]; pkk[i] = P.in[14][j0 + i]; pka[i] = P.in[15][j0 + i]; prk[i] = P.in[16][j0 + i]; }
            { const bf16* WTp = (const bf16*)(c.ws + OFF_WT); const int row = c.tid >> 3, chk = c.tid & 7;
              wlr[0] = *(const u32x4*)(WTp + WT_LW + (size_t)(h * 64 + row) * 64 + chk * 8); wlr[1] = *(const u32x4*)(WTp + WT_LA + (size_t)(h * 64 + row) * 64 + chk * 8);
#pragma unroll
              for (int i = 0; i < 2; ++i) { const int idx = c.tid + 512 * i, r2 = idx >> 4, c2 = idx & 15; wlr[2 + i] = *(const u32x4*)(WTp + WT_LG + (size_t)(h * 64 + r2) * 128 + c2 * 8); } } }
        rwkv_prep_unit(P, l, c, u, B, pw0, pa0, pkk, pka, prk, wlr);
    }
}

constexpr int SLOTB = 33280, YST = 68;
__device__ __forceinline__ void scan_chunked(const Params& P, const Ctx& c, int bh) {
    const RwkvBufs B = rwkv_bufs(P, c);
    const int b = bh >> 3, h = bh & 7, w = c.wave, lane = c.lane, lq = lane & 15, g = lane >> 4;
    const size_t rowb = (size_t)b * LP;
    const int ll = c.tid;
    unsigned char* L = c.lds;
    f32x4 st[4];
#pragma unroll
    for (int i = 0; i < 4; ++i) st[i] = (f32x4){0.f, 0.f, 0.f, 0.f};
    u32x4 r0[5], r1[5], r2[5], r3[5], r4[5];
#define SC_UNIT(cc) ((size_t)((b * NCHK + (cc)) * 8 + h))
#define SC_LOAD(R, cc) do { const unsigned char* pa_ = B.UA + SC_UNIT(cc) * UNIT_A; const unsigned char* pb_ = B.UB + SC_UNIT(cc) * UNIT_B; \
        _Pragma("unroll") for (int i_ = 0; i_ < 2; ++i_) { R[i_] = GLD(u32x4, pa_ + (ll + 512 * i_) * 16); R[2 + i_] = GLD(u32x4, pb_ + (ll + 512 * i_) * 16); } \
        if (ll < 16) R[4] = GLD(u32x4, pb_ + 16384 + ll * 16); } while (0)
#define SC_WRITE(R, slot) do { unsigned char* s_ = L + (slot) * SLOTB; \
        _Pragma("unroll") for (int i_ = 0; i_ < 2; ++i_) { *(u32x4*)(s_ + (ll + 512 * i_) * 16) = R[i_]; *(u32x4*)(s_ + 16384 + (ll + 512 * i_) * 16) = R[2 + i_]; } \
        if (ll < 16) *(u32x4*)(s_ + 32768 + ll * 16) = R[4]; } while (0)
#define SC_COMPUTE(ci) do { \
        const unsigned char* sl = L + ((ci) % 3) * SLOTB; \
        const int vcol = 16 * w + lq; \
        bf16x8 gaf[4][2]; f32x4 gcf[4]; u32x2 d0f[4]; \
        _Pragma("unroll") for (int mt = 0; mt < 4; ++mt) { \
            gcf[mt] = *(const f32x4*)(sl + 32768 + (16 * mt + 4 * g) * 4); \
            d0f[mt] = *(const u32x2*)(sl + 16384 + swz(vcol, 16 * mt + 4 * g)); \
            _Pragma("unroll") for (int ks = 0; ks < 2; ++ks) gaf[mt][ks] = *(const bf16x8*)(sl + swz(16 * mt + lq, 32 * ks + 8 * g)); } \
        __builtin_amdgcn_sched_barrier(0);        \
        bf16x8 sb[2]; \
        _Pragma("unroll") for (int ks = 0; ks < 2; ++ks) { u32x4 pw; pw.x = pk2(st[2 * ks][0], st[2 * ks][1]); pw.y = pk2(st[2 * ks][2], st[2 * ks][3]); pw.z = pk2(st[2 * ks + 1][0], st[2 * ks + 1][1]); pw.w = pk2(st[2 * ks + 1][2], st[2 * ks + 1][3]); \
            sb[ks] = __builtin_bit_cast(bf16x8, pw); } \
        _Pragma("unroll") for (int mt = 0; mt < 4; ++mt) { \
            f32x4 ns = (f32x4){bflo(d0f[mt].x), bfhi(d0f[mt].x), bflo(d0f[mt].y), bfhi(d0f[mt].y)} + gcf[mt] * st[mt]; \
            _Pragma("unroll") for (int ks = 0; ks < 2; ++ks) ns = __builtin_amdgcn_mfma_f32_16x16x32_bf16(gaf[mt][ks], sb[ks], ns, 0, 0, 0); \
            st[mt] = ns; } \
        bf16x8 rhf[4][2]; u32x2 y0f[4];        \
        _Pragma("unroll") for (int mt = 0; mt < 4; ++mt) { y0f[mt] = *(const u32x2*)(sl + 24576 + swz(vcol, 16 * mt + 4 * g)); \
            _Pragma("unroll") for (int ks = 0; ks < 2; ++ks) rhf[mt][ks] = *(const bf16x8*)(sl + 8192 + swz(16 * mt + lq, 32 * ks + 8 * g)); } \
        __builtin_amdgcn_sched_barrier(0); \
        f32x4 yav[4]; \
        _Pragma("unroll") for (int mt = 0; mt < 4; ++mt) { yav[mt] = (f32x4){bflo(y0f[mt].x), bfhi(y0f[mt].x), bflo(y0f[mt].y), bfhi(y0f[mt].y)}; \
            _Pragma("unroll") for (int ks = 0; ks < 2; ++ks) yav[mt] = __builtin_amdgcn_mfma_f32_16x16x32_bf16(rhf[mt][ks], sb[ks], yav[mt], 0, 0, 0); } \
        _Pragma("unroll") for (int mt = 0; mt < 4; ++mt) { \
            float* yl = (float*)(L + 3 * SLOTB) + ((ci) & 1) * (64 * YST) + (16 * mt + 4 * g) * YST + vcol; \
            _Pragma("unroll") for (int j = 0; j < 4; ++j) yl[j * YST] = yav[mt][j]; } } while (0)
#define SC_YSTORE(ci) do { const float* ys_ = (const float*)(L + 3 * SLOTB) + ((ci) & 1) * (64 * YST) + (c.tid >> 3) * YST + (c.tid & 7) * 8; \
        float* yg_ = B.Y + (rowb + (ci) * 64 + (c.tid >> 3)) * 512 + h * 64 + (c.tid & 7) * 8; \
        GST(f32x4, yg_) = *(const f32x4*)ys_; GST(f32x4, yg_ + 4) = *(const f32x4*)(ys_ + 4); } while (0)
#define SC_ITER(ci, R) do { if ((ci) + 2 < NCHK) SC_WRITE(R, ((ci) + 2) % 3); if ((ci) + 7 < NCHK) SC_LOAD(R, (ci) + 7); if ((ci) > 0) SC_YSTORE((ci) - 1); if (w < 4) { SC_COMPUTE(ci); } LDS_BARRIER(); } while (0)
    { SC_LOAD(r0, 0); SC_LOAD(r1, 1); SC_WRITE(r0, 0); SC_WRITE(r1, 1); SC_LOAD(r2, 2); SC_LOAD(r3, 3); SC_LOAD(r4, 4); SC_LOAD(r0, 5); SC_LOAD(r1, 6); }
    __syncthreads();
#pragma unroll 1
    for (int cc = 0; cc < NCHK; cc += 5) { SC_ITER(cc, r2); SC_ITER(cc + 1, r3); SC_ITER(cc + 2, r4); SC_ITER(cc + 3, r0); SC_ITER(cc + 4, r1); }
    SC_YSTORE(NCHK - 1);
#undef SC_YSTORE
#undef SC_COMPUTE
#undef SC_ITER
#undef SC_UNIT
#undef SC_LOAD
#undef SC_WRITE
}

__device__ __forceinline__ void phase_gn(const Params& P, int l, const Ctx& c) {
    const RwkvBufs B = rwkv_bufs(P, c);
    const int gw = c.bid * NWAVES + c.wave, NGW = c.G * NWAVES;
    const int c0 = 8 * c.lane;
    float gnw[8], gnb[8];
#pragma unroll
    for (int i = 0; i < 8; ++i) { gnw[i] = P.in[17][l * 512 + c0 + i]; gnb[i] = P.in[18][l * 512 + c0 + i]; }
    f32x4 ny0, ny1; u32x4 nbw, ngw;
#define GN_LOAD(mm) do { const size_t o_ = (size_t)(mm) * 512 + c0; ny0 = *(const f32x4*)(B.Y + o_); ny1 = *(const f32x4*)(B.Y + o_ + 4); nbw = *(const u32x4*)(B.BON + o_); ngw = *(const u32x4*)(B.G + o_); } while (0)
    if (gw < M) GN_LOAD(gw);
    for (int m = gw; m < M; m += NGW) {
        const size_t o = (size_t)m * 512 + c0;
        const f32x4 y0 = ny0, y1 = ny1; const u32x4 bw = nbw, gw4 = ngw;
        if (m + NGW < M) GN_LOAD(m + NGW);
        float y[8] = {y0.x, y0.y, y0.z, y0.w, y1.x, y1.y, y1.z, y1.w};
        const float bo[8] = {bflo(bw.x), bfhi(bw.x), bflo(bw.y), bfhi(bw.y), bflo(bw.z), bfhi(bw.z), bflo(bw.w), bfhi(bw.w)};
        const float gg[8] = {bflo(gw4.x), bfhi(gw4.x), bflo(gw4.y), bfhi(gw4.y), bflo(gw4.z), bfhi(gw4.z), bflo(gw4.w), bfhi(gw4.w)};
        float s = 0.f;
#pragma unroll
        for (int i = 0; i < 8; ++i) s += y[i];
        s += __shfl_xor(s, 1); s += __shfl_xor(s, 2); s += __shfl_xor(s, 4);
        const float mean = s * (1.f / 64.f);
        float q = 0.f;
#pragma unroll
        for (int i = 0; i < 8; ++i) { y[i] -= mean; q += y[i] * y[i]; }
        q += __shfl_xor(q, 1); q += __shfl_xor(q, 2); q += __shfl_xor(q, 4);
        const float rstd = 1.0f / sqrtf(q * (1.f / 64.f) + 64e-5f);
        float ov[8];
#pragma unroll
        for (int i = 0; i < 8; ++i) ov[i] = (y[i] * rstd * gnw[i] + gnb[i] + bo[i]) * gg[i];
        u32x4 ow; ow.x = pk2(ov[0], ov[1]); ow.y = pk2(ov[2], ov[3]); ow.z = pk2(ov[4], ov[5]); ow.w = pk2(ov[6], ov[7]);
        *(u32x4*)(B.ORW + o) = ow;
    }
}

__device__ __forceinline__ void attn_unit(const Ctx& c, int bh, int qb, const bf16* Q, const bf16* K, const bf16* V, bf16* O, const float* FC, float qkb2, const float* gq, const float* gk) {
    const int b = bh >> 3, h = bh & 7, lane = c.lane, w = c.wave, lq = lane & 15, g = lane >> 4;
    const int q0 = qb * 128;
    const size_t rowb = (size_t)b * LP;
    const int qrow = q0 + 16 * w + lq;
    bf16* Ks = (bf16*)c.lds; bf16* Vt = Ks + 64 * 72; float* fks = (float*)(Vt + 64 * 72);
    const bf16* qp = Q + (rowb + qrow) * 512 + h * 64 + 8 * g;
    bf16x8 qf0, qf1;
    { const u32x4 r0 = GLD(u32x4, qp), r1 = GLD(u32x4, qp + 32);
      float x[16] = {bflo(r0.x), bfhi(r0.x), bflo(r0.y), bfhi(r0.y), bflo(r0.z), bfhi(r0.z), bflo(r0.w), bfhi(r0.w), bflo(r1.x), bfhi(r1.x), bflo(r1.y), bfhi(r1.y), bflo(r1.z), bfhi(r1.z), bflo(r1.w), bfhi(r1.w)};
      float ss = 0.f;
#pragma unroll
      for (int i = 0; i < 16; ++i) ss += x[i] * x[i];
      ss += __shfl_xor(ss, 16); ss += __shfl_xor(ss, 32);
      const float rs = QSCALE / sqrtf(ss * (1.f / 64.f) + 1e-6f);
#pragma unroll
      for (int i = 0; i < 8; ++i) { x[i] *= rs * gq[8 * g + i]; x[8 + i] *= rs * gq[32 + 8 * g + i]; }
      u32x4 p0, p1; p0.x = pk2(x[0], x[1]); p0.y = pk2(x[2], x[3]); p0.z = pk2(x[4], x[5]); p0.w = pk2(x[6], x[7]); p1.x = pk2(x[8], x[9]); p1.y = pk2(x[10], x[11]); p1.z = pk2(x[12], x[13]); p1.w = pk2(x[14], x[15]);
      qf0 = __builtin_bit_cast(bf16x8, p0); qf1 = __builtin_bit_cast(bf16x8, p1); }
    const float* FCh = FC + (size_t)bh * LP;
    const float fq = GLD(float, FCh + qrow);
    float mrun = -1e30f, lsum = 0.f;
    f32x4 o[4];
#pragma unroll
    for (int i = 0; i < 4; ++i) o[i] = (f32x4){0.f, 0.f, 0.f, 0.f};
    const int kt_max = (q0 + 127) >> 6;
    const int lkey = c.tid >> 3, lch = c.tid & 7;
    float gkr[8];
#pragma unroll
    for (int i = 0; i < 8; ++i) gkr[i] = gk[lch * 8 + i];
    const size_t gbase = (rowb + lkey) * 512 + h * 64 + lch * 8;
    u32x4 kv = GLD(u32x4, K + gbase + (size_t)kt_max * 64 * 512), vv = GLD(u32x4, V + gbase + (size_t)kt_max * 64 * 512);
    float fkv = GLD(float, FCh + kt_max * 64 + (c.tid & 63));
    volatile unsigned* vote = (volatile unsigned*)(fks + 64);
    for (int kt = kt_max; kt >= 0; --kt) {
        const int k0 = kt * 64;
        LDS_BARRIER();
        { int can = 0; if (kt < kt_max) { const float fl = __shfl(fkv, 63); can = (qkb2 + fq - fl) < (mrun - THR2); }
          const int wall = __all(can); if (lane == 0) vote[w] = (unsigned)wall; }
        { { float x[8] = {bflo(kv.x), bfhi(kv.x), bflo(kv.y), bfhi(kv.y), bflo(kv.z), bfhi(kv.z), bflo(kv.w), bfhi(kv.w)}; float ss = 0.f;
#pragma unroll
              for (int i = 0; i < 8; ++i) ss += x[i] * x[i];
              ss += __shfl_xor(ss, 1); ss += __shfl_xor(ss, 2); ss += __shfl_xor(ss, 4);
              const float rs = 1.0f / sqrtf(ss * (1.f / 64.f) + 1e-6f);
              u32x4 kn; kn.x = pk2(x[0] * rs * gkr[0], x[1] * rs * gkr[1]); kn.y = pk2(x[2] * rs * gkr[2], x[3] * rs * gkr[3]); kn.z = pk2(x[4] * rs * gkr[4], x[5] * rs * gkr[5]); kn.w = pk2(x[6] * rs * gkr[6], x[7] * rs * gkr[7]);
              *(u32x4*)(Ks + lkey * 72 + lch * 8) = kn; }
            bf16* vd = Vt + (lch * 8) * 72 + (lkey ^ (8 * lch));
            vd[0] = (bf16)(vv.x & 0xffff); vd[72] = (bf16)(vv.x >> 16); vd[144] = (bf16)(vv.y & 0xffff); vd[216] = (bf16)(vv.y >> 16);
            vd[288] = (bf16)(vv.z & 0xffff); vd[360] = (bf16)(vv.z >> 16); vd[432] = (bf16)(vv.w & 0xffff); vd[504] = (bf16)(vv.w >> 16);
            if (c.tid < 64) fks[c.tid] = fkv;
            if (kt > 0) { kv = GLD(u32x4, K + gbase + (size_t)(k0 - 64) * 512); vv = GLD(u32x4, V + gbase + (size_t)(k0 - 64) * 512); fkv = GLD(float, FCh + k0 - 64 + (c.tid & 63)); } }
        LDS_BARRIER();
        { unsigned all = vote[0] & vote[1] & vote[2] & vote[3] & vote[4] & vote[5] & vote[6] & vote[7]; if (all) break; }
        if (k0 > q0 + 16 * w + 15) continue;
        f32x4 s[4];
#pragma unroll
        for (int nt = 0; nt < 4; ++nt) { const bf16* kp = Ks + (16 * nt + lq) * 72 + 8 * g; const bf16x8 a0 = *(const bf16x8*)kp, a1 = *(const bf16x8*)(kp + 32);
            s[nt] = __builtin_amdgcn_mfma_f32_16x16x32_bf16(a0, qf0, (f32x4){0.f, 0.f, 0.f, 0.f}, 0, 0, 0);
            s[nt] = __builtin_amdgcn_mfma_f32_16x16x32_bf16(a1, qf1, s[nt], 0, 0, 0); }
        float mx = -INFINITY;
#pragma unroll
        for (int nt = 0; nt < 4; ++nt) { const f32x4 fk = *(const f32x4*)(fks + 16 * nt + 4 * g);
#pragma unroll
            for (int j = 0; j < 4; ++j) { float x = s[nt][j] + fq - fk[j]; const int key = k0 + 16 * nt + 4 * g + j; if (key > qrow) x = -INFINITY; s[nt][j] = x; mx = fmaxf(mx, x); } }
        mx = fmaxf(mx, __shfl_xor(mx, 16)); mx = fmaxf(mx, __shfl_xor(mx, 32));
        const float mnew = fmaxf(mrun, mx), alpha = __builtin_amdgcn_exp2f(mrun - mnew); mrun = mnew;
        float psum = 0.f;
#pragma unroll
        for (int nt = 0; nt < 4; ++nt)
#pragma unroll
            for (int j = 0; j < 4; ++j) { const float p = __builtin_amdgcn_exp2f(s[nt][j] - mnew); s[nt][j] = p; psum += p; }
        lsum = lsum * alpha + psum;
#pragma unroll
        for (int dt = 0; dt < 4; ++dt) o[dt] = o[dt] * alpha;
        bf16x8 pb[2];
#pragma unroll
        for (int k2 = 0; k2 < 2; ++k2) { u32x4 pw; pw.x = pk2(s[2 * k2][0], s[2 * k2][1]); pw.y = pk2(s[2 * k2][2], s[2 * k2][3]); pw.z = pk2(s[2 * k2 + 1][0], s[2 * k2 + 1][1]); pw.w = pk2(s[2 * k2 + 1][2], s[2 * k2 + 1][3]);
            pb[k2] = __builtin_bit_cast(bf16x8, pw); }
#pragma unroll
        for (int dt = 0; dt < 4; ++dt)
#pragma unroll
            for (int k2 = 0; k2 < 2; ++k2) { const int vrow = 16 * dt + lq, vx = 8 * ((vrow >> 3) & 7); const bf16* vp = Vt + vrow * 72;
                const u32x2 lo = *(const u32x2*)(vp + ((32 * k2 + 4 * g) ^ vx)), hi = *(const u32x2*)(vp + ((32 * k2 + 16 + 4 * g) ^ vx));
                u32x4 aw; aw.x = lo.x; aw.y = lo.y; aw.z = hi.x; aw.w = hi.y;
                o[dt] = __builtin_amdgcn_mfma_f32_16x16x32_bf16(__builtin_bit_cast(bf16x8, aw), pb[k2], o[dt], 0, 0, 0); }
    }
    lsum += __shfl_xor(lsum, 16); lsum += __shfl_xor(lsum, 32);
    const float inv = 1.0f / lsum;
    bf16* op = O + (rowb + qrow) * 512 + h * 64 + 4 * g;
#pragma unroll
    for (int dt = 0; dt < 4; ++dt) { u32x2 ow; ow.x = pk2(o[dt][0] * inv, o[dt][1] * inv); ow.y = pk2(o[dt][2] * inv, o[dt][3] * inv); GST(u32x2, op + 16 * dt) = ow; }
    __syncthreads();
}
__device__ __forceinline__ void phase_attn(const Params& P, int l, const Ctx& c, int first_blk) {
    const bf16* Q = (const bf16*)(c.ws + OFF_Q); const bf16* K = (const bf16*)(c.ws + OFF_K); const bf16* V = (const bf16*)(c.ws + OFF_V);
    const float* FC = (const float*)(c.ws + OFF_MISC) + 16 * LP;
    float gqm = fabsf(P.in[5][l * 64 + c.lane]), gkm = fabsf(P.in[6][l * 64 + c.lane]);
#pragma unroll
    for (int o = 1; o < 64; o <<= 1) { gqm = fmaxf(gqm, __shfl_xor(gqm, o)); gkm = fmaxf(gkm, __shfl_xor(gkm, o)); }
    const float qkb2 = 8.0f * gqm * gkm * LOG2E * 1.03f;
    constexpr int NQB = LP / 128, NU = 16 * NQB;
    unsigned* ctr = (unsigned*)(c.ws + OFF_CTL) + 8192 + 64 * l;
    volatile unsigned* slot = (volatile unsigned*)(c.lds + MISC_OFF) + 4;
    for (;;) {
        __syncthreads();
        if (c.tid == 0) *slot = atomicAdd(ctr, 1u);
        __syncthreads();
        const int u = (int)*slot;
        if (u >= NU) break;
        const int bh = u & 15, qb = NQB - 1 - (u >> 4); attn_unit(c, bh, qb, Q, K, V, (bf16*)(c.ws + OFF_OF), FC, qkb2, P.in[5] + l * 64, P.in[6] + l * 64);
    }
}

__device__ __forceinline__ void phase_fixup(const Params& P, int l, const Ctx& c) {
    bf16* ACT = (bf16*)(c.ws + OFF_RW); const bf16* HALO = (const bf16*)(c.ws + OFF_Q);
    const float* cw = P.in[24] + (size_t)l * 3 * NUP;
    const int total = (M / 64) * 2 * DFF;
    for (int idx = c.bid * NTHR + c.tid; idx < total; idx += c.G * NTHR) {
        const int rr = idx / DFF, ch = idx - rr * DFF, q64 = rr >> 1, e = rr & 1, row = q64 * 64 + e;
        const int t = row % LP;
        int s0, s1, s2;
        if (e == 0) { s0 = q64 * 4 + 2; s1 = (q64 - 1) * 4 + 1; s2 = (q64 - 1) * 4 + 0; } else { s0 = q64 * 4 + 3; s1 = q64 * 4 + 2; s2 = (q64 - 1) * 4 + 1; }
        float uc[2];
#pragma unroll
        for (int bj = 0; bj < 2; ++bj) { const int col = bj * DFF + ch;
            const float u0 = bf2f(HALO[(size_t)s0 * NUP + col]);
            const float u1 = (t >= 1) ? bf2f(HALO[(size_t)s1 * NUP + col]) : 0.f;
            const float u2 = (t >= 2) ? bf2f(HALO[(size_t)s2 * NUP + col]) : 0.f;
            uc[bj] = cw[col] * u2 + cw[NUP + col] * u1 + cw[2 * NUP + col] * u0; }
        ACT[(size_t)row * DFF + ch] = (bf16)f2bf(uc[0] * sigmoidf_(uc[0]) * uc[1]);
    }
}

#define OPQ_S(x) asm volatile("" : "+s"(x))
#define OPQ_V(x) asm volatile("" : "+v"(x))
#define PHASE_BEGIN() do { int t_ = threadIdx.x; OPQ_V(t_); c.tid = t_; c.lane = t_ & 63; c.wave = __builtin_amdgcn_readfirstlane(t_ >> 6); int b_ = blockIdx.x; OPQ_S(b_); c.bid = b_; \
    size_t z_ = 0; OPQ_S(z_); unsigned char* w_ = P.ws + z_;   c.ws = w_; ws = w_; l = lc; OPQ_S(l); WT = (pg8::bf16_t*)(ws + OFF_WT); HN = (pg8::bf16_t*)(ws + OFF_HN); } while (0)
__global__ void __launch_bounds__(NTHR, 2) mega(Params P) {
    extern __shared__ __attribute__((aligned(16))) unsigned char lds[];
    Ctx c; c.G = gridDim.x; c.lds = lds;
    volatile LAS unsigned* MISC = (volatile LAS unsigned*)((LAS unsigned char*)lds + MISC_OFF);
    if (threadIdx.x < 16) MISC[threadIdx.x] = 0u;
    __syncthreads();
    (void)xcd_barrier_post((unsigned*)(P.ws + OFF_CTL) + 1024, MISC + 8);
#define SEAM() do { XcdBarrier xb_; xb_.bar = (unsigned*)(P.ws + OFF_CTL) + 1024; xb_.x = xb_xcc_id(); xb_.st = (volatile LAS unsigned*)((LAS unsigned char*)lds + MISC_OFF) + 8; xcd_barrier(xb_); } while (0)
    PG8_LAS unsigned char* ldsl = (PG8_LAS unsigned char*)lds;
    unsigned char* ws; pg8::bf16_t* WT; pg8::bf16_t* HN; int l;
#pragma unroll 1
    for (int lc = 0; lc < DEPTH; ++lc) {
        PHASE_BEGIN();
        convert_weights(P, l, c);
        phase_norm<true>(P, l, c);
        SEAM();
        if (P.out == nullptr) cg::this_grid().sync();
        PHASE_BEGIN();
        phase_fcum(P, c);
        { pg8::Gemm g{HN, WT + WT_IN, M, N1, 1024, 1024}; pg8::StaticOrder S; S.init(M, N1, c.G, c.bid);
          pg8::EpiRoute E{ws};
          pg8::gemm_phase<pg8::EpiRoute, pg8::StaticOrder, true, true>(ldsl, g, S, E); }
        SEAM();
        PHASE_BEGIN();
        for (int rep_ = 0; rep_ < REP_PREP; ++rep_) phase_rwkv_prep(P, l, c);
        SEAM();
        PHASE_BEGIN();
        if (c.bid < 16) { scan_chunked(P, c, c.bid); __syncthreads(); PHASE_BEGIN(); }
        phase_attn(P, l, c, 16);
#if REP_P3 > 1
        __syncthreads(); PHASE_BEGIN();
        if (c.bid < 16) scan_chunked(P, c, c.bid); else phase_attn(P, l, c, 16);
#endif
        SEAM();
        PHASE_BEGIN();
        phase_gn(P, l, c);
        for (int rep_ = 0; rep_ < REP_SYNC; ++rep_) SEAM();
        SEAM();
        PHASE_BEGIN();
#pragma unroll 1
        for (int pass = 0; pass < 3; ++pass) {
            if (pass) { __syncthreads(); PHASE_BEGIN(); }
            const int rw_side = pass == 2 ? ((c.bid >> 2) & 1) : pass;
            const pg8::bf16_t* A = rw_side ? (const pg8::bf16_t*)(ws + OFF_RW + (size_t)M * 512 * 4) : (const pg8::bf16_t*)(ws + OFF_OF);
            pg8::Gemm g{A, WT + (rw_side ? WT_BR : WT_BF), M, 1024, 512, 512};
            pg8::OneUnit S; S.so.init(MMAIN, 1024, c.G, c.bid); S.mode = pass == 2; S.pm = MMAIN / 256; S.pn = c.bid & 3; S.active = c.bid < 8;
            pg8::bf16_t* O = (pass == 2 && rw_side) ? (pg8::bf16_t*)(ws + OFF_TAIL) - (size_t)MMAIN * 1024 : (pg8::bf16_t*)(ws + OFF_K);
            pg8::EpiGateR E{O, (const pg8::bf16_t*)(ws + OFF_GT), P.in[21] + l * NGT, rw_side * 1024, pass == 1};
            pg8::gemm_phase<pg8::EpiGateR, pg8::OneUnit, true, true>(ldsl, g, S, E);
        }
        SEAM();
        PHASE_BEGIN();
#pragma unroll 1
        for (int pass = 0; pass < 2; ++pass) {
            if (pass) { __syncthreads(); PHASE_BEGIN(); }
            const int sl = pass ? (c.bid >> 2) : 0, ks = sl & 3;
            const pg8::bf16_t* A = (pass && sl >= 4) ? (const pg8::bf16_t*)(ws + OFF_TAIL) - (size_t)MMAIN * 1024 : (const pg8::bf16_t*)(ws + OFF_K);
            pg8::Gemm g{A + ks * 256, WT + WT_O + ks * 256, M, 1024, pass ? 256 : 1024, 1024};
            pg8::OneUnit S; S.so.init(MMAIN, 1024, c.G, c.bid); S.mode = pass; S.pm = MMAIN / 256; S.pn = c.bid & 3; S.active = sl < 8;
            pg8::EpiResid E{(float*)(ws + OFF_H), nullptr, pass};
            pg8::gemm_phase<pg8::EpiResid, pg8::OneUnit, true, true>(ldsl, g, S, E);
        }
        SEAM();
        PHASE_BEGIN();
        phase_norm<false>(P, l, c);
        SEAM();
        PHASE_BEGIN();
        { pg8::Gemm g{HN, WT + WT_UP, M, NUP, 1024, 1024}; pg8::StaticOrder S; S.init(M, NUP, c.G, c.bid);
          pg8::EpiUp E{(pg8::bf16_t*)(ws + OFF_RW), (pg8::bf16_t*)(ws + OFF_Q), P.in[24] + (size_t)l * 3 * NUP};
          pg8::gemm_phase<pg8::EpiUp, pg8::StaticOrder, true, true>(ldsl, g, S, E); }
        SEAM();
        PHASE_BEGIN();
        phase_fixup(P, l, c);
        SEAM();
        PHASE_BEGIN();
#pragma unroll 1
        for (int pass = 0; pass < 2; ++pass) {
            if (pass) { __syncthreads(); PHASE_BEGIN(); }
            const int sl = pass ? (c.bid >> 2) : 0;
            const int ko = (sl < 6) ? sl * 384 : 2304 + (sl - 6) * 256, kl = (sl < 6) ? 384 : 256;
            pg8::Gemm g{(const pg8::bf16_t*)(ws + OFF_RW) + (pass ? ko : 0), WT + WT_DN + (pass ? ko : 0), M, 1024, pass ? kl : DFF, DFF};
            pg8::OneUnit S; S.so.init(MMAIN, 1024, c.G, c.bid); S.mode = pass; S.pm = MMAIN / 256; S.pn = c.bid & 3; S.active = sl < 8;
            pg8::EpiResid E{(float*)(ws + OFF_H), (l == DEPTH - 1 && !pass) ? P.out : nullptr, pass};
            pg8::gemm_phase<pg8::EpiResid, pg8::OneUnit, true, true>(ldsl, g, S, E);
        }
        SEAM();
        if (l == DEPTH - 1) {
            PHASE_BEGIN();
            const float* H = (const float*)(ws + OFF_H);
            for (int idx = c.bid * NTHR + c.tid; idx < (NMETA + SEQ - (MMAIN - LP)) * (DM / 4); idx += c.G * NTHR) {
                const int r = idx / (DM / 4), q4 = idx - r * (DM / 4), t = (MMAIN - LP) + r;
                *(f32x4*)(P.out + ((size_t)SEQ + (t - NMETA)) * DM + 4 * q4) = *(const f32x4*)(H + (size_t)(LP + t) * DM + 4 * q4);
            }
        }
    }
}

extern "C" void kernel_launch(void* const* d_in, const int* in_sizes, int n_in, void* d_out, int out_size, void* d_ws, size_t ws_size, hipStream_t stream) {
    static int grid = 0;
    if (grid == 0) {
        if (n_in != 26 || out_size != NB * SEQ * DM || ws_size < WS_NEED) { fprintf(stderr, "kernel_launch: unexpected shapes (n_in %d out %d ws %zu need %zu)\n", n_in, out_size, ws_size, (size_t)WS_NEED); grid = -1; return; }
        int dev = 0, cus = 0, per_cu = 0;
        if (hipGetDevice(&dev) != hipSuccess || hipDeviceGetAttribute(&cus, hipDeviceAttributeMultiprocessorCount, dev) != hipSuccess) { grid = -1; return; }
        if (hipFuncSetAttribute((const void*)mega, hipFuncAttributeMaxDynamicSharedMemorySize, LDS_BYTES) != hipSuccess) { fprintf(stderr, "kernel_launch: hipFuncSetAttribute failed\n"); grid = -1; return; }
        if (hipOccupancyMaxActiveBlocksPerMultiprocessor(&per_cu, (const void*)mega, NTHR, LDS_BYTES) != hipSuccess || per_cu < 1) { fprintf(stderr, "kernel_launch: occupancy query says %d\n", per_cu); per_cu = 1; }
        (void)hipGetLastError();
        grid = cus;
    }
    if (grid < 0) return;
    if (hipMemsetAsync((char*)d_ws + OFF_CTL, 0, 65536, stream) != hipSuccess) { fprintf(stderr, "kernel_launch: memset failed\n"); return; }
    Params p{};
    for (int i = 0; i < 26; ++i) p.in[i] = (const float*)d_in[i];
    p.out = (float*)d_out; p.ws = (unsigned char*)d_ws;
    void* args[] = {&p};
    hipError_t e = hipLaunchCooperativeKernel((const void*)mega, dim3(grid), dim3(NTHR), args, LDS_BYTES, stream);
    if (e != hipSuccess) fprintf(stderr, "kernel_launch: cooperative launch failed: %s (grid %d)\n", hipGetErrorString(e), grid);
}
```

```cpp
#include <hip/hip_runtime.h>
#include <hip/hip_cooperative_groups.h>
#include <cstdio>
#include <cstdint>
#include <cmath>
namespace cg = cooperative_groups;
namespace pg8 {
#define PG8_LAS __attribute__((address_space(3)))
typedef unsigned short bf16_t;
typedef short bf16x8 __attribute__((ext_vector_type(8)));
typedef float f32x4 __attribute__((ext_vector_type(4)));
typedef unsigned u32x4 __attribute__((ext_vector_type(4)));
constexpr int BM = 256, BK = 64, HALF = 128, HTB = HALF * BK * 2  , STAGE_BYTES = 8 * HTB, NXCD = 8, WGM = 8;

__host__ __device__ __forceinline__ int lds_byte(int r, int c) { const int st = (r >> 4) * 2 + (c >> 5), rr = r & 15, cc = c & 31, ob = rr * 64 + cc * 2; return st * 1024 + (ob ^ (((ob >> 9) & 1) << 5)); }
__host__ __device__ __forceinline__ void stage_rc(int b, int& R, int& C) { const int st = b / 1024, sb = b % 1024, swz = sb ^ (((sb >> 9) & 1) << 5); R = (st >> 1) * 16 + swz / 64; C = (st & 1) * 32 + (swz % 64) / 2; }
__host__ __device__ __forceinline__ int perm32(int rho) { const int n = rho >> 4, i = rho & 15; return 8 * (i >> 2) + 4 * n + (i & 3); }

struct Unit { int pm, pn; };
struct Gemm { const bf16_t* A; const bf16_t* Bt; int M, N, K, ld; };

struct StaticOrder {
    int nM, nN, nwg, G, c;
    __host__ __device__ void init(int M, int N, int G_, int c_) { nM = M / BM; nN = N / BM; nwg = nM * nN; G = G_; c = c_; }
    __host__ __device__ bool next(int i, Unit& u) const {
        const long L = (long)i * G + c; if (L >= nwg) return false;
        int wgid = (int)L; { const int q = nwg / NXCD, r = nwg % NXCD, xcd = wgid % NXCD, off = wgid / NXCD; wgid = (xcd < r ? xcd * (q + 1) : r * (q + 1) + (xcd - r) * q) + off; }
        const int nig = WGM * nN, gid = wgid / nig, fm = gid * WGM, gsz = (nM - fm) < WGM ? (nM - fm) : WGM;
        u.pm = fm + ((wgid % nig) % gsz); u.pn = (wgid % nig) / gsz; return true;
    }
    __device__ __forceinline__ void a_ready(const Unit&) const {}
    __device__ __forceinline__ void done(const Unit&) const {}
};

__device__ __forceinline__ unsigned cvt_pk_bf16(float lo, float hi) { unsigned r; asm volatile("v_cvt_pk_bf16_f32 %0, %1, %2" : "=v"(r) : "v"(lo), "v"(hi)); return r; }
typedef float f32x2 __attribute__((ext_vector_type(2)));
template <class Epi, class Sched, bool ALIGN_EPI = false, bool SP2 = false>
__device__ __forceinline__ void gemm_phase(PG8_LAS unsigned char* lds, const Gemm g, const Sched& S, const Epi& E) {
    int tid_ = threadIdx.x; asm volatile("" : "+v"(tid_)); const int tid = tid_, wid = __builtin_amdgcn_readfirstlane(tid >> 6), lane = tid & 63, wr = wid >> 2, wc = wid & 3, fr = lane & 15, fq = lane >> 4;
    const int K = g.K, nt = K / BK, LD = g.ld;
    unsigned voffA[2], voffB[2];
#pragma unroll
    for (int i = 0; i < 2; ++i) { int R, C; stage_rc(tid * 16 + i * 8192, R, C); const int Rb = Epi::PERM ? ((R & ~31) + perm32(R & 31)) : R;
        voffA[i] = (unsigned)(R * LD + C) * 2u; voffB[i] = (unsigned)(Rb * LD + C) * 2u; }
    const size_t kstep = (size_t)(BK * 2);
    const size_t hstep = (size_t)HALF * LD * 2;
    const size_t tstep = 2 * hstep;
    const unsigned ldsw = (unsigned)wid * 1024u;
    const int aoff = lds_byte(wr * 64 + fr, fq * 8), boff = lds_byte(wc * 32 + fr, fq * 8);
#define PG8_SA(b, h) (((b) * 2 + (h)) * HTB)
#define PG8_SB(b, h) ((4 + (b) * 2 + (h)) * HTB)
#define PG8_STAGE(bufoff, gbase, voff) do { _Pragma("unroll") for (int _i = 0; _i < 2; ++_i) \
        __builtin_amdgcn_global_load_lds((const unsigned*)((const char*)(gbase) + (voff)[_i]), (PG8_LAS unsigned*)(lds + (bufoff) + ldsw + _i * 8192), 16, 0, 0); } while (0)
#define PG8_LDA(dst, b, h) do { _Pragma("unroll") for (int m = 0; m < 4; ++m) _Pragma("unroll") for (int k = 0; k < 2; ++k) dst[m][k] = *(const PG8_LAS bf16x8*)(lds + PG8_SA(b, h) + aoff + m * 2048 + k * 1024); } while (0)
#define PG8_LDB(dst, b, h) do { _Pragma("unroll") for (int n = 0; n < 2; ++n) _Pragma("unroll") for (int k = 0; k < 2; ++k) dst[n][k] = *(const PG8_LAS bf16x8*)(lds + PG8_SB(b, h) + boff + n * 2048 + k * 1024); } while (0)
#define PG8_MMA(ai, bj, At, Bt) do { __builtin_amdgcn_s_setprio(1); _Pragma("unroll") for (int m = 0; m < 4; ++m) _Pragma("unroll") for (int n = 0; n < 2; ++n) _Pragma("unroll") for (int k = 0; k < 2; ++k) \
        acc[ai][bj][m][n] = __builtin_amdgcn_mfma_f32_16x16x32_bf16(Bt[n][k], At[m][k], acc[ai][bj][m][n], 0, 0, 0); __builtin_amdgcn_s_setprio(0); } while (0)
#define PG8_WAIT_V(n) asm volatile("s_waitcnt vmcnt(" #n ")" ::: "memory")
#define PG8_WAIT_L(n) asm volatile("s_waitcnt lgkmcnt(" #n ")" ::: "memory")
#define PG8_BAR __builtin_amdgcn_s_barrier()
#define PG8_SCHED __builtin_amdgcn_sched_barrier(0)
    Unit cur, nxt; int ui = 0;
    if (!S.next(0, cur)) return;
    f32x4 acc[2][2][4][2];
#pragma unroll
    for (int a = 0; a < 2; ++a)
#pragma unroll
        for (int b = 0; b < 2; ++b)
#pragma unroll
            for (int m = 0; m < 4; ++m)
#pragma unroll
                for (int n = 0; n < 2; ++n) acc[a][b][m][n] = (f32x4){0.f, 0.f, 0.f, 0.f};
    bf16x8 At[4][2], B0[2][2], B1[2][2];
    const char* cA = (const char*)g.A + (size_t)cur.pm * tstep; const char* cB = (const char*)g.Bt + (size_t)cur.pn * tstep;
    S.a_ready(cur);
    if constexpr (SP2) {
        PG8_STAGE(PG8_SB(0, 0), cB, voffB); PG8_STAGE(PG8_SB(0, 1), cB + hstep, voffB); PG8_STAGE(PG8_SA(0, 0), cA, voffA); PG8_STAGE(PG8_SA(0, 1), cA + hstep, voffA);
        if (wr == 1) PG8_BAR;
        PG8_WAIT_V(2); PG8_BAR;
        PG8_STAGE(PG8_SB(1, 0), cB + kstep, voffB); PG8_STAGE(PG8_SA(1, 0), cA + kstep, voffA); PG8_STAGE(PG8_SB(1, 1), cB + hstep + kstep, voffB);
        PG8_WAIT_V(6); PG8_BAR;
    } else {
        PG8_STAGE(PG8_SB(0, 0), cB, voffB); PG8_STAGE(PG8_SA(0, 0), cA, voffA); PG8_STAGE(PG8_SB(0, 1), cB + hstep, voffB); PG8_STAGE(PG8_SA(0, 1), cA + hstep, voffA);
        if (wr == 1) PG8_BAR;
        PG8_WAIT_V(4); PG8_BAR;
        PG8_STAGE(PG8_SB(1, 0), cB + kstep, voffB); PG8_STAGE(PG8_SA(1, 0), cA + kstep, voffA); PG8_STAGE(PG8_SB(1, 1), cB + hstep + kstep, voffB);
        PG8_WAIT_V(6); PG8_BAR;
    }
    for (;;) {
        const bool has_next = S.next(ui + 1, nxt);
        const char* nA = has_next ? (const char*)g.A + (size_t)nxt.pm * tstep : cA; const char* nB = has_next ? (const char*)g.Bt + (size_t)nxt.pn * tstep : cB;
        for (int t = 0; t < nt; t += 2) {
            const bool last = (t == nt - 2);
            const char* a1 = cA + (size_t)(t + 1) * kstep;
            const char* a2 = last ? nA : cA + (size_t)(t + 2) * kstep; const char* b2 = last ? nB : cB + (size_t)(t + 2) * kstep;
            const char* a3 = a2 + kstep; const char* b3 = b2 + kstep;
            if (last && has_next) S.a_ready(nxt);
            if constexpr (SP2) {
            PG8_LDB(B0, 0, 0); PG8_LDB(B1, 0, 1); PG8_SCHED; PG8_LDA(At, 0, 0); PG8_STAGE(PG8_SA(1, 1), a1 + hstep, voffA);
            PG8_WAIT_V(8); PG8_WAIT_L(0); PG8_BAR; PG8_MMA(0, 0, At, B0); PG8_MMA(0, 1, At, B1); PG8_BAR; PG8_SCHED;
            PG8_LDA(At, 0, 1); PG8_STAGE(PG8_SB(0, 0), b2, voffB); PG8_STAGE(PG8_SB(0, 1), b2 + hstep, voffB); PG8_STAGE(PG8_SA(0, 0), a2, voffA);
            PG8_WAIT_V(8); PG8_WAIT_L(0); PG8_BAR; PG8_MMA(1, 0, At, B0); PG8_MMA(1, 1, At, B1); PG8_BAR; PG8_SCHED;
            PG8_LDB(B0, 1, 0); PG8_LDB(B1, 1, 1); PG8_SCHED; PG8_LDA(At, 1, 0); PG8_STAGE(PG8_SA(0, 1), a2 + hstep, voffA);
            PG8_WAIT_V(8); PG8_WAIT_L(0); PG8_BAR; PG8_MMA(0, 0, At, B0); PG8_MMA(0, 1, At, B1); PG8_BAR; PG8_SCHED;
            PG8_LDA(At, 1, 1); PG8_STAGE(PG8_SB(1, 0), b3, voffB); PG8_STAGE(PG8_SB(1, 1), b3 + hstep, voffB); PG8_STAGE(PG8_SA(1, 0), a3, voffA);
            PG8_WAIT_V(8); PG8_WAIT_L(0); PG8_BAR; PG8_MMA(1, 0, At, B0); PG8_MMA(1, 1, At, B1); PG8_BAR; PG8_SCHED;
            } else {
            PG8_LDB(B0, 0, 0); PG8_SCHED; PG8_LDA(At, 0, 0); PG8_STAGE(PG8_SA(1, 1), a1 + hstep, voffA);
            PG8_WAIT_L(8); PG8_BAR; PG8_WAIT_L(0); PG8_MMA(0, 0, At, B0); PG8_BAR; PG8_SCHED;
            PG8_LDB(B1, 0, 1); PG8_STAGE(PG8_SB(0, 0), b2, voffB);
            PG8_BAR; PG8_WAIT_L(0); PG8_MMA(0, 1, At, B1); PG8_BAR;
            PG8_LDA(At, 0, 1); PG8_STAGE(PG8_SA(0, 0), a2, voffA);
            PG8_BAR; PG8_WAIT_L(0); PG8_MMA(1, 0, At, B0); PG8_BAR; PG8_SCHED;
            PG8_STAGE(PG8_SB(0, 1), b2 + hstep, voffB);
            PG8_WAIT_V(6); PG8_BAR; PG8_MMA(1, 1, At, B1); PG8_BAR;
            PG8_LDB(B0, 1, 0); PG8_SCHED; PG8_LDA(At, 1, 0); PG8_STAGE(PG8_SA(0, 1), a2 + hstep, voffA);
            PG8_WAIT_L(8); PG8_BAR; PG8_WAIT_L(0); PG8_MMA(0, 0, At, B0); PG8_BAR; PG8_SCHED;
            PG8_LDB(B1, 1, 1); PG8_STAGE(PG8_SB(1, 0), b3, voffB);
            PG8_BAR; PG8_WAIT_L(0); PG8_MMA(0, 1, At, B1); PG8_BAR;
            PG8_LDA(At, 1, 1); PG8_STAGE(PG8_SA(1, 0), a3, voffA);
            PG8_BAR; PG8_WAIT_L(0); PG8_MMA(1, 0, At, B0); PG8_BAR; PG8_SCHED;
            PG8_STAGE(PG8_SB(1, 1), b3 + hstep, voffB);
            PG8_WAIT_V(6); PG8_BAR; PG8_MMA(1, 1, At, B1); PG8_BAR;
            }
        }
        if constexpr (ALIGN_EPI) { if (wr == 0) PG8_BAR; }
        if constexpr (!Epi::AFTER_DRAIN) { E(acc, cur, wr, wc, fr, fq); S.done(cur); }
        if (!has_next) break;
#pragma unroll
        for (int a = 0; a < 2; ++a)
#pragma unroll
            for (int b = 0; b < 2; ++b)
#pragma unroll
                for (int m = 0; m < 4; ++m)
#pragma unroll
                    for (int n = 0; n < 2; ++n) acc[a][b][m][n] = (f32x4){0.f, 0.f, 0.f, 0.f};
        cur = nxt; cA = nA; cB = nB; ++ui;
        if constexpr (ALIGN_EPI) { if (wr == 1) PG8_BAR; }
    }
    PG8_WAIT_V(0);
    if constexpr (!ALIGN_EPI) { if (wr == 0) PG8_BAR; }
    PG8_BAR;
    if constexpr (Epi::AFTER_DRAIN) { E.fused(acc, cur, wr, wc, fr, fq, lds, wid, lane); S.done(cur); }
#undef PG8_SA
#undef PG8_SB
#undef PG8_STAGE
#undef PG8_LDA
#undef PG8_LDB
#undef PG8_MMA
#undef PG8_WAIT_V
#undef PG8_WAIT_L
#undef PG8_BAR
#undef PG8_SCHED
}
}
#define GAS __attribute__((address_space(1)))
#define LAS __attribute__((address_space(3)))
typedef GAS unsigned gu32;
typedef GAS unsigned long long gu64;
#define RLX_AGENT __ATOMIC_RELAXED, __HIP_MEMORY_SCOPE_AGENT
#define LDS_WAIT() asm volatile("s_waitcnt lgkmcnt(0)" ::: "memory")
#define VM_WAIT() asm volatile("s_waitcnt vmcnt(0)" ::: "memory")
__device__ __forceinline__ unsigned long long rt() { return __builtin_amdgcn_s_memrealtime(); }
#define XB_TMO      128
#define XB_XCNT(j)  (256  + 64 * (j))
#define XB_XSUB(j)  (1280 + 64 * (j))
#define XB_XGEN(j)  (2304 + 64 * (j))
#define XB_TOP      3328
#define XB_TOPGEN   3392
#define XCD_BAR_WORDS 3456
#define XB_SPIN_CAP (1u << 18)

__device__ __forceinline__ unsigned xb_ld(unsigned* p)              { return __hip_atomic_load(p, __ATOMIC_RELAXED, __HIP_MEMORY_SCOPE_AGENT); }
__device__ __forceinline__ unsigned xb_add(unsigned* p, unsigned v) { return __hip_atomic_fetch_add(p, v, __ATOMIC_RELAXED, __HIP_MEMORY_SCOPE_AGENT); }
__device__ __forceinline__ unsigned xb_xcc_id() { return (unsigned)__builtin_amdgcn_s_getreg((3 << 11) | 20) & 0xFu; }
#define XB_SPIN(cond, bar) do { unsigned _sp = 0; while (cond) { __builtin_amdgcn_s_sleep(1); \
    if ((++_sp & 255u) == 0u) { if (xb_ld(&(bar)[XB_TMO])) break; if (_sp > XB_SPIN_CAP) { atomicAdd(&(bar)[XB_TMO], 1u); break; } } } } while (0)

struct XcdBarrier {
    unsigned* bar; unsigned x;
    volatile LAS unsigned* st;
};

__device__ __forceinline__ XcdBarrier xcd_barrier_post(unsigned* bar, volatile LAS unsigned* st) {
    XcdBarrier b; b.bar = bar; b.x = xb_xcc_id(); b.st = st;
    if (threadIdx.x == 0) (void)xb_add(&bar[XB_XCNT(b.x)], 1u);
    return b;
}
__device__ __forceinline__ void xcd_barrier_complete(unsigned* bar, unsigned x, unsigned& nloc, unsigned& nx) {
    const unsigned G = gridDim.x * gridDim.y * gridDim.z;
    unsigned sum, cnt, mine, sp = 0u;
    for (;;) {
        sum = 0u; cnt = 0u; mine = 0u;
#pragma unroll
        for (unsigned j = 0; j < 16; ++j) { const unsigned c = xb_ld(&bar[XB_XCNT(j)]); sum += c; cnt += (c > 0u) ? 1u : 0u; mine = (j == x) ? c : mine; }
        if (sum == G) break;
        __builtin_amdgcn_s_sleep(1);
        if ((++sp & 255u) == 0u) { if (xb_ld(&bar[XB_TMO])) break; if (sp > XB_SPIN_CAP) { atomicAdd(&bar[XB_TMO], 1u); break; } }
    }
    nloc = mine > 0u ? mine : 1u; nx = cnt > 0u ? cnt : 1u;
}

__device__ __forceinline__ void xcd_barrier(const XcdBarrier& b) {
    asm volatile("s_waitcnt vmcnt(0)" ::: "memory");
    __syncthreads();
    if (threadIdx.x == 0) {
        unsigned* bar = b.bar;
        __builtin_amdgcn_s_waitcnt(0);
        unsigned nloc = b.st[0], nx = b.st[1];
        if (nloc == 0u) { xcd_barrier_complete(bar, b.x, nloc, nx); b.st[0] = nloc; b.st[1] = nx; }
        const unsigned old = xb_add(&bar[XB_XSUB(b.x)], 1u);
        const unsigned gen = old / nloc;
        if (old + 1u == (gen + 1u) * nloc) {
            __builtin_amdgcn_fence(__ATOMIC_RELEASE, "agent");
            asm volatile("s_waitcnt vmcnt(0)" ::: "memory");
            const unsigned og = xb_add(&bar[XB_TOP], 1u);
            const unsigned tg = og / nx;
            if (og + 1u == (tg + 1u) * nx) xb_add(&bar[XB_TOPGEN], 1u);
            else XB_SPIN(xb_ld(&bar[XB_TOPGEN]) == tg, bar);
            __builtin_amdgcn_fence(__ATOMIC_ACQUIRE, "agent");
            xb_add(&bar[XB_XGEN(b.x)], 1u);
            asm volatile("s_waitcnt vmcnt(0)" ::: "memory");
        } else {
            XB_SPIN(xb_ld(&bar[XB_XGEN(b.x)]) == gen, bar);
            __builtin_amdgcn_fence(__ATOMIC_ACQUIRE, "agent");
            asm volatile("s_waitcnt vmcnt(0)" ::: "memory");
        }
    }
    __syncthreads();
}


constexpr int NB = 2, SEQ = 8192, DM = 1024, DEPTH = 4, NMETA = 16, LP = 8320, M = NB * LP;
constexpr int N_IN = 5384, N1 = 5376, NRW = 1792, NGT = 2048, DFF = 2816, NUP = 5632;
constexpr float LOG2E = 1.4426950408889634f;
constexpr float QSCALE = 0.125f * LOG2E;
constexpr float THR2 = 24.0f * LOG2E;
constexpr int NWAVES = 8, NTHR = 512, MMAIN = 16384;
constexpr int LDS_BYTES = 147456, MISC_OFF = 147456 - 128;

typedef unsigned short bf16;
typedef float f32x4 __attribute__((ext_vector_type(4)));
typedef unsigned u32x4 __attribute__((ext_vector_type(4)));
typedef unsigned u32x2 __attribute__((ext_vector_type(2)));
typedef short bf16x8 __attribute__((ext_vector_type(8)));

constexpr size_t SZ_H = (size_t)M * DM * 4, SZ_X512 = (size_t)M * 512 * 2;
constexpr size_t OFF_CTL = 0, OFF_H = 1u << 20, OFF_WT = OFF_H + SZ_H;
constexpr size_t WT_IN = 0, WT_BF = WT_IN + (size_t)N1 * 1024, WT_BR = WT_BF + 1024 * 512, WT_O = WT_BR + 1024 * 512,
                 WT_UP = WT_O + 1024 * 1024, WT_DN = WT_UP + (size_t)NUP * 1024, WT_LW = WT_DN + (size_t)1024 * DFF, WT_LA = WT_LW + 512 * 64, WT_LG = WT_LA + 512 * 64, WT_END = WT_LG + 512 * 128;
constexpr size_t OFF_HN = OFF_WT + WT_END * 2;
constexpr size_t OFF_Q = OFF_HN + 2 * SZ_X512, OFF_K = OFF_Q + SZ_X512, OFF_V = OFF_K + SZ_X512;
constexpr size_t OFF_RW = OFF_V + SZ_X512, OFF_GT = OFF_RW + (size_t)M * NRW * 2, OFF_MISC = OFF_GT + (size_t)M * NGT * 2;
constexpr size_t OFF_T0 = OFF_MISC + 2 * 16 * LP * 4, OFF_OF = OFF_T0 + 2 * SZ_X512, OFF_TAIL = OFF_OF + SZ_X512, WS_NEED = OFF_TAIL + 256 * 1024 * 2;
static_assert(OFF_HN % 256 == 0 && OFF_RW % 256 == 0 && OFF_T0 % 256 == 0, "alignment");

struct Params { const float* in[26]; float* out; unsigned char* ws; };
struct Ctx { int tid, lane, wave, bid, G; unsigned char* lds; unsigned char* ws; };

__device__ __forceinline__ float bf2f(unsigned b) { return __uint_as_float(b << 16); }
__device__ __forceinline__ float bflo(unsigned w) { return __uint_as_float(w << 16); }
__device__ __forceinline__ float bfhi(unsigned w) { return __uint_as_float(w & 0xffff0000u); }
typedef float f32x2_t_ __attribute__((ext_vector_type(2))); typedef __bf16 bf16x2_t_ __attribute__((ext_vector_type(2)));
__device__ __forceinline__ unsigned pk2(float lo, float hi) { const f32x2_t_ v = {lo, hi}; const bf16x2_t_ r = __builtin_convertvector(v, bf16x2_t_); return __builtin_bit_cast(unsigned, r); }
__device__ __forceinline__ unsigned f2bf(float f) { return pk2(f, 0.f) & 0xffffu; }
__device__ __forceinline__ float wave_sum(float v) {
#pragma unroll
    for (int o = 1; o < 64; o <<= 1) v += __shfl_xor(v, o);
    return v;
}
__device__ __forceinline__ float sigmoidf_(float x) { return __builtin_amdgcn_rcpf(1.f + __expf(-x)); }
template <int CTRL> __device__ __forceinline__ float dppf(float old, float x) {
    return __int_as_float(__builtin_amdgcn_update_dpp(__float_as_int(old), __float_as_int(x), CTRL, 0xf, 0xf, false));
}
__device__ __forceinline__ float allreduce16(float x) {
    x += dppf<0x121>(0.f, x); x += dppf<0x122>(0.f, x); x += dppf<0x124>(0.f, x); x += dppf<0x128>(0.f, x); return x;
}

namespace pg8 {
struct EpiRoute {
    static constexpr bool PERM = true, AFTER_DRAIN = false;
    unsigned char* ws;
    __device__ __forceinline__ void operator()(const f32x4 (&acc)[2][2][4][2], const Unit& u, int wr, int wc, int fr, int fq) const {
        const int pn = u.pn; size_t off; int ldc, colt;
        if (pn < 6) { off = OFF_Q + (size_t)(pn >> 1) * SZ_X512; ldc = 512; colt = (pn & 1) * 256; }
        else if (pn < 13) { off = OFF_RW; ldc = NRW; colt = (pn - 6) * 256; }
        else { off = OFF_GT; ldc = NGT; colt = (pn - 13) * 256; }
        bf16_t* base = (bf16_t*)(ws + off);
        const int row0 = u.pm * BM + wr * 64 + fr, col0 = colt + wc * 32 + 8 * fq;
#pragma unroll
        for (int ai = 0; ai < 2; ++ai)
#pragma unroll
            for (int m = 0; m < 4; ++m) { bf16_t* rowp = base + (size_t)(row0 + ai * HALF + m * 16) * ldc + col0;
#pragma unroll
                for (int bj = 0; bj < 2; ++bj) { const f32x4 v0 = acc[ai][bj][m][0], v1 = acc[ai][bj][m][1];
                    u32x4 w; w.x = cvt_pk_bf16(v0[0], v0[1]); w.y = cvt_pk_bf16(v0[2], v0[3]); w.z = cvt_pk_bf16(v1[0], v1[1]); w.w = cvt_pk_bf16(v1[2], v1[3]);
                    *(u32x4*)(rowp + bj * HALF) = w; } }
    }
};
struct EpiGateR {
    static constexpr bool PERM = true, AFTER_DRAIN = false;
    bf16_t* O; const bf16_t* GT; const float* gb; int goff, accum;
    __device__ __forceinline__ void operator()(const f32x4 (&acc)[2][2][4][2], const Unit& u, int wr, int wc, int fr, int fq) const {
        const int row0 = u.pm * BM + wr * 64 + fr, col0 = u.pn * BM + wc * 32 + 8 * fq;
#pragma unroll
        for (int bj = 0; bj < 2; ++bj) {
            const int c = col0 + bj * HALF;
            const f32x4 b0 = *(const f32x4*)(gb + goff + c), b1 = *(const f32x4*)(gb + goff + c + 4);
#pragma unroll
            for (int ai = 0; ai < 2; ++ai)
#pragma unroll
                for (int m = 0; m < 4; ++m) {
                    const size_t row = (size_t)(row0 + ai * HALF + m * 16);
                    const u32x4 gw = *(const u32x4*)(GT + row * NGT + goff + c);
                    const f32x4 v0 = acc[ai][bj][m][0], v1 = acc[ai][bj][m][1];
                    float r[8];
                    r[0] = sigmoidf_(bflo(gw.x) + b0[0]) * v0[0]; r[1] = sigmoidf_(bfhi(gw.x) + b0[1]) * v0[1];
                    r[2] = sigmoidf_(bflo(gw.y) + b0[2]) * v0[2]; r[3] = sigmoidf_(bfhi(gw.y) + b0[3]) * v0[3];
                    r[4] = sigmoidf_(bflo(gw.z) + b1[0]) * v1[0]; r[5] = sigmoidf_(bfhi(gw.z) + b1[1]) * v1[1];
                    r[6] = sigmoidf_(bflo(gw.w) + b1[2]) * v1[2]; r[7] = sigmoidf_(bfhi(gw.w) + b1[3]) * v1[3];
                    bf16_t* op = O + row * 1024 + c;
                    if (accum) { const u32x4 ow = *(const u32x4*)op;
                        r[0] += bflo(ow.x); r[1] += bfhi(ow.x); r[2] += bflo(ow.y); r[3] += bfhi(ow.y); r[4] += bflo(ow.z); r[5] += bfhi(ow.z); r[6] += bflo(ow.w); r[7] += bfhi(ow.w); }
                    u32x4 w; w.x = cvt_pk_bf16(r[0], r[1]); w.y = cvt_pk_bf16(r[2], r[3]); w.z = cvt_pk_bf16(r[4], r[5]); w.w = cvt_pk_bf16(r[6], r[7]);
                    *(u32x4*)op = w;
                }
        }
    }
};
struct EpiResid {
    static constexpr bool PERM = false, AFTER_DRAIN = false;
    float* H; float* OUT; int atomic;
    __device__ __forceinline__ void operator()(const f32x4 (&acc)[2][2][4][2], const Unit& u, int wr, int wc, int fr, int fq) const {
        const int row0 = u.pm * BM + wr * 64 + fr, col0 = u.pn * BM + wc * 32 + 4 * fq;
#pragma unroll
        for (int ai = 0; ai < 2; ++ai)
#pragma unroll
            for (int m = 0; m < 4; ++m) {
                const int row = row0 + ai * HALF + m * 16;
                float* hp = H + (size_t)row * DM + col0;
                const int b = row >= LP ? 1 : 0, t = row - b * LP;
                float* op = (OUT && t >= NMETA && t < NMETA + SEQ) ? OUT + ((size_t)b * SEQ + (t - NMETA)) * DM + col0 : nullptr;
#pragma unroll
                for (int bj = 0; bj < 2; ++bj)
#pragma unroll
                    for (int n = 0; n < 2; ++n) { const int co = bj * HALF + n * 16;
                        if (atomic) {
                            if (row < LP + NMETA + SEQ) {
#pragma unroll
                                for (int e = 0; e < 4; ++e) unsafeAtomicAdd(hp + co + e, acc[ai][bj][m][n][e]); }
                        } else {
                            const f32x4 v = *(const f32x4*)(hp + co) + acc[ai][bj][m][n];
                            if (OUT) { if (op) *(f32x4*)(op + co) = v; } else *(f32x4*)(hp + co) = v; } }
            }
    }
};
struct EpiResidAtomic {
    static constexpr bool PERM = false, AFTER_DRAIN = false;
    float* H;
    __device__ __forceinline__ void operator()(const f32x4 (&acc)[2][2][4][2], const Unit& u, int wr, int wc, int fr, int fq) const {
        const int row0 = u.pm * BM + wr * 64 + fr, col0 = u.pn * BM + wc * 32 + 4 * fq;
#pragma unroll
        for (int ai = 0; ai < 2; ++ai)
#pragma unroll
            for (int m = 0; m < 4; ++m) { float* hp = H + (size_t)(row0 + ai * HALF + m * 16) * DM + col0;
#pragma unroll
                for (int bj = 0; bj < 2; ++bj)
#pragma unroll
                    for (int n = 0; n < 2; ++n)
#pragma unroll
                        for (int e = 0; e < 4; ++e) unsafeAtomicAdd(hp + bj * HALF + n * 16 + e, acc[ai][bj][m][n][e]); }
    }
};
struct OneUnit {
    StaticOrder so; int mode, pm, pn; bool active;
    __device__ bool next(int i, Unit& u) const { if (mode == 0) return so.next(i, u); if (i != 0 || !active) return false; u.pm = pm; u.pn = pn; return true; }
    __device__ __forceinline__ void a_ready(const Unit&) const {}
    __device__ __forceinline__ void done(const Unit&) const {}
};
struct EpiUp {
    static constexpr bool PERM = true, AFTER_DRAIN = false;
    bf16_t* ACT; bf16_t* HALO; const float* cw;
    __device__ __forceinline__ void operator()(const f32x4 (&acc)[2][2][4][2], const Unit& u, int wr, int wc, int fr, int fq) const {
        const int chan0 = u.pn * 128 + wc * 32 + 8 * fq;
#pragma unroll
        for (int n = 0; n < 2; ++n) {
            const int ch = chan0 + 4 * n;
            f32x4 w[3][2];
#pragma unroll
            for (int j = 0; j < 3; ++j) { w[j][0] = *(const f32x4*)(cw + j * NUP + ch); w[j][1] = *(const f32x4*)(cw + j * NUP + DFF + ch); }
#pragma unroll
            for (int ai = 0; ai < 2; ++ai) {
                const int rowg = u.pm * BM + ai * HALF + wr * 64;
#pragma unroll
                for (int m = 0; m < 4; ++m) {
                    f32x4 uc[2];
#pragma unroll
                    for (int bj = 0; bj < 2; ++bj) {
                        const f32x4 cur = acc[ai][bj][m][n];
                        f32x4 prv; if (m > 0) prv = acc[ai][bj][m - 1][n]; else prv = (f32x4){0.f, 0.f, 0.f, 0.f};
                        f32x4 p1, p2;
#pragma unroll
                        for (int i = 0; i < 4; ++i) {
                            const float r1 = dppf<0x121>(0.f, prv[i]), r2 = dppf<0x122>(0.f, prv[i]);
                            p1[i] = dppf<0x111>(r1, cur[i]); p2[i] = dppf<0x112>(r2, cur[i]);
                        }
                        uc[bj] = w[0][bj] * p2 + w[1][bj] * p1 + w[2][bj] * cur;
                    }
                    float a[4];
#pragma unroll
                    for (int i = 0; i < 4; ++i) a[i] = uc[0][i] * sigmoidf_(uc[0][i]) * uc[1][i];
                    u32x2 o; o.x = cvt_pk_bf16(a[0], a[1]); o.y = cvt_pk_bf16(a[2], a[3]);
                    *(u32x2*)(ACT + (size_t)(rowg + m * 16 + fr) * DFF + ch) = o;
                    if ((m == 3 && fr >= 14) || (m == 0 && fr < 2)) {
                        const int slot = (rowg >> 6) * 4 + (m == 3 ? fr - 14 : 2 + fr);
#pragma unroll
                        for (int bj = 0; bj < 2; ++bj) { const f32x4 cur = acc[ai][bj][m][n]; u32x2 hw; hw.x = cvt_pk_bf16(cur[0], cur[1]); hw.y = cvt_pk_bf16(cur[2], cur[3]);
                            *(u32x2*)(HALO + (size_t)slot * NUP + bj * DFF + ch) = hw; }
                    }
                }
            }
        }
    }
};
}

#ifndef REP_PREP
#define REP_PREP 1
#endif
#ifndef REP_P3
#define REP_P3 1
#endif
#ifndef REP_SYNC
#define REP_SYNC 0
#endif
#define GLD(T, p) (*(const __attribute__((address_space(1))) T*)(p))
#define GST(T, p) (*(__attribute__((address_space(1))) T*)(p))
#define LDS_BARRIER() do { asm volatile("s_waitcnt lgkmcnt(0)" ::: "memory"); __builtin_amdgcn_s_barrier(); asm volatile("" ::: "memory"); } while (0)
__device__ __forceinline__ void transpose_item(const float* W, int Nsrc, int K, bf16* WT, int dst_row0, int src_col0, int k0, float* scr, int lane) {
#pragma unroll 8
    for (int i = 0; i < 32; ++i) { const int kk = 2 * i + (lane >> 5); scr[kk * 33 + (lane & 31)] = W[(size_t)(k0 + kk) * Nsrc + src_col0 + (lane & 31)]; }
    asm volatile("s_waitcnt lgkmcnt(0)" ::: "memory");
    const int c = lane & 7;
#pragma unroll
    for (int j = 0; j < 4; ++j) { const int n = (lane >> 3) + 8 * j; const float* s = scr + (8 * c) * 33 + n;
        u32x4 o; o.x = pk2(s[0 * 33], s[1 * 33]); o.y = pk2(s[2 * 33], s[3 * 33]); o.z = pk2(s[4 * 33], s[5 * 33]); o.w = pk2(s[6 * 33], s[7 * 33]);
        *(u32x4*)(WT + (size_t)(dst_row0 + n) * K + k0 + 8 * c) = o; }
    asm volatile("s_waitcnt lgkmcnt(0)" ::: "memory");
}
__device__ __forceinline__ void convert_weights(const Params& P, int l, const Ctx& c) {
    bf16* WT = (bf16*)(c.ws + OFF_WT);
    float* scr = (float*)(c.lds + c.wave * 16384);
    const int gw = c.bid * NWAVES + c.wave, NGW = c.G * NWAVES;
    constexpr int I_IN = 16 * 168, I_BF = 8 * 32, I_O = 16 * 32, I_UP = 16 * 176, I_DN = 44 * 32, I_LR = 16, I_LG = 32, I_ALL = I_IN + 2 * I_BF + I_O + I_UP + I_DN + 2 * I_LR + I_LG;
    for (int it = gw; it < I_ALL; it += NGW) {
        int r = it;
        if (r < I_IN) { const int kb = r / 168, n0 = 32 * (r % 168); transpose_item(P.in[4] + (size_t)l * 1024 * N_IN, N_IN, 1024, WT + WT_IN, n0, n0 + (n0 >= 1536 ? 8 : 0), 64 * kb, scr, c.lane); continue; } r -= I_IN;
        if (r < I_BF) { const int kb = r / 32, n0 = 32 * (r % 32); transpose_item(P.in[19] + (size_t)l * 512 * 1024, 1024, 512, WT + WT_BF, n0, n0, 64 * kb, scr, c.lane); continue; } r -= I_BF;
        if (r < I_BF) { const int kb = r / 32, n0 = 32 * (r % 32); transpose_item(P.in[20] + (size_t)l * 512 * 1024, 1024, 512, WT + WT_BR, n0, n0, 64 * kb, scr, c.lane); continue; } r -= I_BF;
        if (r < I_O) { const int kb = r / 32, n0 = 32 * (r % 32); transpose_item(P.in[22] + (size_t)l * 1024 * 1024, 1024, 1024, WT + WT_O, n0, n0, 64 * kb, scr, c.lane); continue; } r -= I_O;
        if (r < I_UP) { const int kb = r / 176, n0 = 32 * (r % 176); const int pn = n0 >> 8, bj = (n0 >> 7) & 1, x = n0 & 127;
            transpose_item(P.in[23] + (size_t)l * 1024 * NUP, NUP, 1024, WT + WT_UP, n0, bj * DFF + 128 * pn + x, 64 * kb, scr, c.lane); continue; } r -= I_UP;
        if (r < I_DN) { const int kb = r / 32, n0 = 32 * (r % 32); transpose_item(P.in[25] + (size_t)l * DFF * 1024, 1024, DFF, WT + WT_DN, n0, n0, 64 * kb, scr, c.lane); continue; } r -= I_DN;
        if (r < I_LR) { transpose_item(P.in[10] + (size_t)l * 64 * 512, 512, 64, WT + WT_LW, 32 * r, 32 * r, 0, scr, c.lane); continue; } r -= I_LR;
        if (r < I_LR) { transpose_item(P.in[12] + (size_t)l * 64 * 512, 512, 64, WT + WT_LA, 32 * r, 32 * r, 0, scr, c.lane); continue; } r -= I_LR;
        { const int kb = r / 16, n0 = 32 * (r % 16); transpose_item(P.in[13] + (size_t)l * 128 * 512, 512, 128, WT + WT_LG, n0, n0, 64 * kb, scr, c.lane); }
    }
}

template <bool FG> __device__ __forceinline__ void phase_norm(const Params& P, int l, const Ctx& c) {
    float* H = (float*)(c.ws + OFF_H); bf16* HN = (bf16*)(c.ws + OFF_HN);
    float* LOGF = (float*)(c.ws + OFF_MISC);
    const float* gain = (FG ? P.in[2] : P.in[3]) + l * DM;
    float* wfs = (float*)c.lds;
    if (FG) {
        __syncthreads();
        const float* win = P.in[4] + (size_t)l * 1024 * N_IN + 1536;
        for (int i = c.tid; i < 8192; i += NTHR) wfs[i] = win[(size_t)(i >> 3) * N_IN + (i & 7)];
        __syncthreads();
    }
    const int gw = c.bid * NWAVES + c.wave, NGW = c.G * NWAVES;
#define NORM_LOAD(mm, dst) do { const int b_ = (mm) >= LP ? 1 : 0, t_ = (mm) - b_ * LP; \
        if (FG && l == 0) { const float* src_ = (t_ < NMETA) ? P.in[1] + (size_t)t_ * DM : P.in[0] + ((size_t)b_ * SEQ + (t_ - NMETA)) * DM; const bool real_ = t_ < NMETA + SEQ; \
            _Pragma("unroll") for (int j_ = 0; j_ < 4; ++j_) dst[j_] = real_ ? *(const f32x4*)(src_ + 4 * c.lane + 256 * j_) : (f32x4){0.f, 0.f, 0.f, 0.f}; } \
        else { _Pragma("unroll") for (int j_ = 0; j_ < 4; ++j_) dst[j_] = *(const f32x4*)(H + (size_t)(mm) * DM + 4 * c.lane + 256 * j_); } } while (0)
    f32x4 nv[4];
    if (gw < M) NORM_LOAD(gw, nv);
    for (int m = gw; m < M; m += NGW) {
        const int b = m >= LP ? 1 : 0, t = m - b * LP;
        f32x4 v[4];
#pragma unroll
        for (int j = 0; j < 4; ++j) v[j] = nv[j];
        if (m + NGW < M) NORM_LOAD(m + NGW, nv);
        if (FG && l == 0) {
#pragma unroll
            for (int j = 0; j < 4; ++j) *(f32x4*)(H + (size_t)m * DM + 4 * c.lane + 256 * j) = v[j];
        }
        float ss = 0.f;
#pragma unroll
        for (int j = 0; j < 4; ++j) ss += (v[j].x * v[j].x + v[j].y * v[j].y) + (v[j].z * v[j].z + v[j].w * v[j].w);
        const float rstd = 1.0f / sqrtf(wave_sum(ss) * (1.f / DM) + 1e-6f);
        float f[8];
#pragma unroll
        for (int q = 0; q < 8; ++q) f[q] = 0.f;
#pragma unroll
        for (int j = 0; j < 4; ++j) {
            const f32x4 g = *(const f32x4*)(gain + 4 * c.lane + 256 * j);
            v[j] = v[j] * rstd * g;
            u32x2 o; o.x = pk2(v[j].x, v[j].y); o.y = pk2(v[j].z, v[j].w);
            *(u32x2*)(HN + (size_t)m * DM + 4 * c.lane + 256 * j) = o;
            if (FG) {
#pragma unroll
                for (int e = 0; e < 4; ++e) { const int k = 4 * c.lane + 256 * j + e; const f32x4 w0 = *(const f32x4*)(wfs + k * 8), w1 = *(const f32x4*)(wfs + k * 8 + 4);
                    const float hv = v[j][e];
                    f[0] += hv * w0.x; f[1] += hv * w0.y; f[2] += hv * w0.z; f[3] += hv * w0.w; f[4] += hv * w1.x; f[5] += hv * w1.y; f[6] += hv * w1.z; f[7] += hv * w1.w; }
            }
        }
        if (FG) {
#pragma unroll
            for (int q = 0; q < 8; ++q) f[q] = wave_sum(f[q]);
            float fv = f[0];
#pragma unroll
            for (int q = 1; q < 8; ++q) fv = (c.lane == q) ? f[q] : fv;
            if (c.lane < 8) { const float x = fv + P.in[7][l * 8 + c.lane]; const float ls = fminf(x, 0.f) - __logf(1.f + __expf(-fabsf(x))); LOGF[(size_t)(b * 8 + c.lane) * LP + t] = ls; }
        }
    }
}

__device__ __forceinline__ void phase_fcum(const Params& P, const Ctx& c) {
    const int s = c.bid - (c.G - 16);
    if (s < 0) return;
    const float* LOGF = (const float*)(c.ws + OFF_MISC) + (size_t)s * LP; float* FC = (float*)(c.ws + OFF_MISC) + 16 * LP + (size_t)s * LP;
    float* wt = (float*)c.lds;
    const int base = c.tid * 17;
    float v[17]; float run = 0.f;
#pragma unroll
    for (int i = 0; i < 17; ++i) { const int idx = base + i; const float x = (idx < LP) ? LOGF[idx] : 0.f; run += x; v[i] = run; }
    float incl = run;
#pragma unroll
    for (int o = 1; o < 64; o <<= 1) { const float t = __shfl_up(incl, o); if (c.lane >= o) incl += t; }
    if (c.lane == 63) wt[c.wave] = incl;
    __syncthreads();
    float off = incl - run;
#pragma unroll
    for (int w2 = 0; w2 < 8; ++w2) off += (w2 < c.wave) ? wt[w2] : 0.f;
#pragma unroll
    for (int i = 0; i < 17; ++i) { const int idx = base + i; if (idx < LP) FC[idx] = (v[i] + off) * LOG2E; }
    __syncthreads();
}

__device__ __forceinline__ void phase_qknorm(const Params& P, int l, const Ctx& c) {
    bf16* Q = (bf16*)(c.ws + OFF_Q); bf16* K = (bf16*)(c.ws + OFF_K);
    const int gw = c.bid * NWAVES + c.wave, NGW = c.G * NWAVES;
    const int d0 = (c.lane & 7) * 8;
    float gq[8], gk[8];
#pragma unroll
    for (int i = 0; i < 8; ++i) { gq[i] = P.in[5][l * 64 + d0 + i] * QSCALE; gk[i] = P.in[6][l * 64 + d0 + i]; }
    for (int m = gw; m < M; m += NGW) {
#pragma unroll
        for (int which = 0; which < 2; ++which) {
            bf16* p = (which ? K : Q) + (size_t)m * 512 + 8 * c.lane;
            const u32x4 w = *(const u32x4*)p;
            float x[8] = {bflo(w.x), bfhi(w.x), bflo(w.y), bfhi(w.y), bflo(w.z), bfhi(w.z), bflo(w.w), bfhi(w.w)};
            float ss = 0.f;
#pragma unroll
            for (int i = 0; i < 8; ++i) ss += x[i] * x[i];
            ss += __shfl_xor(ss, 1); ss += __shfl_xor(ss, 2); ss += __shfl_xor(ss, 4);
            const float rs = 1.0f / sqrtf(ss * (1.f / 64.f) + 1e-6f);
#pragma unroll
            for (int i = 0; i < 8; ++i) x[i] = x[i] * rs * (which ? gk[i] : gq[i]);
            u32x4 o; o.x = pk2(x[0], x[1]); o.y = pk2(x[2], x[3]); o.z = pk2(x[4], x[5]); o.w = pk2(x[6], x[7]);
            *(u32x4*)p = o;
        }
    }
}

constexpr int NCHK = LP / 64;
constexpr int NUNIT = NB * NCHK * 8;
constexpr int UNIT_A = 16384, UNIT_B = 16640;
constexpr int ST = 72, STG = 136;
constexpr int L_F0 = 92160, L_F1 = 108544;
struct RwkvBufs { bf16 *BON, *G; unsigned char *UA, *UB; float* Y; bf16* ORW; };
__device__ __forceinline__ RwkvBufs rwkv_bufs(const Params& P, const Ctx& c) {
    RwkvBufs r; r.BON = (bf16*)(c.ws + OFF_HN); r.G = r.BON + (size_t)M * 512;
    r.UA = c.ws + OFF_T0; r.UB = (unsigned char*)P.out;
    r.Y = (float*)(c.ws + OFF_RW); r.ORW = (bf16*)(c.ws + OFF_RW + (size_t)M * 512 * 4);
    return r;
}
__device__ __forceinline__ void mm_tile(const bf16* A, int sa, const bf16* Bt, int sb, int nks, f32x4 (&acc)[2], int w, int lq, int g) {
    const int mt = w >> 1, nt0 = 2 * (w & 1);
    for (int ks = 0; ks < nks; ++ks) {
        const bf16x8 a = *(const bf16x8*)(A + (16 * mt + lq) * sa + 32 * ks + 8 * g);
#pragma unroll
        for (int q = 0; q < 2; ++q) { const bf16x8 b = *(const bf16x8*)(Bt + (16 * (nt0 + q) + lq) * sb + 32 * ks + 8 * g); acc[q] = __builtin_amdgcn_mfma_f32_16x16x32_bf16(a, b, acc[q], 0, 0, 0); }
    }
}
template <bool SA, bool SB> __device__ __forceinline__ void mm_tile2(const bf16* A, int sa, const bf16* Bt, int sb, int nks, f32x4 (&acc)[2], int w, int lq, int g) {
    const int mt = w >> 1, nt0 = 2 * (w & 1);
    const int ra = 16 * mt + lq, xa = SA ? 8 * ((ra >> 3) & 7) : 0;
    for (int ks = 0; ks < nks; ++ks) {
        const bf16x8 a = *(const bf16x8*)(A + ra * sa + ((32 * ks + 8 * g) ^ xa));
#pragma unroll
        for (int q = 0; q < 2; ++q) { const int rb = 16 * (nt0 + q) + lq, xb = SB ? 8 * ((rb >> 3) & 7) : 0;
            const bf16x8 bb = *(const bf16x8*)(Bt + rb * sb + ((32 * ks + 8 * g) ^ xb)); acc[q] = __builtin_amdgcn_mfma_f32_16x16x32_bf16(a, bb, acc[q], 0, 0, 0); }
    }
}
#define ZACC(a) do { a[0] = (f32x4){0.f, 0.f, 0.f, 0.f}; a[1] = (f32x4){0.f, 0.f, 0.f, 0.f}; } while (0)
__device__ __forceinline__ int permk(int k) { return 32 * (k >> 5) + 8 * ((k & 15) >> 2) + 4 * ((k >> 4) & 1) + (k & 3); }
__device__ __forceinline__ int swz(int row, int col) { return row * 128 + ((((col >> 3) ^ (row >> 1)) & 7) << 4) + (col & 7) * 2; }

__device__ __forceinline__ void rwkv_prep_unit(const Params& P, int l, const Ctx& c, int u, const RwkvBufs& B, const float (&pw0)[8], const float (&pa0)[8], const float (&pkk)[8], const float (&pka)[8], const float (&prk)[8], const u32x4 (&wlr)[4], u32x4 (&rc)[7], u32x4 (&rp)[7]) {
    const int h = u & 7, bc = u >> 3, b = bc / NCHK, ch = bc - b * NCHK;
    const size_t m0 = (size_t)b * LP + ch * 64;
    int tid_ = c.tid; asm volatile("" : "+v"(tid_));
    const int tid = tid_, lane = tid & 63, w = c.wave, lq = lane & 15, g = lane >> 4;
    const int t = tid >> 3, cg = tid & 7, c0 = cg * 8, jb = h * 64 + c0;
    unsigned char* L = c.lds;
    bf16* A0 = (bf16*)L; bf16* A1 = A0 + 4608; bf16* A2 = A1 + 4608; bf16* A3 = A2 + 4608; bf16* A4 = A3 + 4608; bf16* A5 = A4 + 4608; bf16* A6 = A5 + 4608;
    bf16* A7 = A6 + 4608; bf16* A8 = A7 + 4608; bf16* A9 = A8 + 4608;
    float* F0 = (float*)(L + L_F0); float* F1 = (float*)(L + L_F1);
    const bf16* RW = (const bf16*)(c.ws + OFF_RW);
    const bf16* WT = (const bf16*)(c.ws + OFF_WT);
    const float* mu = P.in[8] + l * NRW;
    const bool first = (ch == 0 && t == 0);
    const bf16* cur = RW + (m0 + t) * NRW; const bf16* prv = cur - NRW;
    float zr[8], zk[8], zv[8];
#pragma unroll
    for (int s = 0; s < 3; ++s) {
        const u32x4 cw = rc[s]; u32x4 pw = (u32x4){0u, 0u, 0u, 0u}; if (!first) pw = rp[s];
        const float cv[8] = {bflo(cw.x), bfhi(cw.x), bflo(cw.y), bfhi(cw.y), bflo(cw.z), bfhi(cw.z), bflo(cw.w), bfhi(cw.w)};
        const float pv[8] = {bflo(pw.x), bfhi(pw.x), bflo(pw.y), bfhi(pw.y), bflo(pw.z), bfhi(pw.z), bflo(pw.w), bfhi(pw.w)};
#pragma unroll
        for (int i = 0; i < 8; ++i) { const float z = cv[i] + mu[s * 512 + jb + i] * (pv[i] - cv[i]); if (s == 0) zr[i] = z; else if (s == 1) zk[i] = z; else zv[i] = z; }
    }
#pragma unroll
    for (int q4 = 0; q4 < 4; ++q4) {
        const int col = cg * 32 + q4 * 8;
        const u32x4 cw = rc[3 + q4]; u32x4 pw = (u32x4){0u, 0u, 0u, 0u}; if (!first) pw = rp[3 + q4];
        const float cv[8] = {bflo(cw.x), bfhi(cw.x), bflo(cw.y), bfhi(cw.y), bflo(cw.z), bfhi(cw.z), bflo(cw.w), bfhi(cw.w)};
        const float pv[8] = {bflo(pw.x), bfhi(pw.x), bflo(pw.y), bfhi(pw.y), bflo(pw.z), bfhi(pw.z), bflo(pw.w), bfhi(pw.w)};
        float z[8];
#pragma unroll
        for (int i = 0; i < 8; ++i) { z[i] = cv[i] + mu[1536 + col + i] * (pv[i] - cv[i]); if (col < 64) z[i] = 1.f - 2.f / (1.f + __expf(2.f * z[i])); else if (col >= 128) z[i] = sigmoidf_(z[i]); }
        u32x4 o; o.x = pk2(z[0], z[1]); o.y = pk2(z[2], z[3]); o.z = pk2(z[4], z[5]); o.w = pk2(z[6], z[7]);
        bf16* dst = (col < 64) ? A0 + t * ST + col : (col < 128 ? A1 + t * ST + (col - 64) : A2 + t * STG + (col - 128));
        *(u32x4*)dst = o;
    }
    { const int un = u + c.G;
      if (un < NUNIT) { const int hn = un & 7, bcn = un >> 3, bn = bcn / NCHK, chn = bcn - bn * NCHK;
          const bf16* cn = RW + ((size_t)bn * LP + chn * 64 + t) * NRW; const bf16* pn = cn - NRW;
#pragma unroll
          for (int s = 0; s < 3; ++s) { rc[s] = GLD(u32x4, cn + s * 512 + hn * 64 + c0); rp[s] = GLD(u32x4, pn + s * 512 + hn * 64 + c0); }
#pragma unroll
          for (int q4 = 0; q4 < 4; ++q4) { rc[3 + q4] = GLD(u32x4, cn + 1536 + cg * 32 + q4 * 8); rp[3 + q4] = GLD(u32x4, pn + 1536 + cg * 32 + q4 * 8); } } }
    { const int row = tid >> 3, chk = tid & 7;
      *(u32x4*)(A4 + row * ST + chk * 8) = wlr[0];
      *(u32x4*)(A5 + row * ST + chk * 8) = wlr[1];
#pragma unroll
      for (int i = 0; i < 2; ++i) { const int idx = tid + 512 * i, r2 = idx >> 4, c2 = idx & 15;
          *(u32x4*)((bf16*)F1 + r2 * STG + c2 * 8) = wlr[2 + i]; } }
    LDS_BARRIER();
    { f32x4 aw[2], aa[2], ag[2]; ZACC(aw); ZACC(aa); ZACC(ag);
      mm_tile(A4, ST, A0, ST, 2, aw, w, lq, g); mm_tile(A5, ST, A1, ST, 2, aa, w, lq, g); mm_tile((const bf16*)F1, STG, A2, STG, 4, ag, w, lq, g);
      const int mt = w >> 1, nt0 = 2 * (w & 1);
#pragma unroll
      for (int q = 0; q < 2; ++q) { const int o = (16 * (nt0 + q) + lq) * ST + 16 * mt + 4 * g; u32x2 p;
          p.x = pk2(aw[q][0], aw[q][1]); p.y = pk2(aw[q][2], aw[q][3]); *(u32x2*)(A7 + o) = p;
          p.x = pk2(aa[q][0], aa[q][1]); p.y = pk2(aa[q][2], aa[q][3]); *(u32x2*)(A8 + o) = p;
          p.x = pk2(ag[q][0], ag[q][1]); p.y = pk2(ag[q][2], ag[q][3]); *(u32x2*)(A9 + o) = p; } }
    LDS_BARRIER();
    float kk[8], k2[8], ar[8];
    { const u32x4 lw = *(const u32x4*)(A7 + t * ST + c0), la = *(const u32x4*)(A8 + t * ST + c0), lg = *(const u32x4*)(A9 + t * ST + c0);
      const float fw[8] = {bflo(lw.x), bfhi(lw.x), bflo(lw.y), bfhi(lw.y), bflo(lw.z), bfhi(lw.z), bflo(lw.w), bfhi(lw.w)};
      const float fa[8] = {bflo(la.x), bfhi(la.x), bflo(la.y), bfhi(la.y), bflo(la.z), bfhi(la.z), bflo(la.w), bfhi(la.w)};
      float ss = 0.f, bs = 0.f;
#pragma unroll
      for (int i = 0; i < 8; ++i) {
          const float xw = -(pw0[i] + fw[i]); const float sp = fmaxf(xw, 0.f) + __logf(1.f + __expf(-fabsf(xw)));
          F0[t * 64 + c0 + i] = __expf(-sp - 0.5f);
          ar[i] = sigmoidf_(pa0[i] + fa[i]);
          kk[i] = zk[i] * pkk[i]; ss += kk[i] * kk[i];
          k2[i] = zk[i] * (1.f + (ar[i] - 1.f) * pka[i]);
          bs += zr[i] * k2[i] * prk[i]; }
      ss += __shfl_xor(ss, 1); ss += __shfl_xor(ss, 2); ss += __shfl_xor(ss, 4);
      bs += __shfl_xor(bs, 1); bs += __shfl_xor(bs, 2); bs += __shfl_xor(bs, 4);
      const float inv = 1.0f / fmaxf(sqrtf(ss), 1e-12f);
#pragma unroll
      for (int i = 0; i < 8; ++i) kk[i] *= inv;
      u32x4 bo; bo.x = pk2(bs * zv[0], bs * zv[1]); bo.y = pk2(bs * zv[2], bs * zv[3]); bo.z = pk2(bs * zv[4], bs * zv[5]); bo.w = pk2(bs * zv[6], bs * zv[7]);
      *(u32x4*)(B.BON + (m0 + t) * 512 + jb) = bo; *(u32x4*)(B.G + (m0 + t) * 512 + jb) = lg; }
    LDS_BARRIER();
    {
      const int k = tid & 63, sg = tid >> 6; float e[8], run = 0.f;
#pragma unroll
      for (int s = 0; s < 8; ++s) { run += F0[(8 * sg + s) * 64 + k]; e[s] = run; }
      F1[sg * 64 + k] = run;
      LDS_BARRIER();
      float off = 0.f;
#pragma unroll
      for (int s = 0; s < 8; ++s) off += (s < sg) ? F1[s * 64 + k] : 0.f;
#pragma unroll
      for (int s = 0; s < 8; ++s) F0[(8 * sg + s) * 64 + k] = e[s] + off; }
    LDS_BARRIER();
    { float ct[8], cp[8], cC[8];
#pragma unroll
      for (int i = 0; i < 8; ++i) { ct[i] = F0[t * 64 + c0 + i]; cp[i] = (t > 0) ? F0[(t - 1) * 64 + c0 + i] : 0.f; cC[i] = F0[63 * 64 + c0 + i]; }
      float at[8], bt[8], kt[8], rt[8], bh[8], kh[8];
#pragma unroll
      for (int i = 0; i < 8; ++i) { const float gt = __expf(-ct[i]), igt = __expf(ct[i]), gp = __expf(-cp[i]), gct = __expf(ct[i] - cC[i]);
          at[i] = -kk[i] * gp; bt[i] = kk[i] * ar[i] * igt; kt[i] = k2[i] * igt; rt[i] = zr[i] * gt; bh[i] = kk[i] * ar[i] * gct; kh[i] = k2[i] * gct; }
      u32x4 o;
      o.x = pk2(at[0], at[1]); o.y = pk2(at[2], at[3]); o.z = pk2(at[4], at[5]); o.w = pk2(at[6], at[7]); *(u32x4*)(A0 + t * ST + c0) = o;
      o.x = pk2(bt[0], bt[1]); o.y = pk2(bt[2], bt[3]); o.z = pk2(bt[4], bt[5]); o.w = pk2(bt[6], bt[7]); *(u32x4*)(A1 + t * ST + c0) = o;
      o.x = pk2(kt[0], kt[1]); o.y = pk2(kt[2], kt[3]); o.z = pk2(kt[4], kt[5]); o.w = pk2(kt[6], kt[7]); *(u32x4*)(A2 + t * ST + c0) = o;
      o.x = pk2(rt[0], rt[1]); o.y = pk2(rt[2], rt[3]); o.z = pk2(rt[4], rt[5]); o.w = pk2(rt[6], rt[7]); *(u32x4*)(A3 + t * ST + c0) = o;
#pragma unroll
      for (int i = 0; i < 8; ++i) { const int o = (c0 + i) * ST + (t ^ c0);
          A4[o] = (bf16)f2bf(bh[i]); A5[o] = (bf16)f2bf(kh[i]); A6[o] = (bf16)f2bf(zv[i]); F1[t * 128 + c0 + i] = at[i]; }
      if (t == 63) { float* gc = (float*)(B.UB + (size_t)u * UNIT_B + 16384) + c0;
#pragma unroll
          for (int i = 0; i < 8; ++i) gc[i] = __expf(-cC[i]); } }
    LDS_BARRIER();
    { const int mt = w >> 1, nt0 = 2 * (w & 1);
      f32x4 a[2];
      ZACC(a); mm_tile(A0, ST, A1, ST, 2, a, w, lq, g);
#pragma unroll
      for (int q = 0; q < 2; ++q) { const int i = 16 * (nt0 + q) + lq; f32x4 lab;
#pragma unroll
          for (int j = 0; j < 4; ++j) lab[j] = (i < 16 * mt + 4 * g + j) ? a[q][j] : 0.f;
#pragma unroll
          for (int j = 0; j < 4; ++j) F0[i * 64 + j * 16 + 4 * mt + g] = lab[j]; }
      asm volatile("" ::: "memory");
#define ST1_STORE(DST, INCL) do { _Pragma("unroll") for (int q = 0; q < 2; ++q) { const int tt = 16 * (nt0 + q) + lq, i0 = 16 * mt + 4 * g; float v_[4]; \
          _Pragma("unroll") for (int j = 0; j < 4; ++j) v_[j] = (i0 + j < tt + (INCL)) ? a[q][j] : 0.f; \
          u32x2 p_; p_.x = pk2(v_[0], v_[1]); p_.y = pk2(v_[2], v_[3]); *(u32x2*)((DST) + tt * ST + i0) = p_; } } while (0)
      ZACC(a); mm_tile(A2, ST, A0, ST, 2, a, w, lq, g); ST1_STORE(A7, 0); asm volatile("" ::: "memory");
      ZACC(a); mm_tile(A1, ST, A3, ST, 2, a, w, lq, g); ST1_STORE(A8, 1); asm volatile("" ::: "memory");
      ZACC(a); mm_tile(A2, ST, A3, ST, 2, a, w, lq, g); ST1_STORE(A9, 1);
#undef ST1_STORE
    }
    LDS_BARRIER();
    { const int mt = w >> 1, nt0 = 2 * (w & 1); f32x4 a[2]; ZACC(a);
      mm_tile2<true, false>(A6, ST, A7, ST, 2, a, w, lq, g);
#pragma unroll
      for (int q = 0; q < 2; ++q) *(f32x4*)(F1 + (16 * (nt0 + q) + lq) * 128 + 64 + 16 * mt + 4 * g) = a[q]; }
    LDS_BARRIER();
    { float X[16];
      const int col = 16 * w + lq;
#pragma unroll
      for (int r = 0; r < 16; ++r) X[r] = F1[(4 * r + g) * 128 + col];
      LDS_BARRIER();
      f32x4 Lc[4];
#pragma unroll
      for (int q = 0; q < 4; ++q) Lc[q] = *(const f32x4*)(F0 + g * 16 + 4 * q);
#pragma unroll
      for (int i = 0; i < 64; ++i) {
          const float xi = __shfl(X[i >> 2], (i & 3) * 16 + lq);
          f32x4 Ln[4];
#pragma unroll
          for (int q = 0; q < 4; ++q) Ln[q] = Lc[q];
          if (i + 1 < 64) {
#pragma unroll
              for (int q = ((i + 1) >> 4); q < 4; ++q) Ln[q] = *(const f32x4*)(F0 + (i + 1) * 64 + g * 16 + 4 * q);
          }
#pragma unroll
          for (int r = (i >> 2); r < 16; ++r) X[r] += Lc[r >> 2][r & 3] * xi;
#pragma unroll
          for (int q = 0; q < 4; ++q) Lc[q] = Ln[q];
          __builtin_amdgcn_sched_barrier(0);
      }
      bf16* XT = (bf16*)F1 + (w >> 2) * 4608 + ((col & 63) * ST);
#pragma unroll
      for (int r = 0; r < 16; ++r) XT[4 * r + g] = (bf16)f2bf(X[r]); }
    LDS_BARRIER();
    { const int mt = w >> 1, nt0 = 2 * (w & 1);
      const bf16* AhT = (const bf16*)F1; const bf16* W2T = AhT + 4608;
      unsigned char* ua = B.UA + (size_t)u * UNIT_A; unsigned char* ub = B.UB + (size_t)u * UNIT_B;
      const int p0 = 32 * (mt >> 1) + 8 * g + 4 * (mt & 1);
      f32x4 a[2];
      ZACC(a); mm_tile2<false, true>(AhT, ST, A4, ST, 2, a, w, lq, g);
#pragma unroll
      for (int q = 0; q < 2; ++q) { const int k = 16 * (nt0 + q) + lq; u32x2 o; o.x = pk2(a[q][0], a[q][1]); o.y = pk2(a[q][2], a[q][3]); *(u32x2*)(ua + swz(k, p0)) = o; }
      ZACC(a); mm_tile(AhT, ST, A8, ST, 2, a, w, lq, g);
#pragma unroll
      for (int q = 0; q < 2; ++q) { const int tt = 16 * (nt0 + q) + lq; const u32x2 rr = *(const u32x2*)(A3 + tt * ST + 16 * mt + 4 * g);
          u32x2 o; o.x = pk2(a[q][0] + bflo(rr.x), a[q][1] + bfhi(rr.x)); o.y = pk2(a[q][2] + bflo(rr.y), a[q][3] + bfhi(rr.y)); *(u32x2*)(ua + 8192 + swz(tt, p0)) = o; }
      ZACC(a); mm_tile2<true, false>(A4, ST, W2T, ST, 2, a, w, lq, g); mm_tile2<true, true>(A5, ST, A6, ST, 2, a, w, lq, g);
#pragma unroll
      for (int q = 0; q < 2; ++q) { const int v = 16 * (nt0 + q) + lq, k0 = 16 * mt + 4 * g; u32x2 o; o.x = pk2(a[q][0], a[q][1]); o.y = pk2(a[q][2], a[q][3]); *(u32x2*)(ub + swz(v, k0)) = o; }
      ZACC(a); mm_tile(A8, ST, W2T, ST, 2, a, w, lq, g); mm_tile2<false, true>(A9, ST, A6, ST, 2, a, w, lq, g);
#pragma unroll
      for (int q = 0; q < 2; ++q) { const int v = 16 * (nt0 + q) + lq, t0 = 16 * mt + 4 * g; u32x2 o; o.x = pk2(a[q][0], a[q][1]); o.y = pk2(a[q][2], a[q][3]); *(u32x2*)(ub + 8192 + swz(v, t0)) = o; } }
    LDS_BARRIER();
}
__device__ __forceinline__ void phase_rwkv_prep(const Params& P, int l, const Ctx& c) {
    const RwkvBufs B = rwkv_bufs(P, c);
    float pw0[8], pa0[8], pkk[8], pka[8], prk[8]; int hprev = -1;
    u32x4 wlr[4];
    u32x4 rc[7], rp[7];
    if (c.bid < NUNIT) { const int u0 = c.bid, h0 = u0 & 7, bc0 = u0 >> 3, b0 = bc0 / NCHK, ch0 = bc0 - b0 * NCHK, t0 = c.tid >> 3, cg0 = c.tid & 7;
        const bf16* cn = (const bf16*)(c.ws + OFF_RW) + ((size_t)b0 * LP + ch0 * 64 + t0) * NRW; const bf16* pn = cn - NRW;
#pragma unroll
        for (int s = 0; s < 3; ++s) { rc[s] = GLD(u32x4, cn + s * 512 + h0 * 64 + cg0 * 8); rp[s] = GLD(u32x4, pn + s * 512 + h0 * 64 + cg0 * 8); }
#pragma unroll
        for (int q4 = 0; q4 < 4; ++q4) { rc[3 + q4] = GLD(u32x4, cn + 1536 + cg0 * 32 + q4 * 8); rp[3 + q4] = GLD(u32x4, pn + 1536 + cg0 * 32 + q4 * 8); } }
    for (int u = c.bid; u < NUNIT; u += c.G) {
        const int h = u & 7;
        if (h != hprev) { hprev = h; const int j0 = l * 512 + h * 64 + (c.tid & 7) * 8;
#pragma unroll
            for (int i = 0; i < 8; ++i) { pw0[i] = P.in[9][j0 + i]; pa0[i] = P.in[11][j0 + i]; pkk[i] = P.in[14][j0 + i]; pka[i] = P.in[15][j0 + i]; prk[i] = P.in[16][j0 + i]; }
            { const bf16* WTp = (const bf16*)(c.ws + OFF_WT); const int row = c.tid >> 3, chk = c.tid & 7;
              wlr[0] = *(const u32x4*)(WTp + WT_LW + (size_t)(h * 64 + row) * 64 + chk * 8); wlr[1] = *(const u32x4*)(WTp + WT_LA + (size_t)(h * 64 + row) * 64 + chk * 8);
#pragma unroll
              for (int i = 0; i < 2; ++i) { const int idx = c.tid + 512 * i, r2 = idx >> 4, c2 = idx & 15; wlr[2 + i] = *(const u32x4*)(WTp + WT_LG + (size_t)(h * 64 + r2) * 128 + c2 * 8); } } }
        rwkv_prep_unit(P, l, c, u, B, pw0, pa0, pkk, pka, prk, wlr, rc, rp);
    }
}

constexpr int SLOTB = 33280, YST = 68;
__device__ __forceinline__ void scan_chunked(const Params& P, const Ctx& c, int bh) {
    const RwkvBufs B = rwkv_bufs(P, c);
    const int b = bh >> 3, h = bh & 7, w = c.wave, lane = c.lane, lq = lane & 15, g = lane >> 4;
    const size_t rowb = (size_t)b * LP;
    const int ll = c.tid;
    unsigned char* L = c.lds;
    f32x4 st[4];
#pragma unroll
    for (int i = 0; i < 4; ++i) st[i] = (f32x4){0.f, 0.f, 0.f, 0.f};
    u32x4 r0[5], r1[5], r2[5], r3[5], r4[5];
#define SC_UNIT(cc) ((size_t)((b * NCHK + (cc)) * 8 + h))
#define SC_LOAD(R, cc) do { const unsigned char* pa_ = B.UA + SC_UNIT(cc) * UNIT_A; const unsigned char* pb_ = B.UB + SC_UNIT(cc) * UNIT_B; \
        _Pragma("unroll") for (int i_ = 0; i_ < 2; ++i_) { R[i_] = GLD(u32x4, pa_ + (ll + 512 * i_) * 16); R[2 + i_] = GLD(u32x4, pb_ + (ll + 512 * i_) * 16); } \
        if (ll < 16) R[4] = GLD(u32x4, pb_ + 16384 + ll * 16); } while (0)
#define SC_WRITE(R, slot) do { unsigned char* s_ = L + (slot) * SLOTB; \
        _Pragma("unroll") for (int i_ = 0; i_ < 2; ++i_) { *(u32x4*)(s_ + (ll + 512 * i_) * 16) = R[i_]; *(u32x4*)(s_ + 16384 + (ll + 512 * i_) * 16) = R[2 + i_]; } \
        if (ll < 16) *(u32x4*)(s_ + 32768 + ll * 16) = R[4]; } while (0)
#define SC_COMPUTE(ci) do { \
        const unsigned char* sl = L + ((ci) % 3) * SLOTB; \
        const int vcol = 16 * w + lq; \
        bf16x8 gaf[4][2]; f32x4 gcf[4]; u32x2 d0f[4]; \
        _Pragma("unroll") for (int mt = 0; mt < 4; ++mt) { \
            gcf[mt] = *(const f32x4*)(sl + 32768 + (16 * mt + 4 * g) * 4); \
            d0f[mt] = *(const u32x2*)(sl + 16384 + swz(vcol, 16 * mt + 4 * g)); \
            _Pragma("unroll") for (int ks = 0; ks < 2; ++ks) gaf[mt][ks] = *(const bf16x8*)(sl + swz(16 * mt + lq, 32 * ks + 8 * g)); } \
        __builtin_amdgcn_sched_barrier(0);        \
        bf16x8 sb[2]; \
        _Pragma("unroll") for (int ks = 0; ks < 2; ++ks) { u32x4 pw; pw.x = pk2(st[2 * ks][0], st[2 * ks][1]); pw.y = pk2(st[2 * ks][2], st[2 * ks][3]); pw.z = pk2(st[2 * ks + 1][0], st[2 * ks + 1][1]); pw.w = pk2(st[2 * ks + 1][2], st[2 * ks + 1][3]); \
            sb[ks] = __builtin_bit_cast(bf16x8, pw); } \
        _Pragma("unroll") for (int mt = 0; mt < 4; ++mt) { \
            f32x4 ns = (f32x4){bflo(d0f[mt].x), bfhi(d0f[mt].x), bflo(d0f[mt].y), bfhi(d0f[mt].y)} + gcf[mt] * st[mt]; \
            _Pragma("unroll") for (int ks = 0; ks < 2; ++ks) ns = __builtin_amdgcn_mfma_f32_16x16x32_bf16(gaf[mt][ks], sb[ks], ns, 0, 0, 0); \
            st[mt] = ns; } \
        bf16x8 rhf[4][2]; u32x2 y0f[4];        \
        _Pragma("unroll") for (int mt = 0; mt < 4; ++mt) { y0f[mt] = *(const u32x2*)(sl + 24576 + swz(vcol, 16 * mt + 4 * g)); \
            _Pragma("unroll") for (int ks = 0; ks < 2; ++ks) rhf[mt][ks] = *(const bf16x8*)(sl + 8192 + swz(16 * mt + lq, 32 * ks + 8 * g)); } \
        __builtin_amdgcn_sched_barrier(0); \
        f32x4 yav[4]; \
        _Pragma("unroll") for (int mt = 0; mt < 4; ++mt) { yav[mt] = (f32x4){bflo(y0f[mt].x), bfhi(y0f[mt].x), bflo(y0f[mt].y), bfhi(y0f[mt].y)}; \
            _Pragma("unroll") for (int ks = 0; ks < 2; ++ks) yav[mt] = __builtin_amdgcn_mfma_f32_16x16x32_bf16(rhf[mt][ks], sb[ks], yav[mt], 0, 0, 0); } \
        _Pragma("unroll") for (int mt = 0; mt < 4; ++mt) { \
            float* yl = (float*)(L + 3 * SLOTB) + ((ci) & 1) * (64 * YST) + (16 * mt + 4 * g) * YST + vcol; \
            _Pragma("unroll") for (int j = 0; j < 4; ++j) yl[j * YST] = yav[mt][j]; } } while (0)
#define SC_YSTORE(ci) do { const float* ys_ = (const float*)(L + 3 * SLOTB) + ((ci) & 1) * (64 * YST) + (c.tid >> 3) * YST + (c.tid & 7) * 8; \
        float* yg_ = B.Y + (rowb + (ci) * 64 + (c.tid >> 3)) * 512 + h * 64 + (c.tid & 7) * 8; \
        GST(f32x4, yg_) = *(const f32x4*)ys_; GST(f32x4, yg_ + 4) = *(const f32x4*)(ys_ + 4); } while (0)
#define SC_ITER(ci, R) do { if ((ci) + 2 < NCHK) SC_WRITE(R, ((ci) + 2) % 3); if ((ci) + 7 < NCHK) SC_LOAD(R, (ci) + 7); if ((ci) > 0) SC_YSTORE((ci) - 1); if (w < 4) { SC_COMPUTE(ci); } LDS_BARRIER(); } while (0)
    { SC_LOAD(r0, 0); SC_LOAD(r1, 1); SC_WRITE(r0, 0); SC_WRITE(r1, 1); SC_LOAD(r2, 2); SC_LOAD(r3, 3); SC_LOAD(r4, 4); SC_LOAD(r0, 5); SC_LOAD(r1, 6); }
    __syncthreads();
#pragma unroll 1
    for (int cc = 0; cc < NCHK; cc += 5) { SC_ITER(cc, r2); SC_ITER(cc + 1, r3); SC_ITER(cc + 2, r4); SC_ITER(cc + 3, r0); SC_ITER(cc + 4, r1); }
    SC_YSTORE(NCHK - 1);
#undef SC_YSTORE
#undef SC_COMPUTE
#undef SC_ITER
#undef SC_UNIT
#undef SC_LOAD
#undef SC_WRITE
}

__device__ __forceinline__ void phase_gn(const Params& P, int l, const Ctx& c) {
    const RwkvBufs B = rwkv_bufs(P, c);
    const int gw = c.bid * NWAVES + c.wave, NGW = c.G * NWAVES;
    const int c0 = 8 * c.lane;
    float gnw[8], gnb[8];
#pragma unroll
    for (int i = 0; i < 8; ++i) { gnw[i] = P.in[17][l * 512 + c0 + i]; gnb[i] = P.in[18][l * 512 + c0 + i]; }
    f32x4 ny0, ny1; u32x4 nbw, ngw;
#define GN_LOAD(mm) do { const size_t o_ = (size_t)(mm) * 512 + c0; ny0 = *(const f32x4*)(B.Y + o_); ny1 = *(const f32x4*)(B.Y + o_ + 4); nbw = *(const u32x4*)(B.BON + o_); ngw = *(const u32x4*)(B.G + o_); } while (0)
    if (gw < M) GN_LOAD(gw);
    for (int m = gw; m < M; m += NGW) {
        const size_t o = (size_t)m * 512 + c0;
        const f32x4 y0 = ny0, y1 = ny1; const u32x4 bw = nbw, gw4 = ngw;
        if (m + NGW < M) GN_LOAD(m + NGW);
        float y[8] = {y0.x, y0.y, y0.z, y0.w, y1.x, y1.y, y1.z, y1.w};
        const float bo[8] = {bflo(bw.x), bfhi(bw.x), bflo(bw.y), bfhi(bw.y), bflo(bw.z), bfhi(bw.z), bflo(bw.w), bfhi(bw.w)};
        const float gg[8] = {bflo(gw4.x), bfhi(gw4.x), bflo(gw4.y), bfhi(gw4.y), bflo(gw4.z), bfhi(gw4.z), bflo(gw4.w), bfhi(gw4.w)};
        float s = 0.f;
#pragma unroll
        for (int i = 0; i < 8; ++i) s += y[i];
        s += __shfl_xor(s, 1); s += __shfl_xor(s, 2); s += __shfl_xor(s, 4);
        const float mean = s * (1.f / 64.f);
        float q = 0.f;
#pragma unroll
        for (int i = 0; i < 8; ++i) { y[i] -= mean; q += y[i] * y[i]; }
        q += __shfl_xor(q, 1); q += __shfl_xor(q, 2); q += __shfl_xor(q, 4);
        const float rstd = 1.0f / sqrtf(q * (1.f / 64.f) + 64e-5f);
        float ov[8];
#pragma unroll
        for (int i = 0; i < 8; ++i) ov[i] = (y[i] * rstd * gnw[i] + gnb[i] + bo[i]) * gg[i];
        u32x4 ow; ow.x = pk2(ov[0], ov[1]); ow.y = pk2(ov[2], ov[3]); ow.z = pk2(ov[4], ov[5]); ow.w = pk2(ov[6], ov[7]);
        *(u32x4*)(B.ORW + o) = ow;
    }
}

__device__ __forceinline__ void attn_unit(const Ctx& c, int bh, int qb, const bf16* Q, const bf16* K, const bf16* V, bf16* O, const float* FC, float qkb2, const float* gq, const float* gk) {
    const int b = bh >> 3, h = bh & 7, lane = c.lane, w = c.wave, lq = lane & 15, g = lane >> 4;
    const int q0 = qb * 128;
    const size_t rowb = (size_t)b * LP;
    const int qrow = q0 + 16 * w + lq;
    bf16* Ks = (bf16*)c.lds; bf16* Vt = Ks + 64 * 72; float* fks = (float*)(Vt + 64 * 72);
    const bf16* qp = Q + (rowb + qrow) * 512 + h * 64 + 8 * g;
    bf16x8 qf0, qf1;
    { const u32x4 r0 = GLD(u32x4, qp), r1 = GLD(u32x4, qp + 32);
      float x[16] = {bflo(r0.x), bfhi(r0.x), bflo(r0.y), bfhi(r0.y), bflo(r0.z), bfhi(r0.z), bflo(r0.w), bfhi(r0.w), bflo(r1.x), bfhi(r1.x), bflo(r1.y), bfhi(r1.y), bflo(r1.z), bfhi(r1.z), bflo(r1.w), bfhi(r1.w)};
      float ss = 0.f;
#pragma unroll
      for (int i = 0; i < 16; ++i) ss += x[i] * x[i];
      ss += __shfl_xor(ss, 16); ss += __shfl_xor(ss, 32);
      const float rs = QSCALE / sqrtf(ss * (1.f / 64.f) + 1e-6f);
#pragma unroll
      for (int i = 0; i < 8; ++i) { x[i] *= rs * gq[8 * g + i]; x[8 + i] *= rs * gq[32 + 8 * g + i]; }
      u32x4 p0, p1; p0.x = pk2(x[0], x[1]); p0.y = pk2(x[2], x[3]); p0.z = pk2(x[4], x[5]); p0.w = pk2(x[6], x[7]); p1.x = pk2(x[8], x[9]); p1.y = pk2(x[10], x[11]); p1.z = pk2(x[12], x[13]); p1.w = pk2(x[14], x[15]);
      qf0 = __builtin_bit_cast(bf16x8, p0); qf1 = __builtin_bit_cast(bf16x8, p1); }
    const float* FCh = FC + (size_t)bh * LP;
    const float fq = GLD(float, FCh + qrow);
    float mrun = -1e30f, lsum = 0.f;
    f32x4 o[4];
#pragma unroll
    for (int i = 0; i < 4; ++i) o[i] = (f32x4){0.f, 0.f, 0.f, 0.f};
    const int kt_max = (q0 + 127) >> 6;
    const int lkey = c.tid >> 3, lch = c.tid & 7;
    float gkr[8];
#pragma unroll
    for (int i = 0; i < 8; ++i) gkr[i] = gk[lch * 8 + i];
    const size_t gbase = (rowb + lkey) * 512 + h * 64 + lch * 8;
    u32x4 kv = GLD(u32x4, K + gbase + (size_t)kt_max * 64 * 512), vv = GLD(u32x4, V + gbase + (size_t)kt_max * 64 * 512);
    float fkv = GLD(float, FCh + kt_max * 64 + (c.tid & 63));
    volatile unsigned* vote = (volatile unsigned*)(fks + 64);
    for (int kt = kt_max; kt >= 0; --kt) {
        const int k0 = kt * 64;
        LDS_BARRIER();
        { int can = 0; if (kt < kt_max) { const float fl = __shfl(fkv, 63); can = (qkb2 + fq - fl) < (mrun - THR2); }
          const int wall = __all(can); if (lane == 0) vote[w] = (unsigned)wall; }
        { { float x[8] = {bflo(kv.x), bfhi(kv.x), bflo(kv.y), bfhi(kv.y), bflo(kv.z), bfhi(kv.z), bflo(kv.w), bfhi(kv.w)}; float ss = 0.f;
#pragma unroll
              for (int i = 0; i < 8; ++i) ss += x[i] * x[i];
              ss += __shfl_xor(ss, 1); ss += __shfl_xor(ss, 2); ss += __shfl_xor(ss, 4);
              const float rs = 1.0f / sqrtf(ss * (1.f / 64.f) + 1e-6f);
              u32x4 kn; kn.x = pk2(x[0] * rs * gkr[0], x[1] * rs * gkr[1]); kn.y = pk2(x[2] * rs * gkr[2], x[3] * rs * gkr[3]); kn.z = pk2(x[4] * rs * gkr[4], x[5] * rs * gkr[5]); kn.w = pk2(x[6] * rs * gkr[6], x[7] * rs * gkr[7]);
              *(u32x4*)(Ks + lkey * 72 + lch * 8) = kn; }
            bf16* vd = Vt + (lch * 8) * 72 + (lkey ^ (8 * lch));
            vd[0] = (bf16)(vv.x & 0xffff); vd[72] = (bf16)(vv.x >> 16); vd[144] = (bf16)(vv.y & 0xffff); vd[216] = (bf16)(vv.y >> 16);
            vd[288] = (bf16)(vv.z & 0xffff); vd[360] = (bf16)(vv.z >> 16); vd[432] = (bf16)(vv.w & 0xffff); vd[504] = (bf16)(vv.w >> 16);
            if (c.tid < 64) fks[c.tid] = fkv;
            if (kt > 0) { kv = GLD(u32x4, K + gbase + (size_t)(k0 - 64) * 512); vv = GLD(u32x4, V + gbase + (size_t)(k0 - 64) * 512); fkv = GLD(float, FCh + k0 - 64 + (c.tid & 63)); } }
        LDS_BARRIER();
        { unsigned all = vote[0] & vote[1] & vote[2] & vote[3] & vote[4] & vote[5] & vote[6] & vote[7]; if (all) break; }
        if (k0 > q0 + 16 * w + 15) continue;
        f32x4 s[4];
#pragma unroll
        for (int nt = 0; nt < 4; ++nt) { const bf16* kp = Ks + (16 * nt + lq) * 72 + 8 * g; const bf16x8 a0 = *(const bf16x8*)kp, a1 = *(const bf16x8*)(kp + 32);
            s[nt] = __builtin_amdgcn_mfma_f32_16x16x32_bf16(a0, qf0, (f32x4){0.f, 0.f, 0.f, 0.f}, 0, 0, 0);
            s[nt] = __builtin_amdgcn_mfma_f32_16x16x32_bf16(a1, qf1, s[nt], 0, 0, 0); }
        float mx = -INFINITY;
#pragma unroll
        for (int nt = 0; nt < 4; ++nt) { const f32x4 fk = *(const f32x4*)(fks + 16 * nt + 4 * g);
#pragma unroll
            for (int j = 0; j < 4; ++j) { float x = s[nt][j] + fq - fk[j]; const int key = k0 + 16 * nt + 4 * g + j; if (key > qrow) x = -INFINITY; s[nt][j] = x; mx = fmaxf(mx, x); } }
        mx = fmaxf(mx, __shfl_xor(mx, 16)); mx = fmaxf(mx, __shfl_xor(mx, 32));
        const float mnew = fmaxf(mrun, mx), alpha = __builtin_amdgcn_exp2f(mrun - mnew); mrun = mnew;
        float psum = 0.f;
#pragma unroll
        for (int nt = 0; nt < 4; ++nt)
#pragma unroll
            for (int j = 0; j < 4; ++j) { const float p = __builtin_amdgcn_exp2f(s[nt][j] - mnew); s[nt][j] = p; psum += p; }
        lsum = lsum * alpha + psum;
#pragma unroll
        for (int dt = 0; dt < 4; ++dt) o[dt] = o[dt] * alpha;
        bf16x8 pb[2];
#pragma unroll
        for (int k2 = 0; k2 < 2; ++k2) { u32x4 pw; pw.x = pk2(s[2 * k2][0], s[2 * k2][1]); pw.y = pk2(s[2 * k2][2], s[2 * k2][3]); pw.z = pk2(s[2 * k2 + 1][0], s[2 * k2 + 1][1]); pw.w = pk2(s[2 * k2 + 1][2], s[2 * k2 + 1][3]);
            pb[k2] = __builtin_bit_cast(bf16x8, pw); }
#pragma unroll
        for (int dt = 0; dt < 4; ++dt)
#pragma unroll
            for (int k2 = 0; k2 < 2; ++k2) { const int vrow = 16 * dt + lq, vx = 8 * ((vrow >> 3) & 7); const bf16* vp = Vt + vrow * 72;
                const u32x2 lo = *(const u32x2*)(vp + ((32 * k2 + 4 * g) ^ vx)), hi = *(const u32x2*)(vp + ((32 * k2 + 16 + 4 * g) ^ vx));
                u32x4 aw; aw.x = lo.x; aw.y = lo.y; aw.z = hi.x; aw.w = hi.y;
                o[dt] = __builtin_amdgcn_mfma_f32_16x16x32_bf16(__builtin_bit_cast(bf16x8, aw), pb[k2], o[dt], 0, 0, 0); }
    }
    lsum += __shfl_xor(lsum, 16); lsum += __shfl_xor(lsum, 32);
    const float inv = 1.0f / lsum;
    bf16* op = O + (rowb + qrow) * 512 + h * 64 + 4 * g;
#pragma unroll
    for (int dt = 0; dt < 4; ++dt) { u32x2 ow; ow.x = pk2(o[dt][0] * inv, o[dt][1] * inv); ow.y = pk2(o[dt][2] * inv, o[dt][3] * inv); GST(u32x2, op + 16 * dt) = ow; }
    __syncthreads();
}
__device__ __forceinline__ void phase_attn(const Params& P, int l, const Ctx& c, int first_blk) {
    const bf16* Q = (const bf16*)(c.ws + OFF_Q); const bf16* K = (const bf16*)(c.ws + OFF_K); const bf16* V = (const bf16*)(c.ws + OFF_V);
    const float* FC = (const float*)(c.ws + OFF_MISC) + 16 * LP;
    float gqm = fabsf(P.in[5][l * 64 + c.lane]), gkm = fabsf(P.in[6][l * 64 + c.lane]);
#pragma unroll
    for (int o = 1; o < 64; o <<= 1) { gqm = fmaxf(gqm, __shfl_xor(gqm, o)); gkm = fmaxf(gkm, __shfl_xor(gkm, o)); }
    const float qkb2 = 8.0f * gqm * gkm * LOG2E * 1.03f;
    constexpr int NQB = LP / 128, NU = 16 * NQB;
    unsigned* ctr = (unsigned*)(c.ws + OFF_CTL) + 8192 + 64 * l;
    volatile unsigned* slot = (volatile unsigned*)(c.lds + MISC_OFF) + 4;
    for (;;) {
        __syncthreads();
        if (c.tid == 0) *slot = atomicAdd(ctr, 1u);
        __syncthreads();
        const int u = (int)*slot;
        if (u >= NU) break;
        const int bh = u & 15, qb = NQB - 1 - (u >> 4); attn_unit(c, bh, qb, Q, K, V, (bf16*)(c.ws + OFF_OF), FC, qkb2, P.in[5] + l * 64, P.in[6] + l * 64);
    }
}

__device__ __forceinline__ void phase_fixup(const Params& P, int l, const Ctx& c) {
    bf16* ACT = (bf16*)(c.ws + OFF_RW); const bf16* HALO = (const bf16*)(c.ws + OFF_Q);
    const float* cw = P.in[24] + (size_t)l * 3 * NUP;
    const int total = (M / 64) * 2 * DFF;
    for (int idx = c.bid * NTHR + c.tid; idx < total; idx += c.G * NTHR) {
        const int rr = idx / DFF, ch = idx - rr * DFF, q64 = rr >> 1, e = rr & 1, row = q64 * 64 + e;
        const int t = row % LP;
        int s0, s1, s2;
        if (e == 0) { s0 = q64 * 4 + 2; s1 = (q64 - 1) * 4 + 1; s2 = (q64 - 1) * 4 + 0; } else { s0 = q64 * 4 + 3; s1 = q64 * 4 + 2; s2 = (q64 - 1) * 4 + 1; }
        float uc[2];
#pragma unroll
        for (int bj = 0; bj < 2; ++bj) { const int col = bj * DFF + ch;
            const float u0 = bf2f(HALO[(size_t)s0 * NUP + col]);
            const float u1 = (t >= 1) ? bf2f(HALO[(size_t)s1 * NUP + col]) : 0.f;
            const float u2 = (t >= 2) ? bf2f(HALO[(size_t)s2 * NUP + col]) : 0.f;
            uc[bj] = cw[col] * u2 + cw[NUP + col] * u1 + cw[2 * NUP + col] * u0; }
        ACT[(size_t)row * DFF + ch] = (bf16)f2bf(uc[0] * sigmoidf_(uc[0]) * uc[1]);
    }
}

#define OPQ_S(x) asm volatile("" : "+s"(x))
#define OPQ_V(x) asm volatile("" : "+v"(x))
#define PHASE_BEGIN() do { int t_ = threadIdx.x; OPQ_V(t_); c.tid = t_; c.lane = t_ & 63; c.wave = __builtin_amdgcn_readfirstlane(t_ >> 6); int b_ = blockIdx.x; OPQ_S(b_); c.bid = b_; \
    size_t z_ = 0; OPQ_S(z_); unsigned char* w_ = P.ws + z_;   c.ws = w_; ws = w_; l = lc; OPQ_S(l); WT = (pg8::bf16_t*)(ws + OFF_WT); HN = (pg8::bf16_t*)(ws + OFF_HN); } while (0)
__global__ void __launch_bounds__(NTHR, 2) mega(Params P) {
    extern __shared__ __attribute__((aligned(16))) unsigned char lds[];
    Ctx c; c.G = gridDim.x; c.lds = lds;
    volatile LAS unsigned* MISC = (volatile LAS unsigned*)((LAS unsigned char*)lds + MISC_OFF);
    if (threadIdx.x < 16) MISC[threadIdx.x] = 0u;
    __syncthreads();
    (void)xcd_barrier_post((unsigned*)(P.ws + OFF_CTL) + 1024, MISC + 8);
#define SEAM() do { XcdBarrier xb_; xb_.bar = (unsigned*)(P.ws + OFF_CTL) + 1024; xb_.x = xb_xcc_id(); xb_.st = (volatile LAS unsigned*)((LAS unsigned char*)lds + MISC_OFF) + 8; xcd_barrier(xb_); } while (0)
    PG8_LAS unsigned char* ldsl = (PG8_LAS unsigned char*)lds;
    unsigned char* ws; pg8::bf16_t* WT; pg8::bf16_t* HN; int l;
#pragma unroll 1
    for (int lc = 0; lc < DEPTH; ++lc) {
        PHASE_BEGIN();
        convert_weights(P, l, c);
        phase_norm<true>(P, l, c);
        SEAM();
        if (P.out == nullptr) cg::this_grid().sync();
        PHASE_BEGIN();
        phase_fcum(P, c);
        { pg8::Gemm g{HN, WT + WT_IN, M, N1, 1024, 1024}; pg8::StaticOrder S; S.init(M, N1, c.G, c.bid);
          pg8::EpiRoute E{ws};
          pg8::gemm_phase<pg8::EpiRoute, pg8::StaticOrder, true, true>(ldsl, g, S, E); }
        SEAM();
        PHASE_BEGIN();
        for (int rep_ = 0; rep_ < REP_PREP; ++rep_) phase_rwkv_prep(P, l, c);
        SEAM();
        PHASE_BEGIN();
        if (c.bid < 16) { scan_chunked(P, c, c.bid); __syncthreads(); PHASE_BEGIN(); }
        phase_attn(P, l, c, 16);
#if REP_P3 > 1
        __syncthreads(); PHASE_BEGIN();
        if (c.bid < 16) scan_chunked(P, c, c.bid); else phase_attn(P, l, c, 16);
#endif
        SEAM();
        PHASE_BEGIN();
        phase_gn(P, l, c);
        for (int rep_ = 0; rep_ < REP_SYNC; ++rep_) SEAM();
        SEAM();
        PHASE_BEGIN();
#pragma unroll 1
        for (int pass = 0; pass < 3; ++pass) {
            if (pass) { __syncthreads(); PHASE_BEGIN(); }
            const int rw_side = pass == 2 ? ((c.bid >> 2) & 1) : pass;
            const pg8::bf16_t* A = rw_side ? (const pg8::bf16_t*)(ws + OFF_RW + (size_t)M * 512 * 4) : (const pg8::bf16_t*)(ws + OFF_OF);
            pg8::Gemm g{A, WT + (rw_side ? WT_BR : WT_BF), M, 1024, 512, 512};
            pg8::OneUnit S; S.so.init(MMAIN, 1024, c.G, c.bid); S.mode = pass == 2; S.pm = MMAIN / 256; S.pn = c.bid & 3; S.active = c.bid < 8;
            pg8::bf16_t* O = (pass == 2 && rw_side) ? (pg8::bf16_t*)(ws + OFF_TAIL) - (size_t)MMAIN * 1024 : (pg8::bf16_t*)(ws + OFF_K);
            pg8::EpiGateR E{O, (const pg8::bf16_t*)(ws + OFF_GT), P.in[21] + l * NGT, rw_side * 1024, pass == 1};
            pg8::gemm_phase<pg8::EpiGateR, pg8::OneUnit, true, true>(ldsl, g, S, E);
        }
        SEAM();
        PHASE_BEGIN();
#pragma unroll 1
        for (int pass = 0; pass < 2; ++pass) {
            if (pass) { __syncthreads(); PHASE_BEGIN(); }
            const int sl = pass ? (c.bid >> 2) : 0, ks = sl & 3;
            const pg8::bf16_t* A = (pass && sl >= 4) ? (const pg8::bf16_t*)(ws + OFF_TAIL) - (size_t)MMAIN * 1024 : (const pg8::bf16_t*)(ws + OFF_K);
            pg8::Gemm g{A + ks * 256, WT + WT_O + ks * 256, M, 1024, pass ? 256 : 1024, 1024};
            pg8::OneUnit S; S.so.init(MMAIN, 1024, c.G, c.bid); S.mode = pass; S.pm = MMAIN / 256; S.pn = c.bid & 3; S.active = sl < 8;
            pg8::EpiResid E{(float*)(ws + OFF_H), nullptr, pass};
            pg8::gemm_phase<pg8::EpiResid, pg8::OneUnit, true, true>(ldsl, g, S, E);
        }
        SEAM();
        PHASE_BEGIN();
        phase_norm<false>(P, l, c);
        SEAM();
        PHASE_BEGIN();
        { pg8::Gemm g{HN, WT + WT_UP, M, NUP, 1024, 1024}; pg8::StaticOrder S; S.init(M, NUP, c.G, c.bid);
          pg8::EpiUp E{(pg8::bf16_t*)(ws + OFF_RW), (pg8::bf16_t*)(ws + OFF_Q), P.in[24] + (size_t)l * 3 * NUP};
          pg8::gemm_phase<pg8::EpiUp, pg8::StaticOrder, true, true>(ldsl, g, S, E); }
        SEAM();
        PHASE_BEGIN();
        phase_fixup(P, l, c);
        SEAM();
        PHASE_BEGIN();
#pragma unroll 1
        for (int pass = 0; pass < 2; ++pass) {
            if (pass) { __syncthreads(); PHASE_BEGIN(); }
            const int sl = pass ? (c.bid >> 2) : 0;
            const int ko = (sl < 6) ? sl * 384 : 2304 + (sl - 6) * 256, kl = (sl < 6) ? 384 : 256;
            pg8::Gemm g{(const pg8::bf16_t*)(ws + OFF_RW) + (pass ? ko : 0), WT + WT_DN + (pass ? ko : 0), M, 1024, pass ? kl : DFF, DFF};
            pg8::OneUnit S; S.so.init(MMAIN, 1024, c.G, c.bid); S.mode = pass; S.pm = MMAIN / 256; S.pn = c.bid & 3; S.active = sl < 8;
            pg8::EpiResid E{(float*)(ws + OFF_H), (l == DEPTH - 1 && !pass) ? P.out : nullptr, pass};
            pg8::gemm_phase<pg8::EpiResid, pg8::OneUnit, true, true>(ldsl, g, S, E);
        }
        SEAM();
        if (l == DEPTH - 1) {
            PHASE_BEGIN();
            const float* H = (const float*)(ws + OFF_H);
            for (int idx = c.bid * NTHR + c.tid; idx < (NMETA + SEQ - (MMAIN - LP)) * (DM / 4); idx += c.G * NTHR) {
                const int r = idx / (DM / 4), q4 = idx - r * (DM / 4), t = (MMAIN - LP) + r;
                *(f32x4*)(P.out + ((size_t)SEQ + (t - NMETA)) * DM + 4 * q4) = *(const f32x4*)(H + (size_t)(LP + t) * DM + 4 * q4);
            }
        }
    }
}

extern "C" void kernel_launch(void* const* d_in, const int* in_sizes, int n_in, void* d_out, int out_size, void* d_ws, size_t ws_size, hipStream_t stream) {
    static int grid = 0;
    if (grid == 0) {
        if (n_in != 26 || out_size != NB * SEQ * DM || ws_size < WS_NEED) { fprintf(stderr, "kernel_launch: unexpected shapes (n_in %d out %d ws %zu need %zu)\n", n_in, out_size, ws_size, (size_t)WS_NEED); grid = -1; return; }
        int dev = 0, cus = 0, per_cu = 0;
        if (hipGetDevice(&dev) != hipSuccess || hipDeviceGetAttribute(&cus, hipDeviceAttributeMultiprocessorCount, dev) != hipSuccess) { grid = -1; return; }
        if (hipFuncSetAttribute((const void*)mega, hipFuncAttributeMaxDynamicSharedMemorySize, LDS_BYTES) != hipSuccess) { fprintf(stderr, "kernel_launch: hipFuncSetAttribute failed\n"); grid = -1; return; }
        if (hipOccupancyMaxActiveBlocksPerMultiprocessor(&per_cu, (const void*)mega, NTHR, LDS_BYTES) != hipSuccess || per_cu < 1) { fprintf(stderr, "kernel_launch: occupancy query says %d\n", per_cu); per_cu = 1; }
        (void)hipGetLastError();
        grid = cus;
    }
    if (grid < 0) return;
    if (hipMemsetAsync((char*)d_ws + OFF_CTL, 0, 65536, stream) != hipSuccess) { fprintf(stderr, "kernel_launch: memset failed\n"); return; }
    Params p{};
    for (int i = 0; i < 26; ++i) p.in[i] = (const float*)d_in[i];
    p.out = (float*)d_out; p.ws = (unsigned char*)d_ws;
    void* args[] = {&p};
    hipError_t e = hipLaunchCooperativeKernel((const void*)mega, dim3(grid), dim3(NTHR), args, LDS_BYTES, stream);
    if (e != hipSuccess) fprintf(stderr, "kernel_launch: cooperative launch failed: %s (grid %d)\n", hipGetErrorString(e), grid);
}
```

```cpp
#include <hip/hip_runtime.h>
#include <hip/hip_cooperative_groups.h>
#include <cstdio>
#include <cstdint>
#include <cmath>
namespace cg = cooperative_groups;
namespace pg8 {
#define PG8_LAS __attribute__((address_space(3)))
typedef unsigned short bf16_t;
typedef short bf16x8 __attribute__((ext_vector_type(8)));
typedef float f32x4 __attribute__((ext_vector_type(4)));
typedef unsigned u32x4 __attribute__((ext_vector_type(4)));
constexpr int BM = 256, BK = 64, HALF = 128, HTB = HALF * BK * 2  , STAGE_BYTES = 8 * HTB, NXCD = 8, WGM = 8;

__host__ __device__ __forceinline__ int lds_byte(int r, int c) { const int st = (r >> 4) * 2 + (c >> 5), rr = r & 15, cc = c & 31, ob = rr * 64 + cc * 2; return st * 1024 + (ob ^ (((ob >> 9) & 1) << 5)); }
__host__ __device__ __forceinline__ void stage_rc(int b, int& R, int& C) { const int st = b / 1024, sb = b % 1024, swz = sb ^ (((sb >> 9) & 1) << 5); R = (st >> 1) * 16 + swz / 64; C = (st & 1) * 32 + (swz % 64) / 2; }
__host__ __device__ __forceinline__ int perm32(int rho) { const int n = rho >> 4, i = rho & 15; return 8 * (i >> 2) + 4 * n + (i & 3); }

struct Unit { int pm, pn; };
struct Gemm { const bf16_t* A; const bf16_t* Bt; int M, N, K, ld; };

struct StaticOrder {
    int nM, nN, nwg, G, c;
    __host__ __device__ void init(int M, int N, int G_, int c_) { nM = M / BM; nN = N / BM; nwg = nM * nN; G = G_; c = c_; }
    __host__ __device__ bool next(int i, Unit& u) const {
        const long L = (long)i * G + c; if (L >= nwg) return false;
        int wgid = (int)L; { const int q = nwg / NXCD, r = nwg % NXCD, xcd = wgid % NXCD, off = wgid / NXCD; wgid = (xcd < r ? xcd * (q + 1) : r * (q + 1) + (xcd - r) * q) + off; }
        const int nig = WGM * nN, gid = wgid / nig, fm = gid * WGM, gsz = (nM - fm) < WGM ? (nM - fm) : WGM;
        u.pm = fm + ((wgid % nig) % gsz); u.pn = (wgid % nig) / gsz; return true;
    }
    __device__ __forceinline__ void a_ready(const Unit&) const {}
    __device__ __forceinline__ void done(const Unit&) const {}
};

__device__ __forceinline__ unsigned cvt_pk_bf16(float lo, float hi) { unsigned r; asm volatile("v_cvt_pk_bf16_f32 %0, %1, %2" : "=v"(r) : "v"(lo), "v"(hi)); return r; }
typedef float f32x2 __attribute__((ext_vector_type(2)));
template <class Epi, class Sched, bool ALIGN_EPI = false, bool SP2 = false>
__device__ __forceinline__ void gemm_phase(PG8_LAS unsigned char* lds, const Gemm g, const Sched& S, const Epi& E) {
    int tid_ = threadIdx.x; asm volatile("" : "+v"(tid_)); const int tid = tid_, wid = __builtin_amdgcn_readfirstlane(tid >> 6), lane = tid & 63, wr = wid >> 2, wc = wid & 3, fr = lane & 15, fq = lane >> 4;
    const int K = g.K, nt = K / BK, LD = g.ld;
    unsigned voffA[2], voffB[2];
#pragma unroll
    for (int i = 0; i < 2; ++i) { int R, C; stage_rc(tid * 16 + i * 8192, R, C); const int Rb = Epi::PERM ? ((R & ~31) + perm32(R & 31)) : R;
        voffA[i] = (unsigned)(R * LD + C) * 2u; voffB[i] = (unsigned)(Rb * LD + C) * 2u; }
    const size_t kstep = (size_t)(BK * 2);
    const size_t hstep = (size_t)HALF * LD * 2;
    const size_t tstep = 2 * hstep;
    const unsigned ldsw = (unsigned)wid * 1024u;
    const int aoff = lds_byte(wr * 64 + fr, fq * 8), boff = lds_byte(wc * 32 + fr, fq * 8);
#define PG8_SA(b, h) (((b) * 2 + (h)) * HTB)
#define PG8_SB(b, h) ((4 + (b) * 2 + (h)) * HTB)
#define PG8_STAGE(bufoff, gbase, voff) do { _Pragma("unroll") for (int _i = 0; _i < 2; ++_i) \
        __builtin_amdgcn_global_load_lds((const unsigned*)((const char*)(gbase) + (voff)[_i]), (PG8_LAS unsigned*)(lds + (bufoff) + ldsw + _i * 8192), 16, 0, 0); } while (0)
#define PG8_LDA(dst, b, h) do { _Pragma("unroll") for (int m = 0; m < 4; ++m) _Pragma("unroll") for (int k = 0; k < 2; ++k) dst[m][k] = *(const PG8_LAS bf16x8*)(lds + PG8_SA(b, h) + aoff + m * 2048 + k * 1024); } while (0)
#define PG8_LDB(dst, b, h) do { _Pragma("unroll") for (int n = 0; n < 2; ++n) _Pragma("unroll") for (int k = 0; k < 2; ++k) dst[n][k] = *(const PG8_LAS bf16x8*)(lds + PG8_SB(b, h) + boff + n * 2048 + k * 1024); } while (0)
#define PG8_MMA(ai, bj, At, Bt) do { __builtin_amdgcn_s_setprio(1); _Pragma("unroll") for (int m = 0; m < 4; ++m) _Pragma("unroll") for (int n = 0; n < 2; ++n) _Pragma("unroll") for (int k = 0; k < 2; ++k) \
        acc[ai][bj][m][n] = __builtin_amdgcn_mfma_f32_16x16x32_bf16(Bt[n][k], At[m][k], acc[ai][bj][m][n], 0, 0, 0); __builtin_amdgcn_s_setprio(0); } while (0)
#define PG8_WAIT_V(n) asm volatile("s_waitcnt vmcnt(" #n ")" ::: "memory")
#define PG8_WAIT_L(n) asm volatile("s_waitcnt lgkmcnt(" #n ")" ::: "memory")
#define PG8_BAR __builtin_amdgcn_s_barrier()
#define PG8_SCHED __builtin_amdgcn_sched_barrier(0)
    Unit cur, nxt; int ui = 0;
    if (!S.next(0, cur)) return;
    f32x4 acc[2][2][4][2];
#pragma unroll
    for (int a = 0; a < 2; ++a)
#pragma unroll
        for (int b = 0; b < 2; ++b)
#pragma unroll
            for (int m = 0; m < 4; ++m)
#pragma unroll
                for (int n = 0; n < 2; ++n) acc[a][b][m][n] = (f32x4){0.f, 0.f, 0.f, 0.f};
    bf16x8 At[4][2], B0[2][2], B1[2][2];
    const char* cA = (const char*)g.A + (size_t)cur.pm * tstep; const char* cB = (const char*)g.Bt + (size_t)cur.pn * tstep;
    S.a_ready(cur);
    if constexpr (SP2) {
        PG8_STAGE(PG8_SB(0, 0), cB, voffB); PG8_STAGE(PG8_SB(0, 1), cB + hstep, voffB); PG8_STAGE(PG8_SA(0, 0), cA, voffA); PG8_STAGE(PG8_SA(0, 1), cA + hstep, voffA);
        if (wr == 1) PG8_BAR;
        PG8_WAIT_V(2); PG8_BAR;
        PG8_STAGE(PG8_SB(1, 0), cB + kstep, voffB); PG8_STAGE(PG8_SA(1, 0), cA + kstep, voffA); PG8_STAGE(PG8_SB(1, 1), cB + hstep + kstep, voffB);
        PG8_WAIT_V(6); PG8_BAR;
    } else {
        PG8_STAGE(PG8_SB(0, 0), cB, voffB); PG8_STAGE(PG8_SA(0, 0), cA, voffA); PG8_STAGE(PG8_SB(0, 1), cB + hstep, voffB); PG8_STAGE(PG8_SA(0, 1), cA + hstep, voffA);
        if (wr == 1) PG8_BAR;
        PG8_WAIT_V(4); PG8_BAR;
        PG8_STAGE(PG8_SB(1, 0), cB + kstep, voffB); PG8_STAGE(PG8_SA(1, 0), cA + kstep, voffA); PG8_STAGE(PG8_SB(1, 1), cB + hstep + kstep, voffB);
        PG8_WAIT_V(6); PG8_BAR;
    }
    for (;;) {
        const bool has_next = S.next(ui + 1, nxt);
        const char* nA = has_next ? (const char*)g.A + (size_t)nxt.pm * tstep : cA; const char* nB = has_next ? (const char*)g.Bt + (size_t)nxt.pn * tstep : cB;
        for (int t = 0; t < nt; t += 2) {
            const bool last = (t == nt - 2);
            const char* a1 = cA + (size_t)(t + 1) * kstep;
            const char* a2 = last ? nA : cA + (size_t)(t + 2) * kstep; const char* b2 = last ? nB : cB + (size_t)(t + 2) * kstep;
            const char* a3 = a2 + kstep; const char* b3 = b2 + kstep;
            if (last && has_next) S.a_ready(nxt);
            if constexpr (SP2) {
            PG8_LDB(B0, 0, 0); PG8_LDB(B1, 0, 1); PG8_SCHED; PG8_LDA(At, 0, 0); PG8_STAGE(PG8_SA(1, 1), a1 + hstep, voffA);
            PG8_WAIT_V(8); PG8_WAIT_L(0); PG8_BAR; PG8_MMA(0, 0, At, B0); PG8_MMA(0, 1, At, B1); PG8_BAR; PG8_SCHED;
            PG8_LDA(At, 0, 1); PG8_STAGE(PG8_SB(0, 0), b2, voffB); PG8_STAGE(PG8_SB(0, 1), b2 + hstep, voffB); PG8_STAGE(PG8_SA(0, 0), a2, voffA);
            PG8_WAIT_V(8); PG8_WAIT_L(0); PG8_BAR; PG8_MMA(1, 0, At, B0); PG8_MMA(1, 1, At, B1); PG8_BAR; PG8_SCHED;
            PG8_LDB(B0, 1, 0); PG8_LDB(B1, 1, 1); PG8_SCHED; PG8_LDA(At, 1, 0); PG8_STAGE(PG8_SA(0, 1), a2 + hstep, voffA);
            PG8_WAIT_V(8); PG8_WAIT_L(0); PG8_BAR; PG8_MMA(0, 0, At, B0); PG8_MMA(0, 1, At, B1); PG8_BAR; PG8_SCHED;
            PG8_LDA(At, 1, 1); PG8_STAGE(PG8_SB(1, 0), b3, voffB); PG8_STAGE(PG8_SB(1, 1), b3 + hstep, voffB); PG8_STAGE(PG8_SA(1, 0), a3, voffA);
            PG8_WAIT_V(8); PG8_WAIT_L(0); PG8_BAR; PG8_MMA(1, 0, At, B0); PG8_MMA(1, 1, At, B1); PG8_BAR; PG8_SCHED;
            } else {
            PG8_LDB(B0, 0, 0); PG8_SCHED; PG8_LDA(At, 0, 0); PG8_STAGE(PG8_SA(1, 1), a1 + hstep, voffA);
            PG8_WAIT_L(8); PG8_BAR; PG8_WAIT_L(0); PG8_MMA(0, 0, At, B0); PG8_BAR; PG8_SCHED;
            PG8_LDB(B1, 0, 1); PG8_STAGE(PG8_SB(0, 0), b2, voffB);
            PG8_BAR; PG8_WAIT_L(0); PG8_MMA(0, 1, At, B1); PG8_BAR;
            PG8_LDA(At, 0, 1); PG8_STAGE(PG8_SA(0, 0), a2, voffA);
            PG8_BAR; PG8_WAIT_L(0); PG8_MMA(1, 0, At, B0); PG8_BAR; PG8_SCHED;
            PG8_STAGE(PG8_SB(0, 1), b2 + hstep, voffB);
            PG8_WAIT_V(6); PG8_BAR; PG8_MMA(1, 1, At, B1); PG8_BAR;
            PG8_LDB(B0, 1, 0); PG8_SCHED; PG8_LDA(At, 1, 0); PG8_STAGE(PG8_SA(0, 1), a2 + hstep, voffA);
            PG8_WAIT_L(8); PG8_BAR; PG8_WAIT_L(0); PG8_MMA(0, 0, At, B0); PG8_BAR; PG8_SCHED;
            PG8_LDB(B1, 1, 1); PG8_STAGE(PG8_SB(1, 0), b3, voffB);
            PG8_BAR; PG8_WAIT_L(0); PG8_MMA(0, 1, At, B1); PG8_BAR;
            PG8_LDA(At, 1, 1); PG8_STAGE(PG8_SA(1, 0), a3, voffA);
            PG8_BAR; PG8_WAIT_L(0); PG8_MMA(1, 0, At, B0); PG8_BAR; PG8_SCHED;
            PG8_STAGE(PG8_SB(1, 1), b3 + hstep, voffB);
            PG8_WAIT_V(6); PG8_BAR; PG8_MMA(1, 1, At, B1); PG8_BAR;
            }
        }
        if constexpr (ALIGN_EPI) { if (wr == 0) PG8_BAR; }
        if constexpr (!Epi::AFTER_DRAIN) { E(acc, cur, wr, wc, fr, fq); S.done(cur); }
        if (!has_next) break;
#pragma unroll
        for (int a = 0; a < 2; ++a)
#pragma unroll
            for (int b = 0; b < 2; ++b)
#pragma unroll
                for (int m = 0; m < 4; ++m)
#pragma unroll
                    for (int n = 0; n < 2; ++n) acc[a][b][m][n] = (f32x4){0.f, 0.f, 0.f, 0.f};
        cur = nxt; cA = nA; cB = nB; ++ui;
        if constexpr (ALIGN_EPI) { if (wr == 1) PG8_BAR; }
    }
    PG8_WAIT_V(0);
    if constexpr (!ALIGN_EPI) { if (wr == 0) PG8_BAR; }
    PG8_BAR;
    if constexpr (Epi::AFTER_DRAIN) { E.fused(acc, cur, wr, wc, fr, fq, lds, wid, lane); S.done(cur); }
#undef PG8_SA
#undef PG8_SB
#undef PG8_STAGE
#undef PG8_LDA
#undef PG8_LDB
#undef PG8_MMA
#undef PG8_WAIT_V
#undef PG8_WAIT_L
#undef PG8_BAR
#undef PG8_SCHED
}
}
#define GAS __attribute__((address_space(1)))
#define LAS __attribute__((address_space(3)))
typedef GAS unsigned gu32;
typedef GAS unsigned long long gu64;
#define RLX_AGENT __ATOMIC_RELAXED, __HIP_MEMORY_SCOPE_AGENT
#define LDS_WAIT() asm volatile("s_waitcnt lgkmcnt(0)" ::: "memory")
#define VM_WAIT() asm volatile("s_waitcnt vmcnt(0)" ::: "memory")
__device__ __forceinline__ unsigned long long rt() { return __builtin_amdgcn_s_memrealtime(); }
#define XB_TMO      128
#define XB_XCNT(j)  (256  + 64 * (j))
#define XB_XSUB(j)  (1280 + 64 * (j))
#define XB_XGEN(j)  (2304 + 64 * (j))
#define XB_TOP      3328
#define XB_TOPGEN   3392
#define XCD_BAR_WORDS 3456
#define XB_SPIN_CAP (1u << 18)

__device__ __forceinline__ unsigned xb_ld(unsigned* p)              { return __hip_atomic_load(p, __ATOMIC_RELAXED, __HIP_MEMORY_SCOPE_AGENT); }
__device__ __forceinline__ unsigned xb_add(unsigned* p, unsigned v) { return __hip_atomic_fetch_add(p, v, __ATOMIC_RELAXED, __HIP_MEMORY_SCOPE_AGENT); }
__device__ __forceinline__ unsigned xb_xcc_id() { return (unsigned)__builtin_amdgcn_s_getreg((3 << 11) | 20) & 0xFu; }
#define XB_SPIN(cond, bar) do { unsigned _sp = 0; while (cond) { __builtin_amdgcn_s_sleep(1); \
    if ((++_sp & 255u) == 0u) { if (xb_ld(&(bar)[XB_TMO])) break; if (_sp > XB_SPIN_CAP) { atomicAdd(&(bar)[XB_TMO], 1u); break; } } } } while (0)

struct XcdBarrier {
    unsigned* bar; unsigned x;
    volatile LAS unsigned* st;
};

__device__ __forceinline__ XcdBarrier xcd_barrier_post(unsigned* bar, volatile LAS unsigned* st) {
    XcdBarrier b; b.bar = bar; b.x = xb_xcc_id(); b.st = st;
    if (threadIdx.x == 0) (void)xb_add(&bar[XB_XCNT(b.x)], 1u);
    return b;
}
__device__ __forceinline__ void xcd_barrier_complete(unsigned* bar, unsigned x, unsigned& nloc, unsigned& nx) {
    const unsigned G = gridDim.x * gridDim.y * gridDim.z;
    unsigned sum, cnt, mine, sp = 0u;
    for (;;) {
        sum = 0u; cnt = 0u; mine = 0u;
#pragma unroll
        for (unsigned j = 0; j < 16; ++j) { const unsigned c = xb_ld(&bar[XB_XCNT(j)]); sum += c; cnt += (c > 0u) ? 1u : 0u; mine = (j == x) ? c : mine; }
        if (sum == G) break;
        __builtin_amdgcn_s_sleep(1);
        if ((++sp & 255u) == 0u) { if (xb_ld(&bar[XB_TMO])) break; if (sp > XB_SPIN_CAP) { atomicAdd(&bar[XB_TMO], 1u); break; } }
    }
    nloc = mine > 0u ? mine : 1u; nx = cnt > 0u ? cnt : 1u;
}

__device__ __forceinline__ void xcd_barrier(const XcdBarrier& b) {
    asm volatile("s_waitcnt vmcnt(0)" ::: "memory");
    __syncthreads();
    if (threadIdx.x == 0) {
        unsigned* bar = b.bar;
        __builtin_amdgcn_s_waitcnt(0);
        unsigned nloc = b.st[0], nx = b.st[1];
        if (nloc == 0u) { xcd_barrier_complete(bar, b.x, nloc, nx); b.st[0] = nloc; b.st[1] = nx; }
        const unsigned old = xb_add(&bar[XB_XSUB(b.x)], 1u);
        const unsigned gen = old / nloc;
        if (old + 1u == (gen + 1u) * nloc) {
            __builtin_amdgcn_fence(__ATOMIC_RELEASE, "agent");
            asm volatile("s_waitcnt vmcnt(0)" ::: "memory");
            const unsigned og = xb_add(&bar[XB_TOP], 1u);
            const unsigned tg = og / nx;
            if (og + 1u == (tg + 1u) * nx) xb_add(&bar[XB_TOPGEN], 1u);
            else XB_SPIN(xb_ld(&bar[XB_TOPGEN]) == tg, bar);
            __builtin_amdgcn_fence(__ATOMIC_ACQUIRE, "agent");
            xb_add(&bar[XB_XGEN(b.x)], 1u);
            asm volatile("s_waitcnt vmcnt(0)" ::: "memory");
        } else {
            XB_SPIN(xb_ld(&bar[XB_XGEN(b.x)]) == gen, bar);
            __builtin_amdgcn_fence(__ATOMIC_ACQUIRE, "agent");
            asm volatile("s_waitcnt vmcnt(0)" ::: "memory");
        }
    }
    __syncthreads();
}


constexpr int NB = 2, SEQ = 8192, DM = 1024, DEPTH = 4, NMETA = 16, LP = 8320, M = NB * LP;
constexpr int N_IN = 5384, N1 = 5376, NRW = 1792, NGT = 2048, DFF = 2816, NUP = 5632;
constexpr float LOG2E = 1.4426950408889634f;
constexpr float QSCALE = 0.125f * LOG2E;
constexpr float THR2 = 24.0f * LOG2E;
constexpr int NWAVES = 8, NTHR = 512, MMAIN = 16384;
constexpr int LDS_BYTES = 147456, MISC_OFF = 147456 - 128;

typedef unsigned short bf16;
typedef float f32x4 __attribute__((ext_vector_type(4)));
typedef unsigned u32x4 __attribute__((ext_vector_type(4)));
typedef unsigned u32x2 __attribute__((ext_vector_type(2)));
typedef short bf16x8 __attribute__((ext_vector_type(8)));

constexpr size_t SZ_H = (size_t)M * DM * 4, SZ_X512 = (size_t)M * 512 * 2;
constexpr size_t OFF_CTL = 0, OFF_H = 1u << 20, OFF_WT = OFF_H + SZ_H;
constexpr size_t WT_IN = 0, WT_BF = WT_IN + (size_t)N1 * 1024, WT_BR = WT_BF + 1024 * 512, WT_O = WT_BR + 1024 * 512,
                 WT_UP = WT_O + 1024 * 1024, WT_DN = WT_UP + (size_t)NUP * 1024, WT_LW = WT_DN + (size_t)1024 * DFF, WT_LA = WT_LW + 512 * 64, WT_LG = WT_LA + 512 * 64, WT_END = WT_LG + 512 * 128;
constexpr size_t OFF_HN = OFF_WT + WT_END * 2;
constexpr size_t OFF_Q = OFF_HN + 2 * SZ_X512, OFF_K = OFF_Q + SZ_X512, OFF_V = OFF_K + SZ_X512;
constexpr size_t OFF_RW = OFF_V + SZ_X512, OFF_GT = OFF_RW + (size_t)M * NRW * 2, OFF_MISC = OFF_GT + (size_t)M * NGT * 2;
constexpr size_t OFF_T0 = OFF_MISC + 2 * 16 * LP * 4, OFF_OF = OFF_T0 + 2 * SZ_X512, OFF_TAIL = OFF_OF + SZ_X512, WS_NEED = OFF_TAIL + 256 * 1024 * 2;
static_assert(OFF_HN % 256 == 0 && OFF_RW % 256 == 0 && OFF_T0 % 256 == 0, "alignment");

struct Params { const float* in[26]; float* out; unsigned char* ws; };
struct Ctx { int tid, lane, wave, bid, G; unsigned char* lds; unsigned char* ws; };

__device__ __forceinline__ float bf2f(unsigned b) { return __uint_as_float(b << 16); }
__device__ __forceinline__ float bflo(unsigned w) { return __uint_as_float(w << 16); }
__device__ __forceinline__ float bfhi(unsigned w) { return __uint_as_float(w & 0xffff0000u); }
typedef float f32x2_t_ __attribute__((ext_vector_type(2))); typedef __bf16 bf16x2_t_ __attribute__((ext_vector_type(2)));
__device__ __forceinline__ unsigned pk2(float lo, float hi) { const f32x2_t_ v = {lo, hi}; const bf16x2_t_ r = __builtin_convertvector(v, bf16x2_t_); return __builtin_bit_cast(unsigned, r); }
__device__ __forceinline__ unsigned f2bf(float f) { return pk2(f, 0.f) & 0xffffu; }
__device__ __forceinline__ float wave_sum(float v) {
#pragma unroll
    for (int o = 1; o < 64; o <<= 1) v += __shfl_xor(v, o);
    return v;
}
__device__ __forceinline__ float sigmoidf_(float x) { return __builtin_amdgcn_rcpf(1.f + __expf(-x)); }
template <int CTRL> __device__ __forceinline__ float dppf(float old, float x) {
    return __int_as_float(__builtin_amdgcn_update_dpp(__float_as_int(old), __float_as_int(x), CTRL, 0xf, 0xf, false));
}
__device__ __forceinline__ float allreduce16(float x) {
    x += dppf<0x121>(0.f, x); x += dppf<0x122>(0.f, x); x += dppf<0x124>(0.f, x); x += dppf<0x128>(0.f, x); return x;
}

namespace pg8 {
struct EpiRoute {
    static constexpr bool PERM = true, AFTER_DRAIN = false;
    unsigned char* ws;
    __device__ __forceinline__ void operator()(const f32x4 (&acc)[2][2][4][2], const Unit& u, int wr, int wc, int fr, int fq) const {
        const int pn = u.pn; size_t off; int ldc, colt;
        if (pn < 6) { off = OFF_Q + (size_t)(pn >> 1) * SZ_X512; ldc = 512; colt = (pn & 1) * 256; }
        else if (pn < 13) { off = OFF_RW; ldc = NRW; colt = (pn - 6) * 256; }
        else { off = OFF_GT; ldc = NGT; colt = (pn - 13) * 256; }
        bf16_t* base = (bf16_t*)(ws + off);
        const int row0 = u.pm * BM + wr * 64 + fr, col0 = colt + wc * 32 + 8 * fq;
#pragma unroll
        for (int ai = 0; ai < 2; ++ai)
#pragma unroll
            for (int m = 0; m < 4; ++m) { bf16_t* rowp = base + (size_t)(row0 + ai * HALF + m * 16) * ldc + col0;
#pragma unroll
                for (int bj = 0; bj < 2; ++bj) { const f32x4 v0 = acc[ai][bj][m][0], v1 = acc[ai][bj][m][1];
                    u32x4 w; w.x = cvt_pk_bf16(v0[0], v0[1]); w.y = cvt_pk_bf16(v0[2], v0[3]); w.z = cvt_pk_bf16(v1[0], v1[1]); w.w = cvt_pk_bf16(v1[2], v1[3]);
                    *(u32x4*)(rowp + bj * HALF) = w; } }
    }
};
struct EpiGateR {
    static constexpr bool PERM = true, AFTER_DRAIN = false;
    bf16_t* O; const bf16_t* GT; const float* gb; int goff, accum;
    __device__ __forceinline__ void operator()(const f32x4 (&acc)[2][2][4][2], const Unit& u, int wr, int wc, int fr, int fq) const {
        const int row0 = u.pm * BM + wr * 64 + fr, col0 = u.pn * BM + wc * 32 + 8 * fq;
#pragma unroll
        for (int bj = 0; bj < 2; ++bj) {
            const int c = col0 + bj * HALF;
            const f32x4 b0 = *(const f32x4*)(gb + goff + c), b1 = *(const f32x4*)(gb + goff + c + 4);
#pragma unroll
            for (int ai = 0; ai < 2; ++ai)
#pragma unroll
                for (int m = 0; m < 4; ++m) {
                    const size_t row = (size_t)(row0 + ai * HALF + m * 16);
                    const u32x4 gw = *(const u32x4*)(GT + row * NGT + goff + c);
                    const f32x4 v0 = acc[ai][bj][m][0], v1 = acc[ai][bj][m][1];
                    float r[8];
                    r[0] = sigmoidf_(bflo(gw.x) + b0[0]) * v0[0]; r[1] = sigmoidf_(bfhi(gw.x) + b0[1]) * v0[1];
                    r[2] = sigmoidf_(bflo(gw.y) + b0[2]) * v0[2]; r[3] = sigmoidf_(bfhi(gw.y) + b0[3]) * v0[3];
                    r[4] = sigmoidf_(bflo(gw.z) + b1[0]) * v1[0]; r[5] = sigmoidf_(bfhi(gw.z) + b1[1]) * v1[1];
                    r[6] = sigmoidf_(bflo(gw.w) + b1[2]) * v1[2]; r[7] = sigmoidf_(bfhi(gw.w) + b1[3]) * v1[3];
                    bf16_t* op = O + row * 1024 + c;
                    if (accum) { const u32x4 ow = *(const u32x4*)op;
                        r[0] += bflo(ow.x); r[1] += bfhi(ow.x); r[2] += bflo(ow.y); r[3] += bfhi(ow.y); r[4] += bflo(ow.z); r[5] += bfhi(ow.z); r[6] += bflo(ow.w); r[7] += bfhi(ow.w); }
                    u32x4 w; w.x = cvt_pk_bf16(r[0], r[1]); w.y = cvt_pk_bf16(r[2], r[3]); w.z = cvt_pk_bf16(r[4], r[5]); w.w = cvt_pk_bf16(r[6], r[7]);
                    *(u32x4*)op = w;
                }
        }
    }
};
struct EpiResid {
    static constexpr bool PERM = false, AFTER_DRAIN = false;
    float* H; float* OUT; int atomic;
    __device__ __forceinline__ void operator()(const f32x4 (&acc)[2][2][4][2], const Unit& u, int wr, int wc, int fr, int fq) const {
        const int row0 = u.pm * BM + wr * 64 + fr, col0 = u.pn * BM + wc * 32 + 4 * fq;
#pragma unroll
        for (int ai = 0; ai < 2; ++ai)
#pragma unroll
            for (int m = 0; m < 4; ++m) {
                const int row = row0 + ai * HALF + m * 16;
                float* hp = H + (size_t)row * DM + col0;
                const int b = row >= LP ? 1 : 0, t = row - b * LP;
                float* op = (OUT && t >= NMETA && t < NMETA + SEQ) ? OUT + ((size_t)b * SEQ + (t - NMETA)) * DM + col0 : nullptr;
#pragma unroll
                for (int bj = 0; bj < 2; ++bj)
#pragma unroll
                    for (int n = 0; n < 2; ++n) { const int co = bj * HALF + n * 16;
                        if (atomic) {
                            if (row < LP + NMETA + SEQ) {
#pragma unroll
                                for (int e = 0; e < 4; ++e) unsafeAtomicAdd(hp + co + e, acc[ai][bj][m][n][e]); }
                        } else {
                            const f32x4 v = *(const f32x4*)(hp + co) + acc[ai][bj][m][n];
                            if (OUT) { if (op) *(f32x4*)(op + co) = v; } else *(f32x4*)(hp + co) = v; } }
            }
    }
};
struct EpiResidAtomic {
    static constexpr bool PERM = false, AFTER_DRAIN = false;
    float* H;
    __device__ __forceinline__ void operator()(const f32x4 (&acc)[2][2][4][2], const Unit& u, int wr, int wc, int fr, int fq) const {
        const int row0 = u.pm * BM + wr * 64 + fr, col0 = u.pn * BM + wc * 32 + 4 * fq;
#pragma unroll
        for (int ai = 0; ai < 2; ++ai)
#pragma unroll
            for (int m = 0; m < 4; ++m) { float* hp = H + (size_t)(row0 + ai * HALF + m * 16) * DM + col0;
#pragma unroll
                for (int bj = 0; bj < 2; ++bj)
#pragma unroll
                    for (int n = 0; n < 2; ++n)
#pragma unroll
                        for (int e = 0; e < 4; ++e) unsafeAtomicAdd(hp + bj * HALF + n * 16 + e, acc[ai][bj][m][n][e]); }
    }
};
struct OneUnit {
    StaticOrder so; int mode, pm, pn; bool active;
    __device__ bool next(int i, Unit& u) const { if (mode == 0) return so.next(i, u); if (i != 0 || !active) return false; u.pm = pm; u.pn = pn; return true; }
    __device__ __forceinline__ void a_ready(const Unit&) const {}
    __device__ __forceinline__ void done(const Unit&) const {}
};
struct EpiUp {
    static constexpr bool PERM = true, AFTER_DRAIN = false;
    bf16_t* ACT; bf16_t* HALO; const float* cw;
    __device__ __forceinline__ void operator()(const f32x4 (&acc)[2][2][4][2], const Unit& u, int wr, int wc, int fr, int fq) const {
        const int chan0 = u.pn * 128 + wc * 32 + 8 * fq;
#pragma unroll
        for (int n = 0; n < 2; ++n) {
            const int ch = chan0 + 4 * n;
            f32x4 w[3][2];
#pragma unroll
            for (int j = 0; j < 3; ++j) { w[j][0] = *(const f32x4*)(cw + j * NUP + ch); w[j][1] = *(const f32x4*)(cw + j * NUP + DFF + ch); }
#pragma unroll
            for (int ai = 0; ai < 2; ++ai) {
                const int rowg = u.pm * BM + ai * HALF + wr * 64;
#pragma unroll
                for (int m = 0; m < 4; ++m) {
                    f32x4 uc[2];
#pragma unroll
                    for (int bj = 0; bj < 2; ++bj) {
                        const f32x4 cur = acc[ai][bj][m][n];
                        f32x4 prv; if (m > 0) prv = acc[ai][bj][m - 1][n]; else prv = (f32x4){0.f, 0.f, 0.f, 0.f};
                        f32x4 p1, p2;
#pragma unroll
                        for (int i = 0; i < 4; ++i) {
                            const float r1 = dppf<0x121>(0.f, prv[i]), r2 = dppf<0x122>(0.f, prv[i]);
                            p1[i] = dppf<0x111>(r1, cur[i]); p2[i] = dppf<0x112>(r2, cur[i]);
                        }
                        uc[bj] = w[0][bj] * p2 + w[1][bj] * p1 + w[2][bj] * cur;
                    }
                    float a[4];
#pragma unroll
                    for (int i = 0; i < 4; ++i) a[i] = uc[0][i] * sigmoidf_(uc[0][i]) * uc[1][i];
                    u32x2 o; o.x = cvt_pk_bf16(a[0], a[1]); o.y = cvt_pk_bf16(a[2], a[3]);
                    *(u32x2*)(ACT + (size_t)(rowg + m * 16 + fr) * DFF + ch) = o;
                    if ((m == 3 && fr >= 14) || (m == 0 && fr < 2)) {
                        const int slot = (rowg >> 6) * 4 + (m == 3 ? fr - 14 : 2 + fr);
#pragma unroll
                        for (int bj = 0; bj < 2; ++bj) { const f32x4 cur = acc[ai][bj][m][n]; u32x2 hw; hw.x = cvt_pk_bf16(cur[0], cur[1]); hw.y = cvt_pk_bf16(cur[2], cur[3]);
                            *(u32x2*)(HALO + (size_t)slot * NUP + bj * DFF + ch) = hw; }
                    }
                }
            }
        }
    }
};
}

#ifndef REP_PREP
#define REP_PREP 1
#endif
#ifndef REP_P3
#define REP_P3 1
#endif
#ifndef REP_SYNC
#define REP_SYNC 0
#endif
#define GLD(T, p) (*(const __attribute__((address_space(1))) T*)(p))
#define GST(T, p) (*(__attribute__((address_space(1))) T*)(p))
#define LDS_BARRIER() do { asm volatile("s_waitcnt lgkmcnt(0)" ::: "memory"); __builtin_amdgcn_s_barrier(); asm volatile("" ::: "memory"); } while (0)
__device__ __forceinline__ void transpose_item(const float* W, int Nsrc, int K, bf16* WT, int dst_row0, int src_col0, int k0, float* scr, int lane) {
#pragma unroll 8
    for (int i = 0; i < 32; ++i) { const int kk = 2 * i + (lane >> 5); scr[kk * 33 + (lane & 31)] = W[(size_t)(k0 + kk) * Nsrc + src_col0 + (lane & 31)]; }
    asm volatile("s_waitcnt lgkmcnt(0)" ::: "memory");
    const int c = lane & 7;
#pragma unroll
    for (int j = 0; j < 4; ++j) { const int n = (lane >> 3) + 8 * j; const float* s = scr + (8 * c) * 33 + n;
        u32x4 o; o.x = pk2(s[0 * 33], s[1 * 33]); o.y = pk2(s[2 * 33], s[3 * 33]); o.z = pk2(s[4 * 33], s[5 * 33]); o.w = pk2(s[6 * 33], s[7 * 33]);
        *(u32x4*)(WT + (size_t)(dst_row0 + n) * K + k0 + 8 * c) = o; }
    asm volatile("s_waitcnt lgkmcnt(0)" ::: "memory");
}
__device__ __forceinline__ void convert_weights(const Params& P, int l, const Ctx& c) {
    bf16* WT = (bf16*)(c.ws + OFF_WT);
    float* scr = (float*)(c.lds + c.wave * 16384);
    const int gw = c.bid * NWAVES + c.wave, NGW = c.G * NWAVES;
    constexpr int I_IN = 16 * 168, I_BF = 8 * 32, I_O = 16 * 32, I_UP = 16 * 176, I_DN = 44 * 32, I_LR = 16, I_LG = 32, I_ALL = I_IN + 2 * I_BF + I_O + I_UP + I_DN + 2 * I_LR + I_LG;
    for (int it = gw; it < I_ALL; it += NGW) {
        int r = it;
        if (r < I_IN) { const int kb = r / 168, n0 = 32 * (r % 168); transpose_item(P.in[4] + (size_t)l * 1024 * N_IN, N_IN, 1024, WT + WT_IN, n0, n0 + (n0 >= 1536 ? 8 : 0), 64 * kb, scr, c.lane); continue; } r -= I_IN;
        if (r < I_BF) { const int kb = r / 32, n0 = 32 * (r % 32); transpose_item(P.in[19] + (size_t)l * 512 * 1024, 1024, 512, WT + WT_BF, n0, n0, 64 * kb, scr, c.lane); continue; } r -= I_BF;
        if (r < I_BF) { const int kb = r / 32, n0 = 32 * (r % 32); transpose_item(P.in[20] + (size_t)l * 512 * 1024, 1024, 512, WT + WT_BR, n0, n0, 64 * kb, scr, c.lane); continue; } r -= I_BF;
        if (r < I_O) { const int kb = r / 32, n0 = 32 * (r % 32); transpose_item(P.in[22] + (size_t)l * 1024 * 1024, 1024, 1024, WT + WT_O, n0, n0, 64 * kb, scr, c.lane); continue; } r -= I_O;
        if (r < I_UP) { const int kb = r / 176, n0 = 32 * (r % 176); const int pn = n0 >> 8, bj = (n0 >> 7) & 1, x = n0 & 127;
            transpose_item(P.in[23] + (size_t)l * 1024 * NUP, NUP, 1024, WT + WT_UP, n0, bj * DFF + 128 * pn + x, 64 * kb, scr, c.lane); continue; } r -= I_UP;
        if (r < I_DN) { const int kb = r / 32, n0 = 32 * (r % 32); transpose_item(P.in[25] + (size_t)l * DFF * 1024, 1024, DFF, WT + WT_DN, n0, n0, 64 * kb, scr, c.lane); continue; } r -= I_DN;
        if (r < I_LR) { transpose_item(P.in[10] + (size_t)l * 64 * 512, 512, 64, WT + WT_LW, 32 * r, 32 * r, 0, scr, c.lane); continue; } r -= I_LR;
        if (r < I_LR) { transpose_item(P.in[12] + (size_t)l * 64 * 512, 512, 64, WT + WT_LA, 32 * r, 32 * r, 0, scr, c.lane); continue; } r -= I_LR;
        { const int kb = r / 16, n0 = 32 * (r % 16); transpose_item(P.in[13] + (size_t)l * 128 * 512, 512, 128, WT + WT_LG, n0, n0, 64 * kb, scr, c.lane); }
    }
}

template <bool FG> __device__ __forceinline__ void phase_norm(const Params& P, int l, const Ctx& c) {
    float* H = (float*)(c.ws + OFF_H); bf16* HN = (bf16*)(c.ws + OFF_HN);
    float* LOGF = (float*)(c.ws + OFF_MISC);
    const float* gain = (FG ? P.in[2] : P.in[3]) + l * DM;
    float* wfs = (float*)c.lds;
    if (FG) {
        __syncthreads();
        const float* win = P.in[4] + (size_t)l * 1024 * N_IN + 1536;
        for (int i = c.tid; i < 8192; i += NTHR) wfs[i] = win[(size_t)(i >> 3) * N_IN + (i & 7)];
        __syncthreads();
    }
    const int gw = c.bid * NWAVES + c.wave, NGW = c.G * NWAVES;
#define NORM_LOAD(mm, dst) do { const int b_ = (mm) >= LP ? 1 : 0, t_ = (mm) - b_ * LP; \
        if (FG && l == 0) { const float* src_ = (t_ < NMETA) ? P.in[1] + (size_t)t_ * DM : P.in[0] + ((size_t)b_ * SEQ + (t_ - NMETA)) * DM; const bool real_ = t_ < NMETA + SEQ; \
            _Pragma("unroll") for (int j_ = 0; j_ < 4; ++j_) dst[j_] = real_ ? *(const f32x4*)(src_ + 4 * c.lane + 256 * j_) : (f32x4){0.f, 0.f, 0.f, 0.f}; } \
        else { _Pragma("unroll") for (int j_ = 0; j_ < 4; ++j_) dst[j_] = *(const f32x4*)(H + (size_t)(mm) * DM + 4 * c.lane + 256 * j_); } } while (0)
    f32x4 nv[4];
    if (gw < M) NORM_LOAD(gw, nv);
    for (int m = gw; m < M; m += NGW) {
        const int b = m >= LP ? 1 : 0, t = m - b * LP;
        f32x4 v[4];
#pragma unroll
        for (int j = 0; j < 4; ++j) v[j] = nv[j];
        if (m + NGW < M) NORM_LOAD(m + NGW, nv);
        if (FG && l == 0) {
#pragma unroll
            for (int j = 0; j < 4; ++j) *(f32x4*)(H + (size_t)m * DM + 4 * c.lane + 256 * j) = v[j];
        }
        float ss = 0.f;
#pragma unroll
        for (int j = 0; j < 4; ++j) ss += (v[j].x * v[j].x + v[j].y * v[j].y) + (v[j].z * v[j].z + v[j].w * v[j].w);
        const float rstd = 1.0f / sqrtf(wave_sum(ss) * (1.f / DM) + 1e-6f);
        float f[8];
#pragma unroll
        for (int q = 0; q < 8; ++q) f[q] = 0.f;
#pragma unroll
        for (int j = 0; j < 4; ++j) {
            const f32x4 g = *(const f32x4*)(gain + 4 * c.lane + 256 * j);
            v[j] = v[j] * rstd * g;
            u32x2 o; o.x = pk2(v[j].x, v[j].y); o.y = pk2(v[j].z, v[j].w);
            *(u32x2*)(HN + (size_t)m * DM + 4 * c.lane + 256 * j) = o;
            if (FG) {
#pragma unroll
                for (int e = 0; e < 4; ++e) { const int k = 4 * c.lane + 256 * j + e; const f32x4 w0 = *(const f32x4*)(wfs + k * 8), w1 = *(const f32x4*)(wfs + k * 8 + 4);
                    const float hv = v[j][e];
                    f[0] += hv * w0.x; f[1] += hv * w0.y; f[2] += hv * w0.z; f[3] += hv * w0.w; f[4] += hv * w1.x; f[5] += hv * w1.y; f[6] += hv * w1.z; f[7] += hv * w1.w; }
            }
        }
        if (FG) {
#pragma unroll
            for (int q = 0; q < 8; ++q) f[q] = wave_sum(f[q]);
            float fv = f[0];
#pragma unroll
            for (int q = 1; q < 8; ++q) fv = (c.lane == q) ? f[q] : fv;
            if (c.lane < 8) { const float x = fv + P.in[7][l * 8 + c.lane]; const float ls = fminf(x, 0.f) - __logf(1.f + __expf(-fabsf(x))); LOGF[(size_t)(b * 8 + c.lane) * LP + t] = ls; }
        }
    }
}

__device__ __forceinline__ void phase_fcum(const Params& P, const Ctx& c) {
    const int s = c.bid - (c.G - 16);
    if (s < 0) return;
    const float* LOGF = (const float*)(c.ws + OFF_MISC) + (size_t)s * LP; float* FC = (float*)(c.ws + OFF_MISC) + 16 * LP + (size_t)s * LP;
    float* wt = (float*)c.lds;
    const int base = c.tid * 17;
    float v[17]; float run = 0.f;
#pragma unroll
    for (int i = 0; i < 17; ++i) { const int idx = base + i; const float x = (idx < LP) ? LOGF[idx] : 0.f; run += x; v[i] = run; }
    float incl = run;
#pragma unroll
    for (int o = 1; o < 64; o <<= 1) { const float t = __shfl_up(incl, o); if (c.lane >= o) incl += t; }
    if (c.lane == 63) wt[c.wave] = incl;
    __syncthreads();
    float off = incl - run;
#pragma unroll
    for (int w2 = 0; w2 < 8; ++w2) off += (w2 < c.wave) ? wt[w2] : 0.f;
#pragma unroll
    for (int i = 0; i < 17; ++i) { const int idx = base + i; if (idx < LP) FC[idx] = (v[i] + off) * LOG2E; }
    __syncthreads();
}

__device__ __forceinline__ void phase_qknorm(const Params& P, int l, const Ctx& c) {
    bf16* Q = (bf16*)(c.ws + OFF_Q); bf16* K = (bf16*)(c.ws + OFF_K);
    const int gw = c.bid * NWAVES + c.wave, NGW = c.G * NWAVES;
    const int d0 = (c.lane & 7) * 8;
    float gq[8], gk[8];
#pragma unroll
    for (int i = 0; i < 8; ++i) { gq[i] = P.in[5][l * 64 + d0 + i] * QSCALE; gk[i] = P.in[6][l * 64 + d0 + i]; }
    for (int m = gw; m < M; m += NGW) {
#pragma unroll
        for (int which = 0; which < 2; ++which) {
            bf16* p = (which ? K : Q) + (size_t)m * 512 + 8 * c.lane;
            const u32x4 w = *(const u32x4*)p;
            float x[8] = {bflo(w.x), bfhi(w.x), bflo(w.y), bfhi(w.y), bflo(w.z), bfhi(w.z), bflo(w.w), bfhi(w.w)};
            float ss = 0.f;
#pragma unroll
            for (int i = 0; i < 8; ++i) ss += x[i] * x[i];
            ss += __shfl_xor(ss, 1); ss += __shfl_xor(ss, 2); ss += __shfl_xor(ss, 4);
            const float rs = 1.0f / sqrtf(ss * (1.f / 64.f) + 1e-6f);
#pragma unroll
            for (int i = 0; i < 8; ++i) x[i] = x[i] * rs * (which ? gk[i] : gq[i]);
            u32x4 o; o.x = pk2(x[0], x[1]); o.y = pk2(x[2], x[3]); o.z = pk2(x[4], x[5]); o.w = pk2(x[6], x[7]);
            *(u32x4*)p = o;
        }
    }
}

constexpr int NCHK = LP / 64;
constexpr int NUNIT = NB * NCHK * 8;
constexpr int UNIT_A = 16384, UNIT_B = 16640;
constexpr int ST = 72, STG = 136;
constexpr int L_F0 = 92160, L_F1 = 108544, L_MU = 141312;
struct RwkvBufs { bf16 *BON, *G; unsigned char *UA, *UB; float* Y; bf16* ORW; };
__device__ __forceinline__ RwkvBufs rwkv_bufs(const Params& P, const Ctx& c) {
    RwkvBufs r; r.BON = (bf16*)(c.ws + OFF_HN); r.G = r.BON + (size_t)M * 512;
    r.UA = c.ws + OFF_T0; r.UB = (unsigned char*)P.out;
    r.Y = (float*)(c.ws + OFF_RW); r.ORW = (bf16*)(c.ws + OFF_RW + (size_t)M * 512 * 4);
    return r;
}
__device__ __forceinline__ void mm_tile(const bf16* A, int sa, const bf16* Bt, int sb, int nks, f32x4 (&acc)[2], int w, int lq, int g) {
    const int mt = w >> 1, nt0 = 2 * (w & 1);
    for (int ks = 0; ks < nks; ++ks) {
        const bf16x8 a = *(const bf16x8*)(A + (16 * mt + lq) * sa + 32 * ks + 8 * g);
#pragma unroll
        for (int q = 0; q < 2; ++q) { const bf16x8 b = *(const bf16x8*)(Bt + (16 * (nt0 + q) + lq) * sb + 32 * ks + 8 * g); acc[q] = __builtin_amdgcn_mfma_f32_16x16x32_bf16(a, b, acc[q], 0, 0, 0); }
    }
}
template <bool SA, bool SB> __device__ __forceinline__ void mm_tile2(const bf16* A, int sa, const bf16* Bt, int sb, int nks, f32x4 (&acc)[2], int w, int lq, int g) {
    const int mt = w >> 1, nt0 = 2 * (w & 1);
    const int ra = 16 * mt + lq, xa = SA ? 8 * ((ra >> 3) & 7) : 0;
    for (int ks = 0; ks < nks; ++ks) {
        const bf16x8 a = *(const bf16x8*)(A + ra * sa + ((32 * ks + 8 * g) ^ xa));
#pragma unroll
        for (int q = 0; q < 2; ++q) { const int rb = 16 * (nt0 + q) + lq, xb = SB ? 8 * ((rb >> 3) & 7) : 0;
            const bf16x8 bb = *(const bf16x8*)(Bt + rb * sb + ((32 * ks + 8 * g) ^ xb)); acc[q] = __builtin_amdgcn_mfma_f32_16x16x32_bf16(a, bb, acc[q], 0, 0, 0); }
    }
}
#define ZACC(a) do { a[0] = (f32x4){0.f, 0.f, 0.f, 0.f}; a[1] = (f32x4){0.f, 0.f, 0.f, 0.f}; } while (0)
__device__ __forceinline__ int permk(int k) { return 32 * (k >> 5) + 8 * ((k & 15) >> 2) + 4 * ((k >> 4) & 1) + (k & 3); }
__device__ __forceinline__ int swz(int row, int col) { return row * 128 + ((((col >> 3) ^ (row >> 1)) & 7) << 4) + (col & 7) * 2; }

__device__ __forceinline__ void rwkv_prep_unit(const Params& P, int l, const Ctx& c, int u, const RwkvBufs& B, const float (&pw0)[8], const float (&pa0)[8], const float (&pkk)[8], const float (&pka)[8], const float (&prk)[8], const u32x4 (&wlr)[4], u32x4 (&rc)[7], u32x4 (&rp)[7]) {
    const int h = u & 7, bc = u >> 3, b = bc / NCHK, ch = bc - b * NCHK;
    const size_t m0 = (size_t)b * LP + ch * 64;
    int tid_ = c.tid; asm volatile("" : "+v"(tid_));
    const int tid = tid_, lane = tid & 63, w = c.wave, lq = lane & 15, g = lane >> 4;
    const int t = tid >> 3, cg = tid & 7, c0 = cg * 8, jb = h * 64 + c0;
    unsigned char* L = c.lds;
    bf16* A0 = (bf16*)L; bf16* A1 = A0 + 4608; bf16* A2 = A1 + 4608; bf16* A3 = A2 + 4608; bf16* A4 = A3 + 4608; bf16* A5 = A4 + 4608; bf16* A6 = A5 + 4608;
    bf16* A7 = A6 + 4608; bf16* A8 = A7 + 4608; bf16* A9 = A8 + 4608;
    float* F0 = (float*)(L + L_F0); float* F1 = (float*)(L + L_F1);
    const bf16* RW = (const bf16*)(c.ws + OFF_RW);
    const bf16* WT = (const bf16*)(c.ws + OFF_WT);
    const float* mu = (const float*)(c.lds + L_MU);
    const bool first = (ch == 0 && t == 0);
    const bf16* cur = RW + (m0 + t) * NRW; const bf16* prv = cur - NRW;
    float zr[8], zk[8], zv[8];
#pragma unroll
    for (int s = 0; s < 3; ++s) {
        const u32x4 cw = rc[s]; u32x4 pw = (u32x4){0u, 0u, 0u, 0u}; if (!first) pw = rp[s];
        const float cv[8] = {bflo(cw.x), bfhi(cw.x), bflo(cw.y), bfhi(cw.y), bflo(cw.z), bfhi(cw.z), bflo(cw.w), bfhi(cw.w)};
        const float pv[8] = {bflo(pw.x), bfhi(pw.x), bflo(pw.y), bfhi(pw.y), bflo(pw.z), bfhi(pw.z), bflo(pw.w), bfhi(pw.w)};
#pragma unroll
        for (int i = 0; i < 8; ++i) { const float z = cv[i] + mu[s * 64 + c0 + i] * (pv[i] - cv[i]); if (s == 0) zr[i] = z; else if (s == 1) zk[i] = z; else zv[i] = z; }
    }
#pragma unroll
    for (int q4 = 0; q4 < 4; ++q4) {
        const int col = cg * 32 + q4 * 8;
        const u32x4 cw = rc[3 + q4]; u32x4 pw = (u32x4){0u, 0u, 0u, 0u}; if (!first) pw = rp[3 + q4];
        const float cv[8] = {bflo(cw.x), bfhi(cw.x), bflo(cw.y), bfhi(cw.y), bflo(cw.z), bfhi(cw.z), bflo(cw.w), bfhi(cw.w)};
        const float pv[8] = {bflo(pw.x), bfhi(pw.x), bflo(pw.y), bfhi(pw.y), bflo(pw.z), bfhi(pw.z), bflo(pw.w), bfhi(pw.w)};
        float z[8];
#pragma unroll
        for (int i = 0; i < 8; ++i) { z[i] = cv[i] + mu[192 + col + i] * (pv[i] - cv[i]); if (col < 64) z[i] = 1.f - 2.f / (1.f + __expf(2.f * z[i])); else if (col >= 128) z[i] = sigmoidf_(z[i]); }
        u32x4 o; o.x = pk2(z[0], z[1]); o.y = pk2(z[2], z[3]); o.z = pk2(z[4], z[5]); o.w = pk2(z[6], z[7]);
        bf16* dst = (col < 64) ? A0 + t * ST + col : (col < 128 ? A1 + t * ST + (col - 64) : A2 + t * STG + (col - 128));
        *(u32x4*)dst = o;
    }
    { const int un = u + c.G;
      if (un < NUNIT) { const int hn = un & 7, bcn = un >> 3, bn = bcn / NCHK, chn = bcn - bn * NCHK;
          const bf16* cn = RW + ((size_t)bn * LP + chn * 64 + t) * NRW; const bf16* pn = cn - NRW;
#pragma unroll
          for (int s = 0; s < 3; ++s) { rc[s] = GLD(u32x4, cn + s * 512 + hn * 64 + c0); rp[s] = GLD(u32x4, pn + s * 512 + hn * 64 + c0); }
#pragma unroll
          for (int q4 = 0; q4 < 4; ++q4) { rc[3 + q4] = GLD(u32x4, cn + 1536 + cg * 32 + q4 * 8); rp[3 + q4] = GLD(u32x4, pn + 1536 + cg * 32 + q4 * 8); } } }
    { const int row = tid >> 3, chk = tid & 7;
      *(u32x4*)(A4 + row * ST + chk * 8) = wlr[0];
      *(u32x4*)(A5 + row * ST + chk * 8) = wlr[1];
#pragma unroll
      for (int i = 0; i < 2; ++i) { const int idx = tid + 512 * i, r2 = idx >> 4, c2 = idx & 15;
          *(u32x4*)((bf16*)F1 + r2 * STG + c2 * 8) = wlr[2 + i]; } }
    LDS_BARRIER();
    { f32x4 aw[2], aa[2], ag[2]; ZACC(aw); ZACC(aa); ZACC(ag);
      mm_tile(A4, ST, A0, ST, 2, aw, w, lq, g); mm_tile(A5, ST, A1, ST, 2, aa, w, lq, g); mm_tile((const bf16*)F1, STG, A2, STG, 4, ag, w, lq, g);
      const int mt = w >> 1, nt0 = 2 * (w & 1);
#pragma unroll
      for (int q = 0; q < 2; ++q) { const int o = (16 * (nt0 + q) + lq) * ST + 16 * mt + 4 * g; u32x2 p;
          p.x = pk2(aw[q][0], aw[q][1]); p.y = pk2(aw[q][2], aw[q][3]); *(u32x2*)(A7 + o) = p;
          p.x = pk2(aa[q][0], aa[q][1]); p.y = pk2(aa[q][2], aa[q][3]); *(u32x2*)(A8 + o) = p;
          p.x = pk2(ag[q][0], ag[q][1]); p.y = pk2(ag[q][2], ag[q][3]); *(u32x2*)(A9 + o) = p; } }
    LDS_BARRIER();
    float kk[8], k2[8], ar[8];
    { const u32x4 lw = *(const u32x4*)(A7 + t * ST + c0), la = *(const u32x4*)(A8 + t * ST + c0), lg = *(const u32x4*)(A9 + t * ST + c0);
      const float fw[8] = {bflo(lw.x), bfhi(lw.x), bflo(lw.y), bfhi(lw.y), bflo(lw.z), bfhi(lw.z), bflo(lw.w), bfhi(lw.w)};
      const float fa[8] = {bflo(la.x), bfhi(la.x), bflo(la.y), bfhi(la.y), bflo(la.z), bfhi(la.z), bflo(la.w), bfhi(la.w)};
      float ss = 0.f, bs = 0.f;
#pragma unroll
      for (int i = 0; i < 8; ++i) {
          const float xw = -(pw0[i] + fw[i]); const float sp = fmaxf(xw, 0.f) + __logf(1.f + __expf(-fabsf(xw)));
          F0[t * 64 + c0 + i] = __expf(-sp - 0.5f);
          ar[i] = sigmoidf_(pa0[i] + fa[i]);
          kk[i] = zk[i] * pkk[i]; ss += kk[i] * kk[i];
          k2[i] = zk[i] * (1.f + (ar[i] - 1.f) * pka[i]);
          bs += zr[i] * k2[i] * prk[i]; }
      ss += __shfl_xor(ss, 1); ss += __shfl_xor(ss, 2); ss += __shfl_xor(ss, 4);
      bs += __shfl_xor(bs, 1); bs += __shfl_xor(bs, 2); bs += __shfl_xor(bs, 4);
      const float inv = 1.0f / fmaxf(sqrtf(ss), 1e-12f);
#pragma unroll
      for (int i = 0; i < 8; ++i) kk[i] *= inv;
      u32x4 bo; bo.x = pk2(bs * zv[0], bs * zv[1]); bo.y = pk2(bs * zv[2], bs * zv[3]); bo.z = pk2(bs * zv[4], bs * zv[5]); bo.w = pk2(bs * zv[6], bs * zv[7]);
      *(u32x4*)(B.BON + (m0 + t) * 512 + jb) = bo; *(u32x4*)(B.G + (m0 + t) * 512 + jb) = lg; }
    LDS_BARRIER();
    {
      const int k = tid & 63, sg = tid >> 6; float e[8], run = 0.f;
#pragma unroll
      for (int s = 0; s < 8; ++s) { run += F0[(8 * sg + s) * 64 + k]; e[s] = run; }
      F1[sg * 64 + k] = run;
      LDS_BARRIER();
      float off = 0.f;
#pragma unroll
      for (int s = 0; s < 8; ++s) off += (s < sg) ? F1[s * 64 + k] : 0.f;
#pragma unroll
      for (int s = 0; s < 8; ++s) F0[(8 * sg + s) * 64 + k] = e[s] + off; }
    LDS_BARRIER();
    { float ct[8], cp[8], cC[8];
#pragma unroll
      for (int i = 0; i < 8; ++i) { ct[i] = F0[t * 64 + c0 + i]; cp[i] = (t > 0) ? F0[(t - 1) * 64 + c0 + i] : 0.f; cC[i] = F0[63 * 64 + c0 + i]; }
      float at[8], bt[8], kt[8], rt[8], bh[8], kh[8];
#pragma unroll
      for (int i = 0; i < 8; ++i) { const float gt = __expf(-ct[i]), igt = __expf(ct[i]), gp = __expf(-cp[i]), gct = __expf(ct[i] - cC[i]);
          at[i] = -kk[i] * gp; bt[i] = kk[i] * ar[i] * igt; kt[i] = k2[i] * igt; rt[i] = zr[i] * gt; bh[i] = kk[i] * ar[i] * gct; kh[i] = k2[i] * gct; }
      u32x4 o;
      o.x = pk2(at[0], at[1]); o.y = pk2(at[2], at[3]); o.z = pk2(at[4], at[5]); o.w = pk2(at[6], at[7]); *(u32x4*)(A0 + t * ST + c0) = o;
      o.x = pk2(bt[0], bt[1]); o.y = pk2(bt[2], bt[3]); o.z = pk2(bt[4], bt[5]); o.w = pk2(bt[6], bt[7]); *(u32x4*)(A1 + t * ST + c0) = o;
      o.x = pk2(kt[0], kt[1]); o.y = pk2(kt[2], kt[3]); o.z = pk2(kt[4], kt[5]); o.w = pk2(kt[6], kt[7]); *(u32x4*)(A2 + t * ST + c0) = o;
      o.x = pk2(rt[0], rt[1]); o.y = pk2(rt[2], rt[3]); o.z = pk2(rt[4], rt[5]); o.w = pk2(rt[6], rt[7]); *(u32x4*)(A3 + t * ST + c0) = o;
#pragma unroll
      for (int i = 0; i < 8; ++i) { const int o = (c0 + i) * ST + (t ^ c0);
          A4[o] = (bf16)f2bf(bh[i]); A5[o] = (bf16)f2bf(kh[i]); A6[o] = (bf16)f2bf(zv[i]); F1[t * 128 + c0 + i] = at[i]; }
      if (t == 63) { float* gc = (float*)(B.UB + (size_t)u * UNIT_B + 16384) + c0;
#pragma unroll
          for (int i = 0; i < 8; ++i) gc[i] = __expf(-cC[i]); } }
    LDS_BARRIER();
    { const int mt = w >> 1, nt0 = 2 * (w & 1);
      f32x4 a[2];
      ZACC(a); mm_tile(A0, ST, A1, ST, 2, a, w, lq, g);
#pragma unroll
      for (int q = 0; q < 2; ++q) { const int i = 16 * (nt0 + q) + lq; f32x4 lab;
#pragma unroll
          for (int j = 0; j < 4; ++j) lab[j] = (i < 16 * mt + 4 * g + j) ? a[q][j] : 0.f;
#pragma unroll
          for (int j = 0; j < 4; ++j) F0[i * 64 + j * 16 + 4 * mt + g] = lab[j]; }
      asm volatile("" ::: "memory");
#define ST1_STORE(DST, INCL) do { _Pragma("unroll") for (int q = 0; q < 2; ++q) { const int tt = 16 * (nt0 + q) + lq, i0 = 16 * mt + 4 * g; float v_[4]; \
          _Pragma("unroll") for (int j = 0; j < 4; ++j) v_[j] = (i0 + j < tt + (INCL)) ? a[q][j] : 0.f; \
          u32x2 p_; p_.x = pk2(v_[0], v_[1]); p_.y = pk2(v_[2], v_[3]); *(u32x2*)((DST) + tt * ST + i0) = p_; } } while (0)
      ZACC(a); mm_tile(A2, ST, A0, ST, 2, a, w, lq, g); ST1_STORE(A7, 0); asm volatile("" ::: "memory");
      ZACC(a); mm_tile(A1, ST, A3, ST, 2, a, w, lq, g); ST1_STORE(A8, 1); asm volatile("" ::: "memory");
      ZACC(a); mm_tile(A2, ST, A3, ST, 2, a, w, lq, g); ST1_STORE(A9, 1);
#undef ST1_STORE
    }
    LDS_BARRIER();
    { const int mt = w >> 1, nt0 = 2 * (w & 1); f32x4 a[2]; ZACC(a);
      mm_tile2<true, false>(A6, ST, A7, ST, 2, a, w, lq, g);
#pragma unroll
      for (int q = 0; q < 2; ++q) *(f32x4*)(F1 + (16 * (nt0 + q) + lq) * 128 + 64 + 16 * mt + 4 * g) = a[q]; }
    LDS_BARRIER();
    { float X[16];
      const int col = 16 * w + lq;
#pragma unroll
      for (int r = 0; r < 16; ++r) X[r] = F1[(4 * r + g) * 128 + col];
      LDS_BARRIER();
      f32x4 Lc[4];
#pragma unroll
      for (int q = 0; q < 4; ++q) Lc[q] = *(const f32x4*)(F0 + g * 16 + 4 * q);
#pragma unroll
      for (int i = 0; i < 64; ++i) {
          const float xi = __shfl(X[i >> 2], (i & 3) * 16 + lq);
          f32x4 Ln[4];
#pragma unroll
          for (int q = 0; q < 4; ++q) Ln[q] = Lc[q];
          if (i + 1 < 64) {
#pragma unroll
              for (int q = ((i + 1) >> 4); q < 4; ++q) Ln[q] = *(const f32x4*)(F0 + (i + 1) * 64 + g * 16 + 4 * q);
          }
#pragma unroll
          for (int r = (i >> 2); r < 16; ++r) X[r] += Lc[r >> 2][r & 3] * xi;
#pragma unroll
          for (int q = 0; q < 4; ++q) Lc[q] = Ln[q];
          __builtin_amdgcn_sched_barrier(0);
      }
      bf16* XT = (bf16*)F1 + (w >> 2) * 4608 + ((col & 63) * ST);
#pragma unroll
      for (int r = 0; r < 16; ++r) XT[4 * r + g] = (bf16)f2bf(X[r]); }
    LDS_BARRIER();
    { const int mt = w >> 1, nt0 = 2 * (w & 1);
      const bf16* AhT = (const bf16*)F1; const bf16* W2T = AhT + 4608;
      unsigned char* ua = B.UA + (size_t)u * UNIT_A; unsigned char* ub = B.UB + (size_t)u * UNIT_B;
      const int p0 = 32 * (mt >> 1) + 8 * g + 4 * (mt & 1);
      f32x4 a[2];
      ZACC(a); mm_tile2<false, true>(AhT, ST, A4, ST, 2, a, w, lq, g);
#pragma unroll
      for (int q = 0; q < 2; ++q) { const int k = 16 * (nt0 + q) + lq; u32x2 o; o.x = pk2(a[q][0], a[q][1]); o.y = pk2(a[q][2], a[q][3]); *(u32x2*)(ua + swz(k, p0)) = o; }
      ZACC(a); mm_tile(AhT, ST, A8, ST, 2, a, w, lq, g);
#pragma unroll
      for (int q = 0; q < 2; ++q) { const int tt = 16 * (nt0 + q) + lq; const u32x2 rr = *(const u32x2*)(A3 + tt * ST + 16 * mt + 4 * g);
          u32x2 o; o.x = pk2(a[q][0] + bflo(rr.x), a[q][1] + bfhi(rr.x)); o.y = pk2(a[q][2] + bflo(rr.y), a[q][3] + bfhi(rr.y)); *(u32x2*)(ua + 8192 + swz(tt, p0)) = o; }
      ZACC(a); mm_tile2<true, false>(A4, ST, W2T, ST, 2, a, w, lq, g); mm_tile2<true, true>(A5, ST, A6, ST, 2, a, w, lq, g);
#pragma unroll
      for (int q = 0; q < 2; ++q) { const int v = 16 * (nt0 + q) + lq, k0 = 16 * mt + 4 * g; u32x2 o; o.x = pk2(a[q][0], a[q][1]); o.y = pk2(a[q][2], a[q][3]); *(u32x2*)(ub + swz(v, k0)) = o; }
      ZACC(a); mm_tile(A8, ST, W2T, ST, 2, a, w, lq, g); mm_tile2<false, true>(A9, ST, A6, ST, 2, a, w, lq, g);
#pragma unroll
      for (int q = 0; q < 2; ++q) { const int v = 16 * (nt0 + q) + lq, t0 = 16 * mt + 4 * g; u32x2 o; o.x = pk2(a[q][0], a[q][1]); o.y = pk2(a[q][2], a[q][3]); *(u32x2*)(ub + 8192 + swz(v, t0)) = o; } }
    LDS_BARRIER();
}
__device__ __forceinline__ void phase_rwkv_prep(const Params& P, int l, const Ctx& c) {
    const RwkvBufs B = rwkv_bufs(P, c);
    float pw0[8], pa0[8], pkk[8], pka[8], prk[8]; int hprev = -1;
    u32x4 wlr[4];
    u32x4 rc[7], rp[7];
    if (c.bid < NUNIT) { const int u0 = c.bid, h0 = u0 & 7, bc0 = u0 >> 3, b0 = bc0 / NCHK, ch0 = bc0 - b0 * NCHK, t0 = c.tid >> 3, cg0 = c.tid & 7;
        const bf16* cn = (const bf16*)(c.ws + OFF_RW) + ((size_t)b0 * LP + ch0 * 64 + t0) * NRW; const bf16* pn = cn - NRW;
#pragma unroll
        for (int s = 0; s < 3; ++s) { rc[s] = GLD(u32x4, cn + s * 512 + h0 * 64 + cg0 * 8); rp[s] = GLD(u32x4, pn + s * 512 + h0 * 64 + cg0 * 8); }
#pragma unroll
        for (int q4 = 0; q4 < 4; ++q4) { rc[3 + q4] = GLD(u32x4, cn + 1536 + cg0 * 32 + q4 * 8); rp[3 + q4] = GLD(u32x4, pn + 1536 + cg0 * 32 + q4 * 8); } }
    for (int u = c.bid; u < NUNIT; u += c.G) {
        const int h = u & 7;
        if (h != hprev) {
            __syncthreads();
            if (c.tid < 448) { const int i = c.tid; ((float*)(c.lds + L_MU))[i] = (i < 192) ? P.in[8][l * NRW + (i >> 6) * 512 + h * 64 + (i & 63)] : P.in[8][l * NRW + 1536 + (i - 192)]; }
            __syncthreads(); }
        if (h != hprev) { hprev = h; const int j0 = l * 512 + h * 64 + (c.tid & 7) * 8;
#pragma unroll
            for (int i = 0; i < 8; ++i) { pw0[i] = P.in[9][j0 + i]; pa0[i] = P.in[11][j0 + i]; pkk[i] = P.in[14][j0 + i]; pka[i] = P.in[15][j0 + i]; prk[i] = P.in[16][j0 + i]; }
            { const bf16* WTp = (const bf16*)(c.ws + OFF_WT); const int row = c.tid >> 3, chk = c.tid & 7;
              wlr[0] = *(const u32x4*)(WTp + WT_LW + (size_t)(h * 64 + row) * 64 + chk * 8); wlr[1] = *(const u32x4*)(WTp + WT_LA + (size_t)(h * 64 + row) * 64 + chk * 8);
#pragma unroll
              for (int i = 0; i < 2; ++i) { const int idx = c.tid + 512 * i, r2 = idx >> 4, c2 = idx & 15; wlr[2 + i] = *(const u32x4*)(WTp + WT_LG + (size_t)(h * 64 + r2) * 128 + c2 * 8); } } }
        rwkv_prep_unit(P, l, c, u, B, pw0, pa0, pkk, pka, prk, wlr, rc, rp);
    }
}

constexpr int SLOTB = 33280, YST = 68;
__device__ __forceinline__ void scan_chunked(const Params& P, const Ctx& c, int bh) {
    const RwkvBufs B = rwkv_bufs(P, c);
    const int b = bh >> 3, h = bh & 7, w = c.wave, lane = c.lane, lq = lane & 15, g = lane >> 4;
    const size_t rowb = (size_t)b * LP;
    const int ll = c.tid;
    unsigned char* L = c.lds;
    f32x4 st[4];
#pragma unroll
    for (int i = 0; i < 4; ++i) st[i] = (f32x4){0.f, 0.f, 0.f, 0.f};
    u32x4 r0[5], r1[5], r2[5], r3[5], r4[5];
#define SC_UNIT(cc) ((size_t)((b * NCHK + (cc)) * 8 + h))
#define SC_LOAD(R, cc) do { const unsigned char* pa_ = B.UA + SC_UNIT(cc) * UNIT_A; const unsigned char* pb_ = B.UB + SC_UNIT(cc) * UNIT_B; \
        _Pragma("unroll") for (int i_ = 0; i_ < 2; ++i_) { R[i_] = GLD(u32x4, pa_ + (ll + 512 * i_) * 16); R[2 + i_] = GLD(u32x4, pb_ + (ll + 512 * i_) * 16); } \
        if (ll < 16) R[4] = GLD(u32x4, pb_ + 16384 + ll * 16); } while (0)
#define SC_WRITE(R, slot) do { unsigned char* s_ = L + (slot) * SLOTB; \
        _Pragma("unroll") for (int i_ = 0; i_ < 2; ++i_) { *(u32x4*)(s_ + (ll + 512 * i_) * 16) = R[i_]; *(u32x4*)(s_ + 16384 + (ll + 512 * i_) * 16) = R[2 + i_]; } \
        if (ll < 16) *(u32x4*)(s_ + 32768 + ll * 16) = R[4]; } while (0)
#define SC_COMPUTE(ci) do { \
        const unsigned char* sl = L + ((ci) % 3) * SLOTB; \
        const int vcol = 16 * w + lq; \
        bf16x8 gaf[4][2]; f32x4 gcf[4]; u32x2 d0f[4]; \
        _Pragma("unroll") for (int mt = 0; mt < 4; ++mt) { \
            gcf[mt] = *(const f32x4*)(sl + 32768 + (16 * mt + 4 * g) * 4); \
            d0f[mt] = *(const u32x2*)(sl + 16384 + swz(vcol, 16 * mt + 4 * g)); \
            _Pragma("unroll") for (int ks = 0; ks < 2; ++ks) gaf[mt][ks] = *(const bf16x8*)(sl + swz(16 * mt + lq, 32 * ks + 8 * g)); } \
        __builtin_amdgcn_sched_barrier(0);        \
        bf16x8 sb[2]; \
        _Pragma("unroll") for (int ks = 0; ks < 2; ++ks) { u32x4 pw; pw.x = pk2(st[2 * ks][0], st[2 * ks][1]); pw.y = pk2(st[2 * ks][2], st[2 * ks][3]); pw.z = pk2(st[2 * ks + 1][0], st[2 * ks + 1][1]); pw.w = pk2(st[2 * ks + 1][2], st[2 * ks + 1][3]); \
            sb[ks] = __builtin_bit_cast(bf16x8, pw); } \
        _Pragma("unroll") for (int mt = 0; mt < 4; ++mt) { \
            f32x4 ns = (f32x4){bflo(d0f[mt].x), bfhi(d0f[mt].x), bflo(d0f[mt].y), bfhi(d0f[mt].y)} + gcf[mt] * st[mt]; \
            _Pragma("unroll") for (int ks = 0; ks < 2; ++ks) ns = __builtin_amdgcn_mfma_f32_16x16x32_bf16(gaf[mt][ks], sb[ks], ns, 0, 0, 0); \
            st[mt] = ns; } \
        bf16x8 rhf[4][2]; u32x2 y0f[4];        \
        _Pragma("unroll") for (int mt = 0; mt < 4; ++mt) { y0f[mt] = *(const u32x2*)(sl + 24576 + swz(vcol, 16 * mt + 4 * g)); \
            _Pragma("unroll") for (int ks = 0; ks < 2; ++ks) rhf[mt][ks] = *(const bf16x8*)(sl + 8192 + swz(16 * mt + lq, 32 * ks + 8 * g)); } \
        __builtin_amdgcn_sched_barrier(0); \
        f32x4 yav[4]; \
        _Pragma("unroll") for (int mt = 0; mt < 4; ++mt) { yav[mt] = (f32x4){bflo(y0f[mt].x), bfhi(y0f[mt].x), bflo(y0f[mt].y), bfhi(y0f[mt].y)}; \
            _Pragma("unroll") for (int ks = 0; ks < 2; ++ks) yav[mt] = __builtin_amdgcn_mfma_f32_16x16x32_bf16(rhf[mt][ks], sb[ks], yav[mt], 0, 0, 0); } \
        _Pragma("unroll") for (int mt = 0; mt < 4; ++mt) { \
            float* yl = (float*)(L + 3 * SLOTB) + ((ci) & 1) * (64 * YST) + (16 * mt + 4 * g) * YST + vcol; \
            _Pragma("unroll") for (int j = 0; j < 4; ++j) yl[j * YST] = yav[mt][j]; } } while (0)
#define SC_YSTORE(ci) do { const float* ys_ = (const float*)(L + 3 * SLOTB) + ((ci) & 1) * (64 * YST) + (c.tid >> 3) * YST + (c.tid & 7) * 8; \
        float* yg_ = B.Y + (rowb + (ci) * 64 + (c.tid >> 3)) * 512 + h * 64 + (c.tid & 7) * 8; \
        GST(f32x4, yg_) = *(const f32x4*)ys_; GST(f32x4, yg_ + 4) = *(const f32x4*)(ys_ + 4); } while (0)
#define SC_ITER(ci, R) do { if ((ci) + 2 < NCHK) SC_WRITE(R, ((ci) + 2) % 3); if ((ci) + 7 < NCHK) SC_LOAD(R, (ci) + 7); if ((ci) > 0) SC_YSTORE((ci) - 1); if (w < 4) { SC_COMPUTE(ci); } LDS_BARRIER(); } while (0)
    { SC_LOAD(r0, 0); SC_LOAD(r1, 1); SC_WRITE(r0, 0); SC_WRITE(r1, 1); SC_LOAD(r2, 2); SC_LOAD(r3, 3); SC_LOAD(r4, 4); SC_LOAD(r0, 5); SC_LOAD(r1, 6); }
    __syncthreads();
#pragma unroll 1
    for (int cc = 0; cc < NCHK; cc += 5) { SC_ITER(cc, r2); SC_ITER(cc + 1, r3); SC_ITER(cc + 2, r4); SC_ITER(cc + 3, r0); SC_ITER(cc + 4, r1); }
    SC_YSTORE(NCHK - 1);
#undef SC_YSTORE
#undef SC_COMPUTE
#undef SC_ITER
#undef SC_UNIT
#undef SC_LOAD
#undef SC_WRITE
}

__device__ __forceinline__ void phase_gn(const Params& P, int l, const Ctx& c) {
    const RwkvBufs B = rwkv_bufs(P, c);
    const int gw = c.bid * NWAVES + c.wave, NGW = c.G * NWAVES;
    const int c0 = 8 * c.lane;
    float gnw[8], gnb[8];
#pragma unroll
    for (int i = 0; i < 8; ++i) { gnw[i] = P.in[17][l * 512 + c0 + i]; gnb[i] = P.in[18][l * 512 + c0 + i]; }
    f32x4 ny0, ny1; u32x4 nbw, ngw;
#define GN_LOAD(mm) do { const size_t o_ = (size_t)(mm) * 512 + c0; ny0 = *(const f32x4*)(B.Y + o_); ny1 = *(const f32x4*)(B.Y + o_ + 4); nbw = *(const u32x4*)(B.BON + o_); ngw = *(const u32x4*)(B.G + o_); } while (0)
    if (gw < M) GN_LOAD(gw);
    for (int m = gw; m < M; m += NGW) {
        const size_t o = (size_t)m * 512 + c0;
        const f32x4 y0 = ny0, y1 = ny1; const u32x4 bw = nbw, gw4 = ngw;
        if (m + NGW < M) GN_LOAD(m + NGW);
        float y[8] = {y0.x, y0.y, y0.z, y0.w, y1.x, y1.y, y1.z, y1.w};
        const float bo[8] = {bflo(bw.x), bfhi(bw.x), bflo(bw.y), bfhi(bw.y), bflo(bw.z), bfhi(bw.z), bflo(bw.w), bfhi(bw.w)};
        const float gg[8] = {bflo(gw4.x), bfhi(gw4.x), bflo(gw4.y), bfhi(gw4.y), bflo(gw4.z), bfhi(gw4.z), bflo(gw4.w), bfhi(gw4.w)};
        float s = 0.f;
#pragma unroll
        for (int i = 0; i < 8; ++i) s += y[i];
        s += __shfl_xor(s, 1); s += __shfl_xor(s, 2); s += __shfl_xor(s, 4);
        const float mean = s * (1.f / 64.f);
        float q = 0.f;
#pragma unroll
        for (int i = 0; i < 8; ++i) { y[i] -= mean; q += y[i] * y[i]; }
        q += __shfl_xor(q, 1); q += __shfl_xor(q, 2); q += __shfl_xor(q, 4);
        const float rstd = 1.0f / sqrtf(q * (1.f / 64.f) + 64e-5f);
        float ov[8];
#pragma unroll
        for (int i = 0; i < 8; ++i) ov[i] = (y[i] * rstd * gnw[i] + gnb[i] + bo[i]) * gg[i];
        u32x4 ow; ow.x = pk2(ov[0], ov[1]); ow.y = pk2(ov[2], ov[3]); ow.z = pk2(ov[4], ov[5]); ow.w = pk2(ov[6], ov[7]);
        *(u32x4*)(B.ORW + o) = ow;
    }
}

__device__ __forceinline__ void attn_unit(const Ctx& c, int bh, int qb, const bf16* Q, const bf16* K, const bf16* V, bf16* O, const float* FC, float qkb2, const float* gq, const float* gk) {
    const int b = bh >> 3, h = bh & 7, lane = c.lane, w = c.wave, lq = lane & 15, g = lane >> 4;
    const int q0 = qb * 128;
    const size_t rowb = (size_t)b * LP;
    const int qrow = q0 + 16 * w + lq;
    bf16* Ks = (bf16*)c.lds; bf16* Vt = Ks + 64 * 72; float* fks = (float*)(Vt + 64 * 72);
    const bf16* qp = Q + (rowb + qrow) * 512 + h * 64 + 8 * g;
    bf16x8 qf0, qf1;
    { const u32x4 r0 = GLD(u32x4, qp), r1 = GLD(u32x4, qp + 32);
      float x[16] = {bflo(r0.x), bfhi(r0.x), bflo(r0.y), bfhi(r0.y), bflo(r0.z), bfhi(r0.z), bflo(r0.w), bfhi(r0.w), bflo(r1.x), bfhi(r1.x), bflo(r1.y), bfhi(r1.y), bflo(r1.z), bfhi(r1.z), bflo(r1.w), bfhi(r1.w)};
      float ss = 0.f;
#pragma unroll
      for (int i = 0; i < 16; ++i) ss += x[i] * x[i];
      ss += __shfl_xor(ss, 16); ss += __shfl_xor(ss, 32);
      const float rs = QSCALE / sqrtf(ss * (1.f / 64.f) + 1e-6f);
#pragma unroll
      for (int i = 0; i < 8; ++i) { x[i] *= rs * gq[8 * g + i]; x[8 + i] *= rs * gq[32 + 8 * g + i]; }
      u32x4 p0, p1; p0.x = pk2(x[0], x[1]); p0.y = pk2(x[2], x[3]); p0.z = pk2(x[4], x[5]); p0.w = pk2(x[6], x[7]); p1.x = pk2(x[8], x[9]); p1.y = pk2(x[10], x[11]); p1.z = pk2(x[12], x[13]); p1.w = pk2(x[14], x[15]);
      qf0 = __builtin_bit_cast(bf16x8, p0); qf1 = __builtin_bit_cast(bf16x8, p1); }
    const float* FCh = FC + (size_t)bh * LP;
    const float fq = GLD(float, FCh + qrow);
    float mrun = -1e30f, lsum = 0.f;
    f32x4 o[4];
#pragma unroll
    for (int i = 0; i < 4; ++i) o[i] = (f32x4){0.f, 0.f, 0.f, 0.f};
    const int kt_max = (q0 + 127) >> 6;
    const int lkey = c.tid >> 3, lch = c.tid & 7;
    float gkr[8];
#pragma unroll
    for (int i = 0; i < 8; ++i) gkr[i] = gk[lch * 8 + i];
    const size_t gbase = (rowb + lkey) * 512 + h * 64 + lch * 8;
    u32x4 kv = GLD(u32x4, K + gbase + (size_t)kt_max * 64 * 512), vv = GLD(u32x4, V + gbase + (size_t)kt_max * 64 * 512);
    float fkv = GLD(float, FCh + kt_max * 64 + (c.tid & 63));
    volatile unsigned* vote = (volatile unsigned*)(fks + 64);
    for (int kt = kt_max; kt >= 0; --kt) {
        const int k0 = kt * 64;
        LDS_BARRIER();
        { int can = 0; if (kt < kt_max) { const float fl = __shfl(fkv, 63); can = (qkb2 + fq - fl) < (mrun - THR2); }
          const int wall = __all(can); if (lane == 0) vote[w] = (unsigned)wall; }
        { { float x[8] = {bflo(kv.x), bfhi(kv.x), bflo(kv.y), bfhi(kv.y), bflo(kv.z), bfhi(kv.z), bflo(kv.w), bfhi(kv.w)}; float ss = 0.f;
#pragma unroll
              for (int i = 0; i < 8; ++i) ss += x[i] * x[i];
              ss += __shfl_xor(ss, 1); ss += __shfl_xor(ss, 2); ss += __shfl_xor(ss, 4);
              const float rs = 1.0f / sqrtf(ss * (1.f / 64.f) + 1e-6f);
              u32x4 kn; kn.x = pk2(x[0] * rs * gkr[0], x[1] * rs * gkr[1]); kn.y = pk2(x[2] * rs * gkr[2], x[3] * rs * gkr[3]); kn.z = pk2(x[4] * rs * gkr[4], x[5] * rs * gkr[5]); kn.w = pk2(x[6] * rs * gkr[6], x[7] * rs * gkr[7]);
              *(u32x4*)(Ks + lkey * 72 + lch * 8) = kn; }
            bf16* vd = Vt + (lch * 8) * 72 + (lkey ^ (8 * lch));
            vd[0] = (bf16)(vv.x & 0xffff); vd[72] = (bf16)(vv.x >> 16); vd[144] = (bf16)(vv.y & 0xffff); vd[216] = (bf16)(vv.y >> 16);
            vd[288] = (bf16)(vv.z & 0xffff); vd[360] = (bf16)(vv.z >> 16); vd[432] = (bf16)(vv.w & 0xffff); vd[504] = (bf16)(vv.w >> 16);
            if (c.tid < 64) fks[c.tid] = fkv;
            if (kt > 0) { kv = GLD(u32x4, K + gbase + (size_t)(k0 - 64) * 512); vv = GLD(u32x4, V + gbase + (size_t)(k0 - 64) * 512); fkv = GLD(float, FCh + k0 - 64 + (c.tid & 63)); } }
        LDS_BARRIER();
        { unsigned all = vote[0] & vote[1] & vote[2] & vote[3] & vote[4] & vote[5] & vote[6] & vote[7]; if (all) break; }
        if (k0 > q0 + 16 * w + 15) continue;
        f32x4 s[4];
#pragma unroll
        for (int nt = 0; nt < 4; ++nt) { const bf16* kp = Ks + (16 * nt + lq) * 72 + 8 * g; const bf16x8 a0 = *(const bf16x8*)kp, a1 = *(const bf16x8*)(kp + 32);
            s[nt] = __builtin_amdgcn_mfma_f32_16x16x32_bf16(a0, qf0, (f32x4){0.f, 0.f, 0.f, 0.f}, 0, 0, 0);
            s[nt] = __builtin_amdgcn_mfma_f32_16x16x32_bf16(a1, qf1, s[nt], 0, 0, 0); }
        float mx = -INFINITY;
#pragma unroll
        for (int nt = 0; nt < 4; ++nt) { const f32x4 fk = *(const f32x4*)(fks + 16 * nt + 4 * g);
#pragma unroll
            for (int j = 0; j < 4; ++j) { float x = s[nt][j] + fq - fk[j]; const int key = k0 + 16 * nt + 4 * g + j; if (key > qrow) x = -INFINITY; s[nt][j] = x; mx = fmaxf(mx, x); } }
        mx = fmaxf(mx, __shfl_xor(mx, 16)); mx = fmaxf(mx, __shfl_xor(mx, 32));
        const float mnew = fmaxf(mrun, mx), alpha = __builtin_amdgcn_exp2f(mrun - mnew); mrun = mnew;
        float psum = 0.f;
#pragma unroll
        for (int nt = 0; nt < 4; ++nt)
#pragma unroll
            for (int j = 0; j < 4; ++j) { const float p = __builtin_amdgcn_exp2f(s[nt][j] - mnew); s[nt][j] = p; psum += p; }
        lsum = lsum * alpha + psum;
#pragma unroll
        for (int dt = 0; dt < 4; ++dt) o[dt] = o[dt] * alpha;
        bf16x8 pb[2];
#pragma unroll
        for (int k2 = 0; k2 < 2; ++k2) { u32x4 pw; pw.x = pk2(s[2 * k2][0], s[2 * k2][1]); pw.y = pk2(s[2 * k2][2], s[2 * k2][3]); pw.z = pk2(s[2 * k2 + 1][0], s[2 * k2 + 1][1]); pw.w = pk2(s[2 * k2 + 1][2], s[2 * k2 + 1][3]);
            pb[k2] = __builtin_bit_cast(bf16x8, pw); }
#pragma unroll
        for (int dt = 0; dt < 4; ++dt)
#pragma unroll
            for (int k2 = 0; k2 < 2; ++k2) { const int vrow = 16 * dt + lq, vx = 8 * ((vrow >> 3) & 7); const bf16* vp = Vt + vrow * 72;
                const u32x2 lo = *(const u32x2*)(vp + ((32 * k2 + 4 * g) ^ vx)), hi = *(const u32x2*)(vp + ((32 * k2 + 16 + 4 * g) ^ vx));
                u32x4 aw; aw.x = lo.x; aw.y = lo.y; aw.z = hi.x; aw.w = hi.y;
                o[dt] = __builtin_amdgcn_mfma_f32_16x16x32_bf16(__builtin_bit_cast(bf16x8, aw), pb[k2], o[dt], 0, 0, 0); }
    }
    lsum += __shfl_xor(lsum, 16); lsum += __shfl_xor(lsum, 32);
    const float inv = 1.0f / lsum;
    bf16* op = O + (rowb + qrow) * 512 + h * 64 + 4 * g;
#pragma unroll
    for (int dt = 0; dt < 4; ++dt) { u32x2 ow; ow.x = pk2(o[dt][0] * inv, o[dt][1] * inv); ow.y = pk2(o[dt][2] * inv, o[dt][3] * inv); GST(u32x2, op + 16 * dt) = ow; }
    __syncthreads();
}
__device__ __forceinline__ void phase_attn(const Params& P, int l, const Ctx& c, int first_blk) {
    const bf16* Q = (const bf16*)(c.ws + OFF_Q); const bf16* K = (const bf16*)(c.ws + OFF_K); const bf16* V = (const bf16*)(c.ws + OFF_V);
    const float* FC = (const float*)(c.ws + OFF_MISC) + 16 * LP;
    float gqm = fabsf(P.in[5][l * 64 + c.lane]), gkm = fabsf(P.in[6][l * 64 + c.lane]);
#pragma unroll
    for (int o = 1; o < 64; o <<= 1) { gqm = fmaxf(gqm, __shfl_xor(gqm, o)); gkm = fmaxf(gkm, __shfl_xor(gkm, o)); }
    const float qkb2 = 8.0f * gqm * gkm * LOG2E * 1.03f;
    constexpr int NQB = LP / 128, NU = 16 * NQB;
    unsigned* ctr = (unsigned*)(c.ws + OFF_CTL) + 8192 + 64 * l;
    volatile unsigned* slot = (volatile unsigned*)(c.lds + MISC_OFF) + 4;
    for (;;) {
        __syncthreads();
        if (c.tid == 0) *slot = atomicAdd(ctr, 1u);
        __syncthreads();
        const int u = (int)*slot;
        if (u >= NU) break;
        const int bh = u & 15, qb = NQB - 1 - (u >> 4); attn_unit(c, bh, qb, Q, K, V, (bf16*)(c.ws + OFF_OF), FC, qkb2, P.in[5] + l * 64, P.in[6] + l * 64);
    }
}

__device__ __forceinline__ void phase_fixup(const Params& P, int l, const Ctx& c) {
    bf16* ACT = (bf16*)(c.ws + OFF_RW); const bf16* HALO = (const bf16*)(c.ws + OFF_Q);
    const float* cw = P.in[24] + (size_t)l * 3 * NUP;
    const int total = (M / 64) * 2 * DFF;
    for (int idx = c.bid * NTHR + c.tid; idx < total; idx += c.G * NTHR) {
        const int rr = idx / DFF, ch = idx - rr * DFF, q64 = rr >> 1, e = rr & 1, row = q64 * 64 + e;
        const int t = row % LP;
        int s0, s1, s2;
        if (e == 0) { s0 = q64 * 4 + 2; s1 = (q64 - 1) * 4 + 1; s2 = (q64 - 1) * 4 + 0; } else { s0 = q64 * 4 + 3; s1 = q64 * 4 + 2; s2 = (q64 - 1) * 4 + 1; }
        float uc[2];
#pragma unroll
        for (int bj = 0; bj < 2; ++bj) { const int col = bj * DFF + ch;
            const float u0 = bf2f(HALO[(size_t)s0 * NUP + col]);
            const float u1 = (t >= 1) ? bf2f(HALO[(size_t)s1 * NUP + col]) : 0.f;
            const float u2 = (t >= 2) ? bf2f(HALO[(size_t)s2 * NUP + col]) : 0.f;
            uc[bj] = cw[col] * u2 + cw[NUP + col] * u1 + cw[2 * NUP + col] * u0; }
        ACT[(size_t)row * DFF + ch] = (bf16)f2bf(uc[0] * sigmoidf_(uc[0]) * uc[1]);
    }
}

#define OPQ_S(x) asm volatile("" : "+s"(x))
#define OPQ_V(x) asm volatile("" : "+v"(x))
#define PHASE_BEGIN() do { int t_ = threadIdx.x; OPQ_V(t_); c.tid = t_; c.lane = t_ & 63; c.wave = __builtin_amdgcn_readfirstlane(t_ >> 6); int b_ = blockIdx.x; OPQ_S(b_); c.bid = b_; \
    size_t z_ = 0; OPQ_S(z_); unsigned char* w_ = P.ws + z_;   c.ws = w_; ws = w_; l = lc; OPQ_S(l); WT = (pg8::bf16_t*)(ws + OFF_WT); HN = (pg8::bf16_t*)(ws + OFF_HN); } while (0)
__global__ void __launch_bounds__(NTHR, 2) mega(Params P) {
    extern __shared__ __attribute__((aligned(16))) unsigned char lds[];
    Ctx c; c.G = gridDim.x; c.lds = lds;
    volatile LAS unsigned* MISC = (volatile LAS unsigned*)((LAS unsigned char*)lds + MISC_OFF);
    if (threadIdx.x < 16) MISC[threadIdx.x] = 0u;
    __syncthreads();
    (void)xcd_barrier_post((unsigned*)(P.ws + OFF_CTL) + 1024, MISC + 8);
#define SEAM() do { XcdBarrier xb_; xb_.bar = (unsigned*)(P.ws + OFF_CTL) + 1024; xb_.x = xb_xcc_id(); xb_.st = (volatile LAS unsigned*)((LAS unsigned char*)lds + MISC_OFF) + 8; xcd_barrier(xb_); } while (0)
    PG8_LAS unsigned char* ldsl = (PG8_LAS unsigned char*)lds;
    unsigned char* ws; pg8::bf16_t* WT; pg8::bf16_t* HN; int l;
#pragma unroll 1
    for (int lc = 0; lc < DEPTH; ++lc) {
        PHASE_BEGIN();
        convert_weights(P, l, c);
        phase_norm<true>(P, l, c);
        SEAM();
        if (P.out == nullptr) cg::this_grid().sync();
        PHASE_BEGIN();
        phase_fcum(P, c);
        { pg8::Gemm g{HN, WT + WT_IN, M, N1, 1024, 1024}; pg8::StaticOrder S; S.init(M, N1, c.G, c.bid);
          pg8::EpiRoute E{ws};
          pg8::gemm_phase<pg8::EpiRoute, pg8::StaticOrder, true, true>(ldsl, g, S, E); }
        SEAM();
        PHASE_BEGIN();
        for (int rep_ = 0; rep_ < REP_PREP; ++rep_) phase_rwkv_prep(P, l, c);
        SEAM();
        PHASE_BEGIN();
        if (c.bid < 16) { scan_chunked(P, c, c.bid); __syncthreads(); PHASE_BEGIN(); }
        phase_attn(P, l, c, 16);
#if REP_P3 > 1
        __syncthreads(); PHASE_BEGIN();
        if (c.bid < 16) scan_chunked(P, c, c.bid); else phase_attn(P, l, c, 16);
#endif
        SEAM();
        PHASE_BEGIN();
        phase_gn(P, l, c);
        for (int rep_ = 0; rep_ < REP_SYNC; ++rep_) SEAM();
        SEAM();
        PHASE_BEGIN();
#pragma unroll 1
        for (int pass = 0; pass < 3; ++pass) {
            if (pass) { __syncthreads(); PHASE_BEGIN(); }
            const int rw_side = pass == 2 ? ((c.bid >> 2) & 1) : pass;
            const pg8::bf16_t* A = rw_side ? (const pg8::bf16_t*)(ws + OFF_RW + (size_t)M * 512 * 4) : (const pg8::bf16_t*)(ws + OFF_OF);
            pg8::Gemm g{A, WT + (rw_side ? WT_BR : WT_BF), M, 1024, 512, 512};
            pg8::OneUnit S; S.so.init(MMAIN, 1024, c.G, c.bid); S.mode = pass == 2; S.pm = MMAIN / 256; S.pn = c.bid & 3; S.active = c.bid < 8;
            pg8::bf16_t* O = (pass == 2 && rw_side) ? (pg8::bf16_t*)(ws + OFF_TAIL) - (size_t)MMAIN * 1024 : (pg8::bf16_t*)(ws + OFF_K);
            pg8::EpiGateR E{O, (const pg8::bf16_t*)(ws + OFF_GT), P.in[21] + l * NGT, rw_side * 1024, pass == 1};
            pg8::gemm_phase<pg8::EpiGateR, pg8::OneUnit, true, true>(ldsl, g, S, E);
        }
        SEAM();
        PHASE_BEGIN();
#pragma unroll 1
        for (int pass = 0; pass < 2; ++pass) {
            if (pass) { __syncthreads(); PHASE_BEGIN(); }
            const int sl = pass ? (c.bid >> 2) : 0, ks = sl & 3;
            const pg8::bf16_t* A = (pass && sl >= 4) ? (const pg8::bf16_t*)(ws + OFF_TAIL) - (size_t)MMAIN * 1024 : (const pg8::bf16_t*)(ws + OFF_K);
            pg8::Gemm g{A + ks * 256, WT + WT_O + ks * 256, M, 1024, pass ? 256 : 1024, 1024};
            pg8::OneUnit S; S.so.init(MMAIN, 1024, c.G, c.bid); S.mode = pass; S.pm = MMAIN / 256; S.pn = c.bid & 3; S.active = sl < 8;
            pg8::EpiResid E{(float*)(ws + OFF_H), nullptr, pass};
            pg8::gemm_phase<pg8::EpiResid, pg8::OneUnit, true, true>(ldsl, g, S, E);
        }
        SEAM();
        PHASE_BEGIN();
        phase_norm<false>(P, l, c);
        SEAM();
        PHASE_BEGIN();
        { pg8::Gemm g{HN, WT + WT_UP, M, NUP, 1024, 1024}; pg8::StaticOrder S; S.init(M, NUP, c.G, c.bid);
          pg8::EpiUp E{(pg8::bf16_t*)(ws + OFF_RW), (pg8::bf16_t*)(ws + OFF_Q), P.in[24] + (size_t)l * 3 * NUP};
          pg8::gemm_phase<pg8::EpiUp, pg8::StaticOrder, true, true>(ldsl, g, S, E); }
        SEAM();
        PHASE_BEGIN();
        phase_fixup(P, l, c);
        SEAM();
        PHASE_BEGIN();
#pragma unroll 1
        for (int pass = 0; pass < 2; ++pass) {
            if (pass) { __syncthreads(); PHASE_BEGIN(); }
            const int sl = pass ? (c.bid >> 2) : 0;
            const int ko = (sl < 6) ? sl * 384 : 2304 + (sl - 6) * 256, kl = (sl < 6) ? 384 : 256;
            pg8::Gemm g{(const pg8::bf16_t*)(ws + OFF_RW) + (pass ? ko : 0), WT + WT_DN + (pass ? ko : 0), M, 1024, pass ? kl : DFF, DFF};
            pg8::OneUnit S; S.so.init(MMAIN, 1024, c.G, c.bid); S.mode = pass; S.pm = MMAIN / 256; S.pn = c.bid & 3; S.active = sl < 8;
            pg8::EpiResid E{(float*)(ws + OFF_H), (l == DEPTH - 1 && !pass) ? P.out : nullptr, pass};
            pg8::gemm_phase<pg8::EpiResid, pg8::OneUnit, true, true>(ldsl, g, S, E);
        }
        SEAM();
        if (l == DEPTH - 1) {
            PHASE_BEGIN();
            const float* H = (const float*)(ws + OFF_H);
            for (int idx = c.bid * NTHR + c.tid; idx < (NMETA + SEQ - (MMAIN - LP)) * (DM / 4); idx += c.G * NTHR) {
                const int r = idx / (DM / 4), q4 = idx - r * (DM / 4), t = (MMAIN - LP) + r;
                *(f32x4*)(P.out + ((size_t)SEQ + (t - NMETA)) * DM + 4 * q4) = *(const f32x4*)(H + (size_t)(LP + t) * DM + 4 * q4);
            }
        }
    }
}

extern "C" void kernel_launch(void* const* d_in, const int* in_sizes, int n_in, void* d_out, int out_size, void* d_ws, size_t ws_size, hipStream_t stream) {
    static int grid = 0;
    if (grid == 0) {
        if (n_in != 26 || out_size != NB * SEQ * DM || ws_size < WS_NEED) { fprintf(stderr, "kernel_launch: unexpected shapes (n_in %d out %d ws %zu need %zu)\n", n_in, out_size, ws_size, (size_t)WS_NEED); grid = -1; return; }
        int dev = 0, cus = 0, per_cu = 0;
        if (hipGetDevice(&dev) != hipSuccess || hipDeviceGetAttribute(&cus, hipDeviceAttributeMultiprocessorCount, dev) != hipSuccess) { grid = -1; return; }
        if (hipFuncSetAttribute((const void*)mega, hipFuncAttributeMaxDynamicSharedMemorySize, LDS_BYTES) != hipSuccess) { fprintf(stderr, "kernel_launch: hipFuncSetAttribute failed\n"); grid = -1; return; }
        if (hipOccupancyMaxActiveBlocksPerMultiprocessor(&per_cu, (const void*)mega, NTHR, LDS_BYTES) != hipSuccess || per_cu < 1) { fprintf(stderr, "kernel_launch: occupancy query says %d\n", per_cu); per_cu = 1; }
        (void)hipGetLastError();
        grid = cus;
    }
    if (grid < 0) return;
    if (hipMemsetAsync((char*)d_ws + OFF_CTL, 0, 65536, stream) != hipSuccess) { fprintf(stderr, "kernel_launch: memset failed\n"); return; }
    Params p{};
    for (int i = 0; i < 26; ++i) p.in[i] = (const float*)d_in[i];
    p.out = (float*)d_out; p.ws = (unsigned char*)d_ws;
    void* args[] = {&p};
    hipError_t e = hipLaunchCooperativeKernel((const void*)mega, dim3(grid), dim3(NTHR), args, LDS_BYTES, stream);
    if (e != hipSuccess) fprintf(stderr, "kernel_launch: cooperative launch failed: %s (grid %d)\n", hipGetErrorString(e), grid);
}
```

```cpp
#include <hip/hip_runtime.h>
#include <hip/hip_cooperative_groups.h>
#include <cstdio>
#include <cstdint>
#include <cmath>
namespace cg = cooperative_groups;
namespace pg8 {
#define PG8_LAS __attribute__((address_space(3)))
typedef unsigned short bf16_t;
typedef short bf16x8 __attribute__((ext_vector_type(8)));
typedef float f32x4 __attribute__((ext_vector_type(4)));
typedef unsigned u32x4 __attribute__((ext_vector_type(4)));
constexpr int BM = 256, BK = 64, HALF = 128, HTB = HALF * BK * 2  , STAGE_BYTES = 8 * HTB, NXCD = 8, WGM = 8;

__host__ __device__ __forceinline__ int lds_byte(int r, int c) { const int st = (r >> 4) * 2 + (c >> 5), rr = r & 15, cc = c & 31, ob = rr * 64 + cc * 2; return st * 1024 + (ob ^ (((ob >> 9) & 1) << 5)); }
__host__ __device__ __forceinline__ void stage_rc(int b, int& R, int& C) { const int st = b / 1024, sb = b % 1024, swz = sb ^ (((sb >> 9) & 1) << 5); R = (st >> 1) * 16 + swz / 64; C = (st & 1) * 32 + (swz % 64) / 2; }
__host__ __device__ __forceinline__ int perm32(int rho) { const int n = rho >> 4, i = rho & 15; return 8 * (i >> 2) + 4 * n + (i & 3); }

struct Unit { int pm, pn; };
struct Gemm { const bf16_t* A; const bf16_t* Bt; int M, N, K, ld; };

struct StaticOrder {
    int nM, nN, nwg, G, c;
    __host__ __device__ void init(int M, int N, int G_, int c_) { nM = M / BM; nN = N / BM; nwg = nM * nN; G = G_; c = c_; }
    __host__ __device__ bool next(int i, Unit& u) const {
        const long L = (long)i * G + c; if (L >= nwg) return false;
        int wgid = (int)L; { const int q = nwg / NXCD, r = nwg % NXCD, xcd = wgid % NXCD, off = wgid / NXCD; wgid = (xcd < r ? xcd * (q + 1) : r * (q + 1) + (xcd - r) * q) + off; }
        const int nig = WGM * nN, gid = wgid / nig, fm = gid * WGM, gsz = (nM - fm) < WGM ? (nM - fm) : WGM;
        u.pm = fm + ((wgid % nig) % gsz); u.pn = (wgid % nig) / gsz; return true;
    }
    __device__ __forceinline__ void a_ready(const Unit&) const {}
    __device__ __forceinline__ void done(const Unit&) const {}
};

__device__ __forceinline__ unsigned cvt_pk_bf16(float lo, float hi) { unsigned r; asm volatile("v_cvt_pk_bf16_f32 %0, %1, %2" : "=v"(r) : "v"(lo), "v"(hi)); return r; }
typedef float f32x2 __attribute__((ext_vector_type(2)));
template <class Epi, class Sched, bool ALIGN_EPI = false, bool SP2 = false>
__device__ __forceinline__ void gemm_phase(PG8_LAS unsigned char* lds, const Gemm g, const Sched& S, const Epi& E) {
    int tid_ = threadIdx.x; asm volatile("" : "+v"(tid_)); const int tid = tid_, wid = __builtin_amdgcn_readfirstlane(tid >> 6), lane = tid & 63, wr = wid >> 2, wc = wid & 3, fr = lane & 15, fq = lane >> 4;
    const int K = g.K, nt = K / BK, LD = g.ld;
    unsigned voffA[2], voffB[2];
#pragma unroll
    for (int i = 0; i < 2; ++i) { int R, C; stage_rc(tid * 16 + i * 8192, R, C); const int Rb = Epi::PERM ? ((R & ~31) + perm32(R & 31)) : R;
        voffA[i] = (unsigned)(R * LD + C) * 2u; voffB[i] = (unsigned)(Rb * LD + C) * 2u; }
    const size_t kstep = (size_t)(BK * 2);
    const size_t hstep = (size_t)HALF * LD * 2;
    const size_t tstep = 2 * hstep;
    const unsigned ldsw = (unsigned)wid * 1024u;
    const int aoff = lds_byte(wr * 64 + fr, fq * 8), boff = lds_byte(wc * 32 + fr, fq * 8);
#define PG8_SA(b, h) (((b) * 2 + (h)) * HTB)
#define PG8_SB(b, h) ((4 + (b) * 2 + (h)) * HTB)
#define PG8_STAGE(bufoff, gbase, voff) do { _Pragma("unroll") for (int _i = 0; _i < 2; ++_i) \
        __builtin_amdgcn_global_load_lds((const unsigned*)((const char*)(gbase) + (voff)[_i]), (PG8_LAS unsigned*)(lds + (bufoff) + ldsw + _i * 8192), 16, 0, 0); } while (0)
#define PG8_LDA(dst, b, h) do { _Pragma("unroll") for (int m = 0; m < 4; ++m) _Pragma("unroll") for (int k = 0; k < 2; ++k) dst[m][k] = *(const PG8_LAS bf16x8*)(lds + PG8_SA(b, h) + aoff + m * 2048 + k * 1024); } while (0)
#define PG8_LDB(dst, b, h) do { _Pragma("unroll") for (int n = 0; n < 2; ++n) _Pragma("unroll") for (int k = 0; k < 2; ++k) dst[n][k] = *(const PG8_LAS bf16x8*)(lds + PG8_SB(b, h) + boff + n * 2048 + k * 1024); } while (0)
#define PG8_MMA(ai, bj, At, Bt) do { __builtin_amdgcn_s_setprio(1); _Pragma("unroll") for (int m = 0; m < 4; ++m) _Pragma("unroll") for (int n = 0; n < 2; ++n) _Pragma("unroll") for (int k = 0; k < 2; ++k) \
        acc[ai][bj][m][n] = __builtin_amdgcn_mfma_f32_16x16x32_bf16(Bt[n][k], At[m][k], acc[ai][bj][m][n], 0, 0, 0); __builtin_amdgcn_s_setprio(0); } while (0)
#define PG8_WAIT_V(n) asm volatile("s_waitcnt vmcnt(" #n ")" ::: "memory")
#define PG8_WAIT_L(n) asm volatile("s_waitcnt lgkmcnt(" #n ")" ::: "memory")
#define PG8_BAR __builtin_amdgcn_s_barrier()
#define PG8_SCHED __builtin_amdgcn_sched_barrier(0)
    Unit cur, nxt; int ui = 0;
    if (!S.next(0, cur)) return;
    f32x4 acc[2][2][4][2];
#pragma unroll
    for (int a = 0; a < 2; ++a)
#pragma unroll
        for (int b = 0; b < 2; ++b)
#pragma unroll
            for (int m = 0; m < 4; ++m)
#pragma unroll
                for (int n = 0; n < 2; ++n) acc[a][b][m][n] = (f32x4){0.f, 0.f, 0.f, 0.f};
    bf16x8 At[4][2], B0[2][2], B1[2][2];
    const char* cA = (const char*)g.A + (size_t)cur.pm * tstep; const char* cB = (const char*)g.Bt + (size_t)cur.pn * tstep;
    S.a_ready(cur);
    if constexpr (SP2) {
        PG8_STAGE(PG8_SB(0, 0), cB, voffB); PG8_STAGE(PG8_SB(0, 1), cB + hstep, voffB); PG8_STAGE(PG8_SA(0, 0), cA, voffA); PG8_STAGE(PG8_SA(0, 1), cA + hstep, voffA);
        if (wr == 1) PG8_BAR;
        PG8_WAIT_V(2); PG8_BAR;
        PG8_STAGE(PG8_SB(1, 0), cB + kstep, voffB); PG8_STAGE(PG8_SA(1, 0), cA + kstep, voffA); PG8_STAGE(PG8_SB(1, 1), cB + hstep + kstep, voffB);
        PG8_WAIT_V(6); PG8_BAR;
    } else {
        PG8_STAGE(PG8_SB(0, 0), cB, voffB); PG8_STAGE(PG8_SA(0, 0), cA, voffA); PG8_STAGE(PG8_SB(0, 1), cB + hstep, voffB); PG8_STAGE(PG8_SA(0, 1), cA + hstep, voffA);
        if (wr == 1) PG8_BAR;
        PG8_WAIT_V(4); PG8_BAR;
        PG8_STAGE(PG8_SB(1, 0), cB + kstep, voffB); PG8_STAGE(PG8_SA(1, 0), cA + kstep, voffA); PG8_STAGE(PG8_SB(1, 1), cB + hstep + kstep, voffB);
        PG8_WAIT_V(6); PG8_BAR;
    }
    for (;;) {
        const bool has_next = S.next(ui + 1, nxt);
        const char* nA = has_next ? (const char*)g.A + (size_t)nxt.pm * tstep : cA; const char* nB = has_next ? (const char*)g.Bt + (size_t)nxt.pn * tstep : cB;
        for (int t = 0; t < nt; t += 2) {
            const bool last = (t == nt - 2);
            const char* a1 = cA + (size_t)(t + 1) * kstep;
            const char* a2 = last ? nA : cA + (size_t)(t + 2) * kstep; const char* b2 = last ? nB : cB + (size_t)(t + 2) * kstep;
            const char* a3 = a2 + kstep; const char* b3 = b2 + kstep;
            if (last && has_next) S.a_ready(nxt);
            if constexpr (SP2) {
            PG8_LDB(B0, 0, 0); PG8_LDB(B1, 0, 1); PG8_SCHED; PG8_LDA(At, 0, 0); PG8_STAGE(PG8_SA(1, 1), a1 + hstep, voffA);
            PG8_WAIT_V(8); PG8_WAIT_L(0); PG8_BAR; PG8_MMA(0, 0, At, B0); PG8_MMA(0, 1, At, B1); PG8_BAR; PG8_SCHED;
            PG8_LDA(At, 0, 1); PG8_STAGE(PG8_SB(0, 0), b2, voffB); PG8_STAGE(PG8_SB(0, 1), b2 + hstep, voffB); PG8_STAGE(PG8_SA(0, 0), a2, voffA);
            PG8_WAIT_V(8); PG8_WAIT_L(0); PG8_BAR; PG8_MMA(1, 0, At, B0); PG8_MMA(1, 1, At, B1); PG8_BAR; PG8_SCHED;
            PG8_LDB(B0, 1, 0); PG8_LDB(B1, 1, 1); PG8_SCHED; PG8_LDA(At, 1, 0); PG8_STAGE(PG8_SA(0, 1), a2 + hstep, voffA);
            PG8_WAIT_V(8); PG8_WAIT_L(0); PG8_BAR; PG8_MMA(0, 0, At, B0); PG8_MMA(0, 1, At, B1); PG8_BAR; PG8_SCHED;
            PG8_LDA(At, 1, 1); PG8_STAGE(PG8_SB(1, 0), b3, voffB); PG8_STAGE(PG8_SB(1, 1), b3 + hstep, voffB); PG8_STAGE(PG8_SA(1, 0), a3, voffA);
            PG8_WAIT_V(8); PG8_WAIT_L(0); PG8_BAR; PG8_MMA(1, 0, At, B0); PG8_MMA(1, 1, At, B1); PG8_BAR; PG8_SCHED;
            } else {
            PG8_LDB(B0, 0, 0); PG8_SCHED; PG8_LDA(At, 0, 0); PG8_STAGE(PG8_SA(1, 1), a1 + hstep, voffA);
            PG8_WAIT_L(8); PG8_BAR; PG8_WAIT_L(0); PG8_MMA(0, 0, At, B0); PG8_BAR; PG8_SCHED;
            PG8_LDB(B1, 0, 1); PG8_STAGE(PG8_SB(0, 0), b2, voffB);
            PG8_BAR; PG8_WAIT_L(0); PG8_MMA(0, 1, At, B1); PG8_BAR;
            PG8_LDA(At, 0, 1); PG8_STAGE(PG8_SA(0, 0), a2, voffA);
            PG8_BAR; PG8_WAIT_L(0); PG8_MMA(1, 0, At, B0); PG8_BAR; PG8_SCHED;
            PG8_STAGE(PG8_SB(0, 1), b2 + hstep, voffB);
            PG8_WAIT_V(6); PG8_BAR; PG8_MMA(1, 1, At, B1); PG8_BAR;
            PG8_LDB(B0, 1, 0); PG8_SCHED; PG8_LDA(At, 1, 0); PG8_STAGE(PG8_SA(0, 1), a2 + hstep, voffA);
            PG8_WAIT_L(8); PG8_BAR; PG8_WAIT_L(0); PG8_MMA(0, 0, At, B0); PG8_BAR; PG8_SCHED;
            PG8_LDB(B1, 1, 1); PG8_STAGE(PG8_SB(1, 0), b3, voffB);
            PG8_BAR; PG8_WAIT_L(0); PG8_MMA(0, 1, At, B1); PG8_BAR;
            PG8_LDA(At, 1, 1); PG8_STAGE(PG8_SA(1, 0), a3, voffA);
            PG8_BAR; PG8_WAIT_L(0); PG8_MMA(1, 0, At, B0); PG8_BAR; PG8_SCHED;
            PG8_STAGE(PG8_SB(1, 1), b3 + hstep, voffB);
            PG8_WAIT_V(6); PG8_BAR; PG8_MMA(1, 1, At, B1); PG8_BAR;
            }
        }
        if constexpr (ALIGN_EPI) { if (wr == 0) PG8_BAR; }
        if constexpr (!Epi::AFTER_DRAIN) { E(acc, cur, wr, wc, fr, fq); S.done(cur); }
        if (!has_next) break;
#pragma unroll
        for (int a = 0; a < 2; ++a)
#pragma unroll
            for (int b = 0; b < 2; ++b)
#pragma unroll
                for (int m = 0; m < 4; ++m)
#pragma unroll
                    for (int n = 0; n < 2; ++n) acc[a][b][m][n] = (f32x4){0.f, 0.f, 0.f, 0.f};
        cur = nxt; cA = nA; cB = nB; ++ui;
        if constexpr (ALIGN_EPI) { if (wr == 1) PG8_BAR; }
    }
    PG8_WAIT_V(0);
    if constexpr (!ALIGN_EPI) { if (wr == 0) PG8_BAR; }
    PG8_BAR;
    if constexpr (Epi::AFTER_DRAIN) { E.fused(acc, cur, wr, wc, fr, fq, lds, wid, lane); S.done(cur); }
#undef PG8_SA
#undef PG8_SB
#undef PG8_STAGE
#undef PG8_LDA
#undef PG8_LDB
#undef PG8_MMA
#undef PG8_WAIT_V
#undef PG8_WAIT_L
#undef PG8_BAR
#undef PG8_SCHED
}
}
#define GAS __attribute__((address_space(1)))
#define LAS __attribute__((address_space(3)))
typedef GAS unsigned gu32;
typedef GAS unsigned long long gu64;
#define RLX_AGENT __ATOMIC_RELAXED, __HIP_MEMORY_SCOPE_AGENT
#define LDS_WAIT() asm volatile("s_waitcnt lgkmcnt(0)" ::: "memory")
#define VM_WAIT() asm volatile("s_waitcnt vmcnt(0)" ::: "memory")
__device__ __forceinline__ unsigned long long rt() { return __builtin_amdgcn_s_memrealtime(); }
#define XB_TMO      128
#define XB_XCNT(j)  (256  + 64 * (j))
#define XB_XSUB(j)  (1280 + 64 * (j))
#define XB_XGEN(j)  (2304 + 64 * (j))
#define XB_TOP      3328
#define XB_TOPGEN   3392
#define XCD_BAR_WORDS 3456
#define XB_SPIN_CAP (1u << 18)

__device__ __forceinline__ unsigned xb_ld(unsigned* p)              { return __hip_atomic_load(p, __ATOMIC_RELAXED, __HIP_MEMORY_SCOPE_AGENT); }
__device__ __forceinline__ unsigned xb_add(unsigned* p, unsigned v) { return __hip_atomic_fetch_add(p, v, __ATOMIC_RELAXED, __HIP_MEMORY_SCOPE_AGENT); }
__device__ __forceinline__ unsigned xb_xcc_id() { return (unsigned)__builtin_amdgcn_s_getreg((3 << 11) | 20) & 0xFu; }
#define XB_SPIN(cond, bar) do { unsigned _sp = 0; while (cond) { __builtin_amdgcn_s_sleep(1); \
    if ((++_sp & 255u) == 0u) { if (xb_ld(&(bar)[XB_TMO])) break; if (_sp > XB_SPIN_CAP) { atomicAdd(&(bar)[XB_TMO], 1u); break; } } } } while (0)

struct XcdBarrier {
    unsigned* bar; unsigned x;
    volatile LAS unsigned* st;
};

__device__ __forceinline__ XcdBarrier xcd_barrier_post(unsigned* bar, volatile LAS unsigned* st) {
    XcdBarrier b; b.bar = bar; b.x = xb_xcc_id(); b.st = st;
    if (threadIdx.x == 0) (void)xb_add(&bar[XB_XCNT(b.x)], 1u);
    return b;
}
__device__ __forceinline__ void xcd_barrier_complete(unsigned* bar, unsigned x, unsigned& nloc, unsigned& nx) {
    const unsigned G = gridDim.x * gridDim.y * gridDim.z;
    unsigned sum, cnt, mine, sp = 0u;
    for (;;) {
        sum = 0u; cnt = 0u; mine = 0u;
#pragma unroll
        for (unsigned j = 0; j < 16; ++j) { const unsigned c = xb_ld(&bar[XB_XCNT(j)]); sum += c; cnt += (c > 0u) ? 1u : 0u; mine = (j == x) ? c : mine; }
        if (sum == G) break;
        __builtin_amdgcn_s_sleep(1);
        if ((++sp & 255u) == 0u) { if (xb_ld(&bar[XB_TMO])) break; if (sp > XB_SPIN_CAP) { atomicAdd(&bar[XB_TMO], 1u); break; } }
    }
    nloc = mine > 0u ? mine : 1u; nx = cnt > 0u ? cnt : 1u;
}

__device__ __forceinline__ void xcd_barrier(const XcdBarrier& b) {
    asm volatile("s_waitcnt vmcnt(0)" ::: "memory");
    __syncthreads();
    if (threadIdx.x == 0) {
        unsigned* bar = b.bar;
        __builtin_amdgcn_s_waitcnt(0);
        unsigned nloc = b.st[0], nx = b.st[1];
        if (nloc == 0u) { xcd_barrier_complete(bar, b.x, nloc, nx); b.st[0] = nloc; b.st[1] = nx; }
        const unsigned old = xb_add(&bar[XB_XSUB(b.x)], 1u);
        const unsigned gen = old / nloc;
        if (old + 1u == (gen + 1u) * nloc) {
            __builtin_amdgcn_fence(__ATOMIC_RELEASE, "agent");
            asm volatile("s_waitcnt vmcnt(0)" ::: "memory");
            const unsigned og = xb_add(&bar[XB_TOP], 1u);
            const unsigned tg = og / nx;
            if (og + 1u == (tg + 1u) * nx) xb_add(&bar[XB_TOPGEN], 1u);
            else XB_SPIN(xb_ld(&bar[XB_TOPGEN]) == tg, bar);
            __builtin_amdgcn_fence(__ATOMIC_ACQUIRE, "agent");
            xb_add(&bar[XB_XGEN(b.x)], 1u);
            asm volatile("s_waitcnt vmcnt(0)" ::: "memory");
        } else {
            XB_SPIN(xb_ld(&bar[XB_XGEN(b.x)]) == gen, bar);
            __builtin_amdgcn_fence(__ATOMIC_ACQUIRE, "agent");
            asm volatile("s_waitcnt vmcnt(0)" ::: "memory");
        }
    }
    __syncthreads();
}


constexpr int NB = 2, SEQ = 8192, DM = 1024, DEPTH = 4, NMETA = 16, LP = 8320, M = NB * LP;
constexpr int N_IN = 5384, N1 = 5376, NRW = 1792, NGT = 2048, DFF = 2816, NUP = 5632;
constexpr float LOG2E = 1.4426950408889634f;
constexpr float QSCALE = 0.125f * LOG2E;
constexpr float THR2 = 24.0f * LOG2E;
constexpr int NWAVES = 8, NTHR = 512, MMAIN = 16384;
constexpr int LDS_BYTES = 147456, MISC_OFF = 147456 - 128;

typedef unsigned short bf16;
typedef float f32x4 __attribute__((ext_vector_type(4)));
typedef unsigned u32x4 __attribute__((ext_vector_type(4)));
typedef unsigned u32x2 __attribute__((ext_vector_type(2)));
typedef short bf16x8 __attribute__((ext_vector_type(8)));

constexpr size_t SZ_H = (size_t)M * DM * 4, SZ_X512 = (size_t)M * 512 * 2;
constexpr size_t OFF_CTL = 0, OFF_H = 1u << 20, OFF_WT = OFF_H + SZ_H;
constexpr size_t WT_IN = 0, WT_BF = WT_IN + (size_t)N1 * 1024, WT_BR = WT_BF + 1024 * 512, WT_O = WT_BR + 1024 * 512,
                 WT_UP = WT_O + 1024 * 1024, WT_DN = WT_UP + (size_t)NUP * 1024, WT_LW = WT_DN + (size_t)1024 * DFF, WT_LA = WT_LW + 512 * 64, WT_LG = WT_LA + 512 * 64, WT_END = WT_LG + 512 * 128;
constexpr size_t OFF_HN = OFF_WT + WT_END * 2;
constexpr size_t OFF_Q = OFF_HN + 2 * SZ_X512, OFF_K = OFF_Q + SZ_X512, OFF_V = OFF_K + SZ_X512;
constexpr size_t OFF_RW = OFF_V + SZ_X512, OFF_GT = OFF_RW + (size_t)M * NRW * 2, OFF_MISC = OFF_GT + (size_t)M * NGT * 2;
constexpr size_t OFF_T0 = OFF_MISC + 2 * 16 * LP * 4, OFF_OF = OFF_T0 + 2 * SZ_X512, OFF_TAIL = OFF_OF + SZ_X512, WS_NEED = OFF_TAIL + 256 * 1024 * 2;
static_assert(OFF_HN % 256 == 0 && OFF_RW % 256 == 0 && OFF_T0 % 256 == 0, "alignment");

struct Params { const float* in[26]; float* out; unsigned char* ws; };
struct Ctx { int tid, lane, wave, bid, G; unsigned char* lds; unsigned char* ws; };

__device__ __forceinline__ float bf2f(unsigned b) { return __uint_as_float(b << 16); }
__device__ __forceinline__ float bflo(unsigned w) { return __uint_as_float(w << 16); }
__device__ __forceinline__ float bfhi(unsigned w) { return __uint_as_float(w & 0xffff0000u); }
typedef float f32x2_t_ __attribute__((ext_vector_type(2))); typedef __bf16 bf16x2_t_ __attribute__((ext_vector_type(2)));
__device__ __forceinline__ unsigned pk2(float lo, float hi) { const f32x2_t_ v = {lo, hi}; const bf16x2_t_ r = __builtin_convertvector(v, bf16x2_t_); return __builtin_bit_cast(unsigned, r); }
__device__ __forceinline__ unsigned f2bf(float f) { return pk2(f, 0.f) & 0xffffu; }
__device__ __forceinline__ float wave_sum(float v) {
#pragma unroll
    for (int o = 1; o < 64; o <<= 1) v += __shfl_xor(v, o);
    return v;
}
__device__ __forceinline__ float sigmoidf_(float x) { return __builtin_amdgcn_rcpf(1.f + __expf(-x)); }
template <int CTRL> __device__ __forceinline__ float dppf(float old, float x) {
    return __int_as_float(__builtin_amdgcn_update_dpp(__float_as_int(old), __float_as_int(x), CTRL, 0xf, 0xf, false));
}
__device__ __forceinline__ float allreduce16(float x) {
    x += dppf<0x121>(0.f, x); x += dppf<0x122>(0.f, x); x += dppf<0x124>(0.f, x); x += dppf<0x128>(0.f, x); return x;
}

namespace pg8 {
struct EpiRoute {
    static constexpr bool PERM = true, AFTER_DRAIN = false;
    unsigned char* ws;
    __device__ __forceinline__ void operator()(const f32x4 (&acc)[2][2][4][2], const Unit& u, int wr, int wc, int fr, int fq) const {
        const int pn = u.pn; size_t off; int ldc, colt;
        if (pn < 6) { off = OFF_Q + (size_t)(pn >> 1) * SZ_X512; ldc = 512; colt = (pn & 1) * 256; }
        else if (pn < 13) { off = OFF_RW; ldc = NRW; colt = (pn - 6) * 256; }
        else { off = OFF_GT; ldc = NGT; colt = (pn - 13) * 256; }
        bf16_t* base = (bf16_t*)(ws + off);
        const int row0 = u.pm * BM + wr * 64 + fr, col0 = colt + wc * 32 + 8 * fq;
#pragma unroll
        for (int ai = 0; ai < 2; ++ai)
#pragma unroll
            for (int m = 0; m < 4; ++m) { bf16_t* rowp = base + (size_t)(row0 + ai * HALF + m * 16) * ldc + col0;
#pragma unroll
                for (int bj = 0; bj < 2; ++bj) { const f32x4 v0 = acc[ai][bj][m][0], v1 = acc[ai][bj][m][1];
                    u32x4 w; w.x = cvt_pk_bf16(v0[0], v0[1]); w.y = cvt_pk_bf16(v0[2], v0[3]); w.z = cvt_pk_bf16(v1[0], v1[1]); w.w = cvt_pk_bf16(v1[2], v1[3]);
                    *(u32x4*)(rowp + bj * HALF) = w; } }
    }
};
struct EpiGateR {
    static constexpr bool PERM = true, AFTER_DRAIN = false;
    bf16_t* O; const bf16_t* GT; const float* gb; int goff, accum;
    __device__ __forceinline__ void operator()(const f32x4 (&acc)[2][2][4][2], const Unit& u, int wr, int wc, int fr, int fq) const {
        const int row0 = u.pm * BM + wr * 64 + fr, col0 = u.pn * BM + wc * 32 + 8 * fq;
#pragma unroll
        for (int bj = 0; bj < 2; ++bj) {
            const int c = col0 + bj * HALF;
            const f32x4 b0 = *(const f32x4*)(gb + goff + c), b1 = *(const f32x4*)(gb + goff + c + 4);
#pragma unroll
            for (int ai = 0; ai < 2; ++ai)
#pragma unroll
                for (int m = 0; m < 4; ++m) {
                    const size_t row = (size_t)(row0 + ai * HALF + m * 16);
                    const u32x4 gw = *(const u32x4*)(GT + row * NGT + goff + c);
                    const f32x4 v0 = acc[ai][bj][m][0], v1 = acc[ai][bj][m][1];
                    float r[8];
                    r[0] = sigmoidf_(bflo(gw.x) + b0[0]) * v0[0]; r[1] = sigmoidf_(bfhi(gw.x) + b0[1]) * v0[1];
                    r[2] = sigmoidf_(bflo(gw.y) + b0[2]) * v0[2]; r[3] = sigmoidf_(bfhi(gw.y) + b0[3]) * v0[3];
                    r[4] = sigmoidf_(bflo(gw.z) + b1[0]) * v1[0]; r[5] = sigmoidf_(bfhi(gw.z) + b1[1]) * v1[1];
                    r[6] = sigmoidf_(bflo(gw.w) + b1[2]) * v1[2]; r[7] = sigmoidf_(bfhi(gw.w) + b1[3]) * v1[3];
                    bf16_t* op = O + row * 1024 + c;
                    if (accum) { const u32x4 ow = *(const u32x4*)op;
                        r[0] += bflo(ow.x); r[1] += bfhi(ow.x); r[2] += bflo(ow.y); r[3] += bfhi(ow.y); r[4] += bflo(ow.z); r[5] += bfhi(ow.z); r[6] += bflo(ow.w); r[7] += bfhi(ow.w); }
                    u32x4 w; w.x = cvt_pk_bf16(r[0], r[1]); w.y = cvt_pk_bf16(r[2], r[3]); w.z = cvt_pk_bf16(r[4], r[5]); w.w = cvt_pk_bf16(r[6], r[7]);
                    *(u32x4*)op = w;
                }
        }
    }
};
struct EpiResid {
    static constexpr bool PERM = false, AFTER_DRAIN = false;
    float* H; float* OUT; int atomic;
    __device__ __forceinline__ void operator()(const f32x4 (&acc)[2][2][4][2], const Unit& u, int wr, int wc, int fr, int fq) const {
        const int row0 = u.pm * BM + wr * 64 + fr, col0 = u.pn * BM + wc * 32 + 4 * fq;
#pragma unroll
        for (int ai = 0; ai < 2; ++ai)
#pragma unroll
            for (int m = 0; m < 4; ++m) {
                const int row = row0 + ai * HALF + m * 16;
                float* hp = H + (size_t)row * DM + col0;
                const int b = row >= LP ? 1 : 0, t = row - b * LP;
                float* op = (OUT && t >= NMETA && t < NMETA + SEQ) ? OUT + ((size_t)b * SEQ + (t - NMETA)) * DM + col0 : nullptr;
#pragma unroll
                for (int bj = 0; bj < 2; ++bj)
#pragma unroll
                    for (int n = 0; n < 2; ++n) { const int co = bj * HALF + n * 16;
                        if (atomic) {
                            if (row < LP + NMETA + SEQ) {
#pragma unroll
                                for (int e = 0; e < 4; ++e) unsafeAtomicAdd(hp + co + e, acc[ai][bj][m][n][e]); }
                        } else {
                            const f32x4 v = *(const f32x4*)(hp + co) + acc[ai][bj][m][n];
                            if (OUT) { if (op) *(f32x4*)(op + co) = v; } else *(f32x4*)(hp + co) = v; } }
            }
    }
};
struct EpiResidAtomic {
    static constexpr bool PERM = false, AFTER_DRAIN = false;
    float* H;
    __device__ __forceinline__ void operator()(const f32x4 (&acc)[2][2][4][2], const Unit& u, int wr, int wc, int fr, int fq) const {
        const int row0 = u.pm * BM + wr * 64 + fr, col0 = u.pn * BM + wc * 32 + 4 * fq;
#pragma unroll
        for (int ai = 0; ai < 2; ++ai)
#pragma unroll
            for (int m = 0; m < 4; ++m) { float* hp = H + (size_t)(row0 + ai * HALF + m * 16) * DM + col0;
#pragma unroll
                for (int bj = 0; bj < 2; ++bj)
#pragma unroll
                    for (int n = 0; n < 2; ++n)
#pragma unroll
                        for (int e = 0; e < 4; ++e) unsafeAtomicAdd(hp + bj * HALF + n * 16 + e, acc[ai][bj][m][n][e]); }
    }
};
struct OneUnit {
    StaticOrder so; int mode, pm, pn; bool active;
    __device__ bool next(int i, Unit& u) const { if (mode == 0) return so.next(i, u); if (i != 0 || !active) return false; u.pm = pm; u.pn = pn; return true; }
    __device__ __forceinline__ void a_ready(const Unit&) const {}
    __device__ __forceinline__ void done(const Unit&) const {}
};
struct EpiUp {
    static constexpr bool PERM = true, AFTER_DRAIN = false;
    bf16_t* ACT; bf16_t* HALO; const float* cw;
    __device__ __forceinline__ void operator()(const f32x4 (&acc)[2][2][4][2], const Unit& u, int wr, int wc, int fr, int fq) const {
        const int chan0 = u.pn * 128 + wc * 32 + 8 * fq;
#pragma unroll
        for (int n = 0; n < 2; ++n) {
            const int ch = chan0 + 4 * n;
            f32x4 w[3][2];
#pragma unroll
            for (int j = 0; j < 3; ++j) { w[j][0] = *(const f32x4*)(cw + j * NUP + ch); w[j][1] = *(const f32x4*)(cw + j * NUP + DFF + ch); }
#pragma unroll
            for (int ai = 0; ai < 2; ++ai) {
                const int rowg = u.pm * BM + ai * HALF + wr * 64;
#pragma unroll
                for (int m = 0; m < 4; ++m) {
                    f32x4 uc[2];
#pragma unroll
                    for (int bj = 0; bj < 2; ++bj) {
                        const f32x4 cur = acc[ai][bj][m][n];
                        f32x4 prv; if (m > 0) prv = acc[ai][bj][m - 1][n]; else prv = (f32x4){0.f, 0.f, 0.f, 0.f};
                        f32x4 p1, p2;
#pragma unroll
                        for (int i = 0; i < 4; ++i) {
                            const float r1 = dppf<0x121>(0.f, prv[i]), r2 = dppf<0x122>(0.f, prv[i]);
                            p1[i] = dppf<0x111>(r1, cur[i]); p2[i] = dppf<0x112>(r2, cur[i]);
                        }
                        uc[bj] = w[0][bj] * p2 + w[1][bj] * p1 + w[2][bj] * cur;
                    }
                    float a[4];
#pragma unroll
                    for (int i = 0; i < 4; ++i) a[i] = uc[0][i] * sigmoidf_(uc[0][i]) * uc[1][i];
                    u32x2 o; o.x = cvt_pk_bf16(a[0], a[1]); o.y = cvt_pk_bf16(a[2], a[3]);
                    *(u32x2*)(ACT + (size_t)(rowg + m * 16 + fr) * DFF + ch) = o;
                    if ((m == 3 && fr >= 14) || (m == 0 && fr < 2)) {
                        const int slot = (rowg >> 6) * 4 + (m == 3 ? fr - 14 : 2 + fr);
#pragma unroll
                        for (int bj = 0; bj < 2; ++bj) { const f32x4 cur = acc[ai][bj][m][n]; u32x2 hw; hw.x = cvt_pk_bf16(cur[0], cur[1]); hw.y = cvt_pk_bf16(cur[2], cur[3]);
                            *(u32x2*)(HALO + (size_t)slot * NUP + bj * DFF + ch) = hw; }
                    }
                }
            }
        }
    }
};
}

#ifndef REP_PREP
#define REP_PREP 1
#endif
#ifndef REP_P3
#define REP_P3 1
#endif
#ifndef REP_SYNC
#define REP_SYNC 0
#endif
#define GLD(T, p) (*(const __attribute__((address_space(1))) T*)(p))
#define GST(T, p) (*(__attribute__((address_space(1))) T*)(p))
#define LDS_BARRIER() do { asm volatile("s_waitcnt lgkmcnt(0)" ::: "memory"); __builtin_amdgcn_s_barrier(); asm volatile("" ::: "memory"); } while (0)
__device__ __forceinline__ void transpose_item(const float* W, int Nsrc, int K, bf16* WT, int dst_row0, int src_col0, int k0, float* scr, int lane) {
#pragma unroll 8
    for (int i = 0; i < 32; ++i) { const int kk = 2 * i + (lane >> 5); scr[kk * 33 + (lane & 31)] = W[(size_t)(k0 + kk) * Nsrc + src_col0 + (lane & 31)]; }
    asm volatile("s_waitcnt lgkmcnt(0)" ::: "memory");
    const int c = lane & 7;
#pragma unroll
    for (int j = 0; j < 4; ++j) { const int n = (lane >> 3) + 8 * j; const float* s = scr + (8 * c) * 33 + n;
        u32x4 o; o.x = pk2(s[0 * 33], s[1 * 33]); o.y = pk2(s[2 * 33], s[3 * 33]); o.z = pk2(s[4 * 33], s[5 * 33]); o.w = pk2(s[6 * 33], s[7 * 33]);
        *(u32x4*)(WT + (size_t)(dst_row0 + n) * K + k0 + 8 * c) = o; }
    asm volatile("s_waitcnt lgkmcnt(0)" ::: "memory");
}
__device__ __forceinline__ void convert_weights(const Params& P, int l, const Ctx& c) {
    bf16* WT = (bf16*)(c.ws + OFF_WT);
    float* scr = (float*)(c.lds + c.wave * 16384);
    const int gw = c.bid * NWAVES + c.wave, NGW = c.G * NWAVES;
    constexpr int I_IN = 16 * 168, I_BF = 8 * 32, I_O = 16 * 32, I_UP = 16 * 176, I_DN = 44 * 32, I_LR = 16, I_LG = 32, I_ALL = I_IN + 2 * I_BF + I_O + I_UP + I_DN + 2 * I_LR + I_LG;
    for (int it = gw; it < I_ALL; it += NGW) {
        int r = it;
        if (r < I_IN) { const int kb = r / 168, n0 = 32 * (r % 168); transpose_item(P.in[4] + (size_t)l * 1024 * N_IN, N_IN, 1024, WT + WT_IN, n0, n0 + (n0 >= 1536 ? 8 : 0), 64 * kb, scr, c.lane); continue; } r -= I_IN;
        if (r < I_BF) { const int kb = r / 32, n0 = 32 * (r % 32); transpose_item(P.in[19] + (size_t)l * 512 * 1024, 1024, 512, WT + WT_BF, n0, n0, 64 * kb, scr, c.lane); continue; } r -= I_BF;
        if (r < I_BF) { const int kb = r / 32, n0 = 32 * (r % 32); transpose_item(P.in[20] + (size_t)l * 512 * 1024, 1024, 512, WT + WT_BR, n0, n0, 64 * kb, scr, c.lane); continue; } r -= I_BF;
        if (r < I_O) { const int kb = r / 32, n0 = 32 * (r % 32); transpose_item(P.in[22] + (size_t)l * 1024 * 1024, 1024, 1024, WT + WT_O, n0, n0, 64 * kb, scr, c.lane); continue; } r -= I_O;
        if (r < I_UP) { const int kb = r / 176, n0 = 32 * (r % 176); const int pn = n0 >> 8, bj = (n0 >> 7) & 1, x = n0 & 127;
            transpose_item(P.in[23] + (size_t)l * 1024 * NUP, NUP, 1024, WT + WT_UP, n0, bj * DFF + 128 * pn + x, 64 * kb, scr, c.lane); continue; } r -= I_UP;
        if (r < I_DN) { const int kb = r / 32, n0 = 32 * (r % 32); transpose_item(P.in[25] + (size_t)l * DFF * 1024, 1024, DFF, WT + WT_DN, n0, n0, 64 * kb, scr, c.lane); continue; } r -= I_DN;
        if (r < I_LR) { transpose_item(P.in[10] + (size_t)l * 64 * 512, 512, 64, WT + WT_LW, 32 * r, 32 * r, 0, scr, c.lane); continue; } r -= I_LR;
        if (r < I_LR) { transpose_item(P.in[12] + (size_t)l * 64 * 512, 512, 64, WT + WT_LA, 32 * r, 32 * r, 0, scr, c.lane); continue; } r -= I_LR;
        { const int kb = r / 16, n0 = 32 * (r % 16); transpose_item(P.in[13] + (size_t)l * 128 * 512, 512, 128, WT + WT_LG, n0, n0, 64 * kb, scr, c.lane); }
    }
}

template <bool FG> __device__ __forceinline__ void phase_norm(const Params& P, int l, const Ctx& c) {
    float* H = (float*)(c.ws + OFF_H); bf16* HN = (bf16*)(c.ws + OFF_HN);
    float* LOGF = (float*)(c.ws + OFF_MISC);
    const float* gain = (FG ? P.in[2] : P.in[3]) + l * DM;
    float* wfs = (float*)c.lds;
    if (FG) {
        __syncthreads();
        const float* win = P.in[4] + (size_t)l * 1024 * N_IN + 1536;
        for (int i = c.tid; i < 8192; i += NTHR) wfs[i] = win[(size_t)(i >> 3) * N_IN + (i & 7)];
        __syncthreads();
    }
    const int gw = c.bid * NWAVES + c.wave, NGW = c.G * NWAVES;
#define NORM_LOAD(mm, dst) do { const int b_ = (mm) >= LP ? 1 : 0, t_ = (mm) - b_ * LP; \
        if (FG && l == 0) { const float* src_ = (t_ < NMETA) ? P.in[1] + (size_t)t_ * DM : P.in[0] + ((size_t)b_ * SEQ + (t_ - NMETA)) * DM; const bool real_ = t_ < NMETA + SEQ; \
            _Pragma("unroll") for (int j_ = 0; j_ < 4; ++j_) dst[j_] = real_ ? *(const f32x4*)(src_ + 4 * c.lane + 256 * j_) : (f32x4){0.f, 0.f, 0.f, 0.f}; } \
        else { _Pragma("unroll") for (int j_ = 0; j_ < 4; ++j_) dst[j_] = *(const f32x4*)(H + (size_t)(mm) * DM + 4 * c.lane + 256 * j_); } } while (0)
    f32x4 gv[4];
#pragma unroll
    for (int j = 0; j < 4; ++j) gv[j] = *(const f32x4*)(gain + 4 * c.lane + 256 * j);
    f32x4 nv[4];
    if (gw < M) NORM_LOAD(gw, nv);
    for (int m = gw; m < M; m += NGW) {
        const int b = m >= LP ? 1 : 0, t = m - b * LP;
        f32x4 v[4];
#pragma unroll
        for (int j = 0; j < 4; ++j) v[j] = nv[j];
        if (m + NGW < M) NORM_LOAD(m + NGW, nv);
        if (FG && l == 0) {
#pragma unroll
            for (int j = 0; j < 4; ++j) *(f32x4*)(H + (size_t)m * DM + 4 * c.lane + 256 * j) = v[j];
        }
        float ss = 0.f;
#pragma unroll
        for (int j = 0; j < 4; ++j) ss += (v[j].x * v[j].x + v[j].y * v[j].y) + (v[j].z * v[j].z + v[j].w * v[j].w);
        const float rstd = 1.0f / sqrtf(wave_sum(ss) * (1.f / DM) + 1e-6f);
        float f[8];
#pragma unroll
        for (int q = 0; q < 8; ++q) f[q] = 0.f;
#pragma unroll
        for (int j = 0; j < 4; ++j) {
            const f32x4 g = gv[j];
            v[j] = v[j] * rstd * g;
            u32x2 o; o.x = pk2(v[j].x, v[j].y); o.y = pk2(v[j].z, v[j].w);
            *(u32x2*)(HN + (size_t)m * DM + 4 * c.lane + 256 * j) = o;
            if (FG) {
#pragma unroll
                for (int e = 0; e < 4; ++e) { const int k = 4 * c.lane + 256 * j + e; const f32x4 w0 = *(const f32x4*)(wfs + k * 8), w1 = *(const f32x4*)(wfs + k * 8 + 4);
                    const float hv = v[j][e];
                    f[0] += hv * w0.x; f[1] += hv * w0.y; f[2] += hv * w0.z; f[3] += hv * w0.w; f[4] += hv * w1.x; f[5] += hv * w1.y; f[6] += hv * w1.z; f[7] += hv * w1.w; }
            }
        }
        if (FG) {
#pragma unroll
            for (int q = 0; q < 8; ++q) f[q] = wave_sum(f[q]);
            float fv = f[0];
#pragma unroll
            for (int q = 1; q < 8; ++q) fv = (c.lane == q) ? f[q] : fv;
            if (c.lane < 8) { const float x = fv + P.in[7][l * 8 + c.lane]; const float ls = fminf(x, 0.f) - __logf(1.f + __expf(-fabsf(x))); LOGF[(size_t)(b * 8 + c.lane) * LP + t] = ls; }
        }
    }
}

__device__ __forceinline__ void phase_fcum(const Params& P, const Ctx& c) {
    const int s = c.bid - (c.G - 16);
    if (s < 0) return;
    const float* LOGF = (const float*)(c.ws + OFF_MISC) + (size_t)s * LP; float* FC = (float*)(c.ws + OFF_MISC) + 16 * LP + (size_t)s * LP;
    float* wt = (float*)c.lds;
    const int base = c.tid * 17;
    float v[17]; float run = 0.f;
#pragma unroll
    for (int i = 0; i < 17; ++i) { const int idx = base + i; const float x = (idx < LP) ? LOGF[idx] : 0.f; run += x; v[i] = run; }
    float incl = run;
#pragma unroll
    for (int o = 1; o < 64; o <<= 1) { const float t = __shfl_up(incl, o); if (c.lane >= o) incl += t; }
    if (c.lane == 63) wt[c.wave] = incl;
    __syncthreads();
    float off = incl - run;
#pragma unroll
    for (int w2 = 0; w2 < 8; ++w2) off += (w2 < c.wave) ? wt[w2] : 0.f;
#pragma unroll
    for (int i = 0; i < 17; ++i) { const int idx = base + i; if (idx < LP) FC[idx] = (v[i] + off) * LOG2E; }
    __syncthreads();
}

__device__ __forceinline__ void phase_qknorm(const Params& P, int l, const Ctx& c) {
    bf16* Q = (bf16*)(c.ws + OFF_Q); bf16* K = (bf16*)(c.ws + OFF_K);
    const int gw = c.bid * NWAVES + c.wave, NGW = c.G * NWAVES;
    const int d0 = (c.lane & 7) * 8;
    float gq[8], gk[8];
#pragma unroll
    for (int i = 0; i < 8; ++i) { gq[i] = P.in[5][l * 64 + d0 + i] * QSCALE; gk[i] = P.in[6][l * 64 + d0 + i]; }
    for (int m = gw; m < M; m += NGW) {
#pragma unroll
        for (int which = 0; which < 2; ++which) {
            bf16* p = (which ? K : Q) + (size_t)m * 512 + 8 * c.lane;
            const u32x4 w = *(const u32x4*)p;
            float x[8] = {bflo(w.x), bfhi(w.x), bflo(w.y), bfhi(w.y), bflo(w.z), bfhi(w.z), bflo(w.w), bfhi(w.w)};
            float ss = 0.f;
#pragma unroll
            for (int i = 0; i < 8; ++i) ss += x[i] * x[i];
            ss += __shfl_xor(ss, 1); ss += __shfl_xor(ss, 2); ss += __shfl_xor(ss, 4);
            const float rs = 1.0f / sqrtf(ss * (1.f / 64.f) + 1e-6f);
#pragma unroll
            for (int i = 0; i < 8; ++i) x[i] = x[i] * rs * (which ? gk[i] : gq[i]);
            u32x4 o; o.x = pk2(x[0], x[1]); o.y = pk2(x[2], x[3]); o.z = pk2(x[4], x[5]); o.w = pk2(x[6], x[7]);
            *(u32x4*)p = o;
        }
    }
}

constexpr int NCHK = LP / 64;
constexpr int NUNIT = NB * NCHK * 8;
constexpr int UNIT_A = 16384, UNIT_B = 16640;
constexpr int ST = 72, STG = 136;
constexpr int L_F0 = 92160, L_F1 = 108544, L_MU = 141312;
struct RwkvBufs { bf16 *BON, *G; unsigned char *UA, *UB; float* Y; bf16* ORW; };
__device__ __forceinline__ RwkvBufs rwkv_bufs(const Params& P, const Ctx& c) {
    RwkvBufs r; r.BON = (bf16*)(c.ws + OFF_HN); r.G = r.BON + (size_t)M * 512;
    r.UA = c.ws + OFF_T0; r.UB = (unsigned char*)P.out;
    r.Y = (float*)(c.ws + OFF_RW); r.ORW = (bf16*)(c.ws + OFF_RW + (size_t)M * 512 * 4);
    return r;
}
__device__ __forceinline__ void mm_tile(const bf16* A, int sa, const bf16* Bt, int sb, int nks, f32x4 (&acc)[2], int w, int lq, int g) {
    const int mt = w >> 1, nt0 = 2 * (w & 1);
    for (int ks = 0; ks < nks; ++ks) {
        const bf16x8 a = *(const bf16x8*)(A + (16 * mt + lq) * sa + 32 * ks + 8 * g);
#pragma unroll
        for (int q = 0; q < 2; ++q) { const bf16x8 b = *(const bf16x8*)(Bt + (16 * (nt0 + q) + lq) * sb + 32 * ks + 8 * g); acc[q] = __builtin_amdgcn_mfma_f32_16x16x32_bf16(a, b, acc[q], 0, 0, 0); }
    }
}
template <bool SA, bool SB> __device__ __forceinline__ void mm_tile2(const bf16* A, int sa, const bf16* Bt, int sb, int nks, f32x4 (&acc)[2], int w, int lq, int g) {
    const int mt = w >> 1, nt0 = 2 * (w & 1);
    const int ra = 16 * mt + lq, xa = SA ? 8 * ((ra >> 3) & 7) : 0;
    for (int ks = 0; ks < nks; ++ks) {
        const bf16x8 a = *(const bf16x8*)(A + ra * sa + ((32 * ks + 8 * g) ^ xa));
#pragma unroll
        for (int q = 0; q < 2; ++q) { const int rb = 16 * (nt0 + q) + lq, xb = SB ? 8 * ((rb >> 3) & 7) : 0;
            const bf16x8 bb = *(const bf16x8*)(Bt + rb * sb + ((32 * ks + 8 * g) ^ xb)); acc[q] = __builtin_amdgcn_mfma_f32_16x16x32_bf16(a, bb, acc[q], 0, 0, 0); }
    }
}
#define ZACC(a) do { a[0] = (f32x4){0.f, 0.f, 0.f, 0.f}; a[1] = (f32x4){0.f, 0.f, 0.f, 0.f}; } while (0)
__device__ __forceinline__ int permk(int k) { return 32 * (k >> 5) + 8 * ((k & 15) >> 2) + 4 * ((k >> 4) & 1) + (k & 3); }
__device__ __forceinline__ int swz(int row, int col) { return row * 128 + ((((col >> 3) ^ (row >> 1)) & 7) << 4) + (col & 7) * 2; }

__device__ __forceinline__ void rwkv_prep_unit(const Params& P, int l, const Ctx& c, int u, const RwkvBufs& B, const float (&pw0)[8], const float (&pa0)[8], const float (&pkk)[8], const float (&pka)[8], const float (&prk)[8], const u32x4 (&wlr)[4], u32x4 (&rc)[7], u32x4 (&rp)[7]) {
    const int h = u & 7, bc = u >> 3, b = bc / NCHK, ch = bc - b * NCHK;
    const size_t m0 = (size_t)b * LP + ch * 64;
    int tid_ = c.tid; asm volatile("" : "+v"(tid_));
    const int tid = tid_, lane = tid & 63, w = c.wave, lq = lane & 15, g = lane >> 4;
    const int t = tid >> 3, cg = tid & 7, c0 = cg * 8, jb = h * 64 + c0;
    unsigned char* L = c.lds;
    bf16* A0 = (bf16*)L; bf16* A1 = A0 + 4608; bf16* A2 = A1 + 4608; bf16* A3 = A2 + 4608; bf16* A4 = A3 + 4608; bf16* A5 = A4 + 4608; bf16* A6 = A5 + 4608;
    bf16* A7 = A6 + 4608; bf16* A8 = A7 + 4608; bf16* A9 = A8 + 4608;
    float* F0 = (float*)(L + L_F0); float* F1 = (float*)(L + L_F1);
    const bf16* RW = (const bf16*)(c.ws + OFF_RW);
    const bf16* WT = (const bf16*)(c.ws + OFF_WT);
    const float* mu = (const float*)(c.lds + L_MU);
    const bool first = (ch == 0 && t == 0);
    const bf16* cur = RW + (m0 + t) * NRW; const bf16* prv = cur - NRW;
    float zr[8], zk[8], zv[8];
#pragma unroll
    for (int s = 0; s < 3; ++s) {
        const u32x4 cw = rc[s]; u32x4 pw = (u32x4){0u, 0u, 0u, 0u}; if (!first) pw = rp[s];
        const float cv[8] = {bflo(cw.x), bfhi(cw.x), bflo(cw.y), bfhi(cw.y), bflo(cw.z), bfhi(cw.z), bflo(cw.w), bfhi(cw.w)};
        const float pv[8] = {bflo(pw.x), bfhi(pw.x), bflo(pw.y), bfhi(pw.y), bflo(pw.z), bfhi(pw.z), bflo(pw.w), bfhi(pw.w)};
#pragma unroll
        for (int i = 0; i < 8; ++i) { const float z = cv[i] + mu[s * 64 + c0 + i] * (pv[i] - cv[i]); if (s == 0) zr[i] = z; else if (s == 1) zk[i] = z; else zv[i] = z; }
    }
#pragma unroll
    for (int q4 = 0; q4 < 4; ++q4) {
        const int col = cg * 32 + q4 * 8;
        const u32x4 cw = rc[3 + q4]; u32x4 pw = (u32x4){0u, 0u, 0u, 0u}; if (!first) pw = rp[3 + q4];
        const float cv[8] = {bflo(cw.x), bfhi(cw.x), bflo(cw.y), bfhi(cw.y), bflo(cw.z), bfhi(cw.z), bflo(cw.w), bfhi(cw.w)};
        const float pv[8] = {bflo(pw.x), bfhi(pw.x), bflo(pw.y), bfhi(pw.y), bflo(pw.z), bfhi(pw.z), bflo(pw.w), bfhi(pw.w)};
        float z[8];
#pragma unroll
        for (int i = 0; i < 8; ++i) { z[i] = cv[i] + mu[192 + col + i] * (pv[i] - cv[i]); if (col < 64) z[i] = 1.f - 2.f / (1.f + __expf(2.f * z[i])); else if (col >= 128) z[i] = sigmoidf_(z[i]); }
        u32x4 o; o.x = pk2(z[0], z[1]); o.y = pk2(z[2], z[3]); o.z = pk2(z[4], z[5]); o.w = pk2(z[6], z[7]);
        bf16* dst = (col < 64) ? A0 + t * ST + col : (col < 128 ? A1 + t * ST + (col - 64) : A2 + t * STG + (col - 128));
        *(u32x4*)dst = o;
    }
    { const int un = u + c.G;
      if (un < NUNIT) { const int hn = un & 7, bcn = un >> 3, bn = bcn / NCHK, chn = bcn - bn * NCHK;
          const bf16* cn = RW + ((size_t)bn * LP + chn * 64 + t) * NRW; const bf16* pn = cn - NRW;
#pragma unroll
          for (int s = 0; s < 3; ++s) { rc[s] = GLD(u32x4, cn + s * 512 + hn * 64 + c0); rp[s] = GLD(u32x4, pn + s * 512 + hn * 64 + c0); }
#pragma unroll
          for (int q4 = 0; q4 < 4; ++q4) { rc[3 + q4] = GLD(u32x4, cn + 1536 + cg * 32 + q4 * 8); rp[3 + q4] = GLD(u32x4, pn + 1536 + cg * 32 + q4 * 8); } } }
    { const int row = tid >> 3, chk = tid & 7;
      *(u32x4*)(A4 + row * ST + chk * 8) = wlr[0];
      *(u32x4*)(A5 + row * ST + chk * 8) = wlr[1];
#pragma unroll
      for (int i = 0; i < 2; ++i) { const int idx = tid + 512 * i, r2 = idx >> 4, c2 = idx & 15;
          *(u32x4*)((bf16*)F1 + r2 * STG + c2 * 8) = wlr[2 + i]; } }
    LDS_BARRIER();
    { f32x4 aw[2], aa[2], ag[2]; ZACC(aw); ZACC(aa); ZACC(ag);
      mm_tile(A4, ST, A0, ST, 2, aw, w, lq, g); mm_tile(A5, ST, A1, ST, 2, aa, w, lq, g); mm_tile((const bf16*)F1, STG, A2, STG, 4, ag, w, lq, g);
      const int mt = w >> 1, nt0 = 2 * (w & 1);
#pragma unroll
      for (int q = 0; q < 2; ++q) { const int o = (16 * (nt0 + q) + lq) * ST + 16 * mt + 4 * g; u32x2 p;
          p.x = pk2(aw[q][0], aw[q][1]); p.y = pk2(aw[q][2], aw[q][3]); *(u32x2*)(A7 + o) = p;
          p.x = pk2(aa[q][0], aa[q][1]); p.y = pk2(aa[q][2], aa[q][3]); *(u32x2*)(A8 + o) = p;
          p.x = pk2(ag[q][0], ag[q][1]); p.y = pk2(ag[q][2], ag[q][3]); *(u32x2*)(A9 + o) = p; } }
    LDS_BARRIER();
    float kk[8], k2[8], ar[8];
    { const u32x4 lw = *(const u32x4*)(A7 + t * ST + c0), la = *(const u32x4*)(A8 + t * ST + c0), lg = *(const u32x4*)(A9 + t * ST + c0);
      const float fw[8] = {bflo(lw.x), bfhi(lw.x), bflo(lw.y), bfhi(lw.y), bflo(lw.z), bfhi(lw.z), bflo(lw.w), bfhi(lw.w)};
      const float fa[8] = {bflo(la.x), bfhi(la.x), bflo(la.y), bfhi(la.y), bflo(la.z), bfhi(la.z), bflo(la.w), bfhi(la.w)};
      float ss = 0.f, bs = 0.f;
#pragma unroll
      for (int i = 0; i < 8; ++i) {
          const float xw = -(pw0[i] + fw[i]); const float sp = fmaxf(xw, 0.f) + __logf(1.f + __expf(-fabsf(xw)));
          F0[t * 64 + c0 + i] = __expf(-sp - 0.5f);
          ar[i] = sigmoidf_(pa0[i] + fa[i]);
          kk[i] = zk[i] * pkk[i]; ss += kk[i] * kk[i];
          k2[i] = zk[i] * (1.f + (ar[i] - 1.f) * pka[i]);
          bs += zr[i] * k2[i] * prk[i]; }
      ss += __shfl_xor(ss, 1); ss += __shfl_xor(ss, 2); ss += __shfl_xor(ss, 4);
      bs += __shfl_xor(bs, 1); bs += __shfl_xor(bs, 2); bs += __shfl_xor(bs, 4);
      const float inv = 1.0f / fmaxf(sqrtf(ss), 1e-12f);
#pragma unroll
      for (int i = 0; i < 8; ++i) kk[i] *= inv;
      u32x4 bo; bo.x = pk2(bs * zv[0], bs * zv[1]); bo.y = pk2(bs * zv[2], bs * zv[3]); bo.z = pk2(bs * zv[4], bs * zv[5]); bo.w = pk2(bs * zv[6], bs * zv[7]);
      *(u32x4*)(B.BON + (m0 + t) * 512 + jb) = bo; *(u32x4*)(B.G + (m0 + t) * 512 + jb) = lg; }
    LDS_BARRIER();
    {
      const int k = tid & 63, sg = tid >> 6; float e[8], run = 0.f;
#pragma unroll
      for (int s = 0; s < 8; ++s) { run += F0[(8 * sg + s) * 64 + k]; e[s] = run; }
      F1[sg * 64 + k] = run;
      LDS_BARRIER();
      float off = 0.f;
#pragma unroll
      for (int s = 0; s < 8; ++s) off += (s < sg) ? F1[s * 64 + k] : 0.f;
#pragma unroll
      for (int s = 0; s < 8; ++s) F0[(8 * sg + s) * 64 + k] = e[s] + off; }
    LDS_BARRIER();
    { float ct[8], cp[8], cC[8];
#pragma unroll
      for (int i = 0; i < 8; ++i) { ct[i] = F0[t * 64 + c0 + i]; cp[i] = (t > 0) ? F0[(t - 1) * 64 + c0 + i] : 0.f; cC[i] = F0[63 * 64 + c0 + i]; }
      float at[8], bt[8], kt[8], rt[8], bh[8], kh[8];
#pragma unroll
      for (int i = 0; i < 8; ++i) { const float gt = __expf(-ct[i]), igt = __expf(ct[i]), gp = __expf(-cp[i]), gct = __expf(ct[i] - cC[i]);
          at[i] = -kk[i] * gp; bt[i] = kk[i] * ar[i] * igt; kt[i] = k2[i] * igt; rt[i] = zr[i] * gt; bh[i] = kk[i] * ar[i] * gct; kh[i] = k2[i] * gct; }
      u32x4 o;
      o.x = pk2(at[0], at[1]); o.y = pk2(at[2], at[3]); o.z = pk2(at[4], at[5]); o.w = pk2(at[6], at[7]); *(u32x4*)(A0 + t * ST + c0) = o;
      o.x = pk2(bt[0], bt[1]); o.y = pk2(bt[2], bt[3]); o.z = pk2(bt[4], bt[5]); o.w = pk2(bt[6], bt[7]); *(u32x4*)(A1 + t * ST + c0) = o;
      o.x = pk2(kt[0], kt[1]); o.y = pk2(kt[2], kt[3]); o.z = pk2(kt[4], kt[5]); o.w = pk2(kt[6], kt[7]); *(u32x4*)(A2 + t * ST + c0) = o;
      o.x = pk2(rt[0], rt[1]); o.y = pk2(rt[2], rt[3]); o.z = pk2(rt[4], rt[5]); o.w = pk2(rt[6], rt[7]); *(u32x4*)(A3 + t * ST + c0) = o;
#pragma unroll
      for (int i = 0; i < 8; ++i) { const int o = (c0 + i) * ST + (t ^ c0);
          A4[o] = (bf16)f2bf(bh[i]); A5[o] = (bf16)f2bf(kh[i]); A6[o] = (bf16)f2bf(zv[i]); F1[t * 128 + c0 + i] = at[i]; }
      if (t == 63) { float* gc = (float*)(B.UB + (size_t)u * UNIT_B + 16384) + c0;
#pragma unroll
          for (int i = 0; i < 8; ++i) gc[i] = __expf(-cC[i]); } }
    LDS_BARRIER();
    { const int mt = w >> 1, nt0 = 2 * (w & 1);
      f32x4 a[2];
      ZACC(a); mm_tile(A0, ST, A1, ST, 2, a, w, lq, g);
#pragma unroll
      for (int q = 0; q < 2; ++q) { const int i = 16 * (nt0 + q) + lq; f32x4 lab;
#pragma unroll
          for (int j = 0; j < 4; ++j) lab[j] = (i < 16 * mt + 4 * g + j) ? a[q][j] : 0.f;
#pragma unroll
          for (int j = 0; j < 4; ++j) F0[i * 64 + j * 16 + 4 * mt + g] = lab[j]; }
      asm volatile("" ::: "memory");
#define ST1_STORE(DST, INCL) do { _Pragma("unroll") for (int q = 0; q < 2; ++q) { const int tt = 16 * (nt0 + q) + lq, i0 = 16 * mt + 4 * g; float v_[4]; \
          _Pragma("unroll") for (int j = 0; j < 4; ++j) v_[j] = (i0 + j < tt + (INCL)) ? a[q][j] : 0.f; \
          u32x2 p_; p_.x = pk2(v_[0], v_[1]); p_.y = pk2(v_[2], v_[3]); *(u32x2*)((DST) + tt * ST + i0) = p_; } } while (0)
      ZACC(a); mm_tile(A2, ST, A0, ST, 2, a, w, lq, g); ST1_STORE(A7, 0); asm volatile("" ::: "memory");
      ZACC(a); mm_tile(A1, ST, A3, ST, 2, a, w, lq, g); ST1_STORE(A8, 1); asm volatile("" ::: "memory");
      ZACC(a); mm_tile(A2, ST, A3, ST, 2, a, w, lq, g); ST1_STORE(A9, 1);
#undef ST1_STORE
    }
    LDS_BARRIER();
    { const int mt = w >> 1, nt0 = 2 * (w & 1); f32x4 a[2]; ZACC(a);
      mm_tile2<true, false>(A6, ST, A7, ST, 2, a, w, lq, g);
#pragma unroll
      for (int q = 0; q < 2; ++q) *(f32x4*)(F1 + (16 * (nt0 + q) + lq) * 128 + 64 + 16 * mt + 4 * g) = a[q]; }
    LDS_BARRIER();
    { float X[16];
      const int col = 16 * w + lq;
#pragma unroll
      for (int r = 0; r < 16; ++r) X[r] = F1[(4 * r + g) * 128 + col];
      LDS_BARRIER();
      f32x4 Lc[4];
#pragma unroll
      for (int q = 0; q < 4; ++q) Lc[q] = *(const f32x4*)(F0 + g * 16 + 4 * q);
#pragma unroll
      for (int i = 0; i < 64; ++i) {
          const float xi = __shfl(X[i >> 2], (i & 3) * 16 + lq);
          f32x4 Ln[4];
#pragma unroll
          for (int q = 0; q < 4; ++q) Ln[q] = Lc[q];
          if (i + 1 < 64) {
#pragma unroll
              for (int q = ((i + 1) >> 4); q < 4; ++q) Ln[q] = *(const f32x4*)(F0 + (i + 1) * 64 + g * 16 + 4 * q);
          }
#pragma unroll
          for (int r = (i >> 2); r < 16; ++r) X[r] += Lc[r >> 2][r & 3] * xi;
#pragma unroll
          for (int q = 0; q < 4; ++q) Lc[q] = Ln[q];
          __builtin_amdgcn_sched_barrier(0);
      }
      bf16* XT = (bf16*)F1 + (w >> 2) * 4608 + ((col & 63) * ST);
#pragma unroll
      for (int r = 0; r < 16; ++r) XT[4 * r + g] = (bf16)f2bf(X[r]); }
    LDS_BARRIER();
    { const int mt = w >> 1, nt0 = 2 * (w & 1);
      const bf16* AhT = (const bf16*)F1; const bf16* W2T = AhT + 4608;
      unsigned char* ua = B.UA + (size_t)u * UNIT_A; unsigned char* ub = B.UB + (size_t)u * UNIT_B;
      const int p0 = 32 * (mt >> 1) + 8 * g + 4 * (mt & 1);
      f32x4 a[2];
      ZACC(a); mm_tile2<false, true>(AhT, ST, A4, ST, 2, a, w, lq, g);
#pragma unroll
      for (int q = 0; q < 2; ++q) { const int k = 16 * (nt0 + q) + lq; u32x2 o; o.x = pk2(a[q][0], a[q][1]); o.y = pk2(a[q][2], a[q][3]); *(u32x2*)(ua + swz(k, p0)) = o; }
      ZACC(a); mm_tile(AhT, ST, A8, ST, 2, a, w, lq, g);
#pragma unroll
      for (int q = 0; q < 2; ++q) { const int tt = 16 * (nt0 + q) + lq; const u32x2 rr = *(const u32x2*)(A3 + tt * ST + 16 * mt + 4 * g);
          u32x2 o; o.x = pk2(a[q][0] + bflo(rr.x), a[q][1] + bfhi(rr.x)); o.y = pk2(a[q][2] + bflo(rr.y), a[q][3] + bfhi(rr.y)); *(u32x2*)(ua + 8192 + swz(tt, p0)) = o; }
      ZACC(a); mm_tile2<true, false>(A4, ST, W2T, ST, 2, a, w, lq, g); mm_tile2<true, true>(A5, ST, A6, ST, 2, a, w, lq, g);
#pragma unroll
      for (int q = 0; q < 2; ++q) { const int v = 16 * (nt0 + q) + lq, k0 = 16 * mt + 4 * g; u32x2 o; o.x = pk2(a[q][0], a[q][1]); o.y = pk2(a[q][2], a[q][3]); *(u32x2*)(ub + swz(v, k0)) = o; }
      ZACC(a); mm_tile(A8, ST, W2T, ST, 2, a, w, lq, g); mm_tile2<false, true>(A9, ST, A6, ST, 2, a, w, lq, g);
#pragma unroll
      for (int q = 0; q < 2; ++q) { const int v = 16 * (nt0 + q) + lq, t0 = 16 * mt + 4 * g; u32x2 o; o.x = pk2(a[q][0], a[q][1]); o.y = pk2(a[q][2], a[q][3]); *(u32x2*)(ub + 8192 + swz(v, t0)) = o; } }
    LDS_BARRIER();
}
__device__ __forceinline__ void phase_rwkv_prep(const Params& P, int l, const Ctx& c) {
    const RwkvBufs B = rwkv_bufs(P, c);
    float pw0[8], pa0[8], pkk[8], pka[8], prk[8]; int hprev = -1;
    u32x4 wlr[4];
    u32x4 rc[7], rp[7];
    if (c.bid < NUNIT) { const int u0 = c.bid, h0 = u0 & 7, bc0 = u0 >> 3, b0 = bc0 / NCHK, ch0 = bc0 - b0 * NCHK, t0 = c.tid >> 3, cg0 = c.tid & 7;
        const bf16* cn = (const bf16*)(c.ws + OFF_RW) + ((size_t)b0 * LP + ch0 * 64 + t0) * NRW; const bf16* pn = cn - NRW;
#pragma unroll
        for (int s = 0; s < 3; ++s) { rc[s] = GLD(u32x4, cn + s * 512 + h0 * 64 + cg0 * 8); rp[s] = GLD(u32x4, pn + s * 512 + h0 * 64 + cg0 * 8); }
#pragma unroll
        for (int q4 = 0; q4 < 4; ++q4) { rc[3 + q4] = GLD(u32x4, cn + 1536 + cg0 * 32 + q4 * 8); rp[3 + q4] = GLD(u32x4, pn + 1536 + cg0 * 32 + q4 * 8); } }
    for (int u = c.bid; u < NUNIT; u += c.G) {
        const int h = u & 7;
        if (h != hprev) {
            __syncthreads();
            if (c.tid < 448) { const int i = c.tid; ((float*)(c.lds + L_MU))[i] = (i < 192) ? P.in[8][l * NRW + (i >> 6) * 512 + h * 64 + (i & 63)] : P.in[8][l * NRW + 1536 + (i - 192)]; }
            __syncthreads(); }
        if (h != hprev) { hprev = h; const int j0 = l * 512 + h * 64 + (c.tid & 7) * 8;
#pragma unroll
            for (int i = 0; i < 8; ++i) { pw0[i] = P.in[9][j0 + i]; pa0[i] = P.in[11][j0 + i]; pkk[i] = P.in[14][j0 + i]; pka[i] = P.in[15][j0 + i]; prk[i] = P.in[16][j0 + i]; }
            { const bf16* WTp = (const bf16*)(c.ws + OFF_WT); const int row = c.tid >> 3, chk = c.tid & 7;
              wlr[0] = *(const u32x4*)(WTp + WT_LW + (size_t)(h * 64 + row) * 64 + chk * 8); wlr[1] = *(const u32x4*)(WTp + WT_LA + (size_t)(h * 64 + row) * 64 + chk * 8);
#pragma unroll
              for (int i = 0; i < 2; ++i) { const int idx = c.tid + 512 * i, r2 = idx >> 4, c2 = idx & 15; wlr[2 + i] = *(const u32x4*)(WTp + WT_LG + (size_t)(h * 64 + r2) * 128 + c2 * 8); } } }
        rwkv_prep_unit(P, l, c, u, B, pw0, pa0, pkk, pka, prk, wlr, rc, rp);
    }
}

constexpr int SLOTB = 33280, YST = 68;
__device__ __forceinline__ void scan_chunked(const Params& P, const Ctx& c, int bh) {
    const RwkvBufs B = rwkv_bufs(P, c);
    const int b = bh >> 3, h = bh & 7, w = c.wave, lane = c.lane, lq = lane & 15, g = lane >> 4;
    const size_t rowb = (size_t)b * LP;
    const int ll = c.tid;
    unsigned char* L = c.lds;
    f32x4 st[4];
#pragma unroll
    for (int i = 0; i < 4; ++i) st[i] = (f32x4){0.f, 0.f, 0.f, 0.f};
    u32x4 r0[5], r1[5], r2[5], r3[5], r4[5];
#define SC_UNIT(cc) ((size_t)((b * NCHK + (cc)) * 8 + h))
#define SC_LOAD(R, cc) do { const unsigned char* pa_ = B.UA + SC_UNIT(cc) * UNIT_A; const unsigned char* pb_ = B.UB + SC_UNIT(cc) * UNIT_B; \
        _Pragma("unroll") for (int i_ = 0; i_ < 2; ++i_) { R[i_] = GLD(u32x4, pa_ + (ll + 512 * i_) * 16); R[2 + i_] = GLD(u32x4, pb_ + (ll + 512 * i_) * 16); } \
        if (ll < 16) R[4] = GLD(u32x4, pb_ + 16384 + ll * 16); } while (0)
#define SC_WRITE(R, slot) do { unsigned char* s_ = L + (slot) * SLOTB; \
        _Pragma("unroll") for (int i_ = 0; i_ < 2; ++i_) { *(u32x4*)(s_ + (ll + 512 * i_) * 16) = R[i_]; *(u32x4*)(s_ + 16384 + (ll + 512 * i_) * 16) = R[2 + i_]; } \
        if (ll < 16) *(u32x4*)(s_ + 32768 + ll * 16) = R[4]; } while (0)
#define SC_COMPUTE(ci) do { \
        const unsigned char* sl = L + ((ci) % 3) * SLOTB; \
        const int vcol = 16 * w + lq; \
        bf16x8 gaf[4][2]; f32x4 gcf[4]; u32x2 d0f[4]; \
        _Pragma("unroll") for (int mt = 0; mt < 4; ++mt) { \
            gcf[mt] = *(const f32x4*)(sl + 32768 + (16 * mt + 4 * g) * 4); \
            d0f[mt] = *(const u32x2*)(sl + 16384 + swz(vcol, 16 * mt + 4 * g)); \
            _Pragma("unroll") for (int ks = 0; ks < 2; ++ks) gaf[mt][ks] = *(const bf16x8*)(sl + swz(16 * mt + lq, 32 * ks + 8 * g)); } \
        __builtin_amdgcn_sched_barrier(0);        \
        bf16x8 sb[2]; \
        _Pragma("unroll") for (int ks = 0; ks < 2; ++ks) { u32x4 pw; pw.x = pk2(st[2 * ks][0], st[2 * ks][1]); pw.y = pk2(st[2 * ks][2], st[2 * ks][3]); pw.z = pk2(st[2 * ks + 1][0], st[2 * ks + 1][1]); pw.w = pk2(st[2 * ks + 1][2], st[2 * ks + 1][3]); \
            sb[ks] = __builtin_bit_cast(bf16x8, pw); } \
        _Pragma("unroll") for (int mt = 0; mt < 4; ++mt) { \
            f32x4 ns = (f32x4){bflo(d0f[mt].x), bfhi(d0f[mt].x), bflo(d0f[mt].y), bfhi(d0f[mt].y)} + gcf[mt] * st[mt]; \
            _Pragma("unroll") for (int ks = 0; ks < 2; ++ks) ns = __builtin_amdgcn_mfma_f32_16x16x32_bf16(gaf[mt][ks], sb[ks], ns, 0, 0, 0); \
            st[mt] = ns; } \
        bf16x8 rhf[4][2]; u32x2 y0f[4];        \
        _Pragma("unroll") for (int mt = 0; mt < 4; ++mt) { y0f[mt] = *(const u32x2*)(sl + 24576 + swz(vcol, 16 * mt + 4 * g)); \
            _Pragma("unroll") for (int ks = 0; ks < 2; ++ks) rhf[mt][ks] = *(const bf16x8*)(sl + 8192 + swz(16 * mt + lq, 32 * ks + 8 * g)); } \
        __builtin_amdgcn_sched_barrier(0); \
        f32x4 yav[4]; \
        _Pragma("unroll") for (int mt = 0; mt < 4; ++mt) { yav[mt] = (f32x4){bflo(y0f[mt].x), bfhi(y0f[mt].x), bflo(y0f[mt].y), bfhi(y0f[mt].y)}; \
            _Pragma("unroll") for (int ks = 0; ks < 2; ++ks) yav[mt] = __builtin_amdgcn_mfma_f32_16x16x32_bf16(rhf[mt][ks], sb[ks], yav[mt], 0, 0, 0); } \
        _Pragma("unroll") for (int mt = 0; mt < 4; ++mt) { \
            float* yl = (float*)(L + 3 * SLOTB) + ((ci) & 1) * (64 * YST) + (16 * mt + 4 * g) * YST + vcol; \
            _Pragma("unroll") for (int j = 0; j < 4; ++j) yl[j * YST] = yav[mt][j]; } } while (0)
#define SC_YSTORE(ci) do { const float* ys_ = (const float*)(L + 3 * SLOTB) + ((ci) & 1) * (64 * YST) + (c.tid >> 3) * YST + (c.tid & 7) * 8; \
        float* yg_ = B.Y + (rowb + (ci) * 64 + (c.tid >> 3)) * 512 + h * 64 + (c.tid & 7) * 8; \
        GST(f32x4, yg_) = *(const f32x4*)ys_; GST(f32x4, yg_ + 4) = *(const f32x4*)(ys_ + 4); } while (0)
#define SC_ITER(ci, R) do { if ((ci) + 2 < NCHK) SC_WRITE(R, ((ci) + 2) % 3); if ((ci) + 7 < NCHK) SC_LOAD(R, (ci) + 7); if ((ci) > 0) SC_YSTORE((ci) - 1); if (w < 4) { SC_COMPUTE(ci); } LDS_BARRIER(); } while (0)
    { SC_LOAD(r0, 0); SC_LOAD(r1, 1); SC_WRITE(r0, 0); SC_WRITE(r1, 1); SC_LOAD(r2, 2); SC_LOAD(r3, 3); SC_LOAD(r4, 4); SC_LOAD(r0, 5); SC_LOAD(r1, 6); }
    __syncthreads();
#pragma unroll 1
    for (int cc = 0; cc < NCHK; cc += 5) { SC_ITER(cc, r2); SC_ITER(cc + 1, r3); SC_ITER(cc + 2, r4); SC_ITER(cc + 3, r0); SC_ITER(cc + 4, r1); }
    SC_YSTORE(NCHK - 1);
#undef SC_YSTORE
#undef SC_COMPUTE
#undef SC_ITER
#undef SC_UNIT
#undef SC_LOAD
#undef SC_WRITE
}

__device__ __forceinline__ void phase_gn(const Params& P, int l, const Ctx& c) {
    const RwkvBufs B = rwkv_bufs(P, c);
    const int gw = c.bid * NWAVES + c.wave, NGW = c.G * NWAVES;
    const int c0 = 8 * c.lane;
    float gnw[8], gnb[8];
#pragma unroll
    for (int i = 0; i < 8; ++i) { gnw[i] = P.in[17][l * 512 + c0 + i]; gnb[i] = P.in[18][l * 512 + c0 + i]; }
    f32x4 ny0, ny1; u32x4 nbw, ngw;
#define GN_LOAD(mm) do { const size_t o_ = (size_t)(mm) * 512 + c0; ny0 = *(const f32x4*)(B.Y + o_); ny1 = *(const f32x4*)(B.Y + o_ + 4); nbw = *(const u32x4*)(B.BON + o_); ngw = *(const u32x4*)(B.G + o_); } while (0)
    if (gw < M) GN_LOAD(gw);
    for (int m = gw; m < M; m += NGW) {
        const size_t o = (size_t)m * 512 + c0;
        const f32x4 y0 = ny0, y1 = ny1; const u32x4 bw = nbw, gw4 = ngw;
        if (m + NGW < M) GN_LOAD(m + NGW);
        float y[8] = {y0.x, y0.y, y0.z, y0.w, y1.x, y1.y, y1.z, y1.w};
        const float bo[8] = {bflo(bw.x), bfhi(bw.x), bflo(bw.y), bfhi(bw.y), bflo(bw.z), bfhi(bw.z), bflo(bw.w), bfhi(bw.w)};
        const float gg[8] = {bflo(gw4.x), bfhi(gw4.x), bflo(gw4.y), bfhi(gw4.y), bflo(gw4.z), bfhi(gw4.z), bflo(gw4.w), bfhi(gw4.w)};
        float s = 0.f;
#pragma unroll
        for (int i = 0; i < 8; ++i) s += y[i];
        s += __shfl_xor(s, 1); s += __shfl_xor(s, 2); s += __shfl_xor(s, 4);
        const float mean = s * (1.f / 64.f);
        float q = 0.f;
#pragma unroll
        for (int i = 0; i < 8; ++i) { y[i] -= mean; q += y[i] * y[i]; }
        q += __shfl_xor(q, 1); q += __shfl_xor(q, 2); q += __shfl_xor(q, 4);
        const float rstd = 1.0f / sqrtf(q * (1.f / 64.f) + 64e-5f);
        float ov[8];
#pragma unroll
        for (int i = 0; i < 8; ++i) ov[i] = (y[i] * rstd * gnw[i] + gnb[i] + bo[i]) * gg[i];
        u32x4 ow; ow.x = pk2(ov[0], ov[1]); ow.y = pk2(ov[2], ov[3]); ow.z = pk2(ov[4], ov[5]); ow.w = pk2(ov[6], ov[7]);
        *(u32x4*)(B.ORW + o) = ow;
    }
}

__device__ __forceinline__ void attn_unit(const Ctx& c, int bh, int qb, const bf16* Q, const bf16* K, const bf16* V, bf16* O, const float* FC, float qkb2, const float* gq, const float* gk) {
    const int b = bh >> 3, h = bh & 7, lane = c.lane, w = c.wave, lq = lane & 15, g = lane >> 4;
    const int q0 = qb * 128;
    const size_t rowb = (size_t)b * LP;
    const int qrow = q0 + 16 * w + lq;
    bf16* Ks = (bf16*)c.lds; bf16* Vt = Ks + 64 * 72; float* fks = (float*)(Vt + 64 * 72);
    const bf16* qp = Q + (rowb + qrow) * 512 + h * 64 + 8 * g;
    bf16x8 qf0, qf1;
    { const u32x4 r0 = GLD(u32x4, qp), r1 = GLD(u32x4, qp + 32);
      float x[16] = {bflo(r0.x), bfhi(r0.x), bflo(r0.y), bfhi(r0.y), bflo(r0.z), bfhi(r0.z), bflo(r0.w), bfhi(r0.w), bflo(r1.x), bfhi(r1.x), bflo(r1.y), bfhi(r1.y), bflo(r1.z), bfhi(r1.z), bflo(r1.w), bfhi(r1.w)};
      float ss = 0.f;
#pragma unroll
      for (int i = 0; i < 16; ++i) ss += x[i] * x[i];
      ss += __shfl_xor(ss, 16); ss += __shfl_xor(ss, 32);
      const float rs = QSCALE / sqrtf(ss * (1.f / 64.f) + 1e-6f);
#pragma unroll
      for (int i = 0; i < 8; ++i) { x[i] *= rs * gq[8 * g + i]; x[8 + i] *= rs * gq[32 + 8 * g + i]; }
      u32x4 p0, p1; p0.x = pk2(x[0], x[1]); p0.y = pk2(x[2], x[3]); p0.z = pk2(x[4], x[5]); p0.w = pk2(x[6], x[7]); p1.x = pk2(x[8], x[9]); p1.y = pk2(x[10], x[11]); p1.z = pk2(x[12], x[13]); p1.w = pk2(x[14], x[15]);
      qf0 = __builtin_bit_cast(bf16x8, p0); qf1 = __builtin_bit_cast(bf16x8, p1); }
    const float* FCh = FC + (size_t)bh * LP;
    const float fq = GLD(float, FCh + qrow);
    float mrun = -1e30f, lsum = 0.f;
    f32x4 o[4];
#pragma unroll
    for (int i = 0; i < 4; ++i) o[i] = (f32x4){0.f, 0.f, 0.f, 0.f};
    const int kt_max = (q0 + 127) >> 6;
    const int lkey = c.tid >> 3, lch = c.tid & 7;
    float gkr[8];
#pragma unroll
    for (int i = 0; i < 8; ++i) gkr[i] = gk[lch * 8 + i];
    const size_t gbase = (rowb + lkey) * 512 + h * 64 + lch * 8;
    u32x4 kv = GLD(u32x4, K + gbase + (size_t)kt_max * 64 * 512), vv = GLD(u32x4, V + gbase + (size_t)kt_max * 64 * 512);
    float fkv = GLD(float, FCh + kt_max * 64 + (c.tid & 63));
    volatile unsigned* vote = (volatile unsigned*)(fks + 64);
    for (int kt = kt_max; kt >= 0; --kt) {
        const int k0 = kt * 64;
        LDS_BARRIER();
        { int can = 0; if (kt < kt_max) { const float fl = __shfl(fkv, 63); can = (qkb2 + fq - fl) < (mrun - THR2); }
          const int wall = __all(can); if (lane == 0) vote[w] = (unsigned)wall; }
        { { float x[8] = {bflo(kv.x), bfhi(kv.x), bflo(kv.y), bfhi(kv.y), bflo(kv.z), bfhi(kv.z), bflo(kv.w), bfhi(kv.w)}; float ss = 0.f;
#pragma unroll
              for (int i = 0; i < 8; ++i) ss += x[i] * x[i];
              ss += __shfl_xor(ss, 1); ss += __shfl_xor(ss, 2); ss += __shfl_xor(ss, 4);
              const float rs = 1.0f / sqrtf(ss * (1.f / 64.f) + 1e-6f);
              u32x4 kn; kn.x = pk2(x[0] * rs * gkr[0], x[1] * rs * gkr[1]); kn.y = pk2(x[2] * rs * gkr[2], x[3] * rs * gkr[3]); kn.z = pk2(x[4] * rs * gkr[4], x[5] * rs * gkr[5]); kn.w = pk2(x[6] * rs * gkr[6], x[7] * rs * gkr[7]);
              *(u32x4*)(Ks + lkey * 72 + lch * 8) = kn; }
            bf16* vd = Vt + (lch * 8) * 72 + (lkey ^ (8 * lch));
            vd[0] = (bf16)(vv.x & 0xffff); vd[72] = (bf16)(vv.x >> 16); vd[144] = (bf16)(vv.y & 0xffff); vd[216] = (bf16)(vv.y >> 16);
            vd[288] = (bf16)(vv.z & 0xffff); vd[360] = (bf16)(vv.z >> 16); vd[432] = (bf16)(vv.w & 0xffff); vd[504] = (bf16)(vv.w >> 16);
            if (c.tid < 64) fks[c.tid] = fkv;
            if (kt > 0) { kv = GLD(u32x4, K + gbase + (size_t)(k0 - 64) * 512); vv = GLD(u32x4, V + gbase + (size_t)(k0 - 64) * 512); fkv = GLD(float, FCh + k0 - 64 + (c.tid & 63)); } }
        LDS_BARRIER();
        { unsigned all = vote[0] & vote[1] & vote[2] & vote[3] & vote[4] & vote[5] & vote[6] & vote[7]; if (all) break; }
        if (k0 > q0 + 16 * w + 15) continue;
        f32x4 s[4];
#pragma unroll
        for (int nt = 0; nt < 4; ++nt) { const bf16* kp = Ks + (16 * nt + lq) * 72 + 8 * g; const bf16x8 a0 = *(const bf16x8*)kp, a1 = *(const bf16x8*)(kp + 32);
            s[nt] = __builtin_amdgcn_mfma_f32_16x16x32_bf16(a0, qf0, (f32x4){0.f, 0.f, 0.f, 0.f}, 0, 0, 0);
            s[nt] = __builtin_amdgcn_mfma_f32_16x16x32_bf16(a1, qf1, s[nt], 0, 0, 0); }
        float mx = -INFINITY;
#pragma unroll
        for (int nt = 0; nt < 4; ++nt) { const f32x4 fk = *(const f32x4*)(fks + 16 * nt + 4 * g);
#pragma unroll
            for (int j = 0; j < 4; ++j) { float x = s[nt][j] + fq - fk[j]; const int key = k0 + 16 * nt + 4 * g + j; if (key > qrow) x = -INFINITY; s[nt][j] = x; mx = fmaxf(mx, x); } }
        mx = fmaxf(mx, __shfl_xor(mx, 16)); mx = fmaxf(mx, __shfl_xor(mx, 32));
        const float mnew = fmaxf(mrun, mx), alpha = __builtin_amdgcn_exp2f(mrun - mnew); mrun = mnew;
        float psum = 0.f;
#pragma unroll
        for (int nt = 0; nt < 4; ++nt)
#pragma unroll
            for (int j = 0; j < 4; ++j) { const float p = __builtin_amdgcn_exp2f(s[nt][j] - mnew); s[nt][j] = p; psum += p; }
        lsum = lsum * alpha + psum;
#pragma unroll
        for (int dt = 0; dt < 4; ++dt) o[dt] = o[dt] * alpha;
        bf16x8 pb[2];
#pragma unroll
        for (int k2 = 0; k2 < 2; ++k2) { u32x4 pw; pw.x = pk2(s[2 * k2][0], s[2 * k2][1]); pw.y = pk2(s[2 * k2][2], s[2 * k2][3]); pw.z = pk2(s[2 * k2 + 1][0], s[2 * k2 + 1][1]); pw.w = pk2(s[2 * k2 + 1][2], s[2 * k2 + 1][3]);
            pb[k2] = __builtin_bit_cast(bf16x8, pw); }
#pragma unroll
        for (int dt = 0; dt < 4; ++dt)
#pragma unroll
            for (int k2 = 0; k2 < 2; ++k2) { const int vrow = 16 * dt + lq, vx = 8 * ((vrow >> 3) & 7); const bf16* vp = Vt + vrow * 72;
                const u32x2 lo = *(const u32x2*)(vp + ((32 * k2 + 4 * g) ^ vx)), hi = *(const u32x2*)(vp + ((32 * k2 + 16 + 4 * g) ^ vx));
                u32x4 aw; aw.x = lo.x; aw.y = lo.y; aw.z = hi.x; aw.w = hi.y;
                o[dt] = __builtin_amdgcn_mfma_f32_16x16x32_bf16(__builtin_bit_cast(bf16x8, aw), pb[k2], o[dt], 0, 0, 0); }
    }
    lsum += __shfl_xor(lsum, 16); lsum += __shfl_xor(lsum, 32);
    const float inv = 1.0f / lsum;
    bf16* op = O + (rowb + qrow) * 512 + h * 64 + 4 * g;
#pragma unroll
    for (int dt = 0; dt < 4; ++dt) { u32x2 ow; ow.x = pk2(o[dt][0] * inv, o[dt][1] * inv); ow.y = pk2(o[dt][2] * inv, o[dt][3] * inv); GST(u32x2, op + 16 * dt) = ow; }
    __syncthreads();
}
__device__ __forceinline__ void phase_attn(const Params& P, int l, const Ctx& c, int first_blk) {
    const bf16* Q = (const bf16*)(c.ws + OFF_Q); const bf16* K = (const bf16*)(c.ws + OFF_K); const bf16* V = (const bf16*)(c.ws + OFF_V);
    const float* FC = (const float*)(c.ws + OFF_MISC) + 16 * LP;
    float gqm = fabsf(P.in[5][l * 64 + c.lane]), gkm = fabsf(P.in[6][l * 64 + c.lane]);
#pragma unroll
    for (int o = 1; o < 64; o <<= 1) { gqm = fmaxf(gqm, __shfl_xor(gqm, o)); gkm = fmaxf(gkm, __shfl_xor(gkm, o)); }
    const float qkb2 = 8.0f * gqm * gkm * LOG2E * 1.03f;
    constexpr int NQB = LP / 128, NU = 16 * NQB;
    unsigned* ctr = (unsigned*)(c.ws + OFF_CTL) + 8192 + 64 * l;
    volatile unsigned* slot = (volatile unsigned*)(c.lds + MISC_OFF) + 4;
    for (;;) {
        __syncthreads();
        if (c.tid == 0) *slot = atomicAdd(ctr, 1u);
        __syncthreads();
        const int u = (int)*slot;
        if (u >= NU) break;
        const int bh = u & 15, qb = NQB - 1 - (u >> 4); attn_unit(c, bh, qb, Q, K, V, (bf16*)(c.ws + OFF_OF), FC, qkb2, P.in[5] + l * 64, P.in[6] + l * 64);
    }
}

__device__ __forceinline__ void phase_fixup(const Params& P, int l, const Ctx& c) {
    bf16* ACT = (bf16*)(c.ws + OFF_RW); const bf16* HALO = (const bf16*)(c.ws + OFF_Q);
    const float* cw = P.in[24] + (size_t)l * 3 * NUP;
    const int total = (M / 64) * 2 * DFF;
    for (int idx = c.bid * NTHR + c.tid; idx < total; idx += c.G * NTHR) {
        const int rr = idx / DFF, ch = idx - rr * DFF, q64 = rr >> 1, e = rr & 1, row = q64 * 64 + e;
        const int t = row % LP;
        int s0, s1, s2;
        if (e == 0) { s0 = q64 * 4 + 2; s1 = (q64 - 1) * 4 + 1; s2 = (q64 - 1) * 4 + 0; } else { s0 = q64 * 4 + 3; s1 = q64 * 4 + 2; s2 = (q64 - 1) * 4 + 1; }
        float uc[2];
#pragma unroll
        for (int bj = 0; bj < 2; ++bj) { const int col = bj * DFF + ch;
            const float u0 = bf2f(HALO[(size_t)s0 * NUP + col]);
            const float u1 = (t >= 1) ? bf2f(HALO[(size_t)s1 * NUP + col]) : 0.f;
            const float u2 = (t >= 2) ? bf2f(HALO[(size_t)s2 * NUP + col]) : 0.f;
            uc[bj] = cw[col] * u2 + cw[NUP + col] * u1 + cw[2 * NUP + col] * u0; }
        ACT[(size_t)row * DFF + ch] = (bf16)f2bf(uc[0] * sigmoidf_(uc[0]) * uc[1]);
    }
}

#define OPQ_S(x) asm volatile("" : "+s"(x))
#define OPQ_V(x) asm volatile("" : "+v"(x))
#define PHASE_BEGIN() do { int t_ = threadIdx.x; OPQ_V(t_); c.tid = t_; c.lane = t_ & 63; c.wave = __builtin_amdgcn_readfirstlane(t_ >> 6); int b_ = blockIdx.x; OPQ_S(b_); c.bid = b_; \
    size_t z_ = 0; OPQ_S(z_); unsigned char* w_ = P.ws + z_;   c.ws = w_; ws = w_; l = lc; OPQ_S(l); WT = (pg8::bf16_t*)(ws + OFF_WT); HN = (pg8::bf16_t*)(ws + OFF_HN); } while (0)
__global__ void __launch_bounds__(NTHR, 2) mega(Params P) {
    extern __shared__ __attribute__((aligned(16))) unsigned char lds[];
    Ctx c; c.G = gridDim.x; c.lds = lds;
    volatile LAS unsigned* MISC = (volatile LAS unsigned*)((LAS unsigned char*)lds + MISC_OFF);
    if (threadIdx.x < 16) MISC[threadIdx.x] = 0u;
    __syncthreads();
    (void)xcd_barrier_post((unsigned*)(P.ws + OFF_CTL) + 1024, MISC + 8);
#define SEAM() do { XcdBarrier xb_; xb_.bar = (unsigned*)(P.ws + OFF_CTL) + 1024; xb_.x = xb_xcc_id(); xb_.st = (volatile LAS unsigned*)((LAS unsigned char*)lds + MISC_OFF) + 8; xcd_barrier(xb_); } while (0)
    PG8_LAS unsigned char* ldsl = (PG8_LAS unsigned char*)lds;
    unsigned char* ws; pg8::bf16_t* WT; pg8::bf16_t* HN; int l;
#pragma unroll 1
    for (int lc = 0; lc < DEPTH; ++lc) {
        PHASE_BEGIN();
        convert_weights(P, l, c);
        phase_norm<true>(P, l, c);
        SEAM();
        if (P.out == nullptr) cg::this_grid().sync();
        PHASE_BEGIN();
        phase_fcum(P, c);
        { pg8::Gemm g{HN, WT + WT_IN, M, N1, 1024, 1024}; pg8::StaticOrder S; S.init(M, N1, c.G, c.bid);
          pg8::EpiRoute E{ws};
          pg8::gemm_phase<pg8::EpiRoute, pg8::StaticOrder, true, true>(ldsl, g, S, E); }
        SEAM();
        PHASE_BEGIN();
        for (int rep_ = 0; rep_ < REP_PREP; ++rep_) phase_rwkv_prep(P, l, c);
        SEAM();
        PHASE_BEGIN();
        if (c.bid < 16) { scan_chunked(P, c, c.bid); __syncthreads(); PHASE_BEGIN(); }
        phase_attn(P, l, c, 16);
#if REP_P3 > 1
        __syncthreads(); PHASE_BEGIN();
        if (c.bid < 16) scan_chunked(P, c, c.bid); else phase_attn(P, l, c, 16);
#endif
        SEAM();
        PHASE_BEGIN();
        phase_gn(P, l, c);
        for (int rep_ = 0; rep_ < REP_SYNC; ++rep_) SEAM();
        SEAM();
        PHASE_BEGIN();
#pragma unroll 1
        for (int pass = 0; pass < 3; ++pass) {
            if (pass) { __syncthreads(); PHASE_BEGIN(); }
            const int rw_side = pass == 2 ? ((c.bid >> 2) & 1) : pass;
            const pg8::bf16_t* A = rw_side ? (const pg8::bf16_t*)(ws + OFF_RW + (size_t)M * 512 * 4) : (const pg8::bf16_t*)(ws + OFF_OF);
            pg8::Gemm g{A, WT + (rw_side ? WT_BR : WT_BF), M, 1024, 512, 512};
            pg8::OneUnit S; S.so.init(MMAIN, 1024, c.G, c.bid); S.mode = pass == 2; S.pm = MMAIN / 256; S.pn = c.bid & 3; S.active = c.bid < 8;
            pg8::bf16_t* O = (pass == 2 && rw_side) ? (pg8::bf16_t*)(ws + OFF_TAIL) - (size_t)MMAIN * 1024 : (pg8::bf16_t*)(ws + OFF_K);
            pg8::EpiGateR E{O, (const pg8::bf16_t*)(ws + OFF_GT), P.in[21] + l * NGT, rw_side * 1024, pass == 1};
            pg8::gemm_phase<pg8::EpiGateR, pg8::OneUnit, true, true>(ldsl, g, S, E);
        }
        SEAM();
        PHASE_BEGIN();
#pragma unroll 1
        for (int pass = 0; pass < 2; ++pass) {
            if (pass) { __syncthreads(); PHASE_BEGIN(); }
            const int sl = pass ? (c.bid >> 2) : 0, ks = sl & 3;
            const pg8::bf16_t* A = (pass && sl >= 4) ? (const pg8::bf16_t*)(ws + OFF_TAIL) - (size_t)MMAIN * 1024 : (const pg8::bf16_t*)(ws + OFF_K);
            pg8::Gemm g{A + ks * 256, WT + WT_O + ks * 256, M, 1024, pass ? 256 : 1024, 1024};
            pg8::OneUnit S; S.so.init(MMAIN, 1024, c.G, c.bid); S.mode = pass; S.pm = MMAIN / 256; S.pn = c.bid & 3; S.active = sl < 8;
            pg8::EpiResid E{(float*)(ws + OFF_H), nullptr, pass};
            pg8::gemm_phase<pg8::EpiResid, pg8::OneUnit, true, true>(ldsl, g, S, E);
        }
        SEAM();
        PHASE_BEGIN();
        phase_norm<false>(P, l, c);
        SEAM();
        PHASE_BEGIN();
        { pg8::Gemm g{HN, WT + WT_UP, M, NUP, 1024, 1024}; pg8::StaticOrder S; S.init(M, NUP, c.G, c.bid);
          pg8::EpiUp E{(pg8::bf16_t*)(ws + OFF_RW), (pg8::bf16_t*)(ws + OFF_Q), P.in[24] + (size_t)l * 3 * NUP};
          pg8::gemm_phase<pg8::EpiUp, pg8::StaticOrder, true, true>(ldsl, g, S, E); }
        SEAM();
        PHASE_BEGIN();
        phase_fixup(P, l, c);
        SEAM();
        PHASE_BEGIN();
#pragma unroll 1
        for (int pass = 0; pass < 2; ++pass) {
            if (pass) { __syncthreads(); PHASE_BEGIN(); }
            const int sl = pass ? (c.bid >> 2) : 0;
            const int ko = (sl < 6) ? sl * 384 : 2304 + (sl - 6) * 256, kl = (sl < 6) ? 384 : 256;
            pg8::Gemm g{(const pg8::bf16_t*)(ws + OFF_RW) + (pass ? ko : 0), WT + WT_DN + (pass ? ko : 0), M, 1024, pass ? kl : DFF, DFF};
            pg8::OneUnit S; S.so.init(MMAIN, 1024, c.G, c.bid); S.mode = pass; S.pm = MMAIN / 256; S.pn = c.bid & 3; S.active = sl < 8;
            pg8::EpiResid E{(float*)(ws + OFF_H), (l == DEPTH - 1 && !pass) ? P.out : nullptr, pass};
            pg8::gemm_phase<pg8::EpiResid, pg8::OneUnit, true, true>(ldsl, g, S, E);
        }
        SEAM();
        if (l == DEPTH - 1) {
            PHASE_BEGIN();
            const float* H = (const float*)(ws + OFF_H);
            for (int idx = c.bid * NTHR + c.tid; idx < (NMETA + SEQ - (MMAIN - LP)) * (DM / 4); idx += c.G * NTHR) {
                const int r = idx / (DM / 4), q4 = idx - r * (DM / 4), t = (MMAIN - LP) + r;
                *(f32x4*)(P.out + ((size_t)SEQ + (t - NMETA)) * DM + 4 * q4) = *(const f32x4*)(H + (size_t)(LP + t) * DM + 4 * q4);
            }
        }
    }
}

extern "C" void kernel_launch(void* const* d_in, const int* in_sizes, int n_in, void* d_out, int out_size, void* d_ws, size_t ws_size, hipStream_t stream) {
    static int grid = 0;
    if (grid == 0) {
        if (n_in != 26 || out_size != NB * SEQ * DM || ws_size < WS_NEED) { fprintf(stderr, "kernel_launch: unexpected shapes (n_in %d out %d ws %zu need %zu)\n", n_in, out_size, ws_size, (size_t)WS_NEED); grid = -1; return; }
        int dev = 0, cus = 0, per_cu = 0;
        if (hipGetDevice(&dev) != hipSuccess || hipDeviceGetAttribute(&cus, hipDeviceAttributeMultiprocessorCount, dev) != hipSuccess) { grid = -1; return; }
        if (hipFuncSetAttribute((const void*)mega, hipFuncAttributeMaxDynamicSharedMemorySize, LDS_BYTES) != hipSuccess) { fprintf(stderr, "kernel_launch: hipFuncSetAttribute failed\n"); grid = -1; return; }
        if (hipOccupancyMaxActiveBlocksPerMultiprocessor(&per_cu, (const void*)mega, NTHR, LDS_BYTES) != hipSuccess || per_cu < 1) { fprintf(stderr, "kernel_launch: occupancy query says %d\n", per_cu); per_cu = 1; }
        (void)hipGetLastError();
        grid = cus;
    }
    if (grid < 0) return;
    if (hipMemsetAsync((char*)d_ws + OFF_CTL, 0, 65536, stream) != hipSuccess) { fprintf(stderr, "kernel_launch: memset failed\n"); return; }
    Params p{};
    for (int i = 0; i < 26; ++i) p.in[i] = (const float*)d_in[i];
    p.out = (float*)d_out; p.ws = (unsigned char*)d_ws;
    void* args[] = {&p};
    hipError_t e = hipLaunchCooperativeKernel((const void*)mega, dim3(grid), dim3(NTHR), args, LDS_BYTES, stream);
    if (e != hipSuccess) fprintf(stderr, "kernel_launch: cooperative launch failed: %s (grid %d)\n", hipGetErrorString(e), grid);
}
```
